# Optimizing an MI355X kernel written in HIP

```python
import math
import jax, jax.numpy as jnp
from jax import lax
import numpy as np

D_MODEL = 2048
BATCH = 2
SEQ = 8192
DEPTH = 1

CHUNK = 64
N_PREV_CHUNKS = 8
BAND = N_PREV_CHUNKS + 1
REL_CLIP = 128

A_HEADS = 8
A_HEAD_DIM = 128
A_WIDTH = A_HEADS * A_HEAD_DIM

LRU_WIDTH = 512
LRU_BLOCKS = 8
LRU_BLOCK_DIM = LRU_WIDTH // LRU_BLOCKS
CONV_WIDTH = 4
LRU_C = 8.0

N_MEM = 256
C_HEADS = 4
C_HEAD_DIM = 128
C_WIDTH = C_HEADS * C_HEAD_DIM

MIX_WIDTH = A_WIDTH + LRU_WIDTH + C_WIDTH
IN_WIDTH = 3 * A_WIDTH + 2 * LRU_WIDTH + C_WIDTH
N_BRANCHES = 3

PEER_HEADS = 8
N_KEYS = 128
N_EXPERTS = N_KEYS * N_KEYS
PEER_QDIM = 256
PEER_HALF = PEER_QDIM // 2
PEER_TOPK = 16
TOK_BLOCK = 128

EPS = 1e-6
NEG = -1e30

kernel_name = "hybrid_chunk_attn_rglru_memxattn_peer"


def rms_norm(x, g):
    xf = x.astype(jnp.float32)
    y = xf * lax.rsqrt(jnp.mean(xf * xf, axis=-1, keepdims=True) + EPS)
    return (y * g.astype(jnp.float32)).astype(x.dtype)


def chunk_band_attention(q, k, v, rel_bias):
    B, S, H, Dh = q.shape
    nC = S // CHUNK
    qc = q.reshape(B, nC, CHUNK, H, Dh)
    pad = ((0, 0), (N_PREV_CHUNKS, 0), (0, 0), (0, 0), (0, 0))
    kp = jnp.pad(k.reshape(B, nC, CHUNK, H, Dh), pad)
    vp = jnp.pad(v.reshape(B, nC, CHUNK, H, Dh), pad)
    kb = jnp.concatenate([kp[:, j:j + nC] for j in range(BAND)], axis=2)
    vb = jnp.concatenate([vp[:, j:j + nC] for j in range(BAND)], axis=2)
    s = jnp.einsum('bnqhd,bnkhd->bnhqk', qc, kb).astype(jnp.float32) * (Dh ** -0.5)
    qi = np.arange(CHUNK)[:, None]
    km = np.arange(BAND * CHUNK)[None, :]
    dist = N_PREV_CHUNKS * CHUNK + qi - km
    ridx = np.clip(dist, -REL_CLIP, REL_CLIP) + REL_CLIP
    bias = rel_bias[:, ridx].astype(jnp.float32)
    valid = (np.arange(nC)[:, None] + km // CHUNK) >= N_PREV_CHUNKS
    s = jnp.where(valid[None, :, None, None, :], s + bias[None, None], NEG)
    p = jax.nn.softmax(s, axis=-1).astype(v.dtype)
    o = jnp.einsum('bnhqk,bnkhd->bnqhd', p, vb)
    return o.reshape(B, S, H * Dh)


def rg_lru_branch(xl, gl, conv_w, conv_b, wa, ba, wx, bx, lam):
    B, S, W = xl.shape
    xc = lax.conv_general_dilated(
        xl, conv_w.astype(xl.dtype)[:, None, :], window_strides=(1,),
        padding=[(CONV_WIDTH - 1, 0)], dimension_numbers=('NWC', 'WIO', 'NWC'),
        feature_group_count=W) + conv_b
    xg = xc.reshape(B, S, LRU_BLOCKS, LRU_BLOCK_DIM)
    r = jax.nn.sigmoid(jnp.einsum('bsgi,gij->bsgj', xg, wa).reshape(B, S, W) + ba).astype(jnp.float32)
    i = jax.nn.sigmoid(jnp.einsum('bsgi,gij->bsgj', xg, wx).reshape(B, S, W) + bx).astype(jnp.float32)
    log_a = -LRU_C * r * jax.nn.softplus(-lam.astype(jnp.float32))
    a = jnp.exp(log_a)
    mult = jnp.sqrt(jnp.clip(1.0 - jnp.exp(2.0 * log_a), 1e-12, 1.0))
    u = mult * (i * xc.astype(jnp.float32))

    def combine(l, r_):
        a1, b1 = l
        a2, b2 = r_
        return a1 * a2, a2 * b1 + b2

    _, h = lax.associative_scan(combine, (a, u), axis=1)
    return (h * jax.nn.gelu(gl.astype(jnp.float32))).astype(xl.dtype)


def memory_cross_attention(qc, mem, mem_norm_g, w_mem_kv, xq_g, xk_g):
    B, S, _ = qc.shape
    mn = rms_norm(mem, mem_norm_g)
    kv = mn @ w_mem_kv
    k, v = jnp.split(kv, 2, axis=-1)
    q = rms_norm(qc.reshape(B, S, C_HEADS, C_HEAD_DIM), xq_g)
    k = rms_norm(k.reshape(B, N_MEM, C_HEADS, C_HEAD_DIM), xk_g)
    v = v.reshape(B, N_MEM, C_HEADS, C_HEAD_DIM)
    s = jnp.einsum('bshd,bmhd->bhsm', q, k).astype(jnp.float32) * (C_HEAD_DIM ** -0.5)
    p = jax.nn.softmax(s, axis=-1).astype(v.dtype)
    return jnp.einsum('bhsm,bmhd->bshd', p, v).reshape(B, S, C_WIDTH)


def peer(h, w_peer_q, peer_keys, peer_u, peer_v):
    B, S, D = h.shape
    q = (h @ w_peer_q).reshape(B, S, PEER_HEADS, 2, PEER_HALF)
    s = jnp.einsum('bshcd,hckd->bshck', q, peer_keys).astype(jnp.float32)
    sv, si = lax.top_k(s, PEER_TOPK)
    cand = (sv[..., 0, :, None] + sv[..., 1, None, :]).reshape(B, S, PEER_HEADS, PEER_TOPK * PEER_TOPK)
    cidx = (si[..., 0, :, None] * N_KEYS + si[..., 1, None, :]).reshape(B, S, PEER_HEADS, PEER_TOPK * PEER_TOPK)
    fv, fpos = lax.top_k(cand, PEER_TOPK)
    idx = jnp.take_along_axis(cidx, fpos, axis=-1)
    g = jax.nn.softmax(fv, axis=-1).astype(h.dtype)
    nb = (B * S) // TOK_BLOCK
    xb = h.reshape(nb, TOK_BLOCK, D)
    ib = idx.reshape(nb, TOK_BLOCK, PEER_HEADS, PEER_TOPK)
    gb = g.reshape(nb, TOK_BLOCK, PEER_HEADS, PEER_TOPK)

    def block(args):
        xt, it, gt = args
        u = peer_u[it]
        act = jax.nn.gelu(jnp.einsum('thkd,td->thk', u, xt)) * gt
        return jnp.einsum('thk,thkd->td', act, peer_v[it])

    out = lax.map(block, (xb, ib, gb))
    return out.reshape(B, S, D)


def setup_inputs(seed: int = 0) -> dict:
    key = jax.random.key(seed)
    ks = jax.random.split(key, 32)
    f32 = jnp.float32
    D = D_MODEL
    nrm = lambda k, shape, scale: jax.random.normal(k, shape, f32) * scale
    gain = lambda k, shape: 1.0 + 0.02 * jax.random.normal(k, shape, f32)
    a_init = jax.random.uniform(ks[10], (LRU_WIDTH,), f32, 0.9, 0.999) ** (1.0 / LRU_C)
    lru_lambda = jnp.log(a_init) - jnp.log1p(-a_init)
    w_branch = jnp.concatenate([
        nrm(ks[17], (A_WIDTH, D), A_WIDTH ** -0.5),
        nrm(ks[18], (LRU_WIDTH, D), LRU_WIDTH ** -0.5),
        nrm(ks[19], (C_WIDTH, D), C_WIDTH ** -0.5)], axis=0)
    return {
        "x": nrm(ks[0], (BATCH, SEQ, D), 1.0),
        "mem": nrm(ks[1], (BATCH, N_MEM, D), 1.0),
        "norm1_g": gain(ks[2], (D,)),
        "w_in": nrm(ks[3], (D, IN_WIDTH), D ** -0.5),
        "attn_q_norm_g": gain(ks[4], (A_HEAD_DIM,)),
        "attn_k_norm_g": gain(ks[5], (A_HEAD_DIM,)),
        "rel_bias": nrm(ks[6], (A_HEADS, 2 * REL_CLIP + 1), 0.1),
        "conv_w": nrm(ks[7], (CONV_WIDTH, LRU_WIDTH), CONV_WIDTH ** -0.5),
        "conv_b": nrm(ks[8], (LRU_WIDTH,), 0.02),
        "lru_wa": nrm(ks[9], (LRU_BLOCKS, LRU_BLOCK_DIM, LRU_BLOCK_DIM), LRU_BLOCK_DIM ** -0.5),
        "lru_ba": nrm(ks[11], (LRU_WIDTH,), 0.02),
        "lru_wx": nrm(ks[12], (LRU_BLOCKS, LRU_BLOCK_DIM, LRU_BLOCK_DIM), LRU_BLOCK_DIM ** -0.5),
        "lru_bx": nrm(ks[13], (LRU_WIDTH,), 0.02),
        "lru_lambda": lru_lambda,
        "mem_norm_g": gain(ks[14], (D,)),
        "w_mem_kv": nrm(ks[15], (D, 2 * C_WIDTH), D ** -0.5),
        "xq_norm_g": gain(ks[16], (C_HEAD_DIM,)),
        "xk_norm_g": gain(ks[20], (C_HEAD_DIM,)),
        "w_gate": nrm(ks[21], (D, N_BRANCHES * D), D ** -0.5),
        "b_gate": nrm(ks[22], (N_BRANCHES * D,), 0.02),
        "w_branch": w_branch,
        "w_o": nrm(ks[23], (D, D), D ** -0.5),
        "norm2_g": gain(ks[24], (D,)),
        "w_peer_q": nrm(ks[25], (D, PEER_HEADS * PEER_QDIM), D ** -0.5),
        "peer_keys": nrm(ks[26], (PEER_HEADS, 2, N_KEYS, PEER_HALF), PEER_HALF ** -0.5),
        "peer_u": nrm(ks[27], (N_EXPERTS, D), D ** -0.5),
        "peer_v": nrm(ks[28], (N_EXPERTS, D), 0.5),
    }


def reference(x, mem, norm1_g, w_in, attn_q_norm_g, attn_k_norm_g, rel_bias, conv_w, conv_b,
              lru_wa, lru_ba, lru_wx, lru_bx, lru_lambda, mem_norm_g, w_mem_kv, xq_norm_g, xk_norm_g,
              w_gate, b_gate, w_branch, w_o, norm2_g, w_peer_q, peer_keys, peer_u, peer_v):
    B, S, D = x.shape
    for _ in range(DEPTH):
        h = rms_norm(x, norm1_g)
        proj = h @ w_in
        cuts = np.cumsum([A_WIDTH, A_WIDTH, A_WIDTH, LRU_WIDTH, LRU_WIDTH])
        qa, ka, va, xl, gl, qc = jnp.split(proj, cuts, axis=-1)

        qa = rms_norm(qa.reshape(B, S, A_HEADS, A_HEAD_DIM), attn_q_norm_g)
        ka = rms_norm(ka.reshape(B, S, A_HEADS, A_HEAD_DIM), attn_k_norm_g)
        va = va.reshape(B, S, A_HEADS, A_HEAD_DIM)
        o_a = chunk_band_attention(qa, ka, va, rel_bias)

        o_b = rg_lru_branch(xl, gl, conv_w, conv_b, lru_wa, lru_ba, lru_wx, lru_bx, lru_lambda)

        o_c = memory_cross_attention(qc, mem, mem_norm_g, w_mem_kv, xq_norm_g, xk_norm_g)

        y_a = o_a @ w_branch[:A_WIDTH]
        y_b = o_b @ w_branch[A_WIDTH:A_WIDTH + LRU_WIDTH]
        y_c = o_c @ w_branch[A_WIDTH + LRU_WIDTH:]
        g = jax.nn.sigmoid(h @ w_gate + b_gate).reshape(B, S, N_BRANCHES, D)
        merged = g[:, :, 0] * y_a + g[:, :, 1] * y_b + g[:, :, 2] * y_c
        x = x + merged @ w_o

        x = x + peer(rms_norm(x, norm2_g), w_peer_q, peer_keys, peer_u, peer_v)
    return x
```

```cpp
#include <hip/hip_runtime.h>
#include <hip/hip_cooperative_groups.h>
#include <cstdio>
#include <cstdint>
namespace cg = cooperative_groups;

typedef unsigned short bf16_t;
typedef short bf16x8 __attribute__((ext_vector_type(8)));
typedef float f32x4 __attribute__((ext_vector_type(4)));
typedef unsigned u32x4 __attribute__((ext_vector_type(4)));
typedef unsigned u32x2 __attribute__((ext_vector_type(2)));

constexpr int D = 2048, BATCH = 2, SEQ = 8192, T = BATCH * SEQ;
constexpr int CHUNK = 64, NPREV = 8, NCH = SEQ / CHUNK;
constexpr int AW = 1024, LW = 512, CW = 512, INW = 4608, GW = 6144;
constexpr int NMEM = 256;
constexpr int PH = 8, NKEYS = 128, TOPK = 16;
constexpr float EPS = 1e-6f;
constexpr int C_QA = 0, C_KA = 1024, C_VA = 2048, C_XL = 3072, C_GL = 3584, C_QC = 4096;

constexpr size_t MiB = 1u << 20;
constexpr size_t WS_CTL = 0;
constexpr size_t WS_WT_IN = 2 * MiB, WS_WT_GATE = 20 * MiB, WS_WT_BR = 44 * MiB, WS_WT_O = 52 * MiB, WS_WT_PQ = 60 * MiB, WS_WT_MKV = 68 * MiB;
constexpr size_t WS_KEYSB = 72 * MiB, WS_MEMN = 73 * MiB, WS_MEMKV = 75 * MiB, WS_LRUSUM = 76 * MiB, WS_RS2 = 77 * MiB;
constexpr size_t WS_HO = 80 * MiB;
constexpr size_t WS_PROJ = 144 * MiB;
constexpr size_t WS_MERGED = 144 * MiB, WS_X2BF = 208 * MiB;
constexpr size_t WS_G = 288 * MiB;
constexpr size_t WS_TABU = 288 * MiB, WS_TABV = 352 * MiB, WS_Q = 416 * MiB;
constexpr size_t WS_RIDX = 480 * MiB, WS_RG = 488 * MiB, WS_END = 496 * MiB;

struct Params { const float* in[27]; float* out; unsigned char* ws; };

__device__ __forceinline__ float bf2f(unsigned v16) { return __uint_as_float(v16 << 16); }
__device__ __forceinline__ unsigned f2bf(float f) { unsigned u = __float_as_uint(f); return (u + 0x7fffu + ((u >> 16) & 1u)) >> 16; }
__device__ __forceinline__ unsigned pk2(float lo, float hi) { return f2bf(lo) | (f2bf(hi) << 16); }
__device__ __forceinline__ float wave_sum(float v) {
#pragma unroll
    for (int o = 1; o < 64; o <<= 1) v += __shfl_xor(v, o);
    return v;
}
__device__ __forceinline__ float sigmoid_(float x) { return 1.f / (1.f + __expf(-x)); }
__device__ __forceinline__ float gelu_tanh(float x) { const float y = 1.5957691216f * (x + 0.044715f * x * x * x); return x / (1.f + __expf(-y)); }
__device__ __forceinline__ void unpack8(const u32x4 w, float* f) {
    f[0] = __uint_as_float(w.x << 16); f[1] = __uint_as_float(w.x & 0xffff0000u);
    f[2] = __uint_as_float(w.y << 16); f[3] = __uint_as_float(w.y & 0xffff0000u);
    f[4] = __uint_as_float(w.z << 16); f[5] = __uint_as_float(w.z & 0xffff0000u);
    f[6] = __uint_as_float(w.w << 16); f[7] = __uint_as_float(w.w & 0xffff0000u);
}

__device__ __forceinline__ void transpose_item(const float* __restrict__ W, int K, int N, bf16_t* __restrict__ WT, const float* __restrict__ ks, float* scr, int item, int lane) {
    const int nblk = N / 32, kb = item / nblk, nb = item % nblk, k0 = 64 * kb, n0 = 32 * nb;
#pragma unroll 8
    for (int i = 0; i < 32; ++i) { const int kk = 2 * i + (lane >> 5); float v = W[(size_t)(k0 + kk) * N + n0 + (lane & 31)]; if (ks) v *= ks[k0 + kk]; scr[kk * 33 + (lane & 31)] = v; }
    asm volatile("s_waitcnt lgkmcnt(0)" ::: "memory");
    const int c = lane & 7;
#pragma unroll
    for (int j = 0; j < 4; ++j) { const int n = (lane >> 3) + 8 * j; const float* s = scr + (8 * c) * 33 + n;
        u32x4 o; o.x = pk2(s[0 * 33], s[1 * 33]); o.y = pk2(s[2 * 33], s[3 * 33]); o.z = pk2(s[4 * 33], s[5 * 33]); o.w = pk2(s[6 * 33], s[7 * 33]);
        *(u32x4*)(WT + (size_t)(n0 + n) * K + k0 + 8 * c) = o; }
    asm volatile("s_waitcnt lgkmcnt(0)" ::: "memory");
}
__device__ __forceinline__ void transpose_all(const float* W, int K, int N, bf16_t* WT, const float* ks, float* scr, int gw, int NW, int lane) {
    const int nitems = (K / 64) * (N / 32);
    for (int it = gw; it < nitems; it += NW) transpose_item(W, K, N, WT, ks, scr, it, lane);
}
__device__ __forceinline__ void rms_row_bf16(const float* xrow, const float* g, bf16_t* orow, int lane) {
    const f32x4* xr = (const f32x4*)xrow + lane; const f32x4* gr = (const f32x4*)g + lane;
    f32x4 v[8]; float s = 0.f;
#pragma unroll
    for (int j = 0; j < 8; ++j) { v[j] = xr[64 * j]; s += (v[j].x * v[j].x + v[j].y * v[j].y) + (v[j].z * v[j].z + v[j].w * v[j].w); }
    const float rstd = rsqrtf(wave_sum(s) * (1.f / D) + EPS);
    u32x2* o8 = (u32x2*)orow + lane;
#pragma unroll
    for (int j = 0; j < 8; ++j) { const f32x4 gg = gr[64 * j]; u32x2 o; o.x = pk2(v[j].x * rstd * gg.x, v[j].y * rstd * gg.y); o.y = pk2(v[j].z * rstd * gg.z, v[j].w * rstd * gg.w); o8[64 * j] = o; }
}

template <int TM, int TN, class Epi>
__device__ __forceinline__ void gemm_simple(const bf16_t* __restrict__ A, int lda, const bf16_t* __restrict__ Bt, int ldb, int M, int N, int K, const Epi& epi, int gw, int NW, int lane) {
    const int r = lane & 15, q = lane >> 4;
    const int ntm = M / (16 * TM), ntn = N / (16 * TN);
    for (int tile = gw; tile < ntm * ntn; tile += NW) {
        const int tm = tile / ntn, tn = tile % ntn;
        f32x4 acc[TM][TN];
#pragma unroll
        for (int i = 0; i < TM; ++i)
#pragma unroll
            for (int j = 0; j < TN; ++j) acc[i][j] = (f32x4){0.f, 0.f, 0.f, 0.f};
        const bf16_t* ap = A + (size_t)(tm * 16 * TM + r) * lda + q * 8;
        const bf16_t* bp = Bt + (size_t)(tn * 16 * TN + r) * ldb + q * 8;
        for (int k0 = 0; k0 < K; k0 += 32) {
            bf16x8 af[TM], bfr[TN];
#pragma unroll
            for (int i = 0; i < TM; ++i) af[i] = *(const bf16x8*)(ap + (size_t)i * 16 * lda + k0);
#pragma unroll
            for (int j = 0; j < TN; ++j) bfr[j] = *(const bf16x8*)(bp + (size_t)j * 16 * ldb + k0);
#pragma unroll
            for (int i = 0; i < TM; ++i)
#pragma unroll
                for (int j = 0; j < TN; ++j) acc[i][j] = __builtin_amdgcn_mfma_f32_16x16x32_bf16(af[i], bfr[j], acc[i][j], 0, 0, 0);
        }
#pragma unroll
        for (int i = 0; i < TM; ++i)
#pragma unroll
            for (int j = 0; j < TN; ++j)
#pragma unroll
                for (int e = 0; e < 4; ++e) epi(tm * 16 * TM + i * 16 + q * 4 + e, tn * 16 * TN + j * 16 + r, acc[i][j][e]);
    }
}
struct EpiProj { bf16_t* P; __device__ __forceinline__ void operator()(int row, int col, float v) const { if (col >= C_GL && col < C_QC) v = gelu_tanh(v); P[(size_t)row * INW + col] = (bf16_t)f2bf(v); } };
struct EpiGate { bf16_t* G; const float* b; __device__ __forceinline__ void operator()(int row, int col, float v) const { G[(size_t)row * GW + col] = (bf16_t)f2bf(sigmoid_(v + b[col])); } };
struct EpiStore { bf16_t* C; int ldc; __device__ __forceinline__ void operator()(int row, int col, float v) const { C[(size_t)row * ldc + col] = (bf16_t)f2bf(v); } };
struct EpiWo { const float* x; float* out; bf16_t* xb; __device__ __forceinline__ void operator()(int row, int col, float v) const { const size_t o = (size_t)row * D + col; const float y = x[o] + v; out[o] = y; xb[o] = (bf16_t)f2bf(y); } };
struct EpiQ { bf16_t* Q; const float* rs; __device__ __forceinline__ void operator()(int row, int col, float v) const { Q[(size_t)row * D + col] = (bf16_t)f2bf(v * rs[row]); } };

__device__ __forceinline__ void headnorm(bf16_t* vec, const float* g, float scale, int lane) {
    unsigned* p = (unsigned*)vec + lane; const unsigned w = *p;
    const float a = bf2f(w & 0xffffu), b = bf2f(w >> 16);
    const float rs = rsqrtf(wave_sum(a * a + b * b) * (1.f / 128.f) + EPS) * scale;
    *p = pk2(a * rs * g[2 * lane], b * rs * g[2 * lane + 1]);
}

template <bool PASS2>
__device__ __forceinline__ void lru_unit(const Params& p, int b, int c, int g, int lane) {
    const bf16_t* PROJ = (const bf16_t*)(p.ws + WS_PROJ); bf16_t* O = (bf16_t*)(p.ws + WS_HO);
    float* SUMA = (float*)(p.ws + WS_LRUSUM); float* SUMB = SUMA + BATCH * NCH * LW;
    const float* conv_w = p.in[7]; const float* conv_b = p.in[8]; const float* lru_wa = p.in[9]; const float* lru_ba = p.in[10];
    const float* lru_wx = p.in[11]; const float* lru_bx = p.in[12]; const float* lam = p.in[13];
    const int ch = g * 64 + lane;
    float wa_r[64], wx_r[64];
#pragma unroll
    for (int i = 0; i < 64; ++i) { wa_r[i] = lru_wa[(size_t)(g * 64 + i) * 64 + lane]; wx_r[i] = lru_wx[(size_t)(g * 64 + i) * 64 + lane]; }
    const float cw0 = conv_w[0 * LW + ch], cw1 = conv_w[1 * LW + ch], cw2 = conv_w[2 * LW + ch], cw3 = conv_w[3 * LW + ch], cb = conv_b[ch];
    const float ba_ = lru_ba[ch], bx_ = lru_bx[ch];
    const float sp = log1pf(__expf(-lam[ch]));
    const int t0 = c * CHUNK; const size_t row0 = (size_t)b * SEQ + t0;
    float x0 = 0.f, x1 = 0.f, x2 = 0.f;
    if (t0 >= 3) { x0 = bf2f(PROJ[(row0 - 3) * INW + C_XL + ch]); x1 = bf2f(PROJ[(row0 - 2) * INW + C_XL + ch]); x2 = bf2f(PROJ[(row0 - 1) * INW + C_XL + ch]); }
    float h = 0.f, aprod = 1.f;
    if (PASS2) { for (int j = 0; j < c; ++j) { const size_t o = (size_t)(b * NCH + j) * LW + ch; h = SUMA[o] * h + SUMB[o]; } }
    for (int t = 0; t < CHUNK; ++t) {
        const float x3 = bf2f(PROJ[(row0 + t) * INW + C_XL + ch]);
        const float xc = cw0 * x0 + cw1 * x1 + cw2 * x2 + cw3 * x3 + cb;
        x0 = x1; x1 = x2; x2 = x3;
        float rp = ba_, ip = bx_;
#pragma unroll
        for (int i = 0; i < 64; ++i) { const float xi = __int_as_float(__builtin_amdgcn_readlane(__float_as_int(xc), i)); rp = fmaf(xi, wa_r[i], rp); ip = fmaf(xi, wx_r[i], ip); }
        const float r = sigmoid_(rp), ig = sigmoid_(ip);
        const float la = -8.f * r * sp; const float a = __expf(la);
        const float mult = sqrtf(fminf(fmaxf(-expm1f(2.f * la), 1e-12f), 1.f));
        h = a * h + mult * ig * xc;
        if (PASS2) { const float gg = bf2f(PROJ[(row0 + t) * INW + C_GL + ch]); O[(row0 + t) * D + AW + ch] = (bf16_t)f2bf(h * gg); }
        else aprod *= a;
    }
    if (!PASS2) { const size_t o = (size_t)(b * NCH + c) * LW + ch; SUMA[o] = aprod; SUMB[o] = h; }
}

__device__ __forceinline__ void attn_simple(const bf16_t* Qp, int ldq, const bf16_t* Kp, const bf16_t* Vp, int ldkv, int nkeys, int koff, const float* bias_h, bf16_t* Op, int ldo, int tid) {
    const int qi = tid >> 2, part = tid & 3;
    float q[32], o[32];
    { const u32x4* qp = (const u32x4*)(Qp + (size_t)qi * ldq + part * 32);
#pragma unroll
      for (int j = 0; j < 4; ++j) unpack8(qp[j], q + 8 * j); }
#pragma unroll
    for (int d = 0; d < 32; ++d) o[d] = 0.f;
    float m = -1e30f, l = 0.f;
    for (int kk0 = 0; kk0 < nkeys; kk0 += 8) {
        float s[8];
#pragma unroll
        for (int j = 0; j < 8; ++j) {
            const u32x4* kp = (const u32x4*)(Kp + (size_t)(kk0 + j) * ldkv + part * 32);
            float acc = 0.f;
#pragma unroll
            for (int w = 0; w < 4; ++w) { float kf[8]; unpack8(kp[w], kf);
#pragma unroll
                for (int e = 0; e < 8; ++e) acc = fmaf(q[8 * w + e], kf[e], acc); }
            acc += __shfl_xor(acc, 1); acc += __shfl_xor(acc, 2);
            if (bias_h) { int dist = qi + koff - (kk0 + j); dist = dist < -128 ? -128 : (dist > 128 ? 128 : dist); acc += bias_h[dist + 128]; }
            s[j] = acc;
        }
        float mx = s[0];
#pragma unroll
        for (int j = 1; j < 8; ++j) mx = fmaxf(mx, s[j]);
        const float mn = fmaxf(m, mx), corr = __expf(m - mn);
        l *= corr;
#pragma unroll
        for (int d = 0; d < 32; ++d) o[d] *= corr;
#pragma unroll
        for (int j = 0; j < 8; ++j) {
            const float pj = __expf(s[j] - mn); l += pj;
            const u32x4* vp = (const u32x4*)(Vp + (size_t)(kk0 + j) * ldkv + part * 32);
#pragma unroll
            for (int w = 0; w < 4; ++w) { float vf[8]; unpack8(vp[w], vf);
#pragma unroll
                for (int e = 0; e < 8; ++e) o[8 * w + e] = fmaf(pj, vf[e], o[8 * w + e]); }
        }
        m = mn;
    }
    const float inv = 1.f / l;
    u32x4* op = (u32x4*)(Op + (size_t)qi * ldo + part * 32);
#pragma unroll
    for (int w = 0; w < 4; ++w) { u32x4 ov; ov.x = pk2(o[8 * w] * inv, o[8 * w + 1] * inv); ov.y = pk2(o[8 * w + 2] * inv, o[8 * w + 3] * inv); ov.z = pk2(o[8 * w + 4] * inv, o[8 * w + 5] * inv); ov.w = pk2(o[8 * w + 6] * inv, o[8 * w + 7] * inv); op[w] = ov; }
}

__device__ __forceinline__ void gemm_branch(const bf16_t* __restrict__ Ob, const bf16_t* __restrict__ WT, const bf16_t* __restrict__ G, bf16_t* __restrict__ Mg, int gw, int NW, int lane) {
    const int r = lane & 15, q = lane >> 4;
    const int ntn = D / 32, ntiles = (T / 32) * ntn;
    for (int tile = gw; tile < ntiles; tile += NW) {
        const int tm = tile / ntn, tn = tile % ntn;
        f32x4 acc[3][2][2];
#pragma unroll
        for (int s = 0; s < 3; ++s)
#pragma unroll
            for (int i = 0; i < 2; ++i)
#pragma unroll
                for (int j = 0; j < 2; ++j) acc[s][i][j] = (f32x4){0.f, 0.f, 0.f, 0.f};
        const bf16_t* ap = Ob + (size_t)(tm * 32 + r) * D + q * 8;
        const bf16_t* bp = WT + (size_t)(tn * 32 + r) * D + q * 8;
#pragma unroll
        for (int s = 0; s < 3; ++s) {
            const int kb = s == 0 ? 0 : (s == 1 ? 1024 : 1536), ke = s == 0 ? 1024 : (s == 1 ? 1536 : 2048);
            for (int k0 = kb; k0 < ke; k0 += 32) {
                bf16x8 af[2], bfr[2];
#pragma unroll
                for (int i = 0; i < 2; ++i) af[i] = *(const bf16x8*)(ap + (size_t)i * 16 * D + k0);
#pragma unroll
                for (int j = 0; j < 2; ++j) bfr[j] = *(const bf16x8*)(bp + (size_t)j * 16 * D + k0);
#pragma unroll
                for (int i = 0; i < 2; ++i)
#pragma unroll
                    for (int j = 0; j < 2; ++j) acc[s][i][j] = __builtin_amdgcn_mfma_f32_16x16x32_bf16(af[i], bfr[j], acc[s][i][j], 0, 0, 0);
            }
        }
#pragma unroll
        for (int i = 0; i < 2; ++i)
#pragma unroll
            for (int j = 0; j < 2; ++j)
#pragma unroll
                for (int e = 0; e < 4; ++e) {
                    const int row = tm * 32 + i * 16 + q * 4 + e, col = tn * 32 + j * 16 + r;
                    const bf16_t* gp = G + (size_t)row * GW + col;
                    const float mval = bf2f(gp[0]) * acc[0][i][j][e] + bf2f(gp[2048]) * acc[1][i][j][e] + bf2f(gp[4096]) * acc[2][i][j][e];
                    Mg[(size_t)row * D + col] = (bf16_t)f2bf(mval);
                }
    }
}

__device__ __forceinline__ unsigned long long shfl_xor64(unsigned long long v, int m) {
    const unsigned lo = __shfl_xor((unsigned)v, m), hi = __shfl_xor((unsigned)(v >> 32), m);
    return ((unsigned long long)hi << 32) | lo;
}
__device__ __forceinline__ unsigned fkey(float f) { const unsigned u = __float_as_uint(f); return (u & 0x80000000u) ? ~u : (u | 0x80000000u); }
__device__ __forceinline__ float fkey_inv(unsigned k) { const unsigned u = (k & 0x80000000u) ? (k & 0x7fffffffu) : ~k; return __uint_as_float(u); }
__device__ __forceinline__ unsigned long long wave_max64(unsigned long long k) {
#pragma unroll
    for (int o = 1; o < 64; o <<= 1) { const unsigned long long t = shfl_xor64(k, o); k = t > k ? t : k; }
    return k;
}
__device__ __forceinline__ void route_unit(const Params& p, int t, int h, int lane) {
    const bf16_t* Q = (const bf16_t*)(p.ws + WS_Q); const bf16_t* KB = (const bf16_t*)(p.ws + WS_KEYSB);
    int* RIDX = (int*)(p.ws + WS_RIDX); float* RG = (float*)(p.ws + WS_RG);
    float sv_l[2] = {0.f, 0.f}; int si_l[2] = {0, 0};
#pragma unroll
    for (int c = 0; c < 2; ++c) {
        const bf16_t* qv = Q + (size_t)t * D + h * 256 + c * 128;
        const unsigned qw = ((const unsigned*)qv)[lane];
        const float qa = bf2f(qw & 0xffffu), qb = bf2f(qw >> 16);
        const bf16_t* k0p = KB + ((size_t)(h * 2 + c) * NKEYS + lane) * 128;
        const bf16_t* k1p = k0p + 64 * 128;
        float s0 = 0.f, s1 = 0.f;
#pragma unroll
        for (int w = 0; w < 16; ++w) {
            float k0f[8], k1f[8]; unpack8(((const u32x4*)k0p)[w], k0f); unpack8(((const u32x4*)k1p)[w], k1f);
#pragma unroll
            for (int e = 0; e < 8; e += 2) {
                const int src = 4 * w + e / 2;
                const float xa = __int_as_float(__builtin_amdgcn_readlane(__float_as_int(qa), src));
                const float xb = __int_as_float(__builtin_amdgcn_readlane(__float_as_int(qb), src));
                s0 = fmaf(xa, k0f[e], s0); s0 = fmaf(xb, k0f[e + 1], s0);
                s1 = fmaf(xa, k1f[e], s1); s1 = fmaf(xb, k1f[e + 1], s1);
            }
        }
        unsigned long long ka = ((unsigned long long)fkey(s0) << 32) | (unsigned)(255 - lane);
        unsigned long long kb = ((unsigned long long)fkey(s1) << 32) | (unsigned)(255 - (lane + 64));
        for (int rnd = 0; rnd < TOPK; ++rnd) {
            const unsigned long long best = wave_max64(ka > kb ? ka : kb);
            if (ka == best) ka = 0ull; if (kb == best) kb = 0ull;
            if (lane == rnd) { sv_l[c] = fkey_inv((unsigned)(best >> 32)); si_l[c] = 255 - (int)(best & 0xffffffffu); }
        }
    }
    unsigned long long kc[4];
#pragma unroll
    for (int m = 0; m < 4; ++m) { const int cid = lane + 64 * m, i = cid >> 4, j = cid & 15;
        const float v = __shfl(sv_l[0], i) + __shfl(sv_l[1], j);
        kc[m] = ((unsigned long long)fkey(v) << 32) | (unsigned)(1023 - cid); }
    float fv = 0.f; int cidx = 0;
    for (int rnd = 0; rnd < TOPK; ++rnd) {
        unsigned long long loc = kc[0] > kc[1] ? kc[0] : kc[1]; const unsigned long long loc2 = kc[2] > kc[3] ? kc[2] : kc[3]; loc = loc > loc2 ? loc : loc2;
        const unsigned long long best = wave_max64(loc);
#pragma unroll
        for (int m = 0; m < 4; ++m) if (kc[m] == best) kc[m] = 0ull;
        if (lane == rnd) { fv = fkey_inv((unsigned)(best >> 32)); cidx = 1023 - (int)(best & 0xffffffffu); }
    }
    const float fmax_ = __shfl(fv, 0);
    float e = lane < 16 ? __expf(fv - fmax_) : 0.f;
    float ssum = e;
#pragma unroll
    for (int o = 1; o < 16; o <<= 1) ssum += __shfl_xor(ssum, o);
    const int ci = cidx >> 4, cj = cidx & 15;
    const int e0 = __shfl(si_l[0], ci), e1 = __shfl(si_l[1], cj);
    if (lane < 16) { RIDX[(size_t)t * 128 + h * 16 + lane] = e0 * NKEYS + e1; RG[(size_t)t * 128 + h * 16 + lane] = e / ssum; }
}

__device__ __forceinline__ void peer_token(const Params& p, int t, int lane) {
    const bf16_t* XB = (const bf16_t*)(p.ws + WS_X2BF); const bf16_t* TU = (const bf16_t*)(p.ws + WS_TABU); const bf16_t* TV = (const bf16_t*)(p.ws + WS_TABV);
    const int* RIDX = (const int*)(p.ws + WS_RIDX); const float* RG = (const float*)(p.ws + WS_RG); const float* RS2 = (const float*)(p.ws + WS_RS2);
    float xf[32], of[32];
#pragma unroll
    for (int j = 0; j < 4; ++j) unpack8(*(const u32x4*)(XB + (size_t)t * D + j * 512 + lane * 8), xf + 8 * j);
#pragma unroll
    for (int d = 0; d < 32; ++d) of[d] = 0.f;
    const float rs = RS2[t];
    const int i0 = RIDX[(size_t)t * 128 + lane], i1 = RIDX[(size_t)t * 128 + 64 + lane];
    const float g0 = RG[(size_t)t * 128 + lane], g1 = RG[(size_t)t * 128 + 64 + lane];
    for (int pi = 0; pi < 128; ++pi) {
        const int e = (pi < 64) ? __shfl(i0, pi) : __shfl(i1, pi - 64);
        const float g = (pi < 64) ? __shfl(g0, pi) : __shfl(g1, pi - 64);
        const bf16_t* ur = TU + (size_t)e * D + lane * 8; const bf16_t* vr = TV + (size_t)e * D + lane * 8;
        float dot = 0.f;
#pragma unroll
        for (int j = 0; j < 4; ++j) { float uf[8]; unpack8(*(const u32x4*)(ur + j * 512), uf);
#pragma unroll
            for (int q = 0; q < 8; ++q) dot = fmaf(uf[q], xf[8 * j + q], dot); }
        dot = wave_sum(dot);
        const float act = gelu_tanh(dot * rs) * g;
#pragma unroll
        for (int j = 0; j < 4; ++j) { float vf[8]; unpack8(*(const u32x4*)(vr + j * 512), vf);
#pragma unroll
            for (int q = 0; q < 8; ++q) of[8 * j + q] = fmaf(act, vf[q], of[8 * j + q]); }
    }
    float* orow = p.out + (size_t)t * D;
#pragma unroll
    for (int j = 0; j < 4; ++j) {
        f32x4* o4 = (f32x4*)(orow + j * 512 + lane * 8);
        f32x4 a = o4[0], b = o4[1];
        a.x += of[8 * j + 0]; a.y += of[8 * j + 1]; a.z += of[8 * j + 2]; a.w += of[8 * j + 3];
        b.x += of[8 * j + 4]; b.y += of[8 * j + 5]; b.z += of[8 * j + 6]; b.w += of[8 * j + 7];
        o4[0] = a; o4[1] = b;
    }
}

__global__ void __launch_bounds__(256, 2) fwd(Params p) {
    cg::grid_group grid = cg::this_grid();
    __shared__ float smem[4 * 64 * 33];
    const int tid = threadIdx.x, lane = tid & 63, wave = tid >> 6;
    const int nwb = blockDim.x >> 6;
    const int gw = blockIdx.x * nwb + wave, NW = gridDim.x * nwb;
    unsigned char* ws = p.ws;
    bf16_t* WT_IN = (bf16_t*)(ws + WS_WT_IN); bf16_t* WT_GATE = (bf16_t*)(ws + WS_WT_GATE); bf16_t* WT_BR = (bf16_t*)(ws + WS_WT_BR);
    bf16_t* WT_O = (bf16_t*)(ws + WS_WT_O); bf16_t* WT_PQ = (bf16_t*)(ws + WS_WT_PQ); bf16_t* WT_MKV = (bf16_t*)(ws + WS_WT_MKV);
    bf16_t* KEYSB = (bf16_t*)(ws + WS_KEYSB); bf16_t* MEMN = (bf16_t*)(ws + WS_MEMN); bf16_t* MEMKV = (bf16_t*)(ws + WS_MEMKV);
    bf16_t* HO = (bf16_t*)(ws + WS_HO); bf16_t* PROJ = (bf16_t*)(ws + WS_PROJ); bf16_t* G = (bf16_t*)(ws + WS_G);
    bf16_t* MERGED = (bf16_t*)(ws + WS_MERGED); bf16_t* X2BF = (bf16_t*)(ws + WS_X2BF); bf16_t* QB = (bf16_t*)(ws + WS_Q);
    bf16_t* TABU = (bf16_t*)(ws + WS_TABU); bf16_t* TABV = (bf16_t*)(ws + WS_TABV); float* RS2 = (float*)(ws + WS_RS2);

    {
        float* scr = smem + wave * (64 * 33);
        transpose_all(p.in[3], D, INW, WT_IN, nullptr, scr, gw, NW, lane);
        transpose_all(p.in[18], D, GW, WT_GATE, nullptr, scr, gw, NW, lane);
        transpose_all(p.in[20], D, D, WT_BR, nullptr, scr, gw, NW, lane);
        transpose_all(p.in[21], D, D, WT_O, nullptr, scr, gw, NW, lane);
        transpose_all(p.in[23], D, D, WT_PQ, p.in[22], scr, gw, NW, lane);
        transpose_all(p.in[15], D, 2 * CW, WT_MKV, nullptr, scr, gw, NW, lane);
        for (int m = gw; m < T; m += NW) rms_row_bf16(p.in[0] + (size_t)m * D, p.in[2], HO + (size_t)m * D, lane);
        for (int m = gw; m < BATCH * NMEM; m += NW) rms_row_bf16(p.in[1] + (size_t)m * D, p.in[14], MEMN + (size_t)m * D, lane);
        const float* keys = p.in[24];
        for (int i = gw * 64 + lane; i < PH * 2 * NKEYS * 128 / 2; i += NW * 64) ((unsigned*)KEYSB)[i] = pk2(keys[2 * i], keys[2 * i + 1]);
    }
    grid.sync();
    {
        gemm_simple<4, 4>(HO, D, WT_IN, D, T, INW, D, EpiProj{PROJ}, gw, NW, lane);
        gemm_simple<4, 4>(HO, D, WT_GATE, D, T, GW, D, EpiGate{G, p.in[19]}, gw, NW, lane);
        gemm_simple<4, 4>(MEMN, D, WT_MKV, D, BATCH * NMEM, 2 * CW, D, EpiStore{MEMKV, 2 * CW}, gw, NW, lane);
    }
    grid.sync();
    {
        const float qscale = 0.08838834764831845f;
        for (int it = gw; it < T * 20; it += NW) { const int t = it / 20, j = it % 20;
            if (j < 8) headnorm(PROJ + (size_t)t * INW + C_QA + j * 128, p.in[4], qscale, lane);
            else if (j < 16) headnorm(PROJ + (size_t)t * INW + C_KA + (j - 8) * 128, p.in[5], 1.f, lane);
            else headnorm(PROJ + (size_t)t * INW + C_QC + (j - 16) * 128, p.in[16], qscale, lane); }
        for (int it = gw; it < BATCH * NMEM * 4; it += NW) { const int m = it / 4, j = it % 4; headnorm(MEMKV + (size_t)m * (2 * CW) + j * 128, p.in[17], 1.f, lane); }
        for (int u = gw; u < BATCH * NCH * 8; u += NW) { const int g = u % 8, c = (u / 8) % NCH, b = u / (8 * NCH); lru_unit<false>(p, b, c, g, lane); }
    }
    grid.sync();
    {
        const int nA = BATCH * 8 * NCH, nC = BATCH * 4 * NCH;
        for (int u = blockIdx.x; u < nA + nC; u += gridDim.x) {
            if (u < nA) {
                const int n = u % NCH, h = (u / NCH) % 8, b = u / (NCH * 8);
                const int jstart = n < NPREV ? NPREV - n : 0;
                const size_t qrow = (size_t)b * SEQ + (size_t)n * CHUNK, krow = (size_t)b * SEQ + (size_t)(n - NPREV + jstart) * CHUNK;
                attn_simple(PROJ + qrow * INW + C_QA + h * 128, INW, PROJ + krow * INW + C_KA + h * 128, PROJ + krow * INW + C_VA + h * 128, INW,
                            (NPREV + 1 - jstart) * CHUNK, (NPREV - jstart) * CHUNK, p.in[6] + h * 257, HO + qrow * D + h * 128, D, tid);
            } else {
                const int v = u - nA; const int n = v % NCH, h = (v / NCH) % 4, b = v / (NCH * 4);
                const size_t qrow = (size_t)b * SEQ + (size_t)n * CHUNK;
                attn_simple(PROJ + qrow * INW + C_QC + h * 128, INW, MEMKV + (size_t)b * NMEM * (2 * CW) + h * 128, MEMKV + (size_t)b * NMEM * (2 * CW) + CW + h * 128, 2 * CW,
                            NMEM, 0, nullptr, HO + qrow * D + AW + LW + h * 128, D, tid);
            }
        }
        for (int u = gw; u < BATCH * NCH * 8; u += NW) { const int g = u % 8, c = (u / 8) % NCH, b = u / (8 * NCH); lru_unit<true>(p, b, c, g, lane); }
    }
    grid.sync();
    gemm_branch(HO, WT_BR, G, MERGED, gw, NW, lane);
    grid.sync();
    {
        gemm_simple<4, 4>(MERGED, D, WT_O, D, T, D, D, EpiWo{p.in[0], p.out, X2BF}, gw, NW, lane);
        const float* pu = p.in[25]; const float* pv = p.in[26]; const float* g2 = p.in[22];
        const size_t n8 = (size_t)16384 * D / 8;
        for (size_t i = (size_t)gw * 64 + lane; i < n8; i += (size_t)NW * 64) {
            const int k = (int)((i * 8) % D);
            const f32x4 a = *(const f32x4*)(pu + i * 8), b = *(const f32x4*)(pu + i * 8 + 4), ga = *(const f32x4*)(g2 + k), gb = *(const f32x4*)(g2 + k + 4);
            u32x4 o; o.x = pk2(a.x * ga.x, a.y * ga.y); o.y = pk2(a.z * ga.z, a.w * ga.w); o.z = pk2(b.x * gb.x, b.y * gb.y); o.w = pk2(b.z * gb.z, b.w * gb.w);
            *(u32x4*)(TABU + i * 8) = o;
            const f32x4 c = *(const f32x4*)(pv + i * 8), d = *(const f32x4*)(pv + i * 8 + 4);
            u32x4 o2; o2.x = pk2(c.x, c.y); o2.y = pk2(c.z, c.w); o2.z = pk2(d.x, d.y); o2.w = pk2(d.z, d.w);
            *(u32x4*)(TABV + i * 8) = o2;
        }
    }
    grid.sync();
    for (int m = gw; m < T; m += NW) {
        const f32x4* xr = (const f32x4*)(p.out + (size_t)m * D) + lane; float s = 0.f;
#pragma unroll
        for (int j = 0; j < 8; ++j) { const f32x4 v = xr[64 * j]; s += (v.x * v.x + v.y * v.y) + (v.z * v.z + v.w * v.w); }
        s = wave_sum(s);
        if (lane == 0) RS2[m] = rsqrtf(s * (1.f / D) + EPS);
    }
    grid.sync();
    gemm_simple<4, 4>(X2BF, D, WT_PQ, D, T, D, D, EpiQ{QB, RS2}, gw, NW, lane);
    grid.sync();
    for (int u = gw; u < T * PH; u += NW) route_unit(p, u % T, u / T, lane);
    grid.sync();
    for (int t = gw; t < T; t += NW) peer_token(p, t, lane);
}

extern "C" void kernel_launch(void* const* d_in, const int* in_sizes, int n_in, void* d_out, int out_size, void* d_ws, size_t ws_size, hipStream_t stream) {
    static int grid = 0;
    if (grid == 0) {
        if (n_in != 27 || out_size != T * D || ws_size < WS_END) { fprintf(stderr, "kernel_launch: unexpected problem (n_in %d out %d ws %zu)\n", n_in, out_size, ws_size); grid = -1; return; }
        int dev = 0, cus = 0, per_cu = 0;
        hipGetDevice(&dev); hipDeviceGetAttribute(&cus, hipDeviceAttributeMultiprocessorCount, dev);
        hipOccupancyMaxActiveBlocksPerMultiprocessor(&per_cu, (const void*)fwd, 256, 0);
        if (per_cu < 1) { fprintf(stderr, "kernel_launch: occupancy query says %d\n", per_cu); grid = -1; return; }
        grid = cus * (per_cu < 2 ? per_cu : 2);
    }
    if (grid < 0) return;
    hipMemsetAsync((char*)d_ws + WS_CTL, 0, 1 * MiB, stream);
    Params p{};
    for (int i = 0; i < 27; ++i) p.in[i] = (const float*)d_in[i];
    p.out = (float*)d_out; p.ws = (unsigned char*)d_ws;
    void* args[] = {&p};
    hipError_t e = hipLaunchCooperativeKernel((const void*)fwd, dim3(grid), dim3(256), args, 0, stream);
    if (e != hipSuccess) fprintf(stderr, "cooperative launch failed: %s (grid %d)\n", hipGetErrorString(e), grid);
}
```

```cpp
#include <hip/hip_runtime.h>
#include <hip/hip_cooperative_groups.h>
#include <cstdio>
#include <cstdint>
namespace cg = cooperative_groups;

#define LAS __attribute__((address_space(3)))
typedef unsigned short bf16_t;
typedef short bf16x8 __attribute__((ext_vector_type(8)));
typedef float f32x4 __attribute__((ext_vector_type(4)));
typedef unsigned u32x4 __attribute__((ext_vector_type(4)));
typedef unsigned u32x2 __attribute__((ext_vector_type(2)));

constexpr int D = 2048, BATCH = 2, SEQ = 8192, T = BATCH * SEQ;
constexpr int CHUNK = 64, NPREV = 8, NCH = SEQ / CHUNK;
constexpr int AW = 1024, LW = 512, CW = 512, INW = 4608, GW = 6144;
constexpr int NMEM = 256;
constexpr int PH = 8, NKEYS = 128, TOPK = 16;
constexpr float EPS = 1e-6f;
constexpr int C_QA = 0, C_KA = 1024, C_VA = 2048, C_XL = 3072, C_GL = 3584, C_QC = 4096;

constexpr size_t MiB = 1u << 20;
constexpr size_t WS_CTL = 0;
constexpr size_t WS_WT_IN = 2 * MiB, WS_WT_GATE = 20 * MiB, WS_WT_BR = 44 * MiB, WS_WT_O = 52 * MiB, WS_WT_PQ = 60 * MiB, WS_WT_MKV = 68 * MiB;
constexpr size_t WS_KEYSB = 72 * MiB, WS_MEMN = 73 * MiB, WS_MEMKV = 75 * MiB, WS_LRUSUM = 76 * MiB, WS_RS2 = 77 * MiB;
constexpr size_t WS_HO = 80 * MiB;
constexpr size_t WS_PROJ = 144 * MiB;
constexpr size_t WS_MERGED = 144 * MiB, WS_X2BF = 208 * MiB;
constexpr size_t WS_G = 288 * MiB;
constexpr size_t WS_TABU = 288 * MiB, WS_TABV = 320 * MiB, WS_Q = 416 * MiB;
constexpr size_t WS_SCU = 77 * MiB, WS_SCV = 77 * MiB + 65536;
constexpr size_t WS_RIDX = 480 * MiB, WS_RG = 488 * MiB, WS_END = 496 * MiB;

constexpr size_t CTL_BAR_BYTE = 16384, CTL_SS2_BYTE = 512 * 1024;
struct Params { const float* in[27]; float* out; unsigned char* ws; };

__device__ __forceinline__ float bf2f(unsigned v16) { return __uint_as_float(v16 << 16); }
__device__ __forceinline__ unsigned f2bf(float f) { unsigned u = __float_as_uint(f); return (u + 0x7fffu + ((u >> 16) & 1u)) >> 16; }
__device__ __forceinline__ unsigned pk2(float lo, float hi) { return f2bf(lo) | (f2bf(hi) << 16); }
__device__ __forceinline__ float wave_sum(float v) {
#pragma unroll
    for (int o = 1; o < 64; o <<= 1) v += __shfl_xor(v, o);
    return v;
}
__device__ __forceinline__ float sigmoid_(float x) { return 1.f / (1.f + __expf(-x)); }
__device__ __forceinline__ float gelu_tanh(float x) { const float y = 1.5957691216f * (x + 0.044715f * x * x * x); return x / (1.f + __expf(-y)); }
__device__ __forceinline__ void unpack8(const u32x4 w, float* f) {
    f[0] = __uint_as_float(w.x << 16); f[1] = __uint_as_float(w.x & 0xffff0000u);
    f[2] = __uint_as_float(w.y << 16); f[3] = __uint_as_float(w.y & 0xffff0000u);
    f[4] = __uint_as_float(w.z << 16); f[5] = __uint_as_float(w.z & 0xffff0000u);
    f[6] = __uint_as_float(w.w << 16); f[7] = __uint_as_float(w.w & 0xffff0000u);
}

__device__ __forceinline__ void transpose_item(const float* __restrict__ W, int K, int N, bf16_t* __restrict__ WT, const float* __restrict__ ks, float* scr, int item, int lane) {
    const int nblk = N / 32, kb = item / nblk, nb = item % nblk, k0 = 64 * kb, n0 = 32 * nb;
#pragma unroll 8
    for (int i = 0; i < 32; ++i) { const int kk = 2 * i + (lane >> 5); float v = W[(size_t)(k0 + kk) * N + n0 + (lane & 31)]; if (ks) v *= ks[k0 + kk]; scr[kk * 33 + (lane & 31)] = v; }
    asm volatile("s_waitcnt lgkmcnt(0)" ::: "memory");
    const int c = lane & 7;
#pragma unroll
    for (int j = 0; j < 4; ++j) { const int n = (lane >> 3) + 8 * j; const float* s = scr + (8 * c) * 33 + n;
        u32x4 o; o.x = pk2(s[0 * 33], s[1 * 33]); o.y = pk2(s[2 * 33], s[3 * 33]); o.z = pk2(s[4 * 33], s[5 * 33]); o.w = pk2(s[6 * 33], s[7 * 33]);
        *(u32x4*)(WT + (size_t)(n0 + n) * K + k0 + 8 * c) = o; }
    asm volatile("s_waitcnt lgkmcnt(0)" ::: "memory");
}
__device__ __forceinline__ void transpose_all(const float* W, int K, int N, bf16_t* WT, const float* ks, float* scr, int gw, int NW, int lane) {
    const int nitems = (K / 64) * (N / 32);
    for (int it = gw; it < nitems; it += NW) transpose_item(W, K, N, WT, ks, scr, it, lane);
}
__device__ __forceinline__ void rms_row_bf16(const float* xrow, const float* g, bf16_t* orow, int lane) {
    const f32x4* xr = (const f32x4*)xrow + lane; const f32x4* gr = (const f32x4*)g + lane;
    f32x4 v[8]; float s = 0.f;
#pragma unroll
    for (int j = 0; j < 8; ++j) { v[j] = xr[64 * j]; s += (v[j].x * v[j].x + v[j].y * v[j].y) + (v[j].z * v[j].z + v[j].w * v[j].w); }
    const float rstd = rsqrtf(wave_sum(s) * (1.f / D) + EPS);
    u32x2* o8 = (u32x2*)orow + lane;
#pragma unroll
    for (int j = 0; j < 8; ++j) { const f32x4 gg = gr[64 * j]; u32x2 o; o.x = pk2(v[j].x * rstd * gg.x, v[j].y * rstd * gg.y); o.y = pk2(v[j].z * rstd * gg.z, v[j].w * rstd * gg.w); o8[64 * j] = o; }
}

template <int TM, int TN, class Epi>
__device__ __forceinline__ void gemm_simple(const bf16_t* __restrict__ A, int lda, const bf16_t* __restrict__ Bt, int ldb, int M, int N, int K, const Epi& epi, int gw, int NW, int lane) {
    const int r = lane & 15, q = lane >> 4;
    const int ntm = M / (16 * TM), ntn = N / (16 * TN);
    for (int tile = gw; tile < ntm * ntn; tile += NW) {
        const int tm = tile / ntn, tn = tile % ntn;
        f32x4 acc[TM][TN];
#pragma unroll
        for (int i = 0; i < TM; ++i)
#pragma unroll
            for (int j = 0; j < TN; ++j) acc[i][j] = (f32x4){0.f, 0.f, 0.f, 0.f};
        const bf16_t* ap = A + (size_t)(tm * 16 * TM + r) * lda + q * 8;
        const bf16_t* bp = Bt + (size_t)(tn * 16 * TN + r) * ldb + q * 8;
        for (int k0 = 0; k0 < K; k0 += 32) {
            bf16x8 af[TM], bfr[TN];
#pragma unroll
            for (int i = 0; i < TM; ++i) af[i] = *(const bf16x8*)(ap + (size_t)i * 16 * lda + k0);
#pragma unroll
            for (int j = 0; j < TN; ++j) bfr[j] = *(const bf16x8*)(bp + (size_t)j * 16 * ldb + k0);
#pragma unroll
            for (int i = 0; i < TM; ++i)
#pragma unroll
                for (int j = 0; j < TN; ++j) acc[i][j] = __builtin_amdgcn_mfma_f32_16x16x32_bf16(af[i], bfr[j], acc[i][j], 0, 0, 0);
        }
#pragma unroll
        for (int i = 0; i < TM; ++i)
#pragma unroll
            for (int j = 0; j < TN; ++j)
#pragma unroll
                for (int e = 0; e < 4; ++e) epi(tm * 16 * TM + i * 16 + q * 4 + e, tn * 16 * TN + j * 16 + r, acc[i][j][e]);
    }
}
struct EpiProj { bf16_t* P; __device__ __forceinline__ void operator()(int row, int col, float v) const { if (col >= C_GL && col < C_QC) v = gelu_tanh(v); P[(size_t)row * INW + col] = (bf16_t)f2bf(v); } };
struct EpiGate { bf16_t* G; const float* b; __device__ __forceinline__ void operator()(int row, int col, float v) const { G[(size_t)row * GW + col] = (bf16_t)f2bf(sigmoid_(v + b[col])); } };
struct EpiStore { bf16_t* C; int ldc; __device__ __forceinline__ void operator()(int row, int col, float v) const { C[(size_t)row * ldc + col] = (bf16_t)f2bf(v); } };
struct EpiWo { const float* x; float* out; bf16_t* xb; __device__ __forceinline__ void operator()(int row, int col, float v) const { const size_t o = (size_t)row * D + col; const float y = x[o] + v; out[o] = y; xb[o] = (bf16_t)f2bf(y); } };
struct EpiQ { bf16_t* Q; const float* rs; __device__ __forceinline__ void operator()(int row, int col, float v) const { Q[(size_t)row * D + col] = (bf16_t)f2bf(v * rs[row]); } };

__device__ __forceinline__ void headnorm(bf16_t* vec, const float* g, float scale, int lane) {
    unsigned* p = (unsigned*)vec + lane; const unsigned w = *p;
    const float a = bf2f(w & 0xffffu), b = bf2f(w >> 16);
    const float rs = rsqrtf(wave_sum(a * a + b * b) * (1.f / 128.f) + EPS) * scale;
    *p = pk2(a * rs * g[2 * lane], b * rs * g[2 * lane + 1]);
}

template <bool PASS2>
__device__ __forceinline__ void lru_unit(const Params& p, int b, int c, int g, int lane) {
    const bf16_t* PROJ = (const bf16_t*)(p.ws + WS_PROJ); bf16_t* O = (bf16_t*)(p.ws + WS_HO);
    float* SUMA = (float*)(p.ws + WS_LRUSUM); float* SUMB = SUMA + BATCH * NCH * LW;
    const float* conv_w = p.in[7]; const float* conv_b = p.in[8]; const float* lru_wa = p.in[9]; const float* lru_ba = p.in[10];
    const float* lru_wx = p.in[11]; const float* lru_bx = p.in[12]; const float* lam = p.in[13];
    const int ch = g * 64 + lane;
    float wa_r[64], wx_r[64];
#pragma unroll
    for (int i = 0; i < 64; ++i) { wa_r[i] = lru_wa[(size_t)(g * 64 + i) * 64 + lane]; wx_r[i] = lru_wx[(size_t)(g * 64 + i) * 64 + lane]; }
    const float cw0 = conv_w[0 * LW + ch], cw1 = conv_w[1 * LW + ch], cw2 = conv_w[2 * LW + ch], cw3 = conv_w[3 * LW + ch], cb = conv_b[ch];
    const float ba_ = lru_ba[ch], bx_ = lru_bx[ch];
    const float sp = log1pf(__expf(-lam[ch]));
    const int t0 = c * CHUNK; const size_t row0 = (size_t)b * SEQ + t0;
    float x0 = 0.f, x1 = 0.f, x2 = 0.f;
    if (t0 >= 3) { x0 = bf2f(PROJ[(row0 - 3) * INW + C_XL + ch]); x1 = bf2f(PROJ[(row0 - 2) * INW + C_XL + ch]); x2 = bf2f(PROJ[(row0 - 1) * INW + C_XL + ch]); }
    float h = 0.f, aprod = 1.f;
    if (PASS2) { for (int j = 0; j < c; ++j) { const size_t o = (size_t)(b * NCH + j) * LW + ch; h = SUMA[o] * h + SUMB[o]; } }
    for (int t = 0; t < CHUNK; ++t) {
        const float x3 = bf2f(PROJ[(row0 + t) * INW + C_XL + ch]);
        const float xc = cw0 * x0 + cw1 * x1 + cw2 * x2 + cw3 * x3 + cb;
        x0 = x1; x1 = x2; x2 = x3;
        float rp = ba_, ip = bx_;
#pragma unroll
        for (int i = 0; i < 64; ++i) { const float xi = __int_as_float(__builtin_amdgcn_readlane(__float_as_int(xc), i)); rp = fmaf(xi, wa_r[i], rp); ip = fmaf(xi, wx_r[i], ip); }
        const float r = sigmoid_(rp), ig = sigmoid_(ip);
        const float la = -8.f * r * sp; const float a = __expf(la);
        const float mult = sqrtf(fminf(fmaxf(-expm1f(2.f * la), 1e-12f), 1.f));
        h = a * h + mult * ig * xc;
        if (PASS2) { const float gg = bf2f(PROJ[(row0 + t) * INW + C_GL + ch]); O[(row0 + t) * D + AW + ch] = (bf16_t)f2bf(h * gg); }
        else aprod *= a;
    }
    if (!PASS2) { const size_t o = (size_t)(b * NCH + c) * LW + ch; SUMA[o] = aprod; SUMB[o] = h; }
}

__device__ __forceinline__ void attn_simple(const bf16_t* Qp, int ldq, const bf16_t* Kp, const bf16_t* Vp, int ldkv, int nkeys, int koff, const float* bias_h, bf16_t* Op, int ldo, int tid) {
    const int qi = tid >> 2, part = tid & 3;
    float q[32], o[32];
    { const u32x4* qp = (const u32x4*)(Qp + (size_t)qi * ldq + part * 32);
#pragma unroll
      for (int j = 0; j < 4; ++j) unpack8(qp[j], q + 8 * j); }
#pragma unroll
    for (int d = 0; d < 32; ++d) o[d] = 0.f;
    float m = -1e30f, l = 0.f;
    for (int kk0 = 0; kk0 < nkeys; kk0 += 8) {
        float s[8];
#pragma unroll
        for (int j = 0; j < 8; ++j) {
            const u32x4* kp = (const u32x4*)(Kp + (size_t)(kk0 + j) * ldkv + part * 32);
            float acc = 0.f;
#pragma unroll
            for (int w = 0; w < 4; ++w) { float kf[8]; unpack8(kp[w], kf);
#pragma unroll
                for (int e = 0; e < 8; ++e) acc = fmaf(q[8 * w + e], kf[e], acc); }
            acc += __shfl_xor(acc, 1); acc += __shfl_xor(acc, 2);
            if (bias_h) { int dist = qi + koff - (kk0 + j); dist = dist < -128 ? -128 : (dist > 128 ? 128 : dist); acc += bias_h[dist + 128]; }
            s[j] = acc;
        }
        float mx = s[0];
#pragma unroll
        for (int j = 1; j < 8; ++j) mx = fmaxf(mx, s[j]);
        const float mn = fmaxf(m, mx), corr = __expf(m - mn);
        l *= corr;
#pragma unroll
        for (int d = 0; d < 32; ++d) o[d] *= corr;
#pragma unroll
        for (int j = 0; j < 8; ++j) {
            const float pj = __expf(s[j] - mn); l += pj;
            const u32x4* vp = (const u32x4*)(Vp + (size_t)(kk0 + j) * ldkv + part * 32);
#pragma unroll
            for (int w = 0; w < 4; ++w) { float vf[8]; unpack8(vp[w], vf);
#pragma unroll
                for (int e = 0; e < 8; ++e) o[8 * w + e] = fmaf(pj, vf[e], o[8 * w + e]); }
        }
        m = mn;
    }
    const float inv = 1.f / l;
    u32x4* op = (u32x4*)(Op + (size_t)qi * ldo + part * 32);
#pragma unroll
    for (int w = 0; w < 4; ++w) { u32x4 ov; ov.x = pk2(o[8 * w] * inv, o[8 * w + 1] * inv); ov.y = pk2(o[8 * w + 2] * inv, o[8 * w + 3] * inv); ov.z = pk2(o[8 * w + 4] * inv, o[8 * w + 5] * inv); ov.w = pk2(o[8 * w + 6] * inv, o[8 * w + 7] * inv); op[w] = ov; }
}

__device__ __forceinline__ void gemm_branch(const bf16_t* __restrict__ Ob, const bf16_t* __restrict__ WT, const bf16_t* __restrict__ G, bf16_t* __restrict__ Mg, int gw, int NW, int lane) {
    const int r = lane & 15, q = lane >> 4;
    const int ntn = D / 32, ntiles = (T / 32) * ntn;
    for (int tile = gw; tile < ntiles; tile += NW) {
        const int tm = tile / ntn, tn = tile % ntn;
        f32x4 acc[3][2][2];
#pragma unroll
        for (int s = 0; s < 3; ++s)
#pragma unroll
            for (int i = 0; i < 2; ++i)
#pragma unroll
                for (int j = 0; j < 2; ++j) acc[s][i][j] = (f32x4){0.f, 0.f, 0.f, 0.f};
        const bf16_t* ap = Ob + (size_t)(tm * 32 + r) * D + q * 8;
        const bf16_t* bp = WT + (size_t)(tn * 32 + r) * D + q * 8;
#pragma unroll
        for (int s = 0; s < 3; ++s) {
            const int kb = s == 0 ? 0 : (s == 1 ? 1024 : 1536), ke = s == 0 ? 1024 : (s == 1 ? 1536 : 2048);
            for (int k0 = kb; k0 < ke; k0 += 32) {
                bf16x8 af[2], bfr[2];
#pragma unroll
                for (int i = 0; i < 2; ++i) af[i] = *(const bf16x8*)(ap + (size_t)i * 16 * D + k0);
#pragma unroll
                for (int j = 0; j < 2; ++j) bfr[j] = *(const bf16x8*)(bp + (size_t)j * 16 * D + k0);
#pragma unroll
                for (int i = 0; i < 2; ++i)
#pragma unroll
                    for (int j = 0; j < 2; ++j) acc[s][i][j] = __builtin_amdgcn_mfma_f32_16x16x32_bf16(af[i], bfr[j], acc[s][i][j], 0, 0, 0);
            }
        }
#pragma unroll
        for (int i = 0; i < 2; ++i)
#pragma unroll
            for (int j = 0; j < 2; ++j)
#pragma unroll
                for (int e = 0; e < 4; ++e) {
                    const int row = tm * 32 + i * 16 + q * 4 + e, col = tn * 32 + j * 16 + r;
                    const bf16_t* gp = G + (size_t)row * GW + col;
                    const float mval = bf2f(gp[0]) * acc[0][i][j][e] + bf2f(gp[2048]) * acc[1][i][j][e] + bf2f(gp[4096]) * acc[2][i][j][e];
                    Mg[(size_t)row * D + col] = (bf16_t)f2bf(mval);
                }
    }
}

__device__ __forceinline__ unsigned long long shfl_xor64(unsigned long long v, int m) {
    const unsigned lo = __shfl_xor((unsigned)v, m), hi = __shfl_xor((unsigned)(v >> 32), m);
    return ((unsigned long long)hi << 32) | lo;
}
__device__ __forceinline__ unsigned fkey(float f) { const unsigned u = __float_as_uint(f); return (u & 0x80000000u) ? ~u : (u | 0x80000000u); }
__device__ __forceinline__ float fkey_inv(unsigned k) { const unsigned u = (k & 0x80000000u) ? (k & 0x7fffffffu) : ~k; return __uint_as_float(u); }
__device__ __forceinline__ unsigned long long wave_max64(unsigned long long k) {
#pragma unroll
    for (int o = 1; o < 64; o <<= 1) { const unsigned long long t = shfl_xor64(k, o); k = t > k ? t : k; }
    return k;
}
__device__ __forceinline__ void route_unit(const Params& p, int t, int h, int lane) {
    const bf16_t* Q = (const bf16_t*)(p.ws + WS_Q); const bf16_t* KB = (const bf16_t*)(p.ws + WS_KEYSB);
    int* RIDX = (int*)(p.ws + WS_RIDX); float* RG = (float*)(p.ws + WS_RG);
    float sv_l[2] = {0.f, 0.f}; int si_l[2] = {0, 0};
#pragma unroll
    for (int c = 0; c < 2; ++c) {
        const bf16_t* qv = Q + (size_t)t * D + h * 256 + c * 128;
        const unsigned qw = ((const unsigned*)qv)[lane];
        const float qa = bf2f(qw & 0xffffu), qb = bf2f(qw >> 16);
        const bf16_t* k0p = KB + ((size_t)(h * 2 + c) * NKEYS + lane) * 128;
        const bf16_t* k1p = k0p + 64 * 128;
        float s0 = 0.f, s1 = 0.f;
#pragma unroll
        for (int w = 0; w < 16; ++w) {
            float k0f[8], k1f[8]; unpack8(((const u32x4*)k0p)[w], k0f); unpack8(((const u32x4*)k1p)[w], k1f);
#pragma unroll
            for (int e = 0; e < 8; e += 2) {
                const int src = 4 * w + e / 2;
                const float xa = __int_as_float(__builtin_amdgcn_readlane(__float_as_int(qa), src));
                const float xb = __int_as_float(__builtin_amdgcn_readlane(__float_as_int(qb), src));
                s0 = fmaf(xa, k0f[e], s0); s0 = fmaf(xb, k0f[e + 1], s0);
                s1 = fmaf(xa, k1f[e], s1); s1 = fmaf(xb, k1f[e + 1], s1);
            }
        }
        unsigned long long ka = ((unsigned long long)fkey(s0) << 32) | (unsigned)(255 - lane);
        unsigned long long kb = ((unsigned long long)fkey(s1) << 32) | (unsigned)(255 - (lane + 64));
        for (int rnd = 0; rnd < TOPK; ++rnd) {
            const unsigned long long best = wave_max64(ka > kb ? ka : kb);
            if (ka == best) ka = 0ull; if (kb == best) kb = 0ull;
            if (lane == rnd) { sv_l[c] = fkey_inv((unsigned)(best >> 32)); si_l[c] = 255 - (int)(best & 0xffffffffu); }
        }
    }
    unsigned long long kc[4];
#pragma unroll
    for (int m = 0; m < 4; ++m) { const int cid = lane + 64 * m, i = cid >> 4, j = cid & 15;
        const float v = __shfl(sv_l[0], i) + __shfl(sv_l[1], j);
        kc[m] = ((unsigned long long)fkey(v) << 32) | (unsigned)(1023 - cid); }
    float fv = 0.f; int cidx = 0;
    for (int rnd = 0; rnd < TOPK; ++rnd) {
        unsigned long long loc = kc[0] > kc[1] ? kc[0] : kc[1]; const unsigned long long loc2 = kc[2] > kc[3] ? kc[2] : kc[3]; loc = loc > loc2 ? loc : loc2;
        const unsigned long long best = wave_max64(loc);
#pragma unroll
        for (int m = 0; m < 4; ++m) if (kc[m] == best) kc[m] = 0ull;
        if (lane == rnd) { fv = fkey_inv((unsigned)(best >> 32)); cidx = 1023 - (int)(best & 0xffffffffu); }
    }
    const float fmax_ = __shfl(fv, 0);
    float e = lane < 16 ? __expf(fv - fmax_) : 0.f;
    float ssum = e;
#pragma unroll
    for (int o = 1; o < 16; o <<= 1) ssum += __shfl_xor(ssum, o);
    const int ci = cidx >> 4, cj = cidx & 15;
    const int e0 = __shfl(si_l[0], ci), e1 = __shfl(si_l[1], cj);
    if (lane < 16) { RIDX[(size_t)t * 128 + h * 16 + lane] = e0 * NKEYS + e1; RG[(size_t)t * 128 + h * 16 + lane] = e / ssum; }
}

typedef float f32x2 __attribute__((ext_vector_type(2)));
__device__ __forceinline__ void fp8_row(const float* __restrict__ src, const float* __restrict__ kscale, unsigned char* __restrict__ dst, float* __restrict__ scale_out, int lane) {
    f32x4 v[8]; float mx = 0.f;
#pragma unroll
    for (int j = 0; j < 8; ++j) { v[j] = ((const f32x4*)src)[64 * j + lane];
        if (kscale) v[j] = v[j] * ((const f32x4*)kscale)[64 * j + lane];
        mx = fmaxf(mx, fmaxf(fmaxf(fabsf(v[j].x), fabsf(v[j].y)), fmaxf(fabsf(v[j].z), fabsf(v[j].w)))); }
#pragma unroll
    for (int o = 1; o < 64; o <<= 1) mx = fmaxf(mx, __shfl_xor(mx, o));
    const float sc = mx > 0.f ? mx * (1.f / 448.f) : 1.f, inv = 1.f / sc;
#pragma unroll
    for (int j = 0; j < 8; ++j) {
        const f32x4 q = v[j] * inv;
        int w = __builtin_amdgcn_cvt_pk_fp8_f32(fminf(fmaxf(q.x, -448.f), 448.f), fminf(fmaxf(q.y, -448.f), 448.f), 0, false);
        w = __builtin_amdgcn_cvt_pk_fp8_f32(fminf(fmaxf(q.z, -448.f), 448.f), fminf(fmaxf(q.w, -448.f), 448.f), w, true);
        ((unsigned*)dst)[64 * j + lane] = (unsigned)w;
    }
    if (lane == 0) *scale_out = sc;
}
struct RowB { u32x4 w[2]; };
__device__ __forceinline__ void peer_load_batch(RowB (&buf)[4], const unsigned char* tab, int isel, int pbase, int lane) {
#pragma unroll
    for (int r = 0; r < 4; ++r) { const int e = __shfl(isel, (pbase + r) & 63); const unsigned char* rp = tab + (size_t)e * 2048 + lane * 16;
        buf[r].w[0] = *(const u32x4*)rp; buf[r].w[1] = *(const u32x4*)(rp + 1024); }
}
__device__ __forceinline__ void cvt16(const u32x4 w, float* f) {
#pragma unroll
    for (int q = 0; q < 4; ++q) { const f32x2 lo = __builtin_amdgcn_cvt_pk_f32_fp8((int)w[q], false), hi = __builtin_amdgcn_cvt_pk_f32_fp8((int)w[q], true);
        f[4 * q] = lo.x; f[4 * q + 1] = lo.y; f[4 * q + 2] = hi.x; f[4 * q + 3] = hi.y; }
}
__device__ __forceinline__ void peer_token(const Params& p, int t, int lane, LAS float* actL) {
    const bf16_t* XB = (const bf16_t*)(p.ws + WS_X2BF); const unsigned char* TU = p.ws + WS_TABU; const unsigned char* TV = p.ws + WS_TABV;
    const float* SCU = (const float*)(p.ws + WS_SCU); const float* SCV = (const float*)(p.ws + WS_SCV);
    const int* RIDX = (const int*)(p.ws + WS_RIDX); const float* RG = (const float*)(p.ws + WS_RG); const float* SS2 = (const float*)(p.ws + WS_CTL + CTL_SS2_BYTE);
    float xf[2][16];
#pragma unroll
    for (int j = 0; j < 2; ++j) { const bf16_t* xp = XB + (size_t)t * D + j * 1024 + lane * 16; unpack8(*(const u32x4*)xp, xf[j]); unpack8(*(const u32x4*)(xp + 8), xf[j] + 8); }
    const float rs = rsqrtf(SS2[t] * (1.f / D) + EPS);
    const int i0 = RIDX[(size_t)t * 128 + lane], i1 = RIDX[(size_t)t * 128 + 64 + lane];
    const float su0 = SCU[i0] * rs, su1 = SCU[i1] * rs;
    const float gv0 = RG[(size_t)t * 128 + lane] * SCV[i0], gv1 = RG[(size_t)t * 128 + 64 + lane] * SCV[i1];
    RowB A[4], B[4];
    const int rl = 2 * ((lane >> 5) & 1) + ((lane >> 4) & 1);
#define PEER_DOT(buf, pb) do { float d[4]; \
        _Pragma("unroll") for (int r = 0; r < 4; ++r) { float f0[16], f1[16]; cvt16(buf[r].w[0], f0); cvt16(buf[r].w[1], f1); float a0 = 0.f, a1 = 0.f; \
            _Pragma("unroll") for (int q = 0; q < 16; ++q) { a0 = fmaf(f0[q], xf[0][q], a0); a1 = fmaf(f1[q], xf[1][q], a1); } d[r] = a0 + a1; } \
        const bool up = (lane & 32) != 0; \
        const float k0 = (up ? d[2] : d[0]) + __shfl_xor(up ? d[0] : d[2], 32), k1 = (up ? d[3] : d[1]) + __shfl_xor(up ? d[1] : d[3], 32); \
        const bool u2 = (lane & 16) != 0; \
        float v = (u2 ? k1 : k0) + __shfl_xor(u2 ? k0 : k1, 16); \
        v += __shfl_xor(v, 8); v += __shfl_xor(v, 4); v += __shfl_xor(v, 2); v += __shfl_xor(v, 1); \
        const int pi = (pb) + rl; const float su = __shfl(pi < 64 ? su0 : su1, pi & 63), gv = __shfl(pi < 64 ? gv0 : gv1, pi & 63); \
        if ((lane & 15) == 0) actL[pi] = gelu_tanh(v * su) * gv; } while (0)
    peer_load_batch(A, TU, i0, 0, lane);
    for (int b = 0; b < 32; b += 2) {
        peer_load_batch(B, TU, b < 16 ? i0 : i1, 4 * (b + 1), lane);
        PEER_DOT(A, 4 * b);
        if (b + 2 < 32) peer_load_batch(A, TU, (b + 2) < 16 ? i0 : i1, 4 * (b + 2), lane);
        PEER_DOT(B, 4 * (b + 1));
    }
#undef PEER_DOT
    float of[2][16];
#pragma unroll
    for (int j = 0; j < 2; ++j)
#pragma unroll
        for (int q = 0; q < 16; ++q) of[j][q] = 0.f;
#define PEER_AXPY(buf, pb) do { \
        _Pragma("unroll") for (int r = 0; r < 4; ++r) { const float a = actL[(pb) + r]; float f0[16], f1[16]; cvt16(buf[r].w[0], f0); cvt16(buf[r].w[1], f1); \
            _Pragma("unroll") for (int q = 0; q < 16; ++q) { of[0][q] = fmaf(a, f0[q], of[0][q]); of[1][q] = fmaf(a, f1[q], of[1][q]); } } } while (0)
    peer_load_batch(A, TV, i0, 0, lane);
    for (int b = 0; b < 32; b += 2) {
        peer_load_batch(B, TV, b < 16 ? i0 : i1, 4 * (b + 1), lane);
        PEER_AXPY(A, 4 * b);
        if (b + 2 < 32) peer_load_batch(A, TV, (b + 2) < 16 ? i0 : i1, 4 * (b + 2), lane);
        PEER_AXPY(B, 4 * (b + 1));
    }
#undef PEER_AXPY
    float* orow = p.out + (size_t)t * D;
#pragma unroll
    for (int j = 0; j < 2; ++j)
#pragma unroll
        for (int q = 0; q < 4; ++q) { f32x4* o4 = (f32x4*)(orow + j * 1024 + lane * 16 + 4 * q); f32x4 a = *o4;
            a.x += of[j][4 * q]; a.y += of[j][4 * q + 1]; a.z += of[j][4 * q + 2]; a.w += of[j][4 * q + 3]; *o4 = a; }
}

namespace pg8 {
#define PG8_LAS __attribute__((address_space(3)))
constexpr int BM = 256, BK = 64, HALF = 128, HTB = HALF * BK * 2, STAGE_BYTES = 8 * HTB, NXCD = 8, WGM = 8;
__host__ __device__ __forceinline__ int lds_byte(int r, int c) { const int st = (r >> 4) * 2 + (c >> 5), rr = r & 15, cc = c & 31, ob = rr * 64 + cc * 2; return st * 1024 + (ob ^ (((ob >> 9) & 1) << 5)); }
__host__ __device__ __forceinline__ void stage_rc(int b, int& R, int& C) { const int st = b / 1024, sb = b % 1024, swz = sb ^ (((sb >> 9) & 1) << 5); R = (st >> 1) * 16 + swz / 64; C = (st & 1) * 32 + (swz % 64) / 2; }
__host__ __device__ __forceinline__ int perm32(int rho) { const int n = rho >> 4, i = rho & 15; return 8 * (i >> 2) + 4 * n + (i & 3); }
struct Unit { const char* A; const char* B; int pm, pn, kind, nt; };
__device__ __forceinline__ const char* uni_ptr(const char* p) { const unsigned long long v = (unsigned long long)p; const unsigned lo = __builtin_amdgcn_readfirstlane((unsigned)v), hi = __builtin_amdgcn_readfirstlane((unsigned)(v >> 32)); return (const char*)(((unsigned long long)hi << 32) | lo); }
__device__ __forceinline__ void uni(Unit& u) { u.A = uni_ptr(u.A); u.B = uni_ptr(u.B); u.pm = __builtin_amdgcn_readfirstlane(u.pm); u.pn = __builtin_amdgcn_readfirstlane(u.pn); u.kind = __builtin_amdgcn_readfirstlane(u.kind); u.nt = __builtin_amdgcn_readfirstlane(u.nt); }
__device__ __forceinline__ void tile_of(int L, int nM, int nN, int& pm, int& pn) {
    const int nwg = nM * nN; int wgid = L; { const int q = nwg / NXCD, r = nwg % NXCD, xcd = wgid % NXCD, off = wgid / NXCD; wgid = (xcd < r ? xcd * (q + 1) : r * (q + 1) + (xcd - r) * q) + off; }
    const int nig = WGM * nN, gid = wgid / nig, fm = gid * WGM, gsz = (nM - fm) < WGM ? (nM - fm) : WGM;
    pm = fm + ((wgid % nig) % gsz); pn = (wgid % nig) / gsz;
}
template <class Epi, class Sched>
__device__ __forceinline__ void gemm_phase(PG8_LAS unsigned char* lds, const int lda, const int ldb, const Sched& S, const Epi& E) {
    const int tid = threadIdx.x, wid = __builtin_amdgcn_readfirstlane(tid >> 6), lane = tid & 63, wr = wid >> 2, wc = wid & 3, fr = lane & 15, fq = lane >> 4;
    unsigned voffA[2], voffB[2];
#pragma unroll
    for (int i = 0; i < 2; ++i) { int R, C; stage_rc(tid * 16 + i * 8192, R, C); const int Rb = (R & ~31) + perm32(R & 31);
        voffA[i] = (unsigned)(R * lda + C) * 2u; voffB[i] = (unsigned)(Rb * ldb + C) * 2u; }
    const size_t kstep = (size_t)(BK * 2);
    const size_t hstepA = (size_t)HALF * lda * 2, hstepB = (size_t)HALF * ldb * 2;
    const unsigned ldsw = (unsigned)wid * 1024u;
    const int aoff = lds_byte(wr * 64 + fr, fq * 8), boff = lds_byte(wc * 32 + fr, fq * 8);
#define PG8_SA(b, h) (((b) * 2 + (h)) * HTB)
#define PG8_SB(b, h) ((4 + (b) * 2 + (h)) * HTB)
#define PG8_STAGE(bufoff, gbase, voff) do { _Pragma("unroll") for (int _i = 0; _i < 2; ++_i) \
        __builtin_amdgcn_global_load_lds((const unsigned*)((const char*)(gbase) + (voff)[_i]), (PG8_LAS unsigned*)(lds + (bufoff) + ldsw + _i * 8192), 16, 0, 0); } while (0)
#define PG8_LDA(dst, b, h) do { _Pragma("unroll") for (int m = 0; m < 4; ++m) _Pragma("unroll") for (int k = 0; k < 2; ++k) dst[m][k] = *(const PG8_LAS bf16x8*)(lds + PG8_SA(b, h) + aoff + m * 2048 + k * 1024); } while (0)
#define PG8_LDB(dst, b, h) do { _Pragma("unroll") for (int n = 0; n < 2; ++n) _Pragma("unroll") for (int k = 0; k < 2; ++k) dst[n][k] = *(const PG8_LAS bf16x8*)(lds + PG8_SB(b, h) + boff + n * 2048 + k * 1024); } while (0)
#define PG8_MMA(ai, bj, At, Bt) do { __builtin_amdgcn_s_setprio(1); _Pragma("unroll") for (int m = 0; m < 4; ++m) _Pragma("unroll") for (int n = 0; n < 2; ++n) _Pragma("unroll") for (int k = 0; k < 2; ++k) \
        acc[ai][bj][m][n] = __builtin_amdgcn_mfma_f32_16x16x32_bf16(Bt[n][k], At[m][k], acc[ai][bj][m][n], 0, 0, 0); __builtin_amdgcn_s_setprio(0); } while (0)
#define PG8_WAIT_V(n) asm volatile("s_waitcnt vmcnt(" #n ")" ::: "memory")
#define PG8_WAIT_L(n) asm volatile("s_waitcnt lgkmcnt(" #n ")" ::: "memory")
#define PG8_BAR __builtin_amdgcn_s_barrier()
#define PG8_SCHED __builtin_amdgcn_sched_barrier(0)
    Unit cur, nxt; int ui = 0;
    if (!S.next(0, cur)) return;
    f32x4 acc[2][2][4][2];
#pragma unroll
    for (int a = 0; a < 2; ++a)
#pragma unroll
        for (int b = 0; b < 2; ++b)
#pragma unroll
            for (int m = 0; m < 4; ++m)
#pragma unroll
                for (int n = 0; n < 2; ++n) acc[a][b][m][n] = (f32x4){0.f, 0.f, 0.f, 0.f};
    bf16x8 At[4][2], B0[2][2], B1[2][2];
    const char* cA = cur.A; const char* cB = cur.B;
    PG8_STAGE(PG8_SB(0, 0), cB, voffB); PG8_STAGE(PG8_SB(0, 1), cB + hstepB, voffB); PG8_STAGE(PG8_SA(0, 0), cA, voffA); PG8_STAGE(PG8_SA(0, 1), cA + hstepA, voffA);
    if (wr == 1) PG8_BAR;
    PG8_WAIT_V(2); PG8_BAR;
    PG8_STAGE(PG8_SB(1, 0), cB + kstep, voffB); PG8_STAGE(PG8_SA(1, 0), cA + kstep, voffA); PG8_STAGE(PG8_SB(1, 1), cB + hstepB + kstep, voffB);
    PG8_WAIT_V(6); PG8_BAR;
    for (;;) {
        const bool has_next = S.next(ui + 1, nxt);
        const char* nA = has_next ? nxt.A : cA; const char* nB = has_next ? nxt.B : cB;
        const int nt = cur.nt;
        for (int t = 0; t < nt; t += 2) {
            const bool last = (t == nt - 2);
            const char* a1 = cA + (size_t)(t + 1) * kstep;
            const char* a2 = last ? nA : cA + (size_t)(t + 2) * kstep; const char* b2 = last ? nB : cB + (size_t)(t + 2) * kstep;
            const char* a3 = a2 + kstep; const char* b3 = b2 + kstep;
            PG8_LDB(B0, 0, 0); PG8_LDB(B1, 0, 1); PG8_SCHED; PG8_LDA(At, 0, 0); PG8_STAGE(PG8_SA(1, 1), a1 + hstepA, voffA);
            PG8_WAIT_V(8); PG8_WAIT_L(0); PG8_BAR; PG8_MMA(0, 0, At, B0); PG8_MMA(0, 1, At, B1); PG8_BAR; PG8_SCHED;
            PG8_LDA(At, 0, 1); PG8_STAGE(PG8_SB(0, 0), b2, voffB); PG8_STAGE(PG8_SB(0, 1), b2 + hstepB, voffB); PG8_STAGE(PG8_SA(0, 0), a2, voffA);
            PG8_WAIT_V(8); PG8_WAIT_L(0); PG8_BAR; PG8_MMA(1, 0, At, B0); PG8_MMA(1, 1, At, B1); PG8_BAR; PG8_SCHED;
            PG8_LDB(B0, 1, 0); PG8_LDB(B1, 1, 1); PG8_SCHED; PG8_LDA(At, 1, 0); PG8_STAGE(PG8_SA(0, 1), a2 + hstepA, voffA);
            PG8_WAIT_V(8); PG8_WAIT_L(0); PG8_BAR; PG8_MMA(0, 0, At, B0); PG8_MMA(0, 1, At, B1); PG8_BAR; PG8_SCHED;
            PG8_LDA(At, 1, 1); PG8_STAGE(PG8_SB(1, 0), b3, voffB); PG8_STAGE(PG8_SB(1, 1), b3 + hstepB, voffB); PG8_STAGE(PG8_SA(1, 0), a3, voffA);
            PG8_WAIT_V(8); PG8_WAIT_L(0); PG8_BAR; PG8_MMA(1, 0, At, B0); PG8_MMA(1, 1, At, B1); PG8_BAR; PG8_SCHED;
        }
        if (wr == 0) PG8_BAR;
        E(acc, cur, wr, wc, fr, fq);
        if (!has_next) break;
#pragma unroll
        for (int a = 0; a < 2; ++a)
#pragma unroll
            for (int b = 0; b < 2; ++b)
#pragma unroll
                for (int m = 0; m < 4; ++m)
#pragma unroll
                    for (int n = 0; n < 2; ++n) acc[a][b][m][n] = (f32x4){0.f, 0.f, 0.f, 0.f};
        cur = nxt; cA = nA; cB = nB; ++ui;
        if (wr == 1) PG8_BAR;
    }
    PG8_WAIT_V(0);
    PG8_BAR;
#undef PG8_SA
#undef PG8_SB
#undef PG8_STAGE
#undef PG8_LDA
#undef PG8_LDB
#undef PG8_MMA
#undef PG8_WAIT_V
#undef PG8_WAIT_L
#undef PG8_BAR
#undef PG8_SCHED
}
}
typedef f32x4 AccT[2][2][4][2];
__device__ __forceinline__ unsigned cvt_pk_bf16(float lo, float hi) { unsigned r; asm volatile("v_cvt_pk_bf16_f32 %0, %1, %2" : "=v"(r) : "v"(lo), "v"(hi)); return r; }
__device__ __forceinline__ u32x4 pack8(const f32x4 v0, const f32x4 v1) { u32x4 w; w.x = cvt_pk_bf16(v0[0], v0[1]); w.y = cvt_pk_bf16(v0[2], v0[3]); w.z = cvt_pk_bf16(v1[0], v1[1]); w.w = cvt_pk_bf16(v1[2], v1[3]); return w; }
template <int MODE>
__device__ __forceinline__ void store_tile_bf16(const AccT& acc, bf16_t* base, int ldc, int row0, int col0, const float* bias) {
    f32x4 bv[2][2];
#pragma unroll
    for (int bj = 0; bj < 2; ++bj)
#pragma unroll
        for (int n = 0; n < 2; ++n) bv[bj][n] = (MODE == 2) ? *(const f32x4*)(bias + col0 + bj * 128 + 4 * n) : (f32x4){0.f, 0.f, 0.f, 0.f};
#pragma unroll
    for (int ai = 0; ai < 2; ++ai)
#pragma unroll
        for (int m = 0; m < 4; ++m) { bf16_t* rowp = base + (size_t)(row0 + ai * 128 + m * 16) * ldc + col0;
#pragma unroll
            for (int bj = 0; bj < 2; ++bj) { f32x4 v0 = acc[ai][bj][m][0], v1 = acc[ai][bj][m][1];
                if (MODE == 1) { _Pragma("unroll") for (int e = 0; e < 4; ++e) { v0[e] = gelu_tanh(v0[e]); v1[e] = gelu_tanh(v1[e]); } }
                if (MODE == 2) { v0 = v0 + bv[bj][0]; v1 = v1 + bv[bj][1]; _Pragma("unroll") for (int e = 0; e < 4; ++e) { v0[e] = sigmoid_(v0[e]); v1[e] = sigmoid_(v1[e]); } }
                *(u32x4*)(rowp + bj * 128) = pack8(v0, v1); } }
}
struct SchedP1 { const char* H; const char* WT; const char* MEMN; const char* WTM; int G, c;
    __device__ __forceinline__ bool next(int i, pg8::Unit& u) const {
        const int L = i * G + c; const int n1 = 64 * 42;
        if (L < n1) { pg8::tile_of(L, 64, 42, u.pm, u.pn); u.kind = 0; u.A = H + (size_t)u.pm * 256 * D * 2; u.B = WT + (size_t)u.pn * 256 * D * 2; u.nt = D / 64; pg8::uni(u); return true; }
        if (L < n1 + 8) { const int j = L - n1; u.pm = j >> 2; u.pn = j & 3; u.kind = 1; u.A = MEMN + (size_t)u.pm * 256 * D * 2; u.B = WTM + (size_t)u.pn * 256 * D * 2; u.nt = D / 64; pg8::uni(u); return true; }
        return false; } };
struct EpiP1 { bf16_t* PROJ; bf16_t* G; bf16_t* MEMKV; const float* bgate;
    __device__ __forceinline__ void operator()(const AccT& acc, const pg8::Unit& u, int wr, int wc, int fr, int fq) const {
        const int row0 = u.pm * 256 + wr * 64 + fr, cl = wc * 32 + 8 * fq;
        if (u.kind == 1) { store_tile_bf16<0>(acc, MEMKV, 2 * CW, row0, u.pn * 256 + cl, nullptr); return; }
        if (u.pn >= 18) { store_tile_bf16<2>(acc, G, GW, row0, (u.pn - 18) * 256 + cl, bgate); return; }
        if (u.pn == 14 || u.pn == 15) { store_tile_bf16<1>(acc, PROJ, INW, row0, u.pn * 256 + cl, nullptr); return; }
        store_tile_bf16<0>(acc, PROJ, INW, row0, u.pn * 256 + cl, nullptr);
    } };
struct SchedP3 { const char* O; const char* WT; int G, c;
    __device__ __forceinline__ bool next(int i, pg8::Unit& u) const {
        const int ti = i / 3, seg = i - 3 * ti; const int L = ti * G + c; if (L >= 64 * 8) return false;
        pg8::tile_of(L, 64, 8, u.pm, u.pn); u.kind = seg;
        const int kb = seg == 0 ? 0 : (seg == 1 ? 1024 : 1536);
        u.A = O + ((size_t)u.pm * 256 * D + kb) * 2; u.B = WT + ((size_t)u.pn * 256 * D + kb) * 2; u.nt = seg == 0 ? 16 : 8; pg8::uni(u); return true; } };
struct EpiP3 { const bf16_t* G; float* slab; bf16_t* MERGED;
    __device__ __forceinline__ void operator()(const AccT& acc, const pg8::Unit& u, int wr, int wc, int fr, int fq) const {
        const int row0 = u.pm * 256 + wr * 64 + fr, col0 = u.pn * 256 + wc * 32 + 8 * fq, seg = u.kind;
        f32x4* sl = (f32x4*)slab + threadIdx.x;
#pragma unroll
        for (int ai = 0; ai < 2; ++ai)
#pragma unroll
            for (int m = 0; m < 4; ++m)
#pragma unroll
                for (int bj = 0; bj < 2; ++bj) {
                    const size_t row = (size_t)(row0 + ai * 128 + m * 16); const int col = col0 + bj * 128;
                    float gf[8]; unpack8(*(const u32x4*)(G + row * GW + seg * D + col), gf);
                    f32x4 v0 = acc[ai][bj][m][0], v1 = acc[ai][bj][m][1];
                    v0[0] *= gf[0]; v0[1] *= gf[1]; v0[2] *= gf[2]; v0[3] *= gf[3]; v1[0] *= gf[4]; v1[1] *= gf[5]; v1[2] *= gf[6]; v1[3] *= gf[7];
                    if (seg > 0) { v0 = v0 + sl[0]; v1 = v1 + sl[512]; }
                    if (seg < 2) { sl[0] = v0; sl[512] = v1; }
                    else *(u32x4*)(MERGED + row * D + col) = pack8(v0, v1);
                    sl += 1024; asm volatile("" : "+v"(sl) :: "memory");
                }
    } };
struct SchedSq { const char* A; const char* WT; int G, c;
    __device__ __forceinline__ bool next(int i, pg8::Unit& u) const {
        const int L = i * G + c; if (L >= 64 * 8) return false;
        pg8::tile_of(L, 64, 8, u.pm, u.pn); u.kind = 0; u.A = A + (size_t)u.pm * 256 * D * 2; u.B = WT + (size_t)u.pn * 256 * D * 2; u.nt = D / 64; pg8::uni(u); return true; } };
struct EpiP4 { const float* x; float* out; bf16_t* xb; float* ss;
    __device__ __forceinline__ void operator()(const AccT& acc, const pg8::Unit& u, int wr, int wc, int fr, int fq) const {
        const int row0 = u.pm * 256 + wr * 64 + fr, col0 = u.pn * 256 + wc * 32 + 8 * fq;
#pragma unroll
        for (int ai = 0; ai < 2; ++ai)
#pragma unroll
            for (int m = 0; m < 4; ++m) { const size_t row = (size_t)(row0 + ai * 128 + m * 16); float sq = 0.f;
#pragma unroll
                for (int bj = 0; bj < 2; ++bj) { const size_t o = row * D + col0 + bj * 128;
                    const f32x4 v0 = acc[ai][bj][m][0] + *(const f32x4*)(x + o), v1 = acc[ai][bj][m][1] + *(const f32x4*)(x + o + 4);
                    *(f32x4*)(out + o) = v0; *(f32x4*)(out + o + 4) = v1; *(u32x4*)(xb + o) = pack8(v0, v1);
                    sq += (v0[0] * v0[0] + v0[1] * v0[1]) + (v0[2] * v0[2] + v0[3] * v0[3]) + (v1[0] * v1[0] + v1[1] * v1[1]) + (v1[2] * v1[2] + v1[3] * v1[3]); }
                sq += __shfl_xor(sq, 16); sq += __shfl_xor(sq, 32);
                if (fq == 0) atomicAdd(ss + row, sq); }
    } };
struct EpiP5 { bf16_t* Q; const float* ss;
    __device__ __forceinline__ void operator()(const AccT& acc, const pg8::Unit& u, int wr, int wc, int fr, int fq) const {
        const int row0 = u.pm * 256 + wr * 64 + fr, col0 = u.pn * 256 + wc * 32 + 8 * fq;
#pragma unroll
        for (int ai = 0; ai < 2; ++ai)
#pragma unroll
            for (int m = 0; m < 4; ++m) { const size_t row = (size_t)(row0 + ai * 128 + m * 16); const float rs = rsqrtf(ss[row] * (1.f / D) + EPS);
#pragma unroll
                for (int bj = 0; bj < 2; ++bj) *(u32x4*)(Q + row * D + col0 + bj * 128) = pack8(acc[ai][bj][m][0] * rs, acc[ai][bj][m][1] * rs); }
    } };


namespace att {
using s16x4  = __attribute__((ext_vector_type(4))) short;
using f32x16 = __attribute__((ext_vector_type(16))) float;
constexpr int NWV = 8, QBLK = 32, KVBLK = 64, DH = 128;
constexpr float THR = 8.f;
constexpr int SHM_V = KVBLK * DH * 2, SHM_K = KVBLK * DH * 2;
constexpr int OFF_WS = 2 * SHM_V + 2 * SHM_K, OFF_BT = OFF_WS + NWV * 64 * 4, OFF_OST = OFF_BT + 1536, LDS_NEED = OFF_OST + NWV * 8192;
#define KSWZ(row, colB) ((row) * 256 + ((colB) ^ (((row) & 7) << 4)))
#define SBAR() __builtin_amdgcn_sched_barrier(0)
__device__ __forceinline__ int crow(int r, int hi) { return (r & 3) + 8 * (r >> 2) + 4 * hi; }
__device__ __forceinline__ unsigned cvtpk(float lo, float hi) { unsigned r; asm volatile("v_cvt_pk_bf16_f32 %0, %1, %2" : "=v"(r) : "v"(lo), "v"(hi)); return r; }
__device__ __forceinline__ void partialSM(f32x16& p0, f32x16& p1, float& m_reg, float& mn, float& alpha) {
  constexpr float C = 1.4426950408889634f;
  float pmax = p0[0];
#pragma unroll
  for (int r = 1; r < 16; ++r) pmax = fmaxf(pmax, p0[r]);
#pragma unroll
  for (int r = 0; r < 16; ++r) pmax = fmaxf(pmax, p1[r]);
  { auto rr = __builtin_amdgcn_permlane32_swap(__float_as_uint(pmax), __float_as_uint(pmax), false, false);
    pmax = fmaxf(__uint_as_float(rr[0]), __uint_as_float(rr[1])); }
  if (__builtin_expect(__all(pmax - m_reg <= THR), 1)) { mn = m_reg; alpha = 1.f; }
  else { mn = fmaxf(m_reg, pmax); alpha = __builtin_amdgcn_exp2f((m_reg - mn) * C); m_reg = mn; }
  float mnC = -mn * C;
#pragma unroll
  for (int r = 0; r < 16; ++r) p0[r] = fmaf(p0[r], C, mnC);
#pragma unroll
  for (int r = 0; r < 16; ++r) p1[r] = fmaf(p1[r], C, mnC);
#pragma unroll
  for (int r = 0; r < 16; ++r) p0[r] = __builtin_amdgcn_exp2f(p0[r]);
}
__device__ __forceinline__ void finishSM(f32x16& p0, f32x16& p1, float alpha, float& l_reg, bf16x8& pa0, bf16x8& pa1, bf16x8& pa2, bf16x8& pa3) {
#pragma unroll
  for (int r = 0; r < 16; ++r) p1[r] = __builtin_amdgcn_exp2f(p1[r]);
  float ps = 0;
#pragma unroll
  for (int r = 0; r < 16; ++r) ps += p0[r];
#pragma unroll
  for (int r = 0; r < 16; ++r) ps += p1[r];
  { auto rr = __builtin_amdgcn_permlane32_swap(__float_as_uint(ps), __float_as_uint(ps), false, false);
    ps = __uint_as_float(rr[0]) + __uint_as_float(rr[1]); }
  l_reg = l_reg * alpha + ps;
#define PK4(P, BASE, OUT) do { unsigned a0 = cvtpk(P[BASE + 0], P[BASE + 1]), a1 = cvtpk(P[BASE + 2], P[BASE + 3]);   \
    unsigned b0 = cvtpk(P[BASE + 4], P[BASE + 5]), b1 = cvtpk(P[BASE + 6], P[BASE + 7]);                              \
    auto r0 = __builtin_amdgcn_permlane32_swap(a0, b0, false, false); auto r1 = __builtin_amdgcn_permlane32_swap(a1, b1, false, false); \
    u32x4 w = {r0[0], r1[0], r0[1], r1[1]}; OUT = *reinterpret_cast<bf16x8*>(&w); } while (0)
  PK4(p0, 0, pa0); PK4(p0, 8, pa1); PK4(p1, 0, pa2); PK4(p1, 8, pa3);
#undef PK4
}
template <bool BIAS>
__device__ __forceinline__ void qkt(f32x16& p0, f32x16& p1, const LAS char* Ks, const LAS char* qs, int r32, int hi, const LAS float* bp) {
  if (BIAS) {
#pragma unroll
    for (int r = 0; r < 16; ++r) { p0[r] = bp[(r & 3) + 8 * (r >> 2)]; p1[r] = bp[32 + (r & 3) + 8 * (r >> 2)]; }
  } else { p0 = f32x16{}; p1 = f32x16{}; }
#pragma unroll
  for (int d0 = 0; d0 < 8; ++d0) { int cb = (d0 * 16 + hi * 8) * 2;
    bf16x8 b0 = *reinterpret_cast<const LAS bf16x8*>(Ks + KSWZ(r32, cb));
    bf16x8 b1 = *reinterpret_cast<const LAS bf16x8*>(Ks + KSWZ(32 + r32, cb));
    const bf16x8 qv = *reinterpret_cast<const LAS bf16x8*>(qs + d0 * 1024);
    p0 = __builtin_amdgcn_mfma_f32_32x32x16_bf16(b0, qv, p0, 0, 0, 0);
    p1 = __builtin_amdgcn_mfma_f32_32x32x16_bf16(b1, qv, p1, 0, 0, 0); }
}
__device__ __forceinline__ int v_st(int k, int c) { const int kk = (k & ~0xC) | ((k & 4) << 1) | ((k & 8) >> 1); return ((kk >> 3) * 4 + (c >> 5)) * 512 + ((kk & 7) * 32 + (c & 31)) * 2; }
__device__ __forceinline__ int v_rd_base(int lane) { return ((lane & 3) << 3) | (((lane >> 2) & 3) << 6) | (((lane >> 4) & 1) << 5) | (((lane >> 5) & 1) << 8); }
constexpr int v_rd_off(int d0, int ks, int half) { return d0 * 512 + ks * 4096 + half * 2048; }
template <int OFF> __device__ __forceinline__ s16x4 tr_read(int vb) {
  s16x4 r; asm volatile("ds_read_b64_tr_b16 %0, %1 offset:%2" : "=&v"(r) : "v"(vb), "i"(OFF) : "memory"); return r;
}
template <int D0> __device__ __forceinline__ void pv_one(f32x16& od, int vb, bf16x8 pa0, bf16x8 pa1, bf16x8 pa2, bf16x8 pa3) {
  const s16x4 l0 = tr_read<v_rd_off(D0, 0, 0)>(vb), h0 = tr_read<v_rd_off(D0, 0, 1)>(vb), l1 = tr_read<v_rd_off(D0, 1, 0)>(vb), h1 = tr_read<v_rd_off(D0, 1, 1)>(vb);
  const s16x4 l2 = tr_read<v_rd_off(D0, 2, 0)>(vb), h2 = tr_read<v_rd_off(D0, 2, 1)>(vb), l3 = tr_read<v_rd_off(D0, 3, 0)>(vb), h3 = tr_read<v_rd_off(D0, 3, 1)>(vb);
  asm volatile("s_waitcnt lgkmcnt(0)" ::: "memory"); SBAR();
#define PK(L, H) (bf16x8){L[0], L[1], L[2], L[3], H[0], H[1], H[2], H[3]}
  od = __builtin_amdgcn_mfma_f32_32x32x16_bf16(pa0, PK(l0, h0), od, 0, 0, 0);
  od = __builtin_amdgcn_mfma_f32_32x32x16_bf16(pa1, PK(l1, h1), od, 0, 0, 0);
  od = __builtin_amdgcn_mfma_f32_32x32x16_bf16(pa2, PK(l2, h2), od, 0, 0, 0);
  od = __builtin_amdgcn_mfma_f32_32x32x16_bf16(pa3, PK(l3, h3), od, 0, 0, 0);
#undef PK
}
__device__ __forceinline__ void pv_d0(f32x16* o, int vb, bf16x8 pa0, bf16x8 pa1, bf16x8 pa2, bf16x8 pa3) {
  pv_one<0>(o[0], vb, pa0, pa1, pa2, pa3); pv_one<1>(o[1], vb, pa0, pa1, pa2, pa3); pv_one<2>(o[2], vb, pa0, pa1, pa2, pa3); pv_one<3>(o[3], vb, pa0, pa1, pa2, pa3);
}
template <int LDQ, int LDK, int LDO, bool BAND>
__device__ __forceinline__ void attn_body(const bf16_t* Qb, const bf16_t* Kh, const bf16_t* Vh, bf16_t* Ob,
                                          const int NT, const int kc0, const float* btab_src, LAS char* lds) {
  const int tid = threadIdx.x, wid = __builtin_amdgcn_readfirstlane(tid >> 6), lane = tid & 63, r32 = lane & 31, hi = lane >> 5;
  LAS char* V_lds = lds; LAS char* K_lds = lds + 2 * SHM_V;
  LAS float* wsf = (LAS float*)(lds + OFF_WS) + wid * 64; LAS float* li_l = wsf; LAS float* al_l = wsf + 32;
  LAS float* btab = (LAS float*)(lds + OFF_BT);
  if (BAND) { if (tid < 384) btab[tid] = tid < 64 ? btab_src[256] : (tid < 256 ? btab_src[320 - tid] : -30000.f); }
  float m_reg = -10000.f, l_reg = 0; f32x16 o[4] = {};
  const bf16_t* Qw = Qb + (long)(wid * QBLK + r32) * LDQ + hi * 8;
  LAS char* qr = lds + OFF_OST + wid * 8192 + lane * 16;
#pragma unroll
  for (int d0 = 0; d0 < 8; ++d0) *reinterpret_cast<LAS bf16x8*>(qr + d0 * 1024) = *reinterpret_cast<const bf16x8*>(Qw + d0 * 16);
  const int sr = tid >> 4, sc = (tid & 15) * 8, vst0 = v_st(sr, sc), vst1 = v_st(32 + sr, sc);
  const int vb0 = (int)(unsigned)(uintptr_t)V_lds + v_rd_base(lane);
  struct { bf16x8 vs0, vs1, ks0, ks1; } sr_[1];
  const int pw = wid >> 1, qi = (wid & 1) * 32 + r32;
#define TROW(t) ((BAND ? (((kc0) + (t)) > 0 ? ((kc0) + (t)) : 0) : (t)) * KVBLK)
#define SLOAD(i, t) do { const long k0_ = TROW(t); sr_[i].vs0 = *reinterpret_cast<const bf16x8*>(&Vh[(k0_ + sr) * LDK + sc]); sr_[i].vs1 = *reinterpret_cast<const bf16x8*>(&Vh[(k0_ + 32 + sr) * LDK + sc]); \
    sr_[i].ks0 = *reinterpret_cast<const bf16x8*>(&Kh[(k0_ + sr) * LDK + sc]); sr_[i].ks1 = *reinterpret_cast<const bf16x8*>(&Kh[(k0_ + 32 + sr) * LDK + sc]); } while (0)
#define SWRITE(b, i) do { *(LAS bf16x8*)(V_lds + (b) * SHM_V + vst0) = sr_[i].vs0; *(LAS bf16x8*)(V_lds + (b) * SHM_V + vst1) = sr_[i].vs1; int kc_ = sc * 2; \
    *(LAS bf16x8*)(K_lds + (b) * SHM_K + KSWZ(sr, kc_)) = sr_[i].ks0; *(LAS bf16x8*)(K_lds + (b) * SHM_K + KSWZ(32 + sr, kc_)) = sr_[i].ks1; } while (0)
#define SWAIT() asm volatile("s_waitcnt vmcnt(0)" ::: "memory")
#define RESC(a) do { if (__any((a) < 1.f)) { if (hi == 0) al_l[r32] = (a); asm volatile("s_waitcnt lgkmcnt(0)" ::: "memory"); \
    _Pragma("unroll") for (int d = 0; d < 4; ++d) _Pragma("unroll") for (int r = 0; r < 16; ++r) o[d][r] *= al_l[crow(r, hi)]; } } while (0)
#define BPTR(t) ({ const int t_ = (t); const int dch = pw + 8 - t_; int kb_ = 192 - dch * 64 - qi + 4 * hi; kb_ = kb_ < 0 ? 0 : kb_; \
    if (dch < 0 || dch > 8 || (kc0) + t_ < 0) kb_ = 288; (const LAS float*)(btab + kb_); })
  f32x16 pA0, pA1, pB0, pB1; float mnA, mnB, alA, alB; bf16x8 pa0, pa1, pa2, pa3;
  constexpr int SE = 0, SO = 0;
  SLOAD(SE, 0); asm volatile("s_waitcnt vmcnt(0)" ::: "memory"); SWRITE(0, SE); __syncthreads();
  qkt<BAND>(pA0, pA1, K_lds, qr, r32, hi, BPTR(0)); partialSM(pA0, pA1, m_reg, mnA, alA);
  SLOAD(SO, 1);
  SWAIT(); SWRITE(1, SO); __syncthreads();
  for (int j = 1; j + 1 < NT; j += 2) {
    SBAR(); qkt<BAND>(pB0, pB1, K_lds + SHM_K, qr, r32, hi, BPTR(j));
    finishSM(pA0, pA1, alA, l_reg, pa0, pa1, pa2, pa3); SBAR();
    SLOAD(SO, j + 1); SBAR();
    pv_d0(o, vb0, pa0, pa1, pa2, pa3); partialSM(pB0, pB1, m_reg, mnB, alB);
    __syncthreads(); SWAIT(); SWRITE(0, SE);
    RESC(alB); __syncthreads();
    SBAR(); qkt<BAND>(pA0, pA1, K_lds, qr, r32, hi, BPTR(j + 1));
    finishSM(pB0, pB1, alB, l_reg, pa0, pa1, pa2, pa3); SBAR();
    SLOAD(SE, j + 2); SBAR();
    pv_d0(o, vb0 + SHM_V, pa0, pa1, pa2, pa3); partialSM(pA0, pA1, m_reg, mnA, alA);
    __syncthreads(); SWAIT(); SWRITE(1, SO);
    RESC(alA); __syncthreads();
  }
  SBAR(); qkt<BAND>(pB0, pB1, K_lds + SHM_K, qr, r32, hi, BPTR(NT - 1));
  finishSM(pA0, pA1, alA, l_reg, pa0, pa1, pa2, pa3); SBAR();
  pv_d0(o, vb0, pa0, pa1, pa2, pa3); partialSM(pB0, pB1, m_reg, mnB, alB);
  __syncthreads(); RESC(alB);
  finishSM(pB0, pB1, alB, l_reg, pa0, pa1, pa2, pa3); SBAR();
  pv_d0(o, vb0 + SHM_V, pa0, pa1, pa2, pa3);
  if (hi == 0) li_l[r32] = l_reg; asm volatile("s_waitcnt lgkmcnt(0)" ::: "memory");
  float rli[16];
#pragma unroll
  for (int r = 0; r < 16; ++r) rli[r] = __builtin_amdgcn_rcpf(li_l[crow(r, hi)]);
  { LAS bf16_t* stg = (LAS bf16_t*)(lds + OFF_OST + wid * 8192);
#pragma unroll
    for (int r = 0; r < 16; ++r) { const int orow = crow(r, hi);
#pragma unroll
      for (int d0 = 0; d0 < 4; ++d0) stg[orow * 128 + d0 * 32 + r32] = (bf16_t)f2bf(o[d0][r] * rli[r]); }
    asm volatile("s_waitcnt lgkmcnt(0)" ::: "memory");
    bf16_t* Ow = Ob + (long)(wid * QBLK) * LDO;
#pragma unroll
    for (int i = 0; i < 8; ++i) { const int row = i * 4 + (lane >> 4), ch = lane & 15; const u32x4 v = *(const LAS u32x4*)(stg + row * 128 + ch * 8); *(u32x4*)(Ow + (long)row * LDO + ch * 8) = v; } }
  __syncthreads();
#undef TROW
#undef SLOAD
#undef SWRITE
#undef SWAIT
#undef RESC
#undef BPTR
}
#undef KSWZ
#undef SBAR
}

#define XB_TMO      128
#define XB_XCNT(j)  (256  + 64 * (j))
#define XB_XSUB(j)  (1280 + 64 * (j))
#define XB_XGEN(j)  (2304 + 64 * (j))
#define XB_TOP      3328
#define XB_TOPGEN   3392
#define XCD_BAR_WORDS 3456
#define XB_SPIN_CAP (1u << 22)
__device__ __forceinline__ unsigned xb_ld(unsigned* p)              { return __hip_atomic_load(p, __ATOMIC_RELAXED, __HIP_MEMORY_SCOPE_AGENT); }
__device__ __forceinline__ unsigned xb_add(unsigned* p, unsigned v) { return __hip_atomic_fetch_add(p, v, __ATOMIC_RELAXED, __HIP_MEMORY_SCOPE_AGENT); }
__device__ __forceinline__ unsigned xb_xcc_id() { return (unsigned)__builtin_amdgcn_s_getreg((3 << 11) | 20) & 0xFu; }
#define XB_SPIN(cond, bar) do { unsigned _sp = 0; while (cond) { __builtin_amdgcn_s_sleep(1); \
    if ((++_sp & 255u) == 0u) { if (xb_ld(&(bar)[XB_TMO])) break; if (_sp > XB_SPIN_CAP) { atomicAdd(&(bar)[XB_TMO], 1u); break; } } } } while (0)
struct XcdBarrier { unsigned* bar; unsigned x; volatile LAS unsigned* st; };
__device__ __forceinline__ XcdBarrier xcd_barrier_post(unsigned* bar, volatile LAS unsigned* st) {
    XcdBarrier b; b.bar = bar; b.x = xb_xcc_id(); b.st = st;
    if (threadIdx.x == 0) (void)xb_add(&bar[XB_XCNT(b.x)], 1u);
    return b;
}
__device__ __forceinline__ void xcd_barrier_complete(unsigned* bar, unsigned x, unsigned& nloc, unsigned& nx) {
    const unsigned G = gridDim.x * gridDim.y * gridDim.z;
    unsigned sum, cnt, mine, sp = 0u;
    for (;;) {
        sum = 0u; cnt = 0u; mine = 0u;
#pragma unroll
        for (unsigned j = 0; j < 16; ++j) { const unsigned c = xb_ld(&bar[XB_XCNT(j)]); sum += c; cnt += (c > 0u) ? 1u : 0u; mine = (j == x) ? c : mine; }
        if (sum == G) break;
        __builtin_amdgcn_s_sleep(1);
        if ((++sp & 255u) == 0u) { if (xb_ld(&bar[XB_TMO])) break; if (sp > XB_SPIN_CAP) { atomicAdd(&bar[XB_TMO], 1u); break; } }
    }
    nloc = mine > 0u ? mine : 1u; nx = cnt > 0u ? cnt : 1u;
}
__device__ __forceinline__ void xcd_barrier(const XcdBarrier& b) {
    asm volatile("s_waitcnt vmcnt(0)" ::: "memory");
    __syncthreads();
    if (threadIdx.x == 0) {
        unsigned* bar = b.bar;
        __builtin_amdgcn_s_waitcnt(0);
        unsigned nloc = b.st[0], nx = b.st[1];
        if (nloc == 0u) { xcd_barrier_complete(bar, b.x, nloc, nx); b.st[0] = nloc; b.st[1] = nx; }
        const unsigned old = xb_add(&bar[XB_XSUB(b.x)], 1u);
        const unsigned gen = old / nloc;
        if (old + 1u == (gen + 1u) * nloc) {
            __builtin_amdgcn_fence(__ATOMIC_RELEASE, "agent");
            asm volatile("s_waitcnt vmcnt(0)" ::: "memory");
            const unsigned og = xb_add(&bar[XB_TOP], 1u);
            const unsigned tg = og / nx;
            if (og + 1u == (tg + 1u) * nx) xb_add(&bar[XB_TOPGEN], 1u);
            else XB_SPIN(xb_ld(&bar[XB_TOPGEN]) == tg, bar);
            __builtin_amdgcn_fence(__ATOMIC_ACQUIRE, "agent");
            xb_add(&bar[XB_XGEN(b.x)], 1u);
            asm volatile("s_waitcnt vmcnt(0)" ::: "memory");
        } else {
            XB_SPIN(xb_ld(&bar[XB_XGEN(b.x)]) == gen, bar);
            __builtin_amdgcn_fence(__ATOMIC_ACQUIRE, "agent");
            asm volatile("s_waitcnt vmcnt(0)" ::: "memory");
        }
    }
    __syncthreads();
}
constexpr int RING_BYTES = 131072, MISC_OFF = 143360, LDS_BYTES = 147456, NTHREADS = 512;
static_assert(att::LDS_NEED <= MISC_OFF, "attention scratch below the MISC words");
constexpr size_t WS_SLAB = WS_X2BF;

__global__ void __launch_bounds__(NTHREADS, 2) fwd(Params p) {
    cg::grid_group grid = cg::this_grid();
    extern __shared__ __attribute__((aligned(16))) unsigned char lds_raw[];
    LAS unsigned char* lds = (LAS unsigned char*)lds_raw;
    volatile LAS unsigned* MISC = (volatile LAS unsigned*)(lds + MISC_OFF);
    const int tid = threadIdx.x, lane = tid & 63, wave = __builtin_amdgcn_readfirstlane(tid >> 6);
    const int nwb = NTHREADS / 64;
    const int gw = blockIdx.x * nwb + wave, NW = gridDim.x * nwb;
    const int Gd = gridDim.x, cb = blockIdx.x;
    unsigned char* ws = p.ws;
    bf16_t* WT_IN = (bf16_t*)(ws + WS_WT_IN); bf16_t* WT_GATE = (bf16_t*)(ws + WS_WT_GATE); bf16_t* WT_BR = (bf16_t*)(ws + WS_WT_BR);
    bf16_t* WT_O = (bf16_t*)(ws + WS_WT_O); bf16_t* WT_PQ = (bf16_t*)(ws + WS_WT_PQ); bf16_t* WT_MKV = (bf16_t*)(ws + WS_WT_MKV);
    bf16_t* KEYSB = (bf16_t*)(ws + WS_KEYSB); bf16_t* MEMN = (bf16_t*)(ws + WS_MEMN); bf16_t* MEMKV = (bf16_t*)(ws + WS_MEMKV);
    bf16_t* HO = (bf16_t*)(ws + WS_HO); bf16_t* PROJ = (bf16_t*)(ws + WS_PROJ); bf16_t* G = (bf16_t*)(ws + WS_G);
    bf16_t* MERGED = (bf16_t*)(ws + WS_MERGED); bf16_t* X2BF = (bf16_t*)(ws + WS_X2BF); bf16_t* QB = (bf16_t*)(ws + WS_Q);
        float* SS2 = (float*)(ws + WS_CTL + CTL_SS2_BYTE);
    if (tid < 64) MISC[tid] = 0u;
    __syncthreads();
    XcdBarrier bar = xcd_barrier_post((unsigned*)(ws + WS_CTL + CTL_BAR_BYTE), MISC + 8);

    {
        float* scr = (float*)lds_raw + wave * (64 * 33);
        transpose_all(p.in[3], D, INW, WT_IN, nullptr, scr, gw, NW, lane);
        transpose_all(p.in[18], D, GW, WT_GATE, nullptr, scr, gw, NW, lane);
        transpose_all(p.in[20], D, D, WT_BR, nullptr, scr, gw, NW, lane);
        transpose_all(p.in[21], D, D, WT_O, nullptr, scr, gw, NW, lane);
        transpose_all(p.in[23], D, D, WT_PQ, p.in[22], scr, gw, NW, lane);
        transpose_all(p.in[15], D, 2 * CW, WT_MKV, nullptr, scr, gw, NW, lane);
        for (int m = gw; m < T; m += NW) rms_row_bf16(p.in[0] + (size_t)m * D, p.in[2], HO + (size_t)m * D, lane);
        for (int m = gw; m < BATCH * NMEM; m += NW) rms_row_bf16(p.in[1] + (size_t)m * D, p.in[14], MEMN + (size_t)m * D, lane);
        const float* keys = p.in[24];
        for (int i = gw * 64 + lane; i < PH * 2 * NKEYS * 128 / 2; i += NW * 64) ((unsigned*)KEYSB)[i] = pk2(keys[2 * i], keys[2 * i + 1]);
    }
    grid.sync();
    {
        SchedP1 S{(const char*)HO, (const char*)WT_IN, (const char*)MEMN, (const char*)WT_MKV, Gd, cb};
        EpiP1 E{PROJ, G, MEMKV, p.in[19]};
        pg8::gemm_phase(lds, D, D, S, E);
    }
    xcd_barrier(bar);
    {
        const float qscale = 0.08838834764831845f;
        for (int it = gw; it < T * 20; it += NW) { const int t = it / 20, j = it % 20;
            if (j < 8) headnorm(PROJ + (size_t)t * INW + C_QA + j * 128, p.in[4], qscale, lane);
            else if (j < 16) headnorm(PROJ + (size_t)t * INW + C_KA + (j - 8) * 128, p.in[5], 1.f, lane);
            else headnorm(PROJ + (size_t)t * INW + C_QC + (j - 16) * 128, p.in[16], qscale, lane); }
        for (int it = gw; it < BATCH * NMEM * 4; it += NW) { const int m = it / 4, j = it % 4; headnorm(MEMKV + (size_t)m * (2 * CW) + j * 128, p.in[17], 1.f, lane); }
        for (int u = gw; u < BATCH * NCH * 8; u += NW) { const int g = u % 8, c = (u / 8) % NCH, b = u / (8 * NCH); lru_unit<false>(p, b, c, g, lane); }
    }
    xcd_barrier(bar);
    {
        const int nA = BATCH * 8 * (NCH / 4), nC = BATCH * 4 * (SEQ / 256);
        for (int u = cb; u < nA + nC; u += Gd) {
            if (u < nA) {
                const int cg = u % (NCH / 4), h = (u / (NCH / 4)) % 8, b = u / ((NCH / 4) * 8);
                const size_t brow = (size_t)b * SEQ, qrow = brow + (size_t)cg * 256;
                att::attn_body<INW, INW, D, true>(PROJ + qrow * INW + C_QA + h * 128, PROJ + brow * INW + C_KA + h * 128, PROJ + brow * INW + C_VA + h * 128,
                                                  HO + qrow * D + h * 128, 12, cg * 4 - NPREV, p.in[6] + h * 257, (LAS char*)lds);
            } else {
                const int v = u - nA; const int qb = v % (SEQ / 256), h = (v / (SEQ / 256)) % 4, b = v / ((SEQ / 256) * 4);
                const size_t qrow = (size_t)b * SEQ + (size_t)qb * 256;
                att::attn_body<INW, 2 * CW, D, false>(PROJ + qrow * INW + C_QC + h * 128, MEMKV + (size_t)b * NMEM * (2 * CW) + h * 128, MEMKV + (size_t)b * NMEM * (2 * CW) + CW + h * 128,
                                                     HO + qrow * D + AW + LW + h * 128, NMEM / 64, 0, nullptr, (LAS char*)lds);
            }
        }
        for (int u = gw; u < BATCH * NCH * 8; u += NW) { const int g = u % 8, c = (u / 8) % NCH, b = u / (8 * NCH); lru_unit<true>(p, b, c, g, lane); }
    }
    xcd_barrier(bar);
    {
        SchedP3 S{(const char*)HO, (const char*)WT_BR, Gd, cb};
        EpiP3 E{G, (float*)(ws + WS_SLAB) + (size_t)cb * (32 * 512 * 4), MERGED};
        pg8::gemm_phase(lds, D, D, S, E);
    }
    xcd_barrier(bar);
    {
        SchedSq S{(const char*)MERGED, (const char*)WT_O, Gd, cb};
        EpiP4 E{p.in[0], p.out, X2BF, SS2};
        pg8::gemm_phase(lds, D, D, S, E);
        for (int r = gw; r < 2 * 16384; r += NW) {
            if (r < 16384) fp8_row(p.in[25] + (size_t)r * D, p.in[22], ws + WS_TABU + (size_t)r * 2048, (float*)(ws + WS_SCU) + r, lane);
            else { const int e = r - 16384; fp8_row(p.in[26] + (size_t)e * D, nullptr, ws + WS_TABV + (size_t)e * 2048, (float*)(ws + WS_SCV) + e, lane); }
        }
    }
    xcd_barrier(bar);
    {
        SchedSq S{(const char*)X2BF, (const char*)WT_PQ, Gd, cb};
        EpiP5 E{QB, SS2};
        pg8::gemm_phase(lds, D, D, S, E);
    }
    xcd_barrier(bar);
    for (int u = gw; u < T * PH; u += NW) route_unit(p, u % T, u / T, lane);
    xcd_barrier(bar);
    { LAS float* actL = (LAS float*)lds + wave * 128;
      for (int t = gw; t < T; t += NW) peer_token(p, t, lane, actL); }
}

extern "C" void kernel_launch(void* const* d_in, const int* in_sizes, int n_in, void* d_out, int out_size, void* d_ws, size_t ws_size, hipStream_t stream) {
    static int grid = 0;
    if (grid == 0) {
        if (n_in != 27 || out_size != T * D || ws_size < WS_END) { fprintf(stderr, "kernel_launch: unexpected problem (n_in %d out %d ws %zu)\n", n_in, out_size, ws_size); grid = -1; return; }
        int dev = 0, cus = 0, per_cu = 0;
        (void)hipGetDevice(&dev); (void)hipDeviceGetAttribute(&cus, hipDeviceAttributeMultiprocessorCount, dev);
        if (hipFuncSetAttribute((const void*)fwd, hipFuncAttributeMaxDynamicSharedMemorySize, LDS_BYTES) != hipSuccess) { fprintf(stderr, "kernel_launch: hipFuncSetAttribute failed\n"); grid = -1; return; }
        (void)hipOccupancyMaxActiveBlocksPerMultiprocessor(&per_cu, (const void*)fwd, NTHREADS, LDS_BYTES);
        if (per_cu < 1) { fprintf(stderr, "kernel_launch: occupancy query says %d\n", per_cu); grid = -1; return; }
        grid = cus;
    }
    if (grid < 0) return;
    (void)hipMemsetAsync((char*)d_ws + WS_CTL, 0, 1 * MiB, stream);
    Params p{};
    for (int i = 0; i < 27; ++i) p.in[i] = (const float*)d_in[i];
    p.out = (float*)d_out; p.ws = (unsigned char*)d_ws;
    void* args[] = {&p};
    hipError_t e = hipLaunchCooperativeKernel((const void*)fwd, dim3(grid), dim3(NTHREADS), args, LDS_BYTES, stream);
    if (e != hipSuccess) fprintf(stderr, "cooperative launch failed: %s (grid %d)\n", hipGetErrorString(e), grid);
}
```

```cpp
#include <hip/hip_runtime.h>
#include <hip/hip_cooperative_groups.h>
#include <cstdio>
#include <cstdint>
namespace cg = cooperative_groups;

#define LAS __attribute__((address_space(3)))
typedef unsigned short bf16_t;
typedef short bf16x8 __attribute__((ext_vector_type(8)));
typedef float f32x4 __attribute__((ext_vector_type(4)));
typedef unsigned u32x4 __attribute__((ext_vector_type(4)));
typedef unsigned u32x2 __attribute__((ext_vector_type(2)));

constexpr int D = 2048, BATCH = 2, SEQ = 8192, T = BATCH * SEQ;
constexpr int CHUNK = 64, NPREV = 8, NCH = SEQ / CHUNK;
constexpr int AW = 1024, LW = 512, CW = 512, INW = 4608, GW = 6144;
constexpr int NMEM = 256;
constexpr int PH = 8, NKEYS = 128, TOPK = 16;
constexpr float EPS = 1e-6f;
constexpr int C_QA = 0, C_KA = 1024, C_VA = 2048, C_XL = 3072, C_GL = 3584, C_QC = 4096;

constexpr size_t MiB = 1u << 20;
constexpr size_t WS_CTL = 0;
constexpr size_t WS_WT_IN = 2 * MiB, WS_WT_GATE = 20 * MiB, WS_WT_BR = 44 * MiB, WS_WT_O = 52 * MiB, WS_WT_PQ = 60 * MiB, WS_WT_MKV = 68 * MiB;
constexpr size_t WS_KEYSB = 72 * MiB, WS_MEMN = 73 * MiB, WS_MEMKV = 75 * MiB, WS_LRUSUM = 76 * MiB, WS_RS2 = 77 * MiB;
constexpr size_t WS_HO = 80 * MiB;
constexpr size_t WS_PROJ = 144 * MiB;
constexpr size_t WS_MERGED = 144 * MiB, WS_X2BF = 208 * MiB;
constexpr size_t WS_G = 288 * MiB;
constexpr size_t WS_TABU = 288 * MiB, WS_TABV = 320 * MiB, WS_Q = 416 * MiB;
constexpr size_t WS_SCU = 77 * MiB, WS_SCV = 77 * MiB + 65536;
constexpr size_t WS_RIDX = 480 * MiB, WS_RG = 488 * MiB, WS_END = 496 * MiB;

constexpr size_t CTL_BAR_BYTE = 16384, CTL_SS2_BYTE = 512 * 1024;
struct Params { const float* in[27]; float* out; unsigned char* ws; };

__device__ __forceinline__ float bf2f(unsigned v16) { return __uint_as_float(v16 << 16); }
__device__ __forceinline__ unsigned f2bf(float f) { unsigned u = __float_as_uint(f); return (u + 0x7fffu + ((u >> 16) & 1u)) >> 16; }
__device__ __forceinline__ unsigned pk2(float lo, float hi) { return f2bf(lo) | (f2bf(hi) << 16); }
__device__ __forceinline__ float wave_sum(float v) {
#pragma unroll
    for (int o = 1; o < 64; o <<= 1) v += __shfl_xor(v, o);
    return v;
}
__device__ __forceinline__ float sigmoid_(float x) { return 1.f / (1.f + __expf(-x)); }
__device__ __forceinline__ float gelu_tanh(float x) { const float y = 1.5957691216f * (x + 0.044715f * x * x * x); return x / (1.f + __expf(-y)); }
__device__ __forceinline__ void unpack8(const u32x4 w, float* f) {
    f[0] = __uint_as_float(w.x << 16); f[1] = __uint_as_float(w.x & 0xffff0000u);
    f[2] = __uint_as_float(w.y << 16); f[3] = __uint_as_float(w.y & 0xffff0000u);
    f[4] = __uint_as_float(w.z << 16); f[5] = __uint_as_float(w.z & 0xffff0000u);
    f[6] = __uint_as_float(w.w << 16); f[7] = __uint_as_float(w.w & 0xffff0000u);
}

__device__ __forceinline__ void transpose_item(const float* __restrict__ W, int K, int N, bf16_t* __restrict__ WT, const float* __restrict__ ks, float* scr, int item, int lane) {
    const int nblk = N / 32, kb = item / nblk, nb = item % nblk, k0 = 64 * kb, n0 = 32 * nb;
#pragma unroll 8
    for (int i = 0; i < 32; ++i) { const int kk = 2 * i + (lane >> 5); float v = W[(size_t)(k0 + kk) * N + n0 + (lane & 31)]; if (ks) v *= ks[k0 + kk]; scr[kk * 33 + (lane & 31)] = v; }
    asm volatile("s_waitcnt lgkmcnt(0)" ::: "memory");
    const int c = lane & 7;
#pragma unroll
    for (int j = 0; j < 4; ++j) { const int n = (lane >> 3) + 8 * j; const float* s = scr + (8 * c) * 33 + n;
        u32x4 o; o.x = pk2(s[0 * 33], s[1 * 33]); o.y = pk2(s[2 * 33], s[3 * 33]); o.z = pk2(s[4 * 33], s[5 * 33]); o.w = pk2(s[6 * 33], s[7 * 33]);
        *(u32x4*)(WT + (size_t)(n0 + n) * K + k0 + 8 * c) = o; }
    asm volatile("s_waitcnt lgkmcnt(0)" ::: "memory");
}
__device__ __forceinline__ void transpose_all(const float* W, int K, int N, bf16_t* WT, const float* ks, float* scr, int gw, int NW, int lane) {
    const int nitems = (K / 64) * (N / 32);
    for (int it = gw; it < nitems; it += NW) transpose_item(W, K, N, WT, ks, scr, it, lane);
}
__device__ __forceinline__ void rms_row_bf16(const float* xrow, const float* g, bf16_t* orow, int lane) {
    const f32x4* xr = (const f32x4*)xrow + lane; const f32x4* gr = (const f32x4*)g + lane;
    f32x4 v[8]; float s = 0.f;
#pragma unroll
    for (int j = 0; j < 8; ++j) { v[j] = xr[64 * j]; s += (v[j].x * v[j].x + v[j].y * v[j].y) + (v[j].z * v[j].z + v[j].w * v[j].w); }
    const float rstd = rsqrtf(wave_sum(s) * (1.f / D) + EPS);
    u32x2* o8 = (u32x2*)orow + lane;
#pragma unroll
    for (int j = 0; j < 8; ++j) { const f32x4 gg = gr[64 * j]; u32x2 o; o.x = pk2(v[j].x * rstd * gg.x, v[j].y * rstd * gg.y); o.y = pk2(v[j].z * rstd * gg.z, v[j].w * rstd * gg.w); o8[64 * j] = o; }
}

template <int TM, int TN, class Epi>
__device__ __forceinline__ void gemm_simple(const bf16_t* __restrict__ A, int lda, const bf16_t* __restrict__ Bt, int ldb, int M, int N, int K, const Epi& epi, int gw, int NW, int lane) {
    const int r = lane & 15, q = lane >> 4;
    const int ntm = M / (16 * TM), ntn = N / (16 * TN);
    for (int tile = gw; tile < ntm * ntn; tile += NW) {
        const int tm = tile / ntn, tn = tile % ntn;
        f32x4 acc[TM][TN];
#pragma unroll
        for (int i = 0; i < TM; ++i)
#pragma unroll
            for (int j = 0; j < TN; ++j) acc[i][j] = (f32x4){0.f, 0.f, 0.f, 0.f};
        const bf16_t* ap = A + (size_t)(tm * 16 * TM + r) * lda + q * 8;
        const bf16_t* bp = Bt + (size_t)(tn * 16 * TN + r) * ldb + q * 8;
        for (int k0 = 0; k0 < K; k0 += 32) {
            bf16x8 af[TM], bfr[TN];
#pragma unroll
            for (int i = 0; i < TM; ++i) af[i] = *(const bf16x8*)(ap + (size_t)i * 16 * lda + k0);
#pragma unroll
            for (int j = 0; j < TN; ++j) bfr[j] = *(const bf16x8*)(bp + (size_t)j * 16 * ldb + k0);
#pragma unroll
            for (int i = 0; i < TM; ++i)
#pragma unroll
                for (int j = 0; j < TN; ++j) acc[i][j] = __builtin_amdgcn_mfma_f32_16x16x32_bf16(af[i], bfr[j], acc[i][j], 0, 0, 0);
        }
#pragma unroll
        for (int i = 0; i < TM; ++i)
#pragma unroll
            for (int j = 0; j < TN; ++j)
#pragma unroll
                for (int e = 0; e < 4; ++e) epi(tm * 16 * TM + i * 16 + q * 4 + e, tn * 16 * TN + j * 16 + r, acc[i][j][e]);
    }
}
struct EpiProj { bf16_t* P; __device__ __forceinline__ void operator()(int row, int col, float v) const { if (col >= C_GL && col < C_QC) v = gelu_tanh(v); P[(size_t)row * INW + col] = (bf16_t)f2bf(v); } };
struct EpiGate { bf16_t* G; const float* b; __device__ __forceinline__ void operator()(int row, int col, float v) const { G[(size_t)row * GW + col] = (bf16_t)f2bf(sigmoid_(v + b[col])); } };
struct EpiStore { bf16_t* C; int ldc; __device__ __forceinline__ void operator()(int row, int col, float v) const { C[(size_t)row * ldc + col] = (bf16_t)f2bf(v); } };
struct EpiWo { const float* x; float* out; bf16_t* xb; __device__ __forceinline__ void operator()(int row, int col, float v) const { const size_t o = (size_t)row * D + col; const float y = x[o] + v; out[o] = y; xb[o] = (bf16_t)f2bf(y); } };
struct EpiQ { bf16_t* Q; const float* rs; __device__ __forceinline__ void operator()(int row, int col, float v) const { Q[(size_t)row * D + col] = (bf16_t)f2bf(v * rs[row]); } };

__device__ __forceinline__ void headnorm(bf16_t* vec, const float* g, float scale, int lane) {
    unsigned* p = (unsigned*)vec + lane; const unsigned w = *p;
    const float a = bf2f(w & 0xffffu), b = bf2f(w >> 16);
    const float rs = rsqrtf(wave_sum(a * a + b * b) * (1.f / 128.f) + EPS) * scale;
    *p = pk2(a * rs * g[2 * lane], b * rs * g[2 * lane + 1]);
}

template <bool PASS2>
__device__ __forceinline__ void lru_unit(const Params& p, int b, int c, int g, int lane) {
    const bf16_t* PROJ = (const bf16_t*)(p.ws + WS_PROJ); bf16_t* O = (bf16_t*)(p.ws + WS_HO);
    float* SUMA = (float*)(p.ws + WS_LRUSUM); float* SUMB = SUMA + BATCH * NCH * LW;
    const float* conv_w = p.in[7]; const float* conv_b = p.in[8]; const float* lru_wa = p.in[9]; const float* lru_ba = p.in[10];
    const float* lru_wx = p.in[11]; const float* lru_bx = p.in[12]; const float* lam = p.in[13];
    const int ch = g * 64 + lane;
    float wa_r[64], wx_r[64];
#pragma unroll
    for (int i = 0; i < 64; ++i) { wa_r[i] = lru_wa[(size_t)(g * 64 + i) * 64 + lane]; wx_r[i] = lru_wx[(size_t)(g * 64 + i) * 64 + lane]; }
    const float cw0 = conv_w[0 * LW + ch], cw1 = conv_w[1 * LW + ch], cw2 = conv_w[2 * LW + ch], cw3 = conv_w[3 * LW + ch], cb = conv_b[ch];
    const float ba_ = lru_ba[ch], bx_ = lru_bx[ch];
    const float sp = log1pf(__expf(-lam[ch]));
    const int t0 = c * CHUNK; const size_t row0 = (size_t)b * SEQ + t0;
    float x0 = 0.f, x1 = 0.f, x2 = 0.f;
    if (t0 >= 3) { x0 = bf2f(PROJ[(row0 - 3) * INW + C_XL + ch]); x1 = bf2f(PROJ[(row0 - 2) * INW + C_XL + ch]); x2 = bf2f(PROJ[(row0 - 1) * INW + C_XL + ch]); }
    float h = 0.f, aprod = 1.f;
    if (PASS2) { for (int j = 0; j < c; ++j) { const size_t o = (size_t)(b * NCH + j) * LW + ch; h = SUMA[o] * h + SUMB[o]; } }
    for (int t = 0; t < CHUNK; ++t) {
        const float x3 = bf2f(PROJ[(row0 + t) * INW + C_XL + ch]);
        const float xc = cw0 * x0 + cw1 * x1 + cw2 * x2 + cw3 * x3 + cb;
        x0 = x1; x1 = x2; x2 = x3;
        float rp = ba_, ip = bx_;
#pragma unroll
        for (int i = 0; i < 64; ++i) { const float xi = __int_as_float(__builtin_amdgcn_readlane(__float_as_int(xc), i)); rp = fmaf(xi, wa_r[i], rp); ip = fmaf(xi, wx_r[i], ip); }
        const float r = sigmoid_(rp), ig = sigmoid_(ip);
        const float la = -8.f * r * sp; const float a = __expf(la);
        const float mult = sqrtf(fminf(fmaxf(-expm1f(2.f * la), 1e-12f), 1.f));
        h = a * h + mult * ig * xc;
        if (PASS2) { const float gg = bf2f(PROJ[(row0 + t) * INW + C_GL + ch]); O[(row0 + t) * D + AW + ch] = (bf16_t)f2bf(h * gg); }
        else aprod *= a;
    }
    if (!PASS2) { const size_t o = (size_t)(b * NCH + c) * LW + ch; SUMA[o] = aprod; SUMB[o] = h; }
}

__device__ __forceinline__ void attn_simple(const bf16_t* Qp, int ldq, const bf16_t* Kp, const bf16_t* Vp, int ldkv, int nkeys, int koff, const float* bias_h, bf16_t* Op, int ldo, int tid) {
    const int qi = tid >> 2, part = tid & 3;
    float q[32], o[32];
    { const u32x4* qp = (const u32x4*)(Qp + (size_t)qi * ldq + part * 32);
#pragma unroll
      for (int j = 0; j < 4; ++j) unpack8(qp[j], q + 8 * j); }
#pragma unroll
    for (int d = 0; d < 32; ++d) o[d] = 0.f;
    float m = -1e30f, l = 0.f;
    for (int kk0 = 0; kk0 < nkeys; kk0 += 8) {
        float s[8];
#pragma unroll
        for (int j = 0; j < 8; ++j) {
            const u32x4* kp = (const u32x4*)(Kp + (size_t)(kk0 + j) * ldkv + part * 32);
            float acc = 0.f;
#pragma unroll
            for (int w = 0; w < 4; ++w) { float kf[8]; unpack8(kp[w], kf);
#pragma unroll
                for (int e = 0; e < 8; ++e) acc = fmaf(q[8 * w + e], kf[e], acc); }
            acc += __shfl_xor(acc, 1); acc += __shfl_xor(acc, 2);
            if (bias_h) { int dist = qi + koff - (kk0 + j); dist = dist < -128 ? -128 : (dist > 128 ? 128 : dist); acc += bias_h[dist + 128]; }
            s[j] = acc;
        }
        float mx = s[0];
#pragma unroll
        for (int j = 1; j < 8; ++j) mx = fmaxf(mx, s[j]);
        const float mn = fmaxf(m, mx), corr = __expf(m - mn);
        l *= corr;
#pragma unroll
        for (int d = 0; d < 32; ++d) o[d] *= corr;
#pragma unroll
        for (int j = 0; j < 8; ++j) {
            const float pj = __expf(s[j] - mn); l += pj;
            const u32x4* vp = (const u32x4*)(Vp + (size_t)(kk0 + j) * ldkv + part * 32);
#pragma unroll
            for (int w = 0; w < 4; ++w) { float vf[8]; unpack8(vp[w], vf);
#pragma unroll
                for (int e = 0; e < 8; ++e) o[8 * w + e] = fmaf(pj, vf[e], o[8 * w + e]); }
        }
        m = mn;
    }
    const float inv = 1.f / l;
    u32x4* op = (u32x4*)(Op + (size_t)qi * ldo + part * 32);
#pragma unroll
    for (int w = 0; w < 4; ++w) { u32x4 ov; ov.x = pk2(o[8 * w] * inv, o[8 * w + 1] * inv); ov.y = pk2(o[8 * w + 2] * inv, o[8 * w + 3] * inv); ov.z = pk2(o[8 * w + 4] * inv, o[8 * w + 5] * inv); ov.w = pk2(o[8 * w + 6] * inv, o[8 * w + 7] * inv); op[w] = ov; }
}

__device__ __forceinline__ void gemm_branch(const bf16_t* __restrict__ Ob, const bf16_t* __restrict__ WT, const bf16_t* __restrict__ G, bf16_t* __restrict__ Mg, int gw, int NW, int lane) {
    const int r = lane & 15, q = lane >> 4;
    const int ntn = D / 32, ntiles = (T / 32) * ntn;
    for (int tile = gw; tile < ntiles; tile += NW) {
        const int tm = tile / ntn, tn = tile % ntn;
        f32x4 acc[3][2][2];
#pragma unroll
        for (int s = 0; s < 3; ++s)
#pragma unroll
            for (int i = 0; i < 2; ++i)
#pragma unroll
                for (int j = 0; j < 2; ++j) acc[s][i][j] = (f32x4){0.f, 0.f, 0.f, 0.f};
        const bf16_t* ap = Ob + (size_t)(tm * 32 + r) * D + q * 8;
        const bf16_t* bp = WT + (size_t)(tn * 32 + r) * D + q * 8;
#pragma unroll
        for (int s = 0; s < 3; ++s) {
            const int kb = s == 0 ? 0 : (s == 1 ? 1024 : 1536), ke = s == 0 ? 1024 : (s == 1 ? 1536 : 2048);
            for (int k0 = kb; k0 < ke; k0 += 32) {
                bf16x8 af[2], bfr[2];
#pragma unroll
                for (int i = 0; i < 2; ++i) af[i] = *(const bf16x8*)(ap + (size_t)i * 16 * D + k0);
#pragma unroll
                for (int j = 0; j < 2; ++j) bfr[j] = *(const bf16x8*)(bp + (size_t)j * 16 * D + k0);
#pragma unroll
                for (int i = 0; i < 2; ++i)
#pragma unroll
                    for (int j = 0; j < 2; ++j) acc[s][i][j] = __builtin_amdgcn_mfma_f32_16x16x32_bf16(af[i], bfr[j], acc[s][i][j], 0, 0, 0);
            }
        }
#pragma unroll
        for (int i = 0; i < 2; ++i)
#pragma unroll
            for (int j = 0; j < 2; ++j)
#pragma unroll
                for (int e = 0; e < 4; ++e) {
                    const int row = tm * 32 + i * 16 + q * 4 + e, col = tn * 32 + j * 16 + r;
                    const bf16_t* gp = G + (size_t)row * GW + col;
                    const float mval = bf2f(gp[0]) * acc[0][i][j][e] + bf2f(gp[2048]) * acc[1][i][j][e] + bf2f(gp[4096]) * acc[2][i][j][e];
                    Mg[(size_t)row * D + col] = (bf16_t)f2bf(mval);
                }
    }
}

__device__ __forceinline__ unsigned long long shfl_xor64(unsigned long long v, int m) {
    const unsigned lo = __shfl_xor((unsigned)v, m), hi = __shfl_xor((unsigned)(v >> 32), m);
    return ((unsigned long long)hi << 32) | lo;
}
__device__ __forceinline__ unsigned fkey(float f) { const unsigned u = __float_as_uint(f); return (u & 0x80000000u) ? ~u : (u | 0x80000000u); }
__device__ __forceinline__ float fkey_inv(unsigned k) { const unsigned u = (k & 0x80000000u) ? (k & 0x7fffffffu) : ~k; return __uint_as_float(u); }
__device__ __forceinline__ unsigned long long wave_max64(unsigned long long k) {
#pragma unroll
    for (int o = 1; o < 64; o <<= 1) { const unsigned long long t = shfl_xor64(k, o); k = t > k ? t : k; }
    return k;
}
__device__ __forceinline__ void route_unit(const Params& p, int t, int h, int lane) {
    const bf16_t* Q = (const bf16_t*)(p.ws + WS_Q); const bf16_t* KB = (const bf16_t*)(p.ws + WS_KEYSB);
    int* RIDX = (int*)(p.ws + WS_RIDX); float* RG = (float*)(p.ws + WS_RG);
    float sv_l[2] = {0.f, 0.f}; int si_l[2] = {0, 0};
#pragma unroll
    for (int c = 0; c < 2; ++c) {
        const bf16_t* qv = Q + (size_t)t * D + h * 256 + c * 128;
        const unsigned qw = ((const unsigned*)qv)[lane];
        const float qa = bf2f(qw & 0xffffu), qb = bf2f(qw >> 16);
        const bf16_t* k0p = KB + ((size_t)(h * 2 + c) * NKEYS + lane) * 128;
        const bf16_t* k1p = k0p + 64 * 128;
        float s0 = 0.f, s1 = 0.f;
#pragma unroll
        for (int w = 0; w < 16; ++w) {
            float k0f[8], k1f[8]; unpack8(((const u32x4*)k0p)[w], k0f); unpack8(((const u32x4*)k1p)[w], k1f);
#pragma unroll
            for (int e = 0; e < 8; e += 2) {
                const int src = 4 * w + e / 2;
                const float xa = __int_as_float(__builtin_amdgcn_readlane(__float_as_int(qa), src));
                const float xb = __int_as_float(__builtin_amdgcn_readlane(__float_as_int(qb), src));
                s0 = fmaf(xa, k0f[e], s0); s0 = fmaf(xb, k0f[e + 1], s0);
                s1 = fmaf(xa, k1f[e], s1); s1 = fmaf(xb, k1f[e + 1], s1);
            }
        }
        unsigned long long ka = ((unsigned long long)fkey(s0) << 32) | (unsigned)(255 - lane);
        unsigned long long kb = ((unsigned long long)fkey(s1) << 32) | (unsigned)(255 - (lane + 64));
        for (int rnd = 0; rnd < TOPK; ++rnd) {
            const unsigned long long best = wave_max64(ka > kb ? ka : kb);
            if (ka == best) ka = 0ull; if (kb == best) kb = 0ull;
            if (lane == rnd) { sv_l[c] = fkey_inv((unsigned)(best >> 32)); si_l[c] = 255 - (int)(best & 0xffffffffu); }
        }
    }
    unsigned long long kc[4];
#pragma unroll
    for (int m = 0; m < 4; ++m) { const int cid = lane + 64 * m, i = cid >> 4, j = cid & 15;
        const float v = __shfl(sv_l[0], i) + __shfl(sv_l[1], j);
        kc[m] = ((unsigned long long)fkey(v) << 32) | (unsigned)(1023 - cid); }
    float fv = 0.f; int cidx = 0;
    for (int rnd = 0; rnd < TOPK; ++rnd) {
        unsigned long long loc = kc[0] > kc[1] ? kc[0] : kc[1]; const unsigned long long loc2 = kc[2] > kc[3] ? kc[2] : kc[3]; loc = loc > loc2 ? loc : loc2;
        const unsigned long long best = wave_max64(loc);
#pragma unroll
        for (int m = 0; m < 4; ++m) if (kc[m] == best) kc[m] = 0ull;
        if (lane == rnd) { fv = fkey_inv((unsigned)(best >> 32)); cidx = 1023 - (int)(best & 0xffffffffu); }
    }
    const float fmax_ = __shfl(fv, 0);
    float e = lane < 16 ? __expf(fv - fmax_) : 0.f;
    float ssum = e;
#pragma unroll
    for (int o = 1; o < 16; o <<= 1) ssum += __shfl_xor(ssum, o);
    const int ci = cidx >> 4, cj = cidx & 15;
    const int e0 = __shfl(si_l[0], ci), e1 = __shfl(si_l[1], cj);
    if (lane < 16) { RIDX[(size_t)t * 128 + h * 16 + lane] = e0 * NKEYS + e1; RG[(size_t)t * 128 + h * 16 + lane] = e / ssum; }
}

typedef float f32x2 __attribute__((ext_vector_type(2)));
__device__ __forceinline__ void fp8_row(const float* __restrict__ src, const float* __restrict__ kscale, unsigned char* __restrict__ dst, float* __restrict__ scale_out, int lane) {
    f32x4 v[8]; float mx = 0.f;
#pragma unroll
    for (int j = 0; j < 8; ++j) { v[j] = ((const f32x4*)src)[64 * j + lane];
        if (kscale) v[j] = v[j] * ((const f32x4*)kscale)[64 * j + lane];
        mx = fmaxf(mx, fmaxf(fmaxf(fabsf(v[j].x), fabsf(v[j].y)), fmaxf(fabsf(v[j].z), fabsf(v[j].w)))); }
#pragma unroll
    for (int o = 1; o < 64; o <<= 1) mx = fmaxf(mx, __shfl_xor(mx, o));
    const float sc = mx > 0.f ? mx * (1.f / 448.f) : 1.f, inv = 1.f / sc;
#pragma unroll
    for (int j = 0; j < 8; ++j) {
        const f32x4 q = v[j] * inv;
        int w = __builtin_amdgcn_cvt_pk_fp8_f32(fminf(fmaxf(q.x, -448.f), 448.f), fminf(fmaxf(q.y, -448.f), 448.f), 0, false);
        w = __builtin_amdgcn_cvt_pk_fp8_f32(fminf(fmaxf(q.z, -448.f), 448.f), fminf(fmaxf(q.w, -448.f), 448.f), w, true);
        ((unsigned*)dst)[64 * j + lane] = (unsigned)w;
    }
    if (lane == 0) *scale_out = sc;
}
struct RowB { u32x4 w[2]; };
__device__ __forceinline__ void peer_load_batch(RowB (&buf)[4], const unsigned char* tab, int isel, int pbase, int lane) {
#pragma unroll
    for (int r = 0; r < 4; ++r) { const int e = __shfl(isel, (pbase + r) & 63); const unsigned char* rp = tab + (size_t)e * 2048 + lane * 16;
        buf[r].w[0] = *(const u32x4*)rp; buf[r].w[1] = *(const u32x4*)(rp + 1024); }
}
__device__ __forceinline__ void cvt16(const u32x4 w, float* f) {
#pragma unroll
    for (int q = 0; q < 4; ++q) { const f32x2 lo = __builtin_amdgcn_cvt_pk_f32_fp8((int)w[q], false), hi = __builtin_amdgcn_cvt_pk_f32_fp8((int)w[q], true);
        f[4 * q] = lo.x; f[4 * q + 1] = lo.y; f[4 * q + 2] = hi.x; f[4 * q + 3] = hi.y; }
}
__device__ __forceinline__ void peer_token(const Params& p, int t, int lane, LAS float* actL) {
    const bf16_t* XB = (const bf16_t*)(p.ws + WS_X2BF); const unsigned char* TU = p.ws + WS_TABU; const unsigned char* TV = p.ws + WS_TABV;
    const float* SCU = (const float*)(p.ws + WS_SCU); const float* SCV = (const float*)(p.ws + WS_SCV);
    const int* RIDX = (const int*)(p.ws + WS_RIDX); const float* RG = (const float*)(p.ws + WS_RG); const float* SS2 = (const float*)(p.ws + WS_CTL + CTL_SS2_BYTE);
    float xf[2][16];
#pragma unroll
    for (int j = 0; j < 2; ++j) { const bf16_t* xp = XB + (size_t)t * D + j * 1024 + lane * 16; unpack8(*(const u32x4*)xp, xf[j]); unpack8(*(const u32x4*)(xp + 8), xf[j] + 8); }
    const float rs = rsqrtf(SS2[t] * (1.f / D) + EPS);
    const int i0 = RIDX[(size_t)t * 128 + lane], i1 = RIDX[(size_t)t * 128 + 64 + lane];
    const float su0 = SCU[i0] * rs, su1 = SCU[i1] * rs;
    const float gv0 = RG[(size_t)t * 128 + lane] * SCV[i0], gv1 = RG[(size_t)t * 128 + 64 + lane] * SCV[i1];
    RowB A[4], B[4];
    const int rl = 2 * ((lane >> 5) & 1) + ((lane >> 4) & 1);
#define PEER_DOT(buf, pb) do { float d[4]; \
        _Pragma("unroll") for (int r = 0; r < 4; ++r) { float f0[16], f1[16]; cvt16(buf[r].w[0], f0); cvt16(buf[r].w[1], f1); float a0 = 0.f, a1 = 0.f; \
            _Pragma("unroll") for (int q = 0; q < 16; ++q) { a0 = fmaf(f0[q], xf[0][q], a0); a1 = fmaf(f1[q], xf[1][q], a1); } d[r] = a0 + a1; } \
        const bool up = (lane & 32) != 0; \
        const float k0 = (up ? d[2] : d[0]) + __shfl_xor(up ? d[0] : d[2], 32), k1 = (up ? d[3] : d[1]) + __shfl_xor(up ? d[1] : d[3], 32); \
        const bool u2 = (lane & 16) != 0; \
        float v = (u2 ? k1 : k0) + __shfl_xor(u2 ? k0 : k1, 16); \
        v += __shfl_xor(v, 8); v += __shfl_xor(v, 4); v += __shfl_xor(v, 2); v += __shfl_xor(v, 1); \
        const int pi = (pb) + rl; const float su = __shfl(pi < 64 ? su0 : su1, pi & 63), gv = __shfl(pi < 64 ? gv0 : gv1, pi & 63); \
        if ((lane & 15) == 0) actL[pi] = gelu_tanh(v * su) * gv; } while (0)
    peer_load_batch(A, TU, i0, 0, lane);
    for (int b = 0; b < 32; b += 2) {
        peer_load_batch(B, TU, b < 16 ? i0 : i1, 4 * (b + 1), lane);
        PEER_DOT(A, 4 * b);
        if (b + 2 < 32) peer_load_batch(A, TU, (b + 2) < 16 ? i0 : i1, 4 * (b + 2), lane);
        PEER_DOT(B, 4 * (b + 1));
    }
#undef PEER_DOT
    float of[2][16];
#pragma unroll
    for (int j = 0; j < 2; ++j)
#pragma unroll
        for (int q = 0; q < 16; ++q) of[j][q] = 0.f;
#define PEER_AXPY(buf, pb) do { \
        _Pragma("unroll") for (int r = 0; r < 4; ++r) { const float a = actL[(pb) + r]; float f0[16], f1[16]; cvt16(buf[r].w[0], f0); cvt16(buf[r].w[1], f1); \
            _Pragma("unroll") for (int q = 0; q < 16; ++q) { of[0][q] = fmaf(a, f0[q], of[0][q]); of[1][q] = fmaf(a, f1[q], of[1][q]); } } } while (0)
    peer_load_batch(A, TV, i0, 0, lane);
    for (int b = 0; b < 32; b += 2) {
        peer_load_batch(B, TV, b < 16 ? i0 : i1, 4 * (b + 1), lane);
        PEER_AXPY(A, 4 * b);
        if (b + 2 < 32) peer_load_batch(A, TV, (b + 2) < 16 ? i0 : i1, 4 * (b + 2), lane);
        PEER_AXPY(B, 4 * (b + 1));
    }
#undef PEER_AXPY
    float* orow = p.out + (size_t)t * D;
#pragma unroll
    for (int j = 0; j < 2; ++j)
#pragma unroll
        for (int q = 0; q < 4; ++q) { f32x4* o4 = (f32x4*)(orow + j * 1024 + lane * 16 + 4 * q); f32x4 a = *o4;
            a.x += of[j][4 * q]; a.y += of[j][4 * q + 1]; a.z += of[j][4 * q + 2]; a.w += of[j][4 * q + 3]; *o4 = a; }
}

namespace pg8 {
#define PG8_LAS __attribute__((address_space(3)))
constexpr int BM = 256, BK = 64, HALF = 128, HTB = HALF * BK * 2, STAGE_BYTES = 8 * HTB, NXCD = 8, WGM = 8;
__host__ __device__ __forceinline__ int lds_byte(int r, int c) { const int st = (r >> 4) * 2 + (c >> 5), rr = r & 15, cc = c & 31, ob = rr * 64 + cc * 2; return st * 1024 + (ob ^ (((ob >> 9) & 1) << 5)); }
__host__ __device__ __forceinline__ void stage_rc(int b, int& R, int& C) { const int st = b / 1024, sb = b % 1024, swz = sb ^ (((sb >> 9) & 1) << 5); R = (st >> 1) * 16 + swz / 64; C = (st & 1) * 32 + (swz % 64) / 2; }
__host__ __device__ __forceinline__ int perm32(int rho) { const int n = rho >> 4, i = rho & 15; return 8 * (i >> 2) + 4 * n + (i & 3); }
struct Unit { const char* A; const char* B; int pm, pn, kind, nt; };
__device__ __forceinline__ const char* uni_ptr(const char* p) { const unsigned long long v = (unsigned long long)p; const unsigned lo = __builtin_amdgcn_readfirstlane((unsigned)v), hi = __builtin_amdgcn_readfirstlane((unsigned)(v >> 32)); return (const char*)(((unsigned long long)hi << 32) | lo); }
__device__ __forceinline__ void uni(Unit& u) { u.A = uni_ptr(u.A); u.B = uni_ptr(u.B); u.pm = __builtin_amdgcn_readfirstlane(u.pm); u.pn = __builtin_amdgcn_readfirstlane(u.pn); u.kind = __builtin_amdgcn_readfirstlane(u.kind); u.nt = __builtin_amdgcn_readfirstlane(u.nt); }
__device__ __forceinline__ void tile_of(int L, int nM, int nN, int& pm, int& pn) {
    const int nwg = nM * nN; int wgid = L; { const int q = nwg / NXCD, r = nwg % NXCD, xcd = wgid % NXCD, off = wgid / NXCD; wgid = (xcd < r ? xcd * (q + 1) : r * (q + 1) + (xcd - r) * q) + off; }
    const int nig = WGM * nN, gid = wgid / nig, fm = gid * WGM, gsz = (nM - fm) < WGM ? (nM - fm) : WGM;
    pm = fm + ((wgid % nig) % gsz); pn = (wgid % nig) / gsz;
}
template <class Epi, class Sched>
__device__ __forceinline__ void gemm_phase(PG8_LAS unsigned char* lds, const int lda, const int ldb, const Sched& S, const Epi& E) {
    const int tid = threadIdx.x, wid = __builtin_amdgcn_readfirstlane(tid >> 6), lane = tid & 63, wr = wid >> 2, wc = wid & 3, fr = lane & 15, fq = lane >> 4;
    unsigned voffA[2], voffB[2];
#pragma unroll
    for (int i = 0; i < 2; ++i) { int R, C; stage_rc(tid * 16 + i * 8192, R, C); const int Rb = (R & ~31) + perm32(R & 31);
        voffA[i] = (unsigned)(R * lda + C) * 2u; voffB[i] = (unsigned)(Rb * ldb + C) * 2u; }
    const size_t kstep = (size_t)(BK * 2);
    const size_t hstepA = (size_t)HALF * lda * 2, hstepB = (size_t)HALF * ldb * 2;
    const unsigned ldsw = (unsigned)wid * 1024u;
    const int aoff = lds_byte(wr * 64 + fr, fq * 8), boff = lds_byte(wc * 32 + fr, fq * 8);
#define PG8_SA(b, h) (((b) * 2 + (h)) * HTB)
#define PG8_SB(b, h) ((4 + (b) * 2 + (h)) * HTB)
#define PG8_STAGE(bufoff, gbase, voff) do { _Pragma("unroll") for (int _i = 0; _i < 2; ++_i) \
        __builtin_amdgcn_global_load_lds((const unsigned*)((const char*)(gbase) + (voff)[_i]), (PG8_LAS unsigned*)(lds + (bufoff) + ldsw + _i * 8192), 16, 0, 0); } while (0)
#define PG8_LDA(dst, b, h) do { _Pragma("unroll") for (int m = 0; m < 4; ++m) _Pragma("unroll") for (int k = 0; k < 2; ++k) dst[m][k] = *(const PG8_LAS bf16x8*)(lds + PG8_SA(b, h) + aoff + m * 2048 + k * 1024); } while (0)
#define PG8_LDB(dst, b, h) do { _Pragma("unroll") for (int n = 0; n < 2; ++n) _Pragma("unroll") for (int k = 0; k < 2; ++k) dst[n][k] = *(const PG8_LAS bf16x8*)(lds + PG8_SB(b, h) + boff + n * 2048 + k * 1024); } while (0)
#define PG8_MMA(ai, bj, At, Bt) do { __builtin_amdgcn_s_setprio(1); _Pragma("unroll") for (int m = 0; m < 4; ++m) _Pragma("unroll") for (int n = 0; n < 2; ++n) _Pragma("unroll") for (int k = 0; k < 2; ++k) \
        acc[ai][bj][m][n] = __builtin_amdgcn_mfma_f32_16x16x32_bf16(Bt[n][k], At[m][k], acc[ai][bj][m][n], 0, 0, 0); __builtin_amdgcn_s_setprio(0); } while (0)
#define PG8_WAIT_V(n) asm volatile("s_waitcnt vmcnt(" #n ")" ::: "memory")
#define PG8_WAIT_L(n) asm volatile("s_waitcnt lgkmcnt(" #n ")" ::: "memory")
#define PG8_BAR __builtin_amdgcn_s_barrier()
#define PG8_SCHED __builtin_amdgcn_sched_barrier(0)
    Unit cur, nxt; int ui = 0;
    if (!S.next(0, cur)) return;
    f32x4 acc[2][2][4][2];
#pragma unroll
    for (int a = 0; a < 2; ++a)
#pragma unroll
        for (int b = 0; b < 2; ++b)
#pragma unroll
            for (int m = 0; m < 4; ++m)
#pragma unroll
                for (int n = 0; n < 2; ++n) acc[a][b][m][n] = (f32x4){0.f, 0.f, 0.f, 0.f};
    bf16x8 At[4][2], B0[2][2], B1[2][2];
    const char* cA = cur.A; const char* cB = cur.B;
    PG8_STAGE(PG8_SB(0, 0), cB, voffB); PG8_STAGE(PG8_SB(0, 1), cB + hstepB, voffB); PG8_STAGE(PG8_SA(0, 0), cA, voffA); PG8_STAGE(PG8_SA(0, 1), cA + hstepA, voffA);
    if (wr == 1) PG8_BAR;
    PG8_WAIT_V(2); PG8_BAR;
    PG8_STAGE(PG8_SB(1, 0), cB + kstep, voffB); PG8_STAGE(PG8_SA(1, 0), cA + kstep, voffA); PG8_STAGE(PG8_SB(1, 1), cB + hstepB + kstep, voffB);
    PG8_WAIT_V(6); PG8_BAR;
    for (;;) {
        const bool has_next = S.next(ui + 1, nxt);
        const char* nA = has_next ? nxt.A : cA; const char* nB = has_next ? nxt.B : cB;
        const int nt = cur.nt;
        for (int t = 0; t < nt; t += 2) {
            const bool last = (t == nt - 2);
            const char* a1 = cA + (size_t)(t + 1) * kstep;
            const char* a2 = last ? nA : cA + (size_t)(t + 2) * kstep; const char* b2 = last ? nB : cB + (size_t)(t + 2) * kstep;
            const char* a3 = a2 + kstep; const char* b3 = b2 + kstep;
            PG8_LDB(B0, 0, 0); PG8_LDB(B1, 0, 1); PG8_SCHED; PG8_LDA(At, 0, 0); PG8_STAGE(PG8_SA(1, 1), a1 + hstepA, voffA);
            PG8_WAIT_V(8); PG8_WAIT_L(0); PG8_BAR; PG8_MMA(0, 0, At, B0); PG8_MMA(0, 1, At, B1); PG8_BAR; PG8_SCHED;
            PG8_LDA(At, 0, 1); PG8_STAGE(PG8_SB(0, 0), b2, voffB); PG8_STAGE(PG8_SB(0, 1), b2 + hstepB, voffB); PG8_STAGE(PG8_SA(0, 0), a2, voffA);
            PG8_WAIT_V(8); PG8_WAIT_L(0); PG8_BAR; PG8_MMA(1, 0, At, B0); PG8_MMA(1, 1, At, B1); PG8_BAR; PG8_SCHED;
            PG8_LDB(B0, 1, 0); PG8_LDB(B1, 1, 1); PG8_SCHED; PG8_LDA(At, 1, 0); PG8_STAGE(PG8_SA(0, 1), a2 + hstepA, voffA);
            PG8_WAIT_V(8); PG8_WAIT_L(0); PG8_BAR; PG8_MMA(0, 0, At, B0); PG8_MMA(0, 1, At, B1); PG8_BAR; PG8_SCHED;
            PG8_LDA(At, 1, 1); PG8_STAGE(PG8_SB(1, 0), b3, voffB); PG8_STAGE(PG8_SB(1, 1), b3 + hstepB, voffB); PG8_STAGE(PG8_SA(1, 0), a3, voffA);
            PG8_WAIT_V(8); PG8_WAIT_L(0); PG8_BAR; PG8_MMA(1, 0, At, B0); PG8_MMA(1, 1, At, B1); PG8_BAR; PG8_SCHED;
        }
        if (wr == 0) PG8_BAR;
        E(acc, cur, wr, wc, fr, fq);
        if (!has_next) break;
#pragma unroll
        for (int a = 0; a < 2; ++a)
#pragma unroll
            for (int b = 0; b < 2; ++b)
#pragma unroll
                for (int m = 0; m < 4; ++m)
#pragma unroll
                    for (int n = 0; n < 2; ++n) acc[a][b][m][n] = (f32x4){0.f, 0.f, 0.f, 0.f};
        cur = nxt; cA = nA; cB = nB; ++ui;
        if (wr == 1) PG8_BAR;
    }
    PG8_WAIT_V(0);
    PG8_BAR;
#undef PG8_SA
#undef PG8_SB
#undef PG8_STAGE
#undef PG8_LDA
#undef PG8_LDB
#undef PG8_MMA
#undef PG8_WAIT_V
#undef PG8_WAIT_L
#undef PG8_BAR
#undef PG8_SCHED
}
}
typedef f32x4 AccT[2][2][4][2];
__device__ __forceinline__ unsigned cvt_pk_bf16(float lo, float hi) { unsigned r; asm volatile("v_cvt_pk_bf16_f32 %0, %1, %2" : "=v"(r) : "v"(lo), "v"(hi)); return r; }
__device__ __forceinline__ u32x4 pack8(const f32x4 v0, const f32x4 v1) { u32x4 w; w.x = cvt_pk_bf16(v0[0], v0[1]); w.y = cvt_pk_bf16(v0[2], v0[3]); w.z = cvt_pk_bf16(v1[0], v1[1]); w.w = cvt_pk_bf16(v1[2], v1[3]); return w; }
template <int MODE>
__device__ __forceinline__ void store_tile_bf16(const AccT& acc, bf16_t* base, int ldc, int row0, int col0, const float* bias) {
    f32x4 bv[2][2];
#pragma unroll
    for (int bj = 0; bj < 2; ++bj)
#pragma unroll
        for (int n = 0; n < 2; ++n) bv[bj][n] = (MODE == 2) ? *(const f32x4*)(bias + col0 + bj * 128 + 4 * n) : (f32x4){0.f, 0.f, 0.f, 0.f};
#pragma unroll
    for (int ai = 0; ai < 2; ++ai)
#pragma unroll
        for (int m = 0; m < 4; ++m) { bf16_t* rowp = base + (size_t)(row0 + ai * 128 + m * 16) * ldc + col0;
#pragma unroll
            for (int bj = 0; bj < 2; ++bj) { f32x4 v0 = acc[ai][bj][m][0], v1 = acc[ai][bj][m][1];
                if (MODE == 1) { _Pragma("unroll") for (int e = 0; e < 4; ++e) { v0[e] = gelu_tanh(v0[e]); v1[e] = gelu_tanh(v1[e]); } }
                if (MODE == 2) { v0 = v0 + bv[bj][0]; v1 = v1 + bv[bj][1]; _Pragma("unroll") for (int e = 0; e < 4; ++e) { v0[e] = sigmoid_(v0[e]); v1[e] = sigmoid_(v1[e]); } }
                *(u32x4*)(rowp + bj * 128) = pack8(v0, v1); } }
}
struct SchedP1 { const char* H; const char* WT; const char* MEMN; const char* WTM; int G, c;
    __device__ __forceinline__ bool next(int i, pg8::Unit& u) const {
        const int L = i * G + c; const int n1 = 64 * 42;
        if (L < n1) { pg8::tile_of(L, 64, 42, u.pm, u.pn); u.kind = 0; u.A = H + (size_t)u.pm * 256 * D * 2; u.B = WT + (size_t)u.pn * 256 * D * 2; u.nt = D / 64; pg8::uni(u); return true; }
        if (L < n1 + 8) { const int j = L - n1; u.pm = j >> 2; u.pn = j & 3; u.kind = 1; u.A = MEMN + (size_t)u.pm * 256 * D * 2; u.B = WTM + (size_t)u.pn * 256 * D * 2; u.nt = D / 64; pg8::uni(u); return true; }
        return false; } };
struct EpiP1 { bf16_t* PROJ; bf16_t* G; bf16_t* MEMKV; const float* bgate;
    __device__ __forceinline__ void operator()(const AccT& acc, const pg8::Unit& u, int wr, int wc, int fr, int fq) const {
        const int row0 = u.pm * 256 + wr * 64 + fr, cl = wc * 32 + 8 * fq;
        if (u.kind == 1) { store_tile_bf16<0>(acc, MEMKV, 2 * CW, row0, u.pn * 256 + cl, nullptr); return; }
        if (u.pn >= 18) { store_tile_bf16<2>(acc, G, GW, row0, (u.pn - 18) * 256 + cl, bgate); return; }
        if (u.pn == 14 || u.pn == 15) { store_tile_bf16<1>(acc, PROJ, INW, row0, u.pn * 256 + cl, nullptr); return; }
        store_tile_bf16<0>(acc, PROJ, INW, row0, u.pn * 256 + cl, nullptr);
    } };
struct SchedP3 { const char* O; const char* WT; int G, c;
    __device__ __forceinline__ bool next(int i, pg8::Unit& u) const {
        const int ti = i / 3, seg = i - 3 * ti; const int L = ti * G + c; if (L >= 64 * 8) return false;
        pg8::tile_of(L, 64, 8, u.pm, u.pn); u.kind = seg;
        const int kb = seg == 0 ? 0 : (seg == 1 ? 1024 : 1536);
        u.A = O + ((size_t)u.pm * 256 * D + kb) * 2; u.B = WT + ((size_t)u.pn * 256 * D + kb) * 2; u.nt = seg == 0 ? 16 : 8; pg8::uni(u); return true; } };
struct EpiP3 { const bf16_t* G; float* slab; bf16_t* MERGED;
    __device__ __forceinline__ void operator()(const AccT& acc, const pg8::Unit& u, int wr, int wc, int fr, int fq) const {
        const int row0 = u.pm * 256 + wr * 64 + fr, col0 = u.pn * 256 + wc * 32 + 8 * fq, seg = u.kind;
        f32x4* sl = (f32x4*)slab + threadIdx.x;
#pragma unroll
        for (int ai = 0; ai < 2; ++ai)
#pragma unroll
            for (int m = 0; m < 4; ++m)
#pragma unroll
                for (int bj = 0; bj < 2; ++bj) {
                    const size_t row = (size_t)(row0 + ai * 128 + m * 16); const int col = col0 + bj * 128;
                    float gf[8]; unpack8(*(const u32x4*)(G + row * GW + seg * D + col), gf);
                    f32x4 v0 = acc[ai][bj][m][0], v1 = acc[ai][bj][m][1];
                    v0[0] *= gf[0]; v0[1] *= gf[1]; v0[2] *= gf[2]; v0[3] *= gf[3]; v1[0] *= gf[4]; v1[1] *= gf[5]; v1[2] *= gf[6]; v1[3] *= gf[7];
                    if (seg > 0) { v0 = v0 + sl[0]; v1 = v1 + sl[512]; }
                    if (seg < 2) { sl[0] = v0; sl[512] = v1; }
                    else *(u32x4*)(MERGED + row * D + col) = pack8(v0, v1);
                    sl += 1024; asm volatile("" : "+v"(sl) :: "memory");
                }
    } };
struct SchedSq { const char* A; const char* WT; int G, c;
    __device__ __forceinline__ bool next(int i, pg8::Unit& u) const {
        const int L = i * G + c; if (L >= 64 * 8) return false;
        pg8::tile_of(L, 64, 8, u.pm, u.pn); u.kind = 0; u.A = A + (size_t)u.pm * 256 * D * 2; u.B = WT + (size_t)u.pn * 256 * D * 2; u.nt = D / 64; pg8::uni(u); return true; } };
struct EpiP4 { const float* x; float* out; bf16_t* xb; float* ss;
    __device__ __forceinline__ void operator()(const AccT& acc, const pg8::Unit& u, int wr, int wc, int fr, int fq) const {
        const int row0 = u.pm * 256 + wr * 64 + fr, col0 = u.pn * 256 + wc * 32 + 8 * fq;
#pragma unroll
        for (int ai = 0; ai < 2; ++ai)
#pragma unroll
            for (int m = 0; m < 4; ++m) { const size_t row = (size_t)(row0 + ai * 128 + m * 16); float sq = 0.f;
#pragma unroll
                for (int bj = 0; bj < 2; ++bj) { const size_t o = row * D + col0 + bj * 128;
                    const f32x4 v0 = acc[ai][bj][m][0] + *(const f32x4*)(x + o), v1 = acc[ai][bj][m][1] + *(const f32x4*)(x + o + 4);
                    *(f32x4*)(out + o) = v0; *(f32x4*)(out + o + 4) = v1; *(u32x4*)(xb + o) = pack8(v0, v1);
                    sq += (v0[0] * v0[0] + v0[1] * v0[1]) + (v0[2] * v0[2] + v0[3] * v0[3]) + (v1[0] * v1[0] + v1[1] * v1[1]) + (v1[2] * v1[2] + v1[3] * v1[3]); }
                sq += __shfl_xor(sq, 16); sq += __shfl_xor(sq, 32);
                if (fq == 0) atomicAdd(ss + row, sq); }
    } };
struct EpiP5 { bf16_t* Q; const float* ss;
    __device__ __forceinline__ void operator()(const AccT& acc, const pg8::Unit& u, int wr, int wc, int fr, int fq) const {
        const int row0 = u.pm * 256 + wr * 64 + fr, col0 = u.pn * 256 + wc * 32 + 8 * fq;
#pragma unroll
        for (int ai = 0; ai < 2; ++ai)
#pragma unroll
            for (int m = 0; m < 4; ++m) { const size_t row = (size_t)(row0 + ai * 128 + m * 16); const float rs = rsqrtf(ss[row] * (1.f / D) + EPS);
#pragma unroll
                for (int bj = 0; bj < 2; ++bj) *(u32x4*)(Q + row * D + col0 + bj * 128) = pack8(acc[ai][bj][m][0] * rs, acc[ai][bj][m][1] * rs); }
    } };


namespace att {
using s16x4  = __attribute__((ext_vector_type(4))) short;
using f32x16 = __attribute__((ext_vector_type(16))) float;
constexpr int NWV = 8, QBLK = 32, KVBLK = 64, DH = 128;
constexpr float THR = 8.f;
constexpr int SHM_V = KVBLK * DH * 2, SHM_K = KVBLK * DH * 2;
constexpr int OFF_WS = 2 * SHM_V + 2 * SHM_K, OFF_BT = OFF_WS + NWV * 64 * 4, OFF_OST = OFF_BT + 1536, LDS_NEED = OFF_OST + NWV * 8192;
#define KSWZ(row, colB) ((row) * 256 + ((colB) ^ (((row) & 7) << 4)))
#define SBAR() __builtin_amdgcn_sched_barrier(0)
__device__ __forceinline__ int crow(int r, int hi) { return (r & 3) + 8 * (r >> 2) + 4 * hi; }
__device__ __forceinline__ unsigned cvtpk(float lo, float hi) { unsigned r; asm volatile("v_cvt_pk_bf16_f32 %0, %1, %2" : "=v"(r) : "v"(lo), "v"(hi)); return r; }
__device__ __forceinline__ void partialSM(f32x16& p0, f32x16& p1, float& m_reg, float& mn, float& alpha) {
  constexpr float C = 1.4426950408889634f;
  float pmax = p0[0];
#pragma unroll
  for (int r = 1; r < 16; ++r) pmax = fmaxf(pmax, p0[r]);
#pragma unroll
  for (int r = 0; r < 16; ++r) pmax = fmaxf(pmax, p1[r]);
  { auto rr = __builtin_amdgcn_permlane32_swap(__float_as_uint(pmax), __float_as_uint(pmax), false, false);
    pmax = fmaxf(__uint_as_float(rr[0]), __uint_as_float(rr[1])); }
  if (__builtin_expect(__all(pmax - m_reg <= THR), 1)) { mn = m_reg; alpha = 1.f; }
  else { mn = fmaxf(m_reg, pmax); alpha = __builtin_amdgcn_exp2f((m_reg - mn) * C); m_reg = mn; }
  float mnC = -mn * C;
#pragma unroll
  for (int r = 0; r < 16; ++r) p0[r] = fmaf(p0[r], C, mnC);
#pragma unroll
  for (int r = 0; r < 16; ++r) p1[r] = fmaf(p1[r], C, mnC);
#pragma unroll
  for (int r = 0; r < 16; ++r) p0[r] = __builtin_amdgcn_exp2f(p0[r]);
}
__device__ __forceinline__ void finishSM(f32x16& p0, f32x16& p1, float alpha, float& l_reg, bf16x8& pa0, bf16x8& pa1, bf16x8& pa2, bf16x8& pa3) {
#pragma unroll
  for (int r = 0; r < 16; ++r) p1[r] = __builtin_amdgcn_exp2f(p1[r]);
  float ps = 0;
#pragma unroll
  for (int r = 0; r < 16; ++r) ps += p0[r];
#pragma unroll
  for (int r = 0; r < 16; ++r) ps += p1[r];
  { auto rr = __builtin_amdgcn_permlane32_swap(__float_as_uint(ps), __float_as_uint(ps), false, false);
    ps = __uint_as_float(rr[0]) + __uint_as_float(rr[1]); }
  l_reg = l_reg * alpha + ps;
#define PK4(P, BASE, OUT) do { unsigned a0 = cvtpk(P[BASE + 0], P[BASE + 1]), a1 = cvtpk(P[BASE + 2], P[BASE + 3]);   \
    unsigned b0 = cvtpk(P[BASE + 4], P[BASE + 5]), b1 = cvtpk(P[BASE + 6], P[BASE + 7]);                              \
    auto r0 = __builtin_amdgcn_permlane32_swap(a0, b0, false, false); auto r1 = __builtin_amdgcn_permlane32_swap(a1, b1, false, false); \
    u32x4 w = {r0[0], r1[0], r0[1], r1[1]}; OUT = *reinterpret_cast<bf16x8*>(&w); } while (0)
  PK4(p0, 0, pa0); PK4(p0, 8, pa1); PK4(p1, 0, pa2); PK4(p1, 8, pa3);
#undef PK4
}
template <bool BIAS>
__device__ __forceinline__ void qkt(f32x16& p0, f32x16& p1, const LAS char* Ks, const LAS char* qs, int r32, int hi, const LAS float* bp) {
  if (BIAS) {
#pragma unroll
    for (int r = 0; r < 16; ++r) { p0[r] = bp[(r & 3) + 8 * (r >> 2)]; p1[r] = bp[32 + (r & 3) + 8 * (r >> 2)]; }
  } else { p0 = f32x16{}; p1 = f32x16{}; }
#pragma unroll
  for (int d0 = 0; d0 < 8; ++d0) { int cb = (d0 * 16 + hi * 8) * 2;
    bf16x8 b0 = *reinterpret_cast<const LAS bf16x8*>(Ks + KSWZ(r32, cb));
    bf16x8 b1 = *reinterpret_cast<const LAS bf16x8*>(Ks + KSWZ(32 + r32, cb));
    const bf16x8 qv = *reinterpret_cast<const LAS bf16x8*>(qs + d0 * 1024);
    p0 = __builtin_amdgcn_mfma_f32_32x32x16_bf16(b0, qv, p0, 0, 0, 0);
    p1 = __builtin_amdgcn_mfma_f32_32x32x16_bf16(b1, qv, p1, 0, 0, 0); }
}
__device__ __forceinline__ int v_st(int k, int c) { const int kk = (k & ~0xC) | ((k & 4) << 1) | ((k & 8) >> 1); return ((kk >> 3) * 4 + (c >> 5)) * 512 + ((kk & 7) * 32 + (c & 31)) * 2; }
__device__ __forceinline__ int v_rd_base(int lane) { return ((lane & 3) << 3) | (((lane >> 2) & 3) << 6) | (((lane >> 4) & 1) << 5) | (((lane >> 5) & 1) << 8); }
constexpr int v_rd_off(int d0, int ks, int half) { return d0 * 512 + ks * 4096 + half * 2048; }
template <int OFF> __device__ __forceinline__ s16x4 tr_read(int vb) {
  s16x4 r; asm volatile("ds_read_b64_tr_b16 %0, %1 offset:%2" : "=&v"(r) : "v"(vb), "i"(OFF) : "memory"); return r;
}
template <int D0> __device__ __forceinline__ void pv_one(f32x16& od, int vb, bf16x8 pa0, bf16x8 pa1, bf16x8 pa2, bf16x8 pa3) {
  const s16x4 l0 = tr_read<v_rd_off(D0, 0, 0)>(vb), h0 = tr_read<v_rd_off(D0, 0, 1)>(vb), l1 = tr_read<v_rd_off(D0, 1, 0)>(vb), h1 = tr_read<v_rd_off(D0, 1, 1)>(vb);
  const s16x4 l2 = tr_read<v_rd_off(D0, 2, 0)>(vb), h2 = tr_read<v_rd_off(D0, 2, 1)>(vb), l3 = tr_read<v_rd_off(D0, 3, 0)>(vb), h3 = tr_read<v_rd_off(D0, 3, 1)>(vb);
  asm volatile("s_waitcnt lgkmcnt(0)" ::: "memory"); SBAR();
#define PK(L, H) (bf16x8){L[0], L[1], L[2], L[3], H[0], H[1], H[2], H[3]}
  od = __builtin_amdgcn_mfma_f32_32x32x16_bf16(pa0, PK(l0, h0), od, 0, 0, 0);
  od = __builtin_amdgcn_mfma_f32_32x32x16_bf16(pa1, PK(l1, h1), od, 0, 0, 0);
  od = __builtin_amdgcn_mfma_f32_32x32x16_bf16(pa2, PK(l2, h2), od, 0, 0, 0);
  od = __builtin_amdgcn_mfma_f32_32x32x16_bf16(pa3, PK(l3, h3), od, 0, 0, 0);
#undef PK
}
__device__ __forceinline__ void pv_d0(f32x16* o, int vb, bf16x8 pa0, bf16x8 pa1, bf16x8 pa2, bf16x8 pa3) {
  pv_one<0>(o[0], vb, pa0, pa1, pa2, pa3); pv_one<1>(o[1], vb, pa0, pa1, pa2, pa3); pv_one<2>(o[2], vb, pa0, pa1, pa2, pa3); pv_one<3>(o[3], vb, pa0, pa1, pa2, pa3);
}
template <int LDQ, int LDK, int LDO, bool BAND>
__device__ __forceinline__ void attn_body(const bf16_t* Qb, const bf16_t* Kh, const bf16_t* Vh, bf16_t* Ob,
                                          const int NT, const int kc0, const float* btab_src, LAS char* lds) {
  const int tid = threadIdx.x, wid = __builtin_amdgcn_readfirstlane(tid >> 6), lane = tid & 63, r32 = lane & 31, hi = lane >> 5;
  LAS char* V_lds = lds; LAS char* K_lds = lds + 2 * SHM_V;
  LAS float* wsf = (LAS float*)(lds + OFF_WS) + wid * 64; LAS float* li_l = wsf; LAS float* al_l = wsf + 32;
  LAS float* btab = (LAS float*)(lds + OFF_BT);
  if (BAND) { if (tid < 384) btab[tid] = tid < 64 ? btab_src[256] : (tid < 256 ? btab_src[320 - tid] : -30000.f); }
  float m_reg = -10000.f, l_reg = 0; f32x16 o[4] = {};
  const bf16_t* Qw = Qb + (long)(wid * QBLK + r32) * LDQ + hi * 8;
  LAS char* qr = lds + OFF_OST + wid * 8192 + lane * 16;
#pragma unroll
  for (int d0 = 0; d0 < 8; ++d0) *reinterpret_cast<LAS bf16x8*>(qr + d0 * 1024) = *reinterpret_cast<const bf16x8*>(Qw + d0 * 16);
  const int sr = tid >> 4, sc = (tid & 15) * 8, vst0 = v_st(sr, sc), vst1 = v_st(32 + sr, sc);
  const int vb0 = (int)(unsigned)(uintptr_t)V_lds + v_rd_base(lane);
  struct { bf16x8 vs0, vs1, ks0, ks1; } sr_[1];
  const int pw = wid >> 1, qi = (wid & 1) * 32 + r32;
#define TROW(t) ((BAND ? (((kc0) + (t)) > 0 ? ((kc0) + (t)) : 0) : (t)) * KVBLK)
#define SLOAD(i, t) do { const long k0_ = TROW(t); sr_[i].vs0 = *reinterpret_cast<const bf16x8*>(&Vh[(k0_ + sr) * LDK + sc]); sr_[i].vs1 = *reinterpret_cast<const bf16x8*>(&Vh[(k0_ + 32 + sr) * LDK + sc]); \
    sr_[i].ks0 = *reinterpret_cast<const bf16x8*>(&Kh[(k0_ + sr) * LDK + sc]); sr_[i].ks1 = *reinterpret_cast<const bf16x8*>(&Kh[(k0_ + 32 + sr) * LDK + sc]); } while (0)
#define SWRITE(b, i) do { *(LAS bf16x8*)(V_lds + (b) * SHM_V + vst0) = sr_[i].vs0; *(LAS bf16x8*)(V_lds + (b) * SHM_V + vst1) = sr_[i].vs1; int kc_ = sc * 2; \
    *(LAS bf16x8*)(K_lds + (b) * SHM_K + KSWZ(sr, kc_)) = sr_[i].ks0; *(LAS bf16x8*)(K_lds + (b) * SHM_K + KSWZ(32 + sr, kc_)) = sr_[i].ks1; } while (0)
#define SWAIT() asm volatile("s_waitcnt vmcnt(0)" ::: "memory")
#define RESC(a) do { if (__any((a) < 1.f)) { if (hi == 0) al_l[r32] = (a); asm volatile("s_waitcnt lgkmcnt(0)" ::: "memory"); \
    _Pragma("unroll") for (int d = 0; d < 4; ++d) _Pragma("unroll") for (int r = 0; r < 16; ++r) o[d][r] *= al_l[crow(r, hi)]; } } while (0)
#define BPTR(t) ({ const int t_ = (t); const int dch = pw + 8 - t_; int kb_ = 192 - dch * 64 - qi + 4 * hi; kb_ = kb_ < 0 ? 0 : kb_; \
    if (dch < 0 || dch > 8 || (kc0) + t_ < 0) kb_ = 288; (const LAS float*)(btab + kb_); })
  f32x16 pA0, pA1, pB0, pB1; float mnA, mnB, alA, alB; bf16x8 pa0, pa1, pa2, pa3;
  constexpr int SE = 0, SO = 0;
  SLOAD(SE, 0); asm volatile("s_waitcnt vmcnt(0)" ::: "memory"); SWRITE(0, SE); __syncthreads();
  qkt<BAND>(pA0, pA1, K_lds, qr, r32, hi, BPTR(0)); partialSM(pA0, pA1, m_reg, mnA, alA);
  SLOAD(SO, 1);
  SWAIT(); SWRITE(1, SO); __syncthreads();
  for (int j = 1; j + 1 < NT; j += 2) {
    SBAR(); qkt<BAND>(pB0, pB1, K_lds + SHM_K, qr, r32, hi, BPTR(j));
    finishSM(pA0, pA1, alA, l_reg, pa0, pa1, pa2, pa3); SBAR();
    SLOAD(SO, j + 1); SBAR();
    pv_d0(o, vb0, pa0, pa1, pa2, pa3); partialSM(pB0, pB1, m_reg, mnB, alB);
    __syncthreads(); SWAIT(); SWRITE(0, SE);
    RESC(alB); __syncthreads();
    SBAR(); qkt<BAND>(pA0, pA1, K_lds, qr, r32, hi, BPTR(j + 1));
    finishSM(pB0, pB1, alB, l_reg, pa0, pa1, pa2, pa3); SBAR();
    SLOAD(SE, j + 2); SBAR();
    pv_d0(o, vb0 + SHM_V, pa0, pa1, pa2, pa3); partialSM(pA0, pA1, m_reg, mnA, alA);
    __syncthreads(); SWAIT(); SWRITE(1, SO);
    RESC(alA); __syncthreads();
  }
  SBAR(); qkt<BAND>(pB0, pB1, K_lds + SHM_K, qr, r32, hi, BPTR(NT - 1));
  finishSM(pA0, pA1, alA, l_reg, pa0, pa1, pa2, pa3); SBAR();
  pv_d0(o, vb0, pa0, pa1, pa2, pa3); partialSM(pB0, pB1, m_reg, mnB, alB);
  __syncthreads(); RESC(alB);
  finishSM(pB0, pB1, alB, l_reg, pa0, pa1, pa2, pa3); SBAR();
  pv_d0(o, vb0 + SHM_V, pa0, pa1, pa2, pa3);
  if (hi == 0) li_l[r32] = l_reg; asm volatile("s_waitcnt lgkmcnt(0)" ::: "memory");
  float rli[16];
#pragma unroll
  for (int r = 0; r < 16; ++r) rli[r] = __builtin_amdgcn_rcpf(li_l[crow(r, hi)]);
  { LAS bf16_t* stg = (LAS bf16_t*)(lds + OFF_OST + wid * 8192);
#pragma unroll
    for (int r = 0; r < 16; ++r) { const int orow = crow(r, hi);
#pragma unroll
      for (int d0 = 0; d0 < 4; ++d0) stg[orow * 128 + d0 * 32 + r32] = (bf16_t)f2bf(o[d0][r] * rli[r]); }
    asm volatile("s_waitcnt lgkmcnt(0)" ::: "memory");
    bf16_t* Ow = Ob + (long)(wid * QBLK) * LDO;
#pragma unroll
    for (int i = 0; i < 8; ++i) { const int row = i * 4 + (lane >> 4), ch = lane & 15; const u32x4 v = *(const LAS u32x4*)(stg + row * 128 + ch * 8); *(u32x4*)(Ow + (long)row * LDO + ch * 8) = v; } }
  __syncthreads();
#undef TROW
#undef SLOAD
#undef SWRITE
#undef SWAIT
#undef RESC
#undef BPTR
}
#undef KSWZ
#undef SBAR
}


namespace rt {
using f32x16 = __attribute__((ext_vector_type(16))) float;
#define RKSWZ(row, colB) ((row) * 256 + ((colB) ^ (((row) & 7) << 4)))
__device__ __forceinline__ int crow(int r, int hi) { return (r & 3) + 8 * (r >> 2) + 4 * hi; }
__device__ __forceinline__ void ce_desc(unsigned& a, unsigned& b) { const unsigned mx = a > b ? a : b, mn = a > b ? b : a; a = mx; b = mn; }
__device__ __forceinline__ void sort16_desc(unsigned (&v)[16]) {
#pragma unroll
  for (int k = 2; k <= 16; k <<= 1)
#pragma unroll
    for (int j = k >> 1; j > 0; j >>= 1)
#pragma unroll
      for (int i = 0; i < 16; ++i) { const int l = i ^ j; if (l > i) { if ((i & k) == 0) ce_desc(v[i], v[l]); else ce_desc(v[l], v[i]); } }
}
__device__ __forceinline__ void merge16_desc(unsigned (&a)[16], const unsigned (&b)[16]) {
#pragma unroll
  for (int i = 0; i < 16; ++i) a[i] = a[i] > b[15 - i] ? a[i] : b[15 - i];
#pragma unroll
  for (int j = 8; j > 0; j >>= 1)
#pragma unroll
    for (int i = 0; i < 16; ++i) { const int l = i ^ j; if (l > i) ce_desc(a[i], a[l]); }
}
__device__ __forceinline__ unsigned fkey(float f) { const unsigned u = __float_as_uint(f); return (u & 0x80000000u) ? ~u : (u | 0x80000000u); }
__device__ __forceinline__ float fkey_inv(unsigned k) { const unsigned u = (k & 0x80000000u) ? (k & 0x7fffffffu) : ~k; return __uint_as_float(u); }
__device__ __forceinline__ void top16_half(const f32x16 (&sc)[4], int hi, unsigned (&out)[16]) {
  unsigned g[16];
#pragma unroll
  for (int blk = 0; blk < 4; ++blk) {
#pragma unroll
    for (int r = 0; r < 16; ++r) g[r] = (fkey(sc[blk][r]) & 0xFFFFFF80u) | (unsigned)(32 * blk + (r & 3) + 8 * (r >> 2) + 4 * hi);
    sort16_desc(g);
    if (blk == 0) {
#pragma unroll
      for (int r = 0; r < 16; ++r) out[r] = g[r];
    } else merge16_desc(out, g);
  }
  unsigned pb[16];
#pragma unroll
  for (int r = 0; r < 16; ++r) { auto rr = __builtin_amdgcn_permlane32_swap(out[r], out[r], false, false); pb[r] = hi ? rr[0] : rr[1]; }
  merge16_desc(out, pb);
}
__device__ __forceinline__ void route_phase(const Params& p, LAS unsigned char* lds, int tid, int lane, int wave) {
  const bf16_t* Q = (const bf16_t*)(p.ws + WS_Q); const bf16_t* KB = (const bf16_t*)(p.ws + WS_KEYSB);
  int* RIDX = (int*)(p.ws + WS_RIDX); float* RG = (float*)(p.ws + WS_RG);
  const int h = blockIdx.x & 7, grp = blockIdx.x >> 3;
  const int r32 = lane & 31, hi = lane >> 5;
#pragma unroll
  for (int c = 0; c < 2; ++c)
#pragma unroll
    for (int rep = 0; rep < 4; ++rep) { const int row = rep * 32 + (tid >> 4), cb = (tid & 15) * 16;
      *(LAS u32x4*)(lds + c * 32768 + RKSWZ(row, cb)) = *(const u32x4*)((const char*)KB + ((size_t)(h * 2 + c) * 128 + row) * 256 + cb); }
  __syncthreads();
  for (int tb = grp * 8 + wave; tb < T / 32; tb += (int)(gridDim.x >> 3) * 8) {
    const int t = tb * 32 + r32;
    unsigned ka[16], kb2[16];
#pragma unroll
    for (int c = 0; c < 2; ++c) {
      bf16x8 qf[8];
      const bf16_t* qp = Q + (size_t)t * D + h * 256 + c * 128 + hi * 8;
#pragma unroll
      for (int ks = 0; ks < 8; ++ks) qf[ks] = *(const bf16x8*)(qp + ks * 16);
      f32x16 sc[4];
#pragma unroll
      for (int blk = 0; blk < 4; ++blk) { sc[blk] = f32x16{};
#pragma unroll
        for (int ks = 0; ks < 8; ++ks) { const bf16x8 kf = *(const LAS bf16x8*)(lds + c * 32768 + RKSWZ(32 * blk + r32, (16 * ks + 8 * hi) * 2));
          sc[blk] = __builtin_amdgcn_mfma_f32_32x32x16_bf16(kf, qf[ks], sc[blk], 0, 0, 0); } }
      if (c == 0) top16_half(sc, hi, ka); else top16_half(sc, hi, kb2);
    }
    float av[16], bv[16];
#pragma unroll
    for (int i = 0; i < 16; ++i) { av[i] = fkey_inv(ka[i] & 0xFFFFFF80u); bv[i] = fkey_inv(kb2[i] & 0xFFFFFF80u); }
    float T[16];
#pragma unroll
    for (int k = 0; k < 16; ++k) T[k] = -3.0e38f;
#pragma unroll
    for (int i = 0; i < 16; ++i)
#pragma unroll
      for (int j = 0; j < 16; ++j) if ((i + 1) * (j + 1) <= 16) { float v = av[i] + bv[j];
#pragma unroll
          for (int k = 0; k < 16; ++k) { const float mx = fmaxf(T[k], v); v = fminf(T[k], v); T[k] = mx; } }
    const float m = T[0], theta = T[15];
    float Z = 0.f;
#pragma unroll
    for (int k = 0; k < 16; ++k) Z += __expf(T[k] - m);
    const float rz = 1.f / Z;
    int slot = 0; int cn = 0;
    int* ip = RIDX + (size_t)t * 128 + h * 16; float* gp = RG + (size_t)t * 128 + h * 16;
#pragma unroll
    for (int i = 0; i < 16; ++i)
#pragma unroll
      for (int j = 0; j < 16; ++j) if ((i + 1) * (j + 1) <= 16) { const float v = av[i] + bv[j];
          const bool sel = (v >= theta) && (slot < 16);
          if (sel && ((cn & 1) == hi)) { ip[slot] = (int)((ka[i] & 127u) * 128u + (kb2[j] & 127u)); gp[slot] = __expf(v - m) * rz; }
          slot += sel ? 1 : 0; ++cn; }
  }
}
#undef RKSWZ
}

#define XB_TMO      128
#define XB_XCNT(j)  (256  + 64 * (j))
#define XB_XSUB(j)  (1280 + 64 * (j))
#define XB_XGEN(j)  (2304 + 64 * (j))
#define XB_TOP      3328
#define XB_TOPGEN   3392
#define XCD_BAR_WORDS 3456
#define XB_SPIN_CAP (1u << 22)
__device__ __forceinline__ unsigned xb_ld(unsigned* p)              { return __hip_atomic_load(p, __ATOMIC_RELAXED, __HIP_MEMORY_SCOPE_AGENT); }
__device__ __forceinline__ unsigned xb_add(unsigned* p, unsigned v) { return __hip_atomic_fetch_add(p, v, __ATOMIC_RELAXED, __HIP_MEMORY_SCOPE_AGENT); }
__device__ __forceinline__ unsigned xb_xcc_id() { return (unsigned)__builtin_amdgcn_s_getreg((3 << 11) | 20) & 0xFu; }
#define XB_SPIN(cond, bar) do { unsigned _sp = 0; while (cond) { __builtin_amdgcn_s_sleep(1); \
    if ((++_sp & 255u) == 0u) { if (xb_ld(&(bar)[XB_TMO])) break; if (_sp > XB_SPIN_CAP) { atomicAdd(&(bar)[XB_TMO], 1u); break; } } } } while (0)
struct XcdBarrier { unsigned* bar; unsigned x; volatile LAS unsigned* st; };
__device__ __forceinline__ XcdBarrier xcd_barrier_post(unsigned* bar, volatile LAS unsigned* st) {
    XcdBarrier b; b.bar = bar; b.x = xb_xcc_id(); b.st = st;
    if (threadIdx.x == 0) (void)xb_add(&bar[XB_XCNT(b.x)], 1u);
    return b;
}
__device__ __forceinline__ void xcd_barrier_complete(unsigned* bar, unsigned x, unsigned& nloc, unsigned& nx) {
    const unsigned G = gridDim.x * gridDim.y * gridDim.z;
    unsigned sum, cnt, mine, sp = 0u;
    for (;;) {
        sum = 0u; cnt = 0u; mine = 0u;
#pragma unroll
        for (unsigned j = 0; j < 16; ++j) { const unsigned c = xb_ld(&bar[XB_XCNT(j)]); sum += c; cnt += (c > 0u) ? 1u : 0u; mine = (j == x) ? c : mine; }
        if (sum == G) break;
        __builtin_amdgcn_s_sleep(1);
        if ((++sp & 255u) == 0u) { if (xb_ld(&bar[XB_TMO])) break; if (sp > XB_SPIN_CAP) { atomicAdd(&bar[XB_TMO], 1u); break; } }
    }
    nloc = mine > 0u ? mine : 1u; nx = cnt > 0u ? cnt : 1u;
}
__device__ __forceinline__ void xcd_barrier(const XcdBarrier& b) {
    asm volatile("s_waitcnt vmcnt(0)" ::: "memory");
    __syncthreads();
    if (threadIdx.x == 0) {
        unsigned* bar = b.bar;
        __builtin_amdgcn_s_waitcnt(0);
        unsigned nloc = b.st[0], nx = b.st[1];
        if (nloc == 0u) { xcd_barrier_complete(bar, b.x, nloc, nx); b.st[0] = nloc; b.st[1] = nx; }
        const unsigned old = xb_add(&bar[XB_XSUB(b.x)], 1u);
        const unsigned gen = old / nloc;
        if (old + 1u == (gen + 1u) * nloc) {
            __builtin_amdgcn_fence(__ATOMIC_RELEASE, "agent");
            asm volatile("s_waitcnt vmcnt(0)" ::: "memory");
            const unsigned og = xb_add(&bar[XB_TOP], 1u);
            const unsigned tg = og / nx;
            if (og + 1u == (tg + 1u) * nx) xb_add(&bar[XB_TOPGEN], 1u);
            else XB_SPIN(xb_ld(&bar[XB_TOPGEN]) == tg, bar);
            __builtin_amdgcn_fence(__ATOMIC_ACQUIRE, "agent");
            xb_add(&bar[XB_XGEN(b.x)], 1u);
            asm volatile("s_waitcnt vmcnt(0)" ::: "memory");
        } else {
            XB_SPIN(xb_ld(&bar[XB_XGEN(b.x)]) == gen, bar);
            __builtin_amdgcn_fence(__ATOMIC_ACQUIRE, "agent");
            asm volatile("s_waitcnt vmcnt(0)" ::: "memory");
        }
    }
    __syncthreads();
}
constexpr int RING_BYTES = 131072, MISC_OFF = 143360, LDS_BYTES = 147456, NTHREADS = 512;
static_assert(att::LDS_NEED <= MISC_OFF, "attention scratch below the MISC words");
constexpr size_t WS_SLAB = WS_X2BF;

#ifndef PROBE_MASK
#define PROBE_MASK 0
#endif
#define PH_BEGIN(i) unsigned long long t0_##i = 0; if ((PROBE_MASK >> (i)) & 1) t0_##i = __builtin_amdgcn_s_memrealtime();
#define PH_END(i) if ((PROBE_MASK >> (i)) & 1) probe_acc += __builtin_amdgcn_s_memrealtime() - t0_##i;
__global__ void __launch_bounds__(NTHREADS, 2) fwd(Params p) {
    cg::grid_group grid = cg::this_grid();
    extern __shared__ __attribute__((aligned(16))) unsigned char lds_raw[];
    LAS unsigned char* lds = (LAS unsigned char*)lds_raw;
    volatile LAS unsigned* MISC = (volatile LAS unsigned*)(lds + MISC_OFF);
    const int tid = threadIdx.x, lane = tid & 63, wave = __builtin_amdgcn_readfirstlane(tid >> 6);
    const int nwb = NTHREADS / 64;
    const int gw = blockIdx.x * nwb + wave, NW = gridDim.x * nwb;
    const int Gd = gridDim.x, cb = blockIdx.x;
    unsigned char* ws = p.ws;
    bf16_t* WT_IN = (bf16_t*)(ws + WS_WT_IN); bf16_t* WT_GATE = (bf16_t*)(ws + WS_WT_GATE); bf16_t* WT_BR = (bf16_t*)(ws + WS_WT_BR);
    bf16_t* WT_O = (bf16_t*)(ws + WS_WT_O); bf16_t* WT_PQ = (bf16_t*)(ws + WS_WT_PQ); bf16_t* WT_MKV = (bf16_t*)(ws + WS_WT_MKV);
    bf16_t* KEYSB = (bf16_t*)(ws + WS_KEYSB); bf16_t* MEMN = (bf16_t*)(ws + WS_MEMN); bf16_t* MEMKV = (bf16_t*)(ws + WS_MEMKV);
    bf16_t* HO = (bf16_t*)(ws + WS_HO); bf16_t* PROJ = (bf16_t*)(ws + WS_PROJ); bf16_t* G = (bf16_t*)(ws + WS_G);
    bf16_t* MERGED = (bf16_t*)(ws + WS_MERGED); bf16_t* X2BF = (bf16_t*)(ws + WS_X2BF); bf16_t* QB = (bf16_t*)(ws + WS_Q);
        float* SS2 = (float*)(ws + WS_CTL + CTL_SS2_BYTE);
    if (tid < 64) MISC[tid] = 0u;
    __syncthreads();
    XcdBarrier bar = xcd_barrier_post((unsigned*)(ws + WS_CTL + CTL_BAR_BYTE), MISC + 8);

    unsigned long long probe_acc = 0;
    PH_BEGIN(0)
    {
        float* scr = (float*)lds_raw + wave * (64 * 33);
        transpose_all(p.in[3], D, INW, WT_IN, nullptr, scr, gw, NW, lane);
        transpose_all(p.in[18], D, GW, WT_GATE, nullptr, scr, gw, NW, lane);
        transpose_all(p.in[20], D, D, WT_BR, nullptr, scr, gw, NW, lane);
        transpose_all(p.in[21], D, D, WT_O, nullptr, scr, gw, NW, lane);
        transpose_all(p.in[23], D, D, WT_PQ, p.in[22], scr, gw, NW, lane);
        transpose_all(p.in[15], D, 2 * CW, WT_MKV, nullptr, scr, gw, NW, lane);
        for (int m = gw; m < T; m += NW) rms_row_bf16(p.in[0] + (size_t)m * D, p.in[2], HO + (size_t)m * D, lane);
        for (int m = gw; m < BATCH * NMEM; m += NW) rms_row_bf16(p.in[1] + (size_t)m * D, p.in[14], MEMN + (size_t)m * D, lane);
        const float* keys = p.in[24];
        for (int i = gw * 64 + lane; i < PH * 2 * NKEYS * 128 / 2; i += NW * 64) ((unsigned*)KEYSB)[i] = pk2(keys[2 * i], keys[2 * i + 1]);
    }
    grid.sync();
    PH_END(0)
    PH_BEGIN(1)
    {
        SchedP1 S{(const char*)HO, (const char*)WT_IN, (const char*)MEMN, (const char*)WT_MKV, Gd, cb};
        EpiP1 E{PROJ, G, MEMKV, p.in[19]};
        pg8::gemm_phase(lds, D, D, S, E);
    }
    xcd_barrier(bar);
    PH_END(1)
    PH_BEGIN(2)
    {
        const float qscale = 0.08838834764831845f;
        for (int it = gw; it < T * 20; it += NW) { const int t = it / 20, j = it % 20;
            if (j < 8) headnorm(PROJ + (size_t)t * INW + C_QA + j * 128, p.in[4], qscale, lane);
            else if (j < 16) headnorm(PROJ + (size_t)t * INW + C_KA + (j - 8) * 128, p.in[5], 1.f, lane);
            else headnorm(PROJ + (size_t)t * INW + C_QC + (j - 16) * 128, p.in[16], qscale, lane); }
        for (int it = gw; it < BATCH * NMEM * 4; it += NW) { const int m = it / 4, j = it % 4; headnorm(MEMKV + (size_t)m * (2 * CW) + j * 128, p.in[17], 1.f, lane); }
        for (int u = gw; u < BATCH * NCH * 8; u += NW) { const int g = u % 8, c = (u / 8) % NCH, b = u / (8 * NCH); lru_unit<false>(p, b, c, g, lane); }
    }
    xcd_barrier(bar);
    PH_END(2)
    PH_BEGIN(3)
    {
        const int nA = BATCH * 8 * (NCH / 4), nC = BATCH * 4 * (SEQ / 256);
        for (int u = cb; u < nA + nC; u += Gd) {
            if (u < nA) {
                const int cg = u % (NCH / 4), h = (u / (NCH / 4)) % 8, b = u / ((NCH / 4) * 8);
                const size_t brow = (size_t)b * SEQ, qrow = brow + (size_t)cg * 256;
                att::attn_body<INW, INW, D, true>(PROJ + qrow * INW + C_QA + h * 128, PROJ + brow * INW + C_KA + h * 128, PROJ + brow * INW + C_VA + h * 128,
                                                  HO + qrow * D + h * 128, 12, cg * 4 - NPREV, p.in[6] + h * 257, (LAS char*)lds);
            } else {
                const int v = u - nA; const int qb = v % (SEQ / 256), h = (v / (SEQ / 256)) % 4, b = v / ((SEQ / 256) * 4);
                const size_t qrow = (size_t)b * SEQ + (size_t)qb * 256;
                att::attn_body<INW, 2 * CW, D, false>(PROJ + qrow * INW + C_QC + h * 128, MEMKV + (size_t)b * NMEM * (2 * CW) + h * 128, MEMKV + (size_t)b * NMEM * (2 * CW) + CW + h * 128,
                                                     HO + qrow * D + AW + LW + h * 128, NMEM / 64, 0, nullptr, (LAS char*)lds);
            }
        }
        for (int u = gw; u < BATCH * NCH * 8; u += NW) { const int g = u % 8, c = (u / 8) % NCH, b = u / (8 * NCH); lru_unit<true>(p, b, c, g, lane); }
    }
    xcd_barrier(bar);
    PH_END(3)
    PH_BEGIN(4)
    {
        SchedP3 S{(const char*)HO, (const char*)WT_BR, Gd, cb};
        EpiP3 E{G, (float*)(ws + WS_SLAB) + (size_t)cb * (32 * 512 * 4), MERGED};
        pg8::gemm_phase(lds, D, D, S, E);
    }
    xcd_barrier(bar);
    PH_END(4)
    PH_BEGIN(5)
    {
        SchedSq S{(const char*)MERGED, (const char*)WT_O, Gd, cb};
        EpiP4 E{p.in[0], p.out, X2BF, SS2};
        pg8::gemm_phase(lds, D, D, S, E);
        for (int r = gw; r < 2 * 16384; r += NW) {
            if (r < 16384) fp8_row(p.in[25] + (size_t)r * D, p.in[22], ws + WS_TABU + (size_t)r * 2048, (float*)(ws + WS_SCU) + r, lane);
            else { const int e = r - 16384; fp8_row(p.in[26] + (size_t)e * D, nullptr, ws + WS_TABV + (size_t)e * 2048, (float*)(ws + WS_SCV) + e, lane); }
        }
    }
    xcd_barrier(bar);
    PH_END(5)
    PH_BEGIN(6)
    {
        SchedSq S{(const char*)X2BF, (const char*)WT_PQ, Gd, cb};
        EpiP5 E{QB, SS2};
        pg8::gemm_phase(lds, D, D, S, E);
    }
    xcd_barrier(bar);
    PH_END(6)
    PH_BEGIN(7)
    rt::route_phase(p, lds, tid, lane, wave);
    xcd_barrier(bar);
    PH_END(7)
    PH_BEGIN(8)
    { LAS float* actL = (LAS float*)lds + wave * 128;
      for (int t = gw; t < T; t += NW) peer_token(p, t, lane, actL); }
    if (PROBE_MASK) { __syncthreads(); PH_END(8) const unsigned long long te = __builtin_amdgcn_s_memrealtime(); while (__builtin_amdgcn_s_memrealtime() - te < probe_acc) __builtin_amdgcn_s_sleep(8); }
}

extern "C" void kernel_launch(void* const* d_in, const int* in_sizes, int n_in, void* d_out, int out_size, void* d_ws, size_t ws_size, hipStream_t stream) {
    static int grid = 0;
    if (grid == 0) {
        if (n_in != 27 || out_size != T * D || ws_size < WS_END) { fprintf(stderr, "kernel_launch: unexpected problem (n_in %d out %d ws %zu)\n", n_in, out_size, ws_size); grid = -1; return; }
        int dev = 0, cus = 0, per_cu = 0;
        (void)hipGetDevice(&dev); (void)hipDeviceGetAttribute(&cus, hipDeviceAttributeMultiprocessorCount, dev);
        if (hipFuncSetAttribute((const void*)fwd, hipFuncAttributeMaxDynamicSharedMemorySize, LDS_BYTES) != hipSuccess) { fprintf(stderr, "kernel_launch: hipFuncSetAttribute failed\n"); grid = -1; return; }
        (void)hipOccupancyMaxActiveBlocksPerMultiprocessor(&per_cu, (const void*)fwd, NTHREADS, LDS_BYTES);
        if (per_cu < 1) { fprintf(stderr, "kernel_launch: occupancy query says %d\n", per_cu); grid = -1; return; }
        grid = cus;
    }
    if (grid < 0) return;
    (void)hipMemsetAsync((char*)d_ws + WS_CTL, 0, 1 * MiB, stream);
    Params p{};
    for (int i = 0; i < 27; ++i) p.in[i] = (const float*)d_in[i];
    p.out = (float*)d_out; p.ws = (unsigned char*)d_ws;
    void* args[] = {&p};
    hipError_t e = hipLaunchCooperativeKernel((const void*)fwd, dim3(grid), dim3(NTHREADS), args, LDS_BYTES, stream);
    if (e != hipSuccess) fprintf(stderr, "cooperative launch failed: %s (grid %d)\n", hipGetErrorString(e), grid);
}
```

```cpp
#include <hip/hip_runtime.h>
#include <hip/hip_cooperative_groups.h>
#include <cstdio>
#include <cstdint>
namespace cg = cooperative_groups;

#define LAS __attribute__((address_space(3)))
typedef unsigned short bf16_t;
typedef short bf16x8 __attribute__((ext_vector_type(8)));
typedef float f32x4 __attribute__((ext_vector_type(4)));
typedef unsigned u32x4 __attribute__((ext_vector_type(4)));
typedef unsigned u32x2 __attribute__((ext_vector_type(2)));

constexpr int D = 2048, BATCH = 2, SEQ = 8192, T = BATCH * SEQ;
constexpr int CHUNK = 64, NPREV = 8, NCH = SEQ / CHUNK;
constexpr int AW = 1024, LW = 512, CW = 512, INW = 4608, GW = 6144;
constexpr int NMEM = 256;
constexpr int PH = 8, NKEYS = 128, TOPK = 16;
constexpr float EPS = 1e-6f;
constexpr int C_QA = 0, C_KA = 1024, C_VA = 2048, C_XL = 3072, C_GL = 3584, C_QC = 4096;

constexpr size_t MiB = 1u << 20;
constexpr size_t WS_CTL = 0;
constexpr size_t WS_WT_IN = 2 * MiB, WS_WT_GATE = 20 * MiB, WS_WT_BR = 44 * MiB, WS_WT_O = 52 * MiB, WS_WT_PQ = 60 * MiB, WS_WT_MKV = 68 * MiB;
constexpr size_t WS_KEYSB = 72 * MiB, WS_MEMN = 73 * MiB, WS_MEMKV = 75 * MiB, WS_LRUSUM = 76 * MiB, WS_RS2 = 77 * MiB;
constexpr size_t WS_HO = 80 * MiB;
constexpr size_t WS_PROJ = 144 * MiB;
constexpr size_t WS_MERGED = 144 * MiB, WS_X2BF = 208 * MiB;
constexpr size_t WS_G = 288 * MiB;
constexpr size_t WS_TABU = 288 * MiB, WS_TABV = 320 * MiB, WS_Q = 416 * MiB;
constexpr size_t WS_SCU = 77 * MiB, WS_SCV = 77 * MiB + 65536;
constexpr size_t WS_RIDX = 480 * MiB, WS_RG = 488 * MiB, WS_END = 496 * MiB;

constexpr size_t CTL_BAR_BYTE = 16384, CTL_SS2_BYTE = 512 * 1024;
struct Params { const float* in[27]; float* out; unsigned char* ws; };

__device__ __forceinline__ float bf2f(unsigned v16) { return __uint_as_float(v16 << 16); }
__device__ __forceinline__ unsigned f2bf(float f) { unsigned u = __float_as_uint(f); return (u + 0x7fffu + ((u >> 16) & 1u)) >> 16; }
__device__ __forceinline__ unsigned pk2(float lo, float hi) { return f2bf(lo) | (f2bf(hi) << 16); }
__device__ __forceinline__ float wave_sum(float v) {
#pragma unroll
    for (int o = 1; o < 64; o <<= 1) v += __shfl_xor(v, o);
    return v;
}
__device__ __forceinline__ float sigmoid_(float x) { return 1.f / (1.f + __expf(-x)); }
__device__ __forceinline__ float gelu_tanh(float x) { const float y = 1.5957691216f * (x + 0.044715f * x * x * x); return x / (1.f + __expf(-y)); }
__device__ __forceinline__ void unpack8(const u32x4 w, float* f) {
    f[0] = __uint_as_float(w.x << 16); f[1] = __uint_as_float(w.x & 0xffff0000u);
    f[2] = __uint_as_float(w.y << 16); f[3] = __uint_as_float(w.y & 0xffff0000u);
    f[4] = __uint_as_float(w.z << 16); f[5] = __uint_as_float(w.z & 0xffff0000u);
    f[6] = __uint_as_float(w.w << 16); f[7] = __uint_as_float(w.w & 0xffff0000u);
}

__device__ __forceinline__ void transpose_item(const float* __restrict__ W, int K, int N, bf16_t* __restrict__ WT, const float* __restrict__ ks, float* scr, int item, int lane) {
    const int nblk = N / 32, kb = item / nblk, nb = item % nblk, k0 = 64 * kb, n0 = 32 * nb;
#pragma unroll 8
    for (int i = 0; i < 32; ++i) { const int kk = 2 * i + (lane >> 5); float v = W[(size_t)(k0 + kk) * N + n0 + (lane & 31)]; if (ks) v *= ks[k0 + kk]; scr[kk * 33 + (lane & 31)] = v; }
    asm volatile("s_waitcnt lgkmcnt(0)" ::: "memory");
    const int c = lane & 7;
#pragma unroll
    for (int j = 0; j < 4; ++j) { const int n = (lane >> 3) + 8 * j; const float* s = scr + (8 * c) * 33 + n;
        u32x4 o; o.x = pk2(s[0 * 33], s[1 * 33]); o.y = pk2(s[2 * 33], s[3 * 33]); o.z = pk2(s[4 * 33], s[5 * 33]); o.w = pk2(s[6 * 33], s[7 * 33]);
        *(u32x4*)(WT + (size_t)(n0 + n) * K + k0 + 8 * c) = o; }
    asm volatile("s_waitcnt lgkmcnt(0)" ::: "memory");
}
__device__ __forceinline__ void transpose_all(const float* W, int K, int N, bf16_t* WT, const float* ks, float* scr, int gw, int NW, int lane) {
    const int nitems = (K / 64) * (N / 32);
    for (int it = gw; it < nitems; it += NW) transpose_item(W, K, N, WT, ks, scr, it, lane);
}
__device__ __forceinline__ void rms_row_bf16(const float* xrow, const float* g, bf16_t* orow, int lane) {
    const f32x4* xr = (const f32x4*)xrow + lane; const f32x4* gr = (const f32x4*)g + lane;
    f32x4 v[8]; float s = 0.f;
#pragma unroll
    for (int j = 0; j < 8; ++j) { v[j] = xr[64 * j]; s += (v[j].x * v[j].x + v[j].y * v[j].y) + (v[j].z * v[j].z + v[j].w * v[j].w); }
    const float rstd = rsqrtf(wave_sum(s) * (1.f / D) + EPS);
    u32x2* o8 = (u32x2*)orow + lane;
#pragma unroll
    for (int j = 0; j < 8; ++j) { const f32x4 gg = gr[64 * j]; u32x2 o; o.x = pk2(v[j].x * rstd * gg.x, v[j].y * rstd * gg.y); o.y = pk2(v[j].z * rstd * gg.z, v[j].w * rstd * gg.w); o8[64 * j] = o; }
}

template <int TM, int TN, class Epi>
__device__ __forceinline__ void gemm_simple(const bf16_t* __restrict__ A, int lda, const bf16_t* __restrict__ Bt, int ldb, int M, int N, int K, const Epi& epi, int gw, int NW, int lane) {
    const int r = lane & 15, q = lane >> 4;
    const int ntm = M / (16 * TM), ntn = N / (16 * TN);
    for (int tile = gw; tile < ntm * ntn; tile += NW) {
        const int tm = tile / ntn, tn = tile % ntn;
        f32x4 acc[TM][TN];
#pragma unroll
        for (int i = 0; i < TM; ++i)
#pragma unroll
            for (int j = 0; j < TN; ++j) acc[i][j] = (f32x4){0.f, 0.f, 0.f, 0.f};
        const bf16_t* ap = A + (size_t)(tm * 16 * TM + r) * lda + q * 8;
        const bf16_t* bp = Bt + (size_t)(tn * 16 * TN + r) * ldb + q * 8;
        for (int k0 = 0; k0 < K; k0 += 32) {
            bf16x8 af[TM], bfr[TN];
#pragma unroll
            for (int i = 0; i < TM; ++i) af[i] = *(const bf16x8*)(ap + (size_t)i * 16 * lda + k0);
#pragma unroll
            for (int j = 0; j < TN; ++j) bfr[j] = *(const bf16x8*)(bp + (size_t)j * 16 * ldb + k0);
#pragma unroll
            for (int i = 0; i < TM; ++i)
#pragma unroll
                for (int j = 0; j < TN; ++j) acc[i][j] = __builtin_amdgcn_mfma_f32_16x16x32_bf16(af[i], bfr[j], acc[i][j], 0, 0, 0);
        }
#pragma unroll
        for (int i = 0; i < TM; ++i)
#pragma unroll
            for (int j = 0; j < TN; ++j)
#pragma unroll
                for (int e = 0; e < 4; ++e) epi(tm * 16 * TM + i * 16 + q * 4 + e, tn * 16 * TN + j * 16 + r, acc[i][j][e]);
    }
}
struct EpiProj { bf16_t* P; __device__ __forceinline__ void operator()(int row, int col, float v) const { if (col >= C_GL && col < C_QC) v = gelu_tanh(v); P[(size_t)row * INW + col] = (bf16_t)f2bf(v); } };
struct EpiGate { bf16_t* G; const float* b; __device__ __forceinline__ void operator()(int row, int col, float v) const { G[(size_t)row * GW + col] = (bf16_t)f2bf(sigmoid_(v + b[col])); } };
struct EpiStore { bf16_t* C; int ldc; __device__ __forceinline__ void operator()(int row, int col, float v) const { C[(size_t)row * ldc + col] = (bf16_t)f2bf(v); } };
struct EpiWo { const float* x; float* out; bf16_t* xb; __device__ __forceinline__ void operator()(int row, int col, float v) const { const size_t o = (size_t)row * D + col; const float y = x[o] + v; out[o] = y; xb[o] = (bf16_t)f2bf(y); } };
struct EpiQ { bf16_t* Q; const float* rs; __device__ __forceinline__ void operator()(int row, int col, float v) const { Q[(size_t)row * D + col] = (bf16_t)f2bf(v * rs[row]); } };

__device__ __forceinline__ void headnorm(bf16_t* vec, const float* g, float scale, int lane) {
    unsigned* p = (unsigned*)vec + lane; const unsigned w = *p;
    const float a = bf2f(w & 0xffffu), b = bf2f(w >> 16);
    const float rs = rsqrtf(wave_sum(a * a + b * b) * (1.f / 128.f) + EPS) * scale;
    *p = pk2(a * rs * g[2 * lane], b * rs * g[2 * lane + 1]);
}

template <bool PASS2>
__device__ __forceinline__ void lru_unit(const Params& p, int b, int c, int g, int lane) {
    const bf16_t* PROJ = (const bf16_t*)(p.ws + WS_PROJ); bf16_t* O = (bf16_t*)(p.ws + WS_HO);
    float* SUMA = (float*)(p.ws + WS_LRUSUM); float* SUMB = SUMA + BATCH * NCH * LW;
    const float* conv_w = p.in[7]; const float* conv_b = p.in[8]; const float* lru_wa = p.in[9]; const float* lru_ba = p.in[10];
    const float* lru_wx = p.in[11]; const float* lru_bx = p.in[12]; const float* lam = p.in[13];
    const int ch = g * 64 + lane;
    float wa_r[64], wx_r[64];
#pragma unroll
    for (int i = 0; i < 64; ++i) { wa_r[i] = lru_wa[(size_t)(g * 64 + i) * 64 + lane]; wx_r[i] = lru_wx[(size_t)(g * 64 + i) * 64 + lane]; }
    const float cw0 = conv_w[0 * LW + ch], cw1 = conv_w[1 * LW + ch], cw2 = conv_w[2 * LW + ch], cw3 = conv_w[3 * LW + ch], cb = conv_b[ch];
    const float ba_ = lru_ba[ch], bx_ = lru_bx[ch];
    const float sp = log1pf(__expf(-lam[ch]));
    const int t0 = c * CHUNK; const size_t row0 = (size_t)b * SEQ + t0;
    float x0 = 0.f, x1 = 0.f, x2 = 0.f;
    if (t0 >= 3) { x0 = bf2f(PROJ[(row0 - 3) * INW + C_XL + ch]); x1 = bf2f(PROJ[(row0 - 2) * INW + C_XL + ch]); x2 = bf2f(PROJ[(row0 - 1) * INW + C_XL + ch]); }
    float h = 0.f, aprod = 1.f;
    if (PASS2) { for (int j = 0; j < c; ++j) { const size_t o = (size_t)(b * NCH + j) * LW + ch; h = SUMA[o] * h + SUMB[o]; } }
    for (int t = 0; t < CHUNK; ++t) {
        const float x3 = bf2f(PROJ[(row0 + t) * INW + C_XL + ch]);
        const float xc = cw0 * x0 + cw1 * x1 + cw2 * x2 + cw3 * x3 + cb;
        x0 = x1; x1 = x2; x2 = x3;
        float rp = ba_, ip = bx_;
#pragma unroll
        for (int i = 0; i < 64; ++i) { const float xi = __int_as_float(__builtin_amdgcn_readlane(__float_as_int(xc), i)); rp = fmaf(xi, wa_r[i], rp); ip = fmaf(xi, wx_r[i], ip); }
        const float r = sigmoid_(rp), ig = sigmoid_(ip);
        const float la = -8.f * r * sp; const float a = __expf(la);
        const float mult = sqrtf(fminf(fmaxf(-expm1f(2.f * la), 1e-12f), 1.f));
        h = a * h + mult * ig * xc;
        if (PASS2) { const float gg = bf2f(PROJ[(row0 + t) * INW + C_GL + ch]); O[(row0 + t) * D + AW + ch] = (bf16_t)f2bf(h * gg); }
        else aprod *= a;
    }
    if (!PASS2) { const size_t o = (size_t)(b * NCH + c) * LW + ch; SUMA[o] = aprod; SUMB[o] = h; }
}

__device__ __forceinline__ void attn_simple(const bf16_t* Qp, int ldq, const bf16_t* Kp, const bf16_t* Vp, int ldkv, int nkeys, int koff, const float* bias_h, bf16_t* Op, int ldo, int tid) {
    const int qi = tid >> 2, part = tid & 3;
    float q[32], o[32];
    { const u32x4* qp = (const u32x4*)(Qp + (size_t)qi * ldq + part * 32);
#pragma unroll
      for (int j = 0; j < 4; ++j) unpack8(qp[j], q + 8 * j); }
#pragma unroll
    for (int d = 0; d < 32; ++d) o[d] = 0.f;
    float m = -1e30f, l = 0.f;
    for (int kk0 = 0; kk0 < nkeys; kk0 += 8) {
        float s[8];
#pragma unroll
        for (int j = 0; j < 8; ++j) {
            const u32x4* kp = (const u32x4*)(Kp + (size_t)(kk0 + j) * ldkv + part * 32);
            float acc = 0.f;
#pragma unroll
            for (int w = 0; w < 4; ++w) { float kf[8]; unpack8(kp[w], kf);
#pragma unroll
                for (int e = 0; e < 8; ++e) acc = fmaf(q[8 * w + e], kf[e], acc); }
            acc += __shfl_xor(acc, 1); acc += __shfl_xor(acc, 2);
            if (bias_h) { int dist = qi + koff - (kk0 + j); dist = dist < -128 ? -128 : (dist > 128 ? 128 : dist); acc += bias_h[dist + 128]; }
            s[j] = acc;
        }
        float mx = s[0];
#pragma unroll
        for (int j = 1; j < 8; ++j) mx = fmaxf(mx, s[j]);
        const float mn = fmaxf(m, mx), corr = __expf(m - mn);
        l *= corr;
#pragma unroll
        for (int d = 0; d < 32; ++d) o[d] *= corr;
#pragma unroll
        for (int j = 0; j < 8; ++j) {
            const float pj = __expf(s[j] - mn); l += pj;
            const u32x4* vp = (const u32x4*)(Vp + (size_t)(kk0 + j) * ldkv + part * 32);
#pragma unroll
            for (int w = 0; w < 4; ++w) { float vf[8]; unpack8(vp[w], vf);
#pragma unroll
                for (int e = 0; e < 8; ++e) o[8 * w + e] = fmaf(pj, vf[e], o[8 * w + e]); }
        }
        m = mn;
    }
    const float inv = 1.f / l;
    u32x4* op = (u32x4*)(Op + (size_t)qi * ldo + part * 32);
#pragma unroll
    for (int w = 0; w < 4; ++w) { u32x4 ov; ov.x = pk2(o[8 * w] * inv, o[8 * w + 1] * inv); ov.y = pk2(o[8 * w + 2] * inv, o[8 * w + 3] * inv); ov.z = pk2(o[8 * w + 4] * inv, o[8 * w + 5] * inv); ov.w = pk2(o[8 * w + 6] * inv, o[8 * w + 7] * inv); op[w] = ov; }
}

__device__ __forceinline__ void gemm_branch(const bf16_t* __restrict__ Ob, const bf16_t* __restrict__ WT, const bf16_t* __restrict__ G, bf16_t* __restrict__ Mg, int gw, int NW, int lane) {
    const int r = lane & 15, q = lane >> 4;
    const int ntn = D / 32, ntiles = (T / 32) * ntn;
    for (int tile = gw; tile < ntiles; tile += NW) {
        const int tm = tile / ntn, tn = tile % ntn;
        f32x4 acc[3][2][2];
#pragma unroll
        for (int s = 0; s < 3; ++s)
#pragma unroll
            for (int i = 0; i < 2; ++i)
#pragma unroll
                for (int j = 0; j < 2; ++j) acc[s][i][j] = (f32x4){0.f, 0.f, 0.f, 0.f};
        const bf16_t* ap = Ob + (size_t)(tm * 32 + r) * D + q * 8;
        const bf16_t* bp = WT + (size_t)(tn * 32 + r) * D + q * 8;
#pragma unroll
        for (int s = 0; s < 3; ++s) {
            const int kb = s == 0 ? 0 : (s == 1 ? 1024 : 1536), ke = s == 0 ? 1024 : (s == 1 ? 1536 : 2048);
            for (int k0 = kb; k0 < ke; k0 += 32) {
                bf16x8 af[2], bfr[2];
#pragma unroll
                for (int i = 0; i < 2; ++i) af[i] = *(const bf16x8*)(ap + (size_t)i * 16 * D + k0);
#pragma unroll
                for (int j = 0; j < 2; ++j) bfr[j] = *(const bf16x8*)(bp + (size_t)j * 16 * D + k0);
#pragma unroll
                for (int i = 0; i < 2; ++i)
#pragma unroll
                    for (int j = 0; j < 2; ++j) acc[s][i][j] = __builtin_amdgcn_mfma_f32_16x16x32_bf16(af[i], bfr[j], acc[s][i][j], 0, 0, 0);
            }
        }
#pragma unroll
        for (int i = 0; i < 2; ++i)
#pragma unroll
            for (int j = 0; j < 2; ++j)
#pragma unroll
                for (int e = 0; e < 4; ++e) {
                    const int row = tm * 32 + i * 16 + q * 4 + e, col = tn * 32 + j * 16 + r;
                    const bf16_t* gp = G + (size_t)row * GW + col;
                    const float mval = bf2f(gp[0]) * acc[0][i][j][e] + bf2f(gp[2048]) * acc[1][i][j][e] + bf2f(gp[4096]) * acc[2][i][j][e];
                    Mg[(size_t)row * D + col] = (bf16_t)f2bf(mval);
                }
    }
}

__device__ __forceinline__ unsigned long long shfl_xor64(unsigned long long v, int m) {
    const unsigned lo = __shfl_xor((unsigned)v, m), hi = __shfl_xor((unsigned)(v >> 32), m);
    return ((unsigned long long)hi << 32) | lo;
}
__device__ __forceinline__ unsigned fkey(float f) { const unsigned u = __float_as_uint(f); return (u & 0x80000000u) ? ~u : (u | 0x80000000u); }
__device__ __forceinline__ float fkey_inv(unsigned k) { const unsigned u = (k & 0x80000000u) ? (k & 0x7fffffffu) : ~k; return __uint_as_float(u); }
__device__ __forceinline__ unsigned long long wave_max64(unsigned long long k) {
#pragma unroll
    for (int o = 1; o < 64; o <<= 1) { const unsigned long long t = shfl_xor64(k, o); k = t > k ? t : k; }
    return k;
}
__device__ __forceinline__ void route_unit(const Params& p, int t, int h, int lane) {
    const bf16_t* Q = (const bf16_t*)(p.ws + WS_Q); const bf16_t* KB = (const bf16_t*)(p.ws + WS_KEYSB);
    int* RIDX = (int*)(p.ws + WS_RIDX); float* RG = (float*)(p.ws + WS_RG);
    float sv_l[2] = {0.f, 0.f}; int si_l[2] = {0, 0};
#pragma unroll
    for (int c = 0; c < 2; ++c) {
        const bf16_t* qv = Q + (size_t)t * D + h * 256 + c * 128;
        const unsigned qw = ((const unsigned*)qv)[lane];
        const float qa = bf2f(qw & 0xffffu), qb = bf2f(qw >> 16);
        const bf16_t* k0p = KB + ((size_t)(h * 2 + c) * NKEYS + lane) * 128;
        const bf16_t* k1p = k0p + 64 * 128;
        float s0 = 0.f, s1 = 0.f;
#pragma unroll
        for (int w = 0; w < 16; ++w) {
            float k0f[8], k1f[8]; unpack8(((const u32x4*)k0p)[w], k0f); unpack8(((const u32x4*)k1p)[w], k1f);
#pragma unroll
            for (int e = 0; e < 8; e += 2) {
                const int src = 4 * w + e / 2;
                const float xa = __int_as_float(__builtin_amdgcn_readlane(__float_as_int(qa), src));
                const float xb = __int_as_float(__builtin_amdgcn_readlane(__float_as_int(qb), src));
                s0 = fmaf(xa, k0f[e], s0); s0 = fmaf(xb, k0f[e + 1], s0);
                s1 = fmaf(xa, k1f[e], s1); s1 = fmaf(xb, k1f[e + 1], s1);
            }
        }
        unsigned long long ka = ((unsigned long long)fkey(s0) << 32) | (unsigned)(255 - lane);
        unsigned long long kb = ((unsigned long long)fkey(s1) << 32) | (unsigned)(255 - (lane + 64));
        for (int rnd = 0; rnd < TOPK; ++rnd) {
            const unsigned long long best = wave_max64(ka > kb ? ka : kb);
            if (ka == best) ka = 0ull; if (kb == best) kb = 0ull;
            if (lane == rnd) { sv_l[c] = fkey_inv((unsigned)(best >> 32)); si_l[c] = 255 - (int)(best & 0xffffffffu); }
        }
    }
    unsigned long long kc[4];
#pragma unroll
    for (int m = 0; m < 4; ++m) { const int cid = lane + 64 * m, i = cid >> 4, j = cid & 15;
        const float v = __shfl(sv_l[0], i) + __shfl(sv_l[1], j);
        kc[m] = ((unsigned long long)fkey(v) << 32) | (unsigned)(1023 - cid); }
    float fv = 0.f; int cidx = 0;
    for (int rnd = 0; rnd < TOPK; ++rnd) {
        unsigned long long loc = kc[0] > kc[1] ? kc[0] : kc[1]; const unsigned long long loc2 = kc[2] > kc[3] ? kc[2] : kc[3]; loc = loc > loc2 ? loc : loc2;
        const unsigned long long best = wave_max64(loc);
#pragma unroll
        for (int m = 0; m < 4; ++m) if (kc[m] == best) kc[m] = 0ull;
        if (lane == rnd) { fv = fkey_inv((unsigned)(best >> 32)); cidx = 1023 - (int)(best & 0xffffffffu); }
    }
    const float fmax_ = __shfl(fv, 0);
    float e = lane < 16 ? __expf(fv - fmax_) : 0.f;
    float ssum = e;
#pragma unroll
    for (int o = 1; o < 16; o <<= 1) ssum += __shfl_xor(ssum, o);
    const int ci = cidx >> 4, cj = cidx & 15;
    const int e0 = __shfl(si_l[0], ci), e1 = __shfl(si_l[1], cj);
    if (lane < 16) { RIDX[(size_t)t * 128 + h * 16 + lane] = e0 * NKEYS + e1; RG[(size_t)t * 128 + h * 16 + lane] = e / ssum; }
}

typedef float f32x2 __attribute__((ext_vector_type(2)));
__device__ __forceinline__ void fp4_row(const float* __restrict__ src, const float* __restrict__ kscale, unsigned char* __restrict__ dst, float* __restrict__ scale_out, int lane) {
    f32x4 v[8]; float mx = 0.f;
#pragma unroll
    for (int j = 0; j < 8; ++j) { v[j] = ((const f32x4*)src)[64 * j + lane];
        if (kscale) v[j] = v[j] * ((const f32x4*)kscale)[64 * j + lane];
        mx = fmaxf(mx, fmaxf(fmaxf(fabsf(v[j].x), fabsf(v[j].y)), fmaxf(fabsf(v[j].z), fabsf(v[j].w)))); }
#pragma unroll
    for (int o = 1; o < 64; o <<= 1) mx = fmaxf(mx, __shfl_xor(mx, o));
    const float sc = mx > 0.f ? mx * (1.f / 6.f) : 1.f, inv = 1.f / sc;
    u32x4 out;
#pragma unroll
    for (int w = 0; w < 4; ++w) {
        const f32x4 a = v[2 * w] * inv, b = v[2 * w + 1] * inv;
        unsigned pk = 0u;
        pk = __builtin_amdgcn_cvt_scalef32_pk_fp4_f32(pk, fminf(fmaxf(a.x, -6.f), 6.f), fminf(fmaxf(a.y, -6.f), 6.f), 1.0f, 0);
        pk = __builtin_amdgcn_cvt_scalef32_pk_fp4_f32(pk, fminf(fmaxf(a.z, -6.f), 6.f), fminf(fmaxf(a.w, -6.f), 6.f), 1.0f, 1);
        pk = __builtin_amdgcn_cvt_scalef32_pk_fp4_f32(pk, fminf(fmaxf(b.x, -6.f), 6.f), fminf(fmaxf(b.y, -6.f), 6.f), 1.0f, 2);
        pk = __builtin_amdgcn_cvt_scalef32_pk_fp4_f32(pk, fminf(fmaxf(b.z, -6.f), 6.f), fminf(fmaxf(b.w, -6.f), 6.f), 1.0f, 3);
        out[w] = pk;
    }
    ((u32x4*)dst)[lane] = out;
    if (lane == 0) *scale_out = sc;
}
struct RowB8 { u32x4 w[8]; };
__device__ __forceinline__ void peer_load_batch(RowB8& buf, const unsigned char* tab, int isel, int pbase, int lane) {
#pragma unroll
    for (int r = 0; r < 8; ++r) { const int e = __builtin_amdgcn_readlane(isel, (pbase + r) & 63);
        buf.w[r] = *(const u32x4*)(tab + (size_t)e * 1024 + lane * 16); }
}
__device__ __forceinline__ float dot_row(const u32x4 w, const float (&xf)[32]) {
    float a0 = 0.f, a1 = 0.f;
#pragma unroll
    for (int q = 0; q < 4; ++q) {
        const f32x2 a = __builtin_amdgcn_cvt_scalef32_pk_f32_fp4(w[q], 1.0f, 0), b = __builtin_amdgcn_cvt_scalef32_pk_f32_fp4(w[q], 1.0f, 1);
        const f32x2 c = __builtin_amdgcn_cvt_scalef32_pk_f32_fp4(w[q], 1.0f, 2), d = __builtin_amdgcn_cvt_scalef32_pk_f32_fp4(w[q], 1.0f, 3);
        a0 = fmaf(a.x, xf[8 * q], a0); a1 = fmaf(a.y, xf[8 * q + 1], a1); a0 = fmaf(b.x, xf[8 * q + 2], a0); a1 = fmaf(b.y, xf[8 * q + 3], a1);
        a0 = fmaf(c.x, xf[8 * q + 4], a0); a1 = fmaf(c.y, xf[8 * q + 5], a1); a0 = fmaf(d.x, xf[8 * q + 6], a0); a1 = fmaf(d.y, xf[8 * q + 7], a1);
    }
    return a0 + a1;
}
__device__ __forceinline__ void axpy_row(const u32x4 w, const float a_, float (&of)[32]) {
#pragma unroll
    for (int q = 0; q < 4; ++q) {
        const f32x2 a = __builtin_amdgcn_cvt_scalef32_pk_f32_fp4(w[q], 1.0f, 0), b = __builtin_amdgcn_cvt_scalef32_pk_f32_fp4(w[q], 1.0f, 1);
        const f32x2 c = __builtin_amdgcn_cvt_scalef32_pk_f32_fp4(w[q], 1.0f, 2), d = __builtin_amdgcn_cvt_scalef32_pk_f32_fp4(w[q], 1.0f, 3);
        of[8 * q] = fmaf(a_, a.x, of[8 * q]); of[8 * q + 1] = fmaf(a_, a.y, of[8 * q + 1]); of[8 * q + 2] = fmaf(a_, b.x, of[8 * q + 2]); of[8 * q + 3] = fmaf(a_, b.y, of[8 * q + 3]);
        of[8 * q + 4] = fmaf(a_, c.x, of[8 * q + 4]); of[8 * q + 5] = fmaf(a_, c.y, of[8 * q + 5]); of[8 * q + 6] = fmaf(a_, d.x, of[8 * q + 6]); of[8 * q + 7] = fmaf(a_, d.y, of[8 * q + 7]);
    }
}
__device__ __forceinline__ void peer_token(const Params& p, int t, int lane, LAS float* actL) {
    const bf16_t* XB = (const bf16_t*)(p.ws + WS_X2BF); const unsigned char* TU = p.ws + WS_TABU; const unsigned char* TV = p.ws + WS_TABV;
    const float* SCU = (const float*)(p.ws + WS_SCU); const float* SCV = (const float*)(p.ws + WS_SCV);
    const int* RIDX = (const int*)(p.ws + WS_RIDX); const float* RG = (const float*)(p.ws + WS_RG); const float* SS2 = (const float*)(p.ws + WS_CTL + CTL_SS2_BYTE);
    float xf[32];
#pragma unroll
    for (int j = 0; j < 8; ++j) { const u32x2 w = *(const u32x2*)(XB + (size_t)t * D + 256 * j + 4 * lane);
        xf[4 * j] = __uint_as_float(w.x << 16); xf[4 * j + 1] = __uint_as_float(w.x & 0xffff0000u); xf[4 * j + 2] = __uint_as_float(w.y << 16); xf[4 * j + 3] = __uint_as_float(w.y & 0xffff0000u); }
    const float rs = rsqrtf(SS2[t] * (1.f / D) + EPS);
    const int i0 = RIDX[(size_t)t * 128 + lane], i1 = RIDX[(size_t)t * 128 + 64 + lane];
    const float su0 = SCU[i0] * rs, su1 = SCU[i1] * rs;
    const float gv0 = RG[(size_t)t * 128 + lane] * SCV[i0], gv1 = RG[(size_t)t * 128 + 64 + lane] * SCV[i1];
    RowB8 A, B;
    const int rl = 4 * ((lane >> 5) & 1) + 2 * ((lane >> 4) & 1) + ((lane >> 3) & 1);
#define PEER_DOT(buf, pb) do { float d[8]; \
        _Pragma("unroll") for (int r = 0; r < 8; ++r) { u32x4 w_ = buf.w[r]; asm volatile("" : "+v"(w_)); d[r] = dot_row(w_, xf); asm volatile("" : "+v"(d[r])); } \
        const bool u5 = (lane & 32) != 0; float k4[4]; \
        _Pragma("unroll") for (int q = 0; q < 4; ++q) k4[q] = (u5 ? d[4 + q] : d[q]) + __shfl_xor(u5 ? d[q] : d[4 + q], 32); \
        const bool u4 = (lane & 16) != 0; float k2[2]; \
        _Pragma("unroll") for (int q = 0; q < 2; ++q) k2[q] = (u4 ? k4[2 + q] : k4[q]) + __shfl_xor(u4 ? k4[q] : k4[2 + q], 16); \
        const bool u3 = (lane & 8) != 0; \
        float v = (u3 ? k2[1] : k2[0]) + __shfl_xor(u3 ? k2[0] : k2[1], 8); \
        v += __shfl_xor(v, 4); v += __shfl_xor(v, 2); v += __shfl_xor(v, 1); \
        const int pi = (pb) + rl; const float su = __shfl(pi < 64 ? su0 : su1, pi & 63), gv = __shfl(pi < 64 ? gv0 : gv1, pi & 63); \
        if ((lane & 7) == 0) actL[pi] = gelu_tanh(v * su) * gv; } while (0)
    peer_load_batch(A, TU, i0, 0, lane);
#pragma unroll 1
    for (int b = 0; b < 16; b += 2) {
        peer_load_batch(B, TU, b < 8 ? i0 : i1, 8 * (b + 1), lane);
        PEER_DOT(A, 8 * b);
        if (b + 2 < 16) peer_load_batch(A, TU, (b + 2) < 8 ? i0 : i1, 8 * (b + 2), lane);
        PEER_DOT(B, 8 * (b + 1));
    }
#undef PEER_DOT
    float of[32];
#pragma unroll
    for (int q = 0; q < 32; ++q) of[q] = 0.f;
#define PIN_OF() do { asm volatile("" : "+v"(of[0]), "+v"(of[1]), "+v"(of[2]), "+v"(of[3]), "+v"(of[4]), "+v"(of[5]), "+v"(of[6]), "+v"(of[7]), "+v"(of[8]), "+v"(of[9]), "+v"(of[10]), "+v"(of[11]), "+v"(of[12]), "+v"(of[13]), "+v"(of[14]), "+v"(of[15])); \
        asm volatile("" : "+v"(of[16]), "+v"(of[17]), "+v"(of[18]), "+v"(of[19]), "+v"(of[20]), "+v"(of[21]), "+v"(of[22]), "+v"(of[23]), "+v"(of[24]), "+v"(of[25]), "+v"(of[26]), "+v"(of[27]), "+v"(of[28]), "+v"(of[29]), "+v"(of[30]), "+v"(of[31])); } while (0)
#define PEER_AXPY(buf, pb) do { \
        _Pragma("unroll") for (int r = 0; r < 8; ++r) { const float a = actL[(pb) + r]; u32x4 w_ = buf.w[r]; asm volatile("" : "+v"(w_)); axpy_row(w_, a, of); PIN_OF(); } } while (0)
    peer_load_batch(A, TV, i0, 0, lane);
#pragma unroll 1
    for (int b = 0; b < 16; b += 2) {
        peer_load_batch(B, TV, b < 8 ? i0 : i1, 8 * (b + 1), lane);
        PEER_AXPY(A, 8 * b);
        if (b + 2 < 16) peer_load_batch(A, TV, (b + 2) < 8 ? i0 : i1, 8 * (b + 2), lane);
        PEER_AXPY(B, 8 * (b + 1));
    }
#undef PEER_AXPY
#undef PIN_OF
    float* orow = p.out + (size_t)t * D;
#pragma unroll
    for (int j = 0; j < 8; ++j) { f32x4* o4 = (f32x4*)(orow + 256 * j + 4 * lane); f32x4 a = *o4;
        a.x += of[4 * j]; a.y += of[4 * j + 1]; a.z += of[4 * j + 2]; a.w += of[4 * j + 3]; *o4 = a; }
}

namespace pg8 {
#define PG8_LAS __attribute__((address_space(3)))
constexpr int BM = 256, BK = 64, HALF = 128, HTB = HALF * BK * 2, STAGE_BYTES = 8 * HTB, NXCD = 8, WGM = 8;
__host__ __device__ __forceinline__ int lds_byte(int r, int c) { const int st = (r >> 4) * 2 + (c >> 5), rr = r & 15, cc = c & 31, ob = rr * 64 + cc * 2; return st * 1024 + (ob ^ (((ob >> 9) & 1) << 5)); }
__host__ __device__ __forceinline__ void stage_rc(int b, int& R, int& C) { const int st = b / 1024, sb = b % 1024, swz = sb ^ (((sb >> 9) & 1) << 5); R = (st >> 1) * 16 + swz / 64; C = (st & 1) * 32 + (swz % 64) / 2; }
__host__ __device__ __forceinline__ int perm32(int rho) { const int n = rho >> 4, i = rho & 15; return 8 * (i >> 2) + 4 * n + (i & 3); }
struct Unit { const char* A; const char* B; int pm, pn, kind, nt; };
__device__ __forceinline__ const char* uni_ptr(const char* p) { const unsigned long long v = (unsigned long long)p; const unsigned lo = __builtin_amdgcn_readfirstlane((unsigned)v), hi = __builtin_amdgcn_readfirstlane((unsigned)(v >> 32)); return (const char*)(((unsigned long long)hi << 32) | lo); }
__device__ __forceinline__ void uni(Unit& u) { u.A = uni_ptr(u.A); u.B = uni_ptr(u.B); u.pm = __builtin_amdgcn_readfirstlane(u.pm); u.pn = __builtin_amdgcn_readfirstlane(u.pn); u.kind = __builtin_amdgcn_readfirstlane(u.kind); u.nt = __builtin_amdgcn_readfirstlane(u.nt); }
__device__ __forceinline__ void tile_of(int L, int nM, int nN, int& pm, int& pn) {
    const int nwg = nM * nN; int wgid = L; { const int q = nwg / NXCD, r = nwg % NXCD, xcd = wgid % NXCD, off = wgid / NXCD; wgid = (xcd < r ? xcd * (q + 1) : r * (q + 1) + (xcd - r) * q) + off; }
    const int nig = WGM * nN, gid = wgid / nig, fm = gid * WGM, gsz = (nM - fm) < WGM ? (nM - fm) : WGM;
    pm = fm + ((wgid % nig) % gsz); pn = (wgid % nig) / gsz;
}
template <class Epi, class Sched>
__device__ __forceinline__ void gemm_phase(PG8_LAS unsigned char* lds, const int lda, const int ldb, const Sched& S, const Epi& E) {
    const int tid = threadIdx.x, wid = __builtin_amdgcn_readfirstlane(tid >> 6), lane = tid & 63, wr = wid >> 2, wc = wid & 3, fr = lane & 15, fq = lane >> 4;
    unsigned voffA[2], voffB[2];
#pragma unroll
    for (int i = 0; i < 2; ++i) { int R, C; stage_rc(tid * 16 + i * 8192, R, C); const int Rb = (R & ~31) + perm32(R & 31);
        voffA[i] = (unsigned)(R * lda + C) * 2u; voffB[i] = (unsigned)(Rb * ldb + C) * 2u; }
    const size_t kstep = (size_t)(BK * 2);
    const size_t hstepA = (size_t)HALF * lda * 2, hstepB = (size_t)HALF * ldb * 2;
    const unsigned ldsw = (unsigned)wid * 1024u;
    const int aoff = lds_byte(wr * 64 + fr, fq * 8), boff = lds_byte(wc * 32 + fr, fq * 8);
#define PG8_SA(b, h) (((b) * 2 + (h)) * HTB)
#define PG8_SB(b, h) ((4 + (b) * 2 + (h)) * HTB)
#define PG8_STAGE(bufoff, gbase, voff) do { _Pragma("unroll") for (int _i = 0; _i < 2; ++_i) \
        __builtin_amdgcn_global_load_lds((const unsigned*)((const char*)(gbase) + (voff)[_i]), (PG8_LAS unsigned*)(lds + (bufoff) + ldsw + _i * 8192), 16, 0, 0); } while (0)
#define PG8_LDA(dst, b, h) do { _Pragma("unroll") for (int m = 0; m < 4; ++m) _Pragma("unroll") for (int k = 0; k < 2; ++k) dst[m][k] = *(const PG8_LAS bf16x8*)(lds + PG8_SA(b, h) + aoff + m * 2048 + k * 1024); } while (0)
#define PG8_LDB(dst, b, h) do { _Pragma("unroll") for (int n = 0; n < 2; ++n) _Pragma("unroll") for (int k = 0; k < 2; ++k) dst[n][k] = *(const PG8_LAS bf16x8*)(lds + PG8_SB(b, h) + boff + n * 2048 + k * 1024); } while (0)
#define PG8_MMA(ai, bj, At, Bt) do { __builtin_amdgcn_s_setprio(1); _Pragma("unroll") for (int m = 0; m < 4; ++m) _Pragma("unroll") for (int n = 0; n < 2; ++n) _Pragma("unroll") for (int k = 0; k < 2; ++k) \
        acc[ai][bj][m][n] = __builtin_amdgcn_mfma_f32_16x16x32_bf16(Bt[n][k], At[m][k], acc[ai][bj][m][n], 0, 0, 0); __builtin_amdgcn_s_setprio(0); } while (0)
#define PG8_WAIT_V(n) asm volatile("s_waitcnt vmcnt(" #n ")" ::: "memory")
#define PG8_WAIT_L(n) asm volatile("s_waitcnt lgkmcnt(" #n ")" ::: "memory")
#define PG8_BAR __builtin_amdgcn_s_barrier()
#define PG8_SCHED __builtin_amdgcn_sched_barrier(0)
    Unit cur, nxt; int ui = 0;
    if (!S.next(0, cur)) return;
    f32x4 acc[2][2][4][2];
#pragma unroll
    for (int a = 0; a < 2; ++a)
#pragma unroll
        for (int b = 0; b < 2; ++b)
#pragma unroll
            for (int m = 0; m < 4; ++m)
#pragma unroll
                for (int n = 0; n < 2; ++n) acc[a][b][m][n] = (f32x4){0.f, 0.f, 0.f, 0.f};
    bf16x8 At[4][2], B0[2][2], B1[2][2];
    const char* cA = cur.A; const char* cB = cur.B;
    PG8_STAGE(PG8_SB(0, 0), cB, voffB); PG8_STAGE(PG8_SB(0, 1), cB + hstepB, voffB); PG8_STAGE(PG8_SA(0, 0), cA, voffA); PG8_STAGE(PG8_SA(0, 1), cA + hstepA, voffA);
    if (wr == 1) PG8_BAR;
    PG8_WAIT_V(2); PG8_BAR;
    PG8_STAGE(PG8_SB(1, 0), cB + kstep, voffB); PG8_STAGE(PG8_SA(1, 0), cA + kstep, voffA); PG8_STAGE(PG8_SB(1, 1), cB + hstepB + kstep, voffB);
    PG8_WAIT_V(6); PG8_BAR;
    for (;;) {
        const bool has_next = S.next(ui + 1, nxt);
        const char* nA = has_next ? nxt.A : cA; const char* nB = has_next ? nxt.B : cB;
        const int nt = cur.nt;
        for (int t = 0; t < nt; t += 2) {
            const bool last = (t == nt - 2);
            const char* a1 = cA + (size_t)(t + 1) * kstep;
            const char* a2 = last ? nA : cA + (size_t)(t + 2) * kstep; const char* b2 = last ? nB : cB + (size_t)(t + 2) * kstep;
            const char* a3 = a2 + kstep; const char* b3 = b2 + kstep;
            PG8_LDB(B0, 0, 0); PG8_LDB(B1, 0, 1); PG8_SCHED; PG8_LDA(At, 0, 0); PG8_STAGE(PG8_SA(1, 1), a1 + hstepA, voffA);
            PG8_WAIT_V(8); PG8_WAIT_L(0); PG8_BAR; PG8_MMA(0, 0, At, B0); PG8_MMA(0, 1, At, B1); PG8_BAR; PG8_SCHED;
            PG8_LDA(At, 0, 1); PG8_STAGE(PG8_SB(0, 0), b2, voffB); PG8_STAGE(PG8_SB(0, 1), b2 + hstepB, voffB); PG8_STAGE(PG8_SA(0, 0), a2, voffA);
            PG8_WAIT_V(8); PG8_WAIT_L(0); PG8_BAR; PG8_MMA(1, 0, At, B0); PG8_MMA(1, 1, At, B1); PG8_BAR; PG8_SCHED;
            PG8_LDB(B0, 1, 0); PG8_LDB(B1, 1, 1); PG8_SCHED; PG8_LDA(At, 1, 0); PG8_STAGE(PG8_SA(0, 1), a2 + hstepA, voffA);
            PG8_WAIT_V(8); PG8_WAIT_L(0); PG8_BAR; PG8_MMA(0, 0, At, B0); PG8_MMA(0, 1, At, B1); PG8_BAR; PG8_SCHED;
            PG8_LDA(At, 1, 1); PG8_STAGE(PG8_SB(1, 0), b3, voffB); PG8_STAGE(PG8_SB(1, 1), b3 + hstepB, voffB); PG8_STAGE(PG8_SA(1, 0), a3, voffA);
            PG8_WAIT_V(8); PG8_WAIT_L(0); PG8_BAR; PG8_MMA(1, 0, At, B0); PG8_MMA(1, 1, At, B1); PG8_BAR; PG8_SCHED;
        }
        if (wr == 0) PG8_BAR;
        E(acc, cur, wr, wc, fr, fq);
        if (!has_next) break;
#pragma unroll
        for (int a = 0; a < 2; ++a)
#pragma unroll
            for (int b = 0; b < 2; ++b)
#pragma unroll
                for (int m = 0; m < 4; ++m)
#pragma unroll
                    for (int n = 0; n < 2; ++n) acc[a][b][m][n] = (f32x4){0.f, 0.f, 0.f, 0.f};
        cur = nxt; cA = nA; cB = nB; ++ui;
        if (wr == 1) PG8_BAR;
    }
    PG8_WAIT_V(0);
    PG8_BAR;
#undef PG8_SA
#undef PG8_SB
#undef PG8_STAGE
#undef PG8_LDA
#undef PG8_LDB
#undef PG8_MMA
#undef PG8_WAIT_V
#undef PG8_WAIT_L
#undef PG8_BAR
#undef PG8_SCHED
}
}
typedef f32x4 AccT[2][2][4][2];
__device__ __forceinline__ unsigned cvt_pk_bf16(float lo, float hi) { unsigned r; asm volatile("v_cvt_pk_bf16_f32 %0, %1, %2" : "=v"(r) : "v"(lo), "v"(hi)); return r; }
__device__ __forceinline__ u32x4 pack8(const f32x4 v0, const f32x4 v1) { u32x4 w; w.x = cvt_pk_bf16(v0[0], v0[1]); w.y = cvt_pk_bf16(v0[2], v0[3]); w.z = cvt_pk_bf16(v1[0], v1[1]); w.w = cvt_pk_bf16(v1[2], v1[3]); return w; }
template <int MODE>
__device__ __forceinline__ void store_tile_bf16(const AccT& acc, bf16_t* base, int ldc, int row0, int col0, const float* bias) {
    f32x4 bv[2][2];
#pragma unroll
    for (int bj = 0; bj < 2; ++bj)
#pragma unroll
        for (int n = 0; n < 2; ++n) bv[bj][n] = (MODE == 2) ? *(const f32x4*)(bias + col0 + bj * 128 + 4 * n) : (f32x4){0.f, 0.f, 0.f, 0.f};
#pragma unroll
    for (int ai = 0; ai < 2; ++ai)
#pragma unroll
        for (int m = 0; m < 4; ++m) { bf16_t* rowp = base + (size_t)(row0 + ai * 128 + m * 16) * ldc + col0;
#pragma unroll
            for (int bj = 0; bj < 2; ++bj) { f32x4 v0 = acc[ai][bj][m][0], v1 = acc[ai][bj][m][1];
                if (MODE == 1) { _Pragma("unroll") for (int e = 0; e < 4; ++e) { v0[e] = gelu_tanh(v0[e]); v1[e] = gelu_tanh(v1[e]); } }
                if (MODE == 2) { v0 = v0 + bv[bj][0]; v1 = v1 + bv[bj][1]; _Pragma("unroll") for (int e = 0; e < 4; ++e) { v0[e] = sigmoid_(v0[e]); v1[e] = sigmoid_(v1[e]); } }
                *(u32x4*)(rowp + bj * 128) = pack8(v0, v1); } }
}
struct SchedP1 { const char* H; const char* WT; const char* MEMN; const char* WTM; int G, c;
    __device__ __forceinline__ bool next(int i, pg8::Unit& u) const {
        const int L = i * G + c; const int n1 = 64 * 42;
        if (L < n1) { pg8::tile_of(L, 64, 42, u.pm, u.pn); u.kind = 0; u.A = H + (size_t)u.pm * 256 * D * 2; u.B = WT + (size_t)u.pn * 256 * D * 2; u.nt = D / 64; pg8::uni(u); return true; }
        if (L < n1 + 8) { const int j = L - n1; u.pm = j >> 2; u.pn = j & 3; u.kind = 1; u.A = MEMN + (size_t)u.pm * 256 * D * 2; u.B = WTM + (size_t)u.pn * 256 * D * 2; u.nt = D / 64; pg8::uni(u); return true; }
        return false; } };
struct EpiP1 { bf16_t* PROJ; bf16_t* G; bf16_t* MEMKV; const float* bgate;
    __device__ __forceinline__ void operator()(const AccT& acc, const pg8::Unit& u, int wr, int wc, int fr, int fq) const {
        const int row0 = u.pm * 256 + wr * 64 + fr, cl = wc * 32 + 8 * fq;
        if (u.kind == 1) { store_tile_bf16<0>(acc, MEMKV, 2 * CW, row0, u.pn * 256 + cl, nullptr); return; }
        if (u.pn >= 18) { store_tile_bf16<2>(acc, G, GW, row0, (u.pn - 18) * 256 + cl, bgate); return; }
        if (u.pn == 14 || u.pn == 15) { store_tile_bf16<1>(acc, PROJ, INW, row0, u.pn * 256 + cl, nullptr); return; }
        store_tile_bf16<0>(acc, PROJ, INW, row0, u.pn * 256 + cl, nullptr);
    } };
struct SchedP3 { const char* O; const char* WT; int G, c;
    __device__ __forceinline__ bool next(int i, pg8::Unit& u) const {
        const int ti = i / 3, seg = i - 3 * ti; const int L = ti * G + c; if (L >= 64 * 8) return false;
        pg8::tile_of(L, 64, 8, u.pm, u.pn); u.kind = seg;
        const int kb = seg == 0 ? 0 : (seg == 1 ? 1024 : 1536);
        u.A = O + ((size_t)u.pm * 256 * D + kb) * 2; u.B = WT + ((size_t)u.pn * 256 * D + kb) * 2; u.nt = seg == 0 ? 16 : 8; pg8::uni(u); return true; } };
struct EpiP3 { const bf16_t* G; float* slab; bf16_t* MERGED;
    __device__ __forceinline__ void operator()(const AccT& acc, const pg8::Unit& u, int wr, int wc, int fr, int fq) const {
        const int row0 = u.pm * 256 + wr * 64 + fr, col0 = u.pn * 256 + wc * 32 + 8 * fq, seg = u.kind;
        f32x4* sl = (f32x4*)slab + threadIdx.x;
#pragma unroll
        for (int ai = 0; ai < 2; ++ai)
#pragma unroll
            for (int m = 0; m < 4; ++m)
#pragma unroll
                for (int bj = 0; bj < 2; ++bj) {
                    const size_t row = (size_t)(row0 + ai * 128 + m * 16); const int col = col0 + bj * 128;
                    float gf[8]; unpack8(*(const u32x4*)(G + row * GW + seg * D + col), gf);
                    f32x4 v0 = acc[ai][bj][m][0], v1 = acc[ai][bj][m][1];
                    v0[0] *= gf[0]; v0[1] *= gf[1]; v0[2] *= gf[2]; v0[3] *= gf[3]; v1[0] *= gf[4]; v1[1] *= gf[5]; v1[2] *= gf[6]; v1[3] *= gf[7];
                    if (seg > 0) { v0 = v0 + sl[0]; v1 = v1 + sl[512]; }
                    if (seg < 2) { sl[0] = v0; sl[512] = v1; }
                    else *(u32x4*)(MERGED + row * D + col) = pack8(v0, v1);
                    sl += 1024; asm volatile("" : "+v"(sl) :: "memory");
                }
    } };
struct SchedSq { const char* A; const char* WT; int G, c;
    __device__ __forceinline__ bool next(int i, pg8::Unit& u) const {
        const int L = i * G + c; if (L >= 64 * 8) return false;
        pg8::tile_of(L, 64, 8, u.pm, u.pn); u.kind = 0; u.A = A + (size_t)u.pm * 256 * D * 2; u.B = WT + (size_t)u.pn * 256 * D * 2; u.nt = D / 64; pg8::uni(u); return true; } };
struct EpiP4 { const float* x; float* out; bf16_t* xb; float* ss;
    __device__ __forceinline__ void operator()(const AccT& acc, const pg8::Unit& u, int wr, int wc, int fr, int fq) const {
        const int row0 = u.pm * 256 + wr * 64 + fr, col0 = u.pn * 256 + wc * 32 + 8 * fq;
#pragma unroll
        for (int ai = 0; ai < 2; ++ai)
#pragma unroll
            for (int m = 0; m < 4; ++m) { const size_t row = (size_t)(row0 + ai * 128 + m * 16); float sq = 0.f;
#pragma unroll
                for (int bj = 0; bj < 2; ++bj) { const size_t o = row * D + col0 + bj * 128;
                    const f32x4 v0 = acc[ai][bj][m][0] + *(const f32x4*)(x + o), v1 = acc[ai][bj][m][1] + *(const f32x4*)(x + o + 4);
                    *(f32x4*)(out + o) = v0; *(f32x4*)(out + o + 4) = v1; *(u32x4*)(xb + o) = pack8(v0, v1);
                    sq += (v0[0] * v0[0] + v0[1] * v0[1]) + (v0[2] * v0[2] + v0[3] * v0[3]) + (v1[0] * v1[0] + v1[1] * v1[1]) + (v1[2] * v1[2] + v1[3] * v1[3]); }
                sq += __shfl_xor(sq, 16); sq += __shfl_xor(sq, 32);
                if (fq == 0) atomicAdd(ss + row, sq); }
    } };
struct EpiP5 { bf16_t* Q; const float* ss;
    __device__ __forceinline__ void operator()(const AccT& acc, const pg8::Unit& u, int wr, int wc, int fr, int fq) const {
        const int row0 = u.pm * 256 + wr * 64 + fr, col0 = u.pn * 256 + wc * 32 + 8 * fq;
#pragma unroll
        for (int ai = 0; ai < 2; ++ai)
#pragma unroll
            for (int m = 0; m < 4; ++m) { const size_t row = (size_t)(row0 + ai * 128 + m * 16); const float rs = rsqrtf(ss[row] * (1.f / D) + EPS);
#pragma unroll
                for (int bj = 0; bj < 2; ++bj) *(u32x4*)(Q + row * D + col0 + bj * 128) = pack8(acc[ai][bj][m][0] * rs, acc[ai][bj][m][1] * rs); }
    } };


namespace att {
using s16x4  = __attribute__((ext_vector_type(4))) short;
using f32x16 = __attribute__((ext_vector_type(16))) float;
constexpr int NWV = 8, QBLK = 32, KVBLK = 64, DH = 128;
constexpr float THR = 8.f;
constexpr int SHM_V = KVBLK * DH * 2, SHM_K = KVBLK * DH * 2;
constexpr int OFF_WS = 2 * SHM_V + 2 * SHM_K, OFF_BT = OFF_WS + NWV * 64 * 4, OFF_OST = OFF_BT + 1536, LDS_NEED = OFF_OST + NWV * 8192;
#define KSWZ(row, colB) ((row) * 256 + ((colB) ^ (((row) & 7) << 4)))
#define SBAR() __builtin_amdgcn_sched_barrier(0)
__device__ __forceinline__ int crow(int r, int hi) { return (r & 3) + 8 * (r >> 2) + 4 * hi; }
__device__ __forceinline__ unsigned cvtpk(float lo, float hi) { unsigned r; asm volatile("v_cvt_pk_bf16_f32 %0, %1, %2" : "=v"(r) : "v"(lo), "v"(hi)); return r; }
__device__ __forceinline__ void partialSM(f32x16& p0, f32x16& p1, float& m_reg, float& mn, float& alpha) {
  constexpr float C = 1.4426950408889634f;
  float pmax = p0[0];
#pragma unroll
  for (int r = 1; r < 16; ++r) pmax = fmaxf(pmax, p0[r]);
#pragma unroll
  for (int r = 0; r < 16; ++r) pmax = fmaxf(pmax, p1[r]);
  { auto rr = __builtin_amdgcn_permlane32_swap(__float_as_uint(pmax), __float_as_uint(pmax), false, false);
    pmax = fmaxf(__uint_as_float(rr[0]), __uint_as_float(rr[1])); }
  if (__builtin_expect(__all(pmax - m_reg <= THR), 1)) { mn = m_reg; alpha = 1.f; }
  else { mn = fmaxf(m_reg, pmax); alpha = __builtin_amdgcn_exp2f((m_reg - mn) * C); m_reg = mn; }
  float mnC = -mn * C;
#pragma unroll
  for (int r = 0; r < 16; ++r) p0[r] = fmaf(p0[r], C, mnC);
#pragma unroll
  for (int r = 0; r < 16; ++r) p1[r] = fmaf(p1[r], C, mnC);
#pragma unroll
  for (int r = 0; r < 16; ++r) p0[r] = __builtin_amdgcn_exp2f(p0[r]);
}
__device__ __forceinline__ void finishSM(f32x16& p0, f32x16& p1, float alpha, float& l_reg, bf16x8& pa0, bf16x8& pa1, bf16x8& pa2, bf16x8& pa3) {
#pragma unroll
  for (int r = 0; r < 16; ++r) p1[r] = __builtin_amdgcn_exp2f(p1[r]);
  float ps = 0;
#pragma unroll
  for (int r = 0; r < 16; ++r) ps += p0[r];
#pragma unroll
  for (int r = 0; r < 16; ++r) ps += p1[r];
  { auto rr = __builtin_amdgcn_permlane32_swap(__float_as_uint(ps), __float_as_uint(ps), false, false);
    ps = __uint_as_float(rr[0]) + __uint_as_float(rr[1]); }
  l_reg = l_reg * alpha + ps;
#define PK4(P, BASE, OUT) do { unsigned a0 = cvtpk(P[BASE + 0], P[BASE + 1]), a1 = cvtpk(P[BASE + 2], P[BASE + 3]);   \
    unsigned b0 = cvtpk(P[BASE + 4], P[BASE + 5]), b1 = cvtpk(P[BASE + 6], P[BASE + 7]);                              \
    auto r0 = __builtin_amdgcn_permlane32_swap(a0, b0, false, false); auto r1 = __builtin_amdgcn_permlane32_swap(a1, b1, false, false); \
    u32x4 w = {r0[0], r1[0], r0[1], r1[1]}; OUT = *reinterpret_cast<bf16x8*>(&w); } while (0)
  PK4(p0, 0, pa0); PK4(p0, 8, pa1); PK4(p1, 0, pa2); PK4(p1, 8, pa3);
#undef PK4
}
template <bool BIAS>
__device__ __forceinline__ void qkt(f32x16& p0, f32x16& p1, const LAS char* Ks, const LAS char* qs, int r32, int hi, const LAS float* bp) {
  if (BIAS) {
#pragma unroll
    for (int r = 0; r < 16; ++r) { p0[r] = bp[(r & 3) + 8 * (r >> 2)]; p1[r] = bp[32 + (r & 3) + 8 * (r >> 2)]; }
  } else { p0 = f32x16{}; p1 = f32x16{}; }
#pragma unroll
  for (int d0 = 0; d0 < 8; ++d0) { int cb = (d0 * 16 + hi * 8) * 2;
    bf16x8 b0 = *reinterpret_cast<const LAS bf16x8*>(Ks + KSWZ(r32, cb));
    bf16x8 b1 = *reinterpret_cast<const LAS bf16x8*>(Ks + KSWZ(32 + r32, cb));
    const bf16x8 qv = *reinterpret_cast<const LAS bf16x8*>(qs + d0 * 1024);
    p0 = __builtin_amdgcn_mfma_f32_32x32x16_bf16(b0, qv, p0, 0, 0, 0);
    p1 = __builtin_amdgcn_mfma_f32_32x32x16_bf16(b1, qv, p1, 0, 0, 0); }
}
__device__ __forceinline__ int v_st(int k, int c) { const int kk = (k & ~0xC) | ((k & 4) << 1) | ((k & 8) >> 1); return ((kk >> 3) * 4 + (c >> 5)) * 512 + ((kk & 7) * 32 + (c & 31)) * 2; }
__device__ __forceinline__ int v_rd_base(int lane) { return ((lane & 3) << 3) | (((lane >> 2) & 3) << 6) | (((lane >> 4) & 1) << 5) | (((lane >> 5) & 1) << 8); }
constexpr int v_rd_off(int d0, int ks, int half) { return d0 * 512 + ks * 4096 + half * 2048; }
template <int OFF> __device__ __forceinline__ s16x4 tr_read(int vb) {
  s16x4 r; asm volatile("ds_read_b64_tr_b16 %0, %1 offset:%2" : "=&v"(r) : "v"(vb), "i"(OFF) : "memory"); return r;
}
template <int D0> __device__ __forceinline__ void pv_one(f32x16& od, int vb, bf16x8 pa0, bf16x8 pa1, bf16x8 pa2, bf16x8 pa3) {
  const s16x4 l0 = tr_read<v_rd_off(D0, 0, 0)>(vb), h0 = tr_read<v_rd_off(D0, 0, 1)>(vb), l1 = tr_read<v_rd_off(D0, 1, 0)>(vb), h1 = tr_read<v_rd_off(D0, 1, 1)>(vb);
  const s16x4 l2 = tr_read<v_rd_off(D0, 2, 0)>(vb), h2 = tr_read<v_rd_off(D0, 2, 1)>(vb), l3 = tr_read<v_rd_off(D0, 3, 0)>(vb), h3 = tr_read<v_rd_off(D0, 3, 1)>(vb);
  asm volatile("s_waitcnt lgkmcnt(0)" ::: "memory"); SBAR();
#define PK(L, H) (bf16x8){L[0], L[1], L[2], L[3], H[0], H[1], H[2], H[3]}
  od = __builtin_amdgcn_mfma_f32_32x32x16_bf16(pa0, PK(l0, h0), od, 0, 0, 0);
  od = __builtin_amdgcn_mfma_f32_32x32x16_bf16(pa1, PK(l1, h1), od, 0, 0, 0);
  od = __builtin_amdgcn_mfma_f32_32x32x16_bf16(pa2, PK(l2, h2), od, 0, 0, 0);
  od = __builtin_amdgcn_mfma_f32_32x32x16_bf16(pa3, PK(l3, h3), od, 0, 0, 0);
#undef PK
}
__device__ __forceinline__ void pv_d0(f32x16* o, int vb, bf16x8 pa0, bf16x8 pa1, bf16x8 pa2, bf16x8 pa3) {
  pv_one<0>(o[0], vb, pa0, pa1, pa2, pa3); pv_one<1>(o[1], vb, pa0, pa1, pa2, pa3); pv_one<2>(o[2], vb, pa0, pa1, pa2, pa3); pv_one<3>(o[3], vb, pa0, pa1, pa2, pa3);
}
template <int LDQ, int LDK, int LDO, bool BAND>
__device__ __forceinline__ void attn_body(const bf16_t* Qb, const bf16_t* Kh, const bf16_t* Vh, bf16_t* Ob,
                                          const int NT, const int kc0, const float* btab_src, LAS char* lds) {
  const int tid = threadIdx.x, wid = __builtin_amdgcn_readfirstlane(tid >> 6), lane = tid & 63, r32 = lane & 31, hi = lane >> 5;
  LAS char* V_lds = lds; LAS char* K_lds = lds + 2 * SHM_V;
  LAS float* wsf = (LAS float*)(lds + OFF_WS) + wid * 64; LAS float* li_l = wsf; LAS float* al_l = wsf + 32;
  LAS float* btab = (LAS float*)(lds + OFF_BT);
  if (BAND) { if (tid < 384) btab[tid] = tid < 64 ? btab_src[256] : (tid < 256 ? btab_src[320 - tid] : -30000.f); }
  float m_reg = -10000.f, l_reg = 0; f32x16 o[4] = {};
  const bf16_t* Qw = Qb + (long)(wid * QBLK + r32) * LDQ + hi * 8;
  LAS char* qr = lds + OFF_OST + wid * 8192 + lane * 16;
#pragma unroll
  for (int d0 = 0; d0 < 8; ++d0) *reinterpret_cast<LAS bf16x8*>(qr + d0 * 1024) = *reinterpret_cast<const bf16x8*>(Qw + d0 * 16);
  const int sr = tid >> 4, sc = (tid & 15) * 8, vst0 = v_st(sr, sc), vst1 = v_st(32 + sr, sc);
  const int vb0 = (int)(unsigned)(uintptr_t)V_lds + v_rd_base(lane);
  struct { bf16x8 vs0, vs1, ks0, ks1; } sr_[1];
  const int pw = wid >> 1, qi = (wid & 1) * 32 + r32;
#define TROW(t) ((BAND ? (((kc0) + (t)) > 0 ? ((kc0) + (t)) : 0) : (t)) * KVBLK)
#define SLOAD(i, t) do { const long k0_ = TROW(t); sr_[i].vs0 = *reinterpret_cast<const bf16x8*>(&Vh[(k0_ + sr) * LDK + sc]); sr_[i].vs1 = *reinterpret_cast<const bf16x8*>(&Vh[(k0_ + 32 + sr) * LDK + sc]); \
    sr_[i].ks0 = *reinterpret_cast<const bf16x8*>(&Kh[(k0_ + sr) * LDK + sc]); sr_[i].ks1 = *reinterpret_cast<const bf16x8*>(&Kh[(k0_ + 32 + sr) * LDK + sc]); } while (0)
#define SWRITE(b, i) do { *(LAS bf16x8*)(V_lds + (b) * SHM_V + vst0) = sr_[i].vs0; *(LAS bf16x8*)(V_lds + (b) * SHM_V + vst1) = sr_[i].vs1; int kc_ = sc * 2; \
    *(LAS bf16x8*)(K_lds + (b) * SHM_K + KSWZ(sr, kc_)) = sr_[i].ks0; *(LAS bf16x8*)(K_lds + (b) * SHM_K + KSWZ(32 + sr, kc_)) = sr_[i].ks1; } while (0)
#define SWAIT() asm volatile("s_waitcnt vmcnt(0)" ::: "memory")
#define RESC(a) do { if (__any((a) < 1.f)) { if (hi == 0) al_l[r32] = (a); asm volatile("s_waitcnt lgkmcnt(0)" ::: "memory"); \
    _Pragma("unroll") for (int d = 0; d < 4; ++d) _Pragma("unroll") for (int r = 0; r < 16; ++r) o[d][r] *= al_l[crow(r, hi)]; } } while (0)
#define BPTR(t) ({ const int t_ = (t); const int dch = pw + 8 - t_; int kb_ = 192 - dch * 64 - qi + 4 * hi; kb_ = kb_ < 0 ? 0 : kb_; \
    if (dch < 0 || dch > 8 || (kc0) + t_ < 0) kb_ = 288; (const LAS float*)(btab + kb_); })
  f32x16 pA0, pA1, pB0, pB1; float mnA, mnB, alA, alB; bf16x8 pa0, pa1, pa2, pa3;
  constexpr int SE = 0, SO = 0;
  SLOAD(SE, 0); asm volatile("s_waitcnt vmcnt(0)" ::: "memory"); SWRITE(0, SE); __syncthreads();
  qkt<BAND>(pA0, pA1, K_lds, qr, r32, hi, BPTR(0)); partialSM(pA0, pA1, m_reg, mnA, alA);
  SLOAD(SO, 1);
  SWAIT(); SWRITE(1, SO); __syncthreads();
  for (int j = 1; j + 1 < NT; j += 2) {
    SBAR(); qkt<BAND>(pB0, pB1, K_lds + SHM_K, qr, r32, hi, BPTR(j));
    finishSM(pA0, pA1, alA, l_reg, pa0, pa1, pa2, pa3); SBAR();
    SLOAD(SO, j + 1); SBAR();
    pv_d0(o, vb0, pa0, pa1, pa2, pa3); partialSM(pB0, pB1, m_reg, mnB, alB);
    __syncthreads(); SWAIT(); SWRITE(0, SE);
    RESC(alB); __syncthreads();
    SBAR(); qkt<BAND>(pA0, pA1, K_lds, qr, r32, hi, BPTR(j + 1));
    finishSM(pB0, pB1, alB, l_reg, pa0, pa1, pa2, pa3); SBAR();
    SLOAD(SE, j + 2); SBAR();
    pv_d0(o, vb0 + SHM_V, pa0, pa1, pa2, pa3); partialSM(pA0, pA1, m_reg, mnA, alA);
    __syncthreads(); SWAIT(); SWRITE(1, SO);
    RESC(alA); __syncthreads();
  }
  SBAR(); qkt<BAND>(pB0, pB1, K_lds + SHM_K, qr, r32, hi, BPTR(NT - 1));
  finishSM(pA0, pA1, alA, l_reg, pa0, pa1, pa2, pa3); SBAR();
  pv_d0(o, vb0, pa0, pa1, pa2, pa3); partialSM(pB0, pB1, m_reg, mnB, alB);
  __syncthreads(); RESC(alB);
  finishSM(pB0, pB1, alB, l_reg, pa0, pa1, pa2, pa3); SBAR();
  pv_d0(o, vb0 + SHM_V, pa0, pa1, pa2, pa3);
  if (hi == 0) li_l[r32] = l_reg; asm volatile("s_waitcnt lgkmcnt(0)" ::: "memory");
  float rli[16];
#pragma unroll
  for (int r = 0; r < 16; ++r) rli[r] = __builtin_amdgcn_rcpf(li_l[crow(r, hi)]);
  { LAS bf16_t* stg = (LAS bf16_t*)(lds + OFF_OST + wid * 8192);
#pragma unroll
    for (int r = 0; r < 16; ++r) { const int orow = crow(r, hi);
#pragma unroll
      for (int d0 = 0; d0 < 4; ++d0) stg[orow * 128 + d0 * 32 + r32] = (bf16_t)f2bf(o[d0][r] * rli[r]); }
    asm volatile("s_waitcnt lgkmcnt(0)" ::: "memory");
    bf16_t* Ow = Ob + (long)(wid * QBLK) * LDO;
#pragma unroll
    for (int i = 0; i < 8; ++i) { const int row = i * 4 + (lane >> 4), ch = lane & 15; const u32x4 v = *(const LAS u32x4*)(stg + row * 128 + ch * 8); *(u32x4*)(Ow + (long)row * LDO + ch * 8) = v; } }
  __syncthreads();
#undef TROW
#undef SLOAD
#undef SWRITE
#undef SWAIT
#undef RESC
#undef BPTR
}
#undef KSWZ
#undef SBAR
}


namespace rt {
using f32x16 = __attribute__((ext_vector_type(16))) float;
#define RKSWZ(row, colB) ((row) * 256 + ((colB) ^ (((row) & 7) << 4)))
__device__ __forceinline__ int crow(int r, int hi) { return (r & 3) + 8 * (r >> 2) + 4 * hi; }
__device__ __forceinline__ void ce_desc(unsigned& a, unsigned& b) { const unsigned mx = a > b ? a : b, mn = a > b ? b : a; a = mx; b = mn; }
__device__ __forceinline__ void sort16_desc(unsigned (&v)[16]) {
#pragma unroll
  for (int k = 2; k <= 16; k <<= 1)
#pragma unroll
    for (int j = k >> 1; j > 0; j >>= 1)
#pragma unroll
      for (int i = 0; i < 16; ++i) { const int l = i ^ j; if (l > i) { if ((i & k) == 0) ce_desc(v[i], v[l]); else ce_desc(v[l], v[i]); } }
}
__device__ __forceinline__ void merge16_desc(unsigned (&a)[16], const unsigned (&b)[16]) {
#pragma unroll
  for (int i = 0; i < 16; ++i) a[i] = a[i] > b[15 - i] ? a[i] : b[15 - i];
#pragma unroll
  for (int j = 8; j > 0; j >>= 1)
#pragma unroll
    for (int i = 0; i < 16; ++i) { const int l = i ^ j; if (l > i) ce_desc(a[i], a[l]); }
}
__device__ __forceinline__ unsigned fkey(float f) { const unsigned u = __float_as_uint(f); return (u & 0x80000000u) ? ~u : (u | 0x80000000u); }
__device__ __forceinline__ float fkey_inv(unsigned k) { const unsigned u = (k & 0x80000000u) ? (k & 0x7fffffffu) : ~k; return __uint_as_float(u); }
__device__ __forceinline__ void top16_half(const f32x16 (&sc)[4], int hi, unsigned (&out)[16]) {
  unsigned g[16];
#pragma unroll
  for (int blk = 0; blk < 4; ++blk) {
#pragma unroll
    for (int r = 0; r < 16; ++r) g[r] = (fkey(sc[blk][r]) & 0xFFFFFF80u) | (unsigned)(32 * blk + (r & 3) + 8 * (r >> 2) + 4 * hi);
    sort16_desc(g);
    if (blk == 0) {
#pragma unroll
      for (int r = 0; r < 16; ++r) out[r] = g[r];
    } else merge16_desc(out, g);
  }
  unsigned pb[16];
#pragma unroll
  for (int r = 0; r < 16; ++r) { auto rr = __builtin_amdgcn_permlane32_swap(out[r], out[r], false, false); pb[r] = hi ? rr[0] : rr[1]; }
  merge16_desc(out, pb);
}
__device__ __forceinline__ void route_phase(const Params& p, LAS unsigned char* lds, int tid, int lane, int wave) {
  const bf16_t* Q = (const bf16_t*)(p.ws + WS_Q); const bf16_t* KB = (const bf16_t*)(p.ws + WS_KEYSB);
  int* RIDX = (int*)(p.ws + WS_RIDX); float* RG = (float*)(p.ws + WS_RG);
  const int h = blockIdx.x & 7, grp = blockIdx.x >> 3;
  const int r32 = lane & 31, hi = lane >> 5;
#pragma unroll
  for (int c = 0; c < 2; ++c)
#pragma unroll
    for (int rep = 0; rep < 4; ++rep) { const int row = rep * 32 + (tid >> 4), cb = (tid & 15) * 16;
      *(LAS u32x4*)(lds + c * 32768 + RKSWZ(row, cb)) = *(const u32x4*)((const char*)KB + ((size_t)(h * 2 + c) * 128 + row) * 256 + cb); }
  __syncthreads();
  for (int tb = grp * 8 + wave; tb < T / 32; tb += (int)(gridDim.x >> 3) * 8) {
    const int t = tb * 32 + r32;
    unsigned ka[16], kb2[16];
#pragma unroll
    for (int c = 0; c < 2; ++c) {
      bf16x8 qf[8];
      const bf16_t* qp = Q + (size_t)t * D + h * 256 + c * 128 + hi * 8;
#pragma unroll
      for (int ks = 0; ks < 8; ++ks) qf[ks] = *(const bf16x8*)(qp + ks * 16);
      f32x16 sc[4];
#pragma unroll
      for (int blk = 0; blk < 4; ++blk) { sc[blk] = f32x16{};
#pragma unroll
        for (int ks = 0; ks < 8; ++ks) { const bf16x8 kf = *(const LAS bf16x8*)(lds + c * 32768 + RKSWZ(32 * blk + r32, (16 * ks + 8 * hi) * 2));
          sc[blk] = __builtin_amdgcn_mfma_f32_32x32x16_bf16(kf, qf[ks], sc[blk], 0, 0, 0); } }
      if (c == 0) top16_half(sc, hi, ka); else top16_half(sc, hi, kb2);
    }
    float av[16], bv[16];
#pragma unroll
    for (int i = 0; i < 16; ++i) { av[i] = fkey_inv(ka[i] & 0xFFFFFF80u); bv[i] = fkey_inv(kb2[i] & 0xFFFFFF80u); }
    float T[16];
#pragma unroll
    for (int k = 0; k < 16; ++k) T[k] = -3.0e38f;
#pragma unroll
    for (int i = 0; i < 16; ++i)
#pragma unroll
      for (int j = 0; j < 16; ++j) if ((i + 1) * (j + 1) <= 16) { float v = av[i] + bv[j];
#pragma unroll
          for (int k = 0; k < 16; ++k) { const float mx = fmaxf(T[k], v); v = fminf(T[k], v); T[k] = mx; } }
    const float m = T[0], theta = T[15];
    float Z = 0.f;
#pragma unroll
    for (int k = 0; k < 16; ++k) Z += __expf(T[k] - m);
    const float rz = 1.f / Z;
    int slot = 0; int cn = 0;
    int* ip = RIDX + (size_t)t * 128 + h * 16; float* gp = RG + (size_t)t * 128 + h * 16;
#pragma unroll
    for (int i = 0; i < 16; ++i)
#pragma unroll
      for (int j = 0; j < 16; ++j) if ((i + 1) * (j + 1) <= 16) { const float v = av[i] + bv[j];
          const bool sel = (v >= theta) && (slot < 16);
          if (sel && ((cn & 1) == hi)) { ip[slot] = (int)((ka[i] & 127u) * 128u + (kb2[j] & 127u)); gp[slot] = __expf(v - m) * rz; }
          slot += sel ? 1 : 0; ++cn; }
  }
}
#undef RKSWZ
}

#define XB_TMO      128
#define XB_XCNT(j)  (256  + 64 * (j))
#define XB_XSUB(j)  (1280 + 64 * (j))
#define XB_XGEN(j)  (2304 + 64 * (j))
#define XB_TOP      3328
#define XB_TOPGEN   3392
#define XCD_BAR_WORDS 3456
#define XB_SPIN_CAP (1u << 22)
__device__ __forceinline__ unsigned xb_ld(unsigned* p)              { return __hip_atomic_load(p, __ATOMIC_RELAXED, __HIP_MEMORY_SCOPE_AGENT); }
__device__ __forceinline__ unsigned xb_add(unsigned* p, unsigned v) { return __hip_atomic_fetch_add(p, v, __ATOMIC_RELAXED, __HIP_MEMORY_SCOPE_AGENT); }
__device__ __forceinline__ unsigned xb_xcc_id() { return (unsigned)__builtin_amdgcn_s_getreg((3 << 11) | 20) & 0xFu; }
#define XB_SPIN(cond, bar) do { unsigned _sp = 0; while (cond) { __builtin_amdgcn_s_sleep(1); \
    if ((++_sp & 255u) == 0u) { if (xb_ld(&(bar)[XB_TMO])) break; if (_sp > XB_SPIN_CAP) { atomicAdd(&(bar)[XB_TMO], 1u); break; } } } } while (0)
struct XcdBarrier { unsigned* bar; unsigned x; volatile LAS unsigned* st; };
__device__ __forceinline__ XcdBarrier xcd_barrier_post(unsigned* bar, volatile LAS unsigned* st) {
    XcdBarrier b; b.bar = bar; b.x = xb_xcc_id(); b.st = st;
    if (threadIdx.x == 0) (void)xb_add(&bar[XB_XCNT(b.x)], 1u);
    return b;
}
__device__ __forceinline__ void xcd_barrier_complete(unsigned* bar, unsigned x, unsigned& nloc, unsigned& nx) {
    const unsigned G = gridDim.x * gridDim.y * gridDim.z;
    unsigned sum, cnt, mine, sp = 0u;
    for (;;) {
        sum = 0u; cnt = 0u; mine = 0u;
#pragma unroll
        for (unsigned j = 0; j < 16; ++j) { const unsigned c = xb_ld(&bar[XB_XCNT(j)]); sum += c; cnt += (c > 0u) ? 1u : 0u; mine = (j == x) ? c : mine; }
        if (sum == G) break;
        __builtin_amdgcn_s_sleep(1);
        if ((++sp & 255u) == 0u) { if (xb_ld(&bar[XB_TMO])) break; if (sp > XB_SPIN_CAP) { atomicAdd(&bar[XB_TMO], 1u); break; } }
    }
    nloc = mine > 0u ? mine : 1u; nx = cnt > 0u ? cnt : 1u;
}
__device__ __forceinline__ void xcd_barrier(const XcdBarrier& b) {
    asm volatile("s_waitcnt vmcnt(0)" ::: "memory");
    __syncthreads();
    if (threadIdx.x == 0) {
        unsigned* bar = b.bar;
        __builtin_amdgcn_s_waitcnt(0);
        unsigned nloc = b.st[0], nx = b.st[1];
        if (nloc == 0u) { xcd_barrier_complete(bar, b.x, nloc, nx); b.st[0] = nloc; b.st[1] = nx; }
        const unsigned old = xb_add(&bar[XB_XSUB(b.x)], 1u);
        const unsigned gen = old / nloc;
        if (old + 1u == (gen + 1u) * nloc) {
            __builtin_amdgcn_fence(__ATOMIC_RELEASE, "agent");
            asm volatile("s_waitcnt vmcnt(0)" ::: "memory");
            const unsigned og = xb_add(&bar[XB_TOP], 1u);
            const unsigned tg = og / nx;
            if (og + 1u == (tg + 1u) * nx) xb_add(&bar[XB_TOPGEN], 1u);
            else XB_SPIN(xb_ld(&bar[XB_TOPGEN]) == tg, bar);
            __builtin_amdgcn_fence(__ATOMIC_ACQUIRE, "agent");
            xb_add(&bar[XB_XGEN(b.x)], 1u);
            asm volatile("s_waitcnt vmcnt(0)" ::: "memory");
        } else {
            XB_SPIN(xb_ld(&bar[XB_XGEN(b.x)]) == gen, bar);
            __builtin_amdgcn_fence(__ATOMIC_ACQUIRE, "agent");
            asm volatile("s_waitcnt vmcnt(0)" ::: "memory");
        }
    }
    __syncthreads();
}
constexpr int RING_BYTES = 131072, MISC_OFF = 143360, LDS_BYTES = 147456, NTHREADS = 512;
static_assert(att::LDS_NEED <= MISC_OFF, "attention scratch below the MISC words");
constexpr size_t WS_SLAB = WS_X2BF;

#ifndef PROBE_MASK
#define PROBE_MASK 0
#endif
#define PH_BEGIN(i) unsigned long long t0_##i = 0; if ((PROBE_MASK >> (i)) & 1) t0_##i = __builtin_amdgcn_s_memrealtime();
#define PH_END(i) if ((PROBE_MASK >> (i)) & 1) probe_acc += __builtin_amdgcn_s_memrealtime() - t0_##i;
__global__ void __launch_bounds__(NTHREADS, 2) fwd(Params p) {
    cg::grid_group grid = cg::this_grid();
    extern __shared__ __attribute__((aligned(16))) unsigned char lds_raw[];
    LAS unsigned char* lds = (LAS unsigned char*)lds_raw;
    volatile LAS unsigned* MISC = (volatile LAS unsigned*)(lds + MISC_OFF);
    const int tid = threadIdx.x, lane = tid & 63, wave = __builtin_amdgcn_readfirstlane(tid >> 6);
    const int nwb = NTHREADS / 64;
    const int gw = blockIdx.x * nwb + wave, NW = gridDim.x * nwb;
    const int Gd = gridDim.x, cb = blockIdx.x;
    unsigned char* ws = p.ws;
    bf16_t* WT_IN = (bf16_t*)(ws + WS_WT_IN); bf16_t* WT_GATE = (bf16_t*)(ws + WS_WT_GATE); bf16_t* WT_BR = (bf16_t*)(ws + WS_WT_BR);
    bf16_t* WT_O = (bf16_t*)(ws + WS_WT_O); bf16_t* WT_PQ = (bf16_t*)(ws + WS_WT_PQ); bf16_t* WT_MKV = (bf16_t*)(ws + WS_WT_MKV);
    bf16_t* KEYSB = (bf16_t*)(ws + WS_KEYSB); bf16_t* MEMN = (bf16_t*)(ws + WS_MEMN); bf16_t* MEMKV = (bf16_t*)(ws + WS_MEMKV);
    bf16_t* HO = (bf16_t*)(ws + WS_HO); bf16_t* PROJ = (bf16_t*)(ws + WS_PROJ); bf16_t* G = (bf16_t*)(ws + WS_G);
    bf16_t* MERGED = (bf16_t*)(ws + WS_MERGED); bf16_t* X2BF = (bf16_t*)(ws + WS_X2BF); bf16_t* QB = (bf16_t*)(ws + WS_Q);
        float* SS2 = (float*)(ws + WS_CTL + CTL_SS2_BYTE);
    if (tid < 64) MISC[tid] = 0u;
    __syncthreads();
    XcdBarrier bar = xcd_barrier_post((unsigned*)(ws + WS_CTL + CTL_BAR_BYTE), MISC + 8);

    unsigned long long probe_acc = 0;
    PH_BEGIN(0)
    {
        float* scr = (float*)lds_raw + wave * (64 * 33);
        transpose_all(p.in[3], D, INW, WT_IN, nullptr, scr, gw, NW, lane);
        transpose_all(p.in[18], D, GW, WT_GATE, nullptr, scr, gw, NW, lane);
        transpose_all(p.in[20], D, D, WT_BR, nullptr, scr, gw, NW, lane);
        transpose_all(p.in[21], D, D, WT_O, nullptr, scr, gw, NW, lane);
        transpose_all(p.in[23], D, D, WT_PQ, p.in[22], scr, gw, NW, lane);
        transpose_all(p.in[15], D, 2 * CW, WT_MKV, nullptr, scr, gw, NW, lane);
        for (int m = gw; m < T; m += NW) rms_row_bf16(p.in[0] + (size_t)m * D, p.in[2], HO + (size_t)m * D, lane);
        for (int m = gw; m < BATCH * NMEM; m += NW) rms_row_bf16(p.in[1] + (size_t)m * D, p.in[14], MEMN + (size_t)m * D, lane);
        const float* keys = p.in[24];
        for (int i = gw * 64 + lane; i < PH * 2 * NKEYS * 128 / 2; i += NW * 64) ((unsigned*)KEYSB)[i] = pk2(keys[2 * i], keys[2 * i + 1]);
    }
    grid.sync();
    PH_END(0)
    PH_BEGIN(1)
    {
        SchedP1 S{(const char*)HO, (const char*)WT_IN, (const char*)MEMN, (const char*)WT_MKV, Gd, cb};
        EpiP1 E{PROJ, G, MEMKV, p.in[19]};
        pg8::gemm_phase(lds, D, D, S, E);
    }
    xcd_barrier(bar);
    PH_END(1)
    PH_BEGIN(2)
    {
        const float qscale = 0.08838834764831845f;
        for (int it = gw; it < T * 20; it += NW) { const int t = it / 20, j = it % 20;
            if (j < 8) headnorm(PROJ + (size_t)t * INW + C_QA + j * 128, p.in[4], qscale, lane);
            else if (j < 16) headnorm(PROJ + (size_t)t * INW + C_KA + (j - 8) * 128, p.in[5], 1.f, lane);
            else headnorm(PROJ + (size_t)t * INW + C_QC + (j - 16) * 128, p.in[16], qscale, lane); }
        for (int it = gw; it < BATCH * NMEM * 4; it += NW) { const int m = it / 4, j = it % 4; headnorm(MEMKV + (size_t)m * (2 * CW) + j * 128, p.in[17], 1.f, lane); }
        for (int u = gw; u < BATCH * NCH * 8; u += NW) { const int g = u % 8, c = (u / 8) % NCH, b = u / (8 * NCH); lru_unit<false>(p, b, c, g, lane); }
    }
    xcd_barrier(bar);
    PH_END(2)
    PH_BEGIN(3)
    {
        const int nA = BATCH * 8 * (NCH / 4), nC = BATCH * 4 * (SEQ / 256);
        for (int u = cb; u < nA + nC; u += Gd) {
            if (u < nA) {
                const int cg = u % (NCH / 4), h = (u / (NCH / 4)) % 8, b = u / ((NCH / 4) * 8);
                const size_t brow = (size_t)b * SEQ, qrow = brow + (size_t)cg * 256;
                att::attn_body<INW, INW, D, true>(PROJ + qrow * INW + C_QA + h * 128, PROJ + brow * INW + C_KA + h * 128, PROJ + brow * INW + C_VA + h * 128,
                                                  HO + qrow * D + h * 128, 12, cg * 4 - NPREV, p.in[6] + h * 257, (LAS char*)lds);
            } else {
                const int v = u - nA; const int qb = v % (SEQ / 256), h = (v / (SEQ / 256)) % 4, b = v / ((SEQ / 256) * 4);
                const size_t qrow = (size_t)b * SEQ + (size_t)qb * 256;
                att::attn_body<INW, 2 * CW, D, false>(PROJ + qrow * INW + C_QC + h * 128, MEMKV + (size_t)b * NMEM * (2 * CW) + h * 128, MEMKV + (size_t)b * NMEM * (2 * CW) + CW + h * 128,
                                                     HO + qrow * D + AW + LW + h * 128, NMEM / 64, 0, nullptr, (LAS char*)lds);
            }
        }
        for (int u = gw; u < BATCH * NCH * 8; u += NW) { const int g = u % 8, c = (u / 8) % NCH, b = u / (8 * NCH); lru_unit<true>(p, b, c, g, lane); }
    }
    xcd_barrier(bar);
    PH_END(3)
    PH_BEGIN(4)
    {
        SchedP3 S{(const char*)HO, (const char*)WT_BR, Gd, cb};
        EpiP3 E{G, (float*)(ws + WS_SLAB) + (size_t)cb * (32 * 512 * 4), MERGED};
        pg8::gemm_phase(lds, D, D, S, E);
    }
    xcd_barrier(bar);
    PH_END(4)
    PH_BEGIN(5)
    {
        SchedSq S{(const char*)MERGED, (const char*)WT_O, Gd, cb};
        EpiP4 E{p.in[0], p.out, X2BF, SS2};
        pg8::gemm_phase(lds, D, D, S, E);
        for (int r = gw; r < 2 * 16384; r += NW) {
            if (r < 16384) fp4_row(p.in[25] + (size_t)r * D, p.in[22], ws + WS_TABU + (size_t)r * 1024, (float*)(ws + WS_SCU) + r, lane);
            else { const int e = r - 16384; fp4_row(p.in[26] + (size_t)e * D, nullptr, ws + WS_TABV + (size_t)e * 1024, (float*)(ws + WS_SCV) + e, lane); }
        }
    }
    xcd_barrier(bar);
    PH_END(5)
    PH_BEGIN(6)
    {
        SchedSq S{(const char*)X2BF, (const char*)WT_PQ, Gd, cb};
        EpiP5 E{QB, SS2};
        pg8::gemm_phase(lds, D, D, S, E);
    }
    xcd_barrier(bar);
    PH_END(6)
    PH_BEGIN(7)
    rt::route_phase(p, lds, tid, lane, wave);
    xcd_barrier(bar);
    PH_END(7)
    PH_BEGIN(8)
    { LAS float* actL = (LAS float*)lds + wave * 128;
      for (int t = gw; t < T; t += NW) peer_token(p, t, lane, actL); }
    if (PROBE_MASK) { __syncthreads(); PH_END(8) const unsigned long long te = __builtin_amdgcn_s_memrealtime(); while (__builtin_amdgcn_s_memrealtime() - te < probe_acc) __builtin_amdgcn_s_sleep(8); }
}

extern "C" void kernel_launch(void* const* d_in, const int* in_sizes, int n_in, void* d_out, int out_size, void* d_ws, size_t ws_size, hipStream_t stream) {
    static int grid = 0;
    if (grid == 0) {
        if (n_in != 27 || out_size != T * D || ws_size < WS_END) { fprintf(stderr, "kernel_launch: unexpected problem (n_in %d out %d ws %zu)\n", n_in, out_size, ws_size); grid = -1; return; }
        int dev = 0, cus = 0, per_cu = 0;
        (void)hipGetDevice(&dev); (void)hipDeviceGetAttribute(&cus, hipDeviceAttributeMultiprocessorCount, dev);
        if (hipFuncSetAttribute((const void*)fwd, hipFuncAttributeMaxDynamicSharedMemorySize, LDS_BYTES) != hipSuccess) { fprintf(stderr, "kernel_launch: hipFuncSetAttribute failed\n"); grid = -1; return; }
        (void)hipOccupancyMaxActiveBlocksPerMultiprocessor(&per_cu, (const void*)fwd, NTHREADS, LDS_BYTES);
        if (per_cu < 1) { fprintf(stderr, "kernel_launch: occupancy query says %d\n", per_cu); grid = -1; return; }
        grid = cus;
    }
    if (grid < 0) return;
    (void)hipMemsetAsync((char*)d_ws + WS_CTL, 0, 1 * MiB, stream);
    Params p{};
    for (int i = 0; i < 27; ++i) p.in[i] = (const float*)d_in[i];
    p.out = (float*)d_out; p.ws = (unsigned char*)d_ws;
    void* args[] = {&p};
    hipError_t e = hipLaunchCooperativeKernel((const void*)fwd, dim3(grid), dim3(NTHREADS), args, LDS_BYTES, stream);
    if (e != hipSuccess) fprintf(stderr, "cooperative launch failed: %s (grid %d)\n", hipGetErrorString(e), grid);
}
```

```cpp
#include <hip/hip_runtime.h>
#include <hip/hip_cooperative_groups.h>
#include <cstdio>
#include <cstdint>
namespace cg = cooperative_groups;

#define LAS __attribute__((address_space(3)))
typedef unsigned short bf16_t;
typedef short bf16x8 __attribute__((ext_vector_type(8)));
typedef float f32x4 __attribute__((ext_vector_type(4)));
typedef unsigned u32x4 __attribute__((ext_vector_type(4)));
typedef unsigned u32x2 __attribute__((ext_vector_type(2)));

constexpr int D = 2048, BATCH = 2, SEQ = 8192, T = BATCH * SEQ;
constexpr int CHUNK = 64, NPREV = 8, NCH = SEQ / CHUNK;
constexpr int AW = 1024, LW = 512, CW = 512, INW = 4608, GW = 6144;
constexpr int NMEM = 256;
constexpr int PH = 8, NKEYS = 128, TOPK = 16;
constexpr float EPS = 1e-6f;
constexpr int C_QA = 0, C_KA = 1024, C_VA = 2048, C_XL = 3072, C_GL = 3584, C_QC = 4096;

constexpr size_t MiB = 1u << 20;
constexpr size_t WS_CTL = 0;
constexpr size_t WS_WT_IN = 2 * MiB, WS_WT_GATE = 20 * MiB, WS_WT_BR = 44 * MiB, WS_WT_O = 52 * MiB, WS_WT_PQ = 60 * MiB, WS_WT_MKV = 68 * MiB;
constexpr size_t WS_KEYSB = 72 * MiB, WS_MEMN = 73 * MiB, WS_MEMKV = 75 * MiB, WS_LRUSUM = 76 * MiB, WS_RS2 = 77 * MiB;
constexpr size_t WS_HO = 80 * MiB;
constexpr size_t WS_PROJ = 144 * MiB;
constexpr size_t WS_MERGED = 144 * MiB, WS_X2BF = 208 * MiB;
constexpr size_t WS_G = 288 * MiB;
constexpr size_t WS_TABU = 496 * MiB, WS_TABV = 512 * MiB, WS_Q = 416 * MiB;
constexpr size_t WS_SCU = 77 * MiB, WS_SCV = 77 * MiB + 65536;
constexpr size_t WS_RIDX = 480 * MiB, WS_RG = 488 * MiB, WS_END = 528 * MiB;

constexpr size_t CTL_BAR_BYTE = 16384, CTL_SS2_BYTE = 512 * 1024;
struct Params { const float* in[27]; float* out; unsigned char* ws; };

__device__ __forceinline__ float bf2f(unsigned v16) { return __uint_as_float(v16 << 16); }
__device__ __forceinline__ unsigned f2bf(float f) { unsigned u = __float_as_uint(f); return (u + 0x7fffu + ((u >> 16) & 1u)) >> 16; }
__device__ __forceinline__ unsigned pk2(float lo, float hi) { return f2bf(lo) | (f2bf(hi) << 16); }
__device__ __forceinline__ float wave_sum(float v) {
#pragma unroll
    for (int o = 1; o < 64; o <<= 1) v += __shfl_xor(v, o);
    return v;
}
typedef __bf16 bf16x2_t __attribute__((ext_vector_type(2)));
__device__ __forceinline__ float dot2bf(unsigned w, unsigned x, float acc) { return __builtin_amdgcn_fdot2_f32_bf16(__builtin_bit_cast(bf16x2_t, w), __builtin_bit_cast(bf16x2_t, x), acc, false); }
__device__ __forceinline__ float sigmoid_(float x) { return 1.f / (1.f + __expf(-x)); }
__device__ __forceinline__ float gelu_tanh(float x) { const float y = 1.5957691216f * (x + 0.044715f * x * x * x); return x / (1.f + __expf(-y)); }
__device__ __forceinline__ void unpack8(const u32x4 w, float* f) {
    f[0] = __uint_as_float(w.x << 16); f[1] = __uint_as_float(w.x & 0xffff0000u);
    f[2] = __uint_as_float(w.y << 16); f[3] = __uint_as_float(w.y & 0xffff0000u);
    f[4] = __uint_as_float(w.z << 16); f[5] = __uint_as_float(w.z & 0xffff0000u);
    f[6] = __uint_as_float(w.w << 16); f[7] = __uint_as_float(w.w & 0xffff0000u);
}

struct TrJob { const float* W; bf16_t* WT; const float* ks; int K, N; };
__device__ __forceinline__ void tr_load(const TrJob& jb, int item, int lane, f32x4 (&v)[8]) {
    const int nblk = jb.N / 32, kb = item / nblk, nb = item % nblk, k0 = 64 * kb, n0 = 32 * nb;
#pragma unroll
    for (int i = 0; i < 8; ++i) { const int kk = 8 * i + (lane >> 3); v[i] = *(const f32x4*)(jb.W + (size_t)(k0 + kk) * jb.N + n0 + 4 * (lane & 7)); if (jb.ks) v[i] = v[i] * jb.ks[k0 + kk]; }
}
__device__ __forceinline__ void tr_store(const TrJob& jb, int item, int lane, const f32x4 (&v)[8], float* scr) {
    const int nblk = jb.N / 32, kb = item / nblk, nb = item % nblk, k0 = 64 * kb, n0 = 32 * nb;
#pragma unroll
    for (int i = 0; i < 8; ++i) { float* d = scr + (8 * i + (lane >> 3)) * 33 + 4 * (lane & 7); d[0] = v[i].x; d[1] = v[i].y; d[2] = v[i].z; d[3] = v[i].w; }
    asm volatile("s_waitcnt lgkmcnt(0)" ::: "memory");
    const int c = lane & 7;
#pragma unroll
    for (int j = 0; j < 4; ++j) { const int n = (lane >> 3) + 8 * j; const float* s = scr + (8 * c) * 33 + n;
        u32x4 o; o.x = pk2(s[0 * 33], s[1 * 33]); o.y = pk2(s[2 * 33], s[3 * 33]); o.z = pk2(s[4 * 33], s[5 * 33]); o.w = pk2(s[6 * 33], s[7 * 33]);
        *(u32x4*)(jb.WT + (size_t)(n0 + n) * jb.K + k0 + 8 * c) = o; }
    asm volatile("s_waitcnt lgkmcnt(0)" ::: "memory");
}
__device__ __forceinline__ void rms_row_bf16(const float* xrow, const float* g, bf16_t* orow, int lane) {
    const f32x4* xr = (const f32x4*)xrow + lane; const f32x4* gr = (const f32x4*)g + lane;
    f32x4 v[8]; float s = 0.f;
#pragma unroll
    for (int j = 0; j < 8; ++j) { v[j] = xr[64 * j]; s += (v[j].x * v[j].x + v[j].y * v[j].y) + (v[j].z * v[j].z + v[j].w * v[j].w); }
    const float rstd = rsqrtf(wave_sum(s) * (1.f / D) + EPS);
    u32x2* o8 = (u32x2*)orow + lane;
#pragma unroll
    for (int j = 0; j < 8; ++j) { const f32x4 gg = gr[64 * j]; u32x2 o; o.x = pk2(v[j].x * rstd * gg.x, v[j].y * rstd * gg.y); o.y = pk2(v[j].z * rstd * gg.z, v[j].w * rstd * gg.w); o8[64 * j] = o; }
}

template <int TM, int TN, class Epi>
__device__ __forceinline__ void gemm_simple(const bf16_t* __restrict__ A, int lda, const bf16_t* __restrict__ Bt, int ldb, int M, int N, int K, const Epi& epi, int gw, int NW, int lane) {
    const int r = lane & 15, q = lane >> 4;
    const int ntm = M / (16 * TM), ntn = N / (16 * TN);
    for (int tile = gw; tile < ntm * ntn; tile += NW) {
        const int tm = tile / ntn, tn = tile % ntn;
        f32x4 acc[TM][TN];
#pragma unroll
        for (int i = 0; i < TM; ++i)
#pragma unroll
            for (int j = 0; j < TN; ++j) acc[i][j] = (f32x4){0.f, 0.f, 0.f, 0.f};
        const bf16_t* ap = A + (size_t)(tm * 16 * TM + r) * lda + q * 8;
        const bf16_t* bp = Bt + (size_t)(tn * 16 * TN + r) * ldb + q * 8;
        for (int k0 = 0; k0 < K; k0 += 32) {
            bf16x8 af[TM], bfr[TN];
#pragma unroll
            for (int i = 0; i < TM; ++i) af[i] = *(const bf16x8*)(ap + (size_t)i * 16 * lda + k0);
#pragma unroll
            for (int j = 0; j < TN; ++j) bfr[j] = *(const bf16x8*)(bp + (size_t)j * 16 * ldb + k0);
#pragma unroll
            for (int i = 0; i < TM; ++i)
#pragma unroll
                for (int j = 0; j < TN; ++j) acc[i][j] = __builtin_amdgcn_mfma_f32_16x16x32_bf16(af[i], bfr[j], acc[i][j], 0, 0, 0);
        }
#pragma unroll
        for (int i = 0; i < TM; ++i)
#pragma unroll
            for (int j = 0; j < TN; ++j)
#pragma unroll
                for (int e = 0; e < 4; ++e) epi(tm * 16 * TM + i * 16 + q * 4 + e, tn * 16 * TN + j * 16 + r, acc[i][j][e]);
    }
}
struct EpiProj { bf16_t* P; __device__ __forceinline__ void operator()(int row, int col, float v) const { if (col >= C_GL && col < C_QC) v = gelu_tanh(v); P[(size_t)row * INW + col] = (bf16_t)f2bf(v); } };
struct EpiGate { bf16_t* G; const float* b; __device__ __forceinline__ void operator()(int row, int col, float v) const { G[(size_t)row * GW + col] = (bf16_t)f2bf(sigmoid_(v + b[col])); } };
struct EpiStore { bf16_t* C; int ldc; __device__ __forceinline__ void operator()(int row, int col, float v) const { C[(size_t)row * ldc + col] = (bf16_t)f2bf(v); } };
struct EpiWo { const float* x; float* out; bf16_t* xb; __device__ __forceinline__ void operator()(int row, int col, float v) const { const size_t o = (size_t)row * D + col; const float y = x[o] + v; out[o] = y; xb[o] = (bf16_t)f2bf(y); } };
struct EpiQ { bf16_t* Q; const float* rs; __device__ __forceinline__ void operator()(int row, int col, float v) const { Q[(size_t)row * D + col] = (bf16_t)f2bf(v * rs[row]); } };

__device__ __forceinline__ void headnorm(bf16_t* vec, const float* g, float scale, int lane) {
    unsigned* p = (unsigned*)vec + lane; const unsigned w = *p;
    const float a = bf2f(w & 0xffffu), b = bf2f(w >> 16);
    const float rs = rsqrtf(wave_sum(a * a + b * b) * (1.f / 128.f) + EPS) * scale;
    *p = pk2(a * rs * g[2 * lane], b * rs * g[2 * lane + 1]);
}
struct HeadGains { float gq[32], gk[32], gc[8]; };
__device__ __forceinline__ void load_head_gains(HeadGains& hg, const float* gq, const float* gk, const float* gc, int lane) {
#pragma unroll
    for (int j = 0; j < 32; ++j) { hg.gq[j] = gq[(lane & 3) * 32 + j]; hg.gk[j] = gk[(lane & 3) * 32 + j]; }
#pragma unroll
    for (int j = 0; j < 8; ++j) hg.gc[j] = gc[(lane & 15) * 8 + j];
}
__device__ __forceinline__ void headnorm_token(bf16_t* row, const HeadGains& hg, float qscale, int lane) {
    u32x4* pa = (u32x4*)(row + C_QA) + lane * 4;
    u32x4* pc = (u32x4*)(row + C_QC) + lane;
    u32x4 w[4]; const u32x4 wc = *pc;
#pragma unroll
    for (int j = 0; j < 4; ++j) w[j] = pa[j];
    float f[32], fc[8]; float ss = 0.f, sc = 0.f;
#pragma unroll
    for (int j = 0; j < 4; ++j) unpack8(w[j], f + 8 * j);
    unpack8(wc, fc);
#pragma unroll
    for (int j = 0; j < 32; ++j) ss = fmaf(f[j], f[j], ss);
#pragma unroll
    for (int j = 0; j < 8; ++j) sc = fmaf(fc[j], fc[j], sc);
    ss += __shfl_xor(ss, 1); ss += __shfl_xor(ss, 2);
    sc += __shfl_xor(sc, 1); sc += __shfl_xor(sc, 2); sc += __shfl_xor(sc, 4); sc += __shfl_xor(sc, 8);
    const bool isq = lane < 32;
    const float rs = rsqrtf(ss * (1.f / 128.f) + EPS) * (isq ? qscale : 1.f), rc = rsqrtf(sc * (1.f / 128.f) + EPS) * qscale;
#pragma unroll
    for (int j = 0; j < 4; ++j) { u32x4 o;
        o.x = pk2(f[8 * j] * rs * (isq ? hg.gq[8 * j] : hg.gk[8 * j]), f[8 * j + 1] * rs * (isq ? hg.gq[8 * j + 1] : hg.gk[8 * j + 1]));
        o.y = pk2(f[8 * j + 2] * rs * (isq ? hg.gq[8 * j + 2] : hg.gk[8 * j + 2]), f[8 * j + 3] * rs * (isq ? hg.gq[8 * j + 3] : hg.gk[8 * j + 3]));
        o.z = pk2(f[8 * j + 4] * rs * (isq ? hg.gq[8 * j + 4] : hg.gk[8 * j + 4]), f[8 * j + 5] * rs * (isq ? hg.gq[8 * j + 5] : hg.gk[8 * j + 5]));
        o.w = pk2(f[8 * j + 6] * rs * (isq ? hg.gq[8 * j + 6] : hg.gk[8 * j + 6]), f[8 * j + 7] * rs * (isq ? hg.gq[8 * j + 7] : hg.gk[8 * j + 7]));
        pa[j] = o; }
    { u32x4 o; o.x = pk2(fc[0] * rc * hg.gc[0], fc[1] * rc * hg.gc[1]); o.y = pk2(fc[2] * rc * hg.gc[2], fc[3] * rc * hg.gc[3]);
      o.z = pk2(fc[4] * rc * hg.gc[4], fc[5] * rc * hg.gc[5]); o.w = pk2(fc[6] * rc * hg.gc[6], fc[7] * rc * hg.gc[7]); *pc = o; }
}

template <bool PASS2>
__device__ __forceinline__ void lru_unit(const Params& p, int b, int c, int g, int lane) {
    const bf16_t* PROJ = (const bf16_t*)(p.ws + WS_PROJ); bf16_t* O = (bf16_t*)(p.ws + WS_HO);
    float* SUMA = (float*)(p.ws + WS_LRUSUM); float* SUMB = SUMA + BATCH * NCH * LW;
    const float* conv_w = p.in[7]; const float* conv_b = p.in[8]; const float* lru_wa = p.in[9]; const float* lru_ba = p.in[10];
    const float* lru_wx = p.in[11]; const float* lru_bx = p.in[12]; const float* lam = p.in[13];
    const int ch = g * 64 + lane;
    unsigned wa_p[32], wx_p[32];
#pragma unroll
    for (int m = 0; m < 32; ++m) { wa_p[m] = pk2(lru_wa[(size_t)(g * 64 + 2 * m) * 64 + lane], lru_wa[(size_t)(g * 64 + 2 * m + 1) * 64 + lane]);
        wx_p[m] = pk2(lru_wx[(size_t)(g * 64 + 2 * m) * 64 + lane], lru_wx[(size_t)(g * 64 + 2 * m + 1) * 64 + lane]); }
    const float cw0 = conv_w[0 * LW + ch], cw1 = conv_w[1 * LW + ch], cw2 = conv_w[2 * LW + ch], cw3 = conv_w[3 * LW + ch], cb = conv_b[ch];
    const float ba_ = lru_ba[ch], bx_ = lru_bx[ch];
    const float sp = log1pf(__expf(-lam[ch]));
    const int t0 = c * CHUNK; const size_t row0 = (size_t)b * SEQ + t0;
    float x0 = 0.f, x1 = 0.f, x2 = 0.f;
    if (t0 >= 3) { x0 = bf2f(PROJ[(row0 - 3) * INW + C_XL + ch]); x1 = bf2f(PROJ[(row0 - 2) * INW + C_XL + ch]); x2 = bf2f(PROJ[(row0 - 1) * INW + C_XL + ch]); }
    float h = 0.f, aprod = 1.f;
    if (PASS2) {
        int j = 0;
        for (; j + 8 <= c; j += 8) { float sa[8], sb[8];
#pragma unroll
            for (int q = 0; q < 8; ++q) { const size_t o = (size_t)(b * NCH + j + q) * LW + ch; sa[q] = SUMA[o]; sb[q] = SUMB[o]; }
#pragma unroll
            for (int q = 0; q < 8; ++q) h = sa[q] * h + sb[q]; }
        for (; j < c; ++j) { const size_t o = (size_t)(b * NCH + j) * LW + ch; h = SUMA[o] * h + SUMB[o]; }
    }
    const bf16_t* xp = PROJ + row0 * INW + C_XL + ch; const bf16_t* gp = PROJ + row0 * INW + C_GL + ch;
    bf16_t xn[16], gn[16];
#pragma unroll
    for (int q = 0; q < 16; ++q) { xn[q] = xp[(size_t)q * INW]; if (PASS2) gn[q] = gp[(size_t)q * INW]; }
#pragma unroll 1
    for (int tb = 0; tb < CHUNK; tb += 16) {
        bf16_t xcur[16], gcur[16];
#pragma unroll
        for (int q = 0; q < 16; ++q) { xcur[q] = xn[q]; if (PASS2) gcur[q] = gn[q]; }
        if (tb + 16 < CHUNK) {
#pragma unroll
            for (int q = 0; q < 16; ++q) { xn[q] = xp[(size_t)(tb + 16 + q) * INW]; if (PASS2) gn[q] = gp[(size_t)(tb + 16 + q) * INW]; }
        }
#pragma unroll
        for (int q = 0; q < 16; ++q) {
            const float x3 = bf2f(xcur[q]);
            const float xc = cw0 * x0 + cw1 * x1 + cw2 * x2 + cw3 * x3 + cb;
            x0 = x1; x1 = x2; x2 = x3;
            float rp = ba_, ip = bx_, rp2 = 0.f, ip2 = 0.f;
            const float xnb = __shfl_xor(xc, 1);
            const unsigned xpk = (lane & 1) ? pk2(xnb, xc) : pk2(xc, xnb);
#pragma unroll
            for (int m = 0; m < 32; m += 2) {
                const unsigned xa = (unsigned)__builtin_amdgcn_readlane((int)xpk, 2 * m), xb = (unsigned)__builtin_amdgcn_readlane((int)xpk, 2 * m + 2);
                rp = dot2bf(wa_p[m], xa, rp); ip = dot2bf(wx_p[m], xa, ip); rp2 = dot2bf(wa_p[m + 1], xb, rp2); ip2 = dot2bf(wx_p[m + 1], xb, ip2); }
            const float r = sigmoid_(rp + rp2), ig = sigmoid_(ip + ip2);
            const float la = -8.f * r * sp; const float a = __expf(la);
            const float mult = sqrtf(fminf(fmaxf(-expm1f(2.f * la), 1e-12f), 1.f));
            h = a * h + mult * ig * xc;
            if (PASS2) O[(row0 + tb + q) * D + AW + ch] = (bf16_t)f2bf(h * bf2f(gcur[q]));
            else aprod *= a;
        }
    }
    if (!PASS2) { const size_t o = (size_t)(b * NCH + c) * LW + ch; SUMA[o] = aprod; SUMB[o] = h; }
}

__device__ __forceinline__ void attn_simple(const bf16_t* Qp, int ldq, const bf16_t* Kp, const bf16_t* Vp, int ldkv, int nkeys, int koff, const float* bias_h, bf16_t* Op, int ldo, int tid) {
    const int qi = tid >> 2, part = tid & 3;
    float q[32], o[32];
    { const u32x4* qp = (const u32x4*)(Qp + (size_t)qi * ldq + part * 32);
#pragma unroll
      for (int j = 0; j < 4; ++j) unpack8(qp[j], q + 8 * j); }
#pragma unroll
    for (int d = 0; d < 32; ++d) o[d] = 0.f;
    float m = -1e30f, l = 0.f;
    for (int kk0 = 0; kk0 < nkeys; kk0 += 8) {
        float s[8];
#pragma unroll
        for (int j = 0; j < 8; ++j) {
            const u32x4* kp = (const u32x4*)(Kp + (size_t)(kk0 + j) * ldkv + part * 32);
            float acc = 0.f;
#pragma unroll
            for (int w = 0; w < 4; ++w) { float kf[8]; unpack8(kp[w], kf);
#pragma unroll
                for (int e = 0; e < 8; ++e) acc = fmaf(q[8 * w + e], kf[e], acc); }
            acc += __shfl_xor(acc, 1); acc += __shfl_xor(acc, 2);
            if (bias_h) { int dist = qi + koff - (kk0 + j); dist = dist < -128 ? -128 : (dist > 128 ? 128 : dist); acc += bias_h[dist + 128]; }
            s[j] = acc;
        }
        float mx = s[0];
#pragma unroll
        for (int j = 1; j < 8; ++j) mx = fmaxf(mx, s[j]);
        const float mn = fmaxf(m, mx), corr = __expf(m - mn);
        l *= corr;
#pragma unroll
        for (int d = 0; d < 32; ++d) o[d] *= corr;
#pragma unroll
        for (int j = 0; j < 8; ++j) {
            const float pj = __expf(s[j] - mn); l += pj;
            const u32x4* vp = (const u32x4*)(Vp + (size_t)(kk0 + j) * ldkv + part * 32);
#pragma unroll
            for (int w = 0; w < 4; ++w) { float vf[8]; unpack8(vp[w], vf);
#pragma unroll
                for (int e = 0; e < 8; ++e) o[8 * w + e] = fmaf(pj, vf[e], o[8 * w + e]); }
        }
        m = mn;
    }
    const float inv = 1.f / l;
    u32x4* op = (u32x4*)(Op + (size_t)qi * ldo + part * 32);
#pragma unroll
    for (int w = 0; w < 4; ++w) { u32x4 ov; ov.x = pk2(o[8 * w] * inv, o[8 * w + 1] * inv); ov.y = pk2(o[8 * w + 2] * inv, o[8 * w + 3] * inv); ov.z = pk2(o[8 * w + 4] * inv, o[8 * w + 5] * inv); ov.w = pk2(o[8 * w + 6] * inv, o[8 * w + 7] * inv); op[w] = ov; }
}

__device__ __forceinline__ void gemm_branch(const bf16_t* __restrict__ Ob, const bf16_t* __restrict__ WT, const bf16_t* __restrict__ G, bf16_t* __restrict__ Mg, int gw, int NW, int lane) {
    const int r = lane & 15, q = lane >> 4;
    const int ntn = D / 32, ntiles = (T / 32) * ntn;
    for (int tile = gw; tile < ntiles; tile += NW) {
        const int tm = tile / ntn, tn = tile % ntn;
        f32x4 acc[3][2][2];
#pragma unroll
        for (int s = 0; s < 3; ++s)
#pragma unroll
            for (int i = 0; i < 2; ++i)
#pragma unroll
                for (int j = 0; j < 2; ++j) acc[s][i][j] = (f32x4){0.f, 0.f, 0.f, 0.f};
        const bf16_t* ap = Ob + (size_t)(tm * 32 + r) * D + q * 8;
        const bf16_t* bp = WT + (size_t)(tn * 32 + r) * D + q * 8;
#pragma unroll
        for (int s = 0; s < 3; ++s) {
            const int kb = s == 0 ? 0 : (s == 1 ? 1024 : 1536), ke = s == 0 ? 1024 : (s == 1 ? 1536 : 2048);
            for (int k0 = kb; k0 < ke; k0 += 32) {
                bf16x8 af[2], bfr[2];
#pragma unroll
                for (int i = 0; i < 2; ++i) af[i] = *(const bf16x8*)(ap + (size_t)i * 16 * D + k0);
#pragma unroll
                for (int j = 0; j < 2; ++j) bfr[j] = *(const bf16x8*)(bp + (size_t)j * 16 * D + k0);
#pragma unroll
                for (int i = 0; i < 2; ++i)
#pragma unroll
                    for (int j = 0; j < 2; ++j) acc[s][i][j] = __builtin_amdgcn_mfma_f32_16x16x32_bf16(af[i], bfr[j], acc[s][i][j], 0, 0, 0);
            }
        }
#pragma unroll
        for (int i = 0; i < 2; ++i)
#pragma unroll
            for (int j = 0; j < 2; ++j)
#pragma unroll
                for (int e = 0; e < 4; ++e) {
                    const int row = tm * 32 + i * 16 + q * 4 + e, col = tn * 32 + j * 16 + r;
                    const bf16_t* gp = G + (size_t)row * GW + col;
                    const float mval = bf2f(gp[0]) * acc[0][i][j][e] + bf2f(gp[2048]) * acc[1][i][j][e] + bf2f(gp[4096]) * acc[2][i][j][e];
                    Mg[(size_t)row * D + col] = (bf16_t)f2bf(mval);
                }
    }
}

__device__ __forceinline__ unsigned long long shfl_xor64(unsigned long long v, int m) {
    const unsigned lo = __shfl_xor((unsigned)v, m), hi = __shfl_xor((unsigned)(v >> 32), m);
    return ((unsigned long long)hi << 32) | lo;
}
__device__ __forceinline__ unsigned fkey(float f) { const unsigned u = __float_as_uint(f); return (u & 0x80000000u) ? ~u : (u | 0x80000000u); }
__device__ __forceinline__ float fkey_inv(unsigned k) { const unsigned u = (k & 0x80000000u) ? (k & 0x7fffffffu) : ~k; return __uint_as_float(u); }
__device__ __forceinline__ unsigned long long wave_max64(unsigned long long k) {
#pragma unroll
    for (int o = 1; o < 64; o <<= 1) { const unsigned long long t = shfl_xor64(k, o); k = t > k ? t : k; }
    return k;
}
__device__ __forceinline__ void route_unit(const Params& p, int t, int h, int lane) {
    const bf16_t* Q = (const bf16_t*)(p.ws + WS_Q); const bf16_t* KB = (const bf16_t*)(p.ws + WS_KEYSB);
    int* RIDX = (int*)(p.ws + WS_RIDX); float* RG = (float*)(p.ws + WS_RG);
    float sv_l[2] = {0.f, 0.f}; int si_l[2] = {0, 0};
#pragma unroll
    for (int c = 0; c < 2; ++c) {
        const bf16_t* qv = Q + (size_t)t * D + h * 256 + c * 128;
        const unsigned qw = ((const unsigned*)qv)[lane];
        const float qa = bf2f(qw & 0xffffu), qb = bf2f(qw >> 16);
        const bf16_t* k0p = KB + ((size_t)(h * 2 + c) * NKEYS + lane) * 128;
        const bf16_t* k1p = k0p + 64 * 128;
        float s0 = 0.f, s1 = 0.f;
#pragma unroll
        for (int w = 0; w < 16; ++w) {
            float k0f[8], k1f[8]; unpack8(((const u32x4*)k0p)[w], k0f); unpack8(((const u32x4*)k1p)[w], k1f);
#pragma unroll
            for (int e = 0; e < 8; e += 2) {
                const int src = 4 * w + e / 2;
                const float xa = __int_as_float(__builtin_amdgcn_readlane(__float_as_int(qa), src));
                const float xb = __int_as_float(__builtin_amdgcn_readlane(__float_as_int(qb), src));
                s0 = fmaf(xa, k0f[e], s0); s0 = fmaf(xb, k0f[e + 1], s0);
                s1 = fmaf(xa, k1f[e], s1); s1 = fmaf(xb, k1f[e + 1], s1);
            }
        }
        unsigned long long ka = ((unsigned long long)fkey(s0) << 32) | (unsigned)(255 - lane);
        unsigned long long kb = ((unsigned long long)fkey(s1) << 32) | (unsigned)(255 - (lane + 64));
        for (int rnd = 0; rnd < TOPK; ++rnd) {
            const unsigned long long best = wave_max64(ka > kb ? ka : kb);
            if (ka == best) ka = 0ull; if (kb == best) kb = 0ull;
            if (lane == rnd) { sv_l[c] = fkey_inv((unsigned)(best >> 32)); si_l[c] = 255 - (int)(best & 0xffffffffu); }
        }
    }
    unsigned long long kc[4];
#pragma unroll
    for (int m = 0; m < 4; ++m) { const int cid = lane + 64 * m, i = cid >> 4, j = cid & 15;
        const float v = __shfl(sv_l[0], i) + __shfl(sv_l[1], j);
        kc[m] = ((unsigned long long)fkey(v) << 32) | (unsigned)(1023 - cid); }
    float fv = 0.f; int cidx = 0;
    for (int rnd = 0; rnd < TOPK; ++rnd) {
        unsigned long long loc = kc[0] > kc[1] ? kc[0] : kc[1]; const unsigned long long loc2 = kc[2] > kc[3] ? kc[2] : kc[3]; loc = loc > loc2 ? loc : loc2;
        const unsigned long long best = wave_max64(loc);
#pragma unroll
        for (int m = 0; m < 4; ++m) if (kc[m] == best) kc[m] = 0ull;
        if (lane == rnd) { fv = fkey_inv((unsigned)(best >> 32)); cidx = 1023 - (int)(best & 0xffffffffu); }
    }
    const float fmax_ = __shfl(fv, 0);
    float e = lane < 16 ? __expf(fv - fmax_) : 0.f;
    float ssum = e;
#pragma unroll
    for (int o = 1; o < 16; o <<= 1) ssum += __shfl_xor(ssum, o);
    const int ci = cidx >> 4, cj = cidx & 15;
    const int e0 = __shfl(si_l[0], ci), e1 = __shfl(si_l[1], cj);
    if (lane < 16) { RIDX[(size_t)t * 128 + h * 16 + lane] = e0 * NKEYS + e1; RG[(size_t)t * 128 + h * 16 + lane] = e / ssum; }
}

typedef float f32x2 __attribute__((ext_vector_type(2)));
__device__ __forceinline__ void fp4_row(const float* __restrict__ src, const float* __restrict__ kscale, unsigned char* __restrict__ dst, float* __restrict__ scale_out, int lane) {
    f32x4 v[8]; float mx = 0.f;
#pragma unroll
    for (int j = 0; j < 8; ++j) { v[j] = ((const f32x4*)src)[64 * j + lane];
        if (kscale) v[j] = v[j] * ((const f32x4*)kscale)[64 * j + lane];
        mx = fmaxf(mx, fmaxf(fmaxf(fabsf(v[j].x), fabsf(v[j].y)), fmaxf(fabsf(v[j].z), fabsf(v[j].w)))); }
#pragma unroll
    for (int o = 1; o < 64; o <<= 1) mx = fmaxf(mx, __shfl_xor(mx, o));
    const float sc = mx > 0.f ? mx * (1.f / 6.f) : 1.f, inv = 1.f / sc;
    u32x4 out;
#pragma unroll
    for (int w = 0; w < 4; ++w) {
        const f32x4 a = v[2 * w] * inv, b = v[2 * w + 1] * inv;
        unsigned pk = 0u;
        pk = __builtin_amdgcn_cvt_scalef32_pk_fp4_f32(pk, fminf(fmaxf(a.x, -6.f), 6.f), fminf(fmaxf(a.y, -6.f), 6.f), 1.0f, 0);
        pk = __builtin_amdgcn_cvt_scalef32_pk_fp4_f32(pk, fminf(fmaxf(a.z, -6.f), 6.f), fminf(fmaxf(a.w, -6.f), 6.f), 1.0f, 1);
        pk = __builtin_amdgcn_cvt_scalef32_pk_fp4_f32(pk, fminf(fmaxf(b.x, -6.f), 6.f), fminf(fmaxf(b.y, -6.f), 6.f), 1.0f, 2);
        pk = __builtin_amdgcn_cvt_scalef32_pk_fp4_f32(pk, fminf(fmaxf(b.z, -6.f), 6.f), fminf(fmaxf(b.w, -6.f), 6.f), 1.0f, 3);
        out[w] = pk;
    }
    ((u32x4*)dst)[lane] = out;
    if (lane == 0) *scale_out = sc;
}
struct RowB8 { u32x4 w[8]; };
__device__ __forceinline__ void peer_load_batch(RowB8& buf, const unsigned char* tab, int isel, int pbase, int lane) {
#pragma unroll
    for (int r = 0; r < 8; ++r) { const int e = __builtin_amdgcn_readlane(isel, (pbase + r) & 63);
        buf.w[r] = *(const u32x4*)(tab + (size_t)e * 1024 + lane * 16); }
}
__device__ __forceinline__ float dot_row(const u32x4 w, const float (&xf)[32]) {
    float a0 = 0.f, a1 = 0.f;
#pragma unroll
    for (int q = 0; q < 4; ++q) {
        const f32x2 a = __builtin_amdgcn_cvt_scalef32_pk_f32_fp4(w[q], 1.0f, 0), b = __builtin_amdgcn_cvt_scalef32_pk_f32_fp4(w[q], 1.0f, 1);
        const f32x2 c = __builtin_amdgcn_cvt_scalef32_pk_f32_fp4(w[q], 1.0f, 2), d = __builtin_amdgcn_cvt_scalef32_pk_f32_fp4(w[q], 1.0f, 3);
        a0 = fmaf(a.x, xf[8 * q], a0); a1 = fmaf(a.y, xf[8 * q + 1], a1); a0 = fmaf(b.x, xf[8 * q + 2], a0); a1 = fmaf(b.y, xf[8 * q + 3], a1);
        a0 = fmaf(c.x, xf[8 * q + 4], a0); a1 = fmaf(c.y, xf[8 * q + 5], a1); a0 = fmaf(d.x, xf[8 * q + 6], a0); a1 = fmaf(d.y, xf[8 * q + 7], a1);
    }
    return a0 + a1;
}
__device__ __forceinline__ void axpy_row(const u32x4 w, const float a_, float (&of)[32]) {
#pragma unroll
    for (int q = 0; q < 4; ++q) {
        const f32x2 a = __builtin_amdgcn_cvt_scalef32_pk_f32_fp4(w[q], 1.0f, 0), b = __builtin_amdgcn_cvt_scalef32_pk_f32_fp4(w[q], 1.0f, 1);
        const f32x2 c = __builtin_amdgcn_cvt_scalef32_pk_f32_fp4(w[q], 1.0f, 2), d = __builtin_amdgcn_cvt_scalef32_pk_f32_fp4(w[q], 1.0f, 3);
        of[8 * q] = fmaf(a_, a.x, of[8 * q]); of[8 * q + 1] = fmaf(a_, a.y, of[8 * q + 1]); of[8 * q + 2] = fmaf(a_, b.x, of[8 * q + 2]); of[8 * q + 3] = fmaf(a_, b.y, of[8 * q + 3]);
        of[8 * q + 4] = fmaf(a_, c.x, of[8 * q + 4]); of[8 * q + 5] = fmaf(a_, c.y, of[8 * q + 5]); of[8 * q + 6] = fmaf(a_, d.x, of[8 * q + 6]); of[8 * q + 7] = fmaf(a_, d.y, of[8 * q + 7]);
    }
}
__device__ __forceinline__ void peer_token(const Params& p, int t, int lane, LAS float* actL) {
    const bf16_t* XB = (const bf16_t*)(p.ws + WS_X2BF); const unsigned char* TU = p.ws + WS_TABU; const unsigned char* TV = p.ws + WS_TABV;
    const float* SCU = (const float*)(p.ws + WS_SCU); const float* SCV = (const float*)(p.ws + WS_SCV);
    const int* RIDX = (const int*)(p.ws + WS_RIDX); const float* RG = (const float*)(p.ws + WS_RG); const float* SS2 = (const float*)(p.ws + WS_CTL + CTL_SS2_BYTE);
    float xf[32];
#pragma unroll
    for (int j = 0; j < 8; ++j) { const u32x2 w = *(const u32x2*)(XB + (size_t)t * D + 256 * j + 4 * lane);
        xf[4 * j] = __uint_as_float(w.x << 16); xf[4 * j + 1] = __uint_as_float(w.x & 0xffff0000u); xf[4 * j + 2] = __uint_as_float(w.y << 16); xf[4 * j + 3] = __uint_as_float(w.y & 0xffff0000u); }
    const float rs = rsqrtf(SS2[t] * (1.f / D) + EPS);
    const int i0 = RIDX[(size_t)t * 128 + lane], i1 = RIDX[(size_t)t * 128 + 64 + lane];
    const float su0 = SCU[i0] * rs, su1 = SCU[i1] * rs;
    const float gv0 = RG[(size_t)t * 128 + lane] * SCV[i0], gv1 = RG[(size_t)t * 128 + 64 + lane] * SCV[i1];
    RowB8 A, B;
    const int rl = 4 * ((lane >> 5) & 1) + 2 * ((lane >> 4) & 1) + ((lane >> 3) & 1);
#define PEER_DOT(buf, pb) do { float d[8]; \
        _Pragma("unroll") for (int r = 0; r < 8; ++r) { u32x4 w_ = buf.w[r]; asm volatile("" : "+v"(w_)); d[r] = dot_row(w_, xf); asm volatile("" : "+v"(d[r])); } \
        const bool u5 = (lane & 32) != 0; float k4[4]; \
        _Pragma("unroll") for (int q = 0; q < 4; ++q) k4[q] = (u5 ? d[4 + q] : d[q]) + __shfl_xor(u5 ? d[q] : d[4 + q], 32); \
        const bool u4 = (lane & 16) != 0; float k2[2]; \
        _Pragma("unroll") for (int q = 0; q < 2; ++q) k2[q] = (u4 ? k4[2 + q] : k4[q]) + __shfl_xor(u4 ? k4[q] : k4[2 + q], 16); \
        const bool u3 = (lane & 8) != 0; \
        float v = (u3 ? k2[1] : k2[0]) + __shfl_xor(u3 ? k2[0] : k2[1], 8); \
        v += __shfl_xor(v, 4); v += __shfl_xor(v, 2); v += __shfl_xor(v, 1); \
        const int pi = (pb) + rl; const float su = __shfl(pi < 64 ? su0 : su1, pi & 63), gv = __shfl(pi < 64 ? gv0 : gv1, pi & 63); \
        if ((lane & 7) == 0) actL[pi] = gelu_tanh(v * su) * gv; } while (0)
    peer_load_batch(A, TU, i0, 0, lane);
#pragma unroll 1
    for (int b = 0; b < 16; b += 2) {
        peer_load_batch(B, TU, b < 8 ? i0 : i1, 8 * (b + 1), lane);
        PEER_DOT(A, 8 * b);
        if (b + 2 < 16) peer_load_batch(A, TU, (b + 2) < 8 ? i0 : i1, 8 * (b + 2), lane);
        PEER_DOT(B, 8 * (b + 1));
    }
#undef PEER_DOT
    float of[32];
#pragma unroll
    for (int q = 0; q < 32; ++q) of[q] = 0.f;
#define PIN_OF() do { asm volatile("" : "+v"(of[0]), "+v"(of[1]), "+v"(of[2]), "+v"(of[3]), "+v"(of[4]), "+v"(of[5]), "+v"(of[6]), "+v"(of[7]), "+v"(of[8]), "+v"(of[9]), "+v"(of[10]), "+v"(of[11]), "+v"(of[12]), "+v"(of[13]), "+v"(of[14]), "+v"(of[15])); \
        asm volatile("" : "+v"(of[16]), "+v"(of[17]), "+v"(of[18]), "+v"(of[19]), "+v"(of[20]), "+v"(of[21]), "+v"(of[22]), "+v"(of[23]), "+v"(of[24]), "+v"(of[25]), "+v"(of[26]), "+v"(of[27]), "+v"(of[28]), "+v"(of[29]), "+v"(of[30]), "+v"(of[31])); } while (0)
#define PEER_AXPY(buf, pb) do { \
        _Pragma("unroll") for (int r = 0; r < 8; ++r) { const float a = actL[(pb) + r]; u32x4 w_ = buf.w[r]; asm volatile("" : "+v"(w_)); axpy_row(w_, a, of); PIN_OF(); } } while (0)
    peer_load_batch(A, TV, i0, 0, lane);
#pragma unroll 1
    for (int b = 0; b < 16; b += 2) {
        peer_load_batch(B, TV, b < 8 ? i0 : i1, 8 * (b + 1), lane);
        PEER_AXPY(A, 8 * b);
        if (b + 2 < 16) peer_load_batch(A, TV, (b + 2) < 8 ? i0 : i1, 8 * (b + 2), lane);
        PEER_AXPY(B, 8 * (b + 1));
    }
#undef PEER_AXPY
#undef PIN_OF
    float* orow = p.out + (size_t)t * D;
#pragma unroll
    for (int j = 0; j < 8; ++j) { f32x4* o4 = (f32x4*)(orow + 256 * j + 4 * lane); f32x4 a = *o4;
        a.x += of[4 * j]; a.y += of[4 * j + 1]; a.z += of[4 * j + 2]; a.w += of[4 * j + 3]; *o4 = a; }
}

namespace pg8 {
#define PG8_LAS __attribute__((address_space(3)))
constexpr int BM = 256, BK = 64, HALF = 128, HTB = HALF * BK * 2, STAGE_BYTES = 8 * HTB, NXCD = 8, WGM = 8;
__host__ __device__ __forceinline__ int lds_byte(int r, int c) { const int st = (r >> 4) * 2 + (c >> 5), rr = r & 15, cc = c & 31, ob = rr * 64 + cc * 2; return st * 1024 + (ob ^ (((ob >> 9) & 1) << 5)); }
__host__ __device__ __forceinline__ void stage_rc(int b, int& R, int& C) { const int st = b / 1024, sb = b % 1024, swz = sb ^ (((sb >> 9) & 1) << 5); R = (st >> 1) * 16 + swz / 64; C = (st & 1) * 32 + (swz % 64) / 2; }
__host__ __device__ __forceinline__ int perm32(int rho) { const int n = rho >> 4, i = rho & 15; return 8 * (i >> 2) + 4 * n + (i & 3); }
struct Unit { const char* A; const char* B; int pm, pn, kind, nt; };
__device__ __forceinline__ const char* uni_ptr(const char* p) { const unsigned long long v = (unsigned long long)p; const unsigned lo = __builtin_amdgcn_readfirstlane((unsigned)v), hi = __builtin_amdgcn_readfirstlane((unsigned)(v >> 32)); return (const char*)(((unsigned long long)hi << 32) | lo); }
__device__ __forceinline__ void uni(Unit& u) { u.A = uni_ptr(u.A); u.B = uni_ptr(u.B); u.pm = __builtin_amdgcn_readfirstlane(u.pm); u.pn = __builtin_amdgcn_readfirstlane(u.pn); u.kind = __builtin_amdgcn_readfirstlane(u.kind); u.nt = __builtin_amdgcn_readfirstlane(u.nt); }
__device__ __forceinline__ void tile_of(int L, int nM, int nN, int& pm, int& pn) {
    const int nwg = nM * nN; int wgid = L; { const int q = nwg / NXCD, r = nwg % NXCD, xcd = wgid % NXCD, off = wgid / NXCD; wgid = (xcd < r ? xcd * (q + 1) : r * (q + 1) + (xcd - r) * q) + off; }
    const int nig = WGM * nN, gid = wgid / nig, fm = gid * WGM, gsz = (nM - fm) < WGM ? (nM - fm) : WGM;
    pm = fm + ((wgid % nig) % gsz); pn = (wgid % nig) / gsz;
}
template <class Epi, class Sched>
__device__ __forceinline__ void gemm_phase(PG8_LAS unsigned char* lds, const int lda, const int ldb, const Sched& S, const Epi& E) {
    const int tid = threadIdx.x, wid = __builtin_amdgcn_readfirstlane(tid >> 6), lane = tid & 63, wr = wid >> 2, wc = wid & 3, fr = lane & 15, fq = lane >> 4;
    unsigned voffA[2], voffB[2];
#pragma unroll
    for (int i = 0; i < 2; ++i) { int R, C; stage_rc(tid * 16 + i * 8192, R, C); const int Rb = (R & ~31) + perm32(R & 31);
        voffA[i] = (unsigned)(R * lda + C) * 2u; voffB[i] = (unsigned)(Rb * ldb + C) * 2u; }
    const size_t kstep = (size_t)(BK * 2);
    const size_t hstepA = (size_t)HALF * lda * 2, hstepB = (size_t)HALF * ldb * 2;
    const unsigned ldsw = (unsigned)wid * 1024u;
    const int aoff = lds_byte(wr * 64 + fr, fq * 8), boff = lds_byte(wc * 32 + fr, fq * 8);
#define PG8_SA(b, h) (((b) * 2 + (h)) * HTB)
#define PG8_SB(b, h) ((4 + (b) * 2 + (h)) * HTB)
#define PG8_STAGE(bufoff, gbase, voff) do { _Pragma("unroll") for (int _i = 0; _i < 2; ++_i) \
        __builtin_amdgcn_global_load_lds((const unsigned*)((const char*)(gbase) + (voff)[_i]), (PG8_LAS unsigned*)(lds + (bufoff) + ldsw + _i * 8192), 16, 0, 0); } while (0)
#define PG8_LDA(dst, b, h) do { _Pragma("unroll") for (int m = 0; m < 4; ++m) _Pragma("unroll") for (int k = 0; k < 2; ++k) dst[m][k] = *(const PG8_LAS bf16x8*)(lds + PG8_SA(b, h) + aoff + m * 2048 + k * 1024); } while (0)
#define PG8_LDB(dst, b, h) do { _Pragma("unroll") for (int n = 0; n < 2; ++n) _Pragma("unroll") for (int k = 0; k < 2; ++k) dst[n][k] = *(const PG8_LAS bf16x8*)(lds + PG8_SB(b, h) + boff + n * 2048 + k * 1024); } while (0)
#define PG8_MMA(ai, bj, At, Bt) do { __builtin_amdgcn_s_setprio(1); _Pragma("unroll") for (int m = 0; m < 4; ++m) _Pragma("unroll") for (int n = 0; n < 2; ++n) _Pragma("unroll") for (int k = 0; k < 2; ++k) \
        acc[ai][bj][m][n] = __builtin_amdgcn_mfma_f32_16x16x32_bf16(Bt[n][k], At[m][k], acc[ai][bj][m][n], 0, 0, 0); __builtin_amdgcn_s_setprio(0); } while (0)
#define PG8_WAIT_V(n) asm volatile("s_waitcnt vmcnt(" #n ")" ::: "memory")
#define PG8_WAIT_L(n) asm volatile("s_waitcnt lgkmcnt(" #n ")" ::: "memory")
#define PG8_BAR __builtin_amdgcn_s_barrier()
#define PG8_SCHED __builtin_amdgcn_sched_barrier(0)
    Unit cur, nxt; int ui = 0;
    if (!S.next(0, cur)) return;
    f32x4 acc[2][2][4][2];
#pragma unroll
    for (int a = 0; a < 2; ++a)
#pragma unroll
        for (int b = 0; b < 2; ++b)
#pragma unroll
            for (int m = 0; m < 4; ++m)
#pragma unroll
                for (int n = 0; n < 2; ++n) acc[a][b][m][n] = (f32x4){0.f, 0.f, 0.f, 0.f};
    bf16x8 At[4][2], B0[2][2], B1[2][2];
    const char* cA = cur.A; const char* cB = cur.B;
    PG8_STAGE(PG8_SB(0, 0), cB, voffB); PG8_STAGE(PG8_SB(0, 1), cB + hstepB, voffB); PG8_STAGE(PG8_SA(0, 0), cA, voffA); PG8_STAGE(PG8_SA(0, 1), cA + hstepA, voffA);
    if (wr == 1) PG8_BAR;
    PG8_WAIT_V(2); PG8_BAR;
    PG8_STAGE(PG8_SB(1, 0), cB + kstep, voffB); PG8_STAGE(PG8_SA(1, 0), cA + kstep, voffA); PG8_STAGE(PG8_SB(1, 1), cB + hstepB + kstep, voffB);
    PG8_WAIT_V(6); PG8_BAR;
    for (;;) {
        const bool has_next = S.next(ui + 1, nxt);
        const char* nA = has_next ? nxt.A : cA; const char* nB = has_next ? nxt.B : cB;
        const int nt = cur.nt;
        for (int t = 0; t < nt; t += 2) {
            const bool last = (t == nt - 2);
            const char* a1 = cA + (size_t)(t + 1) * kstep;
            const char* a2 = last ? nA : cA + (size_t)(t + 2) * kstep; const char* b2 = last ? nB : cB + (size_t)(t + 2) * kstep;
            const char* a3 = a2 + kstep; const char* b3 = b2 + kstep;
            PG8_LDB(B0, 0, 0); PG8_LDB(B1, 0, 1); PG8_SCHED; PG8_LDA(At, 0, 0); PG8_STAGE(PG8_SA(1, 1), a1 + hstepA, voffA);
            PG8_WAIT_V(8); PG8_WAIT_L(0); PG8_BAR; PG8_MMA(0, 0, At, B0); PG8_MMA(0, 1, At, B1); PG8_BAR; PG8_SCHED;
            PG8_LDA(At, 0, 1); PG8_STAGE(PG8_SB(0, 0), b2, voffB); PG8_STAGE(PG8_SB(0, 1), b2 + hstepB, voffB); PG8_STAGE(PG8_SA(0, 0), a2, voffA);
            PG8_WAIT_V(8); PG8_WAIT_L(0); PG8_BAR; PG8_MMA(1, 0, At, B0); PG8_MMA(1, 1, At, B1); PG8_BAR; PG8_SCHED;
            PG8_LDB(B0, 1, 0); PG8_LDB(B1, 1, 1); PG8_SCHED; PG8_LDA(At, 1, 0); PG8_STAGE(PG8_SA(0, 1), a2 + hstepA, voffA);
            PG8_WAIT_V(8); PG8_WAIT_L(0); PG8_BAR; PG8_MMA(0, 0, At, B0); PG8_MMA(0, 1, At, B1); PG8_BAR; PG8_SCHED;
            PG8_LDA(At, 1, 1); PG8_STAGE(PG8_SB(1, 0), b3, voffB); PG8_STAGE(PG8_SB(1, 1), b3 + hstepB, voffB); PG8_STAGE(PG8_SA(1, 0), a3, voffA);
            PG8_WAIT_V(8); PG8_WAIT_L(0); PG8_BAR; PG8_MMA(1, 0, At, B0); PG8_MMA(1, 1, At, B1); PG8_BAR; PG8_SCHED;
        }
        if (wr == 0) PG8_BAR;
        E(acc, cur, wr, wc, fr, fq);
        if (!has_next) break;
        if (E.reset(cur)) {
#pragma unroll
        for (int a = 0; a < 2; ++a)
#pragma unroll
            for (int b = 0; b < 2; ++b)
#pragma unroll
                for (int m = 0; m < 4; ++m)
#pragma unroll
                    for (int n = 0; n < 2; ++n) acc[a][b][m][n] = (f32x4){0.f, 0.f, 0.f, 0.f};
        }
        cur = nxt; cA = nA; cB = nB; ++ui;
        if (wr == 1) PG8_BAR;
    }
    PG8_WAIT_V(0);
    PG8_BAR;
#undef PG8_SA
#undef PG8_SB
#undef PG8_STAGE
#undef PG8_LDA
#undef PG8_LDB
#undef PG8_MMA
#undef PG8_WAIT_V
#undef PG8_WAIT_L
#undef PG8_BAR
#undef PG8_SCHED
}
}
typedef f32x4 AccT[2][2][4][2];
#define EPI_RESET_ALWAYS __device__ __forceinline__ bool reset(const pg8::Unit&) const { return true; }
__device__ __forceinline__ unsigned cvt_pk_bf16(float lo, float hi) { unsigned r; asm volatile("v_cvt_pk_bf16_f32 %0, %1, %2" : "=v"(r) : "v"(lo), "v"(hi)); return r; }
__device__ __forceinline__ u32x4 pack8(const f32x4 v0, const f32x4 v1) { u32x4 w; w.x = cvt_pk_bf16(v0[0], v0[1]); w.y = cvt_pk_bf16(v0[2], v0[3]); w.z = cvt_pk_bf16(v1[0], v1[1]); w.w = cvt_pk_bf16(v1[2], v1[3]); return w; }
template <int MODE>
__device__ __forceinline__ void store_tile_bf16(const AccT& acc, bf16_t* base, int ldc, int row0, int col0, const float* bias) {
    f32x4 bv[2][2];
#pragma unroll
    for (int bj = 0; bj < 2; ++bj)
#pragma unroll
        for (int n = 0; n < 2; ++n) bv[bj][n] = (MODE == 2) ? *(const f32x4*)(bias + col0 + bj * 128 + 4 * n) : (f32x4){0.f, 0.f, 0.f, 0.f};
#pragma unroll
    for (int ai = 0; ai < 2; ++ai)
#pragma unroll
        for (int m = 0; m < 4; ++m) { bf16_t* rowp = base + (size_t)(row0 + ai * 128 + m * 16) * ldc + col0;
#pragma unroll
            for (int bj = 0; bj < 2; ++bj) { f32x4 v0 = acc[ai][bj][m][0], v1 = acc[ai][bj][m][1];
                if (MODE == 1) { _Pragma("unroll") for (int e = 0; e < 4; ++e) { v0[e] = gelu_tanh(v0[e]); v1[e] = gelu_tanh(v1[e]); } }
                if (MODE == 2) { v0 = v0 + bv[bj][0]; v1 = v1 + bv[bj][1]; _Pragma("unroll") for (int e = 0; e < 4; ++e) { v0[e] = sigmoid_(v0[e]); v1[e] = sigmoid_(v1[e]); } }
                *(u32x4*)(rowp + bj * 128) = pack8(v0, v1); } }
}
struct SchedP1 { const char* H; const char* WT; const char* MEMN; const char* WTM; int G, c;
    __device__ __forceinline__ bool next(int i, pg8::Unit& u) const {
        const int L = i * G + c; const int n1 = 64 * 42;
        if (L < n1) { pg8::tile_of(L, 64, 42, u.pm, u.pn); u.kind = 0; u.A = H + (size_t)u.pm * 256 * D * 2; u.B = WT + (size_t)u.pn * 256 * D * 2; u.nt = D / 64; pg8::uni(u); return true; }
        if (L < n1 + 8) { const int j = L - n1; u.pm = j >> 2; u.pn = j & 3; u.kind = 1; u.A = MEMN + (size_t)u.pm * 256 * D * 2; u.B = WTM + (size_t)u.pn * 256 * D * 2; u.nt = D / 64; pg8::uni(u); return true; }
        return false; } };
struct EpiP1 { bf16_t* PROJ; bf16_t* G; bf16_t* MEMKV; const float* bgate; EPI_RESET_ALWAYS
    __device__ __forceinline__ void operator()(AccT& acc, const pg8::Unit& u, int wr, int wc, int fr, int fq) const {
        const int row0 = u.pm * 256 + wr * 64 + fr, cl = wc * 32 + 8 * fq;
        if (u.kind == 1) { store_tile_bf16<0>(acc, MEMKV, 2 * CW, row0, u.pn * 256 + cl, nullptr); return; }
        if (u.pn >= 18) { store_tile_bf16<2>(acc, G, GW, row0, (u.pn - 18) * 256 + cl, bgate); return; }
        if (u.pn == 14 || u.pn == 15) { store_tile_bf16<1>(acc, PROJ, INW, row0, u.pn * 256 + cl, nullptr); return; }
        store_tile_bf16<0>(acc, PROJ, INW, row0, u.pn * 256 + cl, nullptr);
    } };
struct SchedP3 { const char* O; const char* WT; int G, c;
    __device__ __forceinline__ bool next(int i, pg8::Unit& u) const {
        const int ti = i / 3, seg = i - 3 * ti; const int L = ti * G + c; if (L >= 64 * 8) return false;
        pg8::tile_of(L, 64, 8, u.pm, u.pn); u.kind = seg;
        const int kb = seg == 0 ? 0 : (seg == 1 ? 1024 : 1536);
        u.A = O + ((size_t)u.pm * 256 * D + kb) * 2; u.B = WT + ((size_t)u.pn * 256 * D + kb) * 2; u.nt = seg == 0 ? 16 : 8; pg8::uni(u); return true; } };
struct EpiP3 { const bf16_t* G; bf16_t* MERGED;
    __device__ __forceinline__ bool reset(const pg8::Unit& u) const { return u.kind == 2; }
    __device__ __forceinline__ void operator()(AccT& acc, const pg8::Unit& u, int wr, int wc, int fr, int fq) const {
        const int row0 = u.pm * 256 + wr * 64 + fr, col0 = u.pn * 256 + wc * 32 + 8 * fq, seg = u.kind;
#pragma unroll
        for (int ai = 0; ai < 2; ++ai)
#pragma unroll
            for (int mh = 0; mh < 2; ++mh) {
                u32x4 ga[2][2], gb[2][2];
#pragma unroll
                for (int mm = 0; mm < 2; ++mm)
#pragma unroll
                    for (int bj = 0; bj < 2; ++bj) { const bf16_t* gp = G + (size_t)(row0 + ai * 128 + (mh * 2 + mm) * 16) * GW + col0 + bj * 128;
                        ga[mm][bj] = *(const u32x4*)(gp + seg * D); gb[mm][bj] = (seg < 2) ? *(const u32x4*)(gp + (seg + 1) * D) : (u32x4){0u, 0u, 0u, 0u}; }
#pragma unroll
                for (int mm = 0; mm < 2; ++mm)
#pragma unroll
                    for (int bj = 0; bj < 2; ++bj) { const int m = mh * 2 + mm;
                        float fa[8], fb[8]; unpack8(ga[mm][bj], fa); unpack8(gb[mm][bj], fb);
                        if (seg < 2) { _Pragma("unroll") for (int e = 0; e < 8; ++e) fa[e] = fa[e] * __builtin_amdgcn_rcpf(fmaxf(fb[e], 1e-20f)); }
                        f32x4& v0 = acc[ai][bj][m][0]; f32x4& v1 = acc[ai][bj][m][1];
                        v0[0] *= fa[0]; v0[1] *= fa[1]; v0[2] *= fa[2]; v0[3] *= fa[3]; v1[0] *= fa[4]; v1[1] *= fa[5]; v1[2] *= fa[6]; v1[3] *= fa[7];
                        if (seg == 2) *(u32x4*)(MERGED + (size_t)(row0 + ai * 128 + m * 16) * D + col0 + bj * 128) = pack8(v0, v1);
                    }
                asm volatile("" ::: "memory");
            }
    } };
struct SchedSq { const char* A; const char* WT; int G, c;
    __device__ __forceinline__ bool next(int i, pg8::Unit& u) const {
        const int L = i * G + c; if (L >= 64 * 8) return false;
        pg8::tile_of(L, 64, 8, u.pm, u.pn); u.kind = 0; u.A = A + (size_t)u.pm * 256 * D * 2; u.B = WT + (size_t)u.pn * 256 * D * 2; u.nt = D / 64; pg8::uni(u); return true; } };
struct EpiP4 { const float* x; float* out; bf16_t* xb; float* ss; EPI_RESET_ALWAYS
    __device__ __forceinline__ void operator()(AccT& acc, const pg8::Unit& u, int wr, int wc, int fr, int fq) const {
        const int row0 = u.pm * 256 + wr * 64 + fr, col0 = u.pn * 256 + wc * 32 + 8 * fq;
#pragma unroll
        for (int ai = 0; ai < 2; ++ai)
#pragma unroll
            for (int m = 0; m < 4; ++m) { const size_t row = (size_t)(row0 + ai * 128 + m * 16); float sq = 0.f;
#pragma unroll
                for (int bj = 0; bj < 2; ++bj) { const size_t o = row * D + col0 + bj * 128;
                    const f32x4 v0 = acc[ai][bj][m][0] + *(const f32x4*)(x + o), v1 = acc[ai][bj][m][1] + *(const f32x4*)(x + o + 4);
                    *(f32x4*)(out + o) = v0; *(f32x4*)(out + o + 4) = v1; *(u32x4*)(xb + o) = pack8(v0, v1);
                    sq += (v0[0] * v0[0] + v0[1] * v0[1]) + (v0[2] * v0[2] + v0[3] * v0[3]) + (v1[0] * v1[0] + v1[1] * v1[1]) + (v1[2] * v1[2] + v1[3] * v1[3]); }
                sq += __shfl_xor(sq, 16); sq += __shfl_xor(sq, 32);
                if (fq == 0) atomicAdd(ss + row, sq); }
    } };
struct EpiP5 { bf16_t* Q; const float* ss; EPI_RESET_ALWAYS
    __device__ __forceinline__ void operator()(AccT& acc, const pg8::Unit& u, int wr, int wc, int fr, int fq) const {
        const int row0 = u.pm * 256 + wr * 64 + fr, col0 = u.pn * 256 + wc * 32 + 8 * fq;
#pragma unroll
        for (int ai = 0; ai < 2; ++ai)
#pragma unroll
            for (int m = 0; m < 4; ++m) { const size_t row = (size_t)(row0 + ai * 128 + m * 16); const float rs = rsqrtf(ss[row] * (1.f / D) + EPS);
#pragma unroll
                for (int bj = 0; bj < 2; ++bj) *(u32x4*)(Q + row * D + col0 + bj * 128) = pack8(acc[ai][bj][m][0] * rs, acc[ai][bj][m][1] * rs); }
    } };


namespace att {
using s16x4  = __attribute__((ext_vector_type(4))) short;
using f32x16 = __attribute__((ext_vector_type(16))) float;
constexpr int NWV = 8, QBLK = 32, KVBLK = 64, DH = 128;
constexpr float THR = 8.f;
constexpr int SHM_V = KVBLK * DH * 2, SHM_K = KVBLK * DH * 2;
constexpr int OFF_WS = 2 * SHM_V + 2 * SHM_K, OFF_BT = OFF_WS + NWV * 64 * 4, OFF_OST = OFF_BT + 1536, LDS_NEED = OFF_OST + NWV * 8192;
#define KSWZ(row, colB) ((row) * 256 + ((colB) ^ (((row) & 7) << 4)))
#define SBAR() __builtin_amdgcn_sched_barrier(0)
__device__ __forceinline__ int crow(int r, int hi) { return (r & 3) + 8 * (r >> 2) + 4 * hi; }
__device__ __forceinline__ unsigned cvtpk(float lo, float hi) { unsigned r; asm volatile("v_cvt_pk_bf16_f32 %0, %1, %2" : "=v"(r) : "v"(lo), "v"(hi)); return r; }
__device__ __forceinline__ void partialSM(f32x16& p0, f32x16& p1, float& m_reg, float& mn, float& alpha) {
  constexpr float C = 1.4426950408889634f;
  float pmax = p0[0];
#pragma unroll
  for (int r = 1; r < 16; ++r) pmax = fmaxf(pmax, p0[r]);
#pragma unroll
  for (int r = 0; r < 16; ++r) pmax = fmaxf(pmax, p1[r]);
  { auto rr = __builtin_amdgcn_permlane32_swap(__float_as_uint(pmax), __float_as_uint(pmax), false, false);
    pmax = fmaxf(__uint_as_float(rr[0]), __uint_as_float(rr[1])); }
  if (__builtin_expect(__all(pmax - m_reg <= THR), 1)) { mn = m_reg; alpha = 1.f; }
  else { mn = fmaxf(m_reg, pmax); alpha = __builtin_amdgcn_exp2f((m_reg - mn) * C); m_reg = mn; }
  float mnC = -mn * C;
#pragma unroll
  for (int r = 0; r < 16; ++r) p0[r] = fmaf(p0[r], C, mnC);
#pragma unroll
  for (int r = 0; r < 16; ++r) p1[r] = fmaf(p1[r], C, mnC);
#pragma unroll
  for (int r = 0; r < 16; ++r) p0[r] = __builtin_amdgcn_exp2f(p0[r]);
}
__device__ __forceinline__ void finishSM(f32x16& p0, f32x16& p1, float alpha, float& l_reg, bf16x8& pa0, bf16x8& pa1, bf16x8& pa2, bf16x8& pa3) {
#pragma unroll
  for (int r = 0; r < 16; ++r) p1[r] = __builtin_amdgcn_exp2f(p1[r]);
  float ps = 0;
#pragma unroll
  for (int r = 0; r < 16; ++r) ps += p0[r];
#pragma unroll
  for (int r = 0; r < 16; ++r) ps += p1[r];
  { auto rr = __builtin_amdgcn_permlane32_swap(__float_as_uint(ps), __float_as_uint(ps), false, false);
    ps = __uint_as_float(rr[0]) + __uint_as_float(rr[1]); }
  l_reg = l_reg * alpha + ps;
#define PK4(P, BASE, OUT) do { unsigned a0 = cvtpk(P[BASE + 0], P[BASE + 1]), a1 = cvtpk(P[BASE + 2], P[BASE + 3]);   \
    unsigned b0 = cvtpk(P[BASE + 4], P[BASE + 5]), b1 = cvtpk(P[BASE + 6], P[BASE + 7]);                              \
    auto r0 = __builtin_amdgcn_permlane32_swap(a0, b0, false, false); auto r1 = __builtin_amdgcn_permlane32_swap(a1, b1, false, false); \
    u32x4 w = {r0[0], r1[0], r0[1], r1[1]}; OUT = *reinterpret_cast<bf16x8*>(&w); } while (0)
  PK4(p0, 0, pa0); PK4(p0, 8, pa1); PK4(p1, 0, pa2); PK4(p1, 8, pa3);
#undef PK4
}
template <bool BIAS>
__device__ __forceinline__ void qkt(f32x16& p0, f32x16& p1, const LAS char* Ks, const LAS char* qs, int r32, int hi, const LAS float* bp) {
  if (BIAS) {
#pragma unroll
    for (int r = 0; r < 16; ++r) { p0[r] = bp[(r & 3) + 8 * (r >> 2)]; p1[r] = bp[32 + (r & 3) + 8 * (r >> 2)]; }
  } else { p0 = f32x16{}; p1 = f32x16{}; }
#pragma unroll
  for (int d0 = 0; d0 < 8; ++d0) { int cb = (d0 * 16 + hi * 8) * 2;
    bf16x8 b0 = *reinterpret_cast<const LAS bf16x8*>(Ks + KSWZ(r32, cb));
    bf16x8 b1 = *reinterpret_cast<const LAS bf16x8*>(Ks + KSWZ(32 + r32, cb));
    const bf16x8 qv = *reinterpret_cast<const LAS bf16x8*>(qs + d0 * 1024);
    p0 = __builtin_amdgcn_mfma_f32_32x32x16_bf16(b0, qv, p0, 0, 0, 0);
    p1 = __builtin_amdgcn_mfma_f32_32x32x16_bf16(b1, qv, p1, 0, 0, 0); }
}
__device__ __forceinline__ int v_st(int k, int c) { const int kk = (k & ~0xC) | ((k & 4) << 1) | ((k & 8) >> 1); return ((kk >> 3) * 4 + (c >> 5)) * 512 + ((kk & 7) * 32 + (c & 31)) * 2; }
__device__ __forceinline__ int v_rd_base(int lane) { return ((lane & 3) << 3) | (((lane >> 2) & 3) << 6) | (((lane >> 4) & 1) << 5) | (((lane >> 5) & 1) << 8); }
constexpr int v_rd_off(int d0, int ks, int half) { return d0 * 512 + ks * 4096 + half * 2048; }
template <int OFF> __device__ __forceinline__ s16x4 tr_read(int vb) {
  s16x4 r; asm volatile("ds_read_b64_tr_b16 %0, %1 offset:%2" : "=&v"(r) : "v"(vb), "i"(OFF) : "memory"); return r;
}
template <int D0> __device__ __forceinline__ void pv_one(f32x16& od, int vb, bf16x8 pa0, bf16x8 pa1, bf16x8 pa2, bf16x8 pa3) {
  const s16x4 l0 = tr_read<v_rd_off(D0, 0, 0)>(vb), h0 = tr_read<v_rd_off(D0, 0, 1)>(vb), l1 = tr_read<v_rd_off(D0, 1, 0)>(vb), h1 = tr_read<v_rd_off(D0, 1, 1)>(vb);
  const s16x4 l2 = tr_read<v_rd_off(D0, 2, 0)>(vb), h2 = tr_read<v_rd_off(D0, 2, 1)>(vb), l3 = tr_read<v_rd_off(D0, 3, 0)>(vb), h3 = tr_read<v_rd_off(D0, 3, 1)>(vb);
  asm volatile("s_waitcnt lgkmcnt(0)" ::: "memory"); SBAR();
#define PK(L, H) (bf16x8){L[0], L[1], L[2], L[3], H[0], H[1], H[2], H[3]}
  od = __builtin_amdgcn_mfma_f32_32x32x16_bf16(pa0, PK(l0, h0), od, 0, 0, 0);
  od = __builtin_amdgcn_mfma_f32_32x32x16_bf16(pa1, PK(l1, h1), od, 0, 0, 0);
  od = __builtin_amdgcn_mfma_f32_32x32x16_bf16(pa2, PK(l2, h2), od, 0, 0, 0);
  od = __builtin_amdgcn_mfma_f32_32x32x16_bf16(pa3, PK(l3, h3), od, 0, 0, 0);
#undef PK
}
__device__ __forceinline__ void pv_d0(f32x16* o, int vb, bf16x8 pa0, bf16x8 pa1, bf16x8 pa2, bf16x8 pa3) {
  pv_one<0>(o[0], vb, pa0, pa1, pa2, pa3); pv_one<1>(o[1], vb, pa0, pa1, pa2, pa3); pv_one<2>(o[2], vb, pa0, pa1, pa2, pa3); pv_one<3>(o[3], vb, pa0, pa1, pa2, pa3);
}
template <int LDQ, int LDK, int LDO, bool BAND>
__device__ __forceinline__ void attn_body(const bf16_t* Qb, const bf16_t* Kh, const bf16_t* Vh, bf16_t* Ob,
                                          const int NT, const int kc0, const float* btab_src, LAS char* lds) {
  const int tid = threadIdx.x, wid = __builtin_amdgcn_readfirstlane(tid >> 6), lane = tid & 63, r32 = lane & 31, hi = lane >> 5;
  LAS char* V_lds = lds; LAS char* K_lds = lds + 2 * SHM_V;
  LAS float* wsf = (LAS float*)(lds + OFF_WS) + wid * 64; LAS float* li_l = wsf; LAS float* al_l = wsf + 32;
  LAS float* btab = (LAS float*)(lds + OFF_BT);
  if (BAND) { if (tid < 384) btab[tid] = tid < 64 ? btab_src[256] : (tid < 256 ? btab_src[320 - tid] : -30000.f); }
  float m_reg = -10000.f, l_reg = 0; f32x16 o[4] = {};
  const bf16_t* Qw = Qb + (long)(wid * QBLK + r32) * LDQ + hi * 8;
  LAS char* qr = lds + OFF_OST + wid * 8192 + lane * 16;
#pragma unroll
  for (int d0 = 0; d0 < 8; ++d0) *reinterpret_cast<LAS bf16x8*>(qr + d0 * 1024) = *reinterpret_cast<const bf16x8*>(Qw + d0 * 16);
  const int sr = tid >> 4, sc = (tid & 15) * 8, vst0 = v_st(sr, sc), vst1 = v_st(32 + sr, sc);
  const int vb0 = (int)(unsigned)(uintptr_t)V_lds + v_rd_base(lane);
  struct { bf16x8 vs0, vs1, ks0, ks1; } sr_[1];
  const int pw = wid >> 1, qi = (wid & 1) * 32 + r32;
#define TROW(t) ((BAND ? (((kc0) + (t)) > 0 ? ((kc0) + (t)) : 0) : (t)) * KVBLK)
#define SLOAD(i, t) do { const long k0_ = TROW(t); sr_[i].vs0 = *reinterpret_cast<const bf16x8*>(&Vh[(k0_ + sr) * LDK + sc]); sr_[i].vs1 = *reinterpret_cast<const bf16x8*>(&Vh[(k0_ + 32 + sr) * LDK + sc]); \
    sr_[i].ks0 = *reinterpret_cast<const bf16x8*>(&Kh[(k0_ + sr) * LDK + sc]); sr_[i].ks1 = *reinterpret_cast<const bf16x8*>(&Kh[(k0_ + 32 + sr) * LDK + sc]); } while (0)
#define SWRITE(b, i) do { *(LAS bf16x8*)(V_lds + (b) * SHM_V + vst0) = sr_[i].vs0; *(LAS bf16x8*)(V_lds + (b) * SHM_V + vst1) = sr_[i].vs1; int kc_ = sc * 2; \
    *(LAS bf16x8*)(K_lds + (b) * SHM_K + KSWZ(sr, kc_)) = sr_[i].ks0; *(LAS bf16x8*)(K_lds + (b) * SHM_K + KSWZ(32 + sr, kc_)) = sr_[i].ks1; } while (0)
#define SWAIT() asm volatile("s_waitcnt vmcnt(0)" ::: "memory")
#define RESC(a) do { if (__any((a) < 1.f)) { if (hi == 0) al_l[r32] = (a); asm volatile("s_waitcnt lgkmcnt(0)" ::: "memory"); \
    _Pragma("unroll") for (int d = 0; d < 4; ++d) _Pragma("unroll") for (int r = 0; r < 16; ++r) o[d][r] *= al_l[crow(r, hi)]; } } while (0)
#define BPTR(t) ({ const int t_ = (t); const int dch = pw + 8 - t_; int kb_ = 192 - dch * 64 - qi + 4 * hi; kb_ = kb_ < 0 ? 0 : kb_; \
    if (dch < 0 || dch > 8 || (kc0) + t_ < 0) kb_ = 288; (const LAS float*)(btab + kb_); })
  f32x16 pA0, pA1, pB0, pB1; float mnA, mnB, alA, alB; bf16x8 pa0, pa1, pa2, pa3;
  constexpr int SE = 0, SO = 0;
  SLOAD(SE, 0); asm volatile("s_waitcnt vmcnt(0)" ::: "memory"); SWRITE(0, SE); __syncthreads();
  qkt<BAND>(pA0, pA1, K_lds, qr, r32, hi, BPTR(0)); partialSM(pA0, pA1, m_reg, mnA, alA);
  SLOAD(SO, 1);
  SWAIT(); SWRITE(1, SO); __syncthreads();
  for (int j = 1; j + 1 < NT; j += 2) {
    SBAR(); qkt<BAND>(pB0, pB1, K_lds + SHM_K, qr, r32, hi, BPTR(j));
    finishSM(pA0, pA1, alA, l_reg, pa0, pa1, pa2, pa3); SBAR();
    SLOAD(SO, j + 1); SBAR();
    pv_d0(o, vb0, pa0, pa1, pa2, pa3); partialSM(pB0, pB1, m_reg, mnB, alB);
    __syncthreads(); SWAIT(); SWRITE(0, SE);
    RESC(alB); __syncthreads();
    SBAR(); qkt<BAND>(pA0, pA1, K_lds, qr, r32, hi, BPTR(j + 1));
    finishSM(pB0, pB1, alB, l_reg, pa0, pa1, pa2, pa3); SBAR();
    SLOAD(SE, j + 2); SBAR();
    pv_d0(o, vb0 + SHM_V, pa0, pa1, pa2, pa3); partialSM(pA0, pA1, m_reg, mnA, alA);
    __syncthreads(); SWAIT(); SWRITE(1, SO);
    RESC(alA); __syncthreads();
  }
  SBAR(); qkt<BAND>(pB0, pB1, K_lds + SHM_K, qr, r32, hi, BPTR(NT - 1));
  finishSM(pA0, pA1, alA, l_reg, pa0, pa1, pa2, pa3); SBAR();
  pv_d0(o, vb0, pa0, pa1, pa2, pa3); partialSM(pB0, pB1, m_reg, mnB, alB);
  __syncthreads(); RESC(alB);
  finishSM(pB0, pB1, alB, l_reg, pa0, pa1, pa2, pa3); SBAR();
  pv_d0(o, vb0 + SHM_V, pa0, pa1, pa2, pa3);
  if (hi == 0) li_l[r32] = l_reg; asm volatile("s_waitcnt lgkmcnt(0)" ::: "memory");
  float rli[16];
#pragma unroll
  for (int r = 0; r < 16; ++r) rli[r] = __builtin_amdgcn_rcpf(li_l[crow(r, hi)]);
  { LAS bf16_t* stg = (LAS bf16_t*)(lds + OFF_OST + wid * 8192);
#pragma unroll
    for (int r = 0; r < 16; ++r) { const int orow = crow(r, hi);
#pragma unroll
      for (int d0 = 0; d0 < 4; ++d0) stg[orow * 128 + d0 * 32 + r32] = (bf16_t)f2bf(o[d0][r] * rli[r]); }
    asm volatile("s_waitcnt lgkmcnt(0)" ::: "memory");
    bf16_t* Ow = Ob + (long)(wid * QBLK) * LDO;
#pragma unroll
    for (int i = 0; i < 8; ++i) { const int row = i * 4 + (lane >> 4), ch = lane & 15; const u32x4 v = *(const LAS u32x4*)(stg + row * 128 + ch * 8); *(u32x4*)(Ow + (long)row * LDO + ch * 8) = v; } }
  __syncthreads();
#undef TROW
#undef SLOAD
#undef SWRITE
#undef SWAIT
#undef RESC
#undef BPTR
}
#undef KSWZ
#undef SBAR
}


namespace rt {
using f32x16 = __attribute__((ext_vector_type(16))) float;
#define RKSWZ(row, colB) ((row) * 256 + ((colB) ^ (((row) & 7) << 4)))
__device__ __forceinline__ int crow(int r, int hi) { return (r & 3) + 8 * (r >> 2) + 4 * hi; }
__device__ __forceinline__ void ce_desc(unsigned& a, unsigned& b) { const unsigned mx = a > b ? a : b, mn = a > b ? b : a; a = mx; b = mn; }
__device__ __forceinline__ void sort16_desc(unsigned (&v)[16]) {
#pragma unroll
  for (int k = 2; k <= 16; k <<= 1)
#pragma unroll
    for (int j = k >> 1; j > 0; j >>= 1)
#pragma unroll
      for (int i = 0; i < 16; ++i) { const int l = i ^ j; if (l > i) { if ((i & k) == 0) ce_desc(v[i], v[l]); else ce_desc(v[l], v[i]); } }
}
__device__ __forceinline__ void merge16_desc(unsigned (&a)[16], const unsigned (&b)[16]) {
#pragma unroll
  for (int i = 0; i < 16; ++i) a[i] = a[i] > b[15 - i] ? a[i] : b[15 - i];
#pragma unroll
  for (int j = 8; j > 0; j >>= 1)
#pragma unroll
    for (int i = 0; i < 16; ++i) { const int l = i ^ j; if (l > i) ce_desc(a[i], a[l]); }
}
__device__ __forceinline__ unsigned fkey(float f) { const unsigned u = __float_as_uint(f); return (u & 0x80000000u) ? ~u : (u | 0x80000000u); }
__device__ __forceinline__ float fkey_inv(unsigned k) { const unsigned u = (k & 0x80000000u) ? (k & 0x7fffffffu) : ~k; return __uint_as_float(u); }
__device__ __forceinline__ void top16_half(const f32x16 (&sc)[4], int hi, unsigned (&out)[16]) {
  unsigned g[16];
#pragma unroll
  for (int blk = 0; blk < 4; ++blk) {
#pragma unroll
    for (int r = 0; r < 16; ++r) g[r] = (fkey(sc[blk][r]) & 0xFFFFFF80u) | (unsigned)(32 * blk + (r & 3) + 8 * (r >> 2) + 4 * hi);
    sort16_desc(g);
    if (blk == 0) {
#pragma unroll
      for (int r = 0; r < 16; ++r) out[r] = g[r];
    } else merge16_desc(out, g);
  }
  unsigned pb[16];
#pragma unroll
  for (int r = 0; r < 16; ++r) { auto rr = __builtin_amdgcn_permlane32_swap(out[r], out[r], false, false); pb[r] = hi ? rr[0] : rr[1]; }
  merge16_desc(out, pb);
}
__device__ __forceinline__ void route_phase(const Params& p, LAS unsigned char* lds, int tid, int lane, int wave) {
  const bf16_t* Q = (const bf16_t*)(p.ws + WS_Q); const bf16_t* KB = (const bf16_t*)(p.ws + WS_KEYSB);
  int* RIDX = (int*)(p.ws + WS_RIDX); float* RG = (float*)(p.ws + WS_RG);
  const int h = blockIdx.x & 7, grp = blockIdx.x >> 3;
  const int r32 = lane & 31, hi = lane >> 5;
#pragma unroll
  for (int c = 0; c < 2; ++c)
#pragma unroll
    for (int rep = 0; rep < 4; ++rep) { const int row = rep * 32 + (tid >> 4), cb = (tid & 15) * 16;
      *(LAS u32x4*)(lds + c * 32768 + RKSWZ(row, cb)) = *(const u32x4*)((const char*)KB + ((size_t)(h * 2 + c) * 128 + row) * 256 + cb); }
  __syncthreads();
  for (int tb = grp * 8 + wave; tb < T / 32; tb += (int)(gridDim.x >> 3) * 8) {
    const int t = tb * 32 + r32;
    unsigned ka[16], kb2[16];
#pragma unroll
    for (int c = 0; c < 2; ++c) {
      bf16x8 qf[8];
      const bf16_t* qp = Q + (size_t)t * D + h * 256 + c * 128 + hi * 8;
#pragma unroll
      for (int ks = 0; ks < 8; ++ks) qf[ks] = *(const bf16x8*)(qp + ks * 16);
      f32x16 sc[4];
#pragma unroll
      for (int blk = 0; blk < 4; ++blk) { sc[blk] = f32x16{};
#pragma unroll
        for (int ks = 0; ks < 8; ++ks) { const bf16x8 kf = *(const LAS bf16x8*)(lds + c * 32768 + RKSWZ(32 * blk + r32, (16 * ks + 8 * hi) * 2));
          sc[blk] = __builtin_amdgcn_mfma_f32_32x32x16_bf16(kf, qf[ks], sc[blk], 0, 0, 0); } }
      if (c == 0) top16_half(sc, hi, ka); else top16_half(sc, hi, kb2);
    }
    float av[16], bv[16];
#pragma unroll
    for (int i = 0; i < 16; ++i) { av[i] = fkey_inv(ka[i] & 0xFFFFFF80u); bv[i] = fkey_inv(kb2[i] & 0xFFFFFF80u); }
    float T[16];
#pragma unroll
    for (int k = 0; k < 16; ++k) T[k] = -3.0e38f;
#pragma unroll
    for (int i = 0; i < 16; ++i)
#pragma unroll
      for (int j = 0; j < 16; ++j) if ((i + 1) * (j + 1) <= 16) { float v = av[i] + bv[j];
#pragma unroll
          for (int k = 0; k < 16; ++k) { const float mx = fmaxf(T[k], v); v = fminf(T[k], v); T[k] = mx; } }
    const float m = T[0], theta = T[15];
    float Z = 0.f;
#pragma unroll
    for (int k = 0; k < 16; ++k) Z += __expf(T[k] - m);
    const float rz = 1.f / Z;
    int slot = 0; int cn = 0;
    int* ip = RIDX + (size_t)t * 128 + h * 16; float* gp = RG + (size_t)t * 128 + h * 16;
#pragma unroll
    for (int i = 0; i < 16; ++i)
#pragma unroll
      for (int j = 0; j < 16; ++j) if ((i + 1) * (j + 1) <= 16) { const float v = av[i] + bv[j];
          const bool sel = (v >= theta) && (slot < 16);
          if (sel && ((cn & 1) == hi)) { ip[slot] = (int)((ka[i] & 127u) * 128u + (kb2[j] & 127u)); gp[slot] = __expf(v - m) * rz; }
          slot += sel ? 1 : 0; ++cn; }
  }
}
#undef RKSWZ
}

#define XB_TMO      128
#define XB_XCNT(j)  (256  + 64 * (j))
#define XB_XSUB(j)  (1280 + 64 * (j))
#define XB_XGEN(j)  (2304 + 64 * (j))
#define XB_TOP      3328
#define XB_TOPGEN   3392
#define XCD_BAR_WORDS 3456
#define XB_SPIN_CAP (1u << 22)
__device__ __forceinline__ unsigned xb_ld(unsigned* p)              { return __hip_atomic_load(p, __ATOMIC_RELAXED, __HIP_MEMORY_SCOPE_AGENT); }
__device__ __forceinline__ unsigned xb_add(unsigned* p, unsigned v) { return __hip_atomic_fetch_add(p, v, __ATOMIC_RELAXED, __HIP_MEMORY_SCOPE_AGENT); }
__device__ __forceinline__ unsigned xb_xcc_id() { return (unsigned)__builtin_amdgcn_s_getreg((3 << 11) | 20) & 0xFu; }
#define XB_SPIN(cond, bar) do { unsigned _sp = 0; while (cond) { __builtin_amdgcn_s_sleep(1); \
    if ((++_sp & 255u) == 0u) { if (xb_ld(&(bar)[XB_TMO])) break; if (_sp > XB_SPIN_CAP) { atomicAdd(&(bar)[XB_TMO], 1u); break; } } } } while (0)
struct XcdBarrier { unsigned* bar; unsigned x; volatile LAS unsigned* st; };
__device__ __forceinline__ XcdBarrier xcd_barrier_post(unsigned* bar, volatile LAS unsigned* st) {
    XcdBarrier b; b.bar = bar; b.x = xb_xcc_id(); b.st = st;
    if (threadIdx.x == 0) (void)xb_add(&bar[XB_XCNT(b.x)], 1u);
    return b;
}
__device__ __forceinline__ void xcd_barrier_complete(unsigned* bar, unsigned x, unsigned& nloc, unsigned& nx) {
    const unsigned G = gridDim.x * gridDim.y * gridDim.z;
    unsigned sum, cnt, mine, sp = 0u;
    for (;;) {
        sum = 0u; cnt = 0u; mine = 0u;
#pragma unroll
        for (unsigned j = 0; j < 16; ++j) { const unsigned c = xb_ld(&bar[XB_XCNT(j)]); sum += c; cnt += (c > 0u) ? 1u : 0u; mine = (j == x) ? c : mine; }
        if (sum == G) break;
        __builtin_amdgcn_s_sleep(1);
        if ((++sp & 255u) == 0u) { if (xb_ld(&bar[XB_TMO])) break; if (sp > XB_SPIN_CAP) { atomicAdd(&bar[XB_TMO], 1u); break; } }
    }
    nloc = mine > 0u ? mine : 1u; nx = cnt > 0u ? cnt : 1u;
}
__device__ __forceinline__ void xcd_barrier(const XcdBarrier& b) {
    asm volatile("s_waitcnt vmcnt(0)" ::: "memory");
    __syncthreads();
    if (threadIdx.x == 0) {
        unsigned* bar = b.bar;
        __builtin_amdgcn_s_waitcnt(0);
        unsigned nloc = b.st[0], nx = b.st[1];
        if (nloc == 0u) { xcd_barrier_complete(bar, b.x, nloc, nx); b.st[0] = nloc; b.st[1] = nx; }
        const unsigned old = xb_add(&bar[XB_XSUB(b.x)], 1u);
        const unsigned gen = old / nloc;
        if (old + 1u == (gen + 1u) * nloc) {
            __builtin_amdgcn_fence(__ATOMIC_RELEASE, "agent");
            asm volatile("s_waitcnt vmcnt(0)" ::: "memory");
            const unsigned og = xb_add(&bar[XB_TOP], 1u);
            const unsigned tg = og / nx;
            if (og + 1u == (tg + 1u) * nx) xb_add(&bar[XB_TOPGEN], 1u);
            else XB_SPIN(xb_ld(&bar[XB_TOPGEN]) == tg, bar);
            __builtin_amdgcn_fence(__ATOMIC_ACQUIRE, "agent");
            xb_add(&bar[XB_XGEN(b.x)], 1u);
            asm volatile("s_waitcnt vmcnt(0)" ::: "memory");
        } else {
            XB_SPIN(xb_ld(&bar[XB_XGEN(b.x)]) == gen, bar);
            __builtin_amdgcn_fence(__ATOMIC_ACQUIRE, "agent");
            asm volatile("s_waitcnt vmcnt(0)" ::: "memory");
        }
    }
    __syncthreads();
}
constexpr int RING_BYTES = 131072, MISC_OFF = 143360, LDS_BYTES = 147456, NTHREADS = 512;
static_assert(att::LDS_NEED <= MISC_OFF, "attention scratch below the MISC words");
constexpr size_t WS_SLAB = WS_X2BF;

#ifndef PROBE_MASK
#define PROBE_MASK 0
#endif
#define PH_BEGIN(i) unsigned long long t0_##i = 0; if ((PROBE_MASK >> (i)) & 1) t0_##i = __builtin_amdgcn_s_memrealtime();
#define PH_END(i) if ((PROBE_MASK >> (i)) & 1) probe_acc += __builtin_amdgcn_s_memrealtime() - t0_##i;
__global__ void __launch_bounds__(NTHREADS, 2) fwd(Params p) {
    extern __shared__ __attribute__((aligned(16))) unsigned char lds_raw[];
    LAS unsigned char* lds = (LAS unsigned char*)lds_raw;
    volatile LAS unsigned* MISC = (volatile LAS unsigned*)(lds + MISC_OFF);
    const int tid = threadIdx.x, lane = tid & 63, wave = __builtin_amdgcn_readfirstlane(tid >> 6);
    const int nwb = NTHREADS / 64;
    const int gw = blockIdx.x * nwb + wave, NW = gridDim.x * nwb;
    const int Gd = gridDim.x, cb = blockIdx.x;
    unsigned char* ws = p.ws;
    bf16_t* WT_IN = (bf16_t*)(ws + WS_WT_IN); bf16_t* WT_GATE = (bf16_t*)(ws + WS_WT_GATE); bf16_t* WT_BR = (bf16_t*)(ws + WS_WT_BR);
    bf16_t* WT_O = (bf16_t*)(ws + WS_WT_O); bf16_t* WT_PQ = (bf16_t*)(ws + WS_WT_PQ); bf16_t* WT_MKV = (bf16_t*)(ws + WS_WT_MKV);
    bf16_t* KEYSB = (bf16_t*)(ws + WS_KEYSB); bf16_t* MEMN = (bf16_t*)(ws + WS_MEMN); bf16_t* MEMKV = (bf16_t*)(ws + WS_MEMKV);
    bf16_t* HO = (bf16_t*)(ws + WS_HO); bf16_t* PROJ = (bf16_t*)(ws + WS_PROJ); bf16_t* G = (bf16_t*)(ws + WS_G);
    bf16_t* MERGED = (bf16_t*)(ws + WS_MERGED); bf16_t* X2BF = (bf16_t*)(ws + WS_X2BF); bf16_t* QB = (bf16_t*)(ws + WS_Q);
        float* SS2 = (float*)(ws + WS_CTL + CTL_SS2_BYTE);
    if (tid < 64) MISC[tid] = 0u;
    __syncthreads();
    XcdBarrier bar = xcd_barrier_post((unsigned*)(ws + WS_CTL + CTL_BAR_BYTE), MISC + 8);

    unsigned long long probe_acc = 0;
    PH_BEGIN(0)
    {
        float* scr = (float*)lds_raw + wave * (64 * 33);
        const int I0 = (D / 64) * (INW / 32), I1 = I0 + (D / 64) * (GW / 32), I2 = I1 + (D / 64) * (D / 32), I3 = I2 + (D / 64) * (D / 32), I4 = I3 + (D / 64) * (D / 32), I5 = I4 + (D / 64) * (2 * CW / 32);
#define TRJOB(it, jb, li) do { if ((it) < I0) { jb = TrJob{p.in[3], WT_IN, nullptr, D, INW}; li = (it); } else if ((it) < I1) { jb = TrJob{p.in[18], WT_GATE, nullptr, D, GW}; li = (it) - I0; } \
            else if ((it) < I2) { jb = TrJob{p.in[20], WT_BR, nullptr, D, D}; li = (it) - I1; } else if ((it) < I3) { jb = TrJob{p.in[21], WT_O, nullptr, D, D}; li = (it) - I2; } \
            else if ((it) < I4) { jb = TrJob{p.in[23], WT_PQ, p.in[22], D, D}; li = (it) - I3; } else { jb = TrJob{p.in[15], WT_MKV, nullptr, D, 2 * CW}; li = (it) - I4; } } while (0)
        for (int it = gw; it < I5; it += 2 * NW) {
            TrJob ja, jb2; int la, lb; f32x4 va[8], vb[8];
            TRJOB(it, ja, la); tr_load(ja, la, lane, va);
            const bool has2 = it + NW < I5;
            if (has2) { TRJOB(it + NW, jb2, lb); tr_load(jb2, lb, lane, vb); }
            tr_store(ja, la, lane, va, scr);
            if (has2) tr_store(jb2, lb, lane, vb, scr);
        }
#undef TRJOB
        for (int m = gw; m < T; m += NW) rms_row_bf16(p.in[0] + (size_t)m * D, p.in[2], HO + (size_t)m * D, lane);
        for (int m = gw; m < BATCH * NMEM; m += NW) rms_row_bf16(p.in[1] + (size_t)m * D, p.in[14], MEMN + (size_t)m * D, lane);
        const float* keys = p.in[24];
        for (int i = gw * 64 + lane; i < PH * 2 * NKEYS * 128 / 2; i += NW * 64) ((unsigned*)KEYSB)[i] = pk2(keys[2 * i], keys[2 * i + 1]);
    }
    xcd_barrier(bar);
    PH_END(0)
    PH_BEGIN(1)
    {
        SchedP1 S{(const char*)HO, (const char*)WT_IN, (const char*)MEMN, (const char*)WT_MKV, Gd, cb};
        EpiP1 E{PROJ, G, MEMKV, p.in[19]};
        pg8::gemm_phase(lds, D, D, S, E);
    }
    xcd_barrier(bar);
    PH_END(1)
    PH_BEGIN(2)
    {
        const float qscale = 0.08838834764831845f;
        { HeadGains hg; load_head_gains(hg, p.in[4], p.in[5], p.in[16], lane);
          for (int t = gw; t < T; t += NW) headnorm_token(PROJ + (size_t)t * INW, hg, qscale, lane); }
        for (int it = gw; it < BATCH * NMEM * 4; it += NW) { const int m = it / 4, j = it % 4; headnorm(MEMKV + (size_t)m * (2 * CW) + j * 128, p.in[17], 1.f, lane); }
        for (int u = gw; u < BATCH * NCH * 8; u += NW) { const int g = u % 8, c = (u / 8) % NCH, b = u / (8 * NCH); lru_unit<false>(p, b, c, g, lane); }
        for (int r = gw; r < 2 * 16384; r += NW) {
            if (r < 16384) fp4_row(p.in[25] + (size_t)r * D, p.in[22], ws + WS_TABU + (size_t)r * 1024, (float*)(ws + WS_SCU) + r, lane);
            else { const int e = r - 16384; fp4_row(p.in[26] + (size_t)e * D, nullptr, ws + WS_TABV + (size_t)e * 1024, (float*)(ws + WS_SCV) + e, lane); }
        }
    }
    xcd_barrier(bar);
    PH_END(2)
    PH_BEGIN(3)
    {
        const int nA = BATCH * 8 * (NCH / 4), nC = BATCH * 4 * (SEQ / 256);
        for (int u = cb; u < nA + nC; u += Gd) {
            if (u < nA) {
                const int cg = u % (NCH / 4), h = (u / (NCH / 4)) % 8, b = u / ((NCH / 4) * 8);
                const size_t brow = (size_t)b * SEQ, qrow = brow + (size_t)cg * 256;
                att::attn_body<INW, INW, D, true>(PROJ + qrow * INW + C_QA + h * 128, PROJ + brow * INW + C_KA + h * 128, PROJ + brow * INW + C_VA + h * 128,
                                                  HO + qrow * D + h * 128, 12, cg * 4 - NPREV, p.in[6] + h * 257, (LAS char*)lds);
            } else {
                const int v = u - nA; const int qb = v % (SEQ / 256), h = (v / (SEQ / 256)) % 4, b = v / ((SEQ / 256) * 4);
                const size_t qrow = (size_t)b * SEQ + (size_t)qb * 256;
                att::attn_body<INW, 2 * CW, D, false>(PROJ + qrow * INW + C_QC + h * 128, MEMKV + (size_t)b * NMEM * (2 * CW) + h * 128, MEMKV + (size_t)b * NMEM * (2 * CW) + CW + h * 128,
                                                     HO + qrow * D + AW + LW + h * 128, NMEM / 64, 0, nullptr, (LAS char*)lds);
            }
        }
        for (int u = gw; u < BATCH * NCH * 8; u += NW) { const int g = u % 8, c = (u / 8) % NCH, b = u / (8 * NCH); lru_unit<true>(p, b, c, g, lane); }
    }
    xcd_barrier(bar);
    PH_END(3)
    PH_BEGIN(4)
    {
        SchedP3 S{(const char*)HO, (const char*)WT_BR, Gd, cb};
        EpiP3 E{G, MERGED};
        pg8::gemm_phase(lds, D, D, S, E);
    }
    xcd_barrier(bar);
    PH_END(4)
    PH_BEGIN(5)
    {
        SchedSq S{(const char*)MERGED, (const char*)WT_O, Gd, cb};
        EpiP4 E{p.in[0], p.out, X2BF, SS2};
        pg8::gemm_phase(lds, D, D, S, E);
    }
    xcd_barrier(bar);
    PH_END(5)
    PH_BEGIN(6)
    {
        SchedSq S{(const char*)X2BF, (const char*)WT_PQ, Gd, cb};
        EpiP5 E{QB, SS2};
        pg8::gemm_phase(lds, D, D, S, E);
    }
    xcd_barrier(bar);
    PH_END(6)
    PH_BEGIN(7)
    rt::route_phase(p, lds, tid, lane, wave);
    xcd_barrier(bar);
    PH_END(7)
    PH_BEGIN(8)
    { LAS float* actL = (LAS float*)lds + wave * 128;
      for (int t = gw; t < T; t += NW) peer_token(p, t, lane, actL); }
    if (PROBE_MASK) { __syncthreads(); PH_END(8) const unsigned long long te = __builtin_amdgcn_s_memrealtime(); while (__builtin_amdgcn_s_memrealtime() - te < probe_acc) __builtin_amdgcn_s_sleep(8); }
}

extern "C" void kernel_launch(void* const* d_in, const int* in_sizes, int n_in, void* d_out, int out_size, void* d_ws, size_t ws_size, hipStream_t stream) {
    static int grid = 0;
    if (grid == 0) {
        if (n_in != 27 || out_size != T * D || ws_size < WS_END) { fprintf(stderr, "kernel_launch: unexpected problem (n_in %d out %d ws %zu)\n", n_in, out_size, ws_size); grid = -1; return; }
        int dev = 0, cus = 0, per_cu = 0;
        (void)hipGetDevice(&dev); (void)hipDeviceGetAttribute(&cus, hipDeviceAttributeMultiprocessorCount, dev);
        if (hipFuncSetAttribute((const void*)fwd, hipFuncAttributeMaxDynamicSharedMemorySize, LDS_BYTES) != hipSuccess) { fprintf(stderr, "kernel_launch: hipFuncSetAttribute failed\n"); grid = -1; return; }
        (void)hipOccupancyMaxActiveBlocksPerMultiprocessor(&per_cu, (const void*)fwd, NTHREADS, LDS_BYTES);
        if (per_cu < 1) { fprintf(stderr, "kernel_launch: occupancy query says %d\n", per_cu); grid = -1; return; }
        grid = cus;
    }
    if (grid < 0) return;
    (void)hipMemsetAsync((char*)d_ws + WS_CTL, 0, 1 * MiB, stream);
    Params p{};
    for (int i = 0; i < 27; ++i) p.in[i] = (const float*)d_in[i];
    p.out = (float*)d_out; p.ws = (unsigned char*)d_ws;
    void* args[] = {&p};
    hipError_t e = hipLaunchCooperativeKernel((const void*)fwd, dim3(grid), dim3(NTHREADS), args, LDS_BYTES, stream);
    if (e != hipSuccess) fprintf(stderr, "cooperative launch failed: %s (grid %d)\n", hipGetErrorString(e), grid);
}
```

```cpp
#include <hip/hip_runtime.h>
#include <hip/hip_cooperative_groups.h>
#include <cstdio>
#include <cstdint>
namespace cg = cooperative_groups;

#define LAS __attribute__((address_space(3)))
typedef unsigned short bf16_t;
typedef short bf16x8 __attribute__((ext_vector_type(8)));
typedef float f32x4 __attribute__((ext_vector_type(4)));
typedef unsigned u32x4 __attribute__((ext_vector_type(4)));
typedef unsigned u32x2 __attribute__((ext_vector_type(2)));

constexpr int D = 2048, BATCH = 2, SEQ = 8192, T = BATCH * SEQ;
constexpr int CHUNK = 64, NPREV = 8, NCH = SEQ / CHUNK;
constexpr int AW = 1024, LW = 512, CW = 512, INW = 4608, GW = 6144;
constexpr int NMEM = 256;
constexpr int PH = 8, NKEYS = 128, TOPK = 16;
constexpr float EPS = 1e-6f;
constexpr int C_QA = 0, C_KA = 1024, C_VA = 2048, C_XL = 3072, C_GL = 3584, C_QC = 4096;

constexpr size_t MiB = 1u << 20;
constexpr size_t WS_CTL = 0;
constexpr size_t WS_WT_IN = 2 * MiB, WS_WT_GATE = 20 * MiB, WS_WT_BR = 44 * MiB, WS_WT_O = 52 * MiB, WS_WT_PQ = 60 * MiB, WS_WT_MKV = 68 * MiB;
constexpr size_t WS_KEYSB = 72 * MiB, WS_MEMN = 73 * MiB, WS_MEMKV = 75 * MiB, WS_LRUSUM = 76 * MiB, WS_RS2 = 77 * MiB;
constexpr size_t WS_HO = 80 * MiB;
constexpr size_t WS_PROJ = 144 * MiB;
constexpr size_t WS_MERGED = 144 * MiB, WS_X2BF = 208 * MiB;
constexpr size_t WS_G = 288 * MiB;
constexpr size_t WS_TABU = 496 * MiB, WS_TABV = 512 * MiB, WS_Q = 416 * MiB;
constexpr size_t WS_SCU = 77 * MiB, WS_SCV = 77 * MiB + 65536;
constexpr size_t WS_H8 = 496 * MiB;
constexpr float GATE_WSCALE = 256.f;
constexpr size_t WS_RIDX = 480 * MiB, WS_RG = 488 * MiB, WS_END = 528 * MiB;

constexpr size_t CTL_BAR_BYTE = 16384, CTL_SS2_BYTE = 512 * 1024;
struct Params { const float* in[27]; float* out; unsigned char* ws; };

__device__ __forceinline__ float bf2f(unsigned v16) { return __uint_as_float(v16 << 16); }
__device__ __forceinline__ unsigned f2bf(float f) { unsigned u = __float_as_uint(f); return (u + 0x7fffu + ((u >> 16) & 1u)) >> 16; }
__device__ __forceinline__ unsigned pk2(float lo, float hi) { return f2bf(lo) | (f2bf(hi) << 16); }
__device__ __forceinline__ float wave_sum(float v) {
#pragma unroll
    for (int o = 1; o < 64; o <<= 1) v += __shfl_xor(v, o);
    return v;
}
typedef __bf16 bf16x2_t __attribute__((ext_vector_type(2)));
__device__ __forceinline__ float dot2bf(unsigned w, unsigned x, float acc) { return __builtin_amdgcn_fdot2_f32_bf16(__builtin_bit_cast(bf16x2_t, w), __builtin_bit_cast(bf16x2_t, x), acc, false); }
__device__ __forceinline__ float sigmoid_(float x) { return 1.f / (1.f + __expf(-x)); }
__device__ __forceinline__ float gelu_tanh(float x) { const float y = 1.5957691216f * (x + 0.044715f * x * x * x); return x / (1.f + __expf(-y)); }
__device__ __forceinline__ void unpack8(const u32x4 w, float* f) {
    f[0] = __uint_as_float(w.x << 16); f[1] = __uint_as_float(w.x & 0xffff0000u);
    f[2] = __uint_as_float(w.y << 16); f[3] = __uint_as_float(w.y & 0xffff0000u);
    f[4] = __uint_as_float(w.z << 16); f[5] = __uint_as_float(w.z & 0xffff0000u);
    f[6] = __uint_as_float(w.w << 16); f[7] = __uint_as_float(w.w & 0xffff0000u);
}

struct TrJob { const float* W; bf16_t* WT; const float* ks; int K, N; float f8scale; };
__device__ __forceinline__ void tr_load(const TrJob& jb, int item, int lane, f32x4 (&v)[8]) {
    const int nblk = jb.N / 32, kb = item / nblk, nb = item % nblk, k0 = 64 * kb, n0 = 32 * nb;
#pragma unroll
    for (int i = 0; i < 8; ++i) { const int kk = 8 * i + (lane >> 3); v[i] = *(const f32x4*)(jb.W + (size_t)(k0 + kk) * jb.N + n0 + 4 * (lane & 7)); if (jb.ks) v[i] = v[i] * jb.ks[k0 + kk]; }
}
__device__ __forceinline__ void tr_store(const TrJob& jb, int item, int lane, const f32x4 (&v)[8], float* scr) {
    const int nblk = jb.N / 32, kb = item / nblk, nb = item % nblk, k0 = 64 * kb, n0 = 32 * nb;
#pragma unroll
    for (int i = 0; i < 8; ++i) { float* d = scr + (8 * i + (lane >> 3)) * 33 + 4 * (lane & 7); d[0] = v[i].x; d[1] = v[i].y; d[2] = v[i].z; d[3] = v[i].w; }
    asm volatile("s_waitcnt lgkmcnt(0)" ::: "memory");
    const int c = lane & 7;
#pragma unroll
    for (int j = 0; j < 4; ++j) { const int n = (lane >> 3) + 8 * j; const float* s = scr + (8 * c) * 33 + n;
        if (jb.f8scale != 0.f) { const float f = jb.f8scale; u32x2 o;
            int w = __builtin_amdgcn_cvt_pk_fp8_f32(s[0 * 33] * f, s[1 * 33] * f, 0, false); w = __builtin_amdgcn_cvt_pk_fp8_f32(s[2 * 33] * f, s[3 * 33] * f, w, true); o.x = (unsigned)w;
            w = __builtin_amdgcn_cvt_pk_fp8_f32(s[4 * 33] * f, s[5 * 33] * f, 0, false); w = __builtin_amdgcn_cvt_pk_fp8_f32(s[6 * 33] * f, s[7 * 33] * f, w, true); o.y = (unsigned)w;
            *(u32x2*)((unsigned char*)jb.WT + (size_t)(n0 + n) * jb.K + k0 + 8 * c) = o; }
        else { u32x4 o; o.x = pk2(s[0 * 33], s[1 * 33]); o.y = pk2(s[2 * 33], s[3 * 33]); o.z = pk2(s[4 * 33], s[5 * 33]); o.w = pk2(s[6 * 33], s[7 * 33]);
            *(u32x4*)(jb.WT + (size_t)(n0 + n) * jb.K + k0 + 8 * c) = o; } }
    asm volatile("s_waitcnt lgkmcnt(0)" ::: "memory");
}
__device__ __forceinline__ void rms_row_load(const float* xrow, int lane, f32x4 (&v)[8]) {
    const f32x4* xr = (const f32x4*)xrow + lane;
#pragma unroll
    for (int j = 0; j < 8; ++j) v[j] = xr[64 * j];
}
__device__ __forceinline__ void rms_row_finish(const f32x4 (&v)[8], const float* g, bf16_t* orow, unsigned char* o8row, int lane) {
    const f32x4* gr = (const f32x4*)g + lane; float s = 0.f;
#pragma unroll
    for (int j = 0; j < 8; ++j) s += (v[j].x * v[j].x + v[j].y * v[j].y) + (v[j].z * v[j].z + v[j].w * v[j].w);
    const float rstd = rsqrtf(wave_sum(s) * (1.f / D) + EPS);
    u32x2* o8 = (u32x2*)orow + lane;
#pragma unroll
    for (int j = 0; j < 8; ++j) { const f32x4 gg = gr[64 * j]; const float a0 = v[j].x * rstd * gg.x, a1 = v[j].y * rstd * gg.y, a2 = v[j].z * rstd * gg.z, a3 = v[j].w * rstd * gg.w;
        u32x2 o; o.x = pk2(a0, a1); o.y = pk2(a2, a3); o8[64 * j] = o;
        if (o8row) { int w = __builtin_amdgcn_cvt_pk_fp8_f32(fminf(fmaxf(a0, -448.f), 448.f), fminf(fmaxf(a1, -448.f), 448.f), 0, false);
            w = __builtin_amdgcn_cvt_pk_fp8_f32(fminf(fmaxf(a2, -448.f), 448.f), fminf(fmaxf(a3, -448.f), 448.f), w, true); ((unsigned*)o8row)[64 * j + lane] = (unsigned)w; } }
}
__device__ __forceinline__ void rms_rows(const float* X, const float* g, bf16_t* O, unsigned char* O8, int nrows, int gw, int NW, int lane) {
    f32x4 va[8], vb[8];
    int m = gw;
    if (m < nrows) rms_row_load(X + (size_t)m * D, lane, va);
    for (; m < nrows; m += 2 * NW) {
        const bool hb = m + NW < nrows;
        if (hb) rms_row_load(X + (size_t)(m + NW) * D, lane, vb);
        rms_row_finish(va, g, O + (size_t)m * D, O8 ? O8 + (size_t)m * D : nullptr, lane);
        if (m + 2 * NW < nrows) rms_row_load(X + (size_t)(m + 2 * NW) * D, lane, va);
        if (hb) rms_row_finish(vb, g, O + (size_t)(m + NW) * D, O8 ? O8 + (size_t)(m + NW) * D : nullptr, lane);
    }
}

template <int TM, int TN, class Epi>
__device__ __forceinline__ void gemm_simple(const bf16_t* __restrict__ A, int lda, const bf16_t* __restrict__ Bt, int ldb, int M, int N, int K, const Epi& epi, int gw, int NW, int lane) {
    const int r = lane & 15, q = lane >> 4;
    const int ntm = M / (16 * TM), ntn = N / (16 * TN);
    for (int tile = gw; tile < ntm * ntn; tile += NW) {
        const int tm = tile / ntn, tn = tile % ntn;
        f32x4 acc[TM][TN];
#pragma unroll
        for (int i = 0; i < TM; ++i)
#pragma unroll
            for (int j = 0; j < TN; ++j) acc[i][j] = (f32x4){0.f, 0.f, 0.f, 0.f};
        const bf16_t* ap = A + (size_t)(tm * 16 * TM + r) * lda + q * 8;
        const bf16_t* bp = Bt + (size_t)(tn * 16 * TN + r) * ldb + q * 8;
        for (int k0 = 0; k0 < K; k0 += 32) {
            bf16x8 af[TM], bfr[TN];
#pragma unroll
            for (int i = 0; i < TM; ++i) af[i] = *(const bf16x8*)(ap + (size_t)i * 16 * lda + k0);
#pragma unroll
            for (int j = 0; j < TN; ++j) bfr[j] = *(const bf16x8*)(bp + (size_t)j * 16 * ldb + k0);
#pragma unroll
            for (int i = 0; i < TM; ++i)
#pragma unroll
                for (int j = 0; j < TN; ++j) acc[i][j] = __builtin_amdgcn_mfma_f32_16x16x32_bf16(af[i], bfr[j], acc[i][j], 0, 0, 0);
        }
#pragma unroll
        for (int i = 0; i < TM; ++i)
#pragma unroll
            for (int j = 0; j < TN; ++j)
#pragma unroll
                for (int e = 0; e < 4; ++e) epi(tm * 16 * TM + i * 16 + q * 4 + e, tn * 16 * TN + j * 16 + r, acc[i][j][e]);
    }
}
struct EpiProj { bf16_t* P; __device__ __forceinline__ void operator()(int row, int col, float v) const { if (col >= C_GL && col < C_QC) v = gelu_tanh(v); P[(size_t)row * INW + col] = (bf16_t)f2bf(v); } };
struct EpiGate { bf16_t* G; const float* b; __device__ __forceinline__ void operator()(int row, int col, float v) const { G[(size_t)row * GW + col] = (bf16_t)f2bf(sigmoid_(v + b[col])); } };
struct EpiStore { bf16_t* C; int ldc; __device__ __forceinline__ void operator()(int row, int col, float v) const { C[(size_t)row * ldc + col] = (bf16_t)f2bf(v); } };
struct EpiWo { const float* x; float* out; bf16_t* xb; __device__ __forceinline__ void operator()(int row, int col, float v) const { const size_t o = (size_t)row * D + col; const float y = x[o] + v; out[o] = y; xb[o] = (bf16_t)f2bf(y); } };
struct EpiQ { bf16_t* Q; const float* rs; __device__ __forceinline__ void operator()(int row, int col, float v) const { Q[(size_t)row * D + col] = (bf16_t)f2bf(v * rs[row]); } };

__device__ __forceinline__ void headnorm(bf16_t* vec, const float* g, float scale, int lane) {
    unsigned* p = (unsigned*)vec + lane; const unsigned w = *p;
    const float a = bf2f(w & 0xffffu), b = bf2f(w >> 16);
    const float rs = rsqrtf(wave_sum(a * a + b * b) * (1.f / 128.f) + EPS) * scale;
    *p = pk2(a * rs * g[2 * lane], b * rs * g[2 * lane + 1]);
}
struct HeadGains { float gq[32], gk[32], gc[8]; };
__device__ __forceinline__ void load_head_gains(HeadGains& hg, const float* gq, const float* gk, const float* gc, int lane) {
#pragma unroll
    for (int j = 0; j < 32; ++j) { hg.gq[j] = gq[(lane & 3) * 32 + j]; hg.gk[j] = gk[(lane & 3) * 32 + j]; }
#pragma unroll
    for (int j = 0; j < 8; ++j) hg.gc[j] = gc[(lane & 15) * 8 + j];
}
__device__ __forceinline__ void headnorm_token(bf16_t* row, const HeadGains& hg, float qscale, int lane) {
    u32x4* pa = (u32x4*)(row + C_QA) + lane * 4;
    u32x4* pc = (u32x4*)(row + C_QC) + lane;
    u32x4 w[4]; const u32x4 wc = *pc;
#pragma unroll
    for (int j = 0; j < 4; ++j) w[j] = pa[j];
    float f[32], fc[8]; float ss = 0.f, sc = 0.f;
#pragma unroll
    for (int j = 0; j < 4; ++j) unpack8(w[j], f + 8 * j);
    unpack8(wc, fc);
#pragma unroll
    for (int j = 0; j < 32; ++j) ss = fmaf(f[j], f[j], ss);
#pragma unroll
    for (int j = 0; j < 8; ++j) sc = fmaf(fc[j], fc[j], sc);
    ss += __shfl_xor(ss, 1); ss += __shfl_xor(ss, 2);
    sc += __shfl_xor(sc, 1); sc += __shfl_xor(sc, 2); sc += __shfl_xor(sc, 4); sc += __shfl_xor(sc, 8);
    const bool isq = lane < 32;
    const float rs = rsqrtf(ss * (1.f / 128.f) + EPS) * (isq ? qscale : 1.f), rc = rsqrtf(sc * (1.f / 128.f) + EPS) * qscale;
#pragma unroll
    for (int j = 0; j < 4; ++j) { u32x4 o;
        o.x = pk2(f[8 * j] * rs * (isq ? hg.gq[8 * j] : hg.gk[8 * j]), f[8 * j + 1] * rs * (isq ? hg.gq[8 * j + 1] : hg.gk[8 * j + 1]));
        o.y = pk2(f[8 * j + 2] * rs * (isq ? hg.gq[8 * j + 2] : hg.gk[8 * j + 2]), f[8 * j + 3] * rs * (isq ? hg.gq[8 * j + 3] : hg.gk[8 * j + 3]));
        o.z = pk2(f[8 * j + 4] * rs * (isq ? hg.gq[8 * j + 4] : hg.gk[8 * j + 4]), f[8 * j + 5] * rs * (isq ? hg.gq[8 * j + 5] : hg.gk[8 * j + 5]));
        o.w = pk2(f[8 * j + 6] * rs * (isq ? hg.gq[8 * j + 6] : hg.gk[8 * j + 6]), f[8 * j + 7] * rs * (isq ? hg.gq[8 * j + 7] : hg.gk[8 * j + 7]));
        pa[j] = o; }
    { u32x4 o; o.x = pk2(fc[0] * rc * hg.gc[0], fc[1] * rc * hg.gc[1]); o.y = pk2(fc[2] * rc * hg.gc[2], fc[3] * rc * hg.gc[3]);
      o.z = pk2(fc[4] * rc * hg.gc[4], fc[5] * rc * hg.gc[5]); o.w = pk2(fc[6] * rc * hg.gc[6], fc[7] * rc * hg.gc[7]); *pc = o; }
}

template <bool PASS2>
__device__ __forceinline__ void lru_unit(const Params& p, int b, int c, int g, int lane, LAS unsigned char* wl  ) {
    const bf16_t* PROJ = (const bf16_t*)(p.ws + WS_PROJ); bf16_t* O = (bf16_t*)(p.ws + WS_HO);
    float* SUMA = (float*)(p.ws + WS_LRUSUM); float* SUMB = SUMA + BATCH * NCH * LW;
    const float* conv_w = p.in[7]; const float* conv_b = p.in[8]; const float* lru_wa = p.in[9]; const float* lru_ba = p.in[10];
    const float* lru_wx = p.in[11]; const float* lru_bx = p.in[12]; const float* lam = p.in[13];
    const int ch = g * 64 + lane;
    unsigned wa_p[32], wx_p[32];
#pragma unroll
    for (int m = 0; m < 32; ++m) { wa_p[m] = pk2(lru_wa[(size_t)(g * 64 + 2 * m) * 64 + lane], lru_wa[(size_t)(g * 64 + 2 * m + 1) * 64 + lane]);
        wx_p[m] = pk2(lru_wx[(size_t)(g * 64 + 2 * m) * 64 + lane], lru_wx[(size_t)(g * 64 + 2 * m + 1) * 64 + lane]); }
    const float cw0 = conv_w[0 * LW + ch], cw1 = conv_w[1 * LW + ch], cw2 = conv_w[2 * LW + ch], cw3 = conv_w[3 * LW + ch], cb = conv_b[ch];
    const float ba_ = lru_ba[ch], bx_ = lru_bx[ch];
    const float sp = log1pf(__expf(-lam[ch]));
    const int t0 = c * CHUNK; const size_t row0 = (size_t)b * SEQ + t0;
    float x0 = 0.f, x1 = 0.f, x2 = 0.f;
    if (t0 >= 3) { x0 = bf2f(PROJ[(row0 - 3) * INW + C_XL + ch]); x1 = bf2f(PROJ[(row0 - 2) * INW + C_XL + ch]); x2 = bf2f(PROJ[(row0 - 1) * INW + C_XL + ch]); }
    float h = 0.f, aprod = 1.f;
    if (PASS2) {
        int j = 0;
        for (; j + 8 <= c; j += 8) { float sa[8], sb[8];
#pragma unroll
            for (int q = 0; q < 8; ++q) { const size_t o = (size_t)(b * NCH + j + q) * LW + ch; sa[q] = SUMA[o]; sb[q] = SUMB[o]; }
#pragma unroll
            for (int q = 0; q < 8; ++q) h = sa[q] * h + sb[q]; }
        for (; j < c; ++j) { const size_t o = (size_t)(b * NCH + j) * LW + ch; h = SUMA[o] * h + SUMB[o]; }
    }
    { const bf16_t* xs = PROJ + (row0 + (lane >> 3)) * INW + C_XL + g * 64 + (lane & 7) * 8;
      u32x4 tx[8], tg[8];
#pragma unroll
      for (int i = 0; i < 8; ++i) { tx[i] = *(const u32x4*)(xs + (size_t)(8 * i) * INW); if (PASS2) tg[i] = *(const u32x4*)(xs + (size_t)(8 * i) * INW + (C_GL - C_XL)); }
#pragma unroll
      for (int i = 0; i < 8; ++i) { *(LAS u32x4*)(wl + (8 * i + (lane >> 3)) * 128 + (lane & 7) * 16) = tx[i]; if (PASS2) *(LAS u32x4*)(wl + 8192 + (8 * i + (lane >> 3)) * 128 + (lane & 7) * 16) = tg[i]; } }
#pragma unroll 1
    for (int t = 0; t < CHUNK; ++t) {
        const float x3 = bf2f(*(const LAS bf16_t*)(wl + t * 128 + lane * 2));
        const float xc = cw0 * x0 + cw1 * x1 + cw2 * x2 + cw3 * x3 + cb;
        x0 = x1; x1 = x2; x2 = x3;
        float rp = ba_, ip = bx_, rp2 = 0.f, ip2 = 0.f;
        const float xnb = __shfl_xor(xc, 1);
        const unsigned xpk = (lane & 1) ? pk2(xnb, xc) : pk2(xc, xnb);
#pragma unroll
        for (int m = 0; m < 32; m += 2) {
            const unsigned xa = (unsigned)__builtin_amdgcn_readlane((int)xpk, 2 * m), xb = (unsigned)__builtin_amdgcn_readlane((int)xpk, 2 * m + 2);
            rp = dot2bf(wa_p[m], xa, rp); ip = dot2bf(wx_p[m], xa, ip); rp2 = dot2bf(wa_p[m + 1], xb, rp2); ip2 = dot2bf(wx_p[m + 1], xb, ip2); }
        const float r = sigmoid_(rp + rp2), ig = sigmoid_(ip + ip2);
        const float la = -8.f * r * sp; const float a = __expf(la);
        const float mult = sqrtf(fminf(fmaxf(-expm1f(2.f * la), 1e-12f), 1.f));
        h = a * h + mult * ig * xc;
        if (PASS2) O[(row0 + t) * D + AW + ch] = (bf16_t)f2bf(h * bf2f(*(const LAS bf16_t*)(wl + 8192 + t * 128 + lane * 2)));
        else aprod *= a;
    }
    if (!PASS2) { const size_t o = (size_t)(b * NCH + c) * LW + ch; SUMA[o] = aprod; SUMB[o] = h; }
}

__device__ __forceinline__ void attn_simple(const bf16_t* Qp, int ldq, const bf16_t* Kp, const bf16_t* Vp, int ldkv, int nkeys, int koff, const float* bias_h, bf16_t* Op, int ldo, int tid) {
    const int qi = tid >> 2, part = tid & 3;
    float q[32], o[32];
    { const u32x4* qp = (const u32x4*)(Qp + (size_t)qi * ldq + part * 32);
#pragma unroll
      for (int j = 0; j < 4; ++j) unpack8(qp[j], q + 8 * j); }
#pragma unroll
    for (int d = 0; d < 32; ++d) o[d] = 0.f;
    float m = -1e30f, l = 0.f;
    for (int kk0 = 0; kk0 < nkeys; kk0 += 8) {
        float s[8];
#pragma unroll
        for (int j = 0; j < 8; ++j) {
            const u32x4* kp = (const u32x4*)(Kp + (size_t)(kk0 + j) * ldkv + part * 32);
            float acc = 0.f;
#pragma unroll
            for (int w = 0; w < 4; ++w) { float kf[8]; unpack8(kp[w], kf);
#pragma unroll
                for (int e = 0; e < 8; ++e) acc = fmaf(q[8 * w + e], kf[e], acc); }
            acc += __shfl_xor(acc, 1); acc += __shfl_xor(acc, 2);
            if (bias_h) { int dist = qi + koff - (kk0 + j); dist = dist < -128 ? -128 : (dist > 128 ? 128 : dist); acc += bias_h[dist + 128]; }
            s[j] = acc;
        }
        float mx = s[0];
#pragma unroll
        for (int j = 1; j < 8; ++j) mx = fmaxf(mx, s[j]);
        const float mn = fmaxf(m, mx), corr = __expf(m - mn);
        l *= corr;
#pragma unroll
        for (int d = 0; d < 32; ++d) o[d] *= corr;
#pragma unroll
        for (int j = 0; j < 8; ++j) {
            const float pj = __expf(s[j] - mn); l += pj;
            const u32x4* vp = (const u32x4*)(Vp + (size_t)(kk0 + j) * ldkv + part * 32);
#pragma unroll
            for (int w = 0; w < 4; ++w) { float vf[8]; unpack8(vp[w], vf);
#pragma unroll
                for (int e = 0; e < 8; ++e) o[8 * w + e] = fmaf(pj, vf[e], o[8 * w + e]); }
        }
        m = mn;
    }
    const float inv = 1.f / l;
    u32x4* op = (u32x4*)(Op + (size_t)qi * ldo + part * 32);
#pragma unroll
    for (int w = 0; w < 4; ++w) { u32x4 ov; ov.x = pk2(o[8 * w] * inv, o[8 * w + 1] * inv); ov.y = pk2(o[8 * w + 2] * inv, o[8 * w + 3] * inv); ov.z = pk2(o[8 * w + 4] * inv, o[8 * w + 5] * inv); ov.w = pk2(o[8 * w + 6] * inv, o[8 * w + 7] * inv); op[w] = ov; }
}

__device__ __forceinline__ void gemm_branch(const bf16_t* __restrict__ Ob, const bf16_t* __restrict__ WT, const bf16_t* __restrict__ G, bf16_t* __restrict__ Mg, int gw, int NW, int lane) {
    const int r = lane & 15, q = lane >> 4;
    const int ntn = D / 32, ntiles = (T / 32) * ntn;
    for (int tile = gw; tile < ntiles; tile += NW) {
        const int tm = tile / ntn, tn = tile % ntn;
        f32x4 acc[3][2][2];
#pragma unroll
        for (int s = 0; s < 3; ++s)
#pragma unroll
            for (int i = 0; i < 2; ++i)
#pragma unroll
                for (int j = 0; j < 2; ++j) acc[s][i][j] = (f32x4){0.f, 0.f, 0.f, 0.f};
        const bf16_t* ap = Ob + (size_t)(tm * 32 + r) * D + q * 8;
        const bf16_t* bp = WT + (size_t)(tn * 32 + r) * D + q * 8;
#pragma unroll
        for (int s = 0; s < 3; ++s) {
            const int kb = s == 0 ? 0 : (s == 1 ? 1024 : 1536), ke = s == 0 ? 1024 : (s == 1 ? 1536 : 2048);
            for (int k0 = kb; k0 < ke; k0 += 32) {
                bf16x8 af[2], bfr[2];
#pragma unroll
                for (int i = 0; i < 2; ++i) af[i] = *(const bf16x8*)(ap + (size_t)i * 16 * D + k0);
#pragma unroll
                for (int j = 0; j < 2; ++j) bfr[j] = *(const bf16x8*)(bp + (size_t)j * 16 * D + k0);
#pragma unroll
                for (int i = 0; i < 2; ++i)
#pragma unroll
                    for (int j = 0; j < 2; ++j) acc[s][i][j] = __builtin_amdgcn_mfma_f32_16x16x32_bf16(af[i], bfr[j], acc[s][i][j], 0, 0, 0);
            }
        }
#pragma unroll
        for (int i = 0; i < 2; ++i)
#pragma unroll
            for (int j = 0; j < 2; ++j)
#pragma unroll
                for (int e = 0; e < 4; ++e) {
                    const int row = tm * 32 + i * 16 + q * 4 + e, col = tn * 32 + j * 16 + r;
                    const bf16_t* gp = G + (size_t)row * GW + col;
                    const float mval = bf2f(gp[0]) * acc[0][i][j][e] + bf2f(gp[2048]) * acc[1][i][j][e] + bf2f(gp[4096]) * acc[2][i][j][e];
                    Mg[(size_t)row * D + col] = (bf16_t)f2bf(mval);
                }
    }
}

__device__ __forceinline__ unsigned long long shfl_xor64(unsigned long long v, int m) {
    const unsigned lo = __shfl_xor((unsigned)v, m), hi = __shfl_xor((unsigned)(v >> 32), m);
    return ((unsigned long long)hi << 32) | lo;
}
__device__ __forceinline__ unsigned fkey(float f) { const unsigned u = __float_as_uint(f); return (u & 0x80000000u) ? ~u : (u | 0x80000000u); }
__device__ __forceinline__ float fkey_inv(unsigned k) { const unsigned u = (k & 0x80000000u) ? (k & 0x7fffffffu) : ~k; return __uint_as_float(u); }
__device__ __forceinline__ unsigned long long wave_max64(unsigned long long k) {
#pragma unroll
    for (int o = 1; o < 64; o <<= 1) { const unsigned long long t = shfl_xor64(k, o); k = t > k ? t : k; }
    return k;
}
__device__ __forceinline__ void route_unit(const Params& p, int t, int h, int lane) {
    const bf16_t* Q = (const bf16_t*)(p.ws + WS_Q); const bf16_t* KB = (const bf16_t*)(p.ws + WS_KEYSB);
    int* RIDX = (int*)(p.ws + WS_RIDX); float* RG = (float*)(p.ws + WS_RG);
    float sv_l[2] = {0.f, 0.f}; int si_l[2] = {0, 0};
#pragma unroll
    for (int c = 0; c < 2; ++c) {
        const bf16_t* qv = Q + (size_t)t * D + h * 256 + c * 128;
        const unsigned qw = ((const unsigned*)qv)[lane];
        const float qa = bf2f(qw & 0xffffu), qb = bf2f(qw >> 16);
        const bf16_t* k0p = KB + ((size_t)(h * 2 + c) * NKEYS + lane) * 128;
        const bf16_t* k1p = k0p + 64 * 128;
        float s0 = 0.f, s1 = 0.f;
#pragma unroll
        for (int w = 0; w < 16; ++w) {
            float k0f[8], k1f[8]; unpack8(((const u32x4*)k0p)[w], k0f); unpack8(((const u32x4*)k1p)[w], k1f);
#pragma unroll
            for (int e = 0; e < 8; e += 2) {
                const int src = 4 * w + e / 2;
                const float xa = __int_as_float(__builtin_amdgcn_readlane(__float_as_int(qa), src));
                const float xb = __int_as_float(__builtin_amdgcn_readlane(__float_as_int(qb), src));
                s0 = fmaf(xa, k0f[e], s0); s0 = fmaf(xb, k0f[e + 1], s0);
                s1 = fmaf(xa, k1f[e], s1); s1 = fmaf(xb, k1f[e + 1], s1);
            }
        }
        unsigned long long ka = ((unsigned long long)fkey(s0) << 32) | (unsigned)(255 - lane);
        unsigned long long kb = ((unsigned long long)fkey(s1) << 32) | (unsigned)(255 - (lane + 64));
        for (int rnd = 0; rnd < TOPK; ++rnd) {
            const unsigned long long best = wave_max64(ka > kb ? ka : kb);
            if (ka == best) ka = 0ull; if (kb == best) kb = 0ull;
            if (lane == rnd) { sv_l[c] = fkey_inv((unsigned)(best >> 32)); si_l[c] = 255 - (int)(best & 0xffffffffu); }
        }
    }
    unsigned long long kc[4];
#pragma unroll
    for (int m = 0; m < 4; ++m) { const int cid = lane + 64 * m, i = cid >> 4, j = cid & 15;
        const float v = __shfl(sv_l[0], i) + __shfl(sv_l[1], j);
        kc[m] = ((unsigned long long)fkey(v) << 32) | (unsigned)(1023 - cid); }
    float fv = 0.f; int cidx = 0;
    for (int rnd = 0; rnd < TOPK; ++rnd) {
        unsigned long long loc = kc[0] > kc[1] ? kc[0] : kc[1]; const unsigned long long loc2 = kc[2] > kc[3] ? kc[2] : kc[3]; loc = loc > loc2 ? loc : loc2;
        const unsigned long long best = wave_max64(loc);
#pragma unroll
        for (int m = 0; m < 4; ++m) if (kc[m] == best) kc[m] = 0ull;
        if (lane == rnd) { fv = fkey_inv((unsigned)(best >> 32)); cidx = 1023 - (int)(best & 0xffffffffu); }
    }
    const float fmax_ = __shfl(fv, 0);
    float e = lane < 16 ? __expf(fv - fmax_) : 0.f;
    float ssum = e;
#pragma unroll
    for (int o = 1; o < 16; o <<= 1) ssum += __shfl_xor(ssum, o);
    const int ci = cidx >> 4, cj = cidx & 15;
    const int e0 = __shfl(si_l[0], ci), e1 = __shfl(si_l[1], cj);
    if (lane < 16) { RIDX[(size_t)t * 128 + h * 16 + lane] = e0 * NKEYS + e1; RG[(size_t)t * 128 + h * 16 + lane] = e / ssum; }
}

typedef float f32x2 __attribute__((ext_vector_type(2)));
__device__ __forceinline__ void fp4_row_load(const float* __restrict__ src, const float* __restrict__ kscale, int lane, f32x4 (&v)[8]) {
#pragma unroll
    for (int j = 0; j < 8; ++j) { v[j] = ((const f32x4*)src)[64 * j + lane]; if (kscale) v[j] = v[j] * ((const f32x4*)kscale)[64 * j + lane]; }
}
__device__ __forceinline__ void fp4_row_finish(const f32x4 (&v)[8], unsigned char* __restrict__ dst, float* __restrict__ scale_out, int lane) {
    float mx = 0.f;
#pragma unroll
    for (int j = 0; j < 8; ++j) mx = fmaxf(mx, fmaxf(fmaxf(fabsf(v[j].x), fabsf(v[j].y)), fmaxf(fabsf(v[j].z), fabsf(v[j].w))));
#pragma unroll
    for (int o = 1; o < 64; o <<= 1) mx = fmaxf(mx, __shfl_xor(mx, o));
    const float sc = mx > 0.f ? mx * (1.f / 6.f) : 1.f, inv = 1.f / sc;
    u32x4 out;
#pragma unroll
    for (int w = 0; w < 4; ++w) {
        const f32x4 a = v[2 * w] * inv, b = v[2 * w + 1] * inv;
        unsigned pk = 0u;
        pk = __builtin_amdgcn_cvt_scalef32_pk_fp4_f32(pk, fminf(fmaxf(a.x, -6.f), 6.f), fminf(fmaxf(a.y, -6.f), 6.f), 1.0f, 0);
        pk = __builtin_amdgcn_cvt_scalef32_pk_fp4_f32(pk, fminf(fmaxf(a.z, -6.f), 6.f), fminf(fmaxf(a.w, -6.f), 6.f), 1.0f, 1);
        pk = __builtin_amdgcn_cvt_scalef32_pk_fp4_f32(pk, fminf(fmaxf(b.x, -6.f), 6.f), fminf(fmaxf(b.y, -6.f), 6.f), 1.0f, 2);
        pk = __builtin_amdgcn_cvt_scalef32_pk_fp4_f32(pk, fminf(fmaxf(b.z, -6.f), 6.f), fminf(fmaxf(b.w, -6.f), 6.f), 1.0f, 3);
        out[w] = pk;
    }
    ((u32x4*)dst)[lane] = out;
    if (lane == 0) *scale_out = sc;
}
__device__ __forceinline__ void fp4_tables(const Params& p, int gw, int NW, int lane) {
    f32x4 va[8], vb[8];
#define FP4_LOAD(r, v) do { if ((r) < 16384) fp4_row_load(p.in[25] + (size_t)(r) * D, p.in[22], lane, v); else fp4_row_load(p.in[26] + (size_t)((r) - 16384) * D, nullptr, lane, v); } while (0)
#define FP4_FIN(r, v) do { if ((r) < 16384) fp4_row_finish(v, p.ws + WS_TABU + (size_t)(r) * 1024, (float*)(p.ws + WS_SCU) + (r), lane); \
        else fp4_row_finish(v, p.ws + WS_TABV + (size_t)((r) - 16384) * 1024, (float*)(p.ws + WS_SCV) + ((r) - 16384), lane); } while (0)
    const int n = 2 * 16384;
    int r = gw;
    if (r < n) FP4_LOAD(r, va);
    for (; r < n; r += 2 * NW) {
        const bool hb = r + NW < n;
        if (hb) FP4_LOAD(r + NW, vb);
        FP4_FIN(r, va);
        if (r + 2 * NW < n) FP4_LOAD(r + 2 * NW, va);
        if (hb) FP4_FIN(r + NW, vb);
    }
#undef FP4_LOAD
#undef FP4_FIN
}
struct RowB8 { u32x4 w[8]; };
__device__ __forceinline__ void peer_load_batch(RowB8& buf, const unsigned char* tab, int isel, int pbase, int lane) {
#pragma unroll
    for (int r = 0; r < 8; ++r) { const int e = __builtin_amdgcn_readlane(isel, (pbase + r) & 63);
        buf.w[r] = *(const u32x4*)(tab + (size_t)e * 1024 + lane * 16); }
}
__device__ __forceinline__ float dot_row(const u32x4 w, const float (&xf)[32]) {
    float a0 = 0.f, a1 = 0.f;
#pragma unroll
    for (int q = 0; q < 4; ++q) {
        const f32x2 a = __builtin_amdgcn_cvt_scalef32_pk_f32_fp4(w[q], 1.0f, 0), b = __builtin_amdgcn_cvt_scalef32_pk_f32_fp4(w[q], 1.0f, 1);
        const f32x2 c = __builtin_amdgcn_cvt_scalef32_pk_f32_fp4(w[q], 1.0f, 2), d = __builtin_amdgcn_cvt_scalef32_pk_f32_fp4(w[q], 1.0f, 3);
        a0 = fmaf(a.x, xf[8 * q], a0); a1 = fmaf(a.y, xf[8 * q + 1], a1); a0 = fmaf(b.x, xf[8 * q + 2], a0); a1 = fmaf(b.y, xf[8 * q + 3], a1);
        a0 = fmaf(c.x, xf[8 * q + 4], a0); a1 = fmaf(c.y, xf[8 * q + 5], a1); a0 = fmaf(d.x, xf[8 * q + 6], a0); a1 = fmaf(d.y, xf[8 * q + 7], a1);
    }
    return a0 + a1;
}
__device__ __forceinline__ void axpy_row(const u32x4 w, const float a_, float (&of)[32]) {
#pragma unroll
    for (int q = 0; q < 4; ++q) {
        const f32x2 a = __builtin_amdgcn_cvt_scalef32_pk_f32_fp4(w[q], 1.0f, 0), b = __builtin_amdgcn_cvt_scalef32_pk_f32_fp4(w[q], 1.0f, 1);
        const f32x2 c = __builtin_amdgcn_cvt_scalef32_pk_f32_fp4(w[q], 1.0f, 2), d = __builtin_amdgcn_cvt_scalef32_pk_f32_fp4(w[q], 1.0f, 3);
        of[8 * q] = fmaf(a_, a.x, of[8 * q]); of[8 * q + 1] = fmaf(a_, a.y, of[8 * q + 1]); of[8 * q + 2] = fmaf(a_, b.x, of[8 * q + 2]); of[8 * q + 3] = fmaf(a_, b.y, of[8 * q + 3]);
        of[8 * q + 4] = fmaf(a_, c.x, of[8 * q + 4]); of[8 * q + 5] = fmaf(a_, c.y, of[8 * q + 5]); of[8 * q + 6] = fmaf(a_, d.x, of[8 * q + 6]); of[8 * q + 7] = fmaf(a_, d.y, of[8 * q + 7]);
    }
}
__device__ __forceinline__ void peer_token(const Params& p, int t, int lane, LAS float* actL) {
    const bf16_t* XB = (const bf16_t*)(p.ws + WS_X2BF); const unsigned char* TU = p.ws + WS_TABU; const unsigned char* TV = p.ws + WS_TABV;
    const float* SCU = (const float*)(p.ws + WS_SCU); const float* SCV = (const float*)(p.ws + WS_SCV);
    const int* RIDX = (const int*)(p.ws + WS_RIDX); const float* RG = (const float*)(p.ws + WS_RG); const float* SS2 = (const float*)(p.ws + WS_CTL + CTL_SS2_BYTE);
    float xf[32];
#pragma unroll
    for (int j = 0; j < 8; ++j) { const u32x2 w = *(const u32x2*)(XB + (size_t)t * D + 256 * j + 4 * lane);
        xf[4 * j] = __uint_as_float(w.x << 16); xf[4 * j + 1] = __uint_as_float(w.x & 0xffff0000u); xf[4 * j + 2] = __uint_as_float(w.y << 16); xf[4 * j + 3] = __uint_as_float(w.y & 0xffff0000u); }
    const float rs = rsqrtf(SS2[t] * (1.f / D) + EPS);
    const int i0 = RIDX[(size_t)t * 128 + lane], i1 = RIDX[(size_t)t * 128 + 64 + lane];
    const float su0 = SCU[i0] * rs, su1 = SCU[i1] * rs;
    const float gv0 = RG[(size_t)t * 128 + lane] * SCV[i0], gv1 = RG[(size_t)t * 128 + 64 + lane] * SCV[i1];
    RowB8 A, B;
    const int rl = 4 * ((lane >> 5) & 1) + 2 * ((lane >> 4) & 1) + ((lane >> 3) & 1);
#define PEER_DOT(buf, pb) do { float d[8]; \
        _Pragma("unroll") for (int r = 0; r < 8; ++r) { u32x4 w_ = buf.w[r]; asm volatile("" : "+v"(w_)); d[r] = dot_row(w_, xf); asm volatile("" : "+v"(d[r])); } \
        const bool u5 = (lane & 32) != 0; float k4[4]; \
        _Pragma("unroll") for (int q = 0; q < 4; ++q) k4[q] = (u5 ? d[4 + q] : d[q]) + __shfl_xor(u5 ? d[q] : d[4 + q], 32); \
        const bool u4 = (lane & 16) != 0; float k2[2]; \
        _Pragma("unroll") for (int q = 0; q < 2; ++q) k2[q] = (u4 ? k4[2 + q] : k4[q]) + __shfl_xor(u4 ? k4[q] : k4[2 + q], 16); \
        const bool u3 = (lane & 8) != 0; \
        float v = (u3 ? k2[1] : k2[0]) + __shfl_xor(u3 ? k2[0] : k2[1], 8); \
        v += __shfl_xor(v, 4); v += __shfl_xor(v, 2); v += __shfl_xor(v, 1); \
        const int pi = (pb) + rl; const float su = __shfl(pi < 64 ? su0 : su1, pi & 63), gv = __shfl(pi < 64 ? gv0 : gv1, pi & 63); \
        if ((lane & 7) == 0) actL[pi] = gelu_tanh(v * su) * gv; } while (0)
    peer_load_batch(A, TU, i0, 0, lane);
#pragma unroll 1
    for (int b = 0; b < 16; b += 2) {
        peer_load_batch(B, TU, b < 8 ? i0 : i1, 8 * (b + 1), lane);
        PEER_DOT(A, 8 * b);
        if (b + 2 < 16) peer_load_batch(A, TU, (b + 2) < 8 ? i0 : i1, 8 * (b + 2), lane);
        PEER_DOT(B, 8 * (b + 1));
    }
#undef PEER_DOT
    float of[32];
#pragma unroll
    for (int q = 0; q < 32; ++q) of[q] = 0.f;
#define PIN_OF() do { asm volatile("" : "+v"(of[0]), "+v"(of[1]), "+v"(of[2]), "+v"(of[3]), "+v"(of[4]), "+v"(of[5]), "+v"(of[6]), "+v"(of[7]), "+v"(of[8]), "+v"(of[9]), "+v"(of[10]), "+v"(of[11]), "+v"(of[12]), "+v"(of[13]), "+v"(of[14]), "+v"(of[15])); \
        asm volatile("" : "+v"(of[16]), "+v"(of[17]), "+v"(of[18]), "+v"(of[19]), "+v"(of[20]), "+v"(of[21]), "+v"(of[22]), "+v"(of[23]), "+v"(of[24]), "+v"(of[25]), "+v"(of[26]), "+v"(of[27]), "+v"(of[28]), "+v"(of[29]), "+v"(of[30]), "+v"(of[31])); } while (0)
#define PEER_AXPY(buf, pb) do { \
        _Pragma("unroll") for (int r = 0; r < 8; ++r) { const float a = actL[(pb) + r]; u32x4 w_ = buf.w[r]; asm volatile("" : "+v"(w_)); axpy_row(w_, a, of); PIN_OF(); } } while (0)
    peer_load_batch(A, TV, i0, 0, lane);
#pragma unroll 1
    for (int b = 0; b < 16; b += 2) {
        peer_load_batch(B, TV, b < 8 ? i0 : i1, 8 * (b + 1), lane);
        PEER_AXPY(A, 8 * b);
        if (b + 2 < 16) peer_load_batch(A, TV, (b + 2) < 8 ? i0 : i1, 8 * (b + 2), lane);
        PEER_AXPY(B, 8 * (b + 1));
    }
#undef PEER_AXPY
#undef PIN_OF
    float* orow = p.out + (size_t)t * D;
#pragma unroll
    for (int j = 0; j < 8; ++j) { f32x4* o4 = (f32x4*)(orow + 256 * j + 4 * lane); f32x4 a = *o4;
        a.x += of[4 * j]; a.y += of[4 * j + 1]; a.z += of[4 * j + 2]; a.w += of[4 * j + 3]; *o4 = a; }
}

namespace pg8 {
#define PG8_LAS __attribute__((address_space(3)))
constexpr int BM = 256, BK = 64, HALF = 128, HTB = HALF * BK * 2, STAGE_BYTES = 8 * HTB, NXCD = 8, WGM = 8;
__host__ __device__ __forceinline__ int lds_byte(int r, int c) { const int st = (r >> 4) * 2 + (c >> 5), rr = r & 15, cc = c & 31, ob = rr * 64 + cc * 2; return st * 1024 + (ob ^ (((ob >> 9) & 1) << 5)); }
__host__ __device__ __forceinline__ void stage_rc(int b, int& R, int& C) { const int st = b / 1024, sb = b % 1024, swz = sb ^ (((sb >> 9) & 1) << 5); R = (st >> 1) * 16 + swz / 64; C = (st & 1) * 32 + (swz % 64) / 2; }
__host__ __device__ __forceinline__ int perm32(int rho) { const int n = rho >> 4, i = rho & 15; return 8 * (i >> 2) + 4 * n + (i & 3); }
struct Unit { const char* A; const char* B; int pm, pn, kind, nt; };
__device__ __forceinline__ const char* uni_ptr(const char* p) { const unsigned long long v = (unsigned long long)p; const unsigned lo = __builtin_amdgcn_readfirstlane((unsigned)v), hi = __builtin_amdgcn_readfirstlane((unsigned)(v >> 32)); return (const char*)(((unsigned long long)hi << 32) | lo); }
__device__ __forceinline__ void uni(Unit& u) { u.A = uni_ptr(u.A); u.B = uni_ptr(u.B); u.pm = __builtin_amdgcn_readfirstlane(u.pm); u.pn = __builtin_amdgcn_readfirstlane(u.pn); u.kind = __builtin_amdgcn_readfirstlane(u.kind); u.nt = __builtin_amdgcn_readfirstlane(u.nt); }
__device__ __forceinline__ void tile_of(int L, int nM, int nN, int& pm, int& pn) {
    const int nwg = nM * nN; int wgid = L; { const int q = nwg / NXCD, r = nwg % NXCD, xcd = wgid % NXCD, off = wgid / NXCD; wgid = (xcd < r ? xcd * (q + 1) : r * (q + 1) + (xcd - r) * q) + off; }
    const int nig = WGM * nN, gid = wgid / nig, fm = gid * WGM, gsz = (nM - fm) < WGM ? (nM - fm) : WGM;
    pm = fm + ((wgid % nig) % gsz); pn = (wgid % nig) / gsz;
}
typedef int v8i_t __attribute__((ext_vector_type(8))); typedef int v4i_t __attribute__((ext_vector_type(4)));
__device__ __forceinline__ v8i_t cat8(const bf16x8 lo, const bf16x8 hi) { const v4i_t a = __builtin_bit_cast(v4i_t, lo), b = __builtin_bit_cast(v4i_t, hi); return __builtin_shufflevector(a, b, 0, 1, 2, 3, 4, 5, 6, 7); }
template <bool FP8, class Epi, class Sched>
__device__ __forceinline__ void gemm_phase(PG8_LAS unsigned char* lds, const int lda, const int ldb, const Sched& S, const Epi& E) {
    const int tid = threadIdx.x, wid = __builtin_amdgcn_readfirstlane(tid >> 6), lane = tid & 63, wr = wid >> 2, wc = wid & 3, fr = lane & 15, fq = lane >> 4;
    unsigned voffA[2], voffB[2];
#pragma unroll
    for (int i = 0; i < 2; ++i) { int R, C; stage_rc(tid * 16 + i * 8192, R, C); const int Rb = (R & ~31) + perm32(R & 31);
        voffA[i] = (unsigned)(R * lda + C) * 2u; voffB[i] = (unsigned)(Rb * ldb + C) * 2u; }
    const size_t kstep = (size_t)(BK * 2);
    const size_t hstepA = (size_t)HALF * lda * 2, hstepB = (size_t)HALF * ldb * 2;
    const unsigned ldsw = (unsigned)wid * 1024u;
    const int aoff = lds_byte(wr * 64 + fr, fq * 8), boff = lds_byte(wc * 32 + fr, fq * 8);
#define PG8_SA(b, h) (((b) * 2 + (h)) * HTB)
#define PG8_SB(b, h) ((4 + (b) * 2 + (h)) * HTB)
#define PG8_STAGE(bufoff, gbase, voff) do { _Pragma("unroll") for (int _i = 0; _i < 2; ++_i) \
        __builtin_amdgcn_global_load_lds((const unsigned*)((const char*)(gbase) + (voff)[_i]), (PG8_LAS unsigned*)(lds + (bufoff) + ldsw + _i * 8192), 16, 0, 0); } while (0)
#define PG8_LDA(dst, b, h) do { _Pragma("unroll") for (int m = 0; m < 4; ++m) { if constexpr (FP8) dst##8[m] = cat8(*(const PG8_LAS bf16x8*)(lds + PG8_SA(b, h) + aoff + m * 2048), *(const PG8_LAS bf16x8*)(lds + PG8_SA(b, h) + aoff + m * 2048 + 1024)); \
        else { _Pragma("unroll") for (int k = 0; k < 2; ++k) dst[m][k] = *(const PG8_LAS bf16x8*)(lds + PG8_SA(b, h) + aoff + m * 2048 + k * 1024); } } } while (0)
#define PG8_LDB(dst, b, h) do { _Pragma("unroll") for (int n = 0; n < 2; ++n) { if constexpr (FP8) dst##8[n] = cat8(*(const PG8_LAS bf16x8*)(lds + PG8_SB(b, h) + boff + n * 2048), *(const PG8_LAS bf16x8*)(lds + PG8_SB(b, h) + boff + n * 2048 + 1024)); \
        else { _Pragma("unroll") for (int k = 0; k < 2; ++k) dst[n][k] = *(const PG8_LAS bf16x8*)(lds + PG8_SB(b, h) + boff + n * 2048 + k * 1024); } } } while (0)
#define PG8_MMA(ai, bj, At, Bt) do { __builtin_amdgcn_s_setprio(1); \
        if constexpr (FP8) { _Pragma("unroll") for (int m = 0; m < 4; ++m) _Pragma("unroll") for (int n = 0; n < 2; ++n) \
            asm volatile("v_mfma_scale_f32_16x16x128_f8f6f4 %0, %1, %2, %0, %3, %3 op_sel_hi:[0,0,0]" : "+v"(acc[ai][bj][m][n]) : "v"(Bt##8[n]), "v"(At##8[m]), "v"(mxone)); } \
        else { _Pragma("unroll") for (int m = 0; m < 4; ++m) _Pragma("unroll") for (int n = 0; n < 2; ++n) _Pragma("unroll") for (int k = 0; k < 2; ++k) \
            acc[ai][bj][m][n] = __builtin_amdgcn_mfma_f32_16x16x32_bf16(Bt[n][k], At[m][k], acc[ai][bj][m][n], 0, 0, 0); } \
        __builtin_amdgcn_s_setprio(0); } while (0)
#define PG8_WAIT_V(n) asm volatile("s_waitcnt vmcnt(" #n ")" ::: "memory")
#define PG8_WAIT_L(n) asm volatile("s_waitcnt lgkmcnt(" #n ")" ::: "memory")
#define PG8_BAR __builtin_amdgcn_s_barrier()
#define PG8_SCHED __builtin_amdgcn_sched_barrier(0)
    Unit cur, nxt; int ui = 0;
    if (!S.next(0, cur)) return;
    f32x4 acc[2][2][4][2];
#pragma unroll
    for (int a = 0; a < 2; ++a)
#pragma unroll
        for (int b = 0; b < 2; ++b)
#pragma unroll
            for (int m = 0; m < 4; ++m)
#pragma unroll
                for (int n = 0; n < 2; ++n) acc[a][b][m][n] = (f32x4){0.f, 0.f, 0.f, 0.f};
    const int mxone = 0x7F7F7F7F;
    bf16x8 At[4][2], B0[2][2], B1[2][2]; v8i_t At8[4], B08[2], B18[2];
    const char* cA = cur.A; const char* cB = cur.B;
    PG8_STAGE(PG8_SB(0, 0), cB, voffB); PG8_STAGE(PG8_SB(0, 1), cB + hstepB, voffB); PG8_STAGE(PG8_SA(0, 0), cA, voffA); PG8_STAGE(PG8_SA(0, 1), cA + hstepA, voffA);
    if (wr == 1) PG8_BAR;
    PG8_WAIT_V(2); PG8_BAR;
    PG8_STAGE(PG8_SB(1, 0), cB + kstep, voffB); PG8_STAGE(PG8_SA(1, 0), cA + kstep, voffA); PG8_STAGE(PG8_SB(1, 1), cB + hstepB + kstep, voffB);
    PG8_WAIT_V(6); PG8_BAR;
    for (;;) {
        const bool has_next = S.next(ui + 1, nxt);
        const char* nA = has_next ? nxt.A : cA; const char* nB = has_next ? nxt.B : cB;
        const int nt = cur.nt;
        for (int t = 0; t < nt; t += 2) {
            const bool last = (t == nt - 2);
            const char* a1 = cA + (size_t)(t + 1) * kstep;
            const char* a2 = last ? nA : cA + (size_t)(t + 2) * kstep; const char* b2 = last ? nB : cB + (size_t)(t + 2) * kstep;
            const char* a3 = a2 + kstep; const char* b3 = b2 + kstep;
            PG8_LDB(B0, 0, 0); PG8_LDB(B1, 0, 1); PG8_SCHED; PG8_LDA(At, 0, 0); PG8_STAGE(PG8_SA(1, 1), a1 + hstepA, voffA);
            PG8_WAIT_V(8); PG8_WAIT_L(0); PG8_BAR; PG8_MMA(0, 0, At, B0); PG8_MMA(0, 1, At, B1); PG8_BAR; PG8_SCHED;
            PG8_LDA(At, 0, 1); PG8_STAGE(PG8_SB(0, 0), b2, voffB); PG8_STAGE(PG8_SB(0, 1), b2 + hstepB, voffB); PG8_STAGE(PG8_SA(0, 0), a2, voffA);
            PG8_WAIT_V(8); PG8_WAIT_L(0); PG8_BAR; PG8_MMA(1, 0, At, B0); PG8_MMA(1, 1, At, B1); PG8_BAR; PG8_SCHED;
            PG8_LDB(B0, 1, 0); PG8_LDB(B1, 1, 1); PG8_SCHED; PG8_LDA(At, 1, 0); PG8_STAGE(PG8_SA(0, 1), a2 + hstepA, voffA);
            PG8_WAIT_V(8); PG8_WAIT_L(0); PG8_BAR; PG8_MMA(0, 0, At, B0); PG8_MMA(0, 1, At, B1); PG8_BAR; PG8_SCHED;
            PG8_LDA(At, 1, 1); PG8_STAGE(PG8_SB(1, 0), b3, voffB); PG8_STAGE(PG8_SB(1, 1), b3 + hstepB, voffB); PG8_STAGE(PG8_SA(1, 0), a3, voffA);
            PG8_WAIT_V(8); PG8_WAIT_L(0); PG8_BAR; PG8_MMA(1, 0, At, B0); PG8_MMA(1, 1, At, B1); PG8_BAR; PG8_SCHED;
        }
        if (wr == 0) PG8_BAR;
        if constexpr (FP8) asm volatile("s_nop 15\n\ts_nop 15" ::: "memory");
        E(acc, cur, wr, wc, fr, fq);
        if (!has_next) break;
        if (E.reset(cur)) {
#pragma unroll
        for (int a = 0; a < 2; ++a)
#pragma unroll
            for (int b = 0; b < 2; ++b)
#pragma unroll
                for (int m = 0; m < 4; ++m)
#pragma unroll
                    for (int n = 0; n < 2; ++n) acc[a][b][m][n] = (f32x4){0.f, 0.f, 0.f, 0.f};
        }
        cur = nxt; cA = nA; cB = nB; ++ui;
        if (wr == 1) PG8_BAR;
    }
    PG8_WAIT_V(0);
    PG8_BAR;
#undef PG8_SA
#undef PG8_SB
#undef PG8_STAGE
#undef PG8_LDA
#undef PG8_LDB
#undef PG8_MMA
#undef PG8_WAIT_V
#undef PG8_WAIT_L
#undef PG8_BAR
#undef PG8_SCHED
}
}
typedef f32x4 AccT[2][2][4][2];
#define EPI_RESET_ALWAYS __device__ __forceinline__ bool reset(const pg8::Unit&) const { return true; }
__device__ __forceinline__ unsigned cvt_pk_bf16(float lo, float hi) { unsigned r; asm volatile("v_cvt_pk_bf16_f32 %0, %1, %2" : "=v"(r) : "v"(lo), "v"(hi)); return r; }
__device__ __forceinline__ u32x4 pack8(const f32x4 v0, const f32x4 v1) { u32x4 w; w.x = cvt_pk_bf16(v0[0], v0[1]); w.y = cvt_pk_bf16(v0[2], v0[3]); w.z = cvt_pk_bf16(v1[0], v1[1]); w.w = cvt_pk_bf16(v1[2], v1[3]); return w; }
template <int MODE>
__device__ __forceinline__ void store_tile_bf16(const AccT& acc, bf16_t* base, int ldc, int row0, int col0, const float* bias, const float ascale = 1.f) {
#pragma unroll
    for (int ai = 0; ai < 2; ++ai)
#pragma unroll
        for (int m = 0; m < 4; ++m) { bf16_t* rowp = base + (size_t)(row0 + ai * 128 + m * 16) * ldc + col0;
#pragma unroll
            for (int bj = 0; bj < 2; ++bj) { f32x4 v0 = acc[ai][bj][m][0], v1 = acc[ai][bj][m][1];
                if (MODE == 1) { _Pragma("unroll") for (int e = 0; e < 4; ++e) { v0[e] = gelu_tanh(v0[e]); v1[e] = gelu_tanh(v1[e]); } }
                if (MODE == 2) { const f32x4 b0 = *(const f32x4*)(bias + col0 + bj * 128), b1 = *(const f32x4*)(bias + col0 + bj * 128 + 4);
                    v0 = v0 * ascale + b0; v1 = v1 * ascale + b1; _Pragma("unroll") for (int e = 0; e < 4; ++e) { v0[e] = sigmoid_(v0[e]); v1[e] = sigmoid_(v1[e]); } }
                *(u32x4*)(rowp + bj * 128) = pack8(v0, v1); }
            if (MODE == 2) asm volatile("" ::: "memory"); }
}
struct SchedP1a { const char* H; const char* WT; const char* MEMN; const char* WTM; int G, c;
    __device__ __forceinline__ bool next(int i, pg8::Unit& u) const {
        const int L = i * G + c; const int n1 = 64 * 18;
        if (L < n1) { pg8::tile_of(L, 64, 18, u.pm, u.pn); u.kind = 0; u.A = H + (size_t)u.pm * 256 * D * 2; u.B = WT + (size_t)u.pn * 256 * D * 2; u.nt = D / 64; pg8::uni(u); return true; }
        if (L < n1 + 8) { const int j = L - n1; u.pm = j >> 2; u.pn = j & 3; u.kind = 1; u.A = MEMN + (size_t)u.pm * 256 * D * 2; u.B = WTM + (size_t)u.pn * 256 * D * 2; u.nt = D / 64; pg8::uni(u); return true; }
        return false; } };
struct EpiP1a { bf16_t* PROJ; bf16_t* MEMKV; EPI_RESET_ALWAYS
    __device__ __forceinline__ void operator()(AccT& acc, const pg8::Unit& u, int wr, int wc, int fr, int fq) const {
        const int row0 = u.pm * 256 + wr * 64 + fr, cl = wc * 32 + 8 * fq;
        if (u.kind == 1) { store_tile_bf16<0>(acc, MEMKV, 2 * CW, row0, u.pn * 256 + cl, nullptr); return; }
        if (u.pn == 14 || u.pn == 15) { store_tile_bf16<1>(acc, PROJ, INW, row0, u.pn * 256 + cl, nullptr); return; }
        store_tile_bf16<0>(acc, PROJ, INW, row0, u.pn * 256 + cl, nullptr);
    } };
struct SchedP1b { const char* H8; const char* WT8; int G, c;
    __device__ __forceinline__ bool next(int i, pg8::Unit& u) const {
        const int L = i * G + c; if (L >= 64 * 24) return false;
        pg8::tile_of(L, 64, 24, u.pm, u.pn); u.kind = 0; u.A = H8 + (size_t)u.pm * 256 * D; u.B = WT8 + (size_t)u.pn * 256 * D; u.nt = D / 128; pg8::uni(u); return true; } };
struct EpiP1b { bf16_t* G; const float* bgate; EPI_RESET_ALWAYS
    __device__ __forceinline__ void operator()(AccT& acc, const pg8::Unit& u, int wr, int wc, int fr, int fq) const {
        store_tile_bf16<2>(acc, G, GW, u.pm * 256 + wr * 64 + fr, u.pn * 256 + wc * 32 + 8 * fq, bgate, 1.f / GATE_WSCALE);
    } };
struct SchedP3 { const char* O; const char* WT; int G, c;
    __device__ __forceinline__ bool next(int i, pg8::Unit& u) const {
        const int ti = i / 3, seg = i - 3 * ti; const int L = ti * G + c; if (L >= 64 * 8) return false;
        pg8::tile_of(L, 64, 8, u.pm, u.pn); u.kind = seg;
        const int kb = seg == 0 ? 0 : (seg == 1 ? 1024 : 1536);
        u.A = O + ((size_t)u.pm * 256 * D + kb) * 2; u.B = WT + ((size_t)u.pn * 256 * D + kb) * 2; u.nt = seg == 0 ? 16 : 8; pg8::uni(u); return true; } };
struct EpiP3 { const bf16_t* G; bf16_t* MERGED;
    __device__ __forceinline__ bool reset(const pg8::Unit& u) const { return u.kind == 2; }
    __device__ __forceinline__ void operator()(AccT& acc, const pg8::Unit& u, int wr, int wc, int fr, int fq) const {
        const int row0 = u.pm * 256 + wr * 64 + fr, col0 = u.pn * 256 + wc * 32 + 8 * fq, seg = u.kind;
#pragma unroll
        for (int ai = 0; ai < 2; ++ai)
#pragma unroll
            for (int mh = 0; mh < 2; ++mh) {
                u32x4 ga[2][2], gb[2][2];
#pragma unroll
                for (int mm = 0; mm < 2; ++mm)
#pragma unroll
                    for (int bj = 0; bj < 2; ++bj) { const bf16_t* gp = G + (size_t)(row0 + ai * 128 + (mh * 2 + mm) * 16) * GW + col0 + bj * 128;
                        ga[mm][bj] = *(const u32x4*)(gp + seg * D); gb[mm][bj] = (seg < 2) ? *(const u32x4*)(gp + (seg + 1) * D) : (u32x4){0u, 0u, 0u, 0u}; }
#pragma unroll
                for (int mm = 0; mm < 2; ++mm)
#pragma unroll
                    for (int bj = 0; bj < 2; ++bj) { const int m = mh * 2 + mm;
                        float fa[8], fb[8]; unpack8(ga[mm][bj], fa); unpack8(gb[mm][bj], fb);
                        if (seg < 2) { _Pragma("unroll") for (int e = 0; e < 8; ++e) fa[e] = fa[e] * __builtin_amdgcn_rcpf(fmaxf(fb[e], 1e-20f)); }
                        f32x4& v0 = acc[ai][bj][m][0]; f32x4& v1 = acc[ai][bj][m][1];
                        v0[0] *= fa[0]; v0[1] *= fa[1]; v0[2] *= fa[2]; v0[3] *= fa[3]; v1[0] *= fa[4]; v1[1] *= fa[5]; v1[2] *= fa[6]; v1[3] *= fa[7];
                        if (seg == 2) *(u32x4*)(MERGED + (size_t)(row0 + ai * 128 + m * 16) * D + col0 + bj * 128) = pack8(v0, v1);
                    }
                asm volatile("" ::: "memory");
            }
    } };
struct SchedSq { const char* A; const char* WT; int G, c;
    __device__ __forceinline__ bool next(int i, pg8::Unit& u) const {
        const int L = i * G + c; if (L >= 64 * 8) return false;
        pg8::tile_of(L, 64, 8, u.pm, u.pn); u.kind = 0; u.A = A + (size_t)u.pm * 256 * D * 2; u.B = WT + (size_t)u.pn * 256 * D * 2; u.nt = D / 64; pg8::uni(u); return true; } };
struct EpiP4 { const float* x; float* out; bf16_t* xb; float* ss; EPI_RESET_ALWAYS
    __device__ __forceinline__ void operator()(AccT& acc, const pg8::Unit& u, int wr, int wc, int fr, int fq) const {
        const int row0 = u.pm * 256 + wr * 64 + fr, col0 = u.pn * 256 + wc * 32 + 8 * fq;
#pragma unroll
        for (int ai = 0; ai < 2; ++ai)
#pragma unroll
            for (int m = 0; m < 4; ++m) { const size_t row = (size_t)(row0 + ai * 128 + m * 16); float sq = 0.f;
#pragma unroll
                for (int bj = 0; bj < 2; ++bj) { const size_t o = row * D + col0 + bj * 128;
                    const f32x4 v0 = acc[ai][bj][m][0] + *(const f32x4*)(x + o), v1 = acc[ai][bj][m][1] + *(const f32x4*)(x + o + 4);
                    *(f32x4*)(out + o) = v0; *(f32x4*)(out + o + 4) = v1; *(u32x4*)(xb + o) = pack8(v0, v1);
                    sq += (v0[0] * v0[0] + v0[1] * v0[1]) + (v0[2] * v0[2] + v0[3] * v0[3]) + (v1[0] * v1[0] + v1[1] * v1[1]) + (v1[2] * v1[2] + v1[3] * v1[3]); }
                sq += __shfl_xor(sq, 16); sq += __shfl_xor(sq, 32);
                if (fq == 0) atomicAdd(ss + row, sq); }
    } };
struct EpiP5 { bf16_t* Q; const float* ss; EPI_RESET_ALWAYS
    __device__ __forceinline__ void operator()(AccT& acc, const pg8::Unit& u, int wr, int wc, int fr, int fq) const {
        const int row0 = u.pm * 256 + wr * 64 + fr, col0 = u.pn * 256 + wc * 32 + 8 * fq;
#pragma unroll
        for (int ai = 0; ai < 2; ++ai)
#pragma unroll
            for (int m = 0; m < 4; ++m) { const size_t row = (size_t)(row0 + ai * 128 + m * 16); const float rs = rsqrtf(ss[row] * (1.f / D) + EPS);
#pragma unroll
                for (int bj = 0; bj < 2; ++bj) *(u32x4*)(Q + row * D + col0 + bj * 128) = pack8(acc[ai][bj][m][0] * rs, acc[ai][bj][m][1] * rs); }
    } };


namespace att {
using s16x4  = __attribute__((ext_vector_type(4))) short;
using f32x16 = __attribute__((ext_vector_type(16))) float;
constexpr int NWV = 8, QBLK = 32, KVBLK = 64, DH = 128;
constexpr float THR = 8.f;
constexpr int SHM_V = KVBLK * DH * 2, SHM_K = KVBLK * DH * 2;
constexpr int OFF_WS = 2 * SHM_V + 2 * SHM_K, OFF_BT = OFF_WS + NWV * 64 * 4, OFF_OST = OFF_BT + 1536, LDS_NEED = OFF_OST + NWV * 8192;
#define KSWZ(row, colB) ((row) * 256 + ((colB) ^ (((row) & 7) << 4)))
#define SBAR() __builtin_amdgcn_sched_barrier(0)
__device__ __forceinline__ int crow(int r, int hi) { return (r & 3) + 8 * (r >> 2) + 4 * hi; }
__device__ __forceinline__ unsigned cvtpk(float lo, float hi) { unsigned r; asm volatile("v_cvt_pk_bf16_f32 %0, %1, %2" : "=v"(r) : "v"(lo), "v"(hi)); return r; }
__device__ __forceinline__ void partialSM(f32x16& p0, f32x16& p1, float& m_reg, float& mn, float& alpha) {
  constexpr float C = 1.4426950408889634f;
  float pmax = p0[0];
#pragma unroll
  for (int r = 1; r < 16; ++r) pmax = fmaxf(pmax, p0[r]);
#pragma unroll
  for (int r = 0; r < 16; ++r) pmax = fmaxf(pmax, p1[r]);
  { auto rr = __builtin_amdgcn_permlane32_swap(__float_as_uint(pmax), __float_as_uint(pmax), false, false);
    pmax = fmaxf(__uint_as_float(rr[0]), __uint_as_float(rr[1])); }
  if (__builtin_expect(__all(pmax - m_reg <= THR), 1)) { mn = m_reg; alpha = 1.f; }
  else { mn = fmaxf(m_reg, pmax); alpha = __builtin_amdgcn_exp2f((m_reg - mn) * C); m_reg = mn; }
  float mnC = -mn * C;
#pragma unroll
  for (int r = 0; r < 16; ++r) p0[r] = fmaf(p0[r], C, mnC);
#pragma unroll
  for (int r = 0; r < 16; ++r) p1[r] = fmaf(p1[r], C, mnC);
#pragma unroll
  for (int r = 0; r < 16; ++r) p0[r] = __builtin_amdgcn_exp2f(p0[r]);
}
__device__ __forceinline__ void finishSM(f32x16& p0, f32x16& p1, float alpha, float& l_reg, bf16x8& pa0, bf16x8& pa1, bf16x8& pa2, bf16x8& pa3) {
#pragma unroll
  for (int r = 0; r < 16; ++r) p1[r] = __builtin_amdgcn_exp2f(p1[r]);
  float ps = 0;
#pragma unroll
  for (int r = 0; r < 16; ++r) ps += p0[r];
#pragma unroll
  for (int r = 0; r < 16; ++r) ps += p1[r];
  { auto rr = __builtin_amdgcn_permlane32_swap(__float_as_uint(ps), __float_as_uint(ps), false, false);
    ps = __uint_as_float(rr[0]) + __uint_as_float(rr[1]); }
  l_reg = l_reg * alpha + ps;
#define PK4(P, BASE, OUT) do { unsigned a0 = cvtpk(P[BASE + 0], P[BASE + 1]), a1 = cvtpk(P[BASE + 2], P[BASE + 3]);   \
    unsigned b0 = cvtpk(P[BASE + 4], P[BASE + 5]), b1 = cvtpk(P[BASE + 6], P[BASE + 7]);                              \
    auto r0 = __builtin_amdgcn_permlane32_swap(a0, b0, false, false); auto r1 = __builtin_amdgcn_permlane32_swap(a1, b1, false, false); \
    u32x4 w = {r0[0], r1[0], r0[1], r1[1]}; OUT = *reinterpret_cast<bf16x8*>(&w); } while (0)
  PK4(p0, 0, pa0); PK4(p0, 8, pa1); PK4(p1, 0, pa2); PK4(p1, 8, pa3);
#undef PK4
}
template <bool BIAS>
__device__ __forceinline__ void qkt(f32x16& p0, f32x16& p1, const LAS char* Ks, const LAS char* qs, int r32, int hi, const LAS float* bp) {
  if (BIAS) {
#pragma unroll
    for (int r = 0; r < 16; ++r) { p0[r] = bp[(r & 3) + 8 * (r >> 2)]; p1[r] = bp[32 + (r & 3) + 8 * (r >> 2)]; }
  } else { p0 = f32x16{}; p1 = f32x16{}; }
#pragma unroll
  for (int d0 = 0; d0 < 8; ++d0) { int cb = (d0 * 16 + hi * 8) * 2;
    bf16x8 b0 = *reinterpret_cast<const LAS bf16x8*>(Ks + KSWZ(r32, cb));
    bf16x8 b1 = *reinterpret_cast<const LAS bf16x8*>(Ks + KSWZ(32 + r32, cb));
    const bf16x8 qv = *reinterpret_cast<const LAS bf16x8*>(qs + d0 * 1024);
    p0 = __builtin_amdgcn_mfma_f32_32x32x16_bf16(b0, qv, p0, 0, 0, 0);
    p1 = __builtin_amdgcn_mfma_f32_32x32x16_bf16(b1, qv, p1, 0, 0, 0); }
}
__device__ __forceinline__ int v_st(int k, int c) { const int kk = (k & ~0xC) | ((k & 4) << 1) | ((k & 8) >> 1); return ((kk >> 3) * 4 + (c >> 5)) * 512 + ((kk & 7) * 32 + (c & 31)) * 2; }
__device__ __forceinline__ int v_rd_base(int lane) { return ((lane & 3) << 3) | (((lane >> 2) & 3) << 6) | (((lane >> 4) & 1) << 5) | (((lane >> 5) & 1) << 8); }
constexpr int v_rd_off(int d0, int ks, int half) { return d0 * 512 + ks * 4096 + half * 2048; }
template <int OFF> __device__ __forceinline__ s16x4 tr_read(int vb) {
  s16x4 r; asm volatile("ds_read_b64_tr_b16 %0, %1 offset:%2" : "=&v"(r) : "v"(vb), "i"(OFF) : "memory"); return r;
}
template <int D0> __device__ __forceinline__ void pv_one(f32x16& od, int vb, bf16x8 pa0, bf16x8 pa1, bf16x8 pa2, bf16x8 pa3) {
  const s16x4 l0 = tr_read<v_rd_off(D0, 0, 0)>(vb), h0 = tr_read<v_rd_off(D0, 0, 1)>(vb), l1 = tr_read<v_rd_off(D0, 1, 0)>(vb), h1 = tr_read<v_rd_off(D0, 1, 1)>(vb);
  const s16x4 l2 = tr_read<v_rd_off(D0, 2, 0)>(vb), h2 = tr_read<v_rd_off(D0, 2, 1)>(vb), l3 = tr_read<v_rd_off(D0, 3, 0)>(vb), h3 = tr_read<v_rd_off(D0, 3, 1)>(vb);
  asm volatile("s_waitcnt lgkmcnt(0)" ::: "memory"); SBAR();
#define PK(L, H) (bf16x8){L[0], L[1], L[2], L[3], H[0], H[1], H[2], H[3]}
  od = __builtin_amdgcn_mfma_f32_32x32x16_bf16(pa0, PK(l0, h0), od, 0, 0, 0);
  od = __builtin_amdgcn_mfma_f32_32x32x16_bf16(pa1, PK(l1, h1), od, 0, 0, 0);
  od = __builtin_amdgcn_mfma_f32_32x32x16_bf16(pa2, PK(l2, h2), od, 0, 0, 0);
  od = __builtin_amdgcn_mfma_f32_32x32x16_bf16(pa3, PK(l3, h3), od, 0, 0, 0);
#undef PK
}
__device__ __forceinline__ void pv_d0(f32x16* o, int vb, bf16x8 pa0, bf16x8 pa1, bf16x8 pa2, bf16x8 pa3) {
  pv_one<0>(o[0], vb, pa0, pa1, pa2, pa3); pv_one<1>(o[1], vb, pa0, pa1, pa2, pa3); pv_one<2>(o[2], vb, pa0, pa1, pa2, pa3); pv_one<3>(o[3], vb, pa0, pa1, pa2, pa3);
}
template <int LDQ, int LDK, int LDO, bool BAND>
__device__ __forceinline__ void attn_body(const bf16_t* Qb, const bf16_t* Kh, const bf16_t* Vh, bf16_t* Ob,
                                          const int NT, const int kc0, const float* btab_src, LAS char* lds) {
  const int tid = threadIdx.x, wid = __builtin_amdgcn_readfirstlane(tid >> 6), lane = tid & 63, r32 = lane & 31, hi = lane >> 5;
  LAS char* V_lds = lds; LAS char* K_lds = lds + 2 * SHM_V;
  LAS float* wsf = (LAS float*)(lds + OFF_WS) + wid * 64; LAS float* li_l = wsf; LAS float* al_l = wsf + 32;
  LAS float* btab = (LAS float*)(lds + OFF_BT);
  if (BAND) { if (tid < 384) btab[tid] = tid < 64 ? btab_src[256] : (tid < 256 ? btab_src[320 - tid] : -30000.f); }
  float m_reg = -10000.f, l_reg = 0; f32x16 o[4] = {};
  const bf16_t* Qw = Qb + (long)(wid * QBLK + r32) * LDQ + hi * 8;
  LAS char* qr = lds + OFF_OST + wid * 8192 + lane * 16;
#pragma unroll
  for (int d0 = 0; d0 < 8; ++d0) *reinterpret_cast<LAS bf16x8*>(qr + d0 * 1024) = *reinterpret_cast<const bf16x8*>(Qw + d0 * 16);
  const int sr = tid >> 4, sc = (tid & 15) * 8, vst0 = v_st(sr, sc), vst1 = v_st(32 + sr, sc);
  const int vb0 = (int)(unsigned)(uintptr_t)V_lds + v_rd_base(lane);
  struct { bf16x8 vs0, vs1, ks0, ks1; } sr_[1];
  const int pw = wid >> 1, qi = (wid & 1) * 32 + r32;
#define TROW(t) ((BAND ? (((kc0) + (t)) > 0 ? ((kc0) + (t)) : 0) : (t)) * KVBLK)
#define SLOAD(i, t) do { const long k0_ = TROW(t); sr_[i].vs0 = *reinterpret_cast<const bf16x8*>(&Vh[(k0_ + sr) * LDK + sc]); sr_[i].vs1 = *reinterpret_cast<const bf16x8*>(&Vh[(k0_ + 32 + sr) * LDK + sc]); \
    sr_[i].ks0 = *reinterpret_cast<const bf16x8*>(&Kh[(k0_ + sr) * LDK + sc]); sr_[i].ks1 = *reinterpret_cast<const bf16x8*>(&Kh[(k0_ + 32 + sr) * LDK + sc]); } while (0)
#define SWRITE(b, i) do { *(LAS bf16x8*)(V_lds + (b) * SHM_V + vst0) = sr_[i].vs0; *(LAS bf16x8*)(V_lds + (b) * SHM_V + vst1) = sr_[i].vs1; int kc_ = sc * 2; \
    *(LAS bf16x8*)(K_lds + (b) * SHM_K + KSWZ(sr, kc_)) = sr_[i].ks0; *(LAS bf16x8*)(K_lds + (b) * SHM_K + KSWZ(32 + sr, kc_)) = sr_[i].ks1; } while (0)
#define SWAIT() asm volatile("s_waitcnt vmcnt(0)" ::: "memory")
#define RESC(a) do { if (__any((a) < 1.f)) { if (hi == 0) al_l[r32] = (a); asm volatile("s_waitcnt lgkmcnt(0)" ::: "memory"); \
    _Pragma("unroll") for (int d = 0; d < 4; ++d) _Pragma("unroll") for (int r = 0; r < 16; ++r) o[d][r] *= al_l[crow(r, hi)]; } } while (0)
#define BPTR(t) ({ const int t_ = (t); const int dch = pw + 8 - t_; int kb_ = 192 - dch * 64 - qi + 4 * hi; kb_ = kb_ < 0 ? 0 : kb_; \
    if (dch < 0 || dch > 8 || (kc0) + t_ < 0) kb_ = 288; (const LAS float*)(btab + kb_); })
  f32x16 pA0, pA1, pB0, pB1; float mnA, mnB, alA, alB; bf16x8 pa0, pa1, pa2, pa3;
  constexpr int SE = 0, SO = 0;
  SLOAD(SE, 0); asm volatile("s_waitcnt vmcnt(0)" ::: "memory"); SWRITE(0, SE); __syncthreads();
  qkt<BAND>(pA0, pA1, K_lds, qr, r32, hi, BPTR(0)); partialSM(pA0, pA1, m_reg, mnA, alA);
  SLOAD(SO, 1);
  SWAIT(); SWRITE(1, SO); __syncthreads();
  for (int j = 1; j + 1 < NT; j += 2) {
    SBAR(); qkt<BAND>(pB0, pB1, K_lds + SHM_K, qr, r32, hi, BPTR(j));
    finishSM(pA0, pA1, alA, l_reg, pa0, pa1, pa2, pa3); SBAR();
    SLOAD(SO, j + 1); SBAR();
    pv_d0(o, vb0, pa0, pa1, pa2, pa3); partialSM(pB0, pB1, m_reg, mnB, alB);
    __syncthreads(); SWAIT(); SWRITE(0, SE);
    RESC(alB); __syncthreads();
    SBAR(); qkt<BAND>(pA0, pA1, K_lds, qr, r32, hi, BPTR(j + 1));
    finishSM(pB0, pB1, alB, l_reg, pa0, pa1, pa2, pa3); SBAR();
    SLOAD(SE, j + 2); SBAR();
    pv_d0(o, vb0 + SHM_V, pa0, pa1, pa2, pa3); partialSM(pA0, pA1, m_reg, mnA, alA);
    __syncthreads(); SWAIT(); SWRITE(1, SO);
    RESC(alA); __syncthreads();
  }
  SBAR(); qkt<BAND>(pB0, pB1, K_lds + SHM_K, qr, r32, hi, BPTR(NT - 1));
  finishSM(pA0, pA1, alA, l_reg, pa0, pa1, pa2, pa3); SBAR();
  pv_d0(o, vb0, pa0, pa1, pa2, pa3); partialSM(pB0, pB1, m_reg, mnB, alB);
  __syncthreads(); RESC(alB);
  finishSM(pB0, pB1, alB, l_reg, pa0, pa1, pa2, pa3); SBAR();
  pv_d0(o, vb0 + SHM_V, pa0, pa1, pa2, pa3);
  if (hi == 0) li_l[r32] = l_reg; asm volatile("s_waitcnt lgkmcnt(0)" ::: "memory");
  float rli[16];
#pragma unroll
  for (int r = 0; r < 16; ++r) rli[r] = __builtin_amdgcn_rcpf(li_l[crow(r, hi)]);
  { LAS bf16_t* stg = (LAS bf16_t*)(lds + OFF_OST + wid * 8192);
#pragma unroll
    for (int r = 0; r < 16; ++r) { const int orow = crow(r, hi);
#pragma unroll
      for (int d0 = 0; d0 < 4; ++d0) stg[orow * 128 + d0 * 32 + r32] = (bf16_t)f2bf(o[d0][r] * rli[r]); }
    asm volatile("s_waitcnt lgkmcnt(0)" ::: "memory");
    bf16_t* Ow = Ob + (long)(wid * QBLK) * LDO;
#pragma unroll
    for (int i = 0; i < 8; ++i) { const int row = i * 4 + (lane >> 4), ch = lane & 15; const u32x4 v = *(const LAS u32x4*)(stg + row * 128 + ch * 8); *(u32x4*)(Ow + (long)row * LDO + ch * 8) = v; } }
  __syncthreads();
#undef TROW
#undef SLOAD
#undef SWRITE
#undef SWAIT
#undef RESC
#undef BPTR
}
#undef KSWZ
#undef SBAR
}


namespace rt {
using f32x16 = __attribute__((ext_vector_type(16))) float;
#define RKSWZ(row, colB) ((row) * 256 + ((colB) ^ (((row) & 7) << 4)))
__device__ __forceinline__ int crow(int r, int hi) { return (r & 3) + 8 * (r >> 2) + 4 * hi; }
__device__ __forceinline__ void ce_desc(unsigned& a, unsigned& b) { const unsigned mx = a > b ? a : b, mn = a > b ? b : a; a = mx; b = mn; }
__device__ __forceinline__ void sort16_desc(unsigned (&v)[16]) {
#pragma unroll
  for (int k = 2; k <= 16; k <<= 1)
#pragma unroll
    for (int j = k >> 1; j > 0; j >>= 1)
#pragma unroll
      for (int i = 0; i < 16; ++i) { const int l = i ^ j; if (l > i) { if ((i & k) == 0) ce_desc(v[i], v[l]); else ce_desc(v[l], v[i]); } }
}
__device__ __forceinline__ void merge16_desc(unsigned (&a)[16], const unsigned (&b)[16]) {
#pragma unroll
  for (int i = 0; i < 16; ++i) a[i] = a[i] > b[15 - i] ? a[i] : b[15 - i];
#pragma unroll
  for (int j = 8; j > 0; j >>= 1)
#pragma unroll
    for (int i = 0; i < 16; ++i) { const int l = i ^ j; if (l > i) ce_desc(a[i], a[l]); }
}
__device__ __forceinline__ unsigned fkey(float f) { const unsigned u = __float_as_uint(f); return (u & 0x80000000u) ? ~u : (u | 0x80000000u); }
__device__ __forceinline__ float fkey_inv(unsigned k) { const unsigned u = (k & 0x80000000u) ? (k & 0x7fffffffu) : ~k; return __uint_as_float(u); }
__device__ __forceinline__ void top16_half(const f32x16 (&sc)[4], int hi, unsigned (&out)[16]) {
  unsigned g[16];
#pragma unroll
  for (int blk = 0; blk < 4; ++blk) {
#pragma unroll
    for (int r = 0; r < 16; ++r) g[r] = (fkey(sc[blk][r]) & 0xFFFFFF80u) | (unsigned)(32 * blk + (r & 3) + 8 * (r >> 2) + 4 * hi);
    sort16_desc(g);
    if (blk == 0) {
#pragma unroll
      for (int r = 0; r < 16; ++r) out[r] = g[r];
    } else merge16_desc(out, g);
  }
  unsigned pb[16];
#pragma unroll
  for (int r = 0; r < 16; ++r) { auto rr = __builtin_amdgcn_permlane32_swap(out[r], out[r], false, false); pb[r] = hi ? rr[0] : rr[1]; }
  merge16_desc(out, pb);
}
__device__ __forceinline__ void route_phase(const Params& p, LAS unsigned char* lds, int tid, int lane, int wave) {
  const bf16_t* Q = (const bf16_t*)(p.ws + WS_Q); const bf16_t* KB = (const bf16_t*)(p.ws + WS_KEYSB);
  int* RIDX = (int*)(p.ws + WS_RIDX); float* RG = (float*)(p.ws + WS_RG);
  const int h = blockIdx.x & 7, grp = blockIdx.x >> 3;
  const int r32 = lane & 31, hi = lane >> 5;
#pragma unroll
  for (int c = 0; c < 2; ++c)
#pragma unroll
    for (int rep = 0; rep < 4; ++rep) { const int row = rep * 32 + (tid >> 4), cb = (tid & 15) * 16;
      *(LAS u32x4*)(lds + c * 32768 + RKSWZ(row, cb)) = *(const u32x4*)((const char*)KB + ((size_t)(h * 2 + c) * 128 + row) * 256 + cb); }
  __syncthreads();
  for (int tb = grp * 8 + wave; tb < T / 32; tb += (int)(gridDim.x >> 3) * 8) {
    const int t = tb * 32 + r32;
    unsigned ka[16], kb2[16];
#pragma unroll
    for (int c = 0; c < 2; ++c) {
      bf16x8 qf[8];
      const bf16_t* qp = Q + (size_t)t * D + h * 256 + c * 128 + hi * 8;
#pragma unroll
      for (int ks = 0; ks < 8; ++ks) qf[ks] = *(const bf16x8*)(qp + ks * 16);
      f32x16 sc[4];
#pragma unroll
      for (int blk = 0; blk < 4; ++blk) { sc[blk] = f32x16{};
#pragma unroll
        for (int ks = 0; ks < 8; ++ks) { const bf16x8 kf = *(const LAS bf16x8*)(lds + c * 32768 + RKSWZ(32 * blk + r32, (16 * ks + 8 * hi) * 2));
          sc[blk] = __builtin_amdgcn_mfma_f32_32x32x16_bf16(kf, qf[ks], sc[blk], 0, 0, 0); } }
      if (c == 0) top16_half(sc, hi, ka); else top16_half(sc, hi, kb2);
    }
    float av[16], bv[16];
#pragma unroll
    for (int i = 0; i < 16; ++i) { av[i] = fkey_inv(ka[i] & 0xFFFFFF80u); bv[i] = fkey_inv(kb2[i] & 0xFFFFFF80u); }
    float T[16];
#pragma unroll
    for (int k = 0; k < 16; ++k) T[k] = -3.0e38f;
#pragma unroll
    for (int i = 0; i < 16; ++i)
#pragma unroll
      for (int j = 0; j < 16; ++j) if ((i + 1) * (j + 1) <= 16) { float v = av[i] + bv[j];
#pragma unroll
          for (int k = 0; k < 16; ++k) { const float mx = fmaxf(T[k], v); v = fminf(T[k], v); T[k] = mx; } }
    const float m = T[0], theta = T[15];
    float Z = 0.f;
#pragma unroll
    for (int k = 0; k < 16; ++k) Z += __expf(T[k] - m);
    const float rz = 1.f / Z;
    int slot = 0; int cn = 0;
    int* ip = RIDX + (size_t)t * 128 + h * 16; float* gp = RG + (size_t)t * 128 + h * 16;
#pragma unroll
    for (int i = 0; i < 16; ++i)
#pragma unroll
      for (int j = 0; j < 16; ++j) if ((i + 1) * (j + 1) <= 16) { const float v = av[i] + bv[j];
          const bool sel = (v >= theta) && (slot < 16);
          if (sel && ((cn & 1) == hi)) { ip[slot] = (int)((ka[i] & 127u) * 128u + (kb2[j] & 127u)); gp[slot] = __expf(v - m) * rz; }
          slot += sel ? 1 : 0; ++cn; }
  }
}
#undef RKSWZ
}

#define XB_TMO      128
#define XB_XCNT(j)  (256  + 64 * (j))
#define XB_XSUB(j)  (1280 + 64 * (j))
#define XB_XGEN(j)  (2304 + 64 * (j))
#define XB_TOP      3328
#define XB_TOPGEN   3392
#define XCD_BAR_WORDS 3456
#define XB_SPIN_CAP (1u << 22)
__device__ __forceinline__ unsigned xb_ld(unsigned* p)              { return __hip_atomic_load(p, __ATOMIC_RELAXED, __HIP_MEMORY_SCOPE_AGENT); }
__device__ __forceinline__ unsigned xb_add(unsigned* p, unsigned v) { return __hip_atomic_fetch_add(p, v, __ATOMIC_RELAXED, __HIP_MEMORY_SCOPE_AGENT); }
__device__ __forceinline__ unsigned xb_xcc_id() { return (unsigned)__builtin_amdgcn_s_getreg((3 << 11) | 20) & 0xFu; }
#define XB_SPIN(cond, bar) do { unsigned _sp = 0; while (cond) { __builtin_amdgcn_s_sleep(1); \
    if ((++_sp & 255u) == 0u) { if (xb_ld(&(bar)[XB_TMO])) break; if (_sp > XB_SPIN_CAP) { atomicAdd(&(bar)[XB_TMO], 1u); break; } } } } while (0)
struct XcdBarrier { unsigned* bar; unsigned x; volatile LAS unsigned* st; };
__device__ __forceinline__ XcdBarrier xcd_barrier_post(unsigned* bar, volatile LAS unsigned* st) {
    XcdBarrier b; b.bar = bar; b.x = xb_xcc_id(); b.st = st;
    if (threadIdx.x == 0) (void)xb_add(&bar[XB_XCNT(b.x)], 1u);
    return b;
}
__device__ __forceinline__ void xcd_barrier_complete(unsigned* bar, unsigned x, unsigned& nloc, unsigned& nx) {
    const unsigned G = gridDim.x * gridDim.y * gridDim.z;
    unsigned sum, cnt, mine, sp = 0u;
    for (;;) {
        sum = 0u; cnt = 0u; mine = 0u;
#pragma unroll
        for (unsigned j = 0; j < 16; ++j) { const unsigned c = xb_ld(&bar[XB_XCNT(j)]); sum += c; cnt += (c > 0u) ? 1u : 0u; mine = (j == x) ? c : mine; }
        if (sum == G) break;
        __builtin_amdgcn_s_sleep(1);
        if ((++sp & 255u) == 0u) { if (xb_ld(&bar[XB_TMO])) break; if (sp > XB_SPIN_CAP) { atomicAdd(&bar[XB_TMO], 1u); break; } }
    }
    nloc = mine > 0u ? mine : 1u; nx = cnt > 0u ? cnt : 1u;
}
__device__ __forceinline__ void xcd_barrier(const XcdBarrier& b) {
    asm volatile("s_waitcnt vmcnt(0)" ::: "memory");
    __syncthreads();
    if (threadIdx.x == 0) {
        unsigned* bar = b.bar;
        __builtin_amdgcn_s_waitcnt(0);
        unsigned nloc = b.st[0], nx = b.st[1];
        if (nloc == 0u) { xcd_barrier_complete(bar, b.x, nloc, nx); b.st[0] = nloc; b.st[1] = nx; }
        const unsigned old = xb_add(&bar[XB_XSUB(b.x)], 1u);
        const unsigned gen = old / nloc;
        if (old + 1u == (gen + 1u) * nloc) {
            __builtin_amdgcn_fence(__ATOMIC_RELEASE, "agent");
            asm volatile("s_waitcnt vmcnt(0)" ::: "memory");
            const unsigned og = xb_add(&bar[XB_TOP], 1u);
            const unsigned tg = og / nx;
            if (og + 1u == (tg + 1u) * nx) xb_add(&bar[XB_TOPGEN], 1u);
            else XB_SPIN(xb_ld(&bar[XB_TOPGEN]) == tg, bar);
            __builtin_amdgcn_fence(__ATOMIC_ACQUIRE, "agent");
            xb_add(&bar[XB_XGEN(b.x)], 1u);
            asm volatile("s_waitcnt vmcnt(0)" ::: "memory");
        } else {
            XB_SPIN(xb_ld(&bar[XB_XGEN(b.x)]) == gen, bar);
            __builtin_amdgcn_fence(__ATOMIC_ACQUIRE, "agent");
            asm volatile("s_waitcnt vmcnt(0)" ::: "memory");
        }
    }
    __syncthreads();
}
constexpr int RING_BYTES = 131072, MISC_OFF = 143360, LDS_BYTES = 147456, NTHREADS = 512;
static_assert(att::LDS_NEED <= MISC_OFF, "attention scratch below the MISC words");
constexpr size_t WS_SLAB = WS_X2BF;

#ifndef PROBE_MASK
#define PROBE_MASK 0
#endif
#define PH_BEGIN(i) unsigned long long t0_##i = 0; if ((PROBE_MASK >> (i)) & 1) t0_##i = __builtin_amdgcn_s_memrealtime();
#define PH_END(i) if ((PROBE_MASK >> (i)) & 1) probe_acc += __builtin_amdgcn_s_memrealtime() - t0_##i;
__global__ void __launch_bounds__(NTHREADS, 2) fwd(Params p) {
    extern __shared__ __attribute__((aligned(16))) unsigned char lds_raw[];
    LAS unsigned char* lds = (LAS unsigned char*)lds_raw;
    volatile LAS unsigned* MISC = (volatile LAS unsigned*)(lds + MISC_OFF);
    const int tid = threadIdx.x, lane = tid & 63, wave = __builtin_amdgcn_readfirstlane(tid >> 6);
    const int nwb = NTHREADS / 64;
    const int gw = blockIdx.x * nwb + wave, NW = gridDim.x * nwb;
    const int Gd = gridDim.x, cb = blockIdx.x;
    unsigned char* ws = p.ws;
    bf16_t* WT_IN = (bf16_t*)(ws + WS_WT_IN); bf16_t* WT_GATE = (bf16_t*)(ws + WS_WT_GATE); bf16_t* WT_BR = (bf16_t*)(ws + WS_WT_BR);
    bf16_t* WT_O = (bf16_t*)(ws + WS_WT_O); bf16_t* WT_PQ = (bf16_t*)(ws + WS_WT_PQ); bf16_t* WT_MKV = (bf16_t*)(ws + WS_WT_MKV);
    bf16_t* KEYSB = (bf16_t*)(ws + WS_KEYSB); bf16_t* MEMN = (bf16_t*)(ws + WS_MEMN); bf16_t* MEMKV = (bf16_t*)(ws + WS_MEMKV);
    bf16_t* HO = (bf16_t*)(ws + WS_HO); bf16_t* PROJ = (bf16_t*)(ws + WS_PROJ); bf16_t* G = (bf16_t*)(ws + WS_G);
    bf16_t* MERGED = (bf16_t*)(ws + WS_MERGED); bf16_t* X2BF = (bf16_t*)(ws + WS_X2BF); bf16_t* QB = (bf16_t*)(ws + WS_Q);
        float* SS2 = (float*)(ws + WS_CTL + CTL_SS2_BYTE);
    if (tid < 64) MISC[tid] = 0u;
    __syncthreads();
    XcdBarrier bar = xcd_barrier_post((unsigned*)(ws + WS_CTL + CTL_BAR_BYTE), MISC + 8);

    unsigned long long probe_acc = 0;
    PH_BEGIN(0)
    {
        float* scr = (float*)lds_raw + wave * (64 * 33);
        const int I0 = (D / 64) * (INW / 32), I1 = I0 + (D / 64) * (GW / 32), I2 = I1 + (D / 64) * (D / 32), I3 = I2 + (D / 64) * (D / 32), I4 = I3 + (D / 64) * (D / 32), I5 = I4 + (D / 64) * (2 * CW / 32);
#define TRJOB(it, jb, li) do { if ((it) < I0) { jb = TrJob{p.in[3], WT_IN, nullptr, D, INW, 0.f}; li = (it); } else if ((it) < I1) { jb = TrJob{p.in[18], WT_GATE, nullptr, D, GW, GATE_WSCALE}; li = (it) - I0; } \
            else if ((it) < I2) { jb = TrJob{p.in[20], WT_BR, nullptr, D, D, 0.f}; li = (it) - I1; } else if ((it) < I3) { jb = TrJob{p.in[21], WT_O, nullptr, D, D, 0.f}; li = (it) - I2; } \
            else if ((it) < I4) { jb = TrJob{p.in[23], WT_PQ, p.in[22], D, D, 0.f}; li = (it) - I3; } else { jb = TrJob{p.in[15], WT_MKV, nullptr, D, 2 * CW, 0.f}; li = (it) - I4; } } while (0)
        for (int it = gw; it < I5; it += 2 * NW) {
            TrJob ja, jb2; int la, lb; f32x4 va[8], vb[8];
            TRJOB(it, ja, la); tr_load(ja, la, lane, va);
            const bool has2 = it + NW < I5;
            if (has2) { TRJOB(it + NW, jb2, lb); tr_load(jb2, lb, lane, vb); }
            tr_store(ja, la, lane, va, scr);
            if (has2) tr_store(jb2, lb, lane, vb, scr);
        }
#undef TRJOB
        rms_rows(p.in[0], p.in[2], HO, ws + WS_H8, T, gw, NW, lane);
        rms_rows(p.in[1], p.in[14], MEMN, nullptr, BATCH * NMEM, gw, NW, lane);
        const float* keys = p.in[24];
        for (int i = gw * 64 + lane; i < PH * 2 * NKEYS * 128 / 2; i += NW * 64) ((unsigned*)KEYSB)[i] = pk2(keys[2 * i], keys[2 * i + 1]);
    }
    xcd_barrier(bar);
    PH_END(0)
    PH_BEGIN(1)
    {
        SchedP1a Sa{(const char*)HO, (const char*)WT_IN, (const char*)MEMN, (const char*)WT_MKV, Gd, cb};
        EpiP1a Ea{PROJ, MEMKV};
        pg8::gemm_phase<false>(lds, D, D, Sa, Ea);
        SchedP1b Sb{(const char*)(ws + WS_H8), (const char*)WT_GATE, Gd, cb};
        EpiP1b Eb{G, p.in[19]};
        pg8::gemm_phase<true>(lds, D / 2, D / 2, Sb, Eb);
    }
    xcd_barrier(bar);
    PH_END(1)
    PH_BEGIN(2)
    {
        const float qscale = 0.08838834764831845f;
        { HeadGains hg; load_head_gains(hg, p.in[4], p.in[5], p.in[16], lane);
          for (int t = gw; t < T; t += NW) headnorm_token(PROJ + (size_t)t * INW, hg, qscale, lane); }
        for (int it = gw; it < BATCH * NMEM * 4; it += NW) { const int m = it / 4, j = it % 4; headnorm(MEMKV + (size_t)m * (2 * CW) + j * 128, p.in[17], 1.f, lane); }
        for (int u = gw; u < BATCH * NCH * 8; u += NW) { const int g = u % 8, c = (u / 8) % NCH, b = u / (8 * NCH); lru_unit<false>(p, b, c, g, lane, lds + wave * 16384); }
        fp4_tables(p, gw, NW, lane);
    }
    xcd_barrier(bar);
    PH_END(2)
    PH_BEGIN(3)
    {
        const int nA = BATCH * 8 * (NCH / 4), nC = BATCH * 4 * (SEQ / 256);
        for (int u = cb; u < nA + nC; u += Gd) {
            if (u < nA) {
                const int cg = u % (NCH / 4), h = (u / (NCH / 4)) % 8, b = u / ((NCH / 4) * 8);
                const size_t brow = (size_t)b * SEQ, qrow = brow + (size_t)cg * 256;
                att::attn_body<INW, INW, D, true>(PROJ + qrow * INW + C_QA + h * 128, PROJ + brow * INW + C_KA + h * 128, PROJ + brow * INW + C_VA + h * 128,
                                                  HO + qrow * D + h * 128, 12, cg * 4 - NPREV, p.in[6] + h * 257, (LAS char*)lds);
            } else {
                const int v = u - nA; const int qb = v % (SEQ / 256), h = (v / (SEQ / 256)) % 4, b = v / ((SEQ / 256) * 4);
                const size_t qrow = (size_t)b * SEQ + (size_t)qb * 256;
                att::attn_body<INW, 2 * CW, D, false>(PROJ + qrow * INW + C_QC + h * 128, MEMKV + (size_t)b * NMEM * (2 * CW) + h * 128, MEMKV + (size_t)b * NMEM * (2 * CW) + CW + h * 128,
                                                     HO + qrow * D + AW + LW + h * 128, NMEM / 64, 0, nullptr, (LAS char*)lds);
            }
        }
        for (int u = gw; u < BATCH * NCH * 8; u += NW) { const int g = u % 8, c = (u / 8) % NCH, b = u / (8 * NCH); lru_unit<true>(p, b, c, g, lane, lds + wave * 16384); }
    }
    xcd_barrier(bar);
    PH_END(3)
    PH_BEGIN(4)
    {
        SchedP3 S{(const char*)HO, (const char*)WT_BR, Gd, cb};
        EpiP3 E{G, MERGED};
        pg8::gemm_phase<false>(lds, D, D, S, E);
    }
    xcd_barrier(bar);
    PH_END(4)
    PH_BEGIN(5)
    {
        SchedSq S{(const char*)MERGED, (const char*)WT_O, Gd, cb};
        EpiP4 E{p.in[0], p.out, X2BF, SS2};
        pg8::gemm_phase<false>(lds, D, D, S, E);
    }
    xcd_barrier(bar);
    PH_END(5)
    PH_BEGIN(6)
    {
        SchedSq S{(const char*)X2BF, (const char*)WT_PQ, Gd, cb};
        EpiP5 E{QB, SS2};
        pg8::gemm_phase<false>(lds, D, D, S, E);
    }
    xcd_barrier(bar);
    PH_END(6)
    PH_BEGIN(7)
    rt::route_phase(p, lds, tid, lane, wave);
    xcd_barrier(bar);
    PH_END(7)
    PH_BEGIN(8)
    { LAS float* actL = (LAS float*)lds + wave * 128;
      for (int t = gw; t < T; t += NW) peer_token(p, t, lane, actL); }
    if (PROBE_MASK) { __syncthreads(); PH_END(8) const unsigned long long te = __builtin_amdgcn_s_memrealtime(); while (__builtin_amdgcn_s_memrealtime() - te < probe_acc) __builtin_amdgcn_s_sleep(8); }
}

extern "C" void kernel_launch(void* const* d_in, const int* in_sizes, int n_in, void* d_out, int out_size, void* d_ws, size_t ws_size, hipStream_t stream) {
    static int grid = 0;
    if (grid == 0) {
        if (n_in != 27 || out_size != T * D || ws_size < WS_END) { fprintf(stderr, "kernel_launch: unexpected problem (n_in %d out %d ws %zu)\n", n_in, out_size, ws_size); grid = -1; return; }
        int dev = 0, cus = 0, per_cu = 0;
        (void)hipGetDevice(&dev); (void)hipDeviceGetAttribute(&cus, hipDeviceAttributeMultiprocessorCount, dev);
        if (hipFuncSetAttribute((const void*)fwd, hipFuncAttributeMaxDynamicSharedMemorySize, LDS_BYTES) != hipSuccess) { fprintf(stderr, "kernel_launch: hipFuncSetAttribute failed\n"); grid = -1; return; }
        (void)hipOccupancyMaxActiveBlocksPerMultiprocessor(&per_cu, (const void*)fwd, NTHREADS, LDS_BYTES);
        if (per_cu < 1) { fprintf(stderr, "kernel_launch: occupancy query says %d\n", per_cu); grid = -1; return; }
        grid = cus;
    }
    if (grid < 0) return;
    (void)hipMemsetAsync((char*)d_ws + WS_CTL, 0, 1 * MiB, stream);
    Params p{};
    for (int i = 0; i < 27; ++i) p.in[i] = (const float*)d_in[i];
    p.out = (float*)d_out; p.ws = (unsigned char*)d_ws;
    void* args[] = {&p};
    hipError_t e = hipLaunchCooperativeKernel((const void*)fwd, dim3(grid), dim3(NTHREADS), args, LDS_BYTES, stream);
    if (e != hipSuccess) fprintf(stderr, "cooperative launch failed: %s (grid %d)\n", hipGetErrorString(e), grid);
}
```

```cpp
#include <hip/hip_runtime.h>
#include <hip/hip_cooperative_groups.h>
#include <cstdio>
#include <cstdint>
namespace cg = cooperative_groups;
#ifndef PROBE_MASK
#define PROBE_MASK 0
#endif

#define LAS __attribute__((address_space(3)))
typedef unsigned short bf16_t;
typedef short bf16x8 __attribute__((ext_vector_type(8)));
typedef float f32x4 __attribute__((ext_vector_type(4)));
typedef unsigned u32x4 __attribute__((ext_vector_type(4)));
typedef unsigned u32x2 __attribute__((ext_vector_type(2)));

constexpr int D = 2048, BATCH = 2, SEQ = 8192, T = BATCH * SEQ;
constexpr int CHUNK = 64, NPREV = 8, NCH = SEQ / CHUNK;
constexpr int AW = 1024, LW = 512, CW = 512, INW = 4608, GW = 6144;
constexpr int NMEM = 256;
constexpr int PH = 8, NKEYS = 128, TOPK = 16;
constexpr float EPS = 1e-6f;
constexpr int C_QA = 0, C_KA = 1024, C_VA = 2048, C_XL = 3072, C_GL = 3584, C_QC = 4096;

constexpr size_t MiB = 1u << 20;
constexpr size_t WS_CTL = 0;
constexpr size_t WS_WT_IN = 2 * MiB, WS_WT_GATE = 20 * MiB, WS_WT_BR = 44 * MiB, WS_WT_O = 52 * MiB, WS_WT_PQ = 60 * MiB, WS_WT_MKV = 68 * MiB;
constexpr size_t WS_KEYSB = 72 * MiB, WS_MEMN = 73 * MiB, WS_MEMKV = 75 * MiB, WS_LRUSUM = 76 * MiB, WS_RS2 = 77 * MiB;
constexpr size_t WS_HO = 80 * MiB;
constexpr size_t WS_PROJ = 144 * MiB;
constexpr size_t WS_MERGED = 144 * MiB, WS_X2BF = 208 * MiB;
constexpr size_t WS_G = 288 * MiB;
constexpr size_t WS_TABU = 496 * MiB, WS_TABV = 512 * MiB, WS_Q = 416 * MiB;
constexpr size_t WS_SCU = 77 * MiB, WS_SCV = 77 * MiB + 65536;
constexpr size_t WS_AUA = 2 * MiB, WS_AUU = 18 * MiB;
constexpr size_t WS_H8 = 496 * MiB;
constexpr float GATE_WSCALE = 256.f;
constexpr size_t WS_RIDX = 480 * MiB, WS_RG = 488 * MiB, WS_END = 528 * MiB;

constexpr size_t CTL_BAR_BYTE = 16384, CTL_SS2_BYTE = 512 * 1024;
struct Params { const float* in[27]; float* out; unsigned char* ws; };

__device__ __forceinline__ float bf2f(unsigned v16) { return __uint_as_float(v16 << 16); }
__device__ __forceinline__ unsigned f2bf(float f) { unsigned u = __float_as_uint(f); return (u + 0x7fffu + ((u >> 16) & 1u)) >> 16; }
__device__ __forceinline__ unsigned pk2(float lo, float hi) { return f2bf(lo) | (f2bf(hi) << 16); }
__device__ __forceinline__ float wave_sum(float v) {
#pragma unroll
    for (int o = 1; o < 64; o <<= 1) v += __shfl_xor(v, o);
    return v;
}
typedef __bf16 bf16x2_t __attribute__((ext_vector_type(2)));
__device__ __forceinline__ float dot2bf(unsigned w, unsigned x, float acc) { return __builtin_amdgcn_fdot2_f32_bf16(__builtin_bit_cast(bf16x2_t, w), __builtin_bit_cast(bf16x2_t, x), acc, false); }
__device__ __forceinline__ float sigmoid_(float x) { return 1.f / (1.f + __expf(-x)); }
__device__ __forceinline__ float gelu_tanh(float x) { const float y = 1.5957691216f * (x + 0.044715f * x * x * x); return x / (1.f + __expf(-y)); }
__device__ __forceinline__ void unpack8(const u32x4 w, float* f) {
    f[0] = __uint_as_float(w.x << 16); f[1] = __uint_as_float(w.x & 0xffff0000u);
    f[2] = __uint_as_float(w.y << 16); f[3] = __uint_as_float(w.y & 0xffff0000u);
    f[4] = __uint_as_float(w.z << 16); f[5] = __uint_as_float(w.z & 0xffff0000u);
    f[6] = __uint_as_float(w.w << 16); f[7] = __uint_as_float(w.w & 0xffff0000u);
}

struct TrJob { const float* W; bf16_t* WT; const float* ks; int K, N; float f8scale; };
__device__ __forceinline__ void tr_load(const TrJob& jb, int item, int lane, f32x4 (&v)[8]) {
    const int nblk = jb.N / 32, kb = item / nblk, nb = item % nblk, k0 = 64 * kb, n0 = 32 * nb;
#pragma unroll
    for (int i = 0; i < 8; ++i) { const int kk = 8 * i + (lane >> 3); v[i] = *(const f32x4*)(jb.W + (size_t)(k0 + kk) * jb.N + n0 + 4 * (lane & 7)); if (jb.ks) v[i] = v[i] * jb.ks[k0 + kk]; }
}
__device__ __forceinline__ void tr_store(const TrJob& jb, int item, int lane, const f32x4 (&v)[8], float* scr) {
    const int nblk = jb.N / 32, kb = item / nblk, nb = item % nblk, k0 = 64 * kb, n0 = 32 * nb;
#pragma unroll
    for (int i = 0; i < 8; ++i) { float* d = scr + (8 * i + (lane >> 3)) * 33 + 4 * (lane & 7); d[0] = v[i].x; d[1] = v[i].y; d[2] = v[i].z; d[3] = v[i].w; }
    asm volatile("s_waitcnt lgkmcnt(0)" ::: "memory");
    const int c = lane & 7;
#pragma unroll
    for (int j = 0; j < 4; ++j) { const int n = (lane >> 3) + 8 * j; const float* s = scr + (8 * c) * 33 + n;
        if (jb.f8scale != 0.f) { const float f = jb.f8scale; u32x2 o;
            int w = __builtin_amdgcn_cvt_pk_fp8_f32(s[0 * 33] * f, s[1 * 33] * f, 0, false); w = __builtin_amdgcn_cvt_pk_fp8_f32(s[2 * 33] * f, s[3 * 33] * f, w, true); o.x = (unsigned)w;
            w = __builtin_amdgcn_cvt_pk_fp8_f32(s[4 * 33] * f, s[5 * 33] * f, 0, false); w = __builtin_amdgcn_cvt_pk_fp8_f32(s[6 * 33] * f, s[7 * 33] * f, w, true); o.y = (unsigned)w;
            *(u32x2*)((unsigned char*)jb.WT + (size_t)(n0 + n) * jb.K + k0 + 8 * c) = o; }
        else { u32x4 o; o.x = pk2(s[0 * 33], s[1 * 33]); o.y = pk2(s[2 * 33], s[3 * 33]); o.z = pk2(s[4 * 33], s[5 * 33]); o.w = pk2(s[6 * 33], s[7 * 33]);
            *(u32x4*)(jb.WT + (size_t)(n0 + n) * jb.K + k0 + 8 * c) = o; } }
    asm volatile("s_waitcnt lgkmcnt(0)" ::: "memory");
}
__device__ __forceinline__ void rms_row_load(const float* xrow, int lane, f32x4 (&v)[8]) {
    const f32x4* xr = (const f32x4*)xrow + lane;
#pragma unroll
    for (int j = 0; j < 8; ++j) v[j] = xr[64 * j];
}
__device__ __forceinline__ void rms_row_finish(const f32x4 (&v)[8], const float* g, bf16_t* orow, unsigned char* o8row, int lane) {
    const f32x4* gr = (const f32x4*)g + lane; float s = 0.f;
#pragma unroll
    for (int j = 0; j < 8; ++j) s += (v[j].x * v[j].x + v[j].y * v[j].y) + (v[j].z * v[j].z + v[j].w * v[j].w);
    const float rstd = rsqrtf(wave_sum(s) * (1.f / D) + EPS);
    u32x2* o8 = (u32x2*)orow + lane;
#pragma unroll
    for (int j = 0; j < 8; ++j) { const f32x4 gg = gr[64 * j]; const float a0 = v[j].x * rstd * gg.x, a1 = v[j].y * rstd * gg.y, a2 = v[j].z * rstd * gg.z, a3 = v[j].w * rstd * gg.w;
        u32x2 o; o.x = pk2(a0, a1); o.y = pk2(a2, a3); o8[64 * j] = o;
        if (o8row) { int w = __builtin_amdgcn_cvt_pk_fp8_f32(fminf(fmaxf(a0, -448.f), 448.f), fminf(fmaxf(a1, -448.f), 448.f), 0, false);
            w = __builtin_amdgcn_cvt_pk_fp8_f32(fminf(fmaxf(a2, -448.f), 448.f), fminf(fmaxf(a3, -448.f), 448.f), w, true); ((unsigned*)o8row)[64 * j + lane] = (unsigned)w; } }
}
__device__ __forceinline__ void rms_rows(const float* X, const float* g, bf16_t* O, unsigned char* O8, int nrows, int gw, int NW, int lane) {
    f32x4 va[8], vb[8];
    int m = gw;
    if (m < nrows) rms_row_load(X + (size_t)m * D, lane, va);
    for (; m < nrows; m += 2 * NW) {
        const bool hb = m + NW < nrows;
        if (hb) rms_row_load(X + (size_t)(m + NW) * D, lane, vb);
        rms_row_finish(va, g, O + (size_t)m * D, O8 ? O8 + (size_t)m * D : nullptr, lane);
        if (m + 2 * NW < nrows) rms_row_load(X + (size_t)(m + 2 * NW) * D, lane, va);
        if (hb) rms_row_finish(vb, g, O + (size_t)(m + NW) * D, O8 ? O8 + (size_t)(m + NW) * D : nullptr, lane);
    }
}

template <int TM, int TN, class Epi>
__device__ __forceinline__ void gemm_simple(const bf16_t* __restrict__ A, int lda, const bf16_t* __restrict__ Bt, int ldb, int M, int N, int K, const Epi& epi, int gw, int NW, int lane) {
    const int r = lane & 15, q = lane >> 4;
    const int ntm = M / (16 * TM), ntn = N / (16 * TN);
    for (int tile = gw; tile < ntm * ntn; tile += NW) {
        const int tm = tile / ntn, tn = tile % ntn;
        f32x4 acc[TM][TN];
#pragma unroll
        for (int i = 0; i < TM; ++i)
#pragma unroll
            for (int j = 0; j < TN; ++j) acc[i][j] = (f32x4){0.f, 0.f, 0.f, 0.f};
        const bf16_t* ap = A + (size_t)(tm * 16 * TM + r) * lda + q * 8;
        const bf16_t* bp = Bt + (size_t)(tn * 16 * TN + r) * ldb + q * 8;
        for (int k0 = 0; k0 < K; k0 += 32) {
            bf16x8 af[TM], bfr[TN];
#pragma unroll
            for (int i = 0; i < TM; ++i) af[i] = *(const bf16x8*)(ap + (size_t)i * 16 * lda + k0);
#pragma unroll
            for (int j = 0; j < TN; ++j) bfr[j] = *(const bf16x8*)(bp + (size_t)j * 16 * ldb + k0);
#pragma unroll
            for (int i = 0; i < TM; ++i)
#pragma unroll
                for (int j = 0; j < TN; ++j) acc[i][j] = __builtin_amdgcn_mfma_f32_16x16x32_bf16(af[i], bfr[j], acc[i][j], 0, 0, 0);
        }
#pragma unroll
        for (int i = 0; i < TM; ++i)
#pragma unroll
            for (int j = 0; j < TN; ++j)
#pragma unroll
                for (int e = 0; e < 4; ++e) epi(tm * 16 * TM + i * 16 + q * 4 + e, tn * 16 * TN + j * 16 + r, acc[i][j][e]);
    }
}
struct EpiProj { bf16_t* P; __device__ __forceinline__ void operator()(int row, int col, float v) const { if (col >= C_GL && col < C_QC) v = gelu_tanh(v); P[(size_t)row * INW + col] = (bf16_t)f2bf(v); } };
struct EpiGate { bf16_t* G; const float* b; __device__ __forceinline__ void operator()(int row, int col, float v) const { G[(size_t)row * GW + col] = (bf16_t)f2bf(sigmoid_(v + b[col])); } };
struct EpiStore { bf16_t* C; int ldc; __device__ __forceinline__ void operator()(int row, int col, float v) const { C[(size_t)row * ldc + col] = (bf16_t)f2bf(v); } };
struct EpiWo { const float* x; float* out; bf16_t* xb; __device__ __forceinline__ void operator()(int row, int col, float v) const { const size_t o = (size_t)row * D + col; const float y = x[o] + v; out[o] = y; xb[o] = (bf16_t)f2bf(y); } };
struct EpiQ { bf16_t* Q; const float* rs; __device__ __forceinline__ void operator()(int row, int col, float v) const { Q[(size_t)row * D + col] = (bf16_t)f2bf(v * rs[row]); } };

__device__ __forceinline__ void headnorm(bf16_t* vec, const float* g, float scale, int lane) {
    unsigned* p = (unsigned*)vec + lane; const unsigned w = *p;
    const float a = bf2f(w & 0xffffu), b = bf2f(w >> 16);
    const float rs = rsqrtf(wave_sum(a * a + b * b) * (1.f / 128.f) + EPS) * scale;
    *p = pk2(a * rs * g[2 * lane], b * rs * g[2 * lane + 1]);
}
struct HeadGains { float gq[32], gk[32], gc[8]; };
__device__ __forceinline__ void load_head_gains(HeadGains& hg, const float* gq, const float* gk, const float* gc, int lane) {
#pragma unroll
    for (int j = 0; j < 32; ++j) { hg.gq[j] = gq[(lane & 3) * 32 + j]; hg.gk[j] = gk[(lane & 3) * 32 + j]; }
#pragma unroll
    for (int j = 0; j < 8; ++j) hg.gc[j] = gc[(lane & 15) * 8 + j];
}
__device__ __forceinline__ void headnorm_token(bf16_t* row, const HeadGains& hg, float qscale, int lane) {
    u32x4* pa = (u32x4*)(row + C_QA) + lane * 4;
    u32x4* pc = (u32x4*)(row + C_QC) + lane;
    u32x4 w[4]; const u32x4 wc = *pc;
#pragma unroll
    for (int j = 0; j < 4; ++j) w[j] = pa[j];
    float f[32], fc[8]; float ss = 0.f, sc = 0.f;
#pragma unroll
    for (int j = 0; j < 4; ++j) unpack8(w[j], f + 8 * j);
    unpack8(wc, fc);
#pragma unroll
    for (int j = 0; j < 32; ++j) ss = fmaf(f[j], f[j], ss);
#pragma unroll
    for (int j = 0; j < 8; ++j) sc = fmaf(fc[j], fc[j], sc);
    ss += __shfl_xor(ss, 1); ss += __shfl_xor(ss, 2);
    sc += __shfl_xor(sc, 1); sc += __shfl_xor(sc, 2); sc += __shfl_xor(sc, 4); sc += __shfl_xor(sc, 8);
    const bool isq = lane < 32;
    const float rs = rsqrtf(ss * (1.f / 128.f) + EPS) * (isq ? qscale : 1.f), rc = rsqrtf(sc * (1.f / 128.f) + EPS) * qscale;
#pragma unroll
    for (int j = 0; j < 4; ++j) { u32x4 o;
        o.x = pk2(f[8 * j] * rs * (isq ? hg.gq[8 * j] : hg.gk[8 * j]), f[8 * j + 1] * rs * (isq ? hg.gq[8 * j + 1] : hg.gk[8 * j + 1]));
        o.y = pk2(f[8 * j + 2] * rs * (isq ? hg.gq[8 * j + 2] : hg.gk[8 * j + 2]), f[8 * j + 3] * rs * (isq ? hg.gq[8 * j + 3] : hg.gk[8 * j + 3]));
        o.z = pk2(f[8 * j + 4] * rs * (isq ? hg.gq[8 * j + 4] : hg.gk[8 * j + 4]), f[8 * j + 5] * rs * (isq ? hg.gq[8 * j + 5] : hg.gk[8 * j + 5]));
        o.w = pk2(f[8 * j + 6] * rs * (isq ? hg.gq[8 * j + 6] : hg.gk[8 * j + 6]), f[8 * j + 7] * rs * (isq ? hg.gq[8 * j + 7] : hg.gk[8 * j + 7]));
        pa[j] = o; }
    { u32x4 o; o.x = pk2(fc[0] * rc * hg.gc[0], fc[1] * rc * hg.gc[1]); o.y = pk2(fc[2] * rc * hg.gc[2], fc[3] * rc * hg.gc[3]);
      o.z = pk2(fc[4] * rc * hg.gc[4], fc[5] * rc * hg.gc[5]); o.w = pk2(fc[6] * rc * hg.gc[6], fc[7] * rc * hg.gc[7]); *pc = o; }
}

__device__ __forceinline__ void lru_pass1(const Params& p, int b, int c, int g, int lane, LAS unsigned char* wl  ) {
    const bf16_t* PROJ = (const bf16_t*)(p.ws + WS_PROJ);
    float* SUMA = (float*)(p.ws + WS_LRUSUM); float* SUMB = SUMA + BATCH * NCH * LW;
    bf16_t* AUA = (bf16_t*)(p.ws + WS_AUA); bf16_t* AUU = (bf16_t*)(p.ws + WS_AUU);
    const float* conv_w = p.in[7]; const float* conv_b = p.in[8]; const float* lru_wa = p.in[9]; const float* lru_ba = p.in[10];
    const float* lru_wx = p.in[11]; const float* lru_bx = p.in[12]; const float* lam = p.in[13];
    const int ch = g * 64 + lane;
    unsigned wa_p[32], wx_p[32];
#pragma unroll
    for (int m = 0; m < 32; ++m) { wa_p[m] = pk2(lru_wa[(size_t)(g * 64 + 2 * m) * 64 + lane], lru_wa[(size_t)(g * 64 + 2 * m + 1) * 64 + lane]);
        wx_p[m] = pk2(lru_wx[(size_t)(g * 64 + 2 * m) * 64 + lane], lru_wx[(size_t)(g * 64 + 2 * m + 1) * 64 + lane]); }
    const float cw0 = conv_w[0 * LW + ch], cw1 = conv_w[1 * LW + ch], cw2 = conv_w[2 * LW + ch], cw3 = conv_w[3 * LW + ch], cb = conv_b[ch];
    const float ba_ = lru_ba[ch], bx_ = lru_bx[ch];
    const float sp = log1pf(__expf(-lam[ch]));
    const int t0 = c * CHUNK; const size_t row0 = (size_t)b * SEQ + t0;
    float x0 = 0.f, x1 = 0.f, x2 = 0.f;
    if (t0 >= 3) { x0 = bf2f(PROJ[(row0 - 3) * INW + C_XL + ch]); x1 = bf2f(PROJ[(row0 - 2) * INW + C_XL + ch]); x2 = bf2f(PROJ[(row0 - 1) * INW + C_XL + ch]); }
    { const bf16_t* xs = PROJ + (row0 + (lane >> 3)) * INW + C_XL + g * 64 + (lane & 7) * 8;
      u32x4 tx[8];
#pragma unroll
      for (int i = 0; i < 8; ++i) tx[i] = *(const u32x4*)(xs + (size_t)(8 * i) * INW);
#pragma unroll
      for (int i = 0; i < 8; ++i) *(LAS u32x4*)(wl + (8 * i + (lane >> 3)) * 128 + (lane & 7) * 16) = tx[i]; }
    float h = 0.f, aprod = 1.f;
#define LRU_PAIRX(xc_) ({ const float xnb_ = __int_as_float(__builtin_amdgcn_update_dpp(0, __float_as_int(xc_), 0xB1, 0xf, 0xf, true));     \
        (lane & 1) ? pk2(xnb_, xc_) : pk2(xc_, xnb_); })
#define LRU_GATE(rp_, ip_, xc_, a_, u_) do { const float r_ = sigmoid_(rp_), ig_ = sigmoid_(ip_); const float la_ = -8.f * r_ * sp; a_ = __expf(la_); \
        u_ = sqrtf(fminf(fmaxf((1.f - a_) * (1.f + a_), 1e-12f), 1.f)) * ig_ * xc_; } while (0)
#pragma unroll 1
    for (int t = 0; t < CHUNK; t += 2) {
        const float x3 = bf2f(*(const LAS bf16_t*)(wl + t * 128 + lane * 2)), x4 = bf2f(*(const LAS bf16_t*)(wl + (t + 1) * 128 + lane * 2));
        const float xcA = cw0 * x0 + cw1 * x1 + cw2 * x2 + cw3 * x3 + cb, xcB = cw0 * x1 + cw1 * x2 + cw2 * x3 + cw3 * x4 + cb;
        x0 = x2; x1 = x3; x2 = x4;
        const unsigned pkA = LRU_PAIRX(xcA), pkB = LRU_PAIRX(xcB);
        float rA = ba_, iA = bx_, rA2 = 0.f, iA2 = 0.f, rB = ba_, iB = bx_, rB2 = 0.f, iB2 = 0.f;
#pragma unroll
        for (int m = 0; m < 32; m += 2) {
            const unsigned a0 = (unsigned)__builtin_amdgcn_readlane((int)pkA, 2 * m), a1 = (unsigned)__builtin_amdgcn_readlane((int)pkA, 2 * m + 2);
            const unsigned b0 = (unsigned)__builtin_amdgcn_readlane((int)pkB, 2 * m), b1 = (unsigned)__builtin_amdgcn_readlane((int)pkB, 2 * m + 2);
            rA = dot2bf(wa_p[m], a0, rA); iA = dot2bf(wx_p[m], a0, iA); rA2 = dot2bf(wa_p[m + 1], a1, rA2); iA2 = dot2bf(wx_p[m + 1], a1, iA2);
            rB = dot2bf(wa_p[m], b0, rB); iB = dot2bf(wx_p[m], b0, iB); rB2 = dot2bf(wa_p[m + 1], b1, rB2); iB2 = dot2bf(wx_p[m + 1], b1, iB2); }
        float aA, uA, aB, uB;
        LRU_GATE(rA + rA2, iA + iA2, xcA, aA, uA); LRU_GATE(rB + rB2, iB + iB2, xcB, aB, uB);
        const unsigned wA = f2bf(1.f - aA), wB = f2bf(1.f - aB), vA = f2bf(uA), vB = f2bf(uB);
        AUA[(row0 + t) * LW + ch] = (bf16_t)wA; AUA[(row0 + t + 1) * LW + ch] = (bf16_t)wB; AUU[(row0 + t) * LW + ch] = (bf16_t)vA; AUU[(row0 + t + 1) * LW + ch] = (bf16_t)vB;
        const float aAq = 1.f - bf2f(wA), aBq = 1.f - bf2f(wB);
        h = aBq * (aAq * h + bf2f(vA)) + bf2f(vB);
        aprod *= aAq * aBq;
    }
#undef LRU_PAIRX
#undef LRU_GATE
    { const size_t o = (size_t)(b * NCH + c) * LW + ch; SUMA[o] = aprod; SUMB[o] = h; }
}
__device__ __forceinline__ void lru_pass2(const Params& p, int b, int c, int g, int lane) {
    const bf16_t* PROJ = (const bf16_t*)(p.ws + WS_PROJ); bf16_t* O = (bf16_t*)(p.ws + WS_HO);
    const float* SUMA = (const float*)(p.ws + WS_LRUSUM); const float* SUMB = SUMA + BATCH * NCH * LW;
    const bf16_t* AUA = (const bf16_t*)(p.ws + WS_AUA); const bf16_t* AUU = (const bf16_t*)(p.ws + WS_AUU);
    const int ch = g * 64 + lane; const size_t row0 = (size_t)b * SEQ + (size_t)c * CHUNK;
    const bf16_t* ap = AUA + row0 * LW + ch; const bf16_t* up = AUU + row0 * LW + ch; const bf16_t* gp = PROJ + row0 * INW + C_GL + ch;
    bf16_t an[16], un[16], gn[16];
#pragma unroll
    for (int q = 0; q < 16; ++q) { an[q] = ap[(size_t)q * LW]; un[q] = up[(size_t)q * LW]; gn[q] = gp[(size_t)q * INW]; }
    float h = 0.f;
    {
        int j = 0;
#pragma unroll 1
        for (; j + 32 <= c; j += 32) { float sa[32], sb[32];
#pragma unroll
            for (int q = 0; q < 32; ++q) { const size_t o = (size_t)(b * NCH + j + q) * LW + ch; sa[q] = SUMA[o]; sb[q] = SUMB[o]; }
#pragma unroll
            for (int q = 0; q < 32; ++q) h = sa[q] * h + sb[q]; }
#pragma unroll 1
        for (; j + 8 <= c; j += 8) { float sa[8], sb[8];
#pragma unroll
            for (int q = 0; q < 8; ++q) { const size_t o = (size_t)(b * NCH + j + q) * LW + ch; sa[q] = SUMA[o]; sb[q] = SUMB[o]; }
#pragma unroll
            for (int q = 0; q < 8; ++q) h = sa[q] * h + sb[q]; }
        for (; j < c; ++j) { const size_t o = (size_t)(b * NCH + j) * LW + ch; h = SUMA[o] * h + SUMB[o]; }
    }
#pragma unroll 1
    for (int tb = 0; tb < CHUNK; tb += 16) {
        bf16_t ac[16], uc[16], gc[16];
#pragma unroll
        for (int q = 0; q < 16; ++q) { ac[q] = an[q]; uc[q] = un[q]; gc[q] = gn[q]; }
        if (tb + 16 < CHUNK) {
#pragma unroll
            for (int q = 0; q < 16; ++q) { an[q] = ap[(size_t)(tb + 16 + q) * LW]; un[q] = up[(size_t)(tb + 16 + q) * LW]; gn[q] = gp[(size_t)(tb + 16 + q) * INW]; }
        }
#pragma unroll
        for (int q = 0; q < 16; ++q) { h = (1.f - bf2f(ac[q])) * h + bf2f(uc[q]); O[(row0 + tb + q) * D + AW + ch] = (bf16_t)f2bf(h * bf2f(gc[q])); }
    }
}

__device__ __forceinline__ void attn_simple(const bf16_t* Qp, int ldq, const bf16_t* Kp, const bf16_t* Vp, int ldkv, int nkeys, int koff, const float* bias_h, bf16_t* Op, int ldo, int tid) {
    const int qi = tid >> 2, part = tid & 3;
    float q[32], o[32];
    { const u32x4* qp = (const u32x4*)(Qp + (size_t)qi * ldq + part * 32);
#pragma unroll
      for (int j = 0; j < 4; ++j) unpack8(qp[j], q + 8 * j); }
#pragma unroll
    for (int d = 0; d < 32; ++d) o[d] = 0.f;
    float m = -1e30f, l = 0.f;
    for (int kk0 = 0; kk0 < nkeys; kk0 += 8) {
        float s[8];
#pragma unroll
        for (int j = 0; j < 8; ++j) {
            const u32x4* kp = (const u32x4*)(Kp + (size_t)(kk0 + j) * ldkv + part * 32);
            float acc = 0.f;
#pragma unroll
            for (int w = 0; w < 4; ++w) { float kf[8]; unpack8(kp[w], kf);
#pragma unroll
                for (int e = 0; e < 8; ++e) acc = fmaf(q[8 * w + e], kf[e], acc); }
            acc += __shfl_xor(acc, 1); acc += __shfl_xor(acc, 2);
            if (bias_h) { int dist = qi + koff - (kk0 + j); dist = dist < -128 ? -128 : (dist > 128 ? 128 : dist); acc += bias_h[dist + 128]; }
            s[j] = acc;
        }
        float mx = s[0];
#pragma unroll
        for (int j = 1; j < 8; ++j) mx = fmaxf(mx, s[j]);
        const float mn = fmaxf(m, mx), corr = __expf(m - mn);
        l *= corr;
#pragma unroll
        for (int d = 0; d < 32; ++d) o[d] *= corr;
#pragma unroll
        for (int j = 0; j < 8; ++j) {
            const float pj = __expf(s[j] - mn); l += pj;
            const u32x4* vp = (const u32x4*)(Vp + (size_t)(kk0 + j) * ldkv + part * 32);
#pragma unroll
            for (int w = 0; w < 4; ++w) { float vf[8]; unpack8(vp[w], vf);
#pragma unroll
                for (int e = 0; e < 8; ++e) o[8 * w + e] = fmaf(pj, vf[e], o[8 * w + e]); }
        }
        m = mn;
    }
    const float inv = 1.f / l;
    u32x4* op = (u32x4*)(Op + (size_t)qi * ldo + part * 32);
#pragma unroll
    for (int w = 0; w < 4; ++w) { u32x4 ov; ov.x = pk2(o[8 * w] * inv, o[8 * w + 1] * inv); ov.y = pk2(o[8 * w + 2] * inv, o[8 * w + 3] * inv); ov.z = pk2(o[8 * w + 4] * inv, o[8 * w + 5] * inv); ov.w = pk2(o[8 * w + 6] * inv, o[8 * w + 7] * inv); op[w] = ov; }
}

__device__ __forceinline__ void gemm_branch(const bf16_t* __restrict__ Ob, const bf16_t* __restrict__ WT, const bf16_t* __restrict__ G, bf16_t* __restrict__ Mg, int gw, int NW, int lane) {
    const int r = lane & 15, q = lane >> 4;
    const int ntn = D / 32, ntiles = (T / 32) * ntn;
    for (int tile = gw; tile < ntiles; tile += NW) {
        const int tm = tile / ntn, tn = tile % ntn;
        f32x4 acc[3][2][2];
#pragma unroll
        for (int s = 0; s < 3; ++s)
#pragma unroll
            for (int i = 0; i < 2; ++i)
#pragma unroll
                for (int j = 0; j < 2; ++j) acc[s][i][j] = (f32x4){0.f, 0.f, 0.f, 0.f};
        const bf16_t* ap = Ob + (size_t)(tm * 32 + r) * D + q * 8;
        const bf16_t* bp = WT + (size_t)(tn * 32 + r) * D + q * 8;
#pragma unroll
        for (int s = 0; s < 3; ++s) {
            const int kb = s == 0 ? 0 : (s == 1 ? 1024 : 1536), ke = s == 0 ? 1024 : (s == 1 ? 1536 : 2048);
            for (int k0 = kb; k0 < ke; k0 += 32) {
                bf16x8 af[2], bfr[2];
#pragma unroll
                for (int i = 0; i < 2; ++i) af[i] = *(const bf16x8*)(ap + (size_t)i * 16 * D + k0);
#pragma unroll
                for (int j = 0; j < 2; ++j) bfr[j] = *(const bf16x8*)(bp + (size_t)j * 16 * D + k0);
#pragma unroll
                for (int i = 0; i < 2; ++i)
#pragma unroll
                    for (int j = 0; j < 2; ++j) acc[s][i][j] = __builtin_amdgcn_mfma_f32_16x16x32_bf16(af[i], bfr[j], acc[s][i][j], 0, 0, 0);
            }
        }
#pragma unroll
        for (int i = 0; i < 2; ++i)
#pragma unroll
            for (int j = 0; j < 2; ++j)
#pragma unroll
                for (int e = 0; e < 4; ++e) {
                    const int row = tm * 32 + i * 16 + q * 4 + e, col = tn * 32 + j * 16 + r;
                    const bf16_t* gp = G + (size_t)row * GW + col;
                    const float mval = bf2f(gp[0]) * acc[0][i][j][e] + bf2f(gp[2048]) * acc[1][i][j][e] + bf2f(gp[4096]) * acc[2][i][j][e];
                    Mg[(size_t)row * D + col] = (bf16_t)f2bf(mval);
                }
    }
}

__device__ __forceinline__ unsigned long long shfl_xor64(unsigned long long v, int m) {
    const unsigned lo = __shfl_xor((unsigned)v, m), hi = __shfl_xor((unsigned)(v >> 32), m);
    return ((unsigned long long)hi << 32) | lo;
}
__device__ __forceinline__ unsigned fkey(float f) { const unsigned u = __float_as_uint(f); return (u & 0x80000000u) ? ~u : (u | 0x80000000u); }
__device__ __forceinline__ float fkey_inv(unsigned k) { const unsigned u = (k & 0x80000000u) ? (k & 0x7fffffffu) : ~k; return __uint_as_float(u); }
__device__ __forceinline__ unsigned long long wave_max64(unsigned long long k) {
#pragma unroll
    for (int o = 1; o < 64; o <<= 1) { const unsigned long long t = shfl_xor64(k, o); k = t > k ? t : k; }
    return k;
}
__device__ __forceinline__ void route_unit(const Params& p, int t, int h, int lane) {
    const bf16_t* Q = (const bf16_t*)(p.ws + WS_Q); const bf16_t* KB = (const bf16_t*)(p.ws + WS_KEYSB);
    int* RIDX = (int*)(p.ws + WS_RIDX); float* RG = (float*)(p.ws + WS_RG);
    float sv_l[2] = {0.f, 0.f}; int si_l[2] = {0, 0};
#pragma unroll
    for (int c = 0; c < 2; ++c) {
        const bf16_t* qv = Q + (size_t)t * D + h * 256 + c * 128;
        const unsigned qw = ((const unsigned*)qv)[lane];
        const float qa = bf2f(qw & 0xffffu), qb = bf2f(qw >> 16);
        const bf16_t* k0p = KB + ((size_t)(h * 2 + c) * NKEYS + lane) * 128;
        const bf16_t* k1p = k0p + 64 * 128;
        float s0 = 0.f, s1 = 0.f;
#pragma unroll
        for (int w = 0; w < 16; ++w) {
            float k0f[8], k1f[8]; unpack8(((const u32x4*)k0p)[w], k0f); unpack8(((const u32x4*)k1p)[w], k1f);
#pragma unroll
            for (int e = 0; e < 8; e += 2) {
                const int src = 4 * w + e / 2;
                const float xa = __int_as_float(__builtin_amdgcn_readlane(__float_as_int(qa), src));
                const float xb = __int_as_float(__builtin_amdgcn_readlane(__float_as_int(qb), src));
                s0 = fmaf(xa, k0f[e], s0); s0 = fmaf(xb, k0f[e + 1], s0);
                s1 = fmaf(xa, k1f[e], s1); s1 = fmaf(xb, k1f[e + 1], s1);
            }
        }
        unsigned long long ka = ((unsigned long long)fkey(s0) << 32) | (unsigned)(255 - lane);
        unsigned long long kb = ((unsigned long long)fkey(s1) << 32) | (unsigned)(255 - (lane + 64));
        for (int rnd = 0; rnd < TOPK; ++rnd) {
            const unsigned long long best = wave_max64(ka > kb ? ka : kb);
            if (ka == best) ka = 0ull; if (kb == best) kb = 0ull;
            if (lane == rnd) { sv_l[c] = fkey_inv((unsigned)(best >> 32)); si_l[c] = 255 - (int)(best & 0xffffffffu); }
        }
    }
    unsigned long long kc[4];
#pragma unroll
    for (int m = 0; m < 4; ++m) { const int cid = lane + 64 * m, i = cid >> 4, j = cid & 15;
        const float v = __shfl(sv_l[0], i) + __shfl(sv_l[1], j);
        kc[m] = ((unsigned long long)fkey(v) << 32) | (unsigned)(1023 - cid); }
    float fv = 0.f; int cidx = 0;
    for (int rnd = 0; rnd < TOPK; ++rnd) {
        unsigned long long loc = kc[0] > kc[1] ? kc[0] : kc[1]; const unsigned long long loc2 = kc[2] > kc[3] ? kc[2] : kc[3]; loc = loc > loc2 ? loc : loc2;
        const unsigned long long best = wave_max64(loc);
#pragma unroll
        for (int m = 0; m < 4; ++m) if (kc[m] == best) kc[m] = 0ull;
        if (lane == rnd) { fv = fkey_inv((unsigned)(best >> 32)); cidx = 1023 - (int)(best & 0xffffffffu); }
    }
    const float fmax_ = __shfl(fv, 0);
    float e = lane < 16 ? __expf(fv - fmax_) : 0.f;
    float ssum = e;
#pragma unroll
    for (int o = 1; o < 16; o <<= 1) ssum += __shfl_xor(ssum, o);
    const int ci = cidx >> 4, cj = cidx & 15;
    const int e0 = __shfl(si_l[0], ci), e1 = __shfl(si_l[1], cj);
    if (lane < 16) { RIDX[(size_t)t * 128 + h * 16 + lane] = e0 * NKEYS + e1; RG[(size_t)t * 128 + h * 16 + lane] = e / ssum; }
}

typedef float f32x2 __attribute__((ext_vector_type(2)));
__device__ __forceinline__ void fp4_row_load(const float* __restrict__ src, const float* __restrict__ kscale, int lane, f32x4 (&v)[8]) {
#pragma unroll
    for (int j = 0; j < 8; ++j) { v[j] = ((const f32x4*)src)[64 * j + lane]; if (kscale) v[j] = v[j] * ((const f32x4*)kscale)[64 * j + lane]; }
}
__device__ __forceinline__ void fp4_row_finish(const f32x4 (&v)[8], unsigned char* __restrict__ dst, float* __restrict__ scale_out, int lane) {
    float mx = 0.f;
#pragma unroll
    for (int j = 0; j < 8; ++j) mx = fmaxf(mx, fmaxf(fmaxf(fabsf(v[j].x), fabsf(v[j].y)), fmaxf(fabsf(v[j].z), fabsf(v[j].w))));
#pragma unroll
    for (int o = 1; o < 64; o <<= 1) mx = fmaxf(mx, __shfl_xor(mx, o));
    const float sc = mx > 0.f ? mx * (1.f / 6.f) : 1.f, inv = 1.f / sc;
    u32x4 out;
#pragma unroll
    for (int w = 0; w < 4; ++w) {
        const f32x4 a = v[2 * w] * inv, b = v[2 * w + 1] * inv;
        unsigned pk = 0u;
        pk = __builtin_amdgcn_cvt_scalef32_pk_fp4_f32(pk, fminf(fmaxf(a.x, -6.f), 6.f), fminf(fmaxf(a.y, -6.f), 6.f), 1.0f, 0);
        pk = __builtin_amdgcn_cvt_scalef32_pk_fp4_f32(pk, fminf(fmaxf(a.z, -6.f), 6.f), fminf(fmaxf(a.w, -6.f), 6.f), 1.0f, 1);
        pk = __builtin_amdgcn_cvt_scalef32_pk_fp4_f32(pk, fminf(fmaxf(b.x, -6.f), 6.f), fminf(fmaxf(b.y, -6.f), 6.f), 1.0f, 2);
        pk = __builtin_amdgcn_cvt_scalef32_pk_fp4_f32(pk, fminf(fmaxf(b.z, -6.f), 6.f), fminf(fmaxf(b.w, -6.f), 6.f), 1.0f, 3);
        out[w] = pk;
    }
    ((u32x4*)dst)[lane] = out;
    if (lane == 0) *scale_out = sc;
}
__device__ __forceinline__ void fp4_tables(const Params& p, int gw, int NW, int lane) {
    f32x4 va[8], vb[8];
#define FP4_LOAD(r, v) do { if ((r) < 16384) fp4_row_load(p.in[25] + (size_t)(r) * D, p.in[22], lane, v); else fp4_row_load(p.in[26] + (size_t)((r) - 16384) * D, nullptr, lane, v); } while (0)
#define FP4_FIN(r, v) do { if ((r) < 16384) fp4_row_finish(v, p.ws + WS_TABU + (size_t)(r) * 1024, (float*)(p.ws + WS_SCU) + (r), lane); \
        else fp4_row_finish(v, p.ws + WS_TABV + (size_t)((r) - 16384) * 1024, (float*)(p.ws + WS_SCV) + ((r) - 16384), lane); } while (0)
    const int n = 2 * 16384;
    int r = gw;
    if (r < n) FP4_LOAD(r, va);
    for (; r < n; r += 2 * NW) {
        const bool hb = r + NW < n;
        if (hb) FP4_LOAD(r + NW, vb);
        FP4_FIN(r, va);
        if (r + 2 * NW < n) FP4_LOAD(r + 2 * NW, va);
        if (hb) FP4_FIN(r + NW, vb);
    }
#undef FP4_LOAD
#undef FP4_FIN
}
struct RowB8 { u32x4 w[8]; };
__device__ __forceinline__ void peer_load_batch(RowB8& buf, const unsigned char* tab, int isel, int pbase, int lane) {
#pragma unroll
    for (int r = 0; r < 8; ++r) { const int e = __builtin_amdgcn_readlane(isel, (pbase + r) & 63);
        buf.w[r] = *(const u32x4*)(tab + (size_t)e * 1024 + lane * 16); }
}
__device__ __forceinline__ float dot_row(const u32x4 w, const float (&xf)[32]) {
    float a0 = 0.f, a1 = 0.f;
#pragma unroll
    for (int q = 0; q < 4; ++q) {
        const f32x2 a = __builtin_amdgcn_cvt_scalef32_pk_f32_fp4(w[q], 1.0f, 0), b = __builtin_amdgcn_cvt_scalef32_pk_f32_fp4(w[q], 1.0f, 1);
        const f32x2 c = __builtin_amdgcn_cvt_scalef32_pk_f32_fp4(w[q], 1.0f, 2), d = __builtin_amdgcn_cvt_scalef32_pk_f32_fp4(w[q], 1.0f, 3);
        a0 = fmaf(a.x, xf[8 * q], a0); a1 = fmaf(a.y, xf[8 * q + 1], a1); a0 = fmaf(b.x, xf[8 * q + 2], a0); a1 = fmaf(b.y, xf[8 * q + 3], a1);
        a0 = fmaf(c.x, xf[8 * q + 4], a0); a1 = fmaf(c.y, xf[8 * q + 5], a1); a0 = fmaf(d.x, xf[8 * q + 6], a0); a1 = fmaf(d.y, xf[8 * q + 7], a1);
    }
    return a0 + a1;
}
__device__ __forceinline__ void axpy_row(const u32x4 w, const float a_, float (&of)[32]) {
#pragma unroll
    for (int q = 0; q < 4; ++q) {
        const f32x2 a = __builtin_amdgcn_cvt_scalef32_pk_f32_fp4(w[q], 1.0f, 0), b = __builtin_amdgcn_cvt_scalef32_pk_f32_fp4(w[q], 1.0f, 1);
        const f32x2 c = __builtin_amdgcn_cvt_scalef32_pk_f32_fp4(w[q], 1.0f, 2), d = __builtin_amdgcn_cvt_scalef32_pk_f32_fp4(w[q], 1.0f, 3);
        of[8 * q] = fmaf(a_, a.x, of[8 * q]); of[8 * q + 1] = fmaf(a_, a.y, of[8 * q + 1]); of[8 * q + 2] = fmaf(a_, b.x, of[8 * q + 2]); of[8 * q + 3] = fmaf(a_, b.y, of[8 * q + 3]);
        of[8 * q + 4] = fmaf(a_, c.x, of[8 * q + 4]); of[8 * q + 5] = fmaf(a_, c.y, of[8 * q + 5]); of[8 * q + 6] = fmaf(a_, d.x, of[8 * q + 6]); of[8 * q + 7] = fmaf(a_, d.y, of[8 * q + 7]);
    }
}
__device__ __forceinline__ void peer_token(const Params& p, int t, int lane, LAS float* actL) {
    const bf16_t* XB = (const bf16_t*)(p.ws + WS_X2BF); const unsigned char* TU = p.ws + WS_TABU; const unsigned char* TV = p.ws + WS_TABV;
    const float* SCU = (const float*)(p.ws + WS_SCU); const float* SCV = (const float*)(p.ws + WS_SCV);
    const int* RIDX = (const int*)(p.ws + WS_RIDX); const float* RG = (const float*)(p.ws + WS_RG); const float* SS2 = (const float*)(p.ws + WS_CTL + CTL_SS2_BYTE);
    float xf[32];
#pragma unroll
    for (int j = 0; j < 8; ++j) { const u32x2 w = *(const u32x2*)(XB + (size_t)t * D + 256 * j + 4 * lane);
        xf[4 * j] = __uint_as_float(w.x << 16); xf[4 * j + 1] = __uint_as_float(w.x & 0xffff0000u); xf[4 * j + 2] = __uint_as_float(w.y << 16); xf[4 * j + 3] = __uint_as_float(w.y & 0xffff0000u); }
    const float rs = rsqrtf(SS2[t] * (1.f / D) + EPS);
    const int i0 = RIDX[(size_t)t * 128 + lane], i1 = RIDX[(size_t)t * 128 + 64 + lane];
    const float su0 = SCU[i0] * rs, su1 = SCU[i1] * rs;
    const float gv0 = RG[(size_t)t * 128 + lane] * SCV[i0], gv1 = RG[(size_t)t * 128 + 64 + lane] * SCV[i1];
    RowB8 A, B;
    const int rl = 4 * ((lane >> 5) & 1) + 2 * ((lane >> 4) & 1) + ((lane >> 3) & 1);
#define PEER_DOT(buf, pb) do { float d[8]; \
        _Pragma("unroll") for (int r = 0; r < 8; ++r) { u32x4 w_ = buf.w[r]; asm volatile("" : "+v"(w_)); d[r] = dot_row(w_, xf); asm volatile("" : "+v"(d[r])); } \
        const bool u5 = (lane & 32) != 0; float k4[4]; \
        _Pragma("unroll") for (int q = 0; q < 4; ++q) k4[q] = (u5 ? d[4 + q] : d[q]) + __shfl_xor(u5 ? d[q] : d[4 + q], 32); \
        const bool u4 = (lane & 16) != 0; float k2[2]; \
        _Pragma("unroll") for (int q = 0; q < 2; ++q) k2[q] = (u4 ? k4[2 + q] : k4[q]) + __shfl_xor(u4 ? k4[q] : k4[2 + q], 16); \
        const bool u3 = (lane & 8) != 0; \
        float v = (u3 ? k2[1] : k2[0]) + __shfl_xor(u3 ? k2[0] : k2[1], 8); \
        v += __shfl_xor(v, 4); v += __shfl_xor(v, 2); v += __shfl_xor(v, 1); \
        const int pi = (pb) + rl; const float su = __shfl(pi < 64 ? su0 : su1, pi & 63), gv = __shfl(pi < 64 ? gv0 : gv1, pi & 63); \
        if ((lane & 7) == 0) actL[pi] = gelu_tanh(v * su) * gv; } while (0)
    peer_load_batch(A, TU, i0, 0, lane);
#pragma unroll 1
    for (int b = 0; b < 16; b += 2) {
        peer_load_batch(B, TU, b < 8 ? i0 : i1, 8 * (b + 1), lane);
        PEER_DOT(A, 8 * b);
        if (b + 2 < 16) peer_load_batch(A, TU, (b + 2) < 8 ? i0 : i1, 8 * (b + 2), lane);
        PEER_DOT(B, 8 * (b + 1));
    }
#undef PEER_DOT
    float of[32];
#pragma unroll
    for (int q = 0; q < 32; ++q) of[q] = 0.f;
#define PIN_OF() do { asm volatile("" : "+v"(of[0]), "+v"(of[1]), "+v"(of[2]), "+v"(of[3]), "+v"(of[4]), "+v"(of[5]), "+v"(of[6]), "+v"(of[7]), "+v"(of[8]), "+v"(of[9]), "+v"(of[10]), "+v"(of[11]), "+v"(of[12]), "+v"(of[13]), "+v"(of[14]), "+v"(of[15])); \
        asm volatile("" : "+v"(of[16]), "+v"(of[17]), "+v"(of[18]), "+v"(of[19]), "+v"(of[20]), "+v"(of[21]), "+v"(of[22]), "+v"(of[23]), "+v"(of[24]), "+v"(of[25]), "+v"(of[26]), "+v"(of[27]), "+v"(of[28]), "+v"(of[29]), "+v"(of[30]), "+v"(of[31])); } while (0)
#define PEER_AXPY(buf, pb) do { \
        _Pragma("unroll") for (int r = 0; r < 8; ++r) { const float a = actL[(pb) + r]; u32x4 w_ = buf.w[r]; asm volatile("" : "+v"(w_)); axpy_row(w_, a, of); PIN_OF(); } } while (0)
    peer_load_batch(A, TV, i0, 0, lane);
#pragma unroll 1
    for (int b = 0; b < 16; b += 2) {
        peer_load_batch(B, TV, b < 8 ? i0 : i1, 8 * (b + 1), lane);
        PEER_AXPY(A, 8 * b);
        if (b + 2 < 16) peer_load_batch(A, TV, (b + 2) < 8 ? i0 : i1, 8 * (b + 2), lane);
        PEER_AXPY(B, 8 * (b + 1));
    }
#undef PEER_AXPY
#undef PIN_OF
    float* orow = p.out + (size_t)t * D;
#pragma unroll
    for (int j = 0; j < 8; ++j) { f32x4* o4 = (f32x4*)(orow + 256 * j + 4 * lane); f32x4 a = *o4;
        a.x += of[4 * j]; a.y += of[4 * j + 1]; a.z += of[4 * j + 2]; a.w += of[4 * j + 3]; *o4 = a; }
}

namespace pg8 {
#define PG8_LAS __attribute__((address_space(3)))
constexpr int BM = 256, BK = 64, HALF = 128, HTB = HALF * BK * 2, STAGE_BYTES = 8 * HTB, NXCD = 8, WGM = 8;
__host__ __device__ __forceinline__ int lds_byte(int r, int c) { const int st = (r >> 4) * 2 + (c >> 5), rr = r & 15, cc = c & 31, ob = rr * 64 + cc * 2; return st * 1024 + (ob ^ (((ob >> 9) & 1) << 5)); }
__host__ __device__ __forceinline__ void stage_rc(int b, int& R, int& C) { const int st = b / 1024, sb = b % 1024, swz = sb ^ (((sb >> 9) & 1) << 5); R = (st >> 1) * 16 + swz / 64; C = (st & 1) * 32 + (swz % 64) / 2; }
__host__ __device__ __forceinline__ int perm32(int rho) { const int n = rho >> 4, i = rho & 15; return 8 * (i >> 2) + 4 * n + (i & 3); }
struct Unit { const char* A; const char* B; int pm, pn, kind, nt; };
__device__ __forceinline__ const char* uni_ptr(const char* p) { const unsigned long long v = (unsigned long long)p; const unsigned lo = __builtin_amdgcn_readfirstlane((unsigned)v), hi = __builtin_amdgcn_readfirstlane((unsigned)(v >> 32)); return (const char*)(((unsigned long long)hi << 32) | lo); }
__device__ __forceinline__ void uni(Unit& u) { u.A = uni_ptr(u.A); u.B = uni_ptr(u.B); u.pm = __builtin_amdgcn_readfirstlane(u.pm); u.pn = __builtin_amdgcn_readfirstlane(u.pn); u.kind = __builtin_amdgcn_readfirstlane(u.kind); u.nt = __builtin_amdgcn_readfirstlane(u.nt); }
__device__ __forceinline__ void tile_of(int L, int nM, int nN, int& pm, int& pn) {
    const int nwg = nM * nN; int wgid = L; { const int q = nwg / NXCD, r = nwg % NXCD, xcd = wgid % NXCD, off = wgid / NXCD; wgid = (xcd < r ? xcd * (q + 1) : r * (q + 1) + (xcd - r) * q) + off; }
    const int nig = WGM * nN, gid = wgid / nig, fm = gid * WGM, gsz = (nM - fm) < WGM ? (nM - fm) : WGM;
    pm = fm + ((wgid % nig) % gsz); pn = (wgid % nig) / gsz;
}
typedef int v8i_t __attribute__((ext_vector_type(8))); typedef int v4i_t __attribute__((ext_vector_type(4)));
__device__ __forceinline__ v8i_t cat8(const bf16x8 lo, const bf16x8 hi) { const v4i_t a = __builtin_bit_cast(v4i_t, lo), b = __builtin_bit_cast(v4i_t, hi); return __builtin_shufflevector(a, b, 0, 1, 2, 3, 4, 5, 6, 7); }
template <bool FP8, class Epi, class Sched>
__device__ __forceinline__ void gemm_phase(PG8_LAS unsigned char* lds, const int lda, const int ldb, const Sched& S, const Epi& E) {
    const int tid = threadIdx.x, wid = __builtin_amdgcn_readfirstlane(tid >> 6), lane = tid & 63, wr = wid >> 2, wc = wid & 3, fr = lane & 15, fq = lane >> 4;
    unsigned voffA[2], voffB[2];
#pragma unroll
    for (int i = 0; i < 2; ++i) { int R, C; stage_rc(tid * 16 + i * 8192, R, C); const int Rb = (R & ~31) + perm32(R & 31);
        voffA[i] = (unsigned)(R * lda + C) * 2u; voffB[i] = (unsigned)(Rb * ldb + C) * 2u; }
    const size_t kstep = (size_t)(BK * 2);
    const size_t hstepA = (size_t)HALF * lda * 2, hstepB = (size_t)HALF * ldb * 2;
    const unsigned ldsw = (unsigned)wid * 1024u;
    const int aoff = lds_byte(wr * 64 + fr, fq * 8), boff = lds_byte(wc * 32 + fr, fq * 8);
#define PG8_SA(b, h) (((b) * 2 + (h)) * HTB)
#define PG8_SB(b, h) ((4 + (b) * 2 + (h)) * HTB)
#define PG8_STAGE(bufoff, gbase, voff) do { _Pragma("unroll") for (int _i = 0; _i < 2; ++_i) \
        __builtin_amdgcn_global_load_lds((const unsigned*)((const char*)(gbase) + (voff)[_i]), (PG8_LAS unsigned*)(lds + (bufoff) + ldsw + _i * 8192), 16, 0, 0); } while (0)
#define PG8_LDA(dst, b, h) do { _Pragma("unroll") for (int m = 0; m < 4; ++m) { if constexpr (FP8) dst##8[m] = cat8(*(const PG8_LAS bf16x8*)(lds + PG8_SA(b, h) + aoff + m * 2048), *(const PG8_LAS bf16x8*)(lds + PG8_SA(b, h) + aoff + m * 2048 + 1024)); \
        else { _Pragma("unroll") for (int k = 0; k < 2; ++k) dst[m][k] = *(const PG8_LAS bf16x8*)(lds + PG8_SA(b, h) + aoff + m * 2048 + k * 1024); } } } while (0)
#define PG8_LDB(dst, b, h) do { _Pragma("unroll") for (int n = 0; n < 2; ++n) { if constexpr (FP8) dst##8[n] = cat8(*(const PG8_LAS bf16x8*)(lds + PG8_SB(b, h) + boff + n * 2048), *(const PG8_LAS bf16x8*)(lds + PG8_SB(b, h) + boff + n * 2048 + 1024)); \
        else { _Pragma("unroll") for (int k = 0; k < 2; ++k) dst[n][k] = *(const PG8_LAS bf16x8*)(lds + PG8_SB(b, h) + boff + n * 2048 + k * 1024); } } } while (0)
#define PG8_MMA(ai, bj, At, Bt) do { __builtin_amdgcn_s_setprio(1); \
        if constexpr (FP8) { _Pragma("unroll") for (int m = 0; m < 4; ++m) _Pragma("unroll") for (int n = 0; n < 2; ++n) \
            asm volatile("v_mfma_scale_f32_16x16x128_f8f6f4 %0, %1, %2, %0, %3, %3 op_sel_hi:[0,0,0]" : "+v"(acc[ai][bj][m][n]) : "v"(Bt##8[n]), "v"(At##8[m]), "v"(mxone)); } \
        else { _Pragma("unroll") for (int m = 0; m < 4; ++m) _Pragma("unroll") for (int n = 0; n < 2; ++n) _Pragma("unroll") for (int k = 0; k < 2; ++k) \
            acc[ai][bj][m][n] = __builtin_amdgcn_mfma_f32_16x16x32_bf16(Bt[n][k], At[m][k], acc[ai][bj][m][n], 0, 0, 0); } \
        __builtin_amdgcn_s_setprio(0); } while (0)
#define PG8_WAIT_V(n) asm volatile("s_waitcnt vmcnt(" #n ")" ::: "memory")
#define PG8_WAIT_L(n) asm volatile("s_waitcnt lgkmcnt(" #n ")" ::: "memory")
#define PG8_BAR __builtin_amdgcn_s_barrier()
#define PG8_SCHED __builtin_amdgcn_sched_barrier(0)
    Unit cur, nxt; int ui = 0;
    if (!S.next(0, cur)) return;
    f32x4 acc[2][2][4][2];
#pragma unroll
    for (int a = 0; a < 2; ++a)
#pragma unroll
        for (int b = 0; b < 2; ++b)
#pragma unroll
            for (int m = 0; m < 4; ++m)
#pragma unroll
                for (int n = 0; n < 2; ++n) acc[a][b][m][n] = (f32x4){0.f, 0.f, 0.f, 0.f};
    const int mxone = 0x7F7F7F7F;
    bf16x8 At[4][2], B0[2][2], B1[2][2]; v8i_t At8[4], B08[2], B18[2];
    const char* cA = cur.A; const char* cB = cur.B;
    PG8_STAGE(PG8_SB(0, 0), cB, voffB); PG8_STAGE(PG8_SB(0, 1), cB + hstepB, voffB); PG8_STAGE(PG8_SA(0, 0), cA, voffA); PG8_STAGE(PG8_SA(0, 1), cA + hstepA, voffA);
    if (wr == 1) PG8_BAR;
    PG8_WAIT_V(2); PG8_BAR;
    PG8_STAGE(PG8_SB(1, 0), cB + kstep, voffB); PG8_STAGE(PG8_SA(1, 0), cA + kstep, voffA); PG8_STAGE(PG8_SB(1, 1), cB + hstepB + kstep, voffB);
    PG8_WAIT_V(6); PG8_BAR;
    for (;;) {
        const bool has_next = S.next(ui + 1, nxt);
        const char* nA = has_next ? nxt.A : cA; const char* nB = has_next ? nxt.B : cB;
        const int nt = cur.nt;
        for (int t = 0; t < nt; t += 2) {
            const bool last = (t == nt - 2);
            const char* a1 = cA + (size_t)(t + 1) * kstep;
            const char* a2 = last ? nA : cA + (size_t)(t + 2) * kstep; const char* b2 = last ? nB : cB + (size_t)(t + 2) * kstep;
            const char* a3 = a2 + kstep; const char* b3 = b2 + kstep;
            PG8_LDB(B0, 0, 0); PG8_LDB(B1, 0, 1); PG8_SCHED; PG8_LDA(At, 0, 0); PG8_STAGE(PG8_SA(1, 1), a1 + hstepA, voffA);
            PG8_WAIT_V(8); PG8_WAIT_L(0); PG8_BAR; PG8_MMA(0, 0, At, B0); PG8_MMA(0, 1, At, B1); PG8_BAR; PG8_SCHED;
            PG8_LDA(At, 0, 1); PG8_STAGE(PG8_SB(0, 0), b2, voffB); PG8_STAGE(PG8_SB(0, 1), b2 + hstepB, voffB); PG8_STAGE(PG8_SA(0, 0), a2, voffA);
            PG8_WAIT_V(8); PG8_WAIT_L(0); PG8_BAR; PG8_MMA(1, 0, At, B0); PG8_MMA(1, 1, At, B1); PG8_BAR; PG8_SCHED;
            PG8_LDB(B0, 1, 0); PG8_LDB(B1, 1, 1); PG8_SCHED; PG8_LDA(At, 1, 0); PG8_STAGE(PG8_SA(0, 1), a2 + hstepA, voffA);
            PG8_WAIT_V(8); PG8_WAIT_L(0); PG8_BAR; PG8_MMA(0, 0, At, B0); PG8_MMA(0, 1, At, B1); PG8_BAR; PG8_SCHED;
            PG8_LDA(At, 1, 1); PG8_STAGE(PG8_SB(1, 0), b3, voffB); PG8_STAGE(PG8_SB(1, 1), b3 + hstepB, voffB); PG8_STAGE(PG8_SA(1, 0), a3, voffA);
            PG8_WAIT_V(8); PG8_WAIT_L(0); PG8_BAR; PG8_MMA(1, 0, At, B0); PG8_MMA(1, 1, At, B1); PG8_BAR; PG8_SCHED;
        }
        if (wr == 0) PG8_BAR;
        if constexpr (FP8) asm volatile("s_nop 15\n\ts_nop 15" ::: "memory");
        E(acc, cur, wr, wc, fr, fq);
        if (!has_next) break;
        if (E.reset(cur)) {
#pragma unroll
        for (int a = 0; a < 2; ++a)
#pragma unroll
            for (int b = 0; b < 2; ++b)
#pragma unroll
                for (int m = 0; m < 4; ++m)
#pragma unroll
                    for (int n = 0; n < 2; ++n) acc[a][b][m][n] = (f32x4){0.f, 0.f, 0.f, 0.f};
        }
        cur = nxt; cA = nA; cB = nB; ++ui;
        if (wr == 1) PG8_BAR;
    }
    PG8_WAIT_V(0);
    PG8_BAR;
#undef PG8_SA
#undef PG8_SB
#undef PG8_STAGE
#undef PG8_LDA
#undef PG8_LDB
#undef PG8_MMA
#undef PG8_WAIT_V
#undef PG8_WAIT_L
#undef PG8_BAR
#undef PG8_SCHED
}
}
typedef f32x4 AccT[2][2][4][2];
#define EPI_RESET_ALWAYS __device__ __forceinline__ bool reset(const pg8::Unit&) const { return true; }
__device__ __forceinline__ unsigned cvt_pk_bf16(float lo, float hi) { unsigned r; asm volatile("v_cvt_pk_bf16_f32 %0, %1, %2" : "=v"(r) : "v"(lo), "v"(hi)); return r; }
__device__ __forceinline__ u32x4 pack8(const f32x4 v0, const f32x4 v1) { u32x4 w; w.x = cvt_pk_bf16(v0[0], v0[1]); w.y = cvt_pk_bf16(v0[2], v0[3]); w.z = cvt_pk_bf16(v1[0], v1[1]); w.w = cvt_pk_bf16(v1[2], v1[3]); return w; }
template <int MODE>
__device__ __forceinline__ void store_tile_bf16(const AccT& acc, bf16_t* base, int ldc, int row0, int col0, const float* bias, const float ascale = 1.f) {
#pragma unroll
    for (int ai = 0; ai < 2; ++ai)
#pragma unroll
        for (int m = 0; m < 4; ++m) { bf16_t* rowp = base + (size_t)(row0 + ai * 128 + m * 16) * ldc + col0;
#pragma unroll
            for (int bj = 0; bj < 2; ++bj) { f32x4 v0 = acc[ai][bj][m][0], v1 = acc[ai][bj][m][1];
                if (MODE == 1) { _Pragma("unroll") for (int e = 0; e < 4; ++e) { v0[e] = gelu_tanh(v0[e]); v1[e] = gelu_tanh(v1[e]); } }
                if (MODE == 2) { const f32x4 b0 = *(const f32x4*)(bias + col0 + bj * 128), b1 = *(const f32x4*)(bias + col0 + bj * 128 + 4);
                    v0 = v0 * ascale + b0; v1 = v1 * ascale + b1; _Pragma("unroll") for (int e = 0; e < 4; ++e) { v0[e] = sigmoid_(v0[e]); v1[e] = sigmoid_(v1[e]); } }
                *(u32x4*)(rowp + bj * 128) = pack8(v0, v1); }
            if (MODE == 2) asm volatile("" ::: "memory"); }
}
struct SchedP1a { const char* H; const char* WT; const char* MEMN; const char* WTM; int G, c;
    __device__ __forceinline__ bool next(int i, pg8::Unit& u) const {
        const int L = i * G + c; const int n1 = 64 * 18;
        if (L < n1) { pg8::tile_of(L, 64, 18, u.pm, u.pn); u.kind = 0; u.A = H + (size_t)u.pm * 256 * D * 2; u.B = WT + (size_t)u.pn * 256 * D * 2; u.nt = D / 64; pg8::uni(u); return true; }
        if (L < n1 + 8) { const int j = L - n1; u.pm = j >> 2; u.pn = j & 3; u.kind = 1; u.A = MEMN + (size_t)u.pm * 256 * D * 2; u.B = WTM + (size_t)u.pn * 256 * D * 2; u.nt = D / 64; pg8::uni(u); return true; }
        return false; } };
struct EpiP1a { bf16_t* PROJ; bf16_t* MEMKV; EPI_RESET_ALWAYS
    __device__ __forceinline__ void operator()(AccT& acc, const pg8::Unit& u, int wr, int wc, int fr, int fq) const {
        const int row0 = u.pm * 256 + wr * 64 + fr, cl = wc * 32 + 8 * fq;
        if (u.kind == 1) { store_tile_bf16<0>(acc, MEMKV, 2 * CW, row0, u.pn * 256 + cl, nullptr); return; }
        if (u.pn == 14 || u.pn == 15) { store_tile_bf16<1>(acc, PROJ, INW, row0, u.pn * 256 + cl, nullptr); return; }
        store_tile_bf16<0>(acc, PROJ, INW, row0, u.pn * 256 + cl, nullptr);
    } };
struct SchedP1b { const char* H8; const char* WT8; int G, c;
    __device__ __forceinline__ bool next(int i, pg8::Unit& u) const {
        const int L = i * G + c; if (L >= 64 * 24) return false;
        pg8::tile_of(L, 64, 24, u.pm, u.pn); u.kind = 0; u.A = H8 + (size_t)u.pm * 256 * D; u.B = WT8 + (size_t)u.pn * 256 * D; u.nt = D / 128; pg8::uni(u); return true; } };
struct EpiP1b { bf16_t* G; const float* bgate; EPI_RESET_ALWAYS
    __device__ __forceinline__ void operator()(AccT& acc, const pg8::Unit& u, int wr, int wc, int fr, int fq) const {
        store_tile_bf16<2>(acc, G, GW, u.pm * 256 + wr * 64 + fr, u.pn * 256 + wc * 32 + 8 * fq, bgate, 1.f / GATE_WSCALE);
    } };
struct SchedP3 { const char* O; const char* WT; int G, c;
    __device__ __forceinline__ bool next(int i, pg8::Unit& u) const {
        const int ti = i / 3, seg = i - 3 * ti; const int L = ti * G + c; if (L >= 64 * 8) return false;
        pg8::tile_of(L, 64, 8, u.pm, u.pn); u.kind = seg;
        const int kb = seg == 0 ? 0 : (seg == 1 ? 1024 : 1536);
        u.A = O + ((size_t)u.pm * 256 * D + kb) * 2; u.B = WT + ((size_t)u.pn * 256 * D + kb) * 2; u.nt = seg == 0 ? 16 : 8; pg8::uni(u); return true; } };
struct EpiP3 { const bf16_t* G; bf16_t* MERGED;
    __device__ __forceinline__ bool reset(const pg8::Unit& u) const { return u.kind == 2; }
    __device__ __forceinline__ void operator()(AccT& acc, const pg8::Unit& u, int wr, int wc, int fr, int fq) const {
        const int row0 = u.pm * 256 + wr * 64 + fr, col0 = u.pn * 256 + wc * 32 + 8 * fq, seg = u.kind;
#pragma unroll
        for (int ai = 0; ai < 2; ++ai)
#pragma unroll
            for (int mh = 0; mh < 2; ++mh) {
                u32x4 ga[2][2], gb[2][2];
#pragma unroll
                for (int mm = 0; mm < 2; ++mm)
#pragma unroll
                    for (int bj = 0; bj < 2; ++bj) { const bf16_t* gp = G + (size_t)(row0 + ai * 128 + (mh * 2 + mm) * 16) * GW + col0 + bj * 128;
                        ga[mm][bj] = *(const u32x4*)(gp + seg * D); gb[mm][bj] = (seg < 2) ? *(const u32x4*)(gp + (seg + 1) * D) : (u32x4){0u, 0u, 0u, 0u}; }
#pragma unroll
                for (int mm = 0; mm < 2; ++mm)
#pragma unroll
                    for (int bj = 0; bj < 2; ++bj) { const int m = mh * 2 + mm;
                        float fa[8], fb[8]; unpack8(ga[mm][bj], fa); unpack8(gb[mm][bj], fb);
                        if (seg < 2) { _Pragma("unroll") for (int e = 0; e < 8; ++e) fa[e] = fa[e] * __builtin_amdgcn_rcpf(fmaxf(fb[e], 1e-20f)); }
                        f32x4& v0 = acc[ai][bj][m][0]; f32x4& v1 = acc[ai][bj][m][1];
                        v0[0] *= fa[0]; v0[1] *= fa[1]; v0[2] *= fa[2]; v0[3] *= fa[3]; v1[0] *= fa[4]; v1[1] *= fa[5]; v1[2] *= fa[6]; v1[3] *= fa[7];
                        if (seg == 2) *(u32x4*)(MERGED + (size_t)(row0 + ai * 128 + m * 16) * D + col0 + bj * 128) = pack8(v0, v1);
                    }
                asm volatile("" ::: "memory");
            }
    } };
struct SchedSq { const char* A; const char* WT; int G, c;
    __device__ __forceinline__ bool next(int i, pg8::Unit& u) const {
        const int L = i * G + c; if (L >= 64 * 8) return false;
        pg8::tile_of(L, 64, 8, u.pm, u.pn); u.kind = 0; u.A = A + (size_t)u.pm * 256 * D * 2; u.B = WT + (size_t)u.pn * 256 * D * 2; u.nt = D / 64; pg8::uni(u); return true; } };
struct EpiP4 { const float* x; float* out; bf16_t* xb; float* ss; EPI_RESET_ALWAYS
    __device__ __forceinline__ void operator()(AccT& acc, const pg8::Unit& u, int wr, int wc, int fr, int fq) const {
        const int row0 = u.pm * 256 + wr * 64 + fr, col0 = u.pn * 256 + wc * 32 + 8 * fq;
#pragma unroll
        for (int ai = 0; ai < 2; ++ai)
#pragma unroll
            for (int m = 0; m < 4; ++m) { const size_t row = (size_t)(row0 + ai * 128 + m * 16); float sq = 0.f;
#pragma unroll
                for (int bj = 0; bj < 2; ++bj) { const size_t o = row * D + col0 + bj * 128;
                    const f32x4 v0 = acc[ai][bj][m][0] + *(const f32x4*)(x + o), v1 = acc[ai][bj][m][1] + *(const f32x4*)(x + o + 4);
                    *(f32x4*)(out + o) = v0; *(f32x4*)(out + o + 4) = v1; *(u32x4*)(xb + o) = pack8(v0, v1);
                    sq += (v0[0] * v0[0] + v0[1] * v0[1]) + (v0[2] * v0[2] + v0[3] * v0[3]) + (v1[0] * v1[0] + v1[1] * v1[1]) + (v1[2] * v1[2] + v1[3] * v1[3]); }
                sq += __shfl_xor(sq, 16); sq += __shfl_xor(sq, 32);
                if (fq == 0) atomicAdd(ss + row, sq); }
    } };
struct EpiP5 { bf16_t* Q; const float* ss; EPI_RESET_ALWAYS
    __device__ __forceinline__ void operator()(AccT& acc, const pg8::Unit& u, int wr, int wc, int fr, int fq) const {
        const int row0 = u.pm * 256 + wr * 64 + fr, col0 = u.pn * 256 + wc * 32 + 8 * fq;
#pragma unroll
        for (int ai = 0; ai < 2; ++ai)
#pragma unroll
            for (int m = 0; m < 4; ++m) { const size_t row = (size_t)(row0 + ai * 128 + m * 16); const float rs = rsqrtf(ss[row] * (1.f / D) + EPS);
#pragma unroll
                for (int bj = 0; bj < 2; ++bj) *(u32x4*)(Q + row * D + col0 + bj * 128) = pack8(acc[ai][bj][m][0] * rs, acc[ai][bj][m][1] * rs); }
    } };


namespace att {
using s16x4  = __attribute__((ext_vector_type(4))) short;
using f32x16 = __attribute__((ext_vector_type(16))) float;
constexpr int NWV = 8, QBLK = 32, KVBLK = 64, DH = 128;
constexpr float THR = 8.f;
constexpr int SHM_V = KVBLK * DH * 2, SHM_K = KVBLK * DH * 2;
constexpr int OFF_WS = 2 * SHM_V + 2 * SHM_K, OFF_BT = OFF_WS + NWV * 64 * 4, OFF_OST = OFF_BT + 1536, LDS_NEED = OFF_OST + NWV * 8192;
#define KSWZ(row, colB) ((row) * 256 + ((colB) ^ (((row) & 7) << 4)))
#define SBAR() __builtin_amdgcn_sched_barrier(0)
__device__ __forceinline__ int crow(int r, int hi) { return (r & 3) + 8 * (r >> 2) + 4 * hi; }
__device__ __forceinline__ unsigned cvtpk(float lo, float hi) { unsigned r; asm volatile("v_cvt_pk_bf16_f32 %0, %1, %2" : "=v"(r) : "v"(lo), "v"(hi)); return r; }
__device__ __forceinline__ void partialSM(f32x16& p0, f32x16& p1, float& m_reg, float& mn, float& alpha) {
  constexpr float C = 1.4426950408889634f;
  float pmax = p0[0];
#pragma unroll
  for (int r = 1; r < 16; ++r) pmax = fmaxf(pmax, p0[r]);
#pragma unroll
  for (int r = 0; r < 16; ++r) pmax = fmaxf(pmax, p1[r]);
  { auto rr = __builtin_amdgcn_permlane32_swap(__float_as_uint(pmax), __float_as_uint(pmax), false, false);
    pmax = fmaxf(__uint_as_float(rr[0]), __uint_as_float(rr[1])); }
  if (__builtin_expect(__all(pmax - m_reg <= THR), 1)) { mn = m_reg; alpha = 1.f; }
  else { mn = fmaxf(m_reg, pmax); alpha = __builtin_amdgcn_exp2f((m_reg - mn) * C); m_reg = mn; }
  float mnC = -mn * C;
#pragma unroll
  for (int r = 0; r < 16; ++r) p0[r] = fmaf(p0[r], C, mnC);
#pragma unroll
  for (int r = 0; r < 16; ++r) p1[r] = fmaf(p1[r], C, mnC);
#pragma unroll
  for (int r = 0; r < 16; ++r) p0[r] = __builtin_amdgcn_exp2f(p0[r]);
}
__device__ __forceinline__ void finishSM(f32x16& p0, f32x16& p1, float alpha, float& l_reg, bf16x8& pa0, bf16x8& pa1, bf16x8& pa2, bf16x8& pa3) {
#pragma unroll
  for (int r = 0; r < 16; ++r) p1[r] = __builtin_amdgcn_exp2f(p1[r]);
  float ps = 0;
#pragma unroll
  for (int r = 0; r < 16; ++r) ps += p0[r];
#pragma unroll
  for (int r = 0; r < 16; ++r) ps += p1[r];
  { auto rr = __builtin_amdgcn_permlane32_swap(__float_as_uint(ps), __float_as_uint(ps), false, false);
    ps = __uint_as_float(rr[0]) + __uint_as_float(rr[1]); }
  l_reg = l_reg * alpha + ps;
#define PK4(P, BASE, OUT) do { unsigned a0 = cvtpk(P[BASE + 0], P[BASE + 1]), a1 = cvtpk(P[BASE + 2], P[BASE + 3]);   \
    unsigned b0 = cvtpk(P[BASE + 4], P[BASE + 5]), b1 = cvtpk(P[BASE + 6], P[BASE + 7]);                              \
    auto r0 = __builtin_amdgcn_permlane32_swap(a0, b0, false, false); auto r1 = __builtin_amdgcn_permlane32_swap(a1, b1, false, false); \
    u32x4 w = {r0[0], r1[0], r0[1], r1[1]}; OUT = *reinterpret_cast<bf16x8*>(&w); } while (0)
  PK4(p0, 0, pa0); PK4(p0, 8, pa1); PK4(p1, 0, pa2); PK4(p1, 8, pa3);
#undef PK4
}
template <bool BIAS>
__device__ __forceinline__ void qkt(f32x16& p0, f32x16& p1, const LAS char* Ks, const LAS char* qs, int r32, int hi, const LAS float* bp) {
  if (BIAS) {
#pragma unroll
    for (int r = 0; r < 16; ++r) { p0[r] = bp[(r & 3) + 8 * (r >> 2)]; p1[r] = bp[32 + (r & 3) + 8 * (r >> 2)]; }
  } else { p0 = f32x16{}; p1 = f32x16{}; }
#pragma unroll
  for (int d0 = 0; d0 < 8; ++d0) { int cb = (d0 * 16 + hi * 8) * 2;
    bf16x8 b0 = *reinterpret_cast<const LAS bf16x8*>(Ks + KSWZ(r32, cb));
    bf16x8 b1 = *reinterpret_cast<const LAS bf16x8*>(Ks + KSWZ(32 + r32, cb));
    const bf16x8 qv = *reinterpret_cast<const LAS bf16x8*>(qs + d0 * 1024);
    p0 = __builtin_amdgcn_mfma_f32_32x32x16_bf16(b0, qv, p0, 0, 0, 0);
    p1 = __builtin_amdgcn_mfma_f32_32x32x16_bf16(b1, qv, p1, 0, 0, 0); }
}
__device__ __forceinline__ int v_st(int k, int c) { const int kk = (k & ~0xC) | ((k & 4) << 1) | ((k & 8) >> 1); return ((kk >> 3) * 4 + (c >> 5)) * 512 + ((kk & 7) * 32 + (c & 31)) * 2; }
__device__ __forceinline__ int v_rd_base(int lane) { return ((lane & 3) << 3) | (((lane >> 2) & 3) << 6) | (((lane >> 4) & 1) << 5) | (((lane >> 5) & 1) << 8); }
constexpr int v_rd_off(int d0, int ks, int half) { return d0 * 512 + ks * 4096 + half * 2048; }
template <int OFF> __device__ __forceinline__ s16x4 tr_read(int vb) {
  s16x4 r; asm volatile("ds_read_b64_tr_b16 %0, %1 offset:%2" : "=&v"(r) : "v"(vb), "i"(OFF) : "memory"); return r;
}
template <int D0> __device__ __forceinline__ void pv_one(f32x16& od, int vb, bf16x8 pa0, bf16x8 pa1, bf16x8 pa2, bf16x8 pa3) {
  const s16x4 l0 = tr_read<v_rd_off(D0, 0, 0)>(vb), h0 = tr_read<v_rd_off(D0, 0, 1)>(vb), l1 = tr_read<v_rd_off(D0, 1, 0)>(vb), h1 = tr_read<v_rd_off(D0, 1, 1)>(vb);
  const s16x4 l2 = tr_read<v_rd_off(D0, 2, 0)>(vb), h2 = tr_read<v_rd_off(D0, 2, 1)>(vb), l3 = tr_read<v_rd_off(D0, 3, 0)>(vb), h3 = tr_read<v_rd_off(D0, 3, 1)>(vb);
  asm volatile("s_waitcnt lgkmcnt(0)" ::: "memory"); SBAR();
#define PK(L, H) (bf16x8){L[0], L[1], L[2], L[3], H[0], H[1], H[2], H[3]}
  od = __builtin_amdgcn_mfma_f32_32x32x16_bf16(pa0, PK(l0, h0), od, 0, 0, 0);
  od = __builtin_amdgcn_mfma_f32_32x32x16_bf16(pa1, PK(l1, h1), od, 0, 0, 0);
  od = __builtin_amdgcn_mfma_f32_32x32x16_bf16(pa2, PK(l2, h2), od, 0, 0, 0);
  od = __builtin_amdgcn_mfma_f32_32x32x16_bf16(pa3, PK(l3, h3), od, 0, 0, 0);
#undef PK
}
__device__ __forceinline__ void pv_d0(f32x16* o, int vb, bf16x8 pa0, bf16x8 pa1, bf16x8 pa2, bf16x8 pa3) {
  pv_one<0>(o[0], vb, pa0, pa1, pa2, pa3); pv_one<1>(o[1], vb, pa0, pa1, pa2, pa3); pv_one<2>(o[2], vb, pa0, pa1, pa2, pa3); pv_one<3>(o[3], vb, pa0, pa1, pa2, pa3);
}
template <int LDQ, int LDK, int LDO, bool BAND>
__device__ __forceinline__ void attn_body(const bf16_t* Qb, const bf16_t* Kh, const bf16_t* Vh, bf16_t* Ob,
                                          const int NT, const int kc0, const float* btab_src, LAS char* lds) {
  const int tid = threadIdx.x, wid = __builtin_amdgcn_readfirstlane(tid >> 6), lane = tid & 63, r32 = lane & 31, hi = lane >> 5;
  LAS char* V_lds = lds; LAS char* K_lds = lds + 2 * SHM_V;
  LAS float* wsf = (LAS float*)(lds + OFF_WS) + wid * 64; LAS float* li_l = wsf; LAS float* al_l = wsf + 32;
  LAS float* btab = (LAS float*)(lds + OFF_BT);
  if (BAND) { if (tid < 384) btab[tid] = tid < 64 ? btab_src[256] : (tid < 256 ? btab_src[320 - tid] : -30000.f); }
  float m_reg = -10000.f, l_reg = 0; f32x16 o[4] = {};
  const bf16_t* Qw = Qb + (long)(wid * QBLK + r32) * LDQ + hi * 8;
  LAS char* qr = lds + OFF_OST + wid * 8192 + lane * 16;
#pragma unroll
  for (int d0 = 0; d0 < 8; ++d0) *reinterpret_cast<LAS bf16x8*>(qr + d0 * 1024) = *reinterpret_cast<const bf16x8*>(Qw + d0 * 16);
  const int sr = tid >> 4, sc = (tid & 15) * 8, vst0 = v_st(sr, sc), vst1 = v_st(32 + sr, sc);
  const int vb0 = (int)(unsigned)(uintptr_t)V_lds + v_rd_base(lane);
  struct { bf16x8 vs0, vs1, ks0, ks1; } sr_[1];
  const int pw = wid >> 1, qi = (wid & 1) * 32 + r32;
#define TROW(t) ((BAND ? (((kc0) + (t)) > 0 ? ((kc0) + (t)) : 0) : (t)) * KVBLK)
#define SLOAD(i, t) do { const long k0_ = TROW(t); sr_[i].vs0 = *reinterpret_cast<const bf16x8*>(&Vh[(k0_ + sr) * LDK + sc]); sr_[i].vs1 = *reinterpret_cast<const bf16x8*>(&Vh[(k0_ + 32 + sr) * LDK + sc]); \
    sr_[i].ks0 = *reinterpret_cast<const bf16x8*>(&Kh[(k0_ + sr) * LDK + sc]); sr_[i].ks1 = *reinterpret_cast<const bf16x8*>(&Kh[(k0_ + 32 + sr) * LDK + sc]); } while (0)
#define SWRITE(b, i) do { *(LAS bf16x8*)(V_lds + (b) * SHM_V + vst0) = sr_[i].vs0; *(LAS bf16x8*)(V_lds + (b) * SHM_V + vst1) = sr_[i].vs1; int kc_ = sc * 2; \
    *(LAS bf16x8*)(K_lds + (b) * SHM_K + KSWZ(sr, kc_)) = sr_[i].ks0; *(LAS bf16x8*)(K_lds + (b) * SHM_K + KSWZ(32 + sr, kc_)) = sr_[i].ks1; } while (0)
#define SWAIT() asm volatile("s_waitcnt vmcnt(0)" ::: "memory")
#define RESC(a) do { if (__any((a) < 1.f)) { if (hi == 0) al_l[r32] = (a); asm volatile("s_waitcnt lgkmcnt(0)" ::: "memory"); \
    _Pragma("unroll") for (int d = 0; d < 4; ++d) _Pragma("unroll") for (int r = 0; r < 16; ++r) o[d][r] *= al_l[crow(r, hi)]; } } while (0)
#define BPTR(t) ({ const int t_ = (t); const int dch = pw + 8 - t_; int kb_ = 192 - dch * 64 - qi + 4 * hi; kb_ = kb_ < 0 ? 0 : kb_; \
    if (dch < 0 || dch > 8 || (kc0) + t_ < 0) kb_ = 288; (const LAS float*)(btab + kb_); })
  f32x16 pA0, pA1, pB0, pB1; float mnA, mnB, alA, alB; bf16x8 pa0, pa1, pa2, pa3;
  constexpr int SE = 0, SO = 0;
  SLOAD(SE, 0); asm volatile("s_waitcnt vmcnt(0)" ::: "memory"); SWRITE(0, SE); __syncthreads();
  qkt<BAND>(pA0, pA1, K_lds, qr, r32, hi, BPTR(0)); partialSM(pA0, pA1, m_reg, mnA, alA);
  SLOAD(SO, 1);
  SWAIT(); SWRITE(1, SO); __syncthreads();
  for (int j = 1; j + 1 < NT; j += 2) {
    SBAR(); qkt<BAND>(pB0, pB1, K_lds + SHM_K, qr, r32, hi, BPTR(j));
    finishSM(pA0, pA1, alA, l_reg, pa0, pa1, pa2, pa3); SBAR();
    SLOAD(SO, j + 1); SBAR();
    pv_d0(o, vb0, pa0, pa1, pa2, pa3); partialSM(pB0, pB1, m_reg, mnB, alB);
    __syncthreads(); SWAIT(); SWRITE(0, SE);
    RESC(alB); __syncthreads();
    SBAR(); qkt<BAND>(pA0, pA1, K_lds, qr, r32, hi, BPTR(j + 1));
    finishSM(pB0, pB1, alB, l_reg, pa0, pa1, pa2, pa3); SBAR();
    SLOAD(SE, j + 2); SBAR();
    pv_d0(o, vb0 + SHM_V, pa0, pa1, pa2, pa3); partialSM(pA0, pA1, m_reg, mnA, alA);
    __syncthreads(); SWAIT(); SWRITE(1, SO);
    RESC(alA); __syncthreads();
  }
  SBAR(); qkt<BAND>(pB0, pB1, K_lds + SHM_K, qr, r32, hi, BPTR(NT - 1));
  finishSM(pA0, pA1, alA, l_reg, pa0, pa1, pa2, pa3); SBAR();
  pv_d0(o, vb0, pa0, pa1, pa2, pa3); partialSM(pB0, pB1, m_reg, mnB, alB);
  __syncthreads(); RESC(alB);
  finishSM(pB0, pB1, alB, l_reg, pa0, pa1, pa2, pa3); SBAR();
  pv_d0(o, vb0 + SHM_V, pa0, pa1, pa2, pa3);
  if (hi == 0) li_l[r32] = l_reg; asm volatile("s_waitcnt lgkmcnt(0)" ::: "memory");
  float rli[16];
#pragma unroll
  for (int r = 0; r < 16; ++r) rli[r] = __builtin_amdgcn_rcpf(li_l[crow(r, hi)]);
  { LAS bf16_t* stg = (LAS bf16_t*)(lds + OFF_OST + wid * 8192);
#pragma unroll
    for (int r = 0; r < 16; ++r) { const int orow = crow(r, hi);
#pragma unroll
      for (int d0 = 0; d0 < 4; ++d0) stg[orow * 128 + d0 * 32 + r32] = (bf16_t)f2bf(o[d0][r] * rli[r]); }
    asm volatile("s_waitcnt lgkmcnt(0)" ::: "memory");
    bf16_t* Ow = Ob + (long)(wid * QBLK) * LDO;
#pragma unroll
    for (int i = 0; i < 8; ++i) { const int row = i * 4 + (lane >> 4), ch = lane & 15; const u32x4 v = *(const LAS u32x4*)(stg + row * 128 + ch * 8); *(u32x4*)(Ow + (long)row * LDO + ch * 8) = v; } }
  __syncthreads();
#undef TROW
#undef SLOAD
#undef SWRITE
#undef SWAIT
#undef RESC
#undef BPTR
}
#undef KSWZ
#undef SBAR
}


namespace rt {
using f32x16 = __attribute__((ext_vector_type(16))) float;
#define RKSWZ(row, colB) ((row) * 256 + ((colB) ^ (((row) & 7) << 4)))
__device__ __forceinline__ int crow(int r, int hi) { return (r & 3) + 8 * (r >> 2) + 4 * hi; }
__device__ __forceinline__ void ce_desc(unsigned& a, unsigned& b) { const unsigned mx = a > b ? a : b, mn = a > b ? b : a; a = mx; b = mn; }
__device__ __forceinline__ void sort16_desc(unsigned (&v)[16]) {
#pragma unroll
  for (int k = 2; k <= 16; k <<= 1)
#pragma unroll
    for (int j = k >> 1; j > 0; j >>= 1)
#pragma unroll
      for (int i = 0; i < 16; ++i) { const int l = i ^ j; if (l > i) { if ((i & k) == 0) ce_desc(v[i], v[l]); else ce_desc(v[l], v[i]); } }
}
__device__ __forceinline__ void merge16_desc(unsigned (&a)[16], const unsigned (&b)[16]) {
#pragma unroll
  for (int i = 0; i < 16; ++i) a[i] = a[i] > b[15 - i] ? a[i] : b[15 - i];
#pragma unroll
  for (int j = 8; j > 0; j >>= 1)
#pragma unroll
    for (int i = 0; i < 16; ++i) { const int l = i ^ j; if (l > i) ce_desc(a[i], a[l]); }
}
__device__ __forceinline__ unsigned fkey(float f) { const unsigned u = __float_as_uint(f); return (u & 0x80000000u) ? ~u : (u | 0x80000000u); }
__device__ __forceinline__ float fkey_inv(unsigned k) { const unsigned u = (k & 0x80000000u) ? (k & 0x7fffffffu) : ~k; return __uint_as_float(u); }
__device__ __forceinline__ void top16_half(const f32x16 (&sc)[4], int hi, unsigned (&out)[16]) {
  unsigned g[16];
#pragma unroll
  for (int blk = 0; blk < 4; ++blk) {
#pragma unroll
    for (int r = 0; r < 16; ++r) g[r] = (fkey(sc[blk][r]) & 0xFFFFFF80u) | (unsigned)(32 * blk + (r & 3) + 8 * (r >> 2) + 4 * hi);
    sort16_desc(g);
    if (blk == 0) {
#pragma unroll
      for (int r = 0; r < 16; ++r) out[r] = g[r];
    } else merge16_desc(out, g);
  }
  unsigned pb[16];
#pragma unroll
  for (int r = 0; r < 16; ++r) { auto rr = __builtin_amdgcn_permlane32_swap(out[r], out[r], false, false); pb[r] = hi ? rr[0] : rr[1]; }
  merge16_desc(out, pb);
}
__device__ __forceinline__ void route_phase(const Params& p, LAS unsigned char* lds, int tid, int lane, int wave) {
  const bf16_t* Q = (const bf16_t*)(p.ws + WS_Q); const bf16_t* KB = (const bf16_t*)(p.ws + WS_KEYSB);
  int* RIDX = (int*)(p.ws + WS_RIDX); float* RG = (float*)(p.ws + WS_RG);
  const int h = blockIdx.x & 7, grp = blockIdx.x >> 3;
  const int r32 = lane & 31, hi = lane >> 5;
#pragma unroll
  for (int c = 0; c < 2; ++c)
#pragma unroll
    for (int rep = 0; rep < 4; ++rep) { const int row = rep * 32 + (tid >> 4), cb = (tid & 15) * 16;
      *(LAS u32x4*)(lds + c * 32768 + RKSWZ(row, cb)) = *(const u32x4*)((const char*)KB + ((size_t)(h * 2 + c) * 128 + row) * 256 + cb); }
  __syncthreads();
  for (int tb = grp * 8 + wave; tb < T / 32; tb += (int)(gridDim.x >> 3) * 8) {
    const int t = tb * 32 + r32;
    unsigned ka[16], kb2[16];
#pragma unroll
    for (int c = 0; c < 2; ++c) {
      bf16x8 qf[8];
      const bf16_t* qp = Q + (size_t)t * D + h * 256 + c * 128 + hi * 8;
#pragma unroll
      for (int ks = 0; ks < 8; ++ks) qf[ks] = *(const bf16x8*)(qp + ks * 16);
      f32x16 sc[4];
#pragma unroll
      for (int blk = 0; blk < 4; ++blk) { sc[blk] = f32x16{};
#pragma unroll
        for (int ks = 0; ks < 8; ++ks) { const bf16x8 kf = *(const LAS bf16x8*)(lds + c * 32768 + RKSWZ(32 * blk + r32, (16 * ks + 8 * hi) * 2));
          sc[blk] = __builtin_amdgcn_mfma_f32_32x32x16_bf16(kf, qf[ks], sc[blk], 0, 0, 0); } }
      if (c == 0) top16_half(sc, hi, ka); else top16_half(sc, hi, kb2);
    }
    float av[16], bv[16];
#pragma unroll
    for (int i = 0; i < 16; ++i) { av[i] = fkey_inv(ka[i] & 0xFFFFFF80u); bv[i] = fkey_inv(kb2[i] & 0xFFFFFF80u); }
    float T[16];
#pragma unroll
    for (int k = 0; k < 16; ++k) T[k] = -3.0e38f;
#pragma unroll
    for (int i = 0; i < 16; ++i)
#pragma unroll
      for (int j = 0; j < 16; ++j) if ((i + 1) * (j + 1) <= 16) { float v = av[i] + bv[j];
#pragma unroll
          for (int k = 0; k < 16; ++k) { const float mx = fmaxf(T[k], v); v = fminf(T[k], v); T[k] = mx; } }
    const float m = T[0], theta = T[15];
    float Z = 0.f;
#pragma unroll
    for (int k = 0; k < 16; ++k) Z += __expf(T[k] - m);
    const float rz = 1.f / Z;
    int slot = 0; int cn = 0;
    int* ip = RIDX + (size_t)t * 128 + h * 16; float* gp = RG + (size_t)t * 128 + h * 16;
#pragma unroll
    for (int i = 0; i < 16; ++i)
#pragma unroll
      for (int j = 0; j < 16; ++j) if ((i + 1) * (j + 1) <= 16) { const float v = av[i] + bv[j];
          const bool sel = (v >= theta) && (slot < 16);
          if (sel && ((cn & 1) == hi)) { ip[slot] = (int)((ka[i] & 127u) * 128u + (kb2[j] & 127u)); gp[slot] = __expf(v - m) * rz; }
          slot += sel ? 1 : 0; ++cn; }
  }
}
#undef RKSWZ
}

#define XB_TMO      128
#define XB_XCNT(j)  (256  + 64 * (j))
#define XB_XSUB(j)  (1280 + 64 * (j))
#define XB_XGEN(j)  (2304 + 64 * (j))
#define XB_TOP      3328
#define XB_TOPGEN   3392
#define XCD_BAR_WORDS 3456
#define XB_SPIN_CAP (1u << 22)
__device__ __forceinline__ unsigned xb_ld(unsigned* p)              { return __hip_atomic_load(p, __ATOMIC_RELAXED, __HIP_MEMORY_SCOPE_AGENT); }
__device__ __forceinline__ unsigned xb_add(unsigned* p, unsigned v) { return __hip_atomic_fetch_add(p, v, __ATOMIC_RELAXED, __HIP_MEMORY_SCOPE_AGENT); }
__device__ __forceinline__ unsigned xb_xcc_id() { return (unsigned)__builtin_amdgcn_s_getreg((3 << 11) | 20) & 0xFu; }
#define XB_SPIN(cond, bar) do { unsigned _sp = 0; while (cond) { __builtin_amdgcn_s_sleep(1); \
    if ((++_sp & 255u) == 0u) { if (xb_ld(&(bar)[XB_TMO])) break; if (_sp > XB_SPIN_CAP) { atomicAdd(&(bar)[XB_TMO], 1u); break; } } } } while (0)
struct XcdBarrier { unsigned* bar; unsigned x; volatile LAS unsigned* st; };
__device__ __forceinline__ XcdBarrier xcd_barrier_post(unsigned* bar, volatile LAS unsigned* st) {
    XcdBarrier b; b.bar = bar; b.x = xb_xcc_id(); b.st = st;
    if (threadIdx.x == 0) (void)xb_add(&bar[XB_XCNT(b.x)], 1u);
    return b;
}
__device__ __forceinline__ void xcd_barrier_complete(unsigned* bar, unsigned x, unsigned& nloc, unsigned& nx) {
    const unsigned G = gridDim.x * gridDim.y * gridDim.z;
    unsigned sum, cnt, mine, sp = 0u;
    for (;;) {
        sum = 0u; cnt = 0u; mine = 0u;
#pragma unroll
        for (unsigned j = 0; j < 16; ++j) { const unsigned c = xb_ld(&bar[XB_XCNT(j)]); sum += c; cnt += (c > 0u) ? 1u : 0u; mine = (j == x) ? c : mine; }
        if (sum == G) break;
        __builtin_amdgcn_s_sleep(1);
        if ((++sp & 255u) == 0u) { if (xb_ld(&bar[XB_TMO])) break; if (sp > XB_SPIN_CAP) { atomicAdd(&bar[XB_TMO], 1u); break; } }
    }
    nloc = mine > 0u ? mine : 1u; nx = cnt > 0u ? cnt : 1u;
}
__device__ __forceinline__ void xcd_barrier(const XcdBarrier& b) {
    asm volatile("s_waitcnt vmcnt(0)" ::: "memory");
    __syncthreads();
    if (threadIdx.x == 0) {
        unsigned* bar = b.bar;
        __builtin_amdgcn_s_waitcnt(0);
        unsigned nloc = b.st[0], nx = b.st[1];
        if (nloc == 0u) { xcd_barrier_complete(bar, b.x, nloc, nx); b.st[0] = nloc; b.st[1] = nx; }
        const unsigned old = xb_add(&bar[XB_XSUB(b.x)], 1u);
        const unsigned gen = old / nloc;
        if (old + 1u == (gen + 1u) * nloc) {
            __builtin_amdgcn_fence(__ATOMIC_RELEASE, "agent");
            asm volatile("s_waitcnt vmcnt(0)" ::: "memory");
            const unsigned og = xb_add(&bar[XB_TOP], 1u);
            const unsigned tg = og / nx;
            if (og + 1u == (tg + 1u) * nx) xb_add(&bar[XB_TOPGEN], 1u);
            else XB_SPIN(xb_ld(&bar[XB_TOPGEN]) == tg, bar);
            __builtin_amdgcn_fence(__ATOMIC_ACQUIRE, "agent");
            xb_add(&bar[XB_XGEN(b.x)], 1u);
            asm volatile("s_waitcnt vmcnt(0)" ::: "memory");
        } else {
            XB_SPIN(xb_ld(&bar[XB_XGEN(b.x)]) == gen, bar);
            __builtin_amdgcn_fence(__ATOMIC_ACQUIRE, "agent");
            asm volatile("s_waitcnt vmcnt(0)" ::: "memory");
        }
    }
    __syncthreads();
}
constexpr int RING_BYTES = 131072, MISC_OFF = 143360, LDS_BYTES = 147456, NTHREADS = 512;
static_assert(att::LDS_NEED <= MISC_OFF, "attention scratch below the MISC words");
constexpr size_t WS_SLAB = WS_X2BF;

#define PH_BEGIN(i) unsigned long long t0_##i = 0; if ((PROBE_MASK >> (i)) & 1) t0_##i = __builtin_amdgcn_s_memrealtime();
#define PH_END(i) if ((PROBE_MASK >> (i)) & 1) probe_acc += __builtin_amdgcn_s_memrealtime() - t0_##i;
__global__ void __launch_bounds__(NTHREADS, 2) fwd(Params p) {
    extern __shared__ __attribute__((aligned(16))) unsigned char lds_raw[];
    LAS unsigned char* lds = (LAS unsigned char*)lds_raw;
    volatile LAS unsigned* MISC = (volatile LAS unsigned*)(lds + MISC_OFF);
    const int tid = threadIdx.x, lane = tid & 63, wave = __builtin_amdgcn_readfirstlane(tid >> 6);
    const int nwb = NTHREADS / 64;
    const int gw = blockIdx.x * nwb + wave, NW = gridDim.x * nwb;
    const int Gd = gridDim.x, cb = blockIdx.x;
    unsigned char* ws = p.ws;
    bf16_t* WT_IN = (bf16_t*)(ws + WS_WT_IN); bf16_t* WT_GATE = (bf16_t*)(ws + WS_WT_GATE); bf16_t* WT_BR = (bf16_t*)(ws + WS_WT_BR);
    bf16_t* WT_O = (bf16_t*)(ws + WS_WT_O); bf16_t* WT_PQ = (bf16_t*)(ws + WS_WT_PQ); bf16_t* WT_MKV = (bf16_t*)(ws + WS_WT_MKV);
    bf16_t* KEYSB = (bf16_t*)(ws + WS_KEYSB); bf16_t* MEMN = (bf16_t*)(ws + WS_MEMN); bf16_t* MEMKV = (bf16_t*)(ws + WS_MEMKV);
    bf16_t* HO = (bf16_t*)(ws + WS_HO); bf16_t* PROJ = (bf16_t*)(ws + WS_PROJ); bf16_t* G = (bf16_t*)(ws + WS_G);
    bf16_t* MERGED = (bf16_t*)(ws + WS_MERGED); bf16_t* X2BF = (bf16_t*)(ws + WS_X2BF); bf16_t* QB = (bf16_t*)(ws + WS_Q);
        float* SS2 = (float*)(ws + WS_CTL + CTL_SS2_BYTE);
    if (tid < 64) MISC[tid] = 0u;
    __syncthreads();
    XcdBarrier bar = xcd_barrier_post((unsigned*)(ws + WS_CTL + CTL_BAR_BYTE), MISC + 8);

    unsigned long long probe_acc = 0;
    PH_BEGIN(0)
    {
        float* scr = (float*)lds_raw + wave * (64 * 33);
        const int I0 = (D / 64) * (INW / 32), I1 = I0 + (D / 64) * (GW / 32), I2 = I1 + (D / 64) * (D / 32), I3 = I2 + (D / 64) * (D / 32), I4 = I3 + (D / 64) * (D / 32), I5 = I4 + (D / 64) * (2 * CW / 32);
#define TRJOB(it, jb, li) do { if ((it) < I0) { jb = TrJob{p.in[3], WT_IN, nullptr, D, INW, 0.f}; li = (it); } else if ((it) < I1) { jb = TrJob{p.in[18], WT_GATE, nullptr, D, GW, GATE_WSCALE}; li = (it) - I0; } \
            else if ((it) < I2) { jb = TrJob{p.in[20], WT_BR, nullptr, D, D, 0.f}; li = (it) - I1; } else if ((it) < I3) { jb = TrJob{p.in[21], WT_O, nullptr, D, D, 0.f}; li = (it) - I2; } \
            else if ((it) < I4) { jb = TrJob{p.in[23], WT_PQ, p.in[22], D, D, 0.f}; li = (it) - I3; } else { jb = TrJob{p.in[15], WT_MKV, nullptr, D, 2 * CW, 0.f}; li = (it) - I4; } } while (0)
        for (int it = gw; it < I5; it += 2 * NW) {
            TrJob ja, jb2; int la, lb; f32x4 va[8], vb[8];
            TRJOB(it, ja, la); tr_load(ja, la, lane, va);
            const bool has2 = it + NW < I5;
            if (has2) { TRJOB(it + NW, jb2, lb); tr_load(jb2, lb, lane, vb); }
            tr_store(ja, la, lane, va, scr);
            if (has2) tr_store(jb2, lb, lane, vb, scr);
        }
#undef TRJOB
        rms_rows(p.in[0], p.in[2], HO, ws + WS_H8, T, gw, NW, lane);
        rms_rows(p.in[1], p.in[14], MEMN, nullptr, BATCH * NMEM, gw, NW, lane);
        const float* keys = p.in[24];
        for (int i = gw * 64 + lane; i < PH * 2 * NKEYS * 128 / 2; i += NW * 64) ((unsigned*)KEYSB)[i] = pk2(keys[2 * i], keys[2 * i + 1]);
    }
    xcd_barrier(bar);
    PH_END(0)
    PH_BEGIN(1)
    {
        SchedP1a Sa{(const char*)HO, (const char*)WT_IN, (const char*)MEMN, (const char*)WT_MKV, Gd, cb};
        EpiP1a Ea{PROJ, MEMKV};
        pg8::gemm_phase<false>(lds, D, D, Sa, Ea);
        SchedP1b Sb{(const char*)(ws + WS_H8), (const char*)WT_GATE, Gd, cb};
        EpiP1b Eb{G, p.in[19]};
        pg8::gemm_phase<true>(lds, D / 2, D / 2, Sb, Eb);
    }
    xcd_barrier(bar);
    PH_END(1)
    PH_BEGIN(2)
    {
        const float qscale = 0.08838834764831845f;
        { HeadGains hg; load_head_gains(hg, p.in[4], p.in[5], p.in[16], lane);
          for (int t = gw; t < T; t += NW) headnorm_token(PROJ + (size_t)t * INW, hg, qscale, lane); }
        for (int it = gw; it < BATCH * NMEM * 4; it += NW) { const int m = it / 4, j = it % 4; headnorm(MEMKV + (size_t)m * (2 * CW) + j * 128, p.in[17], 1.f, lane); }
        for (int u = gw; u < BATCH * NCH * 8; u += NW) { const int g = u % 8, c = (u / 8) % NCH, b = u / (8 * NCH); lru_pass1(p, b, c, g, lane, lds + wave * 8192); }
        fp4_tables(p, gw, NW, lane);
    }
    xcd_barrier(bar);
    PH_END(2)
    PH_BEGIN(3)
    {
        const int nA = BATCH * 8 * (NCH / 4), nC = BATCH * 4 * (SEQ / 256);
        PH_BEGIN(9)
        for (int u = cb; u < nA + nC; u += Gd) {
            if (u < nA) {
                const int cg = u % (NCH / 4), h = (u / (NCH / 4)) % 8, b = u / ((NCH / 4) * 8);
                const size_t brow = (size_t)b * SEQ, qrow = brow + (size_t)cg * 256;
                att::attn_body<INW, INW, D, true>(PROJ + qrow * INW + C_QA + h * 128, PROJ + brow * INW + C_KA + h * 128, PROJ + brow * INW + C_VA + h * 128,
                                                  HO + qrow * D + h * 128, 12, cg * 4 - NPREV, p.in[6] + h * 257, (LAS char*)lds);
            } else {
                const int v = u - nA; const int qb = v % (SEQ / 256), h = (v / (SEQ / 256)) % 4, b = v / ((SEQ / 256) * 4);
                const size_t qrow = (size_t)b * SEQ + (size_t)qb * 256;
                att::attn_body<INW, 2 * CW, D, false>(PROJ + qrow * INW + C_QC + h * 128, MEMKV + (size_t)b * NMEM * (2 * CW) + h * 128, MEMKV + (size_t)b * NMEM * (2 * CW) + CW + h * 128,
                                                     HO + qrow * D + AW + LW + h * 128, NMEM / 64, 0, nullptr, (LAS char*)lds);
            }
        }
        PH_END(9)
        PH_BEGIN(10)
        for (int u = gw; u < BATCH * NCH * 8; u += NW) { const int g = u % 8, c = (u / 8) % NCH, b = u / (8 * NCH); lru_pass2(p, b, c, g, lane); }
        PH_END(10)
    }
    xcd_barrier(bar);
    PH_END(3)
    PH_BEGIN(4)
    {
        SchedP3 S{(const char*)HO, (const char*)WT_BR, Gd, cb};
        EpiP3 E{G, MERGED};
        pg8::gemm_phase<false>(lds, D, D, S, E);
    }
    xcd_barrier(bar);
    PH_END(4)
    PH_BEGIN(5)
    {
        SchedSq S{(const char*)MERGED, (const char*)WT_O, Gd, cb};
        EpiP4 E{p.in[0], p.out, X2BF, SS2};
        pg8::gemm_phase<false>(lds, D, D, S, E);
    }
    xcd_barrier(bar);
    PH_END(5)
    PH_BEGIN(6)
    {
        SchedSq S{(const char*)X2BF, (const char*)WT_PQ, Gd, cb};
        EpiP5 E{QB, SS2};
        pg8::gemm_phase<false>(lds, D, D, S, E);
    }
    xcd_barrier(bar);
    PH_END(6)
    PH_BEGIN(7)
    rt::route_phase(p, lds, tid, lane, wave);
    xcd_barrier(bar);
    PH_END(7)
    PH_BEGIN(8)
    { LAS float* actL = (LAS float*)lds + wave * 128;
      for (int t = gw; t < T; t += NW) peer_token(p, t, lane, actL); }
    if (PROBE_MASK) { __syncthreads(); PH_END(8) const unsigned long long te = __builtin_amdgcn_s_memrealtime(); while (__builtin_amdgcn_s_memrealtime() - te < probe_acc) __builtin_amdgcn_s_sleep(8); }
}

extern "C" void kernel_launch(void* const* d_in, const int* in_sizes, int n_in, void* d_out, int out_size, void* d_ws, size_t ws_size, hipStream_t stream) {
    static int grid = 0;
    if (grid == 0) {
        if (n_in != 27 || out_size != T * D || ws_size < WS_END) { fprintf(stderr, "kernel_launch: unexpected problem (n_in %d out %d ws %zu)\n", n_in, out_size, ws_size); grid = -1; return; }
        int dev = 0, cus = 0, per_cu = 0;
        (void)hipGetDevice(&dev); (void)hipDeviceGetAttribute(&cus, hipDeviceAttributeMultiprocessorCount, dev);
        if (hipFuncSetAttribute((const void*)fwd, hipFuncAttributeMaxDynamicSharedMemorySize, LDS_BYTES) != hipSuccess) { fprintf(stderr, "kernel_launch: hipFuncSetAttribute failed\n"); grid = -1; return; }
        (void)hipOccupancyMaxActiveBlocksPerMultiprocessor(&per_cu, (const void*)fwd, NTHREADS, LDS_BYTES);
        if (per_cu < 1) { fprintf(stderr, "kernel_launch: occupancy query says %d\n", per_cu); grid = -1; return; }
        grid = cus;
    }
    if (grid < 0) return;
    (void)hipMemsetAsync((char*)d_ws + WS_CTL, 0, 1 * MiB, stream);
    Params p{};
    for (int i = 0; i < 27; ++i) p.in[i] = (const float*)d_in[i];
    p.out = (float*)d_out; p.ws = (unsigned char*)d_ws;
    void* args[] = {&p};
    hipError_t e = hipLaunchCooperativeKernel((const void*)fwd, dim3(grid), dim3(NTHREADS), args, LDS_BYTES, stream);
    if (e != hipSuccess) fprintf(stderr, "cooperative launch failed: %s (grid %d)\n", hipGetErrorString(e), grid);
}
```

```cpp
#include <hip/hip_runtime.h>
#include <hip/hip_cooperative_groups.h>
#include <cstdio>
#include <cstdint>
namespace cg = cooperative_groups;
#ifndef PROBE_MASK
#define PROBE_MASK 0
#endif

#define LAS __attribute__((address_space(3)))
typedef unsigned short bf16_t;
typedef short bf16x8 __attribute__((ext_vector_type(8)));
typedef float f32x4 __attribute__((ext_vector_type(4)));
typedef unsigned u32x4 __attribute__((ext_vector_type(4)));
typedef unsigned u32x2 __attribute__((ext_vector_type(2)));

constexpr int D = 2048, BATCH = 2, SEQ = 8192, T = BATCH * SEQ;
constexpr int CHUNK = 64, NPREV = 8, NCH = SEQ / CHUNK;
constexpr int AW = 1024, LW = 512, CW = 512, INW = 4608, GW = 6144;
constexpr int NMEM = 256;
constexpr int PH = 8, NKEYS = 128, TOPK = 16;
constexpr float EPS = 1e-6f;
constexpr int C_QA = 0, C_KA = 1024, C_VA = 2048, C_XL = 3072, C_GL = 3584, C_QC = 4096;

constexpr size_t MiB = 1u << 20;
constexpr size_t WS_CTL = 0;
constexpr size_t WS_WT_IN = 2 * MiB, WS_WT_GATE = 20 * MiB, WS_WT_BR = 44 * MiB, WS_WT_O = 52 * MiB, WS_WT_PQ = 60 * MiB, WS_WT_MKV = 68 * MiB;
constexpr size_t WS_KEYSB = 72 * MiB, WS_MEMN = 73 * MiB, WS_MEMKV = 75 * MiB, WS_LRUSUM = 76 * MiB, WS_RS2 = 77 * MiB;
constexpr size_t WS_HO = 80 * MiB;
constexpr size_t WS_PROJ = 144 * MiB;
constexpr size_t WS_MERGED = 144 * MiB, WS_X2BF = 208 * MiB;
constexpr size_t WS_G = 288 * MiB;
constexpr size_t WS_TABU = 496 * MiB, WS_TABV = 512 * MiB, WS_Q = 416 * MiB;
constexpr size_t WS_SCU = 77 * MiB, WS_SCV = 77 * MiB + 65536;
constexpr size_t WS_AUA = 2 * MiB, WS_AUU = 18 * MiB;
constexpr size_t WS_H8 = 496 * MiB;
constexpr float GATE_WSCALE = 256.f;
constexpr size_t WS_RIDX = 480 * MiB, WS_RG = 488 * MiB, WS_END = 528 * MiB;

constexpr size_t CTL_BAR_BYTE = 16384, CTL_RANK_BYTE = 65536, CTL_SS2_BYTE = 512 * 1024;
struct Params { const float* in[27]; float* out; unsigned char* ws; };

__device__ __forceinline__ float bf2f(unsigned v16) { return __uint_as_float(v16 << 16); }
__device__ __forceinline__ unsigned f2bf(float f) { unsigned u = __float_as_uint(f); return (u + 0x7fffu + ((u >> 16) & 1u)) >> 16; }
__device__ __forceinline__ unsigned pk2(float lo, float hi) { return f2bf(lo) | (f2bf(hi) << 16); }
__device__ __forceinline__ float wave_sum(float v) {
#pragma unroll
    for (int o = 1; o < 64; o <<= 1) v += __shfl_xor(v, o);
    return v;
}
typedef __bf16 bf16x2_t __attribute__((ext_vector_type(2)));
__device__ __forceinline__ float dot2bf(unsigned w, unsigned x, float acc) { return __builtin_amdgcn_fdot2_f32_bf16(__builtin_bit_cast(bf16x2_t, w), __builtin_bit_cast(bf16x2_t, x), acc, false); }
__device__ __forceinline__ float sigmoid_(float x) { return 1.f / (1.f + __expf(-x)); }
__device__ __forceinline__ float gelu_tanh(float x) { const float y = 1.5957691216f * (x + 0.044715f * x * x * x); return x / (1.f + __expf(-y)); }
__device__ __forceinline__ void unpack8(const u32x4 w, float* f) {
    f[0] = __uint_as_float(w.x << 16); f[1] = __uint_as_float(w.x & 0xffff0000u);
    f[2] = __uint_as_float(w.y << 16); f[3] = __uint_as_float(w.y & 0xffff0000u);
    f[4] = __uint_as_float(w.z << 16); f[5] = __uint_as_float(w.z & 0xffff0000u);
    f[6] = __uint_as_float(w.w << 16); f[7] = __uint_as_float(w.w & 0xffff0000u);
}

struct TrJob { const float* W; bf16_t* WT; const float* ks; int K, N; float f8scale; };
__device__ __forceinline__ void tr_load(const TrJob& jb, int item, int lane, f32x4 (&v)[8]) {
    const int nblk = jb.N / 32, kb = item / nblk, nb = item % nblk, k0 = 64 * kb, n0 = 32 * nb;
#pragma unroll
    for (int i = 0; i < 8; ++i) { const int kk = 8 * i + (lane >> 3); v[i] = *(const f32x4*)(jb.W + (size_t)(k0 + kk) * jb.N + n0 + 4 * (lane & 7)); if (jb.ks) v[i] = v[i] * jb.ks[k0 + kk]; }
}
__device__ __forceinline__ void tr_store(const TrJob& jb, int item, int lane, const f32x4 (&v)[8], float* scr) {
    const int nblk = jb.N / 32, kb = item / nblk, nb = item % nblk, k0 = 64 * kb, n0 = 32 * nb;
#pragma unroll
    for (int i = 0; i < 8; ++i) { float* d = scr + (8 * i + (lane >> 3)) * 33 + 4 * (lane & 7); d[0] = v[i].x; d[1] = v[i].y; d[2] = v[i].z; d[3] = v[i].w; }
    asm volatile("s_waitcnt lgkmcnt(0)" ::: "memory");
    const int c = lane & 7;
#pragma unroll
    for (int j = 0; j < 4; ++j) { const int n = (lane >> 3) + 8 * j; const float* s = scr + (8 * c) * 33 + n;
        if (jb.f8scale != 0.f) { const float f = jb.f8scale; u32x2 o;
            int w = __builtin_amdgcn_cvt_pk_fp8_f32(s[0 * 33] * f, s[1 * 33] * f, 0, false); w = __builtin_amdgcn_cvt_pk_fp8_f32(s[2 * 33] * f, s[3 * 33] * f, w, true); o.x = (unsigned)w;
            w = __builtin_amdgcn_cvt_pk_fp8_f32(s[4 * 33] * f, s[5 * 33] * f, 0, false); w = __builtin_amdgcn_cvt_pk_fp8_f32(s[6 * 33] * f, s[7 * 33] * f, w, true); o.y = (unsigned)w;
            *(u32x2*)((unsigned char*)jb.WT + (size_t)(n0 + n) * jb.K + k0 + 8 * c) = o; }
        else { u32x4 o; o.x = pk2(s[0 * 33], s[1 * 33]); o.y = pk2(s[2 * 33], s[3 * 33]); o.z = pk2(s[4 * 33], s[5 * 33]); o.w = pk2(s[6 * 33], s[7 * 33]);
            *(u32x4*)(jb.WT + (size_t)(n0 + n) * jb.K + k0 + 8 * c) = o; } }
    asm volatile("s_waitcnt lgkmcnt(0)" ::: "memory");
}
__device__ __forceinline__ void rms_row_load(const float* xrow, int lane, f32x4 (&v)[8]) {
    const f32x4* xr = (const f32x4*)xrow + lane;
#pragma unroll
    for (int j = 0; j < 8; ++j) v[j] = xr[64 * j];
}
__device__ __forceinline__ void rms_row_finish(const f32x4 (&v)[8], const float* g, bf16_t* orow, unsigned char* o8row, int lane) {
    const f32x4* gr = (const f32x4*)g + lane; float s = 0.f;
#pragma unroll
    for (int j = 0; j < 8; ++j) s += (v[j].x * v[j].x + v[j].y * v[j].y) + (v[j].z * v[j].z + v[j].w * v[j].w);
    const float rstd = rsqrtf(wave_sum(s) * (1.f / D) + EPS);
    u32x2* o8 = (u32x2*)orow + lane;
#pragma unroll
    for (int j = 0; j < 8; ++j) { const f32x4 gg = gr[64 * j]; const float a0 = v[j].x * rstd * gg.x, a1 = v[j].y * rstd * gg.y, a2 = v[j].z * rstd * gg.z, a3 = v[j].w * rstd * gg.w;
        u32x2 o; o.x = pk2(a0, a1); o.y = pk2(a2, a3); o8[64 * j] = o;
        if (o8row) { int w = __builtin_amdgcn_cvt_pk_fp8_f32(fminf(fmaxf(a0, -448.f), 448.f), fminf(fmaxf(a1, -448.f), 448.f), 0, false);
            w = __builtin_amdgcn_cvt_pk_fp8_f32(fminf(fmaxf(a2, -448.f), 448.f), fminf(fmaxf(a3, -448.f), 448.f), w, true); ((unsigned*)o8row)[64 * j + lane] = (unsigned)w; } }
}
__device__ __forceinline__ void rms_rows(const float* X, const float* g, bf16_t* O, unsigned char* O8, int nrows, int gw, int NW, int lane) {
    f32x4 va[8], vb[8];
    int m = gw;
    if (m < nrows) rms_row_load(X + (size_t)m * D, lane, va);
    for (; m < nrows; m += 2 * NW) {
        const bool hb = m + NW < nrows;
        if (hb) rms_row_load(X + (size_t)(m + NW) * D, lane, vb);
        rms_row_finish(va, g, O + (size_t)m * D, O8 ? O8 + (size_t)m * D : nullptr, lane);
        if (m + 2 * NW < nrows) rms_row_load(X + (size_t)(m + 2 * NW) * D, lane, va);
        if (hb) rms_row_finish(vb, g, O + (size_t)(m + NW) * D, O8 ? O8 + (size_t)(m + NW) * D : nullptr, lane);
    }
}

template <int TM, int TN, class Epi>
__device__ __forceinline__ void gemm_simple(const bf16_t* __restrict__ A, int lda, const bf16_t* __restrict__ Bt, int ldb, int M, int N, int K, const Epi& epi, int gw, int NW, int lane) {
    const int r = lane & 15, q = lane >> 4;
    const int ntm = M / (16 * TM), ntn = N / (16 * TN);
    for (int tile = gw; tile < ntm * ntn; tile += NW) {
        const int tm = tile / ntn, tn = tile % ntn;
        f32x4 acc[TM][TN];
#pragma unroll
        for (int i = 0; i < TM; ++i)
#pragma unroll
            for (int j = 0; j < TN; ++j) acc[i][j] = (f32x4){0.f, 0.f, 0.f, 0.f};
        const bf16_t* ap = A + (size_t)(tm * 16 * TM + r) * lda + q * 8;
        const bf16_t* bp = Bt + (size_t)(tn * 16 * TN + r) * ldb + q * 8;
        for (int k0 = 0; k0 < K; k0 += 32) {
            bf16x8 af[TM], bfr[TN];
#pragma unroll
            for (int i = 0; i < TM; ++i) af[i] = *(const bf16x8*)(ap + (size_t)i * 16 * lda + k0);
#pragma unroll
            for (int j = 0; j < TN; ++j) bfr[j] = *(const bf16x8*)(bp + (size_t)j * 16 * ldb + k0);
#pragma unroll
            for (int i = 0; i < TM; ++i)
#pragma unroll
                for (int j = 0; j < TN; ++j) acc[i][j] = __builtin_amdgcn_mfma_f32_16x16x32_bf16(af[i], bfr[j], acc[i][j], 0, 0, 0);
        }
#pragma unroll
        for (int i = 0; i < TM; ++i)
#pragma unroll
            for (int j = 0; j < TN; ++j)
#pragma unroll
                for (int e = 0; e < 4; ++e) epi(tm * 16 * TM + i * 16 + q * 4 + e, tn * 16 * TN + j * 16 + r, acc[i][j][e]);
    }
}
struct EpiProj { bf16_t* P; __device__ __forceinline__ void operator()(int row, int col, float v) const { if (col >= C_GL && col < C_QC) v = gelu_tanh(v); P[(size_t)row * INW + col] = (bf16_t)f2bf(v); } };
struct EpiGate { bf16_t* G; const float* b; __device__ __forceinline__ void operator()(int row, int col, float v) const { G[(size_t)row * GW + col] = (bf16_t)f2bf(sigmoid_(v + b[col])); } };
struct EpiStore { bf16_t* C; int ldc; __device__ __forceinline__ void operator()(int row, int col, float v) const { C[(size_t)row * ldc + col] = (bf16_t)f2bf(v); } };
struct EpiWo { const float* x; float* out; bf16_t* xb; __device__ __forceinline__ void operator()(int row, int col, float v) const { const size_t o = (size_t)row * D + col; const float y = x[o] + v; out[o] = y; xb[o] = (bf16_t)f2bf(y); } };
struct EpiQ { bf16_t* Q; const float* rs; __device__ __forceinline__ void operator()(int row, int col, float v) const { Q[(size_t)row * D + col] = (bf16_t)f2bf(v * rs[row]); } };

__device__ __forceinline__ void headnorm(bf16_t* vec, const float* g, float scale, int lane) {
    unsigned* p = (unsigned*)vec + lane; const unsigned w = *p;
    const float a = bf2f(w & 0xffffu), b = bf2f(w >> 16);
    const float rs = rsqrtf(wave_sum(a * a + b * b) * (1.f / 128.f) + EPS) * scale;
    *p = pk2(a * rs * g[2 * lane], b * rs * g[2 * lane + 1]);
}
struct HeadGains { float gq[32], gk[32], gc[8]; };
__device__ __forceinline__ void load_head_gains(HeadGains& hg, const float* gq, const float* gk, const float* gc, int lane) {
#pragma unroll
    for (int j = 0; j < 32; ++j) { hg.gq[j] = gq[(lane & 3) * 32 + j]; hg.gk[j] = gk[(lane & 3) * 32 + j]; }
#pragma unroll
    for (int j = 0; j < 8; ++j) hg.gc[j] = gc[(lane & 15) * 8 + j];
}
__device__ __forceinline__ void headnorm_token(bf16_t* row, const HeadGains& hg, float qscale, int lane) {
    u32x4* pa = (u32x4*)(row + C_QA) + lane * 4;
    u32x4* pc = (u32x4*)(row + C_QC) + lane;
    u32x4 w[4]; const u32x4 wc = *pc;
#pragma unroll
    for (int j = 0; j < 4; ++j) w[j] = pa[j];
    float f[32], fc[8]; float ss = 0.f, sc = 0.f;
#pragma unroll
    for (int j = 0; j < 4; ++j) unpack8(w[j], f + 8 * j);
    unpack8(wc, fc);
#pragma unroll
    for (int j = 0; j < 32; ++j) ss = fmaf(f[j], f[j], ss);
#pragma unroll
    for (int j = 0; j < 8; ++j) sc = fmaf(fc[j], fc[j], sc);
    ss += __shfl_xor(ss, 1); ss += __shfl_xor(ss, 2);
    sc += __shfl_xor(sc, 1); sc += __shfl_xor(sc, 2); sc += __shfl_xor(sc, 4); sc += __shfl_xor(sc, 8);
    const bool isq = lane < 32;
    const float rs = rsqrtf(ss * (1.f / 128.f) + EPS) * (isq ? qscale : 1.f), rc = rsqrtf(sc * (1.f / 128.f) + EPS) * qscale;
#pragma unroll
    for (int j = 0; j < 4; ++j) { u32x4 o;
        o.x = pk2(f[8 * j] * rs * (isq ? hg.gq[8 * j] : hg.gk[8 * j]), f[8 * j + 1] * rs * (isq ? hg.gq[8 * j + 1] : hg.gk[8 * j + 1]));
        o.y = pk2(f[8 * j + 2] * rs * (isq ? hg.gq[8 * j + 2] : hg.gk[8 * j + 2]), f[8 * j + 3] * rs * (isq ? hg.gq[8 * j + 3] : hg.gk[8 * j + 3]));
        o.z = pk2(f[8 * j + 4] * rs * (isq ? hg.gq[8 * j + 4] : hg.gk[8 * j + 4]), f[8 * j + 5] * rs * (isq ? hg.gq[8 * j + 5] : hg.gk[8 * j + 5]));
        o.w = pk2(f[8 * j + 6] * rs * (isq ? hg.gq[8 * j + 6] : hg.gk[8 * j + 6]), f[8 * j + 7] * rs * (isq ? hg.gq[8 * j + 7] : hg.gk[8 * j + 7]));
        pa[j] = o; }
    { u32x4 o; o.x = pk2(fc[0] * rc * hg.gc[0], fc[1] * rc * hg.gc[1]); o.y = pk2(fc[2] * rc * hg.gc[2], fc[3] * rc * hg.gc[3]);
      o.z = pk2(fc[4] * rc * hg.gc[4], fc[5] * rc * hg.gc[5]); o.w = pk2(fc[6] * rc * hg.gc[6], fc[7] * rc * hg.gc[7]); *pc = o; }
}

__device__ __forceinline__ void lru_pass1(const Params& p, int b, int c, int g, int lane, LAS unsigned char* wl  ) {
    const bf16_t* PROJ = (const bf16_t*)(p.ws + WS_PROJ);
    float* SUMA = (float*)(p.ws + WS_LRUSUM); float* SUMB = SUMA + BATCH * NCH * LW;
    bf16_t* AUA = (bf16_t*)(p.ws + WS_AUA); bf16_t* AUU = (bf16_t*)(p.ws + WS_AUU);
    const float* conv_w = p.in[7]; const float* conv_b = p.in[8]; const float* lru_wa = p.in[9]; const float* lru_ba = p.in[10];
    const float* lru_wx = p.in[11]; const float* lru_bx = p.in[12]; const float* lam = p.in[13];
    const int ch = g * 64 + lane;
    unsigned wa_p[32], wx_p[32];
#pragma unroll
    for (int m = 0; m < 32; ++m) { wa_p[m] = pk2(lru_wa[(size_t)(g * 64 + 2 * m) * 64 + lane], lru_wa[(size_t)(g * 64 + 2 * m + 1) * 64 + lane]);
        wx_p[m] = pk2(lru_wx[(size_t)(g * 64 + 2 * m) * 64 + lane], lru_wx[(size_t)(g * 64 + 2 * m + 1) * 64 + lane]); }
    const float cw0 = conv_w[0 * LW + ch], cw1 = conv_w[1 * LW + ch], cw2 = conv_w[2 * LW + ch], cw3 = conv_w[3 * LW + ch], cb = conv_b[ch];
    const float ba_ = lru_ba[ch], bx_ = lru_bx[ch];
    const float sp = log1pf(__expf(-lam[ch]));
    const int t0 = c * CHUNK; const size_t row0 = (size_t)b * SEQ + t0;
    float x0 = 0.f, x1 = 0.f, x2 = 0.f;
    if (t0 >= 3) { x0 = bf2f(PROJ[(row0 - 3) * INW + C_XL + ch]); x1 = bf2f(PROJ[(row0 - 2) * INW + C_XL + ch]); x2 = bf2f(PROJ[(row0 - 1) * INW + C_XL + ch]); }
    { const bf16_t* xs = PROJ + (row0 + (lane >> 3)) * INW + C_XL + g * 64 + (lane & 7) * 8;
      u32x4 tx[8];
#pragma unroll
      for (int i = 0; i < 8; ++i) tx[i] = *(const u32x4*)(xs + (size_t)(8 * i) * INW);
#pragma unroll
      for (int i = 0; i < 8; ++i) *(LAS u32x4*)(wl + (8 * i + (lane >> 3)) * 128 + (lane & 7) * 16) = tx[i]; }
    float h = 0.f, aprod = 1.f;
#define LRU_PAIRX(xc_) ({ const float xnb_ = __int_as_float(__builtin_amdgcn_update_dpp(0, __float_as_int(xc_), 0xB1, 0xf, 0xf, true));     \
        (lane & 1) ? pk2(xnb_, xc_) : pk2(xc_, xnb_); })
#define LRU_GATE(rp_, ip_, xc_, a_, u_) do { const float r_ = sigmoid_(rp_), ig_ = sigmoid_(ip_); const float la_ = -8.f * r_ * sp; a_ = __expf(la_); \
        u_ = sqrtf(fminf(fmaxf((1.f - a_) * (1.f + a_), 1e-12f), 1.f)) * ig_ * xc_; } while (0)
#pragma unroll 1
    for (int t = 0; t < CHUNK; t += 2) {
        const float x3 = bf2f(*(const LAS bf16_t*)(wl + t * 128 + lane * 2)), x4 = bf2f(*(const LAS bf16_t*)(wl + (t + 1) * 128 + lane * 2));
        const float xcA = cw0 * x0 + cw1 * x1 + cw2 * x2 + cw3 * x3 + cb, xcB = cw0 * x1 + cw1 * x2 + cw2 * x3 + cw3 * x4 + cb;
        x0 = x2; x1 = x3; x2 = x4;
        const unsigned pkA = LRU_PAIRX(xcA), pkB = LRU_PAIRX(xcB);
        float rA = ba_, iA = bx_, rA2 = 0.f, iA2 = 0.f, rB = ba_, iB = bx_, rB2 = 0.f, iB2 = 0.f;
#pragma unroll
        for (int m = 0; m < 32; m += 2) {
            const unsigned a0 = (unsigned)__builtin_amdgcn_readlane((int)pkA, 2 * m), a1 = (unsigned)__builtin_amdgcn_readlane((int)pkA, 2 * m + 2);
            const unsigned b0 = (unsigned)__builtin_amdgcn_readlane((int)pkB, 2 * m), b1 = (unsigned)__builtin_amdgcn_readlane((int)pkB, 2 * m + 2);
            rA = dot2bf(wa_p[m], a0, rA); iA = dot2bf(wx_p[m], a0, iA); rA2 = dot2bf(wa_p[m + 1], a1, rA2); iA2 = dot2bf(wx_p[m + 1], a1, iA2);
            rB = dot2bf(wa_p[m], b0, rB); iB = dot2bf(wx_p[m], b0, iB); rB2 = dot2bf(wa_p[m + 1], b1, rB2); iB2 = dot2bf(wx_p[m + 1], b1, iB2); }
        float aA, uA, aB, uB;
        LRU_GATE(rA + rA2, iA + iA2, xcA, aA, uA); LRU_GATE(rB + rB2, iB + iB2, xcB, aB, uB);
        const unsigned wA = f2bf(1.f - aA), wB = f2bf(1.f - aB), vA = f2bf(uA), vB = f2bf(uB);
        AUA[(row0 + t) * LW + ch] = (bf16_t)wA; AUA[(row0 + t + 1) * LW + ch] = (bf16_t)wB; AUU[(row0 + t) * LW + ch] = (bf16_t)vA; AUU[(row0 + t + 1) * LW + ch] = (bf16_t)vB;
        const float aAq = 1.f - bf2f(wA), aBq = 1.f - bf2f(wB);
        h = aBq * (aAq * h + bf2f(vA)) + bf2f(vB);
        aprod *= aAq * aBq;
    }
#undef LRU_PAIRX
#undef LRU_GATE
    { const size_t o = (size_t)(b * NCH + c) * LW + ch; SUMA[o] = aprod; SUMB[o] = h; }
}
__device__ __forceinline__ void lru_pass2(const Params& p, int b, int c, int g, int lane) {
    const bf16_t* PROJ = (const bf16_t*)(p.ws + WS_PROJ); bf16_t* O = (bf16_t*)(p.ws + WS_HO);
    const float* SUMA = (const float*)(p.ws + WS_LRUSUM); const float* SUMB = SUMA + BATCH * NCH * LW;
    const bf16_t* AUA = (const bf16_t*)(p.ws + WS_AUA); const bf16_t* AUU = (const bf16_t*)(p.ws + WS_AUU);
    const int ch = g * 64 + lane; const size_t row0 = (size_t)b * SEQ + (size_t)c * CHUNK;
    const bf16_t* ap = AUA + row0 * LW + ch; const bf16_t* up = AUU + row0 * LW + ch; const bf16_t* gp = PROJ + row0 * INW + C_GL + ch;
    bf16_t an[16], un[16], gn[16];
#pragma unroll
    for (int q = 0; q < 16; ++q) { an[q] = ap[(size_t)q * LW]; un[q] = up[(size_t)q * LW]; gn[q] = gp[(size_t)q * INW]; }
    float h = 0.f;
    {
        int j = 0;
#pragma unroll 1
        for (; j + 32 <= c; j += 32) { float sa[32], sb[32];
#pragma unroll
            for (int q = 0; q < 32; ++q) { const size_t o = (size_t)(b * NCH + j + q) * LW + ch; sa[q] = SUMA[o]; sb[q] = SUMB[o]; }
#pragma unroll
            for (int q = 0; q < 32; ++q) h = sa[q] * h + sb[q]; }
#pragma unroll 1
        for (; j + 8 <= c; j += 8) { float sa[8], sb[8];
#pragma unroll
            for (int q = 0; q < 8; ++q) { const size_t o = (size_t)(b * NCH + j + q) * LW + ch; sa[q] = SUMA[o]; sb[q] = SUMB[o]; }
#pragma unroll
            for (int q = 0; q < 8; ++q) h = sa[q] * h + sb[q]; }
        for (; j < c; ++j) { const size_t o = (size_t)(b * NCH + j) * LW + ch; h = SUMA[o] * h + SUMB[o]; }
    }
#pragma unroll 1
    for (int tb = 0; tb < CHUNK; tb += 16) {
        bf16_t ac[16], uc[16], gc[16];
#pragma unroll
        for (int q = 0; q < 16; ++q) { ac[q] = an[q]; uc[q] = un[q]; gc[q] = gn[q]; }
        if (tb + 16 < CHUNK) {
#pragma unroll
            for (int q = 0; q < 16; ++q) { an[q] = ap[(size_t)(tb + 16 + q) * LW]; un[q] = up[(size_t)(tb + 16 + q) * LW]; gn[q] = gp[(size_t)(tb + 16 + q) * INW]; }
        }
#pragma unroll
        for (int q = 0; q < 16; ++q) { h = (1.f - bf2f(ac[q])) * h + bf2f(uc[q]); O[(row0 + tb + q) * D + AW + ch] = (bf16_t)f2bf(h * bf2f(gc[q])); }
    }
}

__device__ __forceinline__ void attn_simple(const bf16_t* Qp, int ldq, const bf16_t* Kp, const bf16_t* Vp, int ldkv, int nkeys, int koff, const float* bias_h, bf16_t* Op, int ldo, int tid) {
    const int qi = tid >> 2, part = tid & 3;
    float q[32], o[32];
    { const u32x4* qp = (const u32x4*)(Qp + (size_t)qi * ldq + part * 32);
#pragma unroll
      for (int j = 0; j < 4; ++j) unpack8(qp[j], q + 8 * j); }
#pragma unroll
    for (int d = 0; d < 32; ++d) o[d] = 0.f;
    float m = -1e30f, l = 0.f;
    for (int kk0 = 0; kk0 < nkeys; kk0 += 8) {
        float s[8];
#pragma unroll
        for (int j = 0; j < 8; ++j) {
            const u32x4* kp = (const u32x4*)(Kp + (size_t)(kk0 + j) * ldkv + part * 32);
            float acc = 0.f;
#pragma unroll
            for (int w = 0; w < 4; ++w) { float kf[8]; unpack8(kp[w], kf);
#pragma unroll
                for (int e = 0; e < 8; ++e) acc = fmaf(q[8 * w + e], kf[e], acc); }
            acc += __shfl_xor(acc, 1); acc += __shfl_xor(acc, 2);
            if (bias_h) { int dist = qi + koff - (kk0 + j); dist = dist < -128 ? -128 : (dist > 128 ? 128 : dist); acc += bias_h[dist + 128]; }
            s[j] = acc;
        }
        float mx = s[0];
#pragma unroll
        for (int j = 1; j < 8; ++j) mx = fmaxf(mx, s[j]);
        const float mn = fmaxf(m, mx), corr = __expf(m - mn);
        l *= corr;
#pragma unroll
        for (int d = 0; d < 32; ++d) o[d] *= corr;
#pragma unroll
        for (int j = 0; j < 8; ++j) {
            const float pj = __expf(s[j] - mn); l += pj;
            const u32x4* vp = (const u32x4*)(Vp + (size_t)(kk0 + j) * ldkv + part * 32);
#pragma unroll
            for (int w = 0; w < 4; ++w) { float vf[8]; unpack8(vp[w], vf);
#pragma unroll
                for (int e = 0; e < 8; ++e) o[8 * w + e] = fmaf(pj, vf[e], o[8 * w + e]); }
        }
        m = mn;
    }
    const float inv = 1.f / l;
    u32x4* op = (u32x4*)(Op + (size_t)qi * ldo + part * 32);
#pragma unroll
    for (int w = 0; w < 4; ++w) { u32x4 ov; ov.x = pk2(o[8 * w] * inv, o[8 * w + 1] * inv); ov.y = pk2(o[8 * w + 2] * inv, o[8 * w + 3] * inv); ov.z = pk2(o[8 * w + 4] * inv, o[8 * w + 5] * inv); ov.w = pk2(o[8 * w + 6] * inv, o[8 * w + 7] * inv); op[w] = ov; }
}

__device__ __forceinline__ void gemm_branch(const bf16_t* __restrict__ Ob, const bf16_t* __restrict__ WT, const bf16_t* __restrict__ G, bf16_t* __restrict__ Mg, int gw, int NW, int lane) {
    const int r = lane & 15, q = lane >> 4;
    const int ntn = D / 32, ntiles = (T / 32) * ntn;
    for (int tile = gw; tile < ntiles; tile += NW) {
        const int tm = tile / ntn, tn = tile % ntn;
        f32x4 acc[3][2][2];
#pragma unroll
        for (int s = 0; s < 3; ++s)
#pragma unroll
            for (int i = 0; i < 2; ++i)
#pragma unroll
                for (int j = 0; j < 2; ++j) acc[s][i][j] = (f32x4){0.f, 0.f, 0.f, 0.f};
        const bf16_t* ap = Ob + (size_t)(tm * 32 + r) * D + q * 8;
        const bf16_t* bp = WT + (size_t)(tn * 32 + r) * D + q * 8;
#pragma unroll
        for (int s = 0; s < 3; ++s) {
            const int kb = s == 0 ? 0 : (s == 1 ? 1024 : 1536), ke = s == 0 ? 1024 : (s == 1 ? 1536 : 2048);
            for (int k0 = kb; k0 < ke; k0 += 32) {
                bf16x8 af[2], bfr[2];
#pragma unroll
                for (int i = 0; i < 2; ++i) af[i] = *(const bf16x8*)(ap + (size_t)i * 16 * D + k0);
#pragma unroll
                for (int j = 0; j < 2; ++j) bfr[j] = *(const bf16x8*)(bp + (size_t)j * 16 * D + k0);
#pragma unroll
                for (int i = 0; i < 2; ++i)
#pragma unroll
                    for (int j = 0; j < 2; ++j) acc[s][i][j] = __builtin_amdgcn_mfma_f32_16x16x32_bf16(af[i], bfr[j], acc[s][i][j], 0, 0, 0);
            }
        }
#pragma unroll
        for (int i = 0; i < 2; ++i)
#pragma unroll
            for (int j = 0; j < 2; ++j)
#pragma unroll
                for (int e = 0; e < 4; ++e) {
                    const int row = tm * 32 + i * 16 + q * 4 + e, col = tn * 32 + j * 16 + r;
                    const bf16_t* gp = G + (size_t)row * GW + col;
                    const float mval = bf2f(gp[0]) * acc[0][i][j][e] + bf2f(gp[2048]) * acc[1][i][j][e] + bf2f(gp[4096]) * acc[2][i][j][e];
                    Mg[(size_t)row * D + col] = (bf16_t)f2bf(mval);
                }
    }
}

__device__ __forceinline__ unsigned long long shfl_xor64(unsigned long long v, int m) {
    const unsigned lo = __shfl_xor((unsigned)v, m), hi = __shfl_xor((unsigned)(v >> 32), m);
    return ((unsigned long long)hi << 32) | lo;
}
__device__ __forceinline__ unsigned fkey(float f) { const unsigned u = __float_as_uint(f); return (u & 0x80000000u) ? ~u : (u | 0x80000000u); }
__device__ __forceinline__ float fkey_inv(unsigned k) { const unsigned u = (k & 0x80000000u) ? (k & 0x7fffffffu) : ~k; return __uint_as_float(u); }
__device__ __forceinline__ unsigned long long wave_max64(unsigned long long k) {
#pragma unroll
    for (int o = 1; o < 64; o <<= 1) { const unsigned long long t = shfl_xor64(k, o); k = t > k ? t : k; }
    return k;
}
__device__ __forceinline__ void route_unit(const Params& p, int t, int h, int lane) {
    const bf16_t* Q = (const bf16_t*)(p.ws + WS_Q); const bf16_t* KB = (const bf16_t*)(p.ws + WS_KEYSB);
    int* RIDX = (int*)(p.ws + WS_RIDX); float* RG = (float*)(p.ws + WS_RG);
    float sv_l[2] = {0.f, 0.f}; int si_l[2] = {0, 0};
#pragma unroll
    for (int c = 0; c < 2; ++c) {
        const bf16_t* qv = Q + (size_t)t * D + h * 256 + c * 128;
        const unsigned qw = ((const unsigned*)qv)[lane];
        const float qa = bf2f(qw & 0xffffu), qb = bf2f(qw >> 16);
        const bf16_t* k0p = KB + ((size_t)(h * 2 + c) * NKEYS + lane) * 128;
        const bf16_t* k1p = k0p + 64 * 128;
        float s0 = 0.f, s1 = 0.f;
#pragma unroll
        for (int w = 0; w < 16; ++w) {
            float k0f[8], k1f[8]; unpack8(((const u32x4*)k0p)[w], k0f); unpack8(((const u32x4*)k1p)[w], k1f);
#pragma unroll
            for (int e = 0; e < 8; e += 2) {
                const int src = 4 * w + e / 2;
                const float xa = __int_as_float(__builtin_amdgcn_readlane(__float_as_int(qa), src));
                const float xb = __int_as_float(__builtin_amdgcn_readlane(__float_as_int(qb), src));
                s0 = fmaf(xa, k0f[e], s0); s0 = fmaf(xb, k0f[e + 1], s0);
                s1 = fmaf(xa, k1f[e], s1); s1 = fmaf(xb, k1f[e + 1], s1);
            }
        }
        unsigned long long ka = ((unsigned long long)fkey(s0) << 32) | (unsigned)(255 - lane);
        unsigned long long kb = ((unsigned long long)fkey(s1) << 32) | (unsigned)(255 - (lane + 64));
        for (int rnd = 0; rnd < TOPK; ++rnd) {
            const unsigned long long best = wave_max64(ka > kb ? ka : kb);
            if (ka == best) ka = 0ull; if (kb == best) kb = 0ull;
            if (lane == rnd) { sv_l[c] = fkey_inv((unsigned)(best >> 32)); si_l[c] = 255 - (int)(best & 0xffffffffu); }
        }
    }
    unsigned long long kc[4];
#pragma unroll
    for (int m = 0; m < 4; ++m) { const int cid = lane + 64 * m, i = cid >> 4, j = cid & 15;
        const float v = __shfl(sv_l[0], i) + __shfl(sv_l[1], j);
        kc[m] = ((unsigned long long)fkey(v) << 32) | (unsigned)(1023 - cid); }
    float fv = 0.f; int cidx = 0;
    for (int rnd = 0; rnd < TOPK; ++rnd) {
        unsigned long long loc = kc[0] > kc[1] ? kc[0] : kc[1]; const unsigned long long loc2 = kc[2] > kc[3] ? kc[2] : kc[3]; loc = loc > loc2 ? loc : loc2;
        const unsigned long long best = wave_max64(loc);
#pragma unroll
        for (int m = 0; m < 4; ++m) if (kc[m] == best) kc[m] = 0ull;
        if (lane == rnd) { fv = fkey_inv((unsigned)(best >> 32)); cidx = 1023 - (int)(best & 0xffffffffu); }
    }
    const float fmax_ = __shfl(fv, 0);
    float e = lane < 16 ? __expf(fv - fmax_) : 0.f;
    float ssum = e;
#pragma unroll
    for (int o = 1; o < 16; o <<= 1) ssum += __shfl_xor(ssum, o);
    const int ci = cidx >> 4, cj = cidx & 15;
    const int e0 = __shfl(si_l[0], ci), e1 = __shfl(si_l[1], cj);
    if (lane < 16) { RIDX[(size_t)t * 128 + h * 16 + lane] = e0 * NKEYS + e1; RG[(size_t)t * 128 + h * 16 + lane] = e / ssum; }
}

typedef float f32x2 __attribute__((ext_vector_type(2)));
__device__ __forceinline__ void fp4_row_load(const float* __restrict__ src, const float* __restrict__ kscale, int lane, f32x4 (&v)[8]) {
#pragma unroll
    for (int j = 0; j < 8; ++j) { v[j] = ((const f32x4*)src)[64 * j + lane]; if (kscale) v[j] = v[j] * ((const f32x4*)kscale)[64 * j + lane]; }
}
__device__ __forceinline__ void fp4_row_finish(const f32x4 (&v)[8], unsigned char* __restrict__ tab, int e, float* __restrict__ scale_out, int lane) {
    float mx = 0.f;
#pragma unroll
    for (int j = 0; j < 8; ++j) mx = fmaxf(mx, fmaxf(fmaxf(fabsf(v[j].x), fabsf(v[j].y)), fmaxf(fabsf(v[j].z), fabsf(v[j].w))));
#pragma unroll
    for (int o = 1; o < 64; o <<= 1) mx = fmaxf(mx, __shfl_xor(mx, o));
    const float sc = mx > 0.f ? mx * (1.f / 6.f) : 1.f, inv = 1.f / sc;
#pragma unroll
    for (int j = 0; j < 8; ++j) {
        const f32x4 a = v[j] * inv;
        unsigned pk = 0u;
        pk = __builtin_amdgcn_cvt_scalef32_pk_fp4_f32(pk, fminf(fmaxf(a.x, -6.f), 6.f), fminf(fmaxf(a.y, -6.f), 6.f), 1.0f, 0);
        pk = __builtin_amdgcn_cvt_scalef32_pk_fp4_f32(pk, fminf(fmaxf(a.z, -6.f), 6.f), fminf(fmaxf(a.w, -6.f), 6.f), 1.0f, 1);
        *(unsigned short*)(tab + ((size_t)j * 16384 + e) * 128 + 2 * lane) = (unsigned short)pk;
    }
    if (lane == 0) *scale_out = sc;
}
__device__ __forceinline__ void fp4_tables(const Params& p, int gw, int NW, int lane) {
    f32x4 va[8], vb[8];
#define FP4_LOAD(r, v) do { if ((r) < 16384) fp4_row_load(p.in[25] + (size_t)(r) * D, p.in[22], lane, v); else fp4_row_load(p.in[26] + (size_t)((r) - 16384) * D, nullptr, lane, v); } while (0)
#define FP4_FIN(r, v) do { if ((r) < 16384) fp4_row_finish(v, p.ws + WS_TABU, (r), (float*)(p.ws + WS_SCU) + (r), lane); \
        else fp4_row_finish(v, p.ws + WS_TABV, (r) - 16384, (float*)(p.ws + WS_SCV) + ((r) - 16384), lane); } while (0)
    const int n = 2 * 16384;
    int r = gw;
    if (r < n) FP4_LOAD(r, va);
    for (; r < n; r += 2 * NW) {
        const bool hb = r + NW < n;
        if (hb) FP4_LOAD(r + NW, vb);
        FP4_FIN(r, va);
        if (r + 2 * NW < n) FP4_LOAD(r + 2 * NW, va);
        if (hb) FP4_FIN(r + NW, vb);
    }
#undef FP4_LOAD
#undef FP4_FIN
}
constexpr size_t WS_ZP = WS_Q;
constexpr size_t WS_X2F8 = 2 * MiB;
__device__ __forceinline__ float dot_chunk(const u32x4 w, const float (&xf)[32]) {
    float a0 = 0.f, a1 = 0.f;
#pragma unroll
    for (int q = 0; q < 4; ++q) {
        const f32x2 a = __builtin_amdgcn_cvt_scalef32_pk_f32_fp4(w[q], 1.0f, 0), b = __builtin_amdgcn_cvt_scalef32_pk_f32_fp4(w[q], 1.0f, 1);
        const f32x2 c = __builtin_amdgcn_cvt_scalef32_pk_f32_fp4(w[q], 1.0f, 2), d = __builtin_amdgcn_cvt_scalef32_pk_f32_fp4(w[q], 1.0f, 3);
        a0 = fmaf(a.x, xf[8 * q], a0); a1 = fmaf(a.y, xf[8 * q + 1], a1); a0 = fmaf(b.x, xf[8 * q + 2], a0); a1 = fmaf(b.y, xf[8 * q + 3], a1);
        a0 = fmaf(c.x, xf[8 * q + 4], a0); a1 = fmaf(c.y, xf[8 * q + 5], a1); a0 = fmaf(d.x, xf[8 * q + 6], a0); a1 = fmaf(d.y, xf[8 * q + 7], a1);
    }
    return a0 + a1;
}
__device__ __forceinline__ void axpy_chunk(const u32x4 w, const float a_, float (&of)[32]) {
#pragma unroll
    for (int q = 0; q < 4; ++q) {
        const f32x2 a = __builtin_amdgcn_cvt_scalef32_pk_f32_fp4(w[q], 1.0f, 0), b = __builtin_amdgcn_cvt_scalef32_pk_f32_fp4(w[q], 1.0f, 1);
        const f32x2 c = __builtin_amdgcn_cvt_scalef32_pk_f32_fp4(w[q], 1.0f, 2), d = __builtin_amdgcn_cvt_scalef32_pk_f32_fp4(w[q], 1.0f, 3);
        of[8 * q] = fmaf(a_, a.x, of[8 * q]); of[8 * q + 1] = fmaf(a_, a.y, of[8 * q + 1]); of[8 * q + 2] = fmaf(a_, b.x, of[8 * q + 2]); of[8 * q + 3] = fmaf(a_, b.y, of[8 * q + 3]);
        of[8 * q + 4] = fmaf(a_, c.x, of[8 * q + 4]); of[8 * q + 5] = fmaf(a_, c.y, of[8 * q + 5]); of[8 * q + 6] = fmaf(a_, d.x, of[8 * q + 6]); of[8 * q + 7] = fmaf(a_, d.y, of[8 * q + 7]);
    }
}
struct PeerTok { u32x4 w[16]; u32x4 x[4]; };
template <bool USTEP>
__device__ __forceinline__ void peer_issue(PeerTok& k, const Params& p, const unsigned char* tab, int t, int xv, int lane) {
    const int* RIDX = (const int*)(p.ws + WS_RIDX);
    const int i0 = RIDX[(size_t)t * 128 + lane], i1 = RIDX[(size_t)t * 128 + 64 + lane];
    const int es = lane >> 3, ck = lane & 7;
    if (USTEP) { const bf16_t* xp = (const bf16_t*)(p.ws + WS_X2BF) + (size_t)t * D + 256 * xv + 32 * ck;
#pragma unroll
        for (int j = 0; j < 4; ++j) k.x[j] = *(const u32x4*)(xp + 8 * j); }
#pragma unroll
    for (int g = 0; g < 16; ++g) { const int e = __shfl(g < 8 ? i0 : i1, (8 * g + es) & 63); k.w[g] = *(const u32x4*)(tab + (size_t)e * 128 + ck * 16); }
}
__device__ __forceinline__ void peer_u_finish(const PeerTok& k, const Params& p, int t, int xv, int lane) {
    const int es = lane >> 3, ck = lane & 7;
    float xf[32];
#pragma unroll
    for (int j = 0; j < 4; ++j) unpack8(k.x[j], xf + 8 * j);
    float zsel0 = 0.f, zsel1 = 0.f;
#pragma unroll
    for (int g = 0; g < 16; ++g) { u32x4 w_ = k.w[g]; asm volatile("" : "+v"(w_)); float d = dot_chunk(w_, xf);
        d += __int_as_float(__builtin_amdgcn_update_dpp(0, __float_as_int(d), 0xB1, 0xf, 0xf, true));
        d += __int_as_float(__builtin_amdgcn_update_dpp(0, __float_as_int(d), 0x4E, 0xf, 0xf, true));
        d += __int_as_float(__builtin_amdgcn_update_dpp(0, __float_as_int(d), 0x141, 0xf, 0xf, true));
        if (g < 8) { if (ck == g) zsel0 = d; } else { if (ck == g - 8) zsel1 = d; }
        asm volatile("" : "+v"(zsel0), "+v"(zsel1)); }
    float* zp = (float*)(p.ws + WS_ZP) + ((size_t)xv * T + t) * 128;
    zp[8 * ck + es] = zsel0; zp[64 + 8 * ck + es] = zsel1;
}
__device__ __forceinline__ void peer_v_finish(const PeerTok& k, const Params& p, int t, int xv, int lane, LAS float* red) {
    const float* RG = (const float*)(p.ws + WS_RG);
    const float a0 = RG[(size_t)t * 128 + lane], a1 = RG[(size_t)t * 128 + 64 + lane];
    const int es = lane >> 3, ck = lane & 7;
    float of[32];
#pragma unroll
    for (int q = 0; q < 32; ++q) of[q] = 0.f;
#pragma unroll
    for (int g = 0; g < 16; ++g) { const float a = __shfl(g < 8 ? a0 : a1, (8 * g + es) & 63); u32x4 w_ = k.w[g]; asm volatile("" : "+v"(w_)); axpy_chunk(w_, a, of);
        asm volatile("" : "+v"(of[0]), "+v"(of[1]), "+v"(of[2]), "+v"(of[3]), "+v"(of[4]), "+v"(of[5]), "+v"(of[6]), "+v"(of[7]), "+v"(of[8]), "+v"(of[9]), "+v"(of[10]), "+v"(of[11]), "+v"(of[12]), "+v"(of[13]), "+v"(of[14]), "+v"(of[15]));
        asm volatile("" : "+v"(of[16]), "+v"(of[17]), "+v"(of[18]), "+v"(of[19]), "+v"(of[20]), "+v"(of[21]), "+v"(of[22]), "+v"(of[23]), "+v"(of[24]), "+v"(of[25]), "+v"(of[26]), "+v"(of[27]), "+v"(of[28]), "+v"(of[29]), "+v"(of[30]), "+v"(of[31])); }
#pragma unroll
    for (int q = 0; q < 8; ++q) *(LAS f32x4*)(red + es * 256 + ck * 32 + 4 * q) = (f32x4){of[4 * q], of[4 * q + 1], of[4 * q + 2], of[4 * q + 3]};
    f32x4 s = *(const LAS f32x4*)(red + 4 * lane);
#pragma unroll
    for (int r = 1; r < 8; ++r) s = s + *(const LAS f32x4*)(red + r * 256 + 4 * lane);
    f32x4* o4 = (f32x4*)(p.out + (size_t)t * D + 256 * xv + 4 * lane);
    *o4 = *o4 + s;
}
template <bool USTEP>
__device__ __forceinline__ void peer_step(const Params& p, int lane, int wave, LAS float* red, int pos, int nx, int rank, int nloc) {
    for (int xv = pos; xv < 8; xv += nx) {
        const int wx = rank * 8 + wave, nwx = nloc * 8;
        const unsigned char* tab = p.ws + (USTEP ? WS_TABU : WS_TABV) + (size_t)xv * 16384 * 128;
        PeerTok A, B;
        int t = wx;
        if (t < T) peer_issue<USTEP>(A, p, tab, t, xv, lane);
#pragma unroll 1
        for (; t < T; t += 2 * nwx) {
            const bool hb = t + nwx < T;
            if (hb) peer_issue<USTEP>(B, p, tab, t + nwx, xv, lane);
            if (USTEP) peer_u_finish(A, p, t, xv, lane); else peer_v_finish(A, p, t, xv, lane, red);
            if (t + 2 * nwx < T) peer_issue<USTEP>(A, p, tab, t + 2 * nwx, xv, lane);
            if (hb) { if (USTEP) peer_u_finish(B, p, t + nwx, xv, lane); else peer_v_finish(B, p, t + nwx, xv, lane, red); }
        }
    }
}
typedef int v8i_p __attribute__((ext_vector_type(8))); typedef int v4i_t __attribute__((ext_vector_type(4)));
struct PeerTokU { u32x4 w[16]; u32x4 b[2][2]; };
__device__ __forceinline__ void peer_u_issue(PeerTokU& k, const Params& p, const unsigned char* tab, int t, int xv, int lane) {
    const int* RIDX = (const int*)(p.ws + WS_RIDX);
    const int i0 = RIDX[(size_t)t * 128 + lane], i1 = RIDX[(size_t)t * 128 + 64 + lane];
    const int es = lane >> 3, ck = lane & 7, q = lane >> 4;
    const unsigned char* xp = p.ws + WS_X2F8 + (size_t)t * D + 256 * xv + 16 * q;
#pragma unroll
    for (int kb = 0; kb < 2; ++kb) { k.b[kb][0] = *(const u32x4*)(xp + 128 * kb); k.b[kb][1] = *(const u32x4*)(xp + 128 * kb + 64); }
#pragma unroll
    for (int g = 0; g < 16; ++g) { const int e = __shfl(g < 8 ? i0 : i1, (8 * g + es) & 63); k.w[g] = *(const u32x4*)(tab + (size_t)e * 128 + ck * 16); }
}
__device__ __forceinline__ void peer_u_mfma(const PeerTokU& k, const Params& p, int t, int xv, int lane, LAS unsigned char* vl) {
    float* zp = (float*)(p.ws + WS_ZP) + ((size_t)xv * T + t) * 128;
    const int es = lane >> 3, ck = lane & 7, r16 = lane & 15, q = lane >> 4;
#pragma unroll
    for (int g = 0; g < 16; ++g) { const int row = 8 * g + es; *(LAS u32x4*)(vl + row * 128 + ((ck ^ (row & 7)) << 4)) = k.w[g]; }
    v8i_p b0, b1;
    { const v4i_t x0 = __builtin_bit_cast(v4i_t, k.b[0][0]), x1 = __builtin_bit_cast(v4i_t, k.b[0][1]), y0 = __builtin_bit_cast(v4i_t, k.b[1][0]), y1 = __builtin_bit_cast(v4i_t, k.b[1][1]);
      b0 = __builtin_shufflevector(x0, x1, 0, 1, 2, 3, 4, 5, 6, 7); b1 = __builtin_shufflevector(y0, y1, 0, 1, 2, 3, 4, 5, 6, 7); }
#pragma unroll
    for (int g = 0; g < 8; ++g) {
        const int row = 16 * g + r16;
        const v4i_t a0 = __builtin_bit_cast(v4i_t, *(const LAS u32x4*)(vl + row * 128 + ((q ^ (row & 7)) << 4)));
        const v4i_t a1 = __builtin_bit_cast(v4i_t, *(const LAS u32x4*)(vl + row * 128 + (((4 + q) ^ (row & 7)) << 4)));
        const v8i_p A0 = {a0[0], a0[1], a0[2], a0[3], 0, 0, 0, 0}, A1 = {a1[0], a1[1], a1[2], a1[3], 0, 0, 0, 0};
        f32x4 acc = {0.f, 0.f, 0.f, 0.f};
        acc = __builtin_amdgcn_mfma_scale_f32_16x16x128_f8f6f4(A0, b0, acc, 4, 0, 0, 0x7F7F7F7F, 0, 0x7F7F7F7F);
        acc = __builtin_amdgcn_mfma_scale_f32_16x16x128_f8f6f4(A1, b1, acc, 4, 0, 0, 0x7F7F7F7F, 0, 0x7F7F7F7F);
        if ((lane & 15) == 0) *(f32x4*)(zp + 16 * g + 4 * (lane >> 4)) = acc;
    }
}
__device__ __forceinline__ void peer_u_step(const Params& p, int lane, int wave, LAS unsigned char* vl, int pos, int nx, int rank, int nloc) {
    for (int xv = pos; xv < 8; xv += nx) {
        const int wx = rank * 8 + wave, nwx = nloc * 8;
        const unsigned char* tab = p.ws + WS_TABU + (size_t)xv * 16384 * 128;
        PeerTokU A, B;
        int t = wx;
        if (t < T) peer_u_issue(A, p, tab, t, xv, lane);
#pragma unroll 1
        for (; t < T; t += 2 * nwx) {
            const bool hb = t + nwx < T;
            if (hb) peer_u_issue(B, p, tab, t + nwx, xv, lane);
            peer_u_mfma(A, p, t, xv, lane, vl);
            if (t + 2 * nwx < T) peer_u_issue(A, p, tab, t + 2 * nwx, xv, lane);
            if (hb) peer_u_mfma(B, p, t + nwx, xv, lane, vl);
        }
    }
}
constexpr size_t WS_ACT8 = 34 * MiB, WS_ASC = 36 * MiB;
__device__ __forceinline__ void peer_combine(const Params& p, int t, int lane) {
    const float* ZP = (const float*)(p.ws + WS_ZP); const int* RIDX = (const int*)(p.ws + WS_RIDX); const float* RG = (const float*)(p.ws + WS_RG);
    const float* SCU = (const float*)(p.ws + WS_SCU); const float* SCV = (const float*)(p.ws + WS_SCV); const float* SS2 = (const float*)(p.ws + WS_CTL + CTL_SS2_BYTE);
    const float rs = rsqrtf(SS2[t] * (1.f / D) + EPS);
    float act[2];
#pragma unroll
    for (int hlf = 0; hlf < 2; ++hlf) { const size_t o = (size_t)t * 128 + 64 * hlf + lane; float z = 0.f;
#pragma unroll
        for (int x = 0; x < 8; ++x) z += ZP[((size_t)x * T) * 128 + o];
        const int e = RIDX[o];
        act[hlf] = gelu_tanh(z * rs * SCU[e]) * RG[o] * SCV[e]; }
    float mx = fmaxf(fabsf(act[0]), fabsf(act[1]));
#pragma unroll
    for (int o = 1; o < 64; o <<= 1) mx = fmaxf(mx, __shfl_xor(mx, o));
    const float sc = mx > 0.f ? mx * (1.f / 448.f) : 1.f, inv = 1.f / sc;
    unsigned char* a8 = p.ws + WS_ACT8 + (size_t)t * 128;
    a8[lane] = (unsigned char)(__builtin_amdgcn_cvt_pk_fp8_f32(act[0] * inv, 0.f, 0, false) & 0xff);
    a8[64 + lane] = (unsigned char)(__builtin_amdgcn_cvt_pk_fp8_f32(act[1] * inv, 0.f, 0, false) & 0xff);
    if (lane == 0) ((float*)(p.ws + WS_ASC))[t] = sc;
}
typedef int v2i_t __attribute__((ext_vector_type(2)));
struct PeerTokV { u32x4 w[16]; u32x4 b[2]; };
__device__ __forceinline__ void peer_v_issue(PeerTokV& k, const Params& p, const unsigned char* tab, int t, int lane) {
    const int* RIDX = (const int*)(p.ws + WS_RIDX);
    const int i0 = RIDX[(size_t)t * 128 + lane], i1 = RIDX[(size_t)t * 128 + 64 + lane];
    const int es = lane >> 3, ck = lane & 7, q = lane >> 4;
    const unsigned char* ap = p.ws + WS_ACT8 + (size_t)t * 128 + 16 * q;
    k.b[0] = *(const u32x4*)ap; k.b[1] = *(const u32x4*)(ap + 64);
#pragma unroll
    for (int g = 0; g < 16; ++g) { const int e = __shfl(g < 8 ? i0 : i1, (8 * g + es) & 63); k.w[g] = *(const u32x4*)(tab + (size_t)e * 128 + ck * 16); }
}
__device__ __forceinline__ void peer_v_mfma(const PeerTokV& k, const Params& p, int t, int xv, int lane, LAS unsigned char* vl) {
    const int es = lane >> 3, ck = lane & 7, n = lane & 15, q = lane >> 4;
#pragma unroll
    for (int g = 0; g < 16; ++g) { const int row = 8 * g + es; *(LAS u32x4*)(vl + row * 128 + ((ck ^ (row & 7)) << 4)) = k.w[g]; }
    const v4i_t x0 = __builtin_bit_cast(v4i_t, k.b[0]), x1 = __builtin_bit_cast(v4i_t, k.b[1]);
    const v8i_p bop = __builtin_shufflevector(x0, x1, 0, 1, 2, 3, 4, 5, 6, 7);
    const int r1 = 32 * q + n, r2 = r1 + 16;
    f32x4 keep = {0.f, 0.f, 0.f, 0.f};
#pragma unroll
    for (int mb = 0; mb < 16; ++mb) {
        const v2i_t t1 = __builtin_amdgcn_ds_read_tr4_b64_v2i32((LAS v2i_t*)(vl + r1 * 128 + ((((mb >> 1) ^ (r1 & 7)) << 4) | ((mb & 1) << 3))));
        const v2i_t t2 = __builtin_amdgcn_ds_read_tr4_b64_v2i32((LAS v2i_t*)(vl + r2 * 128 + ((((mb >> 1) ^ (r2 & 7)) << 4) | ((mb & 1) << 3))));
        const v8i_p aop = {t1[0], t1[1], t2[0], t2[1], 0, 0, 0, 0};
        f32x4 acc = {0.f, 0.f, 0.f, 0.f};
        acc = __builtin_amdgcn_mfma_scale_f32_16x16x128_f8f6f4(aop, bop, acc, 4, 0, 0, 0x7F7F7F7F, 0, 0x7F7F7F7F);
        if (n == mb) keep = acc;
    }
    const float sc = ((const float*)(p.ws + WS_ASC))[t];
    f32x4* o4 = (f32x4*)(p.out + (size_t)t * D + 256 * xv + 16 * n + 4 * q);
    *o4 = *o4 + keep * sc;
}
__device__ __forceinline__ void peer_v_step(const Params& p, int lane, int wave, LAS unsigned char* vl, int pos, int nx, int rank, int nloc) {
    for (int xv = pos; xv < 8; xv += nx) {
        const int wx = rank * 8 + wave, nwx = nloc * 8;
        const unsigned char* tab = p.ws + WS_TABV + (size_t)xv * 16384 * 128;
        PeerTokV A, B;
        int t = wx;
        if (t < T) peer_v_issue(A, p, tab, t, lane);
#pragma unroll 1
        for (; t < T; t += 2 * nwx) {
            const bool hb = t + nwx < T;
            if (hb) peer_v_issue(B, p, tab, t + nwx, lane);
            peer_v_mfma(A, p, t, xv, lane, vl);
            if (t + 2 * nwx < T) peer_v_issue(A, p, tab, t + 2 * nwx, lane);
            if (hb) peer_v_mfma(B, p, t + nwx, xv, lane, vl);
        }
    }
}

namespace pg8 {
#define PG8_LAS __attribute__((address_space(3)))
constexpr int BM = 256, BK = 64, HALF = 128, HTB = HALF * BK * 2, STAGE_BYTES = 8 * HTB, NXCD = 8, WGM = 8;
__host__ __device__ __forceinline__ int lds_byte(int r, int c) { const int st = (r >> 4) * 2 + (c >> 5), rr = r & 15, cc = c & 31, ob = rr * 64 + cc * 2; return st * 1024 + (ob ^ (((ob >> 9) & 1) << 5)); }
__host__ __device__ __forceinline__ void stage_rc(int b, int& R, int& C) { const int st = b / 1024, sb = b % 1024, swz = sb ^ (((sb >> 9) & 1) << 5); R = (st >> 1) * 16 + swz / 64; C = (st & 1) * 32 + (swz % 64) / 2; }
__host__ __device__ __forceinline__ int perm32(int rho) { const int n = rho >> 4, i = rho & 15; return 8 * (i >> 2) + 4 * n + (i & 3); }
struct Unit { const char* A; const char* B; int pm, pn, kind, nt; };
__device__ __forceinline__ const char* uni_ptr(const char* p) { const unsigned long long v = (unsigned long long)p; const unsigned lo = __builtin_amdgcn_readfirstlane((unsigned)v), hi = __builtin_amdgcn_readfirstlane((unsigned)(v >> 32)); return (const char*)(((unsigned long long)hi << 32) | lo); }
__device__ __forceinline__ void uni(Unit& u) { u.A = uni_ptr(u.A); u.B = uni_ptr(u.B); u.pm = __builtin_amdgcn_readfirstlane(u.pm); u.pn = __builtin_amdgcn_readfirstlane(u.pn); u.kind = __builtin_amdgcn_readfirstlane(u.kind); u.nt = __builtin_amdgcn_readfirstlane(u.nt); }
__device__ __forceinline__ void tile_of(int L, int nM, int nN, int& pm, int& pn) {
    const int nwg = nM * nN; int wgid = L; { const int q = nwg / NXCD, r = nwg % NXCD, xcd = wgid % NXCD, off = wgid / NXCD; wgid = (xcd < r ? xcd * (q + 1) : r * (q + 1) + (xcd - r) * q) + off; }
    const int nig = WGM * nN, gid = wgid / nig, fm = gid * WGM, gsz = (nM - fm) < WGM ? (nM - fm) : WGM;
    pm = fm + ((wgid % nig) % gsz); pn = (wgid % nig) / gsz;
}
typedef int v8i_t __attribute__((ext_vector_type(8))); typedef int v4i_t __attribute__((ext_vector_type(4)));
__device__ __forceinline__ v8i_t cat8(const bf16x8 lo, const bf16x8 hi) { const v4i_t a = __builtin_bit_cast(v4i_t, lo), b = __builtin_bit_cast(v4i_t, hi); return __builtin_shufflevector(a, b, 0, 1, 2, 3, 4, 5, 6, 7); }
template <bool FP8, class Epi, class Sched>
__device__ __forceinline__ void gemm_phase(PG8_LAS unsigned char* lds, const int lda, const int ldb, const Sched& S, const Epi& E) {
    const int tid = threadIdx.x, wid = __builtin_amdgcn_readfirstlane(tid >> 6), lane = tid & 63, wr = wid >> 2, wc = wid & 3, fr = lane & 15, fq = lane >> 4;
    unsigned voffA[2], voffB[2];
#pragma unroll
    for (int i = 0; i < 2; ++i) { int R, C; stage_rc(tid * 16 + i * 8192, R, C); const int Rb = (R & ~31) + perm32(R & 31);
        voffA[i] = (unsigned)(R * lda + C) * 2u; voffB[i] = (unsigned)(Rb * ldb + C) * 2u; }
    const size_t kstep = (size_t)(BK * 2);
    const size_t hstepA = (size_t)HALF * lda * 2, hstepB = (size_t)HALF * ldb * 2;
    const unsigned ldsw = (unsigned)wid * 1024u;
    const int aoff = lds_byte(wr * 64 + fr, fq * 8), boff = lds_byte(wc * 32 + fr, fq * 8);
#define PG8_SA(b, h) (((b) * 2 + (h)) * HTB)
#define PG8_SB(b, h) ((4 + (b) * 2 + (h)) * HTB)
#define PG8_STAGE(bufoff, gbase, voff) do { _Pragma("unroll") for (int _i = 0; _i < 2; ++_i) \
        __builtin_amdgcn_global_load_lds((const unsigned*)((const char*)(gbase) + (voff)[_i]), (PG8_LAS unsigned*)(lds + (bufoff) + ldsw + _i * 8192), 16, 0, 0); } while (0)
#define PG8_LDA(dst, b, h) do { _Pragma("unroll") for (int m = 0; m < 4; ++m) { if constexpr (FP8) dst##8[m] = cat8(*(const PG8_LAS bf16x8*)(lds + PG8_SA(b, h) + aoff + m * 2048), *(const PG8_LAS bf16x8*)(lds + PG8_SA(b, h) + aoff + m * 2048 + 1024)); \
        else { _Pragma("unroll") for (int k = 0; k < 2; ++k) dst[m][k] = *(const PG8_LAS bf16x8*)(lds + PG8_SA(b, h) + aoff + m * 2048 + k * 1024); } } } while (0)
#define PG8_LDB(dst, b, h) do { _Pragma("unroll") for (int n = 0; n < 2; ++n) { if constexpr (FP8) dst##8[n] = cat8(*(const PG8_LAS bf16x8*)(lds + PG8_SB(b, h) + boff + n * 2048), *(const PG8_LAS bf16x8*)(lds + PG8_SB(b, h) + boff + n * 2048 + 1024)); \
        else { _Pragma("unroll") for (int k = 0; k < 2; ++k) dst[n][k] = *(const PG8_LAS bf16x8*)(lds + PG8_SB(b, h) + boff + n * 2048 + k * 1024); } } } while (0)
#define PG8_MMA(ai, bj, At, Bt) do { __builtin_amdgcn_s_setprio(1); \
        if constexpr (FP8) { _Pragma("unroll") for (int m = 0; m < 4; ++m) _Pragma("unroll") for (int n = 0; n < 2; ++n) \
            asm volatile("v_mfma_scale_f32_16x16x128_f8f6f4 %0, %1, %2, %0, %3, %3 op_sel_hi:[0,0,0]" : "+v"(acc[ai][bj][m][n]) : "v"(Bt##8[n]), "v"(At##8[m]), "v"(mxone)); } \
        else { _Pragma("unroll") for (int m = 0; m < 4; ++m) _Pragma("unroll") for (int n = 0; n < 2; ++n) _Pragma("unroll") for (int k = 0; k < 2; ++k) \
            acc[ai][bj][m][n] = __builtin_amdgcn_mfma_f32_16x16x32_bf16(Bt[n][k], At[m][k], acc[ai][bj][m][n], 0, 0, 0); } \
        __builtin_amdgcn_s_setprio(0); } while (0)
#define PG8_WAIT_V(n) asm volatile("s_waitcnt vmcnt(" #n ")" ::: "memory")
#define PG8_WAIT_L(n) asm volatile("s_waitcnt lgkmcnt(" #n ")" ::: "memory")
#define PG8_BAR __builtin_amdgcn_s_barrier()
#define PG8_SCHED __builtin_amdgcn_sched_barrier(0)
    Unit cur, nxt; int ui = 0;
    if (!S.next(0, cur)) return;
    f32x4 acc[2][2][4][2];
#pragma unroll
    for (int a = 0; a < 2; ++a)
#pragma unroll
        for (int b = 0; b < 2; ++b)
#pragma unroll
            for (int m = 0; m < 4; ++m)
#pragma unroll
                for (int n = 0; n < 2; ++n) acc[a][b][m][n] = (f32x4){0.f, 0.f, 0.f, 0.f};
    const int mxone = 0x7F7F7F7F;
    bf16x8 At[4][2], B0[2][2], B1[2][2]; v8i_t At8[4], B08[2], B18[2];
    const char* cA = cur.A; const char* cB = cur.B;
    PG8_STAGE(PG8_SB(0, 0), cB, voffB); PG8_STAGE(PG8_SB(0, 1), cB + hstepB, voffB); PG8_STAGE(PG8_SA(0, 0), cA, voffA); PG8_STAGE(PG8_SA(0, 1), cA + hstepA, voffA);
    if (wr == 1) PG8_BAR;
    PG8_WAIT_V(2); PG8_BAR;
    PG8_STAGE(PG8_SB(1, 0), cB + kstep, voffB); PG8_STAGE(PG8_SA(1, 0), cA + kstep, voffA); PG8_STAGE(PG8_SB(1, 1), cB + hstepB + kstep, voffB);
    PG8_WAIT_V(6); PG8_BAR;
    for (;;) {
        const bool has_next = S.next(ui + 1, nxt);
        const char* nA = has_next ? nxt.A : cA; const char* nB = has_next ? nxt.B : cB;
        const int nt = cur.nt;
        for (int t = 0; t < nt; t += 2) {
            const bool last = (t == nt - 2);
            const char* a1 = cA + (size_t)(t + 1) * kstep;
            const char* a2 = last ? nA : cA + (size_t)(t + 2) * kstep; const char* b2 = last ? nB : cB + (size_t)(t + 2) * kstep;
            const char* a3 = a2 + kstep; const char* b3 = b2 + kstep;
            PG8_LDB(B0, 0, 0); PG8_LDB(B1, 0, 1); PG8_SCHED; PG8_LDA(At, 0, 0); PG8_STAGE(PG8_SA(1, 1), a1 + hstepA, voffA);
            PG8_WAIT_V(8); PG8_WAIT_L(0); PG8_BAR; PG8_MMA(0, 0, At, B0); PG8_MMA(0, 1, At, B1); PG8_BAR; PG8_SCHED;
            PG8_LDA(At, 0, 1); PG8_STAGE(PG8_SB(0, 0), b2, voffB); PG8_STAGE(PG8_SB(0, 1), b2 + hstepB, voffB); PG8_STAGE(PG8_SA(0, 0), a2, voffA);
            PG8_WAIT_V(8); PG8_WAIT_L(0); PG8_BAR; PG8_MMA(1, 0, At, B0); PG8_MMA(1, 1, At, B1); PG8_BAR; PG8_SCHED;
            PG8_LDB(B0, 1, 0); PG8_LDB(B1, 1, 1); PG8_SCHED; PG8_LDA(At, 1, 0); PG8_STAGE(PG8_SA(0, 1), a2 + hstepA, voffA);
            PG8_WAIT_V(8); PG8_WAIT_L(0); PG8_BAR; PG8_MMA(0, 0, At, B0); PG8_MMA(0, 1, At, B1); PG8_BAR; PG8_SCHED;
            PG8_LDA(At, 1, 1); PG8_STAGE(PG8_SB(1, 0), b3, voffB); PG8_STAGE(PG8_SB(1, 1), b3 + hstepB, voffB); PG8_STAGE(PG8_SA(1, 0), a3, voffA);
            PG8_WAIT_V(8); PG8_WAIT_L(0); PG8_BAR; PG8_MMA(1, 0, At, B0); PG8_MMA(1, 1, At, B1); PG8_BAR; PG8_SCHED;
        }
        if (wr == 0) PG8_BAR;
        if constexpr (FP8) asm volatile("s_nop 15\n\ts_nop 15" ::: "memory");
        E(acc, cur, wr, wc, fr, fq);
        if (!has_next) break;
        if (E.reset(cur)) {
#pragma unroll
        for (int a = 0; a < 2; ++a)
#pragma unroll
            for (int b = 0; b < 2; ++b)
#pragma unroll
                for (int m = 0; m < 4; ++m)
#pragma unroll
                    for (int n = 0; n < 2; ++n) acc[a][b][m][n] = (f32x4){0.f, 0.f, 0.f, 0.f};
        }
        cur = nxt; cA = nA; cB = nB; ++ui;
        if (wr == 1) PG8_BAR;
    }
    PG8_WAIT_V(0);
    PG8_BAR;
#undef PG8_SA
#undef PG8_SB
#undef PG8_STAGE
#undef PG8_LDA
#undef PG8_LDB
#undef PG8_MMA
#undef PG8_WAIT_V
#undef PG8_WAIT_L
#undef PG8_BAR
#undef PG8_SCHED
}
}
typedef f32x4 AccT[2][2][4][2];
#define EPI_RESET_ALWAYS __device__ __forceinline__ bool reset(const pg8::Unit&) const { return true; }
__device__ __forceinline__ unsigned cvt_pk_bf16(float lo, float hi) { unsigned r; asm volatile("v_cvt_pk_bf16_f32 %0, %1, %2" : "=v"(r) : "v"(lo), "v"(hi)); return r; }
__device__ __forceinline__ u32x4 pack8(const f32x4 v0, const f32x4 v1) { u32x4 w; w.x = cvt_pk_bf16(v0[0], v0[1]); w.y = cvt_pk_bf16(v0[2], v0[3]); w.z = cvt_pk_bf16(v1[0], v1[1]); w.w = cvt_pk_bf16(v1[2], v1[3]); return w; }
template <int MODE>
__device__ __forceinline__ void store_tile_bf16(const AccT& acc, bf16_t* base, int ldc, int row0, int col0, const float* bias, const float ascale = 1.f) {
#pragma unroll
    for (int ai = 0; ai < 2; ++ai)
#pragma unroll
        for (int m = 0; m < 4; ++m) { bf16_t* rowp = base + (size_t)(row0 + ai * 128 + m * 16) * ldc + col0;
#pragma unroll
            for (int bj = 0; bj < 2; ++bj) { f32x4 v0 = acc[ai][bj][m][0], v1 = acc[ai][bj][m][1];
                if (MODE == 1) { _Pragma("unroll") for (int e = 0; e < 4; ++e) { v0[e] = gelu_tanh(v0[e]); v1[e] = gelu_tanh(v1[e]); } }
                if (MODE == 2) { const f32x4 b0 = *(const f32x4*)(bias + col0 + bj * 128), b1 = *(const f32x4*)(bias + col0 + bj * 128 + 4);
                    v0 = v0 * ascale + b0; v1 = v1 * ascale + b1; _Pragma("unroll") for (int e = 0; e < 4; ++e) { v0[e] = sigmoid_(v0[e]); v1[e] = sigmoid_(v1[e]); } }
                *(u32x4*)(rowp + bj * 128) = pack8(v0, v1); }
            if (MODE == 2) asm volatile("" ::: "memory"); }
}
struct SchedP1a { const char* H; const char* WT; const char* MEMN; const char* WTM; int G, c;
    __device__ __forceinline__ bool next(int i, pg8::Unit& u) const {
        const int L = i * G + c; const int n1 = 64 * 18;
        if (L < n1) { pg8::tile_of(L, 64, 18, u.pm, u.pn); u.kind = 0; u.A = H + (size_t)u.pm * 256 * D * 2; u.B = WT + (size_t)u.pn * 256 * D * 2; u.nt = D / 64; pg8::uni(u); return true; }
        if (L < n1 + 8) { const int j = L - n1; u.pm = j >> 2; u.pn = j & 3; u.kind = 1; u.A = MEMN + (size_t)u.pm * 256 * D * 2; u.B = WTM + (size_t)u.pn * 256 * D * 2; u.nt = D / 64; pg8::uni(u); return true; }
        return false; } };
struct EpiP1a { bf16_t* PROJ; bf16_t* MEMKV; EPI_RESET_ALWAYS
    __device__ __forceinline__ void operator()(AccT& acc, const pg8::Unit& u, int wr, int wc, int fr, int fq) const {
        const int row0 = u.pm * 256 + wr * 64 + fr, cl = wc * 32 + 8 * fq;
        if (u.kind == 1) { store_tile_bf16<0>(acc, MEMKV, 2 * CW, row0, u.pn * 256 + cl, nullptr); return; }
        if (u.pn == 14 || u.pn == 15) { store_tile_bf16<1>(acc, PROJ, INW, row0, u.pn * 256 + cl, nullptr); return; }
        store_tile_bf16<0>(acc, PROJ, INW, row0, u.pn * 256 + cl, nullptr);
    } };
struct SchedP1b { const char* H8; const char* WT8; int G, c;
    __device__ __forceinline__ bool next(int i, pg8::Unit& u) const {
        const int L = i * G + c; if (L >= 64 * 24) return false;
        pg8::tile_of(L, 64, 24, u.pm, u.pn); u.kind = 0; u.A = H8 + (size_t)u.pm * 256 * D; u.B = WT8 + (size_t)u.pn * 256 * D; u.nt = D / 128; pg8::uni(u); return true; } };
struct EpiP1b { bf16_t* G; const float* bgate; EPI_RESET_ALWAYS
    __device__ __forceinline__ void operator()(AccT& acc, const pg8::Unit& u, int wr, int wc, int fr, int fq) const {
        store_tile_bf16<2>(acc, G, GW, u.pm * 256 + wr * 64 + fr, u.pn * 256 + wc * 32 + 8 * fq, bgate, 1.f / GATE_WSCALE);
    } };
struct SchedP3 { const char* O; const char* WT; int G, c;
    __device__ __forceinline__ bool next(int i, pg8::Unit& u) const {
        const int ti = i / 3, seg = i - 3 * ti; const int L = ti * G + c; if (L >= 64 * 8) return false;
        pg8::tile_of(L, 64, 8, u.pm, u.pn); u.kind = seg;
        const int kb = seg == 0 ? 0 : (seg == 1 ? 1024 : 1536);
        u.A = O + ((size_t)u.pm * 256 * D + kb) * 2; u.B = WT + ((size_t)u.pn * 256 * D + kb) * 2; u.nt = seg == 0 ? 16 : 8; pg8::uni(u); return true; } };
struct EpiP3 { const bf16_t* G; bf16_t* MERGED;
    __device__ __forceinline__ bool reset(const pg8::Unit& u) const { return u.kind == 2; }
    __device__ __forceinline__ void operator()(AccT& acc, const pg8::Unit& u, int wr, int wc, int fr, int fq) const {
        const int row0 = u.pm * 256 + wr * 64 + fr, col0 = u.pn * 256 + wc * 32 + 8 * fq, seg = u.kind;
#pragma unroll
        for (int ai = 0; ai < 2; ++ai)
#pragma unroll
            for (int mh = 0; mh < 2; ++mh) {
                u32x4 ga[2][2], gb[2][2];
#pragma unroll
                for (int mm = 0; mm < 2; ++mm)
#pragma unroll
                    for (int bj = 0; bj < 2; ++bj) { const bf16_t* gp = G + (size_t)(row0 + ai * 128 + (mh * 2 + mm) * 16) * GW + col0 + bj * 128;
                        ga[mm][bj] = *(const u32x4*)(gp + seg * D); gb[mm][bj] = (seg < 2) ? *(const u32x4*)(gp + (seg + 1) * D) : (u32x4){0u, 0u, 0u, 0u}; }
#pragma unroll
                for (int mm = 0; mm < 2; ++mm)
#pragma unroll
                    for (int bj = 0; bj < 2; ++bj) { const int m = mh * 2 + mm;
                        float fa[8], fb[8]; unpack8(ga[mm][bj], fa); unpack8(gb[mm][bj], fb);
                        if (seg < 2) { _Pragma("unroll") for (int e = 0; e < 8; ++e) fa[e] = fa[e] * __builtin_amdgcn_rcpf(fmaxf(fb[e], 1e-20f)); }
                        f32x4& v0 = acc[ai][bj][m][0]; f32x4& v1 = acc[ai][bj][m][1];
                        v0[0] *= fa[0]; v0[1] *= fa[1]; v0[2] *= fa[2]; v0[3] *= fa[3]; v1[0] *= fa[4]; v1[1] *= fa[5]; v1[2] *= fa[6]; v1[3] *= fa[7];
                        if (seg == 2) *(u32x4*)(MERGED + (size_t)(row0 + ai * 128 + m * 16) * D + col0 + bj * 128) = pack8(v0, v1);
                    }
                asm volatile("" ::: "memory");
            }
    } };
struct SchedSq { const char* A; const char* WT; int G, c;
    __device__ __forceinline__ bool next(int i, pg8::Unit& u) const {
        const int L = i * G + c; if (L >= 64 * 8) return false;
        pg8::tile_of(L, 64, 8, u.pm, u.pn); u.kind = 0; u.A = A + (size_t)u.pm * 256 * D * 2; u.B = WT + (size_t)u.pn * 256 * D * 2; u.nt = D / 64; pg8::uni(u); return true; } };
struct EpiP4 { const float* x; float* out; bf16_t* xb; float* ss; unsigned char* x8; EPI_RESET_ALWAYS
    __device__ __forceinline__ void operator()(AccT& acc, const pg8::Unit& u, int wr, int wc, int fr, int fq) const {
        const int row0 = u.pm * 256 + wr * 64 + fr, col0 = u.pn * 256 + wc * 32 + 8 * fq;
#pragma unroll
        for (int ai = 0; ai < 2; ++ai)
#pragma unroll
            for (int m = 0; m < 4; ++m) { const size_t row = (size_t)(row0 + ai * 128 + m * 16); float sq = 0.f;
#pragma unroll
                for (int bj = 0; bj < 2; ++bj) { const size_t o = row * D + col0 + bj * 128;
                    const f32x4 v0 = acc[ai][bj][m][0] + *(const f32x4*)(x + o), v1 = acc[ai][bj][m][1] + *(const f32x4*)(x + o + 4);
                    *(f32x4*)(out + o) = v0; *(f32x4*)(out + o + 4) = v1; *(u32x4*)(xb + o) = pack8(v0, v1);
                    { int w0 = __builtin_amdgcn_cvt_pk_fp8_f32(v0[0], v0[1], 0, false); w0 = __builtin_amdgcn_cvt_pk_fp8_f32(v0[2], v0[3], w0, true);
                      int w1 = __builtin_amdgcn_cvt_pk_fp8_f32(v1[0], v1[1], 0, false); w1 = __builtin_amdgcn_cvt_pk_fp8_f32(v1[2], v1[3], w1, true);
                      *(u32x2*)(x8 + o) = (u32x2){(unsigned)w0, (unsigned)w1}; }
                    sq += (v0[0] * v0[0] + v0[1] * v0[1]) + (v0[2] * v0[2] + v0[3] * v0[3]) + (v1[0] * v1[0] + v1[1] * v1[1]) + (v1[2] * v1[2] + v1[3] * v1[3]); }
                sq += __shfl_xor(sq, 16); sq += __shfl_xor(sq, 32);
                if (fq == 0) atomicAdd(ss + row, sq); }
    } };
struct EpiP5 { bf16_t* Q; const float* ss; EPI_RESET_ALWAYS
    __device__ __forceinline__ void operator()(AccT& acc, const pg8::Unit& u, int wr, int wc, int fr, int fq) const {
        const int row0 = u.pm * 256 + wr * 64 + fr, col0 = u.pn * 256 + wc * 32 + 8 * fq;
#pragma unroll
        for (int ai = 0; ai < 2; ++ai)
#pragma unroll
            for (int m = 0; m < 4; ++m) { const size_t row = (size_t)(row0 + ai * 128 + m * 16); const float rs = rsqrtf(ss[row] * (1.f / D) + EPS);
#pragma unroll
                for (int bj = 0; bj < 2; ++bj) *(u32x4*)(Q + row * D + col0 + bj * 128) = pack8(acc[ai][bj][m][0] * rs, acc[ai][bj][m][1] * rs); }
    } };


namespace att {
using s16x4  = __attribute__((ext_vector_type(4))) short;
using f32x16 = __attribute__((ext_vector_type(16))) float;
constexpr int NWV = 8, QBLK = 32, KVBLK = 64, DH = 128;
constexpr float THR = 8.f;
constexpr int SHM_V = KVBLK * DH * 2, SHM_K = KVBLK * DH * 2;
constexpr int OFF_WS = 2 * SHM_V + 2 * SHM_K, OFF_BT = OFF_WS + NWV * 64 * 4, OFF_OST = OFF_BT + 1536, LDS_NEED = OFF_OST + NWV * 8192;
#define KSWZ(row, colB) ((row) * 256 + ((colB) ^ (((row) & 7) << 4)))
#define SBAR() __builtin_amdgcn_sched_barrier(0)
__device__ __forceinline__ int crow(int r, int hi) { return (r & 3) + 8 * (r >> 2) + 4 * hi; }
__device__ __forceinline__ unsigned cvtpk(float lo, float hi) { unsigned r; asm volatile("v_cvt_pk_bf16_f32 %0, %1, %2" : "=v"(r) : "v"(lo), "v"(hi)); return r; }
__device__ __forceinline__ void partialSM(f32x16& p0, f32x16& p1, float& m_reg, float& mn, float& alpha) {
  constexpr float C = 1.4426950408889634f;
  float pmax = p0[0];
#pragma unroll
  for (int r = 1; r < 16; ++r) pmax = fmaxf(pmax, p0[r]);
#pragma unroll
  for (int r = 0; r < 16; ++r) pmax = fmaxf(pmax, p1[r]);
  { auto rr = __builtin_amdgcn_permlane32_swap(__float_as_uint(pmax), __float_as_uint(pmax), false, false);
    pmax = fmaxf(__uint_as_float(rr[0]), __uint_as_float(rr[1])); }
  if (__builtin_expect(__all(pmax - m_reg <= THR), 1)) { mn = m_reg; alpha = 1.f; }
  else { mn = fmaxf(m_reg, pmax); alpha = __builtin_amdgcn_exp2f((m_reg - mn) * C); m_reg = mn; }
  float mnC = -mn * C;
#pragma unroll
  for (int r = 0; r < 16; ++r) p0[r] = fmaf(p0[r], C, mnC);
#pragma unroll
  for (int r = 0; r < 16; ++r) p1[r] = fmaf(p1[r], C, mnC);
#pragma unroll
  for (int r = 0; r < 16; ++r) p0[r] = __builtin_amdgcn_exp2f(p0[r]);
}
__device__ __forceinline__ void finishSM(f32x16& p0, f32x16& p1, float alpha, float& l_reg, bf16x8& pa0, bf16x8& pa1, bf16x8& pa2, bf16x8& pa3) {
#pragma unroll
  for (int r = 0; r < 16; ++r) p1[r] = __builtin_amdgcn_exp2f(p1[r]);
  float ps = 0;
#pragma unroll
  for (int r = 0; r < 16; ++r) ps += p0[r];
#pragma unroll
  for (int r = 0; r < 16; ++r) ps += p1[r];
  { auto rr = __builtin_amdgcn_permlane32_swap(__float_as_uint(ps), __float_as_uint(ps), false, false);
    ps = __uint_as_float(rr[0]) + __uint_as_float(rr[1]); }
  l_reg = l_reg * alpha + ps;
#define PK4(P, BASE, OUT) do { unsigned a0 = cvtpk(P[BASE + 0], P[BASE + 1]), a1 = cvtpk(P[BASE + 2], P[BASE + 3]);   \
    unsigned b0 = cvtpk(P[BASE + 4], P[BASE + 5]), b1 = cvtpk(P[BASE + 6], P[BASE + 7]);                              \
    auto r0 = __builtin_amdgcn_permlane32_swap(a0, b0, false, false); auto r1 = __builtin_amdgcn_permlane32_swap(a1, b1, false, false); \
    u32x4 w = {r0[0], r1[0], r0[1], r1[1]}; OUT = *reinterpret_cast<bf16x8*>(&w); } while (0)
  PK4(p0, 0, pa0); PK4(p0, 8, pa1); PK4(p1, 0, pa2); PK4(p1, 8, pa3);
#undef PK4
}
template <bool BIAS>
__device__ __forceinline__ void qkt(f32x16& p0, f32x16& p1, const LAS char* Ks, const LAS char* qs, int r32, int hi, const LAS float* bp) {
  if (BIAS) {
#pragma unroll
    for (int r = 0; r < 16; ++r) { p0[r] = bp[(r & 3) + 8 * (r >> 2)]; p1[r] = bp[32 + (r & 3) + 8 * (r >> 2)]; }
  } else { p0 = f32x16{}; p1 = f32x16{}; }
#pragma unroll
  for (int d0 = 0; d0 < 8; ++d0) { int cb = (d0 * 16 + hi * 8) * 2;
    bf16x8 b0 = *reinterpret_cast<const LAS bf16x8*>(Ks + KSWZ(r32, cb));
    bf16x8 b1 = *reinterpret_cast<const LAS bf16x8*>(Ks + KSWZ(32 + r32, cb));
    const bf16x8 qv = *reinterpret_cast<const LAS bf16x8*>(qs + d0 * 1024);
    p0 = __builtin_amdgcn_mfma_f32_32x32x16_bf16(b0, qv, p0, 0, 0, 0);
    p1 = __builtin_amdgcn_mfma_f32_32x32x16_bf16(b1, qv, p1, 0, 0, 0); }
}
__device__ __forceinline__ int v_st(int k, int c) { const int kk = (k & ~0xC) | ((k & 4) << 1) | ((k & 8) >> 1); return ((kk >> 3) * 4 + (c >> 5)) * 512 + ((kk & 7) * 32 + (c & 31)) * 2; }
__device__ __forceinline__ int v_rd_base(int lane) { return ((lane & 3) << 3) | (((lane >> 2) & 3) << 6) | (((lane >> 4) & 1) << 5) | (((lane >> 5) & 1) << 8); }
constexpr int v_rd_off(int d0, int ks, int half) { return d0 * 512 + ks * 4096 + half * 2048; }
template <int OFF> __device__ __forceinline__ s16x4 tr_read(int vb) {
  s16x4 r; asm volatile("ds_read_b64_tr_b16 %0, %1 offset:%2" : "=&v"(r) : "v"(vb), "i"(OFF) : "memory"); return r;
}
template <int D0> __device__ __forceinline__ void pv_one(f32x16& od, int vb, bf16x8 pa0, bf16x8 pa1, bf16x8 pa2, bf16x8 pa3) {
  const s16x4 l0 = tr_read<v_rd_off(D0, 0, 0)>(vb), h0 = tr_read<v_rd_off(D0, 0, 1)>(vb), l1 = tr_read<v_rd_off(D0, 1, 0)>(vb), h1 = tr_read<v_rd_off(D0, 1, 1)>(vb);
  const s16x4 l2 = tr_read<v_rd_off(D0, 2, 0)>(vb), h2 = tr_read<v_rd_off(D0, 2, 1)>(vb), l3 = tr_read<v_rd_off(D0, 3, 0)>(vb), h3 = tr_read<v_rd_off(D0, 3, 1)>(vb);
  asm volatile("s_waitcnt lgkmcnt(0)" ::: "memory"); SBAR();
#define PK(L, H) (bf16x8){L[0], L[1], L[2], L[3], H[0], H[1], H[2], H[3]}
  od = __builtin_amdgcn_mfma_f32_32x32x16_bf16(pa0, PK(l0, h0), od, 0, 0, 0);
  od = __builtin_amdgcn_mfma_f32_32x32x16_bf16(pa1, PK(l1, h1), od, 0, 0, 0);
  od = __builtin_amdgcn_mfma_f32_32x32x16_bf16(pa2, PK(l2, h2), od, 0, 0, 0);
  od = __builtin_amdgcn_mfma_f32_32x32x16_bf16(pa3, PK(l3, h3), od, 0, 0, 0);
#undef PK
}
__device__ __forceinline__ void pv_d0(f32x16* o, int vb, bf16x8 pa0, bf16x8 pa1, bf16x8 pa2, bf16x8 pa3) {
  pv_one<0>(o[0], vb, pa0, pa1, pa2, pa3); pv_one<1>(o[1], vb, pa0, pa1, pa2, pa3); pv_one<2>(o[2], vb, pa0, pa1, pa2, pa3); pv_one<3>(o[3], vb, pa0, pa1, pa2, pa3);
}
template <int LDQ, int LDK, int LDO, bool BAND>
__device__ __forceinline__ void attn_body(const bf16_t* Qb, const bf16_t* Kh, const bf16_t* Vh, bf16_t* Ob,
                                          const int NT, const int kc0, const float* btab_src, LAS char* lds) {
  const int tid = threadIdx.x, wid = __builtin_amdgcn_readfirstlane(tid >> 6), lane = tid & 63, r32 = lane & 31, hi = lane >> 5;
  LAS char* V_lds = lds; LAS char* K_lds = lds + 2 * SHM_V;
  LAS float* wsf = (LAS float*)(lds + OFF_WS) + wid * 64; LAS float* li_l = wsf; LAS float* al_l = wsf + 32;
  LAS float* btab = (LAS float*)(lds + OFF_BT);
  if (BAND) { if (tid < 384) btab[tid] = tid < 64 ? btab_src[256] : (tid < 256 ? btab_src[320 - tid] : -30000.f); }
  float m_reg = -10000.f, l_reg = 0; f32x16 o[4] = {};
  const bf16_t* Qw = Qb + (long)(wid * QBLK + r32) * LDQ + hi * 8;
  LAS char* qr = lds + OFF_OST + wid * 8192 + lane * 16;
#pragma unroll
  for (int d0 = 0; d0 < 8; ++d0) *reinterpret_cast<LAS bf16x8*>(qr + d0 * 1024) = *reinterpret_cast<const bf16x8*>(Qw + d0 * 16);
  const int sr = tid >> 4, sc = (tid & 15) * 8, vst0 = v_st(sr, sc), vst1 = v_st(32 + sr, sc);
  const int vb0 = (int)(unsigned)(uintptr_t)V_lds + v_rd_base(lane);
  struct { bf16x8 vs0, vs1, ks0, ks1; } sr_[1];
  const int pw = wid >> 1, qi = (wid & 1) * 32 + r32;
#define TROW(t) ((BAND ? (((kc0) + (t)) > 0 ? ((kc0) + (t)) : 0) : (t)) * KVBLK)
#define SLOAD(i, t) do { const long k0_ = TROW(t); sr_[i].vs0 = *reinterpret_cast<const bf16x8*>(&Vh[(k0_ + sr) * LDK + sc]); sr_[i].vs1 = *reinterpret_cast<const bf16x8*>(&Vh[(k0_ + 32 + sr) * LDK + sc]); \
    sr_[i].ks0 = *reinterpret_cast<const bf16x8*>(&Kh[(k0_ + sr) * LDK + sc]); sr_[i].ks1 = *reinterpret_cast<const bf16x8*>(&Kh[(k0_ + 32 + sr) * LDK + sc]); } while (0)
#define SWRITE(b, i) do { *(LAS bf16x8*)(V_lds + (b) * SHM_V + vst0) = sr_[i].vs0; *(LAS bf16x8*)(V_lds + (b) * SHM_V + vst1) = sr_[i].vs1; int kc_ = sc * 2; \
    *(LAS bf16x8*)(K_lds + (b) * SHM_K + KSWZ(sr, kc_)) = sr_[i].ks0; *(LAS bf16x8*)(K_lds + (b) * SHM_K + KSWZ(32 + sr, kc_)) = sr_[i].ks1; } while (0)
#define SWAIT() asm volatile("s_waitcnt vmcnt(0)" ::: "memory")
#define RESC(a) do { if (__any((a) < 1.f)) { if (hi == 0) al_l[r32] = (a); asm volatile("s_waitcnt lgkmcnt(0)" ::: "memory"); \
    _Pragma("unroll") for (int d = 0; d < 4; ++d) _Pragma("unroll") for (int r = 0; r < 16; ++r) o[d][r] *= al_l[crow(r, hi)]; } } while (0)
#define BPTR(t) ({ const int t_ = (t); const int dch = pw + 8 - t_; int kb_ = 192 - dch * 64 - qi + 4 * hi; kb_ = kb_ < 0 ? 0 : kb_; \
    if (dch < 0 || dch > 8 || (kc0) + t_ < 0) kb_ = 288; (const LAS float*)(btab + kb_); })
  f32x16 pA0, pA1, pB0, pB1; float mnA, mnB, alA, alB; bf16x8 pa0, pa1, pa2, pa3;
  constexpr int SE = 0, SO = 0;
  SLOAD(SE, 0); asm volatile("s_waitcnt vmcnt(0)" ::: "memory"); SWRITE(0, SE); __syncthreads();
  qkt<BAND>(pA0, pA1, K_lds, qr, r32, hi, BPTR(0)); partialSM(pA0, pA1, m_reg, mnA, alA);
  SLOAD(SO, 1);
  SWAIT(); SWRITE(1, SO); __syncthreads();
  for (int j = 1; j + 1 < NT; j += 2) {
    SBAR(); qkt<BAND>(pB0, pB1, K_lds + SHM_K, qr, r32, hi, BPTR(j));
    finishSM(pA0, pA1, alA, l_reg, pa0, pa1, pa2, pa3); SBAR();
    SLOAD(SO, j + 1); SBAR();
    pv_d0(o, vb0, pa0, pa1, pa2, pa3); partialSM(pB0, pB1, m_reg, mnB, alB);
    __syncthreads(); SWAIT(); SWRITE(0, SE);
    RESC(alB); __syncthreads();
    SBAR(); qkt<BAND>(pA0, pA1, K_lds, qr, r32, hi, BPTR(j + 1));
    finishSM(pB0, pB1, alB, l_reg, pa0, pa1, pa2, pa3); SBAR();
    SLOAD(SE, j + 2); SBAR();
    pv_d0(o, vb0 + SHM_V, pa0, pa1, pa2, pa3); partialSM(pA0, pA1, m_reg, mnA, alA);
    __syncthreads(); SWAIT(); SWRITE(1, SO);
    RESC(alA); __syncthreads();
  }
  SBAR(); qkt<BAND>(pB0, pB1, K_lds + SHM_K, qr, r32, hi, BPTR(NT - 1));
  finishSM(pA0, pA1, alA, l_reg, pa0, pa1, pa2, pa3); SBAR();
  pv_d0(o, vb0, pa0, pa1, pa2, pa3); partialSM(pB0, pB1, m_reg, mnB, alB);
  __syncthreads(); RESC(alB);
  finishSM(pB0, pB1, alB, l_reg, pa0, pa1, pa2, pa3); SBAR();
  pv_d0(o, vb0 + SHM_V, pa0, pa1, pa2, pa3);
  if (hi == 0) li_l[r32] = l_reg; asm volatile("s_waitcnt lgkmcnt(0)" ::: "memory");
  float rli[16];
#pragma unroll
  for (int r = 0; r < 16; ++r) rli[r] = __builtin_amdgcn_rcpf(li_l[crow(r, hi)]);
  { LAS bf16_t* stg = (LAS bf16_t*)(lds + OFF_OST + wid * 8192);
#pragma unroll
    for (int r = 0; r < 16; ++r) { const int orow = crow(r, hi);
#pragma unroll
      for (int d0 = 0; d0 < 4; ++d0) stg[orow * 128 + d0 * 32 + r32] = (bf16_t)f2bf(o[d0][r] * rli[r]); }
    asm volatile("s_waitcnt lgkmcnt(0)" ::: "memory");
    bf16_t* Ow = Ob + (long)(wid * QBLK) * LDO;
#pragma unroll
    for (int i = 0; i < 8; ++i) { const int row = i * 4 + (lane >> 4), ch = lane & 15; const u32x4 v = *(const LAS u32x4*)(stg + row * 128 + ch * 8); *(u32x4*)(Ow + (long)row * LDO + ch * 8) = v; } }
  __syncthreads();
#undef TROW
#undef SLOAD
#undef SWRITE
#undef SWAIT
#undef RESC
#undef BPTR
}
#undef KSWZ
#undef SBAR
}


namespace rt {
using f32x16 = __attribute__((ext_vector_type(16))) float;
#define RKSWZ(row, colB) ((row) * 256 + ((colB) ^ (((row) & 7) << 4)))
__device__ __forceinline__ int crow(int r, int hi) { return (r & 3) + 8 * (r >> 2) + 4 * hi; }
__device__ __forceinline__ void ce_desc(unsigned& a, unsigned& b) { const unsigned mx = a > b ? a : b, mn = a > b ? b : a; a = mx; b = mn; }
__device__ __forceinline__ void sort16_desc(unsigned (&v)[16]) {
#pragma unroll
  for (int k = 2; k <= 16; k <<= 1)
#pragma unroll
    for (int j = k >> 1; j > 0; j >>= 1)
#pragma unroll
      for (int i = 0; i < 16; ++i) { const int l = i ^ j; if (l > i) { if ((i & k) == 0) ce_desc(v[i], v[l]); else ce_desc(v[l], v[i]); } }
}
__device__ __forceinline__ void merge16_desc(unsigned (&a)[16], const unsigned (&b)[16]) {
#pragma unroll
  for (int i = 0; i < 16; ++i) a[i] = a[i] > b[15 - i] ? a[i] : b[15 - i];
#pragma unroll
  for (int j = 8; j > 0; j >>= 1)
#pragma unroll
    for (int i = 0; i < 16; ++i) { const int l = i ^ j; if (l > i) ce_desc(a[i], a[l]); }
}
__device__ __forceinline__ unsigned fkey(float f) { const unsigned u = __float_as_uint(f); return (u & 0x80000000u) ? ~u : (u | 0x80000000u); }
__device__ __forceinline__ float fkey_inv(unsigned k) { const unsigned u = (k & 0x80000000u) ? (k & 0x7fffffffu) : ~k; return __uint_as_float(u); }
__device__ __forceinline__ void top16_half(const f32x16 (&sc)[4], int hi, unsigned (&out)[16]) {
  unsigned g[16];
#pragma unroll
  for (int blk = 0; blk < 4; ++blk) {
#pragma unroll
    for (int r = 0; r < 16; ++r) g[r] = (fkey(sc[blk][r]) & 0xFFFFFF80u) | (unsigned)(32 * blk + (r & 3) + 8 * (r >> 2) + 4 * hi);
    sort16_desc(g);
    if (blk == 0) {
#pragma unroll
      for (int r = 0; r < 16; ++r) out[r] = g[r];
    } else merge16_desc(out, g);
  }
  unsigned pb[16];
#pragma unroll
  for (int r = 0; r < 16; ++r) { auto rr = __builtin_amdgcn_permlane32_swap(out[r], out[r], false, false); pb[r] = hi ? rr[0] : rr[1]; }
  merge16_desc(out, pb);
}
__device__ __forceinline__ void route_phase(const Params& p, LAS unsigned char* lds, int tid, int lane, int wave) {
  const bf16_t* Q = (const bf16_t*)(p.ws + WS_Q); const bf16_t* KB = (const bf16_t*)(p.ws + WS_KEYSB);
  int* RIDX = (int*)(p.ws + WS_RIDX); float* RG = (float*)(p.ws + WS_RG);
  const int h = blockIdx.x & 7, grp = blockIdx.x >> 3;
  const int r32 = lane & 31, hi = lane >> 5;
#pragma unroll
  for (int c = 0; c < 2; ++c)
#pragma unroll
    for (int rep = 0; rep < 4; ++rep) { const int row = rep * 32 + (tid >> 4), cb = (tid & 15) * 16;
      *(LAS u32x4*)(lds + c * 32768 + RKSWZ(row, cb)) = *(const u32x4*)((const char*)KB + ((size_t)(h * 2 + c) * 128 + row) * 256 + cb); }
  __syncthreads();
  for (int tb = grp * 8 + wave; tb < T / 32; tb += (int)(gridDim.x >> 3) * 8) {
    const int t = tb * 32 + r32;
    unsigned ka[16], kb2[16];
#pragma unroll
    for (int c = 0; c < 2; ++c) {
      bf16x8 qf[8];
      const bf16_t* qp = Q + (size_t)t * D + h * 256 + c * 128 + hi * 8;
#pragma unroll
      for (int ks = 0; ks < 8; ++ks) qf[ks] = *(const bf16x8*)(qp + ks * 16);
      f32x16 sc[4];
#pragma unroll
      for (int blk = 0; blk < 4; ++blk) { sc[blk] = f32x16{};
#pragma unroll
        for (int ks = 0; ks < 8; ++ks) { const bf16x8 kf = *(const LAS bf16x8*)(lds + c * 32768 + RKSWZ(32 * blk + r32, (16 * ks + 8 * hi) * 2));
          sc[blk] = __builtin_amdgcn_mfma_f32_32x32x16_bf16(kf, qf[ks], sc[blk], 0, 0, 0); } }
      if (c == 0) top16_half(sc, hi, ka); else top16_half(sc, hi, kb2);
    }
    float av[16], bv[16];
#pragma unroll
    for (int i = 0; i < 16; ++i) { av[i] = fkey_inv(ka[i] & 0xFFFFFF80u); bv[i] = fkey_inv(kb2[i] & 0xFFFFFF80u); }
    float T[16];
#pragma unroll
    for (int k = 0; k < 16; ++k) T[k] = -3.0e38f;
#pragma unroll
    for (int i = 0; i < 16; ++i)
#pragma unroll
      for (int j = 0; j < 16; ++j) if ((i + 1) * (j + 1) <= 16) { float v = av[i] + bv[j];
#pragma unroll
          for (int k = 0; k < 16; ++k) { const float mx = fmaxf(T[k], v); v = fminf(T[k], v); T[k] = mx; } }
    const float m = T[0], theta = T[15];
    float Z = 0.f;
#pragma unroll
    for (int k = 0; k < 16; ++k) Z += __expf(T[k] - m);
    const float rz = 1.f / Z;
    int slot = 0; int cn = 0;
    int* ip = RIDX + (size_t)t * 128 + h * 16; float* gp = RG + (size_t)t * 128 + h * 16;
#pragma unroll
    for (int i = 0; i < 16; ++i)
#pragma unroll
      for (int j = 0; j < 16; ++j) if ((i + 1) * (j + 1) <= 16) { const float v = av[i] + bv[j];
          const bool sel = (v >= theta) && (slot < 16);
          if (sel && ((cn & 1) == hi)) { ip[slot] = (int)((ka[i] & 127u) * 128u + (kb2[j] & 127u)); gp[slot] = __expf(v - m) * rz; }
          slot += sel ? 1 : 0; ++cn; }
  }
}
#undef RKSWZ
}

#define XB_TMO      128
#define XB_XCNT(j)  (256  + 64 * (j))
#define XB_XSUB(j)  (1280 + 64 * (j))
#define XB_XGEN(j)  (2304 + 64 * (j))
#define XB_TOP      3328
#define XB_TOPGEN   3392
#define XCD_BAR_WORDS 3456
#define XB_SPIN_CAP (1u << 22)
__device__ __forceinline__ unsigned xb_ld(unsigned* p)              { return __hip_atomic_load(p, __ATOMIC_RELAXED, __HIP_MEMORY_SCOPE_AGENT); }
__device__ __forceinline__ unsigned xb_add(unsigned* p, unsigned v) { return __hip_atomic_fetch_add(p, v, __ATOMIC_RELAXED, __HIP_MEMORY_SCOPE_AGENT); }
__device__ __forceinline__ unsigned xb_xcc_id() { return (unsigned)__builtin_amdgcn_s_getreg((3 << 11) | 20) & 0xFu; }
#define XB_SPIN(cond, bar) do { unsigned _sp = 0; while (cond) { __builtin_amdgcn_s_sleep(1); \
    if ((++_sp & 255u) == 0u) { if (xb_ld(&(bar)[XB_TMO])) break; if (_sp > XB_SPIN_CAP) { atomicAdd(&(bar)[XB_TMO], 1u); break; } } } } while (0)
struct XcdBarrier { unsigned* bar; unsigned x; volatile LAS unsigned* st; };
__device__ __forceinline__ XcdBarrier xcd_barrier_post(unsigned* bar, volatile LAS unsigned* st) {
    XcdBarrier b; b.bar = bar; b.x = xb_xcc_id(); b.st = st;
    if (threadIdx.x == 0) (void)xb_add(&bar[XB_XCNT(b.x)], 1u);
    return b;
}
__device__ __forceinline__ void xcd_barrier_complete(unsigned* bar, unsigned x, unsigned& nloc, unsigned& nx) {
    const unsigned G = gridDim.x * gridDim.y * gridDim.z;
    unsigned sum, cnt, mine, sp = 0u;
    for (;;) {
        sum = 0u; cnt = 0u; mine = 0u;
#pragma unroll
        for (unsigned j = 0; j < 16; ++j) { const unsigned c = xb_ld(&bar[XB_XCNT(j)]); sum += c; cnt += (c > 0u) ? 1u : 0u; mine = (j == x) ? c : mine; }
        if (sum == G) break;
        __builtin_amdgcn_s_sleep(1);
        if ((++sp & 255u) == 0u) { if (xb_ld(&bar[XB_TMO])) break; if (sp > XB_SPIN_CAP) { atomicAdd(&bar[XB_TMO], 1u); break; } }
    }
    nloc = mine > 0u ? mine : 1u; nx = cnt > 0u ? cnt : 1u;
}
__device__ __forceinline__ void xcd_barrier(const XcdBarrier& b) {
    asm volatile("s_waitcnt vmcnt(0)" ::: "memory");
    __syncthreads();
    if (threadIdx.x == 0) {
        unsigned* bar = b.bar;
        __builtin_amdgcn_s_waitcnt(0);
        unsigned nloc = b.st[0], nx = b.st[1];
        if (nloc == 0u) { xcd_barrier_complete(bar, b.x, nloc, nx); b.st[0] = nloc; b.st[1] = nx; }
        const unsigned old = xb_add(&bar[XB_XSUB(b.x)], 1u);
        const unsigned gen = old / nloc;
        if (old + 1u == (gen + 1u) * nloc) {
            __builtin_amdgcn_fence(__ATOMIC_RELEASE, "agent");
            asm volatile("s_waitcnt vmcnt(0)" ::: "memory");
            const unsigned og = xb_add(&bar[XB_TOP], 1u);
            const unsigned tg = og / nx;
            if (og + 1u == (tg + 1u) * nx) xb_add(&bar[XB_TOPGEN], 1u);
            else XB_SPIN(xb_ld(&bar[XB_TOPGEN]) == tg, bar);
            __builtin_amdgcn_fence(__ATOMIC_ACQUIRE, "agent");
            xb_add(&bar[XB_XGEN(b.x)], 1u);
            asm volatile("s_waitcnt vmcnt(0)" ::: "memory");
        } else {
            XB_SPIN(xb_ld(&bar[XB_XGEN(b.x)]) == gen, bar);
            __builtin_amdgcn_fence(__ATOMIC_ACQUIRE, "agent");
            asm volatile("s_waitcnt vmcnt(0)" ::: "memory");
        }
    }
    __syncthreads();
}
constexpr int RING_BYTES = 131072, MISC_OFF = 143360, LDS_BYTES = 147456, NTHREADS = 512;
static_assert(att::LDS_NEED <= MISC_OFF, "attention scratch below the MISC words");
constexpr size_t WS_SLAB = WS_X2BF;

#define PH_BEGIN(i) unsigned long long t0_##i = 0; if ((PROBE_MASK >> (i)) & 1) t0_##i = __builtin_amdgcn_s_memrealtime();
#define PH_END(i) if ((PROBE_MASK >> (i)) & 1) probe_acc += __builtin_amdgcn_s_memrealtime() - t0_##i;
__global__ void __launch_bounds__(NTHREADS, 2) fwd(Params p) {
    extern __shared__ __attribute__((aligned(16))) unsigned char lds_raw[];
    LAS unsigned char* lds = (LAS unsigned char*)lds_raw;
    volatile LAS unsigned* MISC = (volatile LAS unsigned*)(lds + MISC_OFF);
    const int tid = threadIdx.x, lane = tid & 63, wave = __builtin_amdgcn_readfirstlane(tid >> 6);
    const int nwb = NTHREADS / 64;
    const int gw = blockIdx.x * nwb + wave, NW = gridDim.x * nwb;
    const int Gd = gridDim.x, cb = blockIdx.x;
    unsigned char* ws = p.ws;
    bf16_t* WT_IN = (bf16_t*)(ws + WS_WT_IN); bf16_t* WT_GATE = (bf16_t*)(ws + WS_WT_GATE); bf16_t* WT_BR = (bf16_t*)(ws + WS_WT_BR);
    bf16_t* WT_O = (bf16_t*)(ws + WS_WT_O); bf16_t* WT_PQ = (bf16_t*)(ws + WS_WT_PQ); bf16_t* WT_MKV = (bf16_t*)(ws + WS_WT_MKV);
    bf16_t* KEYSB = (bf16_t*)(ws + WS_KEYSB); bf16_t* MEMN = (bf16_t*)(ws + WS_MEMN); bf16_t* MEMKV = (bf16_t*)(ws + WS_MEMKV);
    bf16_t* HO = (bf16_t*)(ws + WS_HO); bf16_t* PROJ = (bf16_t*)(ws + WS_PROJ); bf16_t* G = (bf16_t*)(ws + WS_G);
    bf16_t* MERGED = (bf16_t*)(ws + WS_MERGED); bf16_t* X2BF = (bf16_t*)(ws + WS_X2BF); bf16_t* QB = (bf16_t*)(ws + WS_Q);
        float* SS2 = (float*)(ws + WS_CTL + CTL_SS2_BYTE);
    if (tid < 64) MISC[tid] = 0u;
    __syncthreads();
    XcdBarrier bar = xcd_barrier_post((unsigned*)(ws + WS_CTL + CTL_BAR_BYTE), MISC + 8);
    if (tid == 0) MISC[16] = xb_add((unsigned*)(ws + WS_CTL + CTL_RANK_BYTE) + 64 * bar.x, 1u);

    unsigned long long probe_acc = 0;
    PH_BEGIN(0)
    {
        float* scr = (float*)lds_raw + wave * (64 * 33);
        const int I0 = (D / 64) * (INW / 32), I1 = I0 + (D / 64) * (GW / 32), I2 = I1 + (D / 64) * (D / 32), I3 = I2 + (D / 64) * (D / 32), I4 = I3 + (D / 64) * (D / 32), I5 = I4 + (D / 64) * (2 * CW / 32);
#define TRJOB(it, jb, li) do { if ((it) < I0) { jb = TrJob{p.in[3], WT_IN, nullptr, D, INW, 0.f}; li = (it); } else if ((it) < I1) { jb = TrJob{p.in[18], WT_GATE, nullptr, D, GW, GATE_WSCALE}; li = (it) - I0; } \
            else if ((it) < I2) { jb = TrJob{p.in[20], WT_BR, nullptr, D, D, 0.f}; li = (it) - I1; } else if ((it) < I3) { jb = TrJob{p.in[21], WT_O, nullptr, D, D, 0.f}; li = (it) - I2; } \
            else if ((it) < I4) { jb = TrJob{p.in[23], WT_PQ, p.in[22], D, D, 0.f}; li = (it) - I3; } else { jb = TrJob{p.in[15], WT_MKV, nullptr, D, 2 * CW, 0.f}; li = (it) - I4; } } while (0)
        for (int it = gw; it < I5; it += 2 * NW) {
            TrJob ja, jb2; int la, lb; f32x4 va[8], vb[8];
            TRJOB(it, ja, la); tr_load(ja, la, lane, va);
            const bool has2 = it + NW < I5;
            if (has2) { TRJOB(it + NW, jb2, lb); tr_load(jb2, lb, lane, vb); }
            tr_store(ja, la, lane, va, scr);
            if (has2) tr_store(jb2, lb, lane, vb, scr);
        }
#undef TRJOB
        rms_rows(p.in[0], p.in[2], HO, ws + WS_H8, T, gw, NW, lane);
        rms_rows(p.in[1], p.in[14], MEMN, nullptr, BATCH * NMEM, gw, NW, lane);
        const float* keys = p.in[24];
        for (int i = gw * 64 + lane; i < PH * 2 * NKEYS * 128 / 2; i += NW * 64) ((unsigned*)KEYSB)[i] = pk2(keys[2 * i], keys[2 * i + 1]);
    }
    xcd_barrier(bar);
    PH_END(0)
    PH_BEGIN(1)
    {
        SchedP1a Sa{(const char*)HO, (const char*)WT_IN, (const char*)MEMN, (const char*)WT_MKV, Gd, cb};
        EpiP1a Ea{PROJ, MEMKV};
        pg8::gemm_phase<false>(lds, D, D, Sa, Ea);
        SchedP1b Sb{(const char*)(ws + WS_H8), (const char*)WT_GATE, Gd, cb};
        EpiP1b Eb{G, p.in[19]};
        pg8::gemm_phase<true>(lds, D / 2, D / 2, Sb, Eb);
    }
    xcd_barrier(bar);
    PH_END(1)
    PH_BEGIN(2)
    {
        const float qscale = 0.08838834764831845f;
        { HeadGains hg; load_head_gains(hg, p.in[4], p.in[5], p.in[16], lane);
          for (int t = gw; t < T; t += NW) headnorm_token(PROJ + (size_t)t * INW, hg, qscale, lane); }
        for (int it = gw; it < BATCH * NMEM * 4; it += NW) { const int m = it / 4, j = it % 4; headnorm(MEMKV + (size_t)m * (2 * CW) + j * 128, p.in[17], 1.f, lane); }
        for (int u = gw; u < BATCH * NCH * 8; u += NW) { const int g = u % 8, c = (u / 8) % NCH, b = u / (8 * NCH); lru_pass1(p, b, c, g, lane, lds + wave * 8192); }
        fp4_tables(p, gw, NW, lane);
    }
    xcd_barrier(bar);
    PH_END(2)
    PH_BEGIN(3)
    {
        const int nA = BATCH * 8 * (NCH / 4), nC = BATCH * 4 * (SEQ / 256);
        PH_BEGIN(9)
        for (int u = cb; u < nA + nC; u += Gd) {
            if (u < nA) {
                const int cg = u % (NCH / 4), h = (u / (NCH / 4)) % 8, b = u / ((NCH / 4) * 8);
                const size_t brow = (size_t)b * SEQ, qrow = brow + (size_t)cg * 256;
                att::attn_body<INW, INW, D, true>(PROJ + qrow * INW + C_QA + h * 128, PROJ + brow * INW + C_KA + h * 128, PROJ + brow * INW + C_VA + h * 128,
                                                  HO + qrow * D + h * 128, 12, cg * 4 - NPREV, p.in[6] + h * 257, (LAS char*)lds);
            } else {
                const int v = u - nA; const int qb = v % (SEQ / 256), h = (v / (SEQ / 256)) % 4, b = v / ((SEQ / 256) * 4);
                const size_t qrow = (size_t)b * SEQ + (size_t)qb * 256;
                att::attn_body<INW, 2 * CW, D, false>(PROJ + qrow * INW + C_QC + h * 128, MEMKV + (size_t)b * NMEM * (2 * CW) + h * 128, MEMKV + (size_t)b * NMEM * (2 * CW) + CW + h * 128,
                                                     HO + qrow * D + AW + LW + h * 128, NMEM / 64, 0, nullptr, (LAS char*)lds);
            }
        }
        PH_END(9)
        PH_BEGIN(10)
        for (int u = gw; u < BATCH * NCH * 8; u += NW) { const int g = u % 8, c = (u / 8) % NCH, b = u / (8 * NCH); lru_pass2(p, b, c, g, lane); }
        PH_END(10)
    }
    xcd_barrier(bar);
    PH_END(3)
    PH_BEGIN(4)
    {
        SchedP3 S{(const char*)HO, (const char*)WT_BR, Gd, cb};
        EpiP3 E{G, MERGED};
        pg8::gemm_phase<false>(lds, D, D, S, E);
    }
    xcd_barrier(bar);
    PH_END(4)
    PH_BEGIN(5)
    {
        SchedSq S{(const char*)MERGED, (const char*)WT_O, Gd, cb};
        EpiP4 E{p.in[0], p.out, X2BF, SS2, ws + WS_X2F8};
        pg8::gemm_phase<false>(lds, D, D, S, E);
    }
    xcd_barrier(bar);
    PH_END(5)
    PH_BEGIN(6)
    {
        SchedSq S{(const char*)X2BF, (const char*)WT_PQ, Gd, cb};
        EpiP5 E{QB, SS2};
        pg8::gemm_phase<false>(lds, D, D, S, E);
    }
    xcd_barrier(bar);
    PH_END(6)
    PH_BEGIN(7)
    rt::route_phase(p, lds, tid, lane, wave);
    xcd_barrier(bar);
    PH_END(7)
    PH_BEGIN(8)
    int ppos, pnx, prank, pnloc;
    { if (tid == 0) { unsigned pos = 0, nx = 0; const unsigned* bw = (const unsigned*)(ws + WS_CTL + CTL_BAR_BYTE);
#pragma unroll
          for (unsigned j = 0; j < 16; ++j) { const unsigned cj = xb_ld((unsigned*)&bw[XB_XCNT(j)]); nx += cj > 0u ? 1u : 0u; pos += (cj > 0u && j < bar.x) ? 1u : 0u; }
          MISC[17] = pos; MISC[18] = nx > 0u ? nx : 1u; }
      __syncthreads();
      ppos = (int)MISC[17]; pnx = (int)MISC[18]; prank = (int)MISC[16]; pnloc = (int)MISC[8]; if (pnloc < 1) pnloc = 1; }
    peer_u_step(p, lane, wave, lds + wave * 16384, ppos, pnx, prank, pnloc);
    xcd_barrier(bar);
    for (int t = gw; t < T; t += NW) peer_combine(p, t, lane);
    xcd_barrier(bar);
    peer_v_step(p, lane, wave, lds + wave * 16384, ppos, pnx, prank, pnloc);
    if (PROBE_MASK) { __syncthreads(); PH_END(8) const unsigned long long te = __builtin_amdgcn_s_memrealtime(); while (__builtin_amdgcn_s_memrealtime() - te < probe_acc) __builtin_amdgcn_s_sleep(8); }
}

extern "C" void kernel_launch(void* const* d_in, const int* in_sizes, int n_in, void* d_out, int out_size, void* d_ws, size_t ws_size, hipStream_t stream) {
    static int grid = 0;
    if (grid == 0) {
        if (n_in != 27 || out_size != T * D || ws_size < WS_END) { fprintf(stderr, "kernel_launch: unexpected problem (n_in %d out %d ws %zu)\n", n_in, out_size, ws_size); grid = -1; return; }
        int dev = 0, cus = 0, per_cu = 0;
        (void)hipGetDevice(&dev); (void)hipDeviceGetAttribute(&cus, hipDeviceAttributeMultiprocessorCount, dev);
        if (hipFuncSetAttribute((const void*)fwd, hipFuncAttributeMaxDynamicSharedMemorySize, LDS_BYTES) != hipSuccess) { fprintf(stderr, "kernel_launch: hipFuncSetAttribute failed\n"); grid = -1; return; }
        (void)hipOccupancyMaxActiveBlocksPerMultiprocessor(&per_cu, (const void*)fwd, NTHREADS, LDS_BYTES);
        if (per_cu < 1) { fprintf(stderr, "kernel_launch: occupancy query says %d\n", per_cu); grid = -1; return; }
        grid = cus;
    }
    if (grid < 0) return;
    (void)hipMemsetAsync((char*)d_ws + WS_CTL, 0, 1 * MiB, stream);
    Params p{};
    for (int i = 0; i < 27; ++i) p.in[i] = (const float*)d_in[i];
    p.out = (float*)d_out; p.ws = (unsigned char*)d_ws;
    void* args[] = {&p};
    hipError_t e = hipLaunchCooperativeKernel((const void*)fwd, dim3(grid), dim3(NTHREADS), args, LDS_BYTES, stream);
    if (e != hipSuccess) fprintf(stderr, "cooperative launch failed: %s (grid %d)\n", hipGetErrorString(e), grid);
}
```

```cpp
#include <hip/hip_runtime.h>
#include <hip/hip_cooperative_groups.h>
#include <cstdio>
#include <cstdint>
namespace cg = cooperative_groups;
#ifndef PROBE_MASK
#define PROBE_MASK 0
#endif

#define LAS __attribute__((address_space(3)))
typedef unsigned short bf16_t;
typedef short bf16x8 __attribute__((ext_vector_type(8)));
typedef float f32x4 __attribute__((ext_vector_type(4)));
typedef unsigned u32x4 __attribute__((ext_vector_type(4)));
typedef unsigned u32x2 __attribute__((ext_vector_type(2)));

constexpr int D = 2048, BATCH = 2, SEQ = 8192, T = BATCH * SEQ;
constexpr int CHUNK = 64, NPREV = 8, NCH = SEQ / CHUNK;
constexpr int AW = 1024, LW = 512, CW = 512, INW = 4608, GW = 6144;
constexpr int NMEM = 256;
constexpr int PH = 8, NKEYS = 128, TOPK = 16;
constexpr float EPS = 1e-6f;
constexpr int C_QA = 0, C_KA = 1024, C_VA = 2048, C_XL = 3072, C_GL = 3584, C_QC = 4096;

constexpr size_t MiB = 1u << 20;
constexpr size_t WS_CTL = 0;
constexpr size_t WS_WT_IN = 2 * MiB, WS_WT_GATE = 20 * MiB, WS_WT_BR = 44 * MiB, WS_WT_O = 52 * MiB, WS_WT_PQ = 60 * MiB, WS_WT_MKV = 68 * MiB;
constexpr size_t WS_KEYSB = 72 * MiB, WS_MEMN = 73 * MiB, WS_MEMKV = 75 * MiB, WS_LRUSUM = 76 * MiB, WS_RS2 = 77 * MiB;
constexpr size_t WS_HO = 80 * MiB;
constexpr size_t WS_PROJ = 144 * MiB;
constexpr size_t WS_MERGED = 144 * MiB, WS_X2BF = 208 * MiB;
constexpr size_t WS_G = 288 * MiB;
constexpr size_t WS_TABU = 496 * MiB, WS_TABV = 512 * MiB, WS_Q = 416 * MiB;
constexpr size_t WS_SCU = 77 * MiB, WS_SCV = 77 * MiB + 65536;
constexpr size_t WS_AUA = 2 * MiB, WS_AUU = 18 * MiB;
constexpr size_t WS_H8 = 496 * MiB;
constexpr float GATE_WSCALE = 256.f;
constexpr size_t WS_RIDX = 480 * MiB, WS_RG = 488 * MiB, WS_END = 528 * MiB;

constexpr size_t CTL_BAR_BYTE = 16384, CTL_RANK_BYTE = 65536, CTL_SS2_BYTE = 512 * 1024;
struct Params { const float* in[27]; float* out; unsigned char* ws; };

__device__ __forceinline__ float bf2f(unsigned v16) { return __uint_as_float(v16 << 16); }
__device__ __forceinline__ unsigned f2bf(float f) { unsigned u = __float_as_uint(f); return (u + 0x7fffu + ((u >> 16) & 1u)) >> 16; }
__device__ __forceinline__ unsigned pk2(float lo, float hi) { return f2bf(lo) | (f2bf(hi) << 16); }
__device__ __forceinline__ float wave_sum(float v) {
#pragma unroll
    for (int o = 1; o < 64; o <<= 1) v += __shfl_xor(v, o);
    return v;
}
typedef __bf16 bf16x2_t __attribute__((ext_vector_type(2)));
__device__ __forceinline__ float dot2bf(unsigned w, unsigned x, float acc) { return __builtin_amdgcn_fdot2_f32_bf16(__builtin_bit_cast(bf16x2_t, w), __builtin_bit_cast(bf16x2_t, x), acc, false); }
__device__ __forceinline__ float sigmoid_(float x) { return 1.f / (1.f + __expf(-x)); }
__device__ __forceinline__ float gelu_tanh(float x) { const float y = 1.5957691216f * (x + 0.044715f * x * x * x); return x / (1.f + __expf(-y)); }
__device__ __forceinline__ void unpack8(const u32x4 w, float* f) {
    f[0] = __uint_as_float(w.x << 16); f[1] = __uint_as_float(w.x & 0xffff0000u);
    f[2] = __uint_as_float(w.y << 16); f[3] = __uint_as_float(w.y & 0xffff0000u);
    f[4] = __uint_as_float(w.z << 16); f[5] = __uint_as_float(w.z & 0xffff0000u);
    f[6] = __uint_as_float(w.w << 16); f[7] = __uint_as_float(w.w & 0xffff0000u);
}

struct TrJob { const float* W; bf16_t* WT; const float* ks; int K, N; float f8scale; };
__device__ __forceinline__ void tr_load(const TrJob& jb, int item, int lane, f32x4 (&v)[8]) {
    const int nblk = jb.N / 32, kb = item / nblk, nb = item % nblk, k0 = 64 * kb, n0 = 32 * nb;
#pragma unroll
    for (int i = 0; i < 8; ++i) { const int kk = 8 * i + (lane >> 3); v[i] = *(const f32x4*)(jb.W + (size_t)(k0 + kk) * jb.N + n0 + 4 * (lane & 7)); if (jb.ks) v[i] = v[i] * jb.ks[k0 + kk]; }
}
__device__ __forceinline__ void tr_store(const TrJob& jb, int item, int lane, const f32x4 (&v)[8], float* scr) {
    const int nblk = jb.N / 32, kb = item / nblk, nb = item % nblk, k0 = 64 * kb, n0 = 32 * nb;
#pragma unroll
    for (int i = 0; i < 8; ++i) { float* d = scr + (8 * i + (lane >> 3)) * 33 + 4 * (lane & 7); d[0] = v[i].x; d[1] = v[i].y; d[2] = v[i].z; d[3] = v[i].w; }
    asm volatile("s_waitcnt lgkmcnt(0)" ::: "memory");
    const int c = lane & 7;
#pragma unroll
    for (int j = 0; j < 4; ++j) { const int n = (lane >> 3) + 8 * j; const float* s = scr + (8 * c) * 33 + n;
        if (jb.f8scale != 0.f) { const float f = jb.f8scale; u32x2 o;
            int w = __builtin_amdgcn_cvt_pk_fp8_f32(s[0 * 33] * f, s[1 * 33] * f, 0, false); w = __builtin_amdgcn_cvt_pk_fp8_f32(s[2 * 33] * f, s[3 * 33] * f, w, true); o.x = (unsigned)w;
            w = __builtin_amdgcn_cvt_pk_fp8_f32(s[4 * 33] * f, s[5 * 33] * f, 0, false); w = __builtin_amdgcn_cvt_pk_fp8_f32(s[6 * 33] * f, s[7 * 33] * f, w, true); o.y = (unsigned)w;
            *(u32x2*)((unsigned char*)jb.WT + (size_t)(n0 + n) * jb.K + k0 + 8 * c) = o; }
        else { u32x4 o; o.x = pk2(s[0 * 33], s[1 * 33]); o.y = pk2(s[2 * 33], s[3 * 33]); o.z = pk2(s[4 * 33], s[5 * 33]); o.w = pk2(s[6 * 33], s[7 * 33]);
            *(u32x4*)(jb.WT + (size_t)(n0 + n) * jb.K + k0 + 8 * c) = o; } }
    asm volatile("s_waitcnt lgkmcnt(0)" ::: "memory");
}
__device__ __forceinline__ void rms_row_load(const float* xrow, int lane, f32x4 (&v)[8]) {
    const f32x4* xr = (const f32x4*)xrow + lane;
#pragma unroll
    for (int j = 0; j < 8; ++j) v[j] = xr[64 * j];
}
__device__ __forceinline__ void rms_row_finish(const f32x4 (&v)[8], const float* g, bf16_t* orow, unsigned char* o8row, int lane) {
    const f32x4* gr = (const f32x4*)g + lane; float s = 0.f;
#pragma unroll
    for (int j = 0; j < 8; ++j) s += (v[j].x * v[j].x + v[j].y * v[j].y) + (v[j].z * v[j].z + v[j].w * v[j].w);
    const float rstd = rsqrtf(wave_sum(s) * (1.f / D) + EPS);
    u32x2* o8 = (u32x2*)orow + lane;
#pragma unroll
    for (int j = 0; j < 8; ++j) { const f32x4 gg = gr[64 * j]; const float a0 = v[j].x * rstd * gg.x, a1 = v[j].y * rstd * gg.y, a2 = v[j].z * rstd * gg.z, a3 = v[j].w * rstd * gg.w;
        u32x2 o; o.x = pk2(a0, a1); o.y = pk2(a2, a3); o8[64 * j] = o;
        if (o8row) { int w = __builtin_amdgcn_cvt_pk_fp8_f32(fminf(fmaxf(a0, -448.f), 448.f), fminf(fmaxf(a1, -448.f), 448.f), 0, false);
            w = __builtin_amdgcn_cvt_pk_fp8_f32(fminf(fmaxf(a2, -448.f), 448.f), fminf(fmaxf(a3, -448.f), 448.f), w, true); ((unsigned*)o8row)[64 * j + lane] = (unsigned)w; } }
}
__device__ __forceinline__ void rms_rows(const float* X, const float* g, bf16_t* O, unsigned char* O8, int nrows, int gw, int NW, int lane) {
    f32x4 va[8], vb[8];
    int m = gw;
    if (m < nrows) rms_row_load(X + (size_t)m * D, lane, va);
    for (; m < nrows; m += 2 * NW) {
        const bool hb = m + NW < nrows;
        if (hb) rms_row_load(X + (size_t)(m + NW) * D, lane, vb);
        rms_row_finish(va, g, O + (size_t)m * D, O8 ? O8 + (size_t)m * D : nullptr, lane);
        if (m + 2 * NW < nrows) rms_row_load(X + (size_t)(m + 2 * NW) * D, lane, va);
        if (hb) rms_row_finish(vb, g, O + (size_t)(m + NW) * D, O8 ? O8 + (size_t)(m + NW) * D : nullptr, lane);
    }
}

template <int TM, int TN, class Epi>
__device__ __forceinline__ void gemm_simple(const bf16_t* __restrict__ A, int lda, const bf16_t* __restrict__ Bt, int ldb, int M, int N, int K, const Epi& epi, int gw, int NW, int lane) {
    const int r = lane & 15, q = lane >> 4;
    const int ntm = M / (16 * TM), ntn = N / (16 * TN);
    for (int tile = gw; tile < ntm * ntn; tile += NW) {
        const int tm = tile / ntn, tn = tile % ntn;
        f32x4 acc[TM][TN];
#pragma unroll
        for (int i = 0; i < TM; ++i)
#pragma unroll
            for (int j = 0; j < TN; ++j) acc[i][j] = (f32x4){0.f, 0.f, 0.f, 0.f};
        const bf16_t* ap = A + (size_t)(tm * 16 * TM + r) * lda + q * 8;
        const bf16_t* bp = Bt + (size_t)(tn * 16 * TN + r) * ldb + q * 8;
        for (int k0 = 0; k0 < K; k0 += 32) {
            bf16x8 af[TM], bfr[TN];
#pragma unroll
            for (int i = 0; i < TM; ++i) af[i] = *(const bf16x8*)(ap + (size_t)i * 16 * lda + k0);
#pragma unroll
            for (int j = 0; j < TN; ++j) bfr[j] = *(const bf16x8*)(bp + (size_t)j * 16 * ldb + k0);
#pragma unroll
            for (int i = 0; i < TM; ++i)
#pragma unroll
                for (int j = 0; j < TN; ++j) acc[i][j] = __builtin_amdgcn_mfma_f32_16x16x32_bf16(af[i], bfr[j], acc[i][j], 0, 0, 0);
        }
#pragma unroll
        for (int i = 0; i < TM; ++i)
#pragma unroll
            for (int j = 0; j < TN; ++j)
#pragma unroll
                for (int e = 0; e < 4; ++e) epi(tm * 16 * TM + i * 16 + q * 4 + e, tn * 16 * TN + j * 16 + r, acc[i][j][e]);
    }
}
struct EpiProj { bf16_t* P; __device__ __forceinline__ void operator()(int row, int col, float v) const { if (col >= C_GL && col < C_QC) v = gelu_tanh(v); P[(size_t)row * INW + col] = (bf16_t)f2bf(v); } };
struct EpiGate { bf16_t* G; const float* b; __device__ __forceinline__ void operator()(int row, int col, float v) const { G[(size_t)row * GW + col] = (bf16_t)f2bf(sigmoid_(v + b[col])); } };
struct EpiStore { bf16_t* C; int ldc; __device__ __forceinline__ void operator()(int row, int col, float v) const { C[(size_t)row * ldc + col] = (bf16_t)f2bf(v); } };
struct EpiWo { const float* x; float* out; bf16_t* xb; __device__ __forceinline__ void operator()(int row, int col, float v) const { const size_t o = (size_t)row * D + col; const float y = x[o] + v; out[o] = y; xb[o] = (bf16_t)f2bf(y); } };
struct EpiQ { bf16_t* Q; const float* rs; __device__ __forceinline__ void operator()(int row, int col, float v) const { Q[(size_t)row * D + col] = (bf16_t)f2bf(v * rs[row]); } };

__device__ __forceinline__ void headnorm(bf16_t* vec, const float* g, float scale, int lane) {
    unsigned* p = (unsigned*)vec + lane; const unsigned w = *p;
    const float a = bf2f(w & 0xffffu), b = bf2f(w >> 16);
    const float rs = rsqrtf(wave_sum(a * a + b * b) * (1.f / 128.f) + EPS) * scale;
    *p = pk2(a * rs * g[2 * lane], b * rs * g[2 * lane + 1]);
}
struct HeadGains { float gq[32], gk[32], gc[8]; };
__device__ __forceinline__ void load_head_gains(HeadGains& hg, const float* gq, const float* gk, const float* gc, int lane) {
#pragma unroll
    for (int j = 0; j < 32; ++j) { hg.gq[j] = gq[(lane & 3) * 32 + j]; hg.gk[j] = gk[(lane & 3) * 32 + j]; }
#pragma unroll
    for (int j = 0; j < 8; ++j) hg.gc[j] = gc[(lane & 15) * 8 + j];
}
__device__ __forceinline__ void headnorm_token(bf16_t* row, const HeadGains& hg, float qscale, int lane) {
    u32x4* pa = (u32x4*)(row + C_QA) + lane * 4;
    u32x4* pc = (u32x4*)(row + C_QC) + lane;
    u32x4 w[4]; const u32x4 wc = *pc;
#pragma unroll
    for (int j = 0; j < 4; ++j) w[j] = pa[j];
    float f[32], fc[8]; float ss = 0.f, sc = 0.f;
#pragma unroll
    for (int j = 0; j < 4; ++j) unpack8(w[j], f + 8 * j);
    unpack8(wc, fc);
#pragma unroll
    for (int j = 0; j < 32; ++j) ss = fmaf(f[j], f[j], ss);
#pragma unroll
    for (int j = 0; j < 8; ++j) sc = fmaf(fc[j], fc[j], sc);
    ss += __shfl_xor(ss, 1); ss += __shfl_xor(ss, 2);
    sc += __shfl_xor(sc, 1); sc += __shfl_xor(sc, 2); sc += __shfl_xor(sc, 4); sc += __shfl_xor(sc, 8);
    const bool isq = lane < 32;
    const float rs = rsqrtf(ss * (1.f / 128.f) + EPS) * (isq ? qscale : 1.f), rc = rsqrtf(sc * (1.f / 128.f) + EPS) * qscale;
#pragma unroll
    for (int j = 0; j < 4; ++j) { u32x4 o;
        o.x = pk2(f[8 * j] * rs * (isq ? hg.gq[8 * j] : hg.gk[8 * j]), f[8 * j + 1] * rs * (isq ? hg.gq[8 * j + 1] : hg.gk[8 * j + 1]));
        o.y = pk2(f[8 * j + 2] * rs * (isq ? hg.gq[8 * j + 2] : hg.gk[8 * j + 2]), f[8 * j + 3] * rs * (isq ? hg.gq[8 * j + 3] : hg.gk[8 * j + 3]));
        o.z = pk2(f[8 * j + 4] * rs * (isq ? hg.gq[8 * j + 4] : hg.gk[8 * j + 4]), f[8 * j + 5] * rs * (isq ? hg.gq[8 * j + 5] : hg.gk[8 * j + 5]));
        o.w = pk2(f[8 * j + 6] * rs * (isq ? hg.gq[8 * j + 6] : hg.gk[8 * j + 6]), f[8 * j + 7] * rs * (isq ? hg.gq[8 * j + 7] : hg.gk[8 * j + 7]));
        pa[j] = o; }
    { u32x4 o; o.x = pk2(fc[0] * rc * hg.gc[0], fc[1] * rc * hg.gc[1]); o.y = pk2(fc[2] * rc * hg.gc[2], fc[3] * rc * hg.gc[3]);
      o.z = pk2(fc[4] * rc * hg.gc[4], fc[5] * rc * hg.gc[5]); o.w = pk2(fc[6] * rc * hg.gc[6], fc[7] * rc * hg.gc[7]); *pc = o; }
}

__device__ __forceinline__ void lru_pass1(const Params& p, int b, int c, int g, int lane, LAS unsigned char* wl  ) {
    const bf16_t* PROJ = (const bf16_t*)(p.ws + WS_PROJ);
    float* SUMA = (float*)(p.ws + WS_LRUSUM); float* SUMB = SUMA + BATCH * NCH * LW;
    bf16_t* AUA = (bf16_t*)(p.ws + WS_AUA); bf16_t* AUU = (bf16_t*)(p.ws + WS_AUU);
    const float* conv_w = p.in[7]; const float* conv_b = p.in[8]; const float* lru_wa = p.in[9]; const float* lru_ba = p.in[10];
    const float* lru_wx = p.in[11]; const float* lru_bx = p.in[12]; const float* lam = p.in[13];
    const int ch = g * 64 + lane;
    unsigned wa_p[32], wx_p[32];
#pragma unroll
    for (int m = 0; m < 32; ++m) { wa_p[m] = pk2(lru_wa[(size_t)(g * 64 + 2 * m) * 64 + lane], lru_wa[(size_t)(g * 64 + 2 * m + 1) * 64 + lane]);
        wx_p[m] = pk2(lru_wx[(size_t)(g * 64 + 2 * m) * 64 + lane], lru_wx[(size_t)(g * 64 + 2 * m + 1) * 64 + lane]); }
    const float cw0 = conv_w[0 * LW + ch], cw1 = conv_w[1 * LW + ch], cw2 = conv_w[2 * LW + ch], cw3 = conv_w[3 * LW + ch], cb = conv_b[ch];
    const float ba_ = lru_ba[ch], bx_ = lru_bx[ch];
    const float sp = log1pf(__expf(-lam[ch]));
    const int t0 = c * CHUNK; const size_t row0 = (size_t)b * SEQ + t0;
    float x0 = 0.f, x1 = 0.f, x2 = 0.f;
    if (t0 >= 3) { x0 = bf2f(PROJ[(row0 - 3) * INW + C_XL + ch]); x1 = bf2f(PROJ[(row0 - 2) * INW + C_XL + ch]); x2 = bf2f(PROJ[(row0 - 1) * INW + C_XL + ch]); }
    { const bf16_t* xs = PROJ + (row0 + (lane >> 3)) * INW + C_XL + g * 64 + (lane & 7) * 8;
      u32x4 tx[8];
#pragma unroll
      for (int i = 0; i < 8; ++i) tx[i] = *(const u32x4*)(xs + (size_t)(8 * i) * INW);
#pragma unroll
      for (int i = 0; i < 8; ++i) *(LAS u32x4*)(wl + (8 * i + (lane >> 3)) * 128 + (lane & 7) * 16) = tx[i]; }
    float h = 0.f, aprod = 1.f;
#define LRU_PAIRX(xc_) ({ const float xnb_ = __int_as_float(__builtin_amdgcn_update_dpp(0, __float_as_int(xc_), 0xB1, 0xf, 0xf, true));     \
        (lane & 1) ? pk2(xnb_, xc_) : pk2(xc_, xnb_); })
#define LRU_GATE(rp_, ip_, xc_, a_, u_) do { const float r_ = sigmoid_(rp_), ig_ = sigmoid_(ip_); const float la_ = -8.f * r_ * sp; a_ = __expf(la_); \
        u_ = sqrtf(fminf(fmaxf((1.f - a_) * (1.f + a_), 1e-12f), 1.f)) * ig_ * xc_; } while (0)
#pragma unroll 1
    for (int t = 0; t < CHUNK; t += 2) {
        const float x3 = bf2f(*(const LAS bf16_t*)(wl + t * 128 + lane * 2)), x4 = bf2f(*(const LAS bf16_t*)(wl + (t + 1) * 128 + lane * 2));
        const float xcA = cw0 * x0 + cw1 * x1 + cw2 * x2 + cw3 * x3 + cb, xcB = cw0 * x1 + cw1 * x2 + cw2 * x3 + cw3 * x4 + cb;
        x0 = x2; x1 = x3; x2 = x4;
        const unsigned pkA = LRU_PAIRX(xcA), pkB = LRU_PAIRX(xcB);
        float rA = ba_, iA = bx_, rA2 = 0.f, iA2 = 0.f, rB = ba_, iB = bx_, rB2 = 0.f, iB2 = 0.f;
#pragma unroll
        for (int m = 0; m < 32; m += 2) {
            const unsigned a0 = (unsigned)__builtin_amdgcn_readlane((int)pkA, 2 * m), a1 = (unsigned)__builtin_amdgcn_readlane((int)pkA, 2 * m + 2);
            const unsigned b0 = (unsigned)__builtin_amdgcn_readlane((int)pkB, 2 * m), b1 = (unsigned)__builtin_amdgcn_readlane((int)pkB, 2 * m + 2);
            rA = dot2bf(wa_p[m], a0, rA); iA = dot2bf(wx_p[m], a0, iA); rA2 = dot2bf(wa_p[m + 1], a1, rA2); iA2 = dot2bf(wx_p[m + 1], a1, iA2);
            rB = dot2bf(wa_p[m], b0, rB); iB = dot2bf(wx_p[m], b0, iB); rB2 = dot2bf(wa_p[m + 1], b1, rB2); iB2 = dot2bf(wx_p[m + 1], b1, iB2); }
        float aA, uA, aB, uB;
        LRU_GATE(rA + rA2, iA + iA2, xcA, aA, uA); LRU_GATE(rB + rB2, iB + iB2, xcB, aB, uB);
        const unsigned wA = f2bf(1.f - aA), wB = f2bf(1.f - aB), vA = f2bf(uA), vB = f2bf(uB);
        AUA[(row0 + t) * LW + ch] = (bf16_t)wA; AUA[(row0 + t + 1) * LW + ch] = (bf16_t)wB; AUU[(row0 + t) * LW + ch] = (bf16_t)vA; AUU[(row0 + t + 1) * LW + ch] = (bf16_t)vB;
        const float aAq = 1.f - bf2f(wA), aBq = 1.f - bf2f(wB);
        h = aBq * (aAq * h + bf2f(vA)) + bf2f(vB);
        aprod *= aAq * aBq;
    }
#undef LRU_PAIRX
#undef LRU_GATE
    { const size_t o = (size_t)(b * NCH + c) * LW + ch; SUMA[o] = aprod; SUMB[o] = h; }
}
__device__ __forceinline__ void lru_pass2(const Params& p, int b, int c, int g, int lane) {
    const bf16_t* PROJ = (const bf16_t*)(p.ws + WS_PROJ); bf16_t* O = (bf16_t*)(p.ws + WS_HO);
    const float* SUMA = (const float*)(p.ws + WS_LRUSUM); const float* SUMB = SUMA + BATCH * NCH * LW;
    const bf16_t* AUA = (const bf16_t*)(p.ws + WS_AUA); const bf16_t* AUU = (const bf16_t*)(p.ws + WS_AUU);
    const int ch = g * 64 + lane; const size_t row0 = (size_t)b * SEQ + (size_t)c * CHUNK;
    const bf16_t* ap = AUA + row0 * LW + ch; const bf16_t* up = AUU + row0 * LW + ch; const bf16_t* gp = PROJ + row0 * INW + C_GL + ch;
    bf16_t an[16], un[16], gn[16];
#pragma unroll
    for (int q = 0; q < 16; ++q) { an[q] = ap[(size_t)q * LW]; un[q] = up[(size_t)q * LW]; gn[q] = gp[(size_t)q * INW]; }
    float h = 0.f;
    {
        int j = 0;
#pragma unroll 1
        for (; j + 32 <= c; j += 32) { float sa[32], sb[32];
#pragma unroll
            for (int q = 0; q < 32; ++q) { const size_t o = (size_t)(b * NCH + j + q) * LW + ch; sa[q] = SUMA[o]; sb[q] = SUMB[o]; }
#pragma unroll
            for (int q = 0; q < 32; ++q) h = sa[q] * h + sb[q]; }
#pragma unroll 1
        for (; j + 8 <= c; j += 8) { float sa[8], sb[8];
#pragma unroll
            for (int q = 0; q < 8; ++q) { const size_t o = (size_t)(b * NCH + j + q) * LW + ch; sa[q] = SUMA[o]; sb[q] = SUMB[o]; }
#pragma unroll
            for (int q = 0; q < 8; ++q) h = sa[q] * h + sb[q]; }
        for (; j < c; ++j) { const size_t o = (size_t)(b * NCH + j) * LW + ch; h = SUMA[o] * h + SUMB[o]; }
    }
#pragma unroll 1
    for (int tb = 0; tb < CHUNK; tb += 16) {
        bf16_t ac[16], uc[16], gc[16];
#pragma unroll
        for (int q = 0; q < 16; ++q) { ac[q] = an[q]; uc[q] = un[q]; gc[q] = gn[q]; }
        if (tb + 16 < CHUNK) {
#pragma unroll
            for (int q = 0; q < 16; ++q) { an[q] = ap[(size_t)(tb + 16 + q) * LW]; un[q] = up[(size_t)(tb + 16 + q) * LW]; gn[q] = gp[(size_t)(tb + 16 + q) * INW]; }
        }
#pragma unroll
        for (int q = 0; q < 16; ++q) { h = (1.f - bf2f(ac[q])) * h + bf2f(uc[q]); O[(row0 + tb + q) * D + AW + ch] = (bf16_t)f2bf(h * bf2f(gc[q])); }
    }
}

__device__ __forceinline__ void attn_simple(const bf16_t* Qp, int ldq, const bf16_t* Kp, const bf16_t* Vp, int ldkv, int nkeys, int koff, const float* bias_h, bf16_t* Op, int ldo, int tid) {
    const int qi = tid >> 2, part = tid & 3;
    float q[32], o[32];
    { const u32x4* qp = (const u32x4*)(Qp + (size_t)qi * ldq + part * 32);
#pragma unroll
      for (int j = 0; j < 4; ++j) unpack8(qp[j], q + 8 * j); }
#pragma unroll
    for (int d = 0; d < 32; ++d) o[d] = 0.f;
    float m = -1e30f, l = 0.f;
    for (int kk0 = 0; kk0 < nkeys; kk0 += 8) {
        float s[8];
#pragma unroll
        for (int j = 0; j < 8; ++j) {
            const u32x4* kp = (const u32x4*)(Kp + (size_t)(kk0 + j) * ldkv + part * 32);
            float acc = 0.f;
#pragma unroll
            for (int w = 0; w < 4; ++w) { float kf[8]; unpack8(kp[w], kf);
#pragma unroll
                for (int e = 0; e < 8; ++e) acc = fmaf(q[8 * w + e], kf[e], acc); }
            acc += __shfl_xor(acc, 1); acc += __shfl_xor(acc, 2);
            if (bias_h) { int dist = qi + koff - (kk0 + j); dist = dist < -128 ? -128 : (dist > 128 ? 128 : dist); acc += bias_h[dist + 128]; }
            s[j] = acc;
        }
        float mx = s[0];
#pragma unroll
        for (int j = 1; j < 8; ++j) mx = fmaxf(mx, s[j]);
        const float mn = fmaxf(m, mx), corr = __expf(m - mn);
        l *= corr;
#pragma unroll
        for (int d = 0; d < 32; ++d) o[d] *= corr;
#pragma unroll
        for (int j = 0; j < 8; ++j) {
            const float pj = __expf(s[j] - mn); l += pj;
            const u32x4* vp = (const u32x4*)(Vp + (size_t)(kk0 + j) * ldkv + part * 32);
#pragma unroll
            for (int w = 0; w < 4; ++w) { float vf[8]; unpack8(vp[w], vf);
#pragma unroll
                for (int e = 0; e < 8; ++e) o[8 * w + e] = fmaf(pj, vf[e], o[8 * w + e]); }
        }
        m = mn;
    }
    const float inv = 1.f / l;
    u32x4* op = (u32x4*)(Op + (size_t)qi * ldo + part * 32);
#pragma unroll
    for (int w = 0; w < 4; ++w) { u32x4 ov; ov.x = pk2(o[8 * w] * inv, o[8 * w + 1] * inv); ov.y = pk2(o[8 * w + 2] * inv, o[8 * w + 3] * inv); ov.z = pk2(o[8 * w + 4] * inv, o[8 * w + 5] * inv); ov.w = pk2(o[8 * w + 6] * inv, o[8 * w + 7] * inv); op[w] = ov; }
}

__device__ __forceinline__ void gemm_branch(const bf16_t* __restrict__ Ob, const bf16_t* __restrict__ WT, const bf16_t* __restrict__ G, bf16_t* __restrict__ Mg, int gw, int NW, int lane) {
    const int r = lane & 15, q = lane >> 4;
    const int ntn = D / 32, ntiles = (T / 32) * ntn;
    for (int tile = gw; tile < ntiles; tile += NW) {
        const int tm = tile / ntn, tn = tile % ntn;
        f32x4 acc[3][2][2];
#pragma unroll
        for (int s = 0; s < 3; ++s)
#pragma unroll
            for (int i = 0; i < 2; ++i)
#pragma unroll
                for (int j = 0; j < 2; ++j) acc[s][i][j] = (f32x4){0.f, 0.f, 0.f, 0.f};
        const bf16_t* ap = Ob + (size_t)(tm * 32 + r) * D + q * 8;
        const bf16_t* bp = WT + (size_t)(tn * 32 + r) * D + q * 8;
#pragma unroll
        for (int s = 0; s < 3; ++s) {
            const int kb = s == 0 ? 0 : (s == 1 ? 1024 : 1536), ke = s == 0 ? 1024 : (s == 1 ? 1536 : 2048);
            for (int k0 = kb; k0 < ke; k0 += 32) {
                bf16x8 af[2], bfr[2];
#pragma unroll
                for (int i = 0; i < 2; ++i) af[i] = *(const bf16x8*)(ap + (size_t)i * 16 * D + k0);
#pragma unroll
                for (int j = 0; j < 2; ++j) bfr[j] = *(const bf16x8*)(bp + (size_t)j * 16 * D + k0);
#pragma unroll
                for (int i = 0; i < 2; ++i)
#pragma unroll
                    for (int j = 0; j < 2; ++j) acc[s][i][j] = __builtin_amdgcn_mfma_f32_16x16x32_bf16(af[i], bfr[j], acc[s][i][j], 0, 0, 0);
            }
        }
#pragma unroll
        for (int i = 0; i < 2; ++i)
#pragma unroll
            for (int j = 0; j < 2; ++j)
#pragma unroll
                for (int e = 0; e < 4; ++e) {
                    const int row = tm * 32 + i * 16 + q * 4 + e, col = tn * 32 + j * 16 + r;
                    const bf16_t* gp = G + (size_t)row * GW + col;
                    const float mval = bf2f(gp[0]) * acc[0][i][j][e] + bf2f(gp[2048]) * acc[1][i][j][e] + bf2f(gp[4096]) * acc[2][i][j][e];
                    Mg[(size_t)row * D + col] = (bf16_t)f2bf(mval);
                }
    }
}

__device__ __forceinline__ unsigned long long shfl_xor64(unsigned long long v, int m) {
    const unsigned lo = __shfl_xor((unsigned)v, m), hi = __shfl_xor((unsigned)(v >> 32), m);
    return ((unsigned long long)hi << 32) | lo;
}
__device__ __forceinline__ unsigned fkey(float f) { const unsigned u = __float_as_uint(f); return (u & 0x80000000u) ? ~u : (u | 0x80000000u); }
__device__ __forceinline__ float fkey_inv(unsigned k) { const unsigned u = (k & 0x80000000u) ? (k & 0x7fffffffu) : ~k; return __uint_as_float(u); }
__device__ __forceinline__ unsigned long long wave_max64(unsigned long long k) {
#pragma unroll
    for (int o = 1; o < 64; o <<= 1) { const unsigned long long t = shfl_xor64(k, o); k = t > k ? t : k; }
    return k;
}
__device__ __forceinline__ void route_unit(const Params& p, int t, int h, int lane) {
    const bf16_t* Q = (const bf16_t*)(p.ws + WS_Q); const bf16_t* KB = (const bf16_t*)(p.ws + WS_KEYSB);
    int* RIDX = (int*)(p.ws + WS_RIDX); float* RG = (float*)(p.ws + WS_RG);
    float sv_l[2] = {0.f, 0.f}; int si_l[2] = {0, 0};
#pragma unroll
    for (int c = 0; c < 2; ++c) {
        const bf16_t* qv = Q + (size_t)t * D + h * 256 + c * 128;
        const unsigned qw = ((const unsigned*)qv)[lane];
        const float qa = bf2f(qw & 0xffffu), qb = bf2f(qw >> 16);
        const bf16_t* k0p = KB + ((size_t)(h * 2 + c) * NKEYS + lane) * 128;
        const bf16_t* k1p = k0p + 64 * 128;
        float s0 = 0.f, s1 = 0.f;
#pragma unroll
        for (int w = 0; w < 16; ++w) {
            float k0f[8], k1f[8]; unpack8(((const u32x4*)k0p)[w], k0f); unpack8(((const u32x4*)k1p)[w], k1f);
#pragma unroll
            for (int e = 0; e < 8; e += 2) {
                const int src = 4 * w + e / 2;
                const float xa = __int_as_float(__builtin_amdgcn_readlane(__float_as_int(qa), src));
                const float xb = __int_as_float(__builtin_amdgcn_readlane(__float_as_int(qb), src));
                s0 = fmaf(xa, k0f[e], s0); s0 = fmaf(xb, k0f[e + 1], s0);
                s1 = fmaf(xa, k1f[e], s1); s1 = fmaf(xb, k1f[e + 1], s1);
            }
        }
        unsigned long long ka = ((unsigned long long)fkey(s0) << 32) | (unsigned)(255 - lane);
        unsigned long long kb = ((unsigned long long)fkey(s1) << 32) | (unsigned)(255 - (lane + 64));
        for (int rnd = 0; rnd < TOPK; ++rnd) {
            const unsigned long long best = wave_max64(ka > kb ? ka : kb);
            if (ka == best) ka = 0ull; if (kb == best) kb = 0ull;
            if (lane == rnd) { sv_l[c] = fkey_inv((unsigned)(best >> 32)); si_l[c] = 255 - (int)(best & 0xffffffffu); }
        }
    }
    unsigned long long kc[4];
#pragma unroll
    for (int m = 0; m < 4; ++m) { const int cid = lane + 64 * m, i = cid >> 4, j = cid & 15;
        const float v = __shfl(sv_l[0], i) + __shfl(sv_l[1], j);
        kc[m] = ((unsigned long long)fkey(v) << 32) | (unsigned)(1023 - cid); }
    float fv = 0.f; int cidx = 0;
    for (int rnd = 0; rnd < TOPK; ++rnd) {
        unsigned long long loc = kc[0] > kc[1] ? kc[0] : kc[1]; const unsigned long long loc2 = kc[2] > kc[3] ? kc[2] : kc[3]; loc = loc > loc2 ? loc : loc2;
        const unsigned long long best = wave_max64(loc);
#pragma unroll
        for (int m = 0; m < 4; ++m) if (kc[m] == best) kc[m] = 0ull;
        if (lane == rnd) { fv = fkey_inv((unsigned)(best >> 32)); cidx = 1023 - (int)(best & 0xffffffffu); }
    }
    const float fmax_ = __shfl(fv, 0);
    float e = lane < 16 ? __expf(fv - fmax_) : 0.f;
    float ssum = e;
#pragma unroll
    for (int o = 1; o < 16; o <<= 1) ssum += __shfl_xor(ssum, o);
    const int ci = cidx >> 4, cj = cidx & 15;
    const int e0 = __shfl(si_l[0], ci), e1 = __shfl(si_l[1], cj);
    if (lane < 16) { RIDX[(size_t)t * 128 + h * 16 + lane] = e0 * NKEYS + e1; RG[(size_t)t * 128 + h * 16 + lane] = e / ssum; }
}

typedef float f32x2 __attribute__((ext_vector_type(2)));
__device__ __forceinline__ void fp4_row_load(const float* __restrict__ src, const float* __restrict__ kscale, int lane, f32x4 (&v)[8]) {
#pragma unroll
    for (int j = 0; j < 8; ++j) { v[j] = ((const f32x4*)src)[64 * j + lane]; if (kscale) v[j] = v[j] * ((const f32x4*)kscale)[64 * j + lane]; }
}
__device__ __forceinline__ void fp4_row_finish(const f32x4 (&v)[8], unsigned char* __restrict__ tab, int e, float* __restrict__ scale_out, int lane) {
    float mx = 0.f;
#pragma unroll
    for (int j = 0; j < 8; ++j) mx = fmaxf(mx, fmaxf(fmaxf(fabsf(v[j].x), fabsf(v[j].y)), fmaxf(fabsf(v[j].z), fabsf(v[j].w))));
#pragma unroll
    for (int o = 1; o < 64; o <<= 1) mx = fmaxf(mx, __shfl_xor(mx, o));
    const float sc = mx > 0.f ? mx * (1.f / 6.f) : 1.f, inv = 1.f / sc;
#pragma unroll
    for (int j = 0; j < 8; ++j) {
        const f32x4 a = v[j] * inv;
        unsigned pk = 0u;
        pk = __builtin_amdgcn_cvt_scalef32_pk_fp4_f32(pk, fminf(fmaxf(a.x, -6.f), 6.f), fminf(fmaxf(a.y, -6.f), 6.f), 1.0f, 0);
        pk = __builtin_amdgcn_cvt_scalef32_pk_fp4_f32(pk, fminf(fmaxf(a.z, -6.f), 6.f), fminf(fmaxf(a.w, -6.f), 6.f), 1.0f, 1);
        *(unsigned short*)(tab + ((size_t)j * 16384 + e) * 128 + 2 * lane) = (unsigned short)pk;
    }
    if (lane == 0) *scale_out = sc;
}
__device__ __forceinline__ void fp4_tables(const Params& p, int gw, int NW, int lane) {
    f32x4 va[8], vb[8];
#define FP4_LOAD(r, v) do { if ((r) < 16384) fp4_row_load(p.in[25] + (size_t)(r) * D, p.in[22], lane, v); else fp4_row_load(p.in[26] + (size_t)((r) - 16384) * D, nullptr, lane, v); } while (0)
#define FP4_FIN(r, v) do { if ((r) < 16384) fp4_row_finish(v, p.ws + WS_TABU, (r), (float*)(p.ws + WS_SCU) + (r), lane); \
        else fp4_row_finish(v, p.ws + WS_TABV, (r) - 16384, (float*)(p.ws + WS_SCV) + ((r) - 16384), lane); } while (0)
    const int n = 2 * 16384;
    int r = gw;
    if (r < n) FP4_LOAD(r, va);
    for (; r < n; r += 2 * NW) {
        const bool hb = r + NW < n;
        if (hb) FP4_LOAD(r + NW, vb);
        FP4_FIN(r, va);
        if (r + 2 * NW < n) FP4_LOAD(r + 2 * NW, va);
        if (hb) FP4_FIN(r + NW, vb);
    }
#undef FP4_LOAD
#undef FP4_FIN
}
constexpr size_t WS_ZP = WS_Q;
constexpr size_t WS_X2F8 = 2 * MiB;
__device__ __forceinline__ float dot_chunk(const u32x4 w, const float (&xf)[32]) {
    float a0 = 0.f, a1 = 0.f;
#pragma unroll
    for (int q = 0; q < 4; ++q) {
        const f32x2 a = __builtin_amdgcn_cvt_scalef32_pk_f32_fp4(w[q], 1.0f, 0), b = __builtin_amdgcn_cvt_scalef32_pk_f32_fp4(w[q], 1.0f, 1);
        const f32x2 c = __builtin_amdgcn_cvt_scalef32_pk_f32_fp4(w[q], 1.0f, 2), d = __builtin_amdgcn_cvt_scalef32_pk_f32_fp4(w[q], 1.0f, 3);
        a0 = fmaf(a.x, xf[8 * q], a0); a1 = fmaf(a.y, xf[8 * q + 1], a1); a0 = fmaf(b.x, xf[8 * q + 2], a0); a1 = fmaf(b.y, xf[8 * q + 3], a1);
        a0 = fmaf(c.x, xf[8 * q + 4], a0); a1 = fmaf(c.y, xf[8 * q + 5], a1); a0 = fmaf(d.x, xf[8 * q + 6], a0); a1 = fmaf(d.y, xf[8 * q + 7], a1);
    }
    return a0 + a1;
}
__device__ __forceinline__ void axpy_chunk(const u32x4 w, const float a_, float (&of)[32]) {
#pragma unroll
    for (int q = 0; q < 4; ++q) {
        const f32x2 a = __builtin_amdgcn_cvt_scalef32_pk_f32_fp4(w[q], 1.0f, 0), b = __builtin_amdgcn_cvt_scalef32_pk_f32_fp4(w[q], 1.0f, 1);
        const f32x2 c = __builtin_amdgcn_cvt_scalef32_pk_f32_fp4(w[q], 1.0f, 2), d = __builtin_amdgcn_cvt_scalef32_pk_f32_fp4(w[q], 1.0f, 3);
        of[8 * q] = fmaf(a_, a.x, of[8 * q]); of[8 * q + 1] = fmaf(a_, a.y, of[8 * q + 1]); of[8 * q + 2] = fmaf(a_, b.x, of[8 * q + 2]); of[8 * q + 3] = fmaf(a_, b.y, of[8 * q + 3]);
        of[8 * q + 4] = fmaf(a_, c.x, of[8 * q + 4]); of[8 * q + 5] = fmaf(a_, c.y, of[8 * q + 5]); of[8 * q + 6] = fmaf(a_, d.x, of[8 * q + 6]); of[8 * q + 7] = fmaf(a_, d.y, of[8 * q + 7]);
    }
}
struct PeerTok { u32x4 w[16]; u32x4 x[4]; };
template <bool USTEP>
__device__ __forceinline__ void peer_issue(PeerTok& k, const Params& p, const unsigned char* tab, int t, int xv, int lane) {
    const int* RIDX = (const int*)(p.ws + WS_RIDX);
    const int i0 = RIDX[(size_t)t * 128 + lane], i1 = RIDX[(size_t)t * 128 + 64 + lane];
    const int es = lane >> 3, ck = lane & 7;
    if (USTEP) { const bf16_t* xp = (const bf16_t*)(p.ws + WS_X2BF) + (size_t)t * D + 256 * xv + 32 * ck;
#pragma unroll
        for (int j = 0; j < 4; ++j) k.x[j] = *(const u32x4*)(xp + 8 * j); }
#pragma unroll
    for (int g = 0; g < 16; ++g) { const int e = __shfl(g < 8 ? i0 : i1, (8 * g + es) & 63); k.w[g] = *(const u32x4*)(tab + (size_t)e * 128 + ck * 16); }
}
__device__ __forceinline__ void peer_u_finish(const PeerTok& k, const Params& p, int t, int xv, int lane) {
    const int es = lane >> 3, ck = lane & 7;
    float xf[32];
#pragma unroll
    for (int j = 0; j < 4; ++j) unpack8(k.x[j], xf + 8 * j);
    float zsel0 = 0.f, zsel1 = 0.f;
#pragma unroll
    for (int g = 0; g < 16; ++g) { u32x4 w_ = k.w[g]; asm volatile("" : "+v"(w_)); float d = dot_chunk(w_, xf);
        d += __int_as_float(__builtin_amdgcn_update_dpp(0, __float_as_int(d), 0xB1, 0xf, 0xf, true));
        d += __int_as_float(__builtin_amdgcn_update_dpp(0, __float_as_int(d), 0x4E, 0xf, 0xf, true));
        d += __int_as_float(__builtin_amdgcn_update_dpp(0, __float_as_int(d), 0x141, 0xf, 0xf, true));
        if (g < 8) { if (ck == g) zsel0 = d; } else { if (ck == g - 8) zsel1 = d; }
        asm volatile("" : "+v"(zsel0), "+v"(zsel1)); }
    float* zp = (float*)(p.ws + WS_ZP) + ((size_t)xv * T + t) * 128;
    zp[8 * ck + es] = zsel0; zp[64 + 8 * ck + es] = zsel1;
}
__device__ __forceinline__ void peer_v_finish(const PeerTok& k, const Params& p, int t, int xv, int lane, LAS float* red) {
    const float* RG = (const float*)(p.ws + WS_RG);
    const float a0 = RG[(size_t)t * 128 + lane], a1 = RG[(size_t)t * 128 + 64 + lane];
    const int es = lane >> 3, ck = lane & 7;
    float of[32];
#pragma unroll
    for (int q = 0; q < 32; ++q) of[q] = 0.f;
#pragma unroll
    for (int g = 0; g < 16; ++g) { const float a = __shfl(g < 8 ? a0 : a1, (8 * g + es) & 63); u32x4 w_ = k.w[g]; asm volatile("" : "+v"(w_)); axpy_chunk(w_, a, of);
        asm volatile("" : "+v"(of[0]), "+v"(of[1]), "+v"(of[2]), "+v"(of[3]), "+v"(of[4]), "+v"(of[5]), "+v"(of[6]), "+v"(of[7]), "+v"(of[8]), "+v"(of[9]), "+v"(of[10]), "+v"(of[11]), "+v"(of[12]), "+v"(of[13]), "+v"(of[14]), "+v"(of[15]));
        asm volatile("" : "+v"(of[16]), "+v"(of[17]), "+v"(of[18]), "+v"(of[19]), "+v"(of[20]), "+v"(of[21]), "+v"(of[22]), "+v"(of[23]), "+v"(of[24]), "+v"(of[25]), "+v"(of[26]), "+v"(of[27]), "+v"(of[28]), "+v"(of[29]), "+v"(of[30]), "+v"(of[31])); }
#pragma unroll
    for (int q = 0; q < 8; ++q) *(LAS f32x4*)(red + es * 256 + ck * 32 + 4 * q) = (f32x4){of[4 * q], of[4 * q + 1], of[4 * q + 2], of[4 * q + 3]};
    f32x4 s = *(const LAS f32x4*)(red + 4 * lane);
#pragma unroll
    for (int r = 1; r < 8; ++r) s = s + *(const LAS f32x4*)(red + r * 256 + 4 * lane);
    f32x4* o4 = (f32x4*)(p.out + (size_t)t * D + 256 * xv + 4 * lane);
    *o4 = *o4 + s;
}
template <bool USTEP>
__device__ __forceinline__ void peer_step(const Params& p, int lane, int wave, LAS float* red, int pos, int nx, int rank, int nloc) {
    for (int xv = pos; xv < 8; xv += nx) {
        const int wx = rank * 8 + wave, nwx = nloc * 8;
        const unsigned char* tab = p.ws + (USTEP ? WS_TABU : WS_TABV) + (size_t)xv * 16384 * 128;
        PeerTok A, B;
        int t = wx;
        if (t < T) peer_issue<USTEP>(A, p, tab, t, xv, lane);
#pragma unroll 1
        for (; t < T; t += 2 * nwx) {
            const bool hb = t + nwx < T;
            if (hb) peer_issue<USTEP>(B, p, tab, t + nwx, xv, lane);
            if (USTEP) peer_u_finish(A, p, t, xv, lane); else peer_v_finish(A, p, t, xv, lane, red);
            if (t + 2 * nwx < T) peer_issue<USTEP>(A, p, tab, t + 2 * nwx, xv, lane);
            if (hb) { if (USTEP) peer_u_finish(B, p, t + nwx, xv, lane); else peer_v_finish(B, p, t + nwx, xv, lane, red); }
        }
    }
}
typedef int v8i_p __attribute__((ext_vector_type(8))); typedef int v4i_t __attribute__((ext_vector_type(4)));
struct PeerTokU { u32x4 w[16]; u32x4 b[2][2]; };
__device__ __forceinline__ void peer_u_issue(PeerTokU& k, const Params& p, const unsigned char* tab, int t, int xv, int lane) {
    const int* RIDX = (const int*)(p.ws + WS_RIDX);
    const int i0 = RIDX[(size_t)t * 128 + lane], i1 = RIDX[(size_t)t * 128 + 64 + lane];
    const int es = lane >> 3, ck = lane & 7, q = lane >> 4;
    const unsigned char* xp = p.ws + WS_X2F8 + (size_t)t * D + 256 * xv + 16 * q;
#pragma unroll
    for (int kb = 0; kb < 2; ++kb) { k.b[kb][0] = *(const u32x4*)(xp + 128 * kb); k.b[kb][1] = *(const u32x4*)(xp + 128 * kb + 64); }
#pragma unroll
    for (int g = 0; g < 16; ++g) { const int e = __shfl(g < 8 ? i0 : i1, (8 * g + es) & 63); k.w[g] = *(const u32x4*)(tab + (size_t)e * 128 + ck * 16); }
}
__device__ __forceinline__ void peer_u_mfma(const PeerTokU& k, const Params& p, int t, int xv, int lane, LAS unsigned char* vl) {
    float* zp = (float*)(p.ws + WS_ZP) + ((size_t)xv * T + t) * 128;
    const int es = lane >> 3, ck = lane & 7, r16 = lane & 15, q = lane >> 4;
#pragma unroll
    for (int g = 0; g < 16; ++g) { const int row = 8 * g + es; *(LAS u32x4*)(vl + row * 128 + ((ck ^ (row & 7)) << 4)) = k.w[g]; }
    v8i_p b0, b1;
    { const v4i_t x0 = __builtin_bit_cast(v4i_t, k.b[0][0]), x1 = __builtin_bit_cast(v4i_t, k.b[0][1]), y0 = __builtin_bit_cast(v4i_t, k.b[1][0]), y1 = __builtin_bit_cast(v4i_t, k.b[1][1]);
      b0 = __builtin_shufflevector(x0, x1, 0, 1, 2, 3, 4, 5, 6, 7); b1 = __builtin_shufflevector(y0, y1, 0, 1, 2, 3, 4, 5, 6, 7); }
#pragma unroll
    for (int g = 0; g < 8; ++g) {
        const int row = 16 * g + r16;
        const v4i_t a0 = __builtin_bit_cast(v4i_t, *(const LAS u32x4*)(vl + row * 128 + ((q ^ (row & 7)) << 4)));
        const v4i_t a1 = __builtin_bit_cast(v4i_t, *(const LAS u32x4*)(vl + row * 128 + (((4 + q) ^ (row & 7)) << 4)));
        const v8i_p A0 = {a0[0], a0[1], a0[2], a0[3], 0, 0, 0, 0}, A1 = {a1[0], a1[1], a1[2], a1[3], 0, 0, 0, 0};
        f32x4 acc = {0.f, 0.f, 0.f, 0.f};
        acc = __builtin_amdgcn_mfma_scale_f32_16x16x128_f8f6f4(A0, b0, acc, 4, 0, 0, 0x7F7F7F7F, 0, 0x7F7F7F7F);
        acc = __builtin_amdgcn_mfma_scale_f32_16x16x128_f8f6f4(A1, b1, acc, 4, 0, 0, 0x7F7F7F7F, 0, 0x7F7F7F7F);
        if ((lane & 15) == 0) *(f32x4*)(zp + 16 * g + 4 * (lane >> 4)) = acc;
    }
}
__device__ __forceinline__ void peer_u_step(const Params& p, int lane, int wave, LAS unsigned char* vl, int pos, int nx, int rank, int nloc) {
    for (int xv = pos; xv < 8; xv += nx) {
        const int wx = rank * 8 + wave, nwx = nloc * 8;
        const unsigned char* tab = p.ws + WS_TABU + (size_t)xv * 16384 * 128;
        PeerTokU A, B;
        int t = wx;
        if (t < T) peer_u_issue(A, p, tab, t, xv, lane);
#pragma unroll 1
        for (; t < T; t += 2 * nwx) {
            const bool hb = t + nwx < T;
            if (hb) peer_u_issue(B, p, tab, t + nwx, xv, lane);
            peer_u_mfma(A, p, t, xv, lane, vl);
            if (t + 2 * nwx < T) peer_u_issue(A, p, tab, t + 2 * nwx, xv, lane);
            if (hb) peer_u_mfma(B, p, t + nwx, xv, lane, vl);
        }
    }
}
constexpr size_t WS_ACT8 = 34 * MiB, WS_ASC = 36 * MiB;
__device__ __forceinline__ void peer_combine(const Params& p, int t, int lane) {
    const float* ZP = (const float*)(p.ws + WS_ZP); const int* RIDX = (const int*)(p.ws + WS_RIDX); const float* RG = (const float*)(p.ws + WS_RG);
    const float* SCU = (const float*)(p.ws + WS_SCU); const float* SCV = (const float*)(p.ws + WS_SCV); const float* SS2 = (const float*)(p.ws + WS_CTL + CTL_SS2_BYTE);
    const float rs = rsqrtf(SS2[t] * (1.f / D) + EPS);
    float act[2];
#pragma unroll
    for (int hlf = 0; hlf < 2; ++hlf) { const size_t o = (size_t)t * 128 + 64 * hlf + lane; float z = 0.f;
#pragma unroll
        for (int x = 0; x < 8; ++x) z += ZP[((size_t)x * T) * 128 + o];
        const int e = RIDX[o];
        act[hlf] = gelu_tanh(z * rs * SCU[e]) * RG[o] * SCV[e]; }
    float mx = fmaxf(fabsf(act[0]), fabsf(act[1]));
#pragma unroll
    for (int o = 1; o < 64; o <<= 1) mx = fmaxf(mx, __shfl_xor(mx, o));
    const float sc = mx > 0.f ? mx * (1.f / 448.f) : 1.f, inv = 1.f / sc;
    unsigned char* a8 = p.ws + WS_ACT8 + (size_t)t * 128;
    a8[lane] = (unsigned char)(__builtin_amdgcn_cvt_pk_fp8_f32(act[0] * inv, 0.f, 0, false) & 0xff);
    a8[64 + lane] = (unsigned char)(__builtin_amdgcn_cvt_pk_fp8_f32(act[1] * inv, 0.f, 0, false) & 0xff);
    if (lane == 0) ((float*)(p.ws + WS_ASC))[t] = sc;
}
typedef int v2i_t __attribute__((ext_vector_type(2)));
struct PeerTokV { u32x4 w[16]; u32x4 b[2]; };
__device__ __forceinline__ void peer_v_issue(PeerTokV& k, const Params& p, const unsigned char* tab, int t, int lane) {
    const int* RIDX = (const int*)(p.ws + WS_RIDX);
    const int i0 = RIDX[(size_t)t * 128 + lane], i1 = RIDX[(size_t)t * 128 + 64 + lane];
    const int es = lane >> 3, ck = lane & 7, q = lane >> 4;
    const unsigned char* ap = p.ws + WS_ACT8 + (size_t)t * 128 + 16 * q;
    k.b[0] = *(const u32x4*)ap; k.b[1] = *(const u32x4*)(ap + 64);
#pragma unroll
    for (int g = 0; g < 16; ++g) { const int e = __shfl(g < 8 ? i0 : i1, (8 * g + es) & 63); k.w[g] = *(const u32x4*)(tab + (size_t)e * 128 + ck * 16); }
}
__device__ __forceinline__ void peer_v_mfma(const PeerTokV& k, const Params& p, int t, int xv, int lane, LAS unsigned char* vl) {
    const int es = lane >> 3, ck = lane & 7, n = lane & 15, q = lane >> 4;
#pragma unroll
    for (int g = 0; g < 16; ++g) { const int row = 8 * g + es; *(LAS u32x4*)(vl + row * 128 + ((ck ^ (row & 7)) << 4)) = k.w[g]; }
    const v4i_t x0 = __builtin_bit_cast(v4i_t, k.b[0]), x1 = __builtin_bit_cast(v4i_t, k.b[1]);
    const v8i_p bop = __builtin_shufflevector(x0, x1, 0, 1, 2, 3, 4, 5, 6, 7);
    const int r1 = 32 * q + n, r2 = r1 + 16;
    f32x4 keep = {0.f, 0.f, 0.f, 0.f};
#pragma unroll
    for (int mb = 0; mb < 16; ++mb) {
        const v2i_t t1 = __builtin_amdgcn_ds_read_tr4_b64_v2i32((LAS v2i_t*)(vl + r1 * 128 + ((((mb >> 1) ^ (r1 & 7)) << 4) | ((mb & 1) << 3))));
        const v2i_t t2 = __builtin_amdgcn_ds_read_tr4_b64_v2i32((LAS v2i_t*)(vl + r2 * 128 + ((((mb >> 1) ^ (r2 & 7)) << 4) | ((mb & 1) << 3))));
        const v8i_p aop = {t1[0], t1[1], t2[0], t2[1], 0, 0, 0, 0};
        f32x4 acc = {0.f, 0.f, 0.f, 0.f};
        acc = __builtin_amdgcn_mfma_scale_f32_16x16x128_f8f6f4(aop, bop, acc, 4, 0, 0, 0x7F7F7F7F, 0, 0x7F7F7F7F);
        if (n == mb) keep = acc;
    }
    const float sc = ((const float*)(p.ws + WS_ASC))[t];
    const size_t oo = (size_t)t * D + 256 * xv + 16 * n + 4 * q;
    const u32x2 xw = *(const u32x2*)((const bf16_t*)(p.ws + WS_X2BF) + oo);
    const f32x4 x2v = {__uint_as_float(xw.x << 16), __uint_as_float(xw.x & 0xffff0000u), __uint_as_float(xw.y << 16), __uint_as_float(xw.y & 0xffff0000u)};
    *(f32x4*)(p.out + oo) = x2v + keep * sc;
}
__device__ __forceinline__ void peer_v_step(const Params& p, int lane, int wave, LAS unsigned char* vl, int pos, int nx, int rank, int nloc) {
    for (int xv = pos; xv < 8; xv += nx) {
        const int wx = rank * 8 + wave, nwx = nloc * 8;
        const unsigned char* tab = p.ws + WS_TABV + (size_t)xv * 16384 * 128;
        PeerTokV A, B;
        int t = wx;
        if (t < T) peer_v_issue(A, p, tab, t, lane);
#pragma unroll 1
        for (; t < T; t += 2 * nwx) {
            const bool hb = t + nwx < T;
            if (hb) peer_v_issue(B, p, tab, t + nwx, lane);
            peer_v_mfma(A, p, t, xv, lane, vl);
            if (t + 2 * nwx < T) peer_v_issue(A, p, tab, t + 2 * nwx, lane);
            if (hb) peer_v_mfma(B, p, t + nwx, xv, lane, vl);
        }
    }
}

namespace pg8 {
#define PG8_LAS __attribute__((address_space(3)))
constexpr int BM = 256, BK = 64, HALF = 128, HTB = HALF * BK * 2, STAGE_BYTES = 8 * HTB, NXCD = 8, WGM = 8;
__host__ __device__ __forceinline__ int lds_byte(int r, int c) { const int st = (r >> 4) * 2 + (c >> 5), rr = r & 15, cc = c & 31, ob = rr * 64 + cc * 2; return st * 1024 + (ob ^ (((ob >> 9) & 1) << 5)); }
__host__ __device__ __forceinline__ void stage_rc(int b, int& R, int& C) { const int st = b / 1024, sb = b % 1024, swz = sb ^ (((sb >> 9) & 1) << 5); R = (st >> 1) * 16 + swz / 64; C = (st & 1) * 32 + (swz % 64) / 2; }
__host__ __device__ __forceinline__ int perm32(int rho) { const int n = rho >> 4, i = rho & 15; return 8 * (i >> 2) + 4 * n + (i & 3); }
struct Unit { const char* A; const char* B; int pm, pn, kind, nt; };
__device__ __forceinline__ const char* uni_ptr(const char* p) { const unsigned long long v = (unsigned long long)p; const unsigned lo = __builtin_amdgcn_readfirstlane((unsigned)v), hi = __builtin_amdgcn_readfirstlane((unsigned)(v >> 32)); return (const char*)(((unsigned long long)hi << 32) | lo); }
__device__ __forceinline__ void uni(Unit& u) { u.A = uni_ptr(u.A); u.B = uni_ptr(u.B); u.pm = __builtin_amdgcn_readfirstlane(u.pm); u.pn = __builtin_amdgcn_readfirstlane(u.pn); u.kind = __builtin_amdgcn_readfirstlane(u.kind); u.nt = __builtin_amdgcn_readfirstlane(u.nt); }
__device__ __forceinline__ void tile_of(int L, int nM, int nN, int& pm, int& pn) {
    const int nwg = nM * nN; int wgid = L; { const int q = nwg / NXCD, r = nwg % NXCD, xcd = wgid % NXCD, off = wgid / NXCD; wgid = (xcd < r ? xcd * (q + 1) : r * (q + 1) + (xcd - r) * q) + off; }
    const int nig = WGM * nN, gid = wgid / nig, fm = gid * WGM, gsz = (nM - fm) < WGM ? (nM - fm) : WGM;
    pm = fm + ((wgid % nig) % gsz); pn = (wgid % nig) / gsz;
}
typedef int v8i_t __attribute__((ext_vector_type(8))); typedef int v4i_t __attribute__((ext_vector_type(4)));
__device__ __forceinline__ v8i_t cat8(const bf16x8 lo, const bf16x8 hi) { const v4i_t a = __builtin_bit_cast(v4i_t, lo), b = __builtin_bit_cast(v4i_t, hi); return __builtin_shufflevector(a, b, 0, 1, 2, 3, 4, 5, 6, 7); }
template <bool FP8, class Epi, class Sched>
__device__ __forceinline__ void gemm_phase(PG8_LAS unsigned char* lds, const int lda, const int ldb, const Sched& S, const Epi& E) {
    const int tid = threadIdx.x, wid = __builtin_amdgcn_readfirstlane(tid >> 6), lane = tid & 63, wr = wid >> 2, wc = wid & 3, fr = lane & 15, fq = lane >> 4;
    unsigned voffA[2], voffB[2];
#pragma unroll
    for (int i = 0; i < 2; ++i) { int R, C; stage_rc(tid * 16 + i * 8192, R, C); const int Rb = (R & ~31) + perm32(R & 31);
        voffA[i] = (unsigned)(R * lda + C) * 2u; voffB[i] = (unsigned)(Rb * ldb + C) * 2u; }
    const size_t kstep = (size_t)(BK * 2);
    const size_t hstepA = (size_t)HALF * lda * 2, hstepB = (size_t)HALF * ldb * 2;
    const unsigned ldsw = (unsigned)wid * 1024u;
    const int aoff = lds_byte(wr * 64 + fr, fq * 8), boff = lds_byte(wc * 32 + fr, fq * 8);
#define PG8_SA(b, h) (((b) * 2 + (h)) * HTB)
#define PG8_SB(b, h) ((4 + (b) * 2 + (h)) * HTB)
#define PG8_STAGE(bufoff, gbase, voff) do { _Pragma("unroll") for (int _i = 0; _i < 2; ++_i) \
        __builtin_amdgcn_global_load_lds((const unsigned*)((const char*)(gbase) + (voff)[_i]), (PG8_LAS unsigned*)(lds + (bufoff) + ldsw + _i * 8192), 16, 0, 0); } while (0)
#define PG8_LDA(dst, b, h) do { _Pragma("unroll") for (int m = 0; m < 4; ++m) { if constexpr (FP8) dst##8[m] = cat8(*(const PG8_LAS bf16x8*)(lds + PG8_SA(b, h) + aoff + m * 2048), *(const PG8_LAS bf16x8*)(lds + PG8_SA(b, h) + aoff + m * 2048 + 1024)); \
        else { _Pragma("unroll") for (int k = 0; k < 2; ++k) dst[m][k] = *(const PG8_LAS bf16x8*)(lds + PG8_SA(b, h) + aoff + m * 2048 + k * 1024); } } } while (0)
#define PG8_LDB(dst, b, h) do { _Pragma("unroll") for (int n = 0; n < 2; ++n) { if constexpr (FP8) dst##8[n] = cat8(*(const PG8_LAS bf16x8*)(lds + PG8_SB(b, h) + boff + n * 2048), *(const PG8_LAS bf16x8*)(lds + PG8_SB(b, h) + boff + n * 2048 + 1024)); \
        else { _Pragma("unroll") for (int k = 0; k < 2; ++k) dst[n][k] = *(const PG8_LAS bf16x8*)(lds + PG8_SB(b, h) + boff + n * 2048 + k * 1024); } } } while (0)
#define PG8_MMA(ai, bj, At, Bt) do { __builtin_amdgcn_s_setprio(1); \
        if constexpr (FP8) { _Pragma("unroll") for (int m = 0; m < 4; ++m) _Pragma("unroll") for (int n = 0; n < 2; ++n) \
            asm volatile("v_mfma_scale_f32_16x16x128_f8f6f4 %0, %1, %2, %0, %3, %3 op_sel_hi:[0,0,0]" : "+v"(acc[ai][bj][m][n]) : "v"(Bt##8[n]), "v"(At##8[m]), "v"(mxone)); } \
        else { _Pragma("unroll") for (int m = 0; m < 4; ++m) _Pragma("unroll") for (int n = 0; n < 2; ++n) _Pragma("unroll") for (int k = 0; k < 2; ++k) \
            acc[ai][bj][m][n] = __builtin_amdgcn_mfma_f32_16x16x32_bf16(Bt[n][k], At[m][k], acc[ai][bj][m][n], 0, 0, 0); } \
        __builtin_amdgcn_s_setprio(0); } while (0)
#define PG8_WAIT_V(n) asm volatile("s_waitcnt vmcnt(" #n ")" ::: "memory")
#define PG8_WAIT_L(n) asm volatile("s_waitcnt lgkmcnt(" #n ")" ::: "memory")
#define PG8_BAR __builtin_amdgcn_s_barrier()
#define PG8_SCHED __builtin_amdgcn_sched_barrier(0)
    Unit cur, nxt; int ui = 0;
    if (!S.next(0, cur)) return;
    f32x4 acc[2][2][4][2];
#pragma unroll
    for (int a = 0; a < 2; ++a)
#pragma unroll
        for (int b = 0; b < 2; ++b)
#pragma unroll
            for (int m = 0; m < 4; ++m)
#pragma unroll
                for (int n = 0; n < 2; ++n) acc[a][b][m][n] = (f32x4){0.f, 0.f, 0.f, 0.f};
    const int mxone = 0x7F7F7F7F;
    bf16x8 At[4][2], B0[2][2], B1[2][2]; v8i_t At8[4], B08[2], B18[2];
    const char* cA = cur.A; const char* cB = cur.B;
    PG8_STAGE(PG8_SB(0, 0), cB, voffB); PG8_STAGE(PG8_SB(0, 1), cB + hstepB, voffB); PG8_STAGE(PG8_SA(0, 0), cA, voffA); PG8_STAGE(PG8_SA(0, 1), cA + hstepA, voffA);
    if (wr == 1) PG8_BAR;
    PG8_WAIT_V(2); PG8_BAR;
    PG8_STAGE(PG8_SB(1, 0), cB + kstep, voffB); PG8_STAGE(PG8_SA(1, 0), cA + kstep, voffA); PG8_STAGE(PG8_SB(1, 1), cB + hstepB + kstep, voffB);
    PG8_WAIT_V(6); PG8_BAR;
    for (;;) {
        const bool has_next = S.next(ui + 1, nxt);
        const char* nA = has_next ? nxt.A : cA; const char* nB = has_next ? nxt.B : cB;
        const int nt = cur.nt;
        for (int t = 0; t < nt; t += 2) {
            const bool last = (t == nt - 2);
            const char* a1 = cA + (size_t)(t + 1) * kstep;
            const char* a2 = last ? nA : cA + (size_t)(t + 2) * kstep; const char* b2 = last ? nB : cB + (size_t)(t + 2) * kstep;
            const char* a3 = a2 + kstep; const char* b3 = b2 + kstep;
            PG8_LDB(B0, 0, 0); PG8_LDB(B1, 0, 1); PG8_SCHED; PG8_LDA(At, 0, 0); PG8_STAGE(PG8_SA(1, 1), a1 + hstepA, voffA);
            PG8_WAIT_V(8); PG8_WAIT_L(0); PG8_BAR; PG8_MMA(0, 0, At, B0); PG8_MMA(0, 1, At, B1); PG8_BAR; PG8_SCHED;
            PG8_LDA(At, 0, 1); PG8_STAGE(PG8_SB(0, 0), b2, voffB); PG8_STAGE(PG8_SB(0, 1), b2 + hstepB, voffB); PG8_STAGE(PG8_SA(0, 0), a2, voffA);
            PG8_WAIT_V(8); PG8_WAIT_L(0); PG8_BAR; PG8_MMA(1, 0, At, B0); PG8_MMA(1, 1, At, B1); PG8_BAR; PG8_SCHED;
            PG8_LDB(B0, 1, 0); PG8_LDB(B1, 1, 1); PG8_SCHED; PG8_LDA(At, 1, 0); PG8_STAGE(PG8_SA(0, 1), a2 + hstepA, voffA);
            PG8_WAIT_V(8); PG8_WAIT_L(0); PG8_BAR; PG8_MMA(0, 0, At, B0); PG8_MMA(0, 1, At, B1); PG8_BAR; PG8_SCHED;
            PG8_LDA(At, 1, 1); PG8_STAGE(PG8_SB(1, 0), b3, voffB); PG8_STAGE(PG8_SB(1, 1), b3 + hstepB, voffB); PG8_STAGE(PG8_SA(1, 0), a3, voffA);
            PG8_WAIT_V(8); PG8_WAIT_L(0); PG8_BAR; PG8_MMA(1, 0, At, B0); PG8_MMA(1, 1, At, B1); PG8_BAR; PG8_SCHED;
        }
        if (wr == 0) PG8_BAR;
        if constexpr (FP8) asm volatile("s_nop 15\n\ts_nop 15" ::: "memory");
        E(acc, cur, wr, wc, fr, fq);
        if (!has_next) break;
        if (E.reset(cur)) {
#pragma unroll
        for (int a = 0; a < 2; ++a)
#pragma unroll
            for (int b = 0; b < 2; ++b)
#pragma unroll
                for (int m = 0; m < 4; ++m)
#pragma unroll
                    for (int n = 0; n < 2; ++n) acc[a][b][m][n] = (f32x4){0.f, 0.f, 0.f, 0.f};
        }
        cur = nxt; cA = nA; cB = nB; ++ui;
        if (wr == 1) PG8_BAR;
    }
    PG8_WAIT_V(0);
    PG8_BAR;
#undef PG8_SA
#undef PG8_SB
#undef PG8_STAGE
#undef PG8_LDA
#undef PG8_LDB
#undef PG8_MMA
#undef PG8_WAIT_V
#undef PG8_WAIT_L
#undef PG8_BAR
#undef PG8_SCHED
}
}
typedef f32x4 AccT[2][2][4][2];
#define EPI_RESET_ALWAYS __device__ __forceinline__ bool reset(const pg8::Unit&) const { return true; }
__device__ __forceinline__ unsigned cvt_pk_bf16(float lo, float hi) { unsigned r; asm volatile("v_cvt_pk_bf16_f32 %0, %1, %2" : "=v"(r) : "v"(lo), "v"(hi)); return r; }
__device__ __forceinline__ u32x4 pack8(const f32x4 v0, const f32x4 v1) { u32x4 w; w.x = cvt_pk_bf16(v0[0], v0[1]); w.y = cvt_pk_bf16(v0[2], v0[3]); w.z = cvt_pk_bf16(v1[0], v1[1]); w.w = cvt_pk_bf16(v1[2], v1[3]); return w; }
template <int MODE>
__device__ __forceinline__ void store_tile_bf16(const AccT& acc, bf16_t* base, int ldc, int row0, int col0, const float* bias, const float ascale = 1.f) {
#pragma unroll
    for (int ai = 0; ai < 2; ++ai)
#pragma unroll
        for (int m = 0; m < 4; ++m) { bf16_t* rowp = base + (size_t)(row0 + ai * 128 + m * 16) * ldc + col0;
#pragma unroll
            for (int bj = 0; bj < 2; ++bj) { f32x4 v0 = acc[ai][bj][m][0], v1 = acc[ai][bj][m][1];
                if (MODE == 1) { _Pragma("unroll") for (int e = 0; e < 4; ++e) { v0[e] = gelu_tanh(v0[e]); v1[e] = gelu_tanh(v1[e]); } }
                if (MODE == 2) { const f32x4 b0 = *(const f32x4*)(bias + col0 + bj * 128), b1 = *(const f32x4*)(bias + col0 + bj * 128 + 4);
                    v0 = v0 * ascale + b0; v1 = v1 * ascale + b1; _Pragma("unroll") for (int e = 0; e < 4; ++e) { v0[e] = sigmoid_(v0[e]); v1[e] = sigmoid_(v1[e]); } }
                *(u32x4*)(rowp + bj * 128) = pack8(v0, v1); }
            if (MODE == 2) asm volatile("" ::: "memory"); }
}
struct SchedP1a { const char* H; const char* WT; const char* MEMN; const char* WTM; int G, c;
    __device__ __forceinline__ bool next(int i, pg8::Unit& u) const {
        const int L = i * G + c; const int n1 = 64 * 18;
        if (L < n1) { pg8::tile_of(L, 64, 18, u.pm, u.pn); u.kind = 0; u.A = H + (size_t)u.pm * 256 * D * 2; u.B = WT + (size_t)u.pn * 256 * D * 2; u.nt = D / 64; pg8::uni(u); return true; }
        if (L < n1 + 8) { const int j = L - n1; u.pm = j >> 2; u.pn = j & 3; u.kind = 1; u.A = MEMN + (size_t)u.pm * 256 * D * 2; u.B = WTM + (size_t)u.pn * 256 * D * 2; u.nt = D / 64; pg8::uni(u); return true; }
        return false; } };
struct EpiP1a { bf16_t* PROJ; bf16_t* MEMKV; EPI_RESET_ALWAYS
    __device__ __forceinline__ void operator()(AccT& acc, const pg8::Unit& u, int wr, int wc, int fr, int fq) const {
        const int row0 = u.pm * 256 + wr * 64 + fr, cl = wc * 32 + 8 * fq;
        if (u.kind == 1) { store_tile_bf16<0>(acc, MEMKV, 2 * CW, row0, u.pn * 256 + cl, nullptr); return; }
        if (u.pn == 14 || u.pn == 15) { store_tile_bf16<1>(acc, PROJ, INW, row0, u.pn * 256 + cl, nullptr); return; }
        store_tile_bf16<0>(acc, PROJ, INW, row0, u.pn * 256 + cl, nullptr);
    } };
struct SchedP1b { const char* H8; const char* WT8; int G, c;
    __device__ __forceinline__ bool next(int i, pg8::Unit& u) const {
        const int L = i * G + c; if (L >= 64 * 24) return false;
        pg8::tile_of(L, 64, 24, u.pm, u.pn); u.kind = 0; u.A = H8 + (size_t)u.pm * 256 * D; u.B = WT8 + (size_t)u.pn * 256 * D; u.nt = D / 128; pg8::uni(u); return true; } };
struct EpiP1b { bf16_t* G; const float* bgate; EPI_RESET_ALWAYS
    __device__ __forceinline__ void operator()(AccT& acc, const pg8::Unit& u, int wr, int wc, int fr, int fq) const {
        store_tile_bf16<2>(acc, G, GW, u.pm * 256 + wr * 64 + fr, u.pn * 256 + wc * 32 + 8 * fq, bgate, 1.f / GATE_WSCALE);
    } };
struct SchedP3 { const char* O; const char* WT; int G, c;
    __device__ __forceinline__ bool next(int i, pg8::Unit& u) const {
        const int ti = i / 3, seg = i - 3 * ti; const int L = ti * G + c; if (L >= 64 * 8) return false;
        pg8::tile_of(L, 64, 8, u.pm, u.pn); u.kind = seg;
        const int kb = seg == 0 ? 0 : (seg == 1 ? 1024 : 1536);
        u.A = O + ((size_t)u.pm * 256 * D + kb) * 2; u.B = WT + ((size_t)u.pn * 256 * D + kb) * 2; u.nt = seg == 0 ? 16 : 8; pg8::uni(u); return true; } };
struct EpiP3 { const bf16_t* G; bf16_t* MERGED;
    __device__ __forceinline__ bool reset(const pg8::Unit& u) const { return u.kind == 2; }
    __device__ __forceinline__ void operator()(AccT& acc, const pg8::Unit& u, int wr, int wc, int fr, int fq) const {
        const int row0 = u.pm * 256 + wr * 64 + fr, col0 = u.pn * 256 + wc * 32 + 8 * fq, seg = u.kind;
#pragma unroll
        for (int ai = 0; ai < 2; ++ai)
#pragma unroll
            for (int mh = 0; mh < 2; ++mh) {
                u32x4 ga[2][2], gb[2][2];
#pragma unroll
                for (int mm = 0; mm < 2; ++mm)
#pragma unroll
                    for (int bj = 0; bj < 2; ++bj) { const bf16_t* gp = G + (size_t)(row0 + ai * 128 + (mh * 2 + mm) * 16) * GW + col0 + bj * 128;
                        ga[mm][bj] = *(const u32x4*)(gp + seg * D); gb[mm][bj] = (seg < 2) ? *(const u32x4*)(gp + (seg + 1) * D) : (u32x4){0u, 0u, 0u, 0u}; }
#pragma unroll
                for (int mm = 0; mm < 2; ++mm)
#pragma unroll
                    for (int bj = 0; bj < 2; ++bj) { const int m = mh * 2 + mm;
                        float fa[8], fb[8]; unpack8(ga[mm][bj], fa); unpack8(gb[mm][bj], fb);
                        if (seg < 2) { _Pragma("unroll") for (int e = 0; e < 8; ++e) fa[e] = fa[e] * __builtin_amdgcn_rcpf(fmaxf(fb[e], 1e-20f)); }
                        f32x4& v0 = acc[ai][bj][m][0]; f32x4& v1 = acc[ai][bj][m][1];
                        v0[0] *= fa[0]; v0[1] *= fa[1]; v0[2] *= fa[2]; v0[3] *= fa[3]; v1[0] *= fa[4]; v1[1] *= fa[5]; v1[2] *= fa[6]; v1[3] *= fa[7];
                        if (seg == 2) *(u32x4*)(MERGED + (size_t)(row0 + ai * 128 + m * 16) * D + col0 + bj * 128) = pack8(v0, v1);
                    }
                asm volatile("" ::: "memory");
            }
    } };
struct SchedSq { const char* A; const char* WT; int G, c;
    __device__ __forceinline__ bool next(int i, pg8::Unit& u) const {
        const int L = i * G + c; if (L >= 64 * 8) return false;
        pg8::tile_of(L, 64, 8, u.pm, u.pn); u.kind = 0; u.A = A + (size_t)u.pm * 256 * D * 2; u.B = WT + (size_t)u.pn * 256 * D * 2; u.nt = D / 64; pg8::uni(u); return true; } };
struct EpiP4 { const float* x; float* out; bf16_t* xb; float* ss; unsigned char* x8; EPI_RESET_ALWAYS
    __device__ __forceinline__ void operator()(AccT& acc, const pg8::Unit& u, int wr, int wc, int fr, int fq) const {
        const int row0 = u.pm * 256 + wr * 64 + fr, col0 = u.pn * 256 + wc * 32 + 8 * fq;
#pragma unroll
        for (int ai = 0; ai < 2; ++ai)
#pragma unroll
            for (int m = 0; m < 4; ++m) { const size_t row = (size_t)(row0 + ai * 128 + m * 16); float sq = 0.f;
#pragma unroll
                for (int bj = 0; bj < 2; ++bj) { const size_t o = row * D + col0 + bj * 128;
                    const f32x4 v0 = acc[ai][bj][m][0] + *(const f32x4*)(x + o), v1 = acc[ai][bj][m][1] + *(const f32x4*)(x + o + 4);
                    *(u32x4*)(xb + o) = pack8(v0, v1);
                    { int w0 = __builtin_amdgcn_cvt_pk_fp8_f32(v0[0], v0[1], 0, false); w0 = __builtin_amdgcn_cvt_pk_fp8_f32(v0[2], v0[3], w0, true);
                      int w1 = __builtin_amdgcn_cvt_pk_fp8_f32(v1[0], v1[1], 0, false); w1 = __builtin_amdgcn_cvt_pk_fp8_f32(v1[2], v1[3], w1, true);
                      *(u32x2*)(x8 + o) = (u32x2){(unsigned)w0, (unsigned)w1}; }
                    sq += (v0[0] * v0[0] + v0[1] * v0[1]) + (v0[2] * v0[2] + v0[3] * v0[3]) + (v1[0] * v1[0] + v1[1] * v1[1]) + (v1[2] * v1[2] + v1[3] * v1[3]); }
                sq += __shfl_xor(sq, 16); sq += __shfl_xor(sq, 32);
                if (fq == 0) atomicAdd(ss + row, sq); }
    } };
struct EpiP5 { bf16_t* Q; const float* ss; EPI_RESET_ALWAYS
    __device__ __forceinline__ void operator()(AccT& acc, const pg8::Unit& u, int wr, int wc, int fr, int fq) const {
        const int row0 = u.pm * 256 + wr * 64 + fr, col0 = u.pn * 256 + wc * 32 + 8 * fq;
#pragma unroll
        for (int ai = 0; ai < 2; ++ai)
#pragma unroll
            for (int m = 0; m < 4; ++m) { const size_t row = (size_t)(row0 + ai * 128 + m * 16); const float rs = rsqrtf(ss[row] * (1.f / D) + EPS);
#pragma unroll
                for (int bj = 0; bj < 2; ++bj) *(u32x4*)(Q + row * D + col0 + bj * 128) = pack8(acc[ai][bj][m][0] * rs, acc[ai][bj][m][1] * rs); }
    } };


namespace att {
using s16x4  = __attribute__((ext_vector_type(4))) short;
using f32x16 = __attribute__((ext_vector_type(16))) float;
constexpr int NWV = 8, QBLK = 32, KVBLK = 64, DH = 128;
constexpr float THR = 8.f;
constexpr int SHM_V = KVBLK * DH * 2, SHM_K = KVBLK * DH * 2;
constexpr int OFF_WS = 2 * SHM_V + 2 * SHM_K, OFF_BT = OFF_WS + NWV * 64 * 4, OFF_OST = OFF_BT + 1536, LDS_NEED = OFF_OST + NWV * 8192;
#define KSWZ(row, colB) ((row) * 256 + ((colB) ^ (((row) & 7) << 4)))
#define SBAR() __builtin_amdgcn_sched_barrier(0)
__device__ __forceinline__ int crow(int r, int hi) { return (r & 3) + 8 * (r >> 2) + 4 * hi; }
__device__ __forceinline__ unsigned cvtpk(float lo, float hi) { unsigned r; asm volatile("v_cvt_pk_bf16_f32 %0, %1, %2" : "=v"(r) : "v"(lo), "v"(hi)); return r; }
__device__ __forceinline__ void partialSM(f32x16& p0, f32x16& p1, float& m_reg, float& mn, float& alpha) {
  constexpr float C = 1.4426950408889634f;
  float pmax = p0[0];
#pragma unroll
  for (int r = 1; r < 16; ++r) pmax = fmaxf(pmax, p0[r]);
#pragma unroll
  for (int r = 0; r < 16; ++r) pmax = fmaxf(pmax, p1[r]);
  { auto rr = __builtin_amdgcn_permlane32_swap(__float_as_uint(pmax), __float_as_uint(pmax), false, false);
    pmax = fmaxf(__uint_as_float(rr[0]), __uint_as_float(rr[1])); }
  if (__builtin_expect(__all(pmax - m_reg <= THR), 1)) { mn = m_reg; alpha = 1.f; }
  else { mn = fmaxf(m_reg, pmax); alpha = __builtin_amdgcn_exp2f((m_reg - mn) * C); m_reg = mn; }
  float mnC = -mn * C;
#pragma unroll
  for (int r = 0; r < 16; ++r) p0[r] = fmaf(p0[r], C, mnC);
#pragma unroll
  for (int r = 0; r < 16; ++r) p1[r] = fmaf(p1[r], C, mnC);
#pragma unroll
  for (int r = 0; r < 16; ++r) p0[r] = __builtin_amdgcn_exp2f(p0[r]);
}
__device__ __forceinline__ void finishSM(f32x16& p0, f32x16& p1, float alpha, float& l_reg, bf16x8& pa0, bf16x8& pa1, bf16x8& pa2, bf16x8& pa3) {
#pragma unroll
  for (int r = 0; r < 16; ++r) p1[r] = __builtin_amdgcn_exp2f(p1[r]);
  float ps = 0;
#pragma unroll
  for (int r = 0; r < 16; ++r) ps += p0[r];
#pragma unroll
  for (int r = 0; r < 16; ++r) ps += p1[r];
  { auto rr = __builtin_amdgcn_permlane32_swap(__float_as_uint(ps), __float_as_uint(ps), false, false);
    ps = __uint_as_float(rr[0]) + __uint_as_float(rr[1]); }
  l_reg = l_reg * alpha + ps;
#define PK4(P, BASE, OUT) do { unsigned a0 = cvtpk(P[BASE + 0], P[BASE + 1]), a1 = cvtpk(P[BASE + 2], P[BASE + 3]);   \
    unsigned b0 = cvtpk(P[BASE + 4], P[BASE + 5]), b1 = cvtpk(P[BASE + 6], P[BASE + 7]);                              \
    auto r0 = __builtin_amdgcn_permlane32_swap(a0, b0, false, false); auto r1 = __builtin_amdgcn_permlane32_swap(a1, b1, false, false); \
    u32x4 w = {r0[0], r1[0], r0[1], r1[1]}; OUT = *reinterpret_cast<bf16x8*>(&w); } while (0)
  PK4(p0, 0, pa0); PK4(p0, 8, pa1); PK4(p1, 0, pa2); PK4(p1, 8, pa3);
#undef PK4
}
template <bool BIAS>
__device__ __forceinline__ void qkt(f32x16& p0, f32x16& p1, const LAS char* Ks, const LAS char* qs, int r32, int hi, const LAS float* bp) {
  if (BIAS) {
#pragma unroll
    for (int r = 0; r < 16; ++r) { p0[r] = bp[(r & 3) + 8 * (r >> 2)]; p1[r] = bp[32 + (r & 3) + 8 * (r >> 2)]; }
  } else { p0 = f32x16{}; p1 = f32x16{}; }
#pragma unroll
  for (int d0 = 0; d0 < 8; ++d0) { int cb = (d0 * 16 + hi * 8) * 2;
    bf16x8 b0 = *reinterpret_cast<const LAS bf16x8*>(Ks + KSWZ(r32, cb));
    bf16x8 b1 = *reinterpret_cast<const LAS bf16x8*>(Ks + KSWZ(32 + r32, cb));
    const bf16x8 qv = *reinterpret_cast<const LAS bf16x8*>(qs + d0 * 1024);
    p0 = __builtin_amdgcn_mfma_f32_32x32x16_bf16(b0, qv, p0, 0, 0, 0);
    p1 = __builtin_amdgcn_mfma_f32_32x32x16_bf16(b1, qv, p1, 0, 0, 0); }
}
__device__ __forceinline__ int v_st(int k, int c) { const int kk = (k & ~0xC) | ((k & 4) << 1) | ((k & 8) >> 1); return ((kk >> 3) * 4 + (c >> 5)) * 512 + ((kk & 7) * 32 + (c & 31)) * 2; }
__device__ __forceinline__ int v_rd_base(int lane) { return ((lane & 3) << 3) | (((lane >> 2) & 3) << 6) | (((lane >> 4) & 1) << 5) | (((lane >> 5) & 1) << 8); }
constexpr int v_rd_off(int d0, int ks, int half) { return d0 * 512 + ks * 4096 + half * 2048; }
template <int OFF> __device__ __forceinline__ s16x4 tr_read(int vb) {
  s16x4 r; asm volatile("ds_read_b64_tr_b16 %0, %1 offset:%2" : "=&v"(r) : "v"(vb), "i"(OFF) : "memory"); return r;
}
template <int D0> __device__ __forceinline__ void pv_one(f32x16& od, int vb, bf16x8 pa0, bf16x8 pa1, bf16x8 pa2, bf16x8 pa3) {
  const s16x4 l0 = tr_read<v_rd_off(D0, 0, 0)>(vb), h0 = tr_read<v_rd_off(D0, 0, 1)>(vb), l1 = tr_read<v_rd_off(D0, 1, 0)>(vb), h1 = tr_read<v_rd_off(D0, 1, 1)>(vb);
  const s16x4 l2 = tr_read<v_rd_off(D0, 2, 0)>(vb), h2 = tr_read<v_rd_off(D0, 2, 1)>(vb), l3 = tr_read<v_rd_off(D0, 3, 0)>(vb), h3 = tr_read<v_rd_off(D0, 3, 1)>(vb);
  asm volatile("s_waitcnt lgkmcnt(0)" ::: "memory"); SBAR();
#define PK(L, H) (bf16x8){L[0], L[1], L[2], L[3], H[0], H[1], H[2], H[3]}
  od = __builtin_amdgcn_mfma_f32_32x32x16_bf16(pa0, PK(l0, h0), od, 0, 0, 0);
  od = __builtin_amdgcn_mfma_f32_32x32x16_bf16(pa1, PK(l1, h1), od, 0, 0, 0);
  od = __builtin_amdgcn_mfma_f32_32x32x16_bf16(pa2, PK(l2, h2), od, 0, 0, 0);
  od = __builtin_amdgcn_mfma_f32_32x32x16_bf16(pa3, PK(l3, h3), od, 0, 0, 0);
#undef PK
}
__device__ __forceinline__ void pv_d0(f32x16* o, int vb, bf16x8 pa0, bf16x8 pa1, bf16x8 pa2, bf16x8 pa3) {
  pv_one<0>(o[0], vb, pa0, pa1, pa2, pa3); pv_one<1>(o[1], vb, pa0, pa1, pa2, pa3); pv_one<2>(o[2], vb, pa0, pa1, pa2, pa3); pv_one<3>(o[3], vb, pa0, pa1, pa2, pa3);
}
template <int LDQ, int LDK, int LDO, bool BAND>
__device__ __forceinline__ void attn_body(const bf16_t* Qb, const bf16_t* Kh, const bf16_t* Vh, bf16_t* Ob,
                                          const int NT, const int kc0, const float* btab_src, LAS char* lds) {
  const int tid = threadIdx.x, wid = __builtin_amdgcn_readfirstlane(tid >> 6), lane = tid & 63, r32 = lane & 31, hi = lane >> 5;
  LAS char* V_lds = lds; LAS char* K_lds = lds + 2 * SHM_V;
  LAS float* wsf = (LAS float*)(lds + OFF_WS) + wid * 64; LAS float* li_l = wsf; LAS float* al_l = wsf + 32;
  LAS float* btab = (LAS float*)(lds + OFF_BT);
  if (BAND) { if (tid < 384) btab[tid] = tid < 64 ? btab_src[256] : (tid < 256 ? btab_src[320 - tid] : -30000.f); }
  float m_reg = -10000.f, l_reg = 0; f32x16 o[4] = {};
  const bf16_t* Qw = Qb + (long)(wid * QBLK + r32) * LDQ + hi * 8;
  LAS char* qr = lds + OFF_OST + wid * 8192 + lane * 16;
#pragma unroll
  for (int d0 = 0; d0 < 8; ++d0) *reinterpret_cast<LAS bf16x8*>(qr + d0 * 1024) = *reinterpret_cast<const bf16x8*>(Qw + d0 * 16);
  const int sr = tid >> 4, sc = (tid & 15) * 8, vst0 = v_st(sr, sc), vst1 = v_st(32 + sr, sc);
  const int vb0 = (int)(unsigned)(uintptr_t)V_lds + v_rd_base(lane);
  struct { bf16x8 vs0, vs1, ks0, ks1; } sr_[1];
  const int pw = wid >> 1, qi = (wid & 1) * 32 + r32;
#define TROW(t) ((BAND ? (((kc0) + (t)) > 0 ? ((kc0) + (t)) : 0) : (t)) * KVBLK)
#define SLOAD(i, t) do { const long k0_ = TROW(t); sr_[i].vs0 = *reinterpret_cast<const bf16x8*>(&Vh[(k0_ + sr) * LDK + sc]); sr_[i].vs1 = *reinterpret_cast<const bf16x8*>(&Vh[(k0_ + 32 + sr) * LDK + sc]); \
    sr_[i].ks0 = *reinterpret_cast<const bf16x8*>(&Kh[(k0_ + sr) * LDK + sc]); sr_[i].ks1 = *reinterpret_cast<const bf16x8*>(&Kh[(k0_ + 32 + sr) * LDK + sc]); } while (0)
#define SWRITE(b, i) do { *(LAS bf16x8*)(V_lds + (b) * SHM_V + vst0) = sr_[i].vs0; *(LAS bf16x8*)(V_lds + (b) * SHM_V + vst1) = sr_[i].vs1; int kc_ = sc * 2; \
    *(LAS bf16x8*)(K_lds + (b) * SHM_K + KSWZ(sr, kc_)) = sr_[i].ks0; *(LAS bf16x8*)(K_lds + (b) * SHM_K + KSWZ(32 + sr, kc_)) = sr_[i].ks1; } while (0)
#define SWAIT() asm volatile("s_waitcnt vmcnt(0)" ::: "memory")
#define RESC(a) do { if (__any((a) < 1.f)) { if (hi == 0) al_l[r32] = (a); asm volatile("s_waitcnt lgkmcnt(0)" ::: "memory"); \
    _Pragma("unroll") for (int d = 0; d < 4; ++d) _Pragma("unroll") for (int r = 0; r < 16; ++r) o[d][r] *= al_l[crow(r, hi)]; } } while (0)
#define BPTR(t) ({ const int t_ = (t); const int dch = pw + 8 - t_; int kb_ = 192 - dch * 64 - qi + 4 * hi; kb_ = kb_ < 0 ? 0 : kb_; \
    if (dch < 0 || dch > 8 || (kc0) + t_ < 0) kb_ = 288; (const LAS float*)(btab + kb_); })
  f32x16 pA0, pA1, pB0, pB1; float mnA, mnB, alA, alB; bf16x8 pa0, pa1, pa2, pa3;
  constexpr int SE = 0, SO = 0;
  SLOAD(SE, 0); asm volatile("s_waitcnt vmcnt(0)" ::: "memory"); SWRITE(0, SE); __syncthreads();
  qkt<BAND>(pA0, pA1, K_lds, qr, r32, hi, BPTR(0)); partialSM(pA0, pA1, m_reg, mnA, alA);
  SLOAD(SO, 1);
  SWAIT(); SWRITE(1, SO); __syncthreads();
  for (int j = 1; j + 1 < NT; j += 2) {
    SBAR(); qkt<BAND>(pB0, pB1, K_lds + SHM_K, qr, r32, hi, BPTR(j));
    finishSM(pA0, pA1, alA, l_reg, pa0, pa1, pa2, pa3); SBAR();
    SLOAD(SO, j + 1); SBAR();
    pv_d0(o, vb0, pa0, pa1, pa2, pa3); partialSM(pB0, pB1, m_reg, mnB, alB);
    __syncthreads(); SWAIT(); SWRITE(0, SE);
    RESC(alB); __syncthreads();
    SBAR(); qkt<BAND>(pA0, pA1, K_lds, qr, r32, hi, BPTR(j + 1));
    finishSM(pB0, pB1, alB, l_reg, pa0, pa1, pa2, pa3); SBAR();
    SLOAD(SE, j + 2); SBAR();
    pv_d0(o, vb0 + SHM_V, pa0, pa1, pa2, pa3); partialSM(pA0, pA1, m_reg, mnA, alA);
    __syncthreads(); SWAIT(); SWRITE(1, SO);
    RESC(alA); __syncthreads();
  }
  SBAR(); qkt<BAND>(pB0, pB1, K_lds + SHM_K, qr, r32, hi, BPTR(NT - 1));
  finishSM(pA0, pA1, alA, l_reg, pa0, pa1, pa2, pa3); SBAR();
  pv_d0(o, vb0, pa0, pa1, pa2, pa3); partialSM(pB0, pB1, m_reg, mnB, alB);
  __syncthreads(); RESC(alB);
  finishSM(pB0, pB1, alB, l_reg, pa0, pa1, pa2, pa3); SBAR();
  pv_d0(o, vb0 + SHM_V, pa0, pa1, pa2, pa3);
  if (hi == 0) li_l[r32] = l_reg; asm volatile("s_waitcnt lgkmcnt(0)" ::: "memory");
  float rli[16];
#pragma unroll
  for (int r = 0; r < 16; ++r) rli[r] = __builtin_amdgcn_rcpf(li_l[crow(r, hi)]);
  { LAS bf16_t* stg = (LAS bf16_t*)(lds + OFF_OST + wid * 8192);
#pragma unroll
    for (int r = 0; r < 16; ++r) { const int orow = crow(r, hi);
#pragma unroll
      for (int d0 = 0; d0 < 4; ++d0) stg[orow * 128 + d0 * 32 + r32] = (bf16_t)f2bf(o[d0][r] * rli[r]); }
    asm volatile("s_waitcnt lgkmcnt(0)" ::: "memory");
    bf16_t* Ow = Ob + (long)(wid * QBLK) * LDO;
#pragma unroll
    for (int i = 0; i < 8; ++i) { const int row = i * 4 + (lane >> 4), ch = lane & 15; const u32x4 v = *(const LAS u32x4*)(stg + row * 128 + ch * 8); *(u32x4*)(Ow + (long)row * LDO + ch * 8) = v; } }
  __syncthreads();
#undef TROW
#undef SLOAD
#undef SWRITE
#undef SWAIT
#undef RESC
#undef BPTR
}
#undef KSWZ
#undef SBAR
}


namespace rt {
using f32x16 = __attribute__((ext_vector_type(16))) float;
#define RKSWZ(row, colB) ((row) * 256 + ((colB) ^ (((row) & 7) << 4)))
__device__ __forceinline__ int crow(int r, int hi) { return (r & 3) + 8 * (r >> 2) + 4 * hi; }
__device__ __forceinline__ void ce_desc(unsigned& a, unsigned& b) { const unsigned mx = a > b ? a : b, mn = a > b ? b : a; a = mx; b = mn; }
__device__ __forceinline__ void sort16_desc(unsigned (&v)[16]) {
#pragma unroll
  for (int k = 2; k <= 16; k <<= 1)
#pragma unroll
    for (int j = k >> 1; j > 0; j >>= 1)
#pragma unroll
      for (int i = 0; i < 16; ++i) { const int l = i ^ j; if (l > i) { if ((i & k) == 0) ce_desc(v[i], v[l]); else ce_desc(v[l], v[i]); } }
}
__device__ __forceinline__ void merge16_desc(unsigned (&a)[16], const unsigned (&b)[16]) {
#pragma unroll
  for (int i = 0; i < 16; ++i) a[i] = a[i] > b[15 - i] ? a[i] : b[15 - i];
#pragma unroll
  for (int j = 8; j > 0; j >>= 1)
#pragma unroll
    for (int i = 0; i < 16; ++i) { const int l = i ^ j; if (l > i) ce_desc(a[i], a[l]); }
}
__device__ __forceinline__ unsigned fkey(float f) { const unsigned u = __float_as_uint(f); return (u & 0x80000000u) ? ~u : (u | 0x80000000u); }
__device__ __forceinline__ float fkey_inv(unsigned k) { const unsigned u = (k & 0x80000000u) ? (k & 0x7fffffffu) : ~k; return __uint_as_float(u); }
__device__ __forceinline__ void top16_half(const f32x16 (&sc)[4], int hi, unsigned (&out)[16]) {
  unsigned g[16];
#pragma unroll
  for (int blk = 0; blk < 4; ++blk) {
#pragma unroll
    for (int r = 0; r < 16; ++r) g[r] = (fkey(sc[blk][r]) & 0xFFFFFF80u) | (unsigned)(32 * blk + (r & 3) + 8 * (r >> 2) + 4 * hi);
    sort16_desc(g);
    if (blk == 0) {
#pragma unroll
      for (int r = 0; r < 16; ++r) out[r] = g[r];
    } else merge16_desc(out, g);
  }
  unsigned pb[16];
#pragma unroll
  for (int r = 0; r < 16; ++r) { auto rr = __builtin_amdgcn_permlane32_swap(out[r], out[r], false, false); pb[r] = hi ? rr[0] : rr[1]; }
  merge16_desc(out, pb);
}
__device__ __forceinline__ void route_phase(const Params& p, LAS unsigned char* lds, int tid, int lane, int wave) {
  const bf16_t* Q = (const bf16_t*)(p.ws + WS_Q); const bf16_t* KB = (const bf16_t*)(p.ws + WS_KEYSB);
  int* RIDX = (int*)(p.ws + WS_RIDX); float* RG = (float*)(p.ws + WS_RG);
  const int h = blockIdx.x & 7, grp = blockIdx.x >> 3;
  const int r32 = lane & 31, hi = lane >> 5;
#pragma unroll
  for (int c = 0; c < 2; ++c)
#pragma unroll
    for (int rep = 0; rep < 4; ++rep) { const int row = rep * 32 + (tid >> 4), cb = (tid & 15) * 16;
      *(LAS u32x4*)(lds + c * 32768 + RKSWZ(row, cb)) = *(const u32x4*)((const char*)KB + ((size_t)(h * 2 + c) * 128 + row) * 256 + cb); }
  __syncthreads();
  for (int tb = grp * 8 + wave; tb < T / 32; tb += (int)(gridDim.x >> 3) * 8) {
    const int t = tb * 32 + r32;
    unsigned ka[16], kb2[16];
#pragma unroll
    for (int c = 0; c < 2; ++c) {
      bf16x8 qf[8];
      const bf16_t* qp = Q + (size_t)t * D + h * 256 + c * 128 + hi * 8;
#pragma unroll
      for (int ks = 0; ks < 8; ++ks) qf[ks] = *(const bf16x8*)(qp + ks * 16);
      f32x16 sc[4];
#pragma unroll
      for (int blk = 0; blk < 4; ++blk) { sc[blk] = f32x16{};
#pragma unroll
        for (int ks = 0; ks < 8; ++ks) { const bf16x8 kf = *(const LAS bf16x8*)(lds + c * 32768 + RKSWZ(32 * blk + r32, (16 * ks + 8 * hi) * 2));
          sc[blk] = __builtin_amdgcn_mfma_f32_32x32x16_bf16(kf, qf[ks], sc[blk], 0, 0, 0); } }
      if (c == 0) top16_half(sc, hi, ka); else top16_half(sc, hi, kb2);
    }
    float av[16], bv[16];
#pragma unroll
    for (int i = 0; i < 16; ++i) { av[i] = fkey_inv(ka[i] & 0xFFFFFF80u); bv[i] = fkey_inv(kb2[i] & 0xFFFFFF80u); }
    float T[16];
#pragma unroll
    for (int k = 0; k < 16; ++k) T[k] = -3.0e38f;
#pragma unroll
    for (int i = 0; i < 16; ++i)
#pragma unroll
      for (int j = 0; j < 16; ++j) if ((i + 1) * (j + 1) <= 16) { float v = av[i] + bv[j];
#pragma unroll
          for (int k = 0; k < 16; ++k) { const float mx = fmaxf(T[k], v); v = fminf(T[k], v); T[k] = mx; } }
    const float m = T[0], theta = T[15];
    float Z = 0.f;
#pragma unroll
    for (int k = 0; k < 16; ++k) Z += __expf(T[k] - m);
    const float rz = 1.f / Z;
    int slot = 0; int cn = 0;
    int* ip = RIDX + (size_t)t * 128 + h * 16; float* gp = RG + (size_t)t * 128 + h * 16;
#pragma unroll
    for (int i = 0; i < 16; ++i)
#pragma unroll
      for (int j = 0; j < 16; ++j) if ((i + 1) * (j + 1) <= 16) { const float v = av[i] + bv[j];
          const bool sel = (v >= theta) && (slot < 16);
          if (sel && ((cn & 1) == hi)) { ip[slot] = (int)((ka[i] & 127u) * 128u + (kb2[j] & 127u)); gp[slot] = __expf(v - m) * rz; }
          slot += sel ? 1 : 0; ++cn; }
  }
}
#undef RKSWZ
}

#define XB_TMO      128
#define XB_XCNT(j)  (256  + 64 * (j))
#define XB_XSUB(j)  (1280 + 64 * (j))
#define XB_XGEN(j)  (2304 + 64 * (j))
#define XB_TOP      3328
#define XB_TOPGEN   3392
#define XCD_BAR_WORDS 3456
#define XB_SPIN_CAP (1u << 22)
__device__ __forceinline__ unsigned xb_ld(unsigned* p)              { return __hip_atomic_load(p, __ATOMIC_RELAXED, __HIP_MEMORY_SCOPE_AGENT); }
__device__ __forceinline__ unsigned xb_add(unsigned* p, unsigned v) { return __hip_atomic_fetch_add(p, v, __ATOMIC_RELAXED, __HIP_MEMORY_SCOPE_AGENT); }
__device__ __forceinline__ unsigned xb_xcc_id() { return (unsigned)__builtin_amdgcn_s_getreg((3 << 11) | 20) & 0xFu; }
#define XB_SPIN(cond, bar) do { unsigned _sp = 0; while (cond) { __builtin_amdgcn_s_sleep(1); \
    if ((++_sp & 255u) == 0u) { if (xb_ld(&(bar)[XB_TMO])) break; if (_sp > XB_SPIN_CAP) { atomicAdd(&(bar)[XB_TMO], 1u); break; } } } } while (0)
struct XcdBarrier { unsigned* bar; unsigned x; volatile LAS unsigned* st; };
__device__ __forceinline__ XcdBarrier xcd_barrier_post(unsigned* bar, volatile LAS unsigned* st) {
    XcdBarrier b; b.bar = bar; b.x = xb_xcc_id(); b.st = st;
    if (threadIdx.x == 0) (void)xb_add(&bar[XB_XCNT(b.x)], 1u);
    return b;
}
__device__ __forceinline__ void xcd_barrier_complete(unsigned* bar, unsigned x, unsigned& nloc, unsigned& nx) {
    const unsigned G = gridDim.x * gridDim.y * gridDim.z;
    unsigned sum, cnt, mine, sp = 0u;
    for (;;) {
        sum = 0u; cnt = 0u; mine = 0u;
#pragma unroll
        for (unsigned j = 0; j < 16; ++j) { const unsigned c = xb_ld(&bar[XB_XCNT(j)]); sum += c; cnt += (c > 0u) ? 1u : 0u; mine = (j == x) ? c : mine; }
        if (sum == G) break;
        __builtin_amdgcn_s_sleep(1);
        if ((++sp & 255u) == 0u) { if (xb_ld(&bar[XB_TMO])) break; if (sp > XB_SPIN_CAP) { atomicAdd(&bar[XB_TMO], 1u); break; } }
    }
    nloc = mine > 0u ? mine : 1u; nx = cnt > 0u ? cnt : 1u;
}
__device__ __forceinline__ void xcd_barrier(const XcdBarrier& b) {
    asm volatile("s_waitcnt vmcnt(0)" ::: "memory");
    __syncthreads();
    if (threadIdx.x == 0) {
        unsigned* bar = b.bar;
        __builtin_amdgcn_s_waitcnt(0);
        unsigned nloc = b.st[0], nx = b.st[1];
        if (nloc == 0u) { xcd_barrier_complete(bar, b.x, nloc, nx); b.st[0] = nloc; b.st[1] = nx; }
        const unsigned old = xb_add(&bar[XB_XSUB(b.x)], 1u);
        const unsigned gen = old / nloc;
        if (old + 1u == (gen + 1u) * nloc) {
            __builtin_amdgcn_fence(__ATOMIC_RELEASE, "agent");
            asm volatile("s_waitcnt vmcnt(0)" ::: "memory");
            const unsigned og = xb_add(&bar[XB_TOP], 1u);
            const unsigned tg = og / nx;
            if (og + 1u == (tg + 1u) * nx) xb_add(&bar[XB_TOPGEN], 1u);
            else XB_SPIN(xb_ld(&bar[XB_TOPGEN]) == tg, bar);
            __builtin_amdgcn_fence(__ATOMIC_ACQUIRE, "agent");
            xb_add(&bar[XB_XGEN(b.x)], 1u);
            asm volatile("s_waitcnt vmcnt(0)" ::: "memory");
        } else {
            XB_SPIN(xb_ld(&bar[XB_XGEN(b.x)]) == gen, bar);
            __builtin_amdgcn_fence(__ATOMIC_ACQUIRE, "agent");
            asm volatile("s_waitcnt vmcnt(0)" ::: "memory");
        }
    }
    __syncthreads();
}
constexpr int RING_BYTES = 131072, MISC_OFF = 143360, LDS_BYTES = 147456, NTHREADS = 512;
static_assert(att::LDS_NEED <= MISC_OFF, "attention scratch below the MISC words");
constexpr size_t WS_SLAB = WS_X2BF;

__device__ __forceinline__ void touch_buffer(const void* base, size_t bytes, int cb, int Gd, int tid) {
    const u32x4* b = (const u32x4*)base; const size_t n = bytes / 16, stride = (size_t)Gd * NTHREADS;
    u32x4 acc = {0u, 0u, 0u, 0u};
    for (size_t i = (size_t)cb * NTHREADS + tid; i < n; i += stride) { const u32x4 v = b[i]; acc.x ^= v.x; acc.y ^= v.y; acc.z ^= v.z; acc.w ^= v.w; }
    asm volatile("" :: "v"(acc.x), "v"(acc.y), "v"(acc.z), "v"(acc.w));
}
#define PH_BEGIN(i) unsigned long long t0_##i = 0; if ((PROBE_MASK >> (i)) & 1) t0_##i = __builtin_amdgcn_s_memrealtime();
#define PH_END(i) if ((PROBE_MASK >> (i)) & 1) probe_acc += __builtin_amdgcn_s_memrealtime() - t0_##i;
__global__ void __launch_bounds__(NTHREADS, 2) fwd(Params p) {
    extern __shared__ __attribute__((aligned(16))) unsigned char lds_raw[];
    LAS unsigned char* lds = (LAS unsigned char*)lds_raw;
    volatile LAS unsigned* MISC = (volatile LAS unsigned*)(lds + MISC_OFF);
    const int tid = threadIdx.x, lane = tid & 63, wave = __builtin_amdgcn_readfirstlane(tid >> 6);
    const int nwb = NTHREADS / 64;
    const int gw = blockIdx.x * nwb + wave, NW = gridDim.x * nwb;
    const int Gd = gridDim.x, cb = blockIdx.x;
    unsigned char* ws = p.ws;
    bf16_t* WT_IN = (bf16_t*)(ws + WS_WT_IN); bf16_t* WT_GATE = (bf16_t*)(ws + WS_WT_GATE); bf16_t* WT_BR = (bf16_t*)(ws + WS_WT_BR);
    bf16_t* WT_O = (bf16_t*)(ws + WS_WT_O); bf16_t* WT_PQ = (bf16_t*)(ws + WS_WT_PQ); bf16_t* WT_MKV = (bf16_t*)(ws + WS_WT_MKV);
    bf16_t* KEYSB = (bf16_t*)(ws + WS_KEYSB); bf16_t* MEMN = (bf16_t*)(ws + WS_MEMN); bf16_t* MEMKV = (bf16_t*)(ws + WS_MEMKV);
    bf16_t* HO = (bf16_t*)(ws + WS_HO); bf16_t* PROJ = (bf16_t*)(ws + WS_PROJ); bf16_t* G = (bf16_t*)(ws + WS_G);
    bf16_t* MERGED = (bf16_t*)(ws + WS_MERGED); bf16_t* X2BF = (bf16_t*)(ws + WS_X2BF); bf16_t* QB = (bf16_t*)(ws + WS_Q);
        float* SS2 = (float*)(ws + WS_CTL + CTL_SS2_BYTE);
    if (tid < 64) MISC[tid] = 0u;
    __syncthreads();
    XcdBarrier bar = xcd_barrier_post((unsigned*)(ws + WS_CTL + CTL_BAR_BYTE), MISC + 8);
    if (tid == 0) MISC[16] = xb_add((unsigned*)(ws + WS_CTL + CTL_RANK_BYTE) + 64 * bar.x, 1u);

    unsigned long long probe_acc = 0;
    PH_BEGIN(0)
    {
        float* scr = (float*)lds_raw + wave * (64 * 33);
        const int I0 = (D / 64) * (INW / 32), I1 = I0 + (D / 64) * (GW / 32), I2 = I1 + (D / 64) * (D / 32), I3 = I2 + (D / 64) * (D / 32), I4 = I3 + (D / 64) * (D / 32), I5 = I4 + (D / 64) * (2 * CW / 32);
#define TRJOB(it, jb, li) do { if ((it) < I0) { jb = TrJob{p.in[3], WT_IN, nullptr, D, INW, 0.f}; li = (it); } else if ((it) < I1) { jb = TrJob{p.in[18], WT_GATE, nullptr, D, GW, GATE_WSCALE}; li = (it) - I0; } \
            else if ((it) < I2) { jb = TrJob{p.in[20], WT_BR, nullptr, D, D, 0.f}; li = (it) - I1; } else if ((it) < I3) { jb = TrJob{p.in[21], WT_O, nullptr, D, D, 0.f}; li = (it) - I2; } \
            else if ((it) < I4) { jb = TrJob{p.in[23], WT_PQ, p.in[22], D, D, 0.f}; li = (it) - I3; } else { jb = TrJob{p.in[15], WT_MKV, nullptr, D, 2 * CW, 0.f}; li = (it) - I4; } } while (0)
        for (int it = gw; it < I5; it += 2 * NW) {
            TrJob ja, jb2; int la, lb; f32x4 va[8], vb[8];
            TRJOB(it, ja, la); tr_load(ja, la, lane, va);
            const bool has2 = it + NW < I5;
            if (has2) { TRJOB(it + NW, jb2, lb); tr_load(jb2, lb, lane, vb); }
            tr_store(ja, la, lane, va, scr);
            if (has2) tr_store(jb2, lb, lane, vb, scr);
        }
#undef TRJOB
        rms_rows(p.in[0], p.in[2], HO, ws + WS_H8, T, gw, NW, lane);
        rms_rows(p.in[1], p.in[14], MEMN, nullptr, BATCH * NMEM, gw, NW, lane);
        const float* keys = p.in[24];
        for (int i = gw * 64 + lane; i < PH * 2 * NKEYS * 128 / 2; i += NW * 64) ((unsigned*)KEYSB)[i] = pk2(keys[2 * i], keys[2 * i + 1]);
    }
    xcd_barrier(bar);
    PH_END(0)
    PH_BEGIN(1)
    {
        SchedP1a Sa{(const char*)HO, (const char*)WT_IN, (const char*)MEMN, (const char*)WT_MKV, Gd, cb};
        EpiP1a Ea{PROJ, MEMKV};
        pg8::gemm_phase<false>(lds, D, D, Sa, Ea);
        SchedP1b Sb{(const char*)(ws + WS_H8), (const char*)WT_GATE, Gd, cb};
        EpiP1b Eb{G, p.in[19]};
        pg8::gemm_phase<true>(lds, D / 2, D / 2, Sb, Eb);
    }
    xcd_barrier(bar);
    PH_END(1)
    PH_BEGIN(2)
    {
        const float qscale = 0.08838834764831845f;
        { HeadGains hg; load_head_gains(hg, p.in[4], p.in[5], p.in[16], lane);
          for (int t = gw; t < T; t += NW) headnorm_token(PROJ + (size_t)t * INW, hg, qscale, lane); }
        for (int it = gw; it < BATCH * NMEM * 4; it += NW) { const int m = it / 4, j = it % 4; headnorm(MEMKV + (size_t)m * (2 * CW) + j * 128, p.in[17], 1.f, lane); }
        for (int u = gw; u < BATCH * NCH * 8; u += NW) { const int g = u % 8, c = (u / 8) % NCH, b = u / (8 * NCH); lru_pass1(p, b, c, g, lane, lds + wave * 8192); }
        fp4_tables(p, gw, NW, lane);
    }
    xcd_barrier(bar);
    PH_END(2)
    PH_BEGIN(3)
    {
        const int nA = BATCH * 8 * (NCH / 4), nC = BATCH * 4 * (SEQ / 256);
        PH_BEGIN(9)
        for (int u = cb; u < nA + nC; u += Gd) {
            if (u < nA) {
                const int cg = u % (NCH / 4), h = (u / (NCH / 4)) % 8, b = u / ((NCH / 4) * 8);
                const size_t brow = (size_t)b * SEQ, qrow = brow + (size_t)cg * 256;
                att::attn_body<INW, INW, D, true>(PROJ + qrow * INW + C_QA + h * 128, PROJ + brow * INW + C_KA + h * 128, PROJ + brow * INW + C_VA + h * 128,
                                                  HO + qrow * D + h * 128, 12, cg * 4 - NPREV, p.in[6] + h * 257, (LAS char*)lds);
            } else {
                const int v = u - nA; const int qb = v % (SEQ / 256), h = (v / (SEQ / 256)) % 4, b = v / ((SEQ / 256) * 4);
                const size_t qrow = (size_t)b * SEQ + (size_t)qb * 256;
                att::attn_body<INW, 2 * CW, D, false>(PROJ + qrow * INW + C_QC + h * 128, MEMKV + (size_t)b * NMEM * (2 * CW) + h * 128, MEMKV + (size_t)b * NMEM * (2 * CW) + CW + h * 128,
                                                     HO + qrow * D + AW + LW + h * 128, NMEM / 64, 0, nullptr, (LAS char*)lds);
            }
        }
        PH_END(9)
        PH_BEGIN(10)
        for (int u = gw; u < BATCH * NCH * 8; u += NW) { const int g = u % 8, c = (u / 8) % NCH, b = u / (8 * NCH); lru_pass2(p, b, c, g, lane); }
        touch_buffer(WT_BR, (size_t)D * D * 2, cb, Gd, tid); touch_buffer(WT_O, (size_t)D * D * 2, cb, Gd, tid);
        PH_END(10)
    }
    xcd_barrier(bar);
    PH_END(3)
    PH_BEGIN(4)
    {
        SchedP3 S{(const char*)HO, (const char*)WT_BR, Gd, cb};
        EpiP3 E{G, MERGED};
        pg8::gemm_phase<false>(lds, D, D, S, E);
    }
    xcd_barrier(bar);
    PH_END(4)
    PH_BEGIN(5)
    {
        SchedSq S{(const char*)MERGED, (const char*)WT_O, Gd, cb};
        EpiP4 E{p.in[0], p.out, X2BF, SS2, ws + WS_X2F8};
        pg8::gemm_phase<false>(lds, D, D, S, E);
        touch_buffer(WT_PQ, (size_t)D * D * 2, cb, Gd, tid);
    }
    xcd_barrier(bar);
    PH_END(5)
    PH_BEGIN(6)
    {
        SchedSq S{(const char*)X2BF, (const char*)WT_PQ, Gd, cb};
        EpiP5 E{QB, SS2};
        pg8::gemm_phase<false>(lds, D, D, S, E);
    }
    xcd_barrier(bar);
    PH_END(6)
    PH_BEGIN(7)
    rt::route_phase(p, lds, tid, lane, wave);
    xcd_barrier(bar);
    PH_END(7)
    PH_BEGIN(8)
    int ppos, pnx, prank, pnloc;
    { if (tid == 0) { unsigned pos = 0, nx = 0; const unsigned* bw = (const unsigned*)(ws + WS_CTL + CTL_BAR_BYTE);
#pragma unroll
          for (unsigned j = 0; j < 16; ++j) { const unsigned cj = xb_ld((unsigned*)&bw[XB_XCNT(j)]); nx += cj > 0u ? 1u : 0u; pos += (cj > 0u && j < bar.x) ? 1u : 0u; }
          MISC[17] = pos; MISC[18] = nx > 0u ? nx : 1u; }
      __syncthreads();
      ppos = (int)MISC[17]; pnx = (int)MISC[18]; prank = (int)MISC[16]; pnloc = (int)MISC[8]; if (pnloc < 1) pnloc = 1; }
    peer_u_step(p, lane, wave, lds + wave * 16384, ppos, pnx, prank, pnloc);
    xcd_barrier(bar);
    for (int t = gw; t < T; t += NW) peer_combine(p, t, lane);
    xcd_barrier(bar);
    peer_v_step(p, lane, wave, lds + wave * 16384, ppos, pnx, prank, pnloc);
    if (PROBE_MASK) { __syncthreads(); PH_END(8) const unsigned long long te = __builtin_amdgcn_s_memrealtime(); while (__builtin_amdgcn_s_memrealtime() - te < probe_acc) __builtin_amdgcn_s_sleep(8); }
}

extern "C" void kernel_launch(void* const* d_in, const int* in_sizes, int n_in, void* d_out, int out_size, void* d_ws, size_t ws_size, hipStream_t stream) {
    static int grid = 0;
    if (grid == 0) {
        if (n_in != 27 || out_size != T * D || ws_size < WS_END) { fprintf(stderr, "kernel_launch: unexpected problem (n_in %d out %d ws %zu)\n", n_in, out_size, ws_size); grid = -1; return; }
        int dev = 0, cus = 0, per_cu = 0;
        (void)hipGetDevice(&dev); (void)hipDeviceGetAttribute(&cus, hipDeviceAttributeMultiprocessorCount, dev);
        if (hipFuncSetAttribute((const void*)fwd, hipFuncAttributeMaxDynamicSharedMemorySize, LDS_BYTES) != hipSuccess) { fprintf(stderr, "kernel_launch: hipFuncSetAttribute failed\n"); grid = -1; return; }
        (void)hipOccupancyMaxActiveBlocksPerMultiprocessor(&per_cu, (const void*)fwd, NTHREADS, LDS_BYTES);
        if (per_cu < 1) { fprintf(stderr, "kernel_launch: occupancy query says %d\n", per_cu); grid = -1; return; }
        grid = cus;
    }
    if (grid < 0) return;
    (void)hipMemsetAsync((char*)d_ws + WS_CTL, 0, 1 * MiB, stream);
    Params p{};
    for (int i = 0; i < 27; ++i) p.in[i] = (const float*)d_in[i];
    p.out = (float*)d_out; p.ws = (unsigned char*)d_ws;
    void* args[] = {&p};
    hipError_t e = hipLaunchCooperativeKernel((const void*)fwd, dim3(grid), dim3(NTHREADS), args, LDS_BYTES, stream);
    if (e != hipSuccess) fprintf(stderr, "cooperative launch failed: %s (grid %d)\n", hipGetErrorString(e), grid);
}
```

```cpp
#include <hip/hip_runtime.h>
#include <hip/hip_cooperative_groups.h>
#include <cstdio>
#include <cstdint>
namespace cg = cooperative_groups;
#ifndef PROBE_MASK
#define PROBE_MASK 0
#endif

#define LAS __attribute__((address_space(3)))
typedef unsigned short bf16_t;
typedef short bf16x8 __attribute__((ext_vector_type(8)));
typedef float f32x4 __attribute__((ext_vector_type(4)));
typedef unsigned u32x4 __attribute__((ext_vector_type(4)));
typedef unsigned u32x2 __attribute__((ext_vector_type(2)));

constexpr int D = 2048, BATCH = 2, SEQ = 8192, T = BATCH * SEQ;
constexpr int CHUNK = 64, NPREV = 8, NCH = SEQ / CHUNK;
constexpr int AW = 1024, LW = 512, CW = 512, INW = 4608, GW = 6144;
constexpr int NMEM = 256;
constexpr int PH = 8, NKEYS = 128, TOPK = 16;
constexpr float EPS = 1e-6f;
constexpr int C_QA = 0, C_KA = 1024, C_VA = 2048, C_XL = 3072, C_GL = 3584, C_QC = 4096;

constexpr size_t MiB = 1u << 20;
constexpr size_t WS_CTL = 0;
constexpr size_t WS_WT_IN = 2 * MiB, WS_WT_GATE = 20 * MiB, WS_WT_BR = 44 * MiB, WS_WT_O = 52 * MiB, WS_WT_PQ = 60 * MiB, WS_WT_MKV = 68 * MiB;
constexpr size_t WS_KEYSB = 72 * MiB, WS_MEMN = 73 * MiB, WS_MEMKV = 75 * MiB, WS_LRUSUM = 76 * MiB, WS_RS2 = 77 * MiB;
constexpr size_t WS_HO = 80 * MiB;
constexpr size_t WS_PROJ = 144 * MiB;
constexpr size_t WS_MERGED = 144 * MiB, WS_X2BF = 208 * MiB;
constexpr size_t WS_G = 288 * MiB;
constexpr size_t WS_TABU = 496 * MiB, WS_TABV = 512 * MiB, WS_Q = 416 * MiB;
constexpr size_t WS_SCU = 77 * MiB, WS_SCV = 77 * MiB + 65536;
constexpr size_t WS_AUA = 2 * MiB, WS_AUU = 18 * MiB;
constexpr size_t WS_H8 = 496 * MiB;
constexpr float GATE_WSCALE = 256.f;
constexpr size_t WS_RIDX = 480 * MiB, WS_RG = 488 * MiB, WS_END = 528 * MiB;

constexpr size_t CTL_BAR_BYTE = 16384, CTL_RANK_BYTE = 65536, CTL_SS2_BYTE = 512 * 1024;
struct Params { const float* in[27]; float* out; unsigned char* ws; };

__device__ __forceinline__ float bf2f(unsigned v16) { return __uint_as_float(v16 << 16); }
typedef float f32x2c __attribute__((ext_vector_type(2))); typedef __bf16 bf16x2c __attribute__((ext_vector_type(2)));
__device__ __forceinline__ unsigned pk2(float lo, float hi) { const f32x2c v = {lo, hi}; return __builtin_bit_cast(unsigned, __builtin_convertvector(v, bf16x2c)); }
__device__ __forceinline__ unsigned f2bf(float f) { return pk2(f, 0.f) & 0xffffu; }
__device__ __forceinline__ float wave_sum(float v) {
#pragma unroll
    for (int o = 1; o < 64; o <<= 1) v += __shfl_xor(v, o);
    return v;
}
typedef __bf16 bf16x2_t __attribute__((ext_vector_type(2)));
__device__ __forceinline__ float dot2bf(unsigned w, unsigned x, float acc) { return __builtin_amdgcn_fdot2_f32_bf16(__builtin_bit_cast(bf16x2_t, w), __builtin_bit_cast(bf16x2_t, x), acc, false); }
__device__ __forceinline__ float sigmoid_(float x) { return 1.f / (1.f + __expf(-x)); }
__device__ __forceinline__ float gelu_tanh(float x) { const float y = 1.5957691216f * (x + 0.044715f * x * x * x); return x / (1.f + __expf(-y)); }
__device__ __forceinline__ void unpack8(const u32x4 w, float* f) {
    f[0] = __uint_as_float(w.x << 16); f[1] = __uint_as_float(w.x & 0xffff0000u);
    f[2] = __uint_as_float(w.y << 16); f[3] = __uint_as_float(w.y & 0xffff0000u);
    f[4] = __uint_as_float(w.z << 16); f[5] = __uint_as_float(w.z & 0xffff0000u);
    f[6] = __uint_as_float(w.w << 16); f[7] = __uint_as_float(w.w & 0xffff0000u);
}

struct TrJob { const float* W; bf16_t* WT; const float* ks; int K, N; float f8scale; };
__device__ __forceinline__ void tr_load(const TrJob& jb, int item, int lane, f32x4 (&v)[8]) {
    const int nblk = jb.N / 32, kb = item / nblk, nb = item % nblk, k0 = 64 * kb, n0 = 32 * nb;
#pragma unroll
    for (int i = 0; i < 8; ++i) { const int kk = 8 * i + (lane >> 3); v[i] = *(const f32x4*)(jb.W + (size_t)(k0 + kk) * jb.N + n0 + 4 * (lane & 7)); if (jb.ks) v[i] = v[i] * jb.ks[k0 + kk]; }
}
__device__ __forceinline__ void tr_store(const TrJob& jb, int item, int lane, const f32x4 (&v)[8], LAS float* scr) {
    const int nblk = jb.N / 32, kb = item / nblk, nb = item % nblk, k0 = 64 * kb, n0 = 32 * nb;
#pragma unroll
    for (int i = 0; i < 8; ++i) { LAS float* d = scr + (8 * i + (lane >> 3)) * 33 + 4 * (lane & 7); d[0] = v[i].x; d[1] = v[i].y; d[2] = v[i].z; d[3] = v[i].w; }
    asm volatile("s_waitcnt lgkmcnt(0)" ::: "memory");
    const int c = lane & 7;
#pragma unroll
    for (int j = 0; j < 4; ++j) { const int n = (lane >> 3) + 8 * j; const LAS float* s = scr + (8 * c) * 33 + n;
        if (jb.f8scale != 0.f) { const float f = jb.f8scale; u32x2 o;
#define F8C(x_) fminf(fmaxf((x_) * f, -448.f), 448.f)
            int w = __builtin_amdgcn_cvt_pk_fp8_f32(F8C(s[0 * 33]), F8C(s[1 * 33]), 0, false); w = __builtin_amdgcn_cvt_pk_fp8_f32(F8C(s[2 * 33]), F8C(s[3 * 33]), w, true); o.x = (unsigned)w;
            w = __builtin_amdgcn_cvt_pk_fp8_f32(F8C(s[4 * 33]), F8C(s[5 * 33]), 0, false); w = __builtin_amdgcn_cvt_pk_fp8_f32(F8C(s[6 * 33]), F8C(s[7 * 33]), w, true); o.y = (unsigned)w;
#undef F8C
            *(u32x2*)((unsigned char*)jb.WT + (size_t)(n0 + n) * jb.K + k0 + 8 * c) = o; }
        else { u32x4 o; o.x = pk2(s[0 * 33], s[1 * 33]); o.y = pk2(s[2 * 33], s[3 * 33]); o.z = pk2(s[4 * 33], s[5 * 33]); o.w = pk2(s[6 * 33], s[7 * 33]);
            *(u32x4*)(jb.WT + (size_t)(n0 + n) * jb.K + k0 + 8 * c) = o; } }
    asm volatile("s_waitcnt lgkmcnt(0)" ::: "memory");
}
__device__ __forceinline__ void rms_row_load(const float* xrow, int lane, f32x4 (&v)[8]) {
    const f32x4* xr = (const f32x4*)xrow + lane;
#pragma unroll
    for (int j = 0; j < 8; ++j) v[j] = xr[64 * j];
}
__device__ __forceinline__ void rms_row_finish(const f32x4 (&v)[8], const float* g, bf16_t* orow, unsigned char* o8row, int lane) {
    const f32x4* gr = (const f32x4*)g + lane; float s = 0.f;
#pragma unroll
    for (int j = 0; j < 8; ++j) s += (v[j].x * v[j].x + v[j].y * v[j].y) + (v[j].z * v[j].z + v[j].w * v[j].w);
    const float rstd = rsqrtf(wave_sum(s) * (1.f / D) + EPS);
    u32x2* o8 = (u32x2*)orow + lane;
#pragma unroll
    for (int j = 0; j < 8; ++j) { const f32x4 gg = gr[64 * j]; const float a0 = v[j].x * rstd * gg.x, a1 = v[j].y * rstd * gg.y, a2 = v[j].z * rstd * gg.z, a3 = v[j].w * rstd * gg.w;
        u32x2 o; o.x = pk2(a0, a1); o.y = pk2(a2, a3); o8[64 * j] = o;
        if (o8row) { int w = __builtin_amdgcn_cvt_pk_fp8_f32(fminf(fmaxf(a0, -448.f), 448.f), fminf(fmaxf(a1, -448.f), 448.f), 0, false);
            w = __builtin_amdgcn_cvt_pk_fp8_f32(fminf(fmaxf(a2, -448.f), 448.f), fminf(fmaxf(a3, -448.f), 448.f), w, true); ((unsigned*)o8row)[64 * j + lane] = (unsigned)w; } }
}
__device__ __forceinline__ void rms_rows(const float* X, const float* g, bf16_t* O, unsigned char* O8, int nrows, int gw, int NW, int lane) {
    f32x4 va[8], vb[8];
    int m = gw;
    if (m < nrows) rms_row_load(X + (size_t)m * D, lane, va);
    for (; m < nrows; m += 2 * NW) {
        const bool hb = m + NW < nrows;
        if (hb) rms_row_load(X + (size_t)(m + NW) * D, lane, vb);
        rms_row_finish(va, g, O + (size_t)m * D, O8 ? O8 + (size_t)m * D : nullptr, lane);
        if (m + 2 * NW < nrows) rms_row_load(X + (size_t)(m + 2 * NW) * D, lane, va);
        if (hb) rms_row_finish(vb, g, O + (size_t)(m + NW) * D, O8 ? O8 + (size_t)(m + NW) * D : nullptr, lane);
    }
}

template <int TM, int TN, class Epi>
__device__ __forceinline__ void gemm_simple(const bf16_t* __restrict__ A, int lda, const bf16_t* __restrict__ Bt, int ldb, int M, int N, int K, const Epi& epi, int gw, int NW, int lane) {
    const int r = lane & 15, q = lane >> 4;
    const int ntm = M / (16 * TM), ntn = N / (16 * TN);
    for (int tile = gw; tile < ntm * ntn; tile += NW) {
        const int tm = tile / ntn, tn = tile % ntn;
        f32x4 acc[TM][TN];
#pragma unroll
        for (int i = 0; i < TM; ++i)
#pragma unroll
            for (int j = 0; j < TN; ++j) acc[i][j] = (f32x4){0.f, 0.f, 0.f, 0.f};
        const bf16_t* ap = A + (size_t)(tm * 16 * TM + r) * lda + q * 8;
        const bf16_t* bp = Bt + (size_t)(tn * 16 * TN + r) * ldb + q * 8;
        for (int k0 = 0; k0 < K; k0 += 32) {
            bf16x8 af[TM], bfr[TN];
#pragma unroll
            for (int i = 0; i < TM; ++i) af[i] = *(const bf16x8*)(ap + (size_t)i * 16 * lda + k0);
#pragma unroll
            for (int j = 0; j < TN; ++j) bfr[j] = *(const bf16x8*)(bp + (size_t)j * 16 * ldb + k0);
#pragma unroll
            for (int i = 0; i < TM; ++i)
#pragma unroll
                for (int j = 0; j < TN; ++j) acc[i][j] = __builtin_amdgcn_mfma_f32_16x16x32_bf16(af[i], bfr[j], acc[i][j], 0, 0, 0);
        }
#pragma unroll
        for (int i = 0; i < TM; ++i)
#pragma unroll
            for (int j = 0; j < TN; ++j)
#pragma unroll
                for (int e = 0; e < 4; ++e) epi(tm * 16 * TM + i * 16 + q * 4 + e, tn * 16 * TN + j * 16 + r, acc[i][j][e]);
    }
}
struct EpiProj { bf16_t* P; __device__ __forceinline__ void operator()(int row, int col, float v) const { if (col >= C_GL && col < C_QC) v = gelu_tanh(v); P[(size_t)row * INW + col] = (bf16_t)f2bf(v); } };
struct EpiGate { bf16_t* G; const float* b; __device__ __forceinline__ void operator()(int row, int col, float v) const { G[(size_t)row * GW + col] = (bf16_t)f2bf(sigmoid_(v + b[col])); } };
struct EpiStore { bf16_t* C; int ldc; __device__ __forceinline__ void operator()(int row, int col, float v) const { C[(size_t)row * ldc + col] = (bf16_t)f2bf(v); } };
struct EpiWo { const float* x; float* out; bf16_t* xb; __device__ __forceinline__ void operator()(int row, int col, float v) const { const size_t o = (size_t)row * D + col; const float y = x[o] + v; out[o] = y; xb[o] = (bf16_t)f2bf(y); } };
struct EpiQ { bf16_t* Q; const float* rs; __device__ __forceinline__ void operator()(int row, int col, float v) const { Q[(size_t)row * D + col] = (bf16_t)f2bf(v * rs[row]); } };

__device__ __forceinline__ void headnorm(bf16_t* vec, const float* g, float scale, int lane) {
    unsigned* p = (unsigned*)vec + lane; const unsigned w = *p;
    const float a = bf2f(w & 0xffffu), b = bf2f(w >> 16);
    const float rs = rsqrtf(wave_sum(a * a + b * b) * (1.f / 128.f) + EPS) * scale;
    *p = pk2(a * rs * g[2 * lane], b * rs * g[2 * lane + 1]);
}
struct HeadGains { float gq[32], gk[32], gc[8]; };
__device__ __forceinline__ void load_head_gains(HeadGains& hg, const float* gq, const float* gk, const float* gc, int lane) {
#pragma unroll
    for (int j = 0; j < 32; ++j) { hg.gq[j] = gq[(lane & 3) * 32 + j]; hg.gk[j] = gk[(lane & 3) * 32 + j]; }
#pragma unroll
    for (int j = 0; j < 8; ++j) hg.gc[j] = gc[(lane & 15) * 8 + j];
}
__device__ __forceinline__ void headnorm_token(bf16_t* row, const HeadGains& hg, float qscale, int lane) {
    u32x4* pa = (u32x4*)(row + C_QA) + lane * 4;
    u32x4* pc = (u32x4*)(row + C_QC) + lane;
    u32x4 w[4]; const u32x4 wc = *pc;
#pragma unroll
    for (int j = 0; j < 4; ++j) w[j] = pa[j];
    float f[32], fc[8]; float ss = 0.f, sc = 0.f;
#pragma unroll
    for (int j = 0; j < 4; ++j) unpack8(w[j], f + 8 * j);
    unpack8(wc, fc);
#pragma unroll
    for (int j = 0; j < 32; ++j) ss = fmaf(f[j], f[j], ss);
#pragma unroll
    for (int j = 0; j < 8; ++j) sc = fmaf(fc[j], fc[j], sc);
    ss += __shfl_xor(ss, 1); ss += __shfl_xor(ss, 2);
    sc += __shfl_xor(sc, 1); sc += __shfl_xor(sc, 2); sc += __shfl_xor(sc, 4); sc += __shfl_xor(sc, 8);
    const bool isq = lane < 32;
    const float rs = rsqrtf(ss * (1.f / 128.f) + EPS) * (isq ? qscale : 1.f), rc = rsqrtf(sc * (1.f / 128.f) + EPS) * qscale;
#pragma unroll
    for (int j = 0; j < 4; ++j) { u32x4 o;
        o.x = pk2(f[8 * j] * rs * (isq ? hg.gq[8 * j] : hg.gk[8 * j]), f[8 * j + 1] * rs * (isq ? hg.gq[8 * j + 1] : hg.gk[8 * j + 1]));
        o.y = pk2(f[8 * j + 2] * rs * (isq ? hg.gq[8 * j + 2] : hg.gk[8 * j + 2]), f[8 * j + 3] * rs * (isq ? hg.gq[8 * j + 3] : hg.gk[8 * j + 3]));
        o.z = pk2(f[8 * j + 4] * rs * (isq ? hg.gq[8 * j + 4] : hg.gk[8 * j + 4]), f[8 * j + 5] * rs * (isq ? hg.gq[8 * j + 5] : hg.gk[8 * j + 5]));
        o.w = pk2(f[8 * j + 6] * rs * (isq ? hg.gq[8 * j + 6] : hg.gk[8 * j + 6]), f[8 * j + 7] * rs * (isq ? hg.gq[8 * j + 7] : hg.gk[8 * j + 7]));
        pa[j] = o; }
    { u32x4 o; o.x = pk2(fc[0] * rc * hg.gc[0], fc[1] * rc * hg.gc[1]); o.y = pk2(fc[2] * rc * hg.gc[2], fc[3] * rc * hg.gc[3]);
      o.z = pk2(fc[4] * rc * hg.gc[4], fc[5] * rc * hg.gc[5]); o.w = pk2(fc[6] * rc * hg.gc[6], fc[7] * rc * hg.gc[7]); *pc = o; }
}

__device__ __forceinline__ void lru_pass1(const Params& p, int b, int c, int g, int lane, LAS unsigned char* wl  ) {
    const bf16_t* PROJ = (const bf16_t*)(p.ws + WS_PROJ);
    float* SUMA = (float*)(p.ws + WS_LRUSUM); float* SUMB = SUMA + BATCH * NCH * LW;
    bf16_t* AUA = (bf16_t*)(p.ws + WS_AUA); bf16_t* AUU = (bf16_t*)(p.ws + WS_AUU);
    const float* conv_w = p.in[7]; const float* conv_b = p.in[8]; const float* lru_wa = p.in[9]; const float* lru_ba = p.in[10];
    const float* lru_wx = p.in[11]; const float* lru_bx = p.in[12]; const float* lam = p.in[13];
    const int ch = g * 64 + lane;
    unsigned wa_p[32], wx_p[32];
#pragma unroll
    for (int m = 0; m < 32; ++m) { wa_p[m] = pk2(lru_wa[(size_t)(g * 64 + 2 * m) * 64 + lane], lru_wa[(size_t)(g * 64 + 2 * m + 1) * 64 + lane]);
        wx_p[m] = pk2(lru_wx[(size_t)(g * 64 + 2 * m) * 64 + lane], lru_wx[(size_t)(g * 64 + 2 * m + 1) * 64 + lane]); }
    const float cw0 = conv_w[0 * LW + ch], cw1 = conv_w[1 * LW + ch], cw2 = conv_w[2 * LW + ch], cw3 = conv_w[3 * LW + ch], cb = conv_b[ch];
    const float ba_ = lru_ba[ch], bx_ = lru_bx[ch];
    const float sp = log1pf(__expf(-lam[ch]));
    const int t0 = c * CHUNK; const size_t row0 = (size_t)b * SEQ + t0;
    float x0 = 0.f, x1 = 0.f, x2 = 0.f;
    if (t0 >= 3) { x0 = bf2f(PROJ[(row0 - 3) * INW + C_XL + ch]); x1 = bf2f(PROJ[(row0 - 2) * INW + C_XL + ch]); x2 = bf2f(PROJ[(row0 - 1) * INW + C_XL + ch]); }
    { const bf16_t* xs = PROJ + (row0 + (lane >> 3)) * INW + C_XL + g * 64 + (lane & 7) * 8;
      u32x4 tx[8];
#pragma unroll
      for (int i = 0; i < 8; ++i) tx[i] = *(const u32x4*)(xs + (size_t)(8 * i) * INW);
#pragma unroll
      for (int i = 0; i < 8; ++i) *(LAS u32x4*)(wl + (8 * i + (lane >> 3)) * 128 + (lane & 7) * 16) = tx[i]; }
    float h = 0.f, aprod = 1.f;
#define LRU_PAIRX(xc_) ({ const float xnb_ = __int_as_float(__builtin_amdgcn_update_dpp(0, __float_as_int(xc_), 0xB1, 0xf, 0xf, true));     \
        (lane & 1) ? pk2(xnb_, xc_) : pk2(xc_, xnb_); })
#define LRU_GATE(rp_, ip_, xc_, a_, u_) do { const float r_ = sigmoid_(rp_), ig_ = sigmoid_(ip_); const float la_ = -8.f * r_ * sp; a_ = __expf(la_); \
        u_ = sqrtf(fminf(fmaxf((1.f - a_) * (1.f + a_), 1e-12f), 1.f)) * ig_ * xc_; } while (0)
#pragma unroll 1
    for (int t = 0; t < CHUNK; t += 2) {
        const float x3 = bf2f(*(const LAS bf16_t*)(wl + t * 128 + lane * 2)), x4 = bf2f(*(const LAS bf16_t*)(wl + (t + 1) * 128 + lane * 2));
        const float xcA = cw0 * x0 + cw1 * x1 + cw2 * x2 + cw3 * x3 + cb, xcB = cw0 * x1 + cw1 * x2 + cw2 * x3 + cw3 * x4 + cb;
        x0 = x2; x1 = x3; x2 = x4;
        const unsigned pkA = LRU_PAIRX(xcA), pkB = LRU_PAIRX(xcB);
        float rA = ba_, iA = bx_, rA2 = 0.f, iA2 = 0.f, rB = ba_, iB = bx_, rB2 = 0.f, iB2 = 0.f;
#pragma unroll
        for (int m = 0; m < 32; m += 2) {
            const unsigned a0 = (unsigned)__builtin_amdgcn_readlane((int)pkA, 2 * m), a1 = (unsigned)__builtin_amdgcn_readlane((int)pkA, 2 * m + 2);
            const unsigned b0 = (unsigned)__builtin_amdgcn_readlane((int)pkB, 2 * m), b1 = (unsigned)__builtin_amdgcn_readlane((int)pkB, 2 * m + 2);
            rA = dot2bf(wa_p[m], a0, rA); iA = dot2bf(wx_p[m], a0, iA); rA2 = dot2bf(wa_p[m + 1], a1, rA2); iA2 = dot2bf(wx_p[m + 1], a1, iA2);
            rB = dot2bf(wa_p[m], b0, rB); iB = dot2bf(wx_p[m], b0, iB); rB2 = dot2bf(wa_p[m + 1], b1, rB2); iB2 = dot2bf(wx_p[m + 1], b1, iB2); }
        float aA, uA, aB, uB;
        LRU_GATE(rA + rA2, iA + iA2, xcA, aA, uA); LRU_GATE(rB + rB2, iB + iB2, xcB, aB, uB);
        const unsigned wA = f2bf(1.f - aA), wB = f2bf(1.f - aB), vA = f2bf(uA), vB = f2bf(uB);
        AUA[(row0 + t) * LW + ch] = (bf16_t)wA; AUA[(row0 + t + 1) * LW + ch] = (bf16_t)wB; AUU[(row0 + t) * LW + ch] = (bf16_t)vA; AUU[(row0 + t + 1) * LW + ch] = (bf16_t)vB;
        const float aAq = 1.f - bf2f(wA), aBq = 1.f - bf2f(wB);
        h = aBq * (aAq * h + bf2f(vA)) + bf2f(vB);
        aprod *= aAq * aBq;
    }
#undef LRU_PAIRX
#undef LRU_GATE
    { const size_t o = (size_t)(b * NCH + c) * LW + ch; SUMA[o] = aprod; SUMB[o] = h; }
}
__device__ __forceinline__ void lru_pass2(const Params& p, int b, int c, int g, int lane) {
    const bf16_t* PROJ = (const bf16_t*)(p.ws + WS_PROJ); bf16_t* O = (bf16_t*)(p.ws + WS_HO);
    const float* SUMA = (const float*)(p.ws + WS_LRUSUM); const float* SUMB = SUMA + BATCH * NCH * LW;
    const bf16_t* AUA = (const bf16_t*)(p.ws + WS_AUA); const bf16_t* AUU = (const bf16_t*)(p.ws + WS_AUU);
    const int ch = g * 64 + lane; const size_t row0 = (size_t)b * SEQ + (size_t)c * CHUNK;
    const bf16_t* ap = AUA + row0 * LW + ch; const bf16_t* up = AUU + row0 * LW + ch; const bf16_t* gp = PROJ + row0 * INW + C_GL + ch;
    bf16_t an[16], un[16], gn[16];
#pragma unroll
    for (int q = 0; q < 16; ++q) { an[q] = ap[(size_t)q * LW]; un[q] = up[(size_t)q * LW]; gn[q] = gp[(size_t)q * INW]; }
    float h = 0.f;
    {
        int j = 0;
#pragma unroll 1
        for (; j + 32 <= c; j += 32) { float sa[32], sb[32];
#pragma unroll
            for (int q = 0; q < 32; ++q) { const size_t o = (size_t)(b * NCH + j + q) * LW + ch; sa[q] = SUMA[o]; sb[q] = SUMB[o]; }
#pragma unroll
            for (int q = 0; q < 32; ++q) h = sa[q] * h + sb[q]; }
#pragma unroll 1
        for (; j + 8 <= c; j += 8) { float sa[8], sb[8];
#pragma unroll
            for (int q = 0; q < 8; ++q) { const size_t o = (size_t)(b * NCH + j + q) * LW + ch; sa[q] = SUMA[o]; sb[q] = SUMB[o]; }
#pragma unroll
            for (int q = 0; q < 8; ++q) h = sa[q] * h + sb[q]; }
        for (; j < c; ++j) { const size_t o = (size_t)(b * NCH + j) * LW + ch; h = SUMA[o] * h + SUMB[o]; }
    }
#pragma unroll 1
    for (int tb = 0; tb < CHUNK; tb += 16) {
        bf16_t ac[16], uc[16], gc[16];
#pragma unroll
        for (int q = 0; q < 16; ++q) { ac[q] = an[q]; uc[q] = un[q]; gc[q] = gn[q]; }
        if (tb + 16 < CHUNK) {
#pragma unroll
            for (int q = 0; q < 16; ++q) { an[q] = ap[(size_t)(tb + 16 + q) * LW]; un[q] = up[(size_t)(tb + 16 + q) * LW]; gn[q] = gp[(size_t)(tb + 16 + q) * INW]; }
        }
#pragma unroll
        for (int q = 0; q < 16; ++q) { h = (1.f - bf2f(ac[q])) * h + bf2f(uc[q]); O[(row0 + tb + q) * D + AW + ch] = (bf16_t)f2bf(h * bf2f(gc[q])); }
    }
}

__device__ __forceinline__ void attn_simple(const bf16_t* Qp, int ldq, const bf16_t* Kp, const bf16_t* Vp, int ldkv, int nkeys, int koff, const float* bias_h, bf16_t* Op, int ldo, int tid) {
    const int qi = tid >> 2, part = tid & 3;
    float q[32], o[32];
    { const u32x4* qp = (const u32x4*)(Qp + (size_t)qi * ldq + part * 32);
#pragma unroll
      for (int j = 0; j < 4; ++j) unpack8(qp[j], q + 8 * j); }
#pragma unroll
    for (int d = 0; d < 32; ++d) o[d] = 0.f;
    float m = -1e30f, l = 0.f;
    for (int kk0 = 0; kk0 < nkeys; kk0 += 8) {
        float s[8];
#pragma unroll
        for (int j = 0; j < 8; ++j) {
            const u32x4* kp = (const u32x4*)(Kp + (size_t)(kk0 + j) * ldkv + part * 32);
            float acc = 0.f;
#pragma unroll
            for (int w = 0; w < 4; ++w) { float kf[8]; unpack8(kp[w], kf);
#pragma unroll
                for (int e = 0; e < 8; ++e) acc = fmaf(q[8 * w + e], kf[e], acc); }
            acc += __shfl_xor(acc, 1); acc += __shfl_xor(acc, 2);
            if (bias_h) { int dist = qi + koff - (kk0 + j); dist = dist < -128 ? -128 : (dist > 128 ? 128 : dist); acc += bias_h[dist + 128]; }
            s[j] = acc;
        }
        float mx = s[0];
#pragma unroll
        for (int j = 1; j < 8; ++j) mx = fmaxf(mx, s[j]);
        const float mn = fmaxf(m, mx), corr = __expf(m - mn);
        l *= corr;
#pragma unroll
        for (int d = 0; d < 32; ++d) o[d] *= corr;
#pragma unroll
        for (int j = 0; j < 8; ++j) {
            const float pj = __expf(s[j] - mn); l += pj;
            const u32x4* vp = (const u32x4*)(Vp + (size_t)(kk0 + j) * ldkv + part * 32);
#pragma unroll
            for (int w = 0; w < 4; ++w) { float vf[8]; unpack8(vp[w], vf);
#pragma unroll
                for (int e = 0; e < 8; ++e) o[8 * w + e] = fmaf(pj, vf[e], o[8 * w + e]); }
        }
        m = mn;
    }
    const float inv = 1.f / l;
    u32x4* op = (u32x4*)(Op + (size_t)qi * ldo + part * 32);
#pragma unroll
    for (int w = 0; w < 4; ++w) { u32x4 ov; ov.x = pk2(o[8 * w] * inv, o[8 * w + 1] * inv); ov.y = pk2(o[8 * w + 2] * inv, o[8 * w + 3] * inv); ov.z = pk2(o[8 * w + 4] * inv, o[8 * w + 5] * inv); ov.w = pk2(o[8 * w + 6] * inv, o[8 * w + 7] * inv); op[w] = ov; }
}

__device__ __forceinline__ void gemm_branch(const bf16_t* __restrict__ Ob, const bf16_t* __restrict__ WT, const bf16_t* __restrict__ G, bf16_t* __restrict__ Mg, int gw, int NW, int lane) {
    const int r = lane & 15, q = lane >> 4;
    const int ntn = D / 32, ntiles = (T / 32) * ntn;
    for (int tile = gw; tile < ntiles; tile += NW) {
        const int tm = tile / ntn, tn = tile % ntn;
        f32x4 acc[3][2][2];
#pragma unroll
        for (int s = 0; s < 3; ++s)
#pragma unroll
            for (int i = 0; i < 2; ++i)
#pragma unroll
                for (int j = 0; j < 2; ++j) acc[s][i][j] = (f32x4){0.f, 0.f, 0.f, 0.f};
        const bf16_t* ap = Ob + (size_t)(tm * 32 + r) * D + q * 8;
        const bf16_t* bp = WT + (size_t)(tn * 32 + r) * D + q * 8;
#pragma unroll
        for (int s = 0; s < 3; ++s) {
            const int kb = s == 0 ? 0 : (s == 1 ? 1024 : 1536), ke = s == 0 ? 1024 : (s == 1 ? 1536 : 2048);
            for (int k0 = kb; k0 < ke; k0 += 32) {
                bf16x8 af[2], bfr[2];
#pragma unroll
                for (int i = 0; i < 2; ++i) af[i] = *(const bf16x8*)(ap + (size_t)i * 16 * D + k0);
#pragma unroll
                for (int j = 0; j < 2; ++j) bfr[j] = *(const bf16x8*)(bp + (size_t)j * 16 * D + k0);
#pragma unroll
                for (int i = 0; i < 2; ++i)
#pragma unroll
                    for (int j = 0; j < 2; ++j) acc[s][i][j] = __builtin_amdgcn_mfma_f32_16x16x32_bf16(af[i], bfr[j], acc[s][i][j], 0, 0, 0);
            }
        }
#pragma unroll
        for (int i = 0; i < 2; ++i)
#pragma unroll
            for (int j = 0; j < 2; ++j)
#pragma unroll
                for (int e = 0; e < 4; ++e) {
                    const int row = tm * 32 + i * 16 + q * 4 + e, col = tn * 32 + j * 16 + r;
                    const bf16_t* gp = G + (size_t)row * GW + col;
                    const float mval = bf2f(gp[0]) * acc[0][i][j][e] + bf2f(gp[2048]) * acc[1][i][j][e] + bf2f(gp[4096]) * acc[2][i][j][e];
                    Mg[(size_t)row * D + col] = (bf16_t)f2bf(mval);
                }
    }
}

__device__ __forceinline__ unsigned long long shfl_xor64(unsigned long long v, int m) {
    const unsigned lo = __shfl_xor((unsigned)v, m), hi = __shfl_xor((unsigned)(v >> 32), m);
    return ((unsigned long long)hi << 32) | lo;
}
__device__ __forceinline__ unsigned fkey(float f) { const unsigned u = __float_as_uint(f); return (u & 0x80000000u) ? ~u : (u | 0x80000000u); }
__device__ __forceinline__ float fkey_inv(unsigned k) { const unsigned u = (k & 0x80000000u) ? (k & 0x7fffffffu) : ~k; return __uint_as_float(u); }
__device__ __forceinline__ unsigned long long wave_max64(unsigned long long k) {
#pragma unroll
    for (int o = 1; o < 64; o <<= 1) { const unsigned long long t = shfl_xor64(k, o); k = t > k ? t : k; }
    return k;
}
__device__ __forceinline__ void route_unit(const Params& p, int t, int h, int lane) {
    const bf16_t* Q = (const bf16_t*)(p.ws + WS_Q); const bf16_t* KB = (const bf16_t*)(p.ws + WS_KEYSB);
    int* RIDX = (int*)(p.ws + WS_RIDX); float* RG = (float*)(p.ws + WS_RG);
    float sv_l[2] = {0.f, 0.f}; int si_l[2] = {0, 0};
#pragma unroll
    for (int c = 0; c < 2; ++c) {
        const bf16_t* qv = Q + (size_t)t * D + h * 256 + c * 128;
        const unsigned qw = ((const unsigned*)qv)[lane];
        const float qa = bf2f(qw & 0xffffu), qb = bf2f(qw >> 16);
        const bf16_t* k0p = KB + ((size_t)(h * 2 + c) * NKEYS + lane) * 128;
        const bf16_t* k1p = k0p + 64 * 128;
        float s0 = 0.f, s1 = 0.f;
#pragma unroll
        for (int w = 0; w < 16; ++w) {
            float k0f[8], k1f[8]; unpack8(((const u32x4*)k0p)[w], k0f); unpack8(((const u32x4*)k1p)[w], k1f);
#pragma unroll
            for (int e = 0; e < 8; e += 2) {
                const int src = 4 * w + e / 2;
                const float xa = __int_as_float(__builtin_amdgcn_readlane(__float_as_int(qa), src));
                const float xb = __int_as_float(__builtin_amdgcn_readlane(__float_as_int(qb), src));
                s0 = fmaf(xa, k0f[e], s0); s0 = fmaf(xb, k0f[e + 1], s0);
                s1 = fmaf(xa, k1f[e], s1); s1 = fmaf(xb, k1f[e + 1], s1);
            }
        }
        unsigned long long ka = ((unsigned long long)fkey(s0) << 32) | (unsigned)(255 - lane);
        unsigned long long kb = ((unsigned long long)fkey(s1) << 32) | (unsigned)(255 - (lane + 64));
        for (int rnd = 0; rnd < TOPK; ++rnd) {
            const unsigned long long best = wave_max64(ka > kb ? ka : kb);
            if (ka == best) ka = 0ull; if (kb == best) kb = 0ull;
            if (lane == rnd) { sv_l[c] = fkey_inv((unsigned)(best >> 32)); si_l[c] = 255 - (int)(best & 0xffffffffu); }
        }
    }
    unsigned long long kc[4];
#pragma unroll
    for (int m = 0; m < 4; ++m) { const int cid = lane + 64 * m, i = cid >> 4, j = cid & 15;
        const float v = __shfl(sv_l[0], i) + __shfl(sv_l[1], j);
        kc[m] = ((unsigned long long)fkey(v) << 32) | (unsigned)(1023 - cid); }
    float fv = 0.f; int cidx = 0;
    for (int rnd = 0; rnd < TOPK; ++rnd) {
        unsigned long long loc = kc[0] > kc[1] ? kc[0] : kc[1]; const unsigned long long loc2 = kc[2] > kc[3] ? kc[2] : kc[3]; loc = loc > loc2 ? loc : loc2;
        const unsigned long long best = wave_max64(loc);
#pragma unroll
        for (int m = 0; m < 4; ++m) if (kc[m] == best) kc[m] = 0ull;
        if (lane == rnd) { fv = fkey_inv((unsigned)(best >> 32)); cidx = 1023 - (int)(best & 0xffffffffu); }
    }
    const float fmax_ = __shfl(fv, 0);
    float e = lane < 16 ? __expf(fv - fmax_) : 0.f;
    float ssum = e;
#pragma unroll
    for (int o = 1; o < 16; o <<= 1) ssum += __shfl_xor(ssum, o);
    const int ci = cidx >> 4, cj = cidx & 15;
    const int e0 = __shfl(si_l[0], ci), e1 = __shfl(si_l[1], cj);
    if (lane < 16) { RIDX[(size_t)t * 128 + h * 16 + lane] = e0 * NKEYS + e1; RG[(size_t)t * 128 + h * 16 + lane] = e / ssum; }
}

typedef float f32x2 __attribute__((ext_vector_type(2)));
__device__ __forceinline__ void fp4_row_load(const float* __restrict__ src, const float* __restrict__ kscale, int lane, f32x4 (&v)[8]) {
#pragma unroll
    for (int j = 0; j < 8; ++j) { v[j] = ((const f32x4*)src)[64 * j + lane]; if (kscale) v[j] = v[j] * ((const f32x4*)kscale)[64 * j + lane]; }
}
__device__ __forceinline__ void fp4_row_finish(const f32x4 (&v)[8], unsigned char* __restrict__ tab, int e, float* __restrict__ scale_out, int lane) {
    float mx = 0.f;
#pragma unroll
    for (int j = 0; j < 8; ++j) mx = fmaxf(mx, fmaxf(fmaxf(fabsf(v[j].x), fabsf(v[j].y)), fmaxf(fabsf(v[j].z), fabsf(v[j].w))));
#pragma unroll
    for (int o = 1; o < 64; o <<= 1) mx = fmaxf(mx, __shfl_xor(mx, o));
    const float sc = mx > 0.f ? mx * (1.f / 6.f) : 1.f, inv = 1.f / sc;
#pragma unroll
    for (int j = 0; j < 8; ++j) {
        const f32x4 a = v[j] * inv;
        unsigned pk = 0u;
        pk = __builtin_amdgcn_cvt_scalef32_pk_fp4_f32(pk, fminf(fmaxf(a.x, -6.f), 6.f), fminf(fmaxf(a.y, -6.f), 6.f), 1.0f, 0);
        pk = __builtin_amdgcn_cvt_scalef32_pk_fp4_f32(pk, fminf(fmaxf(a.z, -6.f), 6.f), fminf(fmaxf(a.w, -6.f), 6.f), 1.0f, 1);
        *(unsigned short*)(tab + ((size_t)j * 16384 + e) * 128 + 2 * lane) = (unsigned short)pk;
    }
    if (lane == 0) *scale_out = sc;
}
__device__ __forceinline__ void fp4_tables(const Params& p, int gw, int NW, int lane) {
    f32x4 va[8], vb[8];
#define FP4_LOAD(r, v) do { if ((r) < 16384) fp4_row_load(p.in[25] + (size_t)(r) * D, p.in[22], lane, v); else fp4_row_load(p.in[26] + (size_t)((r) - 16384) * D, nullptr, lane, v); } while (0)
#define FP4_FIN(r, v) do { if ((r) < 16384) fp4_row_finish(v, p.ws + WS_TABU, (r), (float*)(p.ws + WS_SCU) + (r), lane); \
        else fp4_row_finish(v, p.ws + WS_TABV, (r) - 16384, (float*)(p.ws + WS_SCV) + ((r) - 16384), lane); } while (0)
    const int n = 2 * 16384;
    int r = gw;
    if (r < n) FP4_LOAD(r, va);
    for (; r < n; r += 2 * NW) {
        const bool hb = r + NW < n;
        if (hb) FP4_LOAD(r + NW, vb);
        FP4_FIN(r, va);
        if (r + 2 * NW < n) FP4_LOAD(r + 2 * NW, va);
        if (hb) FP4_FIN(r + NW, vb);
    }
#undef FP4_LOAD
#undef FP4_FIN
}
constexpr size_t WS_ZP = WS_Q;
constexpr size_t WS_X2F8 = 2 * MiB;
__device__ __forceinline__ float dot_chunk(const u32x4 w, const float (&xf)[32]) {
    float a0 = 0.f, a1 = 0.f;
#pragma unroll
    for (int q = 0; q < 4; ++q) {
        const f32x2 a = __builtin_amdgcn_cvt_scalef32_pk_f32_fp4(w[q], 1.0f, 0), b = __builtin_amdgcn_cvt_scalef32_pk_f32_fp4(w[q], 1.0f, 1);
        const f32x2 c = __builtin_amdgcn_cvt_scalef32_pk_f32_fp4(w[q], 1.0f, 2), d = __builtin_amdgcn_cvt_scalef32_pk_f32_fp4(w[q], 1.0f, 3);
        a0 = fmaf(a.x, xf[8 * q], a0); a1 = fmaf(a.y, xf[8 * q + 1], a1); a0 = fmaf(b.x, xf[8 * q + 2], a0); a1 = fmaf(b.y, xf[8 * q + 3], a1);
        a0 = fmaf(c.x, xf[8 * q + 4], a0); a1 = fmaf(c.y, xf[8 * q + 5], a1); a0 = fmaf(d.x, xf[8 * q + 6], a0); a1 = fmaf(d.y, xf[8 * q + 7], a1);
    }
    return a0 + a1;
}
__device__ __forceinline__ void axpy_chunk(const u32x4 w, const float a_, float (&of)[32]) {
#pragma unroll
    for (int q = 0; q < 4; ++q) {
        const f32x2 a = __builtin_amdgcn_cvt_scalef32_pk_f32_fp4(w[q], 1.0f, 0), b = __builtin_amdgcn_cvt_scalef32_pk_f32_fp4(w[q], 1.0f, 1);
        const f32x2 c = __builtin_amdgcn_cvt_scalef32_pk_f32_fp4(w[q], 1.0f, 2), d = __builtin_amdgcn_cvt_scalef32_pk_f32_fp4(w[q], 1.0f, 3);
        of[8 * q] = fmaf(a_, a.x, of[8 * q]); of[8 * q + 1] = fmaf(a_, a.y, of[8 * q + 1]); of[8 * q + 2] = fmaf(a_, b.x, of[8 * q + 2]); of[8 * q + 3] = fmaf(a_, b.y, of[8 * q + 3]);
        of[8 * q + 4] = fmaf(a_, c.x, of[8 * q + 4]); of[8 * q + 5] = fmaf(a_, c.y, of[8 * q + 5]); of[8 * q + 6] = fmaf(a_, d.x, of[8 * q + 6]); of[8 * q + 7] = fmaf(a_, d.y, of[8 * q + 7]);
    }
}
struct PeerTok { u32x4 w[16]; u32x4 x[4]; };
template <bool USTEP>
__device__ __forceinline__ void peer_issue(PeerTok& k, const Params& p, const unsigned char* tab, int t, int xv, int lane) {
    const int* RIDX = (const int*)(p.ws + WS_RIDX);
    const int i0 = RIDX[(size_t)t * 128 + lane], i1 = RIDX[(size_t)t * 128 + 64 + lane];
    const int es = lane >> 3, ck = lane & 7;
    if (USTEP) { const bf16_t* xp = (const bf16_t*)(p.ws + WS_X2BF) + (size_t)t * D + 256 * xv + 32 * ck;
#pragma unroll
        for (int j = 0; j < 4; ++j) k.x[j] = *(const u32x4*)(xp + 8 * j); }
#pragma unroll
    for (int g = 0; g < 16; ++g) { const int e = __shfl(g < 8 ? i0 : i1, (8 * g + es) & 63); k.w[g] = *(const u32x4*)(tab + (size_t)e * 128 + ck * 16); }
}
__device__ __forceinline__ void peer_u_finish(const PeerTok& k, const Params& p, int t, int xv, int lane) {
    const int es = lane >> 3, ck = lane & 7;
    float xf[32];
#pragma unroll
    for (int j = 0; j < 4; ++j) unpack8(k.x[j], xf + 8 * j);
    float zsel0 = 0.f, zsel1 = 0.f;
#pragma unroll
    for (int g = 0; g < 16; ++g) { u32x4 w_ = k.w[g]; asm volatile("" : "+v"(w_)); float d = dot_chunk(w_, xf);
        d += __int_as_float(__builtin_amdgcn_update_dpp(0, __float_as_int(d), 0xB1, 0xf, 0xf, true));
        d += __int_as_float(__builtin_amdgcn_update_dpp(0, __float_as_int(d), 0x4E, 0xf, 0xf, true));
        d += __int_as_float(__builtin_amdgcn_update_dpp(0, __float_as_int(d), 0x141, 0xf, 0xf, true));
        if (g < 8) { if (ck == g) zsel0 = d; } else { if (ck == g - 8) zsel1 = d; }
        asm volatile("" : "+v"(zsel0), "+v"(zsel1)); }
    float* zp = (float*)(p.ws + WS_ZP) + ((size_t)xv * T + t) * 128;
    zp[8 * ck + es] = zsel0; zp[64 + 8 * ck + es] = zsel1;
}
__device__ __forceinline__ void peer_v_finish(const PeerTok& k, const Params& p, int t, int xv, int lane, LAS float* red) {
    const float* RG = (const float*)(p.ws + WS_RG);
    const float a0 = RG[(size_t)t * 128 + lane], a1 = RG[(size_t)t * 128 + 64 + lane];
    const int es = lane >> 3, ck = lane & 7;
    float of[32];
#pragma unroll
    for (int q = 0; q < 32; ++q) of[q] = 0.f;
#pragma unroll
    for (int g = 0; g < 16; ++g) { const float a = __shfl(g < 8 ? a0 : a1, (8 * g + es) & 63); u32x4 w_ = k.w[g]; asm volatile("" : "+v"(w_)); axpy_chunk(w_, a, of);
        asm volatile("" : "+v"(of[0]), "+v"(of[1]), "+v"(of[2]), "+v"(of[3]), "+v"(of[4]), "+v"(of[5]), "+v"(of[6]), "+v"(of[7]), "+v"(of[8]), "+v"(of[9]), "+v"(of[10]), "+v"(of[11]), "+v"(of[12]), "+v"(of[13]), "+v"(of[14]), "+v"(of[15]));
        asm volatile("" : "+v"(of[16]), "+v"(of[17]), "+v"(of[18]), "+v"(of[19]), "+v"(of[20]), "+v"(of[21]), "+v"(of[22]), "+v"(of[23]), "+v"(of[24]), "+v"(of[25]), "+v"(of[26]), "+v"(of[27]), "+v"(of[28]), "+v"(of[29]), "+v"(of[30]), "+v"(of[31])); }
#pragma unroll
    for (int q = 0; q < 8; ++q) *(LAS f32x4*)(red + es * 256 + ck * 32 + 4 * q) = (f32x4){of[4 * q], of[4 * q + 1], of[4 * q + 2], of[4 * q + 3]};
    f32x4 s = *(const LAS f32x4*)(red + 4 * lane);
#pragma unroll
    for (int r = 1; r < 8; ++r) s = s + *(const LAS f32x4*)(red + r * 256 + 4 * lane);
    f32x4* o4 = (f32x4*)(p.out + (size_t)t * D + 256 * xv + 4 * lane);
    *o4 = *o4 + s;
}
template <bool USTEP>
__device__ __forceinline__ void peer_step(const Params& p, int lane, int wave, LAS float* red, int pos, int nx, int rank, int nloc) {
    for (int xv = pos; xv < 8; xv += nx) {
        const int wx = rank * 8 + wave, nwx = nloc * 8;
        const unsigned char* tab = p.ws + (USTEP ? WS_TABU : WS_TABV) + (size_t)xv * 16384 * 128;
        PeerTok A, B;
        int t = wx;
        if (t < T) peer_issue<USTEP>(A, p, tab, t, xv, lane);
#pragma unroll 1
        for (; t < T; t += 2 * nwx) {
            const bool hb = t + nwx < T;
            if (hb) peer_issue<USTEP>(B, p, tab, t + nwx, xv, lane);
            if (USTEP) peer_u_finish(A, p, t, xv, lane); else peer_v_finish(A, p, t, xv, lane, red);
            if (t + 2 * nwx < T) peer_issue<USTEP>(A, p, tab, t + 2 * nwx, xv, lane);
            if (hb) { if (USTEP) peer_u_finish(B, p, t + nwx, xv, lane); else peer_v_finish(B, p, t + nwx, xv, lane, red); }
        }
    }
}
typedef int v8i_p __attribute__((ext_vector_type(8))); typedef int v4i_t __attribute__((ext_vector_type(4)));
struct PeerTokU { u32x4 w[16]; u32x4 b[2][2]; };
__device__ __forceinline__ void peer_u_issue(PeerTokU& k, const Params& p, const unsigned char* tab, int t, int xv, int lane) {
    const int* RIDX = (const int*)(p.ws + WS_RIDX);
    const int i0 = RIDX[(size_t)t * 128 + lane], i1 = RIDX[(size_t)t * 128 + 64 + lane];
    const int es = lane >> 3, ck = lane & 7, q = lane >> 4;
    const unsigned char* xp = p.ws + WS_X2F8 + (size_t)t * D + 256 * xv + 16 * q;
#pragma unroll
    for (int kb = 0; kb < 2; ++kb) { k.b[kb][0] = *(const u32x4*)(xp + 128 * kb); k.b[kb][1] = *(const u32x4*)(xp + 128 * kb + 64); }
#pragma unroll
    for (int g = 0; g < 16; ++g) { const int e = __shfl(g < 8 ? i0 : i1, (8 * g + es) & 63); k.w[g] = *(const u32x4*)(tab + (size_t)e * 128 + ck * 16); }
}
__device__ __forceinline__ void peer_u_mfma(const PeerTokU& k, const Params& p, int t, int xv, int lane, LAS unsigned char* vl) {
    float* zp = (float*)(p.ws + WS_ZP) + ((size_t)xv * T + t) * 128;
    const int es = lane >> 3, ck = lane & 7, r16 = lane & 15, q = lane >> 4;
#pragma unroll
    for (int g = 0; g < 16; ++g) { const int row = 8 * g + es; *(LAS u32x4*)(vl + row * 128 + ((ck ^ (row & 7)) << 4)) = k.w[g]; }
    v8i_p b0, b1;
    { const v4i_t x0 = __builtin_bit_cast(v4i_t, k.b[0][0]), x1 = __builtin_bit_cast(v4i_t, k.b[0][1]), y0 = __builtin_bit_cast(v4i_t, k.b[1][0]), y1 = __builtin_bit_cast(v4i_t, k.b[1][1]);
      b0 = __builtin_shufflevector(x0, x1, 0, 1, 2, 3, 4, 5, 6, 7); b1 = __builtin_shufflevector(y0, y1, 0, 1, 2, 3, 4, 5, 6, 7); }
#pragma unroll
    for (int g = 0; g < 8; ++g) {
        const int row = 16 * g + r16;
        const v4i_t a0 = __builtin_bit_cast(v4i_t, *(const LAS u32x4*)(vl + row * 128 + ((q ^ (row & 7)) << 4)));
        const v4i_t a1 = __builtin_bit_cast(v4i_t, *(const LAS u32x4*)(vl + row * 128 + (((4 + q) ^ (row & 7)) << 4)));
        const v8i_p A0 = {a0[0], a0[1], a0[2], a0[3], 0, 0, 0, 0}, A1 = {a1[0], a1[1], a1[2], a1[3], 0, 0, 0, 0};
        f32x4 acc = {0.f, 0.f, 0.f, 0.f};
        acc = __builtin_amdgcn_mfma_scale_f32_16x16x128_f8f6f4(A0, b0, acc, 4, 0, 0, 0x7F7F7F7F, 0, 0x7F7F7F7F);
        acc = __builtin_amdgcn_mfma_scale_f32_16x16x128_f8f6f4(A1, b1, acc, 4, 0, 0, 0x7F7F7F7F, 0, 0x7F7F7F7F);
        if ((lane & 15) == 0) *(f32x4*)(zp + 16 * g + 4 * (lane >> 4)) = acc;
    }
}
__device__ __forceinline__ void peer_u_step(const Params& p, int lane, int wave, LAS unsigned char* vl, int pos, int nx, int rank, int nloc) {
    for (int xv = pos; xv < 8; xv += nx) {
        const int wx = rank * 8 + wave, nwx = nloc * 8;
        const unsigned char* tab = p.ws + WS_TABU + (size_t)xv * 16384 * 128;
        PeerTokU A, B;
        int t = wx;
        if (t < T) peer_u_issue(A, p, tab, t, xv, lane);
#pragma unroll 1
        for (; t < T; t += 2 * nwx) {
            const bool hb = t + nwx < T;
            if (hb) peer_u_issue(B, p, tab, t + nwx, xv, lane);
            peer_u_mfma(A, p, t, xv, lane, vl);
            if (t + 2 * nwx < T) peer_u_issue(A, p, tab, t + 2 * nwx, xv, lane);
            if (hb) peer_u_mfma(B, p, t + nwx, xv, lane, vl);
        }
    }
}
constexpr size_t WS_ACT8 = 34 * MiB, WS_ASC = 36 * MiB;
__device__ __forceinline__ void peer_combine(const Params& p, int t, int lane) {
    const float* ZP = (const float*)(p.ws + WS_ZP); const int* RIDX = (const int*)(p.ws + WS_RIDX); const float* RG = (const float*)(p.ws + WS_RG);
    const float* SCU = (const float*)(p.ws + WS_SCU); const float* SCV = (const float*)(p.ws + WS_SCV); const float* SS2 = (const float*)(p.ws + WS_CTL + CTL_SS2_BYTE);
    const float rs = rsqrtf(SS2[t] * (1.f / D) + EPS);
    float act[2];
#pragma unroll
    for (int hlf = 0; hlf < 2; ++hlf) { const size_t o = (size_t)t * 128 + 64 * hlf + lane; float z = 0.f;
#pragma unroll
        for (int x = 0; x < 8; ++x) z += ZP[((size_t)x * T) * 128 + o];
        const int e = RIDX[o];
        act[hlf] = gelu_tanh(z * rs * SCU[e]) * RG[o] * SCV[e]; }
    float mx = fmaxf(fabsf(act[0]), fabsf(act[1]));
#pragma unroll
    for (int o = 1; o < 64; o <<= 1) mx = fmaxf(mx, __shfl_xor(mx, o));
    const float sc = mx > 0.f ? mx * (1.f / 448.f) : 1.f, inv = 1.f / sc;
    unsigned char* a8 = p.ws + WS_ACT8 + (size_t)t * 128;
    a8[lane] = (unsigned char)(__builtin_amdgcn_cvt_pk_fp8_f32(act[0] * inv, 0.f, 0, false) & 0xff);
    a8[64 + lane] = (unsigned char)(__builtin_amdgcn_cvt_pk_fp8_f32(act[1] * inv, 0.f, 0, false) & 0xff);
    if (lane == 0) ((float*)(p.ws + WS_ASC))[t] = sc;
}
typedef int v2i_t __attribute__((ext_vector_type(2)));
struct PeerTokV { u32x4 w[16]; u32x4 b[2]; };
__device__ __forceinline__ void peer_v_issue(PeerTokV& k, const Params& p, const unsigned char* tab, int t, int lane) {
    const int* RIDX = (const int*)(p.ws + WS_RIDX);
    const int i0 = RIDX[(size_t)t * 128 + lane], i1 = RIDX[(size_t)t * 128 + 64 + lane];
    const int es = lane >> 3, ck = lane & 7, q = lane >> 4;
    const unsigned char* ap = p.ws + WS_ACT8 + (size_t)t * 128 + 16 * q;
    k.b[0] = *(const u32x4*)ap; k.b[1] = *(const u32x4*)(ap + 64);
#pragma unroll
    for (int g = 0; g < 16; ++g) { const int e = __shfl(g < 8 ? i0 : i1, (8 * g + es) & 63); k.w[g] = *(const u32x4*)(tab + (size_t)e * 128 + ck * 16); }
}
__device__ __forceinline__ void peer_v_mfma(const PeerTokV& k, const Params& p, int t, int xv, int lane, LAS unsigned char* vl) {
    const int es = lane >> 3, ck = lane & 7, n = lane & 15, q = lane >> 4;
#pragma unroll
    for (int g = 0; g < 16; ++g) { const int row = 8 * g + es; *(LAS u32x4*)(vl + row * 128 + ((ck ^ (row & 7)) << 4)) = k.w[g]; }
    const v4i_t x0 = __builtin_bit_cast(v4i_t, k.b[0]), x1 = __builtin_bit_cast(v4i_t, k.b[1]);
    const v8i_p bop = __builtin_shufflevector(x0, x1, 0, 1, 2, 3, 4, 5, 6, 7);
    const int r1 = 32 * q + n, r2 = r1 + 16;
    f32x4 keep = {0.f, 0.f, 0.f, 0.f};
#pragma unroll
    for (int mb = 0; mb < 16; ++mb) {
        const v2i_t t1 = __builtin_amdgcn_ds_read_tr4_b64_v2i32((LAS v2i_t*)(vl + r1 * 128 + ((((mb >> 1) ^ (r1 & 7)) << 4) | ((mb & 1) << 3))));
        const v2i_t t2 = __builtin_amdgcn_ds_read_tr4_b64_v2i32((LAS v2i_t*)(vl + r2 * 128 + ((((mb >> 1) ^ (r2 & 7)) << 4) | ((mb & 1) << 3))));
        const v8i_p aop = {t1[0], t1[1], t2[0], t2[1], 0, 0, 0, 0};
        f32x4 acc = {0.f, 0.f, 0.f, 0.f};
        acc = __builtin_amdgcn_mfma_scale_f32_16x16x128_f8f6f4(aop, bop, acc, 4, 0, 0, 0x7F7F7F7F, 0, 0x7F7F7F7F);
        if (n == mb) keep = acc;
    }
    const float sc = ((const float*)(p.ws + WS_ASC))[t];
    const size_t oo = (size_t)t * D + 256 * xv + 16 * n + 4 * q;
    const u32x2 xw = *(const u32x2*)((const bf16_t*)(p.ws + WS_X2BF) + oo);
    const f32x4 x2v = {__uint_as_float(xw.x << 16), __uint_as_float(xw.x & 0xffff0000u), __uint_as_float(xw.y << 16), __uint_as_float(xw.y & 0xffff0000u)};
    *(f32x4*)(p.out + oo) = x2v + keep * sc;
}
__device__ __forceinline__ void peer_v_step(const Params& p, int lane, int wave, LAS unsigned char* vl, int pos, int nx, int rank, int nloc) {
    for (int xv = pos; xv < 8; xv += nx) {
        const int wx = rank * 8 + wave, nwx = nloc * 8;
        const unsigned char* tab = p.ws + WS_TABV + (size_t)xv * 16384 * 128;
        PeerTokV A, B;
        int t = wx;
        if (t < T) peer_v_issue(A, p, tab, t, lane);
#pragma unroll 1
        for (; t < T; t += 2 * nwx) {
            const bool hb = t + nwx < T;
            if (hb) peer_v_issue(B, p, tab, t + nwx, lane);
            peer_v_mfma(A, p, t, xv, lane, vl);
            if (t + 2 * nwx < T) peer_v_issue(A, p, tab, t + 2 * nwx, lane);
            if (hb) peer_v_mfma(B, p, t + nwx, xv, lane, vl);
        }
    }
}

namespace pg8 {
#define PG8_LAS __attribute__((address_space(3)))
constexpr int BM = 256, BK = 64, HALF = 128, HTB = HALF * BK * 2, STAGE_BYTES = 8 * HTB, NXCD = 8, WGM = 8;
__host__ __device__ __forceinline__ int lds_byte(int r, int c) { const int st = (r >> 4) * 2 + (c >> 5), rr = r & 15, cc = c & 31, ob = rr * 64 + cc * 2; return st * 1024 + (ob ^ (((ob >> 9) & 1) << 5)); }
__host__ __device__ __forceinline__ void stage_rc(int b, int& R, int& C) { const int st = b / 1024, sb = b % 1024, swz = sb ^ (((sb >> 9) & 1) << 5); R = (st >> 1) * 16 + swz / 64; C = (st & 1) * 32 + (swz % 64) / 2; }
__host__ __device__ __forceinline__ int perm32(int rho) { const int n = rho >> 4, i = rho & 15; return 8 * (i >> 2) + 4 * n + (i & 3); }
struct Unit { const char* A; const char* B; int pm, pn, kind, nt; };
__device__ __forceinline__ const char* uni_ptr(const char* p) { const unsigned long long v = (unsigned long long)p; const unsigned lo = __builtin_amdgcn_readfirstlane((unsigned)v), hi = __builtin_amdgcn_readfirstlane((unsigned)(v >> 32)); return (const char*)(((unsigned long long)hi << 32) | lo); }
__device__ __forceinline__ void uni(Unit& u) { u.A = uni_ptr(u.A); u.B = uni_ptr(u.B); u.pm = __builtin_amdgcn_readfirstlane(u.pm); u.pn = __builtin_amdgcn_readfirstlane(u.pn); u.kind = __builtin_amdgcn_readfirstlane(u.kind); u.nt = __builtin_amdgcn_readfirstlane(u.nt); }
__device__ __forceinline__ void tile_of(int L, int nM, int nN, int& pm, int& pn) {
    const int nwg = nM * nN; int wgid = L; { const int q = nwg / NXCD, r = nwg % NXCD, xcd = wgid % NXCD, off = wgid / NXCD; wgid = (xcd < r ? xcd * (q + 1) : r * (q + 1) + (xcd - r) * q) + off; }
    const int nig = WGM * nN, gid = wgid / nig, fm = gid * WGM, gsz = (nM - fm) < WGM ? (nM - fm) : WGM;
    pm = fm + ((wgid % nig) % gsz); pn = (wgid % nig) / gsz;
}
typedef int v8i_t __attribute__((ext_vector_type(8))); typedef int v4i_t __attribute__((ext_vector_type(4)));
__device__ __forceinline__ v8i_t cat8(const bf16x8 lo, const bf16x8 hi) { const v4i_t a = __builtin_bit_cast(v4i_t, lo), b = __builtin_bit_cast(v4i_t, hi); return __builtin_shufflevector(a, b, 0, 1, 2, 3, 4, 5, 6, 7); }
template <bool FP8, class Epi, class Sched>
__device__ __forceinline__ void gemm_phase(PG8_LAS unsigned char* lds, const int lda, const int ldb, const Sched& S, const Epi& E) {
    const int tid = threadIdx.x, wid = __builtin_amdgcn_readfirstlane(tid >> 6), lane = tid & 63, wr = wid >> 2, wc = wid & 3, fr = lane & 15, fq = lane >> 4;
    unsigned voffA[2], voffB[2];
#pragma unroll
    for (int i = 0; i < 2; ++i) { int R, C; stage_rc(tid * 16 + i * 8192, R, C); const int Rb = (R & ~31) + perm32(R & 31);
        voffA[i] = (unsigned)(R * lda + C) * 2u; voffB[i] = (unsigned)(Rb * ldb + C) * 2u; }
    const size_t kstep = (size_t)(BK * 2);
    const size_t hstepA = (size_t)HALF * lda * 2, hstepB = (size_t)HALF * ldb * 2;
    const unsigned ldsw = (unsigned)wid * 1024u;
    const int aoff = lds_byte(wr * 64 + fr, fq * 8), boff = lds_byte(wc * 32 + fr, fq * 8);
#define PG8_SA(b, h) (((b) * 2 + (h)) * HTB)
#define PG8_SB(b, h) ((4 + (b) * 2 + (h)) * HTB)
#define PG8_STAGE(bufoff, gbase, voff) do { _Pragma("unroll") for (int _i = 0; _i < 2; ++_i) \
        __builtin_amdgcn_global_load_lds((const unsigned*)((const char*)(gbase) + (voff)[_i]), (PG8_LAS unsigned*)(lds + (bufoff) + ldsw + _i * 8192), 16, 0, 0); } while (0)
#define PG8_LDA(dst, b, h) do { _Pragma("unroll") for (int m = 0; m < 4; ++m) { if constexpr (FP8) dst##8[m] = cat8(*(const PG8_LAS bf16x8*)(lds + PG8_SA(b, h) + aoff + m * 2048), *(const PG8_LAS bf16x8*)(lds + PG8_SA(b, h) + aoff + m * 2048 + 1024)); \
        else { _Pragma("unroll") for (int k = 0; k < 2; ++k) dst[m][k] = *(const PG8_LAS bf16x8*)(lds + PG8_SA(b, h) + aoff + m * 2048 + k * 1024); } } } while (0)
#define PG8_LDB(dst, b, h) do { _Pragma("unroll") for (int n = 0; n < 2; ++n) { if constexpr (FP8) dst##8[n] = cat8(*(const PG8_LAS bf16x8*)(lds + PG8_SB(b, h) + boff + n * 2048), *(const PG8_LAS bf16x8*)(lds + PG8_SB(b, h) + boff + n * 2048 + 1024)); \
        else { _Pragma("unroll") for (int k = 0; k < 2; ++k) dst[n][k] = *(const PG8_LAS bf16x8*)(lds + PG8_SB(b, h) + boff + n * 2048 + k * 1024); } } } while (0)
#define PG8_MMA(ai, bj, At, Bt) do { __builtin_amdgcn_s_setprio(1); \
        if constexpr (FP8) { _Pragma("unroll") for (int m = 0; m < 4; ++m) _Pragma("unroll") for (int n = 0; n < 2; ++n) \
            asm volatile("v_mfma_scale_f32_16x16x128_f8f6f4 %0, %1, %2, %0, %3, %3 op_sel_hi:[0,0,0]" : "+v"(acc[ai][bj][m][n]) : "v"(Bt##8[n]), "v"(At##8[m]), "v"(mxone)); } \
        else { _Pragma("unroll") for (int m = 0; m < 4; ++m) _Pragma("unroll") for (int n = 0; n < 2; ++n) _Pragma("unroll") for (int k = 0; k < 2; ++k) \
            acc[ai][bj][m][n] = __builtin_amdgcn_mfma_f32_16x16x32_bf16(Bt[n][k], At[m][k], acc[ai][bj][m][n], 0, 0, 0); } \
        __builtin_amdgcn_s_setprio(0); } while (0)
#define PG8_WAIT_V(n) asm volatile("s_waitcnt vmcnt(" #n ")" ::: "memory")
#define PG8_WAIT_L(n) asm volatile("s_waitcnt lgkmcnt(" #n ")" ::: "memory")
#define PG8_BAR __builtin_amdgcn_s_barrier()
#define PG8_SCHED __builtin_amdgcn_sched_barrier(0)
    Unit cur, nxt; int ui = 0;
    if (!S.next(0, cur)) return;
    f32x4 acc[2][2][4][2];
#pragma unroll
    for (int a = 0; a < 2; ++a)
#pragma unroll
        for (int b = 0; b < 2; ++b)
#pragma unroll
            for (int m = 0; m < 4; ++m)
#pragma unroll
                for (int n = 0; n < 2; ++n) acc[a][b][m][n] = (f32x4){0.f, 0.f, 0.f, 0.f};
    const int mxone = 0x7F7F7F7F;
    bf16x8 At[4][2], B0[2][2], B1[2][2]; v8i_t At8[4], B08[2], B18[2];
    const char* cA = cur.A; const char* cB = cur.B;
    PG8_STAGE(PG8_SB(0, 0), cB, voffB); PG8_STAGE(PG8_SB(0, 1), cB + hstepB, voffB); PG8_STAGE(PG8_SA(0, 0), cA, voffA); PG8_STAGE(PG8_SA(0, 1), cA + hstepA, voffA);
    if (wr == 1) PG8_BAR;
    PG8_WAIT_V(2); PG8_BAR;
    PG8_STAGE(PG8_SB(1, 0), cB + kstep, voffB); PG8_STAGE(PG8_SA(1, 0), cA + kstep, voffA); PG8_STAGE(PG8_SB(1, 1), cB + hstepB + kstep, voffB);
    PG8_WAIT_V(6); PG8_BAR;
    for (;;) {
        const bool has_next = S.next(ui + 1, nxt);
        const char* nA = has_next ? nxt.A : cA; const char* nB = has_next ? nxt.B : cB;
        const int nt = cur.nt;
        for (int t = 0; t < nt; t += 2) {
            const bool last = (t == nt - 2);
            const char* a1 = cA + (size_t)(t + 1) * kstep;
            const char* a2 = last ? nA : cA + (size_t)(t + 2) * kstep; const char* b2 = last ? nB : cB + (size_t)(t + 2) * kstep;
            const char* a3 = a2 + kstep; const char* b3 = b2 + kstep;
            PG8_LDB(B0, 0, 0); PG8_LDB(B1, 0, 1); PG8_SCHED; PG8_LDA(At, 0, 0); PG8_STAGE(PG8_SA(1, 1), a1 + hstepA, voffA);
            PG8_WAIT_V(8); PG8_WAIT_L(0); PG8_BAR; PG8_MMA(0, 0, At, B0); PG8_MMA(0, 1, At, B1); PG8_BAR; PG8_SCHED;
            PG8_LDA(At, 0, 1); PG8_STAGE(PG8_SB(0, 0), b2, voffB); PG8_STAGE(PG8_SB(0, 1), b2 + hstepB, voffB); PG8_STAGE(PG8_SA(0, 0), a2, voffA);
            PG8_WAIT_V(8); PG8_WAIT_L(0); PG8_BAR; PG8_MMA(1, 0, At, B0); PG8_MMA(1, 1, At, B1); PG8_BAR; PG8_SCHED;
            PG8_LDB(B0, 1, 0); PG8_LDB(B1, 1, 1); PG8_SCHED; PG8_LDA(At, 1, 0); PG8_STAGE(PG8_SA(0, 1), a2 + hstepA, voffA);
            PG8_WAIT_V(8); PG8_WAIT_L(0); PG8_BAR; PG8_MMA(0, 0, At, B0); PG8_MMA(0, 1, At, B1); PG8_BAR; PG8_SCHED;
            PG8_LDA(At, 1, 1); PG8_STAGE(PG8_SB(1, 0), b3, voffB); PG8_STAGE(PG8_SB(1, 1), b3 + hstepB, voffB); PG8_STAGE(PG8_SA(1, 0), a3, voffA);
            PG8_WAIT_V(8); PG8_WAIT_L(0); PG8_BAR; PG8_MMA(1, 0, At, B0); PG8_MMA(1, 1, At, B1); PG8_BAR; PG8_SCHED;
        }
        if (wr == 0) PG8_BAR;
        if constexpr (FP8) asm volatile("s_nop 15\n\ts_nop 15" ::: "memory");
        E(acc, cur, wr, wc, fr, fq);
        if (!has_next) break;
        if (E.reset(cur)) {
#pragma unroll
        for (int a = 0; a < 2; ++a)
#pragma unroll
            for (int b = 0; b < 2; ++b)
#pragma unroll
                for (int m = 0; m < 4; ++m)
#pragma unroll
                    for (int n = 0; n < 2; ++n) acc[a][b][m][n] = (f32x4){0.f, 0.f, 0.f, 0.f};
        }
        cur = nxt; cA = nA; cB = nB; ++ui;
        if (wr == 1) PG8_BAR;
    }
    PG8_WAIT_V(0);
    PG8_BAR;
#undef PG8_SA
#undef PG8_SB
#undef PG8_STAGE
#undef PG8_LDA
#undef PG8_LDB
#undef PG8_MMA
#undef PG8_WAIT_V
#undef PG8_WAIT_L
#undef PG8_BAR
#undef PG8_SCHED
}
}
typedef f32x4 AccT[2][2][4][2];
#define EPI_RESET_ALWAYS __device__ __forceinline__ bool reset(const pg8::Unit&) const { return true; }
__device__ __forceinline__ unsigned cvt_pk_bf16(float lo, float hi) { unsigned r; asm volatile("v_cvt_pk_bf16_f32 %0, %1, %2" : "=v"(r) : "v"(lo), "v"(hi)); return r; }
__device__ __forceinline__ u32x4 pack8(const f32x4 v0, const f32x4 v1) { u32x4 w; w.x = cvt_pk_bf16(v0[0], v0[1]); w.y = cvt_pk_bf16(v0[2], v0[3]); w.z = cvt_pk_bf16(v1[0], v1[1]); w.w = cvt_pk_bf16(v1[2], v1[3]); return w; }
template <int MODE>
__device__ __forceinline__ void store_tile_bf16(const AccT& acc, bf16_t* base, int ldc, int row0, int col0, const float* bias, const float ascale = 1.f) {
#pragma unroll
    for (int ai = 0; ai < 2; ++ai)
#pragma unroll
        for (int m = 0; m < 4; ++m) { bf16_t* rowp = base + (size_t)(row0 + ai * 128 + m * 16) * ldc + col0;
#pragma unroll
            for (int bj = 0; bj < 2; ++bj) { f32x4 v0 = acc[ai][bj][m][0], v1 = acc[ai][bj][m][1];
                if (MODE == 1) { _Pragma("unroll") for (int e = 0; e < 4; ++e) { v0[e] = gelu_tanh(v0[e]); v1[e] = gelu_tanh(v1[e]); } }
                if (MODE == 2) { const f32x4 b0 = *(const f32x4*)(bias + col0 + bj * 128), b1 = *(const f32x4*)(bias + col0 + bj * 128 + 4);
                    v0 = v0 * ascale + b0; v1 = v1 * ascale + b1; _Pragma("unroll") for (int e = 0; e < 4; ++e) { v0[e] = sigmoid_(v0[e]); v1[e] = sigmoid_(v1[e]); } }
                *(u32x4*)(rowp + bj * 128) = pack8(v0, v1); }
            if (MODE == 2) asm volatile("" ::: "memory"); }
}
struct SchedP1a { const char* H; const char* WT; const char* MEMN; const char* WTM; int G, c;
    __device__ __forceinline__ bool next(int i, pg8::Unit& u) const {
        const int L = i * G + c; const int n1 = 64 * 18;
        if (L < n1) { pg8::tile_of(L, 64, 18, u.pm, u.pn); u.kind = 0; u.A = H + (size_t)u.pm * 256 * D * 2; u.B = WT + (size_t)u.pn * 256 * D * 2; u.nt = D / 64; pg8::uni(u); return true; }
        if (L < n1 + 8) { const int j = L - n1; u.pm = j >> 2; u.pn = j & 3; u.kind = 1; u.A = MEMN + (size_t)u.pm * 256 * D * 2; u.B = WTM + (size_t)u.pn * 256 * D * 2; u.nt = D / 64; pg8::uni(u); return true; }
        return false; } };
struct EpiP1a { bf16_t* PROJ; bf16_t* MEMKV; EPI_RESET_ALWAYS
    __device__ __forceinline__ void operator()(AccT& acc, const pg8::Unit& u, int wr, int wc, int fr, int fq) const {
        const int row0 = u.pm * 256 + wr * 64 + fr, cl = wc * 32 + 8 * fq;
        if (u.kind == 1) { store_tile_bf16<0>(acc, MEMKV, 2 * CW, row0, u.pn * 256 + cl, nullptr); return; }
        if (u.pn == 14 || u.pn == 15) { store_tile_bf16<1>(acc, PROJ, INW, row0, u.pn * 256 + cl, nullptr); return; }
        store_tile_bf16<0>(acc, PROJ, INW, row0, u.pn * 256 + cl, nullptr);
    } };
struct SchedP1b { const char* H8; const char* WT8; int G, c;
    __device__ __forceinline__ bool next(int i, pg8::Unit& u) const {
        const int L = i * G + c; if (L >= 64 * 24) return false;
        pg8::tile_of(L, 64, 24, u.pm, u.pn); u.kind = 0; u.A = H8 + (size_t)u.pm * 256 * D; u.B = WT8 + (size_t)u.pn * 256 * D; u.nt = D / 128; pg8::uni(u); return true; } };
struct EpiP1b { bf16_t* G; const float* bgate; EPI_RESET_ALWAYS
    __device__ __forceinline__ void operator()(AccT& acc, const pg8::Unit& u, int wr, int wc, int fr, int fq) const {
        store_tile_bf16<2>(acc, G, GW, u.pm * 256 + wr * 64 + fr, u.pn * 256 + wc * 32 + 8 * fq, bgate, 1.f / GATE_WSCALE);
    } };
struct SchedP3 { const char* O; const char* WT; int G, c;
    __device__ __forceinline__ bool next(int i, pg8::Unit& u) const {
        const int ti = i / 3, seg = i - 3 * ti; const int L = ti * G + c; if (L >= 64 * 8) return false;
        pg8::tile_of(L, 64, 8, u.pm, u.pn); u.kind = seg;
        const int kb = seg == 0 ? 0 : (seg == 1 ? 1024 : 1536);
        u.A = O + ((size_t)u.pm * 256 * D + kb) * 2; u.B = WT + ((size_t)u.pn * 256 * D + kb) * 2; u.nt = seg == 0 ? 16 : 8; pg8::uni(u); return true; } };
struct EpiP3 { const bf16_t* G; bf16_t* MERGED;
    __device__ __forceinline__ bool reset(const pg8::Unit& u) const { return u.kind == 2; }
    __device__ __forceinline__ void operator()(AccT& acc, const pg8::Unit& u, int wr, int wc, int fr, int fq) const {
        const int row0 = u.pm * 256 + wr * 64 + fr, col0 = u.pn * 256 + wc * 32 + 8 * fq, seg = u.kind;
#pragma unroll
        for (int ai = 0; ai < 2; ++ai)
#pragma unroll
            for (int mh = 0; mh < 2; ++mh) {
                u32x4 ga[2][2], gb[2][2];
#pragma unroll
                for (int mm = 0; mm < 2; ++mm)
#pragma unroll
                    for (int bj = 0; bj < 2; ++bj) { const bf16_t* gp = G + (size_t)(row0 + ai * 128 + (mh * 2 + mm) * 16) * GW + col0 + bj * 128;
                        ga[mm][bj] = *(const u32x4*)(gp + seg * D); gb[mm][bj] = (seg < 2) ? *(const u32x4*)(gp + (seg + 1) * D) : (u32x4){0u, 0u, 0u, 0u}; }
#pragma unroll
                for (int mm = 0; mm < 2; ++mm)
#pragma unroll
                    for (int bj = 0; bj < 2; ++bj) { const int m = mh * 2 + mm;
                        float fa[8], fb[8]; unpack8(ga[mm][bj], fa); unpack8(gb[mm][bj], fb);
                        if (seg < 2) { _Pragma("unroll") for (int e = 0; e < 8; ++e) fa[e] = fa[e] * __builtin_amdgcn_rcpf(fmaxf(fb[e], 1e-20f)); }
                        f32x4& v0 = acc[ai][bj][m][0]; f32x4& v1 = acc[ai][bj][m][1];
                        v0[0] *= fa[0]; v0[1] *= fa[1]; v0[2] *= fa[2]; v0[3] *= fa[3]; v1[0] *= fa[4]; v1[1] *= fa[5]; v1[2] *= fa[6]; v1[3] *= fa[7];
                        if (seg == 2) *(u32x4*)(MERGED + (size_t)(row0 + ai * 128 + m * 16) * D + col0 + bj * 128) = pack8(v0, v1);
                    }
                asm volatile("" ::: "memory");
            }
    } };
struct SchedSq { const char* A; const char* WT; int G, c;
    __device__ __forceinline__ bool next(int i, pg8::Unit& u) const {
        const int L = i * G + c; if (L >= 64 * 8) return false;
        pg8::tile_of(L, 64, 8, u.pm, u.pn); u.kind = 0; u.A = A + (size_t)u.pm * 256 * D * 2; u.B = WT + (size_t)u.pn * 256 * D * 2; u.nt = D / 64; pg8::uni(u); return true; } };
struct EpiP4 { const float* x; float* out; bf16_t* xb; float* ss; unsigned char* x8; EPI_RESET_ALWAYS
    __device__ __forceinline__ void operator()(AccT& acc, const pg8::Unit& u, int wr, int wc, int fr, int fq) const {
        const int row0 = u.pm * 256 + wr * 64 + fr, col0 = u.pn * 256 + wc * 32 + 8 * fq;
#pragma unroll
        for (int ai = 0; ai < 2; ++ai)
#pragma unroll
            for (int m = 0; m < 4; ++m) { const size_t row = (size_t)(row0 + ai * 128 + m * 16); float sq = 0.f;
#pragma unroll
                for (int bj = 0; bj < 2; ++bj) { const size_t o = row * D + col0 + bj * 128;
                    const f32x4 v0 = acc[ai][bj][m][0] + *(const f32x4*)(x + o), v1 = acc[ai][bj][m][1] + *(const f32x4*)(x + o + 4);
                    *(u32x4*)(xb + o) = pack8(v0, v1);
#define F8X(x_) fminf(fmaxf((x_), -448.f), 448.f)
                    { int w0 = __builtin_amdgcn_cvt_pk_fp8_f32(F8X(v0[0]), F8X(v0[1]), 0, false); w0 = __builtin_amdgcn_cvt_pk_fp8_f32(F8X(v0[2]), F8X(v0[3]), w0, true);
                      int w1 = __builtin_amdgcn_cvt_pk_fp8_f32(F8X(v1[0]), F8X(v1[1]), 0, false); w1 = __builtin_amdgcn_cvt_pk_fp8_f32(F8X(v1[2]), F8X(v1[3]), w1, true);
                      *(u32x2*)(x8 + o) = (u32x2){(unsigned)w0, (unsigned)w1}; }
                    sq += (v0[0] * v0[0] + v0[1] * v0[1]) + (v0[2] * v0[2] + v0[3] * v0[3]) + (v1[0] * v1[0] + v1[1] * v1[1]) + (v1[2] * v1[2] + v1[3] * v1[3]); }
                sq += __shfl_xor(sq, 16); sq += __shfl_xor(sq, 32);
                if (fq == 0) atomicAdd(ss + row, sq); }
    } };
struct EpiP5 { bf16_t* Q; const float* ss; EPI_RESET_ALWAYS
    __device__ __forceinline__ void operator()(AccT& acc, const pg8::Unit& u, int wr, int wc, int fr, int fq) const {
        const int row0 = u.pm * 256 + wr * 64 + fr, col0 = u.pn * 256 + wc * 32 + 8 * fq;
#pragma unroll
        for (int ai = 0; ai < 2; ++ai)
#pragma unroll
            for (int m = 0; m < 4; ++m) { const size_t row = (size_t)(row0 + ai * 128 + m * 16); const float rs = rsqrtf(ss[row] * (1.f / D) + EPS);
#pragma unroll
                for (int bj = 0; bj < 2; ++bj) *(u32x4*)(Q + row * D + col0 + bj * 128) = pack8(acc[ai][bj][m][0] * rs, acc[ai][bj][m][1] * rs); }
    } };


namespace att {
using s16x4  = __attribute__((ext_vector_type(4))) short;
using f32x16 = __attribute__((ext_vector_type(16))) float;
constexpr int NWV = 8, QBLK = 32, KVBLK = 64, DH = 128;
constexpr float THR = 8.f;
constexpr int SHM_V = KVBLK * DH * 2, SHM_K = KVBLK * DH * 2;
constexpr int OFF_WS = 2 * SHM_V + 2 * SHM_K, OFF_BT = OFF_WS + NWV * 64 * 4, OFF_OST = OFF_BT + 1536, LDS_NEED = OFF_OST + NWV * 8192;
#define KSWZ(row, colB) ((row) * 256 + ((colB) ^ (((row) & 7) << 4)))
#define SBAR() __builtin_amdgcn_sched_barrier(0)
__device__ __forceinline__ int crow(int r, int hi) { return (r & 3) + 8 * (r >> 2) + 4 * hi; }
__device__ __forceinline__ unsigned cvtpk(float lo, float hi) { unsigned r; asm volatile("v_cvt_pk_bf16_f32 %0, %1, %2" : "=v"(r) : "v"(lo), "v"(hi)); return r; }
__device__ __forceinline__ void partialSM(f32x16& p0, f32x16& p1, float& m_reg, float& mn, float& alpha) {
  constexpr float C = 1.4426950408889634f;
  float pmax = p0[0];
#pragma unroll
  for (int r = 1; r < 16; ++r) pmax = fmaxf(pmax, p0[r]);
#pragma unroll
  for (int r = 0; r < 16; ++r) pmax = fmaxf(pmax, p1[r]);
  { auto rr = __builtin_amdgcn_permlane32_swap(__float_as_uint(pmax), __float_as_uint(pmax), false, false);
    pmax = fmaxf(__uint_as_float(rr[0]), __uint_as_float(rr[1])); }
  if (__builtin_expect(__all(pmax - m_reg <= THR), 1)) { mn = m_reg; alpha = 1.f; }
  else { mn = fmaxf(m_reg, pmax); alpha = __builtin_amdgcn_exp2f((m_reg - mn) * C); m_reg = mn; }
  float mnC = -mn * C;
#pragma unroll
  for (int r = 0; r < 16; ++r) p0[r] = fmaf(p0[r], C, mnC);
#pragma unroll
  for (int r = 0; r < 16; ++r) p1[r] = fmaf(p1[r], C, mnC);
#pragma unroll
  for (int r = 0; r < 16; ++r) p0[r] = __builtin_amdgcn_exp2f(p0[r]);
}
__device__ __forceinline__ void finishSM(f32x16& p0, f32x16& p1, float alpha, float& l_reg, bf16x8& pa0, bf16x8& pa1, bf16x8& pa2, bf16x8& pa3) {
#pragma unroll
  for (int r = 0; r < 16; ++r) p1[r] = __builtin_amdgcn_exp2f(p1[r]);
  float ps = 0;
#pragma unroll
  for (int r = 0; r < 16; ++r) ps += p0[r];
#pragma unroll
  for (int r = 0; r < 16; ++r) ps += p1[r];
  { auto rr = __builtin_amdgcn_permlane32_swap(__float_as_uint(ps), __float_as_uint(ps), false, false);
    ps = __uint_as_float(rr[0]) + __uint_as_float(rr[1]); }
  l_reg = l_reg * alpha + ps;
#define PK4(P, BASE, OUT) do { unsigned a0 = cvtpk(P[BASE + 0], P[BASE + 1]), a1 = cvtpk(P[BASE + 2], P[BASE + 3]);   \
    unsigned b0 = cvtpk(P[BASE + 4], P[BASE + 5]), b1 = cvtpk(P[BASE + 6], P[BASE + 7]);                              \
    auto r0 = __builtin_amdgcn_permlane32_swap(a0, b0, false, false); auto r1 = __builtin_amdgcn_permlane32_swap(a1, b1, false, false); \
    u32x4 w = {r0[0], r1[0], r0[1], r1[1]}; OUT = *reinterpret_cast<bf16x8*>(&w); } while (0)
  PK4(p0, 0, pa0); PK4(p0, 8, pa1); PK4(p1, 0, pa2); PK4(p1, 8, pa3);
#undef PK4
}
template <bool BIAS>
__device__ __forceinline__ void qkt(f32x16& p0, f32x16& p1, const LAS char* Ks, const LAS char* qs, int r32, int hi, const LAS float* bp) {
  if (BIAS) {
#pragma unroll
    for (int r = 0; r < 16; ++r) { p0[r] = bp[(r & 3) + 8 * (r >> 2)]; p1[r] = bp[32 + (r & 3) + 8 * (r >> 2)]; }
  } else { p0 = f32x16{}; p1 = f32x16{}; }
#pragma unroll
  for (int d0 = 0; d0 < 8; ++d0) { int cb = (d0 * 16 + hi * 8) * 2;
    bf16x8 b0 = *reinterpret_cast<const LAS bf16x8*>(Ks + KSWZ(r32, cb));
    bf16x8 b1 = *reinterpret_cast<const LAS bf16x8*>(Ks + KSWZ(32 + r32, cb));
    const bf16x8 qv = *reinterpret_cast<const LAS bf16x8*>(qs + d0 * 1024);
    p0 = __builtin_amdgcn_mfma_f32_32x32x16_bf16(b0, qv, p0, 0, 0, 0);
    p1 = __builtin_amdgcn_mfma_f32_32x32x16_bf16(b1, qv, p1, 0, 0, 0); }
}
__device__ __forceinline__ int v_st(int k, int c) { const int kk = (k & ~0xC) | ((k & 4) << 1) | ((k & 8) >> 1); return ((kk >> 3) * 4 + (c >> 5)) * 512 + ((kk & 7) * 32 + (c & 31)) * 2; }
__device__ __forceinline__ int v_rd_base(int lane) { return ((lane & 3) << 3) | (((lane >> 2) & 3) << 6) | (((lane >> 4) & 1) << 5) | (((lane >> 5) & 1) << 8); }
constexpr int v_rd_off(int d0, int ks, int half) { return d0 * 512 + ks * 4096 + half * 2048; }
template <int OFF> __device__ __forceinline__ s16x4 tr_read(int vb) {
  s16x4 r; asm volatile("ds_read_b64_tr_b16 %0, %1 offset:%2" : "=&v"(r) : "v"(vb), "i"(OFF) : "memory"); return r;
}
template <int D0> __device__ __forceinline__ void pv_one(f32x16& od, int vb, bf16x8 pa0, bf16x8 pa1, bf16x8 pa2, bf16x8 pa3) {
  const s16x4 l0 = tr_read<v_rd_off(D0, 0, 0)>(vb), h0 = tr_read<v_rd_off(D0, 0, 1)>(vb), l1 = tr_read<v_rd_off(D0, 1, 0)>(vb), h1 = tr_read<v_rd_off(D0, 1, 1)>(vb);
  const s16x4 l2 = tr_read<v_rd_off(D0, 2, 0)>(vb), h2 = tr_read<v_rd_off(D0, 2, 1)>(vb), l3 = tr_read<v_rd_off(D0, 3, 0)>(vb), h3 = tr_read<v_rd_off(D0, 3, 1)>(vb);
  asm volatile("s_waitcnt lgkmcnt(0)" ::: "memory"); SBAR();
#define PK(L, H) (bf16x8){L[0], L[1], L[2], L[3], H[0], H[1], H[2], H[3]}
  od = __builtin_amdgcn_mfma_f32_32x32x16_bf16(pa0, PK(l0, h0), od, 0, 0, 0);
  od = __builtin_amdgcn_mfma_f32_32x32x16_bf16(pa1, PK(l1, h1), od, 0, 0, 0);
  od = __builtin_amdgcn_mfma_f32_32x32x16_bf16(pa2, PK(l2, h2), od, 0, 0, 0);
  od = __builtin_amdgcn_mfma_f32_32x32x16_bf16(pa3, PK(l3, h3), od, 0, 0, 0);
#undef PK
}
__device__ __forceinline__ void pv_d0(f32x16* o, int vb, bf16x8 pa0, bf16x8 pa1, bf16x8 pa2, bf16x8 pa3) {
  pv_one<0>(o[0], vb, pa0, pa1, pa2, pa3); pv_one<1>(o[1], vb, pa0, pa1, pa2, pa3); pv_one<2>(o[2], vb, pa0, pa1, pa2, pa3); pv_one<3>(o[3], vb, pa0, pa1, pa2, pa3);
}
template <int LDQ, int LDK, int LDO, bool BAND>
__device__ __forceinline__ void attn_body(const bf16_t* Qb, const bf16_t* Kh, const bf16_t* Vh, bf16_t* Ob,
                                          const int NT, const int kc0, const float* btab_src, LAS char* lds) {
  const int tid = threadIdx.x, wid = __builtin_amdgcn_readfirstlane(tid >> 6), lane = tid & 63, r32 = lane & 31, hi = lane >> 5;
  LAS char* V_lds = lds; LAS char* K_lds = lds + 2 * SHM_V;
  LAS float* wsf = (LAS float*)(lds + OFF_WS) + wid * 64; LAS float* li_l = wsf; LAS float* al_l = wsf + 32;
  LAS float* btab = (LAS float*)(lds + OFF_BT);
  if (BAND) { if (tid < 384) btab[tid] = tid < 64 ? btab_src[256] : (tid < 256 ? btab_src[320 - tid] : -30000.f); }
  float m_reg = -10000.f, l_reg = 0; f32x16 o[4] = {};
  const bf16_t* Qw = Qb + (long)(wid * QBLK + r32) * LDQ + hi * 8;
  LAS char* qr = lds + OFF_OST + wid * 8192 + lane * 16;
#pragma unroll
  for (int d0 = 0; d0 < 8; ++d0) *reinterpret_cast<LAS bf16x8*>(qr + d0 * 1024) = *reinterpret_cast<const bf16x8*>(Qw + d0 * 16);
  const int sr = tid >> 4, sc = (tid & 15) * 8, vst0 = v_st(sr, sc), vst1 = v_st(32 + sr, sc);
  const int vb0 = (int)(unsigned)(uintptr_t)V_lds + v_rd_base(lane);
  struct { bf16x8 vs0, vs1, ks0, ks1; } sr_[1];
  const int pw = wid >> 1, qi = (wid & 1) * 32 + r32;
#define TROW(t) ((BAND ? (((kc0) + (t)) > 0 ? ((kc0) + (t)) : 0) : (t)) * KVBLK)
#define SLOAD(i, t) do { const long k0_ = TROW(t); sr_[i].vs0 = *reinterpret_cast<const bf16x8*>(&Vh[(k0_ + sr) * LDK + sc]); sr_[i].vs1 = *reinterpret_cast<const bf16x8*>(&Vh[(k0_ + 32 + sr) * LDK + sc]); \
    sr_[i].ks0 = *reinterpret_cast<const bf16x8*>(&Kh[(k0_ + sr) * LDK + sc]); sr_[i].ks1 = *reinterpret_cast<const bf16x8*>(&Kh[(k0_ + 32 + sr) * LDK + sc]); } while (0)
#define SWRITE(b, i) do { *(LAS bf16x8*)(V_lds + (b) * SHM_V + vst0) = sr_[i].vs0; *(LAS bf16x8*)(V_lds + (b) * SHM_V + vst1) = sr_[i].vs1; int kc_ = sc * 2; \
    *(LAS bf16x8*)(K_lds + (b) * SHM_K + KSWZ(sr, kc_)) = sr_[i].ks0; *(LAS bf16x8*)(K_lds + (b) * SHM_K + KSWZ(32 + sr, kc_)) = sr_[i].ks1; } while (0)
#define SWAIT() asm volatile("s_waitcnt vmcnt(0)" ::: "memory")
#define RESC(a) do { if (__any((a) < 1.f)) { if (hi == 0) al_l[r32] = (a); asm volatile("s_waitcnt lgkmcnt(0)" ::: "memory"); \
    _Pragma("unroll") for (int d = 0; d < 4; ++d) _Pragma("unroll") for (int r = 0; r < 16; ++r) o[d][r] *= al_l[crow(r, hi)]; } } while (0)
#define BPTR(t) ({ const int t_ = (t); const int dch = pw + 8 - t_; int kb_ = 192 - dch * 64 - qi + 4 * hi; kb_ = kb_ < 0 ? 0 : kb_; \
    if (dch < 0 || dch > 8 || (kc0) + t_ < 0) kb_ = 288; (const LAS float*)(btab + kb_); })
  f32x16 pA0, pA1, pB0, pB1; float mnA, mnB, alA, alB; bf16x8 pa0, pa1, pa2, pa3;
  constexpr int SE = 0, SO = 0;
  SLOAD(SE, 0); asm volatile("s_waitcnt vmcnt(0)" ::: "memory"); SWRITE(0, SE); __syncthreads();
  qkt<BAND>(pA0, pA1, K_lds, qr, r32, hi, BPTR(0)); partialSM(pA0, pA1, m_reg, mnA, alA);
  SLOAD(SO, 1);
  SWAIT(); SWRITE(1, SO); __syncthreads();
  for (int j = 1; j + 1 < NT; j += 2) {
    SBAR(); qkt<BAND>(pB0, pB1, K_lds + SHM_K, qr, r32, hi, BPTR(j));
    finishSM(pA0, pA1, alA, l_reg, pa0, pa1, pa2, pa3); SBAR();
    SLOAD(SO, j + 1); SBAR();
    pv_d0(o, vb0, pa0, pa1, pa2, pa3); partialSM(pB0, pB1, m_reg, mnB, alB);
    __syncthreads(); SWAIT(); SWRITE(0, SE);
    RESC(alB); __syncthreads();
    SBAR(); qkt<BAND>(pA0, pA1, K_lds, qr, r32, hi, BPTR(j + 1));
    finishSM(pB0, pB1, alB, l_reg, pa0, pa1, pa2, pa3); SBAR();
    SLOAD(SE, j + 2); SBAR();
    pv_d0(o, vb0 + SHM_V, pa0, pa1, pa2, pa3); partialSM(pA0, pA1, m_reg, mnA, alA);
    __syncthreads(); SWAIT(); SWRITE(1, SO);
    RESC(alA); __syncthreads();
  }
  SBAR(); qkt<BAND>(pB0, pB1, K_lds + SHM_K, qr, r32, hi, BPTR(NT - 1));
  finishSM(pA0, pA1, alA, l_reg, pa0, pa1, pa2, pa3); SBAR();
  pv_d0(o, vb0, pa0, pa1, pa2, pa3); partialSM(pB0, pB1, m_reg, mnB, alB);
  __syncthreads(); RESC(alB);
  finishSM(pB0, pB1, alB, l_reg, pa0, pa1, pa2, pa3); SBAR();
  pv_d0(o, vb0 + SHM_V, pa0, pa1, pa2, pa3);
  if (hi == 0) li_l[r32] = l_reg; asm volatile("s_waitcnt lgkmcnt(0)" ::: "memory");
  float rli[16];
#pragma unroll
  for (int r = 0; r < 16; ++r) rli[r] = __builtin_amdgcn_rcpf(li_l[crow(r, hi)]);
  { LAS bf16_t* stg = (LAS bf16_t*)(lds + OFF_OST + wid * 8192);
#pragma unroll
    for (int r = 0; r < 16; ++r) { const int orow = crow(r, hi);
#pragma unroll
      for (int d0 = 0; d0 < 4; ++d0) stg[orow * 128 + d0 * 32 + r32] = (bf16_t)f2bf(o[d0][r] * rli[r]); }
    asm volatile("s_waitcnt lgkmcnt(0)" ::: "memory");
    bf16_t* Ow = Ob + (long)(wid * QBLK) * LDO;
#pragma unroll
    for (int i = 0; i < 8; ++i) { const int row = i * 4 + (lane >> 4), ch = lane & 15; const u32x4 v = *(const LAS u32x4*)(stg + row * 128 + ch * 8); *(u32x4*)(Ow + (long)row * LDO + ch * 8) = v; } }
  __syncthreads();
#undef TROW
#undef SLOAD
#undef SWRITE
#undef SWAIT
#undef RESC
#undef BPTR
}
#undef KSWZ
#undef SBAR
}


namespace rt {
using f32x16 = __attribute__((ext_vector_type(16))) float;
#define RKSWZ(row, colB) ((row) * 256 + ((colB) ^ (((row) & 7) << 4)))
__device__ __forceinline__ int crow(int r, int hi) { return (r & 3) + 8 * (r >> 2) + 4 * hi; }
__device__ __forceinline__ void ce_desc(unsigned& a, unsigned& b) { const unsigned mx = a > b ? a : b, mn = a > b ? b : a; a = mx; b = mn; }
__device__ __forceinline__ void sort16_desc(unsigned (&v)[16]) {
#pragma unroll
  for (int k = 2; k <= 16; k <<= 1)
#pragma unroll
    for (int j = k >> 1; j > 0; j >>= 1)
#pragma unroll
      for (int i = 0; i < 16; ++i) { const int l = i ^ j; if (l > i) { if ((i & k) == 0) ce_desc(v[i], v[l]); else ce_desc(v[l], v[i]); } }
}
__device__ __forceinline__ void merge16_desc(unsigned (&a)[16], const unsigned (&b)[16]) {
#pragma unroll
  for (int i = 0; i < 16; ++i) a[i] = a[i] > b[15 - i] ? a[i] : b[15 - i];
#pragma unroll
  for (int j = 8; j > 0; j >>= 1)
#pragma unroll
    for (int i = 0; i < 16; ++i) { const int l = i ^ j; if (l > i) ce_desc(a[i], a[l]); }
}
__device__ __forceinline__ unsigned fkey(float f) { const unsigned u = __float_as_uint(f); return (u & 0x80000000u) ? ~u : (u | 0x80000000u); }
__device__ __forceinline__ float fkey_inv(unsigned k) { const unsigned u = (k & 0x80000000u) ? (k & 0x7fffffffu) : ~k; return __uint_as_float(u); }
__device__ __forceinline__ void top16_half(const f32x16 (&sc)[4], int hi, unsigned (&out)[16]) {
  unsigned g[16];
#pragma unroll
  for (int blk = 0; blk < 4; ++blk) {
#pragma unroll
    for (int r = 0; r < 16; ++r) g[r] = (fkey(sc[blk][r]) & 0xFFFFFF80u) | (unsigned)(32 * blk + (r & 3) + 8 * (r >> 2) + 4 * hi);
    sort16_desc(g);
    if (blk == 0) {
#pragma unroll
      for (int r = 0; r < 16; ++r) out[r] = g[r];
    } else merge16_desc(out, g);
  }
  unsigned pb[16];
#pragma unroll
  for (int r = 0; r < 16; ++r) { auto rr = __builtin_amdgcn_permlane32_swap(out[r], out[r], false, false); pb[r] = hi ? rr[0] : rr[1]; }
  merge16_desc(out, pb);
}
__device__ __forceinline__ void route_phase(const Params& p, LAS unsigned char* lds, int tid, int lane, int wave) {
  const bf16_t* Q = (const bf16_t*)(p.ws + WS_Q); const bf16_t* KB = (const bf16_t*)(p.ws + WS_KEYSB);
  int* RIDX = (int*)(p.ws + WS_RIDX); float* RG = (float*)(p.ws + WS_RG);
  const int h = blockIdx.x & 7, grp = blockIdx.x >> 3;
  const int r32 = lane & 31, hi = lane >> 5;
#pragma unroll
  for (int c = 0; c < 2; ++c)
#pragma unroll
    for (int rep = 0; rep < 4; ++rep) { const int row = rep * 32 + (tid >> 4), cb = (tid & 15) * 16;
      *(LAS u32x4*)(lds + c * 32768 + RKSWZ(row, cb)) = *(const u32x4*)((const char*)KB + ((size_t)(h * 2 + c) * 128 + row) * 256 + cb); }
  __syncthreads();
  for (int tb = grp * 8 + wave; tb < T / 32; tb += (int)(gridDim.x >> 3) * 8) {
    const int t = tb * 32 + r32;
    unsigned ka[16], kb2[16];
#pragma unroll
    for (int c = 0; c < 2; ++c) {
      bf16x8 qf[8];
      const bf16_t* qp = Q + (size_t)t * D + h * 256 + c * 128 + hi * 8;
#pragma unroll
      for (int ks = 0; ks < 8; ++ks) qf[ks] = *(const bf16x8*)(qp + ks * 16);
      f32x16 sc[4];
#pragma unroll
      for (int blk = 0; blk < 4; ++blk) { sc[blk] = f32x16{};
#pragma unroll
        for (int ks = 0; ks < 8; ++ks) { const bf16x8 kf = *(const LAS bf16x8*)(lds + c * 32768 + RKSWZ(32 * blk + r32, (16 * ks + 8 * hi) * 2));
          sc[blk] = __builtin_amdgcn_mfma_f32_32x32x16_bf16(kf, qf[ks], sc[blk], 0, 0, 0); } }
      if (c == 0) top16_half(sc, hi, ka); else top16_half(sc, hi, kb2);
    }
    float av[16], bv[16];
#pragma unroll
    for (int i = 0; i < 16; ++i) { av[i] = fkey_inv(ka[i] & 0xFFFFFF80u); bv[i] = fkey_inv(kb2[i] & 0xFFFFFF80u); }
    float T[16];
#pragma unroll
    for (int k = 0; k < 16; ++k) T[k] = -3.0e38f;
#pragma unroll
    for (int i = 0; i < 16; ++i)
#pragma unroll
      for (int j = 0; j < 16; ++j) if ((i + 1) * (j + 1) <= 16) { float v = av[i] + bv[j];
#pragma unroll
          for (int k = 0; k < 16; ++k) { const float mx = fmaxf(T[k], v); v = fminf(T[k], v); T[k] = mx; } }
    const float m = T[0], theta = T[15];
    float Z = 0.f;
#pragma unroll
    for (int k = 0; k < 16; ++k) Z += __expf(T[k] - m);
    const float rz = 1.f / Z;
    int slot = 0; int cn = 0;
    int* ip = RIDX + (size_t)t * 128 + h * 16; float* gp = RG + (size_t)t * 128 + h * 16;
#pragma unroll
    for (int i = 0; i < 16; ++i)
#pragma unroll
      for (int j = 0; j < 16; ++j) if ((i + 1) * (j + 1) <= 16) { const float v = av[i] + bv[j];
          const bool sel = (v >= theta) && (slot < 16);
          if (sel && ((cn & 1) == hi)) { ip[slot] = (int)((ka[i] & 127u) * 128u + (kb2[j] & 127u)); gp[slot] = __expf(v - m) * rz; }
          slot += sel ? 1 : 0; ++cn; }
  }
}
#undef RKSWZ
}

#define XB_TMO      128
#define XB_XCNT(j)  (256  + 64 * (j))
#define XB_XSUB(j)  (1280 + 64 * (j))
#define XB_XGEN(j)  (2304 + 64 * (j))
#define XB_TOP      3328
#define XB_TOPGEN   3392
#define XCD_BAR_WORDS 3456
#define XB_SPIN_CAP (1u << 22)
__device__ __forceinline__ unsigned xb_ld(unsigned* p)              { return __hip_atomic_load(p, __ATOMIC_RELAXED, __HIP_MEMORY_SCOPE_AGENT); }
__device__ __forceinline__ unsigned xb_add(unsigned* p, unsigned v) { return __hip_atomic_fetch_add(p, v, __ATOMIC_RELAXED, __HIP_MEMORY_SCOPE_AGENT); }
__device__ __forceinline__ unsigned xb_xcc_id() { return (unsigned)__builtin_amdgcn_s_getreg((3 << 11) | 20) & 0xFu; }
#define XB_SPIN(cond, bar) do { unsigned _sp = 0; while (cond) { __builtin_amdgcn_s_sleep(1); \
    if ((++_sp & 255u) == 0u) { if (xb_ld(&(bar)[XB_TMO])) break; if (_sp > XB_SPIN_CAP) { atomicAdd(&(bar)[XB_TMO], 1u); break; } } } } while (0)
struct XcdBarrier { unsigned* bar; unsigned x; volatile LAS unsigned* st; };
__device__ __forceinline__ XcdBarrier xcd_barrier_post(unsigned* bar, volatile LAS unsigned* st) {
    XcdBarrier b; b.bar = bar; b.x = xb_xcc_id(); b.st = st;
    if (threadIdx.x == 0) (void)xb_add(&bar[XB_XCNT(b.x)], 1u);
    return b;
}
__device__ __forceinline__ void xcd_barrier_complete(unsigned* bar, unsigned x, unsigned& nloc, unsigned& nx) {
    const unsigned G = gridDim.x * gridDim.y * gridDim.z;
    unsigned sum, cnt, mine, sp = 0u;
    for (;;) {
        sum = 0u; cnt = 0u; mine = 0u;
#pragma unroll
        for (unsigned j = 0; j < 16; ++j) { const unsigned c = xb_ld(&bar[XB_XCNT(j)]); sum += c; cnt += (c > 0u) ? 1u : 0u; mine = (j == x) ? c : mine; }
        if (sum == G) break;
        __builtin_amdgcn_s_sleep(1);
        if ((++sp & 255u) == 0u) { if (xb_ld(&bar[XB_TMO])) break; if (sp > XB_SPIN_CAP) { atomicAdd(&bar[XB_TMO], 1u); break; } }
    }
    nloc = mine > 0u ? mine : 1u; nx = cnt > 0u ? cnt : 1u;
}
__device__ __forceinline__ void xcd_barrier(const XcdBarrier& b) {
    asm volatile("s_waitcnt vmcnt(0)" ::: "memory");
    __syncthreads();
    if (threadIdx.x == 0) {
        unsigned* bar = b.bar;
        __builtin_amdgcn_s_waitcnt(0);
        unsigned nloc = b.st[0], nx = b.st[1];
        if (nloc == 0u) { xcd_barrier_complete(bar, b.x, nloc, nx); b.st[0] = nloc; b.st[1] = nx; }
        const unsigned old = xb_add(&bar[XB_XSUB(b.x)], 1u);
        const unsigned gen = old / nloc;
        if (old + 1u == (gen + 1u) * nloc) {
            __builtin_amdgcn_fence(__ATOMIC_RELEASE, "agent");
            asm volatile("s_waitcnt vmcnt(0)" ::: "memory");
            const unsigned og = xb_add(&bar[XB_TOP], 1u);
            const unsigned tg = og / nx;
            if (og + 1u == (tg + 1u) * nx) xb_add(&bar[XB_TOPGEN], 1u);
            else XB_SPIN(xb_ld(&bar[XB_TOPGEN]) == tg, bar);
            __builtin_amdgcn_fence(__ATOMIC_ACQUIRE, "agent");
            xb_add(&bar[XB_XGEN(b.x)], 1u);
            asm volatile("s_waitcnt vmcnt(0)" ::: "memory");
        } else {
            XB_SPIN(xb_ld(&bar[XB_XGEN(b.x)]) == gen, bar);
            __builtin_amdgcn_fence(__ATOMIC_ACQUIRE, "agent");
            asm volatile("s_waitcnt vmcnt(0)" ::: "memory");
        }
    }
    __syncthreads();
}
constexpr int RING_BYTES = 131072, MISC_OFF = 143360, LDS_BYTES = 147456, NTHREADS = 512;
static_assert(att::LDS_NEED <= MISC_OFF, "attention scratch below the MISC words");
constexpr size_t WS_SLAB = WS_X2BF;

__device__ __forceinline__ void touch_buffer(const void* base, size_t bytes, int cb, int Gd, int tid) {
    const u32x4* b = (const u32x4*)base; const size_t n = bytes / 16, stride = (size_t)Gd * NTHREADS;
    u32x4 acc = {0u, 0u, 0u, 0u};
    for (size_t i = (size_t)cb * NTHREADS + tid; i < n; i += stride) { const u32x4 v = b[i]; acc.x ^= v.x; acc.y ^= v.y; acc.z ^= v.z; acc.w ^= v.w; }
    asm volatile("" :: "v"(acc.x), "v"(acc.y), "v"(acc.z), "v"(acc.w));
}
#define PH_BEGIN(i) unsigned long long t0_##i = 0; if ((PROBE_MASK >> (i)) & 1) t0_##i = __builtin_amdgcn_s_memrealtime();
#define PH_END(i) if ((PROBE_MASK >> (i)) & 1) probe_acc += __builtin_amdgcn_s_memrealtime() - t0_##i;
__global__ void __launch_bounds__(NTHREADS, 2) fwd(Params p) {
    extern __shared__ __attribute__((aligned(16))) unsigned char lds_raw[];
    LAS unsigned char* lds = (LAS unsigned char*)lds_raw;
    volatile LAS unsigned* MISC = (volatile LAS unsigned*)(lds + MISC_OFF);
    const int tid = threadIdx.x, lane = tid & 63, wave = __builtin_amdgcn_readfirstlane(tid >> 6);
    const int nwb = NTHREADS / 64;
    const int gw = blockIdx.x * nwb + wave, NW = gridDim.x * nwb;
    const int Gd = gridDim.x, cb = blockIdx.x;
    unsigned char* ws = p.ws;
    bf16_t* WT_IN = (bf16_t*)(ws + WS_WT_IN); bf16_t* WT_GATE = (bf16_t*)(ws + WS_WT_GATE); bf16_t* WT_BR = (bf16_t*)(ws + WS_WT_BR);
    bf16_t* WT_O = (bf16_t*)(ws + WS_WT_O); bf16_t* WT_PQ = (bf16_t*)(ws + WS_WT_PQ); bf16_t* WT_MKV = (bf16_t*)(ws + WS_WT_MKV);
    bf16_t* KEYSB = (bf16_t*)(ws + WS_KEYSB); bf16_t* MEMN = (bf16_t*)(ws + WS_MEMN); bf16_t* MEMKV = (bf16_t*)(ws + WS_MEMKV);
    bf16_t* HO = (bf16_t*)(ws + WS_HO); bf16_t* PROJ = (bf16_t*)(ws + WS_PROJ); bf16_t* G = (bf16_t*)(ws + WS_G);
    bf16_t* MERGED = (bf16_t*)(ws + WS_MERGED); bf16_t* X2BF = (bf16_t*)(ws + WS_X2BF); bf16_t* QB = (bf16_t*)(ws + WS_Q);
        float* SS2 = (float*)(ws + WS_CTL + CTL_SS2_BYTE);
    if (tid < 64) MISC[tid] = 0u;
    __syncthreads();
    XcdBarrier bar = xcd_barrier_post((unsigned*)(ws + WS_CTL + CTL_BAR_BYTE), MISC + 8);
    if (tid == 0) MISC[16] = xb_add((unsigned*)(ws + WS_CTL + CTL_RANK_BYTE) + 64 * bar.x, 1u);

    unsigned long long probe_acc = 0;
    PH_BEGIN(0)
    {
        LAS float* scr = (LAS float*)lds + wave * (64 * 33);
        const int I0 = (D / 64) * (INW / 32), I1 = I0 + (D / 64) * (GW / 32), I2 = I1 + (D / 64) * (D / 32), I3 = I2 + (D / 64) * (D / 32), I4 = I3 + (D / 64) * (D / 32), I5 = I4 + (D / 64) * (2 * CW / 32);
#define TRJOB(it, jb, li) do { if ((it) < I0) { jb = TrJob{p.in[3], WT_IN, nullptr, D, INW, 0.f}; li = (it); } else if ((it) < I1) { jb = TrJob{p.in[18], WT_GATE, nullptr, D, GW, GATE_WSCALE}; li = (it) - I0; } \
            else if ((it) < I2) { jb = TrJob{p.in[20], WT_BR, nullptr, D, D, 0.f}; li = (it) - I1; } else if ((it) < I3) { jb = TrJob{p.in[21], WT_O, nullptr, D, D, 0.f}; li = (it) - I2; } \
            else if ((it) < I4) { jb = TrJob{p.in[23], WT_PQ, p.in[22], D, D, 0.f}; li = (it) - I3; } else { jb = TrJob{p.in[15], WT_MKV, nullptr, D, 2 * CW, 0.f}; li = (it) - I4; } } while (0)
        for (int it = gw; it < I5; it += 2 * NW) {
            TrJob ja, jb2; int la, lb; f32x4 va[8], vb[8];
            TRJOB(it, ja, la); tr_load(ja, la, lane, va);
            const bool has2 = it + NW < I5;
            if (has2) { TRJOB(it + NW, jb2, lb); tr_load(jb2, lb, lane, vb); }
            tr_store(ja, la, lane, va, scr);
            if (has2) tr_store(jb2, lb, lane, vb, scr);
        }
#undef TRJOB
        rms_rows(p.in[0], p.in[2], HO, ws + WS_H8, T, gw, NW, lane);
        rms_rows(p.in[1], p.in[14], MEMN, nullptr, BATCH * NMEM, gw, NW, lane);
        const float* keys = p.in[24];
        for (int i = gw * 64 + lane; i < PH * 2 * NKEYS * 128 / 2; i += NW * 64) ((unsigned*)KEYSB)[i] = pk2(keys[2 * i], keys[2 * i + 1]);
    }
    xcd_barrier(bar);
    PH_END(0)
    PH_BEGIN(1)
    {
        SchedP1a Sa{(const char*)HO, (const char*)WT_IN, (const char*)MEMN, (const char*)WT_MKV, Gd, cb};
        EpiP1a Ea{PROJ, MEMKV};
        pg8::gemm_phase<false>(lds, D, D, Sa, Ea);
        SchedP1b Sb{(const char*)(ws + WS_H8), (const char*)WT_GATE, Gd, cb};
        EpiP1b Eb{G, p.in[19]};
        pg8::gemm_phase<true>(lds, D / 2, D / 2, Sb, Eb);
    }
    xcd_barrier(bar);
    PH_END(1)
    PH_BEGIN(2)
    {
        const float qscale = 0.08838834764831845f;
        { HeadGains hg; load_head_gains(hg, p.in[4], p.in[5], p.in[16], lane);
          for (int t = gw; t < T; t += NW) headnorm_token(PROJ + (size_t)t * INW, hg, qscale, lane); }
        for (int it = gw; it < BATCH * NMEM * 4; it += NW) { const int m = it / 4, j = it % 4; headnorm(MEMKV + (size_t)m * (2 * CW) + j * 128, p.in[17], 1.f, lane); }
        for (int u = gw; u < BATCH * NCH * 8; u += NW) { const int g = u % 8, c = (u / 8) % NCH, b = u / (8 * NCH); lru_pass1(p, b, c, g, lane, lds + wave * 8192); }
        fp4_tables(p, gw, NW, lane);
    }
    xcd_barrier(bar);
    PH_END(2)
    PH_BEGIN(3)
    {
        const int nA = BATCH * 8 * (NCH / 4), nC = BATCH * 4 * (SEQ / 256);
        PH_BEGIN(9)
        for (int u = cb; u < nA + nC; u += Gd) {
            if (u < nA) {
                const int cg = u % (NCH / 4), h = (u / (NCH / 4)) % 8, b = u / ((NCH / 4) * 8);
                const size_t brow = (size_t)b * SEQ, qrow = brow + (size_t)cg * 256;
                att::attn_body<INW, INW, D, true>(PROJ + qrow * INW + C_QA + h * 128, PROJ + brow * INW + C_KA + h * 128, PROJ + brow * INW + C_VA + h * 128,
                                                  HO + qrow * D + h * 128, 12, cg * 4 - NPREV, p.in[6] + h * 257, (LAS char*)lds);
            } else {
                const int v = u - nA; const int qb = v % (SEQ / 256), h = (v / (SEQ / 256)) % 4, b = v / ((SEQ / 256) * 4);
                const size_t qrow = (size_t)b * SEQ + (size_t)qb * 256;
                att::attn_body<INW, 2 * CW, D, false>(PROJ + qrow * INW + C_QC + h * 128, MEMKV + (size_t)b * NMEM * (2 * CW) + h * 128, MEMKV + (size_t)b * NMEM * (2 * CW) + CW + h * 128,
                                                     HO + qrow * D + AW + LW + h * 128, NMEM / 64, 0, nullptr, (LAS char*)lds);
            }
        }
        PH_END(9)
        PH_BEGIN(10)
        for (int u = gw; u < BATCH * NCH * 8; u += NW) { const int g = u % 8, c = (u / 8) % NCH, b = u / (8 * NCH); lru_pass2(p, b, c, g, lane); }
        touch_buffer(WT_BR, (size_t)D * D * 2, cb, Gd, tid); touch_buffer(WT_O, (size_t)D * D * 2, cb, Gd, tid);
        PH_END(10)
    }
    xcd_barrier(bar);
    PH_END(3)
    PH_BEGIN(4)
    {
        SchedP3 S{(const char*)HO, (const char*)WT_BR, Gd, cb};
        EpiP3 E{G, MERGED};
        pg8::gemm_phase<false>(lds, D, D, S, E);
    }
    xcd_barrier(bar);
    PH_END(4)
    PH_BEGIN(5)
    {
        SchedSq S{(const char*)MERGED, (const char*)WT_O, Gd, cb};
        EpiP4 E{p.in[0], p.out, X2BF, SS2, ws + WS_X2F8};
        pg8::gemm_phase<false>(lds, D, D, S, E);
        touch_buffer(WT_PQ, (size_t)D * D * 2, cb, Gd, tid);
    }
    xcd_barrier(bar);
    PH_END(5)
    PH_BEGIN(6)
    {
        SchedSq S{(const char*)X2BF, (const char*)WT_PQ, Gd, cb};
        EpiP5 E{QB, SS2};
        pg8::gemm_phase<false>(lds, D, D, S, E);
    }
    xcd_barrier(bar);
    PH_END(6)
    PH_BEGIN(7)
    rt::route_phase(p, lds, tid, lane, wave);
    xcd_barrier(bar);
    PH_END(7)
    PH_BEGIN(8)
    int ppos, pnx, prank, pnloc;
    { if (tid == 0) { unsigned pos = 0, nx = 0; const unsigned* bw = (const unsigned*)(ws + WS_CTL + CTL_BAR_BYTE);
#pragma unroll
          for (unsigned j = 0; j < 16; ++j) { const unsigned cj = xb_ld((unsigned*)&bw[XB_XCNT(j)]); nx += cj > 0u ? 1u : 0u; pos += (cj > 0u && j < bar.x) ? 1u : 0u; }
          MISC[17] = pos; MISC[18] = nx > 0u ? nx : 1u; }
      __syncthreads();
      ppos = (int)MISC[17]; pnx = (int)MISC[18]; prank = (int)MISC[16]; pnloc = (int)MISC[8]; if (pnloc < 1) pnloc = 1; }
    peer_u_step(p, lane, wave, lds + wave * 16384, ppos, pnx, prank, pnloc);
    xcd_barrier(bar);
    for (int t = gw; t < T; t += NW) peer_combine(p, t, lane);
    xcd_barrier(bar);
    peer_v_step(p, lane, wave, lds + wave * 16384, ppos, pnx, prank, pnloc);
    if (PROBE_MASK) { __syncthreads(); PH_END(8) const unsigned long long te = __builtin_amdgcn_s_memrealtime(); while (__builtin_amdgcn_s_memrealtime() - te < probe_acc) __builtin_amdgcn_s_sleep(8); }
}

extern "C" void kernel_launch(void* const* d_in, const int* in_sizes, int n_in, void* d_out, int out_size, void* d_ws, size_t ws_size, hipStream_t stream) {
    static int grid = 0;
    if (grid == 0) {
        if (n_in != 27 || out_size != T * D || ws_size < WS_END) { fprintf(stderr, "kernel_launch: unexpected problem (n_in %d out %d ws %zu)\n", n_in, out_size, ws_size); grid = -1; return; }
        int dev = 0, cus = 0, per_cu = 0;
        (void)hipGetDevice(&dev); (void)hipDeviceGetAttribute(&cus, hipDeviceAttributeMultiprocessorCount, dev);
        if (hipFuncSetAttribute((const void*)fwd, hipFuncAttributeMaxDynamicSharedMemorySize, LDS_BYTES) != hipSuccess) { fprintf(stderr, "kernel_launch: hipFuncSetAttribute failed\n"); grid = -1; return; }
        (void)hipOccupancyMaxActiveBlocksPerMultiprocessor(&per_cu, (const void*)fwd, NTHREADS, LDS_BYTES);
        if (per_cu < 1) { fprintf(stderr, "kernel_launch: occupancy query says %d\n", per_cu); grid = -1; return; }
        grid = cus;
    }
    if (grid < 0) return;
    (void)hipMemsetAsync((char*)d_ws + WS_CTL, 0, 1 * MiB, stream);
    Params p{};
    for (int i = 0; i < 27; ++i) p.in[i] = (const float*)d_in[i];
    p.out = (float*)d_out; p.ws = (unsigned char*)d_ws;
    void* args[] = {&p};
    hipError_t e = hipLaunchCooperativeKernel((const void*)fwd, dim3(grid), dim3(NTHREADS), args, LDS_BYTES, stream);
    if (e != hipSuccess) fprintf(stderr, "cooperative launch failed: %s (grid %d)\n", hipGetErrorString(e), grid);
}
```

```cpp
#include <hip/hip_runtime.h>
#include <hip/hip_cooperative_groups.h>
#include <cstdio>
#include <cstdint>
namespace cg = cooperative_groups;
#ifndef PROBE_MASK
#define PROBE_MASK 0
#endif

#define LAS __attribute__((address_space(3)))
typedef unsigned short bf16_t;
typedef short bf16x8 __attribute__((ext_vector_type(8)));
typedef float f32x4 __attribute__((ext_vector_type(4)));
typedef unsigned u32x4 __attribute__((ext_vector_type(4)));
typedef unsigned u32x2 __attribute__((ext_vector_type(2)));

constexpr int D = 2048, BATCH = 2, SEQ = 8192, T = BATCH * SEQ;
constexpr int CHUNK = 64, NPREV = 8, NCH = SEQ / CHUNK;
constexpr int AW = 1024, LW = 512, CW = 512, INW = 4608, GW = 6144;
constexpr int NMEM = 256;
constexpr int PH = 8, NKEYS = 128, TOPK = 16;
constexpr float EPS = 1e-6f;
constexpr int C_QA = 0, C_KA = 1024, C_VA = 2048, C_XL = 3072, C_GL = 3584, C_QC = 4096;

constexpr size_t MiB = 1u << 20;
constexpr size_t WS_CTL = 0;
constexpr size_t WS_WT_IN = 2 * MiB, WS_WT_GATE = 20 * MiB, WS_WT_BR = 44 * MiB, WS_WT_O = 52 * MiB, WS_WT_PQ = 60 * MiB, WS_WT_MKV = 68 * MiB;
constexpr size_t WS_KEYSB = 72 * MiB, WS_MEMN = 73 * MiB, WS_MEMKV = 75 * MiB, WS_LRUSUM = 76 * MiB, WS_RS2 = 77 * MiB;
constexpr size_t WS_HO = 80 * MiB;
constexpr size_t WS_PROJ = 144 * MiB;
constexpr size_t WS_MERGED = 144 * MiB, WS_X2BF = 208 * MiB;
constexpr size_t WS_G = 288 * MiB;
constexpr size_t WS_TABU = 496 * MiB, WS_TABV = 512 * MiB, WS_Q = 416 * MiB;
constexpr size_t WS_SCU = 77 * MiB, WS_SCV = 77 * MiB + 65536;
constexpr size_t WS_AUA = 2 * MiB, WS_AUU = 18 * MiB;
constexpr size_t WS_H8 = 496 * MiB;
constexpr float GATE_WSCALE = 256.f;
constexpr size_t WS_RIDX = 480 * MiB, WS_RG = 488 * MiB, WS_END = 528 * MiB;

constexpr size_t CTL_BAR_BYTE = 16384, CTL_RANK_BYTE = 65536, CTL_SS2_BYTE = 512 * 1024;
struct Params { const float* in[27]; float* out; unsigned char* ws; };

__device__ __forceinline__ float bf2f(unsigned v16) { return __uint_as_float(v16 << 16); }
typedef float f32x2c __attribute__((ext_vector_type(2))); typedef __bf16 bf16x2c __attribute__((ext_vector_type(2)));
__device__ __forceinline__ unsigned pk2(float lo, float hi) { const f32x2c v = {lo, hi}; return __builtin_bit_cast(unsigned, __builtin_convertvector(v, bf16x2c)); }
__device__ __forceinline__ unsigned f2bf(float f) { return pk2(f, 0.f) & 0xffffu; }
__device__ __forceinline__ float wave_sum(float v) {
#pragma unroll
    for (int o = 1; o < 64; o <<= 1) v += __shfl_xor(v, o);
    return v;
}
typedef __bf16 bf16x2_t __attribute__((ext_vector_type(2)));
__device__ __forceinline__ float dot2bf(unsigned w, unsigned x, float acc) { return __builtin_amdgcn_fdot2_f32_bf16(__builtin_bit_cast(bf16x2_t, w), __builtin_bit_cast(bf16x2_t, x), acc, false); }
__device__ __forceinline__ float sigmoid_(float x) { return 1.f / (1.f + __expf(-x)); }
__device__ __forceinline__ float gelu_tanh(float x) { const float y = 1.5957691216f * (x + 0.044715f * x * x * x); return x / (1.f + __expf(-y)); }
__device__ __forceinline__ void unpack8(const u32x4 w, float* f) {
    f[0] = __uint_as_float(w.x << 16); f[1] = __uint_as_float(w.x & 0xffff0000u);
    f[2] = __uint_as_float(w.y << 16); f[3] = __uint_as_float(w.y & 0xffff0000u);
    f[4] = __uint_as_float(w.z << 16); f[5] = __uint_as_float(w.z & 0xffff0000u);
    f[6] = __uint_as_float(w.w << 16); f[7] = __uint_as_float(w.w & 0xffff0000u);
}

struct TrJob { const float* W; bf16_t* WT; const float* ks; int K, N; float f8scale; };
__device__ __forceinline__ void tr_load(const TrJob& jb, int item, int lane, f32x4 (&v)[8]) {
    const int nblk = jb.N / 32, kb = item / nblk, nb = item % nblk, k0 = 64 * kb, n0 = 32 * nb;
#pragma unroll
    for (int i = 0; i < 8; ++i) { const int kk = 8 * i + (lane >> 3); v[i] = *(const f32x4*)(jb.W + (size_t)(k0 + kk) * jb.N + n0 + 4 * (lane & 7)); if (jb.ks) v[i] = v[i] * jb.ks[k0 + kk]; }
}
__device__ __forceinline__ void tr_store(const TrJob& jb, int item, int lane, const f32x4 (&v)[8], LAS float* scr) {
    const int nblk = jb.N / 32, kb = item / nblk, nb = item % nblk, k0 = 64 * kb, n0 = 32 * nb;
#pragma unroll
    for (int i = 0; i < 8; ++i) { LAS float* d = scr + (8 * i + (lane >> 3)) * 33 + 4 * (lane & 7); d[0] = v[i].x; d[1] = v[i].y; d[2] = v[i].z; d[3] = v[i].w; }
    asm volatile("s_waitcnt lgkmcnt(0)" ::: "memory");
    const int c = lane & 7;
#pragma unroll
    for (int j = 0; j < 4; ++j) { const int n = (lane >> 3) + 8 * j; const LAS float* s = scr + (8 * c) * 33 + n;
        if (jb.f8scale != 0.f) { const float f = jb.f8scale; u32x2 o;
#define F8C(x_) fminf(fmaxf((x_) * f, -448.f), 448.f)
            int w = __builtin_amdgcn_cvt_pk_fp8_f32(F8C(s[0 * 33]), F8C(s[1 * 33]), 0, false); w = __builtin_amdgcn_cvt_pk_fp8_f32(F8C(s[2 * 33]), F8C(s[3 * 33]), w, true); o.x = (unsigned)w;
            w = __builtin_amdgcn_cvt_pk_fp8_f32(F8C(s[4 * 33]), F8C(s[5 * 33]), 0, false); w = __builtin_amdgcn_cvt_pk_fp8_f32(F8C(s[6 * 33]), F8C(s[7 * 33]), w, true); o.y = (unsigned)w;
#undef F8C
            *(u32x2*)((unsigned char*)jb.WT + (size_t)(n0 + n) * jb.K + k0 + 8 * c) = o; }
        else { u32x4 o; o.x = pk2(s[0 * 33], s[1 * 33]); o.y = pk2(s[2 * 33], s[3 * 33]); o.z = pk2(s[4 * 33], s[5 * 33]); o.w = pk2(s[6 * 33], s[7 * 33]);
            *(u32x4*)(jb.WT + (size_t)(n0 + n) * jb.K + k0 + 8 * c) = o; } }
    asm volatile("s_waitcnt lgkmcnt(0)" ::: "memory");
}
__device__ __forceinline__ void rms_row_load(const float* xrow, int lane, f32x4 (&v)[8]) {
    const f32x4* xr = (const f32x4*)xrow + lane;
#pragma unroll
    for (int j = 0; j < 8; ++j) v[j] = xr[64 * j];
}
__device__ __forceinline__ void rms_row_finish(const f32x4 (&v)[8], const float* g, bf16_t* orow, unsigned char* o8row, int lane) {
    const f32x4* gr = (const f32x4*)g + lane; float s = 0.f;
#pragma unroll
    for (int j = 0; j < 8; ++j) s += (v[j].x * v[j].x + v[j].y * v[j].y) + (v[j].z * v[j].z + v[j].w * v[j].w);
    const float rstd = rsqrtf(wave_sum(s) * (1.f / D) + EPS);
    u32x2* o8 = (u32x2*)orow + lane;
#pragma unroll
    for (int j = 0; j < 8; ++j) { const f32x4 gg = gr[64 * j]; const float a0 = v[j].x * rstd * gg.x, a1 = v[j].y * rstd * gg.y, a2 = v[j].z * rstd * gg.z, a3 = v[j].w * rstd * gg.w;
        u32x2 o; o.x = pk2(a0, a1); o.y = pk2(a2, a3); o8[64 * j] = o;
        if (o8row) { int w = __builtin_amdgcn_cvt_pk_fp8_f32(fminf(fmaxf(a0, -448.f), 448.f), fminf(fmaxf(a1, -448.f), 448.f), 0, false);
            w = __builtin_amdgcn_cvt_pk_fp8_f32(fminf(fmaxf(a2, -448.f), 448.f), fminf(fmaxf(a3, -448.f), 448.f), w, true); ((unsigned*)o8row)[64 * j + lane] = (unsigned)w; } }
}
__device__ __forceinline__ void rms_rows(const float* X, const float* g, bf16_t* O, unsigned char* O8, int nrows, int gw, int NW, int lane) {
    f32x4 va[8], vb[8];
    int m = gw;
    if (m < nrows) rms_row_load(X + (size_t)m * D, lane, va);
    for (; m < nrows; m += 2 * NW) {
        const bool hb = m + NW < nrows;
        if (hb) rms_row_load(X + (size_t)(m + NW) * D, lane, vb);
        rms_row_finish(va, g, O + (size_t)m * D, O8 ? O8 + (size_t)m * D : nullptr, lane);
        if (m + 2 * NW < nrows) rms_row_load(X + (size_t)(m + 2 * NW) * D, lane, va);
        if (hb) rms_row_finish(vb, g, O + (size_t)(m + NW) * D, O8 ? O8 + (size_t)(m + NW) * D : nullptr, lane);
    }
}

template <int TM, int TN, class Epi>
__device__ __forceinline__ void gemm_simple(const bf16_t* __restrict__ A, int lda, const bf16_t* __restrict__ Bt, int ldb, int M, int N, int K, const Epi& epi, int gw, int NW, int lane) {
    const int r = lane & 15, q = lane >> 4;
    const int ntm = M / (16 * TM), ntn = N / (16 * TN);
    for (int tile = gw; tile < ntm * ntn; tile += NW) {
        const int tm = tile / ntn, tn = tile % ntn;
        f32x4 acc[TM][TN];
#pragma unroll
        for (int i = 0; i < TM; ++i)
#pragma unroll
            for (int j = 0; j < TN; ++j) acc[i][j] = (f32x4){0.f, 0.f, 0.f, 0.f};
        const bf16_t* ap = A + (size_t)(tm * 16 * TM + r) * lda + q * 8;
        const bf16_t* bp = Bt + (size_t)(tn * 16 * TN + r) * ldb + q * 8;
        for (int k0 = 0; k0 < K; k0 += 32) {
            bf16x8 af[TM], bfr[TN];
#pragma unroll
            for (int i = 0; i < TM; ++i) af[i] = *(const bf16x8*)(ap + (size_t)i * 16 * lda + k0);
#pragma unroll
            for (int j = 0; j < TN; ++j) bfr[j] = *(const bf16x8*)(bp + (size_t)j * 16 * ldb + k0);
#pragma unroll
            for (int i = 0; i < TM; ++i)
#pragma unroll
                for (int j = 0; j < TN; ++j) acc[i][j] = __builtin_amdgcn_mfma_f32_16x16x32_bf16(af[i], bfr[j], acc[i][j], 0, 0, 0);
        }
#pragma unroll
        for (int i = 0; i < TM; ++i)
#pragma unroll
            for (int j = 0; j < TN; ++j)
#pragma unroll
                for (int e = 0; e < 4; ++e) epi(tm * 16 * TM + i * 16 + q * 4 + e, tn * 16 * TN + j * 16 + r, acc[i][j][e]);
    }
}
struct EpiProj { bf16_t* P; __device__ __forceinline__ void operator()(int row, int col, float v) const { if (col >= C_GL && col < C_QC) v = gelu_tanh(v); P[(size_t)row * INW + col] = (bf16_t)f2bf(v); } };
struct EpiGate { bf16_t* G; const float* b; __device__ __forceinline__ void operator()(int row, int col, float v) const { G[(size_t)row * GW + col] = (bf16_t)f2bf(sigmoid_(v + b[col])); } };
struct EpiStore { bf16_t* C; int ldc; __device__ __forceinline__ void operator()(int row, int col, float v) const { C[(size_t)row * ldc + col] = (bf16_t)f2bf(v); } };
struct EpiWo { const float* x; float* out; bf16_t* xb; __device__ __forceinline__ void operator()(int row, int col, float v) const { const size_t o = (size_t)row * D + col; const float y = x[o] + v; out[o] = y; xb[o] = (bf16_t)f2bf(y); } };
struct EpiQ { bf16_t* Q; const float* rs; __device__ __forceinline__ void operator()(int row, int col, float v) const { Q[(size_t)row * D + col] = (bf16_t)f2bf(v * rs[row]); } };

__device__ __forceinline__ void headnorm(bf16_t* vec, const float* g, float scale, int lane) {
    unsigned* p = (unsigned*)vec + lane; const unsigned w = *p;
    const float a = bf2f(w & 0xffffu), b = bf2f(w >> 16);
    const float rs = rsqrtf(wave_sum(a * a + b * b) * (1.f / 128.f) + EPS) * scale;
    *p = pk2(a * rs * g[2 * lane], b * rs * g[2 * lane + 1]);
}
struct HeadGains { float gq[32], gk[32], gc[8]; };
__device__ __forceinline__ void load_head_gains(HeadGains& hg, const float* gq, const float* gk, const float* gc, int lane) {
#pragma unroll
    for (int j = 0; j < 32; ++j) { hg.gq[j] = gq[(lane & 3) * 32 + j]; hg.gk[j] = gk[(lane & 3) * 32 + j]; }
#pragma unroll
    for (int j = 0; j < 8; ++j) hg.gc[j] = gc[(lane & 15) * 8 + j];
}
__device__ __forceinline__ void headnorm_token(bf16_t* row, const HeadGains& hg, float qscale, int lane) {
    u32x4* pa = (u32x4*)(row + C_QA) + lane * 4;
    u32x4* pc = (u32x4*)(row + C_QC) + lane;
    u32x4 w[4]; const u32x4 wc = *pc;
#pragma unroll
    for (int j = 0; j < 4; ++j) w[j] = pa[j];
    float f[32], fc[8]; float ss = 0.f, sc = 0.f;
#pragma unroll
    for (int j = 0; j < 4; ++j) unpack8(w[j], f + 8 * j);
    unpack8(wc, fc);
#pragma unroll
    for (int j = 0; j < 32; ++j) ss = fmaf(f[j], f[j], ss);
#pragma unroll
    for (int j = 0; j < 8; ++j) sc = fmaf(fc[j], fc[j], sc);
    ss += __shfl_xor(ss, 1); ss += __shfl_xor(ss, 2);
    sc += __shfl_xor(sc, 1); sc += __shfl_xor(sc, 2); sc += __shfl_xor(sc, 4); sc += __shfl_xor(sc, 8);
    const bool isq = lane < 32;
    const float rs = rsqrtf(ss * (1.f / 128.f) + EPS) * (isq ? qscale : 1.f), rc = rsqrtf(sc * (1.f / 128.f) + EPS) * qscale;
#pragma unroll
    for (int j = 0; j < 4; ++j) { u32x4 o;
        o.x = pk2(f[8 * j] * rs * (isq ? hg.gq[8 * j] : hg.gk[8 * j]), f[8 * j + 1] * rs * (isq ? hg.gq[8 * j + 1] : hg.gk[8 * j + 1]));
        o.y = pk2(f[8 * j + 2] * rs * (isq ? hg.gq[8 * j + 2] : hg.gk[8 * j + 2]), f[8 * j + 3] * rs * (isq ? hg.gq[8 * j + 3] : hg.gk[8 * j + 3]));
        o.z = pk2(f[8 * j + 4] * rs * (isq ? hg.gq[8 * j + 4] : hg.gk[8 * j + 4]), f[8 * j + 5] * rs * (isq ? hg.gq[8 * j + 5] : hg.gk[8 * j + 5]));
        o.w = pk2(f[8 * j + 6] * rs * (isq ? hg.gq[8 * j + 6] : hg.gk[8 * j + 6]), f[8 * j + 7] * rs * (isq ? hg.gq[8 * j + 7] : hg.gk[8 * j + 7]));
        pa[j] = o; }
    { u32x4 o; o.x = pk2(fc[0] * rc * hg.gc[0], fc[1] * rc * hg.gc[1]); o.y = pk2(fc[2] * rc * hg.gc[2], fc[3] * rc * hg.gc[3]);
      o.z = pk2(fc[4] * rc * hg.gc[4], fc[5] * rc * hg.gc[5]); o.w = pk2(fc[6] * rc * hg.gc[6], fc[7] * rc * hg.gc[7]); *pc = o; }
}

__device__ __forceinline__ void lru_pass1(const Params& p, int b, int c, int g, int lane, LAS unsigned char* wl  ) {
    const bf16_t* PROJ = (const bf16_t*)(p.ws + WS_PROJ);
    float* SUMA = (float*)(p.ws + WS_LRUSUM); float* SUMB = SUMA + BATCH * NCH * LW;
    bf16_t* AUA = (bf16_t*)(p.ws + WS_AUA); bf16_t* AUU = (bf16_t*)(p.ws + WS_AUU);
    const float* conv_w = p.in[7]; const float* conv_b = p.in[8]; const float* lru_wa = p.in[9]; const float* lru_ba = p.in[10];
    const float* lru_wx = p.in[11]; const float* lru_bx = p.in[12]; const float* lam = p.in[13];
    const int ch = g * 64 + lane;
    unsigned wa_p[32], wx_p[32];
#pragma unroll
    for (int m = 0; m < 32; ++m) { wa_p[m] = pk2(lru_wa[(size_t)(g * 64 + 2 * m) * 64 + lane], lru_wa[(size_t)(g * 64 + 2 * m + 1) * 64 + lane]);
        wx_p[m] = pk2(lru_wx[(size_t)(g * 64 + 2 * m) * 64 + lane], lru_wx[(size_t)(g * 64 + 2 * m + 1) * 64 + lane]); }
    const float cw0 = conv_w[0 * LW + ch], cw1 = conv_w[1 * LW + ch], cw2 = conv_w[2 * LW + ch], cw3 = conv_w[3 * LW + ch], cb = conv_b[ch];
    const float ba_ = lru_ba[ch], bx_ = lru_bx[ch];
    const float sp = log1pf(__expf(-lam[ch]));
    const int t0 = c * CHUNK; const size_t row0 = (size_t)b * SEQ + t0;
    float x0 = 0.f, x1 = 0.f, x2 = 0.f;
    if (t0 >= 3) { x0 = bf2f(PROJ[(row0 - 3) * INW + C_XL + ch]); x1 = bf2f(PROJ[(row0 - 2) * INW + C_XL + ch]); x2 = bf2f(PROJ[(row0 - 1) * INW + C_XL + ch]); }
    { const bf16_t* xs = PROJ + (row0 + (lane >> 3)) * INW + C_XL + g * 64 + (lane & 7) * 8;
      u32x4 tx[8];
#pragma unroll
      for (int i = 0; i < 8; ++i) tx[i] = *(const u32x4*)(xs + (size_t)(8 * i) * INW);
#pragma unroll
      for (int i = 0; i < 8; ++i) *(LAS u32x4*)(wl + (8 * i + (lane >> 3)) * 128 + (lane & 7) * 16) = tx[i]; }
    float h = 0.f, aprod = 1.f;
#define LRU_PAIRX(xc_) ({ const float xnb_ = __int_as_float(__builtin_amdgcn_update_dpp(0, __float_as_int(xc_), 0xB1, 0xf, 0xf, true));     \
        (lane & 1) ? pk2(xnb_, xc_) : pk2(xc_, xnb_); })
#define LRU_GATE(rp_, ip_, xc_, a_, u_) do { const float r_ = sigmoid_(rp_), ig_ = sigmoid_(ip_); const float la_ = -8.f * r_ * sp; a_ = __expf(la_); \
        u_ = sqrtf(fminf(fmaxf((1.f - a_) * (1.f + a_), 1e-12f), 1.f)) * ig_ * xc_; } while (0)
#pragma unroll 1
    for (int t = 0; t < CHUNK; t += 2) {
        const float x3 = bf2f(*(const LAS bf16_t*)(wl + t * 128 + lane * 2)), x4 = bf2f(*(const LAS bf16_t*)(wl + (t + 1) * 128 + lane * 2));
        const float xcA = cw0 * x0 + cw1 * x1 + cw2 * x2 + cw3 * x3 + cb, xcB = cw0 * x1 + cw1 * x2 + cw2 * x3 + cw3 * x4 + cb;
        x0 = x2; x1 = x3; x2 = x4;
        const unsigned pkA = LRU_PAIRX(xcA), pkB = LRU_PAIRX(xcB);
        float rA = ba_, iA = bx_, rA2 = 0.f, iA2 = 0.f, rB = ba_, iB = bx_, rB2 = 0.f, iB2 = 0.f;
#pragma unroll
        for (int m = 0; m < 32; m += 2) {
            const unsigned a0 = (unsigned)__builtin_amdgcn_readlane((int)pkA, 2 * m), a1 = (unsigned)__builtin_amdgcn_readlane((int)pkA, 2 * m + 2);
            const unsigned b0 = (unsigned)__builtin_amdgcn_readlane((int)pkB, 2 * m), b1 = (unsigned)__builtin_amdgcn_readlane((int)pkB, 2 * m + 2);
            rA = dot2bf(wa_p[m], a0, rA); iA = dot2bf(wx_p[m], a0, iA); rA2 = dot2bf(wa_p[m + 1], a1, rA2); iA2 = dot2bf(wx_p[m + 1], a1, iA2);
            rB = dot2bf(wa_p[m], b0, rB); iB = dot2bf(wx_p[m], b0, iB); rB2 = dot2bf(wa_p[m + 1], b1, rB2); iB2 = dot2bf(wx_p[m + 1], b1, iB2); }
        float aA, uA, aB, uB;
        LRU_GATE(rA + rA2, iA + iA2, xcA, aA, uA); LRU_GATE(rB + rB2, iB + iB2, xcB, aB, uB);
        const unsigned wA = f2bf(1.f - aA), wB = f2bf(1.f - aB), vA = f2bf(uA), vB = f2bf(uB);
        AUA[(row0 + t) * LW + ch] = (bf16_t)wA; AUA[(row0 + t + 1) * LW + ch] = (bf16_t)wB; AUU[(row0 + t) * LW + ch] = (bf16_t)vA; AUU[(row0 + t + 1) * LW + ch] = (bf16_t)vB;
        const float aAq = 1.f - bf2f(wA), aBq = 1.f - bf2f(wB);
        h = aBq * (aAq * h + bf2f(vA)) + bf2f(vB);
        aprod *= aAq * aBq;
    }
#undef LRU_PAIRX
#undef LRU_GATE
    { const size_t o = (size_t)(b * NCH + c) * LW + ch; SUMA[o] = aprod; SUMB[o] = h; }
}
__device__ __forceinline__ void lru_pass2(const Params& p, int b, int c, int g, int lane) {
    const bf16_t* PROJ = (const bf16_t*)(p.ws + WS_PROJ); bf16_t* O = (bf16_t*)(p.ws + WS_HO);
    const float* SUMA = (const float*)(p.ws + WS_LRUSUM); const float* SUMB = SUMA + BATCH * NCH * LW;
    const bf16_t* AUA = (const bf16_t*)(p.ws + WS_AUA); const bf16_t* AUU = (const bf16_t*)(p.ws + WS_AUU);
    const int ch = g * 64 + lane; const size_t row0 = (size_t)b * SEQ + (size_t)c * CHUNK;
    const bf16_t* ap = AUA + row0 * LW + ch; const bf16_t* up = AUU + row0 * LW + ch; const bf16_t* gp = PROJ + row0 * INW + C_GL + ch;
    bf16_t an[16], un[16], gn[16];
#pragma unroll
    for (int q = 0; q < 16; ++q) { an[q] = ap[(size_t)q * LW]; un[q] = up[(size_t)q * LW]; gn[q] = gp[(size_t)q * INW]; }
    float h = 0.f;
    {
        int j = 0;
#pragma unroll 1
        for (; j + 32 <= c; j += 32) { float sa[32], sb[32];
#pragma unroll
            for (int q = 0; q < 32; ++q) { const size_t o = (size_t)(b * NCH + j + q) * LW + ch; sa[q] = SUMA[o]; sb[q] = SUMB[o]; }
#pragma unroll
            for (int q = 0; q < 32; ++q) h = sa[q] * h + sb[q]; }
#pragma unroll 1
        for (; j + 8 <= c; j += 8) { float sa[8], sb[8];
#pragma unroll
            for (int q = 0; q < 8; ++q) { const size_t o = (size_t)(b * NCH + j + q) * LW + ch; sa[q] = SUMA[o]; sb[q] = SUMB[o]; }
#pragma unroll
            for (int q = 0; q < 8; ++q) h = sa[q] * h + sb[q]; }
        for (; j < c; ++j) { const size_t o = (size_t)(b * NCH + j) * LW + ch; h = SUMA[o] * h + SUMB[o]; }
    }
#pragma unroll 1
    for (int tb = 0; tb < CHUNK; tb += 16) {
        bf16_t ac[16], uc[16], gc[16];
#pragma unroll
        for (int q = 0; q < 16; ++q) { ac[q] = an[q]; uc[q] = un[q]; gc[q] = gn[q]; }
        if (tb + 16 < CHUNK) {
#pragma unroll
            for (int q = 0; q < 16; ++q) { an[q] = ap[(size_t)(tb + 16 + q) * LW]; un[q] = up[(size_t)(tb + 16 + q) * LW]; gn[q] = gp[(size_t)(tb + 16 + q) * INW]; }
        }
#pragma unroll
        for (int q = 0; q < 16; ++q) { h = (1.f - bf2f(ac[q])) * h + bf2f(uc[q]); O[(row0 + tb + q) * D + AW + ch] = (bf16_t)f2bf(h * bf2f(gc[q])); }
    }
}

__device__ __forceinline__ void attn_simple(const bf16_t* Qp, int ldq, const bf16_t* Kp, const bf16_t* Vp, int ldkv, int nkeys, int koff, const float* bias_h, bf16_t* Op, int ldo, int tid) {
    const int qi = tid >> 2, part = tid & 3;
    float q[32], o[32];
    { const u32x4* qp = (const u32x4*)(Qp + (size_t)qi * ldq + part * 32);
#pragma unroll
      for (int j = 0; j < 4; ++j) unpack8(qp[j], q + 8 * j); }
#pragma unroll
    for (int d = 0; d < 32; ++d) o[d] = 0.f;
    float m = -1e30f, l = 0.f;
    for (int kk0 = 0; kk0 < nkeys; kk0 += 8) {
        float s[8];
#pragma unroll
        for (int j = 0; j < 8; ++j) {
            const u32x4* kp = (const u32x4*)(Kp + (size_t)(kk0 + j) * ldkv + part * 32);
            float acc = 0.f;
#pragma unroll
            for (int w = 0; w < 4; ++w) { float kf[8]; unpack8(kp[w], kf);
#pragma unroll
                for (int e = 0; e < 8; ++e) acc = fmaf(q[8 * w + e], kf[e], acc); }
            acc += __shfl_xor(acc, 1); acc += __shfl_xor(acc, 2);
            if (bias_h) { int dist = qi + koff - (kk0 + j); dist = dist < -128 ? -128 : (dist > 128 ? 128 : dist); acc += bias_h[dist + 128]; }
            s[j] = acc;
        }
        float mx = s[0];
#pragma unroll
        for (int j = 1; j < 8; ++j) mx = fmaxf(mx, s[j]);
        const float mn = fmaxf(m, mx), corr = __expf(m - mn);
        l *= corr;
#pragma unroll
        for (int d = 0; d < 32; ++d) o[d] *= corr;
#pragma unroll
        for (int j = 0; j < 8; ++j) {
            const float pj = __expf(s[j] - mn); l += pj;
            const u32x4* vp = (const u32x4*)(Vp + (size_t)(kk0 + j) * ldkv + part * 32);
#pragma unroll
            for (int w = 0; w < 4; ++w) { float vf[8]; unpack8(vp[w], vf);
#pragma unroll
                for (int e = 0; e < 8; ++e) o[8 * w + e] = fmaf(pj, vf[e], o[8 * w + e]); }
        }
        m = mn;
    }
    const float inv = 1.f / l;
    u32x4* op = (u32x4*)(Op + (size_t)qi * ldo + part * 32);
#pragma unroll
    for (int w = 0; w < 4; ++w) { u32x4 ov; ov.x = pk2(o[8 * w] * inv, o[8 * w + 1] * inv); ov.y = pk2(o[8 * w + 2] * inv, o[8 * w + 3] * inv); ov.z = pk2(o[8 * w + 4] * inv, o[8 * w + 5] * inv); ov.w = pk2(o[8 * w + 6] * inv, o[8 * w + 7] * inv); op[w] = ov; }
}

__device__ __forceinline__ void gemm_branch(const bf16_t* __restrict__ Ob, const bf16_t* __restrict__ WT, const bf16_t* __restrict__ G, bf16_t* __restrict__ Mg, int gw, int NW, int lane) {
    const int r = lane & 15, q = lane >> 4;
    const int ntn = D / 32, ntiles = (T / 32) * ntn;
    for (int tile = gw; tile < ntiles; tile += NW) {
        const int tm = tile / ntn, tn = tile % ntn;
        f32x4 acc[3][2][2];
#pragma unroll
        for (int s = 0; s < 3; ++s)
#pragma unroll
            for (int i = 0; i < 2; ++i)
#pragma unroll
                for (int j = 0; j < 2; ++j) acc[s][i][j] = (f32x4){0.f, 0.f, 0.f, 0.f};
        const bf16_t* ap = Ob + (size_t)(tm * 32 + r) * D + q * 8;
        const bf16_t* bp = WT + (size_t)(tn * 32 + r) * D + q * 8;
#pragma unroll
        for (int s = 0; s < 3; ++s) {
            const int kb = s == 0 ? 0 : (s == 1 ? 1024 : 1536), ke = s == 0 ? 1024 : (s == 1 ? 1536 : 2048);
            for (int k0 = kb; k0 < ke; k0 += 32) {
                bf16x8 af[2], bfr[2];
#pragma unroll
                for (int i = 0; i < 2; ++i) af[i] = *(const bf16x8*)(ap + (size_t)i * 16 * D + k0);
#pragma unroll
                for (int j = 0; j < 2; ++j) bfr[j] = *(const bf16x8*)(bp + (size_t)j * 16 * D + k0);
#pragma unroll
                for (int i = 0; i < 2; ++i)
#pragma unroll
                    for (int j = 0; j < 2; ++j) acc[s][i][j] = __builtin_amdgcn_mfma_f32_16x16x32_bf16(af[i], bfr[j], acc[s][i][j], 0, 0, 0);
            }
        }
#pragma unroll
        for (int i = 0; i < 2; ++i)
#pragma unroll
            for (int j = 0; j < 2; ++j)
#pragma unroll
                for (int e = 0; e < 4; ++e) {
                    const int row = tm * 32 + i * 16 + q * 4 + e, col = tn * 32 + j * 16 + r;
                    const bf16_t* gp = G + (size_t)row * GW + col;
                    const float mval = bf2f(gp[0]) * acc[0][i][j][e] + bf2f(gp[2048]) * acc[1][i][j][e] + bf2f(gp[4096]) * acc[2][i][j][e];
                    Mg[(size_t)row * D + col] = (bf16_t)f2bf(mval);
                }
    }
}

__device__ __forceinline__ unsigned long long shfl_xor64(unsigned long long v, int m) {
    const unsigned lo = __shfl_xor((unsigned)v, m), hi = __shfl_xor((unsigned)(v >> 32), m);
    return ((unsigned long long)hi << 32) | lo;
}
__device__ __forceinline__ unsigned fkey(float f) { const unsigned u = __float_as_uint(f); return (u & 0x80000000u) ? ~u : (u | 0x80000000u); }
__device__ __forceinline__ float fkey_inv(unsigned k) { const unsigned u = (k & 0x80000000u) ? (k & 0x7fffffffu) : ~k; return __uint_as_float(u); }
__device__ __forceinline__ unsigned long long wave_max64(unsigned long long k) {
#pragma unroll
    for (int o = 1; o < 64; o <<= 1) { const unsigned long long t = shfl_xor64(k, o); k = t > k ? t : k; }
    return k;
}
__device__ __forceinline__ void route_unit(const Params& p, int t, int h, int lane) {
    const bf16_t* Q = (const bf16_t*)(p.ws + WS_Q); const bf16_t* KB = (const bf16_t*)(p.ws + WS_KEYSB);
    int* RIDX = (int*)(p.ws + WS_RIDX); float* RG = (float*)(p.ws + WS_RG);
    float sv_l[2] = {0.f, 0.f}; int si_l[2] = {0, 0};
#pragma unroll
    for (int c = 0; c < 2; ++c) {
        const bf16_t* qv = Q + (size_t)t * D + h * 256 + c * 128;
        const unsigned qw = ((const unsigned*)qv)[lane];
        const float qa = bf2f(qw & 0xffffu), qb = bf2f(qw >> 16);
        const bf16_t* k0p = KB + ((size_t)(h * 2 + c) * NKEYS + lane) * 128;
        const bf16_t* k1p = k0p + 64 * 128;
        float s0 = 0.f, s1 = 0.f;
#pragma unroll
        for (int w = 0; w < 16; ++w) {
            float k0f[8], k1f[8]; unpack8(((const u32x4*)k0p)[w], k0f); unpack8(((const u32x4*)k1p)[w], k1f);
#pragma unroll
            for (int e = 0; e < 8; e += 2) {
                const int src = 4 * w + e / 2;
                const float xa = __int_as_float(__builtin_amdgcn_readlane(__float_as_int(qa), src));
                const float xb = __int_as_float(__builtin_amdgcn_readlane(__float_as_int(qb), src));
                s0 = fmaf(xa, k0f[e], s0); s0 = fmaf(xb, k0f[e + 1], s0);
                s1 = fmaf(xa, k1f[e], s1); s1 = fmaf(xb, k1f[e + 1], s1);
            }
        }
        unsigned long long ka = ((unsigned long long)fkey(s0) << 32) | (unsigned)(255 - lane);
        unsigned long long kb = ((unsigned long long)fkey(s1) << 32) | (unsigned)(255 - (lane + 64));
        for (int rnd = 0; rnd < TOPK; ++rnd) {
            const unsigned long long best = wave_max64(ka > kb ? ka : kb);
            if (ka == best) ka = 0ull; if (kb == best) kb = 0ull;
            if (lane == rnd) { sv_l[c] = fkey_inv((unsigned)(best >> 32)); si_l[c] = 255 - (int)(best & 0xffffffffu); }
        }
    }
    unsigned long long kc[4];
#pragma unroll
    for (int m = 0; m < 4; ++m) { const int cid = lane + 64 * m, i = cid >> 4, j = cid & 15;
        const float v = __shfl(sv_l[0], i) + __shfl(sv_l[1], j);
        kc[m] = ((unsigned long long)fkey(v) << 32) | (unsigned)(1023 - cid); }
    float fv = 0.f; int cidx = 0;
    for (int rnd = 0; rnd < TOPK; ++rnd) {
        unsigned long long loc = kc[0] > kc[1] ? kc[0] : kc[1]; const unsigned long long loc2 = kc[2] > kc[3] ? kc[2] : kc[3]; loc = loc > loc2 ? loc : loc2;
        const unsigned long long best = wave_max64(loc);
#pragma unroll
        for (int m = 0; m < 4; ++m) if (kc[m] == best) kc[m] = 0ull;
        if (lane == rnd) { fv = fkey_inv((unsigned)(best >> 32)); cidx = 1023 - (int)(best & 0xffffffffu); }
    }
    const float fmax_ = __shfl(fv, 0);
    float e = lane < 16 ? __expf(fv - fmax_) : 0.f;
    float ssum = e;
#pragma unroll
    for (int o = 1; o < 16; o <<= 1) ssum += __shfl_xor(ssum, o);
    const int ci = cidx >> 4, cj = cidx & 15;
    const int e0 = __shfl(si_l[0], ci), e1 = __shfl(si_l[1], cj);
    if (lane < 16) { RIDX[(size_t)t * 128 + h * 16 + lane] = e0 * NKEYS + e1; RG[(size_t)t * 128 + h * 16 + lane] = e / ssum; }
}

typedef float f32x2 __attribute__((ext_vector_type(2)));
__device__ __forceinline__ void fp4_row_load(const float* __restrict__ src, const float* __restrict__ kscale, int lane, f32x4 (&v)[8]) {
#pragma unroll
    for (int j = 0; j < 8; ++j) { v[j] = ((const f32x4*)src)[64 * j + lane]; if (kscale) v[j] = v[j] * ((const f32x4*)kscale)[64 * j + lane]; }
}
__device__ __forceinline__ void fp4_row_finish(const f32x4 (&v)[8], unsigned char* __restrict__ tab, int e, float* __restrict__ scale_out, int lane) {
    float mx = 0.f;
#pragma unroll
    for (int j = 0; j < 8; ++j) mx = fmaxf(mx, fmaxf(fmaxf(fabsf(v[j].x), fabsf(v[j].y)), fmaxf(fabsf(v[j].z), fabsf(v[j].w))));
#pragma unroll
    for (int o = 1; o < 64; o <<= 1) mx = fmaxf(mx, __shfl_xor(mx, o));
    const float sc = mx > 0.f ? mx * (1.f / 6.f) : 1.f, inv = 1.f / sc;
#pragma unroll
    for (int j = 0; j < 8; ++j) {
        const f32x4 a = v[j] * inv;
        unsigned pk = 0u;
        pk = __builtin_amdgcn_cvt_scalef32_pk_fp4_f32(pk, fminf(fmaxf(a.x, -6.f), 6.f), fminf(fmaxf(a.y, -6.f), 6.f), 1.0f, 0);
        pk = __builtin_amdgcn_cvt_scalef32_pk_fp4_f32(pk, fminf(fmaxf(a.z, -6.f), 6.f), fminf(fmaxf(a.w, -6.f), 6.f), 1.0f, 1);
        *(unsigned short*)(tab + ((size_t)j * 16384 + e) * 128 + 2 * lane) = (unsigned short)pk;
    }
    if (lane == 0) *scale_out = sc;
}
__device__ __forceinline__ void fp4_tables(const Params& p, int gw, int NW, int lane) {
    f32x4 va[8], vb[8];
#define FP4_LOAD(r, v) do { if ((r) < 16384) fp4_row_load(p.in[25] + (size_t)(r) * D, p.in[22], lane, v); else fp4_row_load(p.in[26] + (size_t)((r) - 16384) * D, nullptr, lane, v); } while (0)
#define FP4_FIN(r, v) do { if ((r) < 16384) fp4_row_finish(v, p.ws + WS_TABU, (r), (float*)(p.ws + WS_SCU) + (r), lane); \
        else fp4_row_finish(v, p.ws + WS_TABV, (r) - 16384, (float*)(p.ws + WS_SCV) + ((r) - 16384), lane); } while (0)
    const int n = 2 * 16384;
    int r = gw;
    if (r < n) FP4_LOAD(r, va);
    for (; r < n; r += 2 * NW) {
        const bool hb = r + NW < n;
        if (hb) FP4_LOAD(r + NW, vb);
        FP4_FIN(r, va);
        if (r + 2 * NW < n) FP4_LOAD(r + 2 * NW, va);
        if (hb) FP4_FIN(r + NW, vb);
    }
#undef FP4_LOAD
#undef FP4_FIN
}
constexpr size_t WS_ZP = WS_Q;
constexpr size_t WS_X2F8 = 2 * MiB;
__device__ __forceinline__ float dot_chunk(const u32x4 w, const float (&xf)[32]) {
    float a0 = 0.f, a1 = 0.f;
#pragma unroll
    for (int q = 0; q < 4; ++q) {
        const f32x2 a = __builtin_amdgcn_cvt_scalef32_pk_f32_fp4(w[q], 1.0f, 0), b = __builtin_amdgcn_cvt_scalef32_pk_f32_fp4(w[q], 1.0f, 1);
        const f32x2 c = __builtin_amdgcn_cvt_scalef32_pk_f32_fp4(w[q], 1.0f, 2), d = __builtin_amdgcn_cvt_scalef32_pk_f32_fp4(w[q], 1.0f, 3);
        a0 = fmaf(a.x, xf[8 * q], a0); a1 = fmaf(a.y, xf[8 * q + 1], a1); a0 = fmaf(b.x, xf[8 * q + 2], a0); a1 = fmaf(b.y, xf[8 * q + 3], a1);
        a0 = fmaf(c.x, xf[8 * q + 4], a0); a1 = fmaf(c.y, xf[8 * q + 5], a1); a0 = fmaf(d.x, xf[8 * q + 6], a0); a1 = fmaf(d.y, xf[8 * q + 7], a1);
    }
    return a0 + a1;
}
__device__ __forceinline__ void axpy_chunk(const u32x4 w, const float a_, float (&of)[32]) {
#pragma unroll
    for (int q = 0; q < 4; ++q) {
        const f32x2 a = __builtin_amdgcn_cvt_scalef32_pk_f32_fp4(w[q], 1.0f, 0), b = __builtin_amdgcn_cvt_scalef32_pk_f32_fp4(w[q], 1.0f, 1);
        const f32x2 c = __builtin_amdgcn_cvt_scalef32_pk_f32_fp4(w[q], 1.0f, 2), d = __builtin_amdgcn_cvt_scalef32_pk_f32_fp4(w[q], 1.0f, 3);
        of[8 * q] = fmaf(a_, a.x, of[8 * q]); of[8 * q + 1] = fmaf(a_, a.y, of[8 * q + 1]); of[8 * q + 2] = fmaf(a_, b.x, of[8 * q + 2]); of[8 * q + 3] = fmaf(a_, b.y, of[8 * q + 3]);
        of[8 * q + 4] = fmaf(a_, c.x, of[8 * q + 4]); of[8 * q + 5] = fmaf(a_, c.y, of[8 * q + 5]); of[8 * q + 6] = fmaf(a_, d.x, of[8 * q + 6]); of[8 * q + 7] = fmaf(a_, d.y, of[8 * q + 7]);
    }
}
struct PeerTok { u32x4 w[16]; u32x4 x[4]; };
template <bool USTEP>
__device__ __forceinline__ void peer_issue(PeerTok& k, const Params& p, const unsigned char* tab, int t, int xv, int lane) {
    const int* RIDX = (const int*)(p.ws + WS_RIDX);
    const int i0 = RIDX[(size_t)t * 128 + lane], i1 = RIDX[(size_t)t * 128 + 64 + lane];
    const int es = lane >> 3, ck = lane & 7;
    if (USTEP) { const bf16_t* xp = (const bf16_t*)(p.ws + WS_X2BF) + (size_t)t * D + 256 * xv + 32 * ck;
#pragma unroll
        for (int j = 0; j < 4; ++j) k.x[j] = *(const u32x4*)(xp + 8 * j); }
#pragma unroll
    for (int g = 0; g < 16; ++g) { const int e = __shfl(g < 8 ? i0 : i1, (8 * g + es) & 63); k.w[g] = *(const u32x4*)(tab + (size_t)e * 128 + ck * 16); }
}
__device__ __forceinline__ void peer_u_finish(const PeerTok& k, const Params& p, int t, int xv, int lane) {
    const int es = lane >> 3, ck = lane & 7;
    float xf[32];
#pragma unroll
    for (int j = 0; j < 4; ++j) unpack8(k.x[j], xf + 8 * j);
    float zsel0 = 0.f, zsel1 = 0.f;
#pragma unroll
    for (int g = 0; g < 16; ++g) { u32x4 w_ = k.w[g]; asm volatile("" : "+v"(w_)); float d = dot_chunk(w_, xf);
        d += __int_as_float(__builtin_amdgcn_update_dpp(0, __float_as_int(d), 0xB1, 0xf, 0xf, true));
        d += __int_as_float(__builtin_amdgcn_update_dpp(0, __float_as_int(d), 0x4E, 0xf, 0xf, true));
        d += __int_as_float(__builtin_amdgcn_update_dpp(0, __float_as_int(d), 0x141, 0xf, 0xf, true));
        if (g < 8) { if (ck == g) zsel0 = d; } else { if (ck == g - 8) zsel1 = d; }
        asm volatile("" : "+v"(zsel0), "+v"(zsel1)); }
    float* zp = (float*)(p.ws + WS_ZP) + ((size_t)xv * T + t) * 128;
    zp[8 * ck + es] = zsel0; zp[64 + 8 * ck + es] = zsel1;
}
__device__ __forceinline__ void peer_v_finish(const PeerTok& k, const Params& p, int t, int xv, int lane, LAS float* red) {
    const float* RG = (const float*)(p.ws + WS_RG);
    const float a0 = RG[(size_t)t * 128 + lane], a1 = RG[(size_t)t * 128 + 64 + lane];
    const int es = lane >> 3, ck = lane & 7;
    float of[32];
#pragma unroll
    for (int q = 0; q < 32; ++q) of[q] = 0.f;
#pragma unroll
    for (int g = 0; g < 16; ++g) { const float a = __shfl(g < 8 ? a0 : a1, (8 * g + es) & 63); u32x4 w_ = k.w[g]; asm volatile("" : "+v"(w_)); axpy_chunk(w_, a, of);
        asm volatile("" : "+v"(of[0]), "+v"(of[1]), "+v"(of[2]), "+v"(of[3]), "+v"(of[4]), "+v"(of[5]), "+v"(of[6]), "+v"(of[7]), "+v"(of[8]), "+v"(of[9]), "+v"(of[10]), "+v"(of[11]), "+v"(of[12]), "+v"(of[13]), "+v"(of[14]), "+v"(of[15]));
        asm volatile("" : "+v"(of[16]), "+v"(of[17]), "+v"(of[18]), "+v"(of[19]), "+v"(of[20]), "+v"(of[21]), "+v"(of[22]), "+v"(of[23]), "+v"(of[24]), "+v"(of[25]), "+v"(of[26]), "+v"(of[27]), "+v"(of[28]), "+v"(of[29]), "+v"(of[30]), "+v"(of[31])); }
#pragma unroll
    for (int q = 0; q < 8; ++q) *(LAS f32x4*)(red + es * 256 + ck * 32 + 4 * q) = (f32x4){of[4 * q], of[4 * q + 1], of[4 * q + 2], of[4 * q + 3]};
    f32x4 s = *(const LAS f32x4*)(red + 4 * lane);
#pragma unroll
    for (int r = 1; r < 8; ++r) s = s + *(const LAS f32x4*)(red + r * 256 + 4 * lane);
    f32x4* o4 = (f32x4*)(p.out + (size_t)t * D + 256 * xv + 4 * lane);
    *o4 = *o4 + s;
}
template <bool USTEP>
__device__ __forceinline__ void peer_step(const Params& p, int lane, int wave, LAS float* red, int pos, int nx, int rank, int nloc) {
    for (int xv = pos; xv < 8; xv += nx) {
        const int wx = rank * 8 + wave, nwx = nloc * 8;
        const unsigned char* tab = p.ws + (USTEP ? WS_TABU : WS_TABV) + (size_t)xv * 16384 * 128;
        PeerTok A, B;
        int t = wx;
        if (t < T) peer_issue<USTEP>(A, p, tab, t, xv, lane);
#pragma unroll 1
        for (; t < T; t += 2 * nwx) {
            const bool hb = t + nwx < T;
            if (hb) peer_issue<USTEP>(B, p, tab, t + nwx, xv, lane);
            if (USTEP) peer_u_finish(A, p, t, xv, lane); else peer_v_finish(A, p, t, xv, lane, red);
            if (t + 2 * nwx < T) peer_issue<USTEP>(A, p, tab, t + 2 * nwx, xv, lane);
            if (hb) { if (USTEP) peer_u_finish(B, p, t + nwx, xv, lane); else peer_v_finish(B, p, t + nwx, xv, lane, red); }
        }
    }
}
typedef int v8i_p __attribute__((ext_vector_type(8))); typedef int v4i_t __attribute__((ext_vector_type(4)));
struct PeerTokU { u32x4 w[16]; u32x4 b[2][2]; };
__device__ __forceinline__ void peer_u_issue(PeerTokU& k, const Params& p, const unsigned char* tab, int t, int xv, int lane) {
    const int* RIDX = (const int*)(p.ws + WS_RIDX);
    const int i0 = RIDX[(size_t)t * 128 + lane], i1 = RIDX[(size_t)t * 128 + 64 + lane];
    const int es = lane >> 3, ck = lane & 7, q = lane >> 4;
    const unsigned char* xp = p.ws + WS_X2F8 + (size_t)t * D + 256 * xv + 16 * q;
#pragma unroll
    for (int kb = 0; kb < 2; ++kb) { k.b[kb][0] = *(const u32x4*)(xp + 128 * kb); k.b[kb][1] = *(const u32x4*)(xp + 128 * kb + 64); }
#pragma unroll
    for (int g = 0; g < 16; ++g) { const int e = __shfl(g < 8 ? i0 : i1, (8 * g + es) & 63); k.w[g] = *(const u32x4*)(tab + (size_t)e * 128 + ck * 16); }
}
__device__ __forceinline__ void peer_u_mfma(const PeerTokU& k, const Params& p, int t, int xv, int lane, LAS unsigned char* vl) {
    float* zp = (float*)(p.ws + WS_ZP) + ((size_t)xv * T + t) * 128;
    const int es = lane >> 3, ck = lane & 7, r16 = lane & 15, q = lane >> 4;
#pragma unroll
    for (int g = 0; g < 16; ++g) { const int row = 8 * g + es; *(LAS u32x4*)(vl + row * 128 + ((ck ^ (row & 7)) << 4)) = k.w[g]; }
    v8i_p b0, b1;
    { const v4i_t x0 = __builtin_bit_cast(v4i_t, k.b[0][0]), x1 = __builtin_bit_cast(v4i_t, k.b[0][1]), y0 = __builtin_bit_cast(v4i_t, k.b[1][0]), y1 = __builtin_bit_cast(v4i_t, k.b[1][1]);
      b0 = __builtin_shufflevector(x0, x1, 0, 1, 2, 3, 4, 5, 6, 7); b1 = __builtin_shufflevector(y0, y1, 0, 1, 2, 3, 4, 5, 6, 7); }
#pragma unroll
    for (int g = 0; g < 8; ++g) {
        const int row = 16 * g + r16;
        const v4i_t a0 = __builtin_bit_cast(v4i_t, *(const LAS u32x4*)(vl + row * 128 + ((q ^ (row & 7)) << 4)));
        const v4i_t a1 = __builtin_bit_cast(v4i_t, *(const LAS u32x4*)(vl + row * 128 + (((4 + q) ^ (row & 7)) << 4)));
        const v8i_p A0 = {a0[0], a0[1], a0[2], a0[3], 0, 0, 0, 0}, A1 = {a1[0], a1[1], a1[2], a1[3], 0, 0, 0, 0};
        f32x4 acc = {0.f, 0.f, 0.f, 0.f};
        acc = __builtin_amdgcn_mfma_scale_f32_16x16x128_f8f6f4(A0, b0, acc, 4, 0, 0, 0x7F7F7F7F, 0, 0x7F7F7F7F);
        acc = __builtin_amdgcn_mfma_scale_f32_16x16x128_f8f6f4(A1, b1, acc, 4, 0, 0, 0x7F7F7F7F, 0, 0x7F7F7F7F);
        if ((lane & 15) == 0) *(f32x4*)(zp + 16 * g + 4 * (lane >> 4)) = acc;
    }
}
__device__ __forceinline__ void peer_u_step(const Params& p, int lane, int wave, LAS unsigned char* vl, int pos, int nx, int rank, int nloc) {
    for (int xv = pos; xv < 8; xv += nx) {
        const int wx = rank * 8 + wave, nwx = nloc * 8;
        const unsigned char* tab = p.ws + WS_TABU + (size_t)xv * 16384 * 128;
        PeerTokU A, B;
        int t = wx;
        if (t < T) peer_u_issue(A, p, tab, t, xv, lane);
#pragma unroll 1
        for (; t < T; t += 2 * nwx) {
            const bool hb = t + nwx < T;
            if (hb) peer_u_issue(B, p, tab, t + nwx, xv, lane);
            peer_u_mfma(A, p, t, xv, lane, vl);
            if (t + 2 * nwx < T) peer_u_issue(A, p, tab, t + 2 * nwx, xv, lane);
            if (hb) peer_u_mfma(B, p, t + nwx, xv, lane, vl);
        }
    }
}
constexpr size_t WS_ACT8 = 34 * MiB, WS_ASC = 36 * MiB;
__device__ __forceinline__ void peer_combine(const Params& p, int t, int lane) {
    const float* ZP = (const float*)(p.ws + WS_ZP); const int* RIDX = (const int*)(p.ws + WS_RIDX); const float* RG = (const float*)(p.ws + WS_RG);
    const float* SCU = (const float*)(p.ws + WS_SCU); const float* SCV = (const float*)(p.ws + WS_SCV); const float* SS2 = (const float*)(p.ws + WS_CTL + CTL_SS2_BYTE);
    const float rs = rsqrtf(SS2[t] * (1.f / D) + EPS);
    float act[2];
#pragma unroll
    for (int hlf = 0; hlf < 2; ++hlf) { const size_t o = (size_t)t * 128 + 64 * hlf + lane; float z = 0.f;
#pragma unroll
        for (int x = 0; x < 8; ++x) z += ZP[((size_t)x * T) * 128 + o];
        const int e = RIDX[o];
        act[hlf] = gelu_tanh(z * rs * SCU[e]) * RG[o] * SCV[e]; }
    float mx = fmaxf(fabsf(act[0]), fabsf(act[1]));
#pragma unroll
    for (int o = 1; o < 64; o <<= 1) mx = fmaxf(mx, __shfl_xor(mx, o));
    const float sc = mx > 0.f ? mx * (1.f / 448.f) : 1.f, inv = 1.f / sc;
    unsigned char* a8 = p.ws + WS_ACT8 + (size_t)t * 128;
    a8[lane] = (unsigned char)(__builtin_amdgcn_cvt_pk_fp8_f32(act[0] * inv, 0.f, 0, false) & 0xff);
    a8[64 + lane] = (unsigned char)(__builtin_amdgcn_cvt_pk_fp8_f32(act[1] * inv, 0.f, 0, false) & 0xff);
    if (lane == 0) ((float*)(p.ws + WS_ASC))[t] = sc;
}
typedef int v2i_t __attribute__((ext_vector_type(2)));
struct PeerTokV { u32x4 w[16]; u32x4 b[2]; };
__device__ __forceinline__ void peer_v_issue(PeerTokV& k, const Params& p, const unsigned char* tab, int t, int lane) {
    const int* RIDX = (const int*)(p.ws + WS_RIDX);
    const int i0 = RIDX[(size_t)t * 128 + lane], i1 = RIDX[(size_t)t * 128 + 64 + lane];
    const int es = lane >> 3, ck = lane & 7, q = lane >> 4;
    const unsigned char* ap = p.ws + WS_ACT8 + (size_t)t * 128 + 16 * q;
    k.b[0] = *(const u32x4*)ap; k.b[1] = *(const u32x4*)(ap + 64);
#pragma unroll
    for (int g = 0; g < 16; ++g) { const int e = __shfl(g < 8 ? i0 : i1, (8 * g + es) & 63); k.w[g] = *(const u32x4*)(tab + (size_t)e * 128 + ck * 16); }
}
__device__ __forceinline__ void peer_v_mfma(const PeerTokV& k, const Params& p, int t, int xv, int lane, LAS unsigned char* vl) {
    const int es = lane >> 3, ck = lane & 7, n = lane & 15, q = lane >> 4;
#pragma unroll
    for (int g = 0; g < 16; ++g) { const int row = 8 * g + es; *(LAS u32x4*)(vl + row * 128 + ((ck ^ (row & 7)) << 4)) = k.w[g]; }
    const v4i_t x0 = __builtin_bit_cast(v4i_t, k.b[0]), x1 = __builtin_bit_cast(v4i_t, k.b[1]);
    const v8i_p bop = __builtin_shufflevector(x0, x1, 0, 1, 2, 3, 4, 5, 6, 7);
    const int r1 = 32 * q + n, r2 = r1 + 16;
    f32x4 keep = {0.f, 0.f, 0.f, 0.f};
#pragma unroll
    for (int mb = 0; mb < 16; ++mb) {
        const v2i_t t1 = __builtin_amdgcn_ds_read_tr4_b64_v2i32((LAS v2i_t*)(vl + r1 * 128 + ((((mb >> 1) ^ (r1 & 7)) << 4) | ((mb & 1) << 3))));
        const v2i_t t2 = __builtin_amdgcn_ds_read_tr4_b64_v2i32((LAS v2i_t*)(vl + r2 * 128 + ((((mb >> 1) ^ (r2 & 7)) << 4) | ((mb & 1) << 3))));
        const v8i_p aop = {t1[0], t1[1], t2[0], t2[1], 0, 0, 0, 0};
        f32x4 acc = {0.f, 0.f, 0.f, 0.f};
        acc = __builtin_amdgcn_mfma_scale_f32_16x16x128_f8f6f4(aop, bop, acc, 4, 0, 0, 0x7F7F7F7F, 0, 0x7F7F7F7F);
        if (n == mb) keep = acc;
    }
    const float sc = ((const float*)(p.ws + WS_ASC))[t];
    const size_t oo = (size_t)t * D + 256 * xv + 16 * n + 4 * q;
    const u32x2 xw = *(const u32x2*)((const bf16_t*)(p.ws + WS_X2BF) + oo);
    const f32x4 x2v = {__uint_as_float(xw.x << 16), __uint_as_float(xw.x & 0xffff0000u), __uint_as_float(xw.y << 16), __uint_as_float(xw.y & 0xffff0000u)};
    *(f32x4*)(p.out + oo) = x2v + keep * sc;
}
__device__ __forceinline__ void peer_v_step(const Params& p, int lane, int wave, LAS unsigned char* vl, int pos, int nx, int rank, int nloc) {
    for (int xv = pos; xv < 8; xv += nx) {
        const int wx = rank * 8 + wave, nwx = nloc * 8;
        const unsigned char* tab = p.ws + WS_TABV + (size_t)xv * 16384 * 128;
        PeerTokV A, B;
        int t = wx;
        if (t < T) peer_v_issue(A, p, tab, t, lane);
#pragma unroll 1
        for (; t < T; t += 2 * nwx) {
            const bool hb = t + nwx < T;
            if (hb) peer_v_issue(B, p, tab, t + nwx, lane);
            peer_v_mfma(A, p, t, xv, lane, vl);
            if (t + 2 * nwx < T) peer_v_issue(A, p, tab, t + 2 * nwx, lane);
            if (hb) peer_v_mfma(B, p, t + nwx, xv, lane, vl);
        }
    }
}

namespace pg8 {
#define PG8_LAS __attribute__((address_space(3)))
constexpr int BM = 256, BK = 64, HALF = 128, HTB = HALF * BK * 2, STAGE_BYTES = 8 * HTB, NXCD = 8, WGM = 1;
__host__ __device__ __forceinline__ int lds_byte(int r, int c) { const int st = (r >> 4) * 2 + (c >> 5), rr = r & 15, cc = c & 31, ob = rr * 64 + cc * 2; return st * 1024 + (ob ^ (((ob >> 9) & 1) << 5)); }
__host__ __device__ __forceinline__ void stage_rc(int b, int& R, int& C) { const int st = b / 1024, sb = b % 1024, swz = sb ^ (((sb >> 9) & 1) << 5); R = (st >> 1) * 16 + swz / 64; C = (st & 1) * 32 + (swz % 64) / 2; }
__host__ __device__ __forceinline__ int perm32(int rho) { const int n = rho >> 4, i = rho & 15; return 8 * (i >> 2) + 4 * n + (i & 3); }
struct Unit { const char* A; const char* B; int pm, pn, kind, nt; };
__device__ __forceinline__ const char* uni_ptr(const char* p) { const unsigned long long v = (unsigned long long)p; const unsigned lo = __builtin_amdgcn_readfirstlane((unsigned)v), hi = __builtin_amdgcn_readfirstlane((unsigned)(v >> 32)); return (const char*)(((unsigned long long)hi << 32) | lo); }
__device__ __forceinline__ void uni(Unit& u) { u.A = uni_ptr(u.A); u.B = uni_ptr(u.B); u.pm = __builtin_amdgcn_readfirstlane(u.pm); u.pn = __builtin_amdgcn_readfirstlane(u.pn); u.kind = __builtin_amdgcn_readfirstlane(u.kind); u.nt = __builtin_amdgcn_readfirstlane(u.nt); }
template <int WG = WGM>
__device__ __forceinline__ void tile_of(int L, int nM, int nN, int& pm, int& pn) {
    const int nwg = nM * nN; int wgid = L; { const int q = nwg / NXCD, r = nwg % NXCD, xcd = wgid % NXCD, off = wgid / NXCD; wgid = (xcd < r ? xcd * (q + 1) : r * (q + 1) + (xcd - r) * q) + off; }
    const int nig = WG * nN, gid = wgid / nig, fm = gid * WG, gsz = (nM - fm) < WG ? (nM - fm) : WG;
    pm = fm + ((wgid % nig) % gsz); pn = (wgid % nig) / gsz;
}
typedef int v8i_t __attribute__((ext_vector_type(8))); typedef int v4i_t __attribute__((ext_vector_type(4)));
__device__ __forceinline__ v8i_t cat8(const bf16x8 lo, const bf16x8 hi) { const v4i_t a = __builtin_bit_cast(v4i_t, lo), b = __builtin_bit_cast(v4i_t, hi); return __builtin_shufflevector(a, b, 0, 1, 2, 3, 4, 5, 6, 7); }
template <bool FP8, class Epi, class Sched>
__device__ __forceinline__ void gemm_phase(PG8_LAS unsigned char* lds, const int lda, const int ldb, const Sched& S, const Epi& E) {
    const int tid = threadIdx.x, wid = __builtin_amdgcn_readfirstlane(tid >> 6), lane = tid & 63, wr = wid >> 2, wc = wid & 3, fr = lane & 15, fq = lane >> 4;
    unsigned voffA[2], voffB[2];
#pragma unroll
    for (int i = 0; i < 2; ++i) { int R, C; stage_rc(tid * 16 + i * 8192, R, C); const int Rb = (R & ~31) + perm32(R & 31);
        voffA[i] = (unsigned)(R * lda + C) * 2u; voffB[i] = (unsigned)(Rb * ldb + C) * 2u; }
    const size_t kstep = (size_t)(BK * 2);
    const size_t hstepA = (size_t)HALF * lda * 2, hstepB = (size_t)HALF * ldb * 2;
    const unsigned ldsw = (unsigned)wid * 1024u;
    const int aoff = lds_byte(wr * 64 + fr, fq * 8), boff = lds_byte(wc * 32 + fr, fq * 8);
#define PG8_SA(b, h) (((b) * 2 + (h)) * HTB)
#define PG8_SB(b, h) ((4 + (b) * 2 + (h)) * HTB)
#define PG8_STAGE(bufoff, gbase, voff) do { _Pragma("unroll") for (int _i = 0; _i < 2; ++_i) \
        __builtin_amdgcn_global_load_lds((const unsigned*)((const char*)(gbase) + (voff)[_i]), (PG8_LAS unsigned*)(lds + (bufoff) + ldsw + _i * 8192), 16, 0, 0); } while (0)
#define PG8_LDA(dst, b, h) do { _Pragma("unroll") for (int m = 0; m < 4; ++m) { if constexpr (FP8) dst##8[m] = cat8(*(const PG8_LAS bf16x8*)(lds + PG8_SA(b, h) + aoff + m * 2048), *(const PG8_LAS bf16x8*)(lds + PG8_SA(b, h) + aoff + m * 2048 + 1024)); \
        else { _Pragma("unroll") for (int k = 0; k < 2; ++k) dst[m][k] = *(const PG8_LAS bf16x8*)(lds + PG8_SA(b, h) + aoff + m * 2048 + k * 1024); } } } while (0)
#define PG8_LDB(dst, b, h) do { _Pragma("unroll") for (int n = 0; n < 2; ++n) { if constexpr (FP8) dst##8[n] = cat8(*(const PG8_LAS bf16x8*)(lds + PG8_SB(b, h) + boff + n * 2048), *(const PG8_LAS bf16x8*)(lds + PG8_SB(b, h) + boff + n * 2048 + 1024)); \
        else { _Pragma("unroll") for (int k = 0; k < 2; ++k) dst[n][k] = *(const PG8_LAS bf16x8*)(lds + PG8_SB(b, h) + boff + n * 2048 + k * 1024); } } } while (0)
#define PG8_MMA(ai, bj, At, Bt) do { __builtin_amdgcn_s_setprio(1); \
        if constexpr (FP8) { _Pragma("unroll") for (int m = 0; m < 4; ++m) _Pragma("unroll") for (int n = 0; n < 2; ++n) \
            asm volatile("v_mfma_scale_f32_16x16x128_f8f6f4 %0, %1, %2, %0, %3, %3 op_sel_hi:[0,0,0]" : "+v"(acc[ai][bj][m][n]) : "v"(Bt##8[n]), "v"(At##8[m]), "v"(mxone)); } \
        else { _Pragma("unroll") for (int m = 0; m < 4; ++m) _Pragma("unroll") for (int n = 0; n < 2; ++n) _Pragma("unroll") for (int k = 0; k < 2; ++k) \
            acc[ai][bj][m][n] = __builtin_amdgcn_mfma_f32_16x16x32_bf16(Bt[n][k], At[m][k], acc[ai][bj][m][n], 0, 0, 0); } \
        __builtin_amdgcn_s_setprio(0); } while (0)
#define PG8_WAIT_V(n) asm volatile("s_waitcnt vmcnt(" #n ")" ::: "memory")
#define PG8_WAIT_L(n) asm volatile("s_waitcnt lgkmcnt(" #n ")" ::: "memory")
#define PG8_BAR __builtin_amdgcn_s_barrier()
#define PG8_SCHED __builtin_amdgcn_sched_barrier(0)
    Unit cur, nxt; int ui = 0;
    if (!S.next(0, cur)) return;
    f32x4 acc[2][2][4][2];
#pragma unroll
    for (int a = 0; a < 2; ++a)
#pragma unroll
        for (int b = 0; b < 2; ++b)
#pragma unroll
            for (int m = 0; m < 4; ++m)
#pragma unroll
                for (int n = 0; n < 2; ++n) acc[a][b][m][n] = (f32x4){0.f, 0.f, 0.f, 0.f};
    const int mxone = 0x7F7F7F7F;
    bf16x8 At[4][2], B0[2][2], B1[2][2]; v8i_t At8[4], B08[2], B18[2];
    const char* cA = cur.A; const char* cB = cur.B;
    PG8_STAGE(PG8_SB(0, 0), cB, voffB); PG8_STAGE(PG8_SB(0, 1), cB + hstepB, voffB); PG8_STAGE(PG8_SA(0, 0), cA, voffA); PG8_STAGE(PG8_SA(0, 1), cA + hstepA, voffA);
    if (wr == 1) PG8_BAR;
    PG8_WAIT_V(2); PG8_BAR;
    PG8_STAGE(PG8_SB(1, 0), cB + kstep, voffB); PG8_STAGE(PG8_SA(1, 0), cA + kstep, voffA); PG8_STAGE(PG8_SB(1, 1), cB + hstepB + kstep, voffB);
    PG8_WAIT_V(6); PG8_BAR;
    for (;;) {
        const bool has_next = S.next(ui + 1, nxt);
        const char* nA = has_next ? nxt.A : cA; const char* nB = has_next ? nxt.B : cB;
        const int nt = cur.nt;
        for (int t = 0; t < nt; t += 2) {
            const bool last = (t == nt - 2);
            const char* a1 = cA + (size_t)(t + 1) * kstep;
            const char* a2 = last ? nA : cA + (size_t)(t + 2) * kstep; const char* b2 = last ? nB : cB + (size_t)(t + 2) * kstep;
            const char* a3 = a2 + kstep; const char* b3 = b2 + kstep;
            PG8_LDB(B0, 0, 0); PG8_LDB(B1, 0, 1); PG8_SCHED; PG8_LDA(At, 0, 0); PG8_STAGE(PG8_SA(1, 1), a1 + hstepA, voffA);
            PG8_WAIT_V(8); PG8_WAIT_L(0); PG8_BAR; PG8_MMA(0, 0, At, B0); PG8_MMA(0, 1, At, B1); PG8_BAR; PG8_SCHED;
            PG8_LDA(At, 0, 1); PG8_STAGE(PG8_SB(0, 0), b2, voffB); PG8_STAGE(PG8_SB(0, 1), b2 + hstepB, voffB); PG8_STAGE(PG8_SA(0, 0), a2, voffA);
            PG8_WAIT_V(8); PG8_WAIT_L(0); PG8_BAR; PG8_MMA(1, 0, At, B0); PG8_MMA(1, 1, At, B1); PG8_BAR; PG8_SCHED;
            PG8_LDB(B0, 1, 0); PG8_LDB(B1, 1, 1); PG8_SCHED; PG8_LDA(At, 1, 0); PG8_STAGE(PG8_SA(0, 1), a2 + hstepA, voffA);
            PG8_WAIT_V(8); PG8_WAIT_L(0); PG8_BAR; PG8_MMA(0, 0, At, B0); PG8_MMA(0, 1, At, B1); PG8_BAR; PG8_SCHED;
            PG8_LDA(At, 1, 1); PG8_STAGE(PG8_SB(1, 0), b3, voffB); PG8_STAGE(PG8_SB(1, 1), b3 + hstepB, voffB); PG8_STAGE(PG8_SA(1, 0), a3, voffA);
            PG8_WAIT_V(8); PG8_WAIT_L(0); PG8_BAR; PG8_MMA(1, 0, At, B0); PG8_MMA(1, 1, At, B1); PG8_BAR; PG8_SCHED;
        }
        if (wr == 0) PG8_BAR;
        if constexpr (FP8) asm volatile("s_nop 15\n\ts_nop 15" ::: "memory");
        E(acc, cur, wr, wc, fr, fq);
        if (!has_next) break;
        if (E.reset(cur)) {
#pragma unroll
        for (int a = 0; a < 2; ++a)
#pragma unroll
            for (int b = 0; b < 2; ++b)
#pragma unroll
                for (int m = 0; m < 4; ++m)
#pragma unroll
                    for (int n = 0; n < 2; ++n) acc[a][b][m][n] = (f32x4){0.f, 0.f, 0.f, 0.f};
        }
        cur = nxt; cA = nA; cB = nB; ++ui;
        if (wr == 1) PG8_BAR;
    }
    PG8_WAIT_V(0);
    PG8_BAR;
#undef PG8_SA
#undef PG8_SB
#undef PG8_STAGE
#undef PG8_LDA
#undef PG8_LDB
#undef PG8_MMA
#undef PG8_WAIT_V
#undef PG8_WAIT_L
#undef PG8_BAR
#undef PG8_SCHED
}
}
typedef f32x4 AccT[2][2][4][2];
#define EPI_RESET_ALWAYS __device__ __forceinline__ bool reset(const pg8::Unit&) const { return true; }
__device__ __forceinline__ unsigned cvt_pk_bf16(float lo, float hi) { unsigned r; asm volatile("v_cvt_pk_bf16_f32 %0, %1, %2" : "=v"(r) : "v"(lo), "v"(hi)); return r; }
__device__ __forceinline__ u32x4 pack8(const f32x4 v0, const f32x4 v1) { u32x4 w; w.x = cvt_pk_bf16(v0[0], v0[1]); w.y = cvt_pk_bf16(v0[2], v0[3]); w.z = cvt_pk_bf16(v1[0], v1[1]); w.w = cvt_pk_bf16(v1[2], v1[3]); return w; }
template <int MODE>
__device__ __forceinline__ void store_tile_bf16(const AccT& acc, bf16_t* base, int ldc, int row0, int col0, const float* bias, const float ascale = 1.f) {
#pragma unroll
    for (int ai = 0; ai < 2; ++ai)
#pragma unroll
        for (int m = 0; m < 4; ++m) { bf16_t* rowp = base + (size_t)(row0 + ai * 128 + m * 16) * ldc + col0;
#pragma unroll
            for (int bj = 0; bj < 2; ++bj) { f32x4 v0 = acc[ai][bj][m][0], v1 = acc[ai][bj][m][1];
                if (MODE == 1) { _Pragma("unroll") for (int e = 0; e < 4; ++e) { v0[e] = gelu_tanh(v0[e]); v1[e] = gelu_tanh(v1[e]); } }
                if (MODE == 2) { const f32x4 b0 = *(const f32x4*)(bias + col0 + bj * 128), b1 = *(const f32x4*)(bias + col0 + bj * 128 + 4);
                    v0 = v0 * ascale + b0; v1 = v1 * ascale + b1; _Pragma("unroll") for (int e = 0; e < 4; ++e) { v0[e] = sigmoid_(v0[e]); v1[e] = sigmoid_(v1[e]); } }
                *(u32x4*)(rowp + bj * 128) = pack8(v0, v1); }
            if (MODE == 2) asm volatile("" ::: "memory"); }
}
struct SchedP1a { const char* H; const char* WT; const char* MEMN; const char* WTM; int G, c;
    __device__ __forceinline__ bool next(int i, pg8::Unit& u) const {
        const int L = i * G + c; const int n1 = 64 * 18;
        if (L < n1) { pg8::tile_of(L, 64, 18, u.pm, u.pn); u.kind = 0; u.A = H + (size_t)u.pm * 256 * D * 2; u.B = WT + (size_t)u.pn * 256 * D * 2; u.nt = D / 64; pg8::uni(u); return true; }
        if (L < n1 + 8) { const int j = L - n1; u.pm = j >> 2; u.pn = j & 3; u.kind = 1; u.A = MEMN + (size_t)u.pm * 256 * D * 2; u.B = WTM + (size_t)u.pn * 256 * D * 2; u.nt = D / 64; pg8::uni(u); return true; }
        return false; } };
struct EpiP1a { bf16_t* PROJ; bf16_t* MEMKV; EPI_RESET_ALWAYS
    __device__ __forceinline__ void operator()(AccT& acc, const pg8::Unit& u, int wr, int wc, int fr, int fq) const {
        const int row0 = u.pm * 256 + wr * 64 + fr, cl = wc * 32 + 8 * fq;
        if (u.kind == 1) { store_tile_bf16<0>(acc, MEMKV, 2 * CW, row0, u.pn * 256 + cl, nullptr); return; }
        if (u.pn == 14 || u.pn == 15) { store_tile_bf16<1>(acc, PROJ, INW, row0, u.pn * 256 + cl, nullptr); return; }
        store_tile_bf16<0>(acc, PROJ, INW, row0, u.pn * 256 + cl, nullptr);
    } };
struct SchedP1b { const char* H8; const char* WT8; int G, c;
    __device__ __forceinline__ bool next(int i, pg8::Unit& u) const {
        const int L = i * G + c; if (L >= 64 * 24) return false;
        pg8::tile_of(L, 64, 24, u.pm, u.pn); u.kind = 0; u.A = H8 + (size_t)u.pm * 256 * D; u.B = WT8 + (size_t)u.pn * 256 * D; u.nt = D / 128; pg8::uni(u); return true; } };
struct EpiP1b { bf16_t* G; const float* bgate; EPI_RESET_ALWAYS
    __device__ __forceinline__ void operator()(AccT& acc, const pg8::Unit& u, int wr, int wc, int fr, int fq) const {
        store_tile_bf16<2>(acc, G, GW, u.pm * 256 + wr * 64 + fr, u.pn * 256 + wc * 32 + 8 * fq, bgate, 1.f / GATE_WSCALE);
    } };
struct SchedP3 { const char* O; const char* WT; int G, c;
    __device__ __forceinline__ bool next(int i, pg8::Unit& u) const {
        const int ti = i / 3, seg = i - 3 * ti; const int L = ti * G + c; if (L >= 64 * 8) return false;
        pg8::tile_of(L, 64, 8, u.pm, u.pn); u.kind = seg;
        const int kb = seg == 0 ? 0 : (seg == 1 ? 1024 : 1536);
        u.A = O + ((size_t)u.pm * 256 * D + kb) * 2; u.B = WT + ((size_t)u.pn * 256 * D + kb) * 2; u.nt = seg == 0 ? 16 : 8; pg8::uni(u); return true; } };
struct EpiP3 { const bf16_t* G; bf16_t* MERGED;
    __device__ __forceinline__ bool reset(const pg8::Unit& u) const { return u.kind == 2; }
    __device__ __forceinline__ void operator()(AccT& acc, const pg8::Unit& u, int wr, int wc, int fr, int fq) const {
        const int row0 = u.pm * 256 + wr * 64 + fr, col0 = u.pn * 256 + wc * 32 + 8 * fq, seg = u.kind;
#pragma unroll
        for (int ai = 0; ai < 2; ++ai)
#pragma unroll
            for (int mh = 0; mh < 2; ++mh) {
                u32x4 ga[2][2], gb[2][2];
#pragma unroll
                for (int mm = 0; mm < 2; ++mm)
#pragma unroll
                    for (int bj = 0; bj < 2; ++bj) { const bf16_t* gp = G + (size_t)(row0 + ai * 128 + (mh * 2 + mm) * 16) * GW + col0 + bj * 128;
                        ga[mm][bj] = *(const u32x4*)(gp + seg * D); gb[mm][bj] = (seg < 2) ? *(const u32x4*)(gp + (seg + 1) * D) : (u32x4){0u, 0u, 0u, 0u}; }
#pragma unroll
                for (int mm = 0; mm < 2; ++mm)
#pragma unroll
                    for (int bj = 0; bj < 2; ++bj) { const int m = mh * 2 + mm;
                        float fa[8], fb[8]; unpack8(ga[mm][bj], fa); unpack8(gb[mm][bj], fb);
                        if (seg < 2) { _Pragma("unroll") for (int e = 0; e < 8; ++e) fa[e] = fa[e] * __builtin_amdgcn_rcpf(fmaxf(fb[e], 1e-20f)); }
                        f32x4& v0 = acc[ai][bj][m][0]; f32x4& v1 = acc[ai][bj][m][1];
                        v0[0] *= fa[0]; v0[1] *= fa[1]; v0[2] *= fa[2]; v0[3] *= fa[3]; v1[0] *= fa[4]; v1[1] *= fa[5]; v1[2] *= fa[6]; v1[3] *= fa[7];
                        if (seg == 2) *(u32x4*)(MERGED + (size_t)(row0 + ai * 128 + m * 16) * D + col0 + bj * 128) = pack8(v0, v1);
                    }
                asm volatile("" ::: "memory");
            }
    } };
struct SchedSq { const char* A; const char* WT; int G, c;
    __device__ __forceinline__ bool next(int i, pg8::Unit& u) const {
        const int L = i * G + c; if (L >= 64 * 8) return false;
        pg8::tile_of(L, 64, 8, u.pm, u.pn); u.kind = 0; u.A = A + (size_t)u.pm * 256 * D * 2; u.B = WT + (size_t)u.pn * 256 * D * 2; u.nt = D / 64; pg8::uni(u); return true; } };
struct EpiP4 { const float* x; float* out; bf16_t* xb; float* ss; unsigned char* x8; EPI_RESET_ALWAYS
    __device__ __forceinline__ void operator()(AccT& acc, const pg8::Unit& u, int wr, int wc, int fr, int fq) const {
        const int row0 = u.pm * 256 + wr * 64 + fr, col0 = u.pn * 256 + wc * 32 + 8 * fq;
#pragma unroll
        for (int ai = 0; ai < 2; ++ai)
#pragma unroll
            for (int m = 0; m < 4; ++m) { const size_t row = (size_t)(row0 + ai * 128 + m * 16); float sq = 0.f;
#pragma unroll
                for (int bj = 0; bj < 2; ++bj) { const size_t o = row * D + col0 + bj * 128;
                    const f32x4 v0 = acc[ai][bj][m][0] + *(const f32x4*)(x + o), v1 = acc[ai][bj][m][1] + *(const f32x4*)(x + o + 4);
                    *(u32x4*)(xb + o) = pack8(v0, v1);
#define F8X(x_) fminf(fmaxf((x_), -448.f), 448.f)
                    { int w0 = __builtin_amdgcn_cvt_pk_fp8_f32(F8X(v0[0]), F8X(v0[1]), 0, false); w0 = __builtin_amdgcn_cvt_pk_fp8_f32(F8X(v0[2]), F8X(v0[3]), w0, true);
                      int w1 = __builtin_amdgcn_cvt_pk_fp8_f32(F8X(v1[0]), F8X(v1[1]), 0, false); w1 = __builtin_amdgcn_cvt_pk_fp8_f32(F8X(v1[2]), F8X(v1[3]), w1, true);
                      *(u32x2*)(x8 + o) = (u32x2){(unsigned)w0, (unsigned)w1}; }
                    sq += (v0[0] * v0[0] + v0[1] * v0[1]) + (v0[2] * v0[2] + v0[3] * v0[3]) + (v1[0] * v1[0] + v1[1] * v1[1]) + (v1[2] * v1[2] + v1[3] * v1[3]); }
                sq += __shfl_xor(sq, 16); sq += __shfl_xor(sq, 32);
                if (fq == 0) atomicAdd(ss + row, sq); }
    } };
struct EpiP5 { bf16_t* Q; const float* ss; EPI_RESET_ALWAYS
    __device__ __forceinline__ void operator()(AccT& acc, const pg8::Unit& u, int wr, int wc, int fr, int fq) const {
        const int row0 = u.pm * 256 + wr * 64 + fr, col0 = u.pn * 256 + wc * 32 + 8 * fq;
#pragma unroll
        for (int ai = 0; ai < 2; ++ai)
#pragma unroll
            for (int m = 0; m < 4; ++m) { const size_t row = (size_t)(row0 + ai * 128 + m * 16); const float rs = rsqrtf(ss[row] * (1.f / D) + EPS);
#pragma unroll
                for (int bj = 0; bj < 2; ++bj) *(u32x4*)(Q + row * D + col0 + bj * 128) = pack8(acc[ai][bj][m][0] * rs, acc[ai][bj][m][1] * rs); }
    } };


namespace att {
using s16x4  = __attribute__((ext_vector_type(4))) short;
using f32x16 = __attribute__((ext_vector_type(16))) float;
constexpr int NWV = 8, QBLK = 32, KVBLK = 64, DH = 128;
constexpr float THR = 8.f;
constexpr int SHM_V = KVBLK * DH * 2, SHM_K = KVBLK * DH * 2;
constexpr int OFF_WS = 2 * SHM_V + 2 * SHM_K, OFF_BT = OFF_WS + NWV * 64 * 4, OFF_OST = OFF_BT + 1536, LDS_NEED = OFF_OST + NWV * 8192;
#define KSWZ(row, colB) ((row) * 256 + ((colB) ^ (((row) & 7) << 4)))
#define SBAR() __builtin_amdgcn_sched_barrier(0)
__device__ __forceinline__ int crow(int r, int hi) { return (r & 3) + 8 * (r >> 2) + 4 * hi; }
__device__ __forceinline__ unsigned cvtpk(float lo, float hi) { unsigned r; asm volatile("v_cvt_pk_bf16_f32 %0, %1, %2" : "=v"(r) : "v"(lo), "v"(hi)); return r; }
__device__ __forceinline__ void partialSM(f32x16& p0, f32x16& p1, float& m_reg, float& mn, float& alpha) {
  constexpr float C = 1.4426950408889634f;
  float pmax = p0[0];
#pragma unroll
  for (int r = 1; r < 16; ++r) pmax = fmaxf(pmax, p0[r]);
#pragma unroll
  for (int r = 0; r < 16; ++r) pmax = fmaxf(pmax, p1[r]);
  { auto rr = __builtin_amdgcn_permlane32_swap(__float_as_uint(pmax), __float_as_uint(pmax), false, false);
    pmax = fmaxf(__uint_as_float(rr[0]), __uint_as_float(rr[1])); }
  if (__builtin_expect(__all(pmax - m_reg <= THR), 1)) { mn = m_reg; alpha = 1.f; }
  else { mn = fmaxf(m_reg, pmax); alpha = __builtin_amdgcn_exp2f((m_reg - mn) * C); m_reg = mn; }
  float mnC = -mn * C;
#pragma unroll
  for (int r = 0; r < 16; ++r) p0[r] = fmaf(p0[r], C, mnC);
#pragma unroll
  for (int r = 0; r < 16; ++r) p1[r] = fmaf(p1[r], C, mnC);
#pragma unroll
  for (int r = 0; r < 16; ++r) p0[r] = __builtin_amdgcn_exp2f(p0[r]);
}
__device__ __forceinline__ void finishSM(f32x16& p0, f32x16& p1, float alpha, float& l_reg, bf16x8& pa0, bf16x8& pa1, bf16x8& pa2, bf16x8& pa3) {
#pragma unroll
  for (int r = 0; r < 16; ++r) p1[r] = __builtin_amdgcn_exp2f(p1[r]);
  float ps = 0;
#pragma unroll
  for (int r = 0; r < 16; ++r) ps += p0[r];
#pragma unroll
  for (int r = 0; r < 16; ++r) ps += p1[r];
  { auto rr = __builtin_amdgcn_permlane32_swap(__float_as_uint(ps), __float_as_uint(ps), false, false);
    ps = __uint_as_float(rr[0]) + __uint_as_float(rr[1]); }
  l_reg = l_reg * alpha + ps;
#define PK4(P, BASE, OUT) do { unsigned a0 = cvtpk(P[BASE + 0], P[BASE + 1]), a1 = cvtpk(P[BASE + 2], P[BASE + 3]);   \
    unsigned b0 = cvtpk(P[BASE + 4], P[BASE + 5]), b1 = cvtpk(P[BASE + 6], P[BASE + 7]);                              \
    auto r0 = __builtin_amdgcn_permlane32_swap(a0, b0, false, false); auto r1 = __builtin_amdgcn_permlane32_swap(a1, b1, false, false); \
    u32x4 w = {r0[0], r1[0], r0[1], r1[1]}; OUT = *reinterpret_cast<bf16x8*>(&w); } while (0)
  PK4(p0, 0, pa0); PK4(p0, 8, pa1); PK4(p1, 0, pa2); PK4(p1, 8, pa3);
#undef PK4
}
template <bool BIAS>
__device__ __forceinline__ void qkt(f32x16& p0, f32x16& p1, const LAS char* Ks, const LAS char* qs, int r32, int hi, const LAS float* bp) {
  if (BIAS) {
#pragma unroll
    for (int r = 0; r < 16; ++r) { p0[r] = bp[(r & 3) + 8 * (r >> 2)]; p1[r] = bp[32 + (r & 3) + 8 * (r >> 2)]; }
  } else { p0 = f32x16{}; p1 = f32x16{}; }
#pragma unroll
  for (int d0 = 0; d0 < 8; ++d0) { int cb = (d0 * 16 + hi * 8) * 2;
    bf16x8 b0 = *reinterpret_cast<const LAS bf16x8*>(Ks + KSWZ(r32, cb));
    bf16x8 b1 = *reinterpret_cast<const LAS bf16x8*>(Ks + KSWZ(32 + r32, cb));
    const bf16x8 qv = *reinterpret_cast<const LAS bf16x8*>(qs + d0 * 1024);
    p0 = __builtin_amdgcn_mfma_f32_32x32x16_bf16(b0, qv, p0, 0, 0, 0);
    p1 = __builtin_amdgcn_mfma_f32_32x32x16_bf16(b1, qv, p1, 0, 0, 0); }
}
__device__ __forceinline__ int v_st(int k, int c) { const int kk = (k & ~0xC) | ((k & 4) << 1) | ((k & 8) >> 1); return ((kk >> 3) * 4 + (c >> 5)) * 512 + ((kk & 7) * 32 + (c & 31)) * 2; }
__device__ __forceinline__ int v_rd_base(int lane) { return ((lane & 3) << 3) | (((lane >> 2) & 3) << 6) | (((lane >> 4) & 1) << 5) | (((lane >> 5) & 1) << 8); }
constexpr int v_rd_off(int d0, int ks, int half) { return d0 * 512 + ks * 4096 + half * 2048; }
template <int OFF> __device__ __forceinline__ s16x4 tr_read(int vb) {
  s16x4 r; asm volatile("ds_read_b64_tr_b16 %0, %1 offset:%2" : "=&v"(r) : "v"(vb), "i"(OFF) : "memory"); return r;
}
template <int D0> __device__ __forceinline__ void pv_one(f32x16& od, int vb, bf16x8 pa0, bf16x8 pa1, bf16x8 pa2, bf16x8 pa3) {
  const s16x4 l0 = tr_read<v_rd_off(D0, 0, 0)>(vb), h0 = tr_read<v_rd_off(D0, 0, 1)>(vb), l1 = tr_read<v_rd_off(D0, 1, 0)>(vb), h1 = tr_read<v_rd_off(D0, 1, 1)>(vb);
  const s16x4 l2 = tr_read<v_rd_off(D0, 2, 0)>(vb), h2 = tr_read<v_rd_off(D0, 2, 1)>(vb), l3 = tr_read<v_rd_off(D0, 3, 0)>(vb), h3 = tr_read<v_rd_off(D0, 3, 1)>(vb);
  asm volatile("s_waitcnt lgkmcnt(0)" ::: "memory"); SBAR();
#define PK(L, H) (bf16x8){L[0], L[1], L[2], L[3], H[0], H[1], H[2], H[3]}
  od = __builtin_amdgcn_mfma_f32_32x32x16_bf16(pa0, PK(l0, h0), od, 0, 0, 0);
  od = __builtin_amdgcn_mfma_f32_32x32x16_bf16(pa1, PK(l1, h1), od, 0, 0, 0);
  od = __builtin_amdgcn_mfma_f32_32x32x16_bf16(pa2, PK(l2, h2), od, 0, 0, 0);
  od = __builtin_amdgcn_mfma_f32_32x32x16_bf16(pa3, PK(l3, h3), od, 0, 0, 0);
#undef PK
}
__device__ __forceinline__ void pv_d0(f32x16* o, int vb, bf16x8 pa0, bf16x8 pa1, bf16x8 pa2, bf16x8 pa3) {
  pv_one<0>(o[0], vb, pa0, pa1, pa2, pa3); pv_one<1>(o[1], vb, pa0, pa1, pa2, pa3); pv_one<2>(o[2], vb, pa0, pa1, pa2, pa3); pv_one<3>(o[3], vb, pa0, pa1, pa2, pa3);
}
template <int LDQ, int LDK, int LDO, bool BAND>
__device__ __forceinline__ void attn_body(const bf16_t* Qb, const bf16_t* Kh, const bf16_t* Vh, bf16_t* Ob,
                                          const int NT, const int kc0, const float* btab_src, LAS char* lds) {
  const int tid = threadIdx.x, wid = __builtin_amdgcn_readfirstlane(tid >> 6), lane = tid & 63, r32 = lane & 31, hi = lane >> 5;
  LAS char* V_lds = lds; LAS char* K_lds = lds + 2 * SHM_V;
  LAS float* wsf = (LAS float*)(lds + OFF_WS) + wid * 64; LAS float* li_l = wsf; LAS float* al_l = wsf + 32;
  LAS float* btab = (LAS float*)(lds + OFF_BT);
  if (BAND) { if (tid < 384) btab[tid] = tid < 64 ? btab_src[256] : (tid < 256 ? btab_src[320 - tid] : -30000.f); }
  float m_reg = -10000.f, l_reg = 0; f32x16 o[4] = {};
  const bf16_t* Qw = Qb + (long)(wid * QBLK + r32) * LDQ + hi * 8;
  LAS char* qr = lds + OFF_OST + wid * 8192 + lane * 16;
#pragma unroll
  for (int d0 = 0; d0 < 8; ++d0) *reinterpret_cast<LAS bf16x8*>(qr + d0 * 1024) = *reinterpret_cast<const bf16x8*>(Qw + d0 * 16);
  const int sr = tid >> 4, sc = (tid & 15) * 8, vst0 = v_st(sr, sc), vst1 = v_st(32 + sr, sc);
  const int vb0 = (int)(unsigned)(uintptr_t)V_lds + v_rd_base(lane);
  struct { bf16x8 vs0, vs1, ks0, ks1; } sr_[1];
  const int pw = wid >> 1, qi = (wid & 1) * 32 + r32;
#define TROW(t) ((BAND ? (((kc0) + (t)) > 0 ? ((kc0) + (t)) : 0) : (t)) * KVBLK)
#define SLOAD(i, t) do { const long k0_ = TROW(t); sr_[i].vs0 = *reinterpret_cast<const bf16x8*>(&Vh[(k0_ + sr) * LDK + sc]); sr_[i].vs1 = *reinterpret_cast<const bf16x8*>(&Vh[(k0_ + 32 + sr) * LDK + sc]); \
    sr_[i].ks0 = *reinterpret_cast<const bf16x8*>(&Kh[(k0_ + sr) * LDK + sc]); sr_[i].ks1 = *reinterpret_cast<const bf16x8*>(&Kh[(k0_ + 32 + sr) * LDK + sc]); } while (0)
#define SWRITE(b, i) do { *(LAS bf16x8*)(V_lds + (b) * SHM_V + vst0) = sr_[i].vs0; *(LAS bf16x8*)(V_lds + (b) * SHM_V + vst1) = sr_[i].vs1; int kc_ = sc * 2; \
    *(LAS bf16x8*)(K_lds + (b) * SHM_K + KSWZ(sr, kc_)) = sr_[i].ks0; *(LAS bf16x8*)(K_lds + (b) * SHM_K + KSWZ(32 + sr, kc_)) = sr_[i].ks1; } while (0)
#define SWAIT() asm volatile("s_waitcnt vmcnt(0)" ::: "memory")
#define RESC(a) do { if (__any((a) < 1.f)) { if (hi == 0) al_l[r32] = (a); asm volatile("s_waitcnt lgkmcnt(0)" ::: "memory"); \
    _Pragma("unroll") for (int d = 0; d < 4; ++d) _Pragma("unroll") for (int r = 0; r < 16; ++r) o[d][r] *= al_l[crow(r, hi)]; } } while (0)
#define BPTR(t) ({ const int t_ = (t); const int dch = pw + 8 - t_; int kb_ = 192 - dch * 64 - qi + 4 * hi; kb_ = kb_ < 0 ? 0 : kb_; \
    if (dch < 0 || dch > 8 || (kc0) + t_ < 0) kb_ = 288; (const LAS float*)(btab + kb_); })
  f32x16 pA0, pA1, pB0, pB1; float mnA, mnB, alA, alB; bf16x8 pa0, pa1, pa2, pa3;
  constexpr int SE = 0, SO = 0;
  SLOAD(SE, 0); asm volatile("s_waitcnt vmcnt(0)" ::: "memory"); SWRITE(0, SE); __syncthreads();
  qkt<BAND>(pA0, pA1, K_lds, qr, r32, hi, BPTR(0)); partialSM(pA0, pA1, m_reg, mnA, alA);
  SLOAD(SO, 1);
  SWAIT(); SWRITE(1, SO); __syncthreads();
  for (int j = 1; j + 1 < NT; j += 2) {
    SBAR(); qkt<BAND>(pB0, pB1, K_lds + SHM_K, qr, r32, hi, BPTR(j));
    finishSM(pA0, pA1, alA, l_reg, pa0, pa1, pa2, pa3); SBAR();
    SLOAD(SO, j + 1); SBAR();
    pv_d0(o, vb0, pa0, pa1, pa2, pa3); partialSM(pB0, pB1, m_reg, mnB, alB);
    __syncthreads(); SWAIT(); SWRITE(0, SE);
    RESC(alB); __syncthreads();
    SBAR(); qkt<BAND>(pA0, pA1, K_lds, qr, r32, hi, BPTR(j + 1));
    finishSM(pB0, pB1, alB, l_reg, pa0, pa1, pa2, pa3); SBAR();
    SLOAD(SE, j + 2); SBAR();
    pv_d0(o, vb0 + SHM_V, pa0, pa1, pa2, pa3); partialSM(pA0, pA1, m_reg, mnA, alA);
    __syncthreads(); SWAIT(); SWRITE(1, SO);
    RESC(alA); __syncthreads();
  }
  SBAR(); qkt<BAND>(pB0, pB1, K_lds + SHM_K, qr, r32, hi, BPTR(NT - 1));
  finishSM(pA0, pA1, alA, l_reg, pa0, pa1, pa2, pa3); SBAR();
  pv_d0(o, vb0, pa0, pa1, pa2, pa3); partialSM(pB0, pB1, m_reg, mnB, alB);
  __syncthreads(); RESC(alB);
  finishSM(pB0, pB1, alB, l_reg, pa0, pa1, pa2, pa3); SBAR();
  pv_d0(o, vb0 + SHM_V, pa0, pa1, pa2, pa3);
  if (hi == 0) li_l[r32] = l_reg; asm volatile("s_waitcnt lgkmcnt(0)" ::: "memory");
  float rli[16];
#pragma unroll
  for (int r = 0; r < 16; ++r) rli[r] = __builtin_amdgcn_rcpf(li_l[crow(r, hi)]);
  { LAS bf16_t* stg = (LAS bf16_t*)(lds + OFF_OST + wid * 8192);
#pragma unroll
    for (int r = 0; r < 16; ++r) { const int orow = crow(r, hi);
#pragma unroll
      for (int d0 = 0; d0 < 4; ++d0) stg[orow * 128 + d0 * 32 + r32] = (bf16_t)f2bf(o[d0][r] * rli[r]); }
    asm volatile("s_waitcnt lgkmcnt(0)" ::: "memory");
    bf16_t* Ow = Ob + (long)(wid * QBLK) * LDO;
#pragma unroll
    for (int i = 0; i < 8; ++i) { const int row = i * 4 + (lane >> 4), ch = lane & 15; const u32x4 v = *(const LAS u32x4*)(stg + row * 128 + ch * 8); *(u32x4*)(Ow + (long)row * LDO + ch * 8) = v; } }
  __syncthreads();
#undef TROW
#undef SLOAD
#undef SWRITE
#undef SWAIT
#undef RESC
#undef BPTR
}
#undef KSWZ
#undef SBAR
}


namespace rt {
using f32x16 = __attribute__((ext_vector_type(16))) float;
#define RKSWZ(row, colB) ((row) * 256 + ((colB) ^ (((row) & 7) << 4)))
__device__ __forceinline__ int crow(int r, int hi) { return (r & 3) + 8 * (r >> 2) + 4 * hi; }
__device__ __forceinline__ void ce_desc(unsigned& a, unsigned& b) { const unsigned mx = a > b ? a : b, mn = a > b ? b : a; a = mx; b = mn; }
__device__ __forceinline__ void sort16_desc(unsigned (&v)[16]) {
#pragma unroll
  for (int k = 2; k <= 16; k <<= 1)
#pragma unroll
    for (int j = k >> 1; j > 0; j >>= 1)
#pragma unroll
      for (int i = 0; i < 16; ++i) { const int l = i ^ j; if (l > i) { if ((i & k) == 0) ce_desc(v[i], v[l]); else ce_desc(v[l], v[i]); } }
}
__device__ __forceinline__ void merge16_desc(unsigned (&a)[16], const unsigned (&b)[16]) {
#pragma unroll
  for (int i = 0; i < 16; ++i) a[i] = a[i] > b[15 - i] ? a[i] : b[15 - i];
#pragma unroll
  for (int j = 8; j > 0; j >>= 1)
#pragma unroll
    for (int i = 0; i < 16; ++i) { const int l = i ^ j; if (l > i) ce_desc(a[i], a[l]); }
}
__device__ __forceinline__ unsigned fkey(float f) { const unsigned u = __float_as_uint(f); return (u & 0x80000000u) ? ~u : (u | 0x80000000u); }
__device__ __forceinline__ float fkey_inv(unsigned k) { const unsigned u = (k & 0x80000000u) ? (k & 0x7fffffffu) : ~k; return __uint_as_float(u); }
__device__ __forceinline__ void top16_half(const f32x16 (&sc)[4], int hi, unsigned (&out)[16]) {
  unsigned g[16];
#pragma unroll
  for (int blk = 0; blk < 4; ++blk) {
#pragma unroll
    for (int r = 0; r < 16; ++r) g[r] = (fkey(sc[blk][r]) & 0xFFFFFF80u) | (unsigned)(32 * blk + (r & 3) + 8 * (r >> 2) + 4 * hi);
    sort16_desc(g);
    if (blk == 0) {
#pragma unroll
      for (int r = 0; r < 16; ++r) out[r] = g[r];
    } else merge16_desc(out, g);
  }
  unsigned pb[16];
#pragma unroll
  for (int r = 0; r < 16; ++r) { auto rr = __builtin_amdgcn_permlane32_swap(out[r], out[r], false, false); pb[r] = hi ? rr[0] : rr[1]; }
  merge16_desc(out, pb);
}
__device__ __forceinline__ void route_phase(const Params& p, LAS unsigned char* lds, int tid, int lane, int wave) {
  const bf16_t* Q = (const bf16_t*)(p.ws + WS_Q); const bf16_t* KB = (const bf16_t*)(p.ws + WS_KEYSB);
  int* RIDX = (int*)(p.ws + WS_RIDX); float* RG = (float*)(p.ws + WS_RG);
  const int h = blockIdx.x & 7, grp = blockIdx.x >> 3;
  const int r32 = lane & 31, hi = lane >> 5;
#pragma unroll
  for (int c = 0; c < 2; ++c)
#pragma unroll
    for (int rep = 0; rep < 4; ++rep) { const int row = rep * 32 + (tid >> 4), cb = (tid & 15) * 16;
      *(LAS u32x4*)(lds + c * 32768 + RKSWZ(row, cb)) = *(const u32x4*)((const char*)KB + ((size_t)(h * 2 + c) * 128 + row) * 256 + cb); }
  __syncthreads();
  for (int tb = grp * 8 + wave; tb < T / 32; tb += (int)(gridDim.x >> 3) * 8) {
    const int t = tb * 32 + r32;
    unsigned ka[16], kb2[16];
#pragma unroll
    for (int c = 0; c < 2; ++c) {
      bf16x8 qf[8];
      const bf16_t* qp = Q + (size_t)t * D + h * 256 + c * 128 + hi * 8;
#pragma unroll
      for (int ks = 0; ks < 8; ++ks) qf[ks] = *(const bf16x8*)(qp + ks * 16);
      f32x16 sc[4];
#pragma unroll
      for (int blk = 0; blk < 4; ++blk) { sc[blk] = f32x16{};
#pragma unroll
        for (int ks = 0; ks < 8; ++ks) { const bf16x8 kf = *(const LAS bf16x8*)(lds + c * 32768 + RKSWZ(32 * blk + r32, (16 * ks + 8 * hi) * 2));
          sc[blk] = __builtin_amdgcn_mfma_f32_32x32x16_bf16(kf, qf[ks], sc[blk], 0, 0, 0); } }
      if (c == 0) top16_half(sc, hi, ka); else top16_half(sc, hi, kb2);
    }
    float av[16], bv[16];
#pragma unroll
    for (int i = 0; i < 16; ++i) { av[i] = fkey_inv(ka[i] & 0xFFFFFF80u); bv[i] = fkey_inv(kb2[i] & 0xFFFFFF80u); }
    float T[16];
#pragma unroll
    for (int k = 0; k < 16; ++k) T[k] = -3.0e38f;
#pragma unroll
    for (int i = 0; i < 16; ++i)
#pragma unroll
      for (int j = 0; j < 16; ++j) if ((i + 1) * (j + 1) <= 16) { float v = av[i] + bv[j];
#pragma unroll
          for (int k = 0; k < 16; ++k) { const float mx = fmaxf(T[k], v); v = fminf(T[k], v); T[k] = mx; } }
    const float m = T[0], theta = T[15];
    float Z = 0.f;
#pragma unroll
    for (int k = 0; k < 16; ++k) Z += __expf(T[k] - m);
    const float rz = 1.f / Z;
    int slot = 0; int cn = 0;
    int* ip = RIDX + (size_t)t * 128 + h * 16; float* gp = RG + (size_t)t * 128 + h * 16;
#pragma unroll
    for (int i = 0; i < 16; ++i)
#pragma unroll
      for (int j = 0; j < 16; ++j) if ((i + 1) * (j + 1) <= 16) { const float v = av[i] + bv[j];
          const bool sel = (v >= theta) && (slot < 16);
          if (sel && ((cn & 1) == hi)) { ip[slot] = (int)((ka[i] & 127u) * 128u + (kb2[j] & 127u)); gp[slot] = __expf(v - m) * rz; }
          slot += sel ? 1 : 0; ++cn; }
  }
}
#undef RKSWZ
}

#define XB_TMO      128
#define XB_XCNT(j)  (256  + 64 * (j))
#define XB_XSUB(j)  (1280 + 64 * (j))
#define XB_XGEN(j)  (2304 + 64 * (j))
#define XB_TOP      3328
#define XB_TOPGEN   3392
#define XCD_BAR_WORDS 3456
#define XB_SPIN_CAP (1u << 22)
__device__ __forceinline__ unsigned xb_ld(unsigned* p)              { return __hip_atomic_load(p, __ATOMIC_RELAXED, __HIP_MEMORY_SCOPE_AGENT); }
__device__ __forceinline__ unsigned xb_add(unsigned* p, unsigned v) { return __hip_atomic_fetch_add(p, v, __ATOMIC_RELAXED, __HIP_MEMORY_SCOPE_AGENT); }
__device__ __forceinline__ unsigned xb_xcc_id() { return (unsigned)__builtin_amdgcn_s_getreg((3 << 11) | 20) & 0xFu; }
#define XB_SPIN(cond, bar) do { unsigned _sp = 0; while (cond) { __builtin_amdgcn_s_sleep(1); \
    if ((++_sp & 255u) == 0u) { if (xb_ld(&(bar)[XB_TMO])) break; if (_sp > XB_SPIN_CAP) { atomicAdd(&(bar)[XB_TMO], 1u); break; } } } } while (0)
struct XcdBarrier { unsigned* bar; unsigned x; volatile LAS unsigned* st; };
__device__ __forceinline__ XcdBarrier xcd_barrier_post(unsigned* bar, volatile LAS unsigned* st) {
    XcdBarrier b; b.bar = bar; b.x = xb_xcc_id(); b.st = st;
    if (threadIdx.x == 0) (void)xb_add(&bar[XB_XCNT(b.x)], 1u);
    return b;
}
__device__ __forceinline__ void xcd_barrier_complete(unsigned* bar, unsigned x, unsigned& nloc, unsigned& nx) {
    const unsigned G = gridDim.x * gridDim.y * gridDim.z;
    unsigned sum, cnt, mine, sp = 0u;
    for (;;) {
        sum = 0u; cnt = 0u; mine = 0u;
#pragma unroll
        for (unsigned j = 0; j < 16; ++j) { const unsigned c = xb_ld(&bar[XB_XCNT(j)]); sum += c; cnt += (c > 0u) ? 1u : 0u; mine = (j == x) ? c : mine; }
        if (sum == G) break;
        __builtin_amdgcn_s_sleep(1);
        if ((++sp & 255u) == 0u) { if (xb_ld(&bar[XB_TMO])) break; if (sp > XB_SPIN_CAP) { atomicAdd(&bar[XB_TMO], 1u); break; } }
    }
    nloc = mine > 0u ? mine : 1u; nx = cnt > 0u ? cnt : 1u;
}
__device__ __forceinline__ void xcd_barrier(const XcdBarrier& b) {
    asm volatile("s_waitcnt vmcnt(0)" ::: "memory");
    __syncthreads();
    if (threadIdx.x == 0) {
        unsigned* bar = b.bar;
        __builtin_amdgcn_s_waitcnt(0);
        unsigned nloc = b.st[0], nx = b.st[1];
        if (nloc == 0u) { xcd_barrier_complete(bar, b.x, nloc, nx); b.st[0] = nloc; b.st[1] = nx; }
        const unsigned old = xb_add(&bar[XB_XSUB(b.x)], 1u);
        const unsigned gen = old / nloc;
        if (old + 1u == (gen + 1u) * nloc) {
            __builtin_amdgcn_fence(__ATOMIC_RELEASE, "agent");
            asm volatile("s_waitcnt vmcnt(0)" ::: "memory");
            const unsigned og = xb_add(&bar[XB_TOP], 1u);
            const unsigned tg = og / nx;
            if (og + 1u == (tg + 1u) * nx) xb_add(&bar[XB_TOPGEN], 1u);
            else XB_SPIN(xb_ld(&bar[XB_TOPGEN]) == tg, bar);
            __builtin_amdgcn_fence(__ATOMIC_ACQUIRE, "agent");
            xb_add(&bar[XB_XGEN(b.x)], 1u);
            asm volatile("s_waitcnt vmcnt(0)" ::: "memory");
        } else {
            XB_SPIN(xb_ld(&bar[XB_XGEN(b.x)]) == gen, bar);
            __builtin_amdgcn_fence(__ATOMIC_ACQUIRE, "agent");
            asm volatile("s_waitcnt vmcnt(0)" ::: "memory");
        }
    }
    __syncthreads();
}
constexpr int RING_BYTES = 131072, MISC_OFF = 143360, LDS_BYTES = 147456, NTHREADS = 512;
static_assert(att::LDS_NEED <= MISC_OFF, "attention scratch below the MISC words");
constexpr size_t WS_SLAB = WS_X2BF;

__device__ __forceinline__ void touch_buffer(const void* base, size_t bytes, int cb, int Gd, int tid) {
    const u32x4* b = (const u32x4*)base; const size_t n = bytes / 16, stride = (size_t)Gd * NTHREADS;
    u32x4 acc = {0u, 0u, 0u, 0u};
    for (size_t i = (size_t)cb * NTHREADS + tid; i < n; i += stride) { const u32x4 v = b[i]; acc.x ^= v.x; acc.y ^= v.y; acc.z ^= v.z; acc.w ^= v.w; }
    asm volatile("" :: "v"(acc.x), "v"(acc.y), "v"(acc.z), "v"(acc.w));
}
#define PH_BEGIN(i) unsigned long long t0_##i = 0; if ((PROBE_MASK >> (i)) & 1) t0_##i = __builtin_amdgcn_s_memrealtime();
#define PH_END(i) if ((PROBE_MASK >> (i)) & 1) probe_acc += __builtin_amdgcn_s_memrealtime() - t0_##i;
__global__ void __launch_bounds__(NTHREADS, 2) fwd(Params p) {
    extern __shared__ __attribute__((aligned(16))) unsigned char lds_raw[];
    LAS unsigned char* lds = (LAS unsigned char*)lds_raw;
    volatile LAS unsigned* MISC = (volatile LAS unsigned*)(lds + MISC_OFF);
    const int tid = threadIdx.x, lane = tid & 63, wave = __builtin_amdgcn_readfirstlane(tid >> 6);
    const int nwb = NTHREADS / 64;
    const int gw = blockIdx.x * nwb + wave, NW = gridDim.x * nwb;
    const int Gd = gridDim.x, cb = blockIdx.x;
    unsigned char* ws = p.ws;
    bf16_t* WT_IN = (bf16_t*)(ws + WS_WT_IN); bf16_t* WT_GATE = (bf16_t*)(ws + WS_WT_GATE); bf16_t* WT_BR = (bf16_t*)(ws + WS_WT_BR);
    bf16_t* WT_O = (bf16_t*)(ws + WS_WT_O); bf16_t* WT_PQ = (bf16_t*)(ws + WS_WT_PQ); bf16_t* WT_MKV = (bf16_t*)(ws + WS_WT_MKV);
    bf16_t* KEYSB = (bf16_t*)(ws + WS_KEYSB); bf16_t* MEMN = (bf16_t*)(ws + WS_MEMN); bf16_t* MEMKV = (bf16_t*)(ws + WS_MEMKV);
    bf16_t* HO = (bf16_t*)(ws + WS_HO); bf16_t* PROJ = (bf16_t*)(ws + WS_PROJ); bf16_t* G = (bf16_t*)(ws + WS_G);
    bf16_t* MERGED = (bf16_t*)(ws + WS_MERGED); bf16_t* X2BF = (bf16_t*)(ws + WS_X2BF); bf16_t* QB = (bf16_t*)(ws + WS_Q);
        float* SS2 = (float*)(ws + WS_CTL + CTL_SS2_BYTE);
    if (tid < 64) MISC[tid] = 0u;
    __syncthreads();
    XcdBarrier bar = xcd_barrier_post((unsigned*)(ws + WS_CTL + CTL_BAR_BYTE), MISC + 8);
    if (tid == 0) MISC[16] = xb_add((unsigned*)(ws + WS_CTL + CTL_RANK_BYTE) + 64 * bar.x, 1u);

    unsigned long long probe_acc = 0;
    PH_BEGIN(0)
    {
        LAS float* scr = (LAS float*)lds + wave * (64 * 33);
        const int I0 = (D / 64) * (INW / 32), I1 = I0 + (D / 64) * (GW / 32), I2 = I1 + (D / 64) * (D / 32), I3 = I2 + (D / 64) * (D / 32), I4 = I3 + (D / 64) * (D / 32), I5 = I4 + (D / 64) * (2 * CW / 32);
#define TRJOB(it, jb, li) do { if ((it) < I0) { jb = TrJob{p.in[3], WT_IN, nullptr, D, INW, 0.f}; li = (it); } else if ((it) < I1) { jb = TrJob{p.in[18], WT_GATE, nullptr, D, GW, GATE_WSCALE}; li = (it) - I0; } \
            else if ((it) < I2) { jb = TrJob{p.in[20], WT_BR, nullptr, D, D, 0.f}; li = (it) - I1; } else if ((it) < I3) { jb = TrJob{p.in[21], WT_O, nullptr, D, D, 0.f}; li = (it) - I2; } \
            else if ((it) < I4) { jb = TrJob{p.in[23], WT_PQ, p.in[22], D, D, 0.f}; li = (it) - I3; } else { jb = TrJob{p.in[15], WT_MKV, nullptr, D, 2 * CW, 0.f}; li = (it) - I4; } } while (0)
        for (int it = gw; it < I5; it += 2 * NW) {
            TrJob ja, jb2; int la, lb; f32x4 va[8], vb[8];
            TRJOB(it, ja, la); tr_load(ja, la, lane, va);
            const bool has2 = it + NW < I5;
            if (has2) { TRJOB(it + NW, jb2, lb); tr_load(jb2, lb, lane, vb); }
            tr_store(ja, la, lane, va, scr);
            if (has2) tr_store(jb2, lb, lane, vb, scr);
        }
#undef TRJOB
        rms_rows(p.in[0], p.in[2], HO, ws + WS_H8, T, gw, NW, lane);
        rms_rows(p.in[1], p.in[14], MEMN, nullptr, BATCH * NMEM, gw, NW, lane);
        const float* keys = p.in[24];
        for (int i = gw * 64 + lane; i < PH * 2 * NKEYS * 128 / 2; i += NW * 64) ((unsigned*)KEYSB)[i] = pk2(keys[2 * i], keys[2 * i + 1]);
    }
    xcd_barrier(bar);
    PH_END(0)
    PH_BEGIN(1)
    {
        SchedP1a Sa{(const char*)HO, (const char*)WT_IN, (const char*)MEMN, (const char*)WT_MKV, Gd, cb};
        EpiP1a Ea{PROJ, MEMKV};
        pg8::gemm_phase<false>(lds, D, D, Sa, Ea);
        SchedP1b Sb{(const char*)(ws + WS_H8), (const char*)WT_GATE, Gd, cb};
        EpiP1b Eb{G, p.in[19]};
        pg8::gemm_phase<true>(lds, D / 2, D / 2, Sb, Eb);
    }
    xcd_barrier(bar);
    PH_END(1)
    PH_BEGIN(2)
    {
        const float qscale = 0.08838834764831845f;
        { HeadGains hg; load_head_gains(hg, p.in[4], p.in[5], p.in[16], lane);
          for (int t = gw; t < T; t += NW) headnorm_token(PROJ + (size_t)t * INW, hg, qscale, lane); }
        for (int it = gw; it < BATCH * NMEM * 4; it += NW) { const int m = it / 4, j = it % 4; headnorm(MEMKV + (size_t)m * (2 * CW) + j * 128, p.in[17], 1.f, lane); }
        for (int u = gw; u < BATCH * NCH * 8; u += NW) { const int g = u % 8, c = (u / 8) % NCH, b = u / (8 * NCH); lru_pass1(p, b, c, g, lane, lds + wave * 8192); }
        fp4_tables(p, gw, NW, lane);
    }
    xcd_barrier(bar);
    PH_END(2)
    PH_BEGIN(3)
    {
        const int nA = BATCH * 8 * (NCH / 4), nC = BATCH * 4 * (SEQ / 256);
        PH_BEGIN(9)
        for (int u = cb; u < nA + nC; u += Gd) {
            if (u < nA) {
                const int cg = u % (NCH / 4), h = (u / (NCH / 4)) % 8, b = u / ((NCH / 4) * 8);
                const size_t brow = (size_t)b * SEQ, qrow = brow + (size_t)cg * 256;
                att::attn_body<INW, INW, D, true>(PROJ + qrow * INW + C_QA + h * 128, PROJ + brow * INW + C_KA + h * 128, PROJ + brow * INW + C_VA + h * 128,
                                                  HO + qrow * D + h * 128, 12, cg * 4 - NPREV, p.in[6] + h * 257, (LAS char*)lds);
            } else {
                const int v = u - nA; const int qb = v % (SEQ / 256), h = (v / (SEQ / 256)) % 4, b = v / ((SEQ / 256) * 4);
                const size_t qrow = (size_t)b * SEQ + (size_t)qb * 256;
                att::attn_body<INW, 2 * CW, D, false>(PROJ + qrow * INW + C_QC + h * 128, MEMKV + (size_t)b * NMEM * (2 * CW) + h * 128, MEMKV + (size_t)b * NMEM * (2 * CW) + CW + h * 128,
                                                     HO + qrow * D + AW + LW + h * 128, NMEM / 64, 0, nullptr, (LAS char*)lds);
            }
        }
        PH_END(9)
        PH_BEGIN(10)
        for (int u = gw; u < BATCH * NCH * 8; u += NW) { const int g = u % 8, c = (u / 8) % NCH, b = u / (8 * NCH); lru_pass2(p, b, c, g, lane); }
        touch_buffer(WT_BR, (size_t)D * D * 2, cb, Gd, tid); touch_buffer(WT_O, (size_t)D * D * 2, cb, Gd, tid);
        PH_END(10)
    }
    xcd_barrier(bar);
    PH_END(3)
    PH_BEGIN(4)
    {
        SchedP3 S{(const char*)HO, (const char*)WT_BR, Gd, cb};
        EpiP3 E{G, MERGED};
        pg8::gemm_phase<false>(lds, D, D, S, E);
    }
    xcd_barrier(bar);
    PH_END(4)
    PH_BEGIN(5)
    {
        SchedSq S{(const char*)MERGED, (const char*)WT_O, Gd, cb};
        EpiP4 E{p.in[0], p.out, X2BF, SS2, ws + WS_X2F8};
        pg8::gemm_phase<false>(lds, D, D, S, E);
        touch_buffer(WT_PQ, (size_t)D * D * 2, cb, Gd, tid);
    }
    xcd_barrier(bar);
    PH_END(5)
    PH_BEGIN(6)
    {
        SchedSq S{(const char*)X2BF, (const char*)WT_PQ, Gd, cb};
        EpiP5 E{QB, SS2};
        pg8::gemm_phase<false>(lds, D, D, S, E);
    }
    xcd_barrier(bar);
    PH_END(6)
    PH_BEGIN(7)
    rt::route_phase(p, lds, tid, lane, wave);
    xcd_barrier(bar);
    PH_END(7)
    PH_BEGIN(8)
    int ppos, pnx, prank, pnloc;
    { if (tid == 0) { unsigned pos = 0, nx = 0; const unsigned* bw = (const unsigned*)(ws + WS_CTL + CTL_BAR_BYTE);
#pragma unroll
          for (unsigned j = 0; j < 16; ++j) { const unsigned cj = xb_ld((unsigned*)&bw[XB_XCNT(j)]); nx += cj > 0u ? 1u : 0u; pos += (cj > 0u && j < bar.x) ? 1u : 0u; }
          MISC[17] = pos; MISC[18] = nx > 0u ? nx : 1u; }
      __syncthreads();
      ppos = (int)MISC[17]; pnx = (int)MISC[18]; prank = (int)MISC[16]; pnloc = (int)MISC[8]; if (pnloc < 1) pnloc = 1; }
    peer_u_step(p, lane, wave, lds + wave * 16384, ppos, pnx, prank, pnloc);
    xcd_barrier(bar);
    for (int t = gw; t < T; t += NW) peer_combine(p, t, lane);
    xcd_barrier(bar);
    peer_v_step(p, lane, wave, lds + wave * 16384, ppos, pnx, prank, pnloc);
    if (PROBE_MASK) { __syncthreads(); PH_END(8) const unsigned long long te = __builtin_amdgcn_s_memrealtime(); while (__builtin_amdgcn_s_memrealtime() - te < probe_acc) __builtin_amdgcn_s_sleep(8); }
}

extern "C" void kernel_launch(void* const* d_in, const int* in_sizes, int n_in, void* d_out, int out_size, void* d_ws, size_t ws_size, hipStream_t stream) {
    static int grid = 0;
    if (grid == 0) {
        if (n_in != 27 || out_size != T * D || ws_size < WS_END) { fprintf(stderr, "kernel_launch: unexpected problem (n_in %d out %d ws %zu)\n", n_in, out_size, ws_size); grid = -1; return; }
        int dev = 0, cus = 0, per_cu = 0;
        (void)hipGetDevice(&dev); (void)hipDeviceGetAttribute(&cus, hipDeviceAttributeMultiprocessorCount, dev);
        if (hipFuncSetAttribute((const void*)fwd, hipFuncAttributeMaxDynamicSharedMemorySize, LDS_BYTES) != hipSuccess) { fprintf(stderr, "kernel_launch: hipFuncSetAttribute failed\n"); grid = -1; return; }
        (void)hipOccupancyMaxActiveBlocksPerMultiprocessor(&per_cu, (const void*)fwd, NTHREADS, LDS_BYTES);
        if (per_cu < 1) { fprintf(stderr, "kernel_launch: occupancy query says %d\n", per_cu); grid = -1; return; }
        grid = cus;
    }
    if (grid < 0) return;
    (void)hipMemsetAsync((char*)d_ws + WS_CTL, 0, 1 * MiB, stream);
    Params p{};
    for (int i = 0; i < 27; ++i) p.in[i] = (const float*)d_in[i];
    p.out = (float*)d_out; p.ws = (unsigned char*)d_ws;
    void* args[] = {&p};
    hipError_t e = hipLaunchCooperativeKernel((const void*)fwd, dim3(grid), dim3(NTHREADS), args, LDS_BYTES, stream);
    if (e != hipSuccess) fprintf(stderr, "cooperative launch failed: %s (grid %d)\n", hipGetErrorString(e), grid);
}
```

```cpp
#include <hip/hip_runtime.h>
#include <hip/hip_cooperative_groups.h>
#include <cstdio>
#include <cstdint>
namespace cg = cooperative_groups;
#ifndef PROBE_MASK
#define PROBE_MASK 0
#endif

#define LAS __attribute__((address_space(3)))
typedef unsigned short bf16_t;
typedef short bf16x8 __attribute__((ext_vector_type(8)));
typedef float f32x4 __attribute__((ext_vector_type(4)));
typedef unsigned u32x4 __attribute__((ext_vector_type(4)));
typedef unsigned u32x2 __attribute__((ext_vector_type(2)));

constexpr int D = 2048, BATCH = 2, SEQ = 8192, T = BATCH * SEQ;
constexpr int CHUNK = 64, NPREV = 8, NCH = SEQ / CHUNK;
constexpr int AW = 1024, LW = 512, CW = 512, INW = 4608, GW = 6144;
constexpr int NMEM = 256;
constexpr int PH = 8, NKEYS = 128, TOPK = 16;
constexpr float EPS = 1e-6f;
constexpr int C_QA = 0, C_KA = 1024, C_VA = 2048, C_XL = 3072, C_GL = 3584, C_QC = 4096;

constexpr size_t MiB = 1u << 20;
constexpr size_t WS_CTL = 0;
constexpr size_t WS_WT_IN = 2 * MiB, WS_WT_GATE = 20 * MiB, WS_WT_BR = 44 * MiB, WS_WT_O = 52 * MiB, WS_WT_PQ = 60 * MiB, WS_WT_MKV = 68 * MiB;
constexpr size_t WS_KEYSB = 72 * MiB, WS_MEMN = 73 * MiB, WS_MEMKV = 75 * MiB, WS_LRUSUM = 76 * MiB, WS_RS2 = 77 * MiB;
constexpr size_t WS_HO = 80 * MiB;
constexpr size_t WS_PROJ = 144 * MiB;
constexpr size_t WS_MERGED = 144 * MiB, WS_X2BF = 208 * MiB;
constexpr size_t WS_G = 288 * MiB;
constexpr size_t WS_TABU = 496 * MiB, WS_TABV = 512 * MiB, WS_Q = 416 * MiB;
constexpr size_t WS_SCU = 77 * MiB, WS_SCV = 77 * MiB + 65536;
constexpr size_t WS_AUA = 2 * MiB, WS_AUU = 18 * MiB;
constexpr size_t WS_H8 = 496 * MiB;
constexpr float GATE_WSCALE = 256.f;
constexpr size_t WS_RIDX = 480 * MiB, WS_RG = 488 * MiB, WS_END = 528 * MiB;

constexpr size_t CTL_BAR_BYTE = 16384, CTL_RANK_BYTE = 65536, CTL_SS2_BYTE = 512 * 1024;
struct Params { const float* in[27]; float* out; unsigned char* ws; };

__device__ __forceinline__ float bf2f(unsigned v16) { return __uint_as_float(v16 << 16); }
typedef float f32x2c __attribute__((ext_vector_type(2))); typedef __bf16 bf16x2c __attribute__((ext_vector_type(2)));
__device__ __forceinline__ unsigned pk2(float lo, float hi) { const f32x2c v = {lo, hi}; return __builtin_bit_cast(unsigned, __builtin_convertvector(v, bf16x2c)); }
__device__ __forceinline__ unsigned f2bf(float f) { return pk2(f, 0.f) & 0xffffu; }
__device__ __forceinline__ float wave_sum(float v) {
#pragma unroll
    for (int o = 1; o < 64; o <<= 1) v += __shfl_xor(v, o);
    return v;
}
typedef __bf16 bf16x2_t __attribute__((ext_vector_type(2)));
__device__ __forceinline__ float dot2bf(unsigned w, unsigned x, float acc) { return __builtin_amdgcn_fdot2_f32_bf16(__builtin_bit_cast(bf16x2_t, w), __builtin_bit_cast(bf16x2_t, x), acc, false); }
__device__ __forceinline__ float sigmoid_(float x) { return 1.f / (1.f + __expf(-x)); }
__device__ __forceinline__ float gelu_tanh(float x) { const float y = 1.5957691216f * (x + 0.044715f * x * x * x); return x / (1.f + __expf(-y)); }
__device__ __forceinline__ void unpack8(const u32x4 w, float* f) {
    f[0] = __uint_as_float(w.x << 16); f[1] = __uint_as_float(w.x & 0xffff0000u);
    f[2] = __uint_as_float(w.y << 16); f[3] = __uint_as_float(w.y & 0xffff0000u);
    f[4] = __uint_as_float(w.z << 16); f[5] = __uint_as_float(w.z & 0xffff0000u);
    f[6] = __uint_as_float(w.w << 16); f[7] = __uint_as_float(w.w & 0xffff0000u);
}

struct TrJob { const float* W; bf16_t* WT; const float* ks; int K, N; float f8scale; };
__device__ __forceinline__ void tr_load(const TrJob& jb, int item, int lane, f32x4 (&v)[8]) {
    const int nblk = jb.N / 32, kb = item / nblk, nb = item % nblk, k0 = 64 * kb, n0 = 32 * nb;
#pragma unroll
    for (int i = 0; i < 8; ++i) { const int kk = 8 * i + (lane >> 3); v[i] = *(const f32x4*)(jb.W + (size_t)(k0 + kk) * jb.N + n0 + 4 * (lane & 7)); if (jb.ks) v[i] = v[i] * jb.ks[k0 + kk]; }
}
__device__ __forceinline__ void tr_store(const TrJob& jb, int item, int lane, const f32x4 (&v)[8], LAS float* scr) {
    const int nblk = jb.N / 32, kb = item / nblk, nb = item % nblk, k0 = 64 * kb, n0 = 32 * nb;
#pragma unroll
    for (int i = 0; i < 8; ++i) { LAS float* d = scr + (8 * i + (lane >> 3)) * 33 + 4 * (lane & 7); d[0] = v[i].x; d[1] = v[i].y; d[2] = v[i].z; d[3] = v[i].w; }
    asm volatile("s_waitcnt lgkmcnt(0)" ::: "memory");
    const int c = lane & 7;
#pragma unroll
    for (int j = 0; j < 4; ++j) { const int n = (lane >> 3) + 8 * j; const LAS float* s = scr + (8 * c) * 33 + n;
        if (jb.f8scale != 0.f) { const float f = jb.f8scale; u32x2 o;
#define F8C(x_) fminf(fmaxf((x_) * f, -448.f), 448.f)
            int w = __builtin_amdgcn_cvt_pk_fp8_f32(F8C(s[0 * 33]), F8C(s[1 * 33]), 0, false); w = __builtin_amdgcn_cvt_pk_fp8_f32(F8C(s[2 * 33]), F8C(s[3 * 33]), w, true); o.x = (unsigned)w;
            w = __builtin_amdgcn_cvt_pk_fp8_f32(F8C(s[4 * 33]), F8C(s[5 * 33]), 0, false); w = __builtin_amdgcn_cvt_pk_fp8_f32(F8C(s[6 * 33]), F8C(s[7 * 33]), w, true); o.y = (unsigned)w;
#undef F8C
            *(u32x2*)((unsigned char*)jb.WT + (size_t)(n0 + n) * jb.K + k0 + 8 * c) = o; }
        else { u32x4 o; o.x = pk2(s[0 * 33], s[1 * 33]); o.y = pk2(s[2 * 33], s[3 * 33]); o.z = pk2(s[4 * 33], s[5 * 33]); o.w = pk2(s[6 * 33], s[7 * 33]);
            *(u32x4*)(jb.WT + (size_t)(n0 + n) * jb.K + k0 + 8 * c) = o; } }
    asm volatile("s_waitcnt lgkmcnt(0)" ::: "memory");
}
__device__ __forceinline__ void rms_row_load(const float* xrow, int lane, f32x4 (&v)[8]) {
    const f32x4* xr = (const f32x4*)xrow + lane;
#pragma unroll
    for (int j = 0; j < 8; ++j) v[j] = xr[64 * j];
}
__device__ __forceinline__ void rms_row_finish(const f32x4 (&v)[8], const float* g, bf16_t* orow, unsigned char* o8row, int lane) {
    const f32x4* gr = (const f32x4*)g + lane; float s = 0.f;
#pragma unroll
    for (int j = 0; j < 8; ++j) s += (v[j].x * v[j].x + v[j].y * v[j].y) + (v[j].z * v[j].z + v[j].w * v[j].w);
    const float rstd = rsqrtf(wave_sum(s) * (1.f / D) + EPS);
    u32x2* o8 = (u32x2*)orow + lane;
#pragma unroll
    for (int j = 0; j < 8; ++j) { const f32x4 gg = gr[64 * j]; const float a0 = v[j].x * rstd * gg.x, a1 = v[j].y * rstd * gg.y, a2 = v[j].z * rstd * gg.z, a3 = v[j].w * rstd * gg.w;
        u32x2 o; o.x = pk2(a0, a1); o.y = pk2(a2, a3); o8[64 * j] = o;
        if (o8row) { int w = __builtin_amdgcn_cvt_pk_fp8_f32(fminf(fmaxf(a0, -448.f), 448.f), fminf(fmaxf(a1, -448.f), 448.f), 0, false);
            w = __builtin_amdgcn_cvt_pk_fp8_f32(fminf(fmaxf(a2, -448.f), 448.f), fminf(fmaxf(a3, -448.f), 448.f), w, true); ((unsigned*)o8row)[64 * j + lane] = (unsigned)w; } }
}
__device__ __forceinline__ void rms_rows(const float* X, const float* g, bf16_t* O, unsigned char* O8, int nrows, int gw, int NW, int lane) {
    f32x4 va[8], vb[8];
    int m = gw;
    if (m < nrows) rms_row_load(X + (size_t)m * D, lane, va);
    for (; m < nrows; m += 2 * NW) {
        const bool hb = m + NW < nrows;
        if (hb) rms_row_load(X + (size_t)(m + NW) * D, lane, vb);
        rms_row_finish(va, g, O + (size_t)m * D, O8 ? O8 + (size_t)m * D : nullptr, lane);
        if (m + 2 * NW < nrows) rms_row_load(X + (size_t)(m + 2 * NW) * D, lane, va);
        if (hb) rms_row_finish(vb, g, O + (size_t)(m + NW) * D, O8 ? O8 + (size_t)(m + NW) * D : nullptr, lane);
    }
}

template <int TM, int TN, class Epi>
__device__ __forceinline__ void gemm_simple(const bf16_t* __restrict__ A, int lda, const bf16_t* __restrict__ Bt, int ldb, int M, int N, int K, const Epi& epi, int gw, int NW, int lane) {
    const int r = lane & 15, q = lane >> 4;
    const int ntm = M / (16 * TM), ntn = N / (16 * TN);
    for (int tile = gw; tile < ntm * ntn; tile += NW) {
        const int tm = tile / ntn, tn = tile % ntn;
        f32x4 acc[TM][TN];
#pragma unroll
        for (int i = 0; i < TM; ++i)
#pragma unroll
            for (int j = 0; j < TN; ++j) acc[i][j] = (f32x4){0.f, 0.f, 0.f, 0.f};
        const bf16_t* ap = A + (size_t)(tm * 16 * TM + r) * lda + q * 8;
        const bf16_t* bp = Bt + (size_t)(tn * 16 * TN + r) * ldb + q * 8;
        for (int k0 = 0; k0 < K; k0 += 32) {
            bf16x8 af[TM], bfr[TN];
#pragma unroll
            for (int i = 0; i < TM; ++i) af[i] = *(const bf16x8*)(ap + (size_t)i * 16 * lda + k0);
#pragma unroll
            for (int j = 0; j < TN; ++j) bfr[j] = *(const bf16x8*)(bp + (size_t)j * 16 * ldb + k0);
#pragma unroll
            for (int i = 0; i < TM; ++i)
#pragma unroll
                for (int j = 0; j < TN; ++j) acc[i][j] = __builtin_amdgcn_mfma_f32_16x16x32_bf16(af[i], bfr[j], acc[i][j], 0, 0, 0);
        }
#pragma unroll
        for (int i = 0; i < TM; ++i)
#pragma unroll
            for (int j = 0; j < TN; ++j)
#pragma unroll
                for (int e = 0; e < 4; ++e) epi(tm * 16 * TM + i * 16 + q * 4 + e, tn * 16 * TN + j * 16 + r, acc[i][j][e]);
    }
}
struct EpiProj { bf16_t* P; __device__ __forceinline__ void operator()(int row, int col, float v) const { if (col >= C_GL && col < C_QC) v = gelu_tanh(v); P[(size_t)row * INW + col] = (bf16_t)f2bf(v); } };
struct EpiGate { bf16_t* G; const float* b; __device__ __forceinline__ void operator()(int row, int col, float v) const { G[(size_t)row * GW + col] = (bf16_t)f2bf(sigmoid_(v + b[col])); } };
struct EpiStore { bf16_t* C; int ldc; __device__ __forceinline__ void operator()(int row, int col, float v) const { C[(size_t)row * ldc + col] = (bf16_t)f2bf(v); } };
struct EpiWo { const float* x; float* out; bf16_t* xb; __device__ __forceinline__ void operator()(int row, int col, float v) const { const size_t o = (size_t)row * D + col; const float y = x[o] + v; out[o] = y; xb[o] = (bf16_t)f2bf(y); } };
struct EpiQ { bf16_t* Q; const float* rs; __device__ __forceinline__ void operator()(int row, int col, float v) const { Q[(size_t)row * D + col] = (bf16_t)f2bf(v * rs[row]); } };

__device__ __forceinline__ void headnorm(bf16_t* vec, const float* g, float scale, int lane) {
    unsigned* p = (unsigned*)vec + lane; const unsigned w = *p;
    const float a = bf2f(w & 0xffffu), b = bf2f(w >> 16);
    const float rs = rsqrtf(wave_sum(a * a + b * b) * (1.f / 128.f) + EPS) * scale;
    *p = pk2(a * rs * g[2 * lane], b * rs * g[2 * lane + 1]);
}
struct HeadGains { float gq[32], gk[32], gc[8]; };
__device__ __forceinline__ void load_head_gains(HeadGains& hg, const float* gq, const float* gk, const float* gc, int lane) {
#pragma unroll
    for (int j = 0; j < 32; ++j) { hg.gq[j] = gq[(lane & 3) * 32 + j]; hg.gk[j] = gk[(lane & 3) * 32 + j]; }
#pragma unroll
    for (int j = 0; j < 8; ++j) hg.gc[j] = gc[(lane & 15) * 8 + j];
}
__device__ __forceinline__ void headnorm_token(bf16_t* row, const HeadGains& hg, float qscale, int lane) {
    u32x4* pa = (u32x4*)(row + C_QA) + lane * 4;
    u32x4* pc = (u32x4*)(row + C_QC) + lane;
    u32x4 w[4]; const u32x4 wc = *pc;
#pragma unroll
    for (int j = 0; j < 4; ++j) w[j] = pa[j];
    float f[32], fc[8]; float ss = 0.f, sc = 0.f;
#pragma unroll
    for (int j = 0; j < 4; ++j) unpack8(w[j], f + 8 * j);
    unpack8(wc, fc);
#pragma unroll
    for (int j = 0; j < 32; ++j) ss = fmaf(f[j], f[j], ss);
#pragma unroll
    for (int j = 0; j < 8; ++j) sc = fmaf(fc[j], fc[j], sc);
    ss += __shfl_xor(ss, 1); ss += __shfl_xor(ss, 2);
    sc += __shfl_xor(sc, 1); sc += __shfl_xor(sc, 2); sc += __shfl_xor(sc, 4); sc += __shfl_xor(sc, 8);
    const bool isq = lane < 32;
    const float rs = rsqrtf(ss * (1.f / 128.f) + EPS) * (isq ? qscale : 1.f), rc = rsqrtf(sc * (1.f / 128.f) + EPS) * qscale;
#pragma unroll
    for (int j = 0; j < 4; ++j) { u32x4 o;
        o.x = pk2(f[8 * j] * rs * (isq ? hg.gq[8 * j] : hg.gk[8 * j]), f[8 * j + 1] * rs * (isq ? hg.gq[8 * j + 1] : hg.gk[8 * j + 1]));
        o.y = pk2(f[8 * j + 2] * rs * (isq ? hg.gq[8 * j + 2] : hg.gk[8 * j + 2]), f[8 * j + 3] * rs * (isq ? hg.gq[8 * j + 3] : hg.gk[8 * j + 3]));
        o.z = pk2(f[8 * j + 4] * rs * (isq ? hg.gq[8 * j + 4] : hg.gk[8 * j + 4]), f[8 * j + 5] * rs * (isq ? hg.gq[8 * j + 5] : hg.gk[8 * j + 5]));
        o.w = pk2(f[8 * j + 6] * rs * (isq ? hg.gq[8 * j + 6] : hg.gk[8 * j + 6]), f[8 * j + 7] * rs * (isq ? hg.gq[8 * j + 7] : hg.gk[8 * j + 7]));
        pa[j] = o; }
    { u32x4 o; o.x = pk2(fc[0] * rc * hg.gc[0], fc[1] * rc * hg.gc[1]); o.y = pk2(fc[2] * rc * hg.gc[2], fc[3] * rc * hg.gc[3]);
      o.z = pk2(fc[4] * rc * hg.gc[4], fc[5] * rc * hg.gc[5]); o.w = pk2(fc[6] * rc * hg.gc[6], fc[7] * rc * hg.gc[7]); *pc = o; }
}

__device__ __forceinline__ void fp4_row_load(const float* __restrict__ src, const float* __restrict__ kscale, int lane, f32x4 (&v)[8]);
__device__ __forceinline__ void fp4_row_finish(const f32x4 (&v)[8], unsigned char* __restrict__ tab, int e, float* __restrict__ scale_out, int lane);
__device__ __forceinline__ void lru_pass1(const Params& p, int b, int c, int g, int lane, LAS unsigned char* wl  , const int tr0, const int trs) {
    const bf16_t* PROJ = (const bf16_t*)(p.ws + WS_PROJ);
    float* SUMA = (float*)(p.ws + WS_LRUSUM); float* SUMB = SUMA + BATCH * NCH * LW;
    bf16_t* AUA = (bf16_t*)(p.ws + WS_AUA); bf16_t* AUU = (bf16_t*)(p.ws + WS_AUU);
    const float* conv_w = p.in[7]; const float* conv_b = p.in[8]; const float* lru_wa = p.in[9]; const float* lru_ba = p.in[10];
    const float* lru_wx = p.in[11]; const float* lru_bx = p.in[12]; const float* lam = p.in[13];
    const int ch = g * 64 + lane;
    unsigned wa_p[32], wx_p[32];
#pragma unroll
    for (int m = 0; m < 32; ++m) { wa_p[m] = pk2(lru_wa[(size_t)(g * 64 + 2 * m) * 64 + lane], lru_wa[(size_t)(g * 64 + 2 * m + 1) * 64 + lane]);
        wx_p[m] = pk2(lru_wx[(size_t)(g * 64 + 2 * m) * 64 + lane], lru_wx[(size_t)(g * 64 + 2 * m + 1) * 64 + lane]); }
    const float cw0 = conv_w[0 * LW + ch], cw1 = conv_w[1 * LW + ch], cw2 = conv_w[2 * LW + ch], cw3 = conv_w[3 * LW + ch], cb = conv_b[ch];
    const float ba_ = lru_ba[ch], bx_ = lru_bx[ch];
    const float sp = log1pf(__expf(-lam[ch]));
    const int t0 = c * CHUNK; const size_t row0 = (size_t)b * SEQ + t0;
    float x0 = 0.f, x1 = 0.f, x2 = 0.f;
    if (t0 >= 3) { x0 = bf2f(PROJ[(row0 - 3) * INW + C_XL + ch]); x1 = bf2f(PROJ[(row0 - 2) * INW + C_XL + ch]); x2 = bf2f(PROJ[(row0 - 1) * INW + C_XL + ch]); }
    { const bf16_t* xs = PROJ + (row0 + (lane >> 3)) * INW + C_XL + g * 64 + (lane & 7) * 8;
      u32x4 tx[8];
#pragma unroll
      for (int i = 0; i < 8; ++i) tx[i] = *(const u32x4*)(xs + (size_t)(8 * i) * INW);
#pragma unroll
      for (int i = 0; i < 8; ++i) *(LAS u32x4*)(wl + (8 * i + (lane >> 3)) * 128 + (lane & 7) * 16) = tx[i]; }
    float h = 0.f, aprod = 1.f;
#define LRU_PAIRX(xc_) ({ const float xnb_ = __int_as_float(__builtin_amdgcn_update_dpp(0, __float_as_int(xc_), 0xB1, 0xf, 0xf, true));     \
        (lane & 1) ? pk2(xnb_, xc_) : pk2(xc_, xnb_); })
#define LRU_GATE(rp_, ip_, xc_, a_, u_) do { const float r_ = sigmoid_(rp_), ig_ = sigmoid_(ip_); const float la_ = -8.f * r_ * sp; a_ = __expf(la_); \
        u_ = sqrtf(fminf(fmaxf((1.f - a_) * (1.f + a_), 1e-12f), 1.f)) * ig_ * xc_; } while (0)
#define LRU_TOKPAIR(tp_) do { const int t_ = (tp_);                           \
        const float x3 = bf2f(*(const LAS bf16_t*)(wl + t_ * 128 + lane * 2)), x4 = bf2f(*(const LAS bf16_t*)(wl + (t_ + 1) * 128 + lane * 2)); \
        const float xcA = cw0 * x0 + cw1 * x1 + cw2 * x2 + cw3 * x3 + cb, xcB = cw0 * x1 + cw1 * x2 + cw2 * x3 + cw3 * x4 + cb; \
        x0 = x2; x1 = x3; x2 = x4; \
        const unsigned pkA = LRU_PAIRX(xcA), pkB = LRU_PAIRX(xcB); \
        float rA = ba_, iA = bx_, rA2 = 0.f, iA2 = 0.f, rB = ba_, iB = bx_, rB2 = 0.f, iB2 = 0.f; \
_Pragma("unroll") \
        for (int m = 0; m < 32; m += 2) { \
            const unsigned a0 = (unsigned)__builtin_amdgcn_readlane((int)pkA, 2 * m), a1 = (unsigned)__builtin_amdgcn_readlane((int)pkA, 2 * m + 2); \
            const unsigned b0 = (unsigned)__builtin_amdgcn_readlane((int)pkB, 2 * m), b1 = (unsigned)__builtin_amdgcn_readlane((int)pkB, 2 * m + 2); \
            rA = dot2bf(wa_p[m], a0, rA); iA = dot2bf(wx_p[m], a0, iA); rA2 = dot2bf(wa_p[m + 1], a1, rA2); iA2 = dot2bf(wx_p[m + 1], a1, iA2); \
            rB = dot2bf(wa_p[m], b0, rB); iB = dot2bf(wx_p[m], b0, iB); rB2 = dot2bf(wa_p[m + 1], b1, rB2); iB2 = dot2bf(wx_p[m + 1], b1, iB2); } \
        float aA, uA, aB, uB; \
        LRU_GATE(rA + rA2, iA + iA2, xcA, aA, uA); LRU_GATE(rB + rB2, iB + iB2, xcB, aB, uB); \
        \
        const unsigned wA = f2bf(1.f - aA), wB = f2bf(1.f - aB), vA = f2bf(uA), vB = f2bf(uB); \
        AUA[(row0 + t_) * LW + ch] = (bf16_t)wA; AUA[(row0 + t_ + 1) * LW + ch] = (bf16_t)wB; AUU[(row0 + t_) * LW + ch] = (bf16_t)vA; AUU[(row0 + t_ + 1) * LW + ch] = (bf16_t)vB; \
        const float aAq = 1.f - bf2f(wA), aBq = 1.f - bf2f(wB); \
        h = aBq * (aAq * h + bf2f(vA)) + bf2f(vB); \
        aprod *= aAq * aBq; \
    } while (0)
#define SIDE_LOAD(r_, v_) do { if ((r_) < 16384) fp4_row_load(p.in[25] + (size_t)(r_) * D, p.in[22], lane, v_); else if ((r_) < 32768) fp4_row_load(p.in[26] + (size_t)((r_) - 16384) * D, nullptr, lane, v_); } while (0)
#define SIDE_FIN(r_, v_) do { if ((r_) < 16384) fp4_row_finish(v_, p.ws + WS_TABU, (r_), (float*)(p.ws + WS_SCU) + (r_), lane); \
        else if ((r_) < 32768) fp4_row_finish(v_, p.ws + WS_TABV, (r_) - 16384, (float*)(p.ws + WS_SCV) + ((r_) - 16384), lane); } while (0)
    f32x4 sva[8]; int sr = tr0;
    SIDE_LOAD(sr, sva);
#pragma unroll 1
    for (int tt = 0; tt < CHUNK; tt += 4) {
        LRU_TOKPAIR(tt);
        SIDE_FIN(sr, sva); SIDE_LOAD(sr + trs, sva);
        LRU_TOKPAIR(tt + 2);
        sr += trs;
    }
#undef LRU_TOKPAIR
#undef SIDE_LOAD
#undef SIDE_FIN
#undef LRU_PAIRX
#undef LRU_GATE
    { const size_t o = (size_t)(b * NCH + c) * LW + ch; SUMA[o] = aprod; SUMB[o] = h; }
}
__device__ __forceinline__ void lru_pass2(const Params& p, int b, int c, int g, int lane) {
    const bf16_t* PROJ = (const bf16_t*)(p.ws + WS_PROJ); bf16_t* O = (bf16_t*)(p.ws + WS_HO);
    const float* SUMA = (const float*)(p.ws + WS_LRUSUM); const float* SUMB = SUMA + BATCH * NCH * LW;
    const bf16_t* AUA = (const bf16_t*)(p.ws + WS_AUA); const bf16_t* AUU = (const bf16_t*)(p.ws + WS_AUU);
    const int ch = g * 64 + lane; const size_t row0 = (size_t)b * SEQ + (size_t)c * CHUNK;
    const bf16_t* ap = AUA + row0 * LW + ch; const bf16_t* up = AUU + row0 * LW + ch; const bf16_t* gp = PROJ + row0 * INW + C_GL + ch;
    bf16_t an[16], un[16], gn[16];
#pragma unroll
    for (int q = 0; q < 16; ++q) { an[q] = ap[(size_t)q * LW]; un[q] = up[(size_t)q * LW]; gn[q] = gp[(size_t)q * INW]; }
    float h = 0.f;
    {
        int j = 0;
#pragma unroll 1
        for (; j + 32 <= c; j += 32) { float sa[32], sb[32];
#pragma unroll
            for (int q = 0; q < 32; ++q) { const size_t o = (size_t)(b * NCH + j + q) * LW + ch; sa[q] = SUMA[o]; sb[q] = SUMB[o]; }
#pragma unroll
            for (int q = 0; q < 32; ++q) h = sa[q] * h + sb[q]; }
#pragma unroll 1
        for (; j + 8 <= c; j += 8) { float sa[8], sb[8];
#pragma unroll
            for (int q = 0; q < 8; ++q) { const size_t o = (size_t)(b * NCH + j + q) * LW + ch; sa[q] = SUMA[o]; sb[q] = SUMB[o]; }
#pragma unroll
            for (int q = 0; q < 8; ++q) h = sa[q] * h + sb[q]; }
        for (; j < c; ++j) { const size_t o = (size_t)(b * NCH + j) * LW + ch; h = SUMA[o] * h + SUMB[o]; }
    }
#pragma unroll 1
    for (int tb = 0; tb < CHUNK; tb += 16) {
        bf16_t ac[16], uc[16], gc[16];
#pragma unroll
        for (int q = 0; q < 16; ++q) { ac[q] = an[q]; uc[q] = un[q]; gc[q] = gn[q]; }
        if (tb + 16 < CHUNK) {
#pragma unroll
            for (int q = 0; q < 16; ++q) { an[q] = ap[(size_t)(tb + 16 + q) * LW]; un[q] = up[(size_t)(tb + 16 + q) * LW]; gn[q] = gp[(size_t)(tb + 16 + q) * INW]; }
        }
#pragma unroll
        for (int q = 0; q < 16; ++q) { h = (1.f - bf2f(ac[q])) * h + bf2f(uc[q]); O[(row0 + tb + q) * D + AW + ch] = (bf16_t)f2bf(h * bf2f(gc[q])); }
    }
}

__device__ __forceinline__ void attn_simple(const bf16_t* Qp, int ldq, const bf16_t* Kp, const bf16_t* Vp, int ldkv, int nkeys, int koff, const float* bias_h, bf16_t* Op, int ldo, int tid) {
    const int qi = tid >> 2, part = tid & 3;
    float q[32], o[32];
    { const u32x4* qp = (const u32x4*)(Qp + (size_t)qi * ldq + part * 32);
#pragma unroll
      for (int j = 0; j < 4; ++j) unpack8(qp[j], q + 8 * j); }
#pragma unroll
    for (int d = 0; d < 32; ++d) o[d] = 0.f;
    float m = -1e30f, l = 0.f;
    for (int kk0 = 0; kk0 < nkeys; kk0 += 8) {
        float s[8];
#pragma unroll
        for (int j = 0; j < 8; ++j) {
            const u32x4* kp = (const u32x4*)(Kp + (size_t)(kk0 + j) * ldkv + part * 32);
            float acc = 0.f;
#pragma unroll
            for (int w = 0; w < 4; ++w) { float kf[8]; unpack8(kp[w], kf);
#pragma unroll
                for (int e = 0; e < 8; ++e) acc = fmaf(q[8 * w + e], kf[e], acc); }
            acc += __shfl_xor(acc, 1); acc += __shfl_xor(acc, 2);
            if (bias_h) { int dist = qi + koff - (kk0 + j); dist = dist < -128 ? -128 : (dist > 128 ? 128 : dist); acc += bias_h[dist + 128]; }
            s[j] = acc;
        }
        float mx = s[0];
#pragma unroll
        for (int j = 1; j < 8; ++j) mx = fmaxf(mx, s[j]);
        const float mn = fmaxf(m, mx), corr = __expf(m - mn);
        l *= corr;
#pragma unroll
        for (int d = 0; d < 32; ++d) o[d] *= corr;
#pragma unroll
        for (int j = 0; j < 8; ++j) {
            const float pj = __expf(s[j] - mn); l += pj;
            const u32x4* vp = (const u32x4*)(Vp + (size_t)(kk0 + j) * ldkv + part * 32);
#pragma unroll
            for (int w = 0; w < 4; ++w) { float vf[8]; unpack8(vp[w], vf);
#pragma unroll
                for (int e = 0; e < 8; ++e) o[8 * w + e] = fmaf(pj, vf[e], o[8 * w + e]); }
        }
        m = mn;
    }
    const float inv = 1.f / l;
    u32x4* op = (u32x4*)(Op + (size_t)qi * ldo + part * 32);
#pragma unroll
    for (int w = 0; w < 4; ++w) { u32x4 ov; ov.x = pk2(o[8 * w] * inv, o[8 * w + 1] * inv); ov.y = pk2(o[8 * w + 2] * inv, o[8 * w + 3] * inv); ov.z = pk2(o[8 * w + 4] * inv, o[8 * w + 5] * inv); ov.w = pk2(o[8 * w + 6] * inv, o[8 * w + 7] * inv); op[w] = ov; }
}

__device__ __forceinline__ void gemm_branch(const bf16_t* __restrict__ Ob, const bf16_t* __restrict__ WT, const bf16_t* __restrict__ G, bf16_t* __restrict__ Mg, int gw, int NW, int lane) {
    const int r = lane & 15, q = lane >> 4;
    const int ntn = D / 32, ntiles = (T / 32) * ntn;
    for (int tile = gw; tile < ntiles; tile += NW) {
        const int tm = tile / ntn, tn = tile % ntn;
        f32x4 acc[3][2][2];
#pragma unroll
        for (int s = 0; s < 3; ++s)
#pragma unroll
            for (int i = 0; i < 2; ++i)
#pragma unroll
                for (int j = 0; j < 2; ++j) acc[s][i][j] = (f32x4){0.f, 0.f, 0.f, 0.f};
        const bf16_t* ap = Ob + (size_t)(tm * 32 + r) * D + q * 8;
        const bf16_t* bp = WT + (size_t)(tn * 32 + r) * D + q * 8;
#pragma unroll
        for (int s = 0; s < 3; ++s) {
            const int kb = s == 0 ? 0 : (s == 1 ? 1024 : 1536), ke = s == 0 ? 1024 : (s == 1 ? 1536 : 2048);
            for (int k0 = kb; k0 < ke; k0 += 32) {
                bf16x8 af[2], bfr[2];
#pragma unroll
                for (int i = 0; i < 2; ++i) af[i] = *(const bf16x8*)(ap + (size_t)i * 16 * D + k0);
#pragma unroll
                for (int j = 0; j < 2; ++j) bfr[j] = *(const bf16x8*)(bp + (size_t)j * 16 * D + k0);
#pragma unroll
                for (int i = 0; i < 2; ++i)
#pragma unroll
                    for (int j = 0; j < 2; ++j) acc[s][i][j] = __builtin_amdgcn_mfma_f32_16x16x32_bf16(af[i], bfr[j], acc[s][i][j], 0, 0, 0);
            }
        }
#pragma unroll
        for (int i = 0; i < 2; ++i)
#pragma unroll
            for (int j = 0; j < 2; ++j)
#pragma unroll
                for (int e = 0; e < 4; ++e) {
                    const int row = tm * 32 + i * 16 + q * 4 + e, col = tn * 32 + j * 16 + r;
                    const bf16_t* gp = G + (size_t)row * GW + col;
                    const float mval = bf2f(gp[0]) * acc[0][i][j][e] + bf2f(gp[2048]) * acc[1][i][j][e] + bf2f(gp[4096]) * acc[2][i][j][e];
                    Mg[(size_t)row * D + col] = (bf16_t)f2bf(mval);
                }
    }
}

__device__ __forceinline__ unsigned long long shfl_xor64(unsigned long long v, int m) {
    const unsigned lo = __shfl_xor((unsigned)v, m), hi = __shfl_xor((unsigned)(v >> 32), m);
    return ((unsigned long long)hi << 32) | lo;
}
__device__ __forceinline__ unsigned fkey(float f) { const unsigned u = __float_as_uint(f); return (u & 0x80000000u) ? ~u : (u | 0x80000000u); }
__device__ __forceinline__ float fkey_inv(unsigned k) { const unsigned u = (k & 0x80000000u) ? (k & 0x7fffffffu) : ~k; return __uint_as_float(u); }
__device__ __forceinline__ unsigned long long wave_max64(unsigned long long k) {
#pragma unroll
    for (int o = 1; o < 64; o <<= 1) { const unsigned long long t = shfl_xor64(k, o); k = t > k ? t : k; }
    return k;
}
__device__ __forceinline__ void route_unit(const Params& p, int t, int h, int lane) {
    const bf16_t* Q = (const bf16_t*)(p.ws + WS_Q); const bf16_t* KB = (const bf16_t*)(p.ws + WS_KEYSB);
    int* RIDX = (int*)(p.ws + WS_RIDX); float* RG = (float*)(p.ws + WS_RG);
    float sv_l[2] = {0.f, 0.f}; int si_l[2] = {0, 0};
#pragma unroll
    for (int c = 0; c < 2; ++c) {
        const bf16_t* qv = Q + (size_t)t * D + h * 256 + c * 128;
        const unsigned qw = ((const unsigned*)qv)[lane];
        const float qa = bf2f(qw & 0xffffu), qb = bf2f(qw >> 16);
        const bf16_t* k0p = KB + ((size_t)(h * 2 + c) * NKEYS + lane) * 128;
        const bf16_t* k1p = k0p + 64 * 128;
        float s0 = 0.f, s1 = 0.f;
#pragma unroll
        for (int w = 0; w < 16; ++w) {
            float k0f[8], k1f[8]; unpack8(((const u32x4*)k0p)[w], k0f); unpack8(((const u32x4*)k1p)[w], k1f);
#pragma unroll
            for (int e = 0; e < 8; e += 2) {
                const int src = 4 * w + e / 2;
                const float xa = __int_as_float(__builtin_amdgcn_readlane(__float_as_int(qa), src));
                const float xb = __int_as_float(__builtin_amdgcn_readlane(__float_as_int(qb), src));
                s0 = fmaf(xa, k0f[e], s0); s0 = fmaf(xb, k0f[e + 1], s0);
                s1 = fmaf(xa, k1f[e], s1); s1 = fmaf(xb, k1f[e + 1], s1);
            }
        }
        unsigned long long ka = ((unsigned long long)fkey(s0) << 32) | (unsigned)(255 - lane);
        unsigned long long kb = ((unsigned long long)fkey(s1) << 32) | (unsigned)(255 - (lane + 64));
        for (int rnd = 0; rnd < TOPK; ++rnd) {
            const unsigned long long best = wave_max64(ka > kb ? ka : kb);
            if (ka == best) ka = 0ull; if (kb == best) kb = 0ull;
            if (lane == rnd) { sv_l[c] = fkey_inv((unsigned)(best >> 32)); si_l[c] = 255 - (int)(best & 0xffffffffu); }
        }
    }
    unsigned long long kc[4];
#pragma unroll
    for (int m = 0; m < 4; ++m) { const int cid = lane + 64 * m, i = cid >> 4, j = cid & 15;
        const float v = __shfl(sv_l[0], i) + __shfl(sv_l[1], j);
        kc[m] = ((unsigned long long)fkey(v) << 32) | (unsigned)(1023 - cid); }
    float fv = 0.f; int cidx = 0;
    for (int rnd = 0; rnd < TOPK; ++rnd) {
        unsigned long long loc = kc[0] > kc[1] ? kc[0] : kc[1]; const unsigned long long loc2 = kc[2] > kc[3] ? kc[2] : kc[3]; loc = loc > loc2 ? loc : loc2;
        const unsigned long long best = wave_max64(loc);
#pragma unroll
        for (int m = 0; m < 4; ++m) if (kc[m] == best) kc[m] = 0ull;
        if (lane == rnd) { fv = fkey_inv((unsigned)(best >> 32)); cidx = 1023 - (int)(best & 0xffffffffu); }
    }
    const float fmax_ = __shfl(fv, 0);
    float e = lane < 16 ? __expf(fv - fmax_) : 0.f;
    float ssum = e;
#pragma unroll
    for (int o = 1; o < 16; o <<= 1) ssum += __shfl_xor(ssum, o);
    const int ci = cidx >> 4, cj = cidx & 15;
    const int e0 = __shfl(si_l[0], ci), e1 = __shfl(si_l[1], cj);
    if (lane < 16) { RIDX[(size_t)t * 128 + h * 16 + lane] = e0 * NKEYS + e1; RG[(size_t)t * 128 + h * 16 + lane] = e / ssum; }
}

typedef float f32x2 __attribute__((ext_vector_type(2)));
__device__ __forceinline__ void fp4_row_load(const float* __restrict__ src, const float* __restrict__ kscale, int lane, f32x4 (&v)[8]) {
#pragma unroll
    for (int j = 0; j < 8; ++j) { v[j] = ((const f32x4*)src)[64 * j + lane]; if (kscale) v[j] = v[j] * ((const f32x4*)kscale)[64 * j + lane]; }
}
__device__ __forceinline__ void fp4_row_finish(const f32x4 (&v)[8], unsigned char* __restrict__ tab, int e, float* __restrict__ scale_out, int lane) {
    float mx = 0.f;
#pragma unroll
    for (int j = 0; j < 8; ++j) mx = fmaxf(mx, fmaxf(fmaxf(fabsf(v[j].x), fabsf(v[j].y)), fmaxf(fabsf(v[j].z), fabsf(v[j].w))));
#pragma unroll
    for (int o = 1; o < 64; o <<= 1) mx = fmaxf(mx, __shfl_xor(mx, o));
    const float sc = mx > 0.f ? mx * (1.f / 6.f) : 1.f, inv = 1.f / sc;
#pragma unroll
    for (int j = 0; j < 8; ++j) {
        const f32x4 a = v[j] * inv;
        unsigned pk = 0u;
        pk = __builtin_amdgcn_cvt_scalef32_pk_fp4_f32(pk, fminf(fmaxf(a.x, -6.f), 6.f), fminf(fmaxf(a.y, -6.f), 6.f), 1.0f, 0);
        pk = __builtin_amdgcn_cvt_scalef32_pk_fp4_f32(pk, fminf(fmaxf(a.z, -6.f), 6.f), fminf(fmaxf(a.w, -6.f), 6.f), 1.0f, 1);
        *(unsigned short*)(tab + ((size_t)j * 16384 + e) * 128 + 2 * lane) = (unsigned short)pk;
    }
    if (lane == 0) *scale_out = sc;
}
__device__ __forceinline__ void fp4_tables(const Params& p, int gw, int NW, int lane) {
    f32x4 va[8], vb[8];
#define FP4_LOAD(r, v) do { if ((r) < 16384) fp4_row_load(p.in[25] + (size_t)(r) * D, p.in[22], lane, v); else fp4_row_load(p.in[26] + (size_t)((r) - 16384) * D, nullptr, lane, v); } while (0)
#define FP4_FIN(r, v) do { if ((r) < 16384) fp4_row_finish(v, p.ws + WS_TABU, (r), (float*)(p.ws + WS_SCU) + (r), lane); \
        else fp4_row_finish(v, p.ws + WS_TABV, (r) - 16384, (float*)(p.ws + WS_SCV) + ((r) - 16384), lane); } while (0)
    const int n = 2 * 16384;
    int r = gw;
    if (r < n) FP4_LOAD(r, va);
    for (; r < n; r += 2 * NW) {
        const bool hb = r + NW < n;
        if (hb) FP4_LOAD(r + NW, vb);
        FP4_FIN(r, va);
        if (r + 2 * NW < n) FP4_LOAD(r + 2 * NW, va);
        if (hb) FP4_FIN(r + NW, vb);
    }
#undef FP4_LOAD
#undef FP4_FIN
}
constexpr size_t WS_ZP = WS_Q;
constexpr size_t WS_X2F8 = 2 * MiB;
__device__ __forceinline__ float dot_chunk(const u32x4 w, const float (&xf)[32]) {
    float a0 = 0.f, a1 = 0.f;
#pragma unroll
    for (int q = 0; q < 4; ++q) {
        const f32x2 a = __builtin_amdgcn_cvt_scalef32_pk_f32_fp4(w[q], 1.0f, 0), b = __builtin_amdgcn_cvt_scalef32_pk_f32_fp4(w[q], 1.0f, 1);
        const f32x2 c = __builtin_amdgcn_cvt_scalef32_pk_f32_fp4(w[q], 1.0f, 2), d = __builtin_amdgcn_cvt_scalef32_pk_f32_fp4(w[q], 1.0f, 3);
        a0 = fmaf(a.x, xf[8 * q], a0); a1 = fmaf(a.y, xf[8 * q + 1], a1); a0 = fmaf(b.x, xf[8 * q + 2], a0); a1 = fmaf(b.y, xf[8 * q + 3], a1);
        a0 = fmaf(c.x, xf[8 * q + 4], a0); a1 = fmaf(c.y, xf[8 * q + 5], a1); a0 = fmaf(d.x, xf[8 * q + 6], a0); a1 = fmaf(d.y, xf[8 * q + 7], a1);
    }
    return a0 + a1;
}
__device__ __forceinline__ void axpy_chunk(const u32x4 w, const float a_, float (&of)[32]) {
#pragma unroll
    for (int q = 0; q < 4; ++q) {
        const f32x2 a = __builtin_amdgcn_cvt_scalef32_pk_f32_fp4(w[q], 1.0f, 0), b = __builtin_amdgcn_cvt_scalef32_pk_f32_fp4(w[q], 1.0f, 1);
        const f32x2 c = __builtin_amdgcn_cvt_scalef32_pk_f32_fp4(w[q], 1.0f, 2), d = __builtin_amdgcn_cvt_scalef32_pk_f32_fp4(w[q], 1.0f, 3);
        of[8 * q] = fmaf(a_, a.x, of[8 * q]); of[8 * q + 1] = fmaf(a_, a.y, of[8 * q + 1]); of[8 * q + 2] = fmaf(a_, b.x, of[8 * q + 2]); of[8 * q + 3] = fmaf(a_, b.y, of[8 * q + 3]);
        of[8 * q + 4] = fmaf(a_, c.x, of[8 * q + 4]); of[8 * q + 5] = fmaf(a_, c.y, of[8 * q + 5]); of[8 * q + 6] = fmaf(a_, d.x, of[8 * q + 6]); of[8 * q + 7] = fmaf(a_, d.y, of[8 * q + 7]);
    }
}
struct PeerTok { u32x4 w[16]; u32x4 x[4]; };
template <bool USTEP>
__device__ __forceinline__ void peer_issue(PeerTok& k, const Params& p, const unsigned char* tab, int t, int xv, int lane) {
    const int* RIDX = (const int*)(p.ws + WS_RIDX);
    const int i0 = RIDX[(size_t)t * 128 + lane], i1 = RIDX[(size_t)t * 128 + 64 + lane];
    const int es = lane >> 3, ck = lane & 7;
    if (USTEP) { const bf16_t* xp = (const bf16_t*)(p.ws + WS_X2BF) + (size_t)t * D + 256 * xv + 32 * ck;
#pragma unroll
        for (int j = 0; j < 4; ++j) k.x[j] = *(const u32x4*)(xp + 8 * j); }
#pragma unroll
    for (int g = 0; g < 16; ++g) { const int e = __shfl(g < 8 ? i0 : i1, (8 * g + es) & 63); k.w[g] = *(const u32x4*)(tab + (size_t)e * 128 + ck * 16); }
}
__device__ __forceinline__ void peer_u_finish(const PeerTok& k, const Params& p, int t, int xv, int lane) {
    const int es = lane >> 3, ck = lane & 7;
    float xf[32];
#pragma unroll
    for (int j = 0; j < 4; ++j) unpack8(k.x[j], xf + 8 * j);
    float zsel0 = 0.f, zsel1 = 0.f;
#pragma unroll
    for (int g = 0; g < 16; ++g) { u32x4 w_ = k.w[g]; asm volatile("" : "+v"(w_)); float d = dot_chunk(w_, xf);
        d += __int_as_float(__builtin_amdgcn_update_dpp(0, __float_as_int(d), 0xB1, 0xf, 0xf, true));
        d += __int_as_float(__builtin_amdgcn_update_dpp(0, __float_as_int(d), 0x4E, 0xf, 0xf, true));
        d += __int_as_float(__builtin_amdgcn_update_dpp(0, __float_as_int(d), 0x141, 0xf, 0xf, true));
        if (g < 8) { if (ck == g) zsel0 = d; } else { if (ck == g - 8) zsel1 = d; }
        asm volatile("" : "+v"(zsel0), "+v"(zsel1)); }
    float* zp = (float*)(p.ws + WS_ZP) + ((size_t)xv * T + t) * 128;
    zp[8 * ck + es] = zsel0; zp[64 + 8 * ck + es] = zsel1;
}
__device__ __forceinline__ void peer_v_finish(const PeerTok& k, const Params& p, int t, int xv, int lane, LAS float* red) {
    const float* RG = (const float*)(p.ws + WS_RG);
    const float a0 = RG[(size_t)t * 128 + lane], a1 = RG[(size_t)t * 128 + 64 + lane];
    const int es = lane >> 3, ck = lane & 7;
    float of[32];
#pragma unroll
    for (int q = 0; q < 32; ++q) of[q] = 0.f;
#pragma unroll
    for (int g = 0; g < 16; ++g) { const float a = __shfl(g < 8 ? a0 : a1, (8 * g + es) & 63); u32x4 w_ = k.w[g]; asm volatile("" : "+v"(w_)); axpy_chunk(w_, a, of);
        asm volatile("" : "+v"(of[0]), "+v"(of[1]), "+v"(of[2]), "+v"(of[3]), "+v"(of[4]), "+v"(of[5]), "+v"(of[6]), "+v"(of[7]), "+v"(of[8]), "+v"(of[9]), "+v"(of[10]), "+v"(of[11]), "+v"(of[12]), "+v"(of[13]), "+v"(of[14]), "+v"(of[15]));
        asm volatile("" : "+v"(of[16]), "+v"(of[17]), "+v"(of[18]), "+v"(of[19]), "+v"(of[20]), "+v"(of[21]), "+v"(of[22]), "+v"(of[23]), "+v"(of[24]), "+v"(of[25]), "+v"(of[26]), "+v"(of[27]), "+v"(of[28]), "+v"(of[29]), "+v"(of[30]), "+v"(of[31])); }
#pragma unroll
    for (int q = 0; q < 8; ++q) *(LAS f32x4*)(red + es * 256 + ck * 32 + 4 * q) = (f32x4){of[4 * q], of[4 * q + 1], of[4 * q + 2], of[4 * q + 3]};
    f32x4 s = *(const LAS f32x4*)(red + 4 * lane);
#pragma unroll
    for (int r = 1; r < 8; ++r) s = s + *(const LAS f32x4*)(red + r * 256 + 4 * lane);
    f32x4* o4 = (f32x4*)(p.out + (size_t)t * D + 256 * xv + 4 * lane);
    *o4 = *o4 + s;
}
template <bool USTEP>
__device__ __forceinline__ void peer_step(const Params& p, int lane, int wave, LAS float* red, int pos, int nx, int rank, int nloc) {
    for (int xv = pos; xv < 8; xv += nx) {
        const int wx = rank * 8 + wave, nwx = nloc * 8;
        const unsigned char* tab = p.ws + (USTEP ? WS_TABU : WS_TABV) + (size_t)xv * 16384 * 128;
        PeerTok A, B;
        int t = wx;
        if (t < T) peer_issue<USTEP>(A, p, tab, t, xv, lane);
#pragma unroll 1
        for (; t < T; t += 2 * nwx) {
            const bool hb = t + nwx < T;
            if (hb) peer_issue<USTEP>(B, p, tab, t + nwx, xv, lane);
            if (USTEP) peer_u_finish(A, p, t, xv, lane); else peer_v_finish(A, p, t, xv, lane, red);
            if (t + 2 * nwx < T) peer_issue<USTEP>(A, p, tab, t + 2 * nwx, xv, lane);
            if (hb) { if (USTEP) peer_u_finish(B, p, t + nwx, xv, lane); else peer_v_finish(B, p, t + nwx, xv, lane, red); }
        }
    }
}
typedef int v8i_p __attribute__((ext_vector_type(8))); typedef int v4i_t __attribute__((ext_vector_type(4)));
struct PeerTokU { u32x4 w[16]; u32x4 b[2][2]; };
__device__ __forceinline__ void peer_u_issue(PeerTokU& k, const Params& p, const unsigned char* tab, int t, int xv, int lane) {
    const int* RIDX = (const int*)(p.ws + WS_RIDX);
    const int i0 = RIDX[(size_t)t * 128 + lane], i1 = RIDX[(size_t)t * 128 + 64 + lane];
    const int es = lane >> 3, ck = lane & 7, q = lane >> 4;
    const unsigned char* xp = p.ws + WS_X2F8 + (size_t)t * D + 256 * xv + 16 * q;
#pragma unroll
    for (int kb = 0; kb < 2; ++kb) { k.b[kb][0] = *(const u32x4*)(xp + 128 * kb); k.b[kb][1] = *(const u32x4*)(xp + 128 * kb + 64); }
#pragma unroll
    for (int g = 0; g < 16; ++g) { const int e = __shfl(g < 8 ? i0 : i1, (8 * g + es) & 63); k.w[g] = *(const u32x4*)(tab + (size_t)e * 128 + ck * 16); }
}
__device__ __forceinline__ void peer_u_mfma(const PeerTokU& k, const Params& p, int t, int xv, int lane, LAS unsigned char* vl) {
    float* zp = (float*)(p.ws + WS_ZP) + ((size_t)xv * T + t) * 128;
    const int es = lane >> 3, ck = lane & 7, r16 = lane & 15, q = lane >> 4;
#pragma unroll
    for (int g = 0; g < 16; ++g) { const int row = 8 * g + es; *(LAS u32x4*)(vl + row * 128 + ((ck ^ (row & 7)) << 4)) = k.w[g]; }
    v8i_p b0, b1;
    { const v4i_t x0 = __builtin_bit_cast(v4i_t, k.b[0][0]), x1 = __builtin_bit_cast(v4i_t, k.b[0][1]), y0 = __builtin_bit_cast(v4i_t, k.b[1][0]), y1 = __builtin_bit_cast(v4i_t, k.b[1][1]);
      b0 = __builtin_shufflevector(x0, x1, 0, 1, 2, 3, 4, 5, 6, 7); b1 = __builtin_shufflevector(y0, y1, 0, 1, 2, 3, 4, 5, 6, 7); }
#pragma unroll
    for (int g = 0; g < 8; ++g) {
        const int row = 16 * g + r16;
        const v4i_t a0 = __builtin_bit_cast(v4i_t, *(const LAS u32x4*)(vl + row * 128 + ((q ^ (row & 7)) << 4)));
        const v4i_t a1 = __builtin_bit_cast(v4i_t, *(const LAS u32x4*)(vl + row * 128 + (((4 + q) ^ (row & 7)) << 4)));
        const v8i_p A0 = {a0[0], a0[1], a0[2], a0[3], 0, 0, 0, 0}, A1 = {a1[0], a1[1], a1[2], a1[3], 0, 0, 0, 0};
        f32x4 acc = {0.f, 0.f, 0.f, 0.f};
        acc = __builtin_amdgcn_mfma_scale_f32_16x16x128_f8f6f4(A0, b0, acc, 4, 0, 0, 0x7F7F7F7F, 0, 0x7F7F7F7F);
        acc = __builtin_amdgcn_mfma_scale_f32_16x16x128_f8f6f4(A1, b1, acc, 4, 0, 0, 0x7F7F7F7F, 0, 0x7F7F7F7F);
        if ((lane & 15) == 0) *(f32x4*)(zp + 16 * g + 4 * (lane >> 4)) = acc;
    }
}
__device__ __forceinline__ void peer_u_step(const Params& p, int lane, int wave, LAS unsigned char* vl, int pos, int nx, int rank, int nloc) {
    for (int xv = pos; xv < 8; xv += nx) {
        const int wx = rank * 8 + wave, nwx = nloc * 8;
        const unsigned char* tab = p.ws + WS_TABU + (size_t)xv * 16384 * 128;
        PeerTokU A, B;
        int t = wx;
        if (t < T) peer_u_issue(A, p, tab, t, xv, lane);
#pragma unroll 1
        for (; t < T; t += 2 * nwx) {
            const bool hb = t + nwx < T;
            if (hb) peer_u_issue(B, p, tab, t + nwx, xv, lane);
            peer_u_mfma(A, p, t, xv, lane, vl);
            if (t + 2 * nwx < T) peer_u_issue(A, p, tab, t + 2 * nwx, xv, lane);
            if (hb) peer_u_mfma(B, p, t + nwx, xv, lane, vl);
        }
    }
}
constexpr size_t WS_ACT8 = 34 * MiB, WS_ASC = 36 * MiB;
__device__ __forceinline__ void peer_combine(const Params& p, int t, int lane) {
    const float* ZP = (const float*)(p.ws + WS_ZP); const int* RIDX = (const int*)(p.ws + WS_RIDX); const float* RG = (const float*)(p.ws + WS_RG);
    const float* SCU = (const float*)(p.ws + WS_SCU); const float* SCV = (const float*)(p.ws + WS_SCV); const float* SS2 = (const float*)(p.ws + WS_CTL + CTL_SS2_BYTE);
    const float rs = rsqrtf(SS2[t] * (1.f / D) + EPS);
    float act[2];
#pragma unroll
    for (int hlf = 0; hlf < 2; ++hlf) { const size_t o = (size_t)t * 128 + 64 * hlf + lane; float z = 0.f;
#pragma unroll
        for (int x = 0; x < 8; ++x) z += ZP[((size_t)x * T) * 128 + o];
        const int e = RIDX[o];
        act[hlf] = gelu_tanh(z * rs * SCU[e]) * RG[o] * SCV[e]; }
    float mx = fmaxf(fabsf(act[0]), fabsf(act[1]));
#pragma unroll
    for (int o = 1; o < 64; o <<= 1) mx = fmaxf(mx, __shfl_xor(mx, o));
    const float sc = mx > 0.f ? mx * (1.f / 448.f) : 1.f, inv = 1.f / sc;
    unsigned char* a8 = p.ws + WS_ACT8 + (size_t)t * 128;
    a8[lane] = (unsigned char)(__builtin_amdgcn_cvt_pk_fp8_f32(act[0] * inv, 0.f, 0, false) & 0xff);
    a8[64 + lane] = (unsigned char)(__builtin_amdgcn_cvt_pk_fp8_f32(act[1] * inv, 0.f, 0, false) & 0xff);
    if (lane == 0) ((float*)(p.ws + WS_ASC))[t] = sc;
}
typedef int v2i_t __attribute__((ext_vector_type(2)));
struct PeerTokV { u32x4 w[16]; u32x4 b[2]; };
__device__ __forceinline__ void peer_v_issue(PeerTokV& k, const Params& p, const unsigned char* tab, int t, int lane) {
    const int* RIDX = (const int*)(p.ws + WS_RIDX);
    const int i0 = RIDX[(size_t)t * 128 + lane], i1 = RIDX[(size_t)t * 128 + 64 + lane];
    const int es = lane >> 3, ck = lane & 7, q = lane >> 4;
    const unsigned char* ap = p.ws + WS_ACT8 + (size_t)t * 128 + 16 * q;
    k.b[0] = *(const u32x4*)ap; k.b[1] = *(const u32x4*)(ap + 64);
#pragma unroll
    for (int g = 0; g < 16; ++g) { const int e = __shfl(g < 8 ? i0 : i1, (8 * g + es) & 63); k.w[g] = *(const u32x4*)(tab + (size_t)e * 128 + ck * 16); }
}
__device__ __forceinline__ void peer_v_mfma(const PeerTokV& k, const Params& p, int t, int xv, int lane, LAS unsigned char* vl) {
    const int es = lane >> 3, ck = lane & 7, n = lane & 15, q = lane >> 4;
#pragma unroll
    for (int g = 0; g < 16; ++g) { const int row = 8 * g + es; *(LAS u32x4*)(vl + row * 128 + ((ck ^ (row & 7)) << 4)) = k.w[g]; }
    const v4i_t x0 = __builtin_bit_cast(v4i_t, k.b[0]), x1 = __builtin_bit_cast(v4i_t, k.b[1]);
    const v8i_p bop = __builtin_shufflevector(x0, x1, 0, 1, 2, 3, 4, 5, 6, 7);
    const int r1 = 32 * q + n, r2 = r1 + 16;
    f32x4 keep = {0.f, 0.f, 0.f, 0.f};
#pragma unroll
    for (int mb = 0; mb < 16; ++mb) {
        const v2i_t t1 = __builtin_amdgcn_ds_read_tr4_b64_v2i32((LAS v2i_t*)(vl + r1 * 128 + ((((mb >> 1) ^ (r1 & 7)) << 4) | ((mb & 1) << 3))));
        const v2i_t t2 = __builtin_amdgcn_ds_read_tr4_b64_v2i32((LAS v2i_t*)(vl + r2 * 128 + ((((mb >> 1) ^ (r2 & 7)) << 4) | ((mb & 1) << 3))));
        const v8i_p aop = {t1[0], t1[1], t2[0], t2[1], 0, 0, 0, 0};
        f32x4 acc = {0.f, 0.f, 0.f, 0.f};
        acc = __builtin_amdgcn_mfma_scale_f32_16x16x128_f8f6f4(aop, bop, acc, 4, 0, 0, 0x7F7F7F7F, 0, 0x7F7F7F7F);
        if (n == mb) keep = acc;
    }
    const float sc = ((const float*)(p.ws + WS_ASC))[t];
    const size_t oo = (size_t)t * D + 256 * xv + 16 * n + 4 * q;
    const u32x2 xw = *(const u32x2*)((const bf16_t*)(p.ws + WS_X2BF) + oo);
    const f32x4 x2v = {__uint_as_float(xw.x << 16), __uint_as_float(xw.x & 0xffff0000u), __uint_as_float(xw.y << 16), __uint_as_float(xw.y & 0xffff0000u)};
    *(f32x4*)(p.out + oo) = x2v + keep * sc;
}
__device__ __forceinline__ void peer_v_step(const Params& p, int lane, int wave, LAS unsigned char* vl, int pos, int nx, int rank, int nloc) {
    for (int xv = pos; xv < 8; xv += nx) {
        const int wx = rank * 8 + wave, nwx = nloc * 8;
        const unsigned char* tab = p.ws + WS_TABV + (size_t)xv * 16384 * 128;
        PeerTokV A, B;
        int t = wx;
        if (t < T) peer_v_issue(A, p, tab, t, lane);
#pragma unroll 1
        for (; t < T; t += 2 * nwx) {
            const bool hb = t + nwx < T;
            if (hb) peer_v_issue(B, p, tab, t + nwx, lane);
            peer_v_mfma(A, p, t, xv, lane, vl);
            if (t + 2 * nwx < T) peer_v_issue(A, p, tab, t + 2 * nwx, lane);
            if (hb) peer_v_mfma(B, p, t + nwx, xv, lane, vl);
        }
    }
}

namespace pg8 {
#define PG8_LAS __attribute__((address_space(3)))
constexpr int BM = 256, BK = 64, HALF = 128, HTB = HALF * BK * 2, STAGE_BYTES = 8 * HTB, NXCD = 8, WGM = 1;
__host__ __device__ __forceinline__ int lds_byte(int r, int c) { const int st = (r >> 4) * 2 + (c >> 5), rr = r & 15, cc = c & 31, ob = rr * 64 + cc * 2; return st * 1024 + (ob ^ (((ob >> 9) & 1) << 5)); }
__host__ __device__ __forceinline__ void stage_rc(int b, int& R, int& C) { const int st = b / 1024, sb = b % 1024, swz = sb ^ (((sb >> 9) & 1) << 5); R = (st >> 1) * 16 + swz / 64; C = (st & 1) * 32 + (swz % 64) / 2; }
__host__ __device__ __forceinline__ int perm32(int rho) { const int n = rho >> 4, i = rho & 15; return 8 * (i >> 2) + 4 * n + (i & 3); }
struct Unit { const char* A; const char* B; int pm, pn, kind, nt; };
__device__ __forceinline__ const char* uni_ptr(const char* p) { const unsigned long long v = (unsigned long long)p; const unsigned lo = __builtin_amdgcn_readfirstlane((unsigned)v), hi = __builtin_amdgcn_readfirstlane((unsigned)(v >> 32)); return (const char*)(((unsigned long long)hi << 32) | lo); }
__device__ __forceinline__ void uni(Unit& u) { u.A = uni_ptr(u.A); u.B = uni_ptr(u.B); u.pm = __builtin_amdgcn_readfirstlane(u.pm); u.pn = __builtin_amdgcn_readfirstlane(u.pn); u.kind = __builtin_amdgcn_readfirstlane(u.kind); u.nt = __builtin_amdgcn_readfirstlane(u.nt); }
template <int WG = WGM>
__device__ __forceinline__ void tile_of(int L, int nM, int nN, int& pm, int& pn) {
    const int nwg = nM * nN; int wgid = L; { const int q = nwg / NXCD, r = nwg % NXCD, xcd = wgid % NXCD, off = wgid / NXCD; wgid = (xcd < r ? xcd * (q + 1) : r * (q + 1) + (xcd - r) * q) + off; }
    const int nig = WG * nN, gid = wgid / nig, fm = gid * WG, gsz = (nM - fm) < WG ? (nM - fm) : WG;
    pm = fm + ((wgid % nig) % gsz); pn = (wgid % nig) / gsz;
}
typedef int v8i_t __attribute__((ext_vector_type(8))); typedef int v4i_t __attribute__((ext_vector_type(4)));
__device__ __forceinline__ v8i_t cat8(const bf16x8 lo, const bf16x8 hi) { const v4i_t a = __builtin_bit_cast(v4i_t, lo), b = __builtin_bit_cast(v4i_t, hi); return __builtin_shufflevector(a, b, 0, 1, 2, 3, 4, 5, 6, 7); }
template <bool FP8, class Epi, class Sched>
__device__ __forceinline__ void gemm_phase(PG8_LAS unsigned char* lds, const int lda, const int ldb, const Sched& S, const Epi& E) {
    const int tid = threadIdx.x, wid = __builtin_amdgcn_readfirstlane(tid >> 6), lane = tid & 63, wr = wid >> 2, wc = wid & 3, fr = lane & 15, fq = lane >> 4;
    unsigned voffA[2], voffB[2];
#pragma unroll
    for (int i = 0; i < 2; ++i) { int R, C; stage_rc(tid * 16 + i * 8192, R, C); const int Rb = (R & ~31) + perm32(R & 31);
        voffA[i] = (unsigned)(R * lda + C) * 2u; voffB[i] = (unsigned)(Rb * ldb + C) * 2u; }
    const size_t kstep = (size_t)(BK * 2);
    const size_t hstepA = (size_t)HALF * lda * 2, hstepB = (size_t)HALF * ldb * 2;
    const unsigned ldsw = (unsigned)wid * 1024u;
    const int aoff = lds_byte(wr * 64 + fr, fq * 8), boff = lds_byte(wc * 32 + fr, fq * 8);
#define PG8_SA(b, h) (((b) * 2 + (h)) * HTB)
#define PG8_SB(b, h) ((4 + (b) * 2 + (h)) * HTB)
#define PG8_STAGE(bufoff, gbase, voff) do { _Pragma("unroll") for (int _i = 0; _i < 2; ++_i) \
        __builtin_amdgcn_global_load_lds((const unsigned*)((const char*)(gbase) + (voff)[_i]), (PG8_LAS unsigned*)(lds + (bufoff) + ldsw + _i * 8192), 16, 0, 0); } while (0)
#define PG8_LDA(dst, b, h) do { _Pragma("unroll") for (int m = 0; m < 4; ++m) { if constexpr (FP8) dst##8[m] = cat8(*(const PG8_LAS bf16x8*)(lds + PG8_SA(b, h) + aoff + m * 2048), *(const PG8_LAS bf16x8*)(lds + PG8_SA(b, h) + aoff + m * 2048 + 1024)); \
        else { _Pragma("unroll") for (int k = 0; k < 2; ++k) dst[m][k] = *(const PG8_LAS bf16x8*)(lds + PG8_SA(b, h) + aoff + m * 2048 + k * 1024); } } } while (0)
#define PG8_LDB(dst, b, h) do { _Pragma("unroll") for (int n = 0; n < 2; ++n) { if constexpr (FP8) dst##8[n] = cat8(*(const PG8_LAS bf16x8*)(lds + PG8_SB(b, h) + boff + n * 2048), *(const PG8_LAS bf16x8*)(lds + PG8_SB(b, h) + boff + n * 2048 + 1024)); \
        else { _Pragma("unroll") for (int k = 0; k < 2; ++k) dst[n][k] = *(const PG8_LAS bf16x8*)(lds + PG8_SB(b, h) + boff + n * 2048 + k * 1024); } } } while (0)
#define PG8_MMA(ai, bj, At, Bt) do { __builtin_amdgcn_s_setprio(1); \
        if constexpr (FP8) { _Pragma("unroll") for (int m = 0; m < 4; ++m) _Pragma("unroll") for (int n = 0; n < 2; ++n) \
            asm volatile("v_mfma_scale_f32_16x16x128_f8f6f4 %0, %1, %2, %0, %3, %3 op_sel_hi:[0,0,0]" : "+v"(acc[ai][bj][m][n]) : "v"(Bt##8[n]), "v"(At##8[m]), "v"(mxone)); } \
        else { _Pragma("unroll") for (int m = 0; m < 4; ++m) _Pragma("unroll") for (int n = 0; n < 2; ++n) _Pragma("unroll") for (int k = 0; k < 2; ++k) \
            acc[ai][bj][m][n] = __builtin_amdgcn_mfma_f32_16x16x32_bf16(Bt[n][k], At[m][k], acc[ai][bj][m][n], 0, 0, 0); } \
        __builtin_amdgcn_s_setprio(0); } while (0)
#define PG8_WAIT_V(n) asm volatile("s_waitcnt vmcnt(" #n ")" ::: "memory")
#define PG8_WAIT_L(n) asm volatile("s_waitcnt lgkmcnt(" #n ")" ::: "memory")
#define PG8_BAR __builtin_amdgcn_s_barrier()
#define PG8_SCHED __builtin_amdgcn_sched_barrier(0)
    Unit cur, nxt; int ui = 0;
    if (!S.next(0, cur)) return;
    f32x4 acc[2][2][4][2];
#pragma unroll
    for (int a = 0; a < 2; ++a)
#pragma unroll
        for (int b = 0; b < 2; ++b)
#pragma unroll
            for (int m = 0; m < 4; ++m)
#pragma unroll
                for (int n = 0; n < 2; ++n) acc[a][b][m][n] = (f32x4){0.f, 0.f, 0.f, 0.f};
    const int mxone = 0x7F7F7F7F;
    bf16x8 At[4][2], B0[2][2], B1[2][2]; v8i_t At8[4], B08[2], B18[2];
    const char* cA = cur.A; const char* cB = cur.B;
    PG8_STAGE(PG8_SB(0, 0), cB, voffB); PG8_STAGE(PG8_SB(0, 1), cB + hstepB, voffB); PG8_STAGE(PG8_SA(0, 0), cA, voffA); PG8_STAGE(PG8_SA(0, 1), cA + hstepA, voffA);
    if (wr == 1) PG8_BAR;
    PG8_WAIT_V(2); PG8_BAR;
    PG8_STAGE(PG8_SB(1, 0), cB + kstep, voffB); PG8_STAGE(PG8_SA(1, 0), cA + kstep, voffA); PG8_STAGE(PG8_SB(1, 1), cB + hstepB + kstep, voffB);
    PG8_WAIT_V(6); PG8_BAR;
    for (;;) {
        const bool has_next = S.next(ui + 1, nxt);
        const char* nA = has_next ? nxt.A : cA; const char* nB = has_next ? nxt.B : cB;
        const int nt = cur.nt;
        for (int t = 0; t < nt; t += 2) {
            const bool last = (t == nt - 2);
            const char* a1 = cA + (size_t)(t + 1) * kstep;
            const char* a2 = last ? nA : cA + (size_t)(t + 2) * kstep; const char* b2 = last ? nB : cB + (size_t)(t + 2) * kstep;
            const char* a3 = a2 + kstep; const char* b3 = b2 + kstep;
            PG8_LDB(B0, 0, 0); PG8_LDB(B1, 0, 1); PG8_SCHED; PG8_LDA(At, 0, 0); PG8_STAGE(PG8_SA(1, 1), a1 + hstepA, voffA);
            PG8_WAIT_V(8); PG8_WAIT_L(0); PG8_BAR; PG8_MMA(0, 0, At, B0); PG8_MMA(0, 1, At, B1); PG8_BAR; PG8_SCHED;
            PG8_LDA(At, 0, 1); PG8_STAGE(PG8_SB(0, 0), b2, voffB); PG8_STAGE(PG8_SB(0, 1), b2 + hstepB, voffB); PG8_STAGE(PG8_SA(0, 0), a2, voffA);
            PG8_WAIT_V(8); PG8_WAIT_L(0); PG8_BAR; PG8_MMA(1, 0, At, B0); PG8_MMA(1, 1, At, B1); PG8_BAR; PG8_SCHED;
            PG8_LDB(B0, 1, 0); PG8_LDB(B1, 1, 1); PG8_SCHED; PG8_LDA(At, 1, 0); PG8_STAGE(PG8_SA(0, 1), a2 + hstepA, voffA);
            PG8_WAIT_V(8); PG8_WAIT_L(0); PG8_BAR; PG8_MMA(0, 0, At, B0); PG8_MMA(0, 1, At, B1); PG8_BAR; PG8_SCHED;
            PG8_LDA(At, 1, 1); PG8_STAGE(PG8_SB(1, 0), b3, voffB); PG8_STAGE(PG8_SB(1, 1), b3 + hstepB, voffB); PG8_STAGE(PG8_SA(1, 0), a3, voffA);
            PG8_WAIT_V(8); PG8_WAIT_L(0); PG8_BAR; PG8_MMA(1, 0, At, B0); PG8_MMA(1, 1, At, B1); PG8_BAR; PG8_SCHED;
        }
        if (wr == 0) PG8_BAR;
        if constexpr (FP8) asm volatile("s_nop 15\n\ts_nop 15" ::: "memory");
        E(acc, cur, wr, wc, fr, fq);
        if (!has_next) break;
        if (E.reset(cur)) {
#pragma unroll
        for (int a = 0; a < 2; ++a)
#pragma unroll
            for (int b = 0; b < 2; ++b)
#pragma unroll
                for (int m = 0; m < 4; ++m)
#pragma unroll
                    for (int n = 0; n < 2; ++n) acc[a][b][m][n] = (f32x4){0.f, 0.f, 0.f, 0.f};
        }
        cur = nxt; cA = nA; cB = nB; ++ui;
        if (wr == 1) PG8_BAR;
    }
    PG8_WAIT_V(0);
    PG8_BAR;
#undef PG8_SA
#undef PG8_SB
#undef PG8_STAGE
#undef PG8_LDA
#undef PG8_LDB
#undef PG8_MMA
#undef PG8_WAIT_V
#undef PG8_WAIT_L
#undef PG8_BAR
#undef PG8_SCHED
}
}
typedef f32x4 AccT[2][2][4][2];
#define EPI_RESET_ALWAYS __device__ __forceinline__ bool reset(const pg8::Unit&) const { return true; }
__device__ __forceinline__ unsigned cvt_pk_bf16(float lo, float hi) { unsigned r; asm volatile("v_cvt_pk_bf16_f32 %0, %1, %2" : "=v"(r) : "v"(lo), "v"(hi)); return r; }
__device__ __forceinline__ u32x4 pack8(const f32x4 v0, const f32x4 v1) { u32x4 w; w.x = cvt_pk_bf16(v0[0], v0[1]); w.y = cvt_pk_bf16(v0[2], v0[3]); w.z = cvt_pk_bf16(v1[0], v1[1]); w.w = cvt_pk_bf16(v1[2], v1[3]); return w; }
template <int MODE>
__device__ __forceinline__ void store_tile_bf16(const AccT& acc, bf16_t* base, int ldc, int row0, int col0, const float* bias, const float ascale = 1.f) {
#pragma unroll
    for (int ai = 0; ai < 2; ++ai)
#pragma unroll
        for (int m = 0; m < 4; ++m) { bf16_t* rowp = base + (size_t)(row0 + ai * 128 + m * 16) * ldc + col0;
#pragma unroll
            for (int bj = 0; bj < 2; ++bj) { f32x4 v0 = acc[ai][bj][m][0], v1 = acc[ai][bj][m][1];
                if (MODE == 1) { _Pragma("unroll") for (int e = 0; e < 4; ++e) { v0[e] = gelu_tanh(v0[e]); v1[e] = gelu_tanh(v1[e]); } }
                if (MODE == 2) { const f32x4 b0 = *(const f32x4*)(bias + col0 + bj * 128), b1 = *(const f32x4*)(bias + col0 + bj * 128 + 4);
                    v0 = v0 * ascale + b0; v1 = v1 * ascale + b1; _Pragma("unroll") for (int e = 0; e < 4; ++e) { v0[e] = sigmoid_(v0[e]); v1[e] = sigmoid_(v1[e]); } }
                *(u32x4*)(rowp + bj * 128) = pack8(v0, v1); }
            if (MODE == 2) asm volatile("" ::: "memory"); }
}
struct SchedP1a { const char* H; const char* WT; const char* MEMN; const char* WTM; int G, c;
    __device__ __forceinline__ bool next(int i, pg8::Unit& u) const {
        const int L = i * G + c; const int n1 = 64 * 18;
        if (L < n1) { pg8::tile_of(L, 64, 18, u.pm, u.pn); u.kind = 0; u.A = H + (size_t)u.pm * 256 * D * 2; u.B = WT + (size_t)u.pn * 256 * D * 2; u.nt = D / 64; pg8::uni(u); return true; }
        if (L < n1 + 8) { const int j = L - n1; u.pm = j >> 2; u.pn = j & 3; u.kind = 1; u.A = MEMN + (size_t)u.pm * 256 * D * 2; u.B = WTM + (size_t)u.pn * 256 * D * 2; u.nt = D / 64; pg8::uni(u); return true; }
        return false; } };
struct EpiP1a { bf16_t* PROJ; bf16_t* MEMKV; EPI_RESET_ALWAYS
    __device__ __forceinline__ void operator()(AccT& acc, const pg8::Unit& u, int wr, int wc, int fr, int fq) const {
        const int row0 = u.pm * 256 + wr * 64 + fr, cl = wc * 32 + 8 * fq;
        if (u.kind == 1) { store_tile_bf16<0>(acc, MEMKV, 2 * CW, row0, u.pn * 256 + cl, nullptr); return; }
        if (u.pn == 14 || u.pn == 15) { store_tile_bf16<1>(acc, PROJ, INW, row0, u.pn * 256 + cl, nullptr); return; }
        store_tile_bf16<0>(acc, PROJ, INW, row0, u.pn * 256 + cl, nullptr);
    } };
struct SchedP1b { const char* H8; const char* WT8; int G, c;
    __device__ __forceinline__ bool next(int i, pg8::Unit& u) const {
        const int L = i * G + c; if (L >= 64 * 24) return false;
        pg8::tile_of(L, 64, 24, u.pm, u.pn); u.kind = 0; u.A = H8 + (size_t)u.pm * 256 * D; u.B = WT8 + (size_t)u.pn * 256 * D; u.nt = D / 128; pg8::uni(u); return true; } };
struct EpiP1b { bf16_t* G; const float* bgate; EPI_RESET_ALWAYS
    __device__ __forceinline__ void operator()(AccT& acc, const pg8::Unit& u, int wr, int wc, int fr, int fq) const {
        store_tile_bf16<2>(acc, G, GW, u.pm * 256 + wr * 64 + fr, u.pn * 256 + wc * 32 + 8 * fq, bgate, 1.f / GATE_WSCALE);
    } };
struct SchedP3 { const char* O; const char* WT; int G, c;
    __device__ __forceinline__ bool next(int i, pg8::Unit& u) const {
        const int ti = i / 3, seg = i - 3 * ti; const int L = ti * G + c; if (L >= 64 * 8) return false;
        pg8::tile_of(L, 64, 8, u.pm, u.pn); u.kind = seg;
        const int kb = seg == 0 ? 0 : (seg == 1 ? 1024 : 1536);
        u.A = O + ((size_t)u.pm * 256 * D + kb) * 2; u.B = WT + ((size_t)u.pn * 256 * D + kb) * 2; u.nt = seg == 0 ? 16 : 8; pg8::uni(u); return true; } };
struct EpiP3 { const bf16_t* G; bf16_t* MERGED;
    __device__ __forceinline__ bool reset(const pg8::Unit& u) const { return u.kind == 2; }
    __device__ __forceinline__ void operator()(AccT& acc, const pg8::Unit& u, int wr, int wc, int fr, int fq) const {
        const int row0 = u.pm * 256 + wr * 64 + fr, col0 = u.pn * 256 + wc * 32 + 8 * fq, seg = u.kind;
#pragma unroll
        for (int ai = 0; ai < 2; ++ai)
#pragma unroll
            for (int mh = 0; mh < 2; ++mh) {
                u32x4 ga[2][2], gb[2][2];
#pragma unroll
                for (int mm = 0; mm < 2; ++mm)
#pragma unroll
                    for (int bj = 0; bj < 2; ++bj) { const bf16_t* gp = G + (size_t)(row0 + ai * 128 + (mh * 2 + mm) * 16) * GW + col0 + bj * 128;
                        ga[mm][bj] = *(const u32x4*)(gp + seg * D); gb[mm][bj] = (seg < 2) ? *(const u32x4*)(gp + (seg + 1) * D) : (u32x4){0u, 0u, 0u, 0u}; }
#pragma unroll
                for (int mm = 0; mm < 2; ++mm)
#pragma unroll
                    for (int bj = 0; bj < 2; ++bj) { const int m = mh * 2 + mm;
                        float fa[8], fb[8]; unpack8(ga[mm][bj], fa); unpack8(gb[mm][bj], fb);
                        if (seg < 2) { _Pragma("unroll") for (int e = 0; e < 8; ++e) fa[e] = fa[e] * __builtin_amdgcn_rcpf(fmaxf(fb[e], 1e-20f)); }
                        f32x4& v0 = acc[ai][bj][m][0]; f32x4& v1 = acc[ai][bj][m][1];
                        v0[0] *= fa[0]; v0[1] *= fa[1]; v0[2] *= fa[2]; v0[3] *= fa[3]; v1[0] *= fa[4]; v1[1] *= fa[5]; v1[2] *= fa[6]; v1[3] *= fa[7];
                        if (seg == 2) *(u32x4*)(MERGED + (size_t)(row0 + ai * 128 + m * 16) * D + col0 + bj * 128) = pack8(v0, v1);
                    }
                asm volatile("" ::: "memory");
            }
    } };
struct SchedSq { const char* A; const char* WT; int G, c;
    __device__ __forceinline__ bool next(int i, pg8::Unit& u) const {
        const int L = i * G + c; if (L >= 64 * 8) return false;
        pg8::tile_of(L, 64, 8, u.pm, u.pn); u.kind = 0; u.A = A + (size_t)u.pm * 256 * D * 2; u.B = WT + (size_t)u.pn * 256 * D * 2; u.nt = D / 64; pg8::uni(u); return true; } };
struct EpiP4 { const float* x; float* out; bf16_t* xb; float* ss; unsigned char* x8; EPI_RESET_ALWAYS
    __device__ __forceinline__ void operator()(AccT& acc, const pg8::Unit& u, int wr, int wc, int fr, int fq) const {
        const int row0 = u.pm * 256 + wr * 64 + fr, col0 = u.pn * 256 + wc * 32 + 8 * fq;
#pragma unroll
        for (int ai = 0; ai < 2; ++ai)
#pragma unroll
            for (int m = 0; m < 4; ++m) { const size_t row = (size_t)(row0 + ai * 128 + m * 16); float sq = 0.f;
#pragma unroll
                for (int bj = 0; bj < 2; ++bj) { const size_t o = row * D + col0 + bj * 128;
                    const f32x4 v0 = acc[ai][bj][m][0] + *(const f32x4*)(x + o), v1 = acc[ai][bj][m][1] + *(const f32x4*)(x + o + 4);
                    *(u32x4*)(xb + o) = pack8(v0, v1);
#define F8X(x_) fminf(fmaxf((x_), -448.f), 448.f)
                    { int w0 = __builtin_amdgcn_cvt_pk_fp8_f32(F8X(v0[0]), F8X(v0[1]), 0, false); w0 = __builtin_amdgcn_cvt_pk_fp8_f32(F8X(v0[2]), F8X(v0[3]), w0, true);
                      int w1 = __builtin_amdgcn_cvt_pk_fp8_f32(F8X(v1[0]), F8X(v1[1]), 0, false); w1 = __builtin_amdgcn_cvt_pk_fp8_f32(F8X(v1[2]), F8X(v1[3]), w1, true);
                      *(u32x2*)(x8 + o) = (u32x2){(unsigned)w0, (unsigned)w1}; }
                    sq += (v0[0] * v0[0] + v0[1] * v0[1]) + (v0[2] * v0[2] + v0[3] * v0[3]) + (v1[0] * v1[0] + v1[1] * v1[1]) + (v1[2] * v1[2] + v1[3] * v1[3]); }
                sq += __shfl_xor(sq, 16); sq += __shfl_xor(sq, 32);
                if (fq == 0) atomicAdd(ss + row, sq); }
    } };
struct EpiP5 { bf16_t* Q; const float* ss; EPI_RESET_ALWAYS
    __device__ __forceinline__ void operator()(AccT& acc, const pg8::Unit& u, int wr, int wc, int fr, int fq) const {
        const int row0 = u.pm * 256 + wr * 64 + fr, col0 = u.pn * 256 + wc * 32 + 8 * fq;
#pragma unroll
        for (int ai = 0; ai < 2; ++ai)
#pragma unroll
            for (int m = 0; m < 4; ++m) { const size_t row = (size_t)(row0 + ai * 128 + m * 16); const float rs = rsqrtf(ss[row] * (1.f / D) + EPS);
#pragma unroll
                for (int bj = 0; bj < 2; ++bj) *(u32x4*)(Q + row * D + col0 + bj * 128) = pack8(acc[ai][bj][m][0] * rs, acc[ai][bj][m][1] * rs); }
    } };


namespace att {
using s16x4  = __attribute__((ext_vector_type(4))) short;
using f32x16 = __attribute__((ext_vector_type(16))) float;
constexpr int NWV = 8, QBLK = 32, KVBLK = 64, DH = 128;
constexpr float THR = 8.f;
constexpr int SHM_V = KVBLK * DH * 2, SHM_K = KVBLK * DH * 2;
constexpr int OFF_WS = 2 * SHM_V + 2 * SHM_K, OFF_BT = OFF_WS + NWV * 64 * 4, OFF_OST = OFF_BT + 1536, LDS_NEED = OFF_OST + NWV * 8192;
#define KSWZ(row, colB) ((row) * 256 + ((colB) ^ (((row) & 7) << 4)))
#define SBAR() __builtin_amdgcn_sched_barrier(0)
__device__ __forceinline__ int crow(int r, int hi) { return (r & 3) + 8 * (r >> 2) + 4 * hi; }
__device__ __forceinline__ unsigned cvtpk(float lo, float hi) { unsigned r; asm volatile("v_cvt_pk_bf16_f32 %0, %1, %2" : "=v"(r) : "v"(lo), "v"(hi)); return r; }
__device__ __forceinline__ void partialSM(f32x16& p0, f32x16& p1, float& m_reg, float& mn, float& alpha) {
  constexpr float C = 1.4426950408889634f;
  float pmax = p0[0];
#pragma unroll
  for (int r = 1; r < 16; ++r) pmax = fmaxf(pmax, p0[r]);
#pragma unroll
  for (int r = 0; r < 16; ++r) pmax = fmaxf(pmax, p1[r]);
  { auto rr = __builtin_amdgcn_permlane32_swap(__float_as_uint(pmax), __float_as_uint(pmax), false, false);
    pmax = fmaxf(__uint_as_float(rr[0]), __uint_as_float(rr[1])); }
  if (__builtin_expect(__all(pmax - m_reg <= THR), 1)) { mn = m_reg; alpha = 1.f; }
  else { mn = fmaxf(m_reg, pmax); alpha = __builtin_amdgcn_exp2f((m_reg - mn) * C); m_reg = mn; }
  float mnC = -mn * C;
#pragma unroll
  for (int r = 0; r < 16; ++r) p0[r] = fmaf(p0[r], C, mnC);
#pragma unroll
  for (int r = 0; r < 16; ++r) p1[r] = fmaf(p1[r], C, mnC);
#pragma unroll
  for (int r = 0; r < 16; ++r) p0[r] = __builtin_amdgcn_exp2f(p0[r]);
}
__device__ __forceinline__ void finishSM(f32x16& p0, f32x16& p1, float alpha, float& l_reg, bf16x8& pa0, bf16x8& pa1, bf16x8& pa2, bf16x8& pa3) {
#pragma unroll
  for (int r = 0; r < 16; ++r) p1[r] = __builtin_amdgcn_exp2f(p1[r]);
  float ps = 0;
#pragma unroll
  for (int r = 0; r < 16; ++r) ps += p0[r];
#pragma unroll
  for (int r = 0; r < 16; ++r) ps += p1[r];
  { auto rr = __builtin_amdgcn_permlane32_swap(__float_as_uint(ps), __float_as_uint(ps), false, false);
    ps = __uint_as_float(rr[0]) + __uint_as_float(rr[1]); }
  l_reg = l_reg * alpha + ps;
#define PK4(P, BASE, OUT) do { unsigned a0 = cvtpk(P[BASE + 0], P[BASE + 1]), a1 = cvtpk(P[BASE + 2], P[BASE + 3]);   \
    unsigned b0 = cvtpk(P[BASE + 4], P[BASE + 5]), b1 = cvtpk(P[BASE + 6], P[BASE + 7]);                              \
    auto r0 = __builtin_amdgcn_permlane32_swap(a0, b0, false, false); auto r1 = __builtin_amdgcn_permlane32_swap(a1, b1, false, false); \
    u32x4 w = {r0[0], r1[0], r0[1], r1[1]}; OUT = *reinterpret_cast<bf16x8*>(&w); } while (0)
  PK4(p0, 0, pa0); PK4(p0, 8, pa1); PK4(p1, 0, pa2); PK4(p1, 8, pa3);
#undef PK4
}
template <bool BIAS>
__device__ __forceinline__ void qkt(f32x16& p0, f32x16& p1, const LAS char* Ks, const LAS char* qs, int r32, int hi, const LAS float* bp) {
  if (BIAS) {
#pragma unroll
    for (int r = 0; r < 16; ++r) { p0[r] = bp[(r & 3) + 8 * (r >> 2)]; p1[r] = bp[32 + (r & 3) + 8 * (r >> 2)]; }
  } else { p0 = f32x16{}; p1 = f32x16{}; }
#pragma unroll
  for (int d0 = 0; d0 < 8; ++d0) { int cb = (d0 * 16 + hi * 8) * 2;
    bf16x8 b0 = *reinterpret_cast<const LAS bf16x8*>(Ks + KSWZ(r32, cb));
    bf16x8 b1 = *reinterpret_cast<const LAS bf16x8*>(Ks + KSWZ(32 + r32, cb));
    const bf16x8 qv = *reinterpret_cast<const LAS bf16x8*>(qs + d0 * 1024);
    p0 = __builtin_amdgcn_mfma_f32_32x32x16_bf16(b0, qv, p0, 0, 0, 0);
    p1 = __builtin_amdgcn_mfma_f32_32x32x16_bf16(b1, qv, p1, 0, 0, 0); }
}
__device__ __forceinline__ int v_st(int k, int c) { const int kk = (k & ~0xC) | ((k & 4) << 1) | ((k & 8) >> 1); return ((kk >> 3) * 4 + (c >> 5)) * 512 + ((kk & 7) * 32 + (c & 31)) * 2; }
__device__ __forceinline__ int v_rd_base(int lane) { return ((lane & 3) << 3) | (((lane >> 2) & 3) << 6) | (((lane >> 4) & 1) << 5) | (((lane >> 5) & 1) << 8); }
constexpr int v_rd_off(int d0, int ks, int half) { return d0 * 512 + ks * 4096 + half * 2048; }
template <int OFF> __device__ __forceinline__ s16x4 tr_read(int vb) {
  s16x4 r; asm volatile("ds_read_b64_tr_b16 %0, %1 offset:%2" : "=&v"(r) : "v"(vb), "i"(OFF) : "memory"); return r;
}
template <int D0> __device__ __forceinline__ void pv_one(f32x16& od, int vb, bf16x8 pa0, bf16x8 pa1, bf16x8 pa2, bf16x8 pa3) {
  const s16x4 l0 = tr_read<v_rd_off(D0, 0, 0)>(vb), h0 = tr_read<v_rd_off(D0, 0, 1)>(vb), l1 = tr_read<v_rd_off(D0, 1, 0)>(vb), h1 = tr_read<v_rd_off(D0, 1, 1)>(vb);
  const s16x4 l2 = tr_read<v_rd_off(D0, 2, 0)>(vb), h2 = tr_read<v_rd_off(D0, 2, 1)>(vb), l3 = tr_read<v_rd_off(D0, 3, 0)>(vb), h3 = tr_read<v_rd_off(D0, 3, 1)>(vb);
  asm volatile("s_waitcnt lgkmcnt(0)" ::: "memory"); SBAR();
#define PK(L, H) (bf16x8){L[0], L[1], L[2], L[3], H[0], H[1], H[2], H[3]}
  od = __builtin_amdgcn_mfma_f32_32x32x16_bf16(pa0, PK(l0, h0), od, 0, 0, 0);
  od = __builtin_amdgcn_mfma_f32_32x32x16_bf16(pa1, PK(l1, h1), od, 0, 0, 0);
  od = __builtin_amdgcn_mfma_f32_32x32x16_bf16(pa2, PK(l2, h2), od, 0, 0, 0);
  od = __builtin_amdgcn_mfma_f32_32x32x16_bf16(pa3, PK(l3, h3), od, 0, 0, 0);
#undef PK
}
__device__ __forceinline__ void pv_d0(f32x16* o, int vb, bf16x8 pa0, bf16x8 pa1, bf16x8 pa2, bf16x8 pa3) {
  pv_one<0>(o[0], vb, pa0, pa1, pa2, pa3); pv_one<1>(o[1], vb, pa0, pa1, pa2, pa3); pv_one<2>(o[2], vb, pa0, pa1, pa2, pa3); pv_one<3>(o[3], vb, pa0, pa1, pa2, pa3);
}
template <int LDQ, int LDK, int LDO, bool BAND>
__device__ __forceinline__ void attn_body(const bf16_t* Qb, const bf16_t* Kh, const bf16_t* Vh, bf16_t* Ob,
                                          const int NT, const int kc0, const float* btab_src, LAS char* lds) {
  const int tid = threadIdx.x, wid = __builtin_amdgcn_readfirstlane(tid >> 6), lane = tid & 63, r32 = lane & 31, hi = lane >> 5;
  LAS char* V_lds = lds; LAS char* K_lds = lds + 2 * SHM_V;
  LAS float* wsf = (LAS float*)(lds + OFF_WS) + wid * 64; LAS float* li_l = wsf; LAS float* al_l = wsf + 32;
  LAS float* btab = (LAS float*)(lds + OFF_BT);
  if (BAND) { if (tid < 384) btab[tid] = tid < 64 ? btab_src[256] : (tid < 256 ? btab_src[320 - tid] : -30000.f); }
  float m_reg = -10000.f, l_reg = 0; f32x16 o[4] = {};
  const bf16_t* Qw = Qb + (long)(wid * QBLK + r32) * LDQ + hi * 8;
  LAS char* qr = lds + OFF_OST + wid * 8192 + lane * 16;
#pragma unroll
  for (int d0 = 0; d0 < 8; ++d0) *reinterpret_cast<LAS bf16x8*>(qr + d0 * 1024) = *reinterpret_cast<const bf16x8*>(Qw + d0 * 16);
  const int sr = tid >> 4, sc = (tid & 15) * 8, vst0 = v_st(sr, sc), vst1 = v_st(32 + sr, sc);
  const int vb0 = (int)(unsigned)(uintptr_t)V_lds + v_rd_base(lane);
  struct { bf16x8 vs0, vs1, ks0, ks1; } sr_[1];
  const int pw = wid >> 1, qi = (wid & 1) * 32 + r32;
#define TROW(t) ((BAND ? (((kc0) + (t)) > 0 ? ((kc0) + (t)) : 0) : (t)) * KVBLK)
#define SLOAD(i, t) do { const long k0_ = TROW(t); sr_[i].vs0 = *reinterpret_cast<const bf16x8*>(&Vh[(k0_ + sr) * LDK + sc]); sr_[i].vs1 = *reinterpret_cast<const bf16x8*>(&Vh[(k0_ + 32 + sr) * LDK + sc]); \
    sr_[i].ks0 = *reinterpret_cast<const bf16x8*>(&Kh[(k0_ + sr) * LDK + sc]); sr_[i].ks1 = *reinterpret_cast<const bf16x8*>(&Kh[(k0_ + 32 + sr) * LDK + sc]); } while (0)
#define SWRITE(b, i) do { *(LAS bf16x8*)(V_lds + (b) * SHM_V + vst0) = sr_[i].vs0; *(LAS bf16x8*)(V_lds + (b) * SHM_V + vst1) = sr_[i].vs1; int kc_ = sc * 2; \
    *(LAS bf16x8*)(K_lds + (b) * SHM_K + KSWZ(sr, kc_)) = sr_[i].ks0; *(LAS bf16x8*)(K_lds + (b) * SHM_K + KSWZ(32 + sr, kc_)) = sr_[i].ks1; } while (0)
#define SWAIT() asm volatile("s_waitcnt vmcnt(0)" ::: "memory")
#define RESC(a) do { if (__any((a) < 1.f)) { if (hi == 0) al_l[r32] = (a); asm volatile("s_waitcnt lgkmcnt(0)" ::: "memory"); \
    _Pragma("unroll") for (int d = 0; d < 4; ++d) _Pragma("unroll") for (int r = 0; r < 16; ++r) o[d][r] *= al_l[crow(r, hi)]; } } while (0)
#define BPTR(t) ({ const int t_ = (t); const int dch = pw + 8 - t_; int kb_ = 192 - dch * 64 - qi + 4 * hi; kb_ = kb_ < 0 ? 0 : kb_; \
    if (dch < 0 || dch > 8 || (kc0) + t_ < 0) kb_ = 288; (const LAS float*)(btab + kb_); })
  f32x16 pA0, pA1, pB0, pB1; float mnA, mnB, alA, alB; bf16x8 pa0, pa1, pa2, pa3;
  constexpr int SE = 0, SO = 0;
  SLOAD(SE, 0); asm volatile("s_waitcnt vmcnt(0)" ::: "memory"); SWRITE(0, SE); __syncthreads();
  qkt<BAND>(pA0, pA1, K_lds, qr, r32, hi, BPTR(0)); partialSM(pA0, pA1, m_reg, mnA, alA);
  SLOAD(SO, 1);
  SWAIT(); SWRITE(1, SO); __syncthreads();
  for (int j = 1; j + 1 < NT; j += 2) {
    SBAR(); qkt<BAND>(pB0, pB1, K_lds + SHM_K, qr, r32, hi, BPTR(j));
    finishSM(pA0, pA1, alA, l_reg, pa0, pa1, pa2, pa3); SBAR();
    SLOAD(SO, j + 1); SBAR();
    pv_d0(o, vb0, pa0, pa1, pa2, pa3); partialSM(pB0, pB1, m_reg, mnB, alB);
    __syncthreads(); SWAIT(); SWRITE(0, SE);
    RESC(alB); __syncthreads();
    SBAR(); qkt<BAND>(pA0, pA1, K_lds, qr, r32, hi, BPTR(j + 1));
    finishSM(pB0, pB1, alB, l_reg, pa0, pa1, pa2, pa3); SBAR();
    SLOAD(SE, j + 2); SBAR();
    pv_d0(o, vb0 + SHM_V, pa0, pa1, pa2, pa3); partialSM(pA0, pA1, m_reg, mnA, alA);
    __syncthreads(); SWAIT(); SWRITE(1, SO);
    RESC(alA); __syncthreads();
  }
  SBAR(); qkt<BAND>(pB0, pB1, K_lds + SHM_K, qr, r32, hi, BPTR(NT - 1));
  finishSM(pA0, pA1, alA, l_reg, pa0, pa1, pa2, pa3); SBAR();
  pv_d0(o, vb0, pa0, pa1, pa2, pa3); partialSM(pB0, pB1, m_reg, mnB, alB);
  __syncthreads(); RESC(alB);
  finishSM(pB0, pB1, alB, l_reg, pa0, pa1, pa2, pa3); SBAR();
  pv_d0(o, vb0 + SHM_V, pa0, pa1, pa2, pa3);
  if (hi == 0) li_l[r32] = l_reg; asm volatile("s_waitcnt lgkmcnt(0)" ::: "memory");
  float rli[16];
#pragma unroll
  for (int r = 0; r < 16; ++r) rli[r] = __builtin_amdgcn_rcpf(li_l[crow(r, hi)]);
  { LAS bf16_t* stg = (LAS bf16_t*)(lds + OFF_OST + wid * 8192);
#pragma unroll
    for (int r = 0; r < 16; ++r) { const int orow = crow(r, hi);
#pragma unroll
      for (int d0 = 0; d0 < 4; ++d0) stg[orow * 128 + d0 * 32 + r32] = (bf16_t)f2bf(o[d0][r] * rli[r]); }
    asm volatile("s_waitcnt lgkmcnt(0)" ::: "memory");
    bf16_t* Ow = Ob + (long)(wid * QBLK) * LDO;
#pragma unroll
    for (int i = 0; i < 8; ++i) { const int row = i * 4 + (lane >> 4), ch = lane & 15; const u32x4 v = *(const LAS u32x4*)(stg + row * 128 + ch * 8); *(u32x4*)(Ow + (long)row * LDO + ch * 8) = v; } }
  __syncthreads();
#undef TROW
#undef SLOAD
#undef SWRITE
#undef SWAIT
#undef RESC
#undef BPTR
}
#undef KSWZ
#undef SBAR
}


namespace rt {
using f32x16 = __attribute__((ext_vector_type(16))) float;
#define RKSWZ(row, colB) ((row) * 256 + ((colB) ^ (((row) & 7) << 4)))
__device__ __forceinline__ int crow(int r, int hi) { return (r & 3) + 8 * (r >> 2) + 4 * hi; }
__device__ __forceinline__ void ce_desc(unsigned& a, unsigned& b) { const unsigned mx = a > b ? a : b, mn = a > b ? b : a; a = mx; b = mn; }
__device__ __forceinline__ void sort16_desc(unsigned (&v)[16]) {
#pragma unroll
  for (int k = 2; k <= 16; k <<= 1)
#pragma unroll
    for (int j = k >> 1; j > 0; j >>= 1)
#pragma unroll
      for (int i = 0; i < 16; ++i) { const int l = i ^ j; if (l > i) { if ((i & k) == 0) ce_desc(v[i], v[l]); else ce_desc(v[l], v[i]); } }
}
__device__ __forceinline__ void merge16_desc(unsigned (&a)[16], const unsigned (&b)[16]) {
#pragma unroll
  for (int i = 0; i < 16; ++i) a[i] = a[i] > b[15 - i] ? a[i] : b[15 - i];
#pragma unroll
  for (int j = 8; j > 0; j >>= 1)
#pragma unroll
    for (int i = 0; i < 16; ++i) { const int l = i ^ j; if (l > i) ce_desc(a[i], a[l]); }
}
__device__ __forceinline__ unsigned fkey(float f) { const unsigned u = __float_as_uint(f); return (u & 0x80000000u) ? ~u : (u | 0x80000000u); }
__device__ __forceinline__ float fkey_inv(unsigned k) { const unsigned u = (k & 0x80000000u) ? (k & 0x7fffffffu) : ~k; return __uint_as_float(u); }
__device__ __forceinline__ void top16_half(const f32x16 (&sc)[4], int hi, unsigned (&out)[16]) {
  unsigned g[16];
#pragma unroll
  for (int blk = 0; blk < 4; ++blk) {
#pragma unroll
    for (int r = 0; r < 16; ++r) g[r] = (fkey(sc[blk][r]) & 0xFFFFFF80u) | (unsigned)(32 * blk + (r & 3) + 8 * (r >> 2) + 4 * hi);
    sort16_desc(g);
    if (blk == 0) {
#pragma unroll
      for (int r = 0; r < 16; ++r) out[r] = g[r];
    } else merge16_desc(out, g);
  }
  unsigned pb[16];
#pragma unroll
  for (int r = 0; r < 16; ++r) { auto rr = __builtin_amdgcn_permlane32_swap(out[r], out[r], false, false); pb[r] = hi ? rr[0] : rr[1]; }
  merge16_desc(out, pb);
}
__device__ __forceinline__ void route_phase(const Params& p, LAS unsigned char* lds, int tid, int lane, int wave) {
  const bf16_t* Q = (const bf16_t*)(p.ws + WS_Q); const bf16_t* KB = (const bf16_t*)(p.ws + WS_KEYSB);
  int* RIDX = (int*)(p.ws + WS_RIDX); float* RG = (float*)(p.ws + WS_RG);
  const int h = blockIdx.x & 7, grp = blockIdx.x >> 3;
  const int r32 = lane & 31, hi = lane >> 5;
#pragma unroll
  for (int c = 0; c < 2; ++c)
#pragma unroll
    for (int rep = 0; rep < 4; ++rep) { const int row = rep * 32 + (tid >> 4), cb = (tid & 15) * 16;
      *(LAS u32x4*)(lds + c * 32768 + RKSWZ(row, cb)) = *(const u32x4*)((const char*)KB + ((size_t)(h * 2 + c) * 128 + row) * 256 + cb); }
  __syncthreads();
  for (int tb = grp * 8 + wave; tb < T / 32; tb += (int)(gridDim.x >> 3) * 8) {
    const int t = tb * 32 + r32;
    unsigned ka[16], kb2[16];
#pragma unroll
    for (int c = 0; c < 2; ++c) {
      bf16x8 qf[8];
      const bf16_t* qp = Q + (size_t)t * D + h * 256 + c * 128 + hi * 8;
#pragma unroll
      for (int ks = 0; ks < 8; ++ks) qf[ks] = *(const bf16x8*)(qp + ks * 16);
      f32x16 sc[4];
#pragma unroll
      for (int blk = 0; blk < 4; ++blk) { sc[blk] = f32x16{};
#pragma unroll
        for (int ks = 0; ks < 8; ++ks) { const bf16x8 kf = *(const LAS bf16x8*)(lds + c * 32768 + RKSWZ(32 * blk + r32, (16 * ks + 8 * hi) * 2));
          sc[blk] = __builtin_amdgcn_mfma_f32_32x32x16_bf16(kf, qf[ks], sc[blk], 0, 0, 0); } }
      if (c == 0) top16_half(sc, hi, ka); else top16_half(sc, hi, kb2);
    }
    float av[16], bv[16];
#pragma unroll
    for (int i = 0; i < 16; ++i) { av[i] = fkey_inv(ka[i] & 0xFFFFFF80u); bv[i] = fkey_inv(kb2[i] & 0xFFFFFF80u); }
    float T[16];
#pragma unroll
    for (int k = 0; k < 16; ++k) T[k] = -3.0e38f;
#pragma unroll
    for (int i = 0; i < 16; ++i)
#pragma unroll
      for (int j = 0; j < 16; ++j) if ((i + 1) * (j + 1) <= 16) { float v = av[i] + bv[j];
#pragma unroll
          for (int k = 0; k < 16; ++k) { const float mx = fmaxf(T[k], v); v = fminf(T[k], v); T[k] = mx; } }
    const float m = T[0], theta = T[15];
    float Z = 0.f;
#pragma unroll
    for (int k = 0; k < 16; ++k) Z += __expf(T[k] - m);
    const float rz = 1.f / Z;
    int slot = 0; int cn = 0;
    int* ip = RIDX + (size_t)t * 128 + h * 16; float* gp = RG + (size_t)t * 128 + h * 16;
#pragma unroll
    for (int i = 0; i < 16; ++i)
#pragma unroll
      for (int j = 0; j < 16; ++j) if ((i + 1) * (j + 1) <= 16) { const float v = av[i] + bv[j];
          const bool sel = (v >= theta) && (slot < 16);
          if (sel && ((cn & 1) == hi)) { ip[slot] = (int)((ka[i] & 127u) * 128u + (kb2[j] & 127u)); gp[slot] = __expf(v - m) * rz; }
          slot += sel ? 1 : 0; ++cn; }
  }
}
#undef RKSWZ
}

#define XB_TMO      128
#define XB_XCNT(j)  (256  + 64 * (j))
#define XB_XSUB(j)  (1280 + 64 * (j))
#define XB_XGEN(j)  (2304 + 64 * (j))
#define XB_TOP      3328
#define XB_TOPGEN   3392
#define XCD_BAR_WORDS 3456
#define XB_SPIN_CAP (1u << 22)
__device__ __forceinline__ unsigned xb_ld(unsigned* p)              { return __hip_atomic_load(p, __ATOMIC_RELAXED, __HIP_MEMORY_SCOPE_AGENT); }
__device__ __forceinline__ unsigned xb_add(unsigned* p, unsigned v) { return __hip_atomic_fetch_add(p, v, __ATOMIC_RELAXED, __HIP_MEMORY_SCOPE_AGENT); }
__device__ __forceinline__ unsigned xb_xcc_id() { return (unsigned)__builtin_amdgcn_s_getreg((3 << 11) | 20) & 0xFu; }
#define XB_SPIN(cond, bar) do { unsigned _sp = 0; while (cond) { __builtin_amdgcn_s_sleep(1); \
    if ((++_sp & 255u) == 0u) { if (xb_ld(&(bar)[XB_TMO])) break; if (_sp > XB_SPIN_CAP) { atomicAdd(&(bar)[XB_TMO], 1u); break; } } } } while (0)
struct XcdBarrier { unsigned* bar; unsigned x; volatile LAS unsigned* st; };
__device__ __forceinline__ XcdBarrier xcd_barrier_post(unsigned* bar, volatile LAS unsigned* st) {
    XcdBarrier b; b.bar = bar; b.x = xb_xcc_id(); b.st = st;
    if (threadIdx.x == 0) (void)xb_add(&bar[XB_XCNT(b.x)], 1u);
    return b;
}
__device__ __forceinline__ void xcd_barrier_complete(unsigned* bar, unsigned x, unsigned& nloc, unsigned& nx) {
    const unsigned G = gridDim.x * gridDim.y * gridDim.z;
    unsigned sum, cnt, mine, sp = 0u;
    for (;;) {
        sum = 0u; cnt = 0u; mine = 0u;
#pragma unroll
        for (unsigned j = 0; j < 16; ++j) { const unsigned c = xb_ld(&bar[XB_XCNT(j)]); sum += c; cnt += (c > 0u) ? 1u : 0u; mine = (j == x) ? c : mine; }
        if (sum == G) break;
        __builtin_amdgcn_s_sleep(1);
        if ((++sp & 255u) == 0u) { if (xb_ld(&bar[XB_TMO])) break; if (sp > XB_SPIN_CAP) { atomicAdd(&bar[XB_TMO], 1u); break; } }
    }
    nloc = mine > 0u ? mine : 1u; nx = cnt > 0u ? cnt : 1u;
}
__device__ __forceinline__ void xcd_barrier(const XcdBarrier& b) {
    asm volatile("s_waitcnt vmcnt(0)" ::: "memory");
    __syncthreads();
    if (threadIdx.x == 0) {
        unsigned* bar = b.bar;
        __builtin_amdgcn_s_waitcnt(0);
        unsigned nloc = b.st[0], nx = b.st[1];
        if (nloc == 0u) { xcd_barrier_complete(bar, b.x, nloc, nx); b.st[0] = nloc; b.st[1] = nx; }
        const unsigned old = xb_add(&bar[XB_XSUB(b.x)], 1u);
        const unsigned gen = old / nloc;
        if (old + 1u == (gen + 1u) * nloc) {
            __builtin_amdgcn_fence(__ATOMIC_RELEASE, "agent");
            asm volatile("s_waitcnt vmcnt(0)" ::: "memory");
            const unsigned og = xb_add(&bar[XB_TOP], 1u);
            const unsigned tg = og / nx;
            if (og + 1u == (tg + 1u) * nx) xb_add(&bar[XB_TOPGEN], 1u);
            else XB_SPIN(xb_ld(&bar[XB_TOPGEN]) == tg, bar);
            __builtin_amdgcn_fence(__ATOMIC_ACQUIRE, "agent");
            xb_add(&bar[XB_XGEN(b.x)], 1u);
            asm volatile("s_waitcnt vmcnt(0)" ::: "memory");
        } else {
            XB_SPIN(xb_ld(&bar[XB_XGEN(b.x)]) == gen, bar);
            __builtin_amdgcn_fence(__ATOMIC_ACQUIRE, "agent");
            asm volatile("s_waitcnt vmcnt(0)" ::: "memory");
        }
    }
    __syncthreads();
}
constexpr int RING_BYTES = 131072, MISC_OFF = 143360, LDS_BYTES = 147456, NTHREADS = 512;
static_assert(att::LDS_NEED <= MISC_OFF, "attention scratch below the MISC words");
constexpr size_t WS_SLAB = WS_X2BF;

__device__ __forceinline__ void touch_buffer(const void* base, size_t bytes, int cb, int Gd, int tid) {
    const u32x4* b = (const u32x4*)base; const size_t n = bytes / 16, stride = (size_t)Gd * NTHREADS;
    u32x4 acc = {0u, 0u, 0u, 0u};
    for (size_t i = (size_t)cb * NTHREADS + tid; i < n; i += stride) { const u32x4 v = b[i]; acc.x ^= v.x; acc.y ^= v.y; acc.z ^= v.z; acc.w ^= v.w; }
    asm volatile("" :: "v"(acc.x), "v"(acc.y), "v"(acc.z), "v"(acc.w));
}
#define PH_BEGIN(i) unsigned long long t0_##i = 0; if ((PROBE_MASK >> (i)) & 1) t0_##i = __builtin_amdgcn_s_memrealtime();
#define PH_END(i) if ((PROBE_MASK >> (i)) & 1) probe_acc += __builtin_amdgcn_s_memrealtime() - t0_##i;
__global__ void __launch_bounds__(NTHREADS, 2) fwd(Params p) {
    extern __shared__ __attribute__((aligned(16))) unsigned char lds_raw[];
    LAS unsigned char* lds = (LAS unsigned char*)lds_raw;
    volatile LAS unsigned* MISC = (volatile LAS unsigned*)(lds + MISC_OFF);
    const int tid = threadIdx.x, lane = tid & 63, wave = __builtin_amdgcn_readfirstlane(tid >> 6);
    const int nwb = NTHREADS / 64;
    const int gw = blockIdx.x * nwb + wave, NW = gridDim.x * nwb;
    const int Gd = gridDim.x, cb = blockIdx.x;
    unsigned char* ws = p.ws;
    bf16_t* WT_IN = (bf16_t*)(ws + WS_WT_IN); bf16_t* WT_GATE = (bf16_t*)(ws + WS_WT_GATE); bf16_t* WT_BR = (bf16_t*)(ws + WS_WT_BR);
    bf16_t* WT_O = (bf16_t*)(ws + WS_WT_O); bf16_t* WT_PQ = (bf16_t*)(ws + WS_WT_PQ); bf16_t* WT_MKV = (bf16_t*)(ws + WS_WT_MKV);
    bf16_t* KEYSB = (bf16_t*)(ws + WS_KEYSB); bf16_t* MEMN = (bf16_t*)(ws + WS_MEMN); bf16_t* MEMKV = (bf16_t*)(ws + WS_MEMKV);
    bf16_t* HO = (bf16_t*)(ws + WS_HO); bf16_t* PROJ = (bf16_t*)(ws + WS_PROJ); bf16_t* G = (bf16_t*)(ws + WS_G);
    bf16_t* MERGED = (bf16_t*)(ws + WS_MERGED); bf16_t* X2BF = (bf16_t*)(ws + WS_X2BF); bf16_t* QB = (bf16_t*)(ws + WS_Q);
        float* SS2 = (float*)(ws + WS_CTL + CTL_SS2_BYTE);
    if (tid < 64) MISC[tid] = 0u;
    __syncthreads();
    XcdBarrier bar = xcd_barrier_post((unsigned*)(ws + WS_CTL + CTL_BAR_BYTE), MISC + 8);
    if (tid == 0) MISC[16] = xb_add((unsigned*)(ws + WS_CTL + CTL_RANK_BYTE) + 64 * bar.x, 1u);

    unsigned long long probe_acc = 0;
    PH_BEGIN(0)
    {
        LAS float* scr = (LAS float*)lds + wave * (64 * 33);
        const int I0 = (D / 64) * (INW / 32), I1 = I0 + (D / 64) * (GW / 32), I2 = I1 + (D / 64) * (D / 32), I3 = I2 + (D / 64) * (D / 32), I4 = I3 + (D / 64) * (D / 32), I5 = I4 + (D / 64) * (2 * CW / 32);
#define TRJOB(it, jb, li) do { if ((it) < I0) { jb = TrJob{p.in[3], WT_IN, nullptr, D, INW, 0.f}; li = (it); } else if ((it) < I1) { jb = TrJob{p.in[18], WT_GATE, nullptr, D, GW, GATE_WSCALE}; li = (it) - I0; } \
            else if ((it) < I2) { jb = TrJob{p.in[20], WT_BR, nullptr, D, D, 0.f}; li = (it) - I1; } else if ((it) < I3) { jb = TrJob{p.in[21], WT_O, nullptr, D, D, 0.f}; li = (it) - I2; } \
            else if ((it) < I4) { jb = TrJob{p.in[23], WT_PQ, p.in[22], D, D, 0.f}; li = (it) - I3; } else { jb = TrJob{p.in[15], WT_MKV, nullptr, D, 2 * CW, 0.f}; li = (it) - I4; } } while (0)
        for (int it = gw; it < I5; it += 2 * NW) {
            TrJob ja, jb2; int la, lb; f32x4 va[8], vb[8];
            TRJOB(it, ja, la); tr_load(ja, la, lane, va);
            const bool has2 = it + NW < I5;
            if (has2) { TRJOB(it + NW, jb2, lb); tr_load(jb2, lb, lane, vb); }
            tr_store(ja, la, lane, va, scr);
            if (has2) tr_store(jb2, lb, lane, vb, scr);
        }
#undef TRJOB
        rms_rows(p.in[0], p.in[2], HO, ws + WS_H8, T, gw, NW, lane);
        rms_rows(p.in[1], p.in[14], MEMN, nullptr, BATCH * NMEM, gw, NW, lane);
        const float* keys = p.in[24];
        for (int i = gw * 64 + lane; i < PH * 2 * NKEYS * 128 / 2; i += NW * 64) ((unsigned*)KEYSB)[i] = pk2(keys[2 * i], keys[2 * i + 1]);
    }
    xcd_barrier(bar);
    PH_END(0)
    PH_BEGIN(1)
    {
        SchedP1a Sa{(const char*)HO, (const char*)WT_IN, (const char*)MEMN, (const char*)WT_MKV, Gd, cb};
        EpiP1a Ea{PROJ, MEMKV};
        pg8::gemm_phase<false>(lds, D, D, Sa, Ea);
        SchedP1b Sb{(const char*)(ws + WS_H8), (const char*)WT_GATE, Gd, cb};
        EpiP1b Eb{G, p.in[19]};
        pg8::gemm_phase<true>(lds, D / 2, D / 2, Sb, Eb);
    }
    xcd_barrier(bar);
    PH_END(1)
    PH_BEGIN(2)
    {
        const float qscale = 0.08838834764831845f;
        { HeadGains hg; load_head_gains(hg, p.in[4], p.in[5], p.in[16], lane);
          for (int t = gw; t < T; t += NW) headnorm_token(PROJ + (size_t)t * INW, hg, qscale, lane); }
        for (int it = gw; it < BATCH * NMEM * 4; it += NW) { const int m = it / 4, j = it % 4; headnorm(MEMKV + (size_t)m * (2 * CW) + j * 128, p.in[17], 1.f, lane); }
        for (int u = gw; u < BATCH * NCH * 8; u += NW) { const int g = u % 8, c = (u / 8) % NCH, b = u / (8 * NCH); lru_pass1(p, b, c, g, lane, lds + wave * 8192, u, NW); }
        if (NW != BATCH * NCH * 8) fp4_tables(p, gw, NW, lane);
    }
    xcd_barrier(bar);
    PH_END(2)
    PH_BEGIN(3)
    {
        const int nA = BATCH * 8 * (NCH / 4), nC = BATCH * 4 * (SEQ / 256);
        PH_BEGIN(9)
        for (int u = cb; u < nA + nC; u += Gd) {
            if (u < nA) {
                const int cg = u % (NCH / 4), h = (u / (NCH / 4)) % 8, b = u / ((NCH / 4) * 8);
                const size_t brow = (size_t)b * SEQ, qrow = brow + (size_t)cg * 256;
                att::attn_body<INW, INW, D, true>(PROJ + qrow * INW + C_QA + h * 128, PROJ + brow * INW + C_KA + h * 128, PROJ + brow * INW + C_VA + h * 128,
                                                  HO + qrow * D + h * 128, 12, cg * 4 - NPREV, p.in[6] + h * 257, (LAS char*)lds);
            } else {
                const int v = u - nA; const int qb = v % (SEQ / 256), h = (v / (SEQ / 256)) % 4, b = v / ((SEQ / 256) * 4);
                const size_t qrow = (size_t)b * SEQ + (size_t)qb * 256;
                att::attn_body<INW, 2 * CW, D, false>(PROJ + qrow * INW + C_QC + h * 128, MEMKV + (size_t)b * NMEM * (2 * CW) + h * 128, MEMKV + (size_t)b * NMEM * (2 * CW) + CW + h * 128,
                                                     HO + qrow * D + AW + LW + h * 128, NMEM / 64, 0, nullptr, (LAS char*)lds);
            }
        }
        PH_END(9)
        PH_BEGIN(10)
        for (int u = gw; u < BATCH * NCH * 8; u += NW) { const int g = u % 8, c = (u / 8) % NCH, b = u / (8 * NCH); lru_pass2(p, b, c, g, lane); }
        touch_buffer(WT_BR, (size_t)D * D * 2, cb, Gd, tid); touch_buffer(WT_O, (size_t)D * D * 2, cb, Gd, tid);
        PH_END(10)
    }
    xcd_barrier(bar);
    PH_END(3)
    PH_BEGIN(4)
    {
        SchedP3 S{(const char*)HO, (const char*)WT_BR, Gd, cb};
        EpiP3 E{G, MERGED};
        pg8::gemm_phase<false>(lds, D, D, S, E);
    }
    xcd_barrier(bar);
    PH_END(4)
    PH_BEGIN(5)
    {
        SchedSq S{(const char*)MERGED, (const char*)WT_O, Gd, cb};
        EpiP4 E{p.in[0], p.out, X2BF, SS2, ws + WS_X2F8};
        pg8::gemm_phase<false>(lds, D, D, S, E);
        touch_buffer(WT_PQ, (size_t)D * D * 2, cb, Gd, tid);
    }
    xcd_barrier(bar);
    PH_END(5)
    PH_BEGIN(6)
    {
        SchedSq S{(const char*)X2BF, (const char*)WT_PQ, Gd, cb};
        EpiP5 E{QB, SS2};
        pg8::gemm_phase<false>(lds, D, D, S, E);
    }
    xcd_barrier(bar);
    PH_END(6)
    PH_BEGIN(7)
    rt::route_phase(p, lds, tid, lane, wave);
    xcd_barrier(bar);
    PH_END(7)
    PH_BEGIN(8)
    int ppos, pnx, prank, pnloc;
    { if (tid == 0) { unsigned pos = 0, nx = 0; const unsigned* bw = (const unsigned*)(ws + WS_CTL + CTL_BAR_BYTE);
#pragma unroll
          for (unsigned j = 0; j < 16; ++j) { const unsigned cj = xb_ld((unsigned*)&bw[XB_XCNT(j)]); nx += cj > 0u ? 1u : 0u; pos += (cj > 0u && j < bar.x) ? 1u : 0u; }
          MISC[17] = pos; MISC[18] = nx > 0u ? nx : 1u; }
      __syncthreads();
      ppos = (int)MISC[17]; pnx = (int)MISC[18]; prank = (int)MISC[16]; pnloc = (int)MISC[8]; if (pnloc < 1) pnloc = 1; }
    peer_u_step(p, lane, wave, lds + wave * 16384, ppos, pnx, prank, pnloc);
    xcd_barrier(bar);
    for (int t = gw; t < T; t += NW) peer_combine(p, t, lane);
    xcd_barrier(bar);
    peer_v_step(p, lane, wave, lds + wave * 16384, ppos, pnx, prank, pnloc);
    if (PROBE_MASK) { __syncthreads(); PH_END(8) const unsigned long long te = __builtin_amdgcn_s_memrealtime(); while (__builtin_amdgcn_s_memrealtime() - te < probe_acc) __builtin_amdgcn_s_sleep(8); }
}

extern "C" void kernel_launch(void* const* d_in, const int* in_sizes, int n_in, void* d_out, int out_size, void* d_ws, size_t ws_size, hipStream_t stream) {
    static int grid = 0;
    if (grid == 0) {
        if (n_in != 27 || out_size != T * D || ws_size < WS_END) { fprintf(stderr, "kernel_launch: unexpected problem (n_in %d out %d ws %zu)\n", n_in, out_size, ws_size); grid = -1; return; }
        int dev = 0, cus = 0, per_cu = 0;
        (void)hipGetDevice(&dev); (void)hipDeviceGetAttribute(&cus, hipDeviceAttributeMultiprocessorCount, dev);
        if (hipFuncSetAttribute((const void*)fwd, hipFuncAttributeMaxDynamicSharedMemorySize, LDS_BYTES) != hipSuccess) { fprintf(stderr, "kernel_launch: hipFuncSetAttribute failed\n"); grid = -1; return; }
        (void)hipOccupancyMaxActiveBlocksPerMultiprocessor(&per_cu, (const void*)fwd, NTHREADS, LDS_BYTES);
        if (per_cu < 1) { fprintf(stderr, "kernel_launch: occupancy query says %d\n", per_cu); grid = -1; return; }
        grid = cus;
    }
    if (grid < 0) return;
    (void)hipMemsetAsync((char*)d_ws + WS_CTL, 0, 1 * MiB, stream);
    Params p{};
    for (int i = 0; i < 27; ++i) p.in[i] = (const float*)d_in[i];
    p.out = (float*)d_out; p.ws = (unsigned char*)d_ws;
    void* args[] = {&p};
    hipError_t e = hipLaunchCooperativeKernel((const void*)fwd, dim3(grid), dim3(NTHREADS), args, LDS_BYTES, stream);
    if (e != hipSuccess) fprintf(stderr, "cooperative launch failed: %s (grid %d)\n", hipGetErrorString(e), grid);
}
```

```cpp
#include <hip/hip_runtime.h>
#include <hip/hip_cooperative_groups.h>
#include <cstdio>
#include <cstdint>
namespace cg = cooperative_groups;
#ifndef PROBE_MASK
#define PROBE_MASK 0
#endif

#define LAS __attribute__((address_space(3)))
typedef unsigned short bf16_t;
typedef short bf16x8 __attribute__((ext_vector_type(8)));
typedef float f32x4 __attribute__((ext_vector_type(4)));
typedef unsigned u32x4 __attribute__((ext_vector_type(4)));
typedef unsigned u32x2 __attribute__((ext_vector_type(2)));

constexpr int D = 2048, BATCH = 2, SEQ = 8192, T = BATCH * SEQ;
constexpr int CHUNK = 64, NPREV = 8, NCH = SEQ / CHUNK;
constexpr int AW = 1024, LW = 512, CW = 512, INW = 4608, GW = 6144;
constexpr int NMEM = 256;
constexpr int PH = 8, NKEYS = 128, TOPK = 16;
constexpr float EPS = 1e-6f;
constexpr int C_QA = 0, C_KA = 1024, C_VA = 2048, C_XL = 3072, C_GL = 3584, C_QC = 4096;

constexpr size_t MiB = 1u << 20;
constexpr size_t WS_CTL = 0;
constexpr size_t WS_WT_IN = 2 * MiB, WS_WT_GATE = 20 * MiB, WS_WT_BR = 44 * MiB, WS_WT_O = 52 * MiB, WS_WT_PQ = 60 * MiB, WS_WT_MKV = 68 * MiB;
constexpr size_t WS_KEYSB = 72 * MiB, WS_MEMN = 73 * MiB, WS_MEMKV = 75 * MiB, WS_LRUSUM = 76 * MiB, WS_RS2 = 77 * MiB;
constexpr size_t WS_HO = 80 * MiB;
constexpr size_t WS_PROJ = 144 * MiB;
constexpr size_t WS_MERGED = 144 * MiB, WS_X2BF = 208 * MiB;
constexpr size_t WS_G = 288 * MiB;
constexpr size_t WS_TABU = 496 * MiB, WS_TABV = 512 * MiB, WS_Q = 416 * MiB;
constexpr size_t WS_SCU = 77 * MiB, WS_SCV = 77 * MiB + 65536;
constexpr size_t WS_AUA = 2 * MiB, WS_AUU = 18 * MiB;
constexpr size_t WS_H8 = 496 * MiB;
constexpr float GATE_WSCALE = 256.f;
constexpr size_t WS_RIDX = 480 * MiB, WS_RG = 488 * MiB, WS_END = 528 * MiB;

constexpr size_t CTL_BAR_BYTE = 16384, CTL_RANK_BYTE = 65536, CTL_SS2_BYTE = 512 * 1024;
struct Params { const float* in[27]; float* out; unsigned char* ws; };

__device__ __forceinline__ int fresh_lane() { int l; asm volatile("v_mbcnt_lo_u32_b32 %0, -1, 0\n\tv_mbcnt_hi_u32_b32 %0, -1, %0" : "=v"(l)); return l; }
__device__ __forceinline__ float bf2f(unsigned v16) { return __uint_as_float(v16 << 16); }
typedef float f32x2c __attribute__((ext_vector_type(2))); typedef __bf16 bf16x2c __attribute__((ext_vector_type(2)));
__device__ __forceinline__ unsigned pk2(float lo, float hi) { const f32x2c v = {lo, hi}; return __builtin_bit_cast(unsigned, __builtin_convertvector(v, bf16x2c)); }
__device__ __forceinline__ unsigned f2bf(float f) { return pk2(f, 0.f) & 0xffffu; }
__device__ __forceinline__ float wave_sum(float v) {
#pragma unroll
    for (int o = 1; o < 64; o <<= 1) v += __shfl_xor(v, o);
    return v;
}
typedef __bf16 bf16x2_t __attribute__((ext_vector_type(2)));
__device__ __forceinline__ float dot2bf(unsigned w, unsigned x, float acc) { return __builtin_amdgcn_fdot2_f32_bf16(__builtin_bit_cast(bf16x2_t, w), __builtin_bit_cast(bf16x2_t, x), acc, false); }
__device__ __forceinline__ float sigmoid_(float x) { return 1.f / (1.f + __expf(-x)); }
__device__ __forceinline__ float gelu_tanh(float x) { const float y = 1.5957691216f * (x + 0.044715f * x * x * x); return x / (1.f + __expf(-y)); }
__device__ __forceinline__ void unpack8(const u32x4 w, float* f) {
    f[0] = __uint_as_float(w.x << 16); f[1] = __uint_as_float(w.x & 0xffff0000u);
    f[2] = __uint_as_float(w.y << 16); f[3] = __uint_as_float(w.y & 0xffff0000u);
    f[4] = __uint_as_float(w.z << 16); f[5] = __uint_as_float(w.z & 0xffff0000u);
    f[6] = __uint_as_float(w.w << 16); f[7] = __uint_as_float(w.w & 0xffff0000u);
}

struct TrJob { const float* W; bf16_t* WT; const float* ks; int K, N; float f8scale; };
__device__ __forceinline__ void tr_load(const TrJob& jb, int item, int lane, f32x4 (&v)[8]) {
    const int nblk = jb.N / 32, kb = item / nblk, nb = item % nblk, k0 = 64 * kb, n0 = 32 * nb;
#pragma unroll
    for (int i = 0; i < 8; ++i) { const int kk = 8 * i + (lane >> 3); v[i] = *(const f32x4*)(jb.W + (size_t)(k0 + kk) * jb.N + n0 + 4 * (lane & 7)); if (jb.ks) v[i] = v[i] * jb.ks[k0 + kk]; }
}
__device__ __forceinline__ void tr_store(const TrJob& jb, int item, int lane, const f32x4 (&v)[8], LAS float* scr) {
    const int nblk = jb.N / 32, kb = item / nblk, nb = item % nblk, k0 = 64 * kb, n0 = 32 * nb;
#pragma unroll
    for (int i = 0; i < 8; ++i) { LAS float* d = scr + (8 * i + (lane >> 3)) * 33 + 4 * (lane & 7); d[0] = v[i].x; d[1] = v[i].y; d[2] = v[i].z; d[3] = v[i].w; }
    asm volatile("s_waitcnt lgkmcnt(0)" ::: "memory");
    const int c = lane & 7;
#pragma unroll
    for (int j = 0; j < 4; ++j) { const int n = (lane >> 3) + 8 * j; const LAS float* s = scr + (8 * c) * 33 + n;
        if (jb.f8scale != 0.f) { const float f = jb.f8scale; u32x2 o;
#define F8C(x_) fminf(fmaxf((x_) * f, -448.f), 448.f)
            int w = __builtin_amdgcn_cvt_pk_fp8_f32(F8C(s[0 * 33]), F8C(s[1 * 33]), 0, false); w = __builtin_amdgcn_cvt_pk_fp8_f32(F8C(s[2 * 33]), F8C(s[3 * 33]), w, true); o.x = (unsigned)w;
            w = __builtin_amdgcn_cvt_pk_fp8_f32(F8C(s[4 * 33]), F8C(s[5 * 33]), 0, false); w = __builtin_amdgcn_cvt_pk_fp8_f32(F8C(s[6 * 33]), F8C(s[7 * 33]), w, true); o.y = (unsigned)w;
#undef F8C
            *(u32x2*)((unsigned char*)jb.WT + (size_t)(n0 + n) * jb.K + k0 + 8 * c) = o; }
        else { u32x4 o; o.x = pk2(s[0 * 33], s[1 * 33]); o.y = pk2(s[2 * 33], s[3 * 33]); o.z = pk2(s[4 * 33], s[5 * 33]); o.w = pk2(s[6 * 33], s[7 * 33]);
            *(u32x4*)(jb.WT + (size_t)(n0 + n) * jb.K + k0 + 8 * c) = o; } }
    asm volatile("s_waitcnt lgkmcnt(0)" ::: "memory");
}
__device__ __forceinline__ void rms_row_load(const float* xrow, int lane, f32x4 (&v)[8]) {
    const f32x4* xr = (const f32x4*)xrow + lane;
#pragma unroll
    for (int j = 0; j < 8; ++j) v[j] = xr[64 * j];
}
__device__ __forceinline__ void rms_row_finish(const f32x4 (&v)[8], const float* g, bf16_t* orow, unsigned char* o8row, int lane) {
    const f32x4* gr = (const f32x4*)g + lane; float s = 0.f;
#pragma unroll
    for (int j = 0; j < 8; ++j) s += (v[j].x * v[j].x + v[j].y * v[j].y) + (v[j].z * v[j].z + v[j].w * v[j].w);
    const float rstd = rsqrtf(wave_sum(s) * (1.f / D) + EPS);
    u32x2* o8 = (u32x2*)orow + lane;
#pragma unroll
    for (int j = 0; j < 8; ++j) { const f32x4 gg = gr[64 * j]; const float a0 = v[j].x * rstd * gg.x, a1 = v[j].y * rstd * gg.y, a2 = v[j].z * rstd * gg.z, a3 = v[j].w * rstd * gg.w;
        u32x2 o; o.x = pk2(a0, a1); o.y = pk2(a2, a3); o8[64 * j] = o;
        if (o8row) { int w = __builtin_amdgcn_cvt_pk_fp8_f32(fminf(fmaxf(a0, -448.f), 448.f), fminf(fmaxf(a1, -448.f), 448.f), 0, false);
            w = __builtin_amdgcn_cvt_pk_fp8_f32(fminf(fmaxf(a2, -448.f), 448.f), fminf(fmaxf(a3, -448.f), 448.f), w, true); ((unsigned*)o8row)[64 * j + lane] = (unsigned)w; } }
}
__device__ __forceinline__ void rms_rows(const float* X, const float* g, bf16_t* O, unsigned char* O8, int nrows, int gw, int NW, int lane) {
    f32x4 va[8], vb[8];
    int m = gw;
    if (m < nrows) rms_row_load(X + (size_t)m * D, lane, va);
    for (; m < nrows; m += 2 * NW) {
        const bool hb = m + NW < nrows;
        if (hb) rms_row_load(X + (size_t)(m + NW) * D, lane, vb);
        rms_row_finish(va, g, O + (size_t)m * D, O8 ? O8 + (size_t)m * D : nullptr, lane);
        if (m + 2 * NW < nrows) rms_row_load(X + (size_t)(m + 2 * NW) * D, lane, va);
        if (hb) rms_row_finish(vb, g, O + (size_t)(m + NW) * D, O8 ? O8 + (size_t)(m + NW) * D : nullptr, lane);
    }
}

template <int TM, int TN, class Epi>
__device__ __forceinline__ void gemm_simple(const bf16_t* __restrict__ A, int lda, const bf16_t* __restrict__ Bt, int ldb, int M, int N, int K, const Epi& epi, int gw, int NW, int lane) {
    const int r = lane & 15, q = lane >> 4;
    const int ntm = M / (16 * TM), ntn = N / (16 * TN);
    for (int tile = gw; tile < ntm * ntn; tile += NW) {
        const int tm = tile / ntn, tn = tile % ntn;
        f32x4 acc[TM][TN];
#pragma unroll
        for (int i = 0; i < TM; ++i)
#pragma unroll
            for (int j = 0; j < TN; ++j) acc[i][j] = (f32x4){0.f, 0.f, 0.f, 0.f};
        const bf16_t* ap = A + (size_t)(tm * 16 * TM + r) * lda + q * 8;
        const bf16_t* bp = Bt + (size_t)(tn * 16 * TN + r) * ldb + q * 8;
        for (int k0 = 0; k0 < K; k0 += 32) {
            bf16x8 af[TM], bfr[TN];
#pragma unroll
            for (int i = 0; i < TM; ++i) af[i] = *(const bf16x8*)(ap + (size_t)i * 16 * lda + k0);
#pragma unroll
            for (int j = 0; j < TN; ++j) bfr[j] = *(const bf16x8*)(bp + (size_t)j * 16 * ldb + k0);
#pragma unroll
            for (int i = 0; i < TM; ++i)
#pragma unroll
                for (int j = 0; j < TN; ++j) acc[i][j] = __builtin_amdgcn_mfma_f32_16x16x32_bf16(af[i], bfr[j], acc[i][j], 0, 0, 0);
        }
#pragma unroll
        for (int i = 0; i < TM; ++i)
#pragma unroll
            for (int j = 0; j < TN; ++j)
#pragma unroll
                for (int e = 0; e < 4; ++e) epi(tm * 16 * TM + i * 16 + q * 4 + e, tn * 16 * TN + j * 16 + r, acc[i][j][e]);
    }
}
struct EpiProj { bf16_t* P; __device__ __forceinline__ void operator()(int row, int col, float v) const { if (col >= C_GL && col < C_QC) v = gelu_tanh(v); P[(size_t)row * INW + col] = (bf16_t)f2bf(v); } };
struct EpiGate { bf16_t* G; const float* b; __device__ __forceinline__ void operator()(int row, int col, float v) const { G[(size_t)row * GW + col] = (bf16_t)f2bf(sigmoid_(v + b[col])); } };
struct EpiStore { bf16_t* C; int ldc; __device__ __forceinline__ void operator()(int row, int col, float v) const { C[(size_t)row * ldc + col] = (bf16_t)f2bf(v); } };
struct EpiWo { const float* x; float* out; bf16_t* xb; __device__ __forceinline__ void operator()(int row, int col, float v) const { const size_t o = (size_t)row * D + col; const float y = x[o] + v; out[o] = y; xb[o] = (bf16_t)f2bf(y); } };
struct EpiQ { bf16_t* Q; const float* rs; __device__ __forceinline__ void operator()(int row, int col, float v) const { Q[(size_t)row * D + col] = (bf16_t)f2bf(v * rs[row]); } };

__device__ __forceinline__ void headnorm(bf16_t* vec, const float* g, float scale, int lane) {
    unsigned* p = (unsigned*)vec + lane; const unsigned w = *p;
    const float a = bf2f(w & 0xffffu), b = bf2f(w >> 16);
    const float rs = rsqrtf(wave_sum(a * a + b * b) * (1.f / 128.f) + EPS) * scale;
    *p = pk2(a * rs * g[2 * lane], b * rs * g[2 * lane + 1]);
}
struct HeadGains { float gq[32], gk[32], gc[8]; };
__device__ __forceinline__ void load_head_gains(HeadGains& hg, const float* gq, const float* gk, const float* gc, int lane) {
#pragma unroll
    for (int j = 0; j < 32; ++j) { hg.gq[j] = gq[(lane & 3) * 32 + j]; hg.gk[j] = gk[(lane & 3) * 32 + j]; }
#pragma unroll
    for (int j = 0; j < 8; ++j) hg.gc[j] = gc[(lane & 15) * 8 + j];
}
__device__ __forceinline__ void headnorm_token(bf16_t* row, const HeadGains& hg, float qscale, int lane) {
    u32x4* pa = (u32x4*)(row + C_QA) + lane * 4;
    u32x4* pc = (u32x4*)(row + C_QC) + lane;
    u32x4 w[4]; const u32x4 wc = *pc;
#pragma unroll
    for (int j = 0; j < 4; ++j) w[j] = pa[j];
    float f[32], fc[8]; float ss = 0.f, sc = 0.f;
#pragma unroll
    for (int j = 0; j < 4; ++j) unpack8(w[j], f + 8 * j);
    unpack8(wc, fc);
#pragma unroll
    for (int j = 0; j < 32; ++j) ss = fmaf(f[j], f[j], ss);
#pragma unroll
    for (int j = 0; j < 8; ++j) sc = fmaf(fc[j], fc[j], sc);
    ss += __shfl_xor(ss, 1); ss += __shfl_xor(ss, 2);
    sc += __shfl_xor(sc, 1); sc += __shfl_xor(sc, 2); sc += __shfl_xor(sc, 4); sc += __shfl_xor(sc, 8);
    const bool isq = lane < 32;
    const float rs = rsqrtf(ss * (1.f / 128.f) + EPS) * (isq ? qscale : 1.f), rc = rsqrtf(sc * (1.f / 128.f) + EPS) * qscale;
#pragma unroll
    for (int j = 0; j < 4; ++j) { u32x4 o;
        o.x = pk2(f[8 * j] * rs * (isq ? hg.gq[8 * j] : hg.gk[8 * j]), f[8 * j + 1] * rs * (isq ? hg.gq[8 * j + 1] : hg.gk[8 * j + 1]));
        o.y = pk2(f[8 * j + 2] * rs * (isq ? hg.gq[8 * j + 2] : hg.gk[8 * j + 2]), f[8 * j + 3] * rs * (isq ? hg.gq[8 * j + 3] : hg.gk[8 * j + 3]));
        o.z = pk2(f[8 * j + 4] * rs * (isq ? hg.gq[8 * j + 4] : hg.gk[8 * j + 4]), f[8 * j + 5] * rs * (isq ? hg.gq[8 * j + 5] : hg.gk[8 * j + 5]));
        o.w = pk2(f[8 * j + 6] * rs * (isq ? hg.gq[8 * j + 6] : hg.gk[8 * j + 6]), f[8 * j + 7] * rs * (isq ? hg.gq[8 * j + 7] : hg.gk[8 * j + 7]));
        pa[j] = o; }
    { u32x4 o; o.x = pk2(fc[0] * rc * hg.gc[0], fc[1] * rc * hg.gc[1]); o.y = pk2(fc[2] * rc * hg.gc[2], fc[3] * rc * hg.gc[3]);
      o.z = pk2(fc[4] * rc * hg.gc[4], fc[5] * rc * hg.gc[5]); o.w = pk2(fc[6] * rc * hg.gc[6], fc[7] * rc * hg.gc[7]); *pc = o; }
}

__device__ __forceinline__ void fp4_row_load(const float* __restrict__ src, const float* __restrict__ kscale, int lane, f32x4 (&v)[8]);
__device__ __forceinline__ void fp4_row_finish(const f32x4 (&v)[8], unsigned char* __restrict__ tab, int e, float* __restrict__ scale_out, int lane);
__device__ __forceinline__ void lru_pass1(const Params& p, int b, int c, int g, int lane, LAS unsigned char* wl  , const int tr0, const int trs) {
    const bf16_t* PROJ = (const bf16_t*)(p.ws + WS_PROJ);
    float* SUMA = (float*)(p.ws + WS_LRUSUM); float* SUMB = SUMA + BATCH * NCH * LW;
    bf16_t* AUA = (bf16_t*)(p.ws + WS_AUA); bf16_t* AUU = (bf16_t*)(p.ws + WS_AUU);
    const float* conv_w = p.in[7]; const float* conv_b = p.in[8]; const float* lru_wa = p.in[9]; const float* lru_ba = p.in[10];
    const float* lru_wx = p.in[11]; const float* lru_bx = p.in[12]; const float* lam = p.in[13];
    const int ch = g * 64 + lane;
    unsigned wa_p[32], wx_p[32];
#pragma unroll
    for (int m = 0; m < 32; ++m) { wa_p[m] = pk2(lru_wa[(size_t)(g * 64 + 2 * m) * 64 + lane], lru_wa[(size_t)(g * 64 + 2 * m + 1) * 64 + lane]);
        wx_p[m] = pk2(lru_wx[(size_t)(g * 64 + 2 * m) * 64 + lane], lru_wx[(size_t)(g * 64 + 2 * m + 1) * 64 + lane]); }
    const float cw0 = conv_w[0 * LW + ch], cw1 = conv_w[1 * LW + ch], cw2 = conv_w[2 * LW + ch], cw3 = conv_w[3 * LW + ch], cb = conv_b[ch];
    const float ba_ = lru_ba[ch], bx_ = lru_bx[ch];
    const float sp = log1pf(__expf(-lam[ch]));
    const int t0 = c * CHUNK; const size_t row0 = (size_t)b * SEQ + t0;
    float x0 = 0.f, x1 = 0.f, x2 = 0.f;
    if (t0 >= 3) { x0 = bf2f(PROJ[(row0 - 3) * INW + C_XL + ch]); x1 = bf2f(PROJ[(row0 - 2) * INW + C_XL + ch]); x2 = bf2f(PROJ[(row0 - 1) * INW + C_XL + ch]); }
    { const bf16_t* xs = PROJ + (row0 + (lane >> 3)) * INW + C_XL + g * 64 + (lane & 7) * 8;
      u32x4 tx[8];
#pragma unroll
      for (int i = 0; i < 8; ++i) tx[i] = *(const u32x4*)(xs + (size_t)(8 * i) * INW);
#pragma unroll
      for (int i = 0; i < 8; ++i) *(LAS u32x4*)(wl + (8 * i + (lane >> 3)) * 128 + (lane & 7) * 16) = tx[i]; }
    float h = 0.f, aprod = 1.f;
#define LRU_PAIRX(xc_) ({ const float xnb_ = __int_as_float(__builtin_amdgcn_update_dpp(0, __float_as_int(xc_), 0xB1, 0xf, 0xf, true));     \
        (lane & 1) ? pk2(xnb_, xc_) : pk2(xc_, xnb_); })
#define LRU_GATE(rp_, ip_, xc_, a_, u_) do { const float r_ = sigmoid_(rp_), ig_ = sigmoid_(ip_); const float la_ = -8.f * r_ * sp; a_ = __expf(la_); \
        u_ = sqrtf(fminf(fmaxf((1.f - a_) * (1.f + a_), 1e-12f), 1.f)) * ig_ * xc_; } while (0)
#define LRU_TOKPAIR(tp_) do { const int t_ = (tp_);                           \
        const float x3 = bf2f(*(const LAS bf16_t*)(wl + t_ * 128 + lane * 2)), x4 = bf2f(*(const LAS bf16_t*)(wl + (t_ + 1) * 128 + lane * 2)); \
        const float xcA = cw0 * x0 + cw1 * x1 + cw2 * x2 + cw3 * x3 + cb, xcB = cw0 * x1 + cw1 * x2 + cw2 * x3 + cw3 * x4 + cb; \
        x0 = x2; x1 = x3; x2 = x4; \
        const unsigned pkA = LRU_PAIRX(xcA), pkB = LRU_PAIRX(xcB); \
        float rA = ba_, iA = bx_, rA2 = 0.f, iA2 = 0.f, rB = ba_, iB = bx_, rB2 = 0.f, iB2 = 0.f; \
_Pragma("unroll") \
        for (int m = 0; m < 32; m += 2) { \
            const unsigned a0 = (unsigned)__builtin_amdgcn_readlane((int)pkA, 2 * m), a1 = (unsigned)__builtin_amdgcn_readlane((int)pkA, 2 * m + 2); \
            const unsigned b0 = (unsigned)__builtin_amdgcn_readlane((int)pkB, 2 * m), b1 = (unsigned)__builtin_amdgcn_readlane((int)pkB, 2 * m + 2); \
            rA = dot2bf(wa_p[m], a0, rA); iA = dot2bf(wx_p[m], a0, iA); rA2 = dot2bf(wa_p[m + 1], a1, rA2); iA2 = dot2bf(wx_p[m + 1], a1, iA2); \
            rB = dot2bf(wa_p[m], b0, rB); iB = dot2bf(wx_p[m], b0, iB); rB2 = dot2bf(wa_p[m + 1], b1, rB2); iB2 = dot2bf(wx_p[m + 1], b1, iB2); } \
        float aA, uA, aB, uB; \
        LRU_GATE(rA + rA2, iA + iA2, xcA, aA, uA); LRU_GATE(rB + rB2, iB + iB2, xcB, aB, uB); \
        \
        const unsigned wA = f2bf(1.f - aA), wB = f2bf(1.f - aB), vA = f2bf(uA), vB = f2bf(uB); \
        AUA[(row0 + t_) * LW + ch] = (bf16_t)wA; AUA[(row0 + t_ + 1) * LW + ch] = (bf16_t)wB; AUU[(row0 + t_) * LW + ch] = (bf16_t)vA; AUU[(row0 + t_ + 1) * LW + ch] = (bf16_t)vB; \
        const float aAq = 1.f - bf2f(wA), aBq = 1.f - bf2f(wB); \
        h = aBq * (aAq * h + bf2f(vA)) + bf2f(vB); \
        aprod *= aAq * aBq; \
    } while (0)
#define SIDE_LOAD(r_, v_) do { if ((r_) < 16384) fp4_row_load(p.in[25] + (size_t)(r_) * D, p.in[22], lane, v_); else if ((r_) < 32768) fp4_row_load(p.in[26] + (size_t)((r_) - 16384) * D, nullptr, lane, v_); } while (0)
#define SIDE_FIN(r_, v_) do { if ((r_) < 16384) fp4_row_finish(v_, p.ws + WS_TABU, (r_), (float*)(p.ws + WS_SCU) + (r_), lane); \
        else if ((r_) < 32768) fp4_row_finish(v_, p.ws + WS_TABV, (r_) - 16384, (float*)(p.ws + WS_SCV) + ((r_) - 16384), lane); } while (0)
    f32x4 sva[8]; int sr = tr0;
    SIDE_LOAD(sr, sva);
#pragma unroll 1
    for (int tt = 0; tt < CHUNK; tt += 4) {
        LRU_TOKPAIR(tt);
        SIDE_FIN(sr, sva); SIDE_LOAD(sr + trs, sva);
        LRU_TOKPAIR(tt + 2);
        sr += trs;
    }
#undef LRU_TOKPAIR
#undef SIDE_LOAD
#undef SIDE_FIN
#undef LRU_PAIRX
#undef LRU_GATE
    { const size_t o = (size_t)(b * NCH + c) * LW + ch; SUMA[o] = aprod; SUMB[o] = h; }
}
__device__ __forceinline__ void lru_pass2(const Params& p, int b, int c, int g, int lane) {
    const bf16_t* PROJ = (const bf16_t*)(p.ws + WS_PROJ); bf16_t* O = (bf16_t*)(p.ws + WS_HO);
    const float* SUMA = (const float*)(p.ws + WS_LRUSUM); const float* SUMB = SUMA + BATCH * NCH * LW;
    const bf16_t* AUA = (const bf16_t*)(p.ws + WS_AUA); const bf16_t* AUU = (const bf16_t*)(p.ws + WS_AUU);
    const int ch = g * 64 + lane; const size_t row0 = (size_t)b * SEQ + (size_t)c * CHUNK;
    const bf16_t* ap = AUA + row0 * LW + ch; const bf16_t* up = AUU + row0 * LW + ch; const bf16_t* gp = PROJ + row0 * INW + C_GL + ch;
    bf16_t an[16], un[16], gn[16];
#pragma unroll
    for (int q = 0; q < 16; ++q) { an[q] = ap[(size_t)q * LW]; un[q] = up[(size_t)q * LW]; gn[q] = gp[(size_t)q * INW]; }
    float h = 0.f;
    {
        int j = 0;
#pragma unroll 1
        for (; j + 32 <= c; j += 32) { float sa[32], sb[32];
#pragma unroll
            for (int q = 0; q < 32; ++q) { const size_t o = (size_t)(b * NCH + j + q) * LW + ch; sa[q] = SUMA[o]; sb[q] = SUMB[o]; }
#pragma unroll
            for (int q = 0; q < 32; ++q) h = sa[q] * h + sb[q]; }
#pragma unroll 1
        for (; j + 8 <= c; j += 8) { float sa[8], sb[8];
#pragma unroll
            for (int q = 0; q < 8; ++q) { const size_t o = (size_t)(b * NCH + j + q) * LW + ch; sa[q] = SUMA[o]; sb[q] = SUMB[o]; }
#pragma unroll
            for (int q = 0; q < 8; ++q) h = sa[q] * h + sb[q]; }
        for (; j < c; ++j) { const size_t o = (size_t)(b * NCH + j) * LW + ch; h = SUMA[o] * h + SUMB[o]; }
    }
#pragma unroll 1
    for (int tb = 0; tb < CHUNK; tb += 16) {
        bf16_t ac[16], uc[16], gc[16];
#pragma unroll
        for (int q = 0; q < 16; ++q) { ac[q] = an[q]; uc[q] = un[q]; gc[q] = gn[q]; }
        if (tb + 16 < CHUNK) {
#pragma unroll
            for (int q = 0; q < 16; ++q) { an[q] = ap[(size_t)(tb + 16 + q) * LW]; un[q] = up[(size_t)(tb + 16 + q) * LW]; gn[q] = gp[(size_t)(tb + 16 + q) * INW]; }
        }
#pragma unroll
        for (int q = 0; q < 16; ++q) { h = (1.f - bf2f(ac[q])) * h + bf2f(uc[q]); O[(row0 + tb + q) * D + AW + ch] = (bf16_t)f2bf(h * bf2f(gc[q])); }
    }
}

__device__ __forceinline__ void attn_simple(const bf16_t* Qp, int ldq, const bf16_t* Kp, const bf16_t* Vp, int ldkv, int nkeys, int koff, const float* bias_h, bf16_t* Op, int ldo, int tid) {
    const int qi = tid >> 2, part = tid & 3;
    float q[32], o[32];
    { const u32x4* qp = (const u32x4*)(Qp + (size_t)qi * ldq + part * 32);
#pragma unroll
      for (int j = 0; j < 4; ++j) unpack8(qp[j], q + 8 * j); }
#pragma unroll
    for (int d = 0; d < 32; ++d) o[d] = 0.f;
    float m = -1e30f, l = 0.f;
    for (int kk0 = 0; kk0 < nkeys; kk0 += 8) {
        float s[8];
#pragma unroll
        for (int j = 0; j < 8; ++j) {
            const u32x4* kp = (const u32x4*)(Kp + (size_t)(kk0 + j) * ldkv + part * 32);
            float acc = 0.f;
#pragma unroll
            for (int w = 0; w < 4; ++w) { float kf[8]; unpack8(kp[w], kf);
#pragma unroll
                for (int e = 0; e < 8; ++e) acc = fmaf(q[8 * w + e], kf[e], acc); }
            acc += __shfl_xor(acc, 1); acc += __shfl_xor(acc, 2);
            if (bias_h) { int dist = qi + koff - (kk0 + j); dist = dist < -128 ? -128 : (dist > 128 ? 128 : dist); acc += bias_h[dist + 128]; }
            s[j] = acc;
        }
        float mx = s[0];
#pragma unroll
        for (int j = 1; j < 8; ++j) mx = fmaxf(mx, s[j]);
        const float mn = fmaxf(m, mx), corr = __expf(m - mn);
        l *= corr;
#pragma unroll
        for (int d = 0; d < 32; ++d) o[d] *= corr;
#pragma unroll
        for (int j = 0; j < 8; ++j) {
            const float pj = __expf(s[j] - mn); l += pj;
            const u32x4* vp = (const u32x4*)(Vp + (size_t)(kk0 + j) * ldkv + part * 32);
#pragma unroll
            for (int w = 0; w < 4; ++w) { float vf[8]; unpack8(vp[w], vf);
#pragma unroll
                for (int e = 0; e < 8; ++e) o[8 * w + e] = fmaf(pj, vf[e], o[8 * w + e]); }
        }
        m = mn;
    }
    const float inv = 1.f / l;
    u32x4* op = (u32x4*)(Op + (size_t)qi * ldo + part * 32);
#pragma unroll
    for (int w = 0; w < 4; ++w) { u32x4 ov; ov.x = pk2(o[8 * w] * inv, o[8 * w + 1] * inv); ov.y = pk2(o[8 * w + 2] * inv, o[8 * w + 3] * inv); ov.z = pk2(o[8 * w + 4] * inv, o[8 * w + 5] * inv); ov.w = pk2(o[8 * w + 6] * inv, o[8 * w + 7] * inv); op[w] = ov; }
}

__device__ __forceinline__ void gemm_branch(const bf16_t* __restrict__ Ob, const bf16_t* __restrict__ WT, const bf16_t* __restrict__ G, bf16_t* __restrict__ Mg, int gw, int NW, int lane) {
    const int r = lane & 15, q = lane >> 4;
    const int ntn = D / 32, ntiles = (T / 32) * ntn;
    for (int tile = gw; tile < ntiles; tile += NW) {
        const int tm = tile / ntn, tn = tile % ntn;
        f32x4 acc[3][2][2];
#pragma unroll
        for (int s = 0; s < 3; ++s)
#pragma unroll
            for (int i = 0; i < 2; ++i)
#pragma unroll
                for (int j = 0; j < 2; ++j) acc[s][i][j] = (f32x4){0.f, 0.f, 0.f, 0.f};
        const bf16_t* ap = Ob + (size_t)(tm * 32 + r) * D + q * 8;
        const bf16_t* bp = WT + (size_t)(tn * 32 + r) * D + q * 8;
#pragma unroll
        for (int s = 0; s < 3; ++s) {
            const int kb = s == 0 ? 0 : (s == 1 ? 1024 : 1536), ke = s == 0 ? 1024 : (s == 1 ? 1536 : 2048);
            for (int k0 = kb; k0 < ke; k0 += 32) {
                bf16x8 af[2], bfr[2];
#pragma unroll
                for (int i = 0; i < 2; ++i) af[i] = *(const bf16x8*)(ap + (size_t)i * 16 * D + k0);
#pragma unroll
                for (int j = 0; j < 2; ++j) bfr[j] = *(const bf16x8*)(bp + (size_t)j * 16 * D + k0);
#pragma unroll
                for (int i = 0; i < 2; ++i)
#pragma unroll
                    for (int j = 0; j < 2; ++j) acc[s][i][j] = __builtin_amdgcn_mfma_f32_16x16x32_bf16(af[i], bfr[j], acc[s][i][j], 0, 0, 0);
            }
        }
#pragma unroll
        for (int i = 0; i < 2; ++i)
#pragma unroll
            for (int j = 0; j < 2; ++j)
#pragma unroll
                for (int e = 0; e < 4; ++e) {
                    const int row = tm * 32 + i * 16 + q * 4 + e, col = tn * 32 + j * 16 + r;
                    const bf16_t* gp = G + (size_t)row * GW + col;
                    const float mval = bf2f(gp[0]) * acc[0][i][j][e] + bf2f(gp[2048]) * acc[1][i][j][e] + bf2f(gp[4096]) * acc[2][i][j][e];
                    Mg[(size_t)row * D + col] = (bf16_t)f2bf(mval);
                }
    }
}

__device__ __forceinline__ unsigned long long shfl_xor64(unsigned long long v, int m) {
    const unsigned lo = __shfl_xor((unsigned)v, m), hi = __shfl_xor((unsigned)(v >> 32), m);
    return ((unsigned long long)hi << 32) | lo;
}
__device__ __forceinline__ unsigned fkey(float f) { const unsigned u = __float_as_uint(f); return (u & 0x80000000u) ? ~u : (u | 0x80000000u); }
__device__ __forceinline__ float fkey_inv(unsigned k) { const unsigned u = (k & 0x80000000u) ? (k & 0x7fffffffu) : ~k; return __uint_as_float(u); }
__device__ __forceinline__ unsigned long long wave_max64(unsigned long long k) {
#pragma unroll
    for (int o = 1; o < 64; o <<= 1) { const unsigned long long t = shfl_xor64(k, o); k = t > k ? t : k; }
    return k;
}
__device__ __forceinline__ void route_unit(const Params& p, int t, int h, int lane) {
    const bf16_t* Q = (const bf16_t*)(p.ws + WS_Q); const bf16_t* KB = (const bf16_t*)(p.ws + WS_KEYSB);
    int* RIDX = (int*)(p.ws + WS_RIDX); float* RG = (float*)(p.ws + WS_RG);
    float sv_l[2] = {0.f, 0.f}; int si_l[2] = {0, 0};
#pragma unroll
    for (int c = 0; c < 2; ++c) {
        const bf16_t* qv = Q + (size_t)t * D + h * 256 + c * 128;
        const unsigned qw = ((const unsigned*)qv)[lane];
        const float qa = bf2f(qw & 0xffffu), qb = bf2f(qw >> 16);
        const bf16_t* k0p = KB + ((size_t)(h * 2 + c) * NKEYS + lane) * 128;
        const bf16_t* k1p = k0p + 64 * 128;
        float s0 = 0.f, s1 = 0.f;
#pragma unroll
        for (int w = 0; w < 16; ++w) {
            float k0f[8], k1f[8]; unpack8(((const u32x4*)k0p)[w], k0f); unpack8(((const u32x4*)k1p)[w], k1f);
#pragma unroll
            for (int e = 0; e < 8; e += 2) {
                const int src = 4 * w + e / 2;
                const float xa = __int_as_float(__builtin_amdgcn_readlane(__float_as_int(qa), src));
                const float xb = __int_as_float(__builtin_amdgcn_readlane(__float_as_int(qb), src));
                s0 = fmaf(xa, k0f[e], s0); s0 = fmaf(xb, k0f[e + 1], s0);
                s1 = fmaf(xa, k1f[e], s1); s1 = fmaf(xb, k1f[e + 1], s1);
            }
        }
        unsigned long long ka = ((unsigned long long)fkey(s0) << 32) | (unsigned)(255 - lane);
        unsigned long long kb = ((unsigned long long)fkey(s1) << 32) | (unsigned)(255 - (lane + 64));
        for (int rnd = 0; rnd < TOPK; ++rnd) {
            const unsigned long long best = wave_max64(ka > kb ? ka : kb);
            if (ka == best) ka = 0ull; if (kb == best) kb = 0ull;
            if (lane == rnd) { sv_l[c] = fkey_inv((unsigned)(best >> 32)); si_l[c] = 255 - (int)(best & 0xffffffffu); }
        }
    }
    unsigned long long kc[4];
#pragma unroll
    for (int m = 0; m < 4; ++m) { const int cid = lane + 64 * m, i = cid >> 4, j = cid & 15;
        const float v = __shfl(sv_l[0], i) + __shfl(sv_l[1], j);
        kc[m] = ((unsigned long long)fkey(v) << 32) | (unsigned)(1023 - cid); }
    float fv = 0.f; int cidx = 0;
    for (int rnd = 0; rnd < TOPK; ++rnd) {
        unsigned long long loc = kc[0] > kc[1] ? kc[0] : kc[1]; const unsigned long long loc2 = kc[2] > kc[3] ? kc[2] : kc[3]; loc = loc > loc2 ? loc : loc2;
        const unsigned long long best = wave_max64(loc);
#pragma unroll
        for (int m = 0; m < 4; ++m) if (kc[m] == best) kc[m] = 0ull;
        if (lane == rnd) { fv = fkey_inv((unsigned)(best >> 32)); cidx = 1023 - (int)(best & 0xffffffffu); }
    }
    const float fmax_ = __shfl(fv, 0);
    float e = lane < 16 ? __expf(fv - fmax_) : 0.f;
    float ssum = e;
#pragma unroll
    for (int o = 1; o < 16; o <<= 1) ssum += __shfl_xor(ssum, o);
    const int ci = cidx >> 4, cj = cidx & 15;
    const int e0 = __shfl(si_l[0], ci), e1 = __shfl(si_l[1], cj);
    if (lane < 16) { RIDX[(size_t)t * 128 + h * 16 + lane] = e0 * NKEYS + e1; RG[(size_t)t * 128 + h * 16 + lane] = e / ssum; }
}

typedef float f32x2 __attribute__((ext_vector_type(2)));
__device__ __forceinline__ void fp4_row_load(const float* __restrict__ src, const float* __restrict__ kscale, int lane, f32x4 (&v)[8]) {
#pragma unroll
    for (int j = 0; j < 8; ++j) { v[j] = ((const f32x4*)src)[64 * j + lane]; if (kscale) v[j] = v[j] * ((const f32x4*)kscale)[64 * j + lane]; }
}
__device__ __forceinline__ void fp4_row_finish(const f32x4 (&v)[8], unsigned char* __restrict__ tab, int e, float* __restrict__ scale_out, int lane) {
    float mx = 0.f;
#pragma unroll
    for (int j = 0; j < 8; ++j) mx = fmaxf(mx, fmaxf(fmaxf(fabsf(v[j].x), fabsf(v[j].y)), fmaxf(fabsf(v[j].z), fabsf(v[j].w))));
#pragma unroll
    for (int o = 1; o < 64; o <<= 1) mx = fmaxf(mx, __shfl_xor(mx, o));
    const float sc = mx > 0.f ? mx * (1.f / 6.f) : 1.f, inv = 1.f / sc;
#pragma unroll
    for (int j = 0; j < 8; ++j) {
        const f32x4 a = v[j] * inv;
        unsigned pk = 0u;
        pk = __builtin_amdgcn_cvt_scalef32_pk_fp4_f32(pk, fminf(fmaxf(a.x, -6.f), 6.f), fminf(fmaxf(a.y, -6.f), 6.f), 1.0f, 0);
        pk = __builtin_amdgcn_cvt_scalef32_pk_fp4_f32(pk, fminf(fmaxf(a.z, -6.f), 6.f), fminf(fmaxf(a.w, -6.f), 6.f), 1.0f, 1);
        *(unsigned short*)(tab + ((size_t)j * 16384 + e) * 128 + 2 * lane) = (unsigned short)pk;
    }
    if (lane == 0) *scale_out = sc;
}
__device__ __forceinline__ void fp4_tables(const Params& p, int gw, int NW, int lane) {
    f32x4 va[8], vb[8];
#define FP4_LOAD(r, v) do { if ((r) < 16384) fp4_row_load(p.in[25] + (size_t)(r) * D, p.in[22], lane, v); else fp4_row_load(p.in[26] + (size_t)((r) - 16384) * D, nullptr, lane, v); } while (0)
#define FP4_FIN(r, v) do { if ((r) < 16384) fp4_row_finish(v, p.ws + WS_TABU, (r), (float*)(p.ws + WS_SCU) + (r), lane); \
        else fp4_row_finish(v, p.ws + WS_TABV, (r) - 16384, (float*)(p.ws + WS_SCV) + ((r) - 16384), lane); } while (0)
    const int n = 2 * 16384;
    int r = gw;
    if (r < n) FP4_LOAD(r, va);
    for (; r < n; r += 2 * NW) {
        const bool hb = r + NW < n;
        if (hb) FP4_LOAD(r + NW, vb);
        FP4_FIN(r, va);
        if (r + 2 * NW < n) FP4_LOAD(r + 2 * NW, va);
        if (hb) FP4_FIN(r + NW, vb);
    }
#undef FP4_LOAD
#undef FP4_FIN
}
constexpr size_t WS_ZP = WS_Q;
constexpr size_t WS_X2F8 = 2 * MiB;
__device__ __forceinline__ float dot_chunk(const u32x4 w, const float (&xf)[32]) {
    float a0 = 0.f, a1 = 0.f;
#pragma unroll
    for (int q = 0; q < 4; ++q) {
        const f32x2 a = __builtin_amdgcn_cvt_scalef32_pk_f32_fp4(w[q], 1.0f, 0), b = __builtin_amdgcn_cvt_scalef32_pk_f32_fp4(w[q], 1.0f, 1);
        const f32x2 c = __builtin_amdgcn_cvt_scalef32_pk_f32_fp4(w[q], 1.0f, 2), d = __builtin_amdgcn_cvt_scalef32_pk_f32_fp4(w[q], 1.0f, 3);
        a0 = fmaf(a.x, xf[8 * q], a0); a1 = fmaf(a.y, xf[8 * q + 1], a1); a0 = fmaf(b.x, xf[8 * q + 2], a0); a1 = fmaf(b.y, xf[8 * q + 3], a1);
        a0 = fmaf(c.x, xf[8 * q + 4], a0); a1 = fmaf(c.y, xf[8 * q + 5], a1); a0 = fmaf(d.x, xf[8 * q + 6], a0); a1 = fmaf(d.y, xf[8 * q + 7], a1);
    }
    return a0 + a1;
}
__device__ __forceinline__ void axpy_chunk(const u32x4 w, const float a_, float (&of)[32]) {
#pragma unroll
    for (int q = 0; q < 4; ++q) {
        const f32x2 a = __builtin_amdgcn_cvt_scalef32_pk_f32_fp4(w[q], 1.0f, 0), b = __builtin_amdgcn_cvt_scalef32_pk_f32_fp4(w[q], 1.0f, 1);
        const f32x2 c = __builtin_amdgcn_cvt_scalef32_pk_f32_fp4(w[q], 1.0f, 2), d = __builtin_amdgcn_cvt_scalef32_pk_f32_fp4(w[q], 1.0f, 3);
        of[8 * q] = fmaf(a_, a.x, of[8 * q]); of[8 * q + 1] = fmaf(a_, a.y, of[8 * q + 1]); of[8 * q + 2] = fmaf(a_, b.x, of[8 * q + 2]); of[8 * q + 3] = fmaf(a_, b.y, of[8 * q + 3]);
        of[8 * q + 4] = fmaf(a_, c.x, of[8 * q + 4]); of[8 * q + 5] = fmaf(a_, c.y, of[8 * q + 5]); of[8 * q + 6] = fmaf(a_, d.x, of[8 * q + 6]); of[8 * q + 7] = fmaf(a_, d.y, of[8 * q + 7]);
    }
}
struct PeerTok { u32x4 w[16]; u32x4 x[4]; };
template <bool USTEP>
__device__ __forceinline__ void peer_issue(PeerTok& k, const Params& p, const unsigned char* tab, int t, int xv, int lane) {
    const int* RIDX = (const int*)(p.ws + WS_RIDX);
    const int i0 = RIDX[(size_t)t * 128 + lane], i1 = RIDX[(size_t)t * 128 + 64 + lane];
    const int es = lane >> 3, ck = lane & 7;
    if (USTEP) { const bf16_t* xp = (const bf16_t*)(p.ws + WS_X2BF) + (size_t)t * D + 256 * xv + 32 * ck;
#pragma unroll
        for (int j = 0; j < 4; ++j) k.x[j] = *(const u32x4*)(xp + 8 * j); }
#pragma unroll
    for (int g = 0; g < 16; ++g) { const int e = __shfl(g < 8 ? i0 : i1, (8 * g + es) & 63); k.w[g] = *(const u32x4*)(tab + (size_t)e * 128 + ck * 16); }
}
__device__ __forceinline__ void peer_u_finish(const PeerTok& k, const Params& p, int t, int xv, int lane) {
    const int es = lane >> 3, ck = lane & 7;
    float xf[32];
#pragma unroll
    for (int j = 0; j < 4; ++j) unpack8(k.x[j], xf + 8 * j);
    float zsel0 = 0.f, zsel1 = 0.f;
#pragma unroll
    for (int g = 0; g < 16; ++g) { u32x4 w_ = k.w[g]; asm volatile("" : "+v"(w_)); float d = dot_chunk(w_, xf);
        d += __int_as_float(__builtin_amdgcn_update_dpp(0, __float_as_int(d), 0xB1, 0xf, 0xf, true));
        d += __int_as_float(__builtin_amdgcn_update_dpp(0, __float_as_int(d), 0x4E, 0xf, 0xf, true));
        d += __int_as_float(__builtin_amdgcn_update_dpp(0, __float_as_int(d), 0x141, 0xf, 0xf, true));
        if (g < 8) { if (ck == g) zsel0 = d; } else { if (ck == g - 8) zsel1 = d; }
        asm volatile("" : "+v"(zsel0), "+v"(zsel1)); }
    float* zp = (float*)(p.ws + WS_ZP) + ((size_t)xv * T + t) * 128;
    zp[8 * ck + es] = zsel0; zp[64 + 8 * ck + es] = zsel1;
}
__device__ __forceinline__ void peer_v_finish(const PeerTok& k, const Params& p, int t, int xv, int lane, LAS float* red) {
    const float* RG = (const float*)(p.ws + WS_RG);
    const float a0 = RG[(size_t)t * 128 + lane], a1 = RG[(size_t)t * 128 + 64 + lane];
    const int es = lane >> 3, ck = lane & 7;
    float of[32];
#pragma unroll
    for (int q = 0; q < 32; ++q) of[q] = 0.f;
#pragma unroll
    for (int g = 0; g < 16; ++g) { const float a = __shfl(g < 8 ? a0 : a1, (8 * g + es) & 63); u32x4 w_ = k.w[g]; asm volatile("" : "+v"(w_)); axpy_chunk(w_, a, of);
        asm volatile("" : "+v"(of[0]), "+v"(of[1]), "+v"(of[2]), "+v"(of[3]), "+v"(of[4]), "+v"(of[5]), "+v"(of[6]), "+v"(of[7]), "+v"(of[8]), "+v"(of[9]), "+v"(of[10]), "+v"(of[11]), "+v"(of[12]), "+v"(of[13]), "+v"(of[14]), "+v"(of[15]));
        asm volatile("" : "+v"(of[16]), "+v"(of[17]), "+v"(of[18]), "+v"(of[19]), "+v"(of[20]), "+v"(of[21]), "+v"(of[22]), "+v"(of[23]), "+v"(of[24]), "+v"(of[25]), "+v"(of[26]), "+v"(of[27]), "+v"(of[28]), "+v"(of[29]), "+v"(of[30]), "+v"(of[31])); }
#pragma unroll
    for (int q = 0; q < 8; ++q) *(LAS f32x4*)(red + es * 256 + ck * 32 + 4 * q) = (f32x4){of[4 * q], of[4 * q + 1], of[4 * q + 2], of[4 * q + 3]};
    f32x4 s = *(const LAS f32x4*)(red + 4 * lane);
#pragma unroll
    for (int r = 1; r < 8; ++r) s = s + *(const LAS f32x4*)(red + r * 256 + 4 * lane);
    f32x4* o4 = (f32x4*)(p.out + (size_t)t * D + 256 * xv + 4 * lane);
    *o4 = *o4 + s;
}
template <bool USTEP>
__device__ __forceinline__ void peer_step(const Params& p, int lane, int wave, LAS float* red, int pos, int nx, int rank, int nloc) {
    for (int xv = pos; xv < 8; xv += nx) {
        const int wx = rank * 8 + wave, nwx = nloc * 8;
        const unsigned char* tab = p.ws + (USTEP ? WS_TABU : WS_TABV) + (size_t)xv * 16384 * 128;
        PeerTok A, B;
        int t = wx;
        if (t < T) peer_issue<USTEP>(A, p, tab, t, xv, lane);
#pragma unroll 1
        for (; t < T; t += 2 * nwx) {
            const bool hb = t + nwx < T;
            if (hb) peer_issue<USTEP>(B, p, tab, t + nwx, xv, lane);
            if (USTEP) peer_u_finish(A, p, t, xv, lane); else peer_v_finish(A, p, t, xv, lane, red);
            if (t + 2 * nwx < T) peer_issue<USTEP>(A, p, tab, t + 2 * nwx, xv, lane);
            if (hb) { if (USTEP) peer_u_finish(B, p, t + nwx, xv, lane); else peer_v_finish(B, p, t + nwx, xv, lane, red); }
        }
    }
}
typedef int v8i_p __attribute__((ext_vector_type(8))); typedef int v4i_t __attribute__((ext_vector_type(4)));
struct PeerTokU { u32x4 w[16]; u32x4 b[2][2]; };
__device__ __forceinline__ void peer_u_issue(PeerTokU& k, const Params& p, const unsigned char* tab, int t, int xv, int lane) {
    const int* RIDX = (const int*)(p.ws + WS_RIDX);
    const int i0 = RIDX[(size_t)t * 128 + lane], i1 = RIDX[(size_t)t * 128 + 64 + lane];
    const int es = lane >> 3, ck = lane & 7, q = lane >> 4;
    const unsigned char* xp = p.ws + WS_X2F8 + (size_t)t * D + 256 * xv + 16 * q;
#pragma unroll
    for (int kb = 0; kb < 2; ++kb) { k.b[kb][0] = *(const u32x4*)(xp + 128 * kb); k.b[kb][1] = *(const u32x4*)(xp + 128 * kb + 64); }
#pragma unroll
    for (int g = 0; g < 16; ++g) { const int e = __shfl(g < 8 ? i0 : i1, (8 * g + es) & 63); k.w[g] = *(const u32x4*)(tab + (size_t)e * 128 + ck * 16); }
}
__device__ __forceinline__ void peer_u_mfma(const PeerTokU& k, const Params& p, int t, int xv, int lane, LAS unsigned char* vl) {
    float* zp = (float*)(p.ws + WS_ZP) + ((size_t)xv * T + t) * 128;
    const int es = lane >> 3, ck = lane & 7, r16 = lane & 15, q = lane >> 4;
#pragma unroll
    for (int g = 0; g < 16; ++g) { const int row = 8 * g + es; *(LAS u32x4*)(vl + row * 128 + ((ck ^ (row & 7)) << 4)) = k.w[g]; }
    v8i_p b0, b1;
    { const v4i_t x0 = __builtin_bit_cast(v4i_t, k.b[0][0]), x1 = __builtin_bit_cast(v4i_t, k.b[0][1]), y0 = __builtin_bit_cast(v4i_t, k.b[1][0]), y1 = __builtin_bit_cast(v4i_t, k.b[1][1]);
      b0 = __builtin_shufflevector(x0, x1, 0, 1, 2, 3, 4, 5, 6, 7); b1 = __builtin_shufflevector(y0, y1, 0, 1, 2, 3, 4, 5, 6, 7); }
#pragma unroll
    for (int g = 0; g < 8; ++g) {
        const int row = 16 * g + r16;
        const v4i_t a0 = __builtin_bit_cast(v4i_t, *(const LAS u32x4*)(vl + row * 128 + ((q ^ (row & 7)) << 4)));
        const v4i_t a1 = __builtin_bit_cast(v4i_t, *(const LAS u32x4*)(vl + row * 128 + (((4 + q) ^ (row & 7)) << 4)));
        const v8i_p A0 = {a0[0], a0[1], a0[2], a0[3], 0, 0, 0, 0}, A1 = {a1[0], a1[1], a1[2], a1[3], 0, 0, 0, 0};
        f32x4 acc = {0.f, 0.f, 0.f, 0.f};
        acc = __builtin_amdgcn_mfma_scale_f32_16x16x128_f8f6f4(A0, b0, acc, 4, 0, 0, 0x7F7F7F7F, 0, 0x7F7F7F7F);
        acc = __builtin_amdgcn_mfma_scale_f32_16x16x128_f8f6f4(A1, b1, acc, 4, 0, 0, 0x7F7F7F7F, 0, 0x7F7F7F7F);
        if ((lane & 15) == 0) *(f32x4*)(zp + 16 * g + 4 * (lane >> 4)) = acc;
    }
}
__device__ __forceinline__ void peer_u_step(const Params& p, int lane, int wave, LAS unsigned char* vl, int pos, int nx, int rank, int nloc) {
    for (int xv = pos; xv < 8; xv += nx) {
        const int wx = rank * 8 + wave, nwx = nloc * 8;
        const unsigned char* tab = p.ws + WS_TABU + (size_t)xv * 16384 * 128;
        PeerTokU A, B;
        int t = wx;
        if (t < T) peer_u_issue(A, p, tab, t, xv, lane);
#pragma unroll 1
        for (; t < T; t += 2 * nwx) {
            const bool hb = t + nwx < T;
            if (hb) peer_u_issue(B, p, tab, t + nwx, xv, lane);
            peer_u_mfma(A, p, t, xv, lane, vl);
            if (t + 2 * nwx < T) peer_u_issue(A, p, tab, t + 2 * nwx, xv, lane);
            if (hb) peer_u_mfma(B, p, t + nwx, xv, lane, vl);
        }
    }
}
constexpr size_t WS_ACT8 = 34 * MiB, WS_ASC = 36 * MiB;
__device__ __forceinline__ void peer_combine(const Params& p, int t, int lane) {
    const float* ZP = (const float*)(p.ws + WS_ZP); const int* RIDX = (const int*)(p.ws + WS_RIDX); const float* RG = (const float*)(p.ws + WS_RG);
    const float* SCU = (const float*)(p.ws + WS_SCU); const float* SCV = (const float*)(p.ws + WS_SCV); const float* SS2 = (const float*)(p.ws + WS_CTL + CTL_SS2_BYTE);
    const float rs = rsqrtf(SS2[t] * (1.f / D) + EPS);
    float act[2];
#pragma unroll
    for (int hlf = 0; hlf < 2; ++hlf) { const size_t o = (size_t)t * 128 + 64 * hlf + lane; float z = 0.f;
#pragma unroll
        for (int x = 0; x < 8; ++x) z += ZP[((size_t)x * T) * 128 + o];
        const int e = RIDX[o];
        act[hlf] = gelu_tanh(z * rs * SCU[e]) * RG[o] * SCV[e]; }
    float mx = fmaxf(fabsf(act[0]), fabsf(act[1]));
#pragma unroll
    for (int o = 1; o < 64; o <<= 1) mx = fmaxf(mx, __shfl_xor(mx, o));
    const float sc = mx > 0.f ? mx * (1.f / 448.f) : 1.f, inv = 1.f / sc;
    unsigned char* a8 = p.ws + WS_ACT8 + (size_t)t * 128;
    a8[lane] = (unsigned char)(__builtin_amdgcn_cvt_pk_fp8_f32(act[0] * inv, 0.f, 0, false) & 0xff);
    a8[64 + lane] = (unsigned char)(__builtin_amdgcn_cvt_pk_fp8_f32(act[1] * inv, 0.f, 0, false) & 0xff);
    if (lane == 0) ((float*)(p.ws + WS_ASC))[t] = sc;
}
typedef int v2i_t __attribute__((ext_vector_type(2)));
struct PeerTokV { u32x4 w[16]; u32x4 b[2]; };
__device__ __forceinline__ void peer_v_issue(PeerTokV& k, const Params& p, const unsigned char* tab, int t, int lane) {
    const int* RIDX = (const int*)(p.ws + WS_RIDX);
    const int i0 = RIDX[(size_t)t * 128 + lane], i1 = RIDX[(size_t)t * 128 + 64 + lane];
    const int es = lane >> 3, ck = lane & 7, q = lane >> 4;
    const unsigned char* ap = p.ws + WS_ACT8 + (size_t)t * 128 + 16 * q;
    k.b[0] = *(const u32x4*)ap; k.b[1] = *(const u32x4*)(ap + 64);
#pragma unroll
    for (int g = 0; g < 16; ++g) { const int e = __shfl(g < 8 ? i0 : i1, (8 * g + es) & 63); k.w[g] = *(const u32x4*)(tab + (size_t)e * 128 + ck * 16); }
}
__device__ __forceinline__ void peer_v_mfma(const PeerTokV& k, const Params& p, int t, int xv, int lane, LAS unsigned char* vl) {
    const int es = lane >> 3, ck = lane & 7, n = lane & 15, q = lane >> 4;
#pragma unroll
    for (int g = 0; g < 16; ++g) { const int row = 8 * g + es; *(LAS u32x4*)(vl + row * 128 + ((ck ^ (row & 7)) << 4)) = k.w[g]; }
    const v4i_t x0 = __builtin_bit_cast(v4i_t, k.b[0]), x1 = __builtin_bit_cast(v4i_t, k.b[1]);
    const v8i_p bop = __builtin_shufflevector(x0, x1, 0, 1, 2, 3, 4, 5, 6, 7);
    const int r1 = 32 * q + n, r2 = r1 + 16;
    f32x4 keep = {0.f, 0.f, 0.f, 0.f};
#pragma unroll
    for (int mb = 0; mb < 16; ++mb) {
        const v2i_t t1 = __builtin_amdgcn_ds_read_tr4_b64_v2i32((LAS v2i_t*)(vl + r1 * 128 + ((((mb >> 1) ^ (r1 & 7)) << 4) | ((mb & 1) << 3))));
        const v2i_t t2 = __builtin_amdgcn_ds_read_tr4_b64_v2i32((LAS v2i_t*)(vl + r2 * 128 + ((((mb >> 1) ^ (r2 & 7)) << 4) | ((mb & 1) << 3))));
        const v8i_p aop = {t1[0], t1[1], t2[0], t2[1], 0, 0, 0, 0};
        f32x4 acc = {0.f, 0.f, 0.f, 0.f};
        acc = __builtin_amdgcn_mfma_scale_f32_16x16x128_f8f6f4(aop, bop, acc, 4, 0, 0, 0x7F7F7F7F, 0, 0x7F7F7F7F);
        if (n == mb) keep = acc;
    }
    const float sc = ((const float*)(p.ws + WS_ASC))[t];
    const size_t oo = (size_t)t * D + 256 * xv + 16 * n + 4 * q;
    const u32x2 xw = *(const u32x2*)((const bf16_t*)(p.ws + WS_X2BF) + oo);
    const f32x4 x2v = {__uint_as_float(xw.x << 16), __uint_as_float(xw.x & 0xffff0000u), __uint_as_float(xw.y << 16), __uint_as_float(xw.y & 0xffff0000u)};
    *(f32x4*)(p.out + oo) = x2v + keep * sc;
}
__device__ __forceinline__ void peer_v_step(const Params& p, int lane, int wave, LAS unsigned char* vl, int pos, int nx, int rank, int nloc) {
    for (int xv = pos; xv < 8; xv += nx) {
        const int wx = rank * 8 + wave, nwx = nloc * 8;
        const unsigned char* tab = p.ws + WS_TABV + (size_t)xv * 16384 * 128;
        PeerTokV A, B;
        int t = wx;
        if (t < T) peer_v_issue(A, p, tab, t, lane);
#pragma unroll 1
        for (; t < T; t += 2 * nwx) {
            const bool hb = t + nwx < T;
            if (hb) peer_v_issue(B, p, tab, t + nwx, lane);
            peer_v_mfma(A, p, t, xv, lane, vl);
            if (t + 2 * nwx < T) peer_v_issue(A, p, tab, t + 2 * nwx, lane);
            if (hb) peer_v_mfma(B, p, t + nwx, xv, lane, vl);
        }
    }
}

namespace pg8 {
#define PG8_LAS __attribute__((address_space(3)))
constexpr int BM = 256, BK = 64, HALF = 128, HTB = HALF * BK * 2, STAGE_BYTES = 8 * HTB, NXCD = 8, WGM = 1;
__host__ __device__ __forceinline__ int lds_byte(int r, int c) { const int st = (r >> 4) * 2 + (c >> 5), rr = r & 15, cc = c & 31, ob = rr * 64 + cc * 2; return st * 1024 + (ob ^ (((ob >> 9) & 1) << 5)); }
__host__ __device__ __forceinline__ void stage_rc(int b, int& R, int& C) { const int st = b / 1024, sb = b % 1024, swz = sb ^ (((sb >> 9) & 1) << 5); R = (st >> 1) * 16 + swz / 64; C = (st & 1) * 32 + (swz % 64) / 2; }
__host__ __device__ __forceinline__ int perm32(int rho) { const int n = rho >> 4, i = rho & 15; return 8 * (i >> 2) + 4 * n + (i & 3); }
struct Unit { const char* A; const char* B; int pm, pn, kind, nt; };
__device__ __forceinline__ const char* uni_ptr(const char* p) { const unsigned long long v = (unsigned long long)p; const unsigned lo = __builtin_amdgcn_readfirstlane((unsigned)v), hi = __builtin_amdgcn_readfirstlane((unsigned)(v >> 32)); return (const char*)(((unsigned long long)hi << 32) | lo); }
__device__ __forceinline__ void uni(Unit& u) { u.A = uni_ptr(u.A); u.B = uni_ptr(u.B); u.pm = __builtin_amdgcn_readfirstlane(u.pm); u.pn = __builtin_amdgcn_readfirstlane(u.pn); u.kind = __builtin_amdgcn_readfirstlane(u.kind); u.nt = __builtin_amdgcn_readfirstlane(u.nt); }
template <int WG = WGM>
__device__ __forceinline__ void tile_of(int L, int nM, int nN, int& pm, int& pn) {
    const int nwg = nM * nN; int wgid = L; { const int q = nwg / NXCD, r = nwg % NXCD, xcd = wgid % NXCD, off = wgid / NXCD; wgid = (xcd < r ? xcd * (q + 1) : r * (q + 1) + (xcd - r) * q) + off; }
    const int nig = WG * nN, gid = wgid / nig, fm = gid * WG, gsz = (nM - fm) < WG ? (nM - fm) : WG;
    pm = fm + ((wgid % nig) % gsz); pn = (wgid % nig) / gsz;
}
typedef int v8i_t __attribute__((ext_vector_type(8))); typedef int v4i_t __attribute__((ext_vector_type(4)));
__device__ __forceinline__ v8i_t cat8(const bf16x8 lo, const bf16x8 hi) { const v4i_t a = __builtin_bit_cast(v4i_t, lo), b = __builtin_bit_cast(v4i_t, hi); return __builtin_shufflevector(a, b, 0, 1, 2, 3, 4, 5, 6, 7); }
template <bool FP8, class Epi, class Sched>
__device__ __forceinline__ void gemm_phase(PG8_LAS unsigned char* lds, const int lda, const int ldb, const Sched& S, const Epi& E, const int wid) {
    const int lane = fresh_lane(), tid = wid * 64 + lane, wr = wid >> 2, wc = wid & 3, fr = lane & 15, fq = lane >> 4;
    unsigned voffA[2], voffB[2];
#pragma unroll
    for (int i = 0; i < 2; ++i) { int R, C; stage_rc(tid * 16 + i * 8192, R, C); const int Rb = (R & ~31) + perm32(R & 31);
        voffA[i] = (unsigned)(R * lda + C) * 2u; voffB[i] = (unsigned)(Rb * ldb + C) * 2u; }
    const size_t kstep = (size_t)(BK * 2);
    const size_t hstepA = (size_t)HALF * lda * 2, hstepB = (size_t)HALF * ldb * 2;
    const unsigned ldsw = (unsigned)wid * 1024u;
    const int aoff = lds_byte(wr * 64 + fr, fq * 8), boff = lds_byte(wc * 32 + fr, fq * 8);
#define PG8_SA(b, h) (((b) * 2 + (h)) * HTB)
#define PG8_SB(b, h) ((4 + (b) * 2 + (h)) * HTB)
#define PG8_STAGE(bufoff, gbase, voff) do { _Pragma("unroll") for (int _i = 0; _i < 2; ++_i) \
        __builtin_amdgcn_global_load_lds((const unsigned*)((const char*)(gbase) + (voff)[_i]), (PG8_LAS unsigned*)(lds + (bufoff) + ldsw + _i * 8192), 16, 0, 0); } while (0)
#define PG8_LDA(dst, b, h) do { _Pragma("unroll") for (int m = 0; m < 4; ++m) { if constexpr (FP8) dst##8[m] = cat8(*(const PG8_LAS bf16x8*)(lds + PG8_SA(b, h) + aoff + m * 2048), *(const PG8_LAS bf16x8*)(lds + PG8_SA(b, h) + aoff + m * 2048 + 1024)); \
        else { _Pragma("unroll") for (int k = 0; k < 2; ++k) dst[m][k] = *(const PG8_LAS bf16x8*)(lds + PG8_SA(b, h) + aoff + m * 2048 + k * 1024); } } } while (0)
#define PG8_LDB(dst, b, h) do { _Pragma("unroll") for (int n = 0; n < 2; ++n) { if constexpr (FP8) dst##8[n] = cat8(*(const PG8_LAS bf16x8*)(lds + PG8_SB(b, h) + boff + n * 2048), *(const PG8_LAS bf16x8*)(lds + PG8_SB(b, h) + boff + n * 2048 + 1024)); \
        else { _Pragma("unroll") for (int k = 0; k < 2; ++k) dst[n][k] = *(const PG8_LAS bf16x8*)(lds + PG8_SB(b, h) + boff + n * 2048 + k * 1024); } } } while (0)
#define PG8_MMA(ai, bj, At, Bt) do { __builtin_amdgcn_s_setprio(1); \
        if constexpr (FP8) { _Pragma("unroll") for (int m = 0; m < 4; ++m) _Pragma("unroll") for (int n = 0; n < 2; ++n) \
            asm volatile("v_mfma_scale_f32_16x16x128_f8f6f4 %0, %1, %2, %0, %3, %3 op_sel_hi:[0,0,0]" : "+v"(acc[ai][bj][m][n]) : "v"(Bt##8[n]), "v"(At##8[m]), "v"(mxone)); } \
        else { _Pragma("unroll") for (int m = 0; m < 4; ++m) _Pragma("unroll") for (int n = 0; n < 2; ++n) _Pragma("unroll") for (int k = 0; k < 2; ++k) \
            acc[ai][bj][m][n] = __builtin_amdgcn_mfma_f32_16x16x32_bf16(Bt[n][k], At[m][k], acc[ai][bj][m][n], 0, 0, 0); } \
        __builtin_amdgcn_s_setprio(0); } while (0)
#define PG8_WAIT_V(n) asm volatile("s_waitcnt vmcnt(" #n ")" ::: "memory")
#define PG8_WAIT_L(n) asm volatile("s_waitcnt lgkmcnt(" #n ")" ::: "memory")
#define PG8_BAR __builtin_amdgcn_s_barrier()
#define PG8_SCHED __builtin_amdgcn_sched_barrier(0)
    Unit cur, nxt; int ui = 0;
    if (!S.next(0, cur)) return;
    f32x4 acc[2][2][4][2];
#pragma unroll
    for (int a = 0; a < 2; ++a)
#pragma unroll
        for (int b = 0; b < 2; ++b)
#pragma unroll
            for (int m = 0; m < 4; ++m)
#pragma unroll
                for (int n = 0; n < 2; ++n) acc[a][b][m][n] = (f32x4){0.f, 0.f, 0.f, 0.f};
    const int mxone = 0x7F7F7F7F;
    bf16x8 At[4][2], B0[2][2], B1[2][2]; v8i_t At8[4], B08[2], B18[2];
    const char* cA = cur.A; const char* cB = cur.B;
    PG8_STAGE(PG8_SB(0, 0), cB, voffB); PG8_STAGE(PG8_SB(0, 1), cB + hstepB, voffB); PG8_STAGE(PG8_SA(0, 0), cA, voffA); PG8_STAGE(PG8_SA(0, 1), cA + hstepA, voffA);
    if (wr == 1) PG8_BAR;
    PG8_WAIT_V(2); PG8_BAR;
    PG8_STAGE(PG8_SB(1, 0), cB + kstep, voffB); PG8_STAGE(PG8_SA(1, 0), cA + kstep, voffA); PG8_STAGE(PG8_SB(1, 1), cB + hstepB + kstep, voffB);
    PG8_WAIT_V(6); PG8_BAR;
    for (;;) {
        const bool has_next = S.next(ui + 1, nxt);
        const char* nA = has_next ? nxt.A : cA; const char* nB = has_next ? nxt.B : cB;
        const int nt = cur.nt;
        for (int t = 0; t < nt; t += 2) {
            const bool last = (t == nt - 2);
            const char* a1 = cA + (size_t)(t + 1) * kstep;
            const char* a2 = last ? nA : cA + (size_t)(t + 2) * kstep; const char* b2 = last ? nB : cB + (size_t)(t + 2) * kstep;
            const char* a3 = a2 + kstep; const char* b3 = b2 + kstep;
            PG8_LDB(B0, 0, 0); PG8_LDB(B1, 0, 1); PG8_SCHED; PG8_LDA(At, 0, 0); PG8_STAGE(PG8_SA(1, 1), a1 + hstepA, voffA);
            PG8_WAIT_V(8); PG8_WAIT_L(0); PG8_BAR; PG8_MMA(0, 0, At, B0); PG8_MMA(0, 1, At, B1); PG8_BAR; PG8_SCHED;
            PG8_LDA(At, 0, 1); PG8_STAGE(PG8_SB(0, 0), b2, voffB); PG8_STAGE(PG8_SB(0, 1), b2 + hstepB, voffB); PG8_STAGE(PG8_SA(0, 0), a2, voffA);
            PG8_WAIT_V(8); PG8_WAIT_L(0); PG8_BAR; PG8_MMA(1, 0, At, B0); PG8_MMA(1, 1, At, B1); PG8_BAR; PG8_SCHED;
            PG8_LDB(B0, 1, 0); PG8_LDB(B1, 1, 1); PG8_SCHED; PG8_LDA(At, 1, 0); PG8_STAGE(PG8_SA(0, 1), a2 + hstepA, voffA);
            PG8_WAIT_V(8); PG8_WAIT_L(0); PG8_BAR; PG8_MMA(0, 0, At, B0); PG8_MMA(0, 1, At, B1); PG8_BAR; PG8_SCHED;
            PG8_LDA(At, 1, 1); PG8_STAGE(PG8_SB(1, 0), b3, voffB); PG8_STAGE(PG8_SB(1, 1), b3 + hstepB, voffB); PG8_STAGE(PG8_SA(1, 0), a3, voffA);
            PG8_WAIT_V(8); PG8_WAIT_L(0); PG8_BAR; PG8_MMA(1, 0, At, B0); PG8_MMA(1, 1, At, B1); PG8_BAR; PG8_SCHED;
        }
        if (wr == 0) PG8_BAR;
        if constexpr (FP8) asm volatile("s_nop 15\n\ts_nop 15" ::: "memory");
        E(acc, cur, wr, wc, fr, fq);
        if (!has_next) break;
        if (E.reset(cur)) {
#pragma unroll
        for (int a = 0; a < 2; ++a)
#pragma unroll
            for (int b = 0; b < 2; ++b)
#pragma unroll
                for (int m = 0; m < 4; ++m)
#pragma unroll
                    for (int n = 0; n < 2; ++n) acc[a][b][m][n] = (f32x4){0.f, 0.f, 0.f, 0.f};
        }
        cur = nxt; cA = nA; cB = nB; ++ui;
        if (wr == 1) PG8_BAR;
    }
    PG8_WAIT_V(0);
    PG8_BAR;
#undef PG8_SA
#undef PG8_SB
#undef PG8_STAGE
#undef PG8_LDA
#undef PG8_LDB
#undef PG8_MMA
#undef PG8_WAIT_V
#undef PG8_WAIT_L
#undef PG8_BAR
#undef PG8_SCHED
}
}
typedef f32x4 AccT[2][2][4][2];
#define EPI_RESET_ALWAYS __device__ __forceinline__ bool reset(const pg8::Unit&) const { return true; }
__device__ __forceinline__ unsigned cvt_pk_bf16(float lo, float hi) { unsigned r; asm volatile("v_cvt_pk_bf16_f32 %0, %1, %2" : "=v"(r) : "v"(lo), "v"(hi)); return r; }
__device__ __forceinline__ u32x4 pack8(const f32x4 v0, const f32x4 v1) { u32x4 w; w.x = cvt_pk_bf16(v0[0], v0[1]); w.y = cvt_pk_bf16(v0[2], v0[3]); w.z = cvt_pk_bf16(v1[0], v1[1]); w.w = cvt_pk_bf16(v1[2], v1[3]); return w; }
template <int MODE>
__device__ __forceinline__ void store_tile_bf16(const AccT& acc, bf16_t* base, int ldc, int row0, int col0, const float* bias, const float ascale = 1.f) {
#pragma unroll
    for (int ai = 0; ai < 2; ++ai)
#pragma unroll
        for (int m = 0; m < 4; ++m) { bf16_t* rowp = base + (size_t)(row0 + ai * 128 + m * 16) * ldc + col0;
#pragma unroll
            for (int bj = 0; bj < 2; ++bj) { f32x4 v0 = acc[ai][bj][m][0], v1 = acc[ai][bj][m][1];
                if (MODE == 1) { _Pragma("unroll") for (int e = 0; e < 4; ++e) { v0[e] = gelu_tanh(v0[e]); v1[e] = gelu_tanh(v1[e]); } }
                if (MODE == 2) { const f32x4 b0 = *(const f32x4*)(bias + col0 + bj * 128), b1 = *(const f32x4*)(bias + col0 + bj * 128 + 4);
                    v0 = v0 * ascale + b0; v1 = v1 * ascale + b1; _Pragma("unroll") for (int e = 0; e < 4; ++e) { v0[e] = sigmoid_(v0[e]); v1[e] = sigmoid_(v1[e]); } }
                *(u32x4*)(rowp + bj * 128) = pack8(v0, v1); }
            if (MODE == 2) asm volatile("" ::: "memory"); }
}
struct SchedP1a { const char* H; const char* WT; const char* MEMN; const char* WTM; int G, c;
    __device__ __forceinline__ bool next(int i, pg8::Unit& u) const {
        const int L = i * G + c; const int n1 = 64 * 18;
        if (L < n1) { pg8::tile_of(L, 64, 18, u.pm, u.pn); u.kind = 0; u.A = H + (size_t)u.pm * 256 * D * 2; u.B = WT + (size_t)u.pn * 256 * D * 2; u.nt = D / 64; pg8::uni(u); return true; }
        if (L < n1 + 8) { const int j = L - n1; u.pm = j >> 2; u.pn = j & 3; u.kind = 1; u.A = MEMN + (size_t)u.pm * 256 * D * 2; u.B = WTM + (size_t)u.pn * 256 * D * 2; u.nt = D / 64; pg8::uni(u); return true; }
        return false; } };
struct EpiP1a { bf16_t* PROJ; bf16_t* MEMKV; const float* gq; const float* gk; const float* gc; const float* gmk; LAS float* xs; EPI_RESET_ALWAYS
    __device__ __forceinline__ void operator()(AccT& acc, const pg8::Unit& u, int wr, int wc, int fr, int fq) const {
        const int row0 = u.pm * 256 + wr * 64 + fr, cl = wc * 32 + 8 * fq;
        const float* g = nullptr; float qs = 1.f;
        if (u.kind == 1) { if (u.pn < 2) g = gmk; }
        else if (u.pn < 4) { g = gq; qs = 0.08838834764831845f; } else if (u.pn < 8) g = gk; else if (u.pn >= 16) { g = gc; qs = 0.08838834764831845f; }
        if (g) {
#pragma unroll
            for (int ai = 0; ai < 2; ++ai)
#pragma unroll
                for (int m = 0; m < 4; ++m)
#pragma unroll
                    for (int bj = 0; bj < 2; ++bj) { const f32x4 v0 = acc[ai][bj][m][0], v1 = acc[ai][bj][m][1];
                        float sq = (v0[0] * v0[0] + v0[1] * v0[1]) + (v0[2] * v0[2] + v0[3] * v0[3]) + (v1[0] * v1[0] + v1[1] * v1[1]) + (v1[2] * v1[2] + v1[3] * v1[3]);
                        sq += __shfl_xor(sq, 16); sq += __shfl_xor(sq, 32);
                        if (fq == 0) xs[((ai * 128 + wr * 64 + m * 16 + fr) * 2 + bj) * 4 + wc] = sq; asm volatile("" ::: "memory"); }
            asm volatile("s_waitcnt lgkmcnt(0)" ::: "memory"); __builtin_amdgcn_s_barrier(); asm volatile("" ::: "memory");
#pragma unroll
            for (int ai = 0; ai < 2; ++ai)
#pragma unroll
                for (int m = 0; m < 4; ++m)
#pragma unroll
                    for (int bj = 0; bj < 2; ++bj) { const f32x4 pp = *(const LAS f32x4*)(xs + ((ai * 128 + wr * 64 + m * 16 + fr) * 2 + bj) * 4);
                        const float rs = rsqrtf(((pp[0] + pp[1]) + (pp[2] + pp[3])) * (1.f / 128.f) + EPS) * qs;
                        const f32x4 g0 = *(const f32x4*)(g + cl), g1 = *(const f32x4*)(g + cl + 4);
                        acc[ai][bj][m][0] = acc[ai][bj][m][0] * g0 * rs; acc[ai][bj][m][1] = acc[ai][bj][m][1] * g1 * rs; asm volatile("" ::: "memory"); }
            asm volatile("s_waitcnt lgkmcnt(0)" ::: "memory"); __builtin_amdgcn_s_barrier(); asm volatile("" ::: "memory");
        }
        if (u.kind == 1) { store_tile_bf16<0>(acc, MEMKV, 2 * CW, row0, u.pn * 256 + cl, nullptr); return; }
        if (u.pn == 14 || u.pn == 15) { store_tile_bf16<1>(acc, PROJ, INW, row0, u.pn * 256 + cl, nullptr); return; }
        store_tile_bf16<0>(acc, PROJ, INW, row0, u.pn * 256 + cl, nullptr);
    } };
struct SchedP1b { const char* H8; const char* WT8; int G, c;
    __device__ __forceinline__ bool next(int i, pg8::Unit& u) const {
        const int L = i * G + c; if (L >= 64 * 24) return false;
        pg8::tile_of(L, 64, 24, u.pm, u.pn); u.kind = 0; u.A = H8 + (size_t)u.pm * 256 * D; u.B = WT8 + (size_t)u.pn * 256 * D; u.nt = D / 128; pg8::uni(u); return true; } };
struct EpiP1b { bf16_t* G; const float* bgate; EPI_RESET_ALWAYS
    __device__ __forceinline__ void operator()(AccT& acc, const pg8::Unit& u, int wr, int wc, int fr, int fq) const {
        store_tile_bf16<2>(acc, G, GW, u.pm * 256 + wr * 64 + fr, u.pn * 256 + wc * 32 + 8 * fq, bgate, 1.f / GATE_WSCALE);
    } };
struct SchedP3 { const char* O; const char* WT; int G, c;
    __device__ __forceinline__ bool next(int i, pg8::Unit& u) const {
        const int ti = i / 3, seg = i - 3 * ti; const int L = ti * G + c; if (L >= 64 * 8) return false;
        pg8::tile_of(L, 64, 8, u.pm, u.pn); u.kind = seg;
        const int kb = seg == 0 ? 0 : (seg == 1 ? 1024 : 1536);
        u.A = O + ((size_t)u.pm * 256 * D + kb) * 2; u.B = WT + ((size_t)u.pn * 256 * D + kb) * 2; u.nt = seg == 0 ? 16 : 8; pg8::uni(u); return true; } };
struct EpiP3 { const bf16_t* G; bf16_t* MERGED;
    __device__ __forceinline__ bool reset(const pg8::Unit& u) const { return u.kind == 2; }
    __device__ __forceinline__ void operator()(AccT& acc, const pg8::Unit& u, int wr, int wc, int fr, int fq) const {
        const int row0 = u.pm * 256 + wr * 64 + fr, col0 = u.pn * 256 + wc * 32 + 8 * fq, seg = u.kind;
#pragma unroll
        for (int ai = 0; ai < 2; ++ai)
#pragma unroll
            for (int mh = 0; mh < 2; ++mh) {
                u32x4 ga[2][2], gb[2][2];
#pragma unroll
                for (int mm = 0; mm < 2; ++mm)
#pragma unroll
                    for (int bj = 0; bj < 2; ++bj) { const bf16_t* gp = G + (size_t)(row0 + ai * 128 + (mh * 2 + mm) * 16) * GW + col0 + bj * 128;
                        ga[mm][bj] = *(const u32x4*)(gp + seg * D); gb[mm][bj] = (seg < 2) ? *(const u32x4*)(gp + (seg + 1) * D) : (u32x4){0u, 0u, 0u, 0u}; }
#pragma unroll
                for (int mm = 0; mm < 2; ++mm)
#pragma unroll
                    for (int bj = 0; bj < 2; ++bj) { const int m = mh * 2 + mm;
                        float fa[8], fb[8]; unpack8(ga[mm][bj], fa); unpack8(gb[mm][bj], fb);
                        if (seg < 2) { _Pragma("unroll") for (int e = 0; e < 8; ++e) fa[e] = fa[e] * __builtin_amdgcn_rcpf(fmaxf(fb[e], 1e-20f)); }
                        f32x4& v0 = acc[ai][bj][m][0]; f32x4& v1 = acc[ai][bj][m][1];
                        v0[0] *= fa[0]; v0[1] *= fa[1]; v0[2] *= fa[2]; v0[3] *= fa[3]; v1[0] *= fa[4]; v1[1] *= fa[5]; v1[2] *= fa[6]; v1[3] *= fa[7];
                        if (seg == 2) *(u32x4*)(MERGED + (size_t)(row0 + ai * 128 + m * 16) * D + col0 + bj * 128) = pack8(v0, v1);
                    }
                asm volatile("" ::: "memory");
            }
    } };
struct SchedSq { const char* A; const char* WT; int G, c;
    __device__ __forceinline__ bool next(int i, pg8::Unit& u) const {
        const int L = i * G + c; if (L >= 64 * 8) return false;
        pg8::tile_of(L, 64, 8, u.pm, u.pn); u.kind = 0; u.A = A + (size_t)u.pm * 256 * D * 2; u.B = WT + (size_t)u.pn * 256 * D * 2; u.nt = D / 64; pg8::uni(u); return true; } };
struct EpiP4 { const float* x; float* out; bf16_t* xb; float* ss; unsigned char* x8; EPI_RESET_ALWAYS
    __device__ __forceinline__ void operator()(AccT& acc, const pg8::Unit& u, int wr, int wc, int fr, int fq) const {
        const int row0 = u.pm * 256 + wr * 64 + fr, col0 = u.pn * 256 + wc * 32 + 8 * fq;
#pragma unroll
        for (int ai = 0; ai < 2; ++ai)
#pragma unroll
            for (int m = 0; m < 4; ++m) { const size_t row = (size_t)(row0 + ai * 128 + m * 16); float sq = 0.f;
#pragma unroll
                for (int bj = 0; bj < 2; ++bj) { const size_t o = row * D + col0 + bj * 128;
                    const f32x4 v0 = acc[ai][bj][m][0] + *(const f32x4*)(x + o), v1 = acc[ai][bj][m][1] + *(const f32x4*)(x + o + 4);
                    *(u32x4*)(xb + o) = pack8(v0, v1);
#define F8X(x_) fminf(fmaxf((x_), -448.f), 448.f)
                    { int w0 = __builtin_amdgcn_cvt_pk_fp8_f32(F8X(v0[0]), F8X(v0[1]), 0, false); w0 = __builtin_amdgcn_cvt_pk_fp8_f32(F8X(v0[2]), F8X(v0[3]), w0, true);
                      int w1 = __builtin_amdgcn_cvt_pk_fp8_f32(F8X(v1[0]), F8X(v1[1]), 0, false); w1 = __builtin_amdgcn_cvt_pk_fp8_f32(F8X(v1[2]), F8X(v1[3]), w1, true);
                      *(u32x2*)(x8 + o) = (u32x2){(unsigned)w0, (unsigned)w1}; }
                    sq += (v0[0] * v0[0] + v0[1] * v0[1]) + (v0[2] * v0[2] + v0[3] * v0[3]) + (v1[0] * v1[0] + v1[1] * v1[1]) + (v1[2] * v1[2] + v1[3] * v1[3]); }
                sq += __shfl_xor(sq, 16); sq += __shfl_xor(sq, 32);
                if (fq == 0) atomicAdd(ss + row, sq); }
    } };
struct EpiP5 { bf16_t* Q; const float* ss; EPI_RESET_ALWAYS
    __device__ __forceinline__ void operator()(AccT& acc, const pg8::Unit& u, int wr, int wc, int fr, int fq) const {
        const int row0 = u.pm * 256 + wr * 64 + fr, col0 = u.pn * 256 + wc * 32 + 8 * fq;
#pragma unroll
        for (int ai = 0; ai < 2; ++ai)
#pragma unroll
            for (int m = 0; m < 4; ++m) { const size_t row = (size_t)(row0 + ai * 128 + m * 16); const float rs = rsqrtf(ss[row] * (1.f / D) + EPS);
#pragma unroll
                for (int bj = 0; bj < 2; ++bj) *(u32x4*)(Q + row * D + col0 + bj * 128) = pack8(acc[ai][bj][m][0] * rs, acc[ai][bj][m][1] * rs); }
    } };


namespace att {
using s16x4  = __attribute__((ext_vector_type(4))) short;
using f32x16 = __attribute__((ext_vector_type(16))) float;
constexpr int NWV = 8, QBLK = 32, KVBLK = 64, DH = 128;
constexpr float THR = 8.f;
constexpr int SHM_V = KVBLK * DH * 2, SHM_K = KVBLK * DH * 2;
constexpr int OFF_WS = 2 * SHM_V + 2 * SHM_K, OFF_BT = OFF_WS + NWV * 64 * 4, OFF_OST = OFF_BT + 1536, LDS_NEED = OFF_OST + NWV * 8192;
#define KSWZ(row, colB) ((row) * 256 + ((colB) ^ (((row) & 7) << 4)))
#define SBAR() __builtin_amdgcn_sched_barrier(0)
__device__ __forceinline__ int crow(int r, int hi) { return (r & 3) + 8 * (r >> 2) + 4 * hi; }
__device__ __forceinline__ unsigned cvtpk(float lo, float hi) { unsigned r; asm volatile("v_cvt_pk_bf16_f32 %0, %1, %2" : "=v"(r) : "v"(lo), "v"(hi)); return r; }
__device__ __forceinline__ void partialSM(f32x16& p0, f32x16& p1, float& m_reg, float& mn, float& alpha) {
  constexpr float C = 1.4426950408889634f;
  float pmax = p0[0];
#pragma unroll
  for (int r = 1; r < 16; ++r) pmax = fmaxf(pmax, p0[r]);
#pragma unroll
  for (int r = 0; r < 16; ++r) pmax = fmaxf(pmax, p1[r]);
  { auto rr = __builtin_amdgcn_permlane32_swap(__float_as_uint(pmax), __float_as_uint(pmax), false, false);
    pmax = fmaxf(__uint_as_float(rr[0]), __uint_as_float(rr[1])); }
  if (__builtin_expect(__all(pmax - m_reg <= THR), 1)) { mn = m_reg; alpha = 1.f; }
  else { mn = fmaxf(m_reg, pmax); alpha = __builtin_amdgcn_exp2f((m_reg - mn) * C); m_reg = mn; }
  float mnC = -mn * C;
#pragma unroll
  for (int r = 0; r < 16; ++r) p0[r] = fmaf(p0[r], C, mnC);
#pragma unroll
  for (int r = 0; r < 16; ++r) p1[r] = fmaf(p1[r], C, mnC);
#pragma unroll
  for (int r = 0; r < 16; ++r) p0[r] = __builtin_amdgcn_exp2f(p0[r]);
}
__device__ __forceinline__ void finishSM(f32x16& p0, f32x16& p1, float alpha, float& l_reg, bf16x8& pa0, bf16x8& pa1, bf16x8& pa2, bf16x8& pa3) {
#pragma unroll
  for (int r = 0; r < 16; ++r) p1[r] = __builtin_amdgcn_exp2f(p1[r]);
  float ps = 0;
#pragma unroll
  for (int r = 0; r < 16; ++r) ps += p0[r];
#pragma unroll
  for (int r = 0; r < 16; ++r) ps += p1[r];
  { auto rr = __builtin_amdgcn_permlane32_swap(__float_as_uint(ps), __float_as_uint(ps), false, false);
    ps = __uint_as_float(rr[0]) + __uint_as_float(rr[1]); }
  l_reg = l_reg * alpha + ps;
#define PK4(P, BASE, OUT) do { unsigned a0 = cvtpk(P[BASE + 0], P[BASE + 1]), a1 = cvtpk(P[BASE + 2], P[BASE + 3]);   \
    unsigned b0 = cvtpk(P[BASE + 4], P[BASE + 5]), b1 = cvtpk(P[BASE + 6], P[BASE + 7]);                              \
    auto r0 = __builtin_amdgcn_permlane32_swap(a0, b0, false, false); auto r1 = __builtin_amdgcn_permlane32_swap(a1, b1, false, false); \
    u32x4 w = {r0[0], r1[0], r0[1], r1[1]}; OUT = *reinterpret_cast<bf16x8*>(&w); } while (0)
  PK4(p0, 0, pa0); PK4(p0, 8, pa1); PK4(p1, 0, pa2); PK4(p1, 8, pa3);
#undef PK4
}
template <bool BIAS>
__device__ __forceinline__ void qkt(f32x16& p0, f32x16& p1, const LAS char* Ks, const LAS char* qs, int r32, int hi, const LAS float* bp) {
  if (BIAS) {
#pragma unroll
    for (int r = 0; r < 16; ++r) { p0[r] = bp[(r & 3) + 8 * (r >> 2)]; p1[r] = bp[32 + (r & 3) + 8 * (r >> 2)]; }
  } else { p0 = f32x16{}; p1 = f32x16{}; }
#pragma unroll
  for (int d0 = 0; d0 < 8; ++d0) { int cb = (d0 * 16 + hi * 8) * 2;
    bf16x8 b0 = *reinterpret_cast<const LAS bf16x8*>(Ks + KSWZ(r32, cb));
    bf16x8 b1 = *reinterpret_cast<const LAS bf16x8*>(Ks + KSWZ(32 + r32, cb));
    const bf16x8 qv = *reinterpret_cast<const LAS bf16x8*>(qs + d0 * 1024);
    p0 = __builtin_amdgcn_mfma_f32_32x32x16_bf16(b0, qv, p0, 0, 0, 0);
    p1 = __builtin_amdgcn_mfma_f32_32x32x16_bf16(b1, qv, p1, 0, 0, 0); }
}
__device__ __forceinline__ int v_st(int k, int c) { const int kk = (k & ~0xC) | ((k & 4) << 1) | ((k & 8) >> 1); return ((kk >> 3) * 4 + (c >> 5)) * 512 + ((kk & 7) * 32 + (c & 31)) * 2; }
__device__ __forceinline__ int v_rd_base(int lane) { return ((lane & 3) << 3) | (((lane >> 2) & 3) << 6) | (((lane >> 4) & 1) << 5) | (((lane >> 5) & 1) << 8); }
constexpr int v_rd_off(int d0, int ks, int half) { return d0 * 512 + ks * 4096 + half * 2048; }
template <int OFF> __device__ __forceinline__ s16x4 tr_read(int vb) {
  s16x4 r; asm volatile("ds_read_b64_tr_b16 %0, %1 offset:%2" : "=&v"(r) : "v"(vb), "i"(OFF) : "memory"); return r;
}
template <int D0> __device__ __forceinline__ void pv_one(f32x16& od, int vb, bf16x8 pa0, bf16x8 pa1, bf16x8 pa2, bf16x8 pa3) {
  const s16x4 l0 = tr_read<v_rd_off(D0, 0, 0)>(vb), h0 = tr_read<v_rd_off(D0, 0, 1)>(vb), l1 = tr_read<v_rd_off(D0, 1, 0)>(vb), h1 = tr_read<v_rd_off(D0, 1, 1)>(vb);
  const s16x4 l2 = tr_read<v_rd_off(D0, 2, 0)>(vb), h2 = tr_read<v_rd_off(D0, 2, 1)>(vb), l3 = tr_read<v_rd_off(D0, 3, 0)>(vb), h3 = tr_read<v_rd_off(D0, 3, 1)>(vb);
  asm volatile("s_waitcnt lgkmcnt(0)" ::: "memory"); SBAR();
#define PK(L, H) (bf16x8){L[0], L[1], L[2], L[3], H[0], H[1], H[2], H[3]}
  od = __builtin_amdgcn_mfma_f32_32x32x16_bf16(pa0, PK(l0, h0), od, 0, 0, 0);
  od = __builtin_amdgcn_mfma_f32_32x32x16_bf16(pa1, PK(l1, h1), od, 0, 0, 0);
  od = __builtin_amdgcn_mfma_f32_32x32x16_bf16(pa2, PK(l2, h2), od, 0, 0, 0);
  od = __builtin_amdgcn_mfma_f32_32x32x16_bf16(pa3, PK(l3, h3), od, 0, 0, 0);
#undef PK
}
__device__ __forceinline__ void pv_d0(f32x16* o, int vb, bf16x8 pa0, bf16x8 pa1, bf16x8 pa2, bf16x8 pa3) {
  pv_one<0>(o[0], vb, pa0, pa1, pa2, pa3); pv_one<1>(o[1], vb, pa0, pa1, pa2, pa3); pv_one<2>(o[2], vb, pa0, pa1, pa2, pa3); pv_one<3>(o[3], vb, pa0, pa1, pa2, pa3);
}
template <int LDQ, int LDK, int LDO, bool BAND>
__device__ __forceinline__ void attn_body(const bf16_t* Qb, const bf16_t* Kh, const bf16_t* Vh, bf16_t* Ob,
                                          const int NT, const int kc0, const float* btab_src, LAS char* lds, const int wid) {
  const int lane = fresh_lane(), tid = wid * 64 + lane, r32 = lane & 31, hi = lane >> 5;
  LAS char* V_lds = lds; LAS char* K_lds = lds + 2 * SHM_V;
  LAS float* wsf = (LAS float*)(lds + OFF_WS) + wid * 64; LAS float* li_l = wsf; LAS float* al_l = wsf + 32;
  LAS float* btab = (LAS float*)(lds + OFF_BT);
  if (BAND) { if (tid < 384) btab[tid] = tid < 64 ? btab_src[256] : (tid < 256 ? btab_src[320 - tid] : -30000.f); }
  float m_reg = -10000.f, l_reg = 0; f32x16 o[4] = {};
  const bf16_t* Qw = Qb + (long)(wid * QBLK + r32) * LDQ + hi * 8;
  LAS char* qr = lds + OFF_OST + wid * 8192 + lane * 16;
#pragma unroll
  for (int d0 = 0; d0 < 8; ++d0) *reinterpret_cast<LAS bf16x8*>(qr + d0 * 1024) = *reinterpret_cast<const bf16x8*>(Qw + d0 * 16);
  const int sr = tid >> 4, sc = (tid & 15) * 8, vst0 = v_st(sr, sc), vst1 = v_st(32 + sr, sc);
  const int vb0 = (int)(unsigned)(uintptr_t)V_lds + v_rd_base(lane);
  struct { bf16x8 vs0, vs1, ks0, ks1; } sr_[1];
  const int pw = wid >> 1, qi = (wid & 1) * 32 + r32;
#define TROW(t) ((BAND ? (((kc0) + (t)) > 0 ? ((kc0) + (t)) : 0) : (t)) * KVBLK)
#define SLOAD(i, t) do { const long k0_ = TROW(t); sr_[i].vs0 = *reinterpret_cast<const bf16x8*>(&Vh[(k0_ + sr) * LDK + sc]); sr_[i].vs1 = *reinterpret_cast<const bf16x8*>(&Vh[(k0_ + 32 + sr) * LDK + sc]); \
    sr_[i].ks0 = *reinterpret_cast<const bf16x8*>(&Kh[(k0_ + sr) * LDK + sc]); sr_[i].ks1 = *reinterpret_cast<const bf16x8*>(&Kh[(k0_ + 32 + sr) * LDK + sc]); } while (0)
#define SWRITE(b, i) do { *(LAS bf16x8*)(V_lds + (b) * SHM_V + vst0) = sr_[i].vs0; *(LAS bf16x8*)(V_lds + (b) * SHM_V + vst1) = sr_[i].vs1; int kc_ = sc * 2; \
    *(LAS bf16x8*)(K_lds + (b) * SHM_K + KSWZ(sr, kc_)) = sr_[i].ks0; *(LAS bf16x8*)(K_lds + (b) * SHM_K + KSWZ(32 + sr, kc_)) = sr_[i].ks1; } while (0)
#define SWAIT() asm volatile("s_waitcnt vmcnt(0)" ::: "memory")
#define RESC(a) do { if (__any((a) < 1.f)) { if (hi == 0) al_l[r32] = (a); asm volatile("s_waitcnt lgkmcnt(0)" ::: "memory"); \
    _Pragma("unroll") for (int d = 0; d < 4; ++d) _Pragma("unroll") for (int r = 0; r < 16; ++r) o[d][r] *= al_l[crow(r, hi)]; } } while (0)
#define BPTR(t) ({ const int t_ = (t); const int dch = pw + 8 - t_; int kb_ = 192 - dch * 64 - qi + 4 * hi; kb_ = kb_ < 0 ? 0 : kb_; \
    if (dch < 0 || dch > 8 || (kc0) + t_ < 0) kb_ = 288; (const LAS float*)(btab + kb_); })
  f32x16 pA0, pA1, pB0, pB1; float mnA, mnB, alA, alB; bf16x8 pa0, pa1, pa2, pa3;
  constexpr int SE = 0, SO = 0;
  SLOAD(SE, 0); asm volatile("s_waitcnt vmcnt(0)" ::: "memory"); SWRITE(0, SE); __syncthreads();
  qkt<BAND>(pA0, pA1, K_lds, qr, r32, hi, BPTR(0)); partialSM(pA0, pA1, m_reg, mnA, alA);
  SLOAD(SO, 1);
  SWAIT(); SWRITE(1, SO); __syncthreads();
  for (int j = 1; j + 1 < NT; j += 2) {
    SBAR(); qkt<BAND>(pB0, pB1, K_lds + SHM_K, qr, r32, hi, BPTR(j));
    finishSM(pA0, pA1, alA, l_reg, pa0, pa1, pa2, pa3); SBAR();
    SLOAD(SO, j + 1); SBAR();
    pv_d0(o, vb0, pa0, pa1, pa2, pa3); partialSM(pB0, pB1, m_reg, mnB, alB);
    __syncthreads(); SWAIT(); SWRITE(0, SE);
    RESC(alB); __syncthreads();
    SBAR(); qkt<BAND>(pA0, pA1, K_lds, qr, r32, hi, BPTR(j + 1));
    finishSM(pB0, pB1, alB, l_reg, pa0, pa1, pa2, pa3); SBAR();
    SLOAD(SE, j + 2); SBAR();
    pv_d0(o, vb0 + SHM_V, pa0, pa1, pa2, pa3); partialSM(pA0, pA1, m_reg, mnA, alA);
    __syncthreads(); SWAIT(); SWRITE(1, SO);
    RESC(alA); __syncthreads();
  }
  SBAR(); qkt<BAND>(pB0, pB1, K_lds + SHM_K, qr, r32, hi, BPTR(NT - 1));
  finishSM(pA0, pA1, alA, l_reg, pa0, pa1, pa2, pa3); SBAR();
  pv_d0(o, vb0, pa0, pa1, pa2, pa3); partialSM(pB0, pB1, m_reg, mnB, alB);
  __syncthreads(); RESC(alB);
  finishSM(pB0, pB1, alB, l_reg, pa0, pa1, pa2, pa3); SBAR();
  pv_d0(o, vb0 + SHM_V, pa0, pa1, pa2, pa3);
  if (hi == 0) li_l[r32] = l_reg; asm volatile("s_waitcnt lgkmcnt(0)" ::: "memory");
  float rli[16];
#pragma unroll
  for (int r = 0; r < 16; ++r) rli[r] = __builtin_amdgcn_rcpf(li_l[crow(r, hi)]);
  { LAS bf16_t* stg = (LAS bf16_t*)(lds + OFF_OST + wid * 8192);
#pragma unroll
    for (int r = 0; r < 16; ++r) { const int orow = crow(r, hi);
#pragma unroll
      for (int d0 = 0; d0 < 4; ++d0) stg[orow * 128 + d0 * 32 + r32] = (bf16_t)f2bf(o[d0][r] * rli[r]); }
    asm volatile("s_waitcnt lgkmcnt(0)" ::: "memory");
    bf16_t* Ow = Ob + (long)(wid * QBLK) * LDO;
#pragma unroll
    for (int i = 0; i < 8; ++i) { const int row = i * 4 + (lane >> 4), ch = lane & 15; const u32x4 v = *(const LAS u32x4*)(stg + row * 128 + ch * 8); *(u32x4*)(Ow + (long)row * LDO + ch * 8) = v; } }
  __syncthreads();
#undef TROW
#undef SLOAD
#undef SWRITE
#undef SWAIT
#undef RESC
#undef BPTR
}
#undef KSWZ
#undef SBAR
}


namespace rt {
using f32x16 = __attribute__((ext_vector_type(16))) float;
#define RKSWZ(row, colB) ((row) * 256 + ((colB) ^ (((row) & 7) << 4)))
__device__ __forceinline__ int crow(int r, int hi) { return (r & 3) + 8 * (r >> 2) + 4 * hi; }
__device__ __forceinline__ void ce_desc(unsigned& a, unsigned& b) { const unsigned mx = a > b ? a : b, mn = a > b ? b : a; a = mx; b = mn; }
__device__ __forceinline__ void sort16_desc(unsigned (&v)[16]) {
#pragma unroll
  for (int k = 2; k <= 16; k <<= 1)
#pragma unroll
    for (int j = k >> 1; j > 0; j >>= 1)
#pragma unroll
      for (int i = 0; i < 16; ++i) { const int l = i ^ j; if (l > i) { if ((i & k) == 0) ce_desc(v[i], v[l]); else ce_desc(v[l], v[i]); } }
}
__device__ __forceinline__ void merge16_desc(unsigned (&a)[16], const unsigned (&b)[16]) {
#pragma unroll
  for (int i = 0; i < 16; ++i) a[i] = a[i] > b[15 - i] ? a[i] : b[15 - i];
#pragma unroll
  for (int j = 8; j > 0; j >>= 1)
#pragma unroll
    for (int i = 0; i < 16; ++i) { const int l = i ^ j; if (l > i) ce_desc(a[i], a[l]); }
}
__device__ __forceinline__ unsigned fkey(float f) { const unsigned u = __float_as_uint(f); return (u & 0x80000000u) ? ~u : (u | 0x80000000u); }
__device__ __forceinline__ float fkey_inv(unsigned k) { const unsigned u = (k & 0x80000000u) ? (k & 0x7fffffffu) : ~k; return __uint_as_float(u); }
__device__ __forceinline__ void top16_half(const f32x16 (&sc)[4], int hi, unsigned (&out)[16]) {
  unsigned g[16];
#pragma unroll
  for (int blk = 0; blk < 4; ++blk) {
#pragma unroll
    for (int r = 0; r < 16; ++r) g[r] = (fkey(sc[blk][r]) & 0xFFFFFF80u) | (unsigned)(32 * blk + (r & 3) + 8 * (r >> 2) + 4 * hi);
    sort16_desc(g);
    if (blk == 0) {
#pragma unroll
      for (int r = 0; r < 16; ++r) out[r] = g[r];
    } else merge16_desc(out, g);
  }
  unsigned pb[16];
#pragma unroll
  for (int r = 0; r < 16; ++r) { auto rr = __builtin_amdgcn_permlane32_swap(out[r], out[r], false, false); pb[r] = hi ? rr[0] : rr[1]; }
  merge16_desc(out, pb);
}
__device__ __forceinline__ void route_phase(const Params& p, LAS unsigned char* lds, int wave) {
  const int lane = fresh_lane(), tid = wave * 64 + lane;
  const bf16_t* Q = (const bf16_t*)(p.ws + WS_Q); const bf16_t* KB = (const bf16_t*)(p.ws + WS_KEYSB);
  int* RIDX = (int*)(p.ws + WS_RIDX); float* RG = (float*)(p.ws + WS_RG);
  const int h = blockIdx.x & 7, grp = blockIdx.x >> 3;
  const int r32 = lane & 31, hi = lane >> 5;
#pragma unroll
  for (int c = 0; c < 2; ++c)
#pragma unroll
    for (int rep = 0; rep < 4; ++rep) { const int row = rep * 32 + (tid >> 4), cb = (tid & 15) * 16;
      *(LAS u32x4*)(lds + c * 32768 + RKSWZ(row, cb)) = *(const u32x4*)((const char*)KB + ((size_t)(h * 2 + c) * 128 + row) * 256 + cb); }
  __syncthreads();
  for (int tb = grp * 8 + wave; tb < T / 32; tb += (int)(gridDim.x >> 3) * 8) {
    const int t = tb * 32 + r32;
    unsigned ka[16], kb2[16];
#pragma unroll
    for (int c = 0; c < 2; ++c) {
      bf16x8 qf[8];
      const bf16_t* qp = Q + (size_t)t * D + h * 256 + c * 128 + hi * 8;
#pragma unroll
      for (int ks = 0; ks < 8; ++ks) qf[ks] = *(const bf16x8*)(qp + ks * 16);
      f32x16 sc[4];
#pragma unroll
      for (int blk = 0; blk < 4; ++blk) { sc[blk] = f32x16{};
#pragma unroll
        for (int ks = 0; ks < 8; ++ks) { const bf16x8 kf = *(const LAS bf16x8*)(lds + c * 32768 + RKSWZ(32 * blk + r32, (16 * ks + 8 * hi) * 2));
          sc[blk] = __builtin_amdgcn_mfma_f32_32x32x16_bf16(kf, qf[ks], sc[blk], 0, 0, 0); } }
      if (c == 0) top16_half(sc, hi, ka); else top16_half(sc, hi, kb2);
    }
    float av[16], bv[16];
#pragma unroll
    for (int i = 0; i < 16; ++i) { av[i] = fkey_inv(ka[i] & 0xFFFFFF80u); bv[i] = fkey_inv(kb2[i] & 0xFFFFFF80u); }
    float T[16];
#pragma unroll
    for (int k = 0; k < 16; ++k) T[k] = -3.0e38f;
#pragma unroll
    for (int i = 0; i < 16; ++i)
#pragma unroll
      for (int j = 0; j < 16; ++j) if ((i + 1) * (j + 1) <= 16) { float v = av[i] + bv[j];
#pragma unroll
          for (int k = 0; k < 16; ++k) { const float mx = fmaxf(T[k], v); v = fminf(T[k], v); T[k] = mx; } }
    const float m = T[0], theta = T[15];
    float Z = 0.f;
#pragma unroll
    for (int k = 0; k < 16; ++k) Z += __expf(T[k] - m);
    const float rz = 1.f / Z;
    int slot = 0; int cn = 0;
    int* ip = RIDX + (size_t)t * 128 + h * 16; float* gp = RG + (size_t)t * 128 + h * 16;
#pragma unroll
    for (int i = 0; i < 16; ++i)
#pragma unroll
      for (int j = 0; j < 16; ++j) if ((i + 1) * (j + 1) <= 16) { const float v = av[i] + bv[j];
          const bool sel = (v >= theta) && (slot < 16);
          if (sel && ((cn & 1) == hi)) { ip[slot] = (int)((ka[i] & 127u) * 128u + (kb2[j] & 127u)); gp[slot] = __expf(v - m) * rz; }
          slot += sel ? 1 : 0; ++cn; }
  }
}
#undef RKSWZ
}

#define XB_TMO      128
#define XB_XCNT(j)  (256  + 64 * (j))
#define XB_XSUB(j)  (1280 + 64 * (j))
#define XB_XGEN(j)  (2304 + 64 * (j))
#define XB_TOP      3328
#define XB_TOPGEN   3392
#define XCD_BAR_WORDS 3456
#define XB_SPIN_CAP (1u << 22)
__device__ __forceinline__ unsigned xb_ld(unsigned* p)              { return __hip_atomic_load(p, __ATOMIC_RELAXED, __HIP_MEMORY_SCOPE_AGENT); }
__device__ __forceinline__ unsigned xb_add(unsigned* p, unsigned v) { return __hip_atomic_fetch_add(p, v, __ATOMIC_RELAXED, __HIP_MEMORY_SCOPE_AGENT); }
__device__ __forceinline__ unsigned xb_xcc_id() { return (unsigned)__builtin_amdgcn_s_getreg((3 << 11) | 20) & 0xFu; }
#define XB_SPIN(cond, bar) do { unsigned _sp = 0; while (cond) { __builtin_amdgcn_s_sleep(1); \
    if ((++_sp & 255u) == 0u) { if (xb_ld(&(bar)[XB_TMO])) break; if (_sp > XB_SPIN_CAP) { atomicAdd(&(bar)[XB_TMO], 1u); break; } } } } while (0)
struct XcdBarrier { unsigned* bar; unsigned x; volatile LAS unsigned* st; int w; };
__device__ __forceinline__ XcdBarrier xcd_barrier_post(unsigned* bar, volatile LAS unsigned* st, const int wave) {
    XcdBarrier b; b.bar = bar; b.x = xb_xcc_id(); b.st = st; b.w = wave;
    if (wave == 0 && fresh_lane() == 0) (void)xb_add(&bar[XB_XCNT(b.x)], 1u);
    return b;
}
__device__ __forceinline__ void xcd_barrier_complete(unsigned* bar, unsigned x, unsigned& nloc, unsigned& nx) {
    const unsigned G = gridDim.x * gridDim.y * gridDim.z;
    unsigned sum, cnt, mine, sp = 0u;
    for (;;) {
        sum = 0u; cnt = 0u; mine = 0u;
#pragma unroll
        for (unsigned j = 0; j < 16; ++j) { const unsigned c = xb_ld(&bar[XB_XCNT(j)]); sum += c; cnt += (c > 0u) ? 1u : 0u; mine = (j == x) ? c : mine; }
        if (sum == G) break;
        __builtin_amdgcn_s_sleep(1);
        if ((++sp & 255u) == 0u) { if (xb_ld(&bar[XB_TMO])) break; if (sp > XB_SPIN_CAP) { atomicAdd(&bar[XB_TMO], 1u); break; } }
    }
    nloc = mine > 0u ? mine : 1u; nx = cnt > 0u ? cnt : 1u;
}
__device__ __forceinline__ void xcd_barrier(const XcdBarrier& b) {
    asm volatile("s_waitcnt vmcnt(0)" ::: "memory");
    __syncthreads();
    if (b.w == 0 && fresh_lane() == 0) {
        unsigned* bar = b.bar;
        __builtin_amdgcn_s_waitcnt(0);
        unsigned nloc = b.st[0], nx = b.st[1];
        if (nloc == 0u) { xcd_barrier_complete(bar, b.x, nloc, nx); b.st[0] = nloc; b.st[1] = nx; }
        const unsigned old = xb_add(&bar[XB_XSUB(b.x)], 1u);
        const unsigned gen = old / nloc;
        if (old + 1u == (gen + 1u) * nloc) {
            __builtin_amdgcn_fence(__ATOMIC_RELEASE, "agent");
            asm volatile("s_waitcnt vmcnt(0)" ::: "memory");
            const unsigned og = xb_add(&bar[XB_TOP], 1u);
            const unsigned tg = og / nx;
            if (og + 1u == (tg + 1u) * nx) xb_add(&bar[XB_TOPGEN], 1u);
            else XB_SPIN(xb_ld(&bar[XB_TOPGEN]) == tg, bar);
            __builtin_amdgcn_fence(__ATOMIC_ACQUIRE, "agent");
            xb_add(&bar[XB_XGEN(b.x)], 1u);
            asm volatile("s_waitcnt vmcnt(0)" ::: "memory");
        } else {
            XB_SPIN(xb_ld(&bar[XB_XGEN(b.x)]) == gen, bar);
            __builtin_amdgcn_fence(__ATOMIC_ACQUIRE, "agent");
            asm volatile("s_waitcnt vmcnt(0)" ::: "memory");
        }
    }
    __syncthreads();
}
constexpr int RING_BYTES = 131072, MISC_OFF = 143360, LDS_BYTES = 147456, NTHREADS = 512;
static_assert(att::LDS_NEED <= MISC_OFF, "attention scratch below the MISC words");
constexpr size_t WS_SLAB = WS_X2BF;

__device__ __forceinline__ void touch_buffer(const void* base, size_t bytes, int cb, int Gd, int tid) {
    const u32x4* b = (const u32x4*)base; const size_t n = bytes / 16, stride = (size_t)Gd * NTHREADS;
    u32x4 acc = {0u, 0u, 0u, 0u};
    for (size_t i = (size_t)cb * NTHREADS + tid; i < n; i += stride) { const u32x4 v = b[i]; acc.x ^= v.x; acc.y ^= v.y; acc.z ^= v.z; acc.w ^= v.w; }
    asm volatile("" :: "v"(acc.x), "v"(acc.y), "v"(acc.z), "v"(acc.w));
}
#define PH_BEGIN(i) unsigned long long t0_##i = 0; if ((PROBE_MASK >> (i)) & 1) t0_##i = __builtin_amdgcn_s_memrealtime();
#define PH_END(i) if ((PROBE_MASK >> (i)) & 1) probe_acc += __builtin_amdgcn_s_memrealtime() - t0_##i;
__global__ void __launch_bounds__(NTHREADS, 2) fwd(Params p) {
    extern __shared__ __attribute__((aligned(16))) unsigned char lds_raw[];
    LAS unsigned char* lds = (LAS unsigned char*)lds_raw;
    volatile LAS unsigned* MISC = (volatile LAS unsigned*)(lds + MISC_OFF);
    const int wave = __builtin_amdgcn_readfirstlane((int)threadIdx.x >> 6);
    const int nwb = NTHREADS / 64;
    const int gw = blockIdx.x * nwb + wave, NW = gridDim.x * nwb;
    const int Gd = gridDim.x, cb = blockIdx.x;
    unsigned char* ws = p.ws;
    bf16_t* WT_IN = (bf16_t*)(ws + WS_WT_IN); bf16_t* WT_GATE = (bf16_t*)(ws + WS_WT_GATE); bf16_t* WT_BR = (bf16_t*)(ws + WS_WT_BR);
    bf16_t* WT_O = (bf16_t*)(ws + WS_WT_O); bf16_t* WT_PQ = (bf16_t*)(ws + WS_WT_PQ); bf16_t* WT_MKV = (bf16_t*)(ws + WS_WT_MKV);
    bf16_t* KEYSB = (bf16_t*)(ws + WS_KEYSB); bf16_t* MEMN = (bf16_t*)(ws + WS_MEMN); bf16_t* MEMKV = (bf16_t*)(ws + WS_MEMKV);
    bf16_t* HO = (bf16_t*)(ws + WS_HO); bf16_t* PROJ = (bf16_t*)(ws + WS_PROJ); bf16_t* G = (bf16_t*)(ws + WS_G);
    bf16_t* MERGED = (bf16_t*)(ws + WS_MERGED); bf16_t* X2BF = (bf16_t*)(ws + WS_X2BF); bf16_t* QB = (bf16_t*)(ws + WS_Q);
        float* SS2 = (float*)(ws + WS_CTL + CTL_SS2_BYTE);
    if ((wave * 64 + fresh_lane()) < 64) MISC[(wave * 64 + fresh_lane())] = 0u;
    __syncthreads();
    XcdBarrier bar = xcd_barrier_post((unsigned*)(ws + WS_CTL + CTL_BAR_BYTE), MISC + 8, wave);
    if ((wave * 64 + fresh_lane()) == 0) MISC[16] = xb_add((unsigned*)(ws + WS_CTL + CTL_RANK_BYTE) + 64 * bar.x, 1u);

    unsigned long long probe_acc = 0;
    PH_BEGIN(0)
    {
        LAS float* scr = (LAS float*)lds + wave * (64 * 33);
        const int I0 = (D / 64) * (INW / 32), I1 = I0 + (D / 64) * (GW / 32), I2 = I1 + (D / 64) * (D / 32), I3 = I2 + (D / 64) * (D / 32), I4 = I3 + (D / 64) * (D / 32), I5 = I4 + (D / 64) * (2 * CW / 32);
#define TRJOB(it, jb, li) do { if ((it) < I0) { jb = TrJob{p.in[3], WT_IN, nullptr, D, INW, 0.f}; li = (it); } else if ((it) < I1) { jb = TrJob{p.in[18], WT_GATE, nullptr, D, GW, GATE_WSCALE}; li = (it) - I0; } \
            else if ((it) < I2) { jb = TrJob{p.in[20], WT_BR, nullptr, D, D, 0.f}; li = (it) - I1; } else if ((it) < I3) { jb = TrJob{p.in[21], WT_O, nullptr, D, D, 0.f}; li = (it) - I2; } \
            else if ((it) < I4) { jb = TrJob{p.in[23], WT_PQ, p.in[22], D, D, 0.f}; li = (it) - I3; } else { jb = TrJob{p.in[15], WT_MKV, nullptr, D, 2 * CW, 0.f}; li = (it) - I4; } } while (0)
        for (int it = gw; it < I5; it += 2 * NW) {
            TrJob ja, jb2; int la, lb; f32x4 va[8], vb[8];
            TRJOB(it, ja, la); tr_load(ja, la, fresh_lane(), va);
            const bool has2 = it + NW < I5;
            if (has2) { TRJOB(it + NW, jb2, lb); tr_load(jb2, lb, fresh_lane(), vb); }
            tr_store(ja, la, fresh_lane(), va, scr);
            if (has2) tr_store(jb2, lb, fresh_lane(), vb, scr);
        }
#undef TRJOB
        rms_rows(p.in[0], p.in[2], HO, ws + WS_H8, T, gw, NW, fresh_lane());
        rms_rows(p.in[1], p.in[14], MEMN, nullptr, BATCH * NMEM, gw, NW, fresh_lane());
        const float* keys = p.in[24];
        for (int i = gw * 64 + fresh_lane(); i < PH * 2 * NKEYS * 128 / 2; i += NW * 64) ((unsigned*)KEYSB)[i] = pk2(keys[2 * i], keys[2 * i + 1]);
    }
    xcd_barrier(bar);
    PH_END(0)
    PH_BEGIN(1)
    {
        SchedP1a Sa{(const char*)HO, (const char*)WT_IN, (const char*)MEMN, (const char*)WT_MKV, Gd, cb};
        EpiP1a Ea{PROJ, MEMKV, p.in[4], p.in[5], p.in[16], p.in[17], (LAS float*)(lds + RING_BYTES)};
        pg8::gemm_phase<false>(lds, D, D, Sa, Ea, wave);
        SchedP1b Sb{(const char*)(ws + WS_H8), (const char*)WT_GATE, Gd, cb};
        EpiP1b Eb{G, p.in[19]};
        pg8::gemm_phase<true>(lds, D / 2, D / 2, Sb, Eb, wave);
    }
    xcd_barrier(bar);
    PH_END(1)
    PH_BEGIN(2)
    {
        const float qscale = 0.08838834764831845f;
        for (int u = gw; u < BATCH * NCH * 8; u += NW) { const int g = u % 8, c = (u / 8) % NCH, b = u / (8 * NCH); lru_pass1(p, b, c, g, fresh_lane(), lds + wave * 8192, u, NW); }
        if (NW != BATCH * NCH * 8) fp4_tables(p, gw, NW, fresh_lane());
    }
    xcd_barrier(bar);
    PH_END(2)
    PH_BEGIN(3)
    {
        const int nA = BATCH * 8 * (NCH / 4), nC = BATCH * 4 * (SEQ / 256);
        PH_BEGIN(9)
        for (int u = cb; u < nA + nC; u += Gd) {
            if (u < nA) {
                const int cg = u % (NCH / 4), h = (u / (NCH / 4)) % 8, b = u / ((NCH / 4) * 8);
                const size_t brow = (size_t)b * SEQ, qrow = brow + (size_t)cg * 256;
                att::attn_body<INW, INW, D, true>(PROJ + qrow * INW + C_QA + h * 128, PROJ + brow * INW + C_KA + h * 128, PROJ + brow * INW + C_VA + h * 128,
                                                  HO + qrow * D + h * 128, 12, cg * 4 - NPREV, p.in[6] + h * 257, (LAS char*)lds, wave);
            } else {
                const int v = u - nA; const int qb = v % (SEQ / 256), h = (v / (SEQ / 256)) % 4, b = v / ((SEQ / 256) * 4);
                const size_t qrow = (size_t)b * SEQ + (size_t)qb * 256;
                att::attn_body<INW, 2 * CW, D, false>(PROJ + qrow * INW + C_QC + h * 128, MEMKV + (size_t)b * NMEM * (2 * CW) + h * 128, MEMKV + (size_t)b * NMEM * (2 * CW) + CW + h * 128,
                                                     HO + qrow * D + AW + LW + h * 128, NMEM / 64, 0, nullptr, (LAS char*)lds, wave);
            }
        }
        PH_END(9)
        PH_BEGIN(10)
        for (int u = gw; u < BATCH * NCH * 8; u += NW) { const int g = u % 8, c = (u / 8) % NCH, b = u / (8 * NCH); lru_pass2(p, b, c, g, fresh_lane()); }
        touch_buffer(WT_BR, (size_t)D * D * 2, cb, Gd, (wave * 64 + fresh_lane())); touch_buffer(WT_O, (size_t)D * D * 2, cb, Gd, (wave * 64 + fresh_lane()));
        PH_END(10)
    }
    xcd_barrier(bar);
    PH_END(3)
    PH_BEGIN(4)
    {
        SchedP3 S{(const char*)HO, (const char*)WT_BR, Gd, cb};
        EpiP3 E{G, MERGED};
        pg8::gemm_phase<false>(lds, D, D, S, E, wave);
    }
    xcd_barrier(bar);
    PH_END(4)
    PH_BEGIN(5)
    {
        SchedSq S{(const char*)MERGED, (const char*)WT_O, Gd, cb};
        EpiP4 E{p.in[0], p.out, X2BF, SS2, ws + WS_X2F8};
        pg8::gemm_phase<false>(lds, D, D, S, E, wave);
        touch_buffer(WT_PQ, (size_t)D * D * 2, cb, Gd, (wave * 64 + fresh_lane()));
    }
    xcd_barrier(bar);
    PH_END(5)
    PH_BEGIN(6)
    {
        SchedSq S{(const char*)X2BF, (const char*)WT_PQ, Gd, cb};
        EpiP5 E{QB, SS2};
        pg8::gemm_phase<false>(lds, D, D, S, E, wave);
    }
    xcd_barrier(bar);
    PH_END(6)
    PH_BEGIN(7)
    rt::route_phase(p, lds, wave);
    xcd_barrier(bar);
    PH_END(7)
    PH_BEGIN(8)
    int ppos, pnx, prank, pnloc;
    { if ((wave * 64 + fresh_lane()) == 0) { unsigned pos = 0, nx = 0; const unsigned* bw = (const unsigned*)(ws + WS_CTL + CTL_BAR_BYTE);
#pragma unroll
          for (unsigned j = 0; j < 16; ++j) { const unsigned cj = xb_ld((unsigned*)&bw[XB_XCNT(j)]); nx += cj > 0u ? 1u : 0u; pos += (cj > 0u && j < bar.x) ? 1u : 0u; }
          MISC[17] = pos; MISC[18] = nx > 0u ? nx : 1u; }
      __syncthreads();
      ppos = (int)MISC[17]; pnx = (int)MISC[18]; prank = (int)MISC[16]; pnloc = (int)MISC[8]; if (pnloc < 1) pnloc = 1; }
    peer_u_step(p, fresh_lane(), wave, lds + wave * 16384, ppos, pnx, prank, pnloc);
    xcd_barrier(bar);
    for (int t = gw; t < T; t += NW) peer_combine(p, t, fresh_lane());
    xcd_barrier(bar);
    peer_v_step(p, fresh_lane(), wave, lds + wave * 16384, ppos, pnx, prank, pnloc);
    if (PROBE_MASK) { __syncthreads(); PH_END(8) const unsigned long long te = __builtin_amdgcn_s_memrealtime(); while (__builtin_amdgcn_s_memrealtime() - te < probe_acc) __builtin_amdgcn_s_sleep(8); }
}

extern "C" void kernel_launch(void* const* d_in, const int* in_sizes, int n_in, void* d_out, int out_size, void* d_ws, size_t ws_size, hipStream_t stream) {
    static int grid = 0;
    if (grid == 0) {
        if (n_in != 27 || out_size != T * D || ws_size < WS_END) { fprintf(stderr, "kernel_launch: unexpected problem (n_in %d out %d ws %zu)\n", n_in, out_size, ws_size); grid = -1; return; }
        int dev = 0, cus = 0, per_cu = 0;
        (void)hipGetDevice(&dev); (void)hipDeviceGetAttribute(&cus, hipDeviceAttributeMultiprocessorCount, dev);
        if (hipFuncSetAttribute((const void*)fwd, hipFuncAttributeMaxDynamicSharedMemorySize, LDS_BYTES) != hipSuccess) { fprintf(stderr, "kernel_launch: hipFuncSetAttribute failed\n"); grid = -1; return; }
        (void)hipOccupancyMaxActiveBlocksPerMultiprocessor(&per_cu, (const void*)fwd, NTHREADS, LDS_BYTES);
        if (per_cu < 1) { fprintf(stderr, "kernel_launch: occupancy query says %d\n", per_cu); grid = -1; return; }
        grid = cus;
    }
    if (grid < 0) return;
    (void)hipMemsetAsync((char*)d_ws + WS_CTL, 0, 1 * MiB, stream);
    Params p{};
    for (int i = 0; i < 27; ++i) p.in[i] = (const float*)d_in[i];
    p.out = (float*)d_out; p.ws = (unsigned char*)d_ws;
    void* args[] = {&p};
    hipError_t e = hipLaunchCooperativeKernel((const void*)fwd, dim3(grid), dim3(NTHREADS), args, LDS_BYTES, stream);
    if (e != hipSuccess) fprintf(stderr, "cooperative launch failed: %s (grid %d)\n", hipGetErrorString(e), grid);
}
```

```cpp
#include <hip/hip_runtime.h>
#include <hip/hip_cooperative_groups.h>
#include <cstdio>
#include <cstdint>
namespace cg = cooperative_groups;
#ifndef PROBE_MASK
#define PROBE_MASK 0
#endif

#define LAS __attribute__((address_space(3)))
typedef unsigned short bf16_t;
typedef short bf16x8 __attribute__((ext_vector_type(8)));
typedef float f32x4 __attribute__((ext_vector_type(4)));
typedef unsigned u32x4 __attribute__((ext_vector_type(4)));
typedef unsigned u32x2 __attribute__((ext_vector_type(2)));

constexpr int D = 2048, BATCH = 2, SEQ = 8192, T = BATCH * SEQ;
constexpr int CHUNK = 64, NPREV = 8, NCH = SEQ / CHUNK;
constexpr int AW = 1024, LW = 512, CW = 512, INW = 4608, GW = 6144;
constexpr int NMEM = 256;
constexpr int PH = 8, NKEYS = 128, TOPK = 16;
constexpr float EPS = 1e-6f;
constexpr int C_QA = 0, C_KA = 1024, C_VA = 2048, C_XL = 3072, C_GL = 3584, C_QC = 4096;

constexpr size_t MiB = 1u << 20;
constexpr size_t WS_CTL = 0;
constexpr size_t WS_WT_IN = 2 * MiB, WS_WT_GATE = 20 * MiB, WS_WT_BR = 44 * MiB, WS_WT_O = 52 * MiB, WS_WT_PQ = 60 * MiB, WS_WT_MKV = 68 * MiB;
constexpr size_t WS_KEYSB = 72 * MiB, WS_MEMN = 73 * MiB, WS_MEMKV = 75 * MiB, WS_LRUSUM = 76 * MiB, WS_RS2 = 77 * MiB;
constexpr size_t WS_HO = 80 * MiB;
constexpr size_t WS_PROJ = 144 * MiB;
constexpr size_t WS_MERGED = 144 * MiB, WS_X2BF = 208 * MiB;
constexpr size_t WS_G = 288 * MiB;
constexpr size_t WS_TABU = 496 * MiB, WS_TABV = 512 * MiB, WS_Q = 416 * MiB;
constexpr size_t WS_SCU = 77 * MiB, WS_SCV = 77 * MiB + 65536;
constexpr size_t WS_AUA = 2 * MiB, WS_AUU = 18 * MiB;
constexpr size_t WS_H8 = 496 * MiB;
constexpr float GATE_WSCALE = 256.f;
constexpr size_t WS_RIDX = 480 * MiB, WS_RG = 488 * MiB, WS_END = 528 * MiB;

constexpr size_t CTL_BAR_BYTE = 16384, CTL_RANK_BYTE = 65536, CTL_SS2_BYTE = 512 * 1024;
struct Params { const float* in[27]; float* out; unsigned char* ws; };

__device__ __forceinline__ int fresh_lane() { int l; asm volatile("v_mbcnt_lo_u32_b32 %0, -1, 0\n\tv_mbcnt_hi_u32_b32 %0, -1, %0" : "=v"(l)); return l; }
__device__ __forceinline__ float bf2f(unsigned v16) { return __uint_as_float(v16 << 16); }
typedef float f32x2c __attribute__((ext_vector_type(2))); typedef __bf16 bf16x2c __attribute__((ext_vector_type(2)));
__device__ __forceinline__ unsigned pk2(float lo, float hi) { const f32x2c v = {lo, hi}; return __builtin_bit_cast(unsigned, __builtin_convertvector(v, bf16x2c)); }
__device__ __forceinline__ unsigned f2bf(float f) { return pk2(f, 0.f) & 0xffffu; }
__device__ __forceinline__ float wave_sum(float v) {
#pragma unroll
    for (int o = 1; o < 64; o <<= 1) v += __shfl_xor(v, o);
    return v;
}
typedef __bf16 bf16x2_t __attribute__((ext_vector_type(2)));
__device__ __forceinline__ float dot2bf(unsigned w, unsigned x, float acc) { return __builtin_amdgcn_fdot2_f32_bf16(__builtin_bit_cast(bf16x2_t, w), __builtin_bit_cast(bf16x2_t, x), acc, false); }
__device__ __forceinline__ float sigmoid_(float x) { return 1.f / (1.f + __expf(-x)); }
__device__ __forceinline__ float gelu_tanh(float x) { const float y = 1.5957691216f * (x + 0.044715f * x * x * x); return x / (1.f + __expf(-y)); }
__device__ __forceinline__ void unpack8(const u32x4 w, float* f) {
    f[0] = __uint_as_float(w.x << 16); f[1] = __uint_as_float(w.x & 0xffff0000u);
    f[2] = __uint_as_float(w.y << 16); f[3] = __uint_as_float(w.y & 0xffff0000u);
    f[4] = __uint_as_float(w.z << 16); f[5] = __uint_as_float(w.z & 0xffff0000u);
    f[6] = __uint_as_float(w.w << 16); f[7] = __uint_as_float(w.w & 0xffff0000u);
}

struct TrJob { const float* W; bf16_t* WT; const float* ks; int K, N; float f8scale; };
__device__ __forceinline__ void tr_load(const TrJob& jb, int item, int lane, f32x4 (&v)[8]) {
    const int nblk = jb.N / 32, kb = item / nblk, nb = item % nblk, k0 = 64 * kb, n0 = 32 * nb;
#pragma unroll
    for (int i = 0; i < 8; ++i) { const int kk = 8 * i + (lane >> 3); v[i] = *(const f32x4*)(jb.W + (size_t)(k0 + kk) * jb.N + n0 + 4 * (lane & 7)); if (jb.ks) v[i] = v[i] * jb.ks[k0 + kk]; }
}
__device__ __forceinline__ void tr_store(const TrJob& jb, int item, int lane, const f32x4 (&v)[8], LAS float* scr) {
    const int nblk = jb.N / 32, kb = item / nblk, nb = item % nblk, k0 = 64 * kb, n0 = 32 * nb;
#pragma unroll
    for (int i = 0; i < 8; ++i) { LAS float* d = scr + (8 * i + (lane >> 3)) * 33 + 4 * (lane & 7); d[0] = v[i].x; d[1] = v[i].y; d[2] = v[i].z; d[3] = v[i].w; }
    asm volatile("s_waitcnt lgkmcnt(0)" ::: "memory");
    const int c = lane & 7;
#pragma unroll
    for (int j = 0; j < 4; ++j) { const int n = (lane >> 3) + 8 * j; const LAS float* s = scr + (8 * c) * 33 + n;
        if (jb.f8scale != 0.f) { const float f = jb.f8scale; u32x2 o;
#define F8C(x_) fminf(fmaxf((x_) * f, -448.f), 448.f)
            int w = __builtin_amdgcn_cvt_pk_fp8_f32(F8C(s[0 * 33]), F8C(s[1 * 33]), 0, false); w = __builtin_amdgcn_cvt_pk_fp8_f32(F8C(s[2 * 33]), F8C(s[3 * 33]), w, true); o.x = (unsigned)w;
            w = __builtin_amdgcn_cvt_pk_fp8_f32(F8C(s[4 * 33]), F8C(s[5 * 33]), 0, false); w = __builtin_amdgcn_cvt_pk_fp8_f32(F8C(s[6 * 33]), F8C(s[7 * 33]), w, true); o.y = (unsigned)w;
#undef F8C
            *(u32x2*)((unsigned char*)jb.WT + (size_t)(n0 + n) * jb.K + k0 + 8 * c) = o; }
        else { u32x4 o; o.x = pk2(s[0 * 33], s[1 * 33]); o.y = pk2(s[2 * 33], s[3 * 33]); o.z = pk2(s[4 * 33], s[5 * 33]); o.w = pk2(s[6 * 33], s[7 * 33]);
            *(u32x4*)(jb.WT + (size_t)(n0 + n) * jb.K + k0 + 8 * c) = o; } }
    asm volatile("s_waitcnt lgkmcnt(0)" ::: "memory");
}
__device__ __forceinline__ void rms_row_load(const float* xrow, int lane, f32x4 (&v)[8]) {
    const f32x4* xr = (const f32x4*)xrow + lane;
#pragma unroll
    for (int j = 0; j < 8; ++j) v[j] = xr[64 * j];
}
__device__ __forceinline__ void rms_row_finish(const f32x4 (&v)[8], const float* g, bf16_t* orow, unsigned char* o8row, int lane) {
    const f32x4* gr = (const f32x4*)g + lane; float s = 0.f;
#pragma unroll
    for (int j = 0; j < 8; ++j) s += (v[j].x * v[j].x + v[j].y * v[j].y) + (v[j].z * v[j].z + v[j].w * v[j].w);
    const float rstd = rsqrtf(wave_sum(s) * (1.f / D) + EPS);
    u32x2* o8 = (u32x2*)orow + lane;
#pragma unroll
    for (int j = 0; j < 8; ++j) { const f32x4 gg = gr[64 * j]; const float a0 = v[j].x * rstd * gg.x, a1 = v[j].y * rstd * gg.y, a2 = v[j].z * rstd * gg.z, a3 = v[j].w * rstd * gg.w;
        u32x2 o; o.x = pk2(a0, a1); o.y = pk2(a2, a3); o8[64 * j] = o;
        if (o8row) { int w = __builtin_amdgcn_cvt_pk_fp8_f32(fminf(fmaxf(a0, -448.f), 448.f), fminf(fmaxf(a1, -448.f), 448.f), 0, false);
            w = __builtin_amdgcn_cvt_pk_fp8_f32(fminf(fmaxf(a2, -448.f), 448.f), fminf(fmaxf(a3, -448.f), 448.f), w, true); ((unsigned*)o8row)[64 * j + lane] = (unsigned)w; } }
}
__device__ __forceinline__ void rms_rows(const float* X, const float* g, bf16_t* O, unsigned char* O8, int nrows, int gw, int NW, int lane) {
    f32x4 va[8], vb[8];
    int m = gw;
    if (m < nrows) rms_row_load(X + (size_t)m * D, lane, va);
    for (; m < nrows; m += 2 * NW) {
        const bool hb = m + NW < nrows;
        if (hb) rms_row_load(X + (size_t)(m + NW) * D, lane, vb);
        rms_row_finish(va, g, O + (size_t)m * D, O8 ? O8 + (size_t)m * D : nullptr, lane);
        if (m + 2 * NW < nrows) rms_row_load(X + (size_t)(m + 2 * NW) * D, lane, va);
        if (hb) rms_row_finish(vb, g, O + (size_t)(m + NW) * D, O8 ? O8 + (size_t)(m + NW) * D : nullptr, lane);
    }
}

template <int TM, int TN, class Epi>
__device__ __forceinline__ void gemm_simple(const bf16_t* __restrict__ A, int lda, const bf16_t* __restrict__ Bt, int ldb, int M, int N, int K, const Epi& epi, int gw, int NW, int lane) {
    const int r = lane & 15, q = lane >> 4;
    const int ntm = M / (16 * TM), ntn = N / (16 * TN);
    for (int tile = gw; tile < ntm * ntn; tile += NW) {
        const int tm = tile / ntn, tn = tile % ntn;
        f32x4 acc[TM][TN];
#pragma unroll
        for (int i = 0; i < TM; ++i)
#pragma unroll
            for (int j = 0; j < TN; ++j) acc[i][j] = (f32x4){0.f, 0.f, 0.f, 0.f};
        const bf16_t* ap = A + (size_t)(tm * 16 * TM + r) * lda + q * 8;
        const bf16_t* bp = Bt + (size_t)(tn * 16 * TN + r) * ldb + q * 8;
        for (int k0 = 0; k0 < K; k0 += 32) {
            bf16x8 af[TM], bfr[TN];
#pragma unroll
            for (int i = 0; i < TM; ++i) af[i] = *(const bf16x8*)(ap + (size_t)i * 16 * lda + k0);
#pragma unroll
            for (int j = 0; j < TN; ++j) bfr[j] = *(const bf16x8*)(bp + (size_t)j * 16 * ldb + k0);
#pragma unroll
            for (int i = 0; i < TM; ++i)
#pragma unroll
                for (int j = 0; j < TN; ++j) acc[i][j] = __builtin_amdgcn_mfma_f32_16x16x32_bf16(af[i], bfr[j], acc[i][j], 0, 0, 0);
        }
#pragma unroll
        for (int i = 0; i < TM; ++i)
#pragma unroll
            for (int j = 0; j < TN; ++j)
#pragma unroll
                for (int e = 0; e < 4; ++e) epi(tm * 16 * TM + i * 16 + q * 4 + e, tn * 16 * TN + j * 16 + r, acc[i][j][e]);
    }
}
struct EpiProj { bf16_t* P; __device__ __forceinline__ void operator()(int row, int col, float v) const { if (col >= C_GL && col < C_QC) v = gelu_tanh(v); P[(size_t)row * INW + col] = (bf16_t)f2bf(v); } };
struct EpiGate { bf16_t* G; const float* b; __device__ __forceinline__ void operator()(int row, int col, float v) const { G[(size_t)row * GW + col] = (bf16_t)f2bf(sigmoid_(v + b[col])); } };
struct EpiStore { bf16_t* C; int ldc; __device__ __forceinline__ void operator()(int row, int col, float v) const { C[(size_t)row * ldc + col] = (bf16_t)f2bf(v); } };
struct EpiWo { const float* x; float* out; bf16_t* xb; __device__ __forceinline__ void operator()(int row, int col, float v) const { const size_t o = (size_t)row * D + col; const float y = x[o] + v; out[o] = y; xb[o] = (bf16_t)f2bf(y); } };
struct EpiQ { bf16_t* Q; const float* rs; __device__ __forceinline__ void operator()(int row, int col, float v) const { Q[(size_t)row * D + col] = (bf16_t)f2bf(v * rs[row]); } };

__device__ __forceinline__ void headnorm(bf16_t* vec, const float* g, float scale, int lane) {
    unsigned* p = (unsigned*)vec + lane; const unsigned w = *p;
    const float a = bf2f(w & 0xffffu), b = bf2f(w >> 16);
    const float rs = rsqrtf(wave_sum(a * a + b * b) * (1.f / 128.f) + EPS) * scale;
    *p = pk2(a * rs * g[2 * lane], b * rs * g[2 * lane + 1]);
}
struct HeadGains { float gq[32], gk[32], gc[8]; };
__device__ __forceinline__ void load_head_gains(HeadGains& hg, const float* gq, const float* gk, const float* gc, int lane) {
#pragma unroll
    for (int j = 0; j < 32; ++j) { hg.gq[j] = gq[(lane & 3) * 32 + j]; hg.gk[j] = gk[(lane & 3) * 32 + j]; }
#pragma unroll
    for (int j = 0; j < 8; ++j) hg.gc[j] = gc[(lane & 15) * 8 + j];
}
__device__ __forceinline__ void headnorm_token(bf16_t* row, const HeadGains& hg, float qscale, int lane) {
    u32x4* pa = (u32x4*)(row + C_QA) + lane * 4;
    u32x4* pc = (u32x4*)(row + C_QC) + lane;
    u32x4 w[4]; const u32x4 wc = *pc;
#pragma unroll
    for (int j = 0; j < 4; ++j) w[j] = pa[j];
    float f[32], fc[8]; float ss = 0.f, sc = 0.f;
#pragma unroll
    for (int j = 0; j < 4; ++j) unpack8(w[j], f + 8 * j);
    unpack8(wc, fc);
#pragma unroll
    for (int j = 0; j < 32; ++j) ss = fmaf(f[j], f[j], ss);
#pragma unroll
    for (int j = 0; j < 8; ++j) sc = fmaf(fc[j], fc[j], sc);
    ss += __shfl_xor(ss, 1); ss += __shfl_xor(ss, 2);
    sc += __shfl_xor(sc, 1); sc += __shfl_xor(sc, 2); sc += __shfl_xor(sc, 4); sc += __shfl_xor(sc, 8);
    const bool isq = lane < 32;
    const float rs = rsqrtf(ss * (1.f / 128.f) + EPS) * (isq ? qscale : 1.f), rc = rsqrtf(sc * (1.f / 128.f) + EPS) * qscale;
#pragma unroll
    for (int j = 0; j < 4; ++j) { u32x4 o;
        o.x = pk2(f[8 * j] * rs * (isq ? hg.gq[8 * j] : hg.gk[8 * j]), f[8 * j + 1] * rs * (isq ? hg.gq[8 * j + 1] : hg.gk[8 * j + 1]));
        o.y = pk2(f[8 * j + 2] * rs * (isq ? hg.gq[8 * j + 2] : hg.gk[8 * j + 2]), f[8 * j + 3] * rs * (isq ? hg.gq[8 * j + 3] : hg.gk[8 * j + 3]));
        o.z = pk2(f[8 * j + 4] * rs * (isq ? hg.gq[8 * j + 4] : hg.gk[8 * j + 4]), f[8 * j + 5] * rs * (isq ? hg.gq[8 * j + 5] : hg.gk[8 * j + 5]));
        o.w = pk2(f[8 * j + 6] * rs * (isq ? hg.gq[8 * j + 6] : hg.gk[8 * j + 6]), f[8 * j + 7] * rs * (isq ? hg.gq[8 * j + 7] : hg.gk[8 * j + 7]));
        pa[j] = o; }
    { u32x4 o; o.x = pk2(fc[0] * rc * hg.gc[0], fc[1] * rc * hg.gc[1]); o.y = pk2(fc[2] * rc * hg.gc[2], fc[3] * rc * hg.gc[3]);
      o.z = pk2(fc[4] * rc * hg.gc[4], fc[5] * rc * hg.gc[5]); o.w = pk2(fc[6] * rc * hg.gc[6], fc[7] * rc * hg.gc[7]); *pc = o; }
}

__device__ __forceinline__ void fp4_row_load(const float* __restrict__ src, const float* __restrict__ kscale, int lane, f32x4 (&v)[8]);
__device__ __forceinline__ void fp4_row_finish(const f32x4 (&v)[8], unsigned char* __restrict__ tab, int e, float* __restrict__ scale_out, int lane);
__device__ __forceinline__ void lru_pass1(const Params& p, int b, int c, int g, int lane, LAS unsigned char* wl  , const int tr0, const int trs) {
    const bf16_t* PROJ = (const bf16_t*)(p.ws + WS_PROJ);
    float* SUMA = (float*)(p.ws + WS_LRUSUM); float* SUMB = SUMA + BATCH * NCH * LW;
    bf16_t* AUA = (bf16_t*)(p.ws + WS_AUA); bf16_t* AUU = (bf16_t*)(p.ws + WS_AUU);
    const float* conv_w = p.in[7]; const float* conv_b = p.in[8]; const float* lru_wa = p.in[9]; const float* lru_ba = p.in[10];
    const float* lru_wx = p.in[11]; const float* lru_bx = p.in[12]; const float* lam = p.in[13];
    const int ch = g * 64 + lane;
    unsigned wa_p[32], wx_p[32];
#pragma unroll
    for (int m = 0; m < 32; ++m) { wa_p[m] = pk2(lru_wa[(size_t)(g * 64 + 2 * m) * 64 + lane], lru_wa[(size_t)(g * 64 + 2 * m + 1) * 64 + lane]);
        wx_p[m] = pk2(lru_wx[(size_t)(g * 64 + 2 * m) * 64 + lane], lru_wx[(size_t)(g * 64 + 2 * m + 1) * 64 + lane]); }
    const float cw0 = conv_w[0 * LW + ch], cw1 = conv_w[1 * LW + ch], cw2 = conv_w[2 * LW + ch], cw3 = conv_w[3 * LW + ch], cb = conv_b[ch];
    const float ba_ = lru_ba[ch], bx_ = lru_bx[ch];
    const float sp = log1pf(__expf(-lam[ch]));
    const int t0 = c * CHUNK; const size_t row0 = (size_t)b * SEQ + t0;
    float x0 = 0.f, x1 = 0.f, x2 = 0.f;
    if (t0 >= 3) { x0 = bf2f(PROJ[(row0 - 3) * INW + C_XL + ch]); x1 = bf2f(PROJ[(row0 - 2) * INW + C_XL + ch]); x2 = bf2f(PROJ[(row0 - 1) * INW + C_XL + ch]); }
    { const bf16_t* xs = PROJ + (row0 + (lane >> 3)) * INW + C_XL + g * 64 + (lane & 7) * 8;
      u32x4 tx[8];
#pragma unroll
      for (int i = 0; i < 8; ++i) tx[i] = *(const u32x4*)(xs + (size_t)(8 * i) * INW);
#pragma unroll
      for (int i = 0; i < 8; ++i) *(LAS u32x4*)(wl + (8 * i + (lane >> 3)) * 128 + (lane & 7) * 16) = tx[i]; }
    float h = 0.f, aprod = 1.f;
#define LRU_PAIRX(xc_) ({ const float xnb_ = __int_as_float(__builtin_amdgcn_update_dpp(0, __float_as_int(xc_), 0xB1, 0xf, 0xf, true));     \
        (lane & 1) ? pk2(xnb_, xc_) : pk2(xc_, xnb_); })
#define LRU_GATE(rp_, ip_, xc_, a_, u_) do { const float r_ = sigmoid_(rp_), ig_ = sigmoid_(ip_); const float la_ = -8.f * r_ * sp; a_ = __expf(la_); \
        u_ = sqrtf(fminf(fmaxf((1.f - a_) * (1.f + a_), 1e-12f), 1.f)) * ig_ * xc_; } while (0)
#define LRU_TOKPAIR(tp_) do { const int t_ = (tp_);                           \
        const float x3 = bf2f(*(const LAS bf16_t*)(wl + t_ * 128 + lane * 2)), x4 = bf2f(*(const LAS bf16_t*)(wl + (t_ + 1) * 128 + lane * 2)); \
        const float xcA = cw0 * x0 + cw1 * x1 + cw2 * x2 + cw3 * x3 + cb, xcB = cw0 * x1 + cw1 * x2 + cw2 * x3 + cw3 * x4 + cb; \
        x0 = x2; x1 = x3; x2 = x4; \
        const unsigned pkA = LRU_PAIRX(xcA), pkB = LRU_PAIRX(xcB); \
        float rA = ba_, iA = bx_, rA2 = 0.f, iA2 = 0.f, rB = ba_, iB = bx_, rB2 = 0.f, iB2 = 0.f; \
_Pragma("unroll") \
        for (int m = 0; m < 32; m += 2) { \
            const unsigned a0 = (unsigned)__builtin_amdgcn_readlane((int)pkA, 2 * m), a1 = (unsigned)__builtin_amdgcn_readlane((int)pkA, 2 * m + 2); \
            const unsigned b0 = (unsigned)__builtin_amdgcn_readlane((int)pkB, 2 * m), b1 = (unsigned)__builtin_amdgcn_readlane((int)pkB, 2 * m + 2); \
            rA = dot2bf(wa_p[m], a0, rA); iA = dot2bf(wx_p[m], a0, iA); rA2 = dot2bf(wa_p[m + 1], a1, rA2); iA2 = dot2bf(wx_p[m + 1], a1, iA2); \
            rB = dot2bf(wa_p[m], b0, rB); iB = dot2bf(wx_p[m], b0, iB); rB2 = dot2bf(wa_p[m + 1], b1, rB2); iB2 = dot2bf(wx_p[m + 1], b1, iB2); } \
        float aA, uA, aB, uB; \
        LRU_GATE(rA + rA2, iA + iA2, xcA, aA, uA); LRU_GATE(rB + rB2, iB + iB2, xcB, aB, uB); \
        \
        const unsigned wA = f2bf(1.f - aA), wB = f2bf(1.f - aB), vA = f2bf(uA), vB = f2bf(uB); \
        AUA[(row0 + t_) * LW + ch] = (bf16_t)wA; AUA[(row0 + t_ + 1) * LW + ch] = (bf16_t)wB; AUU[(row0 + t_) * LW + ch] = (bf16_t)vA; AUU[(row0 + t_ + 1) * LW + ch] = (bf16_t)vB; \
        const float aAq = 1.f - bf2f(wA), aBq = 1.f - bf2f(wB); \
        h = aBq * (aAq * h + bf2f(vA)) + bf2f(vB); \
        aprod *= aAq * aBq; \
    } while (0)
#define SIDE_LOAD(r_, v_) do { if ((r_) < 16384) fp4_row_load(p.in[25] + (size_t)(r_) * D, p.in[22], lane, v_); else if ((r_) < 32768) fp4_row_load(p.in[26] + (size_t)((r_) - 16384) * D, nullptr, lane, v_); } while (0)
#define SIDE_FIN(r_, v_) do { if ((r_) < 16384) fp4_row_finish(v_, p.ws + WS_TABU, (r_), (float*)(p.ws + WS_SCU) + (r_), lane); \
        else if ((r_) < 32768) fp4_row_finish(v_, p.ws + WS_TABV, (r_) - 16384, (float*)(p.ws + WS_SCV) + ((r_) - 16384), lane); } while (0)
    f32x4 sva[8]; int sr = tr0;
    SIDE_LOAD(sr, sva);
#pragma unroll 1
    for (int tt = 0; tt < CHUNK; tt += 4) {
        LRU_TOKPAIR(tt);
        SIDE_FIN(sr, sva); SIDE_LOAD(sr + trs, sva);
        LRU_TOKPAIR(tt + 2);
        sr += trs;
    }
#undef LRU_TOKPAIR
#undef SIDE_LOAD
#undef SIDE_FIN
#undef LRU_PAIRX
#undef LRU_GATE
    { const size_t o = (size_t)(b * NCH + c) * LW + ch; SUMA[o] = aprod; SUMB[o] = h; }
}
__device__ __forceinline__ void lru_pass2(const Params& p, int b, int c, int g, int lane) {
    const bf16_t* PROJ = (const bf16_t*)(p.ws + WS_PROJ); bf16_t* O = (bf16_t*)(p.ws + WS_HO);
    const float* SUMA = (const float*)(p.ws + WS_LRUSUM); const float* SUMB = SUMA + BATCH * NCH * LW;
    const bf16_t* AUA = (const bf16_t*)(p.ws + WS_AUA); const bf16_t* AUU = (const bf16_t*)(p.ws + WS_AUU);
    const int ch = g * 64 + lane; const size_t row0 = (size_t)b * SEQ + (size_t)c * CHUNK;
    const bf16_t* ap = AUA + row0 * LW + ch; const bf16_t* up = AUU + row0 * LW + ch; const bf16_t* gp = PROJ + row0 * INW + C_GL + ch;
    bf16_t an[16], un[16], gn[16];
#pragma unroll
    for (int q = 0; q < 16; ++q) { an[q] = ap[(size_t)q * LW]; un[q] = up[(size_t)q * LW]; gn[q] = gp[(size_t)q * INW]; }
    float h = 0.f;
    {
        int j = 0;
#pragma unroll 1
        for (; j + 32 <= c; j += 32) { float sa[32], sb[32];
#pragma unroll
            for (int q = 0; q < 32; ++q) { const size_t o = (size_t)(b * NCH + j + q) * LW + ch; sa[q] = SUMA[o]; sb[q] = SUMB[o]; }
#pragma unroll
            for (int q = 0; q < 32; ++q) h = sa[q] * h + sb[q]; }
#pragma unroll 1
        for (; j + 8 <= c; j += 8) { float sa[8], sb[8];
#pragma unroll
            for (int q = 0; q < 8; ++q) { const size_t o = (size_t)(b * NCH + j + q) * LW + ch; sa[q] = SUMA[o]; sb[q] = SUMB[o]; }
#pragma unroll
            for (int q = 0; q < 8; ++q) h = sa[q] * h + sb[q]; }
        for (; j < c; ++j) { const size_t o = (size_t)(b * NCH + j) * LW + ch; h = SUMA[o] * h + SUMB[o]; }
    }
#pragma unroll 1
    for (int tb = 0; tb < CHUNK; tb += 16) {
        bf16_t ac[16], uc[16], gc[16];
#pragma unroll
        for (int q = 0; q < 16; ++q) { ac[q] = an[q]; uc[q] = un[q]; gc[q] = gn[q]; }
        if (tb + 16 < CHUNK) {
#pragma unroll
            for (int q = 0; q < 16; ++q) { an[q] = ap[(size_t)(tb + 16 + q) * LW]; un[q] = up[(size_t)(tb + 16 + q) * LW]; gn[q] = gp[(size_t)(tb + 16 + q) * INW]; }
        }
#pragma unroll
        for (int q = 0; q < 16; ++q) { h = (1.f - bf2f(ac[q])) * h + bf2f(uc[q]); O[(row0 + tb + q) * D + AW + ch] = (bf16_t)f2bf(h * bf2f(gc[q])); }
    }
}

__device__ __forceinline__ void attn_simple(const bf16_t* Qp, int ldq, const bf16_t* Kp, const bf16_t* Vp, int ldkv, int nkeys, int koff, const float* bias_h, bf16_t* Op, int ldo, int tid) {
    const int qi = tid >> 2, part = tid & 3;
    float q[32], o[32];
    { const u32x4* qp = (const u32x4*)(Qp + (size_t)qi * ldq + part * 32);
#pragma unroll
      for (int j = 0; j < 4; ++j) unpack8(qp[j], q + 8 * j); }
#pragma unroll
    for (int d = 0; d < 32; ++d) o[d] = 0.f;
    float m = -1e30f, l = 0.f;
    for (int kk0 = 0; kk0 < nkeys; kk0 += 8) {
        float s[8];
#pragma unroll
        for (int j = 0; j < 8; ++j) {
            const u32x4* kp = (const u32x4*)(Kp + (size_t)(kk0 + j) * ldkv + part * 32);
            float acc = 0.f;
#pragma unroll
            for (int w = 0; w < 4; ++w) { float kf[8]; unpack8(kp[w], kf);
#pragma unroll
                for (int e = 0; e < 8; ++e) acc = fmaf(q[8 * w + e], kf[e], acc); }
            acc += __shfl_xor(acc, 1); acc += __shfl_xor(acc, 2);
            if (bias_h) { int dist = qi + koff - (kk0 + j); dist = dist < -128 ? -128 : (dist > 128 ? 128 : dist); acc += bias_h[dist + 128]; }
            s[j] = acc;
        }
        float mx = s[0];
#pragma unroll
        for (int j = 1; j < 8; ++j) mx = fmaxf(mx, s[j]);
        const float mn = fmaxf(m, mx), corr = __expf(m - mn);
        l *= corr;
#pragma unroll
        for (int d = 0; d < 32; ++d) o[d] *= corr;
#pragma unroll
        for (int j = 0; j < 8; ++j) {
            const float pj = __expf(s[j] - mn); l += pj;
            const u32x4* vp = (const u32x4*)(Vp + (size_t)(kk0 + j) * ldkv + part * 32);
#pragma unroll
            for (int w = 0; w < 4; ++w) { float vf[8]; unpack8(vp[w], vf);
#pragma unroll
                for (int e = 0; e < 8; ++e) o[8 * w + e] = fmaf(pj, vf[e], o[8 * w + e]); }
        }
        m = mn;
    }
    const float inv = 1.f / l;
    u32x4* op = (u32x4*)(Op + (size_t)qi * ldo + part * 32);
#pragma unroll
    for (int w = 0; w < 4; ++w) { u32x4 ov; ov.x = pk2(o[8 * w] * inv, o[8 * w + 1] * inv); ov.y = pk2(o[8 * w + 2] * inv, o[8 * w + 3] * inv); ov.z = pk2(o[8 * w + 4] * inv, o[8 * w + 5] * inv); ov.w = pk2(o[8 * w + 6] * inv, o[8 * w + 7] * inv); op[w] = ov; }
}

__device__ __forceinline__ void gemm_branch(const bf16_t* __restrict__ Ob, const bf16_t* __restrict__ WT, const bf16_t* __restrict__ G, bf16_t* __restrict__ Mg, int gw, int NW, int lane) {
    const int r = lane & 15, q = lane >> 4;
    const int ntn = D / 32, ntiles = (T / 32) * ntn;
    for (int tile = gw; tile < ntiles; tile += NW) {
        const int tm = tile / ntn, tn = tile % ntn;
        f32x4 acc[3][2][2];
#pragma unroll
        for (int s = 0; s < 3; ++s)
#pragma unroll
            for (int i = 0; i < 2; ++i)
#pragma unroll
                for (int j = 0; j < 2; ++j) acc[s][i][j] = (f32x4){0.f, 0.f, 0.f, 0.f};
        const bf16_t* ap = Ob + (size_t)(tm * 32 + r) * D + q * 8;
        const bf16_t* bp = WT + (size_t)(tn * 32 + r) * D + q * 8;
#pragma unroll
        for (int s = 0; s < 3; ++s) {
            const int kb = s == 0 ? 0 : (s == 1 ? 1024 : 1536), ke = s == 0 ? 1024 : (s == 1 ? 1536 : 2048);
            for (int k0 = kb; k0 < ke; k0 += 32) {
                bf16x8 af[2], bfr[2];
#pragma unroll
                for (int i = 0; i < 2; ++i) af[i] = *(const bf16x8*)(ap + (size_t)i * 16 * D + k0);
#pragma unroll
                for (int j = 0; j < 2; ++j) bfr[j] = *(const bf16x8*)(bp + (size_t)j * 16 * D + k0);
#pragma unroll
                for (int i = 0; i < 2; ++i)
#pragma unroll
                    for (int j = 0; j < 2; ++j) acc[s][i][j] = __builtin_amdgcn_mfma_f32_16x16x32_bf16(af[i], bfr[j], acc[s][i][j], 0, 0, 0);
            }
        }
#pragma unroll
        for (int i = 0; i < 2; ++i)
#pragma unroll
            for (int j = 0; j < 2; ++j)
#pragma unroll
                for (int e = 0; e < 4; ++e) {
                    const int row = tm * 32 + i * 16 + q * 4 + e, col = tn * 32 + j * 16 + r;
                    const bf16_t* gp = G + (size_t)row * GW + col;
                    const float mval = bf2f(gp[0]) * acc[0][i][j][e] + bf2f(gp[2048]) * acc[1][i][j][e] + bf2f(gp[4096]) * acc[2][i][j][e];
                    Mg[(size_t)row * D + col] = (bf16_t)f2bf(mval);
                }
    }
}

__device__ __forceinline__ unsigned long long shfl_xor64(unsigned long long v, int m) {
    const unsigned lo = __shfl_xor((unsigned)v, m), hi = __shfl_xor((unsigned)(v >> 32), m);
    return ((unsigned long long)hi << 32) | lo;
}
__device__ __forceinline__ unsigned fkey(float f) { const unsigned u = __float_as_uint(f); return (u & 0x80000000u) ? ~u : (u | 0x80000000u); }
__device__ __forceinline__ float fkey_inv(unsigned k) { const unsigned u = (k & 0x80000000u) ? (k & 0x7fffffffu) : ~k; return __uint_as_float(u); }
__device__ __forceinline__ unsigned long long wave_max64(unsigned long long k) {
#pragma unroll
    for (int o = 1; o < 64; o <<= 1) { const unsigned long long t = shfl_xor64(k, o); k = t > k ? t : k; }
    return k;
}
__device__ __forceinline__ void route_unit(const Params& p, int t, int h, int lane) {
    const bf16_t* Q = (const bf16_t*)(p.ws + WS_Q); const bf16_t* KB = (const bf16_t*)(p.ws + WS_KEYSB);
    int* RIDX = (int*)(p.ws + WS_RIDX); float* RG = (float*)(p.ws + WS_RG);
    float sv_l[2] = {0.f, 0.f}; int si_l[2] = {0, 0};
#pragma unroll
    for (int c = 0; c < 2; ++c) {
        const bf16_t* qv = Q + (size_t)t * D + h * 256 + c * 128;
        const unsigned qw = ((const unsigned*)qv)[lane];
        const float qa = bf2f(qw & 0xffffu), qb = bf2f(qw >> 16);
        const bf16_t* k0p = KB + ((size_t)(h * 2 + c) * NKEYS + lane) * 128;
        const bf16_t* k1p = k0p + 64 * 128;
        float s0 = 0.f, s1 = 0.f;
#pragma unroll
        for (int w = 0; w < 16; ++w) {
            float k0f[8], k1f[8]; unpack8(((const u32x4*)k0p)[w], k0f); unpack8(((const u32x4*)k1p)[w], k1f);
#pragma unroll
            for (int e = 0; e < 8; e += 2) {
                const int src = 4 * w + e / 2;
                const float xa = __int_as_float(__builtin_amdgcn_readlane(__float_as_int(qa), src));
                const float xb = __int_as_float(__builtin_amdgcn_readlane(__float_as_int(qb), src));
                s0 = fmaf(xa, k0f[e], s0); s0 = fmaf(xb, k0f[e + 1], s0);
                s1 = fmaf(xa, k1f[e], s1); s1 = fmaf(xb, k1f[e + 1], s1);
            }
        }
        unsigned long long ka = ((unsigned long long)fkey(s0) << 32) | (unsigned)(255 - lane);
        unsigned long long kb = ((unsigned long long)fkey(s1) << 32) | (unsigned)(255 - (lane + 64));
        for (int rnd = 0; rnd < TOPK; ++rnd) {
            const unsigned long long best = wave_max64(ka > kb ? ka : kb);
            if (ka == best) ka = 0ull; if (kb == best) kb = 0ull;
            if (lane == rnd) { sv_l[c] = fkey_inv((unsigned)(best >> 32)); si_l[c] = 255 - (int)(best & 0xffffffffu); }
        }
    }
    unsigned long long kc[4];
#pragma unroll
    for (int m = 0; m < 4; ++m) { const int cid = lane + 64 * m, i = cid >> 4, j = cid & 15;
        const float v = __shfl(sv_l[0], i) + __shfl(sv_l[1], j);
        kc[m] = ((unsigned long long)fkey(v) << 32) | (unsigned)(1023 - cid); }
    float fv = 0.f; int cidx = 0;
    for (int rnd = 0; rnd < TOPK; ++rnd) {
        unsigned long long loc = kc[0] > kc[1] ? kc[0] : kc[1]; const unsigned long long loc2 = kc[2] > kc[3] ? kc[2] : kc[3]; loc = loc > loc2 ? loc : loc2;
        const unsigned long long best = wave_max64(loc);
#pragma unroll
        for (int m = 0; m < 4; ++m) if (kc[m] == best) kc[m] = 0ull;
        if (lane == rnd) { fv = fkey_inv((unsigned)(best >> 32)); cidx = 1023 - (int)(best & 0xffffffffu); }
    }
    const float fmax_ = __shfl(fv, 0);
    float e = lane < 16 ? __expf(fv - fmax_) : 0.f;
    float ssum = e;
#pragma unroll
    for (int o = 1; o < 16; o <<= 1) ssum += __shfl_xor(ssum, o);
    const int ci = cidx >> 4, cj = cidx & 15;
    const int e0 = __shfl(si_l[0], ci), e1 = __shfl(si_l[1], cj);
    if (lane < 16) { RIDX[(size_t)t * 128 + h * 16 + lane] = e0 * NKEYS + e1; RG[(size_t)t * 128 + h * 16 + lane] = e / ssum; }
}

typedef float f32x2 __attribute__((ext_vector_type(2)));
__device__ __forceinline__ void fp4_row_load(const float* __restrict__ src, const float* __restrict__ kscale, int lane, f32x4 (&v)[8]) {
#pragma unroll
    for (int j = 0; j < 8; ++j) { v[j] = ((const f32x4*)src)[64 * j + lane]; if (kscale) v[j] = v[j] * ((const f32x4*)kscale)[64 * j + lane]; }
}
__device__ __forceinline__ void fp4_row_finish(const f32x4 (&v)[8], unsigned char* __restrict__ tab, int e, float* __restrict__ scale_out, int lane) {
    float mx = 0.f;
#pragma unroll
    for (int j = 0; j < 8; ++j) mx = fmaxf(mx, fmaxf(fmaxf(fabsf(v[j].x), fabsf(v[j].y)), fmaxf(fabsf(v[j].z), fabsf(v[j].w))));
#pragma unroll
    for (int o = 1; o < 64; o <<= 1) mx = fmaxf(mx, __shfl_xor(mx, o));
    const float sc = mx > 0.f ? mx * (1.f / 6.f) : 1.f, inv = 1.f / sc;
#pragma unroll
    for (int j = 0; j < 8; ++j) {
        const f32x4 a = v[j] * inv;
        unsigned pk = 0u;
        pk = __builtin_amdgcn_cvt_scalef32_pk_fp4_f32(pk, fminf(fmaxf(a.x, -6.f), 6.f), fminf(fmaxf(a.y, -6.f), 6.f), 1.0f, 0);
        pk = __builtin_amdgcn_cvt_scalef32_pk_fp4_f32(pk, fminf(fmaxf(a.z, -6.f), 6.f), fminf(fmaxf(a.w, -6.f), 6.f), 1.0f, 1);
        *(unsigned short*)(tab + ((size_t)j * 16384 + e) * 128 + 2 * lane) = (unsigned short)pk;
    }
    if (lane == 0) *scale_out = sc;
}
__device__ __forceinline__ void fp4_tables(const Params& p, int gw, int NW, int lane) {
    f32x4 va[8], vb[8];
#define FP4_LOAD(r, v) do { if ((r) < 16384) fp4_row_load(p.in[25] + (size_t)(r) * D, p.in[22], lane, v); else fp4_row_load(p.in[26] + (size_t)((r) - 16384) * D, nullptr, lane, v); } while (0)
#define FP4_FIN(r, v) do { if ((r) < 16384) fp4_row_finish(v, p.ws + WS_TABU, (r), (float*)(p.ws + WS_SCU) + (r), lane); \
        else fp4_row_finish(v, p.ws + WS_TABV, (r) - 16384, (float*)(p.ws + WS_SCV) + ((r) - 16384), lane); } while (0)
    const int n = 2 * 16384;
    int r = gw;
    if (r < n) FP4_LOAD(r, va);
    for (; r < n; r += 2 * NW) {
        const bool hb = r + NW < n;
        if (hb) FP4_LOAD(r + NW, vb);
        FP4_FIN(r, va);
        if (r + 2 * NW < n) FP4_LOAD(r + 2 * NW, va);
        if (hb) FP4_FIN(r + NW, vb);
    }
#undef FP4_LOAD
#undef FP4_FIN
}
constexpr size_t WS_ZP = WS_Q;
constexpr size_t WS_X2F8 = 2 * MiB;
__device__ __forceinline__ float dot_chunk(const u32x4 w, const float (&xf)[32]) {
    float a0 = 0.f, a1 = 0.f;
#pragma unroll
    for (int q = 0; q < 4; ++q) {
        const f32x2 a = __builtin_amdgcn_cvt_scalef32_pk_f32_fp4(w[q], 1.0f, 0), b = __builtin_amdgcn_cvt_scalef32_pk_f32_fp4(w[q], 1.0f, 1);
        const f32x2 c = __builtin_amdgcn_cvt_scalef32_pk_f32_fp4(w[q], 1.0f, 2), d = __builtin_amdgcn_cvt_scalef32_pk_f32_fp4(w[q], 1.0f, 3);
        a0 = fmaf(a.x, xf[8 * q], a0); a1 = fmaf(a.y, xf[8 * q + 1], a1); a0 = fmaf(b.x, xf[8 * q + 2], a0); a1 = fmaf(b.y, xf[8 * q + 3], a1);
        a0 = fmaf(c.x, xf[8 * q + 4], a0); a1 = fmaf(c.y, xf[8 * q + 5], a1); a0 = fmaf(d.x, xf[8 * q + 6], a0); a1 = fmaf(d.y, xf[8 * q + 7], a1);
    }
    return a0 + a1;
}
__device__ __forceinline__ void axpy_chunk(const u32x4 w, const float a_, float (&of)[32]) {
#pragma unroll
    for (int q = 0; q < 4; ++q) {
        const f32x2 a = __builtin_amdgcn_cvt_scalef32_pk_f32_fp4(w[q], 1.0f, 0), b = __builtin_amdgcn_cvt_scalef32_pk_f32_fp4(w[q], 1.0f, 1);
        const f32x2 c = __builtin_amdgcn_cvt_scalef32_pk_f32_fp4(w[q], 1.0f, 2), d = __builtin_amdgcn_cvt_scalef32_pk_f32_fp4(w[q], 1.0f, 3);
        of[8 * q] = fmaf(a_, a.x, of[8 * q]); of[8 * q + 1] = fmaf(a_, a.y, of[8 * q + 1]); of[8 * q + 2] = fmaf(a_, b.x, of[8 * q + 2]); of[8 * q + 3] = fmaf(a_, b.y, of[8 * q + 3]);
        of[8 * q + 4] = fmaf(a_, c.x, of[8 * q + 4]); of[8 * q + 5] = fmaf(a_, c.y, of[8 * q + 5]); of[8 * q + 6] = fmaf(a_, d.x, of[8 * q + 6]); of[8 * q + 7] = fmaf(a_, d.y, of[8 * q + 7]);
    }
}
struct PeerTok { u32x4 w[16]; u32x4 x[4]; };
template <bool USTEP>
__device__ __forceinline__ void peer_issue(PeerTok& k, const Params& p, const unsigned char* tab, int t, int xv, int lane) {
    const int* RIDX = (const int*)(p.ws + WS_RIDX);
    const int i0 = RIDX[(size_t)t * 128 + lane], i1 = RIDX[(size_t)t * 128 + 64 + lane];
    const int es = lane >> 3, ck = lane & 7;
    if (USTEP) { const bf16_t* xp = (const bf16_t*)(p.ws + WS_X2BF) + (size_t)t * D + 256 * xv + 32 * ck;
#pragma unroll
        for (int j = 0; j < 4; ++j) k.x[j] = *(const u32x4*)(xp + 8 * j); }
#pragma unroll
    for (int g = 0; g < 16; ++g) { const int e = __shfl(g < 8 ? i0 : i1, (8 * g + es) & 63); k.w[g] = *(const u32x4*)(tab + (size_t)e * 128 + ck * 16); }
}
__device__ __forceinline__ void peer_u_finish(const PeerTok& k, const Params& p, int t, int xv, int lane) {
    const int es = lane >> 3, ck = lane & 7;
    float xf[32];
#pragma unroll
    for (int j = 0; j < 4; ++j) unpack8(k.x[j], xf + 8 * j);
    float zsel0 = 0.f, zsel1 = 0.f;
#pragma unroll
    for (int g = 0; g < 16; ++g) { u32x4 w_ = k.w[g]; asm volatile("" : "+v"(w_)); float d = dot_chunk(w_, xf);
        d += __int_as_float(__builtin_amdgcn_update_dpp(0, __float_as_int(d), 0xB1, 0xf, 0xf, true));
        d += __int_as_float(__builtin_amdgcn_update_dpp(0, __float_as_int(d), 0x4E, 0xf, 0xf, true));
        d += __int_as_float(__builtin_amdgcn_update_dpp(0, __float_as_int(d), 0x141, 0xf, 0xf, true));
        if (g < 8) { if (ck == g) zsel0 = d; } else { if (ck == g - 8) zsel1 = d; }
        asm volatile("" : "+v"(zsel0), "+v"(zsel1)); }
    float* zp = (float*)(p.ws + WS_ZP) + ((size_t)xv * T + t) * 128;
    zp[8 * ck + es] = zsel0; zp[64 + 8 * ck + es] = zsel1;
}
__device__ __forceinline__ void peer_v_finish(const PeerTok& k, const Params& p, int t, int xv, int lane, LAS float* red) {
    const float* RG = (const float*)(p.ws + WS_RG);
    const float a0 = RG[(size_t)t * 128 + lane], a1 = RG[(size_t)t * 128 + 64 + lane];
    const int es = lane >> 3, ck = lane & 7;
    float of[32];
#pragma unroll
    for (int q = 0; q < 32; ++q) of[q] = 0.f;
#pragma unroll
    for (int g = 0; g < 16; ++g) { const float a = __shfl(g < 8 ? a0 : a1, (8 * g + es) & 63); u32x4 w_ = k.w[g]; asm volatile("" : "+v"(w_)); axpy_chunk(w_, a, of);
        asm volatile("" : "+v"(of[0]), "+v"(of[1]), "+v"(of[2]), "+v"(of[3]), "+v"(of[4]), "+v"(of[5]), "+v"(of[6]), "+v"(of[7]), "+v"(of[8]), "+v"(of[9]), "+v"(of[10]), "+v"(of[11]), "+v"(of[12]), "+v"(of[13]), "+v"(of[14]), "+v"(of[15]));
        asm volatile("" : "+v"(of[16]), "+v"(of[17]), "+v"(of[18]), "+v"(of[19]), "+v"(of[20]), "+v"(of[21]), "+v"(of[22]), "+v"(of[23]), "+v"(of[24]), "+v"(of[25]), "+v"(of[26]), "+v"(of[27]), "+v"(of[28]), "+v"(of[29]), "+v"(of[30]), "+v"(of[31])); }
#pragma unroll
    for (int q = 0; q < 8; ++q) *(LAS f32x4*)(red + es * 256 + ck * 32 + 4 * q) = (f32x4){of[4 * q], of[4 * q + 1], of[4 * q + 2], of[4 * q + 3]};
    f32x4 s = *(const LAS f32x4*)(red + 4 * lane);
#pragma unroll
    for (int r = 1; r < 8; ++r) s = s + *(const LAS f32x4*)(red + r * 256 + 4 * lane);
    f32x4* o4 = (f32x4*)(p.out + (size_t)t * D + 256 * xv + 4 * lane);
    *o4 = *o4 + s;
}
template <bool USTEP>
__device__ __forceinline__ void peer_step(const Params& p, int lane, int wave, LAS float* red, int pos, int nx, int rank, int nloc) {
    for (int xv = pos; xv < 8; xv += nx) {
        const int wx = rank * 8 + wave, nwx = nloc * 8;
        const unsigned char* tab = p.ws + (USTEP ? WS_TABU : WS_TABV) + (size_t)xv * 16384 * 128;
        PeerTok A, B;
        int t = wx;
        if (t < T) peer_issue<USTEP>(A, p, tab, t, xv, lane);
#pragma unroll 1
        for (; t < T; t += 2 * nwx) {
            const bool hb = t + nwx < T;
            if (hb) peer_issue<USTEP>(B, p, tab, t + nwx, xv, lane);
            if (USTEP) peer_u_finish(A, p, t, xv, lane); else peer_v_finish(A, p, t, xv, lane, red);
            if (t + 2 * nwx < T) peer_issue<USTEP>(A, p, tab, t + 2 * nwx, xv, lane);
            if (hb) { if (USTEP) peer_u_finish(B, p, t + nwx, xv, lane); else peer_v_finish(B, p, t + nwx, xv, lane, red); }
        }
    }
}
typedef int v8i_p __attribute__((ext_vector_type(8))); typedef int v4i_t __attribute__((ext_vector_type(4)));
struct PeerTokU { u32x4 w[16]; u32x4 b[2][2]; };
__device__ __forceinline__ void peer_u_issue(PeerTokU& k, const Params& p, const unsigned char* tab, int t, int xv, int lane) {
    const int* RIDX = (const int*)(p.ws + WS_RIDX);
    const int i0 = RIDX[(size_t)t * 128 + lane], i1 = RIDX[(size_t)t * 128 + 64 + lane];
    const int es = lane >> 3, ck = lane & 7, q = lane >> 4;
    const unsigned char* xp = p.ws + WS_X2F8 + (size_t)t * D + 256 * xv + 16 * q;
#pragma unroll
    for (int kb = 0; kb < 2; ++kb) { k.b[kb][0] = *(const u32x4*)(xp + 128 * kb); k.b[kb][1] = *(const u32x4*)(xp + 128 * kb + 64); }
#pragma unroll
    for (int g = 0; g < 16; ++g) { const int e = __shfl(g < 8 ? i0 : i1, (8 * g + es) & 63); k.w[g] = *(const u32x4*)(tab + (size_t)e * 128 + ck * 16); }
}
__device__ __forceinline__ void peer_u_mfma(const PeerTokU& k, const Params& p, int t, int xv, int lane, LAS unsigned char* vl) {
    float* zp = (float*)(p.ws + WS_ZP) + ((size_t)xv * T + t) * 128;
    const int es = lane >> 3, ck = lane & 7, r16 = lane & 15, q = lane >> 4;
#pragma unroll
    for (int g = 0; g < 16; ++g) { const int row = 8 * g + es; *(LAS u32x4*)(vl + row * 128 + ((ck ^ (row & 7)) << 4)) = k.w[g]; }
    v8i_p b0, b1;
    { const v4i_t x0 = __builtin_bit_cast(v4i_t, k.b[0][0]), x1 = __builtin_bit_cast(v4i_t, k.b[0][1]), y0 = __builtin_bit_cast(v4i_t, k.b[1][0]), y1 = __builtin_bit_cast(v4i_t, k.b[1][1]);
      b0 = __builtin_shufflevector(x0, x1, 0, 1, 2, 3, 4, 5, 6, 7); b1 = __builtin_shufflevector(y0, y1, 0, 1, 2, 3, 4, 5, 6, 7); }
#pragma unroll
    for (int g = 0; g < 8; ++g) {
        const int row = 16 * g + r16;
        const v4i_t a0 = __builtin_bit_cast(v4i_t, *(const LAS u32x4*)(vl + row * 128 + ((q ^ (row & 7)) << 4)));
        const v4i_t a1 = __builtin_bit_cast(v4i_t, *(const LAS u32x4*)(vl + row * 128 + (((4 + q) ^ (row & 7)) << 4)));
        const v8i_p A0 = {a0[0], a0[1], a0[2], a0[3], 0, 0, 0, 0}, A1 = {a1[0], a1[1], a1[2], a1[3], 0, 0, 0, 0};
        f32x4 acc = {0.f, 0.f, 0.f, 0.f};
        acc = __builtin_amdgcn_mfma_scale_f32_16x16x128_f8f6f4(A0, b0, acc, 4, 0, 0, 0x7F7F7F7F, 0, 0x7F7F7F7F);
        acc = __builtin_amdgcn_mfma_scale_f32_16x16x128_f8f6f4(A1, b1, acc, 4, 0, 0, 0x7F7F7F7F, 0, 0x7F7F7F7F);
        if ((lane & 15) == 0) *(f32x4*)(zp + 16 * g + 4 * (lane >> 4)) = acc;
    }
}
__device__ __forceinline__ void peer_u_step(const Params& p, int lane, int wave, LAS unsigned char* vl, int pos, int nx, int rank, int nloc) {
    for (int xv = pos; xv < 8; xv += nx) {
        const int wx = rank * 8 + wave, nwx = nloc * 8;
        const unsigned char* tab = p.ws + WS_TABU + (size_t)xv * 16384 * 128;
        PeerTokU A, B;
        int t = wx;
        if (t < T) peer_u_issue(A, p, tab, t, xv, lane);
#pragma unroll 1
        for (; t < T; t += 2 * nwx) {
            const bool hb = t + nwx < T;
            if (hb) peer_u_issue(B, p, tab, t + nwx, xv, lane);
            peer_u_mfma(A, p, t, xv, lane, vl);
            if (t + 2 * nwx < T) peer_u_issue(A, p, tab, t + 2 * nwx, xv, lane);
            if (hb) peer_u_mfma(B, p, t + nwx, xv, lane, vl);
        }
    }
}
constexpr size_t WS_ACT8 = 34 * MiB, WS_ASC = 36 * MiB;
__device__ __forceinline__ void peer_combine(const Params& p, int t, int lane) {
    const float* ZP = (const float*)(p.ws + WS_ZP); const int* RIDX = (const int*)(p.ws + WS_RIDX); const float* RG = (const float*)(p.ws + WS_RG);
    const float* SCU = (const float*)(p.ws + WS_SCU); const float* SCV = (const float*)(p.ws + WS_SCV); const float* SS2 = (const float*)(p.ws + WS_CTL + CTL_SS2_BYTE);
    const float rs = rsqrtf(SS2[t] * (1.f / D) + EPS);
    float act[2];
#pragma unroll
    for (int hlf = 0; hlf < 2; ++hlf) { const size_t o = (size_t)t * 128 + 64 * hlf + lane; float z = 0.f;
#pragma unroll
        for (int x = 0; x < 8; ++x) z += ZP[((size_t)x * T) * 128 + o];
        const int e = RIDX[o];
        act[hlf] = gelu_tanh(z * rs * SCU[e]) * RG[o] * SCV[e]; }
    float mx = fmaxf(fabsf(act[0]), fabsf(act[1]));
#pragma unroll
    for (int o = 1; o < 64; o <<= 1) mx = fmaxf(mx, __shfl_xor(mx, o));
    const float sc = mx > 0.f ? mx * (1.f / 448.f) : 1.f, inv = 1.f / sc;
    unsigned char* a8 = p.ws + WS_ACT8 + (size_t)t * 128;
    a8[lane] = (unsigned char)(__builtin_amdgcn_cvt_pk_fp8_f32(act[0] * inv, 0.f, 0, false) & 0xff);
    a8[64 + lane] = (unsigned char)(__builtin_amdgcn_cvt_pk_fp8_f32(act[1] * inv, 0.f, 0, false) & 0xff);
    if (lane == 0) ((float*)(p.ws + WS_ASC))[t] = sc;
}
typedef int v2i_t __attribute__((ext_vector_type(2)));
struct PeerTokV { u32x4 w[16]; u32x4 b[2]; };
__device__ __forceinline__ void peer_v_issue(PeerTokV& k, const Params& p, const unsigned char* tab, int t, int lane) {
    const int* RIDX = (const int*)(p.ws + WS_RIDX);
    const int i0 = RIDX[(size_t)t * 128 + lane], i1 = RIDX[(size_t)t * 128 + 64 + lane];
    const int es = lane >> 3, ck = lane & 7, q = lane >> 4;
    const unsigned char* ap = p.ws + WS_ACT8 + (size_t)t * 128 + 16 * q;
    k.b[0] = *(const u32x4*)ap; k.b[1] = *(const u32x4*)(ap + 64);
#pragma unroll
    for (int g = 0; g < 16; ++g) { const int e = __shfl(g < 8 ? i0 : i1, (8 * g + es) & 63); k.w[g] = *(const u32x4*)(tab + (size_t)e * 128 + ck * 16); }
}
__device__ __forceinline__ void peer_v_mfma(const PeerTokV& k, const Params& p, int t, int xv, int lane, LAS unsigned char* vl) {
    const int es = lane >> 3, ck = lane & 7, n = lane & 15, q = lane >> 4;
#pragma unroll
    for (int g = 0; g < 16; ++g) { const int row = 8 * g + es; *(LAS u32x4*)(vl + row * 128 + ((ck ^ (row & 7)) << 4)) = k.w[g]; }
    const v4i_t x0 = __builtin_bit_cast(v4i_t, k.b[0]), x1 = __builtin_bit_cast(v4i_t, k.b[1]);
    const v8i_p bop = __builtin_shufflevector(x0, x1, 0, 1, 2, 3, 4, 5, 6, 7);
    const int r1 = 32 * q + n, r2 = r1 + 16;
    f32x4 keep = {0.f, 0.f, 0.f, 0.f};
#pragma unroll
    for (int mb = 0; mb < 16; ++mb) {
        const v2i_t t1 = __builtin_amdgcn_ds_read_tr4_b64_v2i32((LAS v2i_t*)(vl + r1 * 128 + ((((mb >> 1) ^ (r1 & 7)) << 4) | ((mb & 1) << 3))));
        const v2i_t t2 = __builtin_amdgcn_ds_read_tr4_b64_v2i32((LAS v2i_t*)(vl + r2 * 128 + ((((mb >> 1) ^ (r2 & 7)) << 4) | ((mb & 1) << 3))));
        const v8i_p aop = {t1[0], t1[1], t2[0], t2[1], 0, 0, 0, 0};
        f32x4 acc = {0.f, 0.f, 0.f, 0.f};
        acc = __builtin_amdgcn_mfma_scale_f32_16x16x128_f8f6f4(aop, bop, acc, 4, 0, 0, 0x7F7F7F7F, 0, 0x7F7F7F7F);
        if (n == mb) keep = acc;
    }
    const float sc = ((const float*)(p.ws + WS_ASC))[t];
    const size_t oo = (size_t)t * D + 256 * xv + 16 * n + 4 * q;
    const u32x2 xw = *(const u32x2*)((const bf16_t*)(p.ws + WS_X2BF) + oo);
    const f32x4 x2v = {__uint_as_float(xw.x << 16), __uint_as_float(xw.x & 0xffff0000u), __uint_as_float(xw.y << 16), __uint_as_float(xw.y & 0xffff0000u)};
    *(f32x4*)(p.out + oo) = x2v + keep * sc;
}
__device__ __forceinline__ void peer_v_step(const Params& p, int lane, int wave, LAS unsigned char* vl, int pos, int nx, int rank, int nloc) {
    for (int xv = pos; xv < 8; xv += nx) {
        const int wx = rank * 8 + wave, nwx = nloc * 8;
        const unsigned char* tab = p.ws + WS_TABV + (size_t)xv * 16384 * 128;
        PeerTokV A, B;
        int t = wx;
        if (t < T) peer_v_issue(A, p, tab, t, lane);
#pragma unroll 1
        for (; t < T; t += 2 * nwx) {
            const bool hb = t + nwx < T;
            if (hb) peer_v_issue(B, p, tab, t + nwx, lane);
            peer_v_mfma(A, p, t, xv, lane, vl);
            if (t + 2 * nwx < T) peer_v_issue(A, p, tab, t + 2 * nwx, lane);
            if (hb) peer_v_mfma(B, p, t + nwx, xv, lane, vl);
        }
    }
}

namespace pg8 {
#define PG8_LAS __attribute__((address_space(3)))
constexpr int BM = 256, BK = 64, HALF = 128, HTB = HALF * BK * 2, STAGE_BYTES = 8 * HTB, NXCD = 8, WGM = 1;
__host__ __device__ __forceinline__ int lds_byte(int r, int c) { const int st = (r >> 4) * 2 + (c >> 5), rr = r & 15, cc = c & 31, ob = rr * 64 + cc * 2; return st * 1024 + (ob ^ (((ob >> 9) & 1) << 5)); }
__host__ __device__ __forceinline__ void stage_rc(int b, int& R, int& C) { const int st = b / 1024, sb = b % 1024, swz = sb ^ (((sb >> 9) & 1) << 5); R = (st >> 1) * 16 + swz / 64; C = (st & 1) * 32 + (swz % 64) / 2; }
__host__ __device__ __forceinline__ int perm32(int rho) { const int n = rho >> 4, i = rho & 15; return 8 * (i >> 2) + 4 * n + (i & 3); }
struct Unit { const char* A; const char* B; int pm, pn, kind, nt; };
__device__ __forceinline__ const char* uni_ptr(const char* p) { const unsigned long long v = (unsigned long long)p; const unsigned lo = __builtin_amdgcn_readfirstlane((unsigned)v), hi = __builtin_amdgcn_readfirstlane((unsigned)(v >> 32)); return (const char*)(((unsigned long long)hi << 32) | lo); }
__device__ __forceinline__ void uni(Unit& u) { u.A = uni_ptr(u.A); u.B = uni_ptr(u.B); u.pm = __builtin_amdgcn_readfirstlane(u.pm); u.pn = __builtin_amdgcn_readfirstlane(u.pn); u.kind = __builtin_amdgcn_readfirstlane(u.kind); u.nt = __builtin_amdgcn_readfirstlane(u.nt); }
template <int WG = WGM>
__device__ __forceinline__ void tile_of(int L, int nM, int nN, int& pm, int& pn) {
    const int nwg = nM * nN; int wgid = L; { const int q = nwg / NXCD, r = nwg % NXCD, xcd = wgid % NXCD, off = wgid / NXCD; wgid = (xcd < r ? xcd * (q + 1) : r * (q + 1) + (xcd - r) * q) + off; }
    const int nig = WG * nN, gid = wgid / nig, fm = gid * WG, gsz = (nM - fm) < WG ? (nM - fm) : WG;
    pm = fm + ((wgid % nig) % gsz); pn = (wgid % nig) / gsz;
}
typedef int v8i_t __attribute__((ext_vector_type(8))); typedef int v4i_t __attribute__((ext_vector_type(4)));
__device__ __forceinline__ v8i_t cat8(const bf16x8 lo, const bf16x8 hi) { const v4i_t a = __builtin_bit_cast(v4i_t, lo), b = __builtin_bit_cast(v4i_t, hi); return __builtin_shufflevector(a, b, 0, 1, 2, 3, 4, 5, 6, 7); }
template <bool FP8, class Epi, class Sched>
__device__ __forceinline__ void gemm_phase(PG8_LAS unsigned char* lds, const int lda, const int ldb, const Sched& S, const Epi& E, const int wid) {
    const int lane = fresh_lane(), tid = wid * 64 + lane, wr = wid >> 2, wc = wid & 3, fr = lane & 15, fq = lane >> 4;
    unsigned voffA[2], voffB[2];
#pragma unroll
    for (int i = 0; i < 2; ++i) { int R, C; stage_rc(tid * 16 + i * 8192, R, C); const int Rb = (R & ~31) + perm32(R & 31);
        voffA[i] = (unsigned)(R * lda + C) * 2u; voffB[i] = (unsigned)(Rb * ldb + C) * 2u; }
    const size_t kstep = (size_t)(BK * 2);
    const size_t hstepA = (size_t)HALF * lda * 2, hstepB = (size_t)HALF * ldb * 2;
    const unsigned ldsw = (unsigned)wid * 1024u;
    const int aoff = lds_byte(wr * 64 + fr, fq * 8), boff = lds_byte(wc * 32 + fr, fq * 8);
#define PG8_SA(b, h) (((b) * 2 + (h)) * HTB)
#define PG8_SB(b, h) ((4 + (b) * 2 + (h)) * HTB)
#define PG8_STAGE(bufoff, gbase, voff) do { _Pragma("unroll") for (int _i = 0; _i < 2; ++_i) \
        __builtin_amdgcn_global_load_lds((const unsigned*)((const char*)(gbase) + (voff)[_i]), (PG8_LAS unsigned*)(lds + (bufoff) + ldsw + _i * 8192), 16, 0, 0); } while (0)
#define PG8_LDA(dst, b, h) do { _Pragma("unroll") for (int m = 0; m < 4; ++m) { if constexpr (FP8) dst##8[m] = cat8(*(const PG8_LAS bf16x8*)(lds + PG8_SA(b, h) + aoff + m * 2048), *(const PG8_LAS bf16x8*)(lds + PG8_SA(b, h) + aoff + m * 2048 + 1024)); \
        else { _Pragma("unroll") for (int k = 0; k < 2; ++k) dst[m][k] = *(const PG8_LAS bf16x8*)(lds + PG8_SA(b, h) + aoff + m * 2048 + k * 1024); } } } while (0)
#define PG8_LDB(dst, b, h) do { _Pragma("unroll") for (int n = 0; n < 2; ++n) { if constexpr (FP8) dst##8[n] = cat8(*(const PG8_LAS bf16x8*)(lds + PG8_SB(b, h) + boff + n * 2048), *(const PG8_LAS bf16x8*)(lds + PG8_SB(b, h) + boff + n * 2048 + 1024)); \
        else { _Pragma("unroll") for (int k = 0; k < 2; ++k) dst[n][k] = *(const PG8_LAS bf16x8*)(lds + PG8_SB(b, h) + boff + n * 2048 + k * 1024); } } } while (0)
#define PG8_MMA(ai, bj, At, Bt) do { __builtin_amdgcn_s_setprio(1); \
        if constexpr (FP8) { _Pragma("unroll") for (int m = 0; m < 4; ++m) _Pragma("unroll") for (int n = 0; n < 2; ++n) \
            asm volatile("v_mfma_scale_f32_16x16x128_f8f6f4 %0, %1, %2, %0, %3, %3 op_sel_hi:[0,0,0]" : "+v"(acc[ai][bj][m][n]) : "v"(Bt##8[n]), "v"(At##8[m]), "v"(mxone)); } \
        else { _Pragma("unroll") for (int m = 0; m < 4; ++m) _Pragma("unroll") for (int n = 0; n < 2; ++n) _Pragma("unroll") for (int k = 0; k < 2; ++k) \
            acc[ai][bj][m][n] = __builtin_amdgcn_mfma_f32_16x16x32_bf16(Bt[n][k], At[m][k], acc[ai][bj][m][n], 0, 0, 0); } \
        __builtin_amdgcn_s_setprio(0); } while (0)
#define PG8_WAIT_V(n) asm volatile("s_waitcnt vmcnt(" #n ")" ::: "memory")
#define PG8_WAIT_L(n) asm volatile("s_waitcnt lgkmcnt(" #n ")" ::: "memory")
#define PG8_BAR __builtin_amdgcn_s_barrier()
#define PG8_SCHED __builtin_amdgcn_sched_barrier(0)
    Unit cur, nxt; int ui = 0;
    if (!S.next(0, cur)) return;
    f32x4 acc[2][2][4][2];
#pragma unroll
    for (int a = 0; a < 2; ++a)
#pragma unroll
        for (int b = 0; b < 2; ++b)
#pragma unroll
            for (int m = 0; m < 4; ++m)
#pragma unroll
                for (int n = 0; n < 2; ++n) acc[a][b][m][n] = (f32x4){0.f, 0.f, 0.f, 0.f};
    const int mxone = 0x7F7F7F7F;
    bf16x8 At[4][2], B0[2][2], B1[2][2]; v8i_t At8[4], B08[2], B18[2];
    const char* cA = cur.A; const char* cB = cur.B;
    PG8_STAGE(PG8_SB(0, 0), cB, voffB); PG8_STAGE(PG8_SB(0, 1), cB + hstepB, voffB); PG8_STAGE(PG8_SA(0, 0), cA, voffA); PG8_STAGE(PG8_SA(0, 1), cA + hstepA, voffA);
    if (wr == 1) PG8_BAR;
    PG8_WAIT_V(2); PG8_BAR;
    PG8_STAGE(PG8_SB(1, 0), cB + kstep, voffB); PG8_STAGE(PG8_SA(1, 0), cA + kstep, voffA); PG8_STAGE(PG8_SB(1, 1), cB + hstepB + kstep, voffB);
    PG8_WAIT_V(6); PG8_BAR;
    for (;;) {
        const bool has_next = S.next(ui + 1, nxt);
        const char* nA = has_next ? nxt.A : cA; const char* nB = has_next ? nxt.B : cB;
        const int nt = cur.nt;
        for (int t = 0; t < nt; t += 2) {
            const bool last = (t == nt - 2);
            const char* a1 = cA + (size_t)(t + 1) * kstep;
            const char* a2 = last ? nA : cA + (size_t)(t + 2) * kstep; const char* b2 = last ? nB : cB + (size_t)(t + 2) * kstep;
            const char* a3 = a2 + kstep; const char* b3 = b2 + kstep;
            PG8_LDB(B0, 0, 0); PG8_LDB(B1, 0, 1); PG8_SCHED; PG8_LDA(At, 0, 0); PG8_STAGE(PG8_SA(1, 1), a1 + hstepA, voffA);
            PG8_WAIT_V(8); PG8_WAIT_L(0); PG8_BAR; PG8_MMA(0, 0, At, B0); PG8_MMA(0, 1, At, B1); PG8_BAR; PG8_SCHED;
            PG8_LDA(At, 0, 1); PG8_STAGE(PG8_SB(0, 0), b2, voffB); PG8_STAGE(PG8_SB(0, 1), b2 + hstepB, voffB); PG8_STAGE(PG8_SA(0, 0), a2, voffA);
            PG8_WAIT_V(8); PG8_WAIT_L(0); PG8_BAR; PG8_MMA(1, 0, At, B0); PG8_MMA(1, 1, At, B1); PG8_BAR; PG8_SCHED;
            PG8_LDB(B0, 1, 0); PG8_LDB(B1, 1, 1); PG8_SCHED; PG8_LDA(At, 1, 0); PG8_STAGE(PG8_SA(0, 1), a2 + hstepA, voffA);
            PG8_WAIT_V(8); PG8_WAIT_L(0); PG8_BAR; PG8_MMA(0, 0, At, B0); PG8_MMA(0, 1, At, B1); PG8_BAR; PG8_SCHED;
            PG8_LDA(At, 1, 1); PG8_STAGE(PG8_SB(1, 0), b3, voffB); PG8_STAGE(PG8_SB(1, 1), b3 + hstepB, voffB); PG8_STAGE(PG8_SA(1, 0), a3, voffA);
            PG8_WAIT_V(8); PG8_WAIT_L(0); PG8_BAR; PG8_MMA(1, 0, At, B0); PG8_MMA(1, 1, At, B1); PG8_BAR; PG8_SCHED;
        }
        if (wr == 0) PG8_BAR;
        if constexpr (FP8) asm volatile("s_nop 15\n\ts_nop 15" ::: "memory");
        E(acc, cur, wr, wc, fr, fq);
        if (!has_next) break;
        if (E.reset(cur)) {
#pragma unroll
        for (int a = 0; a < 2; ++a)
#pragma unroll
            for (int b = 0; b < 2; ++b)
#pragma unroll
                for (int m = 0; m < 4; ++m)
#pragma unroll
                    for (int n = 0; n < 2; ++n) acc[a][b][m][n] = (f32x4){0.f, 0.f, 0.f, 0.f};
        }
        cur = nxt; cA = nA; cB = nB; ++ui;
        if (wr == 1) PG8_BAR;
    }
    PG8_WAIT_V(0);
    PG8_BAR;
#undef PG8_SA
#undef PG8_SB
#undef PG8_STAGE
#undef PG8_LDA
#undef PG8_LDB
#undef PG8_MMA
#undef PG8_WAIT_V
#undef PG8_WAIT_L
#undef PG8_BAR
#undef PG8_SCHED
}
}
typedef f32x4 AccT[2][2][4][2];
#define EPI_RESET_ALWAYS __device__ __forceinline__ bool reset(const pg8::Unit&) const { return true; }
__device__ __forceinline__ unsigned cvt_pk_bf16(float lo, float hi) { unsigned r; asm volatile("v_cvt_pk_bf16_f32 %0, %1, %2" : "=v"(r) : "v"(lo), "v"(hi)); return r; }
__device__ __forceinline__ u32x4 pack8(const f32x4 v0, const f32x4 v1) { u32x4 w; w.x = cvt_pk_bf16(v0[0], v0[1]); w.y = cvt_pk_bf16(v0[2], v0[3]); w.z = cvt_pk_bf16(v1[0], v1[1]); w.w = cvt_pk_bf16(v1[2], v1[3]); return w; }
template <int MODE>
__device__ __forceinline__ void store_tile_bf16(const AccT& acc, bf16_t* base, int ldc, int row0, int col0, const float* bias, const float ascale = 1.f) {
#pragma unroll
    for (int ai = 0; ai < 2; ++ai)
#pragma unroll
        for (int m = 0; m < 4; ++m) { bf16_t* rowp = base + (size_t)(row0 + ai * 128 + m * 16) * ldc + col0;
#pragma unroll
            for (int bj = 0; bj < 2; ++bj) { f32x4 v0 = acc[ai][bj][m][0], v1 = acc[ai][bj][m][1];
                if (MODE == 1) { _Pragma("unroll") for (int e = 0; e < 4; ++e) { v0[e] = gelu_tanh(v0[e]); v1[e] = gelu_tanh(v1[e]); } }
                if (MODE == 2) { const f32x4 b0 = *(const f32x4*)(bias + col0 + bj * 128), b1 = *(const f32x4*)(bias + col0 + bj * 128 + 4);
                    v0 = v0 * ascale + b0; v1 = v1 * ascale + b1; _Pragma("unroll") for (int e = 0; e < 4; ++e) { v0[e] = sigmoid_(v0[e]); v1[e] = sigmoid_(v1[e]); } }
                *(u32x4*)(rowp + bj * 128) = pack8(v0, v1); }
            if (MODE == 2) asm volatile("" ::: "memory"); }
}
struct SchedP1a { const char* H; const char* WT; const char* MEMN; const char* WTM; int G, c;
    __device__ __forceinline__ bool next(int i, pg8::Unit& u) const {
        const int L = i * G + c; const int n1 = 64 * 18;
        if (L < n1) { pg8::tile_of(L, 64, 18, u.pm, u.pn); u.kind = 0; u.A = H + (size_t)u.pm * 256 * D * 2; u.B = WT + (size_t)u.pn * 256 * D * 2; u.nt = D / 64; pg8::uni(u); return true; }
        if (L < n1 + 8) { const int j = L - n1; u.pm = j >> 2; u.pn = j & 3; u.kind = 1; u.A = MEMN + (size_t)u.pm * 256 * D * 2; u.B = WTM + (size_t)u.pn * 256 * D * 2; u.nt = D / 64; pg8::uni(u); return true; }
        return false; } };
struct EpiP1a { bf16_t* PROJ; bf16_t* MEMKV; const float* gq; const float* gk; const float* gc; const float* gmk; LAS float* xs; EPI_RESET_ALWAYS
    __device__ __forceinline__ void operator()(AccT& acc, const pg8::Unit& u, int wr, int wc, int fr, int fq) const {
        const int row0 = u.pm * 256 + wr * 64 + fr, cl = wc * 32 + 8 * fq;
        const float* g = nullptr; float qs = 1.f;
        if (u.kind == 1) { if (u.pn < 2) g = gmk; }
        else if (u.pn < 4) { g = gq; qs = 0.08838834764831845f; } else if (u.pn < 8) g = gk; else if (u.pn >= 16) { g = gc; qs = 0.08838834764831845f; }
        if (g) {
#pragma unroll
            for (int ai = 0; ai < 2; ++ai)
#pragma unroll
                for (int m = 0; m < 4; ++m)
#pragma unroll
                    for (int bj = 0; bj < 2; ++bj) { const f32x4 v0 = acc[ai][bj][m][0], v1 = acc[ai][bj][m][1];
                        float sq = (v0[0] * v0[0] + v0[1] * v0[1]) + (v0[2] * v0[2] + v0[3] * v0[3]) + (v1[0] * v1[0] + v1[1] * v1[1]) + (v1[2] * v1[2] + v1[3] * v1[3]);
                        sq += __shfl_xor(sq, 16); sq += __shfl_xor(sq, 32);
                        if (fq == 0) xs[((ai * 128 + wr * 64 + m * 16 + fr) * 2 + bj) * 4 + wc] = sq; asm volatile("" ::: "memory"); }
            asm volatile("s_waitcnt lgkmcnt(0)" ::: "memory"); __builtin_amdgcn_s_barrier(); asm volatile("" ::: "memory");
#pragma unroll
            for (int ai = 0; ai < 2; ++ai)
#pragma unroll
                for (int m = 0; m < 4; ++m)
#pragma unroll
                    for (int bj = 0; bj < 2; ++bj) { const f32x4 pp = *(const LAS f32x4*)(xs + ((ai * 128 + wr * 64 + m * 16 + fr) * 2 + bj) * 4);
                        const float rs = rsqrtf(((pp[0] + pp[1]) + (pp[2] + pp[3])) * (1.f / 128.f) + EPS) * qs;
                        const f32x4 g0 = *(const f32x4*)(g + cl), g1 = *(const f32x4*)(g + cl + 4);
                        acc[ai][bj][m][0] = acc[ai][bj][m][0] * g0 * rs; acc[ai][bj][m][1] = acc[ai][bj][m][1] * g1 * rs; asm volatile("" ::: "memory"); }
            asm volatile("s_waitcnt lgkmcnt(0)" ::: "memory"); __builtin_amdgcn_s_barrier(); asm volatile("" ::: "memory");
        }
        if (u.kind == 1) { store_tile_bf16<0>(acc, MEMKV, 2 * CW, row0, u.pn * 256 + cl, nullptr); return; }
        if (u.pn == 14 || u.pn == 15) { store_tile_bf16<1>(acc, PROJ, INW, row0, u.pn * 256 + cl, nullptr); return; }
        store_tile_bf16<0>(acc, PROJ, INW, row0, u.pn * 256 + cl, nullptr);
    } };
struct SchedP1b { const char* H8; const char* WT8; int G, c;
    __device__ __forceinline__ bool next(int i, pg8::Unit& u) const {
        const int L = i * G + c; if (L >= 64 * 24) return false;
        pg8::tile_of(L, 64, 24, u.pm, u.pn); u.kind = 0; u.A = H8 + (size_t)u.pm * 256 * D; u.B = WT8 + (size_t)u.pn * 256 * D; u.nt = D / 128; pg8::uni(u); return true; } };
struct EpiP1b { bf16_t* G; const float* bgate; EPI_RESET_ALWAYS
    __device__ __forceinline__ void operator()(AccT& acc, const pg8::Unit& u, int wr, int wc, int fr, int fq) const {
        store_tile_bf16<2>(acc, G, GW, u.pm * 256 + wr * 64 + fr, u.pn * 256 + wc * 32 + 8 * fq, bgate, 1.f / GATE_WSCALE);
    } };
struct SchedP3 { const char* O; const char* WT; int G, c;
    __device__ __forceinline__ bool next(int i, pg8::Unit& u) const {
        const int ti = i / 3, seg = i - 3 * ti; const int L = ti * G + c; if (L >= 64 * 8) return false;
        pg8::tile_of(L, 64, 8, u.pm, u.pn); u.kind = seg;
        const int kb = seg == 0 ? 0 : (seg == 1 ? 1024 : 1536);
        u.A = O + ((size_t)u.pm * 256 * D + kb) * 2; u.B = WT + ((size_t)u.pn * 256 * D + kb) * 2; u.nt = seg == 0 ? 16 : 8; pg8::uni(u); return true; } };
struct EpiP3 { const bf16_t* G; bf16_t* MERGED;
    __device__ __forceinline__ bool reset(const pg8::Unit& u) const { return u.kind == 2; }
    __device__ __forceinline__ void operator()(AccT& acc, const pg8::Unit& u, int wr, int wc, int fr, int fq) const {
        const int row0 = u.pm * 256 + wr * 64 + fr, col0 = u.pn * 256 + wc * 32 + 8 * fq, seg = u.kind;
#pragma unroll
        for (int ai = 0; ai < 2; ++ai)
#pragma unroll
            for (int mh = 0; mh < 2; ++mh) {
                u32x4 ga[2][2], gb[2][2];
#pragma unroll
                for (int mm = 0; mm < 2; ++mm)
#pragma unroll
                    for (int bj = 0; bj < 2; ++bj) { const bf16_t* gp = G + (size_t)(row0 + ai * 128 + (mh * 2 + mm) * 16) * GW + col0 + bj * 128;
                        ga[mm][bj] = *(const u32x4*)(gp + seg * D); gb[mm][bj] = (seg < 2) ? *(const u32x4*)(gp + (seg + 1) * D) : (u32x4){0u, 0u, 0u, 0u}; }
#pragma unroll
                for (int mm = 0; mm < 2; ++mm)
#pragma unroll
                    for (int bj = 0; bj < 2; ++bj) { const int m = mh * 2 + mm;
                        float fa[8], fb[8]; unpack8(ga[mm][bj], fa); unpack8(gb[mm][bj], fb);
                        if (seg < 2) { _Pragma("unroll") for (int e = 0; e < 8; ++e) fa[e] = fa[e] * __builtin_amdgcn_rcpf(fmaxf(fb[e], 1e-20f)); }
                        f32x4& v0 = acc[ai][bj][m][0]; f32x4& v1 = acc[ai][bj][m][1];
                        v0[0] *= fa[0]; v0[1] *= fa[1]; v0[2] *= fa[2]; v0[3] *= fa[3]; v1[0] *= fa[4]; v1[1] *= fa[5]; v1[2] *= fa[6]; v1[3] *= fa[7];
                        if (seg == 2) *(u32x4*)(MERGED + (size_t)(row0 + ai * 128 + m * 16) * D + col0 + bj * 128) = pack8(v0, v1);
                    }
                asm volatile("" ::: "memory");
            }
    } };
struct SchedSq { const char* A; const char* WT; int G, c;
    __device__ __forceinline__ bool next(int i, pg8::Unit& u) const {
        const int L = i * G + c; if (L >= 64 * 8) return false;
        pg8::tile_of(L, 64, 8, u.pm, u.pn); u.kind = 0; u.A = A + (size_t)u.pm * 256 * D * 2; u.B = WT + (size_t)u.pn * 256 * D * 2; u.nt = D / 64; pg8::uni(u); return true; } };
struct EpiP4 { const float* x; float* out; bf16_t* xb; float* ss; unsigned char* x8; EPI_RESET_ALWAYS
    __device__ __forceinline__ void operator()(AccT& acc, const pg8::Unit& u, int wr, int wc, int fr, int fq) const {
        const int row0 = u.pm * 256 + wr * 64 + fr, col0 = u.pn * 256 + wc * 32 + 8 * fq;
#pragma unroll
        for (int ai = 0; ai < 2; ++ai)
#pragma unroll
            for (int m = 0; m < 4; ++m) { const size_t row = (size_t)(row0 + ai * 128 + m * 16); float sq = 0.f;
#pragma unroll
                for (int bj = 0; bj < 2; ++bj) { const size_t o = row * D + col0 + bj * 128;
                    const f32x4 v0 = acc[ai][bj][m][0] + *(const f32x4*)(x + o), v1 = acc[ai][bj][m][1] + *(const f32x4*)(x + o + 4);
                    *(u32x4*)(xb + o) = pack8(v0, v1);
#define F8X(x_) fminf(fmaxf((x_), -448.f), 448.f)
                    { int w0 = __builtin_amdgcn_cvt_pk_fp8_f32(F8X(v0[0]), F8X(v0[1]), 0, false); w0 = __builtin_amdgcn_cvt_pk_fp8_f32(F8X(v0[2]), F8X(v0[3]), w0, true);
                      int w1 = __builtin_amdgcn_cvt_pk_fp8_f32(F8X(v1[0]), F8X(v1[1]), 0, false); w1 = __builtin_amdgcn_cvt_pk_fp8_f32(F8X(v1[2]), F8X(v1[3]), w1, true);
                      *(u32x2*)(x8 + o) = (u32x2){(unsigned)w0, (unsigned)w1}; }
                    sq += (v0[0] * v0[0] + v0[1] * v0[1]) + (v0[2] * v0[2] + v0[3] * v0[3]) + (v1[0] * v1[0] + v1[1] * v1[1]) + (v1[2] * v1[2] + v1[3] * v1[3]); }
                sq += __shfl_xor(sq, 16); sq += __shfl_xor(sq, 32);
                if (fq == 0) atomicAdd(ss + row, sq); }
    } };
struct EpiP5 { bf16_t* Q; const float* ss; EPI_RESET_ALWAYS
    __device__ __forceinline__ void operator()(AccT& acc, const pg8::Unit& u, int wr, int wc, int fr, int fq) const {
        const int row0 = u.pm * 256 + wr * 64 + fr, col0 = u.pn * 256 + wc * 32 + 8 * fq;
#pragma unroll
        for (int ai = 0; ai < 2; ++ai)
#pragma unroll
            for (int m = 0; m < 4; ++m) { const size_t row = (size_t)(row0 + ai * 128 + m * 16); const float rs = rsqrtf(ss[row] * (1.f / D) + EPS);
#pragma unroll
                for (int bj = 0; bj < 2; ++bj) *(u32x4*)(Q + row * D + col0 + bj * 128) = pack8(acc[ai][bj][m][0] * rs, acc[ai][bj][m][1] * rs); }
    } };


namespace att {
using s16x4  = __attribute__((ext_vector_type(4))) short;
using f32x16 = __attribute__((ext_vector_type(16))) float;
constexpr int NWV = 8, QBLK = 32, KVBLK = 64, DH = 128;
constexpr float THR = 8.f;
constexpr int SHM_V = KVBLK * DH * 2, SHM_K = KVBLK * DH * 2;
constexpr int OFF_WS = 2 * SHM_V + 2 * SHM_K, OFF_BT = OFF_WS + NWV * 64 * 4, OFF_OST = OFF_BT + 1536, LDS_NEED = OFF_OST + NWV * 8192;
#define KSWZ(row, colB) ((row) * 256 + ((colB) ^ (((row) & 7) << 4)))
#define SBAR() __builtin_amdgcn_sched_barrier(0)
__device__ __forceinline__ int crow(int r, int hi) { return (r & 3) + 8 * (r >> 2) + 4 * hi; }
__device__ __forceinline__ unsigned cvtpk(float lo, float hi) { unsigned r; asm volatile("v_cvt_pk_bf16_f32 %0, %1, %2" : "=v"(r) : "v"(lo), "v"(hi)); return r; }
__device__ __forceinline__ void partialSM(f32x16& p0, f32x16& p1, float& m_reg, float& mn, float& alpha) {
  constexpr float C = 1.4426950408889634f;
  float pmax = p0[0];
#pragma unroll
  for (int r = 1; r < 16; ++r) pmax = fmaxf(pmax, p0[r]);
#pragma unroll
  for (int r = 0; r < 16; ++r) pmax = fmaxf(pmax, p1[r]);
  { auto rr = __builtin_amdgcn_permlane32_swap(__float_as_uint(pmax), __float_as_uint(pmax), false, false);
    pmax = fmaxf(__uint_as_float(rr[0]), __uint_as_float(rr[1])); }
  if (__builtin_expect(__all(pmax - m_reg <= THR), 1)) { mn = m_reg; alpha = 1.f; }
  else { mn = fmaxf(m_reg, pmax); alpha = __builtin_amdgcn_exp2f((m_reg - mn) * C); m_reg = mn; }
  float mnC = -mn * C;
#pragma unroll
  for (int r = 0; r < 16; ++r) p0[r] = fmaf(p0[r], C, mnC);
#pragma unroll
  for (int r = 0; r < 16; ++r) p1[r] = fmaf(p1[r], C, mnC);
#pragma unroll
  for (int r = 0; r < 16; ++r) p0[r] = __builtin_amdgcn_exp2f(p0[r]);
}
__device__ __forceinline__ void finishSM(f32x16& p0, f32x16& p1, float alpha, float& l_reg, bf16x8& pa0, bf16x8& pa1, bf16x8& pa2, bf16x8& pa3) {
#pragma unroll
  for (int r = 0; r < 16; ++r) p1[r] = __builtin_amdgcn_exp2f(p1[r]);
  float ps = 0;
#pragma unroll
  for (int r = 0; r < 16; ++r) ps += p0[r];
#pragma unroll
  for (int r = 0; r < 16; ++r) ps += p1[r];
  { auto rr = __builtin_amdgcn_permlane32_swap(__float_as_uint(ps), __float_as_uint(ps), false, false);
    ps = __uint_as_float(rr[0]) + __uint_as_float(rr[1]); }
  l_reg = l_reg * alpha + ps;
#define PK4(P, BASE, OUT) do { unsigned a0 = cvtpk(P[BASE + 0], P[BASE + 1]), a1 = cvtpk(P[BASE + 2], P[BASE + 3]);   \
    unsigned b0 = cvtpk(P[BASE + 4], P[BASE + 5]), b1 = cvtpk(P[BASE + 6], P[BASE + 7]);                              \
    auto r0 = __builtin_amdgcn_permlane32_swap(a0, b0, false, false); auto r1 = __builtin_amdgcn_permlane32_swap(a1, b1, false, false); \
    u32x4 w = {r0[0], r1[0], r0[1], r1[1]}; OUT = *reinterpret_cast<bf16x8*>(&w); } while (0)
  PK4(p0, 0, pa0); PK4(p0, 8, pa1); PK4(p1, 0, pa2); PK4(p1, 8, pa3);
#undef PK4
}
template <bool BIAS>
__device__ __forceinline__ void qkt(f32x16& p0, f32x16& p1, const LAS char* Ks, const LAS char* qs, int r32, int hi, const LAS float* bp) {
  if (BIAS) {
#pragma unroll
    for (int r = 0; r < 16; ++r) { p0[r] = bp[(r & 3) + 8 * (r >> 2)]; p1[r] = bp[32 + (r & 3) + 8 * (r >> 2)]; }
  } else { p0 = f32x16{}; p1 = f32x16{}; }
#pragma unroll
  for (int d0 = 0; d0 < 8; ++d0) { int cb = (d0 * 16 + hi * 8) * 2;
    bf16x8 b0 = *reinterpret_cast<const LAS bf16x8*>(Ks + KSWZ(r32, cb));
    bf16x8 b1 = *reinterpret_cast<const LAS bf16x8*>(Ks + KSWZ(32 + r32, cb));
    const bf16x8 qv = *reinterpret_cast<const LAS bf16x8*>(qs + d0 * 1024);
    p0 = __builtin_amdgcn_mfma_f32_32x32x16_bf16(b0, qv, p0, 0, 0, 0);
    p1 = __builtin_amdgcn_mfma_f32_32x32x16_bf16(b1, qv, p1, 0, 0, 0); }
}
__device__ __forceinline__ int v_st(int k, int c) { const int kk = (k & ~0xC) | ((k & 4) << 1) | ((k & 8) >> 1); return ((kk >> 3) * 4 + (c >> 5)) * 512 + ((kk & 7) * 32 + (c & 31)) * 2; }
__device__ __forceinline__ int v_rd_base(int lane) { return ((lane & 3) << 3) | (((lane >> 2) & 3) << 6) | (((lane >> 4) & 1) << 5) | (((lane >> 5) & 1) << 8); }
constexpr int v_rd_off(int d0, int ks, int half) { return d0 * 512 + ks * 4096 + half * 2048; }
template <int OFF> __device__ __forceinline__ s16x4 tr_read(int vb) {
  s16x4 r; asm volatile("ds_read_b64_tr_b16 %0, %1 offset:%2" : "=&v"(r) : "v"(vb), "i"(OFF) : "memory"); return r;
}
template <int D0> __device__ __forceinline__ void pv_one(f32x16& od, int vb, bf16x8 pa0, bf16x8 pa1, bf16x8 pa2, bf16x8 pa3) {
  const s16x4 l0 = tr_read<v_rd_off(D0, 0, 0)>(vb), h0 = tr_read<v_rd_off(D0, 0, 1)>(vb), l1 = tr_read<v_rd_off(D0, 1, 0)>(vb), h1 = tr_read<v_rd_off(D0, 1, 1)>(vb);
  const s16x4 l2 = tr_read<v_rd_off(D0, 2, 0)>(vb), h2 = tr_read<v_rd_off(D0, 2, 1)>(vb), l3 = tr_read<v_rd_off(D0, 3, 0)>(vb), h3 = tr_read<v_rd_off(D0, 3, 1)>(vb);
  asm volatile("s_waitcnt lgkmcnt(0)" ::: "memory"); SBAR();
#define PK(L, H) (bf16x8){L[0], L[1], L[2], L[3], H[0], H[1], H[2], H[3]}
  od = __builtin_amdgcn_mfma_f32_32x32x16_bf16(pa0, PK(l0, h0), od, 0, 0, 0);
  od = __builtin_amdgcn_mfma_f32_32x32x16_bf16(pa1, PK(l1, h1), od, 0, 0, 0);
  od = __builtin_amdgcn_mfma_f32_32x32x16_bf16(pa2, PK(l2, h2), od, 0, 0, 0);
  od = __builtin_amdgcn_mfma_f32_32x32x16_bf16(pa3, PK(l3, h3), od, 0, 0, 0);
#undef PK
}
__device__ __forceinline__ void pv_d0(f32x16* o, int vb, bf16x8 pa0, bf16x8 pa1, bf16x8 pa2, bf16x8 pa3) {
  pv_one<0>(o[0], vb, pa0, pa1, pa2, pa3); pv_one<1>(o[1], vb, pa0, pa1, pa2, pa3); pv_one<2>(o[2], vb, pa0, pa1, pa2, pa3); pv_one<3>(o[3], vb, pa0, pa1, pa2, pa3);
}
template <int LDQ, int LDK, int LDO, bool BAND>
__device__ __forceinline__ void attn_body(const bf16_t* Qb, const bf16_t* Kh, const bf16_t* Vh, bf16_t* Ob,
                                          const int NT, const int kc0, const float* btab_src, LAS char* lds, const int wid) {
  const int lane = fresh_lane(), tid = wid * 64 + lane, r32 = lane & 31, hi = lane >> 5;
  LAS char* V_lds = lds; LAS char* K_lds = lds + 2 * SHM_V;
  LAS float* wsf = (LAS float*)(lds + OFF_WS) + wid * 64; LAS float* li_l = wsf; LAS float* al_l = wsf + 32;
  LAS float* btab = (LAS float*)(lds + OFF_BT);
  if (BAND) { if (tid < 384) btab[tid] = tid < 64 ? btab_src[256] : (tid < 256 ? btab_src[320 - tid] : -30000.f); }
  float m_reg = -10000.f, l_reg = 0; f32x16 o[4] = {};
  const bf16_t* Qw = Qb + (long)(wid * QBLK + r32) * LDQ + hi * 8;
  LAS char* qr = lds + OFF_OST + wid * 8192 + lane * 16;
#pragma unroll
  for (int d0 = 0; d0 < 8; ++d0) *reinterpret_cast<LAS bf16x8*>(qr + d0 * 1024) = *reinterpret_cast<const bf16x8*>(Qw + d0 * 16);
  const int sr = tid >> 4, sc = (tid & 15) * 8, vst0 = v_st(sr, sc), vst1 = v_st(32 + sr, sc);
  const int vb0 = (int)(unsigned)(uintptr_t)V_lds + v_rd_base(lane);
  struct { bf16x8 vs0, vs1, ks0, ks1; } sr_[1];
  const int pw = wid >> 1, qi = (wid & 1) * 32 + r32;
#define TROW(t) ((BAND ? (((kc0) + (t)) > 0 ? ((kc0) + (t)) : 0) : (t)) * KVBLK)
#define SLOAD(i, t) do { const long k0_ = TROW(t); sr_[i].vs0 = *reinterpret_cast<const bf16x8*>(&Vh[(k0_ + sr) * LDK + sc]); sr_[i].vs1 = *reinterpret_cast<const bf16x8*>(&Vh[(k0_ + 32 + sr) * LDK + sc]); \
    sr_[i].ks0 = *reinterpret_cast<const bf16x8*>(&Kh[(k0_ + sr) * LDK + sc]); sr_[i].ks1 = *reinterpret_cast<const bf16x8*>(&Kh[(k0_ + 32 + sr) * LDK + sc]); } while (0)
#define SWRITE(b, i) do { *(LAS bf16x8*)(V_lds + (b) * SHM_V + vst0) = sr_[i].vs0; *(LAS bf16x8*)(V_lds + (b) * SHM_V + vst1) = sr_[i].vs1; int kc_ = sc * 2; \
    *(LAS bf16x8*)(K_lds + (b) * SHM_K + KSWZ(sr, kc_)) = sr_[i].ks0; *(LAS bf16x8*)(K_lds + (b) * SHM_K + KSWZ(32 + sr, kc_)) = sr_[i].ks1; } while (0)
#define SWAIT() asm volatile("s_waitcnt vmcnt(0)" ::: "memory")
#define RESC(a) do { if (__any((a) < 1.f)) { if (hi == 0) al_l[r32] = (a); asm volatile("s_waitcnt lgkmcnt(0)" ::: "memory"); \
    _Pragma("unroll") for (int d = 0; d < 4; ++d) _Pragma("unroll") for (int r = 0; r < 16; ++r) o[d][r] *= al_l[crow(r, hi)]; } } while (0)
#define BPTR(t) ({ const int t_ = (t); const int dch = pw + 8 - t_; int kb_ = 192 - dch * 64 - qi + 4 * hi; kb_ = kb_ < 0 ? 0 : kb_; \
    if (dch < 0 || dch > 8 || (kc0) + t_ < 0) kb_ = 288; (const LAS float*)(btab + kb_); })
  f32x16 pA0, pA1, pB0, pB1; float mnA, mnB, alA, alB; bf16x8 pa0, pa1, pa2, pa3;
  constexpr int SE = 0, SO = 0;
#define ACT(t) (!BAND || ((pw + 8 - (t)) >= 0 && (pw + 8 - (t)) <= 8 && (kc0) + (t) >= 0))
  SLOAD(SE, 0); asm volatile("s_waitcnt vmcnt(0)" ::: "memory"); SWRITE(0, SE); __syncthreads();
  if (ACT(0)) { qkt<BAND>(pA0, pA1, K_lds, qr, r32, hi, BPTR(0)); partialSM(pA0, pA1, m_reg, mnA, alA); }
  SLOAD(SO, 1);
  SWAIT(); SWRITE(1, SO); __syncthreads();
  for (int j = 1; j + 1 < NT; j += 2) {
    const bool a0_ = ACT(j - 1), a1_ = ACT(j), a2_ = ACT(j + 1);
    SBAR(); if (a1_) qkt<BAND>(pB0, pB1, K_lds + SHM_K, qr, r32, hi, BPTR(j));
    if (a0_) finishSM(pA0, pA1, alA, l_reg, pa0, pa1, pa2, pa3); SBAR();
    SLOAD(SO, j + 1); SBAR();
    if (a0_) pv_d0(o, vb0, pa0, pa1, pa2, pa3); if (a1_) partialSM(pB0, pB1, m_reg, mnB, alB);
    __syncthreads(); SWAIT(); SWRITE(0, SE);
    if (a1_) RESC(alB); __syncthreads();
    SBAR(); if (a2_) qkt<BAND>(pA0, pA1, K_lds, qr, r32, hi, BPTR(j + 1));
    if (a1_) finishSM(pB0, pB1, alB, l_reg, pa0, pa1, pa2, pa3); SBAR();
    SLOAD(SE, j + 2); SBAR();
    if (a1_) pv_d0(o, vb0 + SHM_V, pa0, pa1, pa2, pa3); if (a2_) partialSM(pA0, pA1, m_reg, mnA, alA);
    __syncthreads(); SWAIT(); SWRITE(1, SO);
    if (a2_) RESC(alA); __syncthreads();
  }
  { const bool a0_ = ACT(NT - 2), a1_ = ACT(NT - 1);
    SBAR(); if (a1_) qkt<BAND>(pB0, pB1, K_lds + SHM_K, qr, r32, hi, BPTR(NT - 1));
    if (a0_) finishSM(pA0, pA1, alA, l_reg, pa0, pa1, pa2, pa3); SBAR();
    if (a0_) pv_d0(o, vb0, pa0, pa1, pa2, pa3); if (a1_) partialSM(pB0, pB1, m_reg, mnB, alB);
    __syncthreads(); if (a1_) RESC(alB);
    if (a1_) { finishSM(pB0, pB1, alB, l_reg, pa0, pa1, pa2, pa3); SBAR();
      pv_d0(o, vb0 + SHM_V, pa0, pa1, pa2, pa3); } }
#undef ACT
  if (hi == 0) li_l[r32] = l_reg; asm volatile("s_waitcnt lgkmcnt(0)" ::: "memory");
  float rli[16];
#pragma unroll
  for (int r = 0; r < 16; ++r) rli[r] = __builtin_amdgcn_rcpf(li_l[crow(r, hi)]);
  { LAS bf16_t* stg = (LAS bf16_t*)(lds + OFF_OST + wid * 8192);
#pragma unroll
    for (int r = 0; r < 16; ++r) { const int orow = crow(r, hi);
#pragma unroll
      for (int d0 = 0; d0 < 4; ++d0) stg[orow * 128 + d0 * 32 + r32] = (bf16_t)f2bf(o[d0][r] * rli[r]); }
    asm volatile("s_waitcnt lgkmcnt(0)" ::: "memory");
    bf16_t* Ow = Ob + (long)(wid * QBLK) * LDO;
#pragma unroll
    for (int i = 0; i < 8; ++i) { const int row = i * 4 + (lane >> 4), ch = lane & 15; const u32x4 v = *(const LAS u32x4*)(stg + row * 128 + ch * 8); *(u32x4*)(Ow + (long)row * LDO + ch * 8) = v; } }
  __syncthreads();
#undef TROW
#undef SLOAD
#undef SWRITE
#undef SWAIT
#undef RESC
#undef BPTR
}
#undef KSWZ
#undef SBAR
}


namespace rt {
using f32x16 = __attribute__((ext_vector_type(16))) float;
#define RKSWZ(row, colB) ((row) * 256 + ((colB) ^ (((row) & 7) << 4)))
__device__ __forceinline__ int crow(int r, int hi) { return (r & 3) + 8 * (r >> 2) + 4 * hi; }
__device__ __forceinline__ void ce_desc(unsigned& a, unsigned& b) { const unsigned mx = a > b ? a : b, mn = a > b ? b : a; a = mx; b = mn; }
__device__ __forceinline__ void sort16_desc(unsigned (&v)[16]) {
#pragma unroll
  for (int k = 2; k <= 16; k <<= 1)
#pragma unroll
    for (int j = k >> 1; j > 0; j >>= 1)
#pragma unroll
      for (int i = 0; i < 16; ++i) { const int l = i ^ j; if (l > i) { if ((i & k) == 0) ce_desc(v[i], v[l]); else ce_desc(v[l], v[i]); } }
}
__device__ __forceinline__ void merge16_desc(unsigned (&a)[16], const unsigned (&b)[16]) {
#pragma unroll
  for (int i = 0; i < 16; ++i) a[i] = a[i] > b[15 - i] ? a[i] : b[15 - i];
#pragma unroll
  for (int j = 8; j > 0; j >>= 1)
#pragma unroll
    for (int i = 0; i < 16; ++i) { const int l = i ^ j; if (l > i) ce_desc(a[i], a[l]); }
}
__device__ __forceinline__ unsigned fkey(float f) { const unsigned u = __float_as_uint(f); return (u & 0x80000000u) ? ~u : (u | 0x80000000u); }
__device__ __forceinline__ float fkey_inv(unsigned k) { const unsigned u = (k & 0x80000000u) ? (k & 0x7fffffffu) : ~k; return __uint_as_float(u); }
__device__ __forceinline__ void top16_half(const f32x16 (&sc)[4], int hi, unsigned (&out)[16]) {
  unsigned g[16];
#pragma unroll
  for (int blk = 0; blk < 4; ++blk) {
#pragma unroll
    for (int r = 0; r < 16; ++r) g[r] = (fkey(sc[blk][r]) & 0xFFFFFF80u) | (unsigned)(32 * blk + (r & 3) + 8 * (r >> 2) + 4 * hi);
    sort16_desc(g);
    if (blk == 0) {
#pragma unroll
      for (int r = 0; r < 16; ++r) out[r] = g[r];
    } else merge16_desc(out, g);
  }
  unsigned pb[16];
#pragma unroll
  for (int r = 0; r < 16; ++r) { auto rr = __builtin_amdgcn_permlane32_swap(out[r], out[r], false, false); pb[r] = hi ? rr[0] : rr[1]; }
  merge16_desc(out, pb);
}
__device__ __forceinline__ void route_phase(const Params& p, LAS unsigned char* lds, int wave) {
  const int lane = fresh_lane(), tid = wave * 64 + lane;
  const bf16_t* Q = (const bf16_t*)(p.ws + WS_Q); const bf16_t* KB = (const bf16_t*)(p.ws + WS_KEYSB);
  int* RIDX = (int*)(p.ws + WS_RIDX); float* RG = (float*)(p.ws + WS_RG);
  const int h = blockIdx.x & 7, grp = blockIdx.x >> 3;
  const int r32 = lane & 31, hi = lane >> 5;
#pragma unroll
  for (int c = 0; c < 2; ++c)
#pragma unroll
    for (int rep = 0; rep < 4; ++rep) { const int row = rep * 32 + (tid >> 4), cb = (tid & 15) * 16;
      *(LAS u32x4*)(lds + c * 32768 + RKSWZ(row, cb)) = *(const u32x4*)((const char*)KB + ((size_t)(h * 2 + c) * 128 + row) * 256 + cb); }
  __syncthreads();
  for (int tb = grp * 8 + wave; tb < T / 32; tb += (int)(gridDim.x >> 3) * 8) {
    const int t = tb * 32 + r32;
    unsigned ka[16], kb2[16];
#pragma unroll
    for (int c = 0; c < 2; ++c) {
      bf16x8 qf[8];
      const bf16_t* qp = Q + (size_t)t * D + h * 256 + c * 128 + hi * 8;
#pragma unroll
      for (int ks = 0; ks < 8; ++ks) qf[ks] = *(const bf16x8*)(qp + ks * 16);
      f32x16 sc[4];
#pragma unroll
      for (int blk = 0; blk < 4; ++blk) { sc[blk] = f32x16{};
#pragma unroll
        for (int ks = 0; ks < 8; ++ks) { const bf16x8 kf = *(const LAS bf16x8*)(lds + c * 32768 + RKSWZ(32 * blk + r32, (16 * ks + 8 * hi) * 2));
          sc[blk] = __builtin_amdgcn_mfma_f32_32x32x16_bf16(kf, qf[ks], sc[blk], 0, 0, 0); } }
      if (c == 0) top16_half(sc, hi, ka); else top16_half(sc, hi, kb2);
    }
    float av[16], bv[16];
#pragma unroll
    for (int i = 0; i < 16; ++i) { av[i] = fkey_inv(ka[i] & 0xFFFFFF80u); bv[i] = fkey_inv(kb2[i] & 0xFFFFFF80u); }
    float T[16];
#pragma unroll
    for (int k = 0; k < 16; ++k) T[k] = -3.0e38f;
#pragma unroll
    for (int i = 0; i < 16; ++i)
#pragma unroll
      for (int j = 0; j < 16; ++j) if ((i + 1) * (j + 1) <= 16) { float v = av[i] + bv[j];
#pragma unroll
          for (int k = 0; k < 16; ++k) { const float mx = fmaxf(T[k], v); v = fminf(T[k], v); T[k] = mx; } }
    const float m = T[0], theta = T[15];
    float Z = 0.f;
#pragma unroll
    for (int k = 0; k < 16; ++k) Z += __expf(T[k] - m);
    const float rz = 1.f / Z;
    int slot = 0; int cn = 0;
    int* ip = RIDX + (size_t)t * 128 + h * 16; float* gp = RG + (size_t)t * 128 + h * 16;
#pragma unroll
    for (int i = 0; i < 16; ++i)
#pragma unroll
      for (int j = 0; j < 16; ++j) if ((i + 1) * (j + 1) <= 16) { const float v = av[i] + bv[j];
          const bool sel = (v >= theta) && (slot < 16);
          if (sel && ((cn & 1) == hi)) { ip[slot] = (int)((ka[i] & 127u) * 128u + (kb2[j] & 127u)); gp[slot] = __expf(v - m) * rz; }
          slot += sel ? 1 : 0; ++cn; }
  }
}
#undef RKSWZ
}

#define XB_TMO      128
#define XB_XCNT(j)  (256  + 64 * (j))
#define XB_XSUB(j)  (1280 + 64 * (j))
#define XB_XGEN(j)  (2304 + 64 * (j))
#define XB_TOP      3328
#define XB_TOPGEN   3392
#define XCD_BAR_WORDS 3456
#define XB_SPIN_CAP (1u << 22)
__device__ __forceinline__ unsigned xb_ld(unsigned* p)              { return __hip_atomic_load(p, __ATOMIC_RELAXED, __HIP_MEMORY_SCOPE_AGENT); }
__device__ __forceinline__ unsigned xb_add(unsigned* p, unsigned v) { return __hip_atomic_fetch_add(p, v, __ATOMIC_RELAXED, __HIP_MEMORY_SCOPE_AGENT); }
__device__ __forceinline__ unsigned xb_xcc_id() { return (unsigned)__builtin_amdgcn_s_getreg((3 << 11) | 20) & 0xFu; }
#define XB_SPIN(cond, bar) do { unsigned _sp = 0; while (cond) { __builtin_amdgcn_s_sleep(1); \
    if ((++_sp & 255u) == 0u) { if (xb_ld(&(bar)[XB_TMO])) break; if (_sp > XB_SPIN_CAP) { atomicAdd(&(bar)[XB_TMO], 1u); break; } } } } while (0)
struct XcdBarrier { unsigned* bar; unsigned x; volatile LAS unsigned* st; int w; };
__device__ __forceinline__ XcdBarrier xcd_barrier_post(unsigned* bar, volatile LAS unsigned* st, const int wave) {
    XcdBarrier b; b.bar = bar; b.x = xb_xcc_id(); b.st = st; b.w = wave;
    if (wave == 0 && fresh_lane() == 0) (void)xb_add(&bar[XB_XCNT(b.x)], 1u);
    return b;
}
__device__ __forceinline__ void xcd_barrier_complete(unsigned* bar, unsigned x, unsigned& nloc, unsigned& nx) {
    const unsigned G = gridDim.x * gridDim.y * gridDim.z;
    unsigned sum, cnt, mine, sp = 0u;
    for (;;) {
        sum = 0u; cnt = 0u; mine = 0u;
#pragma unroll
        for (unsigned j = 0; j < 16; ++j) { const unsigned c = xb_ld(&bar[XB_XCNT(j)]); sum += c; cnt += (c > 0u) ? 1u : 0u; mine = (j == x) ? c : mine; }
        if (sum == G) break;
        __builtin_amdgcn_s_sleep(1);
        if ((++sp & 255u) == 0u) { if (xb_ld(&bar[XB_TMO])) break; if (sp > XB_SPIN_CAP) { atomicAdd(&bar[XB_TMO], 1u); break; } }
    }
    nloc = mine > 0u ? mine : 1u; nx = cnt > 0u ? cnt : 1u;
}
__device__ __forceinline__ void xcd_barrier(const XcdBarrier& b) {
    asm volatile("s_waitcnt vmcnt(0)" ::: "memory");
    __syncthreads();
    if (b.w == 0 && fresh_lane() == 0) {
        unsigned* bar = b.bar;
        __builtin_amdgcn_s_waitcnt(0);
        unsigned nloc = b.st[0], nx = b.st[1];
        if (nloc == 0u) { xcd_barrier_complete(bar, b.x, nloc, nx); b.st[0] = nloc; b.st[1] = nx; }
        const unsigned old = xb_add(&bar[XB_XSUB(b.x)], 1u);
        const unsigned gen = old / nloc;
        if (old + 1u == (gen + 1u) * nloc) {
            __builtin_amdgcn_fence(__ATOMIC_RELEASE, "agent");
            asm volatile("s_waitcnt vmcnt(0)" ::: "memory");
            const unsigned og = xb_add(&bar[XB_TOP], 1u);
            const unsigned tg = og / nx;
            if (og + 1u == (tg + 1u) * nx) xb_add(&bar[XB_TOPGEN], 1u);
            else XB_SPIN(xb_ld(&bar[XB_TOPGEN]) == tg, bar);
            __builtin_amdgcn_fence(__ATOMIC_ACQUIRE, "agent");
            xb_add(&bar[XB_XGEN(b.x)], 1u);
            asm volatile("s_waitcnt vmcnt(0)" ::: "memory");
        } else {
            XB_SPIN(xb_ld(&bar[XB_XGEN(b.x)]) == gen, bar);
            __builtin_amdgcn_fence(__ATOMIC_ACQUIRE, "agent");
            asm volatile("s_waitcnt vmcnt(0)" ::: "memory");
        }
    }
    __syncthreads();
}
constexpr int RING_BYTES = 131072, MISC_OFF = 143360, LDS_BYTES = 147456, NTHREADS = 512;
static_assert(att::LDS_NEED <= MISC_OFF, "attention scratch below the MISC words");
constexpr size_t WS_SLAB = WS_X2BF;

__device__ __forceinline__ void touch_buffer(const void* base, size_t bytes, int cb, int Gd, int tid) {
    const u32x4* b = (const u32x4*)base; const size_t n = bytes / 16, stride = (size_t)Gd * NTHREADS;
    u32x4 acc = {0u, 0u, 0u, 0u};
    for (size_t i = (size_t)cb * NTHREADS + tid; i < n; i += stride) { const u32x4 v = b[i]; acc.x ^= v.x; acc.y ^= v.y; acc.z ^= v.z; acc.w ^= v.w; }
    asm volatile("" :: "v"(acc.x), "v"(acc.y), "v"(acc.z), "v"(acc.w));
}
#define PH_BEGIN(i) unsigned long long t0_##i = 0; if ((PROBE_MASK >> (i)) & 1) t0_##i = __builtin_amdgcn_s_memrealtime();
#define PH_END(i) if ((PROBE_MASK >> (i)) & 1) probe_acc += __builtin_amdgcn_s_memrealtime() - t0_##i;
__global__ void __launch_bounds__(NTHREADS, 2) fwd(Params p) {
    extern __shared__ __attribute__((aligned(16))) unsigned char lds_raw[];
    LAS unsigned char* lds = (LAS unsigned char*)lds_raw;
    volatile LAS unsigned* MISC = (volatile LAS unsigned*)(lds + MISC_OFF);
    const int wave = __builtin_amdgcn_readfirstlane((int)threadIdx.x >> 6);
    const int nwb = NTHREADS / 64;
    const int gw = blockIdx.x * nwb + wave, NW = gridDim.x * nwb;
    const int Gd = gridDim.x, cb = blockIdx.x;
    unsigned char* ws = p.ws;
    bf16_t* WT_IN = (bf16_t*)(ws + WS_WT_IN); bf16_t* WT_GATE = (bf16_t*)(ws + WS_WT_GATE); bf16_t* WT_BR = (bf16_t*)(ws + WS_WT_BR);
    bf16_t* WT_O = (bf16_t*)(ws + WS_WT_O); bf16_t* WT_PQ = (bf16_t*)(ws + WS_WT_PQ); bf16_t* WT_MKV = (bf16_t*)(ws + WS_WT_MKV);
    bf16_t* KEYSB = (bf16_t*)(ws + WS_KEYSB); bf16_t* MEMN = (bf16_t*)(ws + WS_MEMN); bf16_t* MEMKV = (bf16_t*)(ws + WS_MEMKV);
    bf16_t* HO = (bf16_t*)(ws + WS_HO); bf16_t* PROJ = (bf16_t*)(ws + WS_PROJ); bf16_t* G = (bf16_t*)(ws + WS_G);
    bf16_t* MERGED = (bf16_t*)(ws + WS_MERGED); bf16_t* X2BF = (bf16_t*)(ws + WS_X2BF); bf16_t* QB = (bf16_t*)(ws + WS_Q);
        float* SS2 = (float*)(ws + WS_CTL + CTL_SS2_BYTE);
    if ((wave * 64 + fresh_lane()) < 64) MISC[(wave * 64 + fresh_lane())] = 0u;
    __syncthreads();
    XcdBarrier bar = xcd_barrier_post((unsigned*)(ws + WS_CTL + CTL_BAR_BYTE), MISC + 8, wave);
    if ((wave * 64 + fresh_lane()) == 0) MISC[16] = xb_add((unsigned*)(ws + WS_CTL + CTL_RANK_BYTE) + 64 * bar.x, 1u);

    unsigned long long probe_acc = 0;
    PH_BEGIN(0)
    {
        LAS float* scr = (LAS float*)lds + wave * (64 * 33);
        const int I0 = (D / 64) * (INW / 32), I1 = I0 + (D / 64) * (GW / 32), I2 = I1 + (D / 64) * (D / 32), I3 = I2 + (D / 64) * (D / 32), I4 = I3 + (D / 64) * (D / 32), I5 = I4 + (D / 64) * (2 * CW / 32);
#define TRJOB(it, jb, li) do { if ((it) < I0) { jb = TrJob{p.in[3], WT_IN, nullptr, D, INW, 0.f}; li = (it); } else if ((it) < I1) { jb = TrJob{p.in[18], WT_GATE, nullptr, D, GW, GATE_WSCALE}; li = (it) - I0; } \
            else if ((it) < I2) { jb = TrJob{p.in[20], WT_BR, nullptr, D, D, 0.f}; li = (it) - I1; } else if ((it) < I3) { jb = TrJob{p.in[21], WT_O, nullptr, D, D, 0.f}; li = (it) - I2; } \
            else if ((it) < I4) { jb = TrJob{p.in[23], WT_PQ, p.in[22], D, D, 0.f}; li = (it) - I3; } else { jb = TrJob{p.in[15], WT_MKV, nullptr, D, 2 * CW, 0.f}; li = (it) - I4; } } while (0)
        for (int it = gw; it < I5; it += 2 * NW) {
            TrJob ja, jb2; int la, lb; f32x4 va[8], vb[8];
            TRJOB(it, ja, la); tr_load(ja, la, fresh_lane(), va);
            const bool has2 = it + NW < I5;
            if (has2) { TRJOB(it + NW, jb2, lb); tr_load(jb2, lb, fresh_lane(), vb); }
            tr_store(ja, la, fresh_lane(), va, scr);
            if (has2) tr_store(jb2, lb, fresh_lane(), vb, scr);
        }
#undef TRJOB
        rms_rows(p.in[0], p.in[2], HO, ws + WS_H8, T, gw, NW, fresh_lane());
        rms_rows(p.in[1], p.in[14], MEMN, nullptr, BATCH * NMEM, gw, NW, fresh_lane());
        const float* keys = p.in[24];
        for (int i = gw * 64 + fresh_lane(); i < PH * 2 * NKEYS * 128 / 2; i += NW * 64) ((unsigned*)KEYSB)[i] = pk2(keys[2 * i], keys[2 * i + 1]);
    }
    xcd_barrier(bar);
    PH_END(0)
    PH_BEGIN(1)
    {
        SchedP1a Sa{(const char*)HO, (const char*)WT_IN, (const char*)MEMN, (const char*)WT_MKV, Gd, cb};
        EpiP1a Ea{PROJ, MEMKV, p.in[4], p.in[5], p.in[16], p.in[17], (LAS float*)(lds + RING_BYTES)};
        pg8::gemm_phase<false>(lds, D, D, Sa, Ea, wave);
        SchedP1b Sb{(const char*)(ws + WS_H8), (const char*)WT_GATE, Gd, cb};
        EpiP1b Eb{G, p.in[19]};
        pg8::gemm_phase<true>(lds, D / 2, D / 2, Sb, Eb, wave);
    }
    xcd_barrier(bar);
    PH_END(1)
    PH_BEGIN(2)
    {
        const float qscale = 0.08838834764831845f;
        for (int u = gw; u < BATCH * NCH * 8; u += NW) { const int g = u % 8, c = (u / 8) % NCH, b = u / (8 * NCH); lru_pass1(p, b, c, g, fresh_lane(), lds + wave * 8192, u, NW); }
        if (NW != BATCH * NCH * 8) fp4_tables(p, gw, NW, fresh_lane());
    }
    xcd_barrier(bar);
    PH_END(2)
    PH_BEGIN(3)
    {
        const int nA = BATCH * 8 * (NCH / 4), nC = BATCH * 4 * (SEQ / 256);
        PH_BEGIN(9)
        for (int u = cb; u < nA + nC; u += Gd) {
            if (u < nA) {
                const int cg = u % (NCH / 4), h = (u / (NCH / 4)) % 8, b = u / ((NCH / 4) * 8);
                const size_t brow = (size_t)b * SEQ, qrow = brow + (size_t)cg * 256;
                att::attn_body<INW, INW, D, true>(PROJ + qrow * INW + C_QA + h * 128, PROJ + brow * INW + C_KA + h * 128, PROJ + brow * INW + C_VA + h * 128,
                                                  HO + qrow * D + h * 128, 12, cg * 4 - NPREV, p.in[6] + h * 257, (LAS char*)lds, wave);
            } else {
                const int v = u - nA; const int qb = v % (SEQ / 256), h = (v / (SEQ / 256)) % 4, b = v / ((SEQ / 256) * 4);
                const size_t qrow = (size_t)b * SEQ + (size_t)qb * 256;
                att::attn_body<INW, 2 * CW, D, false>(PROJ + qrow * INW + C_QC + h * 128, MEMKV + (size_t)b * NMEM * (2 * CW) + h * 128, MEMKV + (size_t)b * NMEM * (2 * CW) + CW + h * 128,
                                                     HO + qrow * D + AW + LW + h * 128, NMEM / 64, 0, nullptr, (LAS char*)lds, wave);
            }
        }
        PH_END(9)
        PH_BEGIN(10)
        for (int u = gw; u < BATCH * NCH * 8; u += NW) { const int g = u % 8, c = (u / 8) % NCH, b = u / (8 * NCH); lru_pass2(p, b, c, g, fresh_lane()); }
        touch_buffer(WT_BR, (size_t)D * D * 2, cb, Gd, (wave * 64 + fresh_lane())); touch_buffer(WT_O, (size_t)D * D * 2, cb, Gd, (wave * 64 + fresh_lane()));
        PH_END(10)
    }
    xcd_barrier(bar);
    PH_END(3)
    PH_BEGIN(4)
    {
        SchedP3 S{(const char*)HO, (const char*)WT_BR, Gd, cb};
        EpiP3 E{G, MERGED};
        pg8::gemm_phase<false>(lds, D, D, S, E, wave);
    }
    xcd_barrier(bar);
    PH_END(4)
    PH_BEGIN(5)
    {
        SchedSq S{(const char*)MERGED, (const char*)WT_O, Gd, cb};
        EpiP4 E{p.in[0], p.out, X2BF, SS2, ws + WS_X2F8};
        pg8::gemm_phase<false>(lds, D, D, S, E, wave);
        touch_buffer(WT_PQ, (size_t)D * D * 2, cb, Gd, (wave * 64 + fresh_lane()));
    }
    xcd_barrier(bar);
    PH_END(5)
    PH_BEGIN(6)
    {
        SchedSq S{(const char*)X2BF, (const char*)WT_PQ, Gd, cb};
        EpiP5 E{QB, SS2};
        pg8::gemm_phase<false>(lds, D, D, S, E, wave);
    }
    xcd_barrier(bar);
    PH_END(6)
    PH_BEGIN(7)
    rt::route_phase(p, lds, wave);
    xcd_barrier(bar);
    PH_END(7)
    PH_BEGIN(8)
    int ppos, pnx, prank, pnloc;
    { if ((wave * 64 + fresh_lane()) == 0) { unsigned pos = 0, nx = 0; const unsigned* bw = (const unsigned*)(ws + WS_CTL + CTL_BAR_BYTE);
#pragma unroll
          for (unsigned j = 0; j < 16; ++j) { const unsigned cj = xb_ld((unsigned*)&bw[XB_XCNT(j)]); nx += cj > 0u ? 1u : 0u; pos += (cj > 0u && j < bar.x) ? 1u : 0u; }
          MISC[17] = pos; MISC[18] = nx > 0u ? nx : 1u; }
      __syncthreads();
      ppos = (int)MISC[17]; pnx = (int)MISC[18]; prank = (int)MISC[16]; pnloc = (int)MISC[8]; if (pnloc < 1) pnloc = 1; }
    peer_u_step(p, fresh_lane(), wave, lds + wave * 16384, ppos, pnx, prank, pnloc);
    xcd_barrier(bar);
    for (int t = gw; t < T; t += NW) peer_combine(p, t, fresh_lane());
    xcd_barrier(bar);
    peer_v_step(p, fresh_lane(), wave, lds + wave * 16384, ppos, pnx, prank, pnloc);
    if (PROBE_MASK) { __syncthreads(); PH_END(8) const unsigned long long te = __builtin_amdgcn_s_memrealtime(); while (__builtin_amdgcn_s_memrealtime() - te < probe_acc) __builtin_amdgcn_s_sleep(8); }
}

extern "C" void kernel_launch(void* const* d_in, const int* in_sizes, int n_in, void* d_out, int out_size, void* d_ws, size_t ws_size, hipStream_t stream) {
    static int grid = 0;
    if (grid == 0) {
        if (n_in != 27 || out_size != T * D || ws_size < WS_END) { fprintf(stderr, "kernel_launch: unexpected problem (n_in %d out %d ws %zu)\n", n_in, out_size, ws_size); grid = -1; return; }
        int dev = 0, cus = 0, per_cu = 0;
        (void)hipGetDevice(&dev); (void)hipDeviceGetAttribute(&cus, hipDeviceAttributeMultiprocessorCount, dev);
        if (hipFuncSetAttribute((const void*)fwd, hipFuncAttributeMaxDynamicSharedMemorySize, LDS_BYTES) != hipSuccess) { fprintf(stderr, "kernel_launch: hipFuncSetAttribute failed\n"); grid = -1; return; }
        (void)hipOccupancyMaxActiveBlocksPerMultiprocessor(&per_cu, (const void*)fwd, NTHREADS, LDS_BYTES);
        if (per_cu < 1) { fprintf(stderr, "kernel_launch: occupancy query says %d\n", per_cu); grid = -1; return; }
        grid = cus;
    }
    if (grid < 0) return;
    (void)hipMemsetAsync((char*)d_ws + WS_CTL, 0, 1 * MiB, stream);
    Params p{};
    for (int i = 0; i < 27; ++i) p.in[i] = (const float*)d_in[i];
    p.out = (float*)d_out; p.ws = (unsigned char*)d_ws;
    void* args[] = {&p};
    hipError_t e = hipLaunchCooperativeKernel((const void*)fwd, dim3(grid), dim3(NTHREADS), args, LDS_BYTES, stream);
    if (e != hipSuccess) fprintf(stderr, "cooperative launch failed: %s (grid %d)\n", hipGetErrorString(e), grid);
}
```

```cpp
#include <hip/hip_runtime.h>
#include <hip/hip_cooperative_groups.h>
#include <cstdio>
#include <cstdint>
namespace cg = cooperative_groups;
#ifndef PROBE_MASK
#define PROBE_MASK 0
#endif

#define LAS __attribute__((address_space(3)))
typedef unsigned short bf16_t;
typedef short bf16x8 __attribute__((ext_vector_type(8)));
typedef float f32x4 __attribute__((ext_vector_type(4)));
typedef unsigned u32x4 __attribute__((ext_vector_type(4)));
typedef unsigned u32x2 __attribute__((ext_vector_type(2)));

constexpr int D = 2048, BATCH = 2, SEQ = 8192, T = BATCH * SEQ;
constexpr int CHUNK = 64, NPREV = 8, NCH = SEQ / CHUNK;
constexpr int AW = 1024, LW = 512, CW = 512, INW = 4608, GW = 6144;
constexpr int NMEM = 256;
constexpr int PH = 8, NKEYS = 128, TOPK = 16;
constexpr float EPS = 1e-6f;
constexpr int C_QA = 0, C_KA = 1024, C_VA = 2048, C_XL = 3072, C_GL = 3584, C_QC = 4096;

constexpr size_t MiB = 1u << 20;
constexpr size_t WS_CTL = 0;
constexpr size_t WS_WT_IN = 2 * MiB, WS_WT_GATE = 20 * MiB, WS_WT_BR = 44 * MiB, WS_WT_O = 52 * MiB, WS_WT_PQ = 60 * MiB, WS_WT_MKV = 68 * MiB;
constexpr size_t WS_KEYSB = 72 * MiB, WS_MEMN = 73 * MiB, WS_MEMKV = 75 * MiB, WS_LRUSUM = 76 * MiB, WS_RS2 = 77 * MiB;
constexpr size_t WS_HO = 80 * MiB;
constexpr size_t WS_PROJ = 144 * MiB;
constexpr size_t WS_MERGED = 144 * MiB, WS_X2BF = 208 * MiB;
constexpr size_t WS_G = 288 * MiB;
constexpr size_t WS_TABU = 496 * MiB, WS_TABV = 512 * MiB, WS_Q = 416 * MiB;
constexpr size_t WS_SCU = 77 * MiB, WS_SCV = 77 * MiB + 65536;
constexpr size_t WS_AUA = 2 * MiB, WS_AUU = 416 * MiB;
constexpr size_t WS_H8 = 384 * MiB;
constexpr float GATE_WSCALE = 256.f;
constexpr size_t WS_RIDX = 480 * MiB, WS_RG = 488 * MiB, WS_END = 528 * MiB;

constexpr size_t CTL_BAR_BYTE = 16384, CTL_RANK_BYTE = 65536, CTL_SS2_BYTE = 512 * 1024;
struct Params { const float* in[27]; float* out; unsigned char* ws; };

__device__ __forceinline__ int fresh_lane() { int l; asm volatile("v_mbcnt_lo_u32_b32 %0, -1, 0\n\tv_mbcnt_hi_u32_b32 %0, -1, %0" : "=v"(l)); return l; }
__device__ __forceinline__ float bf2f(unsigned v16) { return __uint_as_float(v16 << 16); }
typedef float f32x2c __attribute__((ext_vector_type(2))); typedef __bf16 bf16x2c __attribute__((ext_vector_type(2)));
__device__ __forceinline__ unsigned pk2(float lo, float hi) { const f32x2c v = {lo, hi}; return __builtin_bit_cast(unsigned, __builtin_convertvector(v, bf16x2c)); }
__device__ __forceinline__ unsigned f2bf(float f) { return pk2(f, 0.f) & 0xffffu; }
__device__ __forceinline__ float wave_sum(float v) {
#pragma unroll
    for (int o = 1; o < 64; o <<= 1) v += __shfl_xor(v, o);
    return v;
}
typedef __bf16 bf16x2_t __attribute__((ext_vector_type(2)));
__device__ __forceinline__ float dot2bf(unsigned w, unsigned x, float acc) { return __builtin_amdgcn_fdot2_f32_bf16(__builtin_bit_cast(bf16x2_t, w), __builtin_bit_cast(bf16x2_t, x), acc, false); }
__device__ __forceinline__ float sigmoid_(float x) { return 1.f / (1.f + __expf(-x)); }
__device__ __forceinline__ float gelu_tanh(float x) { const float y = 1.5957691216f * (x + 0.044715f * x * x * x); return x / (1.f + __expf(-y)); }
__device__ __forceinline__ void unpack8(const u32x4 w, float* f) {
    f[0] = __uint_as_float(w.x << 16); f[1] = __uint_as_float(w.x & 0xffff0000u);
    f[2] = __uint_as_float(w.y << 16); f[3] = __uint_as_float(w.y & 0xffff0000u);
    f[4] = __uint_as_float(w.z << 16); f[5] = __uint_as_float(w.z & 0xffff0000u);
    f[6] = __uint_as_float(w.w << 16); f[7] = __uint_as_float(w.w & 0xffff0000u);
}

struct TrJob { const float* W; bf16_t* WT; const float* ks; int K, N; float f8scale; };
__device__ __forceinline__ void tr_load(const TrJob& jb, int item, int lane, f32x4 (&v)[8]) {
    const int nblk = jb.N / 32, kb = item / nblk, nb = item % nblk, k0 = 64 * kb, n0 = 32 * nb;
#pragma unroll
    for (int i = 0; i < 8; ++i) { const int kk = 8 * i + (lane >> 3); v[i] = *(const f32x4*)(jb.W + (size_t)(k0 + kk) * jb.N + n0 + 4 * (lane & 7)); if (jb.ks) v[i] = v[i] * jb.ks[k0 + kk]; }
}
__device__ __forceinline__ void tr_store(const TrJob& jb, int item, int lane, const f32x4 (&v)[8], LAS float* scr) {
    const int nblk = jb.N / 32, kb = item / nblk, nb = item % nblk, k0 = 64 * kb, n0 = 32 * nb;
#pragma unroll
    for (int i = 0; i < 8; ++i) { LAS float* d = scr + (8 * i + (lane >> 3)) * 33 + 4 * (lane & 7); d[0] = v[i].x; d[1] = v[i].y; d[2] = v[i].z; d[3] = v[i].w; }
    asm volatile("s_waitcnt lgkmcnt(0)" ::: "memory");
    const int c = lane & 7;
#pragma unroll
    for (int j = 0; j < 4; ++j) { const int n = (lane >> 3) + 8 * j; const LAS float* s = scr + (8 * c) * 33 + n;
        if (jb.f8scale != 0.f) { const float f = jb.f8scale; u32x2 o;
#define F8C(x_) fminf(fmaxf((x_) * f, -448.f), 448.f)
            int w = __builtin_amdgcn_cvt_pk_fp8_f32(F8C(s[0 * 33]), F8C(s[1 * 33]), 0, false); w = __builtin_amdgcn_cvt_pk_fp8_f32(F8C(s[2 * 33]), F8C(s[3 * 33]), w, true); o.x = (unsigned)w;
            w = __builtin_amdgcn_cvt_pk_fp8_f32(F8C(s[4 * 33]), F8C(s[5 * 33]), 0, false); w = __builtin_amdgcn_cvt_pk_fp8_f32(F8C(s[6 * 33]), F8C(s[7 * 33]), w, true); o.y = (unsigned)w;
#undef F8C
            *(u32x2*)((unsigned char*)jb.WT + (size_t)(n0 + n) * jb.K + k0 + 8 * c) = o; }
        else { u32x4 o; o.x = pk2(s[0 * 33], s[1 * 33]); o.y = pk2(s[2 * 33], s[3 * 33]); o.z = pk2(s[4 * 33], s[5 * 33]); o.w = pk2(s[6 * 33], s[7 * 33]);
            *(u32x4*)(jb.WT + (size_t)(n0 + n) * jb.K + k0 + 8 * c) = o; } }
    asm volatile("s_waitcnt lgkmcnt(0)" ::: "memory");
}
__device__ __forceinline__ void rms_row_load(const float* xrow, int lane, f32x4 (&v)[8]) {
    const f32x4* xr = (const f32x4*)xrow + lane;
#pragma unroll
    for (int j = 0; j < 8; ++j) v[j] = xr[64 * j];
}
__device__ __forceinline__ void rms_row_finish(const f32x4 (&v)[8], const float* g, bf16_t* orow, unsigned char* o8row, int lane) {
    const f32x4* gr = (const f32x4*)g + lane; float s = 0.f;
#pragma unroll
    for (int j = 0; j < 8; ++j) s += (v[j].x * v[j].x + v[j].y * v[j].y) + (v[j].z * v[j].z + v[j].w * v[j].w);
    const float rstd = rsqrtf(wave_sum(s) * (1.f / D) + EPS);
    u32x2* o8 = (u32x2*)orow + lane;
#pragma unroll
    for (int j = 0; j < 8; ++j) { const f32x4 gg = gr[64 * j]; const float a0 = v[j].x * rstd * gg.x, a1 = v[j].y * rstd * gg.y, a2 = v[j].z * rstd * gg.z, a3 = v[j].w * rstd * gg.w;
        u32x2 o; o.x = pk2(a0, a1); o.y = pk2(a2, a3); o8[64 * j] = o;
        if (o8row) { int w = __builtin_amdgcn_cvt_pk_fp8_f32(fminf(fmaxf(a0, -448.f), 448.f), fminf(fmaxf(a1, -448.f), 448.f), 0, false);
            w = __builtin_amdgcn_cvt_pk_fp8_f32(fminf(fmaxf(a2, -448.f), 448.f), fminf(fmaxf(a3, -448.f), 448.f), w, true); ((unsigned*)o8row)[64 * j + lane] = (unsigned)w; } }
}
__device__ __forceinline__ void rms_rows(const float* X, const float* g, bf16_t* O, unsigned char* O8, int nrows, int gw, int NW, int lane) {
    f32x4 va[8], vb[8];
    int m = gw;
    if (m < nrows) rms_row_load(X + (size_t)m * D, lane, va);
    for (; m < nrows; m += 2 * NW) {
        const bool hb = m + NW < nrows;
        if (hb) rms_row_load(X + (size_t)(m + NW) * D, lane, vb);
        rms_row_finish(va, g, O + (size_t)m * D, O8 ? O8 + (size_t)m * D : nullptr, lane);
        if (m + 2 * NW < nrows) rms_row_load(X + (size_t)(m + 2 * NW) * D, lane, va);
        if (hb) rms_row_finish(vb, g, O + (size_t)(m + NW) * D, O8 ? O8 + (size_t)(m + NW) * D : nullptr, lane);
    }
}

template <int TM, int TN, class Epi>
__device__ __forceinline__ void gemm_simple(const bf16_t* __restrict__ A, int lda, const bf16_t* __restrict__ Bt, int ldb, int M, int N, int K, const Epi& epi, int gw, int NW, int lane) {
    const int r = lane & 15, q = lane >> 4;
    const int ntm = M / (16 * TM), ntn = N / (16 * TN);
    for (int tile = gw; tile < ntm * ntn; tile += NW) {
        const int tm = tile / ntn, tn = tile % ntn;
        f32x4 acc[TM][TN];
#pragma unroll
        for (int i = 0; i < TM; ++i)
#pragma unroll
            for (int j = 0; j < TN; ++j) acc[i][j] = (f32x4){0.f, 0.f, 0.f, 0.f};
        const bf16_t* ap = A + (size_t)(tm * 16 * TM + r) * lda + q * 8;
        const bf16_t* bp = Bt + (size_t)(tn * 16 * TN + r) * ldb + q * 8;
        for (int k0 = 0; k0 < K; k0 += 32) {
            bf16x8 af[TM], bfr[TN];
#pragma unroll
            for (int i = 0; i < TM; ++i) af[i] = *(const bf16x8*)(ap + (size_t)i * 16 * lda + k0);
#pragma unroll
            for (int j = 0; j < TN; ++j) bfr[j] = *(const bf16x8*)(bp + (size_t)j * 16 * ldb + k0);
#pragma unroll
            for (int i = 0; i < TM; ++i)
#pragma unroll
                for (int j = 0; j < TN; ++j) acc[i][j] = __builtin_amdgcn_mfma_f32_16x16x32_bf16(af[i], bfr[j], acc[i][j], 0, 0, 0);
        }
#pragma unroll
        for (int i = 0; i < TM; ++i)
#pragma unroll
            for (int j = 0; j < TN; ++j)
#pragma unroll
                for (int e = 0; e < 4; ++e) epi(tm * 16 * TM + i * 16 + q * 4 + e, tn * 16 * TN + j * 16 + r, acc[i][j][e]);
    }
}
struct EpiProj { bf16_t* P; __device__ __forceinline__ void operator()(int row, int col, float v) const { if (col >= C_GL && col < C_QC) v = gelu_tanh(v); P[(size_t)row * INW + col] = (bf16_t)f2bf(v); } };
struct EpiGate { bf16_t* G; const float* b; __device__ __forceinline__ void operator()(int row, int col, float v) const { G[(size_t)row * GW + col] = (bf16_t)f2bf(sigmoid_(v + b[col])); } };
struct EpiStore { bf16_t* C; int ldc; __device__ __forceinline__ void operator()(int row, int col, float v) const { C[(size_t)row * ldc + col] = (bf16_t)f2bf(v); } };
struct EpiWo { const float* x; float* out; bf16_t* xb; __device__ __forceinline__ void operator()(int row, int col, float v) const { const size_t o = (size_t)row * D + col; const float y = x[o] + v; out[o] = y; xb[o] = (bf16_t)f2bf(y); } };
struct EpiQ { bf16_t* Q; const float* rs; __device__ __forceinline__ void operator()(int row, int col, float v) const { Q[(size_t)row * D + col] = (bf16_t)f2bf(v * rs[row]); } };

__device__ __forceinline__ void headnorm(bf16_t* vec, const float* g, float scale, int lane) {
    unsigned* p = (unsigned*)vec + lane; const unsigned w = *p;
    const float a = bf2f(w & 0xffffu), b = bf2f(w >> 16);
    const float rs = rsqrtf(wave_sum(a * a + b * b) * (1.f / 128.f) + EPS) * scale;
    *p = pk2(a * rs * g[2 * lane], b * rs * g[2 * lane + 1]);
}
struct HeadGains { float gq[32], gk[32], gc[8]; };
__device__ __forceinline__ void load_head_gains(HeadGains& hg, const float* gq, const float* gk, const float* gc, int lane) {
#pragma unroll
    for (int j = 0; j < 32; ++j) { hg.gq[j] = gq[(lane & 3) * 32 + j]; hg.gk[j] = gk[(lane & 3) * 32 + j]; }
#pragma unroll
    for (int j = 0; j < 8; ++j) hg.gc[j] = gc[(lane & 15) * 8 + j];
}
__device__ __forceinline__ void headnorm_token(bf16_t* row, const HeadGains& hg, float qscale, int lane) {
    u32x4* pa = (u32x4*)(row + C_QA) + lane * 4;
    u32x4* pc = (u32x4*)(row + C_QC) + lane;
    u32x4 w[4]; const u32x4 wc = *pc;
#pragma unroll
    for (int j = 0; j < 4; ++j) w[j] = pa[j];
    float f[32], fc[8]; float ss = 0.f, sc = 0.f;
#pragma unroll
    for (int j = 0; j < 4; ++j) unpack8(w[j], f + 8 * j);
    unpack8(wc, fc);
#pragma unroll
    for (int j = 0; j < 32; ++j) ss = fmaf(f[j], f[j], ss);
#pragma unroll
    for (int j = 0; j < 8; ++j) sc = fmaf(fc[j], fc[j], sc);
    ss += __shfl_xor(ss, 1); ss += __shfl_xor(ss, 2);
    sc += __shfl_xor(sc, 1); sc += __shfl_xor(sc, 2); sc += __shfl_xor(sc, 4); sc += __shfl_xor(sc, 8);
    const bool isq = lane < 32;
    const float rs = rsqrtf(ss * (1.f / 128.f) + EPS) * (isq ? qscale : 1.f), rc = rsqrtf(sc * (1.f / 128.f) + EPS) * qscale;
#pragma unroll
    for (int j = 0; j < 4; ++j) { u32x4 o;
        o.x = pk2(f[8 * j] * rs * (isq ? hg.gq[8 * j] : hg.gk[8 * j]), f[8 * j + 1] * rs * (isq ? hg.gq[8 * j + 1] : hg.gk[8 * j + 1]));
        o.y = pk2(f[8 * j + 2] * rs * (isq ? hg.gq[8 * j + 2] : hg.gk[8 * j + 2]), f[8 * j + 3] * rs * (isq ? hg.gq[8 * j + 3] : hg.gk[8 * j + 3]));
        o.z = pk2(f[8 * j + 4] * rs * (isq ? hg.gq[8 * j + 4] : hg.gk[8 * j + 4]), f[8 * j + 5] * rs * (isq ? hg.gq[8 * j + 5] : hg.gk[8 * j + 5]));
        o.w = pk2(f[8 * j + 6] * rs * (isq ? hg.gq[8 * j + 6] : hg.gk[8 * j + 6]), f[8 * j + 7] * rs * (isq ? hg.gq[8 * j + 7] : hg.gk[8 * j + 7]));
        pa[j] = o; }
    { u32x4 o; o.x = pk2(fc[0] * rc * hg.gc[0], fc[1] * rc * hg.gc[1]); o.y = pk2(fc[2] * rc * hg.gc[2], fc[3] * rc * hg.gc[3]);
      o.z = pk2(fc[4] * rc * hg.gc[4], fc[5] * rc * hg.gc[5]); o.w = pk2(fc[6] * rc * hg.gc[6], fc[7] * rc * hg.gc[7]); *pc = o; }
}

__device__ __forceinline__ void fp4_row_load(const float* __restrict__ src, const float* __restrict__ kscale, int lane, f32x4 (&v)[8]);
__device__ __forceinline__ void fp4_row_finish(const f32x4 (&v)[8], unsigned char* __restrict__ tab, int e, float* __restrict__ scale_out, int lane);
__device__ __forceinline__ void lru_pass1(const Params& p, int b, int c, int g, int lane, LAS unsigned char* wl  , const int tr0, const int trs) {
    const bf16_t* PROJ = (const bf16_t*)(p.ws + WS_PROJ);
    float* SUMA = (float*)(p.ws + WS_LRUSUM); float* SUMB = SUMA + BATCH * NCH * LW;
    bf16_t* AUA = (bf16_t*)(p.ws + WS_AUA); bf16_t* AUU = (bf16_t*)(p.ws + WS_AUU);
    const float* conv_w = p.in[7]; const float* conv_b = p.in[8]; const float* lru_wa = p.in[9]; const float* lru_ba = p.in[10];
    const float* lru_wx = p.in[11]; const float* lru_bx = p.in[12]; const float* lam = p.in[13];
    const int ch = g * 64 + lane;
    unsigned wa_p[32], wx_p[32];
#pragma unroll
    for (int m = 0; m < 32; ++m) { wa_p[m] = pk2(lru_wa[(size_t)(g * 64 + 2 * m) * 64 + lane], lru_wa[(size_t)(g * 64 + 2 * m + 1) * 64 + lane]);
        wx_p[m] = pk2(lru_wx[(size_t)(g * 64 + 2 * m) * 64 + lane], lru_wx[(size_t)(g * 64 + 2 * m + 1) * 64 + lane]); }
    const float cw0 = conv_w[0 * LW + ch], cw1 = conv_w[1 * LW + ch], cw2 = conv_w[2 * LW + ch], cw3 = conv_w[3 * LW + ch], cb = conv_b[ch];
    const float ba_ = lru_ba[ch], bx_ = lru_bx[ch];
    const float sp = log1pf(__expf(-lam[ch]));
    const int t0 = c * CHUNK; const size_t row0 = (size_t)b * SEQ + t0;
    float x0 = 0.f, x1 = 0.f, x2 = 0.f;
    if (t0 >= 3) { x0 = bf2f(PROJ[(row0 - 3) * INW + C_XL + ch]); x1 = bf2f(PROJ[(row0 - 2) * INW + C_XL + ch]); x2 = bf2f(PROJ[(row0 - 1) * INW + C_XL + ch]); }
    { const bf16_t* xs = PROJ + (row0 + (lane >> 3)) * INW + C_XL + g * 64 + (lane & 7) * 8;
      u32x4 tx[8];
#pragma unroll
      for (int i = 0; i < 8; ++i) tx[i] = *(const u32x4*)(xs + (size_t)(8 * i) * INW);
#pragma unroll
      for (int i = 0; i < 8; ++i) *(LAS u32x4*)(wl + (8 * i + (lane >> 3)) * 128 + (lane & 7) * 16) = tx[i]; }
    float h = 0.f, aprod = 1.f;
#define LRU_PAIRX(xc_) ({ const float xnb_ = __int_as_float(__builtin_amdgcn_update_dpp(0, __float_as_int(xc_), 0xB1, 0xf, 0xf, true));     \
        (lane & 1) ? pk2(xnb_, xc_) : pk2(xc_, xnb_); })
#define LRU_GATE(rp_, ip_, xc_, a_, u_) do { const float r_ = sigmoid_(rp_), ig_ = sigmoid_(ip_); const float la_ = -8.f * r_ * sp; a_ = __expf(la_); \
        u_ = sqrtf(fminf(fmaxf((1.f - a_) * (1.f + a_), 1e-12f), 1.f)) * ig_ * xc_; } while (0)
#define LRU_TOKPAIR(tp_) do { const int t_ = (tp_);                           \
        const float x3 = bf2f(*(const LAS bf16_t*)(wl + t_ * 128 + lane * 2)), x4 = bf2f(*(const LAS bf16_t*)(wl + (t_ + 1) * 128 + lane * 2)); \
        const float xcA = cw0 * x0 + cw1 * x1 + cw2 * x2 + cw3 * x3 + cb, xcB = cw0 * x1 + cw1 * x2 + cw2 * x3 + cw3 * x4 + cb; \
        x0 = x2; x1 = x3; x2 = x4; \
        const unsigned pkA = LRU_PAIRX(xcA), pkB = LRU_PAIRX(xcB); \
        float rA = ba_, iA = bx_, rA2 = 0.f, iA2 = 0.f, rB = ba_, iB = bx_, rB2 = 0.f, iB2 = 0.f; \
_Pragma("unroll") \
        for (int m = 0; m < 32; m += 2) { \
            const unsigned a0 = (unsigned)__builtin_amdgcn_readlane((int)pkA, 2 * m), a1 = (unsigned)__builtin_amdgcn_readlane((int)pkA, 2 * m + 2); \
            const unsigned b0 = (unsigned)__builtin_amdgcn_readlane((int)pkB, 2 * m), b1 = (unsigned)__builtin_amdgcn_readlane((int)pkB, 2 * m + 2); \
            rA = dot2bf(wa_p[m], a0, rA); iA = dot2bf(wx_p[m], a0, iA); rA2 = dot2bf(wa_p[m + 1], a1, rA2); iA2 = dot2bf(wx_p[m + 1], a1, iA2); \
            rB = dot2bf(wa_p[m], b0, rB); iB = dot2bf(wx_p[m], b0, iB); rB2 = dot2bf(wa_p[m + 1], b1, rB2); iB2 = dot2bf(wx_p[m + 1], b1, iB2); } \
        float aA, uA, aB, uB; \
        LRU_GATE(rA + rA2, iA + iA2, xcA, aA, uA); LRU_GATE(rB + rB2, iB + iB2, xcB, aB, uB); \
        \
        const unsigned wA = f2bf(1.f - aA), wB = f2bf(1.f - aB), vA = f2bf(uA), vB = f2bf(uB); \
        AUA[(row0 + t_) * LW + ch] = (bf16_t)wA; AUA[(row0 + t_ + 1) * LW + ch] = (bf16_t)wB; AUU[(row0 + t_) * LW + ch] = (bf16_t)vA; AUU[(row0 + t_ + 1) * LW + ch] = (bf16_t)vB; \
        const float aAq = 1.f - bf2f(wA), aBq = 1.f - bf2f(wB); \
        h = aBq * (aAq * h + bf2f(vA)) + bf2f(vB); \
        aprod *= aAq * aBq; \
    } while (0)
#define SIDE_LOAD(r_, v_) do { if ((r_) < 16384) fp4_row_load(p.in[25] + (size_t)(r_) * D, p.in[22], lane, v_); else if ((r_) < 32768) fp4_row_load(p.in[26] + (size_t)((r_) - 16384) * D, nullptr, lane, v_); } while (0)
#define SIDE_FIN(r_, v_) do { if ((r_) < 16384) fp4_row_finish(v_, p.ws + WS_TABU, (r_), (float*)(p.ws + WS_SCU) + (r_), lane); \
        else if ((r_) < 32768) fp4_row_finish(v_, p.ws + WS_TABV, (r_) - 16384, (float*)(p.ws + WS_SCV) + ((r_) - 16384), lane); } while (0)
    f32x4 sva[8]; int sr = tr0;
    SIDE_LOAD(sr, sva);
#pragma unroll 1
    for (int tt = 0; tt < CHUNK; tt += 4) {
        LRU_TOKPAIR(tt);
        SIDE_FIN(sr, sva); SIDE_LOAD(sr + trs, sva);
        LRU_TOKPAIR(tt + 2);
        sr += trs;
    }
#undef LRU_TOKPAIR
#undef SIDE_LOAD
#undef SIDE_FIN
#undef LRU_PAIRX
#undef LRU_GATE
    { const size_t o = (size_t)(b * NCH + c) * LW + ch; SUMA[o] = aprod; SUMB[o] = h; }
}
__device__ __forceinline__ void lru_pass2(const Params& p, int b, int c, int g, int lane) {
    const bf16_t* PROJ = (const bf16_t*)(p.ws + WS_PROJ); bf16_t* O = (bf16_t*)(p.ws + WS_HO);
    const float* SUMA = (const float*)(p.ws + WS_LRUSUM); const float* SUMB = SUMA + BATCH * NCH * LW;
    const bf16_t* AUA = (const bf16_t*)(p.ws + WS_AUA); const bf16_t* AUU = (const bf16_t*)(p.ws + WS_AUU);
    const int ch = g * 64 + lane; const size_t row0 = (size_t)b * SEQ + (size_t)c * CHUNK;
    const bf16_t* ap = AUA + row0 * LW + ch; const bf16_t* up = AUU + row0 * LW + ch; const bf16_t* gp = PROJ + row0 * INW + C_GL + ch;
    bf16_t an[16], un[16], gn[16];
#pragma unroll
    for (int q = 0; q < 16; ++q) { an[q] = ap[(size_t)q * LW]; un[q] = up[(size_t)q * LW]; gn[q] = gp[(size_t)q * INW]; }
    float h = 0.f;
    {
        int j = 0;
#pragma unroll 1
        for (; j + 32 <= c; j += 32) { float sa[32], sb[32];
#pragma unroll
            for (int q = 0; q < 32; ++q) { const size_t o = (size_t)(b * NCH + j + q) * LW + ch; sa[q] = SUMA[o]; sb[q] = SUMB[o]; }
#pragma unroll
            for (int q = 0; q < 32; ++q) h = sa[q] * h + sb[q]; }
#pragma unroll 1
        for (; j + 8 <= c; j += 8) { float sa[8], sb[8];
#pragma unroll
            for (int q = 0; q < 8; ++q) { const size_t o = (size_t)(b * NCH + j + q) * LW + ch; sa[q] = SUMA[o]; sb[q] = SUMB[o]; }
#pragma unroll
            for (int q = 0; q < 8; ++q) h = sa[q] * h + sb[q]; }
        for (; j < c; ++j) { const size_t o = (size_t)(b * NCH + j) * LW + ch; h = SUMA[o] * h + SUMB[o]; }
    }
#pragma unroll 1
    for (int tb = 0; tb < CHUNK; tb += 16) {
        bf16_t ac[16], uc[16], gc[16];
#pragma unroll
        for (int q = 0; q < 16; ++q) { ac[q] = an[q]; uc[q] = un[q]; gc[q] = gn[q]; }
        if (tb + 16 < CHUNK) {
#pragma unroll
            for (int q = 0; q < 16; ++q) { an[q] = ap[(size_t)(tb + 16 + q) * LW]; un[q] = up[(size_t)(tb + 16 + q) * LW]; gn[q] = gp[(size_t)(tb + 16 + q) * INW]; }
        }
#pragma unroll
        for (int q = 0; q < 16; ++q) { h = (1.f - bf2f(ac[q])) * h + bf2f(uc[q]); O[(row0 + tb + q) * D + AW + ch] = (bf16_t)f2bf(h * bf2f(gc[q])); }
    }
}

__device__ __forceinline__ void attn_simple(const bf16_t* Qp, int ldq, const bf16_t* Kp, const bf16_t* Vp, int ldkv, int nkeys, int koff, const float* bias_h, bf16_t* Op, int ldo, int tid) {
    const int qi = tid >> 2, part = tid & 3;
    float q[32], o[32];
    { const u32x4* qp = (const u32x4*)(Qp + (size_t)qi * ldq + part * 32);
#pragma unroll
      for (int j = 0; j < 4; ++j) unpack8(qp[j], q + 8 * j); }
#pragma unroll
    for (int d = 0; d < 32; ++d) o[d] = 0.f;
    float m = -1e30f, l = 0.f;
    for (int kk0 = 0; kk0 < nkeys; kk0 += 8) {
        float s[8];
#pragma unroll
        for (int j = 0; j < 8; ++j) {
            const u32x4* kp = (const u32x4*)(Kp + (size_t)(kk0 + j) * ldkv + part * 32);
            float acc = 0.f;
#pragma unroll
            for (int w = 0; w < 4; ++w) { float kf[8]; unpack8(kp[w], kf);
#pragma unroll
                for (int e = 0; e < 8; ++e) acc = fmaf(q[8 * w + e], kf[e], acc); }
            acc += __shfl_xor(acc, 1); acc += __shfl_xor(acc, 2);
            if (bias_h) { int dist = qi + koff - (kk0 + j); dist = dist < -128 ? -128 : (dist > 128 ? 128 : dist); acc += bias_h[dist + 128]; }
            s[j] = acc;
        }
        float mx = s[0];
#pragma unroll
        for (int j = 1; j < 8; ++j) mx = fmaxf(mx, s[j]);
        const float mn = fmaxf(m, mx), corr = __expf(m - mn);
        l *= corr;
#pragma unroll
        for (int d = 0; d < 32; ++d) o[d] *= corr;
#pragma unroll
        for (int j = 0; j < 8; ++j) {
            const float pj = __expf(s[j] - mn); l += pj;
            const u32x4* vp = (const u32x4*)(Vp + (size_t)(kk0 + j) * ldkv + part * 32);
#pragma unroll
            for (int w = 0; w < 4; ++w) { float vf[8]; unpack8(vp[w], vf);
#pragma unroll
                for (int e = 0; e < 8; ++e) o[8 * w + e] = fmaf(pj, vf[e], o[8 * w + e]); }
        }
        m = mn;
    }
    const float inv = 1.f / l;
    u32x4* op = (u32x4*)(Op + (size_t)qi * ldo + part * 32);
#pragma unroll
    for (int w = 0; w < 4; ++w) { u32x4 ov; ov.x = pk2(o[8 * w] * inv, o[8 * w + 1] * inv); ov.y = pk2(o[8 * w + 2] * inv, o[8 * w + 3] * inv); ov.z = pk2(o[8 * w + 4] * inv, o[8 * w + 5] * inv); ov.w = pk2(o[8 * w + 6] * inv, o[8 * w + 7] * inv); op[w] = ov; }
}

__device__ __forceinline__ void gemm_branch(const bf16_t* __restrict__ Ob, const bf16_t* __restrict__ WT, const bf16_t* __restrict__ G, bf16_t* __restrict__ Mg, int gw, int NW, int lane) {
    const int r = lane & 15, q = lane >> 4;
    const int ntn = D / 32, ntiles = (T / 32) * ntn;
    for (int tile = gw; tile < ntiles; tile += NW) {
        const int tm = tile / ntn, tn = tile % ntn;
        f32x4 acc[3][2][2];
#pragma unroll
        for (int s = 0; s < 3; ++s)
#pragma unroll
            for (int i = 0; i < 2; ++i)
#pragma unroll
                for (int j = 0; j < 2; ++j) acc[s][i][j] = (f32x4){0.f, 0.f, 0.f, 0.f};
        const bf16_t* ap = Ob + (size_t)(tm * 32 + r) * D + q * 8;
        const bf16_t* bp = WT + (size_t)(tn * 32 + r) * D + q * 8;
#pragma unroll
        for (int s = 0; s < 3; ++s) {
            const int kb = s == 0 ? 0 : (s == 1 ? 1024 : 1536), ke = s == 0 ? 1024 : (s == 1 ? 1536 : 2048);
            for (int k0 = kb; k0 < ke; k0 += 32) {
                bf16x8 af[2], bfr[2];
#pragma unroll
                for (int i = 0; i < 2; ++i) af[i] = *(const bf16x8*)(ap + (size_t)i * 16 * D + k0);
#pragma unroll
                for (int j = 0; j < 2; ++j) bfr[j] = *(const bf16x8*)(bp + (size_t)j * 16 * D + k0);
#pragma unroll
                for (int i = 0; i < 2; ++i)
#pragma unroll
                    for (int j = 0; j < 2; ++j) acc[s][i][j] = __builtin_amdgcn_mfma_f32_16x16x32_bf16(af[i], bfr[j], acc[s][i][j], 0, 0, 0);
            }
        }
#pragma unroll
        for (int i = 0; i < 2; ++i)
#pragma unroll
            for (int j = 0; j < 2; ++j)
#pragma unroll
                for (int e = 0; e < 4; ++e) {
                    const int row = tm * 32 + i * 16 + q * 4 + e, col = tn * 32 + j * 16 + r;
                    const bf16_t* gp = G + (size_t)row * GW + col;
                    const float mval = bf2f(gp[0]) * acc[0][i][j][e] + bf2f(gp[2048]) * acc[1][i][j][e] + bf2f(gp[4096]) * acc[2][i][j][e];
                    Mg[(size_t)row * D + col] = (bf16_t)f2bf(mval);
                }
    }
}

__device__ __forceinline__ unsigned long long shfl_xor64(unsigned long long v, int m) {
    const unsigned lo = __shfl_xor((unsigned)v, m), hi = __shfl_xor((unsigned)(v >> 32), m);
    return ((unsigned long long)hi << 32) | lo;
}
__device__ __forceinline__ unsigned fkey(float f) { const unsigned u = __float_as_uint(f); return (u & 0x80000000u) ? ~u : (u | 0x80000000u); }
__device__ __forceinline__ float fkey_inv(unsigned k) { const unsigned u = (k & 0x80000000u) ? (k & 0x7fffffffu) : ~k; return __uint_as_float(u); }
__device__ __forceinline__ unsigned long long wave_max64(unsigned long long k) {
#pragma unroll
    for (int o = 1; o < 64; o <<= 1) { const unsigned long long t = shfl_xor64(k, o); k = t > k ? t : k; }
    return k;
}
__device__ __forceinline__ void route_unit(const Params& p, int t, int h, int lane) {
    const bf16_t* Q = (const bf16_t*)(p.ws + WS_Q); const bf16_t* KB = (const bf16_t*)(p.ws + WS_KEYSB);
    int* RIDX = (int*)(p.ws + WS_RIDX); float* RG = (float*)(p.ws + WS_RG);
    float sv_l[2] = {0.f, 0.f}; int si_l[2] = {0, 0};
#pragma unroll
    for (int c = 0; c < 2; ++c) {
        const bf16_t* qv = Q + (size_t)t * D + h * 256 + c * 128;
        const unsigned qw = ((const unsigned*)qv)[lane];
        const float qa = bf2f(qw & 0xffffu), qb = bf2f(qw >> 16);
        const bf16_t* k0p = KB + ((size_t)(h * 2 + c) * NKEYS + lane) * 128;
        const bf16_t* k1p = k0p + 64 * 128;
        float s0 = 0.f, s1 = 0.f;
#pragma unroll
        for (int w = 0; w < 16; ++w) {
            float k0f[8], k1f[8]; unpack8(((const u32x4*)k0p)[w], k0f); unpack8(((const u32x4*)k1p)[w], k1f);
#pragma unroll
            for (int e = 0; e < 8; e += 2) {
                const int src = 4 * w + e / 2;
                const float xa = __int_as_float(__builtin_amdgcn_readlane(__float_as_int(qa), src));
                const float xb = __int_as_float(__builtin_amdgcn_readlane(__float_as_int(qb), src));
                s0 = fmaf(xa, k0f[e], s0); s0 = fmaf(xb, k0f[e + 1], s0);
                s1 = fmaf(xa, k1f[e], s1); s1 = fmaf(xb, k1f[e + 1], s1);
            }
        }
        unsigned long long ka = ((unsigned long long)fkey(s0) << 32) | (unsigned)(255 - lane);
        unsigned long long kb = ((unsigned long long)fkey(s1) << 32) | (unsigned)(255 - (lane + 64));
        for (int rnd = 0; rnd < TOPK; ++rnd) {
            const unsigned long long best = wave_max64(ka > kb ? ka : kb);
            if (ka == best) ka = 0ull; if (kb == best) kb = 0ull;
            if (lane == rnd) { sv_l[c] = fkey_inv((unsigned)(best >> 32)); si_l[c] = 255 - (int)(best & 0xffffffffu); }
        }
    }
    unsigned long long kc[4];
#pragma unroll
    for (int m = 0; m < 4; ++m) { const int cid = lane + 64 * m, i = cid >> 4, j = cid & 15;
        const float v = __shfl(sv_l[0], i) + __shfl(sv_l[1], j);
        kc[m] = ((unsigned long long)fkey(v) << 32) | (unsigned)(1023 - cid); }
    float fv = 0.f; int cidx = 0;
    for (int rnd = 0; rnd < TOPK; ++rnd) {
        unsigned long long loc = kc[0] > kc[1] ? kc[0] : kc[1]; const unsigned long long loc2 = kc[2] > kc[3] ? kc[2] : kc[3]; loc = loc > loc2 ? loc : loc2;
        const unsigned long long best = wave_max64(loc);
#pragma unroll
        for (int m = 0; m < 4; ++m) if (kc[m] == best) kc[m] = 0ull;
        if (lane == rnd) { fv = fkey_inv((unsigned)(best >> 32)); cidx = 1023 - (int)(best & 0xffffffffu); }
    }
    const float fmax_ = __shfl(fv, 0);
    float e = lane < 16 ? __expf(fv - fmax_) : 0.f;
    float ssum = e;
#pragma unroll
    for (int o = 1; o < 16; o <<= 1) ssum += __shfl_xor(ssum, o);
    const int ci = cidx >> 4, cj = cidx & 15;
    const int e0 = __shfl(si_l[0], ci), e1 = __shfl(si_l[1], cj);
    if (lane < 16) { RIDX[(size_t)t * 128 + h * 16 + lane] = e0 * NKEYS + e1; RG[(size_t)t * 128 + h * 16 + lane] = e / ssum; }
}

typedef float f32x2 __attribute__((ext_vector_type(2)));
__device__ __forceinline__ void fp4_row_load(const float* __restrict__ src, const float* __restrict__ kscale, int lane, f32x4 (&v)[8]) {
#pragma unroll
    for (int j = 0; j < 8; ++j) { v[j] = ((const f32x4*)src)[64 * j + lane]; if (kscale) v[j] = v[j] * ((const f32x4*)kscale)[64 * j + lane]; }
}
__device__ __forceinline__ void fp4_row_finish(const f32x4 (&v)[8], unsigned char* __restrict__ tab, int e, float* __restrict__ scale_out, int lane) {
    float mx = 0.f;
#pragma unroll
    for (int j = 0; j < 8; ++j) mx = fmaxf(mx, fmaxf(fmaxf(fabsf(v[j].x), fabsf(v[j].y)), fmaxf(fabsf(v[j].z), fabsf(v[j].w))));
#pragma unroll
    for (int o = 1; o < 64; o <<= 1) mx = fmaxf(mx, __shfl_xor(mx, o));
    const float sc = mx > 0.f ? mx * (1.f / 6.f) : 1.f, inv = 1.f / sc;
#pragma unroll
    for (int j = 0; j < 8; ++j) {
        const f32x4 a = v[j] * inv;
        unsigned pk = 0u;
        pk = __builtin_amdgcn_cvt_scalef32_pk_fp4_f32(pk, fminf(fmaxf(a.x, -6.f), 6.f), fminf(fmaxf(a.y, -6.f), 6.f), 1.0f, 0);
        pk = __builtin_amdgcn_cvt_scalef32_pk_fp4_f32(pk, fminf(fmaxf(a.z, -6.f), 6.f), fminf(fmaxf(a.w, -6.f), 6.f), 1.0f, 1);
        *(unsigned short*)(tab + ((size_t)j * 16384 + e) * 128 + 2 * lane) = (unsigned short)pk;
    }
    if (lane == 0) *scale_out = sc;
}
__device__ __forceinline__ void fp4_tables(const Params& p, int gw, int NW, int lane) {
    f32x4 va[8], vb[8];
#define FP4_LOAD(r, v) do { if ((r) < 16384) fp4_row_load(p.in[25] + (size_t)(r) * D, p.in[22], lane, v); else fp4_row_load(p.in[26] + (size_t)((r) - 16384) * D, nullptr, lane, v); } while (0)
#define FP4_FIN(r, v) do { if ((r) < 16384) fp4_row_finish(v, p.ws + WS_TABU, (r), (float*)(p.ws + WS_SCU) + (r), lane); \
        else fp4_row_finish(v, p.ws + WS_TABV, (r) - 16384, (float*)(p.ws + WS_SCV) + ((r) - 16384), lane); } while (0)
    const int n = 2 * 16384;
    int r = gw;
    if (r < n) FP4_LOAD(r, va);
    for (; r < n; r += 2 * NW) {
        const bool hb = r + NW < n;
        if (hb) FP4_LOAD(r + NW, vb);
        FP4_FIN(r, va);
        if (r + 2 * NW < n) FP4_LOAD(r + 2 * NW, va);
        if (hb) FP4_FIN(r + NW, vb);
    }
#undef FP4_LOAD
#undef FP4_FIN
}
constexpr size_t WS_ZP = WS_Q;
constexpr size_t WS_X2F8 = 2 * MiB;
__device__ __forceinline__ float dot_chunk(const u32x4 w, const float (&xf)[32]) {
    float a0 = 0.f, a1 = 0.f;
#pragma unroll
    for (int q = 0; q < 4; ++q) {
        const f32x2 a = __builtin_amdgcn_cvt_scalef32_pk_f32_fp4(w[q], 1.0f, 0), b = __builtin_amdgcn_cvt_scalef32_pk_f32_fp4(w[q], 1.0f, 1);
        const f32x2 c = __builtin_amdgcn_cvt_scalef32_pk_f32_fp4(w[q], 1.0f, 2), d = __builtin_amdgcn_cvt_scalef32_pk_f32_fp4(w[q], 1.0f, 3);
        a0 = fmaf(a.x, xf[8 * q], a0); a1 = fmaf(a.y, xf[8 * q + 1], a1); a0 = fmaf(b.x, xf[8 * q + 2], a0); a1 = fmaf(b.y, xf[8 * q + 3], a1);
        a0 = fmaf(c.x, xf[8 * q + 4], a0); a1 = fmaf(c.y, xf[8 * q + 5], a1); a0 = fmaf(d.x, xf[8 * q + 6], a0); a1 = fmaf(d.y, xf[8 * q + 7], a1);
    }
    return a0 + a1;
}
__device__ __forceinline__ void axpy_chunk(const u32x4 w, const float a_, float (&of)[32]) {
#pragma unroll
    for (int q = 0; q < 4; ++q) {
        const f32x2 a = __builtin_amdgcn_cvt_scalef32_pk_f32_fp4(w[q], 1.0f, 0), b = __builtin_amdgcn_cvt_scalef32_pk_f32_fp4(w[q], 1.0f, 1);
        const f32x2 c = __builtin_amdgcn_cvt_scalef32_pk_f32_fp4(w[q], 1.0f, 2), d = __builtin_amdgcn_cvt_scalef32_pk_f32_fp4(w[q], 1.0f, 3);
        of[8 * q] = fmaf(a_, a.x, of[8 * q]); of[8 * q + 1] = fmaf(a_, a.y, of[8 * q + 1]); of[8 * q + 2] = fmaf(a_, b.x, of[8 * q + 2]); of[8 * q + 3] = fmaf(a_, b.y, of[8 * q + 3]);
        of[8 * q + 4] = fmaf(a_, c.x, of[8 * q + 4]); of[8 * q + 5] = fmaf(a_, c.y, of[8 * q + 5]); of[8 * q + 6] = fmaf(a_, d.x, of[8 * q + 6]); of[8 * q + 7] = fmaf(a_, d.y, of[8 * q + 7]);
    }
}
struct PeerTok { u32x4 w[16]; u32x4 x[4]; };
template <bool USTEP>
__device__ __forceinline__ void peer_issue(PeerTok& k, const Params& p, const unsigned char* tab, int t, int xv, int lane) {
    const int* RIDX = (const int*)(p.ws + WS_RIDX);
    const int i0 = RIDX[(size_t)t * 128 + lane], i1 = RIDX[(size_t)t * 128 + 64 + lane];
    const int es = lane >> 3, ck = lane & 7;
    if (USTEP) { const bf16_t* xp = (const bf16_t*)(p.ws + WS_X2BF) + (size_t)t * D + 256 * xv + 32 * ck;
#pragma unroll
        for (int j = 0; j < 4; ++j) k.x[j] = *(const u32x4*)(xp + 8 * j); }
#pragma unroll
    for (int g = 0; g < 16; ++g) { const int e = __shfl(g < 8 ? i0 : i1, (8 * g + es) & 63); k.w[g] = *(const u32x4*)(tab + (size_t)e * 128 + ck * 16); }
}
__device__ __forceinline__ void peer_u_finish(const PeerTok& k, const Params& p, int t, int xv, int lane) {
    const int es = lane >> 3, ck = lane & 7;
    float xf[32];
#pragma unroll
    for (int j = 0; j < 4; ++j) unpack8(k.x[j], xf + 8 * j);
    float zsel0 = 0.f, zsel1 = 0.f;
#pragma unroll
    for (int g = 0; g < 16; ++g) { u32x4 w_ = k.w[g]; asm volatile("" : "+v"(w_)); float d = dot_chunk(w_, xf);
        d += __int_as_float(__builtin_amdgcn_update_dpp(0, __float_as_int(d), 0xB1, 0xf, 0xf, true));
        d += __int_as_float(__builtin_amdgcn_update_dpp(0, __float_as_int(d), 0x4E, 0xf, 0xf, true));
        d += __int_as_float(__builtin_amdgcn_update_dpp(0, __float_as_int(d), 0x141, 0xf, 0xf, true));
        if (g < 8) { if (ck == g) zsel0 = d; } else { if (ck == g - 8) zsel1 = d; }
        asm volatile("" : "+v"(zsel0), "+v"(zsel1)); }
    float* zp = (float*)(p.ws + WS_ZP) + ((size_t)xv * T + t) * 128;
    zp[8 * ck + es] = zsel0; zp[64 + 8 * ck + es] = zsel1;
}
__device__ __forceinline__ void peer_v_finish(const PeerTok& k, const Params& p, int t, int xv, int lane, LAS float* red) {
    const float* RG = (const float*)(p.ws + WS_RG);
    const float a0 = RG[(size_t)t * 128 + lane], a1 = RG[(size_t)t * 128 + 64 + lane];
    const int es = lane >> 3, ck = lane & 7;
    float of[32];
#pragma unroll
    for (int q = 0; q < 32; ++q) of[q] = 0.f;
#pragma unroll
    for (int g = 0; g < 16; ++g) { const float a = __shfl(g < 8 ? a0 : a1, (8 * g + es) & 63); u32x4 w_ = k.w[g]; asm volatile("" : "+v"(w_)); axpy_chunk(w_, a, of);
        asm volatile("" : "+v"(of[0]), "+v"(of[1]), "+v"(of[2]), "+v"(of[3]), "+v"(of[4]), "+v"(of[5]), "+v"(of[6]), "+v"(of[7]), "+v"(of[8]), "+v"(of[9]), "+v"(of[10]), "+v"(of[11]), "+v"(of[12]), "+v"(of[13]), "+v"(of[14]), "+v"(of[15]));
        asm volatile("" : "+v"(of[16]), "+v"(of[17]), "+v"(of[18]), "+v"(of[19]), "+v"(of[20]), "+v"(of[21]), "+v"(of[22]), "+v"(of[23]), "+v"(of[24]), "+v"(of[25]), "+v"(of[26]), "+v"(of[27]), "+v"(of[28]), "+v"(of[29]), "+v"(of[30]), "+v"(of[31])); }
#pragma unroll
    for (int q = 0; q < 8; ++q) *(LAS f32x4*)(red + es * 256 + ck * 32 + 4 * q) = (f32x4){of[4 * q], of[4 * q + 1], of[4 * q + 2], of[4 * q + 3]};
    f32x4 s = *(const LAS f32x4*)(red + 4 * lane);
#pragma unroll
    for (int r = 1; r < 8; ++r) s = s + *(const LAS f32x4*)(red + r * 256 + 4 * lane);
    f32x4* o4 = (f32x4*)(p.out + (size_t)t * D + 256 * xv + 4 * lane);
    *o4 = *o4 + s;
}
template <bool USTEP>
__device__ __forceinline__ void peer_step(const Params& p, int lane, int wave, LAS float* red, int pos, int nx, int rank, int nloc) {
    for (int xv = pos; xv < 8; xv += nx) {
        const int wx = rank * 8 + wave, nwx = nloc * 8;
        const unsigned char* tab = p.ws + (USTEP ? WS_TABU : WS_TABV) + (size_t)xv * 16384 * 128;
        PeerTok A, B;
        int t = wx;
        if (t < T) peer_issue<USTEP>(A, p, tab, t, xv, lane);
#pragma unroll 1
        for (; t < T; t += 2 * nwx) {
            const bool hb = t + nwx < T;
            if (hb) peer_issue<USTEP>(B, p, tab, t + nwx, xv, lane);
            if (USTEP) peer_u_finish(A, p, t, xv, lane); else peer_v_finish(A, p, t, xv, lane, red);
            if (t + 2 * nwx < T) peer_issue<USTEP>(A, p, tab, t + 2 * nwx, xv, lane);
            if (hb) { if (USTEP) peer_u_finish(B, p, t + nwx, xv, lane); else peer_v_finish(B, p, t + nwx, xv, lane, red); }
        }
    }
}
typedef int v8i_p __attribute__((ext_vector_type(8))); typedef int v4i_t __attribute__((ext_vector_type(4)));
struct PeerTokU { u32x4 w[16]; u32x4 b[2][2]; };
__device__ __forceinline__ void peer_u_issue(PeerTokU& k, const Params& p, const unsigned char* tab, int t, int xv, int lane) {
    const int* RIDX = (const int*)(p.ws + WS_RIDX);
    const int i0 = RIDX[(size_t)t * 128 + lane], i1 = RIDX[(size_t)t * 128 + 64 + lane];
    const int es = lane >> 3, ck = lane & 7, q = lane >> 4;
    const unsigned char* xp = p.ws + WS_X2F8 + (size_t)t * D + 256 * xv + 16 * q;
#pragma unroll
    for (int kb = 0; kb < 2; ++kb) { k.b[kb][0] = *(const u32x4*)(xp + 128 * kb); k.b[kb][1] = *(const u32x4*)(xp + 128 * kb + 64); }
#pragma unroll
    for (int g = 0; g < 16; ++g) { const int e = __shfl(g < 8 ? i0 : i1, (8 * g + es) & 63); k.w[g] = *(const u32x4*)(tab + (size_t)e * 128 + ck * 16); }
}
__device__ __forceinline__ void peer_u_mfma(const PeerTokU& k, const Params& p, int t, int xv, int lane, LAS unsigned char* vl) {
    float* zp = (float*)(p.ws + WS_ZP) + ((size_t)xv * T + t) * 128;
    const int es = lane >> 3, ck = lane & 7, r16 = lane & 15, q = lane >> 4;
#pragma unroll
    for (int g = 0; g < 16; ++g) { const int row = 8 * g + es; *(LAS u32x4*)(vl + row * 128 + ((ck ^ (row & 7)) << 4)) = k.w[g]; }
    v8i_p b0, b1;
    { const v4i_t x0 = __builtin_bit_cast(v4i_t, k.b[0][0]), x1 = __builtin_bit_cast(v4i_t, k.b[0][1]), y0 = __builtin_bit_cast(v4i_t, k.b[1][0]), y1 = __builtin_bit_cast(v4i_t, k.b[1][1]);
      b0 = __builtin_shufflevector(x0, x1, 0, 1, 2, 3, 4, 5, 6, 7); b1 = __builtin_shufflevector(y0, y1, 0, 1, 2, 3, 4, 5, 6, 7); }
#pragma unroll
    for (int g = 0; g < 8; ++g) {
        const int row = 16 * g + r16;
        const v4i_t a0 = __builtin_bit_cast(v4i_t, *(const LAS u32x4*)(vl + row * 128 + ((q ^ (row & 7)) << 4)));
        const v4i_t a1 = __builtin_bit_cast(v4i_t, *(const LAS u32x4*)(vl + row * 128 + (((4 + q) ^ (row & 7)) << 4)));
        const v8i_p A0 = {a0[0], a0[1], a0[2], a0[3], 0, 0, 0, 0}, A1 = {a1[0], a1[1], a1[2], a1[3], 0, 0, 0, 0};
        f32x4 acc = {0.f, 0.f, 0.f, 0.f};
        acc = __builtin_amdgcn_mfma_scale_f32_16x16x128_f8f6f4(A0, b0, acc, 4, 0, 0, 0x7F7F7F7F, 0, 0x7F7F7F7F);
        acc = __builtin_amdgcn_mfma_scale_f32_16x16x128_f8f6f4(A1, b1, acc, 4, 0, 0, 0x7F7F7F7F, 0, 0x7F7F7F7F);
        if ((lane & 15) == 0) *(f32x4*)(zp + 16 * g + 4 * (lane >> 4)) = acc;
    }
}
__device__ __forceinline__ void peer_u_step(const Params& p, int lane, int wave, LAS unsigned char* vl, int pos, int nx, int rank, int nloc) {
    for (int xv = pos; xv < 8; xv += nx) {
        const int wx = rank * 8 + wave, nwx = nloc * 8;
        const unsigned char* tab = p.ws + WS_TABU + (size_t)xv * 16384 * 128;
        PeerTokU A, B;
        int t = wx;
        if (t < T) peer_u_issue(A, p, tab, t, xv, lane);
#pragma unroll 1
        for (; t < T; t += 2 * nwx) {
            const bool hb = t + nwx < T;
            if (hb) peer_u_issue(B, p, tab, t + nwx, xv, lane);
            peer_u_mfma(A, p, t, xv, lane, vl);
            if (t + 2 * nwx < T) peer_u_issue(A, p, tab, t + 2 * nwx, xv, lane);
            if (hb) peer_u_mfma(B, p, t + nwx, xv, lane, vl);
        }
    }
}
constexpr size_t WS_ACT8 = 34 * MiB, WS_ASC = 36 * MiB;
__device__ __forceinline__ void peer_combine(const Params& p, int t, int lane) {
    const float* ZP = (const float*)(p.ws + WS_ZP); const int* RIDX = (const int*)(p.ws + WS_RIDX); const float* RG = (const float*)(p.ws + WS_RG);
    const float* SCU = (const float*)(p.ws + WS_SCU); const float* SCV = (const float*)(p.ws + WS_SCV); const float* SS2 = (const float*)(p.ws + WS_CTL + CTL_SS2_BYTE);
    const float rs = rsqrtf(SS2[t] * (1.f / D) + EPS);
    float act[2];
#pragma unroll
    for (int hlf = 0; hlf < 2; ++hlf) { const size_t o = (size_t)t * 128 + 64 * hlf + lane; float z = 0.f;
#pragma unroll
        for (int x = 0; x < 8; ++x) z += ZP[((size_t)x * T) * 128 + o];
        const int e = RIDX[o];
        act[hlf] = gelu_tanh(z * rs * SCU[e]) * RG[o] * SCV[e]; }
    float mx = fmaxf(fabsf(act[0]), fabsf(act[1]));
#pragma unroll
    for (int o = 1; o < 64; o <<= 1) mx = fmaxf(mx, __shfl_xor(mx, o));
    const float sc = mx > 0.f ? mx * (1.f / 448.f) : 1.f, inv = 1.f / sc;
    unsigned char* a8 = p.ws + WS_ACT8 + (size_t)t * 128;
    a8[lane] = (unsigned char)(__builtin_amdgcn_cvt_pk_fp8_f32(act[0] * inv, 0.f, 0, false) & 0xff);
    a8[64 + lane] = (unsigned char)(__builtin_amdgcn_cvt_pk_fp8_f32(act[1] * inv, 0.f, 0, false) & 0xff);
    if (lane == 0) ((float*)(p.ws + WS_ASC))[t] = sc;
}
typedef int v2i_t __attribute__((ext_vector_type(2)));
struct PeerTokV { u32x4 w[16]; u32x4 b[2]; };
__device__ __forceinline__ void peer_v_issue(PeerTokV& k, const Params& p, const unsigned char* tab, int t, int lane) {
    const int* RIDX = (const int*)(p.ws + WS_RIDX);
    const int i0 = RIDX[(size_t)t * 128 + lane], i1 = RIDX[(size_t)t * 128 + 64 + lane];
    const int es = lane >> 3, ck = lane & 7, q = lane >> 4;
    const unsigned char* ap = p.ws + WS_ACT8 + (size_t)t * 128 + 16 * q;
    k.b[0] = *(const u32x4*)ap; k.b[1] = *(const u32x4*)(ap + 64);
#pragma unroll
    for (int g = 0; g < 16; ++g) { const int e = __shfl(g < 8 ? i0 : i1, (8 * g + es) & 63); k.w[g] = *(const u32x4*)(tab + (size_t)e * 128 + ck * 16); }
}
__device__ __forceinline__ void peer_v_mfma(const PeerTokV& k, const Params& p, int t, int xv, int lane, LAS unsigned char* vl) {
    const int es = lane >> 3, ck = lane & 7, n = lane & 15, q = lane >> 4;
#pragma unroll
    for (int g = 0; g < 16; ++g) { const int row = 8 * g + es; *(LAS u32x4*)(vl + row * 128 + ((ck ^ (row & 7)) << 4)) = k.w[g]; }
    const v4i_t x0 = __builtin_bit_cast(v4i_t, k.b[0]), x1 = __builtin_bit_cast(v4i_t, k.b[1]);
    const v8i_p bop = __builtin_shufflevector(x0, x1, 0, 1, 2, 3, 4, 5, 6, 7);
    const int r1 = 32 * q + n, r2 = r1 + 16;
    f32x4 keep = {0.f, 0.f, 0.f, 0.f};
#pragma unroll
    for (int mb = 0; mb < 16; ++mb) {
        const v2i_t t1 = __builtin_amdgcn_ds_read_tr4_b64_v2i32((LAS v2i_t*)(vl + r1 * 128 + ((((mb >> 1) ^ (r1 & 7)) << 4) | ((mb & 1) << 3))));
        const v2i_t t2 = __builtin_amdgcn_ds_read_tr4_b64_v2i32((LAS v2i_t*)(vl + r2 * 128 + ((((mb >> 1) ^ (r2 & 7)) << 4) | ((mb & 1) << 3))));
        const v8i_p aop = {t1[0], t1[1], t2[0], t2[1], 0, 0, 0, 0};
        f32x4 acc = {0.f, 0.f, 0.f, 0.f};
        acc = __builtin_amdgcn_mfma_scale_f32_16x16x128_f8f6f4(aop, bop, acc, 4, 0, 0, 0x7F7F7F7F, 0, 0x7F7F7F7F);
        if (n == mb) keep = acc;
    }
    const float sc = ((const float*)(p.ws + WS_ASC))[t];
    const size_t oo = (size_t)t * D + 256 * xv + 16 * n + 4 * q;
    const u32x2 xw = *(const u32x2*)((const bf16_t*)(p.ws + WS_X2BF) + oo);
    const f32x4 x2v = {__uint_as_float(xw.x << 16), __uint_as_float(xw.x & 0xffff0000u), __uint_as_float(xw.y << 16), __uint_as_float(xw.y & 0xffff0000u)};
    *(f32x4*)(p.out + oo) = x2v + keep * sc;
}
__device__ __forceinline__ void peer_v_step(const Params& p, int lane, int wave, LAS unsigned char* vl, int pos, int nx, int rank, int nloc) {
    for (int xv = pos; xv < 8; xv += nx) {
        const int wx = rank * 8 + wave, nwx = nloc * 8;
        const unsigned char* tab = p.ws + WS_TABV + (size_t)xv * 16384 * 128;
        PeerTokV A, B;
        int t = wx;
        if (t < T) peer_v_issue(A, p, tab, t, lane);
#pragma unroll 1
        for (; t < T; t += 2 * nwx) {
            const bool hb = t + nwx < T;
            if (hb) peer_v_issue(B, p, tab, t + nwx, lane);
            peer_v_mfma(A, p, t, xv, lane, vl);
            if (t + 2 * nwx < T) peer_v_issue(A, p, tab, t + 2 * nwx, lane);
            if (hb) peer_v_mfma(B, p, t + nwx, xv, lane, vl);
        }
    }
}

namespace pg8 {
#define PG8_LAS __attribute__((address_space(3)))
constexpr int BM = 256, BK = 64, HALF = 128, HTB = HALF * BK * 2, STAGE_BYTES = 8 * HTB, NXCD = 8, WGM = 1;
__host__ __device__ __forceinline__ int lds_byte(int r, int c) { const int st = (r >> 4) * 2 + (c >> 5), rr = r & 15, cc = c & 31, ob = rr * 64 + cc * 2; return st * 1024 + (ob ^ (((ob >> 9) & 1) << 5)); }
__host__ __device__ __forceinline__ void stage_rc(int b, int& R, int& C) { const int st = b / 1024, sb = b % 1024, swz = sb ^ (((sb >> 9) & 1) << 5); R = (st >> 1) * 16 + swz / 64; C = (st & 1) * 32 + (swz % 64) / 2; }
__host__ __device__ __forceinline__ int perm32(int rho) { const int n = rho >> 4, i = rho & 15; return 8 * (i >> 2) + 4 * n + (i & 3); }
struct Unit { const char* A; const char* B; int pm, pn, kind, nt; };
__device__ __forceinline__ const char* uni_ptr(const char* p) { const unsigned long long v = (unsigned long long)p; const unsigned lo = __builtin_amdgcn_readfirstlane((unsigned)v), hi = __builtin_amdgcn_readfirstlane((unsigned)(v >> 32)); return (const char*)(((unsigned long long)hi << 32) | lo); }
__device__ __forceinline__ void uni(Unit& u) { u.A = uni_ptr(u.A); u.B = uni_ptr(u.B); u.pm = __builtin_amdgcn_readfirstlane(u.pm); u.pn = __builtin_amdgcn_readfirstlane(u.pn); u.kind = __builtin_amdgcn_readfirstlane(u.kind); u.nt = __builtin_amdgcn_readfirstlane(u.nt); }
template <int WG = WGM>
__device__ __forceinline__ void tile_of(int L, int nM, int nN, int& pm, int& pn) {
    const int nwg = nM * nN; int wgid = L; { const int q = nwg / NXCD, r = nwg % NXCD, xcd = wgid % NXCD, off = wgid / NXCD; wgid = (xcd < r ? xcd * (q + 1) : r * (q + 1) + (xcd - r) * q) + off; }
    const int nig = WG * nN, gid = wgid / nig, fm = gid * WG, gsz = (nM - fm) < WG ? (nM - fm) : WG;
    pm = fm + ((wgid % nig) % gsz); pn = (wgid % nig) / gsz;
}
typedef int v8i_t __attribute__((ext_vector_type(8))); typedef int v4i_t __attribute__((ext_vector_type(4)));
__device__ __forceinline__ v8i_t cat8(const bf16x8 lo, const bf16x8 hi) { const v4i_t a = __builtin_bit_cast(v4i_t, lo), b = __builtin_bit_cast(v4i_t, hi); return __builtin_shufflevector(a, b, 0, 1, 2, 3, 4, 5, 6, 7); }
template <bool FP8, class Epi, class Sched>
__device__ __forceinline__ void gemm_phase(PG8_LAS unsigned char* lds, const int lda, const int ldb, const Sched& S, const Epi& E, const int wid) {
    const int lane = fresh_lane(), tid = wid * 64 + lane, wr = wid >> 2, wc = wid & 3, fr = lane & 15, fq = lane >> 4;
    unsigned voffA[2], voffB[2];
#pragma unroll
    for (int i = 0; i < 2; ++i) { int R, C; stage_rc(tid * 16 + i * 8192, R, C); const int Rb = (R & ~31) + perm32(R & 31);
        voffA[i] = (unsigned)(R * lda + C) * 2u; voffB[i] = (unsigned)(Rb * ldb + C) * 2u; }
    const size_t kstep = (size_t)(BK * 2);
    const size_t hstepA = (size_t)HALF * lda * 2, hstepB = (size_t)HALF * ldb * 2;
    const unsigned ldsw = (unsigned)wid * 1024u;
    const int aoff = lds_byte(wr * 64 + fr, fq * 8), boff = lds_byte(wc * 32 + fr, fq * 8);
#define PG8_SA(b, h) (((b) * 2 + (h)) * HTB)
#define PG8_SB(b, h) ((4 + (b) * 2 + (h)) * HTB)
#define PG8_STAGE(bufoff, gbase, voff) do { _Pragma("unroll") for (int _i = 0; _i < 2; ++_i) \
        __builtin_amdgcn_global_load_lds((const unsigned*)((const char*)(gbase) + (voff)[_i]), (PG8_LAS unsigned*)(lds + (bufoff) + ldsw + _i * 8192), 16, 0, 0); } while (0)
#define PG8_LDA(dst, b, h) do { _Pragma("unroll") for (int m = 0; m < 4; ++m) { if constexpr (FP8) dst##8[m] = cat8(*(const PG8_LAS bf16x8*)(lds + PG8_SA(b, h) + aoff + m * 2048), *(const PG8_LAS bf16x8*)(lds + PG8_SA(b, h) + aoff + m * 2048 + 1024)); \
        else { _Pragma("unroll") for (int k = 0; k < 2; ++k) dst[m][k] = *(const PG8_LAS bf16x8*)(lds + PG8_SA(b, h) + aoff + m * 2048 + k * 1024); } } } while (0)
#define PG8_LDB(dst, b, h) do { _Pragma("unroll") for (int n = 0; n < 2; ++n) { if constexpr (FP8) dst##8[n] = cat8(*(const PG8_LAS bf16x8*)(lds + PG8_SB(b, h) + boff + n * 2048), *(const PG8_LAS bf16x8*)(lds + PG8_SB(b, h) + boff + n * 2048 + 1024)); \
        else { _Pragma("unroll") for (int k = 0; k < 2; ++k) dst[n][k] = *(const PG8_LAS bf16x8*)(lds + PG8_SB(b, h) + boff + n * 2048 + k * 1024); } } } while (0)
#define PG8_MMA(ai, bj, At, Bt) do { __builtin_amdgcn_s_setprio(1); \
        if constexpr (FP8) { _Pragma("unroll") for (int m = 0; m < 4; ++m) _Pragma("unroll") for (int n = 0; n < 2; ++n) \
            asm volatile("v_mfma_scale_f32_16x16x128_f8f6f4 %0, %1, %2, %0, %3, %3 op_sel_hi:[0,0,0]" : "+v"(acc[ai][bj][m][n]) : "v"(Bt##8[n]), "v"(At##8[m]), "v"(mxone)); } \
        else { _Pragma("unroll") for (int m = 0; m < 4; ++m) _Pragma("unroll") for (int n = 0; n < 2; ++n) _Pragma("unroll") for (int k = 0; k < 2; ++k) \
            acc[ai][bj][m][n] = __builtin_amdgcn_mfma_f32_16x16x32_bf16(Bt[n][k], At[m][k], acc[ai][bj][m][n], 0, 0, 0); } \
        __builtin_amdgcn_s_setprio(0); } while (0)
#define PG8_WAIT_V(n) asm volatile("s_waitcnt vmcnt(" #n ")" ::: "memory")
#define PG8_WAIT_L(n) asm volatile("s_waitcnt lgkmcnt(" #n ")" ::: "memory")
#define PG8_BAR __builtin_amdgcn_s_barrier()
#define PG8_SCHED __builtin_amdgcn_sched_barrier(0)
    Unit cur, nxt; int ui = 0;
    if (!S.next(0, cur)) return;
    f32x4 acc[2][2][4][2];
#pragma unroll
    for (int a = 0; a < 2; ++a)
#pragma unroll
        for (int b = 0; b < 2; ++b)
#pragma unroll
            for (int m = 0; m < 4; ++m)
#pragma unroll
                for (int n = 0; n < 2; ++n) acc[a][b][m][n] = (f32x4){0.f, 0.f, 0.f, 0.f};
    const int mxone = 0x7F7F7F7F;
    bf16x8 At[4][2], B0[2][2], B1[2][2]; v8i_t At8[4], B08[2], B18[2];
    const char* cA = cur.A; const char* cB = cur.B;
    PG8_STAGE(PG8_SB(0, 0), cB, voffB); PG8_STAGE(PG8_SB(0, 1), cB + hstepB, voffB); PG8_STAGE(PG8_SA(0, 0), cA, voffA); PG8_STAGE(PG8_SA(0, 1), cA + hstepA, voffA);
    if (wr == 1) PG8_BAR;
    PG8_WAIT_V(2); PG8_BAR;
    PG8_STAGE(PG8_SB(1, 0), cB + kstep, voffB); PG8_STAGE(PG8_SA(1, 0), cA + kstep, voffA); PG8_STAGE(PG8_SB(1, 1), cB + hstepB + kstep, voffB);
    PG8_WAIT_V(6); PG8_BAR;
    for (;;) {
        const bool has_next = S.next(ui + 1, nxt);
        const char* nA = has_next ? nxt.A : cA; const char* nB = has_next ? nxt.B : cB;
        const int nt = cur.nt;
        for (int t = 0; t < nt; t += 2) {
            const bool last = (t == nt - 2);
            const char* a1 = cA + (size_t)(t + 1) * kstep;
            const char* a2 = last ? nA : cA + (size_t)(t + 2) * kstep; const char* b2 = last ? nB : cB + (size_t)(t + 2) * kstep;
            const char* a3 = a2 + kstep; const char* b3 = b2 + kstep;
            PG8_LDB(B0, 0, 0); PG8_LDB(B1, 0, 1); PG8_SCHED; PG8_LDA(At, 0, 0); PG8_STAGE(PG8_SA(1, 1), a1 + hstepA, voffA);
            PG8_WAIT_V(8); PG8_WAIT_L(0); PG8_BAR; PG8_MMA(0, 0, At, B0); PG8_MMA(0, 1, At, B1); PG8_BAR; PG8_SCHED;
            PG8_LDA(At, 0, 1); PG8_STAGE(PG8_SB(0, 0), b2, voffB); PG8_STAGE(PG8_SB(0, 1), b2 + hstepB, voffB); PG8_STAGE(PG8_SA(0, 0), a2, voffA);
            PG8_WAIT_V(8); PG8_WAIT_L(0); PG8_BAR; PG8_MMA(1, 0, At, B0); PG8_MMA(1, 1, At, B1); PG8_BAR; PG8_SCHED;
            PG8_LDB(B0, 1, 0); PG8_LDB(B1, 1, 1); PG8_SCHED; PG8_LDA(At, 1, 0); PG8_STAGE(PG8_SA(0, 1), a2 + hstepA, voffA);
            PG8_WAIT_V(8); PG8_WAIT_L(0); PG8_BAR; PG8_MMA(0, 0, At, B0); PG8_MMA(0, 1, At, B1); PG8_BAR; PG8_SCHED;
            PG8_LDA(At, 1, 1); PG8_STAGE(PG8_SB(1, 0), b3, voffB); PG8_STAGE(PG8_SB(1, 1), b3 + hstepB, voffB); PG8_STAGE(PG8_SA(1, 0), a3, voffA);
            PG8_WAIT_V(8); PG8_WAIT_L(0); PG8_BAR; PG8_MMA(1, 0, At, B0); PG8_MMA(1, 1, At, B1); PG8_BAR; PG8_SCHED;
        }
        if (wr == 0) PG8_BAR;
        if constexpr (FP8) asm volatile("s_nop 15\n\ts_nop 15" ::: "memory");
        E(acc, cur, wr, wc, fr, fq);
        if (!has_next) break;
        if (E.reset(cur)) {
#pragma unroll
        for (int a = 0; a < 2; ++a)
#pragma unroll
            for (int b = 0; b < 2; ++b)
#pragma unroll
                for (int m = 0; m < 4; ++m)
#pragma unroll
                    for (int n = 0; n < 2; ++n) acc[a][b][m][n] = (f32x4){0.f, 0.f, 0.f, 0.f};
        }
        cur = nxt; cA = nA; cB = nB; ++ui;
        if (wr == 1) PG8_BAR;
    }
    PG8_WAIT_V(0);
    PG8_BAR;
#undef PG8_SA
#undef PG8_SB
#undef PG8_STAGE
#undef PG8_LDA
#undef PG8_LDB
#undef PG8_MMA
#undef PG8_WAIT_V
#undef PG8_WAIT_L
#undef PG8_BAR
#undef PG8_SCHED
}
}
typedef f32x4 AccT[2][2][4][2];
#define EPI_RESET_ALWAYS __device__ __forceinline__ bool reset(const pg8::Unit&) const { return true; }
__device__ __forceinline__ unsigned cvt_pk_bf16(float lo, float hi) { unsigned r; asm volatile("v_cvt_pk_bf16_f32 %0, %1, %2" : "=v"(r) : "v"(lo), "v"(hi)); return r; }
__device__ __forceinline__ u32x4 pack8(const f32x4 v0, const f32x4 v1) { u32x4 w; w.x = cvt_pk_bf16(v0[0], v0[1]); w.y = cvt_pk_bf16(v0[2], v0[3]); w.z = cvt_pk_bf16(v1[0], v1[1]); w.w = cvt_pk_bf16(v1[2], v1[3]); return w; }
template <int MODE>
__device__ __forceinline__ void store_tile_bf16(const AccT& acc, bf16_t* base, int ldc, int row0, int col0, const float* bias, const float ascale = 1.f) {
#pragma unroll
    for (int ai = 0; ai < 2; ++ai)
#pragma unroll
        for (int m = 0; m < 4; ++m) { bf16_t* rowp = base + (size_t)(row0 + ai * 128 + m * 16) * ldc + col0;
#pragma unroll
            for (int bj = 0; bj < 2; ++bj) { f32x4 v0 = acc[ai][bj][m][0], v1 = acc[ai][bj][m][1];
                if (MODE == 1) { _Pragma("unroll") for (int e = 0; e < 4; ++e) { v0[e] = gelu_tanh(v0[e]); v1[e] = gelu_tanh(v1[e]); } }
                if (MODE == 2) { const f32x4 b0 = *(const f32x4*)(bias + col0 + bj * 128), b1 = *(const f32x4*)(bias + col0 + bj * 128 + 4);
                    v0 = v0 * ascale + b0; v1 = v1 * ascale + b1; _Pragma("unroll") for (int e = 0; e < 4; ++e) { v0[e] = sigmoid_(v0[e]); v1[e] = sigmoid_(v1[e]); } }
                *(u32x4*)(rowp + bj * 128) = pack8(v0, v1); }
            if (MODE == 2) asm volatile("" ::: "memory"); }
}
struct SchedP1a { const char* H; const char* WT; const char* MEMN; const char* WTM; int G, c;
    __device__ __forceinline__ bool next(int i, pg8::Unit& u) const {
        const int L = i * G + c; const int n1 = 64 * 18;
        if (L < n1) { pg8::tile_of(L, 64, 18, u.pm, u.pn); u.kind = 0; u.A = H + (size_t)u.pm * 256 * D * 2; u.B = WT + (size_t)u.pn * 256 * D * 2; u.nt = D / 64; pg8::uni(u); return true; }
        if (L < n1 + 8) { const int j = L - n1; u.pm = j >> 2; u.pn = j & 3; u.kind = 1; u.A = MEMN + (size_t)u.pm * 256 * D * 2; u.B = WTM + (size_t)u.pn * 256 * D * 2; u.nt = D / 64; pg8::uni(u); return true; }
        return false; } };
struct EpiP1a { bf16_t* PROJ; bf16_t* MEMKV; const float* gq; const float* gk; const float* gc; const float* gmk; LAS float* xs; EPI_RESET_ALWAYS
    __device__ __forceinline__ void operator()(AccT& acc, const pg8::Unit& u, int wr, int wc, int fr, int fq) const {
        const int row0 = u.pm * 256 + wr * 64 + fr, cl = wc * 32 + 8 * fq;
        const float* g = nullptr; float qs = 1.f;
        if (u.kind == 1) { if (u.pn < 2) g = gmk; }
        else if (u.pn < 4) { g = gq; qs = 0.08838834764831845f; } else if (u.pn < 8) g = gk; else if (u.pn >= 16) { g = gc; qs = 0.08838834764831845f; }
        if (g) {
#pragma unroll
            for (int ai = 0; ai < 2; ++ai)
#pragma unroll
                for (int m = 0; m < 4; ++m)
#pragma unroll
                    for (int bj = 0; bj < 2; ++bj) { const f32x4 v0 = acc[ai][bj][m][0], v1 = acc[ai][bj][m][1];
                        float sq = (v0[0] * v0[0] + v0[1] * v0[1]) + (v0[2] * v0[2] + v0[3] * v0[3]) + (v1[0] * v1[0] + v1[1] * v1[1]) + (v1[2] * v1[2] + v1[3] * v1[3]);
                        sq += __shfl_xor(sq, 16); sq += __shfl_xor(sq, 32);
                        if (fq == 0) xs[((ai * 128 + wr * 64 + m * 16 + fr) * 2 + bj) * 4 + wc] = sq; asm volatile("" ::: "memory"); }
            asm volatile("s_waitcnt lgkmcnt(0)" ::: "memory"); __builtin_amdgcn_s_barrier(); asm volatile("" ::: "memory");
#pragma unroll
            for (int ai = 0; ai < 2; ++ai)
#pragma unroll
                for (int m = 0; m < 4; ++m)
#pragma unroll
                    for (int bj = 0; bj < 2; ++bj) { const f32x4 pp = *(const LAS f32x4*)(xs + ((ai * 128 + wr * 64 + m * 16 + fr) * 2 + bj) * 4);
                        const float rs = rsqrtf(((pp[0] + pp[1]) + (pp[2] + pp[3])) * (1.f / 128.f) + EPS) * qs;
                        const f32x4 g0 = *(const f32x4*)(g + cl), g1 = *(const f32x4*)(g + cl + 4);
                        acc[ai][bj][m][0] = acc[ai][bj][m][0] * g0 * rs; acc[ai][bj][m][1] = acc[ai][bj][m][1] * g1 * rs; asm volatile("" ::: "memory"); }
            asm volatile("s_waitcnt lgkmcnt(0)" ::: "memory"); __builtin_amdgcn_s_barrier(); asm volatile("" ::: "memory");
        }
        if (u.kind == 1) { store_tile_bf16<0>(acc, MEMKV, 2 * CW, row0, u.pn * 256 + cl, nullptr); return; }
        if (u.pn == 14 || u.pn == 15) { store_tile_bf16<1>(acc, PROJ, INW, row0, u.pn * 256 + cl, nullptr); return; }
        store_tile_bf16<0>(acc, PROJ, INW, row0, u.pn * 256 + cl, nullptr);
    } };
struct SchedG { const char* H8; const char* WT8; int G, c, ti;
    __device__ __forceinline__ bool next(int i, pg8::Unit& u) const {
        const int L = ti * G + c; if (i >= 3 || L >= 64 * 8) return false;
        int pn8; pg8::tile_of(L, 64, 8, u.pm, pn8); u.pn = pn8 + 8 * i; u.kind = i; u.A = H8 + (size_t)u.pm * 256 * D; u.B = WT8 + (size_t)u.pn * 256 * D; u.nt = D / 128; pg8::uni(u); return true; } };
struct EpiG { u32x4* slab; const float* bgate; EPI_RESET_ALWAYS
    __device__ __forceinline__ void operator()(AccT& acc, const pg8::Unit& u, int wr, int wc, int fr, int fq) const {
        const int tid = (wr * 4 + wc) * 64 + fq * 16 + fr, col0 = u.pn * 256 + wc * 32 + 8 * fq;
        u32x4* sp = slab + (size_t)u.kind * (16 * 512) + tid; const float ascale = 1.f / GATE_WSCALE;
#pragma unroll
        for (int ai = 0; ai < 2; ++ai)
#pragma unroll
            for (int m = 0; m < 4; ++m) {
#pragma unroll
                for (int bj = 0; bj < 2; ++bj) { f32x4 v0 = acc[ai][bj][m][0], v1 = acc[ai][bj][m][1];
                    const f32x4 b0 = *(const f32x4*)(bgate + col0 + bj * 128), b1 = *(const f32x4*)(bgate + col0 + bj * 128 + 4);
                    v0 = v0 * ascale + b0; v1 = v1 * ascale + b1; _Pragma("unroll") for (int e = 0; e < 4; ++e) { v0[e] = sigmoid_(v0[e]); v1[e] = sigmoid_(v1[e]); }
                    sp[((ai * 4 + m) * 2 + bj) * 512] = pack8(v0, v1); }
                asm volatile("" ::: "memory"); }
    } };
struct SchedP3 { const char* O; const char* WT; int G, c, ti;
    __device__ __forceinline__ bool next(int i, pg8::Unit& u) const {
        const int seg = i; const int L = ti * G + c; if (i >= 3 || L >= 64 * 8) return false;
        pg8::tile_of(L, 64, 8, u.pm, u.pn); u.kind = seg;
        const int kb = seg == 0 ? 0 : (seg == 1 ? 1024 : 1536);
        u.A = O + ((size_t)u.pm * 256 * D + kb) * 2; u.B = WT + ((size_t)u.pn * 256 * D + kb) * 2; u.nt = seg == 0 ? 16 : 8; pg8::uni(u); return true; } };
struct EpiP3 { const u32x4* slab; bf16_t* MERGED;
    __device__ __forceinline__ bool reset(const pg8::Unit& u) const { return u.kind == 2; }
    __device__ __forceinline__ void operator()(AccT& acc, const pg8::Unit& u, int wr, int wc, int fr, int fq) const {
        const int row0 = u.pm * 256 + wr * 64 + fr, col0 = u.pn * 256 + wc * 32 + 8 * fq, seg = u.kind;
        const u32x4* sa = slab + (size_t)seg * (16 * 512) + ((wr * 4 + wc) * 64 + fq * 16 + fr);
#pragma unroll
        for (int ai = 0; ai < 2; ++ai) {
                u32x4 ga[4][2], gb[4][2];
#pragma unroll
                for (int m = 0; m < 4; ++m)
#pragma unroll
                    for (int bj = 0; bj < 2; ++bj) { const u32x4* gp = sa + ((ai * 4 + m) * 2 + bj) * 512;
                        ga[m][bj] = gp[0]; gb[m][bj] = (seg < 2) ? gp[16 * 512] : (u32x4){0u, 0u, 0u, 0u}; }
#pragma unroll
                for (int m = 0; m < 4; ++m)
#pragma unroll
                    for (int bj = 0; bj < 2; ++bj) {
                        float fa[8], fb[8]; unpack8(ga[m][bj], fa); unpack8(gb[m][bj], fb);
                        if (seg < 2) { _Pragma("unroll") for (int e = 0; e < 8; ++e) fa[e] = fa[e] * __builtin_amdgcn_rcpf(fmaxf(fb[e], 1e-20f)); }
                        f32x4& v0 = acc[ai][bj][m][0]; f32x4& v1 = acc[ai][bj][m][1];
                        v0[0] *= fa[0]; v0[1] *= fa[1]; v0[2] *= fa[2]; v0[3] *= fa[3]; v1[0] *= fa[4]; v1[1] *= fa[5]; v1[2] *= fa[6]; v1[3] *= fa[7];
                        if (seg == 2) *(u32x4*)(MERGED + (size_t)(row0 + ai * 128 + m * 16) * D + col0 + bj * 128) = pack8(v0, v1);
                    }
                asm volatile("" ::: "memory");
            }
    } };
struct SchedSq { const char* A; const char* WT; int G, c;
    __device__ __forceinline__ bool next(int i, pg8::Unit& u) const {
        const int L = i * G + c; if (L >= 64 * 8) return false;
        pg8::tile_of(L, 64, 8, u.pm, u.pn); u.kind = 0; u.A = A + (size_t)u.pm * 256 * D * 2; u.B = WT + (size_t)u.pn * 256 * D * 2; u.nt = D / 64; pg8::uni(u); return true; } };
struct EpiP4 { const float* x; float* out; bf16_t* xb; float* ss; unsigned char* x8; EPI_RESET_ALWAYS
    __device__ __forceinline__ void operator()(AccT& acc, const pg8::Unit& u, int wr, int wc, int fr, int fq) const {
        const int row0 = u.pm * 256 + wr * 64 + fr, col0 = u.pn * 256 + wc * 32 + 8 * fq;
#pragma unroll
        for (int ai = 0; ai < 2; ++ai) {
            f32x4 xv[4][2][2];
#pragma unroll
            for (int m = 0; m < 4; ++m)
#pragma unroll
                for (int bj = 0; bj < 2; ++bj) { const size_t o = (size_t)(row0 + ai * 128 + m * 16) * D + col0 + bj * 128; xv[m][bj][0] = *(const f32x4*)(x + o); xv[m][bj][1] = *(const f32x4*)(x + o + 4); }
#pragma unroll
            for (int m = 0; m < 4; ++m) { const size_t row = (size_t)(row0 + ai * 128 + m * 16); float sq = 0.f;
#pragma unroll
                for (int bj = 0; bj < 2; ++bj) { const size_t o = row * D + col0 + bj * 128;
                    const f32x4 v0 = acc[ai][bj][m][0] + xv[m][bj][0], v1 = acc[ai][bj][m][1] + xv[m][bj][1];
                    *(u32x4*)(xb + o) = pack8(v0, v1);
#define F8X(x_) fminf(fmaxf((x_), -448.f), 448.f)
                    { int w0 = __builtin_amdgcn_cvt_pk_fp8_f32(F8X(v0[0]), F8X(v0[1]), 0, false); w0 = __builtin_amdgcn_cvt_pk_fp8_f32(F8X(v0[2]), F8X(v0[3]), w0, true);
                      int w1 = __builtin_amdgcn_cvt_pk_fp8_f32(F8X(v1[0]), F8X(v1[1]), 0, false); w1 = __builtin_amdgcn_cvt_pk_fp8_f32(F8X(v1[2]), F8X(v1[3]), w1, true);
                      *(u32x2*)(x8 + o) = (u32x2){(unsigned)w0, (unsigned)w1}; }
                    sq += (v0[0] * v0[0] + v0[1] * v0[1]) + (v0[2] * v0[2] + v0[3] * v0[3]) + (v1[0] * v1[0] + v1[1] * v1[1]) + (v1[2] * v1[2] + v1[3] * v1[3]); }
                sq += __shfl_xor(sq, 16); sq += __shfl_xor(sq, 32);
                if (fq == 0) atomicAdd(ss + row, sq); }
        }
    } };
struct EpiP5 { bf16_t* Q; const float* ss; EPI_RESET_ALWAYS
    __device__ __forceinline__ void operator()(AccT& acc, const pg8::Unit& u, int wr, int wc, int fr, int fq) const {
        const int row0 = u.pm * 256 + wr * 64 + fr, col0 = u.pn * 256 + wc * 32 + 8 * fq;
#pragma unroll
        for (int ai = 0; ai < 2; ++ai)
#pragma unroll
            for (int m = 0; m < 4; ++m) { const size_t row = (size_t)(row0 + ai * 128 + m * 16); const float rs = rsqrtf(ss[row] * (1.f / D) + EPS);
#pragma unroll
                for (int bj = 0; bj < 2; ++bj) *(u32x4*)(Q + row * D + col0 + bj * 128) = pack8(acc[ai][bj][m][0] * rs, acc[ai][bj][m][1] * rs); }
    } };


namespace att {
using s16x4  = __attribute__((ext_vector_type(4))) short;
using f32x16 = __attribute__((ext_vector_type(16))) float;
constexpr int NWV = 8, QBLK = 32, KVBLK = 64, DH = 128;
constexpr float THR = 8.f;
constexpr int SHM_V = KVBLK * DH * 2, SHM_K = KVBLK * DH * 2;
constexpr int OFF_WS = 2 * SHM_V + 2 * SHM_K, OFF_BT = OFF_WS + NWV * 64 * 4, OFF_OST = OFF_BT + 1536, LDS_NEED = OFF_OST + NWV * 8192;
#define KSWZ(row, colB) ((row) * 256 + ((colB) ^ (((row) & 7) << 4)))
#define SBAR() __builtin_amdgcn_sched_barrier(0)
__device__ __forceinline__ int crow(int r, int hi) { return (r & 3) + 8 * (r >> 2) + 4 * hi; }
__device__ __forceinline__ unsigned cvtpk(float lo, float hi) { unsigned r; asm volatile("v_cvt_pk_bf16_f32 %0, %1, %2" : "=v"(r) : "v"(lo), "v"(hi)); return r; }
__device__ __forceinline__ void partialSM(f32x16& p0, f32x16& p1, float& m_reg, float& mn, float& alpha) {
  constexpr float C = 1.4426950408889634f;
  float pmax = p0[0];
#pragma unroll
  for (int r = 1; r < 16; ++r) pmax = fmaxf(pmax, p0[r]);
#pragma unroll
  for (int r = 0; r < 16; ++r) pmax = fmaxf(pmax, p1[r]);
  { auto rr = __builtin_amdgcn_permlane32_swap(__float_as_uint(pmax), __float_as_uint(pmax), false, false);
    pmax = fmaxf(__uint_as_float(rr[0]), __uint_as_float(rr[1])); }
  if (__builtin_expect(__all(pmax - m_reg <= THR), 1)) { mn = m_reg; alpha = 1.f; }
  else { mn = fmaxf(m_reg, pmax); alpha = __builtin_amdgcn_exp2f((m_reg - mn) * C); m_reg = mn; }
  float mnC = -mn * C;
#pragma unroll
  for (int r = 0; r < 16; ++r) p0[r] = fmaf(p0[r], C, mnC);
#pragma unroll
  for (int r = 0; r < 16; ++r) p1[r] = fmaf(p1[r], C, mnC);
#pragma unroll
  for (int r = 0; r < 16; ++r) p0[r] = __builtin_amdgcn_exp2f(p0[r]);
}
__device__ __forceinline__ void finishSM(f32x16& p0, f32x16& p1, float alpha, float& l_reg, bf16x8& pa0, bf16x8& pa1, bf16x8& pa2, bf16x8& pa3) {
#pragma unroll
  for (int r = 0; r < 16; ++r) p1[r] = __builtin_amdgcn_exp2f(p1[r]);
  float ps = 0;
#pragma unroll
  for (int r = 0; r < 16; ++r) ps += p0[r];
#pragma unroll
  for (int r = 0; r < 16; ++r) ps += p1[r];
  { auto rr = __builtin_amdgcn_permlane32_swap(__float_as_uint(ps), __float_as_uint(ps), false, false);
    ps = __uint_as_float(rr[0]) + __uint_as_float(rr[1]); }
  l_reg = l_reg * alpha + ps;
#define PK4(P, BASE, OUT) do { unsigned a0 = cvtpk(P[BASE + 0], P[BASE + 1]), a1 = cvtpk(P[BASE + 2], P[BASE + 3]);   \
    unsigned b0 = cvtpk(P[BASE + 4], P[BASE + 5]), b1 = cvtpk(P[BASE + 6], P[BASE + 7]);                              \
    auto r0 = __builtin_amdgcn_permlane32_swap(a0, b0, false, false); auto r1 = __builtin_amdgcn_permlane32_swap(a1, b1, false, false); \
    u32x4 w = {r0[0], r1[0], r0[1], r1[1]}; OUT = *reinterpret_cast<bf16x8*>(&w); } while (0)
  PK4(p0, 0, pa0); PK4(p0, 8, pa1); PK4(p1, 0, pa2); PK4(p1, 8, pa3);
#undef PK4
}
template <bool BIAS>
__device__ __forceinline__ void qkt(f32x16& p0, f32x16& p1, const LAS char* Ks, const LAS char* qs, int r32, int hi, const LAS float* bp) {
  if (BIAS) {
#pragma unroll
    for (int r = 0; r < 16; ++r) { p0[r] = bp[(r & 3) + 8 * (r >> 2)]; p1[r] = bp[32 + (r & 3) + 8 * (r >> 2)]; }
  } else { p0 = f32x16{}; p1 = f32x16{}; }
#pragma unroll
  for (int d0 = 0; d0 < 8; ++d0) { int cb = (d0 * 16 + hi * 8) * 2;
    bf16x8 b0 = *reinterpret_cast<const LAS bf16x8*>(Ks + KSWZ(r32, cb));
    bf16x8 b1 = *reinterpret_cast<const LAS bf16x8*>(Ks + KSWZ(32 + r32, cb));
    const bf16x8 qv = *reinterpret_cast<const LAS bf16x8*>(qs + d0 * 1024);
    p0 = __builtin_amdgcn_mfma_f32_32x32x16_bf16(b0, qv, p0, 0, 0, 0);
    p1 = __builtin_amdgcn_mfma_f32_32x32x16_bf16(b1, qv, p1, 0, 0, 0); }
}
__device__ __forceinline__ int v_st(int k, int c) { const int kk = (k & ~0xC) | ((k & 4) << 1) | ((k & 8) >> 1); return ((kk >> 3) * 4 + (c >> 5)) * 512 + ((kk & 7) * 32 + (c & 31)) * 2; }
__device__ __forceinline__ int v_rd_base(int lane) { return ((lane & 3) << 3) | (((lane >> 2) & 3) << 6) | (((lane >> 4) & 1) << 5) | (((lane >> 5) & 1) << 8); }
constexpr int v_rd_off(int d0, int ks, int half) { return d0 * 512 + ks * 4096 + half * 2048; }
template <int OFF> __device__ __forceinline__ s16x4 tr_read(int vb) {
  s16x4 r; asm volatile("ds_read_b64_tr_b16 %0, %1 offset:%2" : "=&v"(r) : "v"(vb), "i"(OFF) : "memory"); return r;
}
template <int D0> __device__ __forceinline__ void pv_one(f32x16& od, int vb, bf16x8 pa0, bf16x8 pa1, bf16x8 pa2, bf16x8 pa3) {
  const s16x4 l0 = tr_read<v_rd_off(D0, 0, 0)>(vb), h0 = tr_read<v_rd_off(D0, 0, 1)>(vb), l1 = tr_read<v_rd_off(D0, 1, 0)>(vb), h1 = tr_read<v_rd_off(D0, 1, 1)>(vb);
  const s16x4 l2 = tr_read<v_rd_off(D0, 2, 0)>(vb), h2 = tr_read<v_rd_off(D0, 2, 1)>(vb), l3 = tr_read<v_rd_off(D0, 3, 0)>(vb), h3 = tr_read<v_rd_off(D0, 3, 1)>(vb);
  asm volatile("s_waitcnt lgkmcnt(0)" ::: "memory"); SBAR();
#define PK(L, H) (bf16x8){L[0], L[1], L[2], L[3], H[0], H[1], H[2], H[3]}
  od = __builtin_amdgcn_mfma_f32_32x32x16_bf16(pa0, PK(l0, h0), od, 0, 0, 0);
  od = __builtin_amdgcn_mfma_f32_32x32x16_bf16(pa1, PK(l1, h1), od, 0, 0, 0);
  od = __builtin_amdgcn_mfma_f32_32x32x16_bf16(pa2, PK(l2, h2), od, 0, 0, 0);
  od = __builtin_amdgcn_mfma_f32_32x32x16_bf16(pa3, PK(l3, h3), od, 0, 0, 0);
#undef PK
}
__device__ __forceinline__ void pv_d0(f32x16* o, int vb, bf16x8 pa0, bf16x8 pa1, bf16x8 pa2, bf16x8 pa3) {
  pv_one<0>(o[0], vb, pa0, pa1, pa2, pa3); pv_one<1>(o[1], vb, pa0, pa1, pa2, pa3); pv_one<2>(o[2], vb, pa0, pa1, pa2, pa3); pv_one<3>(o[3], vb, pa0, pa1, pa2, pa3);
}
template <int LDQ, int LDK, int LDO, bool BAND>
__device__ __forceinline__ void attn_body(const bf16_t* Qb, const bf16_t* Kh, const bf16_t* Vh, bf16_t* Ob,
                                          const int NT, const int kc0, const float* btab_src, LAS char* lds, const int wid) {
  const int lane = fresh_lane(), tid = wid * 64 + lane, r32 = lane & 31, hi = lane >> 5;
  LAS char* V_lds = lds; LAS char* K_lds = lds + 2 * SHM_V;
  LAS float* wsf = (LAS float*)(lds + OFF_WS) + wid * 64; LAS float* li_l = wsf; LAS float* al_l = wsf + 32;
  LAS float* btab = (LAS float*)(lds + OFF_BT);
  if (BAND) { if (tid < 384) btab[tid] = tid < 64 ? btab_src[256] : (tid < 256 ? btab_src[320 - tid] : -30000.f); }
  float m_reg = -10000.f, l_reg = 0; f32x16 o[4] = {};
  const bf16_t* Qw = Qb + (long)(wid * QBLK + r32) * LDQ + hi * 8;
  LAS char* qr = lds + OFF_OST + wid * 8192 + lane * 16;
#pragma unroll
  for (int d0 = 0; d0 < 8; ++d0) *reinterpret_cast<LAS bf16x8*>(qr + d0 * 1024) = *reinterpret_cast<const bf16x8*>(Qw + d0 * 16);
  const int sr = tid >> 4, sc = (tid & 15) * 8, vst0 = v_st(sr, sc), vst1 = v_st(32 + sr, sc);
  const int vb0 = (int)(unsigned)(uintptr_t)V_lds + v_rd_base(lane);
  struct { bf16x8 vs0, vs1, ks0, ks1; } sr_[1];
  const int pw = wid >> 1, qi = (wid & 1) * 32 + r32;
#define TROW(t) ((BAND ? (((kc0) + (t)) > 0 ? ((kc0) + (t)) : 0) : (t)) * KVBLK)
#define SLOAD(i, t) do { const long k0_ = TROW(t); sr_[i].vs0 = *reinterpret_cast<const bf16x8*>(&Vh[(k0_ + sr) * LDK + sc]); sr_[i].vs1 = *reinterpret_cast<const bf16x8*>(&Vh[(k0_ + 32 + sr) * LDK + sc]); \
    sr_[i].ks0 = *reinterpret_cast<const bf16x8*>(&Kh[(k0_ + sr) * LDK + sc]); sr_[i].ks1 = *reinterpret_cast<const bf16x8*>(&Kh[(k0_ + 32 + sr) * LDK + sc]); } while (0)
#define SWRITE(b, i) do { *(LAS bf16x8*)(V_lds + (b) * SHM_V + vst0) = sr_[i].vs0; *(LAS bf16x8*)(V_lds + (b) * SHM_V + vst1) = sr_[i].vs1; int kc_ = sc * 2; \
    *(LAS bf16x8*)(K_lds + (b) * SHM_K + KSWZ(sr, kc_)) = sr_[i].ks0; *(LAS bf16x8*)(K_lds + (b) * SHM_K + KSWZ(32 + sr, kc_)) = sr_[i].ks1; } while (0)
#define SWAIT() asm volatile("s_waitcnt vmcnt(0)" ::: "memory")
#define RESC(a) do { if (__any((a) < 1.f)) { if (hi == 0) al_l[r32] = (a); asm volatile("s_waitcnt lgkmcnt(0)" ::: "memory"); \
    _Pragma("unroll") for (int d = 0; d < 4; ++d) _Pragma("unroll") for (int r = 0; r < 16; ++r) o[d][r] *= al_l[crow(r, hi)]; } } while (0)
#define BPTR(t) ({ const int t_ = (t); const int dch = pw + 8 - t_; int kb_ = 192 - dch * 64 - qi + 4 * hi; kb_ = kb_ < 0 ? 0 : kb_; \
    if (dch < 0 || dch > 8 || (kc0) + t_ < 0) kb_ = 288; (const LAS float*)(btab + kb_); })
  f32x16 pA0, pA1, pB0, pB1; float mnA, mnB, alA, alB; bf16x8 pa0, pa1, pa2, pa3;
  constexpr int SE = 0, SO = 0;
#define ACT(t) (!BAND || ((pw + 8 - (t)) >= 0 && (pw + 8 - (t)) <= 8 && (kc0) + (t) >= 0))
  SLOAD(SE, 0); asm volatile("s_waitcnt vmcnt(0)" ::: "memory"); SWRITE(0, SE); __syncthreads();
  if (ACT(0)) { qkt<BAND>(pA0, pA1, K_lds, qr, r32, hi, BPTR(0)); partialSM(pA0, pA1, m_reg, mnA, alA); }
  SLOAD(SO, 1);
  SWAIT(); SWRITE(1, SO); __syncthreads();
  for (int j = 1; j + 1 < NT; j += 2) {
    const bool a0_ = ACT(j - 1), a1_ = ACT(j), a2_ = ACT(j + 1);
    SBAR(); if (a1_) qkt<BAND>(pB0, pB1, K_lds + SHM_K, qr, r32, hi, BPTR(j));
    if (a0_) finishSM(pA0, pA1, alA, l_reg, pa0, pa1, pa2, pa3); SBAR();
    SLOAD(SO, j + 1); SBAR();
    if (a0_) pv_d0(o, vb0, pa0, pa1, pa2, pa3); if (a1_) partialSM(pB0, pB1, m_reg, mnB, alB);
    __syncthreads(); SWAIT(); SWRITE(0, SE);
    if (a1_) RESC(alB); __syncthreads();
    SBAR(); if (a2_) qkt<BAND>(pA0, pA1, K_lds, qr, r32, hi, BPTR(j + 1));
    if (a1_) finishSM(pB0, pB1, alB, l_reg, pa0, pa1, pa2, pa3); SBAR();
    SLOAD(SE, j + 2); SBAR();
    if (a1_) pv_d0(o, vb0 + SHM_V, pa0, pa1, pa2, pa3); if (a2_) partialSM(pA0, pA1, m_reg, mnA, alA);
    __syncthreads(); SWAIT(); SWRITE(1, SO);
    if (a2_) RESC(alA); __syncthreads();
  }
  { const bool a0_ = ACT(NT - 2), a1_ = ACT(NT - 1);
    SBAR(); if (a1_) qkt<BAND>(pB0, pB1, K_lds + SHM_K, qr, r32, hi, BPTR(NT - 1));
    if (a0_) finishSM(pA0, pA1, alA, l_reg, pa0, pa1, pa2, pa3); SBAR();
    if (a0_) pv_d0(o, vb0, pa0, pa1, pa2, pa3); if (a1_) partialSM(pB0, pB1, m_reg, mnB, alB);
    __syncthreads(); if (a1_) RESC(alB);
    if (a1_) { finishSM(pB0, pB1, alB, l_reg, pa0, pa1, pa2, pa3); SBAR();
      pv_d0(o, vb0 + SHM_V, pa0, pa1, pa2, pa3); } }
#undef ACT
  if (hi == 0) li_l[r32] = l_reg; asm volatile("s_waitcnt lgkmcnt(0)" ::: "memory");
  float rli[16];
#pragma unroll
  for (int r = 0; r < 16; ++r) rli[r] = __builtin_amdgcn_rcpf(li_l[crow(r, hi)]);
  { LAS bf16_t* stg = (LAS bf16_t*)(lds + OFF_OST + wid * 8192);
#pragma unroll
    for (int r = 0; r < 16; ++r) { const int orow = crow(r, hi);
#pragma unroll
      for (int d0 = 0; d0 < 4; ++d0) stg[orow * 128 + d0 * 32 + r32] = (bf16_t)f2bf(o[d0][r] * rli[r]); }
    asm volatile("s_waitcnt lgkmcnt(0)" ::: "memory");
    bf16_t* Ow = Ob + (long)(wid * QBLK) * LDO;
#pragma unroll
    for (int i = 0; i < 8; ++i) { const int row = i * 4 + (lane >> 4), ch = lane & 15; const u32x4 v = *(const LAS u32x4*)(stg + row * 128 + ch * 8); *(u32x4*)(Ow + (long)row * LDO + ch * 8) = v; } }
  __syncthreads();
#undef TROW
#undef SLOAD
#undef SWRITE
#undef SWAIT
#undef RESC
#undef BPTR
}
#undef KSWZ
#undef SBAR
}


namespace rt {
using f32x16 = __attribute__((ext_vector_type(16))) float;
#define RKSWZ(row, colB) ((row) * 256 + ((colB) ^ (((row) & 7) << 4)))
__device__ __forceinline__ int crow(int r, int hi) { return (r & 3) + 8 * (r >> 2) + 4 * hi; }
__device__ __forceinline__ void ce_desc(unsigned& a, unsigned& b) { const unsigned mx = a > b ? a : b, mn = a > b ? b : a; a = mx; b = mn; }
__device__ __forceinline__ void sort16_desc(unsigned (&v)[16]) {
#pragma unroll
  for (int k = 2; k <= 16; k <<= 1)
#pragma unroll
    for (int j = k >> 1; j > 0; j >>= 1)
#pragma unroll
      for (int i = 0; i < 16; ++i) { const int l = i ^ j; if (l > i) { if ((i & k) == 0) ce_desc(v[i], v[l]); else ce_desc(v[l], v[i]); } }
}
__device__ __forceinline__ void merge16_desc(unsigned (&a)[16], const unsigned (&b)[16]) {
#pragma unroll
  for (int i = 0; i < 16; ++i) a[i] = a[i] > b[15 - i] ? a[i] : b[15 - i];
#pragma unroll
  for (int j = 8; j > 0; j >>= 1)
#pragma unroll
    for (int i = 0; i < 16; ++i) { const int l = i ^ j; if (l > i) ce_desc(a[i], a[l]); }
}
__device__ __forceinline__ unsigned fkey(float f) { const unsigned u = __float_as_uint(f); return (u & 0x80000000u) ? ~u : (u | 0x80000000u); }
__device__ __forceinline__ float fkey_inv(unsigned k) { const unsigned u = (k & 0x80000000u) ? (k & 0x7fffffffu) : ~k; return __uint_as_float(u); }
__device__ __forceinline__ void top16_half(const f32x16 (&sc)[4], int hi, unsigned (&out)[16]) {
  unsigned g[16];
#pragma unroll
  for (int blk = 0; blk < 4; ++blk) {
#pragma unroll
    for (int r = 0; r < 16; ++r) g[r] = (fkey(sc[blk][r]) & 0xFFFFFF80u) | (unsigned)(32 * blk + (r & 3) + 8 * (r >> 2) + 4 * hi);
    sort16_desc(g);
    if (blk == 0) {
#pragma unroll
      for (int r = 0; r < 16; ++r) out[r] = g[r];
    } else merge16_desc(out, g);
  }
  unsigned pb[16];
#pragma unroll
  for (int r = 0; r < 16; ++r) { auto rr = __builtin_amdgcn_permlane32_swap(out[r], out[r], false, false); pb[r] = hi ? rr[0] : rr[1]; }
  merge16_desc(out, pb);
}
__device__ __forceinline__ void route_phase(const Params& p, LAS unsigned char* lds, int wave) {
  const int lane = fresh_lane(), tid = wave * 64 + lane;
  const bf16_t* Q = (const bf16_t*)(p.ws + WS_Q); const bf16_t* KB = (const bf16_t*)(p.ws + WS_KEYSB);
  int* RIDX = (int*)(p.ws + WS_RIDX); float* RG = (float*)(p.ws + WS_RG);
  const int h = blockIdx.x & 7, grp = blockIdx.x >> 3;
  const int r32 = lane & 31, hi = lane >> 5;
#pragma unroll
  for (int c = 0; c < 2; ++c)
#pragma unroll
    for (int rep = 0; rep < 4; ++rep) { const int row = rep * 32 + (tid >> 4), cb = (tid & 15) * 16;
      *(LAS u32x4*)(lds + c * 32768 + RKSWZ(row, cb)) = *(const u32x4*)((const char*)KB + ((size_t)(h * 2 + c) * 128 + row) * 256 + cb); }
  __syncthreads();
  for (int tb = grp * 8 + wave; tb < T / 32; tb += (int)(gridDim.x >> 3) * 8) {
    const int t = tb * 32 + r32;
    unsigned ka[16], kb2[16];
#pragma unroll
    for (int c = 0; c < 2; ++c) {
      bf16x8 qf[8];
      const bf16_t* qp = Q + (size_t)t * D + h * 256 + c * 128 + hi * 8;
#pragma unroll
      for (int ks = 0; ks < 8; ++ks) qf[ks] = *(const bf16x8*)(qp + ks * 16);
      f32x16 sc[4];
#pragma unroll
      for (int blk = 0; blk < 4; ++blk) { sc[blk] = f32x16{};
#pragma unroll
        for (int ks = 0; ks < 8; ++ks) { const bf16x8 kf = *(const LAS bf16x8*)(lds + c * 32768 + RKSWZ(32 * blk + r32, (16 * ks + 8 * hi) * 2));
          sc[blk] = __builtin_amdgcn_mfma_f32_32x32x16_bf16(kf, qf[ks], sc[blk], 0, 0, 0); } }
      if (c == 0) top16_half(sc, hi, ka); else top16_half(sc, hi, kb2);
    }
    float av[16], bv[16];
#pragma unroll
    for (int i = 0; i < 16; ++i) { av[i] = fkey_inv(ka[i] & 0xFFFFFF80u); bv[i] = fkey_inv(kb2[i] & 0xFFFFFF80u); }
    float T[16];
#pragma unroll
    for (int k = 0; k < 16; ++k) T[k] = -3.0e38f;
#pragma unroll
    for (int i = 0; i < 16; ++i)
#pragma unroll
      for (int j = 0; j < 16; ++j) if ((i + 1) * (j + 1) <= 16) { float v = av[i] + bv[j];
#pragma unroll
          for (int k = 0; k < 16; ++k) { const float mx = fmaxf(T[k], v); v = fminf(T[k], v); T[k] = mx; } }
    const float m = T[0], theta = T[15];
    float Z = 0.f;
#pragma unroll
    for (int k = 0; k < 16; ++k) Z += __expf(T[k] - m);
    const float rz = 1.f / Z;
    int slot = 0; int cn = 0;
    int* ip = RIDX + (size_t)t * 128 + h * 16; float* gp = RG + (size_t)t * 128 + h * 16;
#pragma unroll
    for (int i = 0; i < 16; ++i)
#pragma unroll
      for (int j = 0; j < 16; ++j) if ((i + 1) * (j + 1) <= 16) { const float v = av[i] + bv[j];
          const bool sel = (v >= theta) && (slot < 16);
          if (sel && ((cn & 1) == hi)) { ip[slot] = (int)((ka[i] & 127u) * 128u + (kb2[j] & 127u)); gp[slot] = __expf(v - m) * rz; }
          slot += sel ? 1 : 0; ++cn; }
  }
}
#undef RKSWZ
}

#define XB_TMO      128
#define XB_XCNT(j)  (256  + 64 * (j))
#define XB_XSUB(j)  (1280 + 64 * (j))
#define XB_XGEN(j)  (2304 + 64 * (j))
#define XB_TOP      3328
#define XB_TOPGEN   3392
#define XCD_BAR_WORDS 3456
#define XB_SPIN_CAP (1u << 22)
__device__ __forceinline__ unsigned xb_ld(unsigned* p)              { return __hip_atomic_load(p, __ATOMIC_RELAXED, __HIP_MEMORY_SCOPE_AGENT); }
__device__ __forceinline__ unsigned xb_add(unsigned* p, unsigned v) { return __hip_atomic_fetch_add(p, v, __ATOMIC_RELAXED, __HIP_MEMORY_SCOPE_AGENT); }
__device__ __forceinline__ unsigned xb_xcc_id() { return (unsigned)__builtin_amdgcn_s_getreg((3 << 11) | 20) & 0xFu; }
#define XB_SPIN(cond, bar) do { unsigned _sp = 0; while (cond) { __builtin_amdgcn_s_sleep(1); \
    if ((++_sp & 255u) == 0u) { if (xb_ld(&(bar)[XB_TMO])) break; if (_sp > XB_SPIN_CAP) { atomicAdd(&(bar)[XB_TMO], 1u); break; } } } } while (0)
struct XcdBarrier { unsigned* bar; unsigned x; volatile LAS unsigned* st; int w; };
__device__ __forceinline__ XcdBarrier xcd_barrier_post(unsigned* bar, volatile LAS unsigned* st, const int wave) {
    XcdBarrier b; b.bar = bar; b.x = xb_xcc_id(); b.st = st; b.w = wave;
    if (wave == 0 && fresh_lane() == 0) (void)xb_add(&bar[XB_XCNT(b.x)], 1u);
    return b;
}
__device__ __forceinline__ void xcd_barrier_complete(unsigned* bar, unsigned x, unsigned& nloc, unsigned& nx) {
    const unsigned G = gridDim.x * gridDim.y * gridDim.z;
    unsigned sum, cnt, mine, sp = 0u;
    for (;;) {
        sum = 0u; cnt = 0u; mine = 0u;
#pragma unroll
        for (unsigned j = 0; j < 16; ++j) { const unsigned c = xb_ld(&bar[XB_XCNT(j)]); sum += c; cnt += (c > 0u) ? 1u : 0u; mine = (j == x) ? c : mine; }
        if (sum == G) break;
        __builtin_amdgcn_s_sleep(1);
        if ((++sp & 255u) == 0u) { if (xb_ld(&bar[XB_TMO])) break; if (sp > XB_SPIN_CAP) { atomicAdd(&bar[XB_TMO], 1u); break; } }
    }
    nloc = mine > 0u ? mine : 1u; nx = cnt > 0u ? cnt : 1u;
}
__device__ __forceinline__ void xcd_barrier(const XcdBarrier& b) {
    asm volatile("s_waitcnt vmcnt(0)" ::: "memory");
    __syncthreads();
    if (b.w == 0 && fresh_lane() == 0) {
        unsigned* bar = b.bar;
        __builtin_amdgcn_s_waitcnt(0);
        unsigned nloc = b.st[0], nx = b.st[1];
        if (nloc == 0u) { xcd_barrier_complete(bar, b.x, nloc, nx); b.st[0] = nloc; b.st[1] = nx; }
        const unsigned old = xb_add(&bar[XB_XSUB(b.x)], 1u);
        const unsigned gen = old / nloc;
        if (old + 1u == (gen + 1u) * nloc) {
            __builtin_amdgcn_fence(__ATOMIC_RELEASE, "agent");
            asm volatile("s_waitcnt vmcnt(0)" ::: "memory");
            const unsigned og = xb_add(&bar[XB_TOP], 1u);
            const unsigned tg = og / nx;
            if (og + 1u == (tg + 1u) * nx) xb_add(&bar[XB_TOPGEN], 1u);
            else XB_SPIN(xb_ld(&bar[XB_TOPGEN]) == tg, bar);
            __builtin_amdgcn_fence(__ATOMIC_ACQUIRE, "agent");
            xb_add(&bar[XB_XGEN(b.x)], 1u);
            asm volatile("s_waitcnt vmcnt(0)" ::: "memory");
        } else {
            XB_SPIN(xb_ld(&bar[XB_XGEN(b.x)]) == gen, bar);
            __builtin_amdgcn_fence(__ATOMIC_ACQUIRE, "agent");
            asm volatile("s_waitcnt vmcnt(0)" ::: "memory");
        }
    }
    __syncthreads();
}
constexpr int RING_BYTES = 131072, MISC_OFF = 143360, LDS_BYTES = 147456, NTHREADS = 512;
static_assert(att::LDS_NEED <= MISC_OFF, "attention scratch below the MISC words");
constexpr size_t WS_SLAB = WS_X2BF;

__device__ __forceinline__ void touch_buffer(const void* base, size_t bytes, int cb, int Gd, int tid) {
    const u32x4* b = (const u32x4*)base; const size_t n = bytes / 16, stride = (size_t)Gd * NTHREADS;
    u32x4 acc = {0u, 0u, 0u, 0u};
    for (size_t i = (size_t)cb * NTHREADS + tid; i < n; i += stride) { const u32x4 v = b[i]; acc.x ^= v.x; acc.y ^= v.y; acc.z ^= v.z; acc.w ^= v.w; }
    asm volatile("" :: "v"(acc.x), "v"(acc.y), "v"(acc.z), "v"(acc.w));
}
#define PH_BEGIN(i) unsigned long long t0_##i = 0; if ((PROBE_MASK >> (i)) & 1) t0_##i = __builtin_amdgcn_s_memrealtime();
#define PH_END(i) if ((PROBE_MASK >> (i)) & 1) probe_acc += __builtin_amdgcn_s_memrealtime() - t0_##i;
__global__ void __launch_bounds__(NTHREADS, 2) fwd(Params p) {
    extern __shared__ __attribute__((aligned(16))) unsigned char lds_raw[];
    LAS unsigned char* lds = (LAS unsigned char*)lds_raw;
    volatile LAS unsigned* MISC = (volatile LAS unsigned*)(lds + MISC_OFF);
    const int wave = __builtin_amdgcn_readfirstlane((int)threadIdx.x >> 6);
    const int nwb = NTHREADS / 64;
    const int gw = blockIdx.x * nwb + wave, NW = gridDim.x * nwb;
    const int Gd = gridDim.x, cb = blockIdx.x;
    unsigned char* ws = p.ws;
    bf16_t* WT_IN = (bf16_t*)(ws + WS_WT_IN); bf16_t* WT_GATE = (bf16_t*)(ws + WS_WT_GATE); bf16_t* WT_BR = (bf16_t*)(ws + WS_WT_BR);
    bf16_t* WT_O = (bf16_t*)(ws + WS_WT_O); bf16_t* WT_PQ = (bf16_t*)(ws + WS_WT_PQ); bf16_t* WT_MKV = (bf16_t*)(ws + WS_WT_MKV);
    bf16_t* KEYSB = (bf16_t*)(ws + WS_KEYSB); bf16_t* MEMN = (bf16_t*)(ws + WS_MEMN); bf16_t* MEMKV = (bf16_t*)(ws + WS_MEMKV);
    bf16_t* HO = (bf16_t*)(ws + WS_HO); bf16_t* PROJ = (bf16_t*)(ws + WS_PROJ); bf16_t* G = (bf16_t*)(ws + WS_G);
    bf16_t* MERGED = (bf16_t*)(ws + WS_MERGED); bf16_t* X2BF = (bf16_t*)(ws + WS_X2BF); bf16_t* QB = (bf16_t*)(ws + WS_Q);
        float* SS2 = (float*)(ws + WS_CTL + CTL_SS2_BYTE);
    if ((wave * 64 + fresh_lane()) < 64) MISC[(wave * 64 + fresh_lane())] = 0u;
    __syncthreads();
    XcdBarrier bar = xcd_barrier_post((unsigned*)(ws + WS_CTL + CTL_BAR_BYTE), MISC + 8, wave);
    if ((wave * 64 + fresh_lane()) == 0) MISC[16] = xb_add((unsigned*)(ws + WS_CTL + CTL_RANK_BYTE) + 64 * bar.x, 1u);

    unsigned long long probe_acc = 0;
    PH_BEGIN(0)
    {
        LAS float* scr = (LAS float*)lds + wave * (64 * 33);
        const int I0 = (D / 64) * (INW / 32), I1 = I0 + (D / 64) * (GW / 32), I2 = I1 + (D / 64) * (D / 32), I3 = I2 + (D / 64) * (D / 32), I4 = I3 + (D / 64) * (D / 32), I5 = I4 + (D / 64) * (2 * CW / 32);
#define TRJOB(it, jb, li) do { if ((it) < I0) { jb = TrJob{p.in[3], WT_IN, nullptr, D, INW, 0.f}; li = (it); } else if ((it) < I1) { jb = TrJob{p.in[18], WT_GATE, nullptr, D, GW, GATE_WSCALE}; li = (it) - I0; } \
            else if ((it) < I2) { jb = TrJob{p.in[20], WT_BR, nullptr, D, D, 0.f}; li = (it) - I1; } else if ((it) < I3) { jb = TrJob{p.in[21], WT_O, nullptr, D, D, 0.f}; li = (it) - I2; } \
            else if ((it) < I4) { jb = TrJob{p.in[23], WT_PQ, p.in[22], D, D, 0.f}; li = (it) - I3; } else { jb = TrJob{p.in[15], WT_MKV, nullptr, D, 2 * CW, 0.f}; li = (it) - I4; } } while (0)
        for (int it = gw; it < I5; it += 2 * NW) {
            TrJob ja, jb2; int la, lb; f32x4 va[8], vb[8];
            TRJOB(it, ja, la); tr_load(ja, la, fresh_lane(), va);
            const bool has2 = it + NW < I5;
            if (has2) { TRJOB(it + NW, jb2, lb); tr_load(jb2, lb, fresh_lane(), vb); }
            tr_store(ja, la, fresh_lane(), va, scr);
            if (has2) tr_store(jb2, lb, fresh_lane(), vb, scr);
        }
#undef TRJOB
        rms_rows(p.in[0], p.in[2], HO, ws + WS_H8, T, gw, NW, fresh_lane());
        rms_rows(p.in[1], p.in[14], MEMN, nullptr, BATCH * NMEM, gw, NW, fresh_lane());
        const float* keys = p.in[24];
        for (int i = gw * 64 + fresh_lane(); i < PH * 2 * NKEYS * 128 / 2; i += NW * 64) ((unsigned*)KEYSB)[i] = pk2(keys[2 * i], keys[2 * i + 1]);
    }
    xcd_barrier(bar);
    PH_END(0)
    PH_BEGIN(1)
    {
        SchedP1a Sa{(const char*)HO, (const char*)WT_IN, (const char*)MEMN, (const char*)WT_MKV, Gd, cb};
        EpiP1a Ea{PROJ, MEMKV, p.in[4], p.in[5], p.in[16], p.in[17], (LAS float*)(lds + RING_BYTES)};
        pg8::gemm_phase<false>(lds, D, D, Sa, Ea, wave);
    }
    xcd_barrier(bar);
    PH_END(1)
    PH_BEGIN(2)
    {
        const float qscale = 0.08838834764831845f;
        for (int u = gw; u < BATCH * NCH * 8; u += NW) { const int g = u % 8, c = (u / 8) % NCH, b = u / (8 * NCH); lru_pass1(p, b, c, g, fresh_lane(), lds + wave * 8192, u, NW); }
        if (NW != BATCH * NCH * 8) fp4_tables(p, gw, NW, fresh_lane());
    }
    xcd_barrier(bar);
    PH_END(2)
    PH_BEGIN(3)
    {
        const int nA = BATCH * 8 * (NCH / 4), nC = BATCH * 4 * (SEQ / 256);
        PH_BEGIN(9)
        for (int u = cb; u < nA + nC; u += Gd) {
            if (u < nA) {
                const int cg = u % (NCH / 4), h = (u / (NCH / 4)) % 8, b = u / ((NCH / 4) * 8);
                const size_t brow = (size_t)b * SEQ, qrow = brow + (size_t)cg * 256;
                att::attn_body<INW, INW, D, true>(PROJ + qrow * INW + C_QA + h * 128, PROJ + brow * INW + C_KA + h * 128, PROJ + brow * INW + C_VA + h * 128,
                                                  HO + qrow * D + h * 128, 12, cg * 4 - NPREV, p.in[6] + h * 257, (LAS char*)lds, wave);
            } else {
                const int v = u - nA; const int qb = v % (SEQ / 256), h = (v / (SEQ / 256)) % 4, b = v / ((SEQ / 256) * 4);
                const size_t qrow = (size_t)b * SEQ + (size_t)qb * 256;
                att::attn_body<INW, 2 * CW, D, false>(PROJ + qrow * INW + C_QC + h * 128, MEMKV + (size_t)b * NMEM * (2 * CW) + h * 128, MEMKV + (size_t)b * NMEM * (2 * CW) + CW + h * 128,
                                                     HO + qrow * D + AW + LW + h * 128, NMEM / 64, 0, nullptr, (LAS char*)lds, wave);
            }
        }
        PH_END(9)
        PH_BEGIN(10)
        for (int u = gw; u < BATCH * NCH * 8; u += NW) { const int g = u % 8, c = (u / 8) % NCH, b = u / (8 * NCH); lru_pass2(p, b, c, g, fresh_lane()); }
        touch_buffer(WT_BR, (size_t)D * D * 2, cb, Gd, (wave * 64 + fresh_lane())); touch_buffer(WT_O, (size_t)D * D * 2, cb, Gd, (wave * 64 + fresh_lane()));
        PH_END(10)
    }
    PH_BEGIN(4)
    {
        u32x4* slab = (u32x4*)(ws + WS_G) + (size_t)cb * (3 * 16 * 512);
#pragma unroll 1
        for (int ti = 0; ti * Gd < 64 * 8; ++ti) {
            { SchedG S{(const char*)(ws + WS_H8), (const char*)WT_GATE, Gd, cb, ti}; EpiG E{slab, p.in[19]};
              pg8::gemm_phase<true>(lds, D / 2, D / 2, S, E, wave); }
            if (ti == 0) { xcd_barrier(bar); PH_END(3) if ((PROBE_MASK >> 4) & 1) t0_4 = __builtin_amdgcn_s_memrealtime(); }
            { SchedP3 S{(const char*)HO, (const char*)WT_BR, Gd, cb, ti}; EpiP3 E{slab, MERGED};
              pg8::gemm_phase<false>(lds, D, D, S, E, wave); }
        }
    }
    xcd_barrier(bar);
    PH_END(4)
    PH_BEGIN(5)
    {
        SchedSq S{(const char*)MERGED, (const char*)WT_O, Gd, cb};
        EpiP4 E{p.in[0], p.out, X2BF, SS2, ws + WS_X2F8};
        pg8::gemm_phase<false>(lds, D, D, S, E, wave);
        touch_buffer(WT_PQ, (size_t)D * D * 2, cb, Gd, (wave * 64 + fresh_lane()));
    }
    xcd_barrier(bar);
    PH_END(5)
    PH_BEGIN(6)
    {
        SchedSq S{(const char*)X2BF, (const char*)WT_PQ, Gd, cb};
        EpiP5 E{QB, SS2};
        pg8::gemm_phase<false>(lds, D, D, S, E, wave);
    }
    xcd_barrier(bar);
    PH_END(6)
    PH_BEGIN(7)
    rt::route_phase(p, lds, wave);
    xcd_barrier(bar);
    PH_END(7)
    PH_BEGIN(8)
    int ppos, pnx, prank, pnloc;
    { if ((wave * 64 + fresh_lane()) == 0) { unsigned pos = 0, nx = 0; const unsigned* bw = (const unsigned*)(ws + WS_CTL + CTL_BAR_BYTE);
#pragma unroll
          for (unsigned j = 0; j < 16; ++j) { const unsigned cj = xb_ld((unsigned*)&bw[XB_XCNT(j)]); nx += cj > 0u ? 1u : 0u; pos += (cj > 0u && j < bar.x) ? 1u : 0u; }
          MISC[17] = pos; MISC[18] = nx > 0u ? nx : 1u; }
      __syncthreads();
      ppos = (int)MISC[17]; pnx = (int)MISC[18]; prank = (int)MISC[16]; pnloc = (int)MISC[8]; if (pnloc < 1) pnloc = 1; }
    peer_u_step(p, fresh_lane(), wave, lds + wave * 16384, ppos, pnx, prank, pnloc);
    xcd_barrier(bar);
    for (int t = gw; t < T; t += NW) peer_combine(p, t, fresh_lane());
    xcd_barrier(bar);
    peer_v_step(p, fresh_lane(), wave, lds + wave * 16384, ppos, pnx, prank, pnloc);
    if (PROBE_MASK) { __syncthreads(); PH_END(8) const unsigned long long te = __builtin_amdgcn_s_memrealtime(); while (__builtin_amdgcn_s_memrealtime() - te < probe_acc) __builtin_amdgcn_s_sleep(8); }
}

extern "C" void kernel_launch(void* const* d_in, const int* in_sizes, int n_in, void* d_out, int out_size, void* d_ws, size_t ws_size, hipStream_t stream) {
    static int grid = 0;
    if (grid == 0) {
        if (n_in != 27 || out_size != T * D || ws_size < WS_END) { fprintf(stderr, "kernel_launch: unexpected problem (n_in %d out %d ws %zu)\n", n_in, out_size, ws_size); grid = -1; return; }
        int dev = 0, cus = 0, per_cu = 0;
        (void)hipGetDevice(&dev); (void)hipDeviceGetAttribute(&cus, hipDeviceAttributeMultiprocessorCount, dev);
        if (hipFuncSetAttribute((const void*)fwd, hipFuncAttributeMaxDynamicSharedMemorySize, LDS_BYTES) != hipSuccess) { fprintf(stderr, "kernel_launch: hipFuncSetAttribute failed\n"); grid = -1; return; }
        (void)hipOccupancyMaxActiveBlocksPerMultiprocessor(&per_cu, (const void*)fwd, NTHREADS, LDS_BYTES);
        if (per_cu < 1) { fprintf(stderr, "kernel_launch: occupancy query says %d\n", per_cu); grid = -1; return; }
        grid = cus;
    }
    if (grid < 0) return;
    (void)hipMemsetAsync((char*)d_ws + WS_CTL, 0, 1 * MiB, stream);
    Params p{};
    for (int i = 0; i < 27; ++i) p.in[i] = (const float*)d_in[i];
    p.out = (float*)d_out; p.ws = (unsigned char*)d_ws;
    void* args[] = {&p};
    hipError_t e = hipLaunchCooperativeKernel((const void*)fwd, dim3(grid), dim3(NTHREADS), args, LDS_BYTES, stream);
    if (e != hipSuccess) fprintf(stderr, "cooperative launch failed: %s (grid %d)\n", hipGetErrorString(e), grid);
}
```

```cpp
#include <hip/hip_runtime.h>
#include <hip/hip_cooperative_groups.h>
#include <cstdio>
#include <cstdint>
namespace cg = cooperative_groups;
#ifndef PROBE_MASK
#define PROBE_MASK 0
#endif

#define LAS __attribute__((address_space(3)))
typedef unsigned short bf16_t;
typedef short bf16x8 __attribute__((ext_vector_type(8)));
typedef float f32x4 __attribute__((ext_vector_type(4)));
typedef unsigned u32x4 __attribute__((ext_vector_type(4)));
typedef unsigned u32x2 __attribute__((ext_vector_type(2)));

constexpr int D = 2048, BATCH = 2, SEQ = 8192, T = BATCH * SEQ;
constexpr int CHUNK = 64, NPREV = 8, NCH = SEQ / CHUNK;
constexpr int AW = 1024, LW = 512, CW = 512, INW = 4608, GW = 6144;
constexpr int NMEM = 256;
constexpr int PH = 8, NKEYS = 128, TOPK = 16;
constexpr float EPS = 1e-6f;
constexpr int C_QA = 0, C_KA = 1024, C_VA = 2048, C_XL = 3072, C_GL = 3584, C_QC = 4096;

constexpr size_t MiB = 1u << 20;
constexpr size_t WS_CTL = 0;
constexpr size_t WS_WT_IN = 2 * MiB, WS_WT_GATE = 20 * MiB, WS_WT_BR = 44 * MiB, WS_WT_O = 52 * MiB, WS_WT_PQ = 60 * MiB, WS_WT_MKV = 68 * MiB;
constexpr size_t WS_KEYSB = 72 * MiB, WS_MEMN = 73 * MiB, WS_MEMKV = 75 * MiB, WS_LRUSUM = 76 * MiB, WS_RS2 = 77 * MiB;
constexpr size_t WS_HO = 80 * MiB;
constexpr size_t WS_PROJ = 144 * MiB;
constexpr size_t WS_MERGED = 144 * MiB, WS_X2BF = 208 * MiB;
constexpr size_t WS_G = 288 * MiB;
constexpr size_t WS_TABU = 496 * MiB, WS_TABV = 512 * MiB, WS_Q = 416 * MiB;
constexpr size_t WS_SCU = 77 * MiB, WS_SCV = 77 * MiB + 65536;
constexpr size_t WS_AUA = 2 * MiB, WS_AUU = 416 * MiB;
constexpr size_t WS_H8 = 384 * MiB;
constexpr float GATE_WSCALE = 256.f, NLOG2E = -1.4426950408889634f;
constexpr size_t CTL_BG2_BYTE = 768 * 1024;
constexpr size_t WS_RIDX = 480 * MiB, WS_RG = 488 * MiB, WS_END = 528 * MiB;

constexpr size_t CTL_BAR_BYTE = 16384, CTL_RANK_BYTE = 65536, CTL_SS2_BYTE = 512 * 1024;
struct Params { const float* in[27]; float* out; unsigned char* ws; };

__device__ __forceinline__ int fresh_lane() { int l; asm volatile("v_mbcnt_lo_u32_b32 %0, -1, 0\n\tv_mbcnt_hi_u32_b32 %0, -1, %0" : "=v"(l)); return l; }
__device__ __forceinline__ float bf2f(unsigned v16) { return __uint_as_float(v16 << 16); }
typedef float f32x2c __attribute__((ext_vector_type(2))); typedef __bf16 bf16x2c __attribute__((ext_vector_type(2)));
__device__ __forceinline__ unsigned pk2(float lo, float hi) { const f32x2c v = {lo, hi}; return __builtin_bit_cast(unsigned, __builtin_convertvector(v, bf16x2c)); }
__device__ __forceinline__ unsigned f2bf(float f) { return pk2(f, 0.f) & 0xffffu; }
__device__ __forceinline__ float wave_sum(float v) {
#pragma unroll
    for (int o = 1; o < 64; o <<= 1) v += __shfl_xor(v, o);
    return v;
}
typedef __bf16 bf16x2_t __attribute__((ext_vector_type(2)));
__device__ __forceinline__ float dot2bf(unsigned w, unsigned x, float acc) { return __builtin_amdgcn_fdot2_f32_bf16(__builtin_bit_cast(bf16x2_t, w), __builtin_bit_cast(bf16x2_t, x), acc, false); }
__device__ __forceinline__ float sigmoid_(float x) { return 1.f / (1.f + __expf(-x)); }
__device__ __forceinline__ float gelu_tanh(float x) { const float y = 1.5957691216f * (x + 0.044715f * x * x * x); return x / (1.f + __expf(-y)); }
__device__ __forceinline__ void unpack8(const u32x4 w, float* f) {
    f[0] = __uint_as_float(w.x << 16); f[1] = __uint_as_float(w.x & 0xffff0000u);
    f[2] = __uint_as_float(w.y << 16); f[3] = __uint_as_float(w.y & 0xffff0000u);
    f[4] = __uint_as_float(w.z << 16); f[5] = __uint_as_float(w.z & 0xffff0000u);
    f[6] = __uint_as_float(w.w << 16); f[7] = __uint_as_float(w.w & 0xffff0000u);
}

struct TrJob { const float* W; bf16_t* WT; const float* ks; int K, N; float f8scale; };
__device__ __forceinline__ void tr_load(const TrJob& jb, int item, int lane, f32x4 (&v)[8]) {
    const int nblk = jb.N / 32, kb = item / nblk, nb = item % nblk, k0 = 64 * kb, n0 = 32 * nb;
#pragma unroll
    for (int i = 0; i < 8; ++i) { const int kk = 8 * i + (lane >> 3); v[i] = *(const f32x4*)(jb.W + (size_t)(k0 + kk) * jb.N + n0 + 4 * (lane & 7)); if (jb.ks) v[i] = v[i] * jb.ks[k0 + kk]; }
}
__device__ __forceinline__ void tr_store(const TrJob& jb, int item, int lane, const f32x4 (&v)[8], LAS float* scr) {
    const int nblk = jb.N / 32, kb = item / nblk, nb = item % nblk, k0 = 64 * kb, n0 = 32 * nb;
#pragma unroll
    for (int i = 0; i < 8; ++i) { LAS float* d = scr + (8 * i + (lane >> 3)) * 33 + 4 * (lane & 7); d[0] = v[i].x; d[1] = v[i].y; d[2] = v[i].z; d[3] = v[i].w; }
    asm volatile("s_waitcnt lgkmcnt(0)" ::: "memory");
    const int c = lane & 7;
#pragma unroll
    for (int j = 0; j < 4; ++j) { const int n = (lane >> 3) + 8 * j; const LAS float* s = scr + (8 * c) * 33 + n;
        if (jb.f8scale != 0.f) { const float f = jb.f8scale; u32x2 o;
#define F8C(x_) fminf(fmaxf((x_) * f, -448.f), 448.f)
            int w = __builtin_amdgcn_cvt_pk_fp8_f32(F8C(s[0 * 33]), F8C(s[1 * 33]), 0, false); w = __builtin_amdgcn_cvt_pk_fp8_f32(F8C(s[2 * 33]), F8C(s[3 * 33]), w, true); o.x = (unsigned)w;
            w = __builtin_amdgcn_cvt_pk_fp8_f32(F8C(s[4 * 33]), F8C(s[5 * 33]), 0, false); w = __builtin_amdgcn_cvt_pk_fp8_f32(F8C(s[6 * 33]), F8C(s[7 * 33]), w, true); o.y = (unsigned)w;
#undef F8C
            *(u32x2*)((unsigned char*)jb.WT + (size_t)(n0 + n) * jb.K + k0 + 8 * c) = o; }
        else { u32x4 o; o.x = pk2(s[0 * 33], s[1 * 33]); o.y = pk2(s[2 * 33], s[3 * 33]); o.z = pk2(s[4 * 33], s[5 * 33]); o.w = pk2(s[6 * 33], s[7 * 33]);
            *(u32x4*)(jb.WT + (size_t)(n0 + n) * jb.K + k0 + 8 * c) = o; } }
    asm volatile("s_waitcnt lgkmcnt(0)" ::: "memory");
}
__device__ __forceinline__ void rms_row_load(const float* xrow, int lane, f32x4 (&v)[8]) {
    const f32x4* xr = (const f32x4*)xrow + lane;
#pragma unroll
    for (int j = 0; j < 8; ++j) v[j] = xr[64 * j];
}
__device__ __forceinline__ void rms_row_finish(const f32x4 (&v)[8], const float* g, bf16_t* orow, unsigned char* o8row, int lane) {
    const f32x4* gr = (const f32x4*)g + lane; float s = 0.f;
#pragma unroll
    for (int j = 0; j < 8; ++j) s += (v[j].x * v[j].x + v[j].y * v[j].y) + (v[j].z * v[j].z + v[j].w * v[j].w);
    const float rstd = rsqrtf(wave_sum(s) * (1.f / D) + EPS);
    u32x2* o8 = (u32x2*)orow + lane;
#pragma unroll
    for (int j = 0; j < 8; ++j) { const f32x4 gg = gr[64 * j]; const float a0 = v[j].x * rstd * gg.x, a1 = v[j].y * rstd * gg.y, a2 = v[j].z * rstd * gg.z, a3 = v[j].w * rstd * gg.w;
        u32x2 o; o.x = pk2(a0, a1); o.y = pk2(a2, a3); o8[64 * j] = o;
        if (o8row) { int w = __builtin_amdgcn_cvt_pk_fp8_f32(fminf(fmaxf(a0, -448.f), 448.f), fminf(fmaxf(a1, -448.f), 448.f), 0, false);
            w = __builtin_amdgcn_cvt_pk_fp8_f32(fminf(fmaxf(a2, -448.f), 448.f), fminf(fmaxf(a3, -448.f), 448.f), w, true); ((unsigned*)o8row)[64 * j + lane] = (unsigned)w; } }
}
__device__ __forceinline__ void rms_rows(const float* X, const float* g, bf16_t* O, unsigned char* O8, int nrows, int gw, int NW, int lane) {
    f32x4 va[8], vb[8];
    int m = gw;
    if (m < nrows) rms_row_load(X + (size_t)m * D, lane, va);
    for (; m < nrows; m += 2 * NW) {
        const bool hb = m + NW < nrows;
        if (hb) rms_row_load(X + (size_t)(m + NW) * D, lane, vb);
        rms_row_finish(va, g, O + (size_t)m * D, O8 ? O8 + (size_t)m * D : nullptr, lane);
        if (m + 2 * NW < nrows) rms_row_load(X + (size_t)(m + 2 * NW) * D, lane, va);
        if (hb) rms_row_finish(vb, g, O + (size_t)(m + NW) * D, O8 ? O8 + (size_t)(m + NW) * D : nullptr, lane);
    }
}

template <int TM, int TN, class Epi>
__device__ __forceinline__ void gemm_simple(const bf16_t* __restrict__ A, int lda, const bf16_t* __restrict__ Bt, int ldb, int M, int N, int K, const Epi& epi, int gw, int NW, int lane) {
    const int r = lane & 15, q = lane >> 4;
    const int ntm = M / (16 * TM), ntn = N / (16 * TN);
    for (int tile = gw; tile < ntm * ntn; tile += NW) {
        const int tm = tile / ntn, tn = tile % ntn;
        f32x4 acc[TM][TN];
#pragma unroll
        for (int i = 0; i < TM; ++i)
#pragma unroll
            for (int j = 0; j < TN; ++j) acc[i][j] = (f32x4){0.f, 0.f, 0.f, 0.f};
        const bf16_t* ap = A + (size_t)(tm * 16 * TM + r) * lda + q * 8;
        const bf16_t* bp = Bt + (size_t)(tn * 16 * TN + r) * ldb + q * 8;
        for (int k0 = 0; k0 < K; k0 += 32) {
            bf16x8 af[TM], bfr[TN];
#pragma unroll
            for (int i = 0; i < TM; ++i) af[i] = *(const bf16x8*)(ap + (size_t)i * 16 * lda + k0);
#pragma unroll
            for (int j = 0; j < TN; ++j) bfr[j] = *(const bf16x8*)(bp + (size_t)j * 16 * ldb + k0);
#pragma unroll
            for (int i = 0; i < TM; ++i)
#pragma unroll
                for (int j = 0; j < TN; ++j) acc[i][j] = __builtin_amdgcn_mfma_f32_16x16x32_bf16(af[i], bfr[j], acc[i][j], 0, 0, 0);
        }
#pragma unroll
        for (int i = 0; i < TM; ++i)
#pragma unroll
            for (int j = 0; j < TN; ++j)
#pragma unroll
                for (int e = 0; e < 4; ++e) epi(tm * 16 * TM + i * 16 + q * 4 + e, tn * 16 * TN + j * 16 + r, acc[i][j][e]);
    }
}
struct EpiProj { bf16_t* P; __device__ __forceinline__ void operator()(int row, int col, float v) const { if (col >= C_GL && col < C_QC) v = gelu_tanh(v); P[(size_t)row * INW + col] = (bf16_t)f2bf(v); } };
struct EpiGate { bf16_t* G; const float* b; __device__ __forceinline__ void operator()(int row, int col, float v) const { G[(size_t)row * GW + col] = (bf16_t)f2bf(sigmoid_(v + b[col])); } };
struct EpiStore { bf16_t* C; int ldc; __device__ __forceinline__ void operator()(int row, int col, float v) const { C[(size_t)row * ldc + col] = (bf16_t)f2bf(v); } };
struct EpiWo { const float* x; float* out; bf16_t* xb; __device__ __forceinline__ void operator()(int row, int col, float v) const { const size_t o = (size_t)row * D + col; const float y = x[o] + v; out[o] = y; xb[o] = (bf16_t)f2bf(y); } };
struct EpiQ { bf16_t* Q; const float* rs; __device__ __forceinline__ void operator()(int row, int col, float v) const { Q[(size_t)row * D + col] = (bf16_t)f2bf(v * rs[row]); } };

__device__ __forceinline__ void headnorm(bf16_t* vec, const float* g, float scale, int lane) {
    unsigned* p = (unsigned*)vec + lane; const unsigned w = *p;
    const float a = bf2f(w & 0xffffu), b = bf2f(w >> 16);
    const float rs = rsqrtf(wave_sum(a * a + b * b) * (1.f / 128.f) + EPS) * scale;
    *p = pk2(a * rs * g[2 * lane], b * rs * g[2 * lane + 1]);
}
struct HeadGains { float gq[32], gk[32], gc[8]; };
__device__ __forceinline__ void load_head_gains(HeadGains& hg, const float* gq, const float* gk, const float* gc, int lane) {
#pragma unroll
    for (int j = 0; j < 32; ++j) { hg.gq[j] = gq[(lane & 3) * 32 + j]; hg.gk[j] = gk[(lane & 3) * 32 + j]; }
#pragma unroll
    for (int j = 0; j < 8; ++j) hg.gc[j] = gc[(lane & 15) * 8 + j];
}
__device__ __forceinline__ void headnorm_token(bf16_t* row, const HeadGains& hg, float qscale, int lane) {
    u32x4* pa = (u32x4*)(row + C_QA) + lane * 4;
    u32x4* pc = (u32x4*)(row + C_QC) + lane;
    u32x4 w[4]; const u32x4 wc = *pc;
#pragma unroll
    for (int j = 0; j < 4; ++j) w[j] = pa[j];
    float f[32], fc[8]; float ss = 0.f, sc = 0.f;
#pragma unroll
    for (int j = 0; j < 4; ++j) unpack8(w[j], f + 8 * j);
    unpack8(wc, fc);
#pragma unroll
    for (int j = 0; j < 32; ++j) ss = fmaf(f[j], f[j], ss);
#pragma unroll
    for (int j = 0; j < 8; ++j) sc = fmaf(fc[j], fc[j], sc);
    ss += __shfl_xor(ss, 1); ss += __shfl_xor(ss, 2);
    sc += __shfl_xor(sc, 1); sc += __shfl_xor(sc, 2); sc += __shfl_xor(sc, 4); sc += __shfl_xor(sc, 8);
    const bool isq = lane < 32;
    const float rs = rsqrtf(ss * (1.f / 128.f) + EPS) * (isq ? qscale : 1.f), rc = rsqrtf(sc * (1.f / 128.f) + EPS) * qscale;
#pragma unroll
    for (int j = 0; j < 4; ++j) { u32x4 o;
        o.x = pk2(f[8 * j] * rs * (isq ? hg.gq[8 * j] : hg.gk[8 * j]), f[8 * j + 1] * rs * (isq ? hg.gq[8 * j + 1] : hg.gk[8 * j + 1]));
        o.y = pk2(f[8 * j + 2] * rs * (isq ? hg.gq[8 * j + 2] : hg.gk[8 * j + 2]), f[8 * j + 3] * rs * (isq ? hg.gq[8 * j + 3] : hg.gk[8 * j + 3]));
        o.z = pk2(f[8 * j + 4] * rs * (isq ? hg.gq[8 * j + 4] : hg.gk[8 * j + 4]), f[8 * j + 5] * rs * (isq ? hg.gq[8 * j + 5] : hg.gk[8 * j + 5]));
        o.w = pk2(f[8 * j + 6] * rs * (isq ? hg.gq[8 * j + 6] : hg.gk[8 * j + 6]), f[8 * j + 7] * rs * (isq ? hg.gq[8 * j + 7] : hg.gk[8 * j + 7]));
        pa[j] = o; }
    { u32x4 o; o.x = pk2(fc[0] * rc * hg.gc[0], fc[1] * rc * hg.gc[1]); o.y = pk2(fc[2] * rc * hg.gc[2], fc[3] * rc * hg.gc[3]);
      o.z = pk2(fc[4] * rc * hg.gc[4], fc[5] * rc * hg.gc[5]); o.w = pk2(fc[6] * rc * hg.gc[6], fc[7] * rc * hg.gc[7]); *pc = o; }
}

__device__ __forceinline__ void fp4_row_load(const float* __restrict__ src, const float* __restrict__ kscale, int lane, f32x4 (&v)[8]);
__device__ __forceinline__ void fp4_row_finish(const f32x4 (&v)[8], unsigned char* __restrict__ tab, int e, float* __restrict__ scale_out, int lane);
__device__ __forceinline__ void lru_pass1(const Params& p, int b, int c, int g, int lane, LAS unsigned char* wl  , const int tr0, const int trs) {
    const bf16_t* PROJ = (const bf16_t*)(p.ws + WS_PROJ);
    float* SUMA = (float*)(p.ws + WS_LRUSUM); float* SUMB = SUMA + BATCH * NCH * LW;
    bf16_t* AUA = (bf16_t*)(p.ws + WS_AUA); bf16_t* AUU = (bf16_t*)(p.ws + WS_AUU);
    const float* conv_w = p.in[7]; const float* conv_b = p.in[8]; const float* lru_wa = p.in[9]; const float* lru_ba = p.in[10];
    const float* lru_wx = p.in[11]; const float* lru_bx = p.in[12]; const float* lam = p.in[13];
    const int ch = g * 64 + lane;
    unsigned wa_p[32], wx_p[32];
#pragma unroll
    for (int m = 0; m < 32; ++m) { wa_p[m] = pk2(lru_wa[(size_t)(g * 64 + 2 * m) * 64 + lane], lru_wa[(size_t)(g * 64 + 2 * m + 1) * 64 + lane]);
        wx_p[m] = pk2(lru_wx[(size_t)(g * 64 + 2 * m) * 64 + lane], lru_wx[(size_t)(g * 64 + 2 * m + 1) * 64 + lane]); }
    const float cw0 = conv_w[0 * LW + ch], cw1 = conv_w[1 * LW + ch], cw2 = conv_w[2 * LW + ch], cw3 = conv_w[3 * LW + ch], cb = conv_b[ch];
    const float ba_ = lru_ba[ch], bx_ = lru_bx[ch];
    const float sp = log1pf(__expf(-lam[ch]));
    const int t0 = c * CHUNK; const size_t row0 = (size_t)b * SEQ + t0;
    float x0 = 0.f, x1 = 0.f, x2 = 0.f;
    if (t0 >= 3) { x0 = bf2f(PROJ[(row0 - 3) * INW + C_XL + ch]); x1 = bf2f(PROJ[(row0 - 2) * INW + C_XL + ch]); x2 = bf2f(PROJ[(row0 - 1) * INW + C_XL + ch]); }
    { const bf16_t* xs = PROJ + (row0 + (lane >> 3)) * INW + C_XL + g * 64 + (lane & 7) * 8;
      u32x4 tx[8];
#pragma unroll
      for (int i = 0; i < 8; ++i) tx[i] = *(const u32x4*)(xs + (size_t)(8 * i) * INW);
#pragma unroll
      for (int i = 0; i < 8; ++i) *(LAS u32x4*)(wl + (8 * i + (lane >> 3)) * 128 + (lane & 7) * 16) = tx[i]; }
    float h = 0.f, aprod = 1.f;
#define LRU_PAIRX(xc_) ({ const float xnb_ = __int_as_float(__builtin_amdgcn_update_dpp(0, __float_as_int(xc_), 0xB1, 0xf, 0xf, true));     \
        (lane & 1) ? pk2(xnb_, xc_) : pk2(xc_, xnb_); })
#define LRU_GATE(rp_, ip_, xc_, a_, u_) do { const float r_ = sigmoid_(rp_), ig_ = sigmoid_(ip_); const float la_ = -8.f * r_ * sp; a_ = __expf(la_); \
        u_ = sqrtf(fminf(fmaxf((1.f - a_) * (1.f + a_), 1e-12f), 1.f)) * ig_ * xc_; } while (0)
#define LRU_TOKPAIR(tp_) do { const int t_ = (tp_);                           \
        const float x3 = bf2f(*(const LAS bf16_t*)(wl + t_ * 128 + lane * 2)), x4 = bf2f(*(const LAS bf16_t*)(wl + (t_ + 1) * 128 + lane * 2)); \
        const float xcA = cw0 * x0 + cw1 * x1 + cw2 * x2 + cw3 * x3 + cb, xcB = cw0 * x1 + cw1 * x2 + cw2 * x3 + cw3 * x4 + cb; \
        x0 = x2; x1 = x3; x2 = x4; \
        const unsigned pkA = LRU_PAIRX(xcA), pkB = LRU_PAIRX(xcB); \
        float rA = ba_, iA = bx_, rA2 = 0.f, iA2 = 0.f, rB = ba_, iB = bx_, rB2 = 0.f, iB2 = 0.f; \
_Pragma("unroll") \
        for (int m = 0; m < 32; m += 2) { \
            const unsigned a0 = (unsigned)__builtin_amdgcn_readlane((int)pkA, 2 * m), a1 = (unsigned)__builtin_amdgcn_readlane((int)pkA, 2 * m + 2); \
            const unsigned b0 = (unsigned)__builtin_amdgcn_readlane((int)pkB, 2 * m), b1 = (unsigned)__builtin_amdgcn_readlane((int)pkB, 2 * m + 2); \
            rA = dot2bf(wa_p[m], a0, rA); iA = dot2bf(wx_p[m], a0, iA); rA2 = dot2bf(wa_p[m + 1], a1, rA2); iA2 = dot2bf(wx_p[m + 1], a1, iA2); \
            rB = dot2bf(wa_p[m], b0, rB); iB = dot2bf(wx_p[m], b0, iB); rB2 = dot2bf(wa_p[m + 1], b1, rB2); iB2 = dot2bf(wx_p[m + 1], b1, iB2); } \
        float aA, uA, aB, uB; \
        LRU_GATE(rA + rA2, iA + iA2, xcA, aA, uA); LRU_GATE(rB + rB2, iB + iB2, xcB, aB, uB); \
        \
        const unsigned wA = f2bf(1.f - aA), wB = f2bf(1.f - aB), vA = f2bf(uA), vB = f2bf(uB); \
        AUA[(row0 + t_) * LW + ch] = (bf16_t)wA; AUA[(row0 + t_ + 1) * LW + ch] = (bf16_t)wB; AUU[(row0 + t_) * LW + ch] = (bf16_t)vA; AUU[(row0 + t_ + 1) * LW + ch] = (bf16_t)vB; \
        const float aAq = 1.f - bf2f(wA), aBq = 1.f - bf2f(wB); \
        h = aBq * (aAq * h + bf2f(vA)) + bf2f(vB); \
        aprod *= aAq * aBq; \
    } while (0)
#define SIDE_LOAD(r_, v_) do { if ((r_) < 16384) fp4_row_load(p.in[25] + (size_t)(r_) * D, p.in[22], lane, v_); else if ((r_) < 32768) fp4_row_load(p.in[26] + (size_t)((r_) - 16384) * D, nullptr, lane, v_); } while (0)
#define SIDE_FIN(r_, v_) do { if ((r_) < 16384) fp4_row_finish(v_, p.ws + WS_TABU, (r_), (float*)(p.ws + WS_SCU) + (r_), lane); \
        else if ((r_) < 32768) fp4_row_finish(v_, p.ws + WS_TABV, (r_) - 16384, (float*)(p.ws + WS_SCV) + ((r_) - 16384), lane); } while (0)
    f32x4 sva[8]; int sr = tr0;
    SIDE_LOAD(sr, sva);
#pragma unroll 1
    for (int tt = 0; tt < CHUNK; tt += 4) {
        LRU_TOKPAIR(tt);
        SIDE_FIN(sr, sva); SIDE_LOAD(sr + trs, sva);
        LRU_TOKPAIR(tt + 2);
        sr += trs;
    }
#undef LRU_TOKPAIR
#undef SIDE_LOAD
#undef SIDE_FIN
#undef LRU_PAIRX
#undef LRU_GATE
    { const size_t o = (size_t)(b * NCH + c) * LW + ch; SUMA[o] = aprod; SUMB[o] = h; }
}
__device__ __forceinline__ void lru_pass2(const Params& p, int b, int c, int g, int lane) {
    const bf16_t* PROJ = (const bf16_t*)(p.ws + WS_PROJ); bf16_t* O = (bf16_t*)(p.ws + WS_HO);
    const float* SUMA = (const float*)(p.ws + WS_LRUSUM); const float* SUMB = SUMA + BATCH * NCH * LW;
    const bf16_t* AUA = (const bf16_t*)(p.ws + WS_AUA); const bf16_t* AUU = (const bf16_t*)(p.ws + WS_AUU);
    const int ch = g * 64 + lane; const size_t row0 = (size_t)b * SEQ + (size_t)c * CHUNK;
    const bf16_t* ap = AUA + row0 * LW + ch; const bf16_t* up = AUU + row0 * LW + ch; const bf16_t* gp = PROJ + row0 * INW + C_GL + ch;
    bf16_t an[16], un[16], gn[16];
#pragma unroll
    for (int q = 0; q < 16; ++q) { an[q] = ap[(size_t)q * LW]; un[q] = up[(size_t)q * LW]; gn[q] = gp[(size_t)q * INW]; }
    float h = 0.f;
    {
        int j = 0;
#pragma unroll 1
        for (; j + 32 <= c; j += 32) { float sa[32], sb[32];
#pragma unroll
            for (int q = 0; q < 32; ++q) { const size_t o = (size_t)(b * NCH + j + q) * LW + ch; sa[q] = SUMA[o]; sb[q] = SUMB[o]; }
#pragma unroll
            for (int q = 0; q < 32; ++q) h = sa[q] * h + sb[q]; }
#pragma unroll 1
        for (; j + 8 <= c; j += 8) { float sa[8], sb[8];
#pragma unroll
            for (int q = 0; q < 8; ++q) { const size_t o = (size_t)(b * NCH + j + q) * LW + ch; sa[q] = SUMA[o]; sb[q] = SUMB[o]; }
#pragma unroll
            for (int q = 0; q < 8; ++q) h = sa[q] * h + sb[q]; }
        for (; j < c; ++j) { const size_t o = (size_t)(b * NCH + j) * LW + ch; h = SUMA[o] * h + SUMB[o]; }
    }
#pragma unroll 1
    for (int tb = 0; tb < CHUNK; tb += 16) {
        bf16_t ac[16], uc[16], gc[16];
#pragma unroll
        for (int q = 0; q < 16; ++q) { ac[q] = an[q]; uc[q] = un[q]; gc[q] = gn[q]; }
        if (tb + 16 < CHUNK) {
#pragma unroll
            for (int q = 0; q < 16; ++q) { an[q] = ap[(size_t)(tb + 16 + q) * LW]; un[q] = up[(size_t)(tb + 16 + q) * LW]; gn[q] = gp[(size_t)(tb + 16 + q) * INW]; }
        }
#pragma unroll
        for (int q = 0; q < 16; ++q) { h = (1.f - bf2f(ac[q])) * h + bf2f(uc[q]); O[(row0 + tb + q) * D + AW + ch] = (bf16_t)f2bf(h * bf2f(gc[q])); }
    }
}

__device__ __forceinline__ void attn_simple(const bf16_t* Qp, int ldq, const bf16_t* Kp, const bf16_t* Vp, int ldkv, int nkeys, int koff, const float* bias_h, bf16_t* Op, int ldo, int tid) {
    const int qi = tid >> 2, part = tid & 3;
    float q[32], o[32];
    { const u32x4* qp = (const u32x4*)(Qp + (size_t)qi * ldq + part * 32);
#pragma unroll
      for (int j = 0; j < 4; ++j) unpack8(qp[j], q + 8 * j); }
#pragma unroll
    for (int d = 0; d < 32; ++d) o[d] = 0.f;
    float m = -1e30f, l = 0.f;
    for (int kk0 = 0; kk0 < nkeys; kk0 += 8) {
        float s[8];
#pragma unroll
        for (int j = 0; j < 8; ++j) {
            const u32x4* kp = (const u32x4*)(Kp + (size_t)(kk0 + j) * ldkv + part * 32);
            float acc = 0.f;
#pragma unroll
            for (int w = 0; w < 4; ++w) { float kf[8]; unpack8(kp[w], kf);
#pragma unroll
                for (int e = 0; e < 8; ++e) acc = fmaf(q[8 * w + e], kf[e], acc); }
            acc += __shfl_xor(acc, 1); acc += __shfl_xor(acc, 2);
            if (bias_h) { int dist = qi + koff - (kk0 + j); dist = dist < -128 ? -128 : (dist > 128 ? 128 : dist); acc += bias_h[dist + 128]; }
            s[j] = acc;
        }
        float mx = s[0];
#pragma unroll
        for (int j = 1; j < 8; ++j) mx = fmaxf(mx, s[j]);
        const float mn = fmaxf(m, mx), corr = __expf(m - mn);
        l *= corr;
#pragma unroll
        for (int d = 0; d < 32; ++d) o[d] *= corr;
#pragma unroll
        for (int j = 0; j < 8; ++j) {
            const float pj = __expf(s[j] - mn); l += pj;
            const u32x4* vp = (const u32x4*)(Vp + (size_t)(kk0 + j) * ldkv + part * 32);
#pragma unroll
            for (int w = 0; w < 4; ++w) { float vf[8]; unpack8(vp[w], vf);
#pragma unroll
                for (int e = 0; e < 8; ++e) o[8 * w + e] = fmaf(pj, vf[e], o[8 * w + e]); }
        }
        m = mn;
    }
    const float inv = 1.f / l;
    u32x4* op = (u32x4*)(Op + (size_t)qi * ldo + part * 32);
#pragma unroll
    for (int w = 0; w < 4; ++w) { u32x4 ov; ov.x = pk2(o[8 * w] * inv, o[8 * w + 1] * inv); ov.y = pk2(o[8 * w + 2] * inv, o[8 * w + 3] * inv); ov.z = pk2(o[8 * w + 4] * inv, o[8 * w + 5] * inv); ov.w = pk2(o[8 * w + 6] * inv, o[8 * w + 7] * inv); op[w] = ov; }
}

__device__ __forceinline__ void gemm_branch(const bf16_t* __restrict__ Ob, const bf16_t* __restrict__ WT, const bf16_t* __restrict__ G, bf16_t* __restrict__ Mg, int gw, int NW, int lane) {
    const int r = lane & 15, q = lane >> 4;
    const int ntn = D / 32, ntiles = (T / 32) * ntn;
    for (int tile = gw; tile < ntiles; tile += NW) {
        const int tm = tile / ntn, tn = tile % ntn;
        f32x4 acc[3][2][2];
#pragma unroll
        for (int s = 0; s < 3; ++s)
#pragma unroll
            for (int i = 0; i < 2; ++i)
#pragma unroll
                for (int j = 0; j < 2; ++j) acc[s][i][j] = (f32x4){0.f, 0.f, 0.f, 0.f};
        const bf16_t* ap = Ob + (size_t)(tm * 32 + r) * D + q * 8;
        const bf16_t* bp = WT + (size_t)(tn * 32 + r) * D + q * 8;
#pragma unroll
        for (int s = 0; s < 3; ++s) {
            const int kb = s == 0 ? 0 : (s == 1 ? 1024 : 1536), ke = s == 0 ? 1024 : (s == 1 ? 1536 : 2048);
            for (int k0 = kb; k0 < ke; k0 += 32) {
                bf16x8 af[2], bfr[2];
#pragma unroll
                for (int i = 0; i < 2; ++i) af[i] = *(const bf16x8*)(ap + (size_t)i * 16 * D + k0);
#pragma unroll
                for (int j = 0; j < 2; ++j) bfr[j] = *(const bf16x8*)(bp + (size_t)j * 16 * D + k0);
#pragma unroll
                for (int i = 0; i < 2; ++i)
#pragma unroll
                    for (int j = 0; j < 2; ++j) acc[s][i][j] = __builtin_amdgcn_mfma_f32_16x16x32_bf16(af[i], bfr[j], acc[s][i][j], 0, 0, 0);
            }
        }
#pragma unroll
        for (int i = 0; i < 2; ++i)
#pragma unroll
            for (int j = 0; j < 2; ++j)
#pragma unroll
                for (int e = 0; e < 4; ++e) {
                    const int row = tm * 32 + i * 16 + q * 4 + e, col = tn * 32 + j * 16 + r;
                    const bf16_t* gp = G + (size_t)row * GW + col;
                    const float mval = bf2f(gp[0]) * acc[0][i][j][e] + bf2f(gp[2048]) * acc[1][i][j][e] + bf2f(gp[4096]) * acc[2][i][j][e];
                    Mg[(size_t)row * D + col] = (bf16_t)f2bf(mval);
                }
    }
}

__device__ __forceinline__ unsigned long long shfl_xor64(unsigned long long v, int m) {
    const unsigned lo = __shfl_xor((unsigned)v, m), hi = __shfl_xor((unsigned)(v >> 32), m);
    return ((unsigned long long)hi << 32) | lo;
}
__device__ __forceinline__ unsigned fkey(float f) { const unsigned u = __float_as_uint(f); return (u & 0x80000000u) ? ~u : (u | 0x80000000u); }
__device__ __forceinline__ float fkey_inv(unsigned k) { const unsigned u = (k & 0x80000000u) ? (k & 0x7fffffffu) : ~k; return __uint_as_float(u); }
__device__ __forceinline__ unsigned long long wave_max64(unsigned long long k) {
#pragma unroll
    for (int o = 1; o < 64; o <<= 1) { const unsigned long long t = shfl_xor64(k, o); k = t > k ? t : k; }
    return k;
}
__device__ __forceinline__ void route_unit(const Params& p, int t, int h, int lane) {
    const bf16_t* Q = (const bf16_t*)(p.ws + WS_Q); const bf16_t* KB = (const bf16_t*)(p.ws + WS_KEYSB);
    int* RIDX = (int*)(p.ws + WS_RIDX); float* RG = (float*)(p.ws + WS_RG);
    float sv_l[2] = {0.f, 0.f}; int si_l[2] = {0, 0};
#pragma unroll
    for (int c = 0; c < 2; ++c) {
        const bf16_t* qv = Q + (size_t)t * D + h * 256 + c * 128;
        const unsigned qw = ((const unsigned*)qv)[lane];
        const float qa = bf2f(qw & 0xffffu), qb = bf2f(qw >> 16);
        const bf16_t* k0p = KB + ((size_t)(h * 2 + c) * NKEYS + lane) * 128;
        const bf16_t* k1p = k0p + 64 * 128;
        float s0 = 0.f, s1 = 0.f;
#pragma unroll
        for (int w = 0; w < 16; ++w) {
            float k0f[8], k1f[8]; unpack8(((const u32x4*)k0p)[w], k0f); unpack8(((const u32x4*)k1p)[w], k1f);
#pragma unroll
            for (int e = 0; e < 8; e += 2) {
                const int src = 4 * w + e / 2;
                const float xa = __int_as_float(__builtin_amdgcn_readlane(__float_as_int(qa), src));
                const float xb = __int_as_float(__builtin_amdgcn_readlane(__float_as_int(qb), src));
                s0 = fmaf(xa, k0f[e], s0); s0 = fmaf(xb, k0f[e + 1], s0);
                s1 = fmaf(xa, k1f[e], s1); s1 = fmaf(xb, k1f[e + 1], s1);
            }
        }
        unsigned long long ka = ((unsigned long long)fkey(s0) << 32) | (unsigned)(255 - lane);
        unsigned long long kb = ((unsigned long long)fkey(s1) << 32) | (unsigned)(255 - (lane + 64));
        for (int rnd = 0; rnd < TOPK; ++rnd) {
            const unsigned long long best = wave_max64(ka > kb ? ka : kb);
            if (ka == best) ka = 0ull; if (kb == best) kb = 0ull;
            if (lane == rnd) { sv_l[c] = fkey_inv((unsigned)(best >> 32)); si_l[c] = 255 - (int)(best & 0xffffffffu); }
        }
    }
    unsigned long long kc[4];
#pragma unroll
    for (int m = 0; m < 4; ++m) { const int cid = lane + 64 * m, i = cid >> 4, j = cid & 15;
        const float v = __shfl(sv_l[0], i) + __shfl(sv_l[1], j);
        kc[m] = ((unsigned long long)fkey(v) << 32) | (unsigned)(1023 - cid); }
    float fv = 0.f; int cidx = 0;
    for (int rnd = 0; rnd < TOPK; ++rnd) {
        unsigned long long loc = kc[0] > kc[1] ? kc[0] : kc[1]; const unsigned long long loc2 = kc[2] > kc[3] ? kc[2] : kc[3]; loc = loc > loc2 ? loc : loc2;
        const unsigned long long best = wave_max64(loc);
#pragma unroll
        for (int m = 0; m < 4; ++m) if (kc[m] == best) kc[m] = 0ull;
        if (lane == rnd) { fv = fkey_inv((unsigned)(best >> 32)); cidx = 1023 - (int)(best & 0xffffffffu); }
    }
    const float fmax_ = __shfl(fv, 0);
    float e = lane < 16 ? __expf(fv - fmax_) : 0.f;
    float ssum = e;
#pragma unroll
    for (int o = 1; o < 16; o <<= 1) ssum += __shfl_xor(ssum, o);
    const int ci = cidx >> 4, cj = cidx & 15;
    const int e0 = __shfl(si_l[0], ci), e1 = __shfl(si_l[1], cj);
    if (lane < 16) { RIDX[(size_t)t * 128 + h * 16 + lane] = e0 * NKEYS + e1; RG[(size_t)t * 128 + h * 16 + lane] = e / ssum; }
}

typedef float f32x2 __attribute__((ext_vector_type(2)));
__device__ __forceinline__ void fp4_row_load(const float* __restrict__ src, const float* __restrict__ kscale, int lane, f32x4 (&v)[8]) {
#pragma unroll
    for (int j = 0; j < 8; ++j) { v[j] = ((const f32x4*)src)[64 * j + lane]; if (kscale) v[j] = v[j] * ((const f32x4*)kscale)[64 * j + lane]; }
}
__device__ __forceinline__ void fp4_row_finish(const f32x4 (&v)[8], unsigned char* __restrict__ tab, int e, float* __restrict__ scale_out, int lane) {
    float mx = 0.f;
#pragma unroll
    for (int j = 0; j < 8; ++j) mx = fmaxf(mx, fmaxf(fmaxf(fabsf(v[j].x), fabsf(v[j].y)), fmaxf(fabsf(v[j].z), fabsf(v[j].w))));
#pragma unroll
    for (int o = 1; o < 64; o <<= 1) mx = fmaxf(mx, __shfl_xor(mx, o));
    const float sc = mx > 0.f ? mx * (1.f / 6.f) : 1.f, inv = 1.f / sc;
#pragma unroll
    for (int j = 0; j < 8; ++j) {
        const f32x4 a = v[j] * inv;
        unsigned pk = 0u;
        pk = __builtin_amdgcn_cvt_scalef32_pk_fp4_f32(pk, fminf(fmaxf(a.x, -6.f), 6.f), fminf(fmaxf(a.y, -6.f), 6.f), 1.0f, 0);
        pk = __builtin_amdgcn_cvt_scalef32_pk_fp4_f32(pk, fminf(fmaxf(a.z, -6.f), 6.f), fminf(fmaxf(a.w, -6.f), 6.f), 1.0f, 1);
        *(unsigned short*)(tab + ((size_t)j * 16384 + e) * 128 + 2 * lane) = (unsigned short)pk;
    }
    if (lane == 0) *scale_out = sc;
}
__device__ __forceinline__ void fp4_tables(const Params& p, int gw, int NW, int lane) {
    f32x4 va[8], vb[8];
#define FP4_LOAD(r, v) do { if ((r) < 16384) fp4_row_load(p.in[25] + (size_t)(r) * D, p.in[22], lane, v); else fp4_row_load(p.in[26] + (size_t)((r) - 16384) * D, nullptr, lane, v); } while (0)
#define FP4_FIN(r, v) do { if ((r) < 16384) fp4_row_finish(v, p.ws + WS_TABU, (r), (float*)(p.ws + WS_SCU) + (r), lane); \
        else fp4_row_finish(v, p.ws + WS_TABV, (r) - 16384, (float*)(p.ws + WS_SCV) + ((r) - 16384), lane); } while (0)
    const int n = 2 * 16384;
    int r = gw;
    if (r < n) FP4_LOAD(r, va);
    for (; r < n; r += 2 * NW) {
        const bool hb = r + NW < n;
        if (hb) FP4_LOAD(r + NW, vb);
        FP4_FIN(r, va);
        if (r + 2 * NW < n) FP4_LOAD(r + 2 * NW, va);
        if (hb) FP4_FIN(r + NW, vb);
    }
#undef FP4_LOAD
#undef FP4_FIN
}
constexpr size_t WS_ZP = WS_Q;
constexpr size_t WS_X2F8 = 2 * MiB;
__device__ __forceinline__ float dot_chunk(const u32x4 w, const float (&xf)[32]) {
    float a0 = 0.f, a1 = 0.f;
#pragma unroll
    for (int q = 0; q < 4; ++q) {
        const f32x2 a = __builtin_amdgcn_cvt_scalef32_pk_f32_fp4(w[q], 1.0f, 0), b = __builtin_amdgcn_cvt_scalef32_pk_f32_fp4(w[q], 1.0f, 1);
        const f32x2 c = __builtin_amdgcn_cvt_scalef32_pk_f32_fp4(w[q], 1.0f, 2), d = __builtin_amdgcn_cvt_scalef32_pk_f32_fp4(w[q], 1.0f, 3);
        a0 = fmaf(a.x, xf[8 * q], a0); a1 = fmaf(a.y, xf[8 * q + 1], a1); a0 = fmaf(b.x, xf[8 * q + 2], a0); a1 = fmaf(b.y, xf[8 * q + 3], a1);
        a0 = fmaf(c.x, xf[8 * q + 4], a0); a1 = fmaf(c.y, xf[8 * q + 5], a1); a0 = fmaf(d.x, xf[8 * q + 6], a0); a1 = fmaf(d.y, xf[8 * q + 7], a1);
    }
    return a0 + a1;
}
__device__ __forceinline__ void axpy_chunk(const u32x4 w, const float a_, float (&of)[32]) {
#pragma unroll
    for (int q = 0; q < 4; ++q) {
        const f32x2 a = __builtin_amdgcn_cvt_scalef32_pk_f32_fp4(w[q], 1.0f, 0), b = __builtin_amdgcn_cvt_scalef32_pk_f32_fp4(w[q], 1.0f, 1);
        const f32x2 c = __builtin_amdgcn_cvt_scalef32_pk_f32_fp4(w[q], 1.0f, 2), d = __builtin_amdgcn_cvt_scalef32_pk_f32_fp4(w[q], 1.0f, 3);
        of[8 * q] = fmaf(a_, a.x, of[8 * q]); of[8 * q + 1] = fmaf(a_, a.y, of[8 * q + 1]); of[8 * q + 2] = fmaf(a_, b.x, of[8 * q + 2]); of[8 * q + 3] = fmaf(a_, b.y, of[8 * q + 3]);
        of[8 * q + 4] = fmaf(a_, c.x, of[8 * q + 4]); of[8 * q + 5] = fmaf(a_, c.y, of[8 * q + 5]); of[8 * q + 6] = fmaf(a_, d.x, of[8 * q + 6]); of[8 * q + 7] = fmaf(a_, d.y, of[8 * q + 7]);
    }
}
struct PeerTok { u32x4 w[16]; u32x4 x[4]; };
template <bool USTEP>
__device__ __forceinline__ void peer_issue(PeerTok& k, const Params& p, const unsigned char* tab, int t, int xv, int lane) {
    const int* RIDX = (const int*)(p.ws + WS_RIDX);
    const int i0 = RIDX[(size_t)t * 128 + lane], i1 = RIDX[(size_t)t * 128 + 64 + lane];
    const int es = lane >> 3, ck = lane & 7;
    if (USTEP) { const bf16_t* xp = (const bf16_t*)(p.ws + WS_X2BF) + (size_t)t * D + 256 * xv + 32 * ck;
#pragma unroll
        for (int j = 0; j < 4; ++j) k.x[j] = *(const u32x4*)(xp + 8 * j); }
#pragma unroll
    for (int g = 0; g < 16; ++g) { const int e = __shfl(g < 8 ? i0 : i1, (8 * g + es) & 63); k.w[g] = *(const u32x4*)(tab + (size_t)e * 128 + ck * 16); }
}
__device__ __forceinline__ void peer_u_finish(const PeerTok& k, const Params& p, int t, int xv, int lane) {
    const int es = lane >> 3, ck = lane & 7;
    float xf[32];
#pragma unroll
    for (int j = 0; j < 4; ++j) unpack8(k.x[j], xf + 8 * j);
    float zsel0 = 0.f, zsel1 = 0.f;
#pragma unroll
    for (int g = 0; g < 16; ++g) { u32x4 w_ = k.w[g]; asm volatile("" : "+v"(w_)); float d = dot_chunk(w_, xf);
        d += __int_as_float(__builtin_amdgcn_update_dpp(0, __float_as_int(d), 0xB1, 0xf, 0xf, true));
        d += __int_as_float(__builtin_amdgcn_update_dpp(0, __float_as_int(d), 0x4E, 0xf, 0xf, true));
        d += __int_as_float(__builtin_amdgcn_update_dpp(0, __float_as_int(d), 0x141, 0xf, 0xf, true));
        if (g < 8) { if (ck == g) zsel0 = d; } else { if (ck == g - 8) zsel1 = d; }
        asm volatile("" : "+v"(zsel0), "+v"(zsel1)); }
    float* zp = (float*)(p.ws + WS_ZP) + ((size_t)xv * T + t) * 128;
    zp[8 * ck + es] = zsel0; zp[64 + 8 * ck + es] = zsel1;
}
__device__ __forceinline__ void peer_v_finish(const PeerTok& k, const Params& p, int t, int xv, int lane, LAS float* red) {
    const float* RG = (const float*)(p.ws + WS_RG);
    const float a0 = RG[(size_t)t * 128 + lane], a1 = RG[(size_t)t * 128 + 64 + lane];
    const int es = lane >> 3, ck = lane & 7;
    float of[32];
#pragma unroll
    for (int q = 0; q < 32; ++q) of[q] = 0.f;
#pragma unroll
    for (int g = 0; g < 16; ++g) { const float a = __shfl(g < 8 ? a0 : a1, (8 * g + es) & 63); u32x4 w_ = k.w[g]; asm volatile("" : "+v"(w_)); axpy_chunk(w_, a, of);
        asm volatile("" : "+v"(of[0]), "+v"(of[1]), "+v"(of[2]), "+v"(of[3]), "+v"(of[4]), "+v"(of[5]), "+v"(of[6]), "+v"(of[7]), "+v"(of[8]), "+v"(of[9]), "+v"(of[10]), "+v"(of[11]), "+v"(of[12]), "+v"(of[13]), "+v"(of[14]), "+v"(of[15]));
        asm volatile("" : "+v"(of[16]), "+v"(of[17]), "+v"(of[18]), "+v"(of[19]), "+v"(of[20]), "+v"(of[21]), "+v"(of[22]), "+v"(of[23]), "+v"(of[24]), "+v"(of[25]), "+v"(of[26]), "+v"(of[27]), "+v"(of[28]), "+v"(of[29]), "+v"(of[30]), "+v"(of[31])); }
#pragma unroll
    for (int q = 0; q < 8; ++q) *(LAS f32x4*)(red + es * 256 + ck * 32 + 4 * q) = (f32x4){of[4 * q], of[4 * q + 1], of[4 * q + 2], of[4 * q + 3]};
    f32x4 s = *(const LAS f32x4*)(red + 4 * lane);
#pragma unroll
    for (int r = 1; r < 8; ++r) s = s + *(const LAS f32x4*)(red + r * 256 + 4 * lane);
    f32x4* o4 = (f32x4*)(p.out + (size_t)t * D + 256 * xv + 4 * lane);
    *o4 = *o4 + s;
}
template <bool USTEP>
__device__ __forceinline__ void peer_step(const Params& p, int lane, int wave, LAS float* red, int pos, int nx, int rank, int nloc) {
    for (int xv = pos; xv < 8; xv += nx) {
        const int wx = rank * 8 + wave, nwx = nloc * 8;
        const unsigned char* tab = p.ws + (USTEP ? WS_TABU : WS_TABV) + (size_t)xv * 16384 * 128;
        PeerTok A, B;
        int t = wx;
        if (t < T) peer_issue<USTEP>(A, p, tab, t, xv, lane);
#pragma unroll 1
        for (; t < T; t += 2 * nwx) {
            const bool hb = t + nwx < T;
            if (hb) peer_issue<USTEP>(B, p, tab, t + nwx, xv, lane);
            if (USTEP) peer_u_finish(A, p, t, xv, lane); else peer_v_finish(A, p, t, xv, lane, red);
            if (t + 2 * nwx < T) peer_issue<USTEP>(A, p, tab, t + 2 * nwx, xv, lane);
            if (hb) { if (USTEP) peer_u_finish(B, p, t + nwx, xv, lane); else peer_v_finish(B, p, t + nwx, xv, lane, red); }
        }
    }
}
typedef int v8i_p __attribute__((ext_vector_type(8))); typedef int v4i_t __attribute__((ext_vector_type(4)));
struct PeerTokU { u32x4 w[16]; u32x4 b[2][2]; };
__device__ __forceinline__ void peer_u_issue(PeerTokU& k, const Params& p, const unsigned char* tab, int t, int xv, int lane) {
    const int* RIDX = (const int*)(p.ws + WS_RIDX);
    const int i0 = RIDX[(size_t)t * 128 + lane], i1 = RIDX[(size_t)t * 128 + 64 + lane];
    const int es = lane >> 3, ck = lane & 7, q = lane >> 4;
    const unsigned char* xp = p.ws + WS_X2F8 + (size_t)t * D + 256 * xv + 16 * q;
#pragma unroll
    for (int kb = 0; kb < 2; ++kb) { k.b[kb][0] = *(const u32x4*)(xp + 128 * kb); k.b[kb][1] = *(const u32x4*)(xp + 128 * kb + 64); }
#pragma unroll
    for (int g = 0; g < 16; ++g) { const int e = __shfl(g < 8 ? i0 : i1, (8 * g + es) & 63); k.w[g] = *(const u32x4*)(tab + (size_t)e * 128 + ck * 16); }
}
__device__ __forceinline__ void peer_u_mfma(const PeerTokU& k, const Params& p, int t, int xv, int lane, LAS unsigned char* vl) {
    float* zp = (float*)(p.ws + WS_ZP) + ((size_t)xv * T + t) * 128;
    const int es = lane >> 3, ck = lane & 7, r16 = lane & 15, q = lane >> 4;
#pragma unroll
    for (int g = 0; g < 16; ++g) { const int row = 8 * g + es; *(LAS u32x4*)(vl + row * 128 + ((ck ^ (row & 7)) << 4)) = k.w[g]; }
    v8i_p b0, b1;
    { const v4i_t x0 = __builtin_bit_cast(v4i_t, k.b[0][0]), x1 = __builtin_bit_cast(v4i_t, k.b[0][1]), y0 = __builtin_bit_cast(v4i_t, k.b[1][0]), y1 = __builtin_bit_cast(v4i_t, k.b[1][1]);
      b0 = __builtin_shufflevector(x0, x1, 0, 1, 2, 3, 4, 5, 6, 7); b1 = __builtin_shufflevector(y0, y1, 0, 1, 2, 3, 4, 5, 6, 7); }
#pragma unroll
    for (int g = 0; g < 8; ++g) {
        const int row = 16 * g + r16;
        const v4i_t a0 = __builtin_bit_cast(v4i_t, *(const LAS u32x4*)(vl + row * 128 + ((q ^ (row & 7)) << 4)));
        const v4i_t a1 = __builtin_bit_cast(v4i_t, *(const LAS u32x4*)(vl + row * 128 + (((4 + q) ^ (row & 7)) << 4)));
        const v8i_p A0 = {a0[0], a0[1], a0[2], a0[3], 0, 0, 0, 0}, A1 = {a1[0], a1[1], a1[2], a1[3], 0, 0, 0, 0};
        f32x4 acc = {0.f, 0.f, 0.f, 0.f};
        acc = __builtin_amdgcn_mfma_scale_f32_16x16x128_f8f6f4(A0, b0, acc, 4, 0, 0, 0x7F7F7F7F, 0, 0x7F7F7F7F);
        acc = __builtin_amdgcn_mfma_scale_f32_16x16x128_f8f6f4(A1, b1, acc, 4, 0, 0, 0x7F7F7F7F, 0, 0x7F7F7F7F);
        if ((lane & 15) == 0) *(f32x4*)(zp + 16 * g + 4 * (lane >> 4)) = acc;
    }
}
__device__ __forceinline__ void peer_u_step(const Params& p, int lane, int wave, LAS unsigned char* vl, int pos, int nx, int rank, int nloc) {
    for (int xv = pos; xv < 8; xv += nx) {
        const int wx = rank * 8 + wave, nwx = nloc * 8;
        const unsigned char* tab = p.ws + WS_TABU + (size_t)xv * 16384 * 128;
        PeerTokU A, B;
        int t = wx;
        if (t < T) peer_u_issue(A, p, tab, t, xv, lane);
#pragma unroll 1
        for (; t < T; t += 2 * nwx) {
            const bool hb = t + nwx < T;
            if (hb) peer_u_issue(B, p, tab, t + nwx, xv, lane);
            peer_u_mfma(A, p, t, xv, lane, vl);
            if (t + 2 * nwx < T) peer_u_issue(A, p, tab, t + 2 * nwx, xv, lane);
            if (hb) peer_u_mfma(B, p, t + nwx, xv, lane, vl);
        }
    }
}
constexpr size_t WS_ACT8 = 34 * MiB, WS_ASC = 36 * MiB;
__device__ __forceinline__ void peer_combine(const Params& p, int t, int lane) {
    const float* ZP = (const float*)(p.ws + WS_ZP); const int* RIDX = (const int*)(p.ws + WS_RIDX); const float* RG = (const float*)(p.ws + WS_RG);
    const float* SCU = (const float*)(p.ws + WS_SCU); const float* SCV = (const float*)(p.ws + WS_SCV); const float* SS2 = (const float*)(p.ws + WS_CTL + CTL_SS2_BYTE);
    const float rs = rsqrtf(SS2[t] * (1.f / D) + EPS);
    float act[2];
#pragma unroll
    for (int hlf = 0; hlf < 2; ++hlf) { const size_t o = (size_t)t * 128 + 64 * hlf + lane; float z = 0.f;
#pragma unroll
        for (int x = 0; x < 8; ++x) z += ZP[((size_t)x * T) * 128 + o];
        const int e = RIDX[o];
        act[hlf] = gelu_tanh(z * rs * SCU[e]) * RG[o] * SCV[e]; }
    float mx = fmaxf(fabsf(act[0]), fabsf(act[1]));
#pragma unroll
    for (int o = 1; o < 64; o <<= 1) mx = fmaxf(mx, __shfl_xor(mx, o));
    const float sc = mx > 0.f ? mx * (1.f / 448.f) : 1.f, inv = 1.f / sc;
    unsigned char* a8 = p.ws + WS_ACT8 + (size_t)t * 128;
    a8[lane] = (unsigned char)(__builtin_amdgcn_cvt_pk_fp8_f32(act[0] * inv, 0.f, 0, false) & 0xff);
    a8[64 + lane] = (unsigned char)(__builtin_amdgcn_cvt_pk_fp8_f32(act[1] * inv, 0.f, 0, false) & 0xff);
    if (lane == 0) ((float*)(p.ws + WS_ASC))[t] = sc;
}
typedef int v2i_t __attribute__((ext_vector_type(2)));
struct PeerTokV { u32x4 w[16]; u32x4 b[2]; };
__device__ __forceinline__ void peer_v_issue(PeerTokV& k, const Params& p, const unsigned char* tab, int t, int lane) {
    const int* RIDX = (const int*)(p.ws + WS_RIDX);
    const int i0 = RIDX[(size_t)t * 128 + lane], i1 = RIDX[(size_t)t * 128 + 64 + lane];
    const int es = lane >> 3, ck = lane & 7, q = lane >> 4;
    const unsigned char* ap = p.ws + WS_ACT8 + (size_t)t * 128 + 16 * q;
    k.b[0] = *(const u32x4*)ap; k.b[1] = *(const u32x4*)(ap + 64);
#pragma unroll
    for (int g = 0; g < 16; ++g) { const int e = __shfl(g < 8 ? i0 : i1, (8 * g + es) & 63); k.w[g] = *(const u32x4*)(tab + (size_t)e * 128 + ck * 16); }
}
__device__ __forceinline__ void peer_v_mfma(const PeerTokV& k, const Params& p, int t, int xv, int lane, LAS unsigned char* vl) {
    const int es = lane >> 3, ck = lane & 7, n = lane & 15, q = lane >> 4;
#pragma unroll
    for (int g = 0; g < 16; ++g) { const int row = 8 * g + es; *(LAS u32x4*)(vl + row * 128 + ((ck ^ (row & 7)) << 4)) = k.w[g]; }
    const v4i_t x0 = __builtin_bit_cast(v4i_t, k.b[0]), x1 = __builtin_bit_cast(v4i_t, k.b[1]);
    const v8i_p bop = __builtin_shufflevector(x0, x1, 0, 1, 2, 3, 4, 5, 6, 7);
    const int r1 = 32 * q + n, r2 = r1 + 16;
    f32x4 keep = {0.f, 0.f, 0.f, 0.f};
#pragma unroll
    for (int mb = 0; mb < 16; ++mb) {
        const v2i_t t1 = __builtin_amdgcn_ds_read_tr4_b64_v2i32((LAS v2i_t*)(vl + r1 * 128 + ((((mb >> 1) ^ (r1 & 7)) << 4) | ((mb & 1) << 3))));
        const v2i_t t2 = __builtin_amdgcn_ds_read_tr4_b64_v2i32((LAS v2i_t*)(vl + r2 * 128 + ((((mb >> 1) ^ (r2 & 7)) << 4) | ((mb & 1) << 3))));
        const v8i_p aop = {t1[0], t1[1], t2[0], t2[1], 0, 0, 0, 0};
        f32x4 acc = {0.f, 0.f, 0.f, 0.f};
        acc = __builtin_amdgcn_mfma_scale_f32_16x16x128_f8f6f4(aop, bop, acc, 4, 0, 0, 0x7F7F7F7F, 0, 0x7F7F7F7F);
        if (n == mb) keep = acc;
    }
    const float sc = ((const float*)(p.ws + WS_ASC))[t];
    const size_t oo = (size_t)t * D + 256 * xv + 16 * n + 4 * q;
    const u32x2 xw = *(const u32x2*)((const bf16_t*)(p.ws + WS_X2BF) + oo);
    const f32x4 x2v = {__uint_as_float(xw.x << 16), __uint_as_float(xw.x & 0xffff0000u), __uint_as_float(xw.y << 16), __uint_as_float(xw.y & 0xffff0000u)};
    *(f32x4*)(p.out + oo) = x2v + keep * sc;
}
__device__ __forceinline__ void peer_v_step(const Params& p, int lane, int wave, LAS unsigned char* vl, int pos, int nx, int rank, int nloc) {
    for (int xv = pos; xv < 8; xv += nx) {
        const int wx = rank * 8 + wave, nwx = nloc * 8;
        const unsigned char* tab = p.ws + WS_TABV + (size_t)xv * 16384 * 128;
        PeerTokV A, B;
        int t = wx;
        if (t < T) peer_v_issue(A, p, tab, t, lane);
#pragma unroll 1
        for (; t < T; t += 2 * nwx) {
            const bool hb = t + nwx < T;
            if (hb) peer_v_issue(B, p, tab, t + nwx, lane);
            peer_v_mfma(A, p, t, xv, lane, vl);
            if (t + 2 * nwx < T) peer_v_issue(A, p, tab, t + 2 * nwx, lane);
            if (hb) peer_v_mfma(B, p, t + nwx, xv, lane, vl);
        }
    }
}

namespace pg8 {
#define PG8_LAS __attribute__((address_space(3)))
constexpr int BM = 256, BK = 64, HALF = 128, HTB = HALF * BK * 2, STAGE_BYTES = 8 * HTB, NXCD = 8, WGM = 1;
__host__ __device__ __forceinline__ int lds_byte(int r, int c) { const int st = (r >> 4) * 2 + (c >> 5), rr = r & 15, cc = c & 31, ob = rr * 64 + cc * 2; return st * 1024 + (ob ^ (((ob >> 9) & 1) << 5)); }
__host__ __device__ __forceinline__ void stage_rc(int b, int& R, int& C) { const int st = b / 1024, sb = b % 1024, swz = sb ^ (((sb >> 9) & 1) << 5); R = (st >> 1) * 16 + swz / 64; C = (st & 1) * 32 + (swz % 64) / 2; }
__host__ __device__ __forceinline__ int perm32(int rho) { const int n = rho >> 4, i = rho & 15; return 8 * (i >> 2) + 4 * n + (i & 3); }
struct Unit { const char* A; const char* B; int pm, pn, kind, nt; };
__device__ __forceinline__ const char* uni_ptr(const char* p) { const unsigned long long v = (unsigned long long)p; const unsigned lo = __builtin_amdgcn_readfirstlane((unsigned)v), hi = __builtin_amdgcn_readfirstlane((unsigned)(v >> 32)); return (const char*)(((unsigned long long)hi << 32) | lo); }
__device__ __forceinline__ void uni(Unit& u) { u.A = uni_ptr(u.A); u.B = uni_ptr(u.B); u.pm = __builtin_amdgcn_readfirstlane(u.pm); u.pn = __builtin_amdgcn_readfirstlane(u.pn); u.kind = __builtin_amdgcn_readfirstlane(u.kind); u.nt = __builtin_amdgcn_readfirstlane(u.nt); }
template <int WG = WGM>
__device__ __forceinline__ void tile_of(int L, int nM, int nN, int& pm, int& pn) {
    const int nwg = nM * nN; int wgid = L; { const int q = nwg / NXCD, r = nwg % NXCD, xcd = wgid % NXCD, off = wgid / NXCD; wgid = (xcd < r ? xcd * (q + 1) : r * (q + 1) + (xcd - r) * q) + off; }
    const int nig = WG * nN, gid = wgid / nig, fm = gid * WG, gsz = (nM - fm) < WG ? (nM - fm) : WG;
    pm = fm + ((wgid % nig) % gsz); pn = (wgid % nig) / gsz;
}
typedef int v8i_t __attribute__((ext_vector_type(8))); typedef int v4i_t __attribute__((ext_vector_type(4)));
__device__ __forceinline__ v8i_t cat8(const bf16x8 lo, const bf16x8 hi) { const v4i_t a = __builtin_bit_cast(v4i_t, lo), b = __builtin_bit_cast(v4i_t, hi); return __builtin_shufflevector(a, b, 0, 1, 2, 3, 4, 5, 6, 7); }
template <bool FP8, class Epi, class Sched>
__device__ __forceinline__ void gemm_phase(PG8_LAS unsigned char* lds, const int lda, const int ldb, const Sched& S, const Epi& E, const int wid) {
    const int lane = fresh_lane(), tid = wid * 64 + lane, wr = wid >> 2, wc = wid & 3, fr = lane & 15, fq = lane >> 4;
    unsigned voffA[2], voffB[2];
#pragma unroll
    for (int i = 0; i < 2; ++i) { int R, C; stage_rc(tid * 16 + i * 8192, R, C); const int Rb = (R & ~31) + perm32(R & 31);
        voffA[i] = (unsigned)(R * lda + C) * 2u; voffB[i] = (unsigned)(Rb * ldb + C) * 2u; }
    const size_t kstep = (size_t)(BK * 2);
    const size_t hstepA = (size_t)HALF * lda * 2, hstepB = (size_t)HALF * ldb * 2;
    const unsigned ldsw = (unsigned)wid * 1024u;
    const int aoff = lds_byte(wr * 64 + fr, fq * 8), boff = lds_byte(wc * 32 + fr, fq * 8);
#define PG8_SA(b, h) (((b) * 2 + (h)) * HTB)
#define PG8_SB(b, h) ((4 + (b) * 2 + (h)) * HTB)
#define PG8_STAGE(bufoff, gbase, voff) do { _Pragma("unroll") for (int _i = 0; _i < 2; ++_i) \
        __builtin_amdgcn_global_load_lds((const unsigned*)((const char*)(gbase) + (voff)[_i]), (PG8_LAS unsigned*)(lds + (bufoff) + ldsw + _i * 8192), 16, 0, 0); } while (0)
#define PG8_LDA(dst, b, h) do { _Pragma("unroll") for (int m = 0; m < 4; ++m) { if constexpr (FP8) dst##8[m] = cat8(*(const PG8_LAS bf16x8*)(lds + PG8_SA(b, h) + aoff + m * 2048), *(const PG8_LAS bf16x8*)(lds + PG8_SA(b, h) + aoff + m * 2048 + 1024)); \
        else { _Pragma("unroll") for (int k = 0; k < 2; ++k) dst[m][k] = *(const PG8_LAS bf16x8*)(lds + PG8_SA(b, h) + aoff + m * 2048 + k * 1024); } } } while (0)
#define PG8_LDB(dst, b, h) do { _Pragma("unroll") for (int n = 0; n < 2; ++n) { if constexpr (FP8) dst##8[n] = cat8(*(const PG8_LAS bf16x8*)(lds + PG8_SB(b, h) + boff + n * 2048), *(const PG8_LAS bf16x8*)(lds + PG8_SB(b, h) + boff + n * 2048 + 1024)); \
        else { _Pragma("unroll") for (int k = 0; k < 2; ++k) dst[n][k] = *(const PG8_LAS bf16x8*)(lds + PG8_SB(b, h) + boff + n * 2048 + k * 1024); } } } while (0)
#define PG8_MMA(ai, bj, At, Bt) do { __builtin_amdgcn_s_setprio(1); \
        if constexpr (FP8) { _Pragma("unroll") for (int m = 0; m < 4; ++m) _Pragma("unroll") for (int n = 0; n < 2; ++n) \
            asm volatile("v_mfma_scale_f32_16x16x128_f8f6f4 %0, %1, %2, %0, %3, %3 op_sel_hi:[0,0,0]" : "+v"(acc[ai][bj][m][n]) : "v"(Bt##8[n]), "v"(At##8[m]), "v"(mxone)); } \
        else { _Pragma("unroll") for (int m = 0; m < 4; ++m) _Pragma("unroll") for (int n = 0; n < 2; ++n) _Pragma("unroll") for (int k = 0; k < 2; ++k) \
            acc[ai][bj][m][n] = __builtin_amdgcn_mfma_f32_16x16x32_bf16(Bt[n][k], At[m][k], acc[ai][bj][m][n], 0, 0, 0); } \
        __builtin_amdgcn_s_setprio(0); } while (0)
#define PG8_WAIT_V(n) asm volatile("s_waitcnt vmcnt(" #n ")" ::: "memory")
#define PG8_WAIT_L(n) asm volatile("s_waitcnt lgkmcnt(" #n ")" ::: "memory")
#define PG8_BAR __builtin_amdgcn_s_barrier()
#define PG8_SCHED __builtin_amdgcn_sched_barrier(0)
    Unit cur, nxt; int ui = 0;
    if (!S.next(0, cur)) return;
    f32x4 acc[2][2][4][2];
#pragma unroll
    for (int a = 0; a < 2; ++a)
#pragma unroll
        for (int b = 0; b < 2; ++b)
#pragma unroll
            for (int m = 0; m < 4; ++m)
#pragma unroll
                for (int n = 0; n < 2; ++n) acc[a][b][m][n] = (f32x4){0.f, 0.f, 0.f, 0.f};
    const int mxone = 0x7F7F7F7F;
    bf16x8 At[4][2], B0[2][2], B1[2][2]; v8i_t At8[4], B08[2], B18[2];
    const char* cA = cur.A; const char* cB = cur.B;
    PG8_STAGE(PG8_SB(0, 0), cB, voffB); PG8_STAGE(PG8_SB(0, 1), cB + hstepB, voffB); PG8_STAGE(PG8_SA(0, 0), cA, voffA); PG8_STAGE(PG8_SA(0, 1), cA + hstepA, voffA);
    if (wr == 1) PG8_BAR;
    PG8_WAIT_V(2); PG8_BAR;
    PG8_STAGE(PG8_SB(1, 0), cB + kstep, voffB); PG8_STAGE(PG8_SA(1, 0), cA + kstep, voffA); PG8_STAGE(PG8_SB(1, 1), cB + hstepB + kstep, voffB);
    PG8_WAIT_V(6); PG8_BAR;
    for (;;) {
        const bool has_next = S.next(ui + 1, nxt);
        const char* nA = has_next ? nxt.A : cA; const char* nB = has_next ? nxt.B : cB;
        const int nt = cur.nt;
        for (int t = 0; t < nt; t += 2) {
            const bool last = (t == nt - 2);
            const char* a1 = cA + (size_t)(t + 1) * kstep;
            const char* a2 = last ? nA : cA + (size_t)(t + 2) * kstep; const char* b2 = last ? nB : cB + (size_t)(t + 2) * kstep;
            const char* a3 = a2 + kstep; const char* b3 = b2 + kstep;
            PG8_LDB(B0, 0, 0); PG8_LDB(B1, 0, 1); PG8_SCHED; PG8_LDA(At, 0, 0); PG8_STAGE(PG8_SA(1, 1), a1 + hstepA, voffA);
            PG8_WAIT_V(8); PG8_WAIT_L(0); PG8_BAR; PG8_MMA(0, 0, At, B0); PG8_MMA(0, 1, At, B1); PG8_BAR; PG8_SCHED;
            PG8_LDA(At, 0, 1); PG8_STAGE(PG8_SB(0, 0), b2, voffB); PG8_STAGE(PG8_SB(0, 1), b2 + hstepB, voffB); PG8_STAGE(PG8_SA(0, 0), a2, voffA);
            PG8_WAIT_V(8); PG8_WAIT_L(0); PG8_BAR; PG8_MMA(1, 0, At, B0); PG8_MMA(1, 1, At, B1); PG8_BAR; PG8_SCHED;
            PG8_LDB(B0, 1, 0); PG8_LDB(B1, 1, 1); PG8_SCHED; PG8_LDA(At, 1, 0); PG8_STAGE(PG8_SA(0, 1), a2 + hstepA, voffA);
            PG8_WAIT_V(8); PG8_WAIT_L(0); PG8_BAR; PG8_MMA(0, 0, At, B0); PG8_MMA(0, 1, At, B1); PG8_BAR; PG8_SCHED;
            PG8_LDA(At, 1, 1); PG8_STAGE(PG8_SB(1, 0), b3, voffB); PG8_STAGE(PG8_SB(1, 1), b3 + hstepB, voffB); PG8_STAGE(PG8_SA(1, 0), a3, voffA);
            PG8_WAIT_V(8); PG8_WAIT_L(0); PG8_BAR; PG8_MMA(1, 0, At, B0); PG8_MMA(1, 1, At, B1); PG8_BAR; PG8_SCHED;
        }
        if (wr == 0) PG8_BAR;
        if constexpr (FP8) asm volatile("s_nop 15\n\ts_nop 15" ::: "memory");
        E(acc, cur, wr, wc, fr, fq);
        if (!has_next) break;
        if (E.reset(cur)) {
#pragma unroll
        for (int a = 0; a < 2; ++a)
#pragma unroll
            for (int b = 0; b < 2; ++b)
#pragma unroll
                for (int m = 0; m < 4; ++m)
#pragma unroll
                    for (int n = 0; n < 2; ++n) acc[a][b][m][n] = (f32x4){0.f, 0.f, 0.f, 0.f};
        }
        cur = nxt; cA = nA; cB = nB; ++ui;
        if (wr == 1) PG8_BAR;
    }
    PG8_WAIT_V(0);
    PG8_BAR;
#undef PG8_SA
#undef PG8_SB
#undef PG8_STAGE
#undef PG8_LDA
#undef PG8_LDB
#undef PG8_MMA
#undef PG8_WAIT_V
#undef PG8_WAIT_L
#undef PG8_BAR
#undef PG8_SCHED
}
}
typedef f32x4 AccT[2][2][4][2];
#define EPI_RESET_ALWAYS __device__ __forceinline__ bool reset(const pg8::Unit&) const { return true; }
__device__ __forceinline__ unsigned cvt_pk_bf16(float lo, float hi) { unsigned r; asm volatile("v_cvt_pk_bf16_f32 %0, %1, %2" : "=v"(r) : "v"(lo), "v"(hi)); return r; }
__device__ __forceinline__ u32x4 pack8(const f32x4 v0, const f32x4 v1) { u32x4 w; w.x = cvt_pk_bf16(v0[0], v0[1]); w.y = cvt_pk_bf16(v0[2], v0[3]); w.z = cvt_pk_bf16(v1[0], v1[1]); w.w = cvt_pk_bf16(v1[2], v1[3]); return w; }
template <int MODE>
__device__ __forceinline__ void store_tile_bf16(const AccT& acc, bf16_t* base, int ldc, int row0, int col0, const float* bias, const float ascale = 1.f) {
#pragma unroll
    for (int ai = 0; ai < 2; ++ai)
#pragma unroll
        for (int m = 0; m < 4; ++m) { bf16_t* rowp = base + (size_t)(row0 + ai * 128 + m * 16) * ldc + col0;
#pragma unroll
            for (int bj = 0; bj < 2; ++bj) { f32x4 v0 = acc[ai][bj][m][0], v1 = acc[ai][bj][m][1];
                if (MODE == 1) { _Pragma("unroll") for (int e = 0; e < 4; ++e) { v0[e] = gelu_tanh(v0[e]); v1[e] = gelu_tanh(v1[e]); } }
                if (MODE == 2) { const f32x4 b0 = *(const f32x4*)(bias + col0 + bj * 128), b1 = *(const f32x4*)(bias + col0 + bj * 128 + 4);
                    v0 = v0 * ascale + b0; v1 = v1 * ascale + b1; _Pragma("unroll") for (int e = 0; e < 4; ++e) { v0[e] = sigmoid_(v0[e]); v1[e] = sigmoid_(v1[e]); } }
                *(u32x4*)(rowp + bj * 128) = pack8(v0, v1); }
            if (MODE == 2) asm volatile("" ::: "memory"); }
}
struct SchedP1a { const char* H; const char* WT; const char* MEMN; const char* WTM; int G, c;
    __device__ __forceinline__ bool next(int i, pg8::Unit& u) const {
        const int L = i * G + c; const int n1 = 64 * 18;
        if (L < n1) { pg8::tile_of(L, 64, 18, u.pm, u.pn); u.kind = 0; u.A = H + (size_t)u.pm * 256 * D * 2; u.B = WT + (size_t)u.pn * 256 * D * 2; u.nt = D / 64; pg8::uni(u); return true; }
        if (L < n1 + 8) { const int j = L - n1; u.pm = j >> 2; u.pn = j & 3; u.kind = 1; u.A = MEMN + (size_t)u.pm * 256 * D * 2; u.B = WTM + (size_t)u.pn * 256 * D * 2; u.nt = D / 64; pg8::uni(u); return true; }
        return false; } };
struct EpiP1a { bf16_t* PROJ; bf16_t* MEMKV; const float* gq; const float* gk; const float* gc; const float* gmk; LAS float* xs; EPI_RESET_ALWAYS
    __device__ __forceinline__ void operator()(AccT& acc, const pg8::Unit& u, int wr, int wc, int fr, int fq) const {
        const int row0 = u.pm * 256 + wr * 64 + fr, cl = wc * 32 + 8 * fq;
        const float* g = nullptr; float qs = 1.f;
        if (u.kind == 1) { if (u.pn < 2) g = gmk; }
        else if (u.pn < 4) { g = gq; qs = 0.08838834764831845f; } else if (u.pn < 8) g = gk; else if (u.pn >= 16) { g = gc; qs = 0.08838834764831845f; }
        if (g) {
#pragma unroll
            for (int ai = 0; ai < 2; ++ai)
#pragma unroll
                for (int m = 0; m < 4; ++m)
#pragma unroll
                    for (int bj = 0; bj < 2; ++bj) { const f32x4 v0 = acc[ai][bj][m][0], v1 = acc[ai][bj][m][1];
                        float sq = (v0[0] * v0[0] + v0[1] * v0[1]) + (v0[2] * v0[2] + v0[3] * v0[3]) + (v1[0] * v1[0] + v1[1] * v1[1]) + (v1[2] * v1[2] + v1[3] * v1[3]);
                        sq += __shfl_xor(sq, 16); sq += __shfl_xor(sq, 32);
                        if (fq == 0) xs[((ai * 128 + wr * 64 + m * 16 + fr) * 2 + bj) * 4 + wc] = sq; asm volatile("" ::: "memory"); }
            asm volatile("s_waitcnt lgkmcnt(0)" ::: "memory"); __builtin_amdgcn_s_barrier(); asm volatile("" ::: "memory");
#pragma unroll
            for (int ai = 0; ai < 2; ++ai)
#pragma unroll
                for (int m = 0; m < 4; ++m)
#pragma unroll
                    for (int bj = 0; bj < 2; ++bj) { const f32x4 pp = *(const LAS f32x4*)(xs + ((ai * 128 + wr * 64 + m * 16 + fr) * 2 + bj) * 4);
                        const float rs = rsqrtf(((pp[0] + pp[1]) + (pp[2] + pp[3])) * (1.f / 128.f) + EPS) * qs;
                        const f32x4 g0 = *(const f32x4*)(g + cl), g1 = *(const f32x4*)(g + cl + 4);
                        acc[ai][bj][m][0] = acc[ai][bj][m][0] * g0 * rs; acc[ai][bj][m][1] = acc[ai][bj][m][1] * g1 * rs; asm volatile("" ::: "memory"); }
            asm volatile("s_waitcnt lgkmcnt(0)" ::: "memory"); __builtin_amdgcn_s_barrier(); asm volatile("" ::: "memory");
        }
        if (u.kind == 1) { store_tile_bf16<0>(acc, MEMKV, 2 * CW, row0, u.pn * 256 + cl, nullptr); return; }
        if (u.pn == 14 || u.pn == 15) { store_tile_bf16<1>(acc, PROJ, INW, row0, u.pn * 256 + cl, nullptr); return; }
        store_tile_bf16<0>(acc, PROJ, INW, row0, u.pn * 256 + cl, nullptr);
    } };
struct SchedG { const char* H8; const char* WT8; int G, c, ti;
    __device__ __forceinline__ bool next(int i, pg8::Unit& u) const {
        const int L = ti * G + c; if (i >= 3 || L >= 64 * 8) return false;
        int pn8; pg8::tile_of(L, 64, 8, u.pm, pn8); u.pn = pn8 + 8 * i; u.kind = i; u.A = H8 + (size_t)u.pm * 256 * D; u.B = WT8 + (size_t)u.pn * 256 * D; u.nt = D / 128; pg8::uni(u); return true; } };
struct EpiG { u32x4* slab; const float* bgate; EPI_RESET_ALWAYS
    __device__ __forceinline__ void operator()(AccT& acc, const pg8::Unit& u, int wr, int wc, int fr, int fq) const {
        const int tid = (wr * 4 + wc) * 64 + fq * 16 + fr, col0 = u.pn * 256 + wc * 32 + 8 * fq;
        u32x4* sp = slab + (size_t)u.kind * (16 * 512) + tid; const float ascale = 1.f / GATE_WSCALE;
#pragma unroll
        for (int ai = 0; ai < 2; ++ai)
#pragma unroll
            for (int m = 0; m < 4; ++m) {
#pragma unroll
                for (int bj = 0; bj < 2; ++bj) { f32x4 v0 = acc[ai][bj][m][0], v1 = acc[ai][bj][m][1];
                    const f32x4 b0 = *(const f32x4*)(bgate + col0 + bj * 128), b1 = *(const f32x4*)(bgate + col0 + bj * 128 + 4);
                    v0 = v0 * ascale + b0; v1 = v1 * ascale + b1;
                    _Pragma("unroll") for (int e = 0; e < 4; ++e) { v0[e] = 1.f + __builtin_amdgcn_exp2f(fminf(v0[e], 40.f)); v1[e] = 1.f + __builtin_amdgcn_exp2f(fminf(v1[e], 40.f)); }
                    sp[((ai * 4 + m) * 2 + bj) * 512] = pack8(v0, v1); }
                asm volatile("" ::: "memory"); }
    } };
struct SchedP3 { const char* O; const char* WT; int G, c, ti;
    __device__ __forceinline__ bool next(int i, pg8::Unit& u) const {
        const int seg = i; const int L = ti * G + c; if (i >= 3 || L >= 64 * 8) return false;
        pg8::tile_of(L, 64, 8, u.pm, u.pn); u.kind = seg;
        const int kb = seg == 0 ? 0 : (seg == 1 ? 1024 : 1536);
        u.A = O + ((size_t)u.pm * 256 * D + kb) * 2; u.B = WT + ((size_t)u.pn * 256 * D + kb) * 2; u.nt = seg == 0 ? 16 : 8; pg8::uni(u); return true; } };
struct EpiP3 { const u32x4* slab; bf16_t* MERGED;
    __device__ __forceinline__ bool reset(const pg8::Unit& u) const { return u.kind == 2; }
    __device__ __forceinline__ void operator()(AccT& acc, const pg8::Unit& u, int wr, int wc, int fr, int fq) const {
        const int row0 = u.pm * 256 + wr * 64 + fr, col0 = u.pn * 256 + wc * 32 + 8 * fq, seg = u.kind;
        const u32x4* sa = slab + (size_t)seg * (16 * 512) + ((wr * 4 + wc) * 64 + fq * 16 + fr);
#pragma unroll
        for (int ai = 0; ai < 2; ++ai) {
                u32x4 ga[4][2], gb[4][2];
#pragma unroll
                for (int m = 0; m < 4; ++m)
#pragma unroll
                    for (int bj = 0; bj < 2; ++bj) { const u32x4* gp = sa + ((ai * 4 + m) * 2 + bj) * 512;
                        ga[m][bj] = gp[0]; gb[m][bj] = (seg < 2) ? gp[16 * 512] : (u32x4){0u, 0u, 0u, 0u}; }
#pragma unroll
                for (int m = 0; m < 4; ++m)
#pragma unroll
                    for (int bj = 0; bj < 2; ++bj) {
                        float fa[8], fb[8]; unpack8(ga[m][bj], fa); unpack8(gb[m][bj], fb);
                        if (seg < 2) { _Pragma("unroll") for (int e = 0; e < 8; ++e) fa[e] = fb[e] * __builtin_amdgcn_rcpf(fa[e]); }
                        else { _Pragma("unroll") for (int e = 0; e < 8; ++e) fa[e] = __builtin_amdgcn_rcpf(fa[e]); }
                        f32x4& v0 = acc[ai][bj][m][0]; f32x4& v1 = acc[ai][bj][m][1];
                        v0[0] *= fa[0]; v0[1] *= fa[1]; v0[2] *= fa[2]; v0[3] *= fa[3]; v1[0] *= fa[4]; v1[1] *= fa[5]; v1[2] *= fa[6]; v1[3] *= fa[7];
                        if (seg == 2) *(u32x4*)(MERGED + (size_t)(row0 + ai * 128 + m * 16) * D + col0 + bj * 128) = pack8(v0, v1);
                    }
                asm volatile("" ::: "memory");
            }
    } };
struct SchedSq { const char* A; const char* WT; int G, c;
    __device__ __forceinline__ bool next(int i, pg8::Unit& u) const {
        const int L = i * G + c; if (L >= 64 * 8) return false;
        pg8::tile_of(L, 64, 8, u.pm, u.pn); u.kind = 0; u.A = A + (size_t)u.pm * 256 * D * 2; u.B = WT + (size_t)u.pn * 256 * D * 2; u.nt = D / 64; pg8::uni(u); return true; } };
struct EpiP4 { const float* x; float* out; bf16_t* xb; float* ss; unsigned char* x8; EPI_RESET_ALWAYS
    __device__ __forceinline__ void operator()(AccT& acc, const pg8::Unit& u, int wr, int wc, int fr, int fq) const {
        const int row0 = u.pm * 256 + wr * 64 + fr, col0 = u.pn * 256 + wc * 32 + 8 * fq;
#pragma unroll
        for (int ai = 0; ai < 2; ++ai) {
            f32x4 xv[4][2][2];
#pragma unroll
            for (int m = 0; m < 4; ++m)
#pragma unroll
                for (int bj = 0; bj < 2; ++bj) { const size_t o = (size_t)(row0 + ai * 128 + m * 16) * D + col0 + bj * 128; xv[m][bj][0] = *(const f32x4*)(x + o); xv[m][bj][1] = *(const f32x4*)(x + o + 4); }
#pragma unroll
            for (int m = 0; m < 4; ++m) { const size_t row = (size_t)(row0 + ai * 128 + m * 16); float sq = 0.f;
#pragma unroll
                for (int bj = 0; bj < 2; ++bj) { const size_t o = row * D + col0 + bj * 128;
                    const f32x4 v0 = acc[ai][bj][m][0] + xv[m][bj][0], v1 = acc[ai][bj][m][1] + xv[m][bj][1];
                    *(u32x4*)(xb + o) = pack8(v0, v1);
#define F8X(x_) fminf(fmaxf((x_), -448.f), 448.f)
                    { int w0 = __builtin_amdgcn_cvt_pk_fp8_f32(F8X(v0[0]), F8X(v0[1]), 0, false); w0 = __builtin_amdgcn_cvt_pk_fp8_f32(F8X(v0[2]), F8X(v0[3]), w0, true);
                      int w1 = __builtin_amdgcn_cvt_pk_fp8_f32(F8X(v1[0]), F8X(v1[1]), 0, false); w1 = __builtin_amdgcn_cvt_pk_fp8_f32(F8X(v1[2]), F8X(v1[3]), w1, true);
                      *(u32x2*)(x8 + o) = (u32x2){(unsigned)w0, (unsigned)w1}; }
                    sq += (v0[0] * v0[0] + v0[1] * v0[1]) + (v0[2] * v0[2] + v0[3] * v0[3]) + (v1[0] * v1[0] + v1[1] * v1[1]) + (v1[2] * v1[2] + v1[3] * v1[3]); }
                sq += __shfl_xor(sq, 16); sq += __shfl_xor(sq, 32);
                if (fq == 0) atomicAdd(ss + row, sq); }
        }
    } };
struct EpiP5 { bf16_t* Q; const float* ss; EPI_RESET_ALWAYS
    __device__ __forceinline__ void operator()(AccT& acc, const pg8::Unit& u, int wr, int wc, int fr, int fq) const {
        const int row0 = u.pm * 256 + wr * 64 + fr, col0 = u.pn * 256 + wc * 32 + 8 * fq;
#pragma unroll
        for (int ai = 0; ai < 2; ++ai)
#pragma unroll
            for (int m = 0; m < 4; ++m) { const size_t row = (size_t)(row0 + ai * 128 + m * 16); const float rs = rsqrtf(ss[row] * (1.f / D) + EPS);
#pragma unroll
                for (int bj = 0; bj < 2; ++bj) *(u32x4*)(Q + row * D + col0 + bj * 128) = pack8(acc[ai][bj][m][0] * rs, acc[ai][bj][m][1] * rs); }
    } };


namespace att {
using s16x4  = __attribute__((ext_vector_type(4))) short;
using f32x16 = __attribute__((ext_vector_type(16))) float;
constexpr int NWV = 8, QBLK = 32, KVBLK = 64, DH = 128;
constexpr float THR = 8.f;
constexpr int SHM_V = KVBLK * DH * 2, SHM_K = KVBLK * DH * 2;
constexpr int OFF_WS = 2 * SHM_V + 2 * SHM_K, OFF_BT = OFF_WS + NWV * 64 * 4, OFF_OST = OFF_BT + 1536, LDS_NEED = OFF_OST + NWV * 8192;
#define KSWZ(row, colB) ((row) * 256 + ((colB) ^ (((row) & 7) << 4)))
#define SBAR() __builtin_amdgcn_sched_barrier(0)
__device__ __forceinline__ int crow(int r, int hi) { return (r & 3) + 8 * (r >> 2) + 4 * hi; }
__device__ __forceinline__ unsigned cvtpk(float lo, float hi) { unsigned r; asm volatile("v_cvt_pk_bf16_f32 %0, %1, %2" : "=v"(r) : "v"(lo), "v"(hi)); return r; }
__device__ __forceinline__ void partialSM(f32x16& p0, f32x16& p1, float& m_reg, float& mn, float& alpha) {
  constexpr float C = 1.4426950408889634f;
  float pmax = p0[0];
#pragma unroll
  for (int r = 1; r < 16; ++r) pmax = fmaxf(pmax, p0[r]);
#pragma unroll
  for (int r = 0; r < 16; ++r) pmax = fmaxf(pmax, p1[r]);
  { auto rr = __builtin_amdgcn_permlane32_swap(__float_as_uint(pmax), __float_as_uint(pmax), false, false);
    pmax = fmaxf(__uint_as_float(rr[0]), __uint_as_float(rr[1])); }
  if (__builtin_expect(__all(pmax - m_reg <= THR), 1)) { mn = m_reg; alpha = 1.f; }
  else { mn = fmaxf(m_reg, pmax); alpha = __builtin_amdgcn_exp2f((m_reg - mn) * C); m_reg = mn; }
  float mnC = -mn * C;
#pragma unroll
  for (int r = 0; r < 16; ++r) p0[r] = fmaf(p0[r], C, mnC);
#pragma unroll
  for (int r = 0; r < 16; ++r) p1[r] = fmaf(p1[r], C, mnC);
#pragma unroll
  for (int r = 0; r < 16; ++r) p0[r] = __builtin_amdgcn_exp2f(p0[r]);
}
__device__ __forceinline__ void finishSM(f32x16& p0, f32x16& p1, float alpha, float& l_reg, bf16x8& pa0, bf16x8& pa1, bf16x8& pa2, bf16x8& pa3) {
#pragma unroll
  for (int r = 0; r < 16; ++r) p1[r] = __builtin_amdgcn_exp2f(p1[r]);
  float ps = 0;
#pragma unroll
  for (int r = 0; r < 16; ++r) ps += p0[r];
#pragma unroll
  for (int r = 0; r < 16; ++r) ps += p1[r];
  { auto rr = __builtin_amdgcn_permlane32_swap(__float_as_uint(ps), __float_as_uint(ps), false, false);
    ps = __uint_as_float(rr[0]) + __uint_as_float(rr[1]); }
  l_reg = l_reg * alpha + ps;
#define PK4(P, BASE, OUT) do { unsigned a0 = cvtpk(P[BASE + 0], P[BASE + 1]), a1 = cvtpk(P[BASE + 2], P[BASE + 3]);   \
    unsigned b0 = cvtpk(P[BASE + 4], P[BASE + 5]), b1 = cvtpk(P[BASE + 6], P[BASE + 7]);                              \
    auto r0 = __builtin_amdgcn_permlane32_swap(a0, b0, false, false); auto r1 = __builtin_amdgcn_permlane32_swap(a1, b1, false, false); \
    u32x4 w = {r0[0], r1[0], r0[1], r1[1]}; OUT = *reinterpret_cast<bf16x8*>(&w); } while (0)
  PK4(p0, 0, pa0); PK4(p0, 8, pa1); PK4(p1, 0, pa2); PK4(p1, 8, pa3);
#undef PK4
}
template <bool BIAS>
__device__ __forceinline__ void qkt(f32x16& p0, f32x16& p1, const LAS char* Ks, const LAS char* qs, int r32, int hi, const LAS float* bp) {
  if (BIAS) {
#pragma unroll
    for (int r = 0; r < 16; ++r) { p0[r] = bp[(r & 3) + 8 * (r >> 2)]; p1[r] = bp[32 + (r & 3) + 8 * (r >> 2)]; }
  } else { p0 = f32x16{}; p1 = f32x16{}; }
#pragma unroll
  for (int d0 = 0; d0 < 8; ++d0) { int cb = (d0 * 16 + hi * 8) * 2;
    bf16x8 b0 = *reinterpret_cast<const LAS bf16x8*>(Ks + KSWZ(r32, cb));
    bf16x8 b1 = *reinterpret_cast<const LAS bf16x8*>(Ks + KSWZ(32 + r32, cb));
    const bf16x8 qv = *reinterpret_cast<const LAS bf16x8*>(qs + d0 * 1024);
    p0 = __builtin_amdgcn_mfma_f32_32x32x16_bf16(b0, qv, p0, 0, 0, 0);
    p1 = __builtin_amdgcn_mfma_f32_32x32x16_bf16(b1, qv, p1, 0, 0, 0); }
}
__device__ __forceinline__ int v_st(int k, int c) { const int kk = (k & ~0xC) | ((k & 4) << 1) | ((k & 8) >> 1); return ((kk >> 3) * 4 + (c >> 5)) * 512 + ((kk & 7) * 32 + (c & 31)) * 2; }
__device__ __forceinline__ int v_rd_base(int lane) { return ((lane & 3) << 3) | (((lane >> 2) & 3) << 6) | (((lane >> 4) & 1) << 5) | (((lane >> 5) & 1) << 8); }
constexpr int v_rd_off(int d0, int ks, int half) { return d0 * 512 + ks * 4096 + half * 2048; }
template <int OFF> __device__ __forceinline__ s16x4 tr_read(int vb) {
  s16x4 r; asm volatile("ds_read_b64_tr_b16 %0, %1 offset:%2" : "=&v"(r) : "v"(vb), "i"(OFF) : "memory"); return r;
}
template <int D0> __device__ __forceinline__ void pv_one(f32x16& od, int vb, bf16x8 pa0, bf16x8 pa1, bf16x8 pa2, bf16x8 pa3) {
  const s16x4 l0 = tr_read<v_rd_off(D0, 0, 0)>(vb), h0 = tr_read<v_rd_off(D0, 0, 1)>(vb), l1 = tr_read<v_rd_off(D0, 1, 0)>(vb), h1 = tr_read<v_rd_off(D0, 1, 1)>(vb);
  const s16x4 l2 = tr_read<v_rd_off(D0, 2, 0)>(vb), h2 = tr_read<v_rd_off(D0, 2, 1)>(vb), l3 = tr_read<v_rd_off(D0, 3, 0)>(vb), h3 = tr_read<v_rd_off(D0, 3, 1)>(vb);
  asm volatile("s_waitcnt lgkmcnt(0)" ::: "memory"); SBAR();
#define PK(L, H) (bf16x8){L[0], L[1], L[2], L[3], H[0], H[1], H[2], H[3]}
  od = __builtin_amdgcn_mfma_f32_32x32x16_bf16(pa0, PK(l0, h0), od, 0, 0, 0);
  od = __builtin_amdgcn_mfma_f32_32x32x16_bf16(pa1, PK(l1, h1), od, 0, 0, 0);
  od = __builtin_amdgcn_mfma_f32_32x32x16_bf16(pa2, PK(l2, h2), od, 0, 0, 0);
  od = __builtin_amdgcn_mfma_f32_32x32x16_bf16(pa3, PK(l3, h3), od, 0, 0, 0);
#undef PK
}
__device__ __forceinline__ void pv_d0(f32x16* o, int vb, bf16x8 pa0, bf16x8 pa1, bf16x8 pa2, bf16x8 pa3) {
  pv_one<0>(o[0], vb, pa0, pa1, pa2, pa3); pv_one<1>(o[1], vb, pa0, pa1, pa2, pa3); pv_one<2>(o[2], vb, pa0, pa1, pa2, pa3); pv_one<3>(o[3], vb, pa0, pa1, pa2, pa3);
}
template <int LDQ, int LDK, int LDO, bool BAND>
__device__ __forceinline__ void attn_body(const bf16_t* Qb, const bf16_t* Kh, const bf16_t* Vh, bf16_t* Ob,
                                          const int NT, const int kc0, const float* btab_src, LAS char* lds, const int wid) {
  const int lane = fresh_lane(), tid = wid * 64 + lane, r32 = lane & 31, hi = lane >> 5;
  LAS char* V_lds = lds; LAS char* K_lds = lds + 2 * SHM_V;
  LAS float* wsf = (LAS float*)(lds + OFF_WS) + wid * 64; LAS float* li_l = wsf; LAS float* al_l = wsf + 32;
  LAS float* btab = (LAS float*)(lds + OFF_BT);
  if (BAND) { if (tid < 384) btab[tid] = tid < 64 ? btab_src[256] : (tid < 256 ? btab_src[320 - tid] : -30000.f); }
  float m_reg = -10000.f, l_reg = 0; f32x16 o[4] = {};
  const bf16_t* Qw = Qb + (long)(wid * QBLK + r32) * LDQ + hi * 8;
  LAS char* qr = lds + OFF_OST + wid * 8192 + lane * 16;
#pragma unroll
  for (int d0 = 0; d0 < 8; ++d0) *reinterpret_cast<LAS bf16x8*>(qr + d0 * 1024) = *reinterpret_cast<const bf16x8*>(Qw + d0 * 16);
  const int sr = tid >> 4, sc = (tid & 15) * 8, vst0 = v_st(sr, sc), vst1 = v_st(32 + sr, sc);
  const int vb0 = (int)(unsigned)(uintptr_t)V_lds + v_rd_base(lane);
  struct { bf16x8 vs0, vs1, ks0, ks1; } sr_[1];
  const int pw = wid >> 1, qi = (wid & 1) * 32 + r32;
#define TROW(t) ((BAND ? (((kc0) + (t)) > 0 ? ((kc0) + (t)) : 0) : (t)) * KVBLK)
#define SLOAD(i, t) do { const long k0_ = TROW(t); sr_[i].vs0 = *reinterpret_cast<const bf16x8*>(&Vh[(k0_ + sr) * LDK + sc]); sr_[i].vs1 = *reinterpret_cast<const bf16x8*>(&Vh[(k0_ + 32 + sr) * LDK + sc]); \
    sr_[i].ks0 = *reinterpret_cast<const bf16x8*>(&Kh[(k0_ + sr) * LDK + sc]); sr_[i].ks1 = *reinterpret_cast<const bf16x8*>(&Kh[(k0_ + 32 + sr) * LDK + sc]); } while (0)
#define SWRITE(b, i) do { *(LAS bf16x8*)(V_lds + (b) * SHM_V + vst0) = sr_[i].vs0; *(LAS bf16x8*)(V_lds + (b) * SHM_V + vst1) = sr_[i].vs1; int kc_ = sc * 2; \
    *(LAS bf16x8*)(K_lds + (b) * SHM_K + KSWZ(sr, kc_)) = sr_[i].ks0; *(LAS bf16x8*)(K_lds + (b) * SHM_K + KSWZ(32 + sr, kc_)) = sr_[i].ks1; } while (0)
#define SWAIT() asm volatile("s_waitcnt vmcnt(0)" ::: "memory")
#define RESC(a) do { if (__any((a) < 1.f)) { if (hi == 0) al_l[r32] = (a); asm volatile("s_waitcnt lgkmcnt(0)" ::: "memory"); \
    _Pragma("unroll") for (int d = 0; d < 4; ++d) _Pragma("unroll") for (int r = 0; r < 16; ++r) o[d][r] *= al_l[crow(r, hi)]; } } while (0)
#define BPTR(t) ({ const int t_ = (t); const int dch = pw + 8 - t_; int kb_ = 192 - dch * 64 - qi + 4 * hi; kb_ = kb_ < 0 ? 0 : kb_; \
    if (dch < 0 || dch > 8 || (kc0) + t_ < 0) kb_ = 288; (const LAS float*)(btab + kb_); })
  f32x16 pA0, pA1, pB0, pB1; float mnA, mnB, alA, alB; bf16x8 pa0, pa1, pa2, pa3;
  constexpr int SE = 0, SO = 0;
#define ACT(t) (!BAND || ((pw + 8 - (t)) >= 0 && (pw + 8 - (t)) <= 8 && (kc0) + (t) >= 0))
  SLOAD(SE, 0); asm volatile("s_waitcnt vmcnt(0)" ::: "memory"); SWRITE(0, SE); __syncthreads();
  if (ACT(0)) { qkt<BAND>(pA0, pA1, K_lds, qr, r32, hi, BPTR(0)); partialSM(pA0, pA1, m_reg, mnA, alA); }
  SLOAD(SO, 1);
  SWAIT(); SWRITE(1, SO); __syncthreads();
  for (int j = 1; j + 1 < NT; j += 2) {
    const bool a0_ = ACT(j - 1), a1_ = ACT(j), a2_ = ACT(j + 1);
    SBAR(); if (a1_) qkt<BAND>(pB0, pB1, K_lds + SHM_K, qr, r32, hi, BPTR(j));
    if (a0_) finishSM(pA0, pA1, alA, l_reg, pa0, pa1, pa2, pa3); SBAR();
    SLOAD(SO, j + 1); SBAR();
    if (a0_) pv_d0(o, vb0, pa0, pa1, pa2, pa3); if (a1_) partialSM(pB0, pB1, m_reg, mnB, alB);
    __syncthreads(); SWAIT(); SWRITE(0, SE);
    if (a1_) RESC(alB); __syncthreads();
    SBAR(); if (a2_) qkt<BAND>(pA0, pA1, K_lds, qr, r32, hi, BPTR(j + 1));
    if (a1_) finishSM(pB0, pB1, alB, l_reg, pa0, pa1, pa2, pa3); SBAR();
    SLOAD(SE, j + 2); SBAR();
    if (a1_) pv_d0(o, vb0 + SHM_V, pa0, pa1, pa2, pa3); if (a2_) partialSM(pA0, pA1, m_reg, mnA, alA);
    __syncthreads(); SWAIT(); SWRITE(1, SO);
    if (a2_) RESC(alA); __syncthreads();
  }
  { const bool a0_ = ACT(NT - 2), a1_ = ACT(NT - 1);
    SBAR(); if (a1_) qkt<BAND>(pB0, pB1, K_lds + SHM_K, qr, r32, hi, BPTR(NT - 1));
    if (a0_) finishSM(pA0, pA1, alA, l_reg, pa0, pa1, pa2, pa3); SBAR();
    if (a0_) pv_d0(o, vb0, pa0, pa1, pa2, pa3); if (a1_) partialSM(pB0, pB1, m_reg, mnB, alB);
    __syncthreads(); if (a1_) RESC(alB);
    if (a1_) { finishSM(pB0, pB1, alB, l_reg, pa0, pa1, pa2, pa3); SBAR();
      pv_d0(o, vb0 + SHM_V, pa0, pa1, pa2, pa3); } }
#undef ACT
  if (hi == 0) li_l[r32] = l_reg; asm volatile("s_waitcnt lgkmcnt(0)" ::: "memory");
  float rli[16];
#pragma unroll
  for (int r = 0; r < 16; ++r) rli[r] = __builtin_amdgcn_rcpf(li_l[crow(r, hi)]);
  { LAS bf16_t* stg = (LAS bf16_t*)(lds + OFF_OST + wid * 8192);
#pragma unroll
    for (int r = 0; r < 16; ++r) { const int orow = crow(r, hi);
#pragma unroll
      for (int d0 = 0; d0 < 4; ++d0) stg[orow * 128 + d0 * 32 + r32] = (bf16_t)f2bf(o[d0][r] * rli[r]); }
    asm volatile("s_waitcnt lgkmcnt(0)" ::: "memory");
    bf16_t* Ow = Ob + (long)(wid * QBLK) * LDO;
#pragma unroll
    for (int i = 0; i < 8; ++i) { const int row = i * 4 + (lane >> 4), ch = lane & 15; const u32x4 v = *(const LAS u32x4*)(stg + row * 128 + ch * 8); *(u32x4*)(Ow + (long)row * LDO + ch * 8) = v; } }
  __syncthreads();
#undef TROW
#undef SLOAD
#undef SWRITE
#undef SWAIT
#undef RESC
#undef BPTR
}
#undef KSWZ
#undef SBAR
}


namespace rt {
using f32x16 = __attribute__((ext_vector_type(16))) float;
#define RKSWZ(row, colB) ((row) * 256 + ((colB) ^ (((row) & 7) << 4)))
__device__ __forceinline__ int crow(int r, int hi) { return (r & 3) + 8 * (r >> 2) + 4 * hi; }
__device__ __forceinline__ void ce_desc(unsigned& a, unsigned& b) { const unsigned mx = a > b ? a : b, mn = a > b ? b : a; a = mx; b = mn; }
__device__ __forceinline__ void sort16_desc(unsigned (&v)[16]) {
#pragma unroll
  for (int k = 2; k <= 16; k <<= 1)
#pragma unroll
    for (int j = k >> 1; j > 0; j >>= 1)
#pragma unroll
      for (int i = 0; i < 16; ++i) { const int l = i ^ j; if (l > i) { if ((i & k) == 0) ce_desc(v[i], v[l]); else ce_desc(v[l], v[i]); } }
}
__device__ __forceinline__ void merge16_desc(unsigned (&a)[16], const unsigned (&b)[16]) {
#pragma unroll
  for (int i = 0; i < 16; ++i) a[i] = a[i] > b[15 - i] ? a[i] : b[15 - i];
#pragma unroll
  for (int j = 8; j > 0; j >>= 1)
#pragma unroll
    for (int i = 0; i < 16; ++i) { const int l = i ^ j; if (l > i) ce_desc(a[i], a[l]); }
}
__device__ __forceinline__ unsigned fkey(float f) { const unsigned u = __float_as_uint(f); return (u & 0x80000000u) ? ~u : (u | 0x80000000u); }
__device__ __forceinline__ float fkey_inv(unsigned k) { const unsigned u = (k & 0x80000000u) ? (k & 0x7fffffffu) : ~k; return __uint_as_float(u); }
__device__ __forceinline__ void top16_half(const f32x16 (&sc)[4], int hi, unsigned (&out)[16]) {
  unsigned g[16];
#pragma unroll
  for (int blk = 0; blk < 4; ++blk) {
#pragma unroll
    for (int r = 0; r < 16; ++r) g[r] = (fkey(sc[blk][r]) & 0xFFFFFF80u) | (unsigned)(32 * blk + (r & 3) + 8 * (r >> 2) + 4 * hi);
    sort16_desc(g);
    if (blk == 0) {
#pragma unroll
      for (int r = 0; r < 16; ++r) out[r] = g[r];
    } else merge16_desc(out, g);
  }
  unsigned pb[16];
#pragma unroll
  for (int r = 0; r < 16; ++r) { auto rr = __builtin_amdgcn_permlane32_swap(out[r], out[r], false, false); pb[r] = hi ? rr[0] : rr[1]; }
  merge16_desc(out, pb);
}
__device__ __forceinline__ void route_phase(const Params& p, LAS unsigned char* lds, int wave) {
  const int lane = fresh_lane(), tid = wave * 64 + lane;
  const bf16_t* Q = (const bf16_t*)(p.ws + WS_Q); const bf16_t* KB = (const bf16_t*)(p.ws + WS_KEYSB);
  int* RIDX = (int*)(p.ws + WS_RIDX); float* RG = (float*)(p.ws + WS_RG);
  const int h = blockIdx.x & 7, grp = blockIdx.x >> 3;
  const int r32 = lane & 31, hi = lane >> 5;
#pragma unroll
  for (int c = 0; c < 2; ++c)
#pragma unroll
    for (int rep = 0; rep < 4; ++rep) { const int row = rep * 32 + (tid >> 4), cb = (tid & 15) * 16;
      *(LAS u32x4*)(lds + c * 32768 + RKSWZ(row, cb)) = *(const u32x4*)((const char*)KB + ((size_t)(h * 2 + c) * 128 + row) * 256 + cb); }
  __syncthreads();
  for (int tb = grp * 8 + wave; tb < T / 32; tb += (int)(gridDim.x >> 3) * 8) {
    const int t = tb * 32 + r32;
    unsigned ka[16], kb2[16];
#pragma unroll
    for (int c = 0; c < 2; ++c) {
      bf16x8 qf[8];
      const bf16_t* qp = Q + (size_t)t * D + h * 256 + c * 128 + hi * 8;
#pragma unroll
      for (int ks = 0; ks < 8; ++ks) qf[ks] = *(const bf16x8*)(qp + ks * 16);
      f32x16 sc[4];
#pragma unroll
      for (int blk = 0; blk < 4; ++blk) { sc[blk] = f32x16{};
#pragma unroll
        for (int ks = 0; ks < 8; ++ks) { const bf16x8 kf = *(const LAS bf16x8*)(lds + c * 32768 + RKSWZ(32 * blk + r32, (16 * ks + 8 * hi) * 2));
          sc[blk] = __builtin_amdgcn_mfma_f32_32x32x16_bf16(kf, qf[ks], sc[blk], 0, 0, 0); } }
      if (c == 0) top16_half(sc, hi, ka); else top16_half(sc, hi, kb2);
    }
    float av[16], bv[16];
#pragma unroll
    for (int i = 0; i < 16; ++i) { av[i] = fkey_inv(ka[i] & 0xFFFFFF80u); bv[i] = fkey_inv(kb2[i] & 0xFFFFFF80u); }
    float T[16];
#pragma unroll
    for (int k = 0; k < 16; ++k) T[k] = -3.0e38f;
#pragma unroll
    for (int i = 0; i < 16; ++i)
#pragma unroll
      for (int j = 0; j < 16; ++j) if ((i + 1) * (j + 1) <= 16) { float v = av[i] + bv[j];
#pragma unroll
          for (int k = 0; k < 16; ++k) { const float mx = fmaxf(T[k], v); v = fminf(T[k], v); T[k] = mx; } }
    const float m = T[0], theta = T[15];
    float Z = 0.f;
#pragma unroll
    for (int k = 0; k < 16; ++k) Z += __expf(T[k] - m);
    const float rz = 1.f / Z;
    int slot = 0; int cn = 0;
    int* ip = RIDX + (size_t)t * 128 + h * 16; float* gp = RG + (size_t)t * 128 + h * 16;
#pragma unroll
    for (int i = 0; i < 16; ++i)
#pragma unroll
      for (int j = 0; j < 16; ++j) if ((i + 1) * (j + 1) <= 16) { const float v = av[i] + bv[j];
          const bool sel = (v >= theta) && (slot < 16);
          if (sel && ((cn & 1) == hi)) { ip[slot] = (int)((ka[i] & 127u) * 128u + (kb2[j] & 127u)); gp[slot] = __expf(v - m) * rz; }
          slot += sel ? 1 : 0; ++cn; }
  }
}
#undef RKSWZ
}

#define XB_TMO      128
#define XB_XCNT(j)  (256  + 64 * (j))
#define XB_XSUB(j)  (1280 + 64 * (j))
#define XB_XGEN(j)  (2304 + 64 * (j))
#define XB_TOP      3328
#define XB_TOPGEN   3392
#define XCD_BAR_WORDS 3456
#define XB_SPIN_CAP (1u << 22)
__device__ __forceinline__ unsigned xb_ld(unsigned* p)              { return __hip_atomic_load(p, __ATOMIC_RELAXED, __HIP_MEMORY_SCOPE_AGENT); }
__device__ __forceinline__ unsigned xb_add(unsigned* p, unsigned v) { return __hip_atomic_fetch_add(p, v, __ATOMIC_RELAXED, __HIP_MEMORY_SCOPE_AGENT); }
__device__ __forceinline__ unsigned xb_xcc_id() { return (unsigned)__builtin_amdgcn_s_getreg((3 << 11) | 20) & 0xFu; }
#define XB_SPIN(cond, bar) do { unsigned _sp = 0; while (cond) { __builtin_amdgcn_s_sleep(1); \
    if ((++_sp & 255u) == 0u) { if (xb_ld(&(bar)[XB_TMO])) break; if (_sp > XB_SPIN_CAP) { atomicAdd(&(bar)[XB_TMO], 1u); break; } } } } while (0)
struct XcdBarrier { unsigned* bar; unsigned x; volatile LAS unsigned* st; int w; };
__device__ __forceinline__ XcdBarrier xcd_barrier_post(unsigned* bar, volatile LAS unsigned* st, const int wave) {
    XcdBarrier b; b.bar = bar; b.x = xb_xcc_id(); b.st = st; b.w = wave;
    if (wave == 0 && fresh_lane() == 0) (void)xb_add(&bar[XB_XCNT(b.x)], 1u);
    return b;
}
__device__ __forceinline__ void xcd_barrier_complete(unsigned* bar, unsigned x, unsigned& nloc, unsigned& nx) {
    const unsigned G = gridDim.x * gridDim.y * gridDim.z;
    unsigned sum, cnt, mine, sp = 0u;
    for (;;) {
        sum = 0u; cnt = 0u; mine = 0u;
#pragma unroll
        for (unsigned j = 0; j < 16; ++j) { const unsigned c = xb_ld(&bar[XB_XCNT(j)]); sum += c; cnt += (c > 0u) ? 1u : 0u; mine = (j == x) ? c : mine; }
        if (sum == G) break;
        __builtin_amdgcn_s_sleep(1);
        if ((++sp & 255u) == 0u) { if (xb_ld(&bar[XB_TMO])) break; if (sp > XB_SPIN_CAP) { atomicAdd(&bar[XB_TMO], 1u); break; } }
    }
    nloc = mine > 0u ? mine : 1u; nx = cnt > 0u ? cnt : 1u;
}
__device__ __forceinline__ void xcd_barrier(const XcdBarrier& b) {
    asm volatile("s_waitcnt vmcnt(0)" ::: "memory");
    __syncthreads();
    if (b.w == 0 && fresh_lane() == 0) {
        unsigned* bar = b.bar;
        __builtin_amdgcn_s_waitcnt(0);
        unsigned nloc = b.st[0], nx = b.st[1];
        if (nloc == 0u) { xcd_barrier_complete(bar, b.x, nloc, nx); b.st[0] = nloc; b.st[1] = nx; }
        const unsigned old = xb_add(&bar[XB_XSUB(b.x)], 1u);
        const unsigned gen = old / nloc;
        if (old + 1u == (gen + 1u) * nloc) {
            __builtin_amdgcn_fence(__ATOMIC_RELEASE, "agent");
            asm volatile("s_waitcnt vmcnt(0)" ::: "memory");
            const unsigned og = xb_add(&bar[XB_TOP], 1u);
            const unsigned tg = og / nx;
            if (og + 1u == (tg + 1u) * nx) xb_add(&bar[XB_TOPGEN], 1u);
            else XB_SPIN(xb_ld(&bar[XB_TOPGEN]) == tg, bar);
            __builtin_amdgcn_fence(__ATOMIC_ACQUIRE, "agent");
            xb_add(&bar[XB_XGEN(b.x)], 1u);
            asm volatile("s_waitcnt vmcnt(0)" ::: "memory");
        } else {
            XB_SPIN(xb_ld(&bar[XB_XGEN(b.x)]) == gen, bar);
            __builtin_amdgcn_fence(__ATOMIC_ACQUIRE, "agent");
            asm volatile("s_waitcnt vmcnt(0)" ::: "memory");
        }
    }
    __syncthreads();
}
constexpr int RING_BYTES = 131072, MISC_OFF = 143360, LDS_BYTES = 147456, NTHREADS = 512;
static_assert(att::LDS_NEED <= MISC_OFF, "attention scratch below the MISC words");
constexpr size_t WS_SLAB = WS_X2BF;

__device__ __forceinline__ void touch_buffer(const void* base, size_t bytes, int cb, int Gd, int tid) {
    const u32x4* b = (const u32x4*)base; const size_t n = bytes / 16, stride = (size_t)Gd * NTHREADS;
    u32x4 acc = {0u, 0u, 0u, 0u};
    for (size_t i = (size_t)cb * NTHREADS + tid; i < n; i += stride) { const u32x4 v = b[i]; acc.x ^= v.x; acc.y ^= v.y; acc.z ^= v.z; acc.w ^= v.w; }
    asm volatile("" :: "v"(acc.x), "v"(acc.y), "v"(acc.z), "v"(acc.w));
}
#define PH_BEGIN(i) unsigned long long t0_##i = 0; if ((PROBE_MASK >> (i)) & 1) t0_##i = __builtin_amdgcn_s_memrealtime();
#define PH_END(i) if ((PROBE_MASK >> (i)) & 1) probe_acc += __builtin_amdgcn_s_memrealtime() - t0_##i;
__global__ void __launch_bounds__(NTHREADS, 2) fwd(Params p) {
    extern __shared__ __attribute__((aligned(16))) unsigned char lds_raw[];
    LAS unsigned char* lds = (LAS unsigned char*)lds_raw;
    volatile LAS unsigned* MISC = (volatile LAS unsigned*)(lds + MISC_OFF);
    const int wave = __builtin_amdgcn_readfirstlane((int)threadIdx.x >> 6);
    const int nwb = NTHREADS / 64;
    const int gw = blockIdx.x * nwb + wave, NW = gridDim.x * nwb;
    const int Gd = gridDim.x, cb = blockIdx.x;
    unsigned char* ws = p.ws;
    bf16_t* WT_IN = (bf16_t*)(ws + WS_WT_IN); bf16_t* WT_GATE = (bf16_t*)(ws + WS_WT_GATE); bf16_t* WT_BR = (bf16_t*)(ws + WS_WT_BR);
    bf16_t* WT_O = (bf16_t*)(ws + WS_WT_O); bf16_t* WT_PQ = (bf16_t*)(ws + WS_WT_PQ); bf16_t* WT_MKV = (bf16_t*)(ws + WS_WT_MKV);
    bf16_t* KEYSB = (bf16_t*)(ws + WS_KEYSB); bf16_t* MEMN = (bf16_t*)(ws + WS_MEMN); bf16_t* MEMKV = (bf16_t*)(ws + WS_MEMKV);
    bf16_t* HO = (bf16_t*)(ws + WS_HO); bf16_t* PROJ = (bf16_t*)(ws + WS_PROJ); bf16_t* G = (bf16_t*)(ws + WS_G);
    bf16_t* MERGED = (bf16_t*)(ws + WS_MERGED); bf16_t* X2BF = (bf16_t*)(ws + WS_X2BF); bf16_t* QB = (bf16_t*)(ws + WS_Q);
        float* SS2 = (float*)(ws + WS_CTL + CTL_SS2_BYTE);
    if ((wave * 64 + fresh_lane()) < 64) MISC[(wave * 64 + fresh_lane())] = 0u;
    __syncthreads();
    XcdBarrier bar = xcd_barrier_post((unsigned*)(ws + WS_CTL + CTL_BAR_BYTE), MISC + 8, wave);
    if ((wave * 64 + fresh_lane()) == 0) MISC[16] = xb_add((unsigned*)(ws + WS_CTL + CTL_RANK_BYTE) + 64 * bar.x, 1u);

    unsigned long long probe_acc = 0;
    PH_BEGIN(0)
    {
        LAS float* scr = (LAS float*)lds + wave * (64 * 33);
        const int I0 = (D / 64) * (INW / 32), I1 = I0 + (D / 64) * (GW / 32), I2 = I1 + (D / 64) * (D / 32), I3 = I2 + (D / 64) * (D / 32), I4 = I3 + (D / 64) * (D / 32), I5 = I4 + (D / 64) * (2 * CW / 32);
#define TRJOB(it, jb, li) do { if ((it) < I0) { jb = TrJob{p.in[3], WT_IN, nullptr, D, INW, 0.f}; li = (it); } else if ((it) < I1) { jb = TrJob{p.in[18], WT_GATE, nullptr, D, GW, GATE_WSCALE * NLOG2E}; li = (it) - I0; } \
            else if ((it) < I2) { jb = TrJob{p.in[20], WT_BR, nullptr, D, D, 0.f}; li = (it) - I1; } else if ((it) < I3) { jb = TrJob{p.in[21], WT_O, nullptr, D, D, 0.f}; li = (it) - I2; } \
            else if ((it) < I4) { jb = TrJob{p.in[23], WT_PQ, p.in[22], D, D, 0.f}; li = (it) - I3; } else { jb = TrJob{p.in[15], WT_MKV, nullptr, D, 2 * CW, 0.f}; li = (it) - I4; } } while (0)
        for (int it = gw; it < I5; it += 2 * NW) {
            TrJob ja, jb2; int la, lb; f32x4 va[8], vb[8];
            TRJOB(it, ja, la); tr_load(ja, la, fresh_lane(), va);
            const bool has2 = it + NW < I5;
            if (has2) { TRJOB(it + NW, jb2, lb); tr_load(jb2, lb, fresh_lane(), vb); }
            tr_store(ja, la, fresh_lane(), va, scr);
            if (has2) tr_store(jb2, lb, fresh_lane(), vb, scr);
        }
#undef TRJOB
        rms_rows(p.in[0], p.in[2], HO, ws + WS_H8, T, gw, NW, fresh_lane());
        rms_rows(p.in[1], p.in[14], MEMN, nullptr, BATCH * NMEM, gw, NW, fresh_lane());
        { float* bg2 = (float*)(ws + WS_CTL + CTL_BG2_BYTE); for (int i = gw * 64 + fresh_lane(); i < GW; i += NW * 64) bg2[i] = p.in[19][i] * NLOG2E; }
        const float* keys = p.in[24];
        for (int i = gw * 64 + fresh_lane(); i < PH * 2 * NKEYS * 128 / 2; i += NW * 64) ((unsigned*)KEYSB)[i] = pk2(keys[2 * i], keys[2 * i + 1]);
    }
    xcd_barrier(bar);
    PH_END(0)
    PH_BEGIN(1)
    {
        SchedP1a Sa{(const char*)HO, (const char*)WT_IN, (const char*)MEMN, (const char*)WT_MKV, Gd, cb};
        EpiP1a Ea{PROJ, MEMKV, p.in[4], p.in[5], p.in[16], p.in[17], (LAS float*)(lds + RING_BYTES)};
        pg8::gemm_phase<false>(lds, D, D, Sa, Ea, wave);
    }
    xcd_barrier(bar);
    PH_END(1)
    PH_BEGIN(2)
    {
        const float qscale = 0.08838834764831845f;
        for (int u = gw; u < BATCH * NCH * 8; u += NW) { const int g = u % 8, c = (u / 8) % NCH, b = u / (8 * NCH); lru_pass1(p, b, c, g, fresh_lane(), lds + wave * 8192, u, NW); }
        if (NW != BATCH * NCH * 8) fp4_tables(p, gw, NW, fresh_lane());
    }
    xcd_barrier(bar);
    PH_END(2)
    PH_BEGIN(3)
    {
        const int nA = BATCH * 8 * (NCH / 4), nC = BATCH * 4 * (SEQ / 256);
        PH_BEGIN(9)
        for (int u = cb; u < nA + nC; u += Gd) {
            if (u < nA) {
                const int cg = u % (NCH / 4), h = (u / (NCH / 4)) % 8, b = u / ((NCH / 4) * 8);
                const size_t brow = (size_t)b * SEQ, qrow = brow + (size_t)cg * 256;
                att::attn_body<INW, INW, D, true>(PROJ + qrow * INW + C_QA + h * 128, PROJ + brow * INW + C_KA + h * 128, PROJ + brow * INW + C_VA + h * 128,
                                                  HO + qrow * D + h * 128, 12, cg * 4 - NPREV, p.in[6] + h * 257, (LAS char*)lds, wave);
            } else {
                const int v = u - nA; const int qb = v % (SEQ / 256), h = (v / (SEQ / 256)) % 4, b = v / ((SEQ / 256) * 4);
                const size_t qrow = (size_t)b * SEQ + (size_t)qb * 256;
                att::attn_body<INW, 2 * CW, D, false>(PROJ + qrow * INW + C_QC + h * 128, MEMKV + (size_t)b * NMEM * (2 * CW) + h * 128, MEMKV + (size_t)b * NMEM * (2 * CW) + CW + h * 128,
                                                     HO + qrow * D + AW + LW + h * 128, NMEM / 64, 0, nullptr, (LAS char*)lds, wave);
            }
        }
        PH_END(9)
        PH_BEGIN(10)
        for (int u = gw; u < BATCH * NCH * 8; u += NW) { const int g = u % 8, c = (u / 8) % NCH, b = u / (8 * NCH); lru_pass2(p, b, c, g, fresh_lane()); }
        touch_buffer(WT_BR, (size_t)D * D * 2, cb, Gd, (wave * 64 + fresh_lane())); touch_buffer(WT_O, (size_t)D * D * 2, cb, Gd, (wave * 64 + fresh_lane()));
        PH_END(10)
    }
    PH_BEGIN(4)
    {
        u32x4* slab = (u32x4*)(ws + WS_G) + (size_t)cb * (3 * 16 * 512);
#pragma unroll 1
        for (int ti = 0; ti * Gd < 64 * 8; ++ti) {
            { SchedG S{(const char*)(ws + WS_H8), (const char*)WT_GATE, Gd, cb, ti}; EpiG E{slab, (const float*)(ws + WS_CTL + CTL_BG2_BYTE)};
              pg8::gemm_phase<true>(lds, D / 2, D / 2, S, E, wave); }
            if (ti == 0) { xcd_barrier(bar); PH_END(3) if ((PROBE_MASK >> 4) & 1) t0_4 = __builtin_amdgcn_s_memrealtime(); }
            { SchedP3 S{(const char*)HO, (const char*)WT_BR, Gd, cb, ti}; EpiP3 E{slab, MERGED};
              pg8::gemm_phase<false>(lds, D, D, S, E, wave); }
        }
    }
    xcd_barrier(bar);
    PH_END(4)
    PH_BEGIN(5)
    {
        SchedSq S{(const char*)MERGED, (const char*)WT_O, Gd, cb};
        EpiP4 E{p.in[0], p.out, X2BF, SS2, ws + WS_X2F8};
        pg8::gemm_phase<false>(lds, D, D, S, E, wave);
        touch_buffer(WT_PQ, (size_t)D * D * 2, cb, Gd, (wave * 64 + fresh_lane()));
    }
    xcd_barrier(bar);
    PH_END(5)
    PH_BEGIN(6)
    {
        SchedSq S{(const char*)X2BF, (const char*)WT_PQ, Gd, cb};
        EpiP5 E{QB, SS2};
        pg8::gemm_phase<false>(lds, D, D, S, E, wave);
    }
    xcd_barrier(bar);
    PH_END(6)
    PH_BEGIN(7)
    rt::route_phase(p, lds, wave);
    xcd_barrier(bar);
    PH_END(7)
    PH_BEGIN(8)
    int ppos, pnx, prank, pnloc;
    { if ((wave * 64 + fresh_lane()) == 0) { unsigned pos = 0, nx = 0; const unsigned* bw = (const unsigned*)(ws + WS_CTL + CTL_BAR_BYTE);
#pragma unroll
          for (unsigned j = 0; j < 16; ++j) { const unsigned cj = xb_ld((unsigned*)&bw[XB_XCNT(j)]); nx += cj > 0u ? 1u : 0u; pos += (cj > 0u && j < bar.x) ? 1u : 0u; }
          MISC[17] = pos; MISC[18] = nx > 0u ? nx : 1u; }
      __syncthreads();
      ppos = (int)MISC[17]; pnx = (int)MISC[18]; prank = (int)MISC[16]; pnloc = (int)MISC[8]; if (pnloc < 1) pnloc = 1; }
    peer_u_step(p, fresh_lane(), wave, lds + wave * 16384, ppos, pnx, prank, pnloc);
    xcd_barrier(bar);
    for (int t = gw; t < T; t += NW) peer_combine(p, t, fresh_lane());
    xcd_barrier(bar);
    peer_v_step(p, fresh_lane(), wave, lds + wave * 16384, ppos, pnx, prank, pnloc);
    if (PROBE_MASK) { __syncthreads(); PH_END(8) const unsigned long long te = __builtin_amdgcn_s_memrealtime(); while (__builtin_amdgcn_s_memrealtime() - te < probe_acc) __builtin_amdgcn_s_sleep(8); }
}

extern "C" void kernel_launch(void* const* d_in, const int* in_sizes, int n_in, void* d_out, int out_size, void* d_ws, size_t ws_size, hipStream_t stream) {
    static int grid = 0;
    if (grid == 0) {
        if (n_in != 27 || out_size != T * D || ws_size < WS_END) { fprintf(stderr, "kernel_launch: unexpected problem (n_in %d out %d ws %zu)\n", n_in, out_size, ws_size); grid = -1; return; }
        int dev = 0, cus = 0, per_cu = 0;
        (void)hipGetDevice(&dev); (void)hipDeviceGetAttribute(&cus, hipDeviceAttributeMultiprocessorCount, dev);
        if (hipFuncSetAttribute((const void*)fwd, hipFuncAttributeMaxDynamicSharedMemorySize, LDS_BYTES) != hipSuccess) { fprintf(stderr, "kernel_launch: hipFuncSetAttribute failed\n"); grid = -1; return; }
        (void)hipOccupancyMaxActiveBlocksPerMultiprocessor(&per_cu, (const void*)fwd, NTHREADS, LDS_BYTES);
        if (per_cu < 1) { fprintf(stderr, "kernel_launch: occupancy query says %d\n", per_cu); grid = -1; return; }
        grid = cus;
    }
    if (grid < 0) return;
    (void)hipMemsetAsync((char*)d_ws + WS_CTL, 0, 1 * MiB, stream);
    Params p{};
    for (int i = 0; i < 27; ++i) p.in[i] = (const float*)d_in[i];
    p.out = (float*)d_out; p.ws = (unsigned char*)d_ws;
    void* args[] = {&p};
    hipError_t e = hipLaunchCooperativeKernel((const void*)fwd, dim3(grid), dim3(NTHREADS), args, LDS_BYTES, stream);
    if (e != hipSuccess) fprintf(stderr, "cooperative launch failed: %s (grid %d)\n", hipGetErrorString(e), grid);
}
```

```cpp
#include <hip/hip_runtime.h>
#include <hip/hip_cooperative_groups.h>
#include <cstdio>
#include <cstdint>
namespace cg = cooperative_groups;
#ifndef PROBE_MASK
#define PROBE_MASK 0
#endif

#define LAS __attribute__((address_space(3)))
typedef unsigned short bf16_t;
typedef short bf16x8 __attribute__((ext_vector_type(8)));
typedef float f32x4 __attribute__((ext_vector_type(4)));
typedef unsigned u32x4 __attribute__((ext_vector_type(4)));
typedef unsigned u32x2 __attribute__((ext_vector_type(2)));

constexpr int D = 2048, BATCH = 2, SEQ = 8192, T = BATCH * SEQ;
constexpr int CHUNK = 64, NPREV = 8, NCH = SEQ / CHUNK;
constexpr int AW = 1024, LW = 512, CW = 512, INW = 4608, GW = 6144;
constexpr int NMEM = 256;
constexpr int PH = 8, NKEYS = 128, TOPK = 16;
constexpr float EPS = 1e-6f;
constexpr int C_QA = 0, C_KA = 1024, C_VA = 2048, C_XL = 3072, C_GL = 3584, C_QC = 4096;

constexpr size_t MiB = 1u << 20;
constexpr size_t WS_CTL = 0;
constexpr size_t WS_WT_IN = 2 * MiB, WS_WT_GATE = 20 * MiB, WS_WT_BR = 44 * MiB, WS_WT_O = 52 * MiB, WS_WT_PQ = 60 * MiB, WS_WT_MKV = 68 * MiB;
constexpr size_t WS_KEYSB = 72 * MiB, WS_MEMN = 73 * MiB, WS_MEMKV = 75 * MiB, WS_LRUSUM = 76 * MiB, WS_RS2 = 77 * MiB;
constexpr size_t WS_HO = 80 * MiB;
constexpr size_t WS_PROJ = 144 * MiB;
constexpr size_t WS_MERGED = 144 * MiB, WS_X2BF = 208 * MiB;
constexpr size_t WS_G = 288 * MiB;
constexpr size_t WS_TABU = 496 * MiB, WS_TABV = 512 * MiB, WS_Q = 416 * MiB;
constexpr size_t WS_SCU = 77 * MiB, WS_SCV = 77 * MiB + 65536;
constexpr size_t WS_AUA = 2 * MiB, WS_AUU = 416 * MiB;
constexpr size_t WS_H8 = 384 * MiB;
constexpr float GATE_WSCALE = 256.f, NLOG2E = -1.4426950408889634f;
constexpr size_t CTL_LRUW_BYTE = 1024 * 1024;
constexpr size_t CTL_BG2_BYTE = 768 * 1024;
constexpr size_t WS_RIDX = 480 * MiB, WS_RG = 488 * MiB, WS_END = 528 * MiB;

constexpr size_t CTL_BAR_BYTE = 16384, CTL_RANK_BYTE = 65536, CTL_SS2_BYTE = 512 * 1024;
struct Params { const float* in[27]; float* out; unsigned char* ws; };

__device__ __forceinline__ int fresh_lane() { int l; asm volatile("v_mbcnt_lo_u32_b32 %0, -1, 0\n\tv_mbcnt_hi_u32_b32 %0, -1, %0" : "=v"(l)); return l; }
__device__ __forceinline__ float bf2f(unsigned v16) { return __uint_as_float(v16 << 16); }
typedef float f32x2c __attribute__((ext_vector_type(2))); typedef __bf16 bf16x2c __attribute__((ext_vector_type(2)));
__device__ __forceinline__ unsigned pk2(float lo, float hi) { const f32x2c v = {lo, hi}; return __builtin_bit_cast(unsigned, __builtin_convertvector(v, bf16x2c)); }
__device__ __forceinline__ unsigned f2bf(float f) { return pk2(f, 0.f) & 0xffffu; }
__device__ __forceinline__ float wave_sum(float v) {
#pragma unroll
    for (int o = 1; o < 64; o <<= 1) v += __shfl_xor(v, o);
    return v;
}
typedef __bf16 bf16x2_t __attribute__((ext_vector_type(2)));
__device__ __forceinline__ float dot2bf(unsigned w, unsigned x, float acc) { return __builtin_amdgcn_fdot2_f32_bf16(__builtin_bit_cast(bf16x2_t, w), __builtin_bit_cast(bf16x2_t, x), acc, false); }
__device__ __forceinline__ float sigmoid_(float x) { return 1.f / (1.f + __expf(-x)); }
__device__ __forceinline__ float gelu_tanh(float x) { const float y = 1.5957691216f * (x + 0.044715f * x * x * x); return x / (1.f + __expf(-y)); }
__device__ __forceinline__ void unpack8(const u32x4 w, float* f) {
    f[0] = __uint_as_float(w.x << 16); f[1] = __uint_as_float(w.x & 0xffff0000u);
    f[2] = __uint_as_float(w.y << 16); f[3] = __uint_as_float(w.y & 0xffff0000u);
    f[4] = __uint_as_float(w.z << 16); f[5] = __uint_as_float(w.z & 0xffff0000u);
    f[6] = __uint_as_float(w.w << 16); f[7] = __uint_as_float(w.w & 0xffff0000u);
}

struct TrJob { const float* W; bf16_t* WT; const float* ks; int K, N; float f8scale; };
__device__ __forceinline__ void tr_load(const TrJob& jb, int item, int lane, f32x4 (&v)[8]) {
    const int nblk = jb.N / 32, kb = item / nblk, nb = item % nblk, k0 = 64 * kb, n0 = 32 * nb;
#pragma unroll
    for (int i = 0; i < 8; ++i) { const int kk = 8 * i + (lane >> 3); v[i] = *(const f32x4*)(jb.W + (size_t)(k0 + kk) * jb.N + n0 + 4 * (lane & 7)); if (jb.ks) v[i] = v[i] * jb.ks[k0 + kk]; }
}
__device__ __forceinline__ void tr_store(const TrJob& jb, int item, int lane, const f32x4 (&v)[8], LAS float* scr) {
    const int nblk = jb.N / 32, kb = item / nblk, nb = item % nblk, k0 = 64 * kb, n0 = 32 * nb;
#pragma unroll
    for (int i = 0; i < 8; ++i) { LAS float* d = scr + (8 * i + (lane >> 3)) * 33 + 4 * (lane & 7); d[0] = v[i].x; d[1] = v[i].y; d[2] = v[i].z; d[3] = v[i].w; }
    asm volatile("s_waitcnt lgkmcnt(0)" ::: "memory");
    const int c = lane & 7;
#pragma unroll
    for (int j = 0; j < 4; ++j) { const int n = (lane >> 3) + 8 * j; const LAS float* s = scr + (8 * c) * 33 + n;
        if (jb.f8scale != 0.f) { const float f = jb.f8scale; u32x2 o;
#define F8C(x_) fminf(fmaxf((x_) * f, -448.f), 448.f)
            int w = __builtin_amdgcn_cvt_pk_fp8_f32(F8C(s[0 * 33]), F8C(s[1 * 33]), 0, false); w = __builtin_amdgcn_cvt_pk_fp8_f32(F8C(s[2 * 33]), F8C(s[3 * 33]), w, true); o.x = (unsigned)w;
            w = __builtin_amdgcn_cvt_pk_fp8_f32(F8C(s[4 * 33]), F8C(s[5 * 33]), 0, false); w = __builtin_amdgcn_cvt_pk_fp8_f32(F8C(s[6 * 33]), F8C(s[7 * 33]), w, true); o.y = (unsigned)w;
#undef F8C
            *(u32x2*)((unsigned char*)jb.WT + (size_t)(n0 + n) * jb.K + k0 + 8 * c) = o; }
        else { u32x4 o; o.x = pk2(s[0 * 33], s[1 * 33]); o.y = pk2(s[2 * 33], s[3 * 33]); o.z = pk2(s[4 * 33], s[5 * 33]); o.w = pk2(s[6 * 33], s[7 * 33]);
            *(u32x4*)(jb.WT + (size_t)(n0 + n) * jb.K + k0 + 8 * c) = o; } }
    asm volatile("s_waitcnt lgkmcnt(0)" ::: "memory");
}
__device__ __forceinline__ void rms_row_load(const float* xrow, int lane, f32x4 (&v)[8]) {
    const f32x4* xr = (const f32x4*)xrow + lane;
#pragma unroll
    for (int j = 0; j < 8; ++j) v[j] = xr[64 * j];
}
__device__ __forceinline__ void rms_row_finish(const f32x4 (&v)[8], const float* g, bf16_t* orow, unsigned char* o8row, int lane) {
    const f32x4* gr = (const f32x4*)g + lane; float s = 0.f;
#pragma unroll
    for (int j = 0; j < 8; ++j) s += (v[j].x * v[j].x + v[j].y * v[j].y) + (v[j].z * v[j].z + v[j].w * v[j].w);
    const float rstd = rsqrtf(wave_sum(s) * (1.f / D) + EPS);
    u32x2* o8 = (u32x2*)orow + lane;
#pragma unroll
    for (int j = 0; j < 8; ++j) { const f32x4 gg = gr[64 * j]; const float a0 = v[j].x * rstd * gg.x, a1 = v[j].y * rstd * gg.y, a2 = v[j].z * rstd * gg.z, a3 = v[j].w * rstd * gg.w;
        u32x2 o; o.x = pk2(a0, a1); o.y = pk2(a2, a3); o8[64 * j] = o;
        if (o8row) { int w = __builtin_amdgcn_cvt_pk_fp8_f32(fminf(fmaxf(a0, -448.f), 448.f), fminf(fmaxf(a1, -448.f), 448.f), 0, false);
            w = __builtin_amdgcn_cvt_pk_fp8_f32(fminf(fmaxf(a2, -448.f), 448.f), fminf(fmaxf(a3, -448.f), 448.f), w, true); ((unsigned*)o8row)[64 * j + lane] = (unsigned)w; } }
}
__device__ __forceinline__ void rms_rows(const float* X, const float* g, bf16_t* O, unsigned char* O8, int nrows, int gw, int NW, int lane) {
    f32x4 va[8], vb[8];
    int m = gw;
    if (m < nrows) rms_row_load(X + (size_t)m * D, lane, va);
    for (; m < nrows; m += 2 * NW) {
        const bool hb = m + NW < nrows;
        if (hb) rms_row_load(X + (size_t)(m + NW) * D, lane, vb);
        rms_row_finish(va, g, O + (size_t)m * D, O8 ? O8 + (size_t)m * D : nullptr, lane);
        if (m + 2 * NW < nrows) rms_row_load(X + (size_t)(m + 2 * NW) * D, lane, va);
        if (hb) rms_row_finish(vb, g, O + (size_t)(m + NW) * D, O8 ? O8 + (size_t)(m + NW) * D : nullptr, lane);
    }
}

template <int TM, int TN, class Epi>
__device__ __forceinline__ void gemm_simple(const bf16_t* __restrict__ A, int lda, const bf16_t* __restrict__ Bt, int ldb, int M, int N, int K, const Epi& epi, int gw, int NW, int lane) {
    const int r = lane & 15, q = lane >> 4;
    const int ntm = M / (16 * TM), ntn = N / (16 * TN);
    for (int tile = gw; tile < ntm * ntn; tile += NW) {
        const int tm = tile / ntn, tn = tile % ntn;
        f32x4 acc[TM][TN];
#pragma unroll
        for (int i = 0; i < TM; ++i)
#pragma unroll
            for (int j = 0; j < TN; ++j) acc[i][j] = (f32x4){0.f, 0.f, 0.f, 0.f};
        const bf16_t* ap = A + (size_t)(tm * 16 * TM + r) * lda + q * 8;
        const bf16_t* bp = Bt + (size_t)(tn * 16 * TN + r) * ldb + q * 8;
        for (int k0 = 0; k0 < K; k0 += 32) {
            bf16x8 af[TM], bfr[TN];
#pragma unroll
            for (int i = 0; i < TM; ++i) af[i] = *(const bf16x8*)(ap + (size_t)i * 16 * lda + k0);
#pragma unroll
            for (int j = 0; j < TN; ++j) bfr[j] = *(const bf16x8*)(bp + (size_t)j * 16 * ldb + k0);
#pragma unroll
            for (int i = 0; i < TM; ++i)
#pragma unroll
                for (int j = 0; j < TN; ++j) acc[i][j] = __builtin_amdgcn_mfma_f32_16x16x32_bf16(af[i], bfr[j], acc[i][j], 0, 0, 0);
        }
#pragma unroll
        for (int i = 0; i < TM; ++i)
#pragma unroll
            for (int j = 0; j < TN; ++j)
#pragma unroll
                for (int e = 0; e < 4; ++e) epi(tm * 16 * TM + i * 16 + q * 4 + e, tn * 16 * TN + j * 16 + r, acc[i][j][e]);
    }
}
struct EpiProj { bf16_t* P; __device__ __forceinline__ void operator()(int row, int col, float v) const { if (col >= C_GL && col < C_QC) v = gelu_tanh(v); P[(size_t)row * INW + col] = (bf16_t)f2bf(v); } };
struct EpiGate { bf16_t* G; const float* b; __device__ __forceinline__ void operator()(int row, int col, float v) const { G[(size_t)row * GW + col] = (bf16_t)f2bf(sigmoid_(v + b[col])); } };
struct EpiStore { bf16_t* C; int ldc; __device__ __forceinline__ void operator()(int row, int col, float v) const { C[(size_t)row * ldc + col] = (bf16_t)f2bf(v); } };
struct EpiWo { const float* x; float* out; bf16_t* xb; __device__ __forceinline__ void operator()(int row, int col, float v) const { const size_t o = (size_t)row * D + col; const float y = x[o] + v; out[o] = y; xb[o] = (bf16_t)f2bf(y); } };
struct EpiQ { bf16_t* Q; const float* rs; __device__ __forceinline__ void operator()(int row, int col, float v) const { Q[(size_t)row * D + col] = (bf16_t)f2bf(v * rs[row]); } };

__device__ __forceinline__ void headnorm(bf16_t* vec, const float* g, float scale, int lane) {
    unsigned* p = (unsigned*)vec + lane; const unsigned w = *p;
    const float a = bf2f(w & 0xffffu), b = bf2f(w >> 16);
    const float rs = rsqrtf(wave_sum(a * a + b * b) * (1.f / 128.f) + EPS) * scale;
    *p = pk2(a * rs * g[2 * lane], b * rs * g[2 * lane + 1]);
}
struct HeadGains { float gq[32], gk[32], gc[8]; };
__device__ __forceinline__ void load_head_gains(HeadGains& hg, const float* gq, const float* gk, const float* gc, int lane) {
#pragma unroll
    for (int j = 0; j < 32; ++j) { hg.gq[j] = gq[(lane & 3) * 32 + j]; hg.gk[j] = gk[(lane & 3) * 32 + j]; }
#pragma unroll
    for (int j = 0; j < 8; ++j) hg.gc[j] = gc[(lane & 15) * 8 + j];
}
__device__ __forceinline__ void headnorm_token(bf16_t* row, const HeadGains& hg, float qscale, int lane) {
    u32x4* pa = (u32x4*)(row + C_QA) + lane * 4;
    u32x4* pc = (u32x4*)(row + C_QC) + lane;
    u32x4 w[4]; const u32x4 wc = *pc;
#pragma unroll
    for (int j = 0; j < 4; ++j) w[j] = pa[j];
    float f[32], fc[8]; float ss = 0.f, sc = 0.f;
#pragma unroll
    for (int j = 0; j < 4; ++j) unpack8(w[j], f + 8 * j);
    unpack8(wc, fc);
#pragma unroll
    for (int j = 0; j < 32; ++j) ss = fmaf(f[j], f[j], ss);
#pragma unroll
    for (int j = 0; j < 8; ++j) sc = fmaf(fc[j], fc[j], sc);
    ss += __shfl_xor(ss, 1); ss += __shfl_xor(ss, 2);
    sc += __shfl_xor(sc, 1); sc += __shfl_xor(sc, 2); sc += __shfl_xor(sc, 4); sc += __shfl_xor(sc, 8);
    const bool isq = lane < 32;
    const float rs = rsqrtf(ss * (1.f / 128.f) + EPS) * (isq ? qscale : 1.f), rc = rsqrtf(sc * (1.f / 128.f) + EPS) * qscale;
#pragma unroll
    for (int j = 0; j < 4; ++j) { u32x4 o;
        o.x = pk2(f[8 * j] * rs * (isq ? hg.gq[8 * j] : hg.gk[8 * j]), f[8 * j + 1] * rs * (isq ? hg.gq[8 * j + 1] : hg.gk[8 * j + 1]));
        o.y = pk2(f[8 * j + 2] * rs * (isq ? hg.gq[8 * j + 2] : hg.gk[8 * j + 2]), f[8 * j + 3] * rs * (isq ? hg.gq[8 * j + 3] : hg.gk[8 * j + 3]));
        o.z = pk2(f[8 * j + 4] * rs * (isq ? hg.gq[8 * j + 4] : hg.gk[8 * j + 4]), f[8 * j + 5] * rs * (isq ? hg.gq[8 * j + 5] : hg.gk[8 * j + 5]));
        o.w = pk2(f[8 * j + 6] * rs * (isq ? hg.gq[8 * j + 6] : hg.gk[8 * j + 6]), f[8 * j + 7] * rs * (isq ? hg.gq[8 * j + 7] : hg.gk[8 * j + 7]));
        pa[j] = o; }
    { u32x4 o; o.x = pk2(fc[0] * rc * hg.gc[0], fc[1] * rc * hg.gc[1]); o.y = pk2(fc[2] * rc * hg.gc[2], fc[3] * rc * hg.gc[3]);
      o.z = pk2(fc[4] * rc * hg.gc[4], fc[5] * rc * hg.gc[5]); o.w = pk2(fc[6] * rc * hg.gc[6], fc[7] * rc * hg.gc[7]); *pc = o; }
}

__device__ __forceinline__ void fp4_row_load(const float* __restrict__ src, const float* __restrict__ kscale, int lane, f32x4 (&v)[8]);
__device__ __forceinline__ void fp4_row_finish(const f32x4 (&v)[8], unsigned char* __restrict__ tab, int e, float* __restrict__ scale_out, int lane);
__device__ __forceinline__ void lru_pass1(const Params& p, int b, int c, int g, int lane, LAS unsigned char* wl  , const int tr0, const int trs) {
    const bf16_t* PROJ = (const bf16_t*)(p.ws + WS_PROJ);
    float* SUMA = (float*)(p.ws + WS_LRUSUM); float* SUMB = SUMA + BATCH * NCH * LW;
    bf16_t* AUA = (bf16_t*)(p.ws + WS_AUA); bf16_t* AUU = (bf16_t*)(p.ws + WS_AUU);
    const float* conv_w = p.in[7]; const float* conv_b = p.in[8]; const float* lru_wa = p.in[9]; const float* lru_ba = p.in[10];
    const float* lru_wx = p.in[11]; const float* lru_bx = p.in[12]; const float* lam = p.in[13];
    const int ch = g * 64 + lane;
    unsigned wa_p[32], wx_p[32];
#pragma unroll
    for (int m = 0; m < 32; ++m) { wa_p[m] = pk2(lru_wa[(size_t)(g * 64 + 2 * m) * 64 + lane], lru_wa[(size_t)(g * 64 + 2 * m + 1) * 64 + lane]);
        wx_p[m] = pk2(lru_wx[(size_t)(g * 64 + 2 * m) * 64 + lane], lru_wx[(size_t)(g * 64 + 2 * m + 1) * 64 + lane]); }
    const float cw0 = conv_w[0 * LW + ch], cw1 = conv_w[1 * LW + ch], cw2 = conv_w[2 * LW + ch], cw3 = conv_w[3 * LW + ch], cb = conv_b[ch];
    const float ba_ = lru_ba[ch], bx_ = lru_bx[ch];
    const float sp = log1pf(__expf(-lam[ch]));
    const int t0 = c * CHUNK; const size_t row0 = (size_t)b * SEQ + t0;
    float x0 = 0.f, x1 = 0.f, x2 = 0.f;
    if (t0 >= 3) { x0 = bf2f(PROJ[(row0 - 3) * INW + C_XL + ch]); x1 = bf2f(PROJ[(row0 - 2) * INW + C_XL + ch]); x2 = bf2f(PROJ[(row0 - 1) * INW + C_XL + ch]); }
    { const bf16_t* xs = PROJ + (row0 + (lane >> 3)) * INW + C_XL + g * 64 + (lane & 7) * 8;
      u32x4 tx[8];
#pragma unroll
      for (int i = 0; i < 8; ++i) tx[i] = *(const u32x4*)(xs + (size_t)(8 * i) * INW);
#pragma unroll
      for (int i = 0; i < 8; ++i) *(LAS u32x4*)(wl + (8 * i + (lane >> 3)) * 128 + (lane & 7) * 16) = tx[i]; }
    float h = 0.f, aprod = 1.f;
#define LRU_PAIRX(xc_) ({ const float xnb_ = __int_as_float(__builtin_amdgcn_update_dpp(0, __float_as_int(xc_), 0xB1, 0xf, 0xf, true));     \
        (lane & 1) ? pk2(xnb_, xc_) : pk2(xc_, xnb_); })
#define LRU_GATE(rp_, ip_, xc_, a_, u_) do { const float r_ = sigmoid_(rp_), ig_ = sigmoid_(ip_); const float la_ = -8.f * r_ * sp; a_ = __expf(la_); \
        u_ = sqrtf(fminf(fmaxf((1.f - a_) * (1.f + a_), 1e-12f), 1.f)) * ig_ * xc_; } while (0)
#define LRU_TOKPAIR(tp_) do { const int t_ = (tp_);                           \
        const float x3 = bf2f(*(const LAS bf16_t*)(wl + t_ * 128 + lane * 2)), x4 = bf2f(*(const LAS bf16_t*)(wl + (t_ + 1) * 128 + lane * 2)); \
        const float xcA = cw0 * x0 + cw1 * x1 + cw2 * x2 + cw3 * x3 + cb, xcB = cw0 * x1 + cw1 * x2 + cw2 * x3 + cw3 * x4 + cb; \
        x0 = x2; x1 = x3; x2 = x4; \
        const unsigned pkA = LRU_PAIRX(xcA), pkB = LRU_PAIRX(xcB); \
        float rA = ba_, iA = bx_, rA2 = 0.f, iA2 = 0.f, rB = ba_, iB = bx_, rB2 = 0.f, iB2 = 0.f; \
_Pragma("unroll") \
        for (int m = 0; m < 32; m += 2) { \
            const unsigned a0 = (unsigned)__builtin_amdgcn_readlane((int)pkA, 2 * m), a1 = (unsigned)__builtin_amdgcn_readlane((int)pkA, 2 * m + 2); \
            const unsigned b0 = (unsigned)__builtin_amdgcn_readlane((int)pkB, 2 * m), b1 = (unsigned)__builtin_amdgcn_readlane((int)pkB, 2 * m + 2); \
            rA = dot2bf(wa_p[m], a0, rA); iA = dot2bf(wx_p[m], a0, iA); rA2 = dot2bf(wa_p[m + 1], a1, rA2); iA2 = dot2bf(wx_p[m + 1], a1, iA2); \
            rB = dot2bf(wa_p[m], b0, rB); iB = dot2bf(wx_p[m], b0, iB); rB2 = dot2bf(wa_p[m + 1], b1, rB2); iB2 = dot2bf(wx_p[m + 1], b1, iB2); } \
        float aA, uA, aB, uB; \
        LRU_GATE(rA + rA2, iA + iA2, xcA, aA, uA); LRU_GATE(rB + rB2, iB + iB2, xcB, aB, uB); \
        \
        const unsigned wA = f2bf(1.f - aA), wB = f2bf(1.f - aB), vA = f2bf(uA), vB = f2bf(uB); \
        AUA[(row0 + t_) * LW + ch] = (bf16_t)wA; AUA[(row0 + t_ + 1) * LW + ch] = (bf16_t)wB; AUU[(row0 + t_) * LW + ch] = (bf16_t)vA; AUU[(row0 + t_ + 1) * LW + ch] = (bf16_t)vB; \
        const float aAq = 1.f - bf2f(wA), aBq = 1.f - bf2f(wB); \
        h = aBq * (aAq * h + bf2f(vA)) + bf2f(vB); \
        aprod *= aAq * aBq; \
    } while (0)
#define SIDE_LOAD(r_, v_) do { if ((r_) < 16384) fp4_row_load(p.in[25] + (size_t)(r_) * D, p.in[22], lane, v_); else if ((r_) < 32768) fp4_row_load(p.in[26] + (size_t)((r_) - 16384) * D, nullptr, lane, v_); } while (0)
#define SIDE_FIN(r_, v_) do { if ((r_) < 16384) fp4_row_finish(v_, p.ws + WS_TABU, (r_), (float*)(p.ws + WS_SCU) + (r_), lane); \
        else if ((r_) < 32768) fp4_row_finish(v_, p.ws + WS_TABV, (r_) - 16384, (float*)(p.ws + WS_SCV) + ((r_) - 16384), lane); } while (0)
    f32x4 sva[8]; int sr = tr0;
    SIDE_LOAD(sr, sva);
#pragma unroll 1
    for (int tt = 0; tt < CHUNK; tt += 4) {
        LRU_TOKPAIR(tt);
        SIDE_FIN(sr, sva); SIDE_LOAD(sr + trs, sva);
        LRU_TOKPAIR(tt + 2);
        sr += trs;
    }
#undef LRU_TOKPAIR
#undef SIDE_LOAD
#undef SIDE_FIN
#undef LRU_PAIRX
#undef LRU_GATE
    { const size_t o = (size_t)(b * NCH + c) * LW + ch; SUMA[o] = aprod; SUMB[o] = h; }
}
__device__ __forceinline__ void lru_pass2(const Params& p, int b, int c, int g, int lane) {
    const bf16_t* PROJ = (const bf16_t*)(p.ws + WS_PROJ); bf16_t* O = (bf16_t*)(p.ws + WS_HO);
    const float* SUMA = (const float*)(p.ws + WS_LRUSUM); const float* SUMB = SUMA + BATCH * NCH * LW;
    const bf16_t* AUA = (const bf16_t*)(p.ws + WS_AUA); const bf16_t* AUU = (const bf16_t*)(p.ws + WS_AUU);
    const int ch = g * 64 + lane; const size_t row0 = (size_t)b * SEQ + (size_t)c * CHUNK;
    const bf16_t* ap = AUA + row0 * LW + ch; const bf16_t* up = AUU + row0 * LW + ch; const bf16_t* gp = PROJ + row0 * INW + C_GL + ch;
    bf16_t an[16], un[16], gn[16];
#pragma unroll
    for (int q = 0; q < 16; ++q) { an[q] = ap[(size_t)q * LW]; un[q] = up[(size_t)q * LW]; gn[q] = gp[(size_t)q * INW]; }
    float h = 0.f;
    {
        int j = 0;
#pragma unroll 1
        for (; j + 32 <= c; j += 32) { float sa[32], sb[32];
#pragma unroll
            for (int q = 0; q < 32; ++q) { const size_t o = (size_t)(b * NCH + j + q) * LW + ch; sa[q] = SUMA[o]; sb[q] = SUMB[o]; }
#pragma unroll
            for (int q = 0; q < 32; ++q) h = sa[q] * h + sb[q]; }
#pragma unroll 1
        for (; j + 8 <= c; j += 8) { float sa[8], sb[8];
#pragma unroll
            for (int q = 0; q < 8; ++q) { const size_t o = (size_t)(b * NCH + j + q) * LW + ch; sa[q] = SUMA[o]; sb[q] = SUMB[o]; }
#pragma unroll
            for (int q = 0; q < 8; ++q) h = sa[q] * h + sb[q]; }
        for (; j < c; ++j) { const size_t o = (size_t)(b * NCH + j) * LW + ch; h = SUMA[o] * h + SUMB[o]; }
    }
#pragma unroll 1
    for (int tb = 0; tb < CHUNK; tb += 16) {
        bf16_t ac[16], uc[16], gc[16];
#pragma unroll
        for (int q = 0; q < 16; ++q) { ac[q] = an[q]; uc[q] = un[q]; gc[q] = gn[q]; }
        if (tb + 16 < CHUNK) {
#pragma unroll
            for (int q = 0; q < 16; ++q) { an[q] = ap[(size_t)(tb + 16 + q) * LW]; un[q] = up[(size_t)(tb + 16 + q) * LW]; gn[q] = gp[(size_t)(tb + 16 + q) * INW]; }
        }
#pragma unroll
        for (int q = 0; q < 16; ++q) { h = (1.f - bf2f(ac[q])) * h + bf2f(uc[q]); O[(row0 + tb + q) * D + AW + ch] = (bf16_t)f2bf(h * bf2f(gc[q])); }
    }
}

__device__ __forceinline__ void attn_simple(const bf16_t* Qp, int ldq, const bf16_t* Kp, const bf16_t* Vp, int ldkv, int nkeys, int koff, const float* bias_h, bf16_t* Op, int ldo, int tid) {
    const int qi = tid >> 2, part = tid & 3;
    float q[32], o[32];
    { const u32x4* qp = (const u32x4*)(Qp + (size_t)qi * ldq + part * 32);
#pragma unroll
      for (int j = 0; j < 4; ++j) unpack8(qp[j], q + 8 * j); }
#pragma unroll
    for (int d = 0; d < 32; ++d) o[d] = 0.f;
    float m = -1e30f, l = 0.f;
    for (int kk0 = 0; kk0 < nkeys; kk0 += 8) {
        float s[8];
#pragma unroll
        for (int j = 0; j < 8; ++j) {
            const u32x4* kp = (const u32x4*)(Kp + (size_t)(kk0 + j) * ldkv + part * 32);
            float acc = 0.f;
#pragma unroll
            for (int w = 0; w < 4; ++w) { float kf[8]; unpack8(kp[w], kf);
#pragma unroll
                for (int e = 0; e < 8; ++e) acc = fmaf(q[8 * w + e], kf[e], acc); }
            acc += __shfl_xor(acc, 1); acc += __shfl_xor(acc, 2);
            if (bias_h) { int dist = qi + koff - (kk0 + j); dist = dist < -128 ? -128 : (dist > 128 ? 128 : dist); acc += bias_h[dist + 128]; }
            s[j] = acc;
        }
        float mx = s[0];
#pragma unroll
        for (int j = 1; j < 8; ++j) mx = fmaxf(mx, s[j]);
        const float mn = fmaxf(m, mx), corr = __expf(m - mn);
        l *= corr;
#pragma unroll
        for (int d = 0; d < 32; ++d) o[d] *= corr;
#pragma unroll
        for (int j = 0; j < 8; ++j) {
            const float pj = __expf(s[j] - mn); l += pj;
            const u32x4* vp = (const u32x4*)(Vp + (size_t)(kk0 + j) * ldkv + part * 32);
#pragma unroll
            for (int w = 0; w < 4; ++w) { float vf[8]; unpack8(vp[w], vf);
#pragma unroll
                for (int e = 0; e < 8; ++e) o[8 * w + e] = fmaf(pj, vf[e], o[8 * w + e]); }
        }
        m = mn;
    }
    const float inv = 1.f / l;
    u32x4* op = (u32x4*)(Op + (size_t)qi * ldo + part * 32);
#pragma unroll
    for (int w = 0; w < 4; ++w) { u32x4 ov; ov.x = pk2(o[8 * w] * inv, o[8 * w + 1] * inv); ov.y = pk2(o[8 * w + 2] * inv, o[8 * w + 3] * inv); ov.z = pk2(o[8 * w + 4] * inv, o[8 * w + 5] * inv); ov.w = pk2(o[8 * w + 6] * inv, o[8 * w + 7] * inv); op[w] = ov; }
}

__device__ __forceinline__ void gemm_branch(const bf16_t* __restrict__ Ob, const bf16_t* __restrict__ WT, const bf16_t* __restrict__ G, bf16_t* __restrict__ Mg, int gw, int NW, int lane) {
    const int r = lane & 15, q = lane >> 4;
    const int ntn = D / 32, ntiles = (T / 32) * ntn;
    for (int tile = gw; tile < ntiles; tile += NW) {
        const int tm = tile / ntn, tn = tile % ntn;
        f32x4 acc[3][2][2];
#pragma unroll
        for (int s = 0; s < 3; ++s)
#pragma unroll
            for (int i = 0; i < 2; ++i)
#pragma unroll
                for (int j = 0; j < 2; ++j) acc[s][i][j] = (f32x4){0.f, 0.f, 0.f, 0.f};
        const bf16_t* ap = Ob + (size_t)(tm * 32 + r) * D + q * 8;
        const bf16_t* bp = WT + (size_t)(tn * 32 + r) * D + q * 8;
#pragma unroll
        for (int s = 0; s < 3; ++s) {
            const int kb = s == 0 ? 0 : (s == 1 ? 1024 : 1536), ke = s == 0 ? 1024 : (s == 1 ? 1536 : 2048);
            for (int k0 = kb; k0 < ke; k0 += 32) {
                bf16x8 af[2], bfr[2];
#pragma unroll
                for (int i = 0; i < 2; ++i) af[i] = *(const bf16x8*)(ap + (size_t)i * 16 * D + k0);
#pragma unroll
                for (int j = 0; j < 2; ++j) bfr[j] = *(const bf16x8*)(bp + (size_t)j * 16 * D + k0);
#pragma unroll
                for (int i = 0; i < 2; ++i)
#pragma unroll
                    for (int j = 0; j < 2; ++j) acc[s][i][j] = __builtin_amdgcn_mfma_f32_16x16x32_bf16(af[i], bfr[j], acc[s][i][j], 0, 0, 0);
            }
        }
#pragma unroll
        for (int i = 0; i < 2; ++i)
#pragma unroll
            for (int j = 0; j < 2; ++j)
#pragma unroll
                for (int e = 0; e < 4; ++e) {
                    const int row = tm * 32 + i * 16 + q * 4 + e, col = tn * 32 + j * 16 + r;
                    const bf16_t* gp = G + (size_t)row * GW + col;
                    const float mval = bf2f(gp[0]) * acc[0][i][j][e] + bf2f(gp[2048]) * acc[1][i][j][e] + bf2f(gp[4096]) * acc[2][i][j][e];
                    Mg[(size_t)row * D + col] = (bf16_t)f2bf(mval);
                }
    }
}

__device__ __forceinline__ unsigned long long shfl_xor64(unsigned long long v, int m) {
    const unsigned lo = __shfl_xor((unsigned)v, m), hi = __shfl_xor((unsigned)(v >> 32), m);
    return ((unsigned long long)hi << 32) | lo;
}
__device__ __forceinline__ unsigned fkey(float f) { const unsigned u = __float_as_uint(f); return (u & 0x80000000u) ? ~u : (u | 0x80000000u); }
__device__ __forceinline__ float fkey_inv(unsigned k) { const unsigned u = (k & 0x80000000u) ? (k & 0x7fffffffu) : ~k; return __uint_as_float(u); }
__device__ __forceinline__ unsigned long long wave_max64(unsigned long long k) {
#pragma unroll
    for (int o = 1; o < 64; o <<= 1) { const unsigned long long t = shfl_xor64(k, o); k = t > k ? t : k; }
    return k;
}
__device__ __forceinline__ void route_unit(const Params& p, int t, int h, int lane) {
    const bf16_t* Q = (const bf16_t*)(p.ws + WS_Q); const bf16_t* KB = (const bf16_t*)(p.ws + WS_KEYSB);
    int* RIDX = (int*)(p.ws + WS_RIDX); float* RG = (float*)(p.ws + WS_RG);
    float sv_l[2] = {0.f, 0.f}; int si_l[2] = {0, 0};
#pragma unroll
    for (int c = 0; c < 2; ++c) {
        const bf16_t* qv = Q + (size_t)t * D + h * 256 + c * 128;
        const unsigned qw = ((const unsigned*)qv)[lane];
        const float qa = bf2f(qw & 0xffffu), qb = bf2f(qw >> 16);
        const bf16_t* k0p = KB + ((size_t)(h * 2 + c) * NKEYS + lane) * 128;
        const bf16_t* k1p = k0p + 64 * 128;
        float s0 = 0.f, s1 = 0.f;
#pragma unroll
        for (int w = 0; w < 16; ++w) {
            float k0f[8], k1f[8]; unpack8(((const u32x4*)k0p)[w], k0f); unpack8(((const u32x4*)k1p)[w], k1f);
#pragma unroll
            for (int e = 0; e < 8; e += 2) {
                const int src = 4 * w + e / 2;
                const float xa = __int_as_float(__builtin_amdgcn_readlane(__float_as_int(qa), src));
                const float xb = __int_as_float(__builtin_amdgcn_readlane(__float_as_int(qb), src));
                s0 = fmaf(xa, k0f[e], s0); s0 = fmaf(xb, k0f[e + 1], s0);
                s1 = fmaf(xa, k1f[e], s1); s1 = fmaf(xb, k1f[e + 1], s1);
            }
        }
        unsigned long long ka = ((unsigned long long)fkey(s0) << 32) | (unsigned)(255 - lane);
        unsigned long long kb = ((unsigned long long)fkey(s1) << 32) | (unsigned)(255 - (lane + 64));
        for (int rnd = 0; rnd < TOPK; ++rnd) {
            const unsigned long long best = wave_max64(ka > kb ? ka : kb);
            if (ka == best) ka = 0ull; if (kb == best) kb = 0ull;
            if (lane == rnd) { sv_l[c] = fkey_inv((unsigned)(best >> 32)); si_l[c] = 255 - (int)(best & 0xffffffffu); }
        }
    }
    unsigned long long kc[4];
#pragma unroll
    for (int m = 0; m < 4; ++m) { const int cid = lane + 64 * m, i = cid >> 4, j = cid & 15;
        const float v = __shfl(sv_l[0], i) + __shfl(sv_l[1], j);
        kc[m] = ((unsigned long long)fkey(v) << 32) | (unsigned)(1023 - cid); }
    float fv = 0.f; int cidx = 0;
    for (int rnd = 0; rnd < TOPK; ++rnd) {
        unsigned long long loc = kc[0] > kc[1] ? kc[0] : kc[1]; const unsigned long long loc2 = kc[2] > kc[3] ? kc[2] : kc[3]; loc = loc > loc2 ? loc : loc2;
        const unsigned long long best = wave_max64(loc);
#pragma unroll
        for (int m = 0; m < 4; ++m) if (kc[m] == best) kc[m] = 0ull;
        if (lane == rnd) { fv = fkey_inv((unsigned)(best >> 32)); cidx = 1023 - (int)(best & 0xffffffffu); }
    }
    const float fmax_ = __shfl(fv, 0);
    float e = lane < 16 ? __expf(fv - fmax_) : 0.f;
    float ssum = e;
#pragma unroll
    for (int o = 1; o < 16; o <<= 1) ssum += __shfl_xor(ssum, o);
    const int ci = cidx >> 4, cj = cidx & 15;
    const int e0 = __shfl(si_l[0], ci), e1 = __shfl(si_l[1], cj);
    if (lane < 16) { RIDX[(size_t)t * 128 + h * 16 + lane] = e0 * NKEYS + e1; RG[(size_t)t * 128 + h * 16 + lane] = e / ssum; }
}

typedef float f32x2 __attribute__((ext_vector_type(2)));
__device__ __forceinline__ void fp4_row_load(const float* __restrict__ src, const float* __restrict__ kscale, int lane, f32x4 (&v)[8]) {
#pragma unroll
    for (int j = 0; j < 8; ++j) { v[j] = ((const f32x4*)src)[64 * j + lane]; if (kscale) v[j] = v[j] * ((const f32x4*)kscale)[64 * j + lane]; }
}
__device__ __forceinline__ void fp4_row_finish(const f32x4 (&v)[8], unsigned char* __restrict__ tab, int e, float* __restrict__ scale_out, int lane) {
    float mx = 0.f;
#pragma unroll
    for (int j = 0; j < 8; ++j) mx = fmaxf(mx, fmaxf(fmaxf(fabsf(v[j].x), fabsf(v[j].y)), fmaxf(fabsf(v[j].z), fabsf(v[j].w))));
#pragma unroll
    for (int o = 1; o < 64; o <<= 1) mx = fmaxf(mx, __shfl_xor(mx, o));
    const float sc = mx > 0.f ? mx * (1.f / 6.f) : 1.f, inv = 1.f / sc;
#pragma unroll
    for (int j = 0; j < 8; ++j) {
        const f32x4 a = v[j] * inv;
        unsigned pk = 0u;
        pk = __builtin_amdgcn_cvt_scalef32_pk_fp4_f32(pk, fminf(fmaxf(a.x, -6.f), 6.f), fminf(fmaxf(a.y, -6.f), 6.f), 1.0f, 0);
        pk = __builtin_amdgcn_cvt_scalef32_pk_fp4_f32(pk, fminf(fmaxf(a.z, -6.f), 6.f), fminf(fmaxf(a.w, -6.f), 6.f), 1.0f, 1);
        *(unsigned short*)(tab + ((size_t)j * 16384 + e) * 128 + 2 * lane) = (unsigned short)pk;
    }
    if (lane == 0) *scale_out = sc;
}
__device__ __forceinline__ void fp4_tables(const Params& p, int gw, int NW, int lane) {
    f32x4 va[8], vb[8];
#define FP4_LOAD(r, v) do { if ((r) < 16384) fp4_row_load(p.in[25] + (size_t)(r) * D, p.in[22], lane, v); else fp4_row_load(p.in[26] + (size_t)((r) - 16384) * D, nullptr, lane, v); } while (0)
#define FP4_FIN(r, v) do { if ((r) < 16384) fp4_row_finish(v, p.ws + WS_TABU, (r), (float*)(p.ws + WS_SCU) + (r), lane); \
        else fp4_row_finish(v, p.ws + WS_TABV, (r) - 16384, (float*)(p.ws + WS_SCV) + ((r) - 16384), lane); } while (0)
    const int n = 2 * 16384;
    int r = gw;
    if (r < n) FP4_LOAD(r, va);
    for (; r < n; r += 2 * NW) {
        const bool hb = r + NW < n;
        if (hb) FP4_LOAD(r + NW, vb);
        FP4_FIN(r, va);
        if (r + 2 * NW < n) FP4_LOAD(r + 2 * NW, va);
        if (hb) FP4_FIN(r + NW, vb);
    }
#undef FP4_LOAD
#undef FP4_FIN
}
struct LruPre { u32x4 tx[9]; bf16x8 WaB[4][2], WxB[4][2]; };
__device__ __forceinline__ void lru_issue(LruPre& P, const Params& p, int b, int c, int g, int lane) {
    const bf16_t* PROJ = (const bf16_t*)(p.ws + WS_PROJ);
    const int t0 = c * CHUNK; const size_t row0 = (size_t)b * SEQ + t0;
    { const int r8 = lane >> 3, ck = lane & 7;
#pragma unroll
      for (int i = 0; i < 9; ++i) { const int r = 8 * i + r8; P.tx[i] = (u32x4){0u, 0u, 0u, 0u};
          if (r < 67 && (t0 > 0 || r >= 3)) P.tx[i] = *(const u32x4*)(PROJ + (row0 + r - 3) * INW + C_XL + g * 64 + ck * 8); } }
    { const u32x4* wb = (const u32x4*)(p.ws + WS_CTL + CTL_LRUW_BYTE) + (size_t)g * (2 * 4 * 2 * 64) + lane;
#pragma unroll
      for (int nt = 0; nt < 4; ++nt)
#pragma unroll
        for (int ks = 0; ks < 2; ++ks) { P.WaB[nt][ks] = __builtin_bit_cast(bf16x8, wb[(nt * 2 + ks) * 64]); P.WxB[nt][ks] = __builtin_bit_cast(bf16x8, wb[(8 + nt * 2 + ks) * 64]); } }
}
__device__ __forceinline__ void lru_pass1m(const LruPre& P, const Params& p, int b, int c, int g, int lane, LAS unsigned char* wl  ) {
    const bf16_t* PROJ = (const bf16_t*)(p.ws + WS_PROJ);
    float* SUMA = (float*)(p.ws + WS_LRUSUM); float* SUMB = SUMA + BATCH * NCH * LW;
    bf16_t* AUA = (bf16_t*)(p.ws + WS_AUA); bf16_t* AUU = (bf16_t*)(p.ws + WS_AUU);
    const float* conv_w = p.in[7]; const float* conv_b = p.in[8]; const float* lru_wa = p.in[9]; const float* lru_ba = p.in[10];
    const float* lru_wx = p.in[11]; const float* lru_bx = p.in[12]; const float* lam = p.in[13];
    const int t0 = c * CHUNK; const size_t row0 = (size_t)b * SEQ + t0;
    const int jc = lane & 15, kg = lane >> 4;
    constexpr int RS = 144;
    { const int r8 = lane >> 3, ck = lane & 7;
#pragma unroll
      for (int i = 0; i < 9; ++i) { const int r = 8 * i + r8; if (r < 67) *(LAS u32x4*)(wl + r * RS + ck * 16) = P.tx[i]; } }
    asm volatile("s_waitcnt lgkmcnt(0)" ::: "memory");
    bf16x8 Af[4][2];
#pragma unroll
    for (int ks = 0; ks < 2; ++ks) {
        const int ch0 = g * 64 + 32 * ks + 8 * kg;
        f32x4 cw[4][2], cbv[2];
#pragma unroll
        for (int k = 0; k < 4; ++k) { cw[k][0] = *(const f32x4*)(conv_w + k * LW + ch0); cw[k][1] = *(const f32x4*)(conv_w + k * LW + ch0 + 4); }
        cbv[0] = *(const f32x4*)(conv_b + ch0); cbv[1] = *(const f32x4*)(conv_b + ch0 + 4);
#pragma unroll
        for (int mt = 0; mt < 4; ++mt) {
            f32x4 s0 = cbv[0], s1 = cbv[1];
#pragma unroll
            for (int k = 0; k < 4; ++k) { const u32x4 w = *(const LAS u32x4*)(wl + (16 * mt + jc + k) * RS + (32 * ks + 8 * kg) * 2); float xf[8]; unpack8(w, xf);
                s0 = s0 + cw[k][0] * (f32x4){xf[0], xf[1], xf[2], xf[3]}; s1 = s1 + cw[k][1] * (f32x4){xf[4], xf[5], xf[6], xf[7]}; }
            Af[mt][ks] = __builtin_bit_cast(bf16x8, (u32x4){pk2(s0[0], s0[1]), pk2(s0[2], s0[3]), pk2(s1[0], s1[1]), pk2(s1[2], s1[3])});
        }
    }
    float spv[4], bav[4], bxv[4];
#pragma unroll
    for (int nt = 0; nt < 4; ++nt) { const int ch = g * 64 + 16 * nt + jc; spv[nt] = log1pf(__expf(-lam[ch])); bav[nt] = lru_ba[ch]; bxv[nt] = lru_bx[ch]; }
    float Ar[4], Hr[4];
#pragma unroll
    for (int nt = 0; nt < 4; ++nt) { Ar[nt] = 1.f; Hr[nt] = 0.f; }
#pragma unroll
    for (int mt = 0; mt < 4; ++mt) {
#pragma unroll
        for (int nt = 0; nt < 4; ++nt) {
            f32x4 ra = {bav[nt], bav[nt], bav[nt], bav[nt]}, rx = {bxv[nt], bxv[nt], bxv[nt], bxv[nt]}, rc = {0.f, 0.f, 0.f, 0.f};
#pragma unroll
            for (int ks = 0; ks < 2; ++ks) {
                ra = __builtin_amdgcn_mfma_f32_16x16x32_bf16(Af[mt][ks], P.WaB[nt][ks], ra, 0, 0, 0);
                rx = __builtin_amdgcn_mfma_f32_16x16x32_bf16(Af[mt][ks], P.WxB[nt][ks], rx, 0, 0, 0);
                const int es = 16 * nt + jc - 32 * ks - 8 * kg;
                u32x4 id; id.x = es == 0 ? 0x3F80u : (es == 1 ? 0x3F800000u : 0u); id.y = es == 2 ? 0x3F80u : (es == 3 ? 0x3F800000u : 0u);
                id.z = es == 4 ? 0x3F80u : (es == 5 ? 0x3F800000u : 0u); id.w = es == 6 ? 0x3F80u : (es == 7 ? 0x3F800000u : 0u);
                rc = __builtin_amdgcn_mfma_f32_16x16x32_bf16(Af[mt][ks], __builtin_bit_cast(bf16x8, id), rc, 0, 0, 0);
            }
            const int ch = g * 64 + 16 * nt + jc;
            float Al = 1.f, Hl = 0.f;
#pragma unroll
            for (int e = 0; e < 4; ++e) {
                const float r_ = sigmoid_(ra[e]), ig_ = sigmoid_(rx[e]); const float a_ = __expf(-8.f * r_ * spv[nt]);
                const float u_ = sqrtf(fminf(fmaxf((1.f - a_) * (1.f + a_), 1e-12f), 1.f)) * ig_ * rc[e];
                const unsigned wq = f2bf(1.f - a_), vq = f2bf(u_);
                const size_t o = (row0 + 16 * mt + 4 * kg + e) * LW + ch;
                AUA[o] = (bf16_t)wq; AUU[o] = (bf16_t)vq;
                const float aq = 1.f - bf2f(wq);
                Hl = aq * Hl + bf2f(vq); Al *= aq;
            }
            { const float Ap = __shfl_xor(Al, 16), Hp = __shfl_xor(Hl, 16); if (kg & 1) { Hl = Al * Hp + Hl; Al = Al * Ap; } }
            { const float Ap = __shfl_xor(Al, 32), Hp = __shfl_xor(Hl, 32); if (kg == 3) { Hl = Al * Hp + Hl; Al = Al * Ap; } }
            Hr[nt] = Al * Hr[nt] + Hl; Ar[nt] *= Al;
        }
    }
    if (kg == 3) {
#pragma unroll
        for (int nt = 0; nt < 4; ++nt) { const size_t o = (size_t)(b * NCH + c) * LW + g * 64 + 16 * nt + jc; SUMA[o] = Ar[nt]; SUMB[o] = Hr[nt]; }
    }
}
constexpr size_t WS_ZP = WS_Q;
constexpr size_t WS_X2F8 = 2 * MiB;
__device__ __forceinline__ float dot_chunk(const u32x4 w, const float (&xf)[32]) {
    float a0 = 0.f, a1 = 0.f;
#pragma unroll
    for (int q = 0; q < 4; ++q) {
        const f32x2 a = __builtin_amdgcn_cvt_scalef32_pk_f32_fp4(w[q], 1.0f, 0), b = __builtin_amdgcn_cvt_scalef32_pk_f32_fp4(w[q], 1.0f, 1);
        const f32x2 c = __builtin_amdgcn_cvt_scalef32_pk_f32_fp4(w[q], 1.0f, 2), d = __builtin_amdgcn_cvt_scalef32_pk_f32_fp4(w[q], 1.0f, 3);
        a0 = fmaf(a.x, xf[8 * q], a0); a1 = fmaf(a.y, xf[8 * q + 1], a1); a0 = fmaf(b.x, xf[8 * q + 2], a0); a1 = fmaf(b.y, xf[8 * q + 3], a1);
        a0 = fmaf(c.x, xf[8 * q + 4], a0); a1 = fmaf(c.y, xf[8 * q + 5], a1); a0 = fmaf(d.x, xf[8 * q + 6], a0); a1 = fmaf(d.y, xf[8 * q + 7], a1);
    }
    return a0 + a1;
}
__device__ __forceinline__ void axpy_chunk(const u32x4 w, const float a_, float (&of)[32]) {
#pragma unroll
    for (int q = 0; q < 4; ++q) {
        const f32x2 a = __builtin_amdgcn_cvt_scalef32_pk_f32_fp4(w[q], 1.0f, 0), b = __builtin_amdgcn_cvt_scalef32_pk_f32_fp4(w[q], 1.0f, 1);
        const f32x2 c = __builtin_amdgcn_cvt_scalef32_pk_f32_fp4(w[q], 1.0f, 2), d = __builtin_amdgcn_cvt_scalef32_pk_f32_fp4(w[q], 1.0f, 3);
        of[8 * q] = fmaf(a_, a.x, of[8 * q]); of[8 * q + 1] = fmaf(a_, a.y, of[8 * q + 1]); of[8 * q + 2] = fmaf(a_, b.x, of[8 * q + 2]); of[8 * q + 3] = fmaf(a_, b.y, of[8 * q + 3]);
        of[8 * q + 4] = fmaf(a_, c.x, of[8 * q + 4]); of[8 * q + 5] = fmaf(a_, c.y, of[8 * q + 5]); of[8 * q + 6] = fmaf(a_, d.x, of[8 * q + 6]); of[8 * q + 7] = fmaf(a_, d.y, of[8 * q + 7]);
    }
}
struct PeerTok { u32x4 w[16]; u32x4 x[4]; };
template <bool USTEP>
__device__ __forceinline__ void peer_issue(PeerTok& k, const Params& p, const unsigned char* tab, int t, int xv, int lane) {
    const int* RIDX = (const int*)(p.ws + WS_RIDX);
    const int i0 = RIDX[(size_t)t * 128 + lane], i1 = RIDX[(size_t)t * 128 + 64 + lane];
    const int es = lane >> 3, ck = lane & 7;
    if (USTEP) { const bf16_t* xp = (const bf16_t*)(p.ws + WS_X2BF) + (size_t)t * D + 256 * xv + 32 * ck;
#pragma unroll
        for (int j = 0; j < 4; ++j) k.x[j] = *(const u32x4*)(xp + 8 * j); }
#pragma unroll
    for (int g = 0; g < 16; ++g) { const int e = __shfl(g < 8 ? i0 : i1, (8 * g + es) & 63); k.w[g] = *(const u32x4*)(tab + (size_t)e * 128 + ck * 16); }
}
__device__ __forceinline__ void peer_u_finish(const PeerTok& k, const Params& p, int t, int xv, int lane) {
    const int es = lane >> 3, ck = lane & 7;
    float xf[32];
#pragma unroll
    for (int j = 0; j < 4; ++j) unpack8(k.x[j], xf + 8 * j);
    float zsel0 = 0.f, zsel1 = 0.f;
#pragma unroll
    for (int g = 0; g < 16; ++g) { u32x4 w_ = k.w[g]; asm volatile("" : "+v"(w_)); float d = dot_chunk(w_, xf);
        d += __int_as_float(__builtin_amdgcn_update_dpp(0, __float_as_int(d), 0xB1, 0xf, 0xf, true));
        d += __int_as_float(__builtin_amdgcn_update_dpp(0, __float_as_int(d), 0x4E, 0xf, 0xf, true));
        d += __int_as_float(__builtin_amdgcn_update_dpp(0, __float_as_int(d), 0x141, 0xf, 0xf, true));
        if (g < 8) { if (ck == g) zsel0 = d; } else { if (ck == g - 8) zsel1 = d; }
        asm volatile("" : "+v"(zsel0), "+v"(zsel1)); }
    float* zp = (float*)(p.ws + WS_ZP) + ((size_t)xv * T + t) * 128;
    zp[8 * ck + es] = zsel0; zp[64 + 8 * ck + es] = zsel1;
}
__device__ __forceinline__ void peer_v_finish(const PeerTok& k, const Params& p, int t, int xv, int lane, LAS float* red) {
    const float* RG = (const float*)(p.ws + WS_RG);
    const float a0 = RG[(size_t)t * 128 + lane], a1 = RG[(size_t)t * 128 + 64 + lane];
    const int es = lane >> 3, ck = lane & 7;
    float of[32];
#pragma unroll
    for (int q = 0; q < 32; ++q) of[q] = 0.f;
#pragma unroll
    for (int g = 0; g < 16; ++g) { const float a = __shfl(g < 8 ? a0 : a1, (8 * g + es) & 63); u32x4 w_ = k.w[g]; asm volatile("" : "+v"(w_)); axpy_chunk(w_, a, of);
        asm volatile("" : "+v"(of[0]), "+v"(of[1]), "+v"(of[2]), "+v"(of[3]), "+v"(of[4]), "+v"(of[5]), "+v"(of[6]), "+v"(of[7]), "+v"(of[8]), "+v"(of[9]), "+v"(of[10]), "+v"(of[11]), "+v"(of[12]), "+v"(of[13]), "+v"(of[14]), "+v"(of[15]));
        asm volatile("" : "+v"(of[16]), "+v"(of[17]), "+v"(of[18]), "+v"(of[19]), "+v"(of[20]), "+v"(of[21]), "+v"(of[22]), "+v"(of[23]), "+v"(of[24]), "+v"(of[25]), "+v"(of[26]), "+v"(of[27]), "+v"(of[28]), "+v"(of[29]), "+v"(of[30]), "+v"(of[31])); }
#pragma unroll
    for (int q = 0; q < 8; ++q) *(LAS f32x4*)(red + es * 256 + ck * 32 + 4 * q) = (f32x4){of[4 * q], of[4 * q + 1], of[4 * q + 2], of[4 * q + 3]};
    f32x4 s = *(const LAS f32x4*)(red + 4 * lane);
#pragma unroll
    for (int r = 1; r < 8; ++r) s = s + *(const LAS f32x4*)(red + r * 256 + 4 * lane);
    f32x4* o4 = (f32x4*)(p.out + (size_t)t * D + 256 * xv + 4 * lane);
    *o4 = *o4 + s;
}
template <bool USTEP>
__device__ __forceinline__ void peer_step(const Params& p, int lane, int wave, LAS float* red, int pos, int nx, int rank, int nloc) {
    for (int xv = pos; xv < 8; xv += nx) {
        const int wx = rank * 8 + wave, nwx = nloc * 8;
        const unsigned char* tab = p.ws + (USTEP ? WS_TABU : WS_TABV) + (size_t)xv * 16384 * 128;
        PeerTok A, B;
        int t = wx;
        if (t < T) peer_issue<USTEP>(A, p, tab, t, xv, lane);
#pragma unroll 1
        for (; t < T; t += 2 * nwx) {
            const bool hb = t + nwx < T;
            if (hb) peer_issue<USTEP>(B, p, tab, t + nwx, xv, lane);
            if (USTEP) peer_u_finish(A, p, t, xv, lane); else peer_v_finish(A, p, t, xv, lane, red);
            if (t + 2 * nwx < T) peer_issue<USTEP>(A, p, tab, t + 2 * nwx, xv, lane);
            if (hb) { if (USTEP) peer_u_finish(B, p, t + nwx, xv, lane); else peer_v_finish(B, p, t + nwx, xv, lane, red); }
        }
    }
}
typedef int v8i_p __attribute__((ext_vector_type(8))); typedef int v4i_t __attribute__((ext_vector_type(4)));
struct PeerTokU { u32x4 w[16]; u32x4 b[2][2]; };
__device__ __forceinline__ void peer_u_issue(PeerTokU& k, const Params& p, const unsigned char* tab, int t, int xv, int lane) {
    const int* RIDX = (const int*)(p.ws + WS_RIDX);
    const int i0 = RIDX[(size_t)t * 128 + lane], i1 = RIDX[(size_t)t * 128 + 64 + lane];
    const int es = lane >> 3, ck = lane & 7, q = lane >> 4;
    const unsigned char* xp = p.ws + WS_X2F8 + (size_t)t * D + 256 * xv + 16 * q;
#pragma unroll
    for (int kb = 0; kb < 2; ++kb) { k.b[kb][0] = *(const u32x4*)(xp + 128 * kb); k.b[kb][1] = *(const u32x4*)(xp + 128 * kb + 64); }

    { const __amdgpu_buffer_rsrc_t trs = __builtin_amdgcn_make_buffer_rsrc((void*)tab, 0, 16384 * 128, 0x00020000);
#pragma unroll
      for (int g = 0; g < 16; ++g) { const int e = __shfl(g < 8 ? i0 : i1, (8 * g + es) & 63); k.w[g] = __builtin_bit_cast(u32x4, __builtin_amdgcn_raw_buffer_load_b128(trs, e * 128 + ck * 16, 0, 0)); } }
}
__device__ __forceinline__ void peer_u_mfma(const PeerTokU& k, const Params& p, int t, int xv, int lane, LAS unsigned char* vl) {
    bf16_t* zp = (bf16_t*)(p.ws + WS_ZP) + ((size_t)xv * T + t) * 128;
    const int es = lane >> 3, ck = lane & 7, r16 = lane & 15, q = lane >> 4;
#pragma unroll
    for (int g = 0; g < 16; ++g) { const int row = 8 * g + es; *(LAS u32x4*)(vl + row * 128 + ((ck ^ (row & 7)) << 4)) = k.w[g]; }
    v8i_p b0, b1;
    { const v4i_t x0 = __builtin_bit_cast(v4i_t, k.b[0][0]), x1 = __builtin_bit_cast(v4i_t, k.b[0][1]), y0 = __builtin_bit_cast(v4i_t, k.b[1][0]), y1 = __builtin_bit_cast(v4i_t, k.b[1][1]);
      b0 = __builtin_shufflevector(x0, x1, 0, 1, 2, 3, 4, 5, 6, 7); b1 = __builtin_shufflevector(y0, y1, 0, 1, 2, 3, 4, 5, 6, 7); }
#pragma unroll
    for (int h = 0; h < 2; ++h) {
        v4i_t a0[4], a1[4];
#pragma unroll
        for (int g = 0; g < 4; ++g) { const int row = 16 * (4 * h + g) + r16;
            a0[g] = __builtin_bit_cast(v4i_t, *(const LAS u32x4*)(vl + row * 128 + ((q ^ (row & 7)) << 4)));
            a1[g] = __builtin_bit_cast(v4i_t, *(const LAS u32x4*)(vl + row * 128 + (((4 + q) ^ (row & 7)) << 4))); }
        f32x4 acc[4];
#pragma unroll
        for (int g = 0; g < 4; ++g) { const v8i_p A0 = {a0[g][0], a0[g][1], a0[g][2], a0[g][3], 0, 0, 0, 0};
            acc[g] = __builtin_amdgcn_mfma_scale_f32_16x16x128_f8f6f4(A0, b0, (f32x4){0.f, 0.f, 0.f, 0.f}, 4, 0, 0, 0x7F7F7F7F, 0, 0x7F7F7F7F); }
#pragma unroll
        for (int g = 0; g < 4; ++g) { const v8i_p A1 = {a1[g][0], a1[g][1], a1[g][2], a1[g][3], 0, 0, 0, 0};
            acc[g] = __builtin_amdgcn_mfma_scale_f32_16x16x128_f8f6f4(A1, b1, acc[g], 4, 0, 0, 0x7F7F7F7F, 0, 0x7F7F7F7F); }
        u32x2 o = {pk2(acc[0][0], acc[0][1]), pk2(acc[0][2], acc[0][3])};
#pragma unroll
        for (int g = 1; g < 4; ++g) { const u32x2 og = {pk2(acc[g][0], acc[g][1]), pk2(acc[g][2], acc[g][3])}; o.x = (r16 == g) ? og.x : o.x; o.y = (r16 == g) ? og.y : o.y; }
        if (r16 < 4) *(u32x2*)(zp + 16 * (4 * h + r16) + 4 * q) = o;
    }
}
__device__ __forceinline__ void peer_u_step(const Params& p, int lane, int wave, LAS unsigned char* vl, int pos, int nx, int rank, int nloc) {
    for (int xv = pos; xv < 8; xv += nx) {
        const int wx = rank * 8 + wave, nwx = nloc * 8;
        const unsigned char* tab = p.ws + WS_TABU + (size_t)xv * 16384 * 128;
        PeerTokU A, B;
        int t = wx;
        if (t < T) peer_u_issue(A, p, tab, t, xv, lane);
#pragma unroll 1
        for (; t < T; t += 2 * nwx) {
            const bool hb = t + nwx < T;
            if (hb) peer_u_issue(B, p, tab, t + nwx, xv, lane);
            peer_u_mfma(A, p, t, xv, lane, vl);
            if (t + 2 * nwx < T) peer_u_issue(A, p, tab, t + 2 * nwx, xv, lane);
            if (hb) peer_u_mfma(B, p, t + nwx, xv, lane, vl);
        }
    }
}
constexpr size_t WS_ACT8 = 34 * MiB, WS_ASC = 36 * MiB;
__device__ __forceinline__ void peer_combine(const Params& p, int t, int lane) {
    const bf16_t* ZP = (const bf16_t*)(p.ws + WS_ZP); const int* RIDX = (const int*)(p.ws + WS_RIDX); const float* RG = (const float*)(p.ws + WS_RG);
    const float* SCU = (const float*)(p.ws + WS_SCU); const float* SCV = (const float*)(p.ws + WS_SCV); const float* SS2 = (const float*)(p.ws + WS_CTL + CTL_SS2_BYTE);
    const float rs = rsqrtf(SS2[t] * (1.f / D) + EPS);
    float act[2];
#pragma unroll
    for (int hlf = 0; hlf < 2; ++hlf) { const size_t o = (size_t)t * 128 + 64 * hlf + lane; float z = 0.f;
#pragma unroll
        for (int x = 0; x < 8; ++x) z += bf2f(ZP[((size_t)x * T) * 128 + o]);
        const int e = RIDX[o];
        act[hlf] = gelu_tanh(z * rs * SCU[e]) * RG[o] * SCV[e]; }
    float mx = fmaxf(fabsf(act[0]), fabsf(act[1]));
#pragma unroll
    for (int o = 1; o < 64; o <<= 1) mx = fmaxf(mx, __shfl_xor(mx, o));
    const float sc = mx > 0.f ? mx * (1.f / 448.f) : 1.f, inv = 1.f / sc;
    unsigned char* a8 = p.ws + WS_ACT8 + (size_t)t * 128;
    a8[lane] = (unsigned char)(__builtin_amdgcn_cvt_pk_fp8_f32(act[0] * inv, 0.f, 0, false) & 0xff);
    a8[64 + lane] = (unsigned char)(__builtin_amdgcn_cvt_pk_fp8_f32(act[1] * inv, 0.f, 0, false) & 0xff);
    if (lane == 0) ((float*)(p.ws + WS_ASC))[t] = sc;
}
typedef int v2i_t __attribute__((ext_vector_type(2)));
struct PeerTokV { u32x4 w[16]; u32x4 b[2]; };
__device__ __forceinline__ void peer_v_issue(PeerTokV& k, const Params& p, const unsigned char* tab, int t, int lane) {
    const int* RIDX = (const int*)(p.ws + WS_RIDX);
    const int i0 = RIDX[(size_t)t * 128 + lane], i1 = RIDX[(size_t)t * 128 + 64 + lane];
    const int es = lane >> 3, ck = lane & 7, q = lane >> 4;
    const unsigned char* ap = p.ws + WS_ACT8 + (size_t)t * 128 + 16 * q;
    k.b[0] = *(const u32x4*)ap; k.b[1] = *(const u32x4*)(ap + 64);

    { const __amdgpu_buffer_rsrc_t trs = __builtin_amdgcn_make_buffer_rsrc((void*)tab, 0, 16384 * 128, 0x00020000);
#pragma unroll
      for (int g = 0; g < 16; ++g) { const int e = __shfl(g < 8 ? i0 : i1, (8 * g + es) & 63); k.w[g] = __builtin_bit_cast(u32x4, __builtin_amdgcn_raw_buffer_load_b128(trs, e * 128 + ck * 16, 0, 0)); } }
}
__device__ __forceinline__ void peer_v_mfma(const PeerTokV& k, const Params& p, int t, int xv, int lane, LAS unsigned char* vl) {
    const int es = lane >> 3, ck = lane & 7, n = lane & 15, q = lane >> 4;
#pragma unroll
    for (int g = 0; g < 16; ++g) { const int row = 8 * g + es; const u32x4 w = k.w[g];
        *(LAS u32x4*)(vl + row * 128 + ((ck ^ ((row >> 1) & 7)) << 4)) = ((g >> 2) & 1) ? (u32x4){w.z, w.w, w.x, w.y} : w; }
    const v4i_t x0 = __builtin_bit_cast(v4i_t, k.b[0]), x1 = __builtin_bit_cast(v4i_t, k.b[1]);
    const v8i_p bop = __builtin_shufflevector(x0, x1, 0, 1, 2, 3, 4, 5, 6, 7);
    const int r1 = 32 * q + n, r2 = r1 + 16;
    f32x4 keep = {0.f, 0.f, 0.f, 0.f};
#pragma unroll
    for (int mb = 0; mb < 16; ++mb) {
        const int sw = ((((mb >> 1) ^ ((r1 >> 1) & 7)) << 4) | (((mb & 1) ^ (q & 1)) << 3));
        const v2i_t t1 = __builtin_amdgcn_ds_read_tr4_b64_v2i32((LAS v2i_t*)(vl + r1 * 128 + sw));
        const v2i_t t2 = __builtin_amdgcn_ds_read_tr4_b64_v2i32((LAS v2i_t*)(vl + r2 * 128 + sw));
        const v8i_p aop = {t1[0], t1[1], t2[0], t2[1], 0, 0, 0, 0};
        f32x4 acc = {0.f, 0.f, 0.f, 0.f};
        acc = __builtin_amdgcn_mfma_scale_f32_16x16x128_f8f6f4(aop, bop, acc, 4, 0, 0, 0x7F7F7F7F, 0, 0x7F7F7F7F);
        if (n == mb) keep = acc;
    }
    const float sc = ((const float*)(p.ws + WS_ASC))[t];
    const size_t oo = (size_t)t * D + 256 * xv + 16 * n + 4 * q;
    const u32x2 xw = *(const u32x2*)((const bf16_t*)(p.ws + WS_X2BF) + oo);
    const f32x4 x2v = {__uint_as_float(xw.x << 16), __uint_as_float(xw.x & 0xffff0000u), __uint_as_float(xw.y << 16), __uint_as_float(xw.y & 0xffff0000u)};
    *(f32x4*)(p.out + oo) = x2v + keep * sc;
}
__device__ __forceinline__ void peer_v_step(const Params& p, int lane, int wave, LAS unsigned char* vl, int pos, int nx, int rank, int nloc) {
    for (int xv = pos; xv < 8; xv += nx) {
        const int wx = rank * 8 + wave, nwx = nloc * 8;
        const unsigned char* tab = p.ws + WS_TABV + (size_t)xv * 16384 * 128;
        PeerTokV A, B;
        int t = wx;
        if (t < T) peer_v_issue(A, p, tab, t, lane);
#pragma unroll 1
        for (; t < T; t += 2 * nwx) {
            const bool hb = t + nwx < T;
            if (hb) peer_v_issue(B, p, tab, t + nwx, lane);
            peer_v_mfma(A, p, t, xv, lane, vl);
            if (t + 2 * nwx < T) peer_v_issue(A, p, tab, t + 2 * nwx, lane);
            if (hb) peer_v_mfma(B, p, t + nwx, xv, lane, vl);
        }
    }
}

namespace pg8 {
#define PG8_LAS __attribute__((address_space(3)))
constexpr int BM = 256, BK = 64, HALF = 128, HTB = HALF * BK * 2, STAGE_BYTES = 8 * HTB, NXCD = 8, WGM = 1;
__host__ __device__ __forceinline__ int lds_byte(int r, int c) { const int st = (r >> 4) * 2 + (c >> 5), rr = r & 15, cc = c & 31, ob = rr * 64 + cc * 2; return st * 1024 + (ob ^ (((ob >> 9) & 1) << 5)); }
__host__ __device__ __forceinline__ void stage_rc(int b, int& R, int& C) { const int st = b / 1024, sb = b % 1024, swz = sb ^ (((sb >> 9) & 1) << 5); R = (st >> 1) * 16 + swz / 64; C = (st & 1) * 32 + (swz % 64) / 2; }
__host__ __device__ __forceinline__ int perm32(int rho) { const int n = rho >> 4, i = rho & 15; return 8 * (i >> 2) + 4 * n + (i & 3); }
struct Unit { const char* A; const char* B; int pm, pn, kind, nt; };
__device__ __forceinline__ const char* uni_ptr(const char* p) { const unsigned long long v = (unsigned long long)p; const unsigned lo = __builtin_amdgcn_readfirstlane((unsigned)v), hi = __builtin_amdgcn_readfirstlane((unsigned)(v >> 32)); return (const char*)(((unsigned long long)hi << 32) | lo); }
__device__ __forceinline__ void uni(Unit& u) { u.A = uni_ptr(u.A); u.B = uni_ptr(u.B); u.pm = __builtin_amdgcn_readfirstlane(u.pm); u.pn = __builtin_amdgcn_readfirstlane(u.pn); u.kind = __builtin_amdgcn_readfirstlane(u.kind); u.nt = __builtin_amdgcn_readfirstlane(u.nt); }
template <int WG = WGM>
__device__ __forceinline__ void tile_of(int L, int nM, int nN, int& pm, int& pn) {
    const int nwg = nM * nN; int wgid = L; { const int q = nwg / NXCD, r = nwg % NXCD, xcd = wgid % NXCD, off = wgid / NXCD; wgid = (xcd < r ? xcd * (q + 1) : r * (q + 1) + (xcd - r) * q) + off; }
    const int nig = WG * nN, gid = wgid / nig, fm = gid * WG, gsz = (nM - fm) < WG ? (nM - fm) : WG;
    pm = fm + ((wgid % nig) % gsz); pn = (wgid % nig) / gsz;
}
typedef int v8i_t __attribute__((ext_vector_type(8))); typedef int v4i_t __attribute__((ext_vector_type(4)));
__device__ __forceinline__ v8i_t cat8(const bf16x8 lo, const bf16x8 hi) { const v4i_t a = __builtin_bit_cast(v4i_t, lo), b = __builtin_bit_cast(v4i_t, hi); return __builtin_shufflevector(a, b, 0, 1, 2, 3, 4, 5, 6, 7); }
template <bool FP8, class Epi, class Sched>
__device__ __forceinline__ void gemm_phase(PG8_LAS unsigned char* lds, const int lda, const int ldb, const Sched& S, const Epi& E, const int wid, const char* wsb) {
    const __amdgpu_buffer_rsrc_t rsrc = __builtin_amdgcn_make_buffer_rsrc((void*)wsb, 0, 0x7fffffff, 0x00020000);
    const int lane = fresh_lane(), tid = wid * 64 + lane, wr = wid >> 2, wc = wid & 3, fr = lane & 15, fq = lane >> 4;
    unsigned voffA[2], voffB[2];
#pragma unroll
    for (int i = 0; i < 2; ++i) { int R, C; stage_rc(tid * 16 + i * 8192, R, C); const int Rb = (R & ~31) + perm32(R & 31);
        voffA[i] = (unsigned)(R * lda + C) * 2u; voffB[i] = (unsigned)(Rb * ldb + C) * 2u; }
    const size_t kstep = (size_t)(BK * 2);
    const size_t hstepA = (size_t)HALF * lda * 2, hstepB = (size_t)HALF * ldb * 2;
    const unsigned ldsw = (unsigned)wid * 1024u;
    const int aoff = lds_byte(wr * 64 + fr, fq * 8), boff = lds_byte(wc * 32 + fr, fq * 8);
#define PG8_SA(b, h) (((b) * 2 + (h)) * HTB)
#define PG8_SB(b, h) ((4 + (b) * 2 + (h)) * HTB)
#define PG8_STAGE(bufoff, gbase, voff) do { _Pragma("unroll") for (int _i = 0; _i < 2; ++_i) \
        __builtin_amdgcn_raw_ptr_buffer_load_lds(rsrc, (PG8_LAS void*)(lds + (bufoff) + ldsw + _i * 8192), 16, (voff)[_i], (unsigned)((const char*)(gbase) - wsb), 0, 0); } while (0)
#define PG8_LDA(dst, b, h) do { _Pragma("unroll") for (int m = 0; m < 4; ++m) { if constexpr (FP8) dst##8[m] = cat8(*(const PG8_LAS bf16x8*)(lds + PG8_SA(b, h) + aoff + m * 2048), *(const PG8_LAS bf16x8*)(lds + PG8_SA(b, h) + aoff + m * 2048 + 1024)); \
        else { _Pragma("unroll") for (int k = 0; k < 2; ++k) dst[m][k] = *(const PG8_LAS bf16x8*)(lds + PG8_SA(b, h) + aoff + m * 2048 + k * 1024); } } } while (0)
#define PG8_LDB(dst, b, h) do { _Pragma("unroll") for (int n = 0; n < 2; ++n) { if constexpr (FP8) dst##8[n] = cat8(*(const PG8_LAS bf16x8*)(lds + PG8_SB(b, h) + boff + n * 2048), *(const PG8_LAS bf16x8*)(lds + PG8_SB(b, h) + boff + n * 2048 + 1024)); \
        else { _Pragma("unroll") for (int k = 0; k < 2; ++k) dst[n][k] = *(const PG8_LAS bf16x8*)(lds + PG8_SB(b, h) + boff + n * 2048 + k * 1024); } } } while (0)
#define PG8_MMA(ai, bj, At, Bt) do { __builtin_amdgcn_s_setprio(1); \
        if constexpr (FP8) { _Pragma("unroll") for (int m = 0; m < 4; ++m) _Pragma("unroll") for (int n = 0; n < 2; ++n) \
            asm volatile("v_mfma_scale_f32_16x16x128_f8f6f4 %0, %1, %2, %0, %3, %3 op_sel_hi:[0,0,0]" : "+v"(acc[ai][bj][m][n]) : "v"(Bt##8[n]), "v"(At##8[m]), "v"(mxone)); } \
        else { _Pragma("unroll") for (int m = 0; m < 4; ++m) _Pragma("unroll") for (int n = 0; n < 2; ++n) _Pragma("unroll") for (int k = 0; k < 2; ++k) \
            acc[ai][bj][m][n] = __builtin_amdgcn_mfma_f32_16x16x32_bf16(Bt[n][k], At[m][k], acc[ai][bj][m][n], 0, 0, 0); } \
        __builtin_amdgcn_s_setprio(0); } while (0)
#define PG8_WAIT_V(n) asm volatile("s_waitcnt vmcnt(" #n ")" ::: "memory")
#define PG8_WAIT_L(n) asm volatile("s_waitcnt lgkmcnt(" #n ")" ::: "memory")
#define PG8_BAR __builtin_amdgcn_s_barrier()
#define PG8_SCHED __builtin_amdgcn_sched_barrier(0)
    Unit cur, nxt; int ui = 0;
    if (!S.next(0, cur)) return;
    f32x4 acc[2][2][4][2];
#pragma unroll
    for (int a = 0; a < 2; ++a)
#pragma unroll
        for (int b = 0; b < 2; ++b)
#pragma unroll
            for (int m = 0; m < 4; ++m)
#pragma unroll
                for (int n = 0; n < 2; ++n) acc[a][b][m][n] = (f32x4){0.f, 0.f, 0.f, 0.f};
    const int mxone = 0x7F7F7F7F;
    bf16x8 At[4][2], B0[2][2], B1[2][2]; v8i_t At8[4], B08[2], B18[2];
    const char* cA = cur.A; const char* cB = cur.B;
    PG8_STAGE(PG8_SB(0, 0), cB, voffB); PG8_STAGE(PG8_SB(0, 1), cB + hstepB, voffB); PG8_STAGE(PG8_SA(0, 0), cA, voffA); PG8_STAGE(PG8_SA(0, 1), cA + hstepA, voffA);
    if (wr == 1) PG8_BAR;
    PG8_WAIT_V(2); PG8_BAR;
    PG8_STAGE(PG8_SB(1, 0), cB + kstep, voffB); PG8_STAGE(PG8_SA(1, 0), cA + kstep, voffA); PG8_STAGE(PG8_SB(1, 1), cB + hstepB + kstep, voffB);
    PG8_WAIT_V(6); PG8_BAR;
    for (;;) {
        const bool has_next = S.next(ui + 1, nxt);
        const char* nA = has_next ? nxt.A : cA; const char* nB = has_next ? nxt.B : cB;
        const int nt = cur.nt;
        for (int t = 0; t < nt; t += 2) {
            const bool last = (t == nt - 2);
            const char* a1 = cA + (size_t)(t + 1) * kstep;
            const char* a2 = last ? nA : cA + (size_t)(t + 2) * kstep; const char* b2 = last ? nB : cB + (size_t)(t + 2) * kstep;
            const char* a3 = a2 + kstep; const char* b3 = b2 + kstep;
            PG8_LDB(B0, 0, 0); PG8_LDB(B1, 0, 1); PG8_SCHED; PG8_LDA(At, 0, 0); PG8_STAGE(PG8_SA(1, 1), a1 + hstepA, voffA);
            PG8_WAIT_V(8); PG8_WAIT_L(0); PG8_BAR; PG8_MMA(0, 0, At, B0); PG8_MMA(0, 1, At, B1); PG8_BAR; PG8_SCHED;
            PG8_LDA(At, 0, 1); PG8_STAGE(PG8_SB(0, 0), b2, voffB); PG8_STAGE(PG8_SB(0, 1), b2 + hstepB, voffB); PG8_STAGE(PG8_SA(0, 0), a2, voffA);
            PG8_WAIT_V(8); PG8_WAIT_L(0); PG8_BAR; PG8_MMA(1, 0, At, B0); PG8_MMA(1, 1, At, B1); PG8_BAR; PG8_SCHED;
            PG8_LDB(B0, 1, 0); PG8_LDB(B1, 1, 1); PG8_SCHED; PG8_LDA(At, 1, 0); PG8_STAGE(PG8_SA(0, 1), a2 + hstepA, voffA);
            PG8_WAIT_V(8); PG8_WAIT_L(0); PG8_BAR; PG8_MMA(0, 0, At, B0); PG8_MMA(0, 1, At, B1); PG8_BAR; PG8_SCHED;
            PG8_LDA(At, 1, 1); PG8_STAGE(PG8_SB(1, 0), b3, voffB); PG8_STAGE(PG8_SB(1, 1), b3 + hstepB, voffB); PG8_STAGE(PG8_SA(1, 0), a3, voffA);
            PG8_WAIT_V(8); PG8_WAIT_L(0); PG8_BAR; PG8_MMA(1, 0, At, B0); PG8_MMA(1, 1, At, B1); PG8_BAR; PG8_SCHED;
        }
        if (wr == 0) PG8_BAR;
        if constexpr (FP8) asm volatile("s_nop 15\n\ts_nop 15" ::: "memory");
        E(acc, cur, wr, wc, fr, fq);
        if (!has_next) break;
        if (E.reset(cur)) {
#pragma unroll
        for (int a = 0; a < 2; ++a)
#pragma unroll
            for (int b = 0; b < 2; ++b)
#pragma unroll
                for (int m = 0; m < 4; ++m)
#pragma unroll
                    for (int n = 0; n < 2; ++n) acc[a][b][m][n] = (f32x4){0.f, 0.f, 0.f, 0.f};
        }
        cur = nxt; cA = nA; cB = nB; ++ui;
        if (wr == 1) PG8_BAR;
    }
    PG8_WAIT_V(0);
    PG8_BAR;
#undef PG8_SA
#undef PG8_SB
#undef PG8_STAGE
#undef PG8_LDA
#undef PG8_LDB
#undef PG8_MMA
#undef PG8_WAIT_V
#undef PG8_WAIT_L
#undef PG8_BAR
#undef PG8_SCHED
}
}
typedef f32x4 AccT[2][2][4][2];
#define EPI_RESET_ALWAYS __device__ __forceinline__ bool reset(const pg8::Unit&) const { return true; }
__device__ __forceinline__ unsigned cvt_pk_bf16(float lo, float hi) { unsigned r; asm volatile("v_cvt_pk_bf16_f32 %0, %1, %2" : "=v"(r) : "v"(lo), "v"(hi)); return r; }
__device__ __forceinline__ u32x4 pack8(const f32x4 v0, const f32x4 v1) { u32x4 w; w.x = cvt_pk_bf16(v0[0], v0[1]); w.y = cvt_pk_bf16(v0[2], v0[3]); w.z = cvt_pk_bf16(v1[0], v1[1]); w.w = cvt_pk_bf16(v1[2], v1[3]); return w; }
template <int MODE>
__device__ __forceinline__ void store_tile_bf16(const AccT& acc, bf16_t* base, int ldc, int row0, int col0, const float* bias, const float ascale = 1.f) {
#pragma unroll
    for (int ai = 0; ai < 2; ++ai)
#pragma unroll
        for (int m = 0; m < 4; ++m) { bf16_t* rowp = base + (size_t)(row0 + ai * 128 + m * 16) * ldc + col0;
#pragma unroll
            for (int bj = 0; bj < 2; ++bj) { f32x4 v0 = acc[ai][bj][m][0], v1 = acc[ai][bj][m][1];
                if (MODE == 1) { _Pragma("unroll") for (int e = 0; e < 4; ++e) { v0[e] = gelu_tanh(v0[e]); v1[e] = gelu_tanh(v1[e]); } }
                if (MODE == 2) { const f32x4 b0 = *(const f32x4*)(bias + col0 + bj * 128), b1 = *(const f32x4*)(bias + col0 + bj * 128 + 4);
                    v0 = v0 * ascale + b0; v1 = v1 * ascale + b1; _Pragma("unroll") for (int e = 0; e < 4; ++e) { v0[e] = sigmoid_(v0[e]); v1[e] = sigmoid_(v1[e]); } }
                *(u32x4*)(rowp + bj * 128) = pack8(v0, v1); }
            if (MODE == 2) asm volatile("" ::: "memory"); }
}
struct SchedP1a { const char* H; const char* WT; const char* MEMN; const char* WTM; int G, c;
    __device__ __forceinline__ bool next(int i, pg8::Unit& u) const {
        const int L = i * G + c; const int n1 = 64 * 18;
        if (L < n1) { pg8::tile_of(L, 64, 18, u.pm, u.pn); u.kind = 0; u.A = H + (size_t)u.pm * 256 * D * 2; u.B = WT + (size_t)u.pn * 256 * D * 2; u.nt = D / 64; pg8::uni(u); return true; }
        if (L < n1 + 8) { const int j = L - n1; u.pm = j >> 2; u.pn = j & 3; u.kind = 1; u.A = MEMN + (size_t)u.pm * 256 * D * 2; u.B = WTM + (size_t)u.pn * 256 * D * 2; u.nt = D / 64; pg8::uni(u); return true; }
        return false; } };
struct EpiP1a { bf16_t* PROJ; bf16_t* MEMKV; const float* gq; const float* gk; const float* gc; const float* gmk; LAS float* xs; EPI_RESET_ALWAYS
    __device__ __forceinline__ void operator()(AccT& acc, const pg8::Unit& u, int wr, int wc, int fr, int fq) const {
        const int row0 = u.pm * 256 + wr * 64 + fr, cl = wc * 32 + 8 * fq;
        const float* g = nullptr; float qs = 1.f;
        if (u.kind == 1) { if (u.pn < 2) g = gmk; }
        else if (u.pn < 4) { g = gq; qs = 0.08838834764831845f; } else if (u.pn < 8) g = gk; else if (u.pn >= 16) { g = gc; qs = 0.08838834764831845f; }
        if (g) {
#pragma unroll
            for (int ai = 0; ai < 2; ++ai)
#pragma unroll
                for (int m = 0; m < 4; ++m)
#pragma unroll
                    for (int bj = 0; bj < 2; ++bj) { const f32x4 v0 = acc[ai][bj][m][0], v1 = acc[ai][bj][m][1];
                        float sq = (v0[0] * v0[0] + v0[1] * v0[1]) + (v0[2] * v0[2] + v0[3] * v0[3]) + (v1[0] * v1[0] + v1[1] * v1[1]) + (v1[2] * v1[2] + v1[3] * v1[3]);
                        sq += __shfl_xor(sq, 16); sq += __shfl_xor(sq, 32);
                        if (fq == 0) xs[((ai * 128 + wr * 64 + m * 16 + fr) * 2 + bj) * 4 + wc] = sq; asm volatile("" ::: "memory"); }
            asm volatile("s_waitcnt lgkmcnt(0)" ::: "memory"); __builtin_amdgcn_s_barrier(); asm volatile("" ::: "memory");
#pragma unroll
            for (int ai = 0; ai < 2; ++ai)
#pragma unroll
                for (int m = 0; m < 4; ++m)
#pragma unroll
                    for (int bj = 0; bj < 2; ++bj) { const f32x4 pp = *(const LAS f32x4*)(xs + ((ai * 128 + wr * 64 + m * 16 + fr) * 2 + bj) * 4);
                        const float rs = rsqrtf(((pp[0] + pp[1]) + (pp[2] + pp[3])) * (1.f / 128.f) + EPS) * qs;
                        const f32x4 g0 = *(const f32x4*)(g + cl), g1 = *(const f32x4*)(g + cl + 4);
                        acc[ai][bj][m][0] = acc[ai][bj][m][0] * g0 * rs; acc[ai][bj][m][1] = acc[ai][bj][m][1] * g1 * rs; asm volatile("" ::: "memory"); }
            asm volatile("s_waitcnt lgkmcnt(0)" ::: "memory"); __builtin_amdgcn_s_barrier(); asm volatile("" ::: "memory");
        }
        if (u.kind == 1) { store_tile_bf16<0>(acc, MEMKV, 2 * CW, row0, u.pn * 256 + cl, nullptr); return; }
        if (u.pn == 14 || u.pn == 15) { store_tile_bf16<1>(acc, PROJ, INW, row0, u.pn * 256 + cl, nullptr); return; }
        store_tile_bf16<0>(acc, PROJ, INW, row0, u.pn * 256 + cl, nullptr);
    } };
struct SchedG { const char* H8; const char* WT8; int G, c, ti;
    __device__ __forceinline__ bool next(int i, pg8::Unit& u) const {
        const int L = ti * G + c; if (i >= 3 || L >= 64 * 8) return false;
        int pn8; pg8::tile_of(L, 64, 8, u.pm, pn8); u.pn = pn8 + 8 * i; u.kind = i; u.A = H8 + (size_t)u.pm * 256 * D; u.B = WT8 + (size_t)u.pn * 256 * D; u.nt = D / 128; pg8::uni(u); return true; } };
struct EpiG { u32x4* slab; const float* bgate; EPI_RESET_ALWAYS
    __device__ __forceinline__ void operator()(AccT& acc, const pg8::Unit& u, int wr, int wc, int fr, int fq) const {
        const int tid = (wr * 4 + wc) * 64 + fq * 16 + fr, col0 = u.pn * 256 + wc * 32 + 8 * fq;
        u32x4* sp = slab + (size_t)u.kind * (16 * 512) + tid; const float ascale = 1.f / GATE_WSCALE;
#pragma unroll
        for (int ai = 0; ai < 2; ++ai)
#pragma unroll
            for (int m = 0; m < 4; ++m) {
#pragma unroll
                for (int bj = 0; bj < 2; ++bj) { f32x4 v0 = acc[ai][bj][m][0], v1 = acc[ai][bj][m][1];
                    const f32x4 b0 = *(const f32x4*)(bgate + col0 + bj * 128), b1 = *(const f32x4*)(bgate + col0 + bj * 128 + 4);
                    v0 = v0 * ascale + b0; v1 = v1 * ascale + b1;
                    _Pragma("unroll") for (int e = 0; e < 4; ++e) { v0[e] = 1.f + __builtin_amdgcn_exp2f(fminf(v0[e], 40.f)); v1[e] = 1.f + __builtin_amdgcn_exp2f(fminf(v1[e], 40.f)); }
                    sp[((ai * 4 + m) * 2 + bj) * 512] = pack8(v0, v1); }
                asm volatile("" ::: "memory"); }
    } };
struct SchedP3 { const char* O; const char* WT; int G, c, ti;
    __device__ __forceinline__ bool next(int i, pg8::Unit& u) const {
        const int seg = i; const int L = ti * G + c; if (i >= 3 || L >= 64 * 8) return false;
        pg8::tile_of(L, 64, 8, u.pm, u.pn); u.kind = seg;
        const int kb = seg == 0 ? 0 : (seg == 1 ? 1024 : 1536);
        u.A = O + ((size_t)u.pm * 256 * D + kb) * 2; u.B = WT + ((size_t)u.pn * 256 * D + kb) * 2; u.nt = seg == 0 ? 16 : 8; pg8::uni(u); return true; } };
struct EpiP3 { const u32x4* slab; bf16_t* MERGED;
    __device__ __forceinline__ bool reset(const pg8::Unit& u) const { return u.kind == 2; }
    __device__ __forceinline__ void operator()(AccT& acc, const pg8::Unit& u, int wr, int wc, int fr, int fq) const {
        const int row0 = u.pm * 256 + wr * 64 + fr, col0 = u.pn * 256 + wc * 32 + 8 * fq, seg = u.kind;
        const u32x4* sa = slab + (size_t)seg * (16 * 512) + ((wr * 4 + wc) * 64 + fq * 16 + fr);
#pragma unroll
        for (int ai = 0; ai < 2; ++ai) {
                u32x4 ga[4][2], gb[4][2];
#pragma unroll
                for (int m = 0; m < 4; ++m)
#pragma unroll
                    for (int bj = 0; bj < 2; ++bj) { const u32x4* gp = sa + ((ai * 4 + m) * 2 + bj) * 512;
                        ga[m][bj] = gp[0]; gb[m][bj] = (seg < 2) ? gp[16 * 512] : (u32x4){0u, 0u, 0u, 0u}; }
#pragma unroll
                for (int m = 0; m < 4; ++m)
#pragma unroll
                    for (int bj = 0; bj < 2; ++bj) {
                        float fa[8], fb[8]; unpack8(ga[m][bj], fa); unpack8(gb[m][bj], fb);
                        if (seg < 2) { _Pragma("unroll") for (int e = 0; e < 8; ++e) fa[e] = fb[e] * __builtin_amdgcn_rcpf(fa[e]); }
                        else { _Pragma("unroll") for (int e = 0; e < 8; ++e) fa[e] = __builtin_amdgcn_rcpf(fa[e]); }
                        f32x4& v0 = acc[ai][bj][m][0]; f32x4& v1 = acc[ai][bj][m][1];
                        v0[0] *= fa[0]; v0[1] *= fa[1]; v0[2] *= fa[2]; v0[3] *= fa[3]; v1[0] *= fa[4]; v1[1] *= fa[5]; v1[2] *= fa[6]; v1[3] *= fa[7];
                        if (seg == 2) *(u32x4*)(MERGED + (size_t)(row0 + ai * 128 + m * 16) * D + col0 + bj * 128) = pack8(v0, v1);
                    }
                asm volatile("" ::: "memory");
            }
    } };
struct SchedSq { const char* A; const char* WT; int G, c;
    __device__ __forceinline__ bool next(int i, pg8::Unit& u) const {
        const int L = i * G + c; if (L >= 64 * 8) return false;
        pg8::tile_of(L, 64, 8, u.pm, u.pn); u.kind = 0; u.A = A + (size_t)u.pm * 256 * D * 2; u.B = WT + (size_t)u.pn * 256 * D * 2; u.nt = D / 64; pg8::uni(u); return true; } };
struct EpiP4 { const float* x; float* out; bf16_t* xb; float* ss; unsigned char* x8; LAS float* xs; EPI_RESET_ALWAYS
    __device__ __forceinline__ void operator()(AccT& acc, const pg8::Unit& u, int wr, int wc, int fr, int fq) const {
        const int row0 = u.pm * 256 + wr * 64 + fr, col0 = u.pn * 256 + wc * 32 + 8 * fq;
#pragma unroll
        for (int ai = 0; ai < 2; ++ai) {
            f32x4 xv[4][2][2];
#pragma unroll
            for (int m = 0; m < 4; ++m)
#pragma unroll
                for (int bj = 0; bj < 2; ++bj) { const size_t o = (size_t)(row0 + ai * 128 + m * 16) * D + col0 + bj * 128; xv[m][bj][0] = *(const f32x4*)(x + o); xv[m][bj][1] = *(const f32x4*)(x + o + 4); }
#pragma unroll
            for (int m = 0; m < 4; ++m) { const size_t row = (size_t)(row0 + ai * 128 + m * 16); float sq = 0.f; unsigned w8[2][2];
#pragma unroll
                for (int bj = 0; bj < 2; ++bj) { const size_t o = row * D + col0 + bj * 128;
                    const f32x4 v0 = acc[ai][bj][m][0] + xv[m][bj][0], v1 = acc[ai][bj][m][1] + xv[m][bj][1];
                    *(u32x4*)(xb + o) = pack8(v0, v1);
#define F8X(x_) fminf(fmaxf((x_), -448.f), 448.f)
                    { int w0 = __builtin_amdgcn_cvt_pk_fp8_f32(F8X(v0[0]), F8X(v0[1]), 0, false); w0 = __builtin_amdgcn_cvt_pk_fp8_f32(F8X(v0[2]), F8X(v0[3]), w0, true);
                      int w1 = __builtin_amdgcn_cvt_pk_fp8_f32(F8X(v1[0]), F8X(v1[1]), 0, false); w1 = __builtin_amdgcn_cvt_pk_fp8_f32(F8X(v1[2]), F8X(v1[3]), w1, true);
                      w8[bj][0] = (unsigned)w0; w8[bj][1] = (unsigned)w1; }
                    sq += (v0[0] * v0[0] + v0[1] * v0[1]) + (v0[2] * v0[2] + v0[3] * v0[3]) + (v1[0] * v1[0] + v1[1] * v1[1]) + (v1[2] * v1[2] + v1[3] * v1[3]); }
                { const auto s0 = __builtin_amdgcn_permlane16_swap(w8[0][0], w8[1][0], false, false), s1 = __builtin_amdgcn_permlane16_swap(w8[0][1], w8[1][1], false, false);
                  const size_t o8 = row * D + col0 + ((fq & 1) ? 128 - 8 : 0);
                  *(u32x4*)(x8 + o8) = (u32x4){s0[0], s1[0], s0[1], s1[1]}; }
                sq += __shfl_xor(sq, 16); sq += __shfl_xor(sq, 32);
                if (fq == 0) xs[(ai * 128 + wr * 64 + m * 16 + fr) * 4 + wc] = sq; }
        }
        asm volatile("s_waitcnt lgkmcnt(0)" ::: "memory"); __builtin_amdgcn_s_barrier(); asm volatile("" ::: "memory");
        if (fq == 0) {
#pragma unroll
            for (int ai = 0; ai < 2; ++ai) { const int rl = ai * 128 + wr * 64 + wc * 16 + fr; const f32x4 pp = *(const LAS f32x4*)(xs + rl * 4);
                atomicAdd(ss + (size_t)(u.pm * 256 + rl), (pp[0] + pp[1]) + (pp[2] + pp[3])); }
        }
        asm volatile("s_waitcnt lgkmcnt(0)" ::: "memory");
    } };
struct EpiP5 { bf16_t* Q; const float* ss; EPI_RESET_ALWAYS
    __device__ __forceinline__ void operator()(AccT& acc, const pg8::Unit& u, int wr, int wc, int fr, int fq) const {
        const int row0 = u.pm * 256 + wr * 64 + fr, col0 = u.pn * 256 + wc * 32 + 8 * fq;
#pragma unroll
        for (int ai = 0; ai < 2; ++ai)
#pragma unroll
            for (int m = 0; m < 4; ++m) { const size_t row = (size_t)(row0 + ai * 128 + m * 16); const float rs = rsqrtf(ss[row] * (1.f / D) + EPS);
#pragma unroll
                for (int bj = 0; bj < 2; ++bj) *(u32x4*)(Q + row * D + col0 + bj * 128) = pack8(acc[ai][bj][m][0] * rs, acc[ai][bj][m][1] * rs); }
    } };


namespace att {
using s16x4  = __attribute__((ext_vector_type(4))) short;
using f32x16 = __attribute__((ext_vector_type(16))) float;
constexpr int NWV = 8, QBLK = 32, KVBLK = 64, DH = 128;
constexpr float THR = 8.f;
constexpr int SHM_V = KVBLK * DH * 2, SHM_K = KVBLK * DH * 2;
constexpr int OFF_WS = 2 * SHM_V + 2 * SHM_K, OFF_BT = OFF_WS + NWV * 64 * 4, OFF_OST = OFF_BT + 1536, LDS_NEED = OFF_OST + NWV * 8192;
#define KSWZ(row, colB) ((row) * 256 + ((colB) ^ (((row) & 7) << 4)))
#define SBAR() __builtin_amdgcn_sched_barrier(0)
__device__ __forceinline__ int crow(int r, int hi) { return (r & 3) + 8 * (r >> 2) + 4 * hi; }
__device__ __forceinline__ unsigned cvtpk(float lo, float hi) { unsigned r; asm volatile("v_cvt_pk_bf16_f32 %0, %1, %2" : "=v"(r) : "v"(lo), "v"(hi)); return r; }
__device__ __forceinline__ void partialSM(f32x16& p0, f32x16& p1, float& m_reg, float& mn, float& alpha) {
  constexpr float C = 1.4426950408889634f;
  float pmax = p0[0];
#pragma unroll
  for (int r = 1; r < 16; ++r) pmax = fmaxf(pmax, p0[r]);
#pragma unroll
  for (int r = 0; r < 16; ++r) pmax = fmaxf(pmax, p1[r]);
  { auto rr = __builtin_amdgcn_permlane32_swap(__float_as_uint(pmax), __float_as_uint(pmax), false, false);
    pmax = fmaxf(__uint_as_float(rr[0]), __uint_as_float(rr[1])); }
  if (__builtin_expect(__all(pmax - m_reg <= THR), 1)) { mn = m_reg; alpha = 1.f; }
  else { mn = fmaxf(m_reg, pmax); alpha = __builtin_amdgcn_exp2f((m_reg - mn) * C); m_reg = mn; }
  float mnC = -mn * C;
#pragma unroll
  for (int r = 0; r < 16; ++r) p0[r] = fmaf(p0[r], C, mnC);
#pragma unroll
  for (int r = 0; r < 16; ++r) p1[r] = fmaf(p1[r], C, mnC);
#pragma unroll
  for (int r = 0; r < 16; ++r) p0[r] = __builtin_amdgcn_exp2f(p0[r]);
}
__device__ __forceinline__ void finishSM(f32x16& p0, f32x16& p1, float alpha, float& l_reg, bf16x8& pa0, bf16x8& pa1, bf16x8& pa2, bf16x8& pa3) {
#pragma unroll
  for (int r = 0; r < 16; ++r) p1[r] = __builtin_amdgcn_exp2f(p1[r]);
  float ps = 0;
#pragma unroll
  for (int r = 0; r < 16; ++r) ps += p0[r];
#pragma unroll
  for (int r = 0; r < 16; ++r) ps += p1[r];
  { auto rr = __builtin_amdgcn_permlane32_swap(__float_as_uint(ps), __float_as_uint(ps), false, false);
    ps = __uint_as_float(rr[0]) + __uint_as_float(rr[1]); }
  l_reg = l_reg * alpha + ps;
#define PK4(P, BASE, OUT) do { unsigned a0 = cvtpk(P[BASE + 0], P[BASE + 1]), a1 = cvtpk(P[BASE + 2], P[BASE + 3]);   \
    unsigned b0 = cvtpk(P[BASE + 4], P[BASE + 5]), b1 = cvtpk(P[BASE + 6], P[BASE + 7]);                              \
    auto r0 = __builtin_amdgcn_permlane32_swap(a0, b0, false, false); auto r1 = __builtin_amdgcn_permlane32_swap(a1, b1, false, false); \
    u32x4 w = {r0[0], r1[0], r0[1], r1[1]}; OUT = *reinterpret_cast<bf16x8*>(&w); } while (0)
  PK4(p0, 0, pa0); PK4(p0, 8, pa1); PK4(p1, 0, pa2); PK4(p1, 8, pa3);
#undef PK4
}
template <bool BIAS>
__device__ __forceinline__ void qkt(f32x16& p0, f32x16& p1, const LAS char* Ks, const LAS char* qs, int r32, int hi, const LAS float* bp) {
  if (BIAS) {
#pragma unroll
    for (int r = 0; r < 16; ++r) { p0[r] = bp[(r & 3) + 8 * (r >> 2)]; p1[r] = bp[32 + (r & 3) + 8 * (r >> 2)]; }
  } else { p0 = f32x16{}; p1 = f32x16{}; }
#pragma unroll
  for (int d0 = 0; d0 < 8; ++d0) { int cb = (d0 * 16 + hi * 8) * 2;
    bf16x8 b0 = *reinterpret_cast<const LAS bf16x8*>(Ks + KSWZ(r32, cb));
    bf16x8 b1 = *reinterpret_cast<const LAS bf16x8*>(Ks + KSWZ(32 + r32, cb));
    const bf16x8 qv = *reinterpret_cast<const LAS bf16x8*>(qs + d0 * 1024);
    p0 = __builtin_amdgcn_mfma_f32_32x32x16_bf16(b0, qv, p0, 0, 0, 0);
    p1 = __builtin_amdgcn_mfma_f32_32x32x16_bf16(b1, qv, p1, 0, 0, 0); }
}
__device__ __forceinline__ int v_st(int k, int c) { const int kk = (k & ~0xC) | ((k & 4) << 1) | ((k & 8) >> 1); return ((kk >> 3) * 4 + (c >> 5)) * 512 + ((kk & 7) * 32 + (c & 31)) * 2; }
__device__ __forceinline__ int v_rd_base(int lane) { return ((lane & 3) << 3) | (((lane >> 2) & 3) << 6) | (((lane >> 4) & 1) << 5) | (((lane >> 5) & 1) << 8); }
constexpr int v_rd_off(int d0, int ks, int half) { return d0 * 512 + ks * 4096 + half * 2048; }
template <int OFF> __device__ __forceinline__ s16x4 tr_read(int vb) {
  s16x4 r; asm volatile("ds_read_b64_tr_b16 %0, %1 offset:%2" : "=&v"(r) : "v"(vb), "i"(OFF) : "memory"); return r;
}
template <int D0> __device__ __forceinline__ void pv_one(f32x16& od, int vb, bf16x8 pa0, bf16x8 pa1, bf16x8 pa2, bf16x8 pa3) {
  const s16x4 l0 = tr_read<v_rd_off(D0, 0, 0)>(vb), h0 = tr_read<v_rd_off(D0, 0, 1)>(vb), l1 = tr_read<v_rd_off(D0, 1, 0)>(vb), h1 = tr_read<v_rd_off(D0, 1, 1)>(vb);
  const s16x4 l2 = tr_read<v_rd_off(D0, 2, 0)>(vb), h2 = tr_read<v_rd_off(D0, 2, 1)>(vb), l3 = tr_read<v_rd_off(D0, 3, 0)>(vb), h3 = tr_read<v_rd_off(D0, 3, 1)>(vb);
  asm volatile("s_waitcnt lgkmcnt(0)" ::: "memory"); SBAR();
#define PK(L, H) (bf16x8){L[0], L[1], L[2], L[3], H[0], H[1], H[2], H[3]}
  od = __builtin_amdgcn_mfma_f32_32x32x16_bf16(pa0, PK(l0, h0), od, 0, 0, 0);
  od = __builtin_amdgcn_mfma_f32_32x32x16_bf16(pa1, PK(l1, h1), od, 0, 0, 0);
  od = __builtin_amdgcn_mfma_f32_32x32x16_bf16(pa2, PK(l2, h2), od, 0, 0, 0);
  od = __builtin_amdgcn_mfma_f32_32x32x16_bf16(pa3, PK(l3, h3), od, 0, 0, 0);
#undef PK
}
__device__ __forceinline__ void pv_d0(f32x16* o, int vb, bf16x8 pa0, bf16x8 pa1, bf16x8 pa2, bf16x8 pa3) {
  pv_one<0>(o[0], vb, pa0, pa1, pa2, pa3); pv_one<1>(o[1], vb, pa0, pa1, pa2, pa3); pv_one<2>(o[2], vb, pa0, pa1, pa2, pa3); pv_one<3>(o[3], vb, pa0, pa1, pa2, pa3);
}
template <int LDQ, int LDK, int LDO, bool BAND>
__device__ __forceinline__ void attn_body(const bf16_t* Qb, const bf16_t* Kh, const bf16_t* Vh, bf16_t* Ob,
                                          const int NT, const int kc0, const float* btab_src, LAS char* lds, const int wid) {
  const int lane = fresh_lane(), tid = wid * 64 + lane, r32 = lane & 31, hi = lane >> 5;
  LAS char* V_lds = lds; LAS char* K_lds = lds + 2 * SHM_V;
  LAS float* wsf = (LAS float*)(lds + OFF_WS) + wid * 64; LAS float* li_l = wsf; LAS float* al_l = wsf + 32;
  LAS float* btab = (LAS float*)(lds + OFF_BT);
  if (BAND) { if (tid < 384) btab[tid] = tid < 64 ? btab_src[256] : (tid < 256 ? btab_src[320 - tid] : -30000.f); }
  float m_reg = -10000.f, l_reg = 0; f32x16 o[4] = {};
  const bf16_t* Qw = Qb + (long)(wid * QBLK + r32) * LDQ + hi * 8;
  LAS char* qr = lds + OFF_OST + wid * 8192 + lane * 16;
#pragma unroll
  for (int d0 = 0; d0 < 8; ++d0) *reinterpret_cast<LAS bf16x8*>(qr + d0 * 1024) = *reinterpret_cast<const bf16x8*>(Qw + d0 * 16);
  const int sr = tid >> 4, sc = (tid & 15) * 8, vst0 = v_st(sr, sc), vst1 = v_st(32 + sr, sc);
  const int vb0 = (int)(unsigned)(uintptr_t)V_lds + v_rd_base(lane);
  struct { bf16x8 vs0, vs1, ks0, ks1; } sr_[1];
  const int pw = wid >> 1, qi = (wid & 1) * 32 + r32;
#define TROW(t) ((BAND ? (((kc0) + (t)) > 0 ? ((kc0) + (t)) : 0) : (t)) * KVBLK)
#define SLOAD(i, t) do { const long k0_ = TROW(t); sr_[i].vs0 = *reinterpret_cast<const bf16x8*>(&Vh[(k0_ + sr) * LDK + sc]); sr_[i].vs1 = *reinterpret_cast<const bf16x8*>(&Vh[(k0_ + 32 + sr) * LDK + sc]); \
    sr_[i].ks0 = *reinterpret_cast<const bf16x8*>(&Kh[(k0_ + sr) * LDK + sc]); sr_[i].ks1 = *reinterpret_cast<const bf16x8*>(&Kh[(k0_ + 32 + sr) * LDK + sc]); } while (0)
#define SWRITE(b, i) do { *(LAS bf16x8*)(V_lds + (b) * SHM_V + vst0) = sr_[i].vs0; *(LAS bf16x8*)(V_lds + (b) * SHM_V + vst1) = sr_[i].vs1; int kc_ = sc * 2; \
    *(LAS bf16x8*)(K_lds + (b) * SHM_K + KSWZ(sr, kc_)) = sr_[i].ks0; *(LAS bf16x8*)(K_lds + (b) * SHM_K + KSWZ(32 + sr, kc_)) = sr_[i].ks1; } while (0)
#define SWAIT() asm volatile("s_waitcnt vmcnt(0)" ::: "memory")
#define RESC(a) do { if (__any((a) < 1.f)) { if (hi == 0) al_l[r32] = (a); asm volatile("s_waitcnt lgkmcnt(0)" ::: "memory"); \
    _Pragma("unroll") for (int d = 0; d < 4; ++d) _Pragma("unroll") for (int r = 0; r < 16; ++r) o[d][r] *= al_l[crow(r, hi)]; } } while (0)
#define BPTR(t) ({ const int t_ = (t); const int dch = pw + 8 - t_; int kb_ = 192 - dch * 64 - qi + 4 * hi; kb_ = kb_ < 0 ? 0 : kb_; \
    if (dch < 0 || dch > 8 || (kc0) + t_ < 0) kb_ = 288; (const LAS float*)(btab + kb_); })
  f32x16 pA0, pA1, pB0, pB1; float mnA, mnB, alA, alB; bf16x8 pa0, pa1, pa2, pa3;
  constexpr int SE = 0, SO = 0;
#define ACT(t) (!BAND || ((pw + 8 - (t)) >= 0 && (pw + 8 - (t)) <= 8 && (kc0) + (t) >= 0))
  SLOAD(SE, 0); asm volatile("s_waitcnt vmcnt(0)" ::: "memory"); SWRITE(0, SE); __syncthreads();
  if (ACT(0)) { qkt<BAND>(pA0, pA1, K_lds, qr, r32, hi, BPTR(0)); partialSM(pA0, pA1, m_reg, mnA, alA); }
  SLOAD(SO, 1);
  SWAIT(); SWRITE(1, SO); __syncthreads();
  for (int j = 1; j + 1 < NT; j += 2) {
    const bool a0_ = ACT(j - 1), a1_ = ACT(j), a2_ = ACT(j + 1);
    SBAR(); if (a1_) qkt<BAND>(pB0, pB1, K_lds + SHM_K, qr, r32, hi, BPTR(j));
    if (a0_) finishSM(pA0, pA1, alA, l_reg, pa0, pa1, pa2, pa3); SBAR();
    SLOAD(SO, j + 1); SBAR();
    if (a0_) pv_d0(o, vb0, pa0, pa1, pa2, pa3); if (a1_) partialSM(pB0, pB1, m_reg, mnB, alB);
    __syncthreads(); SWAIT(); SWRITE(0, SE);
    if (a1_) RESC(alB); __syncthreads();
    SBAR(); if (a2_) qkt<BAND>(pA0, pA1, K_lds, qr, r32, hi, BPTR(j + 1));
    if (a1_) finishSM(pB0, pB1, alB, l_reg, pa0, pa1, pa2, pa3); SBAR();
    SLOAD(SE, j + 2); SBAR();
    if (a1_) pv_d0(o, vb0 + SHM_V, pa0, pa1, pa2, pa3); if (a2_) partialSM(pA0, pA1, m_reg, mnA, alA);
    __syncthreads(); SWAIT(); SWRITE(1, SO);
    if (a2_) RESC(alA); __syncthreads();
  }
  { const bool a0_ = ACT(NT - 2), a1_ = ACT(NT - 1);
    SBAR(); if (a1_) qkt<BAND>(pB0, pB1, K_lds + SHM_K, qr, r32, hi, BPTR(NT - 1));
    if (a0_) finishSM(pA0, pA1, alA, l_reg, pa0, pa1, pa2, pa3); SBAR();
    if (a0_) pv_d0(o, vb0, pa0, pa1, pa2, pa3); if (a1_) partialSM(pB0, pB1, m_reg, mnB, alB);
    __syncthreads(); if (a1_) RESC(alB);
    if (a1_) { finishSM(pB0, pB1, alB, l_reg, pa0, pa1, pa2, pa3); SBAR();
      pv_d0(o, vb0 + SHM_V, pa0, pa1, pa2, pa3); } }
#undef ACT
  if (hi == 0) li_l[r32] = l_reg; asm volatile("s_waitcnt lgkmcnt(0)" ::: "memory");
  float rli[16];
#pragma unroll
  for (int r = 0; r < 16; ++r) rli[r] = __builtin_amdgcn_rcpf(li_l[crow(r, hi)]);
  { LAS bf16_t* stg = (LAS bf16_t*)(lds + OFF_OST + wid * 8192);
#pragma unroll
    for (int r = 0; r < 16; ++r) { const int orow = crow(r, hi);
#pragma unroll
      for (int d0 = 0; d0 < 4; ++d0) stg[orow * 128 + d0 * 32 + r32] = (bf16_t)f2bf(o[d0][r] * rli[r]); }
    asm volatile("s_waitcnt lgkmcnt(0)" ::: "memory");
    bf16_t* Ow = Ob + (long)(wid * QBLK) * LDO;
#pragma unroll
    for (int i = 0; i < 8; ++i) { const int row = i * 4 + (lane >> 4), ch = lane & 15; const u32x4 v = *(const LAS u32x4*)(stg + row * 128 + ch * 8); *(u32x4*)(Ow + (long)row * LDO + ch * 8) = v; } }
  __syncthreads();
#undef TROW
#undef SLOAD
#undef SWRITE
#undef SWAIT
#undef RESC
#undef BPTR
}
#undef KSWZ
#undef SBAR
}


namespace rt {
using f32x16 = __attribute__((ext_vector_type(16))) float;
#define RKSWZ(row, colB) ((row) * 256 + ((colB) ^ (((row) & 7) << 4)))
__device__ __forceinline__ int crow(int r, int hi) { return (r & 3) + 8 * (r >> 2) + 4 * hi; }
__device__ __forceinline__ void ce_desc(unsigned& a, unsigned& b) { const float fa = __uint_as_float(a), fb = __uint_as_float(b); const float mx = fmaxf(fa, fb), mn = fminf(fa, fb); a = __float_as_uint(mx); b = __float_as_uint(mn); }
__device__ __forceinline__ void sort16_desc(unsigned (&v)[16]) {
#define CE_(a_, b_) ce_desc(v[a_], v[b_])
  CE_(0,13); CE_(1,12); CE_(2,15); CE_(3,14); CE_(4,8); CE_(5,6); CE_(7,11); CE_(9,10);
  CE_(0,5); CE_(1,7); CE_(2,9); CE_(3,4); CE_(6,13); CE_(8,14); CE_(10,15); CE_(11,12);
  CE_(0,1); CE_(2,3); CE_(4,5); CE_(6,8); CE_(7,9); CE_(10,11); CE_(12,13); CE_(14,15);
  CE_(0,2); CE_(1,3); CE_(4,10); CE_(5,11); CE_(6,7); CE_(8,9); CE_(12,14); CE_(13,15);
  CE_(1,2); CE_(3,12); CE_(4,6); CE_(5,7); CE_(8,10); CE_(9,11); CE_(13,14);
  CE_(1,4); CE_(2,6); CE_(5,8); CE_(7,10); CE_(9,13); CE_(11,14);
  CE_(2,4); CE_(3,6); CE_(9,12); CE_(11,13);
  CE_(3,5); CE_(6,8); CE_(7,9); CE_(10,12);
  CE_(3,4); CE_(5,6); CE_(7,8); CE_(9,10); CE_(11,12);
  CE_(6,7); CE_(8,9);
#undef CE_
}
__device__ __forceinline__ void merge16_desc(unsigned (&a)[16], const unsigned (&b)[16]) {
#pragma unroll
  for (int i = 0; i < 16; ++i) a[i] = __float_as_uint(fmaxf(__uint_as_float(a[i]), __uint_as_float(b[15 - i])));
#pragma unroll
  for (int j = 8; j > 0; j >>= 1)
#pragma unroll
    for (int i = 0; i < 16; ++i) { const int l = i ^ j; if (l > i) ce_desc(a[i], a[l]); }
}
__device__ __forceinline__ unsigned fkey(float f) { return __float_as_uint(f); }
__device__ __forceinline__ float fkey_inv(unsigned k) { return __uint_as_float(k); }
__device__ __forceinline__ void top16_half(const f32x16 (&sc)[4], int hi, unsigned (&out)[16]) {
  unsigned g[16];
#pragma unroll
  for (int blk = 0; blk < 4; ++blk) {
#pragma unroll
    for (int r = 0; r < 16; ++r) g[r] = (fkey(sc[blk][r]) & 0xFFFFFF80u) | (unsigned)(32 * blk + (r & 3) + 8 * (r >> 2) + 4 * hi);
    sort16_desc(g);
    if (blk == 0) {
#pragma unroll
      for (int r = 0; r < 16; ++r) out[r] = g[r];
    } else merge16_desc(out, g);
  }
  unsigned pb[16];
#pragma unroll
  for (int r = 0; r < 16; ++r) { auto rr = __builtin_amdgcn_permlane32_swap(out[r], out[r], false, false); pb[r] = hi ? rr[0] : rr[1]; }
  merge16_desc(out, pb);
}
__device__ __forceinline__ void route_phase(const Params& p, LAS unsigned char* lds, int wave) {
  const int lane = fresh_lane(), tid = wave * 64 + lane;
  const bf16_t* Q = (const bf16_t*)(p.ws + WS_Q); const bf16_t* KB = (const bf16_t*)(p.ws + WS_KEYSB);
  int* RIDX = (int*)(p.ws + WS_RIDX); float* RG = (float*)(p.ws + WS_RG);
  const int r32 = lane & 31, hi = lane >> 5;
  int hprev = -1;
#pragma unroll 1
  for (int ti = 0; ti * (int)gridDim.x + (int)blockIdx.x < 64 * 8; ++ti) {
  int pm_, h; pg8::tile_of(ti * (int)gridDim.x + (int)blockIdx.x, 64, 8, pm_, h);
  pm_ = __builtin_amdgcn_readfirstlane(pm_); h = __builtin_amdgcn_readfirstlane(h);
  if (h != hprev) { __syncthreads(); hprev = h;
#pragma unroll
  for (int c = 0; c < 2; ++c)
#pragma unroll
    for (int rep = 0; rep < 4; ++rep) { const int row = rep * 32 + (tid >> 4), cb = (tid & 15) * 16;
      *(LAS u32x4*)(lds + c * 32768 + RKSWZ(row, cb)) = *(const u32x4*)((const char*)KB + ((size_t)(h * 2 + c) * 128 + row) * 256 + cb); }
  __syncthreads(); }
  { const int t = pm_ * 256 + wave * 32 + r32;
    unsigned ka[16], kb2[16];
#pragma unroll
    for (int c = 0; c < 2; ++c) {
      bf16x8 qf[8];
      const bf16_t* qp = Q + (size_t)t * D + h * 256 + c * 128 + hi * 8;
#pragma unroll
      for (int ks = 0; ks < 8; ++ks) qf[ks] = *(const bf16x8*)(qp + ks * 16);
      f32x16 sc[4];
#pragma unroll
      for (int blk = 0; blk < 4; ++blk) { sc[blk] = f32x16{};
#pragma unroll
        for (int ks = 0; ks < 8; ++ks) { const bf16x8 kf = *(const LAS bf16x8*)(lds + c * 32768 + RKSWZ(32 * blk + r32, (16 * ks + 8 * hi) * 2));
          sc[blk] = __builtin_amdgcn_mfma_f32_32x32x16_bf16(kf, qf[ks], sc[blk], 0, 0, 0); } }
      if (c == 0) top16_half(sc, hi, ka); else top16_half(sc, hi, kb2);
    }
    float av[16], bv[16];
#pragma unroll
    for (int i = 0; i < 16; ++i) { av[i] = fkey_inv(ka[i] & 0xFFFFFF80u); bv[i] = fkey_inv(kb2[i] & 0xFFFFFF80u); }
    float T[16];
#pragma unroll
    for (int k = 0; k < 16; ++k) T[k] = av[0] + bv[k];
#pragma unroll
    for (int i = 1; i < 16; ++i)
#pragma unroll
      for (int j = 0; j < 16; ++j) if ((i + 1) * (j + 1) <= 16) { const float v = av[i] + bv[j]; constexpr int dummy_ = 0; (void)dummy_;
          const int pm1 = (i + 1) * (j + 1) - 1;
#pragma unroll
          for (int k = 15; k > pm1; --k) T[k] = __builtin_amdgcn_fmed3f(T[k - 1], T[k], v);
          T[pm1] = fmaxf(T[pm1], v); }
    const float m = T[0], theta = T[15];
    float Z = 0.f;
#pragma unroll
    for (int k = 0; k < 16; ++k) Z += __expf(T[k] - m);
    const float rz = 1.f / Z;
    int slot = 0; int cn = 0;
    LAS unsigned char* rsl = lds + 65536 + wave * 4096 + r32 * 128;
#pragma unroll
    for (int i = 0; i < 16; ++i)
#pragma unroll
      for (int j = 0; j < 16; ++j) if ((i + 1) * (j + 1) <= 16) { const float v = av[i] + bv[j];
          const bool sel = (v >= theta) && (slot < 16);
          if (sel && ((cn & 1) == hi)) { *(LAS int*)(rsl + slot * 4) = (int)((ka[i] & 127u) * 128u + (kb2[j] & 127u)); *(LAS float*)(rsl + 64 + slot * 4) = __expf(v - m) * rz; }
          slot += sel ? 1 : 0; ++cn; }
    asm volatile("s_waitcnt lgkmcnt(0)" ::: "memory");
    { const LAS u32x4* sp_ = (const LAS u32x4*)(rsl + 64 * hi); u32x4* dp_ = (u32x4*)((hi ? (char*)RG : (char*)RIDX) + ((size_t)t * 128 + h * 16) * 4);
#pragma unroll
      for (int i = 0; i < 4; ++i) dp_[i] = sp_[i]; }
    asm volatile("s_waitcnt lgkmcnt(0)" ::: "memory");
  }
  }
}
#undef RKSWZ
}

#define XB_TMO      128
#define XB_XCNT(j)  (256  + 64 * (j))
#define XB_XSUB(j)  (1280 + 64 * (j))
#define XB_XGEN(j)  (2304 + 64 * (j))
#define XB_TOP      3328
#define XB_TOPGEN   3392
#define XCD_BAR_WORDS 3456
#define XB_SPIN_CAP (1u << 22)
__device__ __forceinline__ unsigned xb_ld(unsigned* p)              { return __hip_atomic_load(p, __ATOMIC_RELAXED, __HIP_MEMORY_SCOPE_AGENT); }
__device__ __forceinline__ unsigned xb_add(unsigned* p, unsigned v) { return __hip_atomic_fetch_add(p, v, __ATOMIC_RELAXED, __HIP_MEMORY_SCOPE_AGENT); }
__device__ __forceinline__ unsigned xb_xcc_id() { return (unsigned)__builtin_amdgcn_s_getreg((3 << 11) | 20) & 0xFu; }
#define XB_SPIN(cond, bar) do { unsigned _sp = 0; while (cond) { __builtin_amdgcn_s_sleep(1); \
    if ((++_sp & 255u) == 0u) { if (xb_ld(&(bar)[XB_TMO])) break; if (_sp > XB_SPIN_CAP) { atomicAdd(&(bar)[XB_TMO], 1u); break; } } } } while (0)
struct XcdBarrier { unsigned* bar; unsigned x; volatile LAS unsigned* st; int w; };
__device__ __forceinline__ XcdBarrier xcd_barrier_post(unsigned* bar, volatile LAS unsigned* st, const int wave) {
    XcdBarrier b; b.bar = bar; b.x = xb_xcc_id(); b.st = st; b.w = wave;
    if (wave == 0 && fresh_lane() == 0) (void)xb_add(&bar[XB_XCNT(b.x)], 1u);
    return b;
}
__device__ __forceinline__ void xcd_barrier_complete(unsigned* bar, unsigned x, unsigned& nloc, unsigned& nx) {
    const unsigned G = gridDim.x * gridDim.y * gridDim.z;
    unsigned sum, cnt, mine, sp = 0u;
    for (;;) {
        sum = 0u; cnt = 0u; mine = 0u;
#pragma unroll
        for (unsigned j = 0; j < 16; ++j) { const unsigned c = xb_ld(&bar[XB_XCNT(j)]); sum += c; cnt += (c > 0u) ? 1u : 0u; mine = (j == x) ? c : mine; }
        if (sum == G) break;
        __builtin_amdgcn_s_sleep(1);
        if ((++sp & 255u) == 0u) { if (xb_ld(&bar[XB_TMO])) break; if (sp > XB_SPIN_CAP) { atomicAdd(&bar[XB_TMO], 1u); break; } }
    }
    nloc = mine > 0u ? mine : 1u; nx = cnt > 0u ? cnt : 1u;
}
__device__ __forceinline__ void xcd_barrier(const XcdBarrier& b) {
    asm volatile("s_waitcnt vmcnt(0)" ::: "memory");
    __syncthreads();
    if (b.w == 0 && fresh_lane() == 0) {
        unsigned* bar = b.bar;
        __builtin_amdgcn_s_waitcnt(0);
        unsigned nloc = b.st[0], nx = b.st[1];
        if (nloc == 0u) { xcd_barrier_complete(bar, b.x, nloc, nx); b.st[0] = nloc; b.st[1] = nx; }
        const unsigned old = xb_add(&bar[XB_XSUB(b.x)], 1u);
        const unsigned gen = old / nloc;
        if (old + 1u == (gen + 1u) * nloc) {
            __builtin_amdgcn_fence(__ATOMIC_RELEASE, "agent");
            asm volatile("s_waitcnt vmcnt(0)" ::: "memory");
            const unsigned og = xb_add(&bar[XB_TOP], 1u);
            const unsigned tg = og / nx;
            if (og + 1u == (tg + 1u) * nx) xb_add(&bar[XB_TOPGEN], 1u);
            else XB_SPIN(xb_ld(&bar[XB_TOPGEN]) == tg, bar);
            __builtin_amdgcn_fence(__ATOMIC_ACQUIRE, "agent");
            xb_add(&bar[XB_XGEN(b.x)], 1u);
            asm volatile("s_waitcnt vmcnt(0)" ::: "memory");
        } else {
            XB_SPIN(xb_ld(&bar[XB_XGEN(b.x)]) == gen, bar);
            __builtin_amdgcn_fence(__ATOMIC_ACQUIRE, "agent");
            asm volatile("s_waitcnt vmcnt(0)" ::: "memory");
        }
    }
    __syncthreads();
}
constexpr int RING_BYTES = 131072, MISC_OFF = 143360, LDS_BYTES = 147456, NTHREADS = 512;
static_assert(att::LDS_NEED <= MISC_OFF, "attention scratch below the MISC words");
constexpr size_t WS_SLAB = WS_X2BF;

__device__ __forceinline__ void touch_buffer(const void* base, size_t bytes, int cb, int Gd, int tid) {
    const u32x4* b = (const u32x4*)base; const size_t n = bytes / 16, stride = (size_t)Gd * NTHREADS;
    u32x4 acc = {0u, 0u, 0u, 0u};
    for (size_t i = (size_t)cb * NTHREADS + tid; i < n; i += stride) { const u32x4 v = b[i]; acc.x ^= v.x; acc.y ^= v.y; acc.z ^= v.z; acc.w ^= v.w; }
    asm volatile("" :: "v"(acc.x), "v"(acc.y), "v"(acc.z), "v"(acc.w));
}
#define PH_BEGIN(i) unsigned long long t0_##i = 0; if ((PROBE_MASK >> (i)) & 1) t0_##i = __builtin_amdgcn_s_memrealtime();
#define PH_END(i) if ((PROBE_MASK >> (i)) & 1) probe_acc += __builtin_amdgcn_s_memrealtime() - t0_##i;
__global__ void __launch_bounds__(NTHREADS, 2) fwd(Params p) {
    extern __shared__ __attribute__((aligned(16))) unsigned char lds_raw[];
    LAS unsigned char* lds = (LAS unsigned char*)lds_raw;
    volatile LAS unsigned* MISC = (volatile LAS unsigned*)(lds + MISC_OFF);
    const int wave = __builtin_amdgcn_readfirstlane((int)threadIdx.x >> 6);
    const int nwb = NTHREADS / 64;
    const int gw = blockIdx.x * nwb + wave, NW = gridDim.x * nwb;
    const int Gd = gridDim.x, cb = blockIdx.x;
    unsigned char* ws = p.ws;
    bf16_t* WT_IN = (bf16_t*)(ws + WS_WT_IN); bf16_t* WT_GATE = (bf16_t*)(ws + WS_WT_GATE); bf16_t* WT_BR = (bf16_t*)(ws + WS_WT_BR);
    bf16_t* WT_O = (bf16_t*)(ws + WS_WT_O); bf16_t* WT_PQ = (bf16_t*)(ws + WS_WT_PQ); bf16_t* WT_MKV = (bf16_t*)(ws + WS_WT_MKV);
    bf16_t* KEYSB = (bf16_t*)(ws + WS_KEYSB); bf16_t* MEMN = (bf16_t*)(ws + WS_MEMN); bf16_t* MEMKV = (bf16_t*)(ws + WS_MEMKV);
    bf16_t* HO = (bf16_t*)(ws + WS_HO); bf16_t* PROJ = (bf16_t*)(ws + WS_PROJ); bf16_t* G = (bf16_t*)(ws + WS_G);
    bf16_t* MERGED = (bf16_t*)(ws + WS_MERGED); bf16_t* X2BF = (bf16_t*)(ws + WS_X2BF); bf16_t* QB = (bf16_t*)(ws + WS_Q);
        float* SS2 = (float*)(ws + WS_CTL + CTL_SS2_BYTE);
    if ((wave * 64 + fresh_lane()) < 64) MISC[(wave * 64 + fresh_lane())] = 0u;
    __syncthreads();
    XcdBarrier bar = xcd_barrier_post((unsigned*)(ws + WS_CTL + CTL_BAR_BYTE), MISC + 8, wave);
    if ((wave * 64 + fresh_lane()) == 0) MISC[16] = xb_add((unsigned*)(ws + WS_CTL + CTL_RANK_BYTE) + 64 * bar.x, 1u);

    unsigned long long probe_acc = 0;
    PH_BEGIN(0)
    {
        LAS float* scr = (LAS float*)lds + wave * (64 * 33);
        const int I0 = (D / 64) * (INW / 32), I5 = I0 + (D / 64) * (2 * CW / 32);
#define TRJOB(it, jb, li) do { if ((it) < I0) { jb = TrJob{p.in[3], WT_IN, nullptr, D, INW, 0.f}; li = (it); } else { jb = TrJob{p.in[15], WT_MKV, nullptr, D, 2 * CW, 0.f}; li = (it) - I0; } } while (0)
        for (int it = gw; it < I5; it += 2 * NW) {
            TrJob ja, jb2; int la, lb; f32x4 va[8], vb[8];
            TRJOB(it, ja, la); tr_load(ja, la, fresh_lane(), va);
            const bool has2 = it + NW < I5;
            if (has2) { TRJOB(it + NW, jb2, lb); tr_load(jb2, lb, fresh_lane(), vb); }
            tr_store(ja, la, fresh_lane(), va, scr);
            if (has2) tr_store(jb2, lb, fresh_lane(), vb, scr);
        }
#undef TRJOB
        rms_rows(p.in[0], p.in[2], HO, ws + WS_H8, T, gw, NW, fresh_lane());
        rms_rows(p.in[1], p.in[14], MEMN, nullptr, BATCH * NMEM, gw, NW, fresh_lane());
        { float* bg2 = (float*)(ws + WS_CTL + CTL_BG2_BYTE); for (int i = gw * 64 + fresh_lane(); i < GW; i += NW * 64) bg2[i] = p.in[19][i] * NLOG2E; }
        { u32x4* wb = (u32x4*)(ws + WS_CTL + CTL_LRUW_BYTE);
          for (int i = gw * 64 + fresh_lane(); i < 8 * 2 * 4 * 2 * 64; i += NW * 64) { const int ln = i & 63, ks = (i >> 6) & 1, nt = (i >> 7) & 3, gate = (i >> 9) & 1, g_ = i >> 10;
              const float* W = gate ? p.in[11] : p.in[9]; const size_t o = (size_t)(g_ * 64 + 32 * ks + 8 * (ln >> 4)) * 64 + 16 * nt + (ln & 15);
              wb[i] = (u32x4){pk2(W[o], W[o + 64]), pk2(W[o + 128], W[o + 192]), pk2(W[o + 256], W[o + 320]), pk2(W[o + 384], W[o + 448])}; } }
        const float* keys = p.in[24];
        for (int i = gw * 64 + fresh_lane(); i < PH * 2 * NKEYS * 128 / 2; i += NW * 64) ((unsigned*)KEYSB)[i] = pk2(keys[2 * i], keys[2 * i + 1]);
    }
    xcd_barrier(bar);
    PH_END(0)
    PH_BEGIN(1)
    {
        SchedP1a Sa{(const char*)HO, (const char*)WT_IN, (const char*)MEMN, (const char*)WT_MKV, Gd, cb};
        EpiP1a Ea{PROJ, MEMKV, p.in[4], p.in[5], p.in[16], p.in[17], (LAS float*)(lds + RING_BYTES)};
        pg8::gemm_phase<false>(lds, D, D, Sa, Ea, wave, (const char*)ws);
        {
            const int first = (Gd == 256) ? (64 * 18 + 8 - 4 * Gd) : 0;
            if (cb >= first) {
                LAS float* scr = (LAS float*)lds + wave * (64 * 33);
                const int dw = (cb - first) * (NTHREADS / 64) + wave, NWd = (Gd - first) * (NTHREADS / 64);
                const int J1 = (D / 64) * (GW / 32), J2 = J1 + (D / 64) * (D / 32), J3 = J2 + (D / 64) * (D / 32), J4 = J3 + (D / 64) * (D / 32);
#define TRJOB(it, jb, li) do { if ((it) < J1) { jb = TrJob{p.in[18], WT_GATE, nullptr, D, GW, GATE_WSCALE * NLOG2E}; li = (it); } \
            else if ((it) < J2) { jb = TrJob{p.in[20], WT_BR, nullptr, D, D, 0.f}; li = (it) - J1; } else if ((it) < J3) { jb = TrJob{p.in[21], WT_O, nullptr, D, D, 0.f}; li = (it) - J2; } \
            else { jb = TrJob{p.in[23], WT_PQ, p.in[22], D, D, 0.f}; li = (it) - J3; } } while (0)
                for (int it = dw; it < J4; it += 2 * NWd) {
                    TrJob ja, jb2; int la, lb; f32x4 va[8], vb[8];
                    TRJOB(it, ja, la); tr_load(ja, la, fresh_lane(), va);
                    const bool has2 = it + NWd < J4;
                    if (has2) { TRJOB(it + NWd, jb2, lb); tr_load(jb2, lb, fresh_lane(), vb); }
                    tr_store(ja, la, fresh_lane(), va, scr);
                    if (has2) tr_store(jb2, lb, fresh_lane(), vb, scr);
                }
#undef TRJOB
            }
        }
    }
    xcd_barrier(bar);
    PH_END(1)
    PH_BEGIN(2)
    {
        const float qscale = 0.08838834764831845f;
        for (int u = gw; u < BATCH * NCH * 8; u += NW) { const int g = u % 8, c = (u / 8) % NCH, b = u / (8 * NCH);
            LruPre P; lru_issue(P, p, b, c, g, fresh_lane());
            asm volatile("" ::: "memory");
            lru_pass1m(P, p, b, c, g, fresh_lane(), lds + wave * 16384); }
    }
    unsigned* lru_cnt = (unsigned*)(ws + WS_CTL + 32768);
    asm volatile("s_waitcnt vmcnt(0)" ::: "memory"); __syncthreads();
    if ((wave * 64 + fresh_lane()) == 0) { __builtin_amdgcn_fence(__ATOMIC_RELEASE, "agent"); asm volatile("s_waitcnt vmcnt(0)" ::: "memory"); (void)xb_add(lru_cnt, 1u); }
    PH_END(2)
    PH_BEGIN(3)
    {
        const int nA = BATCH * 8 * (NCH / 4), nC = BATCH * 4 * (SEQ / 256);
        PH_BEGIN(9)
        for (int u = cb; u < nA + nC; u += Gd) {
            if (u < nA) {
                const int cg = u % (NCH / 4), h = (u / (NCH / 4)) % 8, b = u / ((NCH / 4) * 8);
                const size_t brow = (size_t)b * SEQ, qrow = brow + (size_t)cg * 256;
                att::attn_body<INW, INW, D, true>(PROJ + qrow * INW + C_QA + h * 128, PROJ + brow * INW + C_KA + h * 128, PROJ + brow * INW + C_VA + h * 128,
                                                  HO + qrow * D + h * 128, 12, cg * 4 - NPREV, p.in[6] + h * 257, (LAS char*)lds, wave);
            } else {
                const int v = u - nA; const int qb = v % (SEQ / 256), h = (v / (SEQ / 256)) % 4, b = v / ((SEQ / 256) * 4);
                const size_t qrow = (size_t)b * SEQ + (size_t)qb * 256;
                att::attn_body<INW, 2 * CW, D, false>(PROJ + qrow * INW + C_QC + h * 128, MEMKV + (size_t)b * NMEM * (2 * CW) + h * 128, MEMKV + (size_t)b * NMEM * (2 * CW) + CW + h * 128,
                                                     HO + qrow * D + AW + LW + h * 128, NMEM / 64, 0, nullptr, (LAS char*)lds, wave);
            }
        }
        PH_END(9)
        PH_BEGIN(10)
        if ((wave * 64 + fresh_lane()) == 0) { XB_SPIN(xb_ld(lru_cnt) < (unsigned)Gd, bar.bar); __builtin_amdgcn_fence(__ATOMIC_ACQUIRE, "agent"); asm volatile("s_waitcnt vmcnt(0)" ::: "memory"); }
        __syncthreads();
        for (int u = gw; u < BATCH * NCH * 8; u += NW) { const int g = u % 8, c = (u / 8) % NCH, b = u / (8 * NCH); lru_pass2(p, b, c, g, fresh_lane()); }
        PH_END(10)
    }
    PH_BEGIN(4)
    {
        u32x4* slab = (u32x4*)(ws + WS_G) + (size_t)cb * (3 * 16 * 512);
        const bool tab_first = ((cb >> 3) & 1) == 0;
        if (tab_first) fp4_tables(p, gw, NW, fresh_lane());
#pragma unroll 1
        for (int ti = 0; ti * Gd < 64 * 8; ++ti) {
            { SchedG S{(const char*)(ws + WS_H8), (const char*)WT_GATE, Gd, cb, ti}; EpiG E{slab, (const float*)(ws + WS_CTL + CTL_BG2_BYTE)};
              pg8::gemm_phase<true>(lds, D / 2, D / 2, S, E, wave, (const char*)ws); }
            if (ti == 0) { if (!tab_first) fp4_tables(p, gw, NW, fresh_lane()); xcd_barrier(bar); PH_END(3) if ((PROBE_MASK >> 4) & 1) t0_4 = __builtin_amdgcn_s_memrealtime(); }
            { SchedP3 S{(const char*)HO, (const char*)WT_BR, Gd, cb, ti}; EpiP3 E{slab, MERGED};
              pg8::gemm_phase<false>(lds, D, D, S, E, wave, (const char*)ws); }
        }
    }
    xcd_barrier(bar);
    PH_END(4)
    PH_BEGIN(5)
    {
        SchedSq S{(const char*)MERGED, (const char*)WT_O, Gd, cb};
        EpiP4 E{p.in[0], p.out, X2BF, SS2, ws + WS_X2F8, (LAS float*)(lds + RING_BYTES)};
        pg8::gemm_phase<false>(lds, D, D, S, E, wave, (const char*)ws);
        touch_buffer(WT_PQ, (size_t)D * D * 2, cb, Gd, (wave * 64 + fresh_lane()));
    }
    xcd_barrier(bar);
    PH_END(5)
    PH_BEGIN(6)
    {
        SchedSq S{(const char*)X2BF, (const char*)WT_PQ, Gd, cb};
        EpiP5 E{QB, SS2};
        pg8::gemm_phase<false>(lds, D, D, S, E, wave, (const char*)ws);
    }
    PH_END(6)
    PH_BEGIN(7)
    asm volatile("s_waitcnt vmcnt(0)" ::: "memory"); __syncthreads();
    rt::route_phase(p, lds, wave);
    xcd_barrier(bar);
    PH_END(7)
    PH_BEGIN(8)
    int ppos, pnx, prank, pnloc;
    { if ((wave * 64 + fresh_lane()) == 0) { unsigned pos = 0, nx = 0; const unsigned* bw = (const unsigned*)(ws + WS_CTL + CTL_BAR_BYTE);
#pragma unroll
          for (unsigned j = 0; j < 16; ++j) { const unsigned cj = xb_ld((unsigned*)&bw[XB_XCNT(j)]); nx += cj > 0u ? 1u : 0u; pos += (cj > 0u && j < bar.x) ? 1u : 0u; }
          MISC[17] = pos; MISC[18] = nx > 0u ? nx : 1u; }
      __syncthreads();
      ppos = (int)MISC[17]; pnx = (int)MISC[18]; prank = (int)MISC[16]; pnloc = (int)MISC[8]; if (pnloc < 1) pnloc = 1; }
    peer_u_step(p, fresh_lane(), wave, lds + wave * 16384, ppos, pnx, prank, pnloc);
    xcd_barrier(bar);
    for (int t = gw; t < T; t += NW) peer_combine(p, t, fresh_lane());
    xcd_barrier(bar);
    peer_v_step(p, fresh_lane(), wave, lds + wave * 16384, ppos, pnx, prank, pnloc);
    if (PROBE_MASK) { __syncthreads(); PH_END(8) const unsigned long long te = __builtin_amdgcn_s_memrealtime(); while (__builtin_amdgcn_s_memrealtime() - te < probe_acc) __builtin_amdgcn_s_sleep(8); }
}

extern "C" void kernel_launch(void* const* d_in, const int* in_sizes, int n_in, void* d_out, int out_size, void* d_ws, size_t ws_size, hipStream_t stream) {
    static int grid = 0;
    if (grid == 0) {
        if (n_in != 27 || out_size != T * D || ws_size < WS_END) { fprintf(stderr, "kernel_launch: unexpected problem (n_in %d out %d ws %zu)\n", n_in, out_size, ws_size); grid = -1; return; }
        int dev = 0, cus = 0, per_cu = 0;
        (void)hipGetDevice(&dev); (void)hipDeviceGetAttribute(&cus, hipDeviceAttributeMultiprocessorCount, dev);
        if (hipFuncSetAttribute((const void*)fwd, hipFuncAttributeMaxDynamicSharedMemorySize, LDS_BYTES) != hipSuccess) { fprintf(stderr, "kernel_launch: hipFuncSetAttribute failed\n"); grid = -1; return; }
        (void)hipOccupancyMaxActiveBlocksPerMultiprocessor(&per_cu, (const void*)fwd, NTHREADS, LDS_BYTES);
        if (per_cu < 1) { fprintf(stderr, "kernel_launch: occupancy query says %d\n", per_cu); grid = -1; return; }
        grid = cus;
    }
    if (grid < 0) return;
    (void)hipMemsetAsync((char*)d_ws + WS_CTL, 0, 1 * MiB, stream);
    Params p{};
    for (int i = 0; i < 27; ++i) p.in[i] = (const float*)d_in[i];
    p.out = (float*)d_out; p.ws = (unsigned char*)d_ws;
    void* args[] = {&p};
    hipError_t e = hipLaunchCooperativeKernel((const void*)fwd, dim3(grid), dim3(NTHREADS), args, LDS_BYTES, stream);
    if (e != hipSuccess) fprintf(stderr, "cooperative launch failed: %s (grid %d)\n", hipGetErrorString(e), grid);
}
```
